# Optimizing an MI355X kernel written in HIP

```python
import math
import jax, jax.numpy as jnp
from jax import lax
import numpy as np

D_MODEL = 1024
BATCH = 8
SEQ = 4096
DEPTH = 1

CTX_LEN = 256
GRID_W = 64
MIX_WIDTH = D_MODEL
ATTN_WIDTH = MIX_WIDTH // 2
HYENA_WIDTH = MIX_WIDTH - ATTN_WIDTH
N_HEADS = 4
V_DIM = ATTN_WIDTH // N_HEADS
QK_DIM = V_DIM // 2
QK_COLS = N_HEADS * 2 * QK_DIM
V_COLS = N_HEADS * V_DIM
HYENA_ORDER = 2
HYENA_COLS = (HYENA_ORDER + 1) * HYENA_WIDTH
IN_COLS = 2 * QK_COLS + V_COLS + HYENA_COLS
SHORT_CONV = 3
N_BANDS = 8
FEAT_DIM = 1 + 2 * N_BANDS
FILTER_HIDDEN = 64
DECAY_TARGET = 1e-2
FAST_DECAY_PCT = 0.3
SLOW_DECAY_PCT = 1.5
N_EXPERTS = 32
TOP_K = 4
D_EXPERT = D_MODEL
SWIGLU_LIMIT = 7.0
SWIGLU_ALPHA = 1.702
EXPERT_BLOCK = 128
Q_BLOCK = 128
ROPE_BASE = 10000.0
EPS = 1e-6
N_MOD = 6

kernel_name = "hybrid_diffattn_hyena_moe_dit"

F32 = jnp.float32


def rms_norm(x, g):
    x32 = x.astype(F32)
    y = x32 * lax.rsqrt(jnp.mean(x32 * x32, axis=-1, keepdims=True) + EPS)
    return (y * g.astype(F32)).astype(x.dtype)


def modulate(h, shift, scale):
    return h * (1 + scale) + shift


def rope_2d(x, row, col):
    half = QK_DIM // 2
    nf = half // 2
    inv = ROPE_BASE ** (-jnp.arange(nf, dtype=F32) / nf)

    def rot(xp, pos):
        ang = pos.astype(F32)[:, None] * inv[None]
        cos = jnp.cos(ang)[None, :, None, None, :].astype(x.dtype)
        sin = jnp.sin(ang)[None, :, None, None, :].astype(x.dtype)
        x1, x2 = xp[..., :nf], xp[..., nf:]
        return jnp.concatenate([x1 * cos - x2 * sin, x2 * cos + x1 * sin], axis=-1)

    return jnp.concatenate([rot(x[..., :half], row), rot(x[..., half:], col)], axis=-1)


def short_conv(u, w, b):
    L = u.shape[1]
    pad = SHORT_CONV // 2
    up = jnp.pad(u, ((0, 0), (pad, pad), (0, 0)))
    y = b
    for j in range(SHORT_CONV):
        y = y + up[:, j:j + L] * w[j]
    return y


def hyena_filters(L, w1, b1, f1, w2, b2, f2, w3):
    pos = jnp.arange(L, dtype=F32)
    tn = pos / L
    bands = jnp.linspace(1e-4, N_BANDS - 1, N_BANDS, dtype=F32)
    ang = (2.0 * math.pi / L) * pos[:, None] * bands[None]
    feats = jnp.concatenate([tn[:, None], jnp.sin(ang), jnp.cos(ang)], axis=-1)
    h = jnp.sin(f1 * (feats @ w1 + b1))
    h = jnp.sin(f2 * (h @ w2 + b2))
    h = (h @ w3).astype(F32)
    deltas = jnp.abs(jnp.linspace(math.log(DECAY_TARGET) / SLOW_DECAY_PCT,
                                  math.log(DECAY_TARGET) / FAST_DECAY_PCT,
                                  HYENA_WIDTH, dtype=F32))
    window = jnp.exp(-tn[:, None] * deltas[None])
    return h.reshape(L, HYENA_ORDER, 2, HYENA_WIDTH) * window[:, None, None, :]


def long_conv_bidir(u, h_fwd, h_bwd, skip):
    L, C = u.shape[1], u.shape[2]
    h_circ = jnp.concatenate([h_fwd[:1] + h_bwd[:1], h_fwd[1:],
                              jnp.zeros((1, C), F32), h_bwd[:0:-1]], axis=0)
    hf = jnp.fft.rfft(h_circ, n=2 * L, axis=0)
    u32 = u.astype(F32)
    uf = jnp.fft.rfft(u32, n=2 * L, axis=1)
    y = jnp.fft.irfft(uf * hf[None], n=2 * L, axis=1)[:, :L]
    return (y + u32 * skip.astype(F32)).astype(u.dtype)


def hyena_mixer(u, conv_w, conv_b, filters, skip):
    u = short_conv(u, conv_w, conv_b)
    v, x1, x2 = jnp.split(u, 3, axis=-1)
    z = v
    for n, gate in enumerate((x1, x2)):
        z = gate * long_conv_bidir(z, filters[:, n, 0], filters[:, n, 1], skip[n])
    return z


def diff_attend(q, k, v, lam):
    s = jnp.einsum('bqhmd,bkhmd->bhmqk', q, k).astype(F32) * (QK_DIM ** -0.5)
    p = jax.nn.softmax(s, axis=-1)
    a = p[:, :, 0] - lam * p[:, :, 1]
    return jnp.einsum('bhqk,bkhd->bqhd', a.astype(v.dtype), v)


def diff_attention_blocked(q, k_all, v_all, lam):
    B, L = q.shape[:2]
    nb = L // Q_BLOCK
    qb = q.reshape(B, nb, Q_BLOCK, N_HEADS, 2, QK_DIM).swapaxes(0, 1)
    out = lax.map(lambda qi: diff_attend(qi, k_all, v_all, lam), qb)
    return out.swapaxes(0, 1).reshape(B, L, N_HEADS, V_DIM)


def moe(h, router_w, router_b, w1, b1, w2, b2):
    T, D = h.shape
    logits = (h @ router_w + router_b).astype(F32)
    top_val, top_idx = lax.top_k(logits, TOP_K)
    gates = jax.nn.softmax(top_val, axis=-1)
    n_assign = T * TOP_K
    flat_e = top_idx.reshape(-1)
    flat_tok = jnp.arange(n_assign) // TOP_K
    order = jnp.argsort(flat_e)
    e_sorted = flat_e[order]
    tok_sorted = flat_tok[order]
    gate_sorted = gates.reshape(-1)[order]
    counts = jnp.bincount(flat_e, length=N_EXPERTS)
    padded = ((counts + EXPERT_BLOCK - 1) // EXPERT_BLOCK) * EXPERT_BLOCK
    start = jnp.cumsum(counts) - counts
    pend = jnp.cumsum(padded)
    pstart = pend - padded
    dest = pstart[e_sorted] + (jnp.arange(n_assign) - start[e_sorted])
    n_blocks = -(-n_assign // EXPERT_BLOCK) + N_EXPERTS
    buf = jnp.zeros((n_blocks * EXPERT_BLOCK, D), h.dtype).at[dest].set(h[tok_sorted])
    block_e = jnp.clip(jnp.searchsorted(pend, jnp.arange(n_blocks) * EXPERT_BLOCK, side='right'),
                       0, N_EXPERTS - 1)

    def expert_block(args):
        xb, e = args
        gl = xb @ w1[e] + b1[e]
        g, lin = gl[:, :D_EXPERT], gl[:, D_EXPERT:]
        g = jnp.minimum(g, SWIGLU_LIMIT)
        lin = jnp.clip(lin, -SWIGLU_LIMIT, SWIGLU_LIMIT)
        glu = g * jax.nn.sigmoid(SWIGLU_ALPHA * g)
        return ((lin + 1) * glu) @ w2[e] + b2[e]

    out_buf = lax.map(expert_block, (buf.reshape(n_blocks, EXPERT_BLOCK, D), block_e))
    y = out_buf.reshape(-1, D)[dest] * gate_sorted[:, None].astype(h.dtype)
    return jax.ops.segment_sum(y, tok_sorted, num_segments=T)


def trunk_layer(x, ctx, c, c_ctx, p, lam_init, update_ctx):
    B, S, D = x.shape
    Lc = ctx.shape[1]
    ROWS = S // GRID_W
    row = jnp.repeat(jnp.arange(ROWS), GRID_W)
    col = jnp.tile(jnp.arange(GRID_W), ROWS)

    mod_x = (jax.nn.silu(c) @ p['w_mod'] + p['b_mod']).reshape(B, N_MOD, 1, D)
    mod_c = (jax.nn.silu(c_ctx) @ p['w_mod'] + p['b_mod']).reshape(1, N_MOD, 1, D)
    sh1, sc1, g1, sh2, sc2, g2 = [mod_x[:, i] for i in range(N_MOD)]
    csh1, csc1, cg1, csh2, csc2, cg2 = [mod_c[:, i] for i in range(N_MOD)]

    w_in = p['w_in']
    lam = (jnp.exp(jnp.sum(p['lam_q1'].astype(F32) * p['lam_k1'].astype(F32)))
           - jnp.exp(jnp.sum(p['lam_q2'].astype(F32) * p['lam_k2'].astype(F32))) + lam_init)

    h = modulate(rms_norm(x, p['norm1_g']), sh1, sc1)
    hc = modulate(rms_norm(ctx, p['norm1_g']), csh1, csc1)
    proj = h @ w_in
    q = proj[..., :QK_COLS].reshape(B, S, N_HEADS, 2, QK_DIM)
    k = proj[..., QK_COLS:2 * QK_COLS].reshape(B, S, N_HEADS, 2, QK_DIM)
    v = proj[..., 2 * QK_COLS:2 * QK_COLS + V_COLS].reshape(B, S, N_HEADS, V_DIM)
    u_hy = proj[..., 2 * QK_COLS + V_COLS:]
    q = rope_2d(rms_norm(q, p['q_norm_g']), row, col)
    k = rope_2d(rms_norm(k, p['k_norm_g']), row, col)

    kv_c = hc @ w_in[:, QK_COLS:2 * QK_COLS + V_COLS]
    k_c = rms_norm(kv_c[..., :QK_COLS].reshape(B, Lc, N_HEADS, 2, QK_DIM), p['k_norm_g'])
    v_c = kv_c[..., QK_COLS:].reshape(B, Lc, N_HEADS, V_DIM)

    k_all = jnp.concatenate([k_c, k], axis=1)
    v_all = jnp.concatenate([v_c, v], axis=1)
    attn = diff_attention_blocked(q, k_all, v_all, lam)
    attn = (rms_norm(attn, p['subln_g']) * (1.0 - lam_init)).reshape(B, S, ATTN_WIDTH)

    filt_x = hyena_filters(S, p['hy_w1'], p['hy_b1'], p['hy_f1'], p['hy_w2'], p['hy_b2'], p['hy_f2'], p['hy_w3'])
    hy = hyena_mixer(u_hy, p['hy_conv_w'], p['hy_conv_b'], filt_x, p['hy_skip'])
    mix = jnp.concatenate([attn, rms_norm(hy, p['hy_out_g'])], axis=-1) @ p['w_out']
    x_new = x + g1 * mix

    h2 = modulate(rms_norm(x_new, p['norm2_g']), sh2, sc2)
    ffn = moe(h2.reshape(B * S, D), p['router_w'], p['router_b'],
              p['exp_w1'], p['exp_b1'], p['exp_w2'], p['exp_b2']).reshape(B, S, D)
    x_new = x_new + g2 * ffn

    if update_ctx:
        q_c = rms_norm((hc @ w_in[:, :QK_COLS]).reshape(B, Lc, N_HEADS, 2, QK_DIM), p['q_norm_g'])
        attn_c = diff_attend(q_c, k_c, v_c, lam)
        attn_c = (rms_norm(attn_c, p['subln_g']) * (1.0 - lam_init)).reshape(B, Lc, ATTN_WIDTH)
        filt_c = hyena_filters(Lc, p['hy_w1'], p['hy_b1'], p['hy_f1'], p['hy_w2'], p['hy_b2'], p['hy_f2'], p['hy_w3'])
        hy_c = hyena_mixer(hc @ w_in[:, 2 * QK_COLS + V_COLS:], p['hy_conv_w'], p['hy_conv_b'], filt_c, p['hy_skip'])
        mix_c = jnp.concatenate([attn_c, rms_norm(hy_c, p['hy_out_g'])], axis=-1) @ p['w_out']
        ctx = ctx + cg1 * mix_c
        hc2 = modulate(rms_norm(ctx, p['norm2_g']), csh2, csc2)
        ffn_c = moe(hc2.reshape(B * Lc, D), p['router_w'], p['router_b'],
                    p['exp_w1'], p['exp_b1'], p['exp_w2'], p['exp_b2']).reshape(B, Lc, D)
        ctx = ctx + cg2 * ffn_c
    return x_new, ctx


def setup_inputs(seed: int = 0) -> dict:
    key = jax.random.key(seed)
    ks = iter(jax.random.split(key, 40))

    def nrm(shape, scale):
        return jax.random.normal(next(ks), shape, F32) * scale

    def gain(shape):
        return 1.0 + nrm(shape, 0.01)

    L = DEPTH
    return {
        'x': nrm((BATCH, SEQ, D_MODEL), 1.0),
        'c': nrm((BATCH, D_MODEL), 1.0),
        'ctx': nrm((BATCH, CTX_LEN, D_MODEL), 1.0),
        'c_ctx': nrm((D_MODEL,), 1.0),
        'w_mod': nrm((L, D_MODEL, N_MOD * D_MODEL), 0.5 * D_MODEL ** -0.5),
        'b_mod': nrm((L, N_MOD * D_MODEL), 0.01),
        'norm1_g': gain((L, D_MODEL)),
        'norm2_g': gain((L, D_MODEL)),
        'w_in': nrm((L, D_MODEL, IN_COLS), D_MODEL ** -0.5),
        'q_norm_g': gain((L, QK_DIM)),
        'k_norm_g': gain((L, QK_DIM)),
        'lam_q1': nrm((L, QK_DIM), 0.1),
        'lam_k1': nrm((L, QK_DIM), 0.1),
        'lam_q2': nrm((L, QK_DIM), 0.1),
        'lam_k2': nrm((L, QK_DIM), 0.1),
        'subln_g': gain((L, V_DIM)),
        'hy_conv_w': nrm((L, SHORT_CONV, HYENA_COLS), SHORT_CONV ** -0.5),
        'hy_conv_b': nrm((L, HYENA_COLS), 0.01),
        'hy_w1': nrm((L, FEAT_DIM, FILTER_HIDDEN), FEAT_DIM ** -0.5),
        'hy_b1': nrm((L, FILTER_HIDDEN), 0.01),
        'hy_f1': gain((L, FILTER_HIDDEN)),
        'hy_w2': nrm((L, FILTER_HIDDEN, FILTER_HIDDEN), FILTER_HIDDEN ** -0.5),
        'hy_b2': nrm((L, FILTER_HIDDEN), 0.01),
        'hy_f2': gain((L, FILTER_HIDDEN)),
        'hy_w3': nrm((L, FILTER_HIDDEN, HYENA_ORDER * 2 * HYENA_WIDTH), 0.07 * FILTER_HIDDEN ** -0.5),
        'hy_skip': nrm((L, HYENA_ORDER, HYENA_WIDTH), 0.1),
        'hy_out_g': gain((L, HYENA_WIDTH)),
        'w_out': nrm((L, MIX_WIDTH, D_MODEL), MIX_WIDTH ** -0.5),
        'router_w': nrm((L, D_MODEL, N_EXPERTS), D_MODEL ** -0.5),
        'router_b': nrm((L, N_EXPERTS), 0.01),
        'exp_w1': nrm((L, N_EXPERTS, D_MODEL, 2 * D_EXPERT), D_MODEL ** -0.5),
        'exp_b1': nrm((L, N_EXPERTS, 2 * D_EXPERT), 0.01),
        'exp_w2': nrm((L, N_EXPERTS, D_EXPERT, D_MODEL), D_EXPERT ** -0.5),
        'exp_b2': nrm((L, N_EXPERTS, D_MODEL), 0.01),
    }


def reference(x, c, ctx, c_ctx, w_mod, b_mod, norm1_g, norm2_g, w_in, q_norm_g, k_norm_g,
              lam_q1, lam_k1, lam_q2, lam_k2, subln_g, hy_conv_w, hy_conv_b, hy_w1, hy_b1,
              hy_f1, hy_w2, hy_b2, hy_f2, hy_w3, hy_skip, hy_out_g, w_out, router_w, router_b,
              exp_w1, exp_b1, exp_w2, exp_b2):
    for l in range(DEPTH):
        p = {
            'w_mod': w_mod[l], 'b_mod': b_mod[l], 'norm1_g': norm1_g[l], 'norm2_g': norm2_g[l],
            'w_in': w_in[l], 'q_norm_g': q_norm_g[l], 'k_norm_g': k_norm_g[l],
            'lam_q1': lam_q1[l], 'lam_k1': lam_k1[l], 'lam_q2': lam_q2[l], 'lam_k2': lam_k2[l],
            'subln_g': subln_g[l], 'hy_conv_w': hy_conv_w[l], 'hy_conv_b': hy_conv_b[l],
            'hy_w1': hy_w1[l], 'hy_b1': hy_b1[l], 'hy_f1': hy_f1[l], 'hy_w2': hy_w2[l],
            'hy_b2': hy_b2[l], 'hy_f2': hy_f2[l], 'hy_w3': hy_w3[l], 'hy_skip': hy_skip[l],
            'hy_out_g': hy_out_g[l], 'w_out': w_out[l], 'router_w': router_w[l],
            'router_b': router_b[l], 'exp_w1': exp_w1[l], 'exp_b1': exp_b1[l],
            'exp_w2': exp_w2[l], 'exp_b2': exp_b2[l],
        }
        lam_init = 0.8 - 0.6 * math.exp(-0.3 * l)
        x, ctx = trunk_layer(x, ctx, c, c_ctx, p, lam_init, update_ctx=(l < DEPTH - 1))
    return x
```

```cpp
#include <hip/hip_runtime.h>
#include <hip/hip_bf16.h>
#include <cstdio>
#include <cstdint>

#ifndef MK_N_LAUNCHES
#define MK_N_LAUNCHES 1
#endif
#ifndef MK_LAST_PHASE
#define MK_LAST_PHASE 10
#endif

#define GAS __attribute__((address_space(1)))
#define LAS __attribute__((address_space(3)))
typedef unsigned short bf16_t;
typedef short bf16x8 __attribute__((ext_vector_type(8)));
typedef short s16x4 __attribute__((ext_vector_type(4)));
typedef float f32x2 __attribute__((ext_vector_type(2)));
typedef float f32x4 __attribute__((ext_vector_type(4)));
typedef float f32x16 __attribute__((ext_vector_type(16)));
typedef unsigned u32x2 __attribute__((ext_vector_type(2)));
typedef unsigned u32x4 __attribute__((ext_vector_type(4)));
typedef GAS unsigned gu32;

constexpr int NB = 8, SEQ = 4096, DM = 1024, MROWS = NB * SEQ, CTXL = 256, MCTX = NB * CTXL, MTOT = MROWS + MCTX;
constexpr int KVL = CTXL + SEQ;
constexpr int NHEAD = 4, QKW = 512;
constexpr int HYW = 512, HYC = 1536, INC = 3072, QKVC = 1536;
constexpr int NEXP = 32, TOPK = 4, NMOD = 6;
constexpr float EPS = 1e-6f;
constexpr float LAM_INIT = 0.2f;
constexpr float QSCALE = 0.125f * 1.4426950408889634f;

constexpr size_t MiB = 1u << 20;
constexpr size_t WS_CTL = 0, CTL_ZERO_BYTES = 1 * MiB;
constexpr size_t WS_SMALL = 1 * MiB;
constexpr size_t WS_WIN = 2 * MiB;
constexpr size_t WS_WOUT = 8 * MiB;
constexpr size_t WS_W1 = 10 * MiB;
constexpr size_t WS_W2 = 138 * MiB;
constexpr size_t WS_H = 202 * MiB;
constexpr size_t WS_Q = 270 * MiB;
constexpr size_t WS_K = 302 * MiB;
constexpr size_t WS_V = 336 * MiB;
constexpr size_t WS_UT = 370 * MiB;
constexpr size_t WS_FILT = 466 * MiB;
constexpr size_t WS_Z2T = 498 * MiB;
constexpr size_t WS_MIX = 530 * MiB;
constexpr size_t WS_ROUTE = 594 * MiB;
constexpr size_t WS_ACT = 270 * MiB;
constexpr size_t WS_EO = 598 * MiB;
constexpr size_t WS_END = 872 * MiB;
constexpr size_t SM_MOD = 0;
constexpr size_t SM_SCAL = 256 * 1024;
constexpr size_t SM_ROPE = 260 * 1024;
constexpr int CW_BAR = 4096;

constexpr int RING_BYTES = 131072;
constexpr int LDSCTL_OFF = 151552;
constexpr int LDS_BYTES = 152576;
constexpr int NWAVES = 8;

#define LDS_WAIT() asm volatile("s_waitcnt lgkmcnt(0)" ::: "memory")
#define VM_WAIT() asm volatile("s_waitcnt vmcnt(0)" ::: "memory")
#define RLX_AGENT __ATOMIC_RELAXED, __HIP_MEMORY_SCOPE_AGENT

__device__ __forceinline__ unsigned cvt_pk_bf16(float lo, float hi) { unsigned r; asm volatile("v_cvt_pk_bf16_f32 %0, %1, %2" : "=v"(r) : "v"(lo), "v"(hi)); return r; }
__device__ __forceinline__ float bf2f(bf16_t v) { return __uint_as_float(((unsigned)v) << 16); }
__device__ __forceinline__ float wave_sum(float v) {
#pragma unroll
    for (int o = 1; o < 64; o <<= 1) v += __shfl_xor(v, o);
    return v;
}

#define XB_TMO      128
#define XB_XCNT(j)  (256  + 64 * (j))
#define XB_XSUB(j)  (1280 + 64 * (j))
#define XB_XGEN(j)  (2304 + 64 * (j))
#define XB_TOP      3328
#define XB_TOPGEN   3392
#define XCD_BAR_WORDS 3456
#define XB_SPIN_CAP (1u << 22)
__device__ __forceinline__ unsigned xb_ld(unsigned* p)              { return __hip_atomic_load(p, __ATOMIC_RELAXED, __HIP_MEMORY_SCOPE_AGENT); }
__device__ __forceinline__ unsigned xb_add(unsigned* p, unsigned v) { return __hip_atomic_fetch_add(p, v, __ATOMIC_RELAXED, __HIP_MEMORY_SCOPE_AGENT); }
__device__ __forceinline__ unsigned xb_xcc_id() { return (unsigned)__builtin_amdgcn_s_getreg((3 << 11) | 20) & 0xFu; }
#define XB_SPIN(cond, bar) do { unsigned _sp = 0; while (cond) { __builtin_amdgcn_s_sleep(1); \
    if ((++_sp & 255u) == 0u) { if (xb_ld(&(bar)[XB_TMO])) break; if (_sp > XB_SPIN_CAP) { atomicAdd(&(bar)[XB_TMO], 1u); break; } } } } while (0)
struct XcdBarrier { unsigned* bar; unsigned x; volatile LAS unsigned* st; };
__device__ __forceinline__ XcdBarrier xcd_barrier_post(unsigned* bar, volatile LAS unsigned* st, bool leader) {
    XcdBarrier b; b.bar = bar; b.x = xb_xcc_id(); b.st = st;
    if (leader) (void)xb_add(&bar[XB_XCNT(b.x)], 1u);
    return b;
}
__device__ __forceinline__ void xcd_barrier_complete(unsigned* bar, unsigned x, unsigned& nloc, unsigned& nx) {
    const unsigned G = gridDim.x * gridDim.y * gridDim.z;
    unsigned sum, cnt, mine, sp = 0u;
    for (;;) {
        sum = 0u; cnt = 0u; mine = 0u;
#pragma unroll
        for (unsigned j = 0; j < 16; ++j) { const unsigned c = xb_ld(&bar[XB_XCNT(j)]); sum += c; cnt += (c > 0u) ? 1u : 0u; mine = (j == x) ? c : mine; }
        if (sum == G) break;
        __builtin_amdgcn_s_sleep(1);
        if ((++sp & 255u) == 0u) { if (xb_ld(&bar[XB_TMO])) break; if (sp > XB_SPIN_CAP) { atomicAdd(&bar[XB_TMO], 1u); break; } }
    }
    nloc = mine > 0u ? mine : 1u; nx = cnt > 0u ? cnt : 1u;
}
__device__ __forceinline__ void xcd_barrier(const XcdBarrier& b, bool leader) {
    asm volatile("s_waitcnt vmcnt(0)" ::: "memory");
    __syncthreads();
    if (leader) {
        unsigned* bar = b.bar;
        __builtin_amdgcn_s_waitcnt(0);
        unsigned nloc = b.st[0], nx = b.st[1];
        if (nloc == 0u) { xcd_barrier_complete(bar, b.x, nloc, nx); b.st[0] = nloc; b.st[1] = nx; }
        const unsigned old = xb_add(&bar[XB_XSUB(b.x)], 1u);
        const unsigned gen = old / nloc;
        if (old + 1u == (gen + 1u) * nloc) {
            __builtin_amdgcn_fence(__ATOMIC_RELEASE, "agent");
            asm volatile("s_waitcnt vmcnt(0)" ::: "memory");
            const unsigned og = xb_add(&bar[XB_TOP], 1u);
            const unsigned tg = og / nx;
            if (og + 1u == (tg + 1u) * nx) xb_add(&bar[XB_TOPGEN], 1u);
            else XB_SPIN(xb_ld(&bar[XB_TOPGEN]) == tg, bar);
            __builtin_amdgcn_fence(__ATOMIC_ACQUIRE, "agent");
            xb_add(&bar[XB_XGEN(b.x)], 1u);
            asm volatile("s_waitcnt vmcnt(0)" ::: "memory");
        } else {
            XB_SPIN(xb_ld(&bar[XB_XGEN(b.x)]) == gen, bar);
            __builtin_amdgcn_fence(__ATOMIC_ACQUIRE, "agent");
            asm volatile("s_waitcnt vmcnt(0)" ::: "memory");
        }
    }
    __syncthreads();
}

namespace g8 {
constexpr int BM = 256, BK = 64, HALF = 128, HTB = HALF * BK * 2, STAGE_BYTES = 8 * HTB, NXCD = 8, WGM = 8;
__host__ __device__ __forceinline__ int lds_byte(int r, int c) { const int st = (r >> 4) * 2 + (c >> 5), rr = r & 15, cc = c & 31, ob = rr * 64 + cc * 2; return st * 1024 + (ob ^ (((ob >> 9) & 1) << 5)); }
__host__ __device__ __forceinline__ void stage_rc(int b, int& R, int& C) { const int st = b / 1024, sb = b % 1024, swz = sb ^ (((sb >> 9) & 1) << 5); R = (st >> 1) * 16 + swz / 64; C = (st & 1) * 32 + (swz % 64) / 2; }
__host__ __device__ __forceinline__ int perm32(int rho) { const int n = rho >> 4, i = rho & 15; return 8 * (i >> 2) + 4 * n + (i & 3); }

struct Unit { const char* a; const char* b; int pm, pn, kind, ex; };

__device__ __forceinline__ void tile_of(int L, int nM, int nN, int& pm, int& pn) {
    const int nwg = nM * nN; int wgid = L;
    { const int q = nwg / NXCD, r = nwg % NXCD, xcd = wgid % NXCD, off = wgid / NXCD; wgid = (xcd < r ? xcd * (q + 1) : r * (q + 1) + (xcd - r) * q) + off; }
    const int nig = WGM * nN, gid = wgid / nig, fm = gid * WGM, gsz = (nM - fm) < WGM ? (nM - fm) : WGM;
    pm = fm + ((wgid % nig) % gsz); pn = (wgid % nig) / gsz;
}

template <class Epi, class Sched>
__device__ __forceinline__ void gemm_phase(LAS unsigned char* lds, const int K, const Sched& S, const Epi& E, const int wid, const int lane) {
    const int tid = wid * 64 + lane, wr = wid >> 2, wc = wid & 3, fr = lane & 15, fq = lane >> 4;
    const int nt = K / BK;
    unsigned voffA[2], voffB[2];
#pragma unroll
    for (int i = 0; i < 2; ++i) { int R, C; stage_rc(tid * 16 + i * 8192, R, C); const int Rb = (R & ~31) + perm32(R & 31);
        voffA[i] = (unsigned)(R * K + C) * 2u; voffB[i] = (unsigned)(Rb * K + C) * 2u; }
    const size_t kstep = (size_t)(BK * 2);
    const size_t hstep = (size_t)HALF * K * 2;
    const unsigned ldsw = (unsigned)wid * 1024u;
    const int aoff = lds_byte(wr * 64 + fr, fq * 8), boff = lds_byte(wc * 32 + fr, fq * 8);
#define PG8_SA(b, h) (((b) * 2 + (h)) * HTB)
#define PG8_SB(b, h) ((4 + (b) * 2 + (h)) * HTB)
#define PG8_STAGE(bufoff, gbase, voff) do { _Pragma("unroll") for (int _i = 0; _i < 2; ++_i) \
        __builtin_amdgcn_global_load_lds((const unsigned*)((const char*)(gbase) + (voff)[_i]), (LAS unsigned*)(lds + (bufoff) + ldsw + _i * 8192), 16, 0, 0); } while (0)
#define PG8_LDA(dst, b, h) do { _Pragma("unroll") for (int m = 0; m < 4; ++m) _Pragma("unroll") for (int k = 0; k < 2; ++k) dst[m][k] = *(const LAS bf16x8*)(lds + PG8_SA(b, h) + aoff + m * 2048 + k * 1024); } while (0)
#define PG8_LDB(dst, b, h) do { _Pragma("unroll") for (int n = 0; n < 2; ++n) _Pragma("unroll") for (int k = 0; k < 2; ++k) dst[n][k] = *(const LAS bf16x8*)(lds + PG8_SB(b, h) + boff + n * 2048 + k * 1024); } while (0)
#define PG8_MMA(ai, bj, At, Bt) do { __builtin_amdgcn_s_setprio(1); _Pragma("unroll") for (int m = 0; m < 4; ++m) _Pragma("unroll") for (int n = 0; n < 2; ++n) _Pragma("unroll") for (int k = 0; k < 2; ++k) \
        acc[ai][bj][m][n] = __builtin_amdgcn_mfma_f32_16x16x32_bf16(Bt[n][k], At[m][k], acc[ai][bj][m][n], 0, 0, 0); __builtin_amdgcn_s_setprio(0); } while (0)
#define PG8_WAIT_V(n) asm volatile("s_waitcnt vmcnt(" #n ")" ::: "memory")
#define PG8_WAIT_L(n) asm volatile("s_waitcnt lgkmcnt(" #n ")" ::: "memory")
#define PG8_BAR __builtin_amdgcn_s_barrier()
#define PG8_SCHED __builtin_amdgcn_sched_barrier(0)
    Unit cur, nxt; int ui = 0;
    if (!S.next(0, cur)) return;
    f32x4 acc[2][2][4][2];
#pragma unroll
    for (int a = 0; a < 2; ++a)
#pragma unroll
        for (int b = 0; b < 2; ++b)
#pragma unroll
            for (int m = 0; m < 4; ++m)
#pragma unroll
                for (int n = 0; n < 2; ++n) acc[a][b][m][n] = (f32x4){0.f, 0.f, 0.f, 0.f};
    bf16x8 At[4][2], B0[2][2], B1[2][2];
    const char* cA = cur.a; const char* cB = cur.b;
    PG8_STAGE(PG8_SB(0, 0), cB, voffB); PG8_STAGE(PG8_SB(0, 1), cB + hstep, voffB); PG8_STAGE(PG8_SA(0, 0), cA, voffA); PG8_STAGE(PG8_SA(0, 1), cA + hstep, voffA);
    if (wr == 1) PG8_BAR;
    PG8_WAIT_V(2); PG8_BAR;
    PG8_STAGE(PG8_SB(1, 0), cB + kstep, voffB); PG8_STAGE(PG8_SA(1, 0), cA + kstep, voffA); PG8_STAGE(PG8_SB(1, 1), cB + hstep + kstep, voffB);
    PG8_WAIT_V(6); PG8_BAR;
    for (;;) {
        const bool has_next = S.next(ui + 1, nxt);
        const char* nA = has_next ? nxt.a : cA; const char* nB = has_next ? nxt.b : cB;
        for (int t = 0; t < nt; t += 2) {
            const bool last = (t == nt - 2);
            const char* a1 = cA + (size_t)(t + 1) * kstep;
            const char* a2 = last ? nA : cA + (size_t)(t + 2) * kstep; const char* b2 = last ? nB : cB + (size_t)(t + 2) * kstep;
            const char* a3 = a2 + kstep; const char* b3 = b2 + kstep;
            PG8_LDB(B0, 0, 0); PG8_LDB(B1, 0, 1); PG8_SCHED; PG8_LDA(At, 0, 0); PG8_STAGE(PG8_SA(1, 1), a1 + hstep, voffA);
            PG8_WAIT_V(8); PG8_WAIT_L(0); PG8_BAR; PG8_MMA(0, 0, At, B0); PG8_MMA(0, 1, At, B1); PG8_BAR; PG8_SCHED;
            PG8_LDA(At, 0, 1); PG8_STAGE(PG8_SB(0, 0), b2, voffB); PG8_STAGE(PG8_SB(0, 1), b2 + hstep, voffB); PG8_STAGE(PG8_SA(0, 0), a2, voffA);
            PG8_WAIT_V(8); PG8_WAIT_L(0); PG8_BAR; PG8_MMA(1, 0, At, B0); PG8_MMA(1, 1, At, B1); PG8_BAR; PG8_SCHED;
            PG8_LDB(B0, 1, 0); PG8_LDB(B1, 1, 1); PG8_SCHED; PG8_LDA(At, 1, 0); PG8_STAGE(PG8_SA(0, 1), a2 + hstep, voffA);
            PG8_WAIT_V(8); PG8_WAIT_L(0); PG8_BAR; PG8_MMA(0, 0, At, B0); PG8_MMA(0, 1, At, B1); PG8_BAR; PG8_SCHED;
            PG8_LDA(At, 1, 1); PG8_STAGE(PG8_SB(1, 0), b3, voffB); PG8_STAGE(PG8_SB(1, 1), b3 + hstep, voffB); PG8_STAGE(PG8_SA(1, 0), a3, voffA);
            PG8_WAIT_V(8); PG8_WAIT_L(0); PG8_BAR; PG8_MMA(1, 0, At, B0); PG8_MMA(1, 1, At, B1); PG8_BAR; PG8_SCHED;
        }
        if (wr == 0) PG8_BAR;
        E(acc, cur, wr, wc, fr, fq);
        if (!has_next) break;
#pragma unroll
        for (int a = 0; a < 2; ++a)
#pragma unroll
            for (int b = 0; b < 2; ++b)
#pragma unroll
                for (int m = 0; m < 4; ++m)
#pragma unroll
                    for (int n = 0; n < 2; ++n) acc[a][b][m][n] = (f32x4){0.f, 0.f, 0.f, 0.f};
        cur = nxt; cA = nA; cB = nB; ++ui;
        if (wr == 1) PG8_BAR;
    }
    PG8_WAIT_V(0);
    PG8_BAR;
#undef PG8_SA
#undef PG8_SB
#undef PG8_STAGE
#undef PG8_LDA
#undef PG8_LDB
#undef PG8_MMA
#undef PG8_WAIT_V
#undef PG8_WAIT_L
#undef PG8_BAR
#undef PG8_SCHED
}
}

__device__ __forceinline__ int lane_id() { int l; asm volatile("v_mbcnt_lo_u32_b32 %0, -1, 0\n\tv_mbcnt_hi_u32_b32 %0, -1, %0" : "=v"(l)); return l; }
#define FT_DECL const int f_lane = lane_id(), f_tid = F.wave * 64 + f_lane; (void)f_tid; (void)f_lane
typedef const float* cfp_t;
typedef __attribute__((address_space(4))) cfp_t* kin_t;
struct Frame {
    LAS unsigned char* lds;
    volatile LAS unsigned* MISC;
    gu32* ctl;
    int wave, vcu, G;
    kin_t in;
    float* out;
    unsigned char* ws;
};
#define WSP(T, off) ((T*)(F.ws + (off)))

template <class RowMap>
__device__ __forceinline__ void p0_transpose_item(const float* W, int K, int N, bf16_t* WT, const RowMap& rowmap, const float* kscale, LAS float* scr, int item, int lane) {
    const int nblk = N / 32, kb = item / nblk, nb = item % nblk, k0 = 64 * kb, n0 = 32 * nb;
#pragma unroll 8
    for (int i = 0; i < 32; ++i) { const int kk = 2 * i + (lane >> 5); float v = W[(size_t)(k0 + kk) * N + n0 + (lane & 31)]; if (kscale) v *= kscale[k0 + kk]; scr[kk * 33 + (lane & 31)] = v; }
    LDS_WAIT(); asm volatile("" ::: "memory");
    const int c = lane & 7;
#pragma unroll
    for (int j = 0; j < 4; ++j) { const int n = (lane >> 3) + 8 * j; const LAS float* s = scr + (8 * c) * 33 + n;
        u32x4 o; o.x = cvt_pk_bf16(s[0 * 33], s[1 * 33]); o.y = cvt_pk_bf16(s[2 * 33], s[3 * 33]); o.z = cvt_pk_bf16(s[4 * 33], s[5 * 33]); o.w = cvt_pk_bf16(s[6 * 33], s[7 * 33]);
        *(GAS u32x4*)(WT + (size_t)rowmap(n0 + n) * K + k0 + 8 * c) = o; }
    LDS_WAIT(); asm volatile("" ::: "memory");
}
struct MapIdent { int off; __device__ __forceinline__ int operator()(int n) const { return off + n; } };
struct MapWin { __device__ __forceinline__ int operator()(int l) const {
    if (l >= QKVC) return l;
    const int t = l & ~255, r = l & 255, wc = r >> 6, blk = (r >> 5) & 1, bj = (r >> 4) & 1, low = r & 15;
    return t + 128 * bj + 32 * wc + 16 * blk + low; } };
struct MapW1 { int off; __device__ __forceinline__ int operator()(int jp) const { const int bj = jp >> 10, j = jp & 1023; return off + 256 * (j >> 7) + 128 * bj + (j & 127); } };


__device__ __forceinline__ void p0_filter_item(Frame& F, int item) {
    FT_DECL;
#define in F.in
    LAS float* h1s = (LAS float*)(F.lds);
    LAS float* h2s = (LAS float*)(F.lds + 4096);
    const int t0 = item * 16;
    {
        const int tt = f_tid >> 5, hh = (f_tid & 31) * 2; const float pos = (float)(t0 + tt);
        float feats[17]; feats[0] = pos * (1.f / SEQ);
#pragma unroll
        for (int i = 0; i < 8; ++i) { const float band = 1e-4f + (float)i * ((7.f - 1e-4f) / 7.f); const float ang = (6.283185307179586f / SEQ) * pos * band; feats[1 + i] = sinf(ang); feats[9 + i] = cosf(ang); }
#pragma unroll
        for (int u = 0; u < 2; ++u) { const int h = hh + u; float a = in[19][h];
#pragma unroll
            for (int k = 0; k < 17; ++k) a += feats[k] * in[18][k * 64 + h];
            h1s[tt * 64 + h] = sinf(in[20][h] * a); }
        __syncthreads();
#pragma unroll
        for (int u = 0; u < 2; ++u) { const int h = hh + u; float a = in[22][h];
#pragma unroll 8
            for (int k = 0; k < 64; ++k) a += h1s[tt * 64 + k] * in[21][k * 64 + h];
            h2s[tt * 64 + h] = sinf(in[23][h] * a); }
        __syncthreads();
    }
    f32x4 acc[16];
#pragma unroll
    for (int t = 0; t < 16; ++t) acc[t] = (f32x4){0.f, 0.f, 0.f, 0.f};
    const int o = 4 * f_tid;
    for (int k = 0; k < 64; ++k) { const f32x4 w = *(const f32x4*)(in[24] + (size_t)k * 2048 + o);
#pragma unroll
        for (int t = 0; t < 16; ++t) acc[t] += w * h2s[t * 64 + k]; }
    const int c0 = o & 511, od = o >> 9;
    float* dst = WSP(float, WS_FILT) + ((size_t)od * 512 + c0) * SEQ + t0;
#pragma unroll
    for (int e = 0; e < 4; ++e) { const float la = -3.0701134573253944f, lb = -15.350567286626972f; const float delta = fabsf(la + (float)(c0 + e) * ((lb - la) / 511.f));
#pragma unroll
        for (int q = 0; q < 4; ++q) { f32x4 v;
#pragma unroll
            for (int i = 0; i < 4; ++i) { const int t = 4 * q + i; const float tn = (float)(t0 + t) * (1.f / SEQ); v[i] = acc[t][e] * expf(-tn * delta); }
            *(f32x4*)(dst + (size_t)e * SEQ + 4 * q) = v; } }
    __syncthreads();
#undef in
}

__device__ __forceinline__ float silu_f(float v) { return v / (1.f + __expf(-v)); }

__device__ __forceinline__ void p0_prologue(Frame& F) {
    FT_DECL;
#define in F.in
    const int wg = blockIdx.x;
    if (wg < 96) {
        LAS float* sv = (LAS float*)F.lds;
        for (int i = f_tid; i < 9 * 1024; i += 512) { const int r = i >> 10, k = i & 1023; const float c = (r < 8) ? in[1][r * 1024 + k] : in[3][k]; sv[i] = silu_f(c); }
        __syncthreads();
        const int j = wg * 64 + f_lane; const float* wm = in[4];
        float acc[9];
#pragma unroll
        for (int r = 0; r < 9; ++r) acc[r] = 0.f;
        const int kbeg = F.wave * 128;
#pragma unroll 4
        for (int k = kbeg; k < kbeg + 128; ++k) { const float w = wm[(size_t)k * (NMOD * DM) + j];
#pragma unroll
            for (int r = 0; r < 9; ++r) acc[r] += sv[r * 1024 + k] * w; }
        LAS float* red = (LAS float*)(F.lds + 40960);
#pragma unroll
        for (int r = 0; r < 9; ++r) red[(F.wave * 9 + r) * 64 + f_lane] = acc[r];
        __syncthreads();
        for (int i = f_tid; i < 9 * 64; i += 512) { const int r = i >> 6, l = i & 63; float s = in[5][wg * 64 + l];
#pragma unroll
            for (int w = 0; w < 8; ++w) s += red[(w * 9 + r) * 64 + l];
            WSP(float, WS_SMALL + SM_MOD)[r * (NMOD * DM) + wg * 64 + l] = s; }
        __syncthreads();
    } else if (wg == 96) {
        if (F.wave == 0) {
            const float a = wave_sum(in[11][f_lane] * in[12][f_lane]), b = wave_sum(in[13][f_lane] * in[14][f_lane]);
            float gq = fabsf(in[9][f_lane]), gk = fabsf(in[10][f_lane]);
#pragma unroll
            for (int o = 1; o < 64; o <<= 1) { gq = fmaxf(gq, __shfl_xor(gq, o)); gk = fmaxf(gk, __shfl_xor(gk, o)); }
            if (f_lane == 0) { float* sc = WSP(float, WS_SMALL + SM_SCAL); sc[0] = expf(a) - expf(b) + LAM_INIT;
                sc[1] = (8.f * gq * gk * 1.02f + 0.05f) * 1.4426950408889634f; }
        }
        for (int i = f_tid; i < 64 * 16; i += 512) { const int pos = i >> 4, f = i & 15;
            const float inv = powf(10000.f, -(float)f / 16.f); const float ang = (float)pos * inv;
            float* rt = WSP(float, WS_SMALL + SM_ROPE); rt[2 * i] = cosf(ang); rt[2 * i + 1] = sinf(ang); }
    }
    __syncthreads();
    for (int it = wg; it < SEQ / 16; it += F.G) p0_filter_item(F, it);
    {
        LAS float* scr = (LAS float*)(F.lds + 65536 + F.wave * 8704);
        const int gw = F.vcu * NWAVES + F.wave, NGW = F.G * NWAVES;
        constexpr int I_IN = (DM / 64) * (INC / 32), I_OUT = (DM / 64) * (DM / 32), I_1 = (DM / 64) * (2 * DM / 32), I_2 = (DM / 64) * (DM / 32);
        constexpr int NITEMS = I_IN + I_OUT + NEXP * (I_1 + I_2);
        for (int it = gw; it < NITEMS; it += NGW) {
            int r = it;
            if (r < I_IN) { p0_transpose_item(in[8], DM, INC, WSP(bf16_t, WS_WIN), MapWin{}, nullptr, scr, r, f_lane); continue; } r -= I_IN;
            if (r < I_OUT) { p0_transpose_item(in[27], DM, DM, WSP(bf16_t, WS_WOUT), MapIdent{0}, nullptr, scr, r, f_lane); continue; } r -= I_OUT;
            const int e = r / (I_1 + I_2); r -= e * (I_1 + I_2);
            if (r < I_1) p0_transpose_item(in[30] + (size_t)e * DM * 2 * DM, DM, 2 * DM, WSP(bf16_t, WS_W1) + (size_t)e * 2 * DM * DM, MapW1{0}, nullptr, scr, r, f_lane);
            else p0_transpose_item(in[32] + (size_t)e * DM * DM, DM, DM, WSP(bf16_t, WS_W2) + (size_t)e * DM * DM, MapIdent{0}, nullptr, scr, r - I_1, f_lane);
        }
    }
}

#undef in
__device__ __forceinline__ void p1_norm1(Frame& F) {
    FT_DECL;
    const int gw = F.vcu * NWAVES + F.wave, NGW = F.G * NWAVES;
    const float* mod = WSP(float, WS_SMALL + SM_MOD); const float* g1 = F.in[6];
    bf16_t* H = WSP(bf16_t, WS_H);
    for (int m = gw; m < MTOT; m += NGW) {
        const float* xrow = (m < MROWS) ? F.in[0] + (size_t)m * DM : F.in[2] + (size_t)(m - MROWS) * DM;
        const int mb = (m < MROWS) ? (m >> 12) : 8;
        const float* sh = mod + (size_t)mb * (NMOD * DM); const float* sc = sh + DM;
        const GAS f32x4* xr = (const GAS f32x4*)xrow + f_lane;
        f32x4 v[4]; float s = 0.f;
#pragma unroll
        for (int j = 0; j < 4; ++j) { v[j] = xr[64 * j]; s += (v[j].x * v[j].x + v[j].y * v[j].y) + (v[j].z * v[j].z + v[j].w * v[j].w); }
        const float rstd = rsqrtf(wave_sum(s) * (1.f / DM) + EPS);
        GAS u32x2* o8 = (GAS u32x2*)(H + (size_t)m * DM) + f_lane;
#pragma unroll
        for (int j = 0; j < 4; ++j) { const int c = 4 * f_lane + 256 * j;
            const f32x4 g = *(const f32x4*)(g1 + c), a = *(const f32x4*)(sc + c), b = *(const f32x4*)(sh + c);
            const f32x4 y = v[j] * rstd * g * (a + 1.f) + b;
            u32x2 w; w.x = cvt_pk_bf16(y.x, y.y); w.y = cvt_pk_bf16(y.z, y.w); o8[64 * j] = w; }
    }
}

struct SchedInProj {
    int G, c; const char* H; const char* W;
    static constexpr int NA = 136 * 6, NBU = 6 * 128;
    __device__ __forceinline__ bool next(int i, g8::Unit& u) const {
        const long L = (long)i * G + c;
        if (L < NA) { g8::tile_of((int)L, 136, 6, u.pm, u.pn); u.a = H + (size_t)u.pm * 256 * DM * 2; u.b = W + (size_t)u.pn * 256 * DM * 2; u.kind = 0; u.ex = 0; return true; }
        if (L < NA + NBU) { g8::tile_of((int)L - NA, 6, 128, u.pm, u.pn); u.a = W + (size_t)(QKVC + u.pm * 256) * DM * 2; u.b = H + (size_t)u.pn * 256 * DM * 2; u.kind = 1; u.ex = 0; return true; }
        return false;
    }
};
struct EpiInProj {
    bf16_t *Q, *Kb, *Vb, *UT; const float *gq, *gk, *rope;
    __device__ __forceinline__ void operator()(f32x4 (&acc)[2][2][4][2], const g8::Unit& u, int wr, int wc, int fr, int fq) const {
        if (u.kind == 1) {
            const int row0 = u.pm * 256 + wr * 64 + fr, col0 = u.pn * 256 + wc * 32 + 8 * fq;
#pragma unroll
            for (int ai = 0; ai < 2; ++ai)
#pragma unroll
                for (int m = 0; m < 4; ++m) { bf16_t* rowp = UT + (size_t)(row0 + ai * 128 + m * 16) * MROWS + col0;
#pragma unroll
                    for (int bj = 0; bj < 2; ++bj) { const f32x4 v0 = acc[ai][bj][m][0], v1 = acc[ai][bj][m][1];
                        u32x4 w; w.x = cvt_pk_bf16(v0[0], v0[1]); w.y = cvt_pk_bf16(v0[2], v0[3]); w.z = cvt_pk_bf16(v1[0], v1[1]); w.w = cvt_pk_bf16(v1[2], v1[3]);
                        *(u32x4*)(rowp + bj * 128) = w; } }
            return;
        }
        const int blk = fq >> 1, f = fq & 1;
        const int sec = u.pn >> 1;
        const bool ctx = (u.pm >= 128);
        if (sec == 0 && ctx) return;
        const int colbase = (u.pn & 1) * 256 + wc * 64 + 32 * blk + 8 * f;
        float gg[2][2][4];
        if (sec < 2) { const float* gp = (sec == 0 ? gq : gk) + 32 * blk + 8 * f;
#pragma unroll
            for (int bj = 0; bj < 2; ++bj)
#pragma unroll
                for (int n = 0; n < 2; ++n) { const f32x4 t = *(const f32x4*)(gp + 16 * bj + 4 * n); gg[bj][n][0] = t[0]; gg[bj][n][1] = t[1]; gg[bj][n][2] = t[2]; gg[bj][n][3] = t[3]; } }
#pragma unroll
        for (int ai = 0; ai < 2; ++ai)
#pragma unroll
            for (int m = 0; m < 4; ++m) {
                const int rloc = ai * 128 + wr * 64 + m * 16 + fr; const int r = u.pm * 256 + rloc;
                f32x4 v[2][2];
#pragma unroll
                for (int bj = 0; bj < 2; ++bj)
#pragma unroll
                    for (int n = 0; n < 2; ++n) v[bj][n] = acc[ai][bj][m][n];
                size_t orow;
                if (sec == 0) orow = (size_t)r;
                else if (!ctx) orow = (size_t)(r >> 12) * KVL + CTXL + (r & 4095);
                else { const int j = r - MROWS; orow = (size_t)(j >> 8) * KVL + (j & 255); }
                if (sec < 2) {
                    float ss = 0.f;
#pragma unroll
                    for (int bj = 0; bj < 2; ++bj)
#pragma unroll
                        for (int n = 0; n < 2; ++n) ss += (v[bj][n][0] * v[bj][n][0] + v[bj][n][1] * v[bj][n][1]) + (v[bj][n][2] * v[bj][n][2] + v[bj][n][3] * v[bj][n][3]);
                    ss += __shfl_xor(ss, 16); ss += __shfl_xor(ss, 32);
                    const float rstd = rsqrtf(ss * (1.f / 64.f) + EPS);
#pragma unroll
                    for (int bj = 0; bj < 2; ++bj)
#pragma unroll
                        for (int n = 0; n < 2; ++n)
#pragma unroll
                            for (int e = 0; e < 4; ++e) v[bj][n][e] *= rstd * gg[bj][n][e];
                    if (!ctx) {
                        const int t = r & 4095; const int pos = blk ? (t & 63) : (t >> 6);
                        const float* rp = rope + (size_t)(pos * 16 + 8 * f) * 2;
#pragma unroll
                        for (int n = 0; n < 2; ++n) { const f32x4 c0 = *(const f32x4*)(rp + 8 * n), c1 = *(const f32x4*)(rp + 8 * n + 4);
                            const float cs[4] = {c0[0], c0[2], c1[0], c1[2]}, sn[4] = {c0[1], c0[3], c1[1], c1[3]};
#pragma unroll
                            for (int e = 0; e < 4; ++e) { const float x1 = v[0][n][e], x2 = v[1][n][e]; v[0][n][e] = x1 * cs[e] - x2 * sn[e]; v[1][n][e] = x2 * cs[e] + x1 * sn[e]; } }
                    }
                    if (sec == 0) {
#pragma unroll
                        for (int bj = 0; bj < 2; ++bj)
#pragma unroll
                            for (int n = 0; n < 2; ++n) v[bj][n] *= QSCALE;
                    }
                }
                bf16_t* dst = (sec == 0 ? Q : (sec == 1 ? Kb : Vb)) + orow * QKW + colbase;
#pragma unroll
                for (int bj = 0; bj < 2; ++bj) { u32x4 w; w.x = cvt_pk_bf16(v[bj][0][0], v[bj][0][1]); w.y = cvt_pk_bf16(v[bj][0][2], v[bj][0][3]); w.z = cvt_pk_bf16(v[bj][1][0], v[bj][1][1]); w.w = cvt_pk_bf16(v[bj][1][2], v[bj][1][3]);
                    *(u32x4*)(dst + 16 * bj) = w; }
            }
    }
};

struct SchedStatic {
    int G, c, nM, nN; const char* A; const char* B;
    __device__ __forceinline__ bool next(int i, g8::Unit& u) const {
        const long L = (long)i * G + c; if (L >= (long)nM * nN) return false;
        g8::tile_of((int)L, nM, nN, u.pm, u.pn); u.a = A + (size_t)u.pm * 256 * DM * 2; u.b = B + (size_t)u.pn * 256 * DM * 2; u.kind = 0; u.ex = 0; return true;
    }
};
struct EpiOutProj {
    const float* x; float* out; const float* mod;
    __device__ __forceinline__ void operator()(f32x4 (&acc)[2][2][4][2], const g8::Unit& u, int wr, int wc, int fr, int fq) const {
        const int col0 = u.pn * 256 + wc * 32 + 8 * fq;
#pragma unroll
        for (int ai = 0; ai < 2; ++ai)
#pragma unroll
            for (int m = 0; m < 4; ++m) { const int r = u.pm * 256 + ai * 128 + wr * 64 + m * 16 + fr; const float* g1 = mod + (size_t)(r >> 12) * (NMOD * DM) + 2 * DM;
                const size_t off = (size_t)r * DM + col0;
#pragma unroll
                for (int bj = 0; bj < 2; ++bj)
#pragma unroll
                    for (int n = 0; n < 2; ++n) { const int c = bj * 128 + 4 * n; const f32x4 xv = *(const f32x4*)(x + off + c), gv = *(const f32x4*)(g1 + col0 + c);
                        *(f32x4*)(out + off + c) = xv + gv * acc[ai][bj][m][n]; } }
    }
};

namespace att {
constexpr int KVBLK = 64, LDK = QKW, NT = KVL / KVBLK;
constexpr int SHM_V = KVBLK * 128 * 2, SHM_K = KVBLK * 128 * 2;
#define KSWZ(row, colB) ((row) * 256 + ((colB) ^ (((row) & 7) << 4)))
#define SBAR() __builtin_amdgcn_sched_barrier(0)
__device__ __forceinline__ int crow(int r, int hi) { return (r & 3) + 8 * (r >> 2) + 4 * hi; }
__device__ __forceinline__ void expA(f32x16& p) {
#pragma unroll
    for (int r = 0; r < 16; ++r) p[r] = __builtin_amdgcn_exp2f(p[r]);
}
__device__ __forceinline__ void finishSM(f32x16& p0, f32x16& p1, float& l_reg, bf16x8& pa0, bf16x8& pa1, bf16x8& pa2, bf16x8& pa3) {
#pragma unroll
    for (int r = 0; r < 16; ++r) p1[r] = __builtin_amdgcn_exp2f(p1[r]);
    float ps = 0;
#pragma unroll
    for (int r = 0; r < 16; ++r) ps += p0[r];
#pragma unroll
    for (int r = 0; r < 16; ++r) ps += p1[r];
    { auto rr = __builtin_amdgcn_permlane32_swap(__float_as_uint(ps), __float_as_uint(ps), false, false); ps = __uint_as_float(rr[0]) + __uint_as_float(rr[1]); }
    l_reg += ps;
#define PK4(P, BASE, OUT) do { unsigned a0 = cvt_pk_bf16(P[BASE + 0], P[BASE + 1]), a1 = cvt_pk_bf16(P[BASE + 2], P[BASE + 3]);   \
    unsigned b0 = cvt_pk_bf16(P[BASE + 4], P[BASE + 5]), b1 = cvt_pk_bf16(P[BASE + 6], P[BASE + 7]);                              \
    auto r0 = __builtin_amdgcn_permlane32_swap(a0, b0, false, false); auto r1 = __builtin_amdgcn_permlane32_swap(a1, b1, false, false); \
    u32x4 w = {r0[0], r1[0], r0[1], r1[1]}; OUT = *reinterpret_cast<bf16x8*>(&w); } while (0)
    PK4(p0, 0, pa0); PK4(p0, 8, pa1); PK4(p1, 0, pa2); PK4(p1, 8, pa3);
#undef PK4
}
__device__ __forceinline__ void qkt(f32x16& p0, f32x16& p1, const char* Ks, const bf16x8* qr, int r32, int hi, int sub, float negm) {
#pragma unroll
    for (int r = 0; r < 16; ++r) { p0[r] = negm; p1[r] = negm; }
#pragma unroll
    for (int d0 = 0; d0 < 4; ++d0) { const int cb = (sub * 64 + d0 * 16 + hi * 8) * 2;
        const bf16x8 b0 = *reinterpret_cast<const bf16x8*>(Ks + KSWZ(r32, cb));
        const bf16x8 b1 = *reinterpret_cast<const bf16x8*>(Ks + KSWZ(32 + r32, cb));
        p0 = __builtin_amdgcn_mfma_f32_32x32x16_bf16(b0, qr[d0], p0, 0, 0, 0);
        p1 = __builtin_amdgcn_mfma_f32_32x32x16_bf16(b1, qr[d0], p1, 0, 0, 0); }
}
__device__ __forceinline__ int v_st(int k, int c) { const int kk = (k & ~0xC) | ((k & 4) << 1) | ((k & 8) >> 1); return ((kk >> 3) * 4 + (c >> 5)) * 512 + ((kk & 7) * 32 + (c & 31)) * 2; }
__device__ __forceinline__ int v_rd_base(int lane) { return ((lane & 3) << 3) | (((lane >> 2) & 3) << 6) | (((lane >> 4) & 1) << 5) | (((lane >> 5) & 1) << 8); }
constexpr int v_rd_off(int d0, int ks, int half) { return d0 * 512 + ks * 4096 + half * 2048; }
template <int OFF> __device__ __forceinline__ s16x4 tr_read(int vb) {
    s16x4 r; asm volatile("ds_read_b64_tr_b16 %0, %1 offset:%2" : "=&v"(r) : "v"(vb), "i"(OFF) : "memory"); return r;
}
template <int D0> __device__ __forceinline__ void pv_one(f32x16& od, int vb, bf16x8 pa0, bf16x8 pa1, bf16x8 pa2, bf16x8 pa3) {
    const s16x4 l0 = tr_read<v_rd_off(D0, 0, 0)>(vb), h0 = tr_read<v_rd_off(D0, 0, 1)>(vb), l1 = tr_read<v_rd_off(D0, 1, 0)>(vb), h1 = tr_read<v_rd_off(D0, 1, 1)>(vb);
    const s16x4 l2 = tr_read<v_rd_off(D0, 2, 0)>(vb), h2 = tr_read<v_rd_off(D0, 2, 1)>(vb), l3 = tr_read<v_rd_off(D0, 3, 0)>(vb), h3 = tr_read<v_rd_off(D0, 3, 1)>(vb);
    asm volatile("s_waitcnt lgkmcnt(0)" ::: "memory"); SBAR();
#define PK(L, H) (bf16x8){L[0], L[1], L[2], L[3], H[0], H[1], H[2], H[3]}
    od = __builtin_amdgcn_mfma_f32_32x32x16_bf16(pa0, PK(l0, h0), od, 0, 0, 0);
    od = __builtin_amdgcn_mfma_f32_32x32x16_bf16(pa1, PK(l1, h1), od, 0, 0, 0);
    od = __builtin_amdgcn_mfma_f32_32x32x16_bf16(pa2, PK(l2, h2), od, 0, 0, 0);
    od = __builtin_amdgcn_mfma_f32_32x32x16_bf16(pa3, PK(l3, h3), od, 0, 0, 0);
#undef PK
}
__device__ __forceinline__ void pv_d0(f32x16* o, int vb, bf16x8 pa0, bf16x8 pa1, bf16x8 pa2, bf16x8 pa3) {
    pv_one<0>(o[0], vb, pa0, pa1, pa2, pa3); pv_one<1>(o[1], vb, pa0, pa1, pa2, pa3); pv_one<2>(o[2], vb, pa0, pa1, pa2, pa3); pv_one<3>(o[3], vb, pa0, pa1, pa2, pa3);
}

__device__ __forceinline__ void attn_unit(const bf16_t* __restrict__ Qb, const bf16_t* __restrict__ Kh, const bf16_t* __restrict__ Vh, bf16_t* MIXo,
                                          const float lam, const float negm, const float* __restrict__ subg, char* lds, const int wid) {
    const int lane = lane_id(), tid = wid * 64 + lane, r32 = lane & 31, hi = lane >> 5;
    const int sub = wid >> 2, wq = wid & 3;
    char* V_lds = lds; char* K_lds = lds + 2 * SHM_V;
    float* wsf = (float*)(lds + 98304) + wid * 32;
    float l_reg = 0; f32x16 o[4] = {}; bf16x8 qr[4];
    const bf16_t* Qw = Qb + (long)(wq * 32 + r32) * LDK + sub * 64 + hi * 8;
#pragma unroll
    for (int d0 = 0; d0 < 4; ++d0) qr[d0] = *reinterpret_cast<const bf16x8*>(Qw + d0 * 16);
    const int sr = tid >> 4, sc = (tid & 15) * 8, vst0 = v_st(sr, sc), vst1 = v_st(32 + sr, sc);
    const int vb0 = (int)(uintptr_t)V_lds + v_rd_base(lane);
    struct { bf16x8 vs0, vs1, ks0, ks1; } sr_[2];
#define SLOAD(i, k0) do { sr_[i].vs0 = *(const bf16x8*)(&Vh[(long)((k0) + sr) * LDK + sc]); sr_[i].vs1 = *(const bf16x8*)(&Vh[(long)((k0) + 32 + sr) * LDK + sc]); \
    sr_[i].ks0 = *(const bf16x8*)(&Kh[(long)((k0) + sr) * LDK + sc]); sr_[i].ks1 = *(const bf16x8*)(&Kh[(long)((k0) + 32 + sr) * LDK + sc]); } while (0)
#define SWRITE(b, i) do { *(bf16x8*)(V_lds + (b) * SHM_V + vst0) = sr_[i].vs0;          \
    *(bf16x8*)(V_lds + (b) * SHM_V + vst1) = sr_[i].vs1; const int kc = sc * 2;               \
    *(bf16x8*)(K_lds + (b) * SHM_K + KSWZ(sr, kc)) = sr_[i].ks0;                       \
    *(bf16x8*)(K_lds + (b) * SHM_K + KSWZ(32 + sr, kc)) = sr_[i].ks1; } while (0)
#define SWAIT() asm volatile("s_waitcnt vmcnt(4)" ::: "memory")
    f32x16 pA0, pA1, pB0, pB1; bf16x8 pa0, pa1, pa2, pa3;
    constexpr int SE = 0, SO = 1;
    SLOAD(SE, 0); asm volatile("s_waitcnt vmcnt(0)" ::: "memory"); SWRITE(0, SE); __syncthreads();
    qkt(pA0, pA1, K_lds, qr, r32, hi, sub, negm); expA(pA0);
    SLOAD(SO, KVBLK); SLOAD(SE, 2 * KVBLK);
    SWAIT(); SWRITE(1, SO); __syncthreads();
    for (int j = 1; j + 1 < NT; j += 2) {
        SBAR(); qkt(pB0, pB1, K_lds + SHM_K, qr, r32, hi, sub, negm);
        finishSM(pA0, pA1, l_reg, pa0, pa1, pa2, pa3); SBAR();
        SLOAD(SO, (j + 2) * KVBLK); SBAR();
        pv_d0(o, vb0, pa0, pa1, pa2, pa3); expA(pB0);
        __syncthreads(); SWAIT(); SWRITE(0, SE);
        __syncthreads();
        SBAR(); qkt(pA0, pA1, K_lds, qr, r32, hi, sub, negm);
        finishSM(pB0, pB1, l_reg, pa0, pa1, pa2, pa3); SBAR();
        if (j + 3 < NT) SLOAD(SE, (j + 3) * KVBLK); SBAR();
        pv_d0(o, vb0 + SHM_V, pa0, pa1, pa2, pa3); expA(pA0);
        __syncthreads(); SWAIT(); SWRITE(1, SO);
        __syncthreads();
    }
    SBAR(); qkt(pB0, pB1, K_lds + SHM_K, qr, r32, hi, sub, negm);
    finishSM(pA0, pA1, l_reg, pa0, pa1, pa2, pa3); SBAR();
    pv_d0(o, vb0, pa0, pa1, pa2, pa3); expA(pB0);
    finishSM(pB0, pB1, l_reg, pa0, pa1, pa2, pa3); SBAR();
    pv_d0(o, vb0 + SHM_V, pa0, pa1, pa2, pa3);
#undef SLOAD
#undef SWRITE
#undef SWAIT
    if (hi == 0) wsf[r32] = l_reg;
    __syncthreads();
    float* X = (float*)lds;
    float rli[16];
#pragma unroll
    for (int r = 0; r < 16; ++r) rli[r] = __builtin_amdgcn_rcpf(wsf[crow(r, hi)]);
    if (sub == 1) {
#pragma unroll
        for (int r = 0; r < 16; ++r) { const int row = wq * 32 + crow(r, hi); const float s = lam * rli[r];
#pragma unroll
            for (int d0 = 0; d0 < 4; ++d0) X[row * 128 + d0 * 32 + r32] = o[d0][r] * s; }
    }
    __syncthreads();
    bf16_t* Y = (bf16_t*)(lds + 65536);
    if (sub == 0) {
        float sg[4];
#pragma unroll
        for (int d0 = 0; d0 < 4; ++d0) sg[d0] = subg[d0 * 32 + r32] * (1.f - LAM_INIT);
#pragma unroll
        for (int r = 0; r < 16; ++r) { const int row = wq * 32 + crow(r, hi);
            float v[4]; float ss = 0.f;
#pragma unroll
            for (int d0 = 0; d0 < 4; ++d0) { v[d0] = o[d0][r] * rli[r] - X[row * 128 + d0 * 32 + r32]; ss += v[d0] * v[d0]; }
            ss += __shfl_xor(ss, 1); ss += __shfl_xor(ss, 2); ss += __shfl_xor(ss, 4); ss += __shfl_xor(ss, 8); ss += __shfl_xor(ss, 16);
            const float rstd = rsqrtf(ss * (1.f / 128.f) + EPS);
#pragma unroll
            for (int d0 = 0; d0 < 4; ++d0) Y[row * 128 + d0 * 32 + r32] = (bf16_t)(cvt_pk_bf16(v[d0] * rstd * sg[d0], 0.f) & 0xffffu); }
    }
    __syncthreads();
    { const int row = tid >> 2, seg = (tid & 3) * 32;
#pragma unroll
        for (int i = 0; i < 4; ++i) { const u32x4 v = *(const u32x4*)(Y + row * 128 + seg + i * 8); *(u32x4*)(MIXo + (size_t)row * DM + seg + i * 8) = v; } }
    __syncthreads();
}
#undef KSWZ
#undef SBAR
}

__device__ __forceinline__ void p3_attention(Frame& F) {
    FT_DECL;
    const float* sc = WSP(float, WS_SMALL + SM_SCAL);
    const float lam = sc[0], negm = -sc[1];
    const bf16_t* Q = WSP(bf16_t, WS_Q); const bf16_t* Kb = WSP(bf16_t, WS_K); const bf16_t* Vb = WSP(bf16_t, WS_V); bf16_t* MIX = WSP(bf16_t, WS_MIX);
    const int c = blockIdx.x, xcd = c & 7, ci = c >> 3, per = F.G >> 3;
    for (int j = ci; j < 128; j += per) {
        const int pair = xcd * 4 + (j >> 5), qb = j & 31, b = pair >> 2, h = pair & 3;
        att::attn_unit(Q + ((size_t)b * SEQ + qb * 128) * QKW + h * 128, Kb + (size_t)b * KVL * QKW + h * 128, Vb + (size_t)b * KVL * QKW + h * 128,
                       MIX + ((size_t)b * SEQ + qb * 128) * DM + h * 128, lam, negm, F.in[15], (char*)F.lds, F.wave);
    }
}


namespace hy {
constexpr int RB_BYTES = 4352 * 8, IN_OFF = 2 * RB_BYTES, TW1_OFF = IN_OFF + 32768, TW2_OFF = TW1_OFF + 15 * 256 * 8, LDS_END = TW2_OFF + 15 * 16 * 8;
__device__ __forceinline__ f32x2 cmul(f32x2 a, f32x2 b) { return (f32x2){a.x * b.x - a.y * b.y, a.x * b.y + a.y * b.x}; }
__device__ __forceinline__ f32x2 cmulc(f32x2 a, f32x2 b) { return (f32x2){a.x * b.x + a.y * b.y, a.y * b.x - a.x * b.y}; }
__device__ __forceinline__ int P(int i) { return i + (i >> 4); }
template <bool INV> __device__ __forceinline__ void r4(f32x2& a, f32x2& b, f32x2& c, f32x2& d) {
    const f32x2 t0 = a + c, t1 = a - c, t2 = b + d, t3 = b - d;
    const f32x2 st3 = INV ? (f32x2){-t3.y, t3.x} : (f32x2){t3.y, -t3.x};
    a = t0 + t2; c = t0 - t2; b = t1 + st3; d = t1 - st3;
}
template <bool INV> __device__ __forceinline__ f32x2 tw(f32x2 v, float c, float s) {
    return INV ? (f32x2){v.x * c - v.y * s, v.y * c + v.x * s} : (f32x2){v.x * c + v.y * s, v.y * c - v.x * s};
}
template <bool INV> __device__ __forceinline__ void dft16(f32x2 (&v)[16]) {
    constexpr float C1 = 0.9238795325112867f, S1 = 0.3826834323650898f, R2 = 0.7071067811865476f;
    r4<INV>(v[0], v[4], v[8], v[12]); r4<INV>(v[1], v[5], v[9], v[13]); r4<INV>(v[2], v[6], v[10], v[14]); r4<INV>(v[3], v[7], v[11], v[15]);
    v[5] = tw<INV>(v[5], C1, S1);  v[9] = tw<INV>(v[9], R2, R2);    v[13] = tw<INV>(v[13], S1, C1);
    v[6] = tw<INV>(v[6], R2, R2);  v[10] = tw<INV>(v[10], 0.f, 1.f); v[14] = tw<INV>(v[14], -R2, R2);
    v[7] = tw<INV>(v[7], S1, C1);  v[11] = tw<INV>(v[11], -R2, R2);  v[15] = tw<INV>(v[15], -C1, -S1);
    r4<INV>(v[0], v[1], v[2], v[3]); r4<INV>(v[4], v[5], v[6], v[7]); r4<INV>(v[8], v[9], v[10], v[11]); r4<INV>(v[12], v[13], v[14], v[15]);
    f32x2 t;
    t = v[1]; v[1] = v[4]; v[4] = t;   t = v[2]; v[2] = v[8]; v[8] = t;    t = v[3]; v[3] = v[12]; v[12] = t;
    t = v[6]; v[6] = v[9]; v[9] = t;   t = v[7]; v[7] = v[13]; v[13] = t;  t = v[11]; v[11] = v[14]; v[14] = t;
}
struct Ctx { LAS f32x2* R; LAS f32x2* IN; LAS f32x2* TW1; LAS f32x2* TW2; int t, half; f32x2 wt; };
#define HY_OPAQUE(x) asm volatile("" : "+v"(x))
#define HY_W32(m) (f32x2){__builtin_cosf(-0.19634954084936207f * (m)), __builtin_sinf(-0.19634954084936207f * (m))}
template <int MODE> __device__ __forceinline__ void pass1_fwd(const Ctx& X) {
    f32x2 v[16]; int t = X.t; HY_OPAQUE(t);
#pragma unroll
    for (int m = 0; m < 16; ++m) { f32x2 a = X.IN[t + 256 * m]; if (MODE == 1) a = (f32x2){X.half ? a.y : a.x, 0.f}; v[m] = a; }
    if (X.half) {
#pragma unroll
        for (int m = 0; m < 16; ++m) v[m] = cmul(cmul(v[m], HY_W32(m)), X.wt);
    }
    dft16<false>(v);
#pragma unroll
    for (int q = 1; q < 16; ++q) v[q] = cmul(v[q], X.TW1[(q - 1) * 256 + t]);
    const int pb = t + (t >> 4);
#pragma unroll
    for (int q = 0; q < 16; ++q) X.R[pb + 272 * q] = v[q];
}
__device__ __forceinline__ void pass2_fwd(const Ctx& X) {
    int t = X.t; HY_OPAQUE(t);
    const int n2 = t & 15, pb = (t >> 4) * 272 + n2; f32x2 v[16];
#pragma unroll
    for (int m = 0; m < 16; ++m) v[m] = X.R[pb + 17 * m];
    dft16<false>(v);
#pragma unroll
    for (int q = 1; q < 16; ++q) v[q] = cmul(v[q], X.TW2[(q - 1) * 16 + n2]);
#pragma unroll
    for (int q = 0; q < 16; ++q) X.R[pb + 17 * q] = v[q];
}
template <bool FILTER> __device__ __forceinline__ void pass3(const Ctx& X, f32x2 (&H)[16]) {
    f32x2 v[16]; int t = X.t; HY_OPAQUE(t); const int pb = 17 * t;
#pragma unroll
    for (int m = 0; m < 16; ++m) v[m] = X.R[pb + m];
    dft16<false>(v);
    if (FILTER) {
#pragma unroll
        for (int q = 0; q < 16; ++q) H[q] = v[q] * (1.f / 8192.f);
    } else {
#pragma unroll
        for (int q = 0; q < 16; ++q) v[q] = cmul(v[q], H[q]);
        dft16<true>(v);
#pragma unroll
        for (int m = 0; m < 16; ++m) X.R[pb + m] = v[m];
    }
}
__device__ __forceinline__ void pass2_inv(const Ctx& X) {
    int t = X.t; HY_OPAQUE(t);
    const int n2 = t & 15, pb = (t >> 4) * 272 + n2; f32x2 v[16];
    v[0] = X.R[pb];
#pragma unroll
    for (int q = 1; q < 16; ++q) v[q] = cmulc(X.R[pb + 17 * q], X.TW2[(q - 1) * 16 + n2]);
    dft16<true>(v);
#pragma unroll
    for (int m = 0; m < 16; ++m) X.R[pb + 17 * m] = v[m];
}
__device__ __forceinline__ void pass1_inv(const Ctx& X) {
    f32x2 v[16]; int t = X.t; HY_OPAQUE(t); const int pb = t + (t >> 4);
    v[0] = X.R[pb];
#pragma unroll
    for (int q = 1; q < 16; ++q) v[q] = cmulc(X.R[pb + 272 * q], X.TW1[(q - 1) * 256 + t]);
    dft16<true>(v);
    if (X.half) {
#pragma unroll
        for (int m = 0; m < 16; ++m) v[m] = cmulc(cmulc(v[m], HY_W32(m)), X.wt);
    }
#pragma unroll
    for (int m = 0; m < 16; ++m) X.R[pb + 272 * m] = v[m];
}
__device__ __forceinline__ void conv_fft(const Ctx& X, f32x2 (&H)[16]) {
    __syncthreads(); pass1_fwd<0>(X); __syncthreads(); pass2_fwd(X); __syncthreads(); pass3<false>(X, H); __syncthreads(); pass2_inv(X); __syncthreads(); pass1_inv(X); __syncthreads();
}
__device__ __forceinline__ float ldbf(const bf16_t* p) { return bf2f(*p); }
__device__ __forceinline__ float sconv(const bf16_t* row, int b, int n, float w0, float w1, float w2, float bias) {
    const bf16_t* p = row + b * SEQ + n;
    const float c = ldbf(p), l = (n > 0) ? ldbf(p - 1) : 0.f, r = (n < SEQ - 1) ? ldbf(p + 1) : 0.f;
    return bias + w0 * l + w1 * c + w2 * r;
}
__device__ __forceinline__ void setup_tables(LAS unsigned char* lds, int tid) {
    LAS f32x2* TW1 = (LAS f32x2*)(lds + TW1_OFF); LAS f32x2* TW2 = (LAS f32x2*)(lds + TW2_OFF);
    for (int i = tid; i < 15 * 256; i += 512) { const int q = i / 256 + 1, t = i & 255; float s, c; sincosf(-6.283185307179586f * (float)((t * q) & 4095) * (1.f / 4096.f), &s, &c); TW1[i] = (f32x2){c, s}; }
    for (int i = tid; i < 15 * 16; i += 512) { const int q = i / 16 + 1, n2 = i & 15; float s, c; sincosf(-6.283185307179586f * (float)((n2 * q) & 255) * (1.f / 256.f), &s, &c); TW2[i] = (f32x2){c, s}; }
}
__device__ __forceinline__ void unit(Frame& F, int c) {
    FT_DECL;
    const int tid = f_tid; Ctx X; X.half = F.wave >> 2; X.t = tid & 255;
    X.R = (LAS f32x2*)(F.lds + X.half * RB_BYTES); X.IN = (LAS f32x2*)(F.lds + IN_OFF); X.TW1 = (LAS f32x2*)(F.lds + TW1_OFF); X.TW2 = (LAS f32x2*)(F.lds + TW2_OFF);
    { float s, cc; sincosf(-6.283185307179586f * (float)X.t * (1.f / 8192.f), &s, &cc); X.wt = (f32x2){cc, s}; }
    LAS f32x2* RB0 = (LAS f32x2*)(F.lds); LAS f32x2* RB1 = (LAS f32x2*)(F.lds + RB_BYTES);
    const float* FILT = WSP(float, WS_FILT);
    f32x2 H0[16], H1[16];
#pragma unroll
    for (int ord = 0; ord < 2; ++ord) {
        const float* hf = FILT + ((size_t)(ord * 2 + 0) * 512 + c) * SEQ; const float* hb = FILT + ((size_t)(ord * 2 + 1) * 512 + c) * SEQ;
        __syncthreads();
        int nb = tid; HY_OPAQUE(nb);
#pragma unroll
        for (int j = 0; j < 8; ++j) { const int n = nb + 512 * j; const float lo = (n == 0) ? hf[0] + hb[0] : hf[n], hi = (n == 0) ? 0.f : hb[SEQ - n]; X.IN[n] = (f32x2){lo + hi, lo - hi}; }
        __syncthreads(); pass1_fwd<1>(X); __syncthreads(); pass2_fwd(X); __syncthreads();
        if (ord == 0) pass3<true>(X, H0); else pass3<true>(X, H1);
    }
    const bf16_t* UT = WSP(bf16_t, WS_UT);
    const bf16_t* rv = UT + (size_t)c * MROWS; const bf16_t* r1 = UT + (size_t)(512 + c) * MROWS; const bf16_t* r2 = UT + (size_t)(1024 + c) * MROWS;
    const float* cw = F.in[16]; const float* cb = F.in[17];
    const float wv0 = cw[c], wv1 = cw[HYC + c], wv2 = cw[2 * HYC + c], bv = cb[c];
    const float wa0 = cw[512 + c], wa1 = cw[HYC + 512 + c], wa2 = cw[2 * HYC + 512 + c], ba = cb[512 + c];
    const float wb0 = cw[1024 + c], wb1 = cw[HYC + 1024 + c], wb2 = cw[2 * HYC + 1024 + c], bb = cb[1024 + c];
    const float sk0 = F.in[25][c], sk1 = F.in[25][512 + c];
    bf16_t* Z = WSP(bf16_t, WS_Z2T) + (size_t)c * MROWS;
    for (int pr = 0; pr < 4; ++pr) {
        const int b0 = 2 * pr, b1 = b0 + 1;
        f32x2 z[8]; int pc = tid + (tid >> 4); HY_OPAQUE(pc); int nb = tid; HY_OPAQUE(nb);
        __syncthreads();
#pragma unroll
        for (int j = 0; j < 8; ++j) { const int n = nb + 512 * j; z[j] = (f32x2){sconv(rv, b0, n, wv0, wv1, wv2, bv), sconv(rv, b1, n, wv0, wv1, wv2, bv)}; X.IN[n] = z[j]; }
        conv_fft(X, H0);
        HY_OPAQUE(nb); HY_OPAQUE(pc);
#pragma unroll
        for (int j = 0; j < 8; ++j) { const int n = nb + 512 * j; const f32x2 y = RB0[pc + 544 * j] + RB1[pc + 544 * j];
            const f32x2 g = (f32x2){sconv(r1, b0, n, wa0, wa1, wa2, ba), sconv(r1, b1, n, wa0, wa1, wa2, ba)};
            z[j] = g * (y + sk0 * z[j]); X.IN[n] = z[j]; }
        conv_fft(X, H1);
        HY_OPAQUE(nb); HY_OPAQUE(pc);
#pragma unroll
        for (int j = 0; j < 8; ++j) { const int n = nb + 512 * j; const f32x2 y = RB0[pc + 544 * j] + RB1[pc + 544 * j];
            const f32x2 g = (f32x2){sconv(r2, b0, n, wb0, wb1, wb2, bb), sconv(r2, b1, n, wb0, wb1, wb2, bb)};
            const f32x2 o = g * (y + sk1 * z[j]);
            Z[b0 * SEQ + n] = (bf16_t)(cvt_pk_bf16(o.x, 0.f) & 0xffffu); Z[b1 * SEQ + n] = (bf16_t)(cvt_pk_bf16(o.y, 0.f) & 0xffffu); }
    }
    __syncthreads();
}
}

__device__ __forceinline__ void p3_hyena(Frame& F) {
    FT_DECL;
    __syncthreads();
    hy::setup_tables(F.lds, f_tid);
    __syncthreads();
    for (int c = F.vcu; c < HYW; c += F.G) hy::unit(F, c);
}

__device__ __forceinline__ void p4_hynorm(Frame& F) {
    FT_DECL;
    const bf16_t* Z = WSP(bf16_t, WS_Z2T); bf16_t* MIX = WSP(bf16_t, WS_MIX); const float* g = F.in[26];
    LAS bf16_t* T = (LAS bf16_t*)F.lds;
    LAS float* red = (LAS float*)(F.lds + 512 * 72 * 2);
    LAS float* rs = red + 512;
    for (int it = F.vcu; it < MROWS / 64; it += F.G) {
        const int tok0 = it * 64;
        __syncthreads();
#pragma unroll
        for (int j = 0; j < 8; ++j) { const int i = f_tid + 512 * j, row = i >> 3, ch = i & 7; const u32x4 v = *(const u32x4*)(Z + (size_t)row * MROWS + tok0 + ch * 8); *(LAS u32x4*)(T + row * 72 + ch * 8) = v; }
        __syncthreads();
        { const int tok = f_tid & 63, grp = f_tid >> 6; float ss = 0.f;
#pragma unroll 8
            for (int k = 0; k < 64; ++k) { const float v = bf2f(T[(grp * 64 + k) * 72 + tok]); ss += v * v; }
            red[grp * 64 + tok] = ss; }
        __syncthreads();
        if (f_tid < 64) { float ss = 0.f;
#pragma unroll
            for (int w = 0; w < 8; ++w) ss += red[w * 64 + f_tid];
            rs[f_tid] = rsqrtf(ss * (1.f / HYW) + EPS); }
        __syncthreads();
#pragma unroll
        for (int j = 0; j < 8; ++j) { const int i = f_tid + 512 * j, tok = i >> 6, c0 = (i & 63) * 8; const float r = rs[tok];
            float v[8];
#pragma unroll
            for (int e = 0; e < 8; ++e) v[e] = bf2f(T[(c0 + e) * 72 + tok]) * r * g[c0 + e];
            u32x4 w; w.x = cvt_pk_bf16(v[0], v[1]); w.y = cvt_pk_bf16(v[2], v[3]); w.z = cvt_pk_bf16(v[4], v[5]); w.w = cvt_pk_bf16(v[6], v[7]);
            *(u32x4*)(MIX + (size_t)(tok0 + tok) * DM + 512 + c0) = w; }
    }
}

__device__ __forceinline__ void p4_stub(Frame& F) {
    FT_DECL;
    bf16_t* MIX = WSP(bf16_t, WS_MIX);
    const size_t gt = (size_t)F.vcu * 512 + f_tid, NT = (size_t)F.G * 512;
    for (size_t i = gt; i < (size_t)MROWS * 64; i += NT) { const size_t row = i >> 6, ch = i & 63; *(u32x4*)(MIX + row * DM + 512 + ch * 8) = (u32x4){0u, 0u, 0u, 0u}; }
}


constexpr size_t RT_TOPI = 0;
constexpr size_t RT_GATE = 512 * 1024;
constexpr size_t RT_POS = 1024 * 1024;
constexpr size_t RT_WGCNT = 1536 * 1024;
constexpr size_t RT_META = 1600 * 1024;
constexpr size_t RT_LIST = 2048 * 1024;
constexpr size_t RT_GSLOT = 2048 * 1024 + 640 * 1024;
constexpr int MAXSLOT = MROWS * TOPK + NEXP * 256;
constexpr int MAXTILE = MAXSLOT / 256;
constexpr size_t WS_XS = WS_EO;
constexpr int RW_PITCH = 32;
constexpr int P6_LDS_TOPI = 1024 * RW_PITCH * 4;

__device__ __forceinline__ void p6_router(Frame& F) {
    FT_DECL;
#define in F.in
    LAS float* RW = (LAS float*)F.lds;
    LAS int* TI = (LAS int*)(F.lds + P6_LDS_TOPI);
    LAS int* PS = TI + 512;
    LAS int* SC = PS + 512;
    const float* rw = in[28];
    for (int i = f_tid; i < 1024 * 8; i += 512) { const int k = i >> 3, c4 = i & 7; const f32x4 v = *(const f32x4*)(rw + (size_t)k * 32 + c4 * 4);
        const int pi = (k & 3) * 256 + (k >> 2); *(LAS f32x4*)(RW + pi * RW_PITCH + ((c4 ^ ((pi >> 1) & 7)) * 4)) = v; }
    __syncthreads();
    const float* mod = WSP(float, WS_SMALL + SM_MOD); const float* g2n = in[7]; const float* rb = in[29];
    bf16_t* H2 = WSP(bf16_t, WS_H);
    int* topi_g = WSP(int, WS_ROUTE + RT_TOPI); float* gate_g = WSP(float, WS_ROUTE + RT_GATE); int* pos_g = WSP(int, WS_ROUTE + RT_POS); int* wgcnt = WSP(int, WS_ROUTE + RT_WGCNT);
    const int lane = f_lane;
    for (int blk = blockIdx.x; blk < MROWS / 128; blk += F.G) {
        for (int it = 0; it < 8; ++it) {
            const int rl = F.wave * 16 + 2 * it, r0 = blk * 128 + rl;
            const float* sh2 = mod + (size_t)(r0 >> 12) * (NMOD * DM) + 3 * DM; const float* sc2 = sh2 + DM;
            f32x4 h[2][4];
#pragma unroll
            for (int rr = 0; rr < 2; ++rr) {
                const GAS f32x4* xr = (const GAS f32x4*)(F.out + (size_t)(r0 + rr) * DM) + lane; float ss = 0.f;
#pragma unroll
                for (int j = 0; j < 4; ++j) { h[rr][j] = xr[64 * j]; ss += (h[rr][j].x * h[rr][j].x + h[rr][j].y * h[rr][j].y) + (h[rr][j].z * h[rr][j].z + h[rr][j].w * h[rr][j].w); }
                const float rstd = rsqrtf(wave_sum(ss) * (1.f / DM) + EPS);
                GAS u32x2* o8 = (GAS u32x2*)(H2 + (size_t)(r0 + rr) * DM) + lane;
#pragma unroll
                for (int j = 0; j < 4; ++j) { const int c = 4 * lane + 256 * j;
                    const f32x4 g = *(const f32x4*)(g2n + c), a = *(const f32x4*)(sc2 + c), b = *(const f32x4*)(sh2 + c);
                    h[rr][j] = h[rr][j] * rstd * g * (a + 1.f) + b;
                    u32x2 w; w.x = cvt_pk_bf16(h[rr][j].x, h[rr][j].y); w.y = cvt_pk_bf16(h[rr][j].z, h[rr][j].w); o8[64 * j] = w; }
            }
            float a0[32], a1[32]; int lb = lane; asm volatile("" : "+v"(lb)); const int sw = (lb >> 1) & 7;
#pragma unroll
            for (int e = 0; e < 32; ++e) { a0[e] = 0.f; a1[e] = 0.f; }
#pragma unroll
            for (int j = 0; j < 4; ++j)
#pragma unroll
                for (int i = 0; i < 4; ++i) { const LAS float* wp = RW + (i * 256 + 64 * j + lb) * RW_PITCH; const float x0 = h[0][j][i], x1 = h[1][j][i];
#pragma unroll
                    for (int c4 = 0; c4 < 8; ++c4) { const f32x4 w = *(const LAS f32x4*)(wp + 4 * (c4 ^ sw));
#pragma unroll
                        for (int e = 0; e < 4; ++e) { a0[4 * c4 + e] += x0 * w[e]; a1[4 * c4 + e] += x1 * w[e]; } } }
#define RS_STEP(A, CNT, MASK) _Pragma("unroll") for (int i = 0; i < CNT; ++i) { const bool up = (lane & MASK) != 0; const float send = up ? A[i] : A[CNT + i]; const float keep = up ? A[CNT + i] : A[i]; A[i] = keep + __shfl_xor(send, MASK); }
            RS_STEP(a0, 16, 32) RS_STEP(a0, 8, 16) RS_STEP(a0, 4, 8) RS_STEP(a0, 2, 4) RS_STEP(a0, 1, 2)
            RS_STEP(a1, 16, 32) RS_STEP(a1, 8, 16) RS_STEP(a1, 4, 8) RS_STEP(a1, 2, 4) RS_STEP(a1, 1, 2)
#undef RS_STEP
            const int me = lane >> 1; const float bias = rb[me];
            float lg[2]; lg[0] = a0[0] + __shfl_xor(a0[0], 1) + bias; lg[1] = a1[0] + __shfl_xor(a1[0], 1) + bias;
#pragma unroll
            for (int rr = 0; rr < 2; ++rr) {
                float v = lg[rr]; float tv[4]; int ti[4];
#pragma unroll
                for (int k = 0; k < 4; ++k) { float bv = v; int bi = me;
#pragma unroll
                    for (int o = 1; o < 64; o <<= 1) { const float ov = __shfl_xor(bv, o); const int oi = __shfl_xor(bi, o); if (ov > bv || (ov == bv && oi < bi)) { bv = ov; bi = oi; } }
                    tv[k] = bv; ti[k] = bi; if (me == bi) v = -INFINITY; }
                const float e1 = __expf(tv[1] - tv[0]), e2 = __expf(tv[2] - tv[0]), e3 = __expf(tv[3] - tv[0]); const float inv = 1.f / (1.f + e1 + e2 + e3);
                if (lane == 0) { const int r = r0 + rr;
                    *(int4*)(topi_g + (size_t)r * 4) = make_int4(ti[0], ti[1], ti[2], ti[3]);
                    *(f32x4*)(gate_g + (size_t)r * 4) = (f32x4){inv, e1 * inv, e2 * inv, e3 * inv};
                    TI[(rl + rr) * 4 + 0] = ti[0]; TI[(rl + rr) * 4 + 1] = ti[1]; TI[(rl + rr) * 4 + 2] = ti[2]; TI[(rl + rr) * 4 + 3] = ti[3]; }
            }
        }
        __syncthreads();
        { const int e = f_tid & 31, seg = f_tid >> 5; int cnt = 0;
#pragma unroll 4
            for (int i = 0; i < 32; ++i) cnt += (TI[seg * 32 + i] == e) ? 1 : 0;
            SC[seg * 32 + e] = cnt;
            __syncthreads();
            int pre = 0;
            for (int s2 = 0; s2 < seg; ++s2) pre += SC[s2 * 32 + e];
            if (seg == 15) wgcnt[blk * 32 + e] = pre + cnt;
            for (int i = 0; i < 32; ++i) if (TI[seg * 32 + i] == e) { PS[seg * 32 + i] = pre; ++pre; }
        }
        __syncthreads();
        pos_g[(size_t)blk * 512 + f_tid] = PS[f_tid];
        __syncthreads();
    }
#undef in
}

__device__ __forceinline__ void p7_scatter(Frame& F) {
    FT_DECL;
    LAS int* TOT = (LAS int*)F.lds;
    LAS int* BASE = TOT + 32;
    LAS int* PRE = BASE + 32;
    LAS int* PART = PRE + 32;
    const int* wgcnt = WSP(int, WS_ROUTE + RT_WGCNT); const int* topi_g = WSP(int, WS_ROUTE + RT_TOPI); const float* gate_g = WSP(float, WS_ROUTE + RT_GATE); const int* pos_g = WSP(int, WS_ROUTE + RT_POS);
    int* list = WSP(int, WS_ROUTE + RT_LIST); float* gslot = WSP(float, WS_ROUTE + RT_GSLOT); int* meta = WSP(int, WS_ROUTE + RT_META);
    const bf16_t* H2 = WSP(bf16_t, WS_H); bf16_t* XS = WSP(bf16_t, WS_XS);
    for (int blk = blockIdx.x; blk < MROWS / 128; blk += F.G) {
        __syncthreads();
        { const int e = f_tid & 31, part = f_tid >> 5; int st = 0, sp = 0;
            for (int w = part * 16; w < part * 16 + 16; ++w) { const int c = wgcnt[w * 32 + e]; st += c; if (w < blk) sp += c; }
            PART[part * 32 + e] = st; PART[512 + part * 32 + e] = sp; }
        __syncthreads();
        if (f_tid < 32) { int st = 0, sp = 0;
#pragma unroll
            for (int p = 0; p < 16; ++p) { st += PART[p * 32 + f_tid]; sp += PART[512 + p * 32 + f_tid]; }
            TOT[f_tid] = st; PRE[f_tid] = sp; }
        __syncthreads();
        if (f_tid == 0) { int b = 0; for (int e = 0; e < 32; ++e) { BASE[e] = b; b += (TOT[e] + 255) & ~255; }
            if (blk == 0) { int t = 0; for (int e = 0; e < 32; ++e) { meta[e] = TOT[e]; meta[32 + e] = BASE[e]; const int nt = (TOT[e] + 255) >> 8; for (int q = 0; q < nt; ++q) meta[128 + t + q] = e; t += nt; } meta[64] = t; } }
        __syncthreads();
        { const int a = f_tid, row = blk * 128 + (a >> 2); const int e = topi_g[(size_t)blk * 512 + a]; const int slot = BASE[e] + PRE[e] + pos_g[(size_t)blk * 512 + a];
            list[slot] = row * 4 + (a & 3); gslot[slot] = gate_g[(size_t)blk * 512 + a];
            PART[a] = slot; }
        __syncthreads();
        for (int a = F.wave; a < 512; a += NWAVES) { const int slot = PART[a], row = blk * 128 + (a >> 2);
            const GAS u32x4* src = (const GAS u32x4*)(H2 + (size_t)row * DM); GAS u32x4* dst = (GAS u32x4*)(XS + (size_t)slot * DM);
            const u32x4 v0 = src[f_lane], v1 = src[64 + f_lane]; dst[f_lane] = v0; dst[64 + f_lane] = v1; }
        if (blk < NEXP) { const int e = blk, lo = BASE[e] + TOT[e], hi = BASE[e] + ((TOT[e] + 255) & ~255);
            for (int sl = lo + F.wave; sl < hi; sl += NWAVES) { if (f_lane == 0) { list[sl] = -1; gslot[sl] = 0.f; }
                GAS u32x4* dst = (GAS u32x4*)(XS + (size_t)sl * DM); dst[f_lane] = (u32x4){0u, 0u, 0u, 0u}; dst[64 + f_lane] = (u32x4){0u, 0u, 0u, 0u}; } }
    }
}

template <int NPN> struct SchedMoE {
    int G, c, nT; const char* A; const char* W; size_t wstride; const int* tileE;
    __device__ __forceinline__ bool next(int i, g8::Unit& u) const {
        const int L = i * G + c, xcd = L & 7, j = L >> 3, T = (j / NPN) * 8 + xcd, pn = j % NPN;
        if (T >= nT) return false;
        const int e = tileE[T];
        u.pm = T; u.pn = pn; u.kind = 0; u.ex = e; u.a = A + (size_t)T * 256 * DM * 2; u.b = W + (size_t)e * wstride + (size_t)pn * 256 * DM * 2; return true;
    }
};
struct EpiSwiGLU {
    bf16_t* ACT; const float* b1;
    __device__ __forceinline__ void operator()(f32x4 (&acc)[2][2][4][2], const g8::Unit& u, int wr, int wc, int fr, int fq) const {
        const int j0 = u.pn * 128 + wc * 32 + 8 * fq; const float* bp = b1 + (size_t)u.ex * 2 * DM + j0;
        f32x4 bg[2], bl[2];
#pragma unroll
        for (int n = 0; n < 2; ++n) { bg[n] = *(const f32x4*)(bp + 4 * n); bl[n] = *(const f32x4*)(bp + DM + 4 * n); }
#pragma unroll
        for (int ai = 0; ai < 2; ++ai)
#pragma unroll
            for (int m = 0; m < 4; ++m) { const size_t slot = (size_t)u.pm * 256 + ai * 128 + wr * 64 + m * 16 + fr; float o[8];
#pragma unroll
                for (int n = 0; n < 2; ++n)
#pragma unroll
                    for (int e = 0; e < 4; ++e) { float g = acc[ai][0][m][n][e] + bg[n][e], l = acc[ai][1][m][n][e] + bl[n][e];
                        g = fminf(g, 7.f); l = fminf(fmaxf(l, -7.f), 7.f);
                        const float sg = 1.f / (1.f + __expf(-1.702f * g)); o[4 * n + e] = (l + 1.f) * (g * sg); }
                u32x4 w; w.x = cvt_pk_bf16(o[0], o[1]); w.y = cvt_pk_bf16(o[2], o[3]); w.z = cvt_pk_bf16(o[4], o[5]); w.w = cvt_pk_bf16(o[6], o[7]);
                *(u32x4*)(ACT + slot * DM + j0) = w; }
    }
};
struct EpiDown {
    bf16_t* EO; const float* b2; const int* list; const float* gslot;
    __device__ __forceinline__ void operator()(f32x4 (&acc)[2][2][4][2], const g8::Unit& u, int wr, int wc, int fr, int fq) const {
        const int c0 = u.pn * 256 + wc * 32 + 8 * fq; const float* bp = b2 + (size_t)u.ex * DM + c0;
        f32x4 bb[2][2];
#pragma unroll
        for (int bj = 0; bj < 2; ++bj)
#pragma unroll
            for (int n = 0; n < 2; ++n) bb[bj][n] = *(const f32x4*)(bp + bj * 128 + 4 * n);
#pragma unroll
        for (int ai = 0; ai < 2; ++ai)
#pragma unroll
            for (int m = 0; m < 4; ++m) { const size_t slot = (size_t)u.pm * 256 + ai * 128 + wr * 64 + m * 16 + fr; const int li = list[slot]; const float gt = gslot[slot];
                if (li >= 0) { bf16_t* dst = EO + ((size_t)(li & 3) * MROWS + (li >> 2)) * DM + c0;
#pragma unroll
                    for (int bj = 0; bj < 2; ++bj) { const f32x4 v0 = (acc[ai][bj][m][0] + bb[bj][0]) * gt, v1 = (acc[ai][bj][m][1] + bb[bj][1]) * gt;
                        u32x4 w; w.x = cvt_pk_bf16(v0[0], v0[1]); w.y = cvt_pk_bf16(v0[2], v0[3]); w.z = cvt_pk_bf16(v1[0], v1[1]); w.w = cvt_pk_bf16(v1[2], v1[3]);
                        *(u32x4*)(dst + bj * 128) = w; } } }
    }
};
__device__ __forceinline__ const int* moe_tiles(Frame& F, int& nT) {
    FT_DECL;
    LAS int* TE = (LAS int*)(F.lds + RING_BYTES); const int* meta = WSP(int, WS_ROUTE + RT_META);
    __syncthreads();
    nT = meta[64]; if (nT > MAXTILE) nT = MAXTILE;
    for (int i = f_tid; i < MAXTILE; i += 512) TE[i] = (i < nT) ? meta[128 + i] : 0;
    __syncthreads();
    return (const int*)TE;
}

__device__ __forceinline__ void p10_combine(Frame& F) {
    FT_DECL;
    const float* mod = WSP(float, WS_SMALL + SM_MOD); const bf16_t* EO = WSP(bf16_t, WS_EO);
    const size_t gt = (size_t)F.vcu * 512 + f_tid, NTH = (size_t)F.G * 512;
    for (size_t i = gt; i < (size_t)MROWS * 128; i += NTH) { const size_t row = i >> 7; const int c0 = (int)(i & 127) * 8;
        const float* g2 = mod + (size_t)(row >> 12) * (NMOD * DM) + 5 * DM + c0;
        float s[8];
#pragma unroll
        for (int e = 0; e < 8; ++e) s[e] = 0.f;
#pragma unroll
        for (int k = 0; k < 4; ++k) { const u32x4 v = *(const u32x4*)(EO + ((size_t)k * MROWS + row) * DM + c0);
            s[0] += __uint_as_float(v.x << 16); s[1] += __uint_as_float(v.x & 0xffff0000u); s[2] += __uint_as_float(v.y << 16); s[3] += __uint_as_float(v.y & 0xffff0000u);
            s[4] += __uint_as_float(v.z << 16); s[5] += __uint_as_float(v.z & 0xffff0000u); s[6] += __uint_as_float(v.w << 16); s[7] += __uint_as_float(v.w & 0xffff0000u); }
        float* op = F.out + row * DM + c0;
        const f32x4 x0 = *(const f32x4*)op, x1 = *(const f32x4*)(op + 4), ga = *(const f32x4*)g2, gb = *(const f32x4*)(g2 + 4);
        *(f32x4*)op = x0 + ga * (f32x4){s[0], s[1], s[2], s[3]}; *(f32x4*)(op + 4) = x1 + gb * (f32x4){s[4], s[5], s[6], s[7]}; }
}

struct Args { const float* in[34]; float* out; unsigned char* ws; int ph_lo, ph_hi; };
constexpr int N_PHASES = 11;

__global__ void __launch_bounds__(512, 2) mega(Args args) {
    extern __shared__ __attribute__((aligned(16))) unsigned char lds[];
    Frame F;
    F.lds = (LAS unsigned char*)lds;
    F.MISC = (volatile LAS unsigned*)(F.lds + LDSCTL_OFF);
    F.wave = __builtin_amdgcn_readfirstlane(threadIdx.x >> 6);
    FT_DECL;
    F.G = gridDim.x; { const int bx = blockIdx.x; F.vcu = (F.G % 8 == 0) ? (bx % 8) * (F.G / 8) + bx / 8 : bx; }
    F.in = (kin_t)__builtin_amdgcn_kernarg_segment_ptr();
    F.out = args.out; F.ws = args.ws;
    F.ctl = (gu32*)(args.ws + WS_CTL);
    for (int u = f_tid; u < (LDS_BYTES - LDSCTL_OFF) / 4; u += NWAVES * 64) ((LAS unsigned*)(F.lds + LDSCTL_OFF))[u] = 0u;
    __syncthreads();
    const int lo = args.ph_lo, hi = args.ph_hi;
    XcdBarrier bar; bar.bar = (unsigned*)(F.ctl + CW_BAR); bar.x = 0; bar.st = nullptr;
    if (hi - lo > 1) bar = xcd_barrier_post((unsigned*)(F.ctl + CW_BAR), F.MISC + 8, f_tid == 0);
#define IN(k) (lo <= (k) && (k) < hi)
#define SEAM(k) do { if (IN(k) && IN((k) + 1)) xcd_barrier(bar, F.wave == 0 && lane_id() == 0); } while (0)

    if (IN(0)) { p0_prologue(F); } SEAM(0);
    if (IN(1)) { p1_norm1(F); } SEAM(1);
    if (IN(2)) {
        SchedInProj S{F.G, (int)blockIdx.x, (const char*)WSP(bf16_t, WS_H), (const char*)WSP(bf16_t, WS_WIN)};
        EpiInProj E{WSP(bf16_t, WS_Q), WSP(bf16_t, WS_K), WSP(bf16_t, WS_V), WSP(bf16_t, WS_UT), F.in[9], F.in[10], WSP(float, WS_SMALL + SM_ROPE)};
        g8::gemm_phase(F.lds, DM, S, E, F.wave, lane_id());
    } SEAM(2);
    if (IN(3)) { p3_attention(F); p3_hyena(F); } SEAM(3);
    if (IN(4)) { p4_hynorm(F); } SEAM(4);
    if (IN(5)) {
        SchedStatic S{F.G, (int)blockIdx.x, MROWS / 256, DM / 256, (const char*)WSP(bf16_t, WS_MIX), (const char*)WSP(bf16_t, WS_WOUT)};
        EpiOutProj E{F.in[0], F.out, WSP(float, WS_SMALL + SM_MOD)};
        g8::gemm_phase(F.lds, DM, S, E, F.wave, lane_id());
    } SEAM(5);
    if (IN(6)) { p6_router(F); } SEAM(6);
    if (IN(7)) { p7_scatter(F); } SEAM(7);
    if (IN(8)) {
        int nT; const int* TE = moe_tiles(F, nT);
        SchedMoE<8> S{F.G, (int)blockIdx.x, nT, (const char*)WSP(bf16_t, WS_XS), (const char*)WSP(bf16_t, WS_W1), (size_t)2 * DM * DM * 2, TE};
        EpiSwiGLU E{WSP(bf16_t, WS_ACT), F.in[31]};
        g8::gemm_phase(F.lds, DM, S, E, F.wave, lane_id());
    } SEAM(8);
    if (IN(9)) {
        int nT; const int* TE = moe_tiles(F, nT);
        SchedMoE<4> S{F.G, (int)blockIdx.x, nT, (const char*)WSP(bf16_t, WS_ACT), (const char*)WSP(bf16_t, WS_W2), (size_t)DM * DM * 2, TE};
        EpiDown E{WSP(bf16_t, WS_EO), F.in[33], WSP(int, WS_ROUTE + RT_LIST), WSP(float, WS_ROUTE + RT_GSLOT)};
        g8::gemm_phase(F.lds, DM, S, E, F.wave, lane_id());
    } SEAM(9);
    if (IN(10)) { p10_combine(F); }
#undef IN
#undef SEAM
}

extern "C" void kernel_launch(void* const* d_in, const int* in_sizes, int n_in, void* d_out, int out_size, void* d_ws, size_t ws_size, hipStream_t stream) {
    static int grid = 0;
    if (grid == 0) {
        if (n_in != 34 || out_size != MROWS * DM || ws_size < WS_END) { fprintf(stderr, "kernel_launch: unexpected shapes: n_in %d out %d ws %zu (need %zu)\n", n_in, out_size, ws_size, (size_t)WS_END); grid = -1; return; }
        int dev = 0, cus = 0, per_cu = 0;
        if (hipGetDevice(&dev) != hipSuccess || hipDeviceGetAttribute(&cus, hipDeviceAttributeMultiprocessorCount, dev) != hipSuccess) { grid = -1; return; }
        if (hipFuncSetAttribute((const void*)mega, hipFuncAttributeMaxDynamicSharedMemorySize, LDS_BYTES) != hipSuccess) { fprintf(stderr, "kernel_launch: hipFuncSetAttribute failed\n"); grid = -1; return; }
        if (hipOccupancyMaxActiveBlocksPerMultiprocessor(&per_cu, (const void*)mega, NWAVES * 64, LDS_BYTES) != hipSuccess || per_cu < 1) { fprintf(stderr, "kernel_launch: occupancy query says %d\n", per_cu); per_cu = 1; }
        (void)hipGetLastError();
        grid = cus;
    }
    if (grid < 0) return;
    (void)hipMemsetAsync((char*)d_ws + WS_CTL, 0, CTL_ZERO_BYTES, stream);
    Args a{};
    for (int i = 0; i < 34; ++i) a.in[i] = (const float*)d_in[i];
    a.out = (float*)d_out; a.ws = (unsigned char*)d_ws;
    constexpr int LAST = MK_LAST_PHASE + 1;
    if (MK_N_LAUNCHES == 1) { a.ph_lo = 0; a.ph_hi = LAST; hipLaunchKernelGGL(mega, dim3(grid), dim3(NWAVES * 64), LDS_BYTES, stream, a); }
    else for (int p = 0; p < LAST; ++p) { a.ph_lo = p; a.ph_hi = p + 1; hipLaunchKernelGGL(mega, dim3(grid), dim3(NWAVES * 64), LDS_BYTES, stream, a); }
    const hipError_t le = hipPeekAtLastError();
    if (le != hipSuccess) fprintf(stderr, "kernel_launch: launch failed: %s\n", hipGetErrorName(le));
}
```

```cpp
#include <hip/hip_runtime.h>
#include <hip/hip_bf16.h>
#include <cstdio>
#include <cstdint>

#ifndef MK_N_LAUNCHES
#define MK_N_LAUNCHES 1
#endif
#ifndef MK_PROBE_A
#define MK_PROBE_A -2
#endif
#ifndef MK_PA0
#define MK_PA0 0
#define MK_PA1 1
#define MK_PB0 0
#define MK_PB1 1
#define MK_PSA 2e-6f
#define MK_PSB 1e-4f
#endif
#ifndef MK_LAST_PHASE
#define MK_LAST_PHASE 10
#endif

#define GAS __attribute__((address_space(1)))
#define LAS __attribute__((address_space(3)))
typedef unsigned short bf16_t;
typedef short bf16x8 __attribute__((ext_vector_type(8)));
typedef short s16x4 __attribute__((ext_vector_type(4)));
typedef float f32x2 __attribute__((ext_vector_type(2)));
typedef float f32x4 __attribute__((ext_vector_type(4)));
typedef float f32x16 __attribute__((ext_vector_type(16)));
typedef unsigned u32x2 __attribute__((ext_vector_type(2)));
typedef unsigned u32x4 __attribute__((ext_vector_type(4)));
typedef GAS unsigned gu32;

constexpr int NB = 8, SEQ = 4096, DM = 1024, MROWS = NB * SEQ, CTXL = 256, MCTX = NB * CTXL, MTOT = MROWS + MCTX;
constexpr int KVL = CTXL + SEQ;
constexpr int NHEAD = 4, QKW = 512;
constexpr int HYW = 512, HYC = 1536, INC = 3072, QKVC = 1536;
constexpr int NEXP = 32, TOPK = 4, NMOD = 6;
constexpr float EPS = 1e-6f;
constexpr float LAM_INIT = 0.2f;
constexpr float QSCALE = 0.125f * 1.4426950408889634f;

constexpr size_t MiB = 1u << 20;
constexpr size_t WS_CTL = 0, CTL_ZERO_BYTES = 1 * MiB;
constexpr size_t WS_SMALL = 1 * MiB;
constexpr size_t WS_WIN = 2 * MiB;
constexpr size_t WS_WOUT = 8 * MiB;
constexpr size_t WS_W1 = 10 * MiB;
constexpr size_t WS_W2 = 138 * MiB;
constexpr size_t WS_H = 202 * MiB;
constexpr size_t WS_Q = 270 * MiB;
constexpr size_t WS_K = 302 * MiB;
constexpr size_t WS_V = 336 * MiB;
constexpr size_t WS_UT = 370 * MiB;
constexpr size_t WS_FILT = 466 * MiB;
constexpr size_t WS_Z2T = 498 * MiB;
constexpr size_t WS_MIX = 530 * MiB;
constexpr size_t WS_ROUTE = 594 * MiB;
constexpr size_t WS_ACT = 270 * MiB;
constexpr size_t WS_EO = 598 * MiB;
constexpr size_t WS_XN = 870 * MiB;
constexpr size_t WS_END = 998 * MiB;
constexpr size_t SM_MOD = 0;
constexpr size_t SM_SCAL = 256 * 1024;
constexpr size_t SM_ROPE = 260 * 1024;
constexpr int CW_BAR = 4096;

constexpr int RING_BYTES = 131072;
constexpr int LDSCTL_OFF = 151552;
constexpr int LDS_BYTES = 152576;
constexpr int NWAVES = 8;

#define LDS_WAIT() asm volatile("s_waitcnt lgkmcnt(0)" ::: "memory")
#define VM_WAIT() asm volatile("s_waitcnt vmcnt(0)" ::: "memory")
#define RLX_AGENT __ATOMIC_RELAXED, __HIP_MEMORY_SCOPE_AGENT

__device__ __forceinline__ unsigned cvt_pk_bf16(float lo, float hi) { unsigned r; asm volatile("v_cvt_pk_bf16_f32 %0, %1, %2" : "=v"(r) : "v"(lo), "v"(hi)); return r; }
__device__ __forceinline__ float bf2f(bf16_t v) { return __uint_as_float(((unsigned)v) << 16); }
__device__ __forceinline__ float wave_sum(float v) {
#pragma unroll
    for (int o = 1; o < 64; o <<= 1) v += __shfl_xor(v, o);
    return v;
}

#define XB_TMO      128
#define XB_XCNT(j)  (256  + 64 * (j))
#define XB_XSUB(j)  (1280 + 64 * (j))
#define XB_XGEN(j)  (2304 + 64 * (j))
#define XB_TOP      3328
#define XB_TOPGEN   3392
#define XCD_BAR_WORDS 3456
#define XB_SPIN_CAP (1u << 22)
__device__ __forceinline__ unsigned xb_ld(unsigned* p)              { return __hip_atomic_load(p, __ATOMIC_RELAXED, __HIP_MEMORY_SCOPE_AGENT); }
__device__ __forceinline__ unsigned xb_add(unsigned* p, unsigned v) { return __hip_atomic_fetch_add(p, v, __ATOMIC_RELAXED, __HIP_MEMORY_SCOPE_AGENT); }
__device__ __forceinline__ unsigned xb_xcc_id() { return (unsigned)__builtin_amdgcn_s_getreg((3 << 11) | 20) & 0xFu; }
#define XB_SPIN(cond, bar) do { unsigned _sp = 0; while (cond) { __builtin_amdgcn_s_sleep(1); \
    if ((++_sp & 255u) == 0u) { if (xb_ld(&(bar)[XB_TMO])) break; if (_sp > XB_SPIN_CAP) { atomicAdd(&(bar)[XB_TMO], 1u); break; } } } } while (0)
struct XcdBarrier { unsigned* bar; unsigned x; volatile LAS unsigned* st; };
__device__ __forceinline__ XcdBarrier xcd_barrier_post(unsigned* bar, volatile LAS unsigned* st, bool leader) {
    XcdBarrier b; b.bar = bar; b.x = xb_xcc_id(); b.st = st;
    if (leader) (void)xb_add(&bar[XB_XCNT(b.x)], 1u);
    return b;
}
__device__ __forceinline__ void xcd_barrier_complete(unsigned* bar, unsigned x, unsigned& nloc, unsigned& nx) {
    const unsigned G = gridDim.x * gridDim.y * gridDim.z;
    unsigned sum, cnt, mine, sp = 0u;
    for (;;) {
        sum = 0u; cnt = 0u; mine = 0u;
#pragma unroll
        for (unsigned j = 0; j < 16; ++j) { const unsigned c = xb_ld(&bar[XB_XCNT(j)]); sum += c; cnt += (c > 0u) ? 1u : 0u; mine = (j == x) ? c : mine; }
        if (sum == G) break;
        __builtin_amdgcn_s_sleep(1);
        if ((++sp & 255u) == 0u) { if (xb_ld(&bar[XB_TMO])) break; if (sp > XB_SPIN_CAP) { atomicAdd(&bar[XB_TMO], 1u); break; } }
    }
    nloc = mine > 0u ? mine : 1u; nx = cnt > 0u ? cnt : 1u;
}
__device__ __forceinline__ void xcd_barrier(const XcdBarrier& b, bool leader) {
    asm volatile("s_waitcnt vmcnt(0)" ::: "memory");
    __syncthreads();
    if (leader) {
        unsigned* bar = b.bar;
        __builtin_amdgcn_s_waitcnt(0);
        unsigned nloc = b.st[0], nx = b.st[1];
        if (nloc == 0u) { xcd_barrier_complete(bar, b.x, nloc, nx); b.st[0] = nloc; b.st[1] = nx; }
        const unsigned old = xb_add(&bar[XB_XSUB(b.x)], 1u);
        const unsigned gen = old / nloc;
        if (old + 1u == (gen + 1u) * nloc) {
            __builtin_amdgcn_fence(__ATOMIC_RELEASE, "agent");
            asm volatile("s_waitcnt vmcnt(0)" ::: "memory");
            const unsigned og = xb_add(&bar[XB_TOP], 1u);
            const unsigned tg = og / nx;
            if (og + 1u == (tg + 1u) * nx) xb_add(&bar[XB_TOPGEN], 1u);
            else XB_SPIN(xb_ld(&bar[XB_TOPGEN]) == tg, bar);
            __builtin_amdgcn_fence(__ATOMIC_ACQUIRE, "agent");
            xb_add(&bar[XB_XGEN(b.x)], 1u);
            asm volatile("s_waitcnt vmcnt(0)" ::: "memory");
        } else {
            XB_SPIN(xb_ld(&bar[XB_XGEN(b.x)]) == gen, bar);
            __builtin_amdgcn_fence(__ATOMIC_ACQUIRE, "agent");
            asm volatile("s_waitcnt vmcnt(0)" ::: "memory");
        }
    }
    __syncthreads();
}

namespace g8 {
constexpr int BM = 256, BK = 64, HALF = 128, HTB = HALF * BK * 2, STAGE_BYTES = 8 * HTB, NXCD = 8, WGM = 8;
__host__ __device__ __forceinline__ int lds_byte(int r, int c) { const int st = (r >> 4) * 2 + (c >> 5), rr = r & 15, cc = c & 31, ob = rr * 64 + cc * 2; return st * 1024 + (ob ^ (((ob >> 9) & 1) << 5)); }
__host__ __device__ __forceinline__ void stage_rc(int b, int& R, int& C) { const int st = b / 1024, sb = b % 1024, swz = sb ^ (((sb >> 9) & 1) << 5); R = (st >> 1) * 16 + swz / 64; C = (st & 1) * 32 + (swz % 64) / 2; }
__host__ __device__ __forceinline__ int perm32(int rho) { const int n = rho >> 4, i = rho & 15; return 8 * (i >> 2) + 4 * n + (i & 3); }

struct Unit { const char* a; const char* b; int pm, pn, kind, ex; };

__device__ __forceinline__ void tile_of(int L, int nM, int nN, int& pm, int& pn) {
    const int nwg = nM * nN; int wgid = L;
    { const int q = nwg / NXCD, r = nwg % NXCD, xcd = wgid % NXCD, off = wgid / NXCD; wgid = (xcd < r ? xcd * (q + 1) : r * (q + 1) + (xcd - r) * q) + off; }
    const int nig = WGM * nN, gid = wgid / nig, fm = gid * WGM, gsz = (nM - fm) < WGM ? (nM - fm) : WGM;
    pm = fm + ((wgid % nig) % gsz); pn = (wgid % nig) / gsz;
}

template <class Epi, class Sched>
__device__ __forceinline__ void gemm_phase(LAS unsigned char* lds, const int K, const Sched& S, const Epi& E, const int wid, const int lane) {
    const int tid = wid * 64 + lane, wr = wid >> 2, wc = wid & 3, fr = lane & 15, fq = lane >> 4;
    const int nt = K / BK;
    unsigned voffA[2], voffB[2];
#pragma unroll
    for (int i = 0; i < 2; ++i) { int R, C; stage_rc(tid * 16 + i * 8192, R, C); const int Rb = (R & ~31) + perm32(R & 31);
        voffA[i] = (unsigned)(R * K + C) * 2u; voffB[i] = (unsigned)(Rb * K + C) * 2u; }
    const size_t kstep = (size_t)(BK * 2);
    const size_t hstep = (size_t)HALF * K * 2;
    const unsigned ldsw = (unsigned)wid * 1024u;
    const int aoff = lds_byte(wr * 64 + fr, fq * 8), boff = lds_byte(wc * 32 + fr, fq * 8);
#define PG8_SA(b, h) (((b) * 2 + (h)) * HTB)
#define PG8_SB(b, h) ((4 + (b) * 2 + (h)) * HTB)
#define PG8_STAGE(bufoff, gbase, voff) do { _Pragma("unroll") for (int _i = 0; _i < 2; ++_i) \
        __builtin_amdgcn_global_load_lds((const unsigned*)((const char*)(gbase) + (voff)[_i]), (LAS unsigned*)(lds + (bufoff) + ldsw + _i * 8192), 16, 0, 0); } while (0)
#define PG8_LDA(dst, b, h) do { _Pragma("unroll") for (int m = 0; m < 4; ++m) _Pragma("unroll") for (int k = 0; k < 2; ++k) dst[m][k] = *(const LAS bf16x8*)(lds + PG8_SA(b, h) + aoff + m * 2048 + k * 1024); } while (0)
#define PG8_LDB(dst, b, h) do { _Pragma("unroll") for (int n = 0; n < 2; ++n) _Pragma("unroll") for (int k = 0; k < 2; ++k) dst[n][k] = *(const LAS bf16x8*)(lds + PG8_SB(b, h) + boff + n * 2048 + k * 1024); } while (0)
#define PG8_MMA(ai, bj, At, Bt) do { __builtin_amdgcn_s_setprio(1); _Pragma("unroll") for (int m = 0; m < 4; ++m) _Pragma("unroll") for (int n = 0; n < 2; ++n) _Pragma("unroll") for (int k = 0; k < 2; ++k) \
        acc[ai][bj][m][n] = __builtin_amdgcn_mfma_f32_16x16x32_bf16(Bt[n][k], At[m][k], acc[ai][bj][m][n], 0, 0, 0); __builtin_amdgcn_s_setprio(0); } while (0)
#define PG8_WAIT_V(n) asm volatile("s_waitcnt vmcnt(" #n ")" ::: "memory")
#define PG8_WAIT_L(n) asm volatile("s_waitcnt lgkmcnt(" #n ")" ::: "memory")
#define PG8_BAR __builtin_amdgcn_s_barrier()
#define PG8_SCHED __builtin_amdgcn_sched_barrier(0)
    Unit cur, nxt; int ui = 0;
    if (!S.next(0, cur)) return;
    f32x4 acc[2][2][4][2];
#pragma unroll
    for (int a = 0; a < 2; ++a)
#pragma unroll
        for (int b = 0; b < 2; ++b)
#pragma unroll
            for (int m = 0; m < 4; ++m)
#pragma unroll
                for (int n = 0; n < 2; ++n) acc[a][b][m][n] = (f32x4){0.f, 0.f, 0.f, 0.f};
    bf16x8 At[4][2], B0[2][2], B1[2][2];
    const char* cA = cur.a; const char* cB = cur.b;
    PG8_STAGE(PG8_SB(0, 0), cB, voffB); PG8_STAGE(PG8_SB(0, 1), cB + hstep, voffB); PG8_STAGE(PG8_SA(0, 0), cA, voffA); PG8_STAGE(PG8_SA(0, 1), cA + hstep, voffA);
    if (wr == 1) PG8_BAR;
    PG8_WAIT_V(2); PG8_BAR;
    PG8_STAGE(PG8_SB(1, 0), cB + kstep, voffB); PG8_STAGE(PG8_SA(1, 0), cA + kstep, voffA); PG8_STAGE(PG8_SB(1, 1), cB + hstep + kstep, voffB);
    PG8_WAIT_V(6); PG8_BAR;
    for (;;) {
        const bool has_next = S.next(ui + 1, nxt);
        const char* nA = has_next ? nxt.a : cA; const char* nB = has_next ? nxt.b : cB;
        for (int t = 0; t < nt; t += 2) {
            const bool last = (t == nt - 2);
            const char* a1 = cA + (size_t)(t + 1) * kstep;
            const char* a2 = last ? nA : cA + (size_t)(t + 2) * kstep; const char* b2 = last ? nB : cB + (size_t)(t + 2) * kstep;
            const char* a3 = a2 + kstep; const char* b3 = b2 + kstep;
            PG8_LDB(B0, 0, 0); PG8_LDB(B1, 0, 1); PG8_SCHED; PG8_LDA(At, 0, 0); PG8_STAGE(PG8_SA(1, 1), a1 + hstep, voffA);
            PG8_WAIT_V(8); PG8_WAIT_L(0); PG8_BAR; PG8_MMA(0, 0, At, B0); PG8_MMA(0, 1, At, B1); PG8_BAR; PG8_SCHED;
            PG8_LDA(At, 0, 1); PG8_STAGE(PG8_SB(0, 0), b2, voffB); PG8_STAGE(PG8_SB(0, 1), b2 + hstep, voffB); PG8_STAGE(PG8_SA(0, 0), a2, voffA);
            PG8_WAIT_V(8); PG8_WAIT_L(0); PG8_BAR; PG8_MMA(1, 0, At, B0); PG8_MMA(1, 1, At, B1); PG8_BAR; PG8_SCHED;
            PG8_LDB(B0, 1, 0); PG8_LDB(B1, 1, 1); PG8_SCHED; PG8_LDA(At, 1, 0); PG8_STAGE(PG8_SA(0, 1), a2 + hstep, voffA);
            PG8_WAIT_V(8); PG8_WAIT_L(0); PG8_BAR; PG8_MMA(0, 0, At, B0); PG8_MMA(0, 1, At, B1); PG8_BAR; PG8_SCHED;
            PG8_LDA(At, 1, 1); PG8_STAGE(PG8_SB(1, 0), b3, voffB); PG8_STAGE(PG8_SB(1, 1), b3 + hstep, voffB); PG8_STAGE(PG8_SA(1, 0), a3, voffA);
            PG8_WAIT_V(8); PG8_WAIT_L(0); PG8_BAR; PG8_MMA(1, 0, At, B0); PG8_MMA(1, 1, At, B1); PG8_BAR; PG8_SCHED;
        }
        if (wr == 0) PG8_BAR;
        E(acc, cur, wr, wc, fr, fq);
        if (!has_next) break;
#pragma unroll
        for (int a = 0; a < 2; ++a)
#pragma unroll
            for (int b = 0; b < 2; ++b)
#pragma unroll
                for (int m = 0; m < 4; ++m)
#pragma unroll
                    for (int n = 0; n < 2; ++n) acc[a][b][m][n] = (f32x4){0.f, 0.f, 0.f, 0.f};
        cur = nxt; cA = nA; cB = nB; ++ui;
        if (wr == 1) PG8_BAR;
    }
    PG8_WAIT_V(0);
    PG8_BAR;
#undef PG8_SA
#undef PG8_SB
#undef PG8_STAGE
#undef PG8_LDA
#undef PG8_LDB
#undef PG8_MMA
#undef PG8_WAIT_V
#undef PG8_WAIT_L
#undef PG8_BAR
#undef PG8_SCHED
}
}

__device__ __forceinline__ int lane_id() { int l; asm volatile("v_mbcnt_lo_u32_b32 %0, -1, 0\n\tv_mbcnt_hi_u32_b32 %0, -1, %0" : "=v"(l)); return l; }
#define FT_DECL const int f_lane = lane_id(), f_tid = F.wave * 64 + f_lane; (void)f_tid; (void)f_lane
typedef const float* cfp_t;
typedef __attribute__((address_space(4))) cfp_t* kin_t;
struct Frame {
    LAS unsigned char* lds;
    volatile LAS unsigned* MISC;
    gu32* ctl;
    int wave, vcu, G;
    kin_t in;
    float* out;
    unsigned char* ws;
};
#define WSP(T, off) ((T*)(F.ws + (off)))

template <class RowMap>
__device__ __forceinline__ void p0_transpose_item(const float* W, int K, int N, bf16_t* WT, const RowMap& rowmap, const float* kscale, LAS float* scr, int item, int lane) {
    const int nblk = N / 32, kb = item / nblk, nb = item % nblk, k0 = 64 * kb, n0 = 32 * nb;
#pragma unroll 8
    for (int i = 0; i < 32; ++i) { const int kk = 2 * i + (lane >> 5); float v = W[(size_t)(k0 + kk) * N + n0 + (lane & 31)]; if (kscale) v *= kscale[k0 + kk]; scr[kk * 33 + (lane & 31)] = v; }
    LDS_WAIT(); asm volatile("" ::: "memory");
    const int c = lane & 7;
#pragma unroll
    for (int j = 0; j < 4; ++j) { const int n = (lane >> 3) + 8 * j; const LAS float* s = scr + (8 * c) * 33 + n;
        u32x4 o; o.x = cvt_pk_bf16(s[0 * 33], s[1 * 33]); o.y = cvt_pk_bf16(s[2 * 33], s[3 * 33]); o.z = cvt_pk_bf16(s[4 * 33], s[5 * 33]); o.w = cvt_pk_bf16(s[6 * 33], s[7 * 33]);
        *(GAS u32x4*)(WT + (size_t)rowmap(n0 + n) * K + k0 + 8 * c) = o; }
    LDS_WAIT(); asm volatile("" ::: "memory");
}
struct MapIdent { int off; __device__ __forceinline__ int operator()(int n) const { return off + n; } };
struct MapWin { __device__ __forceinline__ int operator()(int l) const {
    if (l >= QKVC) return l;
    const int t = l & ~255, r = l & 255, wc = r >> 6, blk = (r >> 5) & 1, bj = (r >> 4) & 1, low = r & 15;
    return t + 128 * bj + 32 * wc + 16 * blk + low; } };
struct MapW1 { int off; __device__ __forceinline__ int operator()(int jp) const { const int bj = jp >> 10, j = jp & 1023; return off + 256 * (j >> 7) + 128 * bj + (j & 127); } };


__device__ __forceinline__ void p0_filter_item(Frame& F, int item) {
    FT_DECL;
#define in F.in
    LAS float* h1s = (LAS float*)(F.lds);
    LAS float* h2s = (LAS float*)(F.lds + 4096);
    const int t0 = item * 16;
    {
        const int tt = f_tid >> 5, hh = (f_tid & 31) * 2; const float pos = (float)(t0 + tt);
        float feats[17]; feats[0] = pos * (1.f / SEQ);
#pragma unroll
        for (int i = 0; i < 8; ++i) { const float band = 1e-4f + (float)i * ((7.f - 1e-4f) / 7.f); const float ang = (6.283185307179586f / SEQ) * pos * band; feats[1 + i] = sinf(ang); feats[9 + i] = cosf(ang); }
#pragma unroll
        for (int u = 0; u < 2; ++u) { const int h = hh + u; float a = in[19][h];
#pragma unroll
            for (int k = 0; k < 17; ++k) a += feats[k] * in[18][k * 64 + h];
            h1s[tt * 64 + h] = sinf(in[20][h] * a); }
        __syncthreads();
#pragma unroll
        for (int u = 0; u < 2; ++u) { const int h = hh + u; float a = in[22][h];
#pragma unroll 8
            for (int k = 0; k < 64; ++k) a += h1s[tt * 64 + k] * in[21][k * 64 + h];
            h2s[tt * 64 + h] = sinf(in[23][h] * a); }
        __syncthreads();
    }
    f32x4 acc[16];
#pragma unroll
    for (int t = 0; t < 16; ++t) acc[t] = (f32x4){0.f, 0.f, 0.f, 0.f};
    const int o = 4 * f_tid;
    for (int k = 0; k < 64; ++k) { const f32x4 w = *(const f32x4*)(in[24] + (size_t)k * 2048 + o);
#pragma unroll
        for (int t = 0; t < 16; ++t) acc[t] += w * h2s[t * 64 + k]; }
    const int c0 = o & 511, od = o >> 9;
    float* dst = WSP(float, WS_FILT) + ((size_t)od * 512 + c0) * SEQ + t0;
#pragma unroll
    for (int e = 0; e < 4; ++e) { const float la = -3.0701134573253944f, lb = -15.350567286626972f; const float delta = fabsf(la + (float)(c0 + e) * ((lb - la) / 511.f));
#pragma unroll
        for (int q = 0; q < 4; ++q) { f32x4 v;
#pragma unroll
            for (int i = 0; i < 4; ++i) { const int t = 4 * q + i; const float tn = (float)(t0 + t) * (1.f / SEQ); v[i] = acc[t][e] * expf(-tn * delta); }
            *(f32x4*)(dst + (size_t)e * SEQ + 4 * q) = v; } }
    __syncthreads();
#undef in
}

__device__ __forceinline__ float silu_f(float v) { return v / (1.f + __expf(-v)); }

__device__ __forceinline__ void p0_prologue(Frame& F) {
    FT_DECL;
#define in F.in
    const int wg = blockIdx.x;
    if (wg < 96) {
        LAS float* sv = (LAS float*)F.lds;
        for (int i = f_tid; i < 9 * 1024; i += 512) { const int r = i >> 10, k = i & 1023; const float c = (r < 8) ? in[1][r * 1024 + k] : in[3][k]; sv[i] = silu_f(c); }
        __syncthreads();
        const int j = wg * 64 + f_lane; const float* wm = in[4];
        float acc[9];
#pragma unroll
        for (int r = 0; r < 9; ++r) acc[r] = 0.f;
        const int kbeg = F.wave * 128;
#pragma unroll 4
        for (int k = kbeg; k < kbeg + 128; ++k) { const float w = wm[(size_t)k * (NMOD * DM) + j];
#pragma unroll
            for (int r = 0; r < 9; ++r) acc[r] += sv[r * 1024 + k] * w; }
        LAS float* red = (LAS float*)(F.lds + 40960);
#pragma unroll
        for (int r = 0; r < 9; ++r) red[(F.wave * 9 + r) * 64 + f_lane] = acc[r];
        __syncthreads();
        for (int i = f_tid; i < 9 * 64; i += 512) { const int r = i >> 6, l = i & 63; float s = in[5][wg * 64 + l];
#pragma unroll
            for (int w = 0; w < 8; ++w) s += red[(w * 9 + r) * 64 + l];
            WSP(float, WS_SMALL + SM_MOD)[r * (NMOD * DM) + wg * 64 + l] = s; }
        __syncthreads();
    } else if (wg == 96) {
        if (F.wave == 0) {
            const float a = wave_sum(in[11][f_lane] * in[12][f_lane]), b = wave_sum(in[13][f_lane] * in[14][f_lane]);
            float gq = fabsf(in[9][f_lane]), gk = fabsf(in[10][f_lane]);
#pragma unroll
            for (int o = 1; o < 64; o <<= 1) { gq = fmaxf(gq, __shfl_xor(gq, o)); gk = fmaxf(gk, __shfl_xor(gk, o)); }
            if (f_lane == 0) { float* sc = WSP(float, WS_SMALL + SM_SCAL); sc[0] = expf(a) - expf(b) + LAM_INIT;
                sc[1] = (8.f * gq * gk * 1.02f + 0.05f) * 1.4426950408889634f; }
        }
        for (int i = f_tid; i < 64 * 16; i += 512) { const int pos = i >> 4, f = i & 15;
            const float inv = powf(10000.f, -(float)f / 16.f); const float ang = (float)pos * inv;
            float* rt = WSP(float, WS_SMALL + SM_ROPE); rt[2 * i] = cosf(ang); rt[2 * i + 1] = sinf(ang); }
    }
    __syncthreads();
    for (int it = wg; it < SEQ / 16; it += F.G) p0_filter_item(F, it);
    {
        LAS float* scr = (LAS float*)(F.lds + 65536 + F.wave * 8704);
        const int gw = F.vcu * NWAVES + F.wave, NGW = F.G * NWAVES;
        constexpr int I_IN = (DM / 64) * (INC / 32), I_OUT = (DM / 64) * (DM / 32), I_1 = (DM / 64) * (2 * DM / 32), I_2 = (DM / 64) * (DM / 32);
        constexpr int NITEMS = I_IN + I_OUT + NEXP * (I_1 + I_2);
        for (int it = gw; it < NITEMS; it += NGW) {
            int r = it;
            if (r < I_IN) { p0_transpose_item(in[8], DM, INC, WSP(bf16_t, WS_WIN), MapWin{}, nullptr, scr, r, f_lane); continue; } r -= I_IN;
            if (r < I_OUT) { p0_transpose_item(in[27], DM, DM, WSP(bf16_t, WS_WOUT), MapIdent{0}, nullptr, scr, r, f_lane); continue; } r -= I_OUT;
            const int e = r / (I_1 + I_2); r -= e * (I_1 + I_2);
            if (r < I_1) p0_transpose_item(in[30] + (size_t)e * DM * 2 * DM, DM, 2 * DM, WSP(bf16_t, WS_W1) + (size_t)e * 2 * DM * DM, MapW1{0}, nullptr, scr, r, f_lane);
            else p0_transpose_item(in[32] + (size_t)e * DM * DM, DM, DM, WSP(bf16_t, WS_W2) + (size_t)e * DM * DM, MapIdent{0}, nullptr, scr, r - I_1, f_lane);
        }
    }
}

#undef in
__device__ __forceinline__ void p1_norm1(Frame& F) {
    FT_DECL;
    const int gw = F.vcu * NWAVES + F.wave, NGW = F.G * NWAVES;
    const float* mod = WSP(float, WS_SMALL + SM_MOD); const float* g1 = F.in[6];
    bf16_t* H = WSP(bf16_t, WS_H);
    for (int m = gw; m < MTOT; m += NGW) {
        const float* xrow = (m < MROWS) ? F.in[0] + (size_t)m * DM : F.in[2] + (size_t)(m - MROWS) * DM;
        const int mb = (m < MROWS) ? (m >> 12) : 8;
        const float* sh = mod + (size_t)mb * (NMOD * DM); const float* sc = sh + DM;
        const GAS f32x4* xr = (const GAS f32x4*)xrow + f_lane;
        f32x4 v[4]; float s = 0.f;
#pragma unroll
        for (int j = 0; j < 4; ++j) { v[j] = xr[64 * j]; s += (v[j].x * v[j].x + v[j].y * v[j].y) + (v[j].z * v[j].z + v[j].w * v[j].w); }
        const float rstd = rsqrtf(wave_sum(s) * (1.f / DM) + EPS);
        GAS u32x2* o8 = (GAS u32x2*)(H + (size_t)m * DM) + f_lane;
#pragma unroll
        for (int j = 0; j < 4; ++j) { const int c = 4 * f_lane + 256 * j;
            const f32x4 g = *(const f32x4*)(g1 + c), a = *(const f32x4*)(sc + c), b = *(const f32x4*)(sh + c);
            const f32x4 y = v[j] * rstd * g * (a + 1.f) + b;
            u32x2 w; w.x = cvt_pk_bf16(y.x, y.y); w.y = cvt_pk_bf16(y.z, y.w); o8[64 * j] = w; }
    }
}

struct SchedInProj {
    int G, c; const char* H; const char* W;
    static constexpr int NA = 136 * 6, NBU = 6 * 128;
    __device__ __forceinline__ bool next(int i, g8::Unit& u) const {
        const long L = (long)i * G + c;
        if (L < NA) { g8::tile_of((int)L, 136, 6, u.pm, u.pn); u.a = H + (size_t)u.pm * 256 * DM * 2; u.b = W + (size_t)u.pn * 256 * DM * 2; u.kind = 0; u.ex = 0; return true; }
        if (L < NA + NBU) { g8::tile_of((int)L - NA, 6, 128, u.pm, u.pn); u.a = W + (size_t)(QKVC + u.pm * 256) * DM * 2; u.b = H + (size_t)u.pn * 256 * DM * 2; u.kind = 1; u.ex = 0; return true; }
        return false;
    }
};
struct EpiInProj {
    bf16_t *Q, *Kb, *Vb, *UT; const float *gq, *gk, *rope;
    __device__ __forceinline__ void operator()(f32x4 (&acc)[2][2][4][2], const g8::Unit& u, int wr, int wc, int fr, int fq) const {
        if (u.kind == 1) {
            const int row0 = u.pm * 256 + wr * 64 + fr, col0 = u.pn * 256 + wc * 32 + 8 * fq;
#pragma unroll
            for (int ai = 0; ai < 2; ++ai)
#pragma unroll
                for (int m = 0; m < 4; ++m) { bf16_t* rowp = UT + (size_t)(row0 + ai * 128 + m * 16) * MROWS + col0;
#pragma unroll
                    for (int bj = 0; bj < 2; ++bj) { const f32x4 v0 = acc[ai][bj][m][0], v1 = acc[ai][bj][m][1];
                        u32x4 w; w.x = cvt_pk_bf16(v0[0], v0[1]); w.y = cvt_pk_bf16(v0[2], v0[3]); w.z = cvt_pk_bf16(v1[0], v1[1]); w.w = cvt_pk_bf16(v1[2], v1[3]);
                        *(u32x4*)(rowp + bj * 128) = w; } }
            return;
        }
        const int blk = fq >> 1, f = fq & 1;
        const int sec = u.pn >> 1;
        const bool ctx = (u.pm >= 128);
        if (sec == 0 && ctx) return;
        const int colbase = (u.pn & 1) * 256 + wc * 64 + 32 * blk + 8 * f;
        float gg[2][2][4];
        if (sec < 2) { const float* gp = (sec == 0 ? gq : gk) + 32 * blk + 8 * f;
#pragma unroll
            for (int bj = 0; bj < 2; ++bj)
#pragma unroll
                for (int n = 0; n < 2; ++n) { const f32x4 t = *(const f32x4*)(gp + 16 * bj + 4 * n); gg[bj][n][0] = t[0]; gg[bj][n][1] = t[1]; gg[bj][n][2] = t[2]; gg[bj][n][3] = t[3]; } }
#pragma unroll
        for (int ai = 0; ai < 2; ++ai)
#pragma unroll
            for (int m = 0; m < 4; ++m) {
                const int rloc = ai * 128 + wr * 64 + m * 16 + fr; const int r = u.pm * 256 + rloc;
                f32x4 v[2][2];
#pragma unroll
                for (int bj = 0; bj < 2; ++bj)
#pragma unroll
                    for (int n = 0; n < 2; ++n) v[bj][n] = acc[ai][bj][m][n];
                size_t orow;
                if (sec == 0) orow = (size_t)r;
                else if (!ctx) orow = (size_t)(r >> 12) * KVL + CTXL + (r & 4095);
                else { const int j = r - MROWS; orow = (size_t)(j >> 8) * KVL + (j & 255); }
                if (sec < 2) {
                    float ss = 0.f;
#pragma unroll
                    for (int bj = 0; bj < 2; ++bj)
#pragma unroll
                        for (int n = 0; n < 2; ++n) ss += (v[bj][n][0] * v[bj][n][0] + v[bj][n][1] * v[bj][n][1]) + (v[bj][n][2] * v[bj][n][2] + v[bj][n][3] * v[bj][n][3]);
                    ss += __shfl_xor(ss, 16); ss += __shfl_xor(ss, 32);
                    const float rstd = rsqrtf(ss * (1.f / 64.f) + EPS);
#pragma unroll
                    for (int bj = 0; bj < 2; ++bj)
#pragma unroll
                        for (int n = 0; n < 2; ++n)
#pragma unroll
                            for (int e = 0; e < 4; ++e) v[bj][n][e] *= rstd * gg[bj][n][e];
                    if (!ctx) {
                        const int t = r & 4095; const int pos = blk ? (t & 63) : (t >> 6);
                        const float* rp = rope + (size_t)(pos * 16 + 8 * f) * 2;
#pragma unroll
                        for (int n = 0; n < 2; ++n) { const f32x4 c0 = *(const f32x4*)(rp + 8 * n), c1 = *(const f32x4*)(rp + 8 * n + 4);
                            const float cs[4] = {c0[0], c0[2], c1[0], c1[2]}, sn[4] = {c0[1], c0[3], c1[1], c1[3]};
#pragma unroll
                            for (int e = 0; e < 4; ++e) { const float x1 = v[0][n][e], x2 = v[1][n][e]; v[0][n][e] = x1 * cs[e] - x2 * sn[e]; v[1][n][e] = x2 * cs[e] + x1 * sn[e]; } }
                    }
                    if (sec == 0) {
#pragma unroll
                        for (int bj = 0; bj < 2; ++bj)
#pragma unroll
                            for (int n = 0; n < 2; ++n) v[bj][n] *= QSCALE;
                    }
                }
                bf16_t* dst = (sec == 0 ? Q : (sec == 1 ? Kb : Vb)) + orow * QKW + colbase;
#pragma unroll
                for (int bj = 0; bj < 2; ++bj) { u32x4 w; w.x = cvt_pk_bf16(v[bj][0][0], v[bj][0][1]); w.y = cvt_pk_bf16(v[bj][0][2], v[bj][0][3]); w.z = cvt_pk_bf16(v[bj][1][0], v[bj][1][1]); w.w = cvt_pk_bf16(v[bj][1][2], v[bj][1][3]);
                    *(u32x4*)(dst + 16 * bj) = w; }
            }
    }
};

struct SchedStatic {
    int G, c, nM, nN; const char* A; const char* B;
    __device__ __forceinline__ bool next(int i, g8::Unit& u) const {
        const long L = (long)i * G + c; if (L >= (long)nM * nN) return false;
        g8::tile_of((int)L, nM, nN, u.pm, u.pn); u.a = A + (size_t)u.pm * 256 * DM * 2; u.b = B + (size_t)u.pn * 256 * DM * 2; u.kind = 0; u.ex = 0; return true;
    }
};
struct EpiOutProj {
    const float* x; float* out; const float* mod;
    __device__ __forceinline__ void operator()(f32x4 (&acc)[2][2][4][2], const g8::Unit& u, int wr, int wc, int fr, int fq) const {
        const int col0 = u.pn * 256 + wc * 32 + 8 * fq;
#pragma unroll
        for (int ai = 0; ai < 2; ++ai)
#pragma unroll
            for (int m = 0; m < 4; ++m) { const int r = u.pm * 256 + ai * 128 + wr * 64 + m * 16 + fr; const float* g1 = mod + (size_t)(r >> 12) * (NMOD * DM) + 2 * DM;
                const size_t off = (size_t)r * DM + col0;
#pragma unroll
                for (int bj = 0; bj < 2; ++bj)
#pragma unroll
                    for (int n = 0; n < 2; ++n) { const int c = bj * 128 + 4 * n; const f32x4 xv = *(const f32x4*)(x + off + c), gv = *(const f32x4*)(g1 + col0 + c);
                        *(f32x4*)(out + off + c) = xv + gv * acc[ai][bj][m][n]; } }
    }
};

namespace att {
constexpr int KVBLK = 64, LDK = QKW, NT = KVL / KVBLK;
constexpr int SHM_V = KVBLK * 128 * 2, SHM_K = KVBLK * 128 * 2;
#define KSWZ(row, colB) ((row) * 256 + ((colB) ^ (((row) & 7) << 4)))
#define SBAR() __builtin_amdgcn_sched_barrier(0)
__device__ __forceinline__ int crow(int r, int hi) { return (r & 3) + 8 * (r >> 2) + 4 * hi; }
__device__ __forceinline__ void expA(f32x16& p) {
#pragma unroll
    for (int r = 0; r < 16; ++r) p[r] = __builtin_amdgcn_exp2f(p[r]);
}
__device__ __forceinline__ void finishSM(f32x16& p0, f32x16& p1, float& l_reg, bf16x8& pa0, bf16x8& pa1, bf16x8& pa2, bf16x8& pa3) {
#pragma unroll
    for (int r = 0; r < 16; ++r) p1[r] = __builtin_amdgcn_exp2f(p1[r]);
    float ps = 0;
#pragma unroll
    for (int r = 0; r < 16; ++r) ps += p0[r];
#pragma unroll
    for (int r = 0; r < 16; ++r) ps += p1[r];
    { auto rr = __builtin_amdgcn_permlane32_swap(__float_as_uint(ps), __float_as_uint(ps), false, false); ps = __uint_as_float(rr[0]) + __uint_as_float(rr[1]); }
    l_reg += ps;
#define PK4(P, BASE, OUT) do { unsigned a0 = cvt_pk_bf16(P[BASE + 0], P[BASE + 1]), a1 = cvt_pk_bf16(P[BASE + 2], P[BASE + 3]);   \
    unsigned b0 = cvt_pk_bf16(P[BASE + 4], P[BASE + 5]), b1 = cvt_pk_bf16(P[BASE + 6], P[BASE + 7]);                              \
    auto r0 = __builtin_amdgcn_permlane32_swap(a0, b0, false, false); auto r1 = __builtin_amdgcn_permlane32_swap(a1, b1, false, false); \
    u32x4 w = {r0[0], r1[0], r0[1], r1[1]}; OUT = *reinterpret_cast<bf16x8*>(&w); } while (0)
    PK4(p0, 0, pa0); PK4(p0, 8, pa1); PK4(p1, 0, pa2); PK4(p1, 8, pa3);
#undef PK4
}
__device__ __forceinline__ void qkt(f32x16& p0, f32x16& p1, const char* Ks, const bf16x8* qr, int r32, int hi, int sub, float negm) {
#pragma unroll
    for (int r = 0; r < 16; ++r) { p0[r] = negm; p1[r] = negm; }
#pragma unroll
    for (int d0 = 0; d0 < 4; ++d0) { const int cb = (sub * 64 + d0 * 16 + hi * 8) * 2;
        const bf16x8 b0 = *reinterpret_cast<const bf16x8*>(Ks + KSWZ(r32, cb));
        const bf16x8 b1 = *reinterpret_cast<const bf16x8*>(Ks + KSWZ(32 + r32, cb));
        p0 = __builtin_amdgcn_mfma_f32_32x32x16_bf16(b0, qr[d0], p0, 0, 0, 0);
        p1 = __builtin_amdgcn_mfma_f32_32x32x16_bf16(b1, qr[d0], p1, 0, 0, 0); }
}
__device__ __forceinline__ int v_st(int k, int c) { const int kk = (k & ~0xC) | ((k & 4) << 1) | ((k & 8) >> 1); return ((kk >> 3) * 4 + (c >> 5)) * 512 + ((kk & 7) * 32 + (c & 31)) * 2; }
__device__ __forceinline__ int v_rd_base(int lane) { return ((lane & 3) << 3) | (((lane >> 2) & 3) << 6) | (((lane >> 4) & 1) << 5) | (((lane >> 5) & 1) << 8); }
constexpr int v_rd_off(int d0, int ks, int half) { return d0 * 512 + ks * 4096 + half * 2048; }
template <int OFF> __device__ __forceinline__ s16x4 tr_read(int vb) {
    s16x4 r; asm volatile("ds_read_b64_tr_b16 %0, %1 offset:%2" : "=&v"(r) : "v"(vb), "i"(OFF) : "memory"); return r;
}
template <int D0> __device__ __forceinline__ void pv_one(f32x16& od, int vb, bf16x8 pa0, bf16x8 pa1, bf16x8 pa2, bf16x8 pa3) {
    const s16x4 l0 = tr_read<v_rd_off(D0, 0, 0)>(vb), h0 = tr_read<v_rd_off(D0, 0, 1)>(vb), l1 = tr_read<v_rd_off(D0, 1, 0)>(vb), h1 = tr_read<v_rd_off(D0, 1, 1)>(vb);
    const s16x4 l2 = tr_read<v_rd_off(D0, 2, 0)>(vb), h2 = tr_read<v_rd_off(D0, 2, 1)>(vb), l3 = tr_read<v_rd_off(D0, 3, 0)>(vb), h3 = tr_read<v_rd_off(D0, 3, 1)>(vb);
    asm volatile("s_waitcnt lgkmcnt(0)" ::: "memory"); SBAR();
#define PK(L, H) (bf16x8){L[0], L[1], L[2], L[3], H[0], H[1], H[2], H[3]}
    od = __builtin_amdgcn_mfma_f32_32x32x16_bf16(pa0, PK(l0, h0), od, 0, 0, 0);
    od = __builtin_amdgcn_mfma_f32_32x32x16_bf16(pa1, PK(l1, h1), od, 0, 0, 0);
    od = __builtin_amdgcn_mfma_f32_32x32x16_bf16(pa2, PK(l2, h2), od, 0, 0, 0);
    od = __builtin_amdgcn_mfma_f32_32x32x16_bf16(pa3, PK(l3, h3), od, 0, 0, 0);
#undef PK
}
__device__ __forceinline__ void pv_d0(f32x16* o, int vb, bf16x8 pa0, bf16x8 pa1, bf16x8 pa2, bf16x8 pa3) {
    pv_one<0>(o[0], vb, pa0, pa1, pa2, pa3); pv_one<1>(o[1], vb, pa0, pa1, pa2, pa3); pv_one<2>(o[2], vb, pa0, pa1, pa2, pa3); pv_one<3>(o[3], vb, pa0, pa1, pa2, pa3);
}

__device__ __forceinline__ void attn_unit(const bf16_t* __restrict__ Qb, const bf16_t* __restrict__ Kh, const bf16_t* __restrict__ Vh, bf16_t* MIXo,
                                          const float lam, const float negm, const float* __restrict__ subg, char* lds, const int wid) {
    const int lane = lane_id(), tid = wid * 64 + lane, r32 = lane & 31, hi = lane >> 5;
    const int sub = wid >> 2, wq = wid & 3;
    char* V_lds = lds; char* K_lds = lds + 2 * SHM_V;
    float* wsf = (float*)(lds + 98304) + wid * 32;
    float l_reg = 0; f32x16 o[4] = {}; bf16x8 qr[4];
    const bf16_t* Qw = Qb + (long)(wq * 32 + r32) * LDK + sub * 64 + hi * 8;
#pragma unroll
    for (int d0 = 0; d0 < 4; ++d0) qr[d0] = *reinterpret_cast<const bf16x8*>(Qw + d0 * 16);
    const int sr = tid >> 4, sc = (tid & 15) * 8, vst0 = v_st(sr, sc), vst1 = v_st(32 + sr, sc);
    const int vb0 = (int)(uintptr_t)V_lds + v_rd_base(lane);
    struct { bf16x8 vs0, vs1, ks0, ks1; } sr_[2];
#define SLOAD(i, k0) do { sr_[i].vs0 = *(const bf16x8*)(&Vh[(long)((k0) + sr) * LDK + sc]); sr_[i].vs1 = *(const bf16x8*)(&Vh[(long)((k0) + 32 + sr) * LDK + sc]); \
    sr_[i].ks0 = *(const bf16x8*)(&Kh[(long)((k0) + sr) * LDK + sc]); sr_[i].ks1 = *(const bf16x8*)(&Kh[(long)((k0) + 32 + sr) * LDK + sc]); } while (0)
#define SWRITE(b, i) do { *(bf16x8*)(V_lds + (b) * SHM_V + vst0) = sr_[i].vs0;          \
    *(bf16x8*)(V_lds + (b) * SHM_V + vst1) = sr_[i].vs1; const int kc = sc * 2;               \
    *(bf16x8*)(K_lds + (b) * SHM_K + KSWZ(sr, kc)) = sr_[i].ks0;                       \
    *(bf16x8*)(K_lds + (b) * SHM_K + KSWZ(32 + sr, kc)) = sr_[i].ks1; } while (0)
#define SWAIT() asm volatile("s_waitcnt vmcnt(4)" ::: "memory")
    f32x16 pA0, pA1, pB0, pB1; bf16x8 pa0, pa1, pa2, pa3;
    constexpr int SE = 0, SO = 1;
    SLOAD(SE, 0); asm volatile("s_waitcnt vmcnt(0)" ::: "memory"); SWRITE(0, SE); __syncthreads();
    qkt(pA0, pA1, K_lds, qr, r32, hi, sub, negm); expA(pA0);
    SLOAD(SO, KVBLK); SLOAD(SE, 2 * KVBLK);
    SWAIT(); SWRITE(1, SO); __syncthreads();
    for (int j = 1; j + 1 < NT; j += 2) {
        SBAR(); qkt(pB0, pB1, K_lds + SHM_K, qr, r32, hi, sub, negm);
        finishSM(pA0, pA1, l_reg, pa0, pa1, pa2, pa3); SBAR();
        SLOAD(SO, (j + 2) * KVBLK); SBAR();
        pv_d0(o, vb0, pa0, pa1, pa2, pa3); expA(pB0);
        __syncthreads(); SWAIT(); SWRITE(0, SE);
        __syncthreads();
        SBAR(); qkt(pA0, pA1, K_lds, qr, r32, hi, sub, negm);
        finishSM(pB0, pB1, l_reg, pa0, pa1, pa2, pa3); SBAR();
        if (j + 3 < NT) SLOAD(SE, (j + 3) * KVBLK); SBAR();
        pv_d0(o, vb0 + SHM_V, pa0, pa1, pa2, pa3); expA(pA0);
        __syncthreads(); SWAIT(); SWRITE(1, SO);
        __syncthreads();
    }
    SBAR(); qkt(pB0, pB1, K_lds + SHM_K, qr, r32, hi, sub, negm);
    finishSM(pA0, pA1, l_reg, pa0, pa1, pa2, pa3); SBAR();
    pv_d0(o, vb0, pa0, pa1, pa2, pa3); expA(pB0);
    finishSM(pB0, pB1, l_reg, pa0, pa1, pa2, pa3); SBAR();
    pv_d0(o, vb0 + SHM_V, pa0, pa1, pa2, pa3);
#undef SLOAD
#undef SWRITE
#undef SWAIT
    if (hi == 0) wsf[r32] = l_reg;
    __syncthreads();
    float* X = (float*)lds;
    float rli[16];
#pragma unroll
    for (int r = 0; r < 16; ++r) rli[r] = __builtin_amdgcn_rcpf(wsf[crow(r, hi)]);
    if (sub == 1) {
#pragma unroll
        for (int r = 0; r < 16; ++r) { const int row = wq * 32 + crow(r, hi); const float s = lam * rli[r];
#pragma unroll
            for (int d0 = 0; d0 < 4; ++d0) X[row * 128 + d0 * 32 + r32] = o[d0][r] * s; }
    }
    __syncthreads();
    bf16_t* Y = (bf16_t*)(lds + 65536);
    if (sub == 0) {
        float sg[4];
#pragma unroll
        for (int d0 = 0; d0 < 4; ++d0) sg[d0] = subg[d0 * 32 + r32] * (1.f - LAM_INIT);
#pragma unroll
        for (int r = 0; r < 16; ++r) { const int row = wq * 32 + crow(r, hi);
            float v[4]; float ss = 0.f;
#pragma unroll
            for (int d0 = 0; d0 < 4; ++d0) { v[d0] = o[d0][r] * rli[r] - X[row * 128 + d0 * 32 + r32]; ss += v[d0] * v[d0]; }
            ss += __shfl_xor(ss, 1); ss += __shfl_xor(ss, 2); ss += __shfl_xor(ss, 4); ss += __shfl_xor(ss, 8); ss += __shfl_xor(ss, 16);
            const float rstd = rsqrtf(ss * (1.f / 128.f) + EPS);
#pragma unroll
            for (int d0 = 0; d0 < 4; ++d0) Y[row * 128 + d0 * 32 + r32] = (bf16_t)(cvt_pk_bf16(v[d0] * rstd * sg[d0], 0.f) & 0xffffu); }
    }
    __syncthreads();
    { const int row = tid >> 2, seg = (tid & 3) * 32;
#pragma unroll
        for (int i = 0; i < 4; ++i) { const u32x4 v = *(const u32x4*)(Y + row * 128 + seg + i * 8); *(u32x4*)(MIXo + (size_t)row * DM + seg + i * 8) = v; } }
    __syncthreads();
}
#undef KSWZ
#undef SBAR
}

__device__ __forceinline__ void p3_attention(Frame& F) {
    FT_DECL;
    const float* sc = WSP(float, WS_SMALL + SM_SCAL);
    const float lam = sc[0], negm = -sc[1];
    const bf16_t* Q = WSP(bf16_t, WS_Q); const bf16_t* Kb = WSP(bf16_t, WS_K); const bf16_t* Vb = WSP(bf16_t, WS_V); bf16_t* MIX = WSP(bf16_t, WS_MIX);
    const int c = blockIdx.x, xcd = c & 7, ci = c >> 3, per = F.G >> 3;
    for (int j = ci; j < 128; j += per) {
        const int pair = xcd * 4 + (j >> 5), qb = j & 31, b = pair >> 2, h = pair & 3;
        att::attn_unit(Q + ((size_t)b * SEQ + qb * 128) * QKW + h * 128, Kb + (size_t)b * KVL * QKW + h * 128, Vb + (size_t)b * KVL * QKW + h * 128,
                       MIX + ((size_t)b * SEQ + qb * 128) * DM + h * 128, lam, negm, F.in[15], (char*)F.lds, F.wave);
    }
}


namespace hy {
constexpr int RB_BYTES = 4352 * 8, IN_OFF = 2 * RB_BYTES, TW1_OFF = IN_OFF + 32768, TW2_OFF = TW1_OFF + 15 * 256 * 8, LDS_END = TW2_OFF + 15 * 16 * 8;
__device__ __forceinline__ f32x2 cmul(f32x2 a, f32x2 b) { return (f32x2){a.x * b.x - a.y * b.y, a.x * b.y + a.y * b.x}; }
__device__ __forceinline__ f32x2 cmulc(f32x2 a, f32x2 b) { return (f32x2){a.x * b.x + a.y * b.y, a.y * b.x - a.x * b.y}; }
__device__ __forceinline__ int P(int i) { return i + (i >> 4); }
template <bool INV> __device__ __forceinline__ void r4(f32x2& a, f32x2& b, f32x2& c, f32x2& d) {
    const f32x2 t0 = a + c, t1 = a - c, t2 = b + d, t3 = b - d;
    const f32x2 st3 = INV ? (f32x2){-t3.y, t3.x} : (f32x2){t3.y, -t3.x};
    a = t0 + t2; c = t0 - t2; b = t1 + st3; d = t1 - st3;
}
template <bool INV> __device__ __forceinline__ f32x2 tw(f32x2 v, float c, float s) {
    return INV ? (f32x2){v.x * c - v.y * s, v.y * c + v.x * s} : (f32x2){v.x * c + v.y * s, v.y * c - v.x * s};
}
template <bool INV> __device__ __forceinline__ void dft16(f32x2 (&v)[16]) {
    constexpr float C1 = 0.9238795325112867f, S1 = 0.3826834323650898f, R2 = 0.7071067811865476f;
    r4<INV>(v[0], v[4], v[8], v[12]); r4<INV>(v[1], v[5], v[9], v[13]); r4<INV>(v[2], v[6], v[10], v[14]); r4<INV>(v[3], v[7], v[11], v[15]);
    v[5] = tw<INV>(v[5], C1, S1);  v[9] = tw<INV>(v[9], R2, R2);    v[13] = tw<INV>(v[13], S1, C1);
    v[6] = tw<INV>(v[6], R2, R2);  v[10] = tw<INV>(v[10], 0.f, 1.f); v[14] = tw<INV>(v[14], -R2, R2);
    v[7] = tw<INV>(v[7], S1, C1);  v[11] = tw<INV>(v[11], -R2, R2);  v[15] = tw<INV>(v[15], -C1, -S1);
    r4<INV>(v[0], v[1], v[2], v[3]); r4<INV>(v[4], v[5], v[6], v[7]); r4<INV>(v[8], v[9], v[10], v[11]); r4<INV>(v[12], v[13], v[14], v[15]);
    f32x2 t;
    t = v[1]; v[1] = v[4]; v[4] = t;   t = v[2]; v[2] = v[8]; v[8] = t;    t = v[3]; v[3] = v[12]; v[12] = t;
    t = v[6]; v[6] = v[9]; v[9] = t;   t = v[7]; v[7] = v[13]; v[13] = t;  t = v[11]; v[11] = v[14]; v[14] = t;
}
struct Ctx { LAS f32x2* R; LAS f32x2* IN; LAS f32x2* TW1; LAS f32x2* TW2; int t, half; f32x2 wt; };
#define HY_OPAQUE(x) asm volatile("" : "+v"(x))
#define HY_W32(m) (f32x2){__builtin_cosf(-0.19634954084936207f * (m)), __builtin_sinf(-0.19634954084936207f * (m))}
template <int MODE> __device__ __forceinline__ void pass1_fwd(const Ctx& X) {
    f32x2 v[16]; int t = X.t; HY_OPAQUE(t);
#pragma unroll
    for (int m = 0; m < 16; ++m) { f32x2 a = X.IN[t + 256 * m]; if (MODE == 1) a = (f32x2){X.half ? a.y : a.x, 0.f}; v[m] = a; }
    if (X.half) {
#pragma unroll
        for (int m = 0; m < 16; ++m) v[m] = cmul(cmul(v[m], HY_W32(m)), X.wt);
    }
    dft16<false>(v);
#pragma unroll
    for (int q = 1; q < 16; ++q) v[q] = cmul(v[q], X.TW1[(q - 1) * 256 + t]);
    const int pb = t + (t >> 4);
#pragma unroll
    for (int q = 0; q < 16; ++q) X.R[pb + 272 * q] = v[q];
}
__device__ __forceinline__ void pass2_fwd(const Ctx& X) {
    int t = X.t; HY_OPAQUE(t);
    const int n2 = t & 15, pb = (t >> 4) * 272 + n2; f32x2 v[16];
#pragma unroll
    for (int m = 0; m < 16; ++m) v[m] = X.R[pb + 17 * m];
    dft16<false>(v);
#pragma unroll
    for (int q = 1; q < 16; ++q) v[q] = cmul(v[q], X.TW2[(q - 1) * 16 + n2]);
#pragma unroll
    for (int q = 0; q < 16; ++q) X.R[pb + 17 * q] = v[q];
}
template <bool FILTER> __device__ __forceinline__ void pass3(const Ctx& X, f32x2 (&H)[16]) {
    f32x2 v[16]; int t = X.t; HY_OPAQUE(t); const int pb = 17 * t;
#pragma unroll
    for (int m = 0; m < 16; ++m) v[m] = X.R[pb + m];
    dft16<false>(v);
    if (FILTER) {
#pragma unroll
        for (int q = 0; q < 16; ++q) H[q] = v[q] * (1.f / 8192.f);
    } else {
#pragma unroll
        for (int q = 0; q < 16; ++q) v[q] = cmul(v[q], H[q]);
        dft16<true>(v);
#pragma unroll
        for (int m = 0; m < 16; ++m) X.R[pb + m] = v[m];
    }
}
__device__ __forceinline__ void pass2_inv(const Ctx& X) {
    int t = X.t; HY_OPAQUE(t);
    const int n2 = t & 15, pb = (t >> 4) * 272 + n2; f32x2 v[16];
    v[0] = X.R[pb];
#pragma unroll
    for (int q = 1; q < 16; ++q) v[q] = cmulc(X.R[pb + 17 * q], X.TW2[(q - 1) * 16 + n2]);
    dft16<true>(v);
#pragma unroll
    for (int m = 0; m < 16; ++m) X.R[pb + 17 * m] = v[m];
}
__device__ __forceinline__ void pass1_inv(const Ctx& X) {
    f32x2 v[16]; int t = X.t; HY_OPAQUE(t); const int pb = t + (t >> 4);
    v[0] = X.R[pb];
#pragma unroll
    for (int q = 1; q < 16; ++q) v[q] = cmulc(X.R[pb + 272 * q], X.TW1[(q - 1) * 256 + t]);
    dft16<true>(v);
    if (X.half) {
#pragma unroll
        for (int m = 0; m < 16; ++m) v[m] = cmulc(cmulc(v[m], HY_W32(m)), X.wt);
    }
#pragma unroll
    for (int m = 0; m < 16; ++m) X.R[pb + 272 * m] = v[m];
}
__device__ __forceinline__ void conv_fft(const Ctx& X, f32x2 (&H)[16]) {
    __syncthreads(); pass1_fwd<0>(X); __syncthreads(); pass2_fwd(X); __syncthreads(); pass3<false>(X, H); __syncthreads(); pass2_inv(X); __syncthreads(); pass1_inv(X); __syncthreads();
}
__device__ __forceinline__ float ldbf(const bf16_t* p) { return bf2f(*p); }
__device__ __forceinline__ float sconv(const bf16_t* row, int b, int n, float w0, float w1, float w2, float bias) {
    const bf16_t* p = row + b * SEQ + n;
    const float c = ldbf(p), lv = ldbf(p - ((n > 0) ? 1 : 0)), rv = ldbf(p + ((n < SEQ - 1) ? 1 : 0));
    const float l = (n > 0) ? lv : 0.f, r = (n < SEQ - 1) ? rv : 0.f;
    return bias + w0 * l + w1 * c + w2 * r;
}
__device__ __forceinline__ void setup_tables(LAS unsigned char* lds, int tid) {
    LAS f32x2* TW1 = (LAS f32x2*)(lds + TW1_OFF); LAS f32x2* TW2 = (LAS f32x2*)(lds + TW2_OFF);
    for (int i = tid; i < 15 * 256; i += 512) { const int q = i / 256 + 1, t = i & 255; float s, c; sincosf(-6.283185307179586f * (float)((t * q) & 4095) * (1.f / 4096.f), &s, &c); TW1[i] = (f32x2){c, s}; }
    for (int i = tid; i < 15 * 16; i += 512) { const int q = i / 16 + 1, n2 = i & 15; float s, c; sincosf(-6.283185307179586f * (float)((n2 * q) & 255) * (1.f / 256.f), &s, &c); TW2[i] = (f32x2){c, s}; }
}
__device__ __forceinline__ void unit(Frame& F, int c) {
    FT_DECL;
    const int tid = f_tid; Ctx X; X.half = F.wave >> 2; X.t = tid & 255;
    X.R = (LAS f32x2*)(F.lds + X.half * RB_BYTES); X.IN = (LAS f32x2*)(F.lds + IN_OFF); X.TW1 = (LAS f32x2*)(F.lds + TW1_OFF); X.TW2 = (LAS f32x2*)(F.lds + TW2_OFF);
    { float s, cc; sincosf(-6.283185307179586f * (float)X.t * (1.f / 8192.f), &s, &cc); X.wt = (f32x2){cc, s}; }
    LAS f32x2* RB0 = (LAS f32x2*)(F.lds); LAS f32x2* RB1 = (LAS f32x2*)(F.lds + RB_BYTES);
    const float* FILT = WSP(float, WS_FILT);
    f32x2 H0[16], H1[16];
#pragma unroll
    for (int ord = 0; ord < 2; ++ord) {
        const float* hf = FILT + ((size_t)(ord * 2 + 0) * 512 + c) * SEQ; const float* hb = FILT + ((size_t)(ord * 2 + 1) * 512 + c) * SEQ;
        __syncthreads();
        int nb = tid; HY_OPAQUE(nb);
#pragma unroll
        for (int j = 0; j < 8; ++j) { const int n = nb + 512 * j; const float a = hf[n], b = hb[(SEQ - n) & (SEQ - 1)]; const float lo = (n == 0) ? a + b : a, hi = (n == 0) ? 0.f : b; X.IN[n] = (f32x2){lo + hi, lo - hi}; }
        __syncthreads(); pass1_fwd<1>(X); __syncthreads(); pass2_fwd(X); __syncthreads();
        if (ord == 0) pass3<true>(X, H0); else pass3<true>(X, H1);
    }
    const bf16_t* UT = WSP(bf16_t, WS_UT);
    const bf16_t* rv = UT + (size_t)c * MROWS; const bf16_t* r1 = UT + (size_t)(512 + c) * MROWS; const bf16_t* r2 = UT + (size_t)(1024 + c) * MROWS;
    const float* cw = F.in[16]; const float* cb = F.in[17];
    const float wv0 = cw[c], wv1 = cw[HYC + c], wv2 = cw[2 * HYC + c], bv = cb[c];
    const float wa0 = cw[512 + c], wa1 = cw[HYC + 512 + c], wa2 = cw[2 * HYC + 512 + c], ba = cb[512 + c];
    const float wb0 = cw[1024 + c], wb1 = cw[HYC + 1024 + c], wb2 = cw[2 * HYC + 1024 + c], bb = cb[1024 + c];
    const float sk0 = F.in[25][c], sk1 = F.in[25][512 + c];
    bf16_t* Z = WSP(bf16_t, WS_Z2T) + (size_t)c * MROWS;
    for (int pr = 0; pr < 4; ++pr) {
        const int b0 = 2 * pr, b1 = b0 + 1;
        f32x2 z[8]; int pc = tid + (tid >> 4); HY_OPAQUE(pc); int nb = tid; HY_OPAQUE(nb);
        __syncthreads();
#pragma unroll
        for (int j = 0; j < 8; ++j) { const int n = nb + 512 * j; z[j] = (f32x2){sconv(rv, b0, n, wv0, wv1, wv2, bv), sconv(rv, b1, n, wv0, wv1, wv2, bv)}; X.IN[n] = z[j]; }
        conv_fft(X, H0);
        HY_OPAQUE(nb); HY_OPAQUE(pc);
#pragma unroll
        for (int j = 0; j < 8; ++j) { const int n = nb + 512 * j; const f32x2 y = RB0[pc + 544 * j] + RB1[pc + 544 * j];
            const f32x2 g = (f32x2){sconv(r1, b0, n, wa0, wa1, wa2, ba), sconv(r1, b1, n, wa0, wa1, wa2, ba)};
            z[j] = g * (y + sk0 * z[j]); X.IN[n] = z[j]; }
        conv_fft(X, H1);
        HY_OPAQUE(nb); HY_OPAQUE(pc);
#pragma unroll
        for (int j = 0; j < 8; ++j) { const int n = nb + 512 * j; const f32x2 y = RB0[pc + 544 * j] + RB1[pc + 544 * j];
            const f32x2 g = (f32x2){sconv(r2, b0, n, wb0, wb1, wb2, bb), sconv(r2, b1, n, wb0, wb1, wb2, bb)};
            const f32x2 o = g * (y + sk1 * z[j]);
            Z[b0 * SEQ + n] = (bf16_t)(cvt_pk_bf16(o.x, 0.f) & 0xffffu); Z[b1 * SEQ + n] = (bf16_t)(cvt_pk_bf16(o.y, 0.f) & 0xffffu); }
    }
    __syncthreads();
}
}

__device__ __forceinline__ void p3_hyena(Frame& F) {
    FT_DECL;
    __syncthreads();
    hy::setup_tables(F.lds, f_tid);
    __syncthreads();
    for (int c = F.vcu; c < HYW; c += F.G) hy::unit(F, c);
}

__device__ __forceinline__ void p4_hynorm(Frame& F) {
    FT_DECL;
    const bf16_t* Z = WSP(bf16_t, WS_Z2T); bf16_t* MIX = WSP(bf16_t, WS_MIX); const float* g = F.in[26];
    LAS bf16_t* T = (LAS bf16_t*)F.lds;
    LAS float* red = (LAS float*)(F.lds + 512 * 72 * 2);
    LAS float* rs = red + 512;
    for (int it = F.vcu; it < MROWS / 64; it += F.G) {
        const int tok0 = it * 64;
        __syncthreads();
#pragma unroll
        for (int j = 0; j < 8; ++j) { const int i = f_tid + 512 * j, row = i >> 3, ch = i & 7; const u32x4 v = *(const u32x4*)(Z + (size_t)row * MROWS + tok0 + ch * 8); *(LAS u32x4*)(T + row * 72 + ch * 8) = v; }
        __syncthreads();
        { const int tok = f_tid & 63, grp = f_tid >> 6; float ss = 0.f;
#pragma unroll 8
            for (int k = 0; k < 64; ++k) { const float v = bf2f(T[(grp * 64 + k) * 72 + tok]); ss += v * v; }
            red[grp * 64 + tok] = ss; }
        __syncthreads();
        if (f_tid < 64) { float ss = 0.f;
#pragma unroll
            for (int w = 0; w < 8; ++w) ss += red[w * 64 + f_tid];
            rs[f_tid] = rsqrtf(ss * (1.f / HYW) + EPS); }
        __syncthreads();
#pragma unroll
        for (int j = 0; j < 8; ++j) { const int i = f_tid + 512 * j, tok = i >> 6, c0 = (i & 63) * 8; const float r = rs[tok];
            float v[8];
#pragma unroll
            for (int e = 0; e < 8; ++e) v[e] = bf2f(T[(c0 + e) * 72 + tok]) * r * g[c0 + e];
            u32x4 w; w.x = cvt_pk_bf16(v[0], v[1]); w.y = cvt_pk_bf16(v[2], v[3]); w.z = cvt_pk_bf16(v[4], v[5]); w.w = cvt_pk_bf16(v[6], v[7]);
            *(u32x4*)(MIX + (size_t)(tok0 + tok) * DM + 512 + c0) = w; }
    }
}

__device__ __forceinline__ void p4_stub(Frame& F) {
    FT_DECL;
    bf16_t* MIX = WSP(bf16_t, WS_MIX);
    const size_t gt = (size_t)F.vcu * 512 + f_tid, NT = (size_t)F.G * 512;
    for (size_t i = gt; i < (size_t)MROWS * 64; i += NT) { const size_t row = i >> 6, ch = i & 63; *(u32x4*)(MIX + row * DM + 512 + ch * 8) = (u32x4){0u, 0u, 0u, 0u}; }
}


constexpr size_t RT_TOPI = 0;
constexpr size_t RT_GATE = 512 * 1024;
constexpr size_t RT_POS = 1024 * 1024;
constexpr size_t RT_WGCNT = 1536 * 1024;
constexpr size_t RT_META = 1600 * 1024;
constexpr size_t RT_LIST = 2048 * 1024;
constexpr size_t RT_GSLOT = 2048 * 1024 + 640 * 1024;
constexpr int MAXSLOT = MROWS * TOPK + NEXP * 256;
constexpr int MAXTILE = MAXSLOT / 256;
constexpr size_t WS_XS = WS_EO;
constexpr int RW_PITCH = 32;
constexpr int P6_LDS_TOPI = 1024 * RW_PITCH * 4;

__device__ __forceinline__ void p6_router(Frame& F) {
    FT_DECL;
#define in F.in
    LAS float* RW = (LAS float*)F.lds;
    LAS int* TI = (LAS int*)(F.lds + P6_LDS_TOPI);
    LAS int* PS = TI + 512;
    LAS int* SC = PS + 512;
    const float* rw = in[28];
    for (int i = f_tid; i < 1024 * 8; i += 512) { const int k = i >> 3, c4 = i & 7; const f32x4 v = *(const f32x4*)(rw + (size_t)k * 32 + c4 * 4);
        const int pi = (k & 3) * 256 + (k >> 2); *(LAS f32x4*)(RW + pi * RW_PITCH + ((c4 ^ ((pi >> 1) & 7)) * 4)) = v; }
    __syncthreads();
    const float* mod = WSP(float, WS_SMALL + SM_MOD); const float* g2n = in[7]; const float* rb = in[29];
    bf16_t* H2 = WSP(bf16_t, WS_H);
    int* topi_g = WSP(int, WS_ROUTE + RT_TOPI); float* gate_g = WSP(float, WS_ROUTE + RT_GATE); int* pos_g = WSP(int, WS_ROUTE + RT_POS); int* wgcnt = WSP(int, WS_ROUTE + RT_WGCNT);
    const int lane = f_lane;
    for (int blk = blockIdx.x; blk < MROWS / 128; blk += F.G) {
        for (int it = 0; it < 8; ++it) {
            const int rl = F.wave * 16 + 2 * it, r0 = blk * 128 + rl;
            const float* sh2 = mod + (size_t)(r0 >> 12) * (NMOD * DM) + 3 * DM; const float* sc2 = sh2 + DM;
            f32x4 h[2][4];
#pragma unroll
            for (int rr = 0; rr < 2; ++rr) {
                const GAS f32x4* xr = (const GAS f32x4*)(WSP(float, WS_XN) + (size_t)(r0 + rr) * DM) + lane; float ss = 0.f;
#pragma unroll
                for (int j = 0; j < 4; ++j) { h[rr][j] = xr[64 * j]; ss += (h[rr][j].x * h[rr][j].x + h[rr][j].y * h[rr][j].y) + (h[rr][j].z * h[rr][j].z + h[rr][j].w * h[rr][j].w); }
                const float rstd = rsqrtf(wave_sum(ss) * (1.f / DM) + EPS);
                GAS u32x2* o8 = (GAS u32x2*)(H2 + (size_t)(r0 + rr) * DM) + lane;
#pragma unroll
                for (int j = 0; j < 4; ++j) { const int c = 4 * lane + 256 * j;
                    const f32x4 g = *(const f32x4*)(g2n + c), a = *(const f32x4*)(sc2 + c), b = *(const f32x4*)(sh2 + c);
                    h[rr][j] = h[rr][j] * rstd * g * (a + 1.f) + b;
                    u32x2 w; w.x = cvt_pk_bf16(h[rr][j].x, h[rr][j].y); w.y = cvt_pk_bf16(h[rr][j].z, h[rr][j].w); o8[64 * j] = w; }
            }
            float a0[32], a1[32]; int lb = lane; asm volatile("" : "+v"(lb)); const int sw = (lb >> 1) & 7;
#pragma unroll
            for (int e = 0; e < 32; ++e) { a0[e] = 0.f; a1[e] = 0.f; }
#pragma unroll
            for (int j = 0; j < 4; ++j)
#pragma unroll
                for (int i = 0; i < 4; ++i) { const LAS float* wp = RW + (i * 256 + 64 * j + lb) * RW_PITCH; const float x0 = h[0][j][i], x1 = h[1][j][i];
#pragma unroll
                    for (int c4 = 0; c4 < 8; ++c4) { const f32x4 w = *(const LAS f32x4*)(wp + 4 * (c4 ^ sw));
#pragma unroll
                        for (int e = 0; e < 4; ++e) { a0[4 * c4 + e] += x0 * w[e]; a1[4 * c4 + e] += x1 * w[e]; } } }
#define RS_STEP(A, CNT, MASK) _Pragma("unroll") for (int i = 0; i < CNT; ++i) { const bool up = (lane & MASK) != 0; const float send = up ? A[i] : A[CNT + i]; const float keep = up ? A[CNT + i] : A[i]; A[i] = keep + __shfl_xor(send, MASK); }
            RS_STEP(a0, 16, 32) RS_STEP(a0, 8, 16) RS_STEP(a0, 4, 8) RS_STEP(a0, 2, 4) RS_STEP(a0, 1, 2)
            RS_STEP(a1, 16, 32) RS_STEP(a1, 8, 16) RS_STEP(a1, 4, 8) RS_STEP(a1, 2, 4) RS_STEP(a1, 1, 2)
#undef RS_STEP
            const int me = lane >> 1; const float bias = rb[me];
            float lg[2]; lg[0] = a0[0] + __shfl_xor(a0[0], 1) + bias; lg[1] = a1[0] + __shfl_xor(a1[0], 1) + bias;
#pragma unroll
            for (int rr = 0; rr < 2; ++rr) {
                float v = lg[rr]; float tv[4]; int ti[4];
#pragma unroll
                for (int k = 0; k < 4; ++k) { float bv = v; int bi = me;
#pragma unroll
                    for (int o = 1; o < 64; o <<= 1) { const float ov = __shfl_xor(bv, o); const int oi = __shfl_xor(bi, o); if (ov > bv || (ov == bv && oi < bi)) { bv = ov; bi = oi; } }
                    tv[k] = bv; ti[k] = bi; if (me == bi) v = -INFINITY; }
                const float e1 = __expf(tv[1] - tv[0]), e2 = __expf(tv[2] - tv[0]), e3 = __expf(tv[3] - tv[0]); const float inv = 1.f / (1.f + e1 + e2 + e3);
                if (lane == 0) { const int r = r0 + rr;
                    *(int4*)(topi_g + (size_t)r * 4) = make_int4(ti[0], ti[1], ti[2], ti[3]);
                    *(f32x4*)(gate_g + (size_t)r * 4) = (f32x4){inv, e1 * inv, e2 * inv, e3 * inv};
                    TI[(rl + rr) * 4 + 0] = ti[0]; TI[(rl + rr) * 4 + 1] = ti[1]; TI[(rl + rr) * 4 + 2] = ti[2]; TI[(rl + rr) * 4 + 3] = ti[3]; }
            }
        }
        __syncthreads();
        { const int e = f_tid & 31, seg = f_tid >> 5; int cnt = 0;
#pragma unroll 4
            for (int i = 0; i < 32; ++i) cnt += (TI[seg * 32 + i] == e) ? 1 : 0;
            SC[seg * 32 + e] = cnt;
            __syncthreads();
            int pre = 0;
            for (int s2 = 0; s2 < seg; ++s2) pre += SC[s2 * 32 + e];
            if (seg == 15) wgcnt[blk * 32 + e] = pre + cnt;
            for (int i = 0; i < 32; ++i) if (TI[seg * 32 + i] == e) { PS[seg * 32 + i] = pre; ++pre; }
        }
        __syncthreads();
        pos_g[(size_t)blk * 512 + f_tid] = PS[f_tid];
        __syncthreads();
    }
#undef in
}

__device__ __forceinline__ void p7_scatter(Frame& F) {
    FT_DECL;
    LAS int* TOT = (LAS int*)F.lds;
    LAS int* BASE = TOT + 32;
    LAS int* PRE = BASE + 32;
    LAS int* PART = PRE + 32;
    const int* wgcnt = WSP(int, WS_ROUTE + RT_WGCNT); const int* topi_g = WSP(int, WS_ROUTE + RT_TOPI); const float* gate_g = WSP(float, WS_ROUTE + RT_GATE); const int* pos_g = WSP(int, WS_ROUTE + RT_POS);
    int* list = WSP(int, WS_ROUTE + RT_LIST); float* gslot = WSP(float, WS_ROUTE + RT_GSLOT); int* meta = WSP(int, WS_ROUTE + RT_META);
    const bf16_t* H2 = WSP(bf16_t, WS_H); bf16_t* XS = WSP(bf16_t, WS_XS);
    for (int blk = blockIdx.x; blk < MROWS / 128; blk += F.G) {
        __syncthreads();
        { const int e = f_tid & 31, part = f_tid >> 5; int st = 0, sp = 0;
            for (int w = part * 16; w < part * 16 + 16; ++w) { const int c = wgcnt[w * 32 + e]; st += c; if (w < blk) sp += c; }
            PART[part * 32 + e] = st; PART[512 + part * 32 + e] = sp; }
        __syncthreads();
        if (f_tid < 32) { int st = 0, sp = 0;
#pragma unroll
            for (int p = 0; p < 16; ++p) { st += PART[p * 32 + f_tid]; sp += PART[512 + p * 32 + f_tid]; }
            TOT[f_tid] = st; PRE[f_tid] = sp; }
        __syncthreads();
        if (f_tid == 0) { int b = 0; for (int e = 0; e < 32; ++e) { BASE[e] = b; b += (TOT[e] + 255) & ~255; }
            if (blk == 0) { int t = 0; for (int e = 0; e < 32; ++e) { meta[e] = TOT[e]; meta[32 + e] = BASE[e]; const int nt = (TOT[e] + 255) >> 8; for (int q = 0; q < nt; ++q) meta[128 + t + q] = e; t += nt; } meta[64] = t; } }
        __syncthreads();
        { const int a = f_tid, row = blk * 128 + (a >> 2); const int e = topi_g[(size_t)blk * 512 + a]; const int slot = BASE[e] + PRE[e] + pos_g[(size_t)blk * 512 + a];
            list[slot] = row * 4 + (a & 3); gslot[slot] = gate_g[(size_t)blk * 512 + a];
            PART[a] = slot; }
        __syncthreads();
        for (int a0 = F.wave * 4; a0 < 512; a0 += NWAVES * 4) { u32x4 v[4][2]; int sl[4];
#pragma unroll
            for (int q = 0; q < 4; ++q) { const int a = a0 + q; sl[q] = PART[a]; const GAS u32x4* src = (const GAS u32x4*)(H2 + (size_t)(blk * 128 + (a >> 2)) * DM); v[q][0] = src[f_lane]; v[q][1] = src[64 + f_lane]; }
#pragma unroll
            for (int q = 0; q < 4; ++q) { GAS u32x4* dst = (GAS u32x4*)(XS + (size_t)sl[q] * DM); dst[f_lane] = v[q][0]; dst[64 + f_lane] = v[q][1]; } }
        if (blk < NEXP) { const int e = blk, lo = BASE[e] + TOT[e], hi = BASE[e] + ((TOT[e] + 255) & ~255);
            for (int sl = lo + F.wave; sl < hi; sl += NWAVES) { if (f_lane == 0) { list[sl] = -1; gslot[sl] = 0.f; }
                GAS u32x4* dst = (GAS u32x4*)(XS + (size_t)sl * DM); dst[f_lane] = (u32x4){0u, 0u, 0u, 0u}; dst[64 + f_lane] = (u32x4){0u, 0u, 0u, 0u}; } }
    }
}

template <int NPN> struct SchedMoE {
    int G, c, nT; const char* A; const char* W; size_t wstride; const int* tileE;
    __device__ __forceinline__ bool next(int i, g8::Unit& u) const {
        const int L = i * G + c, xcd = L & 7, j = L >> 3, T = (j / NPN) * 8 + xcd, pn = j % NPN;
        if (T >= nT) return false;
        const int e = tileE[T];
        u.pm = T; u.pn = pn; u.kind = 0; u.ex = e; u.a = A + (size_t)T * 256 * DM * 2; u.b = W + (size_t)e * wstride + (size_t)pn * 256 * DM * 2; return true;
    }
};
struct EpiSwiGLU {
    bf16_t* ACT; const float* b1;
    __device__ __forceinline__ void operator()(f32x4 (&acc)[2][2][4][2], const g8::Unit& u, int wr, int wc, int fr, int fq) const {
        const int j0 = u.pn * 128 + wc * 32 + 8 * fq; const float* bp = b1 + (size_t)u.ex * 2 * DM + j0;
        f32x4 bg[2], bl[2];
#pragma unroll
        for (int n = 0; n < 2; ++n) { bg[n] = *(const f32x4*)(bp + 4 * n); bl[n] = *(const f32x4*)(bp + DM + 4 * n); }
#pragma unroll
        for (int ai = 0; ai < 2; ++ai)
#pragma unroll
            for (int m = 0; m < 4; ++m) { const size_t slot = (size_t)u.pm * 256 + ai * 128 + wr * 64 + m * 16 + fr; float o[8];
#pragma unroll
                for (int n = 0; n < 2; ++n)
#pragma unroll
                    for (int e = 0; e < 4; ++e) { float g = acc[ai][0][m][n][e] + bg[n][e], l = acc[ai][1][m][n][e] + bl[n][e];
                        g = fminf(g, 7.f); l = fminf(fmaxf(l, -7.f), 7.f);
                        const float sg = 1.f / (1.f + __expf(-1.702f * g)); o[4 * n + e] = (l + 1.f) * (g * sg); }
                u32x4 w; w.x = cvt_pk_bf16(o[0], o[1]); w.y = cvt_pk_bf16(o[2], o[3]); w.z = cvt_pk_bf16(o[4], o[5]); w.w = cvt_pk_bf16(o[6], o[7]);
                *(u32x4*)(ACT + slot * DM + j0) = w; }
    }
};
struct EpiDown {
    bf16_t* EO; const float* b2; const int* list; const float* gslot;
    __device__ __forceinline__ void operator()(f32x4 (&acc)[2][2][4][2], const g8::Unit& u, int wr, int wc, int fr, int fq) const {
        const int c0 = u.pn * 256 + wc * 32 + 8 * fq; const float* bp = b2 + (size_t)u.ex * DM + c0;
        f32x4 bb[2][2];
#pragma unroll
        for (int bj = 0; bj < 2; ++bj)
#pragma unroll
            for (int n = 0; n < 2; ++n) bb[bj][n] = *(const f32x4*)(bp + bj * 128 + 4 * n);
#pragma unroll
        for (int ai = 0; ai < 2; ++ai)
#pragma unroll
            for (int m = 0; m < 4; ++m) { const size_t slot = (size_t)u.pm * 256 + ai * 128 + wr * 64 + m * 16 + fr; const int li = list[slot]; const float gt = gslot[slot];
                if (li >= 0) { bf16_t* dst = EO + ((size_t)(li & 3) * MROWS + (li >> 2)) * DM + c0;
#pragma unroll
                    for (int bj = 0; bj < 2; ++bj) { const f32x4 v0 = (acc[ai][bj][m][0] + bb[bj][0]) * gt, v1 = (acc[ai][bj][m][1] + bb[bj][1]) * gt;
                        u32x4 w; w.x = cvt_pk_bf16(v0[0], v0[1]); w.y = cvt_pk_bf16(v0[2], v0[3]); w.z = cvt_pk_bf16(v1[0], v1[1]); w.w = cvt_pk_bf16(v1[2], v1[3]);
                        *(u32x4*)(dst + bj * 128) = w; } } }
    }
};
__device__ __forceinline__ const int* moe_tiles(Frame& F, int& nT) {
    FT_DECL;
    LAS int* TE = (LAS int*)(F.lds + RING_BYTES); const int* meta = WSP(int, WS_ROUTE + RT_META);
    __syncthreads();
    nT = meta[64]; if (nT > MAXTILE) nT = MAXTILE;
    for (int i = f_tid; i < MAXTILE; i += 512) TE[i] = (i < nT) ? meta[128 + i] : 0;
    __syncthreads();
    return (const int*)TE;
}

__device__ __forceinline__ void p10_combine(Frame& F) {
    FT_DECL;
    const float* mod = WSP(float, WS_SMALL + SM_MOD); const bf16_t* EO = WSP(bf16_t, WS_EO);
    const size_t gt = (size_t)F.vcu * 512 + f_tid, NTH = (size_t)F.G * 512;
    float pd = 0.f, pa = 0.f;
    if (MK_PROBE_A != -2) { const unsigned long long* st = (const unsigned long long*)(F.ws + WS_CTL + 8192);
        pd = (MK_PROBE_A < 0) ? 0.1f : (float)(st[MK_PA1] - st[MK_PA0]) * MK_PSA; pa = (float)(st[MK_PB1] - st[MK_PB0]) * MK_PSB; }
    constexpr int U = 4;
    for (size_t i0 = gt; i0 < (size_t)MROWS * 128; i0 += NTH * U) {
        u32x4 ev[U][4]; f32x4 xv[U][2], gv[U][2];
#pragma unroll
        for (int u = 0; u < U; ++u) { const size_t i = i0 + (size_t)u * NTH; const size_t row = i >> 7; const int c0 = (int)(i & 127) * 8;
            const float* g2 = mod + (size_t)(row >> 12) * (NMOD * DM) + 5 * DM + c0; const float* op = WSP(float, WS_XN) + row * DM + c0;
#pragma unroll
            for (int k = 0; k < 4; ++k) ev[u][k] = __builtin_nontemporal_load((const u32x4*)(EO + ((size_t)k * MROWS + row) * DM + c0));
            xv[u][0] = *(const f32x4*)op; xv[u][1] = *(const f32x4*)(op + 4); gv[u][0] = *(const f32x4*)g2; gv[u][1] = *(const f32x4*)(g2 + 4); }
#pragma unroll
        for (int u = 0; u < U; ++u) { const size_t i = i0 + (size_t)u * NTH; const size_t row = i >> 7; const int c0 = (int)(i & 127) * 8;
            float s[8];
#pragma unroll
            for (int e = 0; e < 8; ++e) s[e] = 0.f;
#pragma unroll
            for (int k = 0; k < 4; ++k) { const u32x4 v = ev[u][k];
                s[0] += __uint_as_float(v.x << 16); s[1] += __uint_as_float(v.x & 0xffff0000u); s[2] += __uint_as_float(v.y << 16); s[3] += __uint_as_float(v.y & 0xffff0000u);
                s[4] += __uint_as_float(v.z << 16); s[5] += __uint_as_float(v.z & 0xffff0000u); s[6] += __uint_as_float(v.w << 16); s[7] += __uint_as_float(v.w & 0xffff0000u); }
            f32x4 o0 = xv[u][0] + gv[u][0] * (f32x4){s[0], s[1], s[2], s[3]}, o1 = xv[u][1] + gv[u][1] * (f32x4){s[4], s[5], s[6], s[7]};
            if (MK_PROBE_A != -2) { o0 += pd; o1 += pd; if (i == 0) o0[0] += pa; }
            float* op = F.out + row * DM + c0;
            __builtin_nontemporal_store(o0, (f32x4*)op); __builtin_nontemporal_store(o1, (f32x4*)(op + 4)); }
    }
}

struct Args { const float* in[34]; float* out; unsigned char* ws; int ph_lo, ph_hi; };
constexpr int N_PHASES = 11;

__global__ void __launch_bounds__(512, 2) mega(Args args) {
    extern __shared__ __attribute__((aligned(16))) unsigned char lds[];
    Frame F;
    F.lds = (LAS unsigned char*)lds;
    F.MISC = (volatile LAS unsigned*)(F.lds + LDSCTL_OFF);
    F.wave = __builtin_amdgcn_readfirstlane(threadIdx.x >> 6);
    FT_DECL;
    F.G = gridDim.x; { const int bx = blockIdx.x; F.vcu = (F.G % 8 == 0) ? (bx % 8) * (F.G / 8) + bx / 8 : bx; }
    F.in = (kin_t)__builtin_amdgcn_kernarg_segment_ptr();
    F.out = args.out; F.ws = args.ws;
    F.ctl = (gu32*)(args.ws + WS_CTL);
    for (int u = f_tid; u < (LDS_BYTES - LDSCTL_OFF) / 4; u += NWAVES * 64) ((LAS unsigned*)(F.lds + LDSCTL_OFF))[u] = 0u;
    __syncthreads();
    const int lo = args.ph_lo, hi = args.ph_hi;
    XcdBarrier bar; bar.bar = (unsigned*)(F.ctl + CW_BAR); bar.x = 0; bar.st = nullptr;
    if (hi - lo > 1) bar = xcd_barrier_post((unsigned*)(F.ctl + CW_BAR), F.MISC + 8, f_tid == 0);
#define IN(k) (lo <= (k) && (k) < hi)
    unsigned long long* stamps = (unsigned long long*)(args.ws + WS_CTL + 8192);
#define STAMP(k) do { if (MK_PROBE_A != -2 && blockIdx.x == 0 && f_tid == 0) stamps[(k)] = __builtin_amdgcn_s_memrealtime(); } while (0)
    STAMP(0);
#define SEAM(k) do { if (IN(k) && IN((k) + 1)) xcd_barrier(bar, F.wave == 0 && lane_id() == 0); } while (0)

    if (IN(0)) { p0_prologue(F); } SEAM(0); STAMP(1);
    if (IN(1)) { p1_norm1(F); } SEAM(1); STAMP(2);
    if (IN(2)) {
        SchedInProj S{F.G, (int)blockIdx.x, (const char*)WSP(bf16_t, WS_H), (const char*)WSP(bf16_t, WS_WIN)};
        EpiInProj E{WSP(bf16_t, WS_Q), WSP(bf16_t, WS_K), WSP(bf16_t, WS_V), WSP(bf16_t, WS_UT), F.in[9], F.in[10], WSP(float, WS_SMALL + SM_ROPE)};
        g8::gemm_phase(F.lds, DM, S, E, F.wave, lane_id());
    } SEAM(2); STAMP(3);
    if (IN(3)) { p3_attention(F); STAMP(12); p3_hyena(F); } SEAM(3); STAMP(4);
    if (IN(4)) { p4_hynorm(F); } SEAM(4); STAMP(5);
    if (IN(5)) {
        SchedStatic S{F.G, (int)blockIdx.x, MROWS / 256, DM / 256, (const char*)WSP(bf16_t, WS_MIX), (const char*)WSP(bf16_t, WS_WOUT)};
        EpiOutProj E{F.in[0], WSP(float, WS_XN), WSP(float, WS_SMALL + SM_MOD)};
        g8::gemm_phase(F.lds, DM, S, E, F.wave, lane_id());
    } SEAM(5); STAMP(6);
    if (IN(6)) { p6_router(F); } SEAM(6); STAMP(7);
    if (IN(7)) { p7_scatter(F); } SEAM(7); STAMP(8);
    if (IN(8)) {
        int nT; const int* TE = moe_tiles(F, nT);
        SchedMoE<8> S{F.G, (int)blockIdx.x, nT, (const char*)WSP(bf16_t, WS_XS), (const char*)WSP(bf16_t, WS_W1), (size_t)2 * DM * DM * 2, TE};
        EpiSwiGLU E{WSP(bf16_t, WS_ACT), F.in[31]};
        g8::gemm_phase(F.lds, DM, S, E, F.wave, lane_id());
    } SEAM(8); STAMP(9);
    if (IN(9)) {
        int nT; const int* TE = moe_tiles(F, nT);
        SchedMoE<4> S{F.G, (int)blockIdx.x, nT, (const char*)WSP(bf16_t, WS_ACT), (const char*)WSP(bf16_t, WS_W2), (size_t)DM * DM * 2, TE};
        EpiDown E{WSP(bf16_t, WS_EO), F.in[33], WSP(int, WS_ROUTE + RT_LIST), WSP(float, WS_ROUTE + RT_GSLOT)};
        g8::gemm_phase(F.lds, DM, S, E, F.wave, lane_id());
    } SEAM(9); STAMP(10);
    if (IN(10)) { p10_combine(F); }
#undef IN
#undef SEAM
}

extern "C" void kernel_launch(void* const* d_in, const int* in_sizes, int n_in, void* d_out, int out_size, void* d_ws, size_t ws_size, hipStream_t stream) {
    static int grid = 0;
    if (grid == 0) {
        if (n_in != 34 || out_size != MROWS * DM || ws_size < WS_END) { fprintf(stderr, "kernel_launch: unexpected shapes: n_in %d out %d ws %zu (need %zu)\n", n_in, out_size, ws_size, (size_t)WS_END); grid = -1; return; }
        int dev = 0, cus = 0, per_cu = 0;
        if (hipGetDevice(&dev) != hipSuccess || hipDeviceGetAttribute(&cus, hipDeviceAttributeMultiprocessorCount, dev) != hipSuccess) { grid = -1; return; }
        if (hipFuncSetAttribute((const void*)mega, hipFuncAttributeMaxDynamicSharedMemorySize, LDS_BYTES) != hipSuccess) { fprintf(stderr, "kernel_launch: hipFuncSetAttribute failed\n"); grid = -1; return; }
        if (hipOccupancyMaxActiveBlocksPerMultiprocessor(&per_cu, (const void*)mega, NWAVES * 64, LDS_BYTES) != hipSuccess || per_cu < 1) { fprintf(stderr, "kernel_launch: occupancy query says %d\n", per_cu); per_cu = 1; }
        (void)hipGetLastError();
        grid = cus;
    }
    if (grid < 0) return;
    (void)hipMemsetAsync((char*)d_ws + WS_CTL, 0, CTL_ZERO_BYTES, stream);
    Args a{};
    for (int i = 0; i < 34; ++i) a.in[i] = (const float*)d_in[i];
    a.out = (float*)d_out; a.ws = (unsigned char*)d_ws;
    constexpr int LAST = MK_LAST_PHASE + 1;
    if (MK_N_LAUNCHES == 1) { a.ph_lo = 0; a.ph_hi = LAST; hipLaunchKernelGGL(mega, dim3(grid), dim3(NWAVES * 64), LDS_BYTES, stream, a); }
    else for (int p = 0; p < LAST; ++p) { a.ph_lo = p; a.ph_hi = p + 1; hipLaunchKernelGGL(mega, dim3(grid), dim3(NWAVES * 64), LDS_BYTES, stream, a); }
    const hipError_t le = hipPeekAtLastError();
    if (le != hipSuccess) fprintf(stderr, "kernel_launch: launch failed: %s\n", hipGetErrorName(le));
}
```

```cpp
#include <hip/hip_runtime.h>
#include <hip/hip_bf16.h>
#include <cstdio>
#include <cstdint>

#ifndef MK_N_LAUNCHES
#define MK_N_LAUNCHES 1
#endif
#ifndef MK_PROBE_A
#define MK_PROBE_A -2
#endif
#ifndef MK_PA0
#define MK_PA0 0
#define MK_PA1 1
#define MK_PB0 0
#define MK_PB1 1
#define MK_PSA 2e-6f
#define MK_PSB 1e-4f
#endif
#ifndef MK_LAST_PHASE
#define MK_LAST_PHASE 10
#endif

#define GAS __attribute__((address_space(1)))
#define LAS __attribute__((address_space(3)))
typedef unsigned short bf16_t;
typedef short bf16x8 __attribute__((ext_vector_type(8)));
typedef short s16x4 __attribute__((ext_vector_type(4)));
typedef float f32x2 __attribute__((ext_vector_type(2)));
typedef float f32x4 __attribute__((ext_vector_type(4)));
typedef float f32x16 __attribute__((ext_vector_type(16)));
typedef unsigned u32x2 __attribute__((ext_vector_type(2)));
typedef unsigned u32x4 __attribute__((ext_vector_type(4)));
typedef GAS unsigned gu32;

constexpr int NB = 8, SEQ = 4096, DM = 1024, MROWS = NB * SEQ, CTXL = 256, MCTX = NB * CTXL, MTOT = MROWS + MCTX;
constexpr int KVL = CTXL + SEQ;
constexpr int NHEAD = 4, QKW = 512;
constexpr int HYW = 512, HYC = 1536, INC = 3072, QKVC = 1536;
constexpr int NEXP = 32, TOPK = 4, NMOD = 6;
constexpr float EPS = 1e-6f;
constexpr float LAM_INIT = 0.2f;
constexpr float QSCALE = 0.125f * 1.4426950408889634f;

constexpr size_t MiB = 1u << 20;
constexpr size_t WS_CTL = 0, CTL_ZERO_BYTES = 1 * MiB;
constexpr size_t WS_SMALL = 1 * MiB;
constexpr size_t WS_WIN = 2 * MiB;
constexpr size_t WS_WOUT = 8 * MiB;
constexpr size_t WS_W1 = 10 * MiB;
constexpr size_t WS_W2 = 138 * MiB;
constexpr size_t WS_H = 202 * MiB;
constexpr size_t WS_Q = 270 * MiB;
constexpr size_t WS_K = 302 * MiB;
constexpr size_t WS_V = 336 * MiB;
constexpr size_t WS_UT = 370 * MiB;
constexpr size_t WS_FILT = 466 * MiB;
constexpr size_t WS_Z2T = 498 * MiB;
constexpr size_t WS_MIX = 530 * MiB;
constexpr size_t WS_ROUTE = 594 * MiB;
constexpr size_t WS_ACT = 270 * MiB;
constexpr size_t WS_EO = 598 * MiB;
constexpr size_t WS_XN = 870 * MiB;
constexpr size_t WS_END = 998 * MiB;
constexpr size_t SM_MOD = 0;
constexpr size_t SM_SCAL = 256 * 1024;
constexpr size_t SM_ROPE = 260 * 1024;
constexpr int CW_BAR = 4096;

constexpr int RING_BYTES = 131072;
constexpr int LDSCTL_OFF = 151552;
constexpr int LDS_BYTES = 152576;
constexpr int NWAVES = 8;

#define LDS_WAIT() asm volatile("s_waitcnt lgkmcnt(0)" ::: "memory")
#define VM_WAIT() asm volatile("s_waitcnt vmcnt(0)" ::: "memory")
#define RLX_AGENT __ATOMIC_RELAXED, __HIP_MEMORY_SCOPE_AGENT

__device__ __forceinline__ unsigned cvt_pk_bf16(float lo, float hi) { unsigned r; asm volatile("v_cvt_pk_bf16_f32 %0, %1, %2" : "=v"(r) : "v"(lo), "v"(hi)); return r; }
__device__ __forceinline__ float bf2f(bf16_t v) { return __uint_as_float(((unsigned)v) << 16); }
__device__ __forceinline__ float wave_sum(float v) {
#pragma unroll
    for (int o = 1; o < 64; o <<= 1) v += __shfl_xor(v, o);
    return v;
}

#define XB_TMO      128
#define XB_XCNT(j)  (256  + 64 * (j))
#define XB_XSUB(j)  (1280 + 64 * (j))
#define XB_XGEN(j)  (2304 + 64 * (j))
#define XB_TOP      3328
#define XB_TOPGEN   3392
#define XCD_BAR_WORDS 3456
#define XB_SPIN_CAP (1u << 22)
__device__ __forceinline__ unsigned xb_ld(unsigned* p)              { return __hip_atomic_load(p, __ATOMIC_RELAXED, __HIP_MEMORY_SCOPE_AGENT); }
__device__ __forceinline__ unsigned xb_add(unsigned* p, unsigned v) { return __hip_atomic_fetch_add(p, v, __ATOMIC_RELAXED, __HIP_MEMORY_SCOPE_AGENT); }
__device__ __forceinline__ unsigned xb_xcc_id() { return (unsigned)__builtin_amdgcn_s_getreg((3 << 11) | 20) & 0xFu; }
#define XB_SPIN(cond, bar) do { unsigned _sp = 0; while (cond) { __builtin_amdgcn_s_sleep(1); \
    if ((++_sp & 255u) == 0u) { if (xb_ld(&(bar)[XB_TMO])) break; if (_sp > XB_SPIN_CAP) { atomicAdd(&(bar)[XB_TMO], 1u); break; } } } } while (0)
struct XcdBarrier { unsigned* bar; unsigned x; volatile LAS unsigned* st; };
__device__ __forceinline__ XcdBarrier xcd_barrier_post(unsigned* bar, volatile LAS unsigned* st, bool leader) {
    XcdBarrier b; b.bar = bar; b.x = xb_xcc_id(); b.st = st;
    if (leader) (void)xb_add(&bar[XB_XCNT(b.x)], 1u);
    return b;
}
__device__ __forceinline__ void xcd_barrier_complete(unsigned* bar, unsigned x, unsigned& nloc, unsigned& nx) {
    const unsigned G = gridDim.x * gridDim.y * gridDim.z;
    unsigned sum, cnt, mine, sp = 0u;
    for (;;) {
        sum = 0u; cnt = 0u; mine = 0u;
#pragma unroll
        for (unsigned j = 0; j < 16; ++j) { const unsigned c = xb_ld(&bar[XB_XCNT(j)]); sum += c; cnt += (c > 0u) ? 1u : 0u; mine = (j == x) ? c : mine; }
        if (sum == G) break;
        __builtin_amdgcn_s_sleep(1);
        if ((++sp & 255u) == 0u) { if (xb_ld(&bar[XB_TMO])) break; if (sp > XB_SPIN_CAP) { atomicAdd(&bar[XB_TMO], 1u); break; } }
    }
    nloc = mine > 0u ? mine : 1u; nx = cnt > 0u ? cnt : 1u;
}
__device__ __forceinline__ void xcd_barrier(const XcdBarrier& b, bool leader) {
    asm volatile("s_waitcnt vmcnt(0)" ::: "memory");
    __syncthreads();
    if (leader) {
        unsigned* bar = b.bar;
        __builtin_amdgcn_s_waitcnt(0);
        unsigned nloc = b.st[0], nx = b.st[1];
        if (nloc == 0u) { xcd_barrier_complete(bar, b.x, nloc, nx); b.st[0] = nloc; b.st[1] = nx; }
        const unsigned old = xb_add(&bar[XB_XSUB(b.x)], 1u);
        const unsigned gen = old / nloc;
        if (old + 1u == (gen + 1u) * nloc) {
            __builtin_amdgcn_fence(__ATOMIC_RELEASE, "agent");
            asm volatile("s_waitcnt vmcnt(0)" ::: "memory");
            const unsigned og = xb_add(&bar[XB_TOP], 1u);
            const unsigned tg = og / nx;
            if (og + 1u == (tg + 1u) * nx) xb_add(&bar[XB_TOPGEN], 1u);
            else XB_SPIN(xb_ld(&bar[XB_TOPGEN]) == tg, bar);
            __builtin_amdgcn_fence(__ATOMIC_ACQUIRE, "agent");
            xb_add(&bar[XB_XGEN(b.x)], 1u);
            asm volatile("s_waitcnt vmcnt(0)" ::: "memory");
        } else {
            XB_SPIN(xb_ld(&bar[XB_XGEN(b.x)]) == gen, bar);
            __builtin_amdgcn_fence(__ATOMIC_ACQUIRE, "agent");
            asm volatile("s_waitcnt vmcnt(0)" ::: "memory");
        }
    }
    __syncthreads();
}

namespace g8 {
constexpr int BM = 256, BK = 64, HALF = 128, HTB = HALF * BK * 2, STAGE_BYTES = 8 * HTB, NXCD = 8, WGM = 8;
__host__ __device__ __forceinline__ int lds_byte(int r, int c) { const int st = (r >> 4) * 2 + (c >> 5), rr = r & 15, cc = c & 31, ob = rr * 64 + cc * 2; return st * 1024 + (ob ^ (((ob >> 9) & 1) << 5)); }
__host__ __device__ __forceinline__ void stage_rc(int b, int& R, int& C) { const int st = b / 1024, sb = b % 1024, swz = sb ^ (((sb >> 9) & 1) << 5); R = (st >> 1) * 16 + swz / 64; C = (st & 1) * 32 + (swz % 64) / 2; }
__host__ __device__ __forceinline__ int perm32(int rho) { const int n = rho >> 4, i = rho & 15; return 8 * (i >> 2) + 4 * n + (i & 3); }

struct Unit { const char* a; const char* b; int pm, pn, kind, ex; };

__device__ __forceinline__ void tile_of(int L, int nM, int nN, int& pm, int& pn) {
    const int nwg = nM * nN; int wgid = L;
    { const int q = nwg / NXCD, r = nwg % NXCD, xcd = wgid % NXCD, off = wgid / NXCD; wgid = (xcd < r ? xcd * (q + 1) : r * (q + 1) + (xcd - r) * q) + off; }
    const int nig = WGM * nN, gid = wgid / nig, fm = gid * WGM, gsz = (nM - fm) < WGM ? (nM - fm) : WGM;
    pm = fm + ((wgid % nig) % gsz); pn = (wgid % nig) / gsz;
}

typedef int i32x8 __attribute__((ext_vector_type(8)));
template <bool FP8, class Epi, class Sched>
__device__ __forceinline__ void gemm_phase(LAS unsigned char* lds, const int K, const Sched& S, const Epi& E, const int wid, const int lane) {
    const int tid = wid * 64 + lane, wr = wid >> 2, wc = wid & 3, fr = lane & 15, fq = lane >> 4;
    const int nt = FP8 ? K / 128 : K / BK;
    const int RP = FP8 ? K : 2 * K;
    unsigned voffA[2], voffB[2];
#pragma unroll
    for (int i = 0; i < 2; ++i) { int R, C; stage_rc(tid * 16 + i * 8192, R, C); const int Rb = (R & ~31) + perm32(R & 31);
        voffA[i] = (unsigned)(R * RP + C * 2); voffB[i] = (unsigned)(Rb * RP + C * 2); }
    const size_t kstep = (size_t)(BK * 2);
    const size_t hstep = (size_t)HALF * RP;
    const unsigned ldsw = (unsigned)wid * 1024u;
    const int aoff = lds_byte(wr * 64 + fr, FP8 ? fq * 16 : fq * 8), boff = lds_byte(wc * 32 + fr, FP8 ? fq * 16 : fq * 8);
    constexpr int KOFF = FP8 ? 16 : 1024;
#define PG8_SA(b, h) (((b) * 2 + (h)) * HTB)
#define PG8_SB(b, h) ((4 + (b) * 2 + (h)) * HTB)
#define PG8_STAGE(bufoff, gbase, voff) do { _Pragma("unroll") for (int _i = 0; _i < 2; ++_i) \
        __builtin_amdgcn_global_load_lds((const unsigned*)((const char*)(gbase) + (voff)[_i]), (LAS unsigned*)(lds + (bufoff) + ldsw + _i * 8192), 16, 0, 0); } while (0)
#define PG8_LD32(p) __builtin_bit_cast(i32x8, __builtin_shufflevector(*(const LAS u32x4*)(p), *(const LAS u32x4*)((p) + 16), 0, 1, 2, 3, 4, 5, 6, 7))
#define PG8_LDA8(dst, b, h) do { _Pragma("unroll") for (int m = 0; m < 4; ++m) dst[m] = PG8_LD32(lds + PG8_SA(b, h) + aoff + m * 2048); } while (0)
#define PG8_LDB8(dst, b, h) do { _Pragma("unroll") for (int n = 0; n < 2; ++n) dst[n] = PG8_LD32(lds + PG8_SB(b, h) + boff + n * 2048); } while (0)
#define PG8_LDA(dst, b, h) do { _Pragma("unroll") for (int m = 0; m < 4; ++m) _Pragma("unroll") for (int k = 0; k < 2; ++k) dst[m][k] = *(const LAS bf16x8*)(lds + PG8_SA(b, h) + aoff + m * 2048 + k * KOFF); } while (0)
#define PG8_LDB(dst, b, h) do { _Pragma("unroll") for (int n = 0; n < 2; ++n) _Pragma("unroll") for (int k = 0; k < 2; ++k) dst[n][k] = *(const LAS bf16x8*)(lds + PG8_SB(b, h) + boff + n * 2048 + k * KOFF); } while (0)
#define PG8_MMA(ai, bj, At, Bt) do { __builtin_amdgcn_s_setprio(1); _Pragma("unroll") for (int m = 0; m < 4; ++m) _Pragma("unroll") for (int n = 0; n < 2; ++n) _Pragma("unroll") for (int k = 0; k < 2; ++k) \
        acc[ai][bj][m][n] = __builtin_amdgcn_mfma_f32_16x16x32_bf16(Bt[n][k], At[m][k], acc[ai][bj][m][n], 0, 0, 0); __builtin_amdgcn_s_setprio(0); } while (0)
#define PG8_MMA8(ai, bj, At, Bt) do { __builtin_amdgcn_s_setprio(1); _Pragma("unroll") for (int m = 0; m < 4; ++m) _Pragma("unroll") for (int n = 0; n < 2; ++n) \
        asm volatile("v_mfma_scale_f32_16x16x128_f8f6f4 %0, %1, %2, %0, %3, %3 op_sel_hi:[0,0,0]" : "+v"(acc[ai][bj][m][n]) : "v"(Bt[n]), "v"(At[m]), "v"(one_scale)); __builtin_amdgcn_s_setprio(0); } while (0)
#define PG8_WAIT_V(n) asm volatile("s_waitcnt vmcnt(" #n ")" ::: "memory")
#define PG8_WAIT_L(n) asm volatile("s_waitcnt lgkmcnt(" #n ")" ::: "memory")
#define PG8_BAR __builtin_amdgcn_s_barrier()
#define PG8_SCHED __builtin_amdgcn_sched_barrier(0)
    Unit cur, nxt; int ui = 0;
    if (!S.next(0, cur)) return;
    f32x4 acc[2][2][4][2];
#pragma unroll
    for (int a = 0; a < 2; ++a)
#pragma unroll
        for (int b = 0; b < 2; ++b)
#pragma unroll
            for (int m = 0; m < 4; ++m)
#pragma unroll
                for (int n = 0; n < 2; ++n) acc[a][b][m][n] = (f32x4){0.f, 0.f, 0.f, 0.f};
    bf16x8 At[4][2], B0[2][2], B1[2][2];
    i32x8 At8[4], B08[2], B18[2];
    const unsigned one_scale = 0x7f7f7f7fu;
    const char* cA = cur.a; const char* cB = cur.b;
    PG8_STAGE(PG8_SB(0, 0), cB, voffB); PG8_STAGE(PG8_SB(0, 1), cB + hstep, voffB); PG8_STAGE(PG8_SA(0, 0), cA, voffA); PG8_STAGE(PG8_SA(0, 1), cA + hstep, voffA);
    if (wr == 1) PG8_BAR;
    PG8_WAIT_V(2); PG8_BAR;
    PG8_STAGE(PG8_SB(1, 0), cB + kstep, voffB); PG8_STAGE(PG8_SA(1, 0), cA + kstep, voffA); PG8_STAGE(PG8_SB(1, 1), cB + hstep + kstep, voffB);
    PG8_WAIT_V(6); PG8_BAR;
    for (;;) {
        const bool has_next = S.next(ui + 1, nxt);
        const char* nA = has_next ? nxt.a : cA; const char* nB = has_next ? nxt.b : cB;
#pragma unroll 1
        for (int t = 0; t < nt; t += 2) {
            const bool last = (t == nt - 2);
            const char* a1 = cA + (size_t)(t + 1) * kstep;
            const char* a2 = last ? nA : cA + (size_t)(t + 2) * kstep; const char* b2 = last ? nB : cB + (size_t)(t + 2) * kstep;
            const char* a3 = a2 + kstep; const char* b3 = b2 + kstep;
            if constexpr (FP8) {
            PG8_LDB8(B08, 0, 0); PG8_LDB8(B18, 0, 1); PG8_SCHED; PG8_LDA8(At8, 0, 0); PG8_STAGE(PG8_SA(1, 1), a1 + hstep, voffA);
            PG8_WAIT_V(8); PG8_WAIT_L(0); PG8_BAR; PG8_MMA8(0, 0, At8, B08); PG8_MMA8(0, 1, At8, B18); PG8_BAR; PG8_SCHED;
            PG8_LDA8(At8, 0, 1); PG8_STAGE(PG8_SB(0, 0), b2, voffB); PG8_STAGE(PG8_SB(0, 1), b2 + hstep, voffB); PG8_STAGE(PG8_SA(0, 0), a2, voffA);
            PG8_WAIT_V(8); PG8_WAIT_L(0); PG8_BAR; PG8_MMA8(1, 0, At8, B08); PG8_MMA8(1, 1, At8, B18); PG8_BAR; PG8_SCHED;
            PG8_LDB8(B08, 1, 0); PG8_LDB8(B18, 1, 1); PG8_SCHED; PG8_LDA8(At8, 1, 0); PG8_STAGE(PG8_SA(0, 1), a2 + hstep, voffA);
            PG8_WAIT_V(8); PG8_WAIT_L(0); PG8_BAR; PG8_MMA8(0, 0, At8, B08); PG8_MMA8(0, 1, At8, B18); PG8_BAR; PG8_SCHED;
            PG8_LDA8(At8, 1, 1); PG8_STAGE(PG8_SB(1, 0), b3, voffB); PG8_STAGE(PG8_SB(1, 1), b3 + hstep, voffB); PG8_STAGE(PG8_SA(1, 0), a3, voffA);
            PG8_WAIT_V(8); PG8_WAIT_L(0); PG8_BAR; PG8_MMA8(1, 0, At8, B08); PG8_MMA8(1, 1, At8, B18); PG8_BAR; PG8_SCHED;
            } else {
            PG8_LDB(B0, 0, 0); PG8_LDB(B1, 0, 1); PG8_SCHED; PG8_LDA(At, 0, 0); PG8_STAGE(PG8_SA(1, 1), a1 + hstep, voffA);
            PG8_WAIT_V(8); PG8_WAIT_L(0); PG8_BAR; PG8_MMA(0, 0, At, B0); PG8_MMA(0, 1, At, B1); PG8_BAR; PG8_SCHED;
            PG8_LDA(At, 0, 1); PG8_STAGE(PG8_SB(0, 0), b2, voffB); PG8_STAGE(PG8_SB(0, 1), b2 + hstep, voffB); PG8_STAGE(PG8_SA(0, 0), a2, voffA);
            PG8_WAIT_V(8); PG8_WAIT_L(0); PG8_BAR; PG8_MMA(1, 0, At, B0); PG8_MMA(1, 1, At, B1); PG8_BAR; PG8_SCHED;
            PG8_LDB(B0, 1, 0); PG8_LDB(B1, 1, 1); PG8_SCHED; PG8_LDA(At, 1, 0); PG8_STAGE(PG8_SA(0, 1), a2 + hstep, voffA);
            PG8_WAIT_V(8); PG8_WAIT_L(0); PG8_BAR; PG8_MMA(0, 0, At, B0); PG8_MMA(0, 1, At, B1); PG8_BAR; PG8_SCHED;
            PG8_LDA(At, 1, 1); PG8_STAGE(PG8_SB(1, 0), b3, voffB); PG8_STAGE(PG8_SB(1, 1), b3 + hstep, voffB); PG8_STAGE(PG8_SA(1, 0), a3, voffA);
            PG8_WAIT_V(8); PG8_WAIT_L(0); PG8_BAR; PG8_MMA(1, 0, At, B0); PG8_MMA(1, 1, At, B1); PG8_BAR; PG8_SCHED;
            }
        }
        if (wr == 0) PG8_BAR;
        if constexpr (FP8) asm volatile("s_nop 15\n\ts_nop 15" ::: "memory");
        E(acc, cur, wr, wc, fr, fq);
        if (!has_next) break;
#pragma unroll
        for (int a = 0; a < 2; ++a)
#pragma unroll
            for (int b = 0; b < 2; ++b)
#pragma unroll
                for (int m = 0; m < 4; ++m)
#pragma unroll
                    for (int n = 0; n < 2; ++n) acc[a][b][m][n] = (f32x4){0.f, 0.f, 0.f, 0.f};
        cur = nxt; cA = nA; cB = nB; ++ui;
        if (wr == 1) PG8_BAR;
    }
    PG8_WAIT_V(0);
    PG8_BAR;
#undef PG8_SA
#undef PG8_SB
#undef PG8_STAGE
#undef PG8_LDA
#undef PG8_LDB
#undef PG8_MMA
#undef PG8_MMA8
#undef PG8_LDA8
#undef PG8_LDB8
#undef PG8_LD32
#undef PG8_WAIT_V
#undef PG8_WAIT_L
#undef PG8_BAR
#undef PG8_SCHED
}
}

__device__ __forceinline__ int lane_id() { int l; asm volatile("v_mbcnt_lo_u32_b32 %0, -1, 0\n\tv_mbcnt_hi_u32_b32 %0, -1, %0" : "=v"(l)); return l; }
#define FT_DECL const int f_lane = lane_id(), f_tid = F.wave * 64 + f_lane; (void)f_tid; (void)f_lane
typedef const float* cfp_t;
typedef __attribute__((address_space(4))) cfp_t* kin_t;
struct Frame {
    LAS unsigned char* lds;
    volatile LAS unsigned* MISC;
    gu32* ctl;
    int wave, vcu, G;
    kin_t in;
    float* out;
    unsigned char* ws;
};
#define WSP(T, off) ((T*)(F.ws + (off)))

template <class RowMap>
__device__ __forceinline__ void p0_transpose_item(const float* W, int K, int N, bf16_t* WT, const RowMap& rowmap, const float* kscale, LAS float* scr, int item, int lane) {
    const int nblk = N / 32, kb = item / nblk, nb = item % nblk, k0 = 64 * kb, n0 = 32 * nb;
#pragma unroll 8
    for (int i = 0; i < 32; ++i) { const int kk = 2 * i + (lane >> 5); float v = W[(size_t)(k0 + kk) * N + n0 + (lane & 31)]; if (kscale) v *= kscale[k0 + kk]; scr[kk * 33 + (lane & 31)] = v; }
    LDS_WAIT(); asm volatile("" ::: "memory");
    const int c = lane & 7;
#pragma unroll
    for (int j = 0; j < 4; ++j) { const int n = (lane >> 3) + 8 * j; const LAS float* s = scr + (8 * c) * 33 + n;
        u32x4 o; o.x = cvt_pk_bf16(s[0 * 33], s[1 * 33]); o.y = cvt_pk_bf16(s[2 * 33], s[3 * 33]); o.z = cvt_pk_bf16(s[4 * 33], s[5 * 33]); o.w = cvt_pk_bf16(s[6 * 33], s[7 * 33]);
        *(GAS u32x4*)(WT + (size_t)rowmap(n0 + n) * K + k0 + 8 * c) = o; }
    LDS_WAIT(); asm volatile("" ::: "memory");
}

__device__ __forceinline__ unsigned pk4_fp8(float a, float b, float c, float d) { int r = __builtin_amdgcn_cvt_pk_fp8_f32(a, b, 0, false); r = __builtin_amdgcn_cvt_pk_fp8_f32(c, d, r, true); return (unsigned)r; }
constexpr float WSCALE = 32.f;
template <class RowMap>
__device__ __forceinline__ void p0_transpose_item_f8(const float* W, int K, int N, unsigned char* WT, const RowMap& rowmap, LAS float* scr, int item, int lane) {
    const int nblk = N / 32, kb = item / nblk, nb = item % nblk, k0 = 128 * kb, n0 = 32 * nb;
#pragma unroll 8
    for (int i = 0; i < 64; ++i) { const int kk = 2 * i + (lane >> 5); scr[kk * 33 + (lane & 31)] = W[(size_t)(k0 + kk) * N + n0 + (lane & 31)] * WSCALE; }
    LDS_WAIT(); asm volatile("" ::: "memory");
    const int c = lane & 7;
#pragma unroll
    for (int j = 0; j < 4; ++j) { const int n = (lane >> 3) + 8 * j; const LAS float* sp = scr + (16 * c) * 33 + n;
        u32x4 o; o.x = pk4_fp8(sp[0 * 33], sp[1 * 33], sp[2 * 33], sp[3 * 33]); o.y = pk4_fp8(sp[4 * 33], sp[5 * 33], sp[6 * 33], sp[7 * 33]);
        o.z = pk4_fp8(sp[8 * 33], sp[9 * 33], sp[10 * 33], sp[11 * 33]); o.w = pk4_fp8(sp[12 * 33], sp[13 * 33], sp[14 * 33], sp[15 * 33]);
        *(GAS u32x4*)(WT + (size_t)rowmap(n0 + n) * K + k0 + 16 * c) = o; }
    LDS_WAIT(); asm volatile("" ::: "memory");
}
struct MapIdent { int off; __device__ __forceinline__ int operator()(int n) const { return off + n; } };
struct MapWin { __device__ __forceinline__ int operator()(int l) const {
    if (l >= QKVC) return l;
    const int t = l & ~255, r = l & 255, wc = r >> 6, blk = (r >> 5) & 1, bj = (r >> 4) & 1, low = r & 15;
    return t + 128 * bj + 32 * wc + 16 * blk + low; } };
struct MapW1 { int off; __device__ __forceinline__ int operator()(int jp) const { const int bj = jp >> 10, j = jp & 1023; return off + 256 * (j >> 7) + 128 * bj + (j & 127); } };


__device__ __forceinline__ void p0_filter_item(Frame& F, int item) {
    FT_DECL;
#define in F.in
    LAS float* h1s = (LAS float*)(F.lds);
    LAS float* h2s = (LAS float*)(F.lds + 4096);
    const int t0 = item * 16;
    {
        const int tt = f_tid >> 5, hh = (f_tid & 31) * 2; const float pos = (float)(t0 + tt);
        float feats[17]; feats[0] = pos * (1.f / SEQ);
#pragma unroll
        for (int i = 0; i < 8; ++i) { const float band = 1e-4f + (float)i * ((7.f - 1e-4f) / 7.f); const float ang = (6.283185307179586f / SEQ) * pos * band; feats[1 + i] = sinf(ang); feats[9 + i] = cosf(ang); }
#pragma unroll
        for (int u = 0; u < 2; ++u) { const int h = hh + u; float a = in[19][h];
#pragma unroll
            for (int k = 0; k < 17; ++k) a += feats[k] * in[18][k * 64 + h];
            h1s[tt * 64 + h] = sinf(in[20][h] * a); }
        __syncthreads();
#pragma unroll
        for (int u = 0; u < 2; ++u) { const int h = hh + u; float a = in[22][h];
#pragma unroll 8
            for (int k = 0; k < 64; ++k) a += h1s[tt * 64 + k] * in[21][k * 64 + h];
            h2s[tt * 64 + h] = sinf(in[23][h] * a); }
        __syncthreads();
    }
    f32x4 acc[16];
#pragma unroll
    for (int t = 0; t < 16; ++t) acc[t] = (f32x4){0.f, 0.f, 0.f, 0.f};
    const int o = 4 * f_tid;
    for (int k = 0; k < 64; ++k) { const f32x4 w = *(const f32x4*)(in[24] + (size_t)k * 2048 + o);
#pragma unroll
        for (int t = 0; t < 16; ++t) acc[t] += w * h2s[t * 64 + k]; }
    const int c0 = o & 511, od = o >> 9;
    float* dst = WSP(float, WS_FILT) + ((size_t)od * 512 + c0) * SEQ + t0;
#pragma unroll
    for (int e = 0; e < 4; ++e) { const float la = -3.0701134573253944f, lb = -15.350567286626972f; const float delta = fabsf(la + (float)(c0 + e) * ((lb - la) / 511.f));
#pragma unroll
        for (int q = 0; q < 4; ++q) { f32x4 v;
#pragma unroll
            for (int i = 0; i < 4; ++i) { const int t = 4 * q + i; const float tn = (float)(t0 + t) * (1.f / SEQ); v[i] = acc[t][e] * expf(-tn * delta); }
            *(f32x4*)(dst + (size_t)e * SEQ + 4 * q) = v; } }
    __syncthreads();
#undef in
}

__device__ __forceinline__ float silu_f(float v) { return v / (1.f + __expf(-v)); }

__device__ __forceinline__ void p0_prologue(Frame& F) {
    FT_DECL;
#define in F.in
    const int wg = blockIdx.x;
    if (wg < 96) {
        LAS float* sv = (LAS float*)F.lds;
        for (int i = f_tid; i < 9 * 1024; i += 512) { const int r = i >> 10, k = i & 1023; const float c = (r < 8) ? in[1][r * 1024 + k] : in[3][k]; sv[i] = silu_f(c); }
        __syncthreads();
        const int j = wg * 64 + f_lane; const float* wm = in[4];
        float acc[9];
#pragma unroll
        for (int r = 0; r < 9; ++r) acc[r] = 0.f;
        const int kbeg = F.wave * 128;
#pragma unroll 4
        for (int k = kbeg; k < kbeg + 128; ++k) { const float w = wm[(size_t)k * (NMOD * DM) + j];
#pragma unroll
            for (int r = 0; r < 9; ++r) acc[r] += sv[r * 1024 + k] * w; }
        LAS float* red = (LAS float*)(F.lds + 40960);
#pragma unroll
        for (int r = 0; r < 9; ++r) red[(F.wave * 9 + r) * 64 + f_lane] = acc[r];
        __syncthreads();
        for (int i = f_tid; i < 9 * 64; i += 512) { const int r = i >> 6, l = i & 63; float s = in[5][wg * 64 + l];
#pragma unroll
            for (int w = 0; w < 8; ++w) s += red[(w * 9 + r) * 64 + l];
            WSP(float, WS_SMALL + SM_MOD)[r * (NMOD * DM) + wg * 64 + l] = s; }
        __syncthreads();
    } else if (wg == 96) {
        if (F.wave == 0) {
            const float a = wave_sum(in[11][f_lane] * in[12][f_lane]), b = wave_sum(in[13][f_lane] * in[14][f_lane]);
            float gq = fabsf(in[9][f_lane]), gk = fabsf(in[10][f_lane]);
#pragma unroll
            for (int o = 1; o < 64; o <<= 1) { gq = fmaxf(gq, __shfl_xor(gq, o)); gk = fmaxf(gk, __shfl_xor(gk, o)); }
            if (f_lane == 0) { float* sc = WSP(float, WS_SMALL + SM_SCAL); sc[0] = expf(a) - expf(b) + LAM_INIT;
                sc[1] = (8.f * gq * gk * 1.02f + 0.05f) * 1.4426950408889634f; }
        }
        for (int i = f_tid; i < 64 * 16; i += 512) { const int pos = i >> 4, f = i & 15;
            const float inv = powf(10000.f, -(float)f / 16.f); const float ang = (float)pos * inv;
            float* rt = WSP(float, WS_SMALL + SM_ROPE); rt[2 * i] = cosf(ang); rt[2 * i + 1] = sinf(ang); }
    }
    __syncthreads();
    for (int it = wg; it < SEQ / 16; it += F.G) p0_filter_item(F, it);
    __syncthreads();
    {
        LAS float* scr = (LAS float*)(F.lds + F.wave * 16896);
        const int gw = F.vcu * NWAVES + F.wave, NGW = F.G * NWAVES;
        constexpr int I_IN = (DM / 64) * (INC / 32), I_OUT = (DM / 64) * (DM / 32), I_1 = (DM / 128) * (2 * DM / 32), I_2 = (DM / 128) * (DM / 32);
        constexpr int NITEMS = I_IN + I_OUT + NEXP * (I_1 + I_2);
        for (int it = gw; it < NITEMS; it += NGW) {
            int r = it;
            if (r < I_IN) { p0_transpose_item(in[8], DM, INC, WSP(bf16_t, WS_WIN), MapWin{}, nullptr, scr, r, f_lane); continue; } r -= I_IN;
            if (r < I_OUT) { p0_transpose_item(in[27], DM, DM, WSP(bf16_t, WS_WOUT), MapIdent{0}, nullptr, scr, r, f_lane); continue; } r -= I_OUT;
            const int e = r / (I_1 + I_2); r -= e * (I_1 + I_2);
            if (r < I_1) p0_transpose_item_f8(in[30] + (size_t)e * DM * 2 * DM, DM, 2 * DM, WSP(unsigned char, WS_W1) + (size_t)e * 2 * DM * DM, MapW1{0}, scr, r, f_lane);
            else p0_transpose_item_f8(in[32] + (size_t)e * DM * DM, DM, DM, WSP(unsigned char, WS_W2) + (size_t)e * DM * DM, MapIdent{0}, scr, r - I_1, f_lane);
        }
    }
}
#undef in

__device__ __forceinline__ void p1_norm1(Frame& F) {
    FT_DECL;
    const int gw = F.vcu * NWAVES + F.wave, NGW = F.G * NWAVES;
    const float* mod = WSP(float, WS_SMALL + SM_MOD); const float* g1 = F.in[6];
    bf16_t* H = WSP(bf16_t, WS_H);
    for (int m = gw; m < MTOT; m += NGW) {
        const float* xrow = (m < MROWS) ? F.in[0] + (size_t)m * DM : F.in[2] + (size_t)(m - MROWS) * DM;
        const int mb = (m < MROWS) ? (m >> 12) : 8;
        const float* sh = mod + (size_t)mb * (NMOD * DM); const float* sc = sh + DM;
        const GAS f32x4* xr = (const GAS f32x4*)xrow + f_lane;
        f32x4 v[4]; float s = 0.f;
#pragma unroll
        for (int j = 0; j < 4; ++j) { v[j] = xr[64 * j]; s += (v[j].x * v[j].x + v[j].y * v[j].y) + (v[j].z * v[j].z + v[j].w * v[j].w); }
        const float rstd = rsqrtf(wave_sum(s) * (1.f / DM) + EPS);
        GAS u32x2* o8 = (GAS u32x2*)(H + (size_t)m * DM) + f_lane;
#pragma unroll
        for (int j = 0; j < 4; ++j) { const int c = 4 * f_lane + 256 * j;
            const f32x4 g = *(const f32x4*)(g1 + c), a = *(const f32x4*)(sc + c), b = *(const f32x4*)(sh + c);
            const f32x4 y = v[j] * rstd * g * (a + 1.f) + b;
            u32x2 w; w.x = cvt_pk_bf16(y.x, y.y); w.y = cvt_pk_bf16(y.z, y.w); o8[64 * j] = w; }
    }
}

struct SchedInProj {
    int G, c; const char* H; const char* W;
    static constexpr int NA = 136 * 6, NBU = 6 * 128;
    __device__ __forceinline__ bool next(int i, g8::Unit& u) const {
        const long L = (long)i * G + c;
        if (L < NA) { g8::tile_of((int)L, 136, 6, u.pm, u.pn); u.a = H + (size_t)u.pm * 256 * DM * 2; u.b = W + (size_t)u.pn * 256 * DM * 2; u.kind = 0; u.ex = 0; return true; }
        if (L < NA + NBU) { g8::tile_of((int)L - NA, 6, 128, u.pm, u.pn); u.a = W + (size_t)(QKVC + u.pm * 256) * DM * 2; u.b = H + (size_t)u.pn * 256 * DM * 2; u.kind = 1; u.ex = 0; return true; }
        return false;
    }
};
struct EpiInProj {
    bf16_t *Q, *Kb, *Vb, *UT; const float *gq, *gk, *rope;
    __device__ __forceinline__ void operator()(f32x4 (&acc)[2][2][4][2], const g8::Unit& u, int wr, int wc, int fr, int fq) const {
        if (u.kind == 1) {
            const int row0 = u.pm * 256 + wr * 64 + fr, col0 = u.pn * 256 + wc * 32 + 8 * fq;
#pragma unroll
            for (int ai = 0; ai < 2; ++ai)
#pragma unroll
                for (int m = 0; m < 4; ++m) { bf16_t* rowp = UT + (size_t)(row0 + ai * 128 + m * 16) * MROWS + col0;
#pragma unroll
                    for (int bj = 0; bj < 2; ++bj) { const f32x4 v0 = acc[ai][bj][m][0], v1 = acc[ai][bj][m][1];
                        u32x4 w; w.x = cvt_pk_bf16(v0[0], v0[1]); w.y = cvt_pk_bf16(v0[2], v0[3]); w.z = cvt_pk_bf16(v1[0], v1[1]); w.w = cvt_pk_bf16(v1[2], v1[3]);
                        *(u32x4*)(rowp + bj * 128) = w; } }
            return;
        }
        const int blk = fq >> 1, f = fq & 1;
        const int sec = u.pn >> 1;
        const bool ctx = (u.pm >= 128);
        if (sec == 0 && ctx) return;
        const int colbase = (u.pn & 1) * 256 + wc * 64 + 32 * blk + 8 * f;
        float gg[2][2][4];
        if (sec < 2) { const float* gp = (sec == 0 ? gq : gk) + 32 * blk + 8 * f;
#pragma unroll
            for (int bj = 0; bj < 2; ++bj)
#pragma unroll
                for (int n = 0; n < 2; ++n) { const f32x4 t = *(const f32x4*)(gp + 16 * bj + 4 * n); gg[bj][n][0] = t[0]; gg[bj][n][1] = t[1]; gg[bj][n][2] = t[2]; gg[bj][n][3] = t[3]; } }
#pragma unroll
        for (int ai = 0; ai < 2; ++ai)
#pragma unroll
            for (int m = 0; m < 4; ++m) {
                const int rloc = ai * 128 + wr * 64 + m * 16 + fr; const int r = u.pm * 256 + rloc;
                f32x4 v[2][2];
#pragma unroll
                for (int bj = 0; bj < 2; ++bj)
#pragma unroll
                    for (int n = 0; n < 2; ++n) v[bj][n] = acc[ai][bj][m][n];
                size_t orow;
                if (sec == 0) orow = (size_t)r;
                else if (!ctx) orow = (size_t)(r >> 12) * KVL + CTXL + (r & 4095);
                else { const int j = r - MROWS; orow = (size_t)(j >> 8) * KVL + (j & 255); }
                if (sec < 2) {
                    float ss = 0.f;
#pragma unroll
                    for (int bj = 0; bj < 2; ++bj)
#pragma unroll
                        for (int n = 0; n < 2; ++n) ss += (v[bj][n][0] * v[bj][n][0] + v[bj][n][1] * v[bj][n][1]) + (v[bj][n][2] * v[bj][n][2] + v[bj][n][3] * v[bj][n][3]);
                    ss += __shfl_xor(ss, 16); ss += __shfl_xor(ss, 32);
                    const float rstd = rsqrtf(ss * (1.f / 64.f) + EPS);
#pragma unroll
                    for (int bj = 0; bj < 2; ++bj)
#pragma unroll
                        for (int n = 0; n < 2; ++n)
#pragma unroll
                            for (int e = 0; e < 4; ++e) v[bj][n][e] *= rstd * gg[bj][n][e];
                    if (!ctx) {
                        const int t = r & 4095; const int pos = blk ? (t & 63) : (t >> 6);
                        const float* rp = rope + (size_t)(pos * 16 + 8 * f) * 2;
#pragma unroll
                        for (int n = 0; n < 2; ++n) { const f32x4 c0 = *(const f32x4*)(rp + 8 * n), c1 = *(const f32x4*)(rp + 8 * n + 4);
                            const float cs[4] = {c0[0], c0[2], c1[0], c1[2]}, sn[4] = {c0[1], c0[3], c1[1], c1[3]};
#pragma unroll
                            for (int e = 0; e < 4; ++e) { const float x1 = v[0][n][e], x2 = v[1][n][e]; v[0][n][e] = x1 * cs[e] - x2 * sn[e]; v[1][n][e] = x2 * cs[e] + x1 * sn[e]; } }
                    }
                    if (sec == 0) {
#pragma unroll
                        for (int bj = 0; bj < 2; ++bj)
#pragma unroll
                            for (int n = 0; n < 2; ++n) v[bj][n] *= QSCALE;
                    }
                }
                bf16_t* dst = (sec == 0 ? Q : (sec == 1 ? Kb : Vb)) + orow * QKW + colbase;
#pragma unroll
                for (int bj = 0; bj < 2; ++bj) { u32x4 w; w.x = cvt_pk_bf16(v[bj][0][0], v[bj][0][1]); w.y = cvt_pk_bf16(v[bj][0][2], v[bj][0][3]); w.z = cvt_pk_bf16(v[bj][1][0], v[bj][1][1]); w.w = cvt_pk_bf16(v[bj][1][2], v[bj][1][3]);
                    *(u32x4*)(dst + 16 * bj) = w; }
            }
    }
};

struct SchedStatic {
    int G, c, nM, nN; const char* A; const char* B;
    __device__ __forceinline__ bool next(int i, g8::Unit& u) const {
        const long L = (long)i * G + c; if (L >= (long)nM * nN) return false;
        g8::tile_of((int)L, nM, nN, u.pm, u.pn); u.a = A + (size_t)u.pm * 256 * DM * 2; u.b = B + (size_t)u.pn * 256 * DM * 2; u.kind = 0; u.ex = 0; return true;
    }
};
struct EpiOutProj {
    const float* x; float* out; const float* mod;
    __device__ __forceinline__ void operator()(f32x4 (&acc)[2][2][4][2], const g8::Unit& u, int wr, int wc, int fr, int fq) const {
        const int col0 = u.pn * 256 + wc * 32 + 8 * fq;
#pragma unroll
        for (int ai = 0; ai < 2; ++ai)
#pragma unroll
            for (int m = 0; m < 4; ++m) { const int r = u.pm * 256 + ai * 128 + wr * 64 + m * 16 + fr; const float* g1 = mod + (size_t)(r >> 12) * (NMOD * DM) + 2 * DM;
                const size_t off = (size_t)r * DM + col0;
#pragma unroll
                for (int bj = 0; bj < 2; ++bj)
#pragma unroll
                    for (int n = 0; n < 2; ++n) { const int c = bj * 128 + 4 * n; const f32x4 xv = *(const f32x4*)(x + off + c), gv = *(const f32x4*)(g1 + col0 + c);
                        *(f32x4*)(out + off + c) = xv + gv * acc[ai][bj][m][n]; } }
    }
};

namespace att {
constexpr int KVBLK = 64, LDK = QKW, NT = KVL / KVBLK;
constexpr int SHM_V = KVBLK * 128 * 2, SHM_K = KVBLK * 128 * 2;
#define KSWZ(row, colB) ((row) * 256 + ((colB) ^ (((row) & 7) << 4)))
#define SBAR() __builtin_amdgcn_sched_barrier(0)
__device__ __forceinline__ int crow(int r, int hi) { return (r & 3) + 8 * (r >> 2) + 4 * hi; }
__device__ __forceinline__ void expA(f32x16& p) {
#pragma unroll
    for (int r = 0; r < 16; ++r) p[r] = __builtin_amdgcn_exp2f(p[r]);
}
__device__ __forceinline__ void finishSM(f32x16& p0, f32x16& p1, float& l_reg, bf16x8& pa0, bf16x8& pa1, bf16x8& pa2, bf16x8& pa3) {
#pragma unroll
    for (int r = 0; r < 16; ++r) p1[r] = __builtin_amdgcn_exp2f(p1[r]);
    float ps = 0;
#pragma unroll
    for (int r = 0; r < 16; ++r) ps += p0[r];
#pragma unroll
    for (int r = 0; r < 16; ++r) ps += p1[r];
    { auto rr = __builtin_amdgcn_permlane32_swap(__float_as_uint(ps), __float_as_uint(ps), false, false); ps = __uint_as_float(rr[0]) + __uint_as_float(rr[1]); }
    l_reg += ps;
#define PK4(P, BASE, OUT) do { unsigned a0 = cvt_pk_bf16(P[BASE + 0], P[BASE + 1]), a1 = cvt_pk_bf16(P[BASE + 2], P[BASE + 3]);   \
    unsigned b0 = cvt_pk_bf16(P[BASE + 4], P[BASE + 5]), b1 = cvt_pk_bf16(P[BASE + 6], P[BASE + 7]);                              \
    auto r0 = __builtin_amdgcn_permlane32_swap(a0, b0, false, false); auto r1 = __builtin_amdgcn_permlane32_swap(a1, b1, false, false); \
    u32x4 w = {r0[0], r1[0], r0[1], r1[1]}; OUT = *reinterpret_cast<bf16x8*>(&w); } while (0)
    PK4(p0, 0, pa0); PK4(p0, 8, pa1); PK4(p1, 0, pa2); PK4(p1, 8, pa3);
#undef PK4
}
__device__ __forceinline__ void qkt(f32x16& p0, f32x16& p1, const char* Ks, const bf16x8* qr, int r32, int hi, int sub, float negm) {
#pragma unroll
    for (int r = 0; r < 16; ++r) { p0[r] = negm; p1[r] = negm; }
#pragma unroll
    for (int d0 = 0; d0 < 4; ++d0) { const int cb = (sub * 64 + d0 * 16 + hi * 8) * 2;
        const bf16x8 b0 = *reinterpret_cast<const bf16x8*>(Ks + KSWZ(r32, cb));
        const bf16x8 b1 = *reinterpret_cast<const bf16x8*>(Ks + KSWZ(32 + r32, cb));
        p0 = __builtin_amdgcn_mfma_f32_32x32x16_bf16(b0, qr[d0], p0, 0, 0, 0);
        p1 = __builtin_amdgcn_mfma_f32_32x32x16_bf16(b1, qr[d0], p1, 0, 0, 0); }
}
__device__ __forceinline__ int v_st(int k, int c) { const int kk = (k & ~0xC) | ((k & 4) << 1) | ((k & 8) >> 1); return ((kk >> 3) * 4 + (c >> 5)) * 512 + ((kk & 7) * 32 + (c & 31)) * 2; }
__device__ __forceinline__ int v_rd_base(int lane) { return ((lane & 3) << 3) | (((lane >> 2) & 3) << 6) | (((lane >> 4) & 1) << 5) | (((lane >> 5) & 1) << 8); }
constexpr int v_rd_off(int d0, int ks, int half) { return d0 * 512 + ks * 4096 + half * 2048; }
template <int OFF> __device__ __forceinline__ s16x4 tr_read(int vb) {
    s16x4 r; asm volatile("ds_read_b64_tr_b16 %0, %1 offset:%2" : "=&v"(r) : "v"(vb), "i"(OFF) : "memory"); return r;
}
template <int D0> __device__ __forceinline__ void pv_one(f32x16& od, int vb, bf16x8 pa0, bf16x8 pa1, bf16x8 pa2, bf16x8 pa3) {
    const s16x4 l0 = tr_read<v_rd_off(D0, 0, 0)>(vb), h0 = tr_read<v_rd_off(D0, 0, 1)>(vb), l1 = tr_read<v_rd_off(D0, 1, 0)>(vb), h1 = tr_read<v_rd_off(D0, 1, 1)>(vb);
    const s16x4 l2 = tr_read<v_rd_off(D0, 2, 0)>(vb), h2 = tr_read<v_rd_off(D0, 2, 1)>(vb), l3 = tr_read<v_rd_off(D0, 3, 0)>(vb), h3 = tr_read<v_rd_off(D0, 3, 1)>(vb);
    asm volatile("s_waitcnt lgkmcnt(0)" ::: "memory"); SBAR();
#define PK(L, H) (bf16x8){L[0], L[1], L[2], L[3], H[0], H[1], H[2], H[3]}
    od = __builtin_amdgcn_mfma_f32_32x32x16_bf16(pa0, PK(l0, h0), od, 0, 0, 0);
    od = __builtin_amdgcn_mfma_f32_32x32x16_bf16(pa1, PK(l1, h1), od, 0, 0, 0);
    od = __builtin_amdgcn_mfma_f32_32x32x16_bf16(pa2, PK(l2, h2), od, 0, 0, 0);
    od = __builtin_amdgcn_mfma_f32_32x32x16_bf16(pa3, PK(l3, h3), od, 0, 0, 0);
#undef PK
}
__device__ __forceinline__ void pv_d0(f32x16* o, int vb, bf16x8 pa0, bf16x8 pa1, bf16x8 pa2, bf16x8 pa3) {
    pv_one<0>(o[0], vb, pa0, pa1, pa2, pa3); pv_one<1>(o[1], vb, pa0, pa1, pa2, pa3); pv_one<2>(o[2], vb, pa0, pa1, pa2, pa3); pv_one<3>(o[3], vb, pa0, pa1, pa2, pa3);
}

__device__ __forceinline__ void attn_unit(const bf16_t* __restrict__ Qb, const bf16_t* __restrict__ Kh, const bf16_t* __restrict__ Vh, bf16_t* MIXo,
                                          const float lam, const float negm, const float* __restrict__ subg, char* lds, const int wid) {
    const int lane = lane_id(), tid = wid * 64 + lane, r32 = lane & 31, hi = lane >> 5;
    const int sub = wid >> 2, wq = wid & 3;
    char* V_lds = lds; char* K_lds = lds + 2 * SHM_V;
    float* wsf = (float*)(lds + 98304) + wid * 32;
    float l_reg = 0; f32x16 o[4] = {}; bf16x8 qr[4];
    const bf16_t* Qw = Qb + (long)(wq * 32 + r32) * LDK + sub * 64 + hi * 8;
#pragma unroll
    for (int d0 = 0; d0 < 4; ++d0) qr[d0] = *reinterpret_cast<const bf16x8*>(Qw + d0 * 16);
    const int sr = tid >> 4, sc = (tid & 15) * 8, vst0 = v_st(sr, sc), vst1 = v_st(32 + sr, sc);
    const int vb0 = (int)(uintptr_t)V_lds + v_rd_base(lane);
    struct { bf16x8 vs0, vs1, ks0, ks1; } sr_[2];
#define SLOAD(i, k0) do { sr_[i].vs0 = *(const bf16x8*)(&Vh[(long)((k0) + sr) * LDK + sc]); sr_[i].vs1 = *(const bf16x8*)(&Vh[(long)((k0) + 32 + sr) * LDK + sc]); \
    sr_[i].ks0 = *(const bf16x8*)(&Kh[(long)((k0) + sr) * LDK + sc]); sr_[i].ks1 = *(const bf16x8*)(&Kh[(long)((k0) + 32 + sr) * LDK + sc]); } while (0)
#define SWRITE(b, i) do { *(bf16x8*)(V_lds + (b) * SHM_V + vst0) = sr_[i].vs0;          \
    *(bf16x8*)(V_lds + (b) * SHM_V + vst1) = sr_[i].vs1; const int kc = sc * 2;               \
    *(bf16x8*)(K_lds + (b) * SHM_K + KSWZ(sr, kc)) = sr_[i].ks0;                       \
    *(bf16x8*)(K_lds + (b) * SHM_K + KSWZ(32 + sr, kc)) = sr_[i].ks1; } while (0)
#define SWAIT() asm volatile("s_waitcnt vmcnt(4)" ::: "memory")
    f32x16 pA0, pA1, pB0, pB1; bf16x8 pa0, pa1, pa2, pa3;
    constexpr int SE = 0, SO = 1;
    SLOAD(SE, 0); asm volatile("s_waitcnt vmcnt(0)" ::: "memory"); SWRITE(0, SE); __syncthreads();
    qkt(pA0, pA1, K_lds, qr, r32, hi, sub, negm); expA(pA0);
    SLOAD(SO, KVBLK); SLOAD(SE, 2 * KVBLK);
    SWAIT(); SWRITE(1, SO); __syncthreads();
    for (int j = 1; j + 1 < NT; j += 2) {
        SBAR(); qkt(pB0, pB1, K_lds + SHM_K, qr, r32, hi, sub, negm);
        finishSM(pA0, pA1, l_reg, pa0, pa1, pa2, pa3); SBAR();
        SLOAD(SO, (j + 2) * KVBLK); SBAR();
        pv_d0(o, vb0, pa0, pa1, pa2, pa3); expA(pB0);
        __syncthreads(); SWAIT(); SWRITE(0, SE);
        __syncthreads();
        SBAR(); qkt(pA0, pA1, K_lds, qr, r32, hi, sub, negm);
        finishSM(pB0, pB1, l_reg, pa0, pa1, pa2, pa3); SBAR();
        if (j + 3 < NT) SLOAD(SE, (j + 3) * KVBLK); SBAR();
        pv_d0(o, vb0 + SHM_V, pa0, pa1, pa2, pa3); expA(pA0);
        __syncthreads(); SWAIT(); SWRITE(1, SO);
        __syncthreads();
    }
    SBAR(); qkt(pB0, pB1, K_lds + SHM_K, qr, r32, hi, sub, negm);
    finishSM(pA0, pA1, l_reg, pa0, pa1, pa2, pa3); SBAR();
    pv_d0(o, vb0, pa0, pa1, pa2, pa3); expA(pB0);
    finishSM(pB0, pB1, l_reg, pa0, pa1, pa2, pa3); SBAR();
    pv_d0(o, vb0 + SHM_V, pa0, pa1, pa2, pa3);
#undef SLOAD
#undef SWRITE
#undef SWAIT
    if (hi == 0) wsf[r32] = l_reg;
    __syncthreads();
    float* X = (float*)lds;
    float rli[16];
#pragma unroll
    for (int r = 0; r < 16; ++r) rli[r] = __builtin_amdgcn_rcpf(wsf[crow(r, hi)]);
    if (sub == 1) {
#pragma unroll
        for (int r = 0; r < 16; ++r) { const int row = wq * 32 + crow(r, hi); const float s = lam * rli[r];
#pragma unroll
            for (int d0 = 0; d0 < 4; ++d0) X[row * 128 + d0 * 32 + r32] = o[d0][r] * s; }
    }
    __syncthreads();
    bf16_t* Y = (bf16_t*)(lds + 65536);
    if (sub == 0) {
        float sg[4];
#pragma unroll
        for (int d0 = 0; d0 < 4; ++d0) sg[d0] = subg[d0 * 32 + r32] * (1.f - LAM_INIT);
#pragma unroll
        for (int r = 0; r < 16; ++r) { const int row = wq * 32 + crow(r, hi);
            float v[4]; float ss = 0.f;
#pragma unroll
            for (int d0 = 0; d0 < 4; ++d0) { v[d0] = o[d0][r] * rli[r] - X[row * 128 + d0 * 32 + r32]; ss += v[d0] * v[d0]; }
            ss += __shfl_xor(ss, 1); ss += __shfl_xor(ss, 2); ss += __shfl_xor(ss, 4); ss += __shfl_xor(ss, 8); ss += __shfl_xor(ss, 16);
            const float rstd = rsqrtf(ss * (1.f / 128.f) + EPS);
#pragma unroll
            for (int d0 = 0; d0 < 4; ++d0) Y[row * 128 + d0 * 32 + r32] = (bf16_t)(cvt_pk_bf16(v[d0] * rstd * sg[d0], 0.f) & 0xffffu); }
    }
    __syncthreads();
    { const int row = tid >> 2, seg = (tid & 3) * 32;
#pragma unroll
        for (int i = 0; i < 4; ++i) { const u32x4 v = *(const u32x4*)(Y + row * 128 + seg + i * 8); *(u32x4*)(MIXo + (size_t)row * DM + seg + i * 8) = v; } }
    __syncthreads();
}
#undef KSWZ
#undef SBAR
}

__device__ __forceinline__ void p3_attention(Frame& F) {
    FT_DECL;
    const float* sc = WSP(float, WS_SMALL + SM_SCAL);
    const float lam = sc[0], negm = -sc[1];
    const bf16_t* Q = WSP(bf16_t, WS_Q); const bf16_t* Kb = WSP(bf16_t, WS_K); const bf16_t* Vb = WSP(bf16_t, WS_V); bf16_t* MIX = WSP(bf16_t, WS_MIX);
    const int c = blockIdx.x, xcd = c & 7, ci = c >> 3, per = F.G >> 3;
    for (int j = ci; j < 128; j += per) {
        const int pair = xcd * 4 + (j >> 5), qb = j & 31, b = pair >> 2, h = pair & 3;
        att::attn_unit(Q + ((size_t)b * SEQ + qb * 128) * QKW + h * 128, Kb + (size_t)b * KVL * QKW + h * 128, Vb + (size_t)b * KVL * QKW + h * 128,
                       MIX + ((size_t)b * SEQ + qb * 128) * DM + h * 128, lam, negm, F.in[15], (char*)F.lds, F.wave);
    }
}


namespace hy {
constexpr int RB_BYTES = 4352 * 8, IN_OFF = 2 * RB_BYTES, TW1_OFF = IN_OFF + 32768, TW2_OFF = TW1_OFF + 15 * 256 * 8, LDS_END = TW2_OFF + 15 * 16 * 8;
__device__ __forceinline__ f32x2 cmul(f32x2 a, f32x2 b) { return (f32x2){a.x * b.x - a.y * b.y, a.x * b.y + a.y * b.x}; }
__device__ __forceinline__ f32x2 cmulc(f32x2 a, f32x2 b) { return (f32x2){a.x * b.x + a.y * b.y, a.y * b.x - a.x * b.y}; }
__device__ __forceinline__ int P(int i) { return i + (i >> 4); }
template <bool INV> __device__ __forceinline__ void r4(f32x2& a, f32x2& b, f32x2& c, f32x2& d) {
    const f32x2 t0 = a + c, t1 = a - c, t2 = b + d, t3 = b - d;
    const f32x2 st3 = INV ? (f32x2){-t3.y, t3.x} : (f32x2){t3.y, -t3.x};
    a = t0 + t2; c = t0 - t2; b = t1 + st3; d = t1 - st3;
}
template <bool INV> __device__ __forceinline__ f32x2 tw(f32x2 v, float c, float s) {
    return INV ? (f32x2){v.x * c - v.y * s, v.y * c + v.x * s} : (f32x2){v.x * c + v.y * s, v.y * c - v.x * s};
}
template <bool INV> __device__ __forceinline__ void dft16(f32x2 (&v)[16]) {
    constexpr float C1 = 0.9238795325112867f, S1 = 0.3826834323650898f, R2 = 0.7071067811865476f;
    r4<INV>(v[0], v[4], v[8], v[12]); r4<INV>(v[1], v[5], v[9], v[13]); r4<INV>(v[2], v[6], v[10], v[14]); r4<INV>(v[3], v[7], v[11], v[15]);
    v[5] = tw<INV>(v[5], C1, S1);  v[9] = tw<INV>(v[9], R2, R2);    v[13] = tw<INV>(v[13], S1, C1);
    v[6] = tw<INV>(v[6], R2, R2);  v[10] = tw<INV>(v[10], 0.f, 1.f); v[14] = tw<INV>(v[14], -R2, R2);
    v[7] = tw<INV>(v[7], S1, C1);  v[11] = tw<INV>(v[11], -R2, R2);  v[15] = tw<INV>(v[15], -C1, -S1);
    r4<INV>(v[0], v[1], v[2], v[3]); r4<INV>(v[4], v[5], v[6], v[7]); r4<INV>(v[8], v[9], v[10], v[11]); r4<INV>(v[12], v[13], v[14], v[15]);
    f32x2 t;
    t = v[1]; v[1] = v[4]; v[4] = t;   t = v[2]; v[2] = v[8]; v[8] = t;    t = v[3]; v[3] = v[12]; v[12] = t;
    t = v[6]; v[6] = v[9]; v[9] = t;   t = v[7]; v[7] = v[13]; v[13] = t;  t = v[11]; v[11] = v[14]; v[14] = t;
}
struct Ctx { LAS f32x2* R; LAS f32x2* IN; LAS f32x2* TW1; LAS f32x2* TW2; int t, half; f32x2 wt; };
#define HY_OPAQUE(x) asm volatile("" : "+v"(x))
#define HY_W32(m) (f32x2){__builtin_cosf(-0.19634954084936207f * (m)), __builtin_sinf(-0.19634954084936207f * (m))}
template <int MODE> __device__ __forceinline__ void pass1_fwd(const Ctx& X) {
    f32x2 v[16]; int t = X.t; HY_OPAQUE(t);
#pragma unroll
    for (int m = 0; m < 16; ++m) { f32x2 a = X.IN[t + 256 * m]; if (MODE == 1) a = (f32x2){X.half ? a.y : a.x, 0.f}; v[m] = a; }
    if (X.half) {
#pragma unroll
        for (int m = 0; m < 16; ++m) v[m] = cmul(cmul(v[m], HY_W32(m)), X.wt);
    }
    dft16<false>(v);
#pragma unroll
    for (int q = 1; q < 16; ++q) v[q] = cmul(v[q], X.TW1[(q - 1) * 256 + t]);
    const int pb = t + (t >> 4);
#pragma unroll
    for (int q = 0; q < 16; ++q) X.R[pb + 272 * q] = v[q];
}
__device__ __forceinline__ void pass2_fwd(const Ctx& X) {
    int t = X.t; HY_OPAQUE(t);
    const int n2 = t & 15, pb = (t >> 4) * 272 + n2; f32x2 v[16];
#pragma unroll
    for (int m = 0; m < 16; ++m) v[m] = X.R[pb + 17 * m];
    dft16<false>(v);
#pragma unroll
    for (int q = 1; q < 16; ++q) v[q] = cmul(v[q], X.TW2[(q - 1) * 16 + n2]);
#pragma unroll
    for (int q = 0; q < 16; ++q) X.R[pb + 17 * q] = v[q];
}
template <bool FILTER> __device__ __forceinline__ void pass3(const Ctx& X, f32x2 (&H)[16]) {
    f32x2 v[16]; int t = X.t; HY_OPAQUE(t); const int pb = 17 * t;
#pragma unroll
    for (int m = 0; m < 16; ++m) v[m] = X.R[pb + m];
    dft16<false>(v);
    if (FILTER) {
#pragma unroll
        for (int q = 0; q < 16; ++q) H[q] = v[q] * (1.f / 8192.f);
    } else {
#pragma unroll
        for (int q = 0; q < 16; ++q) v[q] = cmul(v[q], H[q]);
        dft16<true>(v);
#pragma unroll
        for (int m = 0; m < 16; ++m) X.R[pb + m] = v[m];
    }
}
__device__ __forceinline__ void pass2_inv(const Ctx& X) {
    int t = X.t; HY_OPAQUE(t);
    const int n2 = t & 15, pb = (t >> 4) * 272 + n2; f32x2 v[16];
    v[0] = X.R[pb];
#pragma unroll
    for (int q = 1; q < 16; ++q) v[q] = cmulc(X.R[pb + 17 * q], X.TW2[(q - 1) * 16 + n2]);
    dft16<true>(v);
#pragma unroll
    for (int m = 0; m < 16; ++m) X.R[pb + 17 * m] = v[m];
}
__device__ __forceinline__ void pass1_inv(const Ctx& X) {
    f32x2 v[16]; int t = X.t; HY_OPAQUE(t); const int pb = t + (t >> 4);
    v[0] = X.R[pb];
#pragma unroll
    for (int q = 1; q < 16; ++q) v[q] = cmulc(X.R[pb + 272 * q], X.TW1[(q - 1) * 256 + t]);
    dft16<true>(v);
    if (X.half) {
#pragma unroll
        for (int m = 0; m < 16; ++m) v[m] = cmulc(cmulc(v[m], HY_W32(m)), X.wt);
    }
#pragma unroll
    for (int m = 0; m < 16; ++m) X.R[pb + 272 * m] = v[m];
}
__device__ __forceinline__ void conv_fft(const Ctx& X, f32x2 (&H)[16]) {
    __syncthreads(); pass1_fwd<0>(X); __syncthreads(); pass2_fwd(X); __syncthreads(); pass3<false>(X, H); __syncthreads(); pass2_inv(X); __syncthreads(); pass1_inv(X); __syncthreads();
}
constexpr int STG_OFF = LDS_END;
constexpr int LDS_END2 = STG_OFF + 2 * SEQ * 2;
static_assert(LDS_END2 <= LDSCTL_OFF, "hyena LDS map");
__device__ __forceinline__ float sconv_lds(const LAS bf16_t* stg, int bs, int n, float w0, float w1, float w2, float bias) {
    const LAS bf16_t* p = stg + bs * SEQ;
    const float c = bf2f(p[n]), lv = bf2f(p[n - ((n > 0) ? 1 : 0)]), rv = bf2f(p[n + ((n < SEQ - 1) ? 1 : 0)]);
    const float l = (n > 0) ? lv : 0.f, r = (n < SEQ - 1) ? rv : 0.f;
    return bias + w0 * l + w1 * c + w2 * r;
}
__device__ __forceinline__ void setup_tables(LAS unsigned char* lds, int tid) {
    LAS f32x2* TW1 = (LAS f32x2*)(lds + TW1_OFF); LAS f32x2* TW2 = (LAS f32x2*)(lds + TW2_OFF);
    for (int i = tid; i < 15 * 256; i += 512) { const int q = i / 256 + 1, t = i & 255; float s, c; sincosf(-6.283185307179586f * (float)((t * q) & 4095) * (1.f / 4096.f), &s, &c); TW1[i] = (f32x2){c, s}; }
    for (int i = tid; i < 15 * 16; i += 512) { const int q = i / 16 + 1, n2 = i & 15; float s, c; sincosf(-6.283185307179586f * (float)((n2 * q) & 255) * (1.f / 256.f), &s, &c); TW2[i] = (f32x2){c, s}; }
}
__device__ __forceinline__ void unit(Frame& F, int c) {
    FT_DECL;
    const int tid = f_tid; Ctx X; X.half = F.wave >> 2; X.t = tid & 255;
    X.R = (LAS f32x2*)(F.lds + X.half * RB_BYTES); X.IN = (LAS f32x2*)(F.lds + IN_OFF); X.TW1 = (LAS f32x2*)(F.lds + TW1_OFF); X.TW2 = (LAS f32x2*)(F.lds + TW2_OFF);
    { float s, cc; sincosf(-6.283185307179586f * (float)X.t * (1.f / 8192.f), &s, &cc); X.wt = (f32x2){cc, s}; }
    LAS f32x2* RB0 = (LAS f32x2*)(F.lds); LAS f32x2* RB1 = (LAS f32x2*)(F.lds + RB_BYTES);
    const float* FILT = WSP(float, WS_FILT);
    f32x2 H0[16], H1[16];
#pragma unroll
    for (int ord = 0; ord < 2; ++ord) {
        const float* hf = FILT + ((size_t)(ord * 2 + 0) * 512 + c) * SEQ; const float* hb = FILT + ((size_t)(ord * 2 + 1) * 512 + c) * SEQ;
        __syncthreads();
        int nb = tid; HY_OPAQUE(nb);
#pragma unroll
        for (int j = 0; j < 8; ++j) { const int n = nb + 512 * j; const float a = hf[n], b = hb[(SEQ - n) & (SEQ - 1)]; const float lo = (n == 0) ? a + b : a, hi = (n == 0) ? 0.f : b; X.IN[n] = (f32x2){lo + hi, lo - hi}; }
        __syncthreads(); pass1_fwd<1>(X); __syncthreads(); pass2_fwd(X); __syncthreads();
        if (ord == 0) pass3<true>(X, H0); else pass3<true>(X, H1);
    }
    const bf16_t* UT = WSP(bf16_t, WS_UT);
    const bf16_t* rv = UT + (size_t)c * MROWS; const bf16_t* r1 = UT + (size_t)(512 + c) * MROWS; const bf16_t* r2 = UT + (size_t)(1024 + c) * MROWS;
    const float* cw = F.in[16]; const float* cb = F.in[17];
    const float wv0 = cw[c], wv1 = cw[HYC + c], wv2 = cw[2 * HYC + c], bv = cb[c];
    const float wa0 = cw[512 + c], wa1 = cw[HYC + 512 + c], wa2 = cw[2 * HYC + 512 + c], ba = cb[512 + c];
    const float wb0 = cw[1024 + c], wb1 = cw[HYC + 1024 + c], wb2 = cw[2 * HYC + 1024 + c], bb = cb[1024 + c];
    const float sk0 = F.in[25][c], sk1 = F.in[25][512 + c];
    bf16_t* Z = WSP(bf16_t, WS_Z2T) + (size_t)c * MROWS;
    LAS bf16_t* STG = (LAS bf16_t*)(F.lds + STG_OFF);
    u32x4 g0 = *(const u32x4*)(rv + tid * 8), g1 = *(const u32x4*)(rv + SEQ + tid * 8);
    for (int pr = 0; pr < 4; ++pr) {
        const int b0 = 2 * pr, b1 = b0 + 1;
        f32x2 z[8]; int pc = tid + (tid >> 4); HY_OPAQUE(pc); int nb = tid; HY_OPAQUE(nb);
        __syncthreads();
        *(LAS u32x4*)(STG + tid * 8) = g0; *(LAS u32x4*)(STG + SEQ + tid * 8) = g1;
        __syncthreads();
#pragma unroll
        for (int j = 0; j < 8; ++j) { const int n = nb + 512 * j; z[j] = (f32x2){sconv_lds(STG, 0, n, wv0, wv1, wv2, bv), sconv_lds(STG, 1, n, wv0, wv1, wv2, bv)}; X.IN[n] = z[j]; }
        g0 = *(const u32x4*)(r1 + b0 * SEQ + tid * 8); g1 = *(const u32x4*)(r1 + b1 * SEQ + tid * 8);
        conv_fft(X, H0);
        *(LAS u32x4*)(STG + tid * 8) = g0; *(LAS u32x4*)(STG + SEQ + tid * 8) = g1;
        __syncthreads();
        HY_OPAQUE(nb); HY_OPAQUE(pc);
#pragma unroll
        for (int j = 0; j < 8; ++j) { const int n = nb + 512 * j; const f32x2 y = RB0[pc + 544 * j] + RB1[pc + 544 * j];
            const f32x2 g = (f32x2){sconv_lds(STG, 0, n, wa0, wa1, wa2, ba), sconv_lds(STG, 1, n, wa0, wa1, wa2, ba)};
            z[j] = g * (y + sk0 * z[j]); X.IN[n] = z[j]; }
        g0 = *(const u32x4*)(r2 + b0 * SEQ + tid * 8); g1 = *(const u32x4*)(r2 + b1 * SEQ + tid * 8);
        conv_fft(X, H1);
        *(LAS u32x4*)(STG + tid * 8) = g0; *(LAS u32x4*)(STG + SEQ + tid * 8) = g1;
        __syncthreads();
        if (pr < 3) { g0 = *(const u32x4*)(rv + (b0 + 2) * SEQ + tid * 8); g1 = *(const u32x4*)(rv + (b1 + 2) * SEQ + tid * 8); }
        HY_OPAQUE(nb); HY_OPAQUE(pc);
        f32x2 o[8];
#pragma unroll
        for (int j = 0; j < 8; ++j) { const int n = nb + 512 * j; const f32x2 y = RB0[pc + 544 * j] + RB1[pc + 544 * j];
            const f32x2 g = (f32x2){sconv_lds(STG, 0, n, wb0, wb1, wb2, bb), sconv_lds(STG, 1, n, wb0, wb1, wb2, bb)};
            o[j] = g * (y + sk1 * z[j]); }
        __syncthreads();
#pragma unroll
        for (int j = 0; j < 8; ++j) { const int n = nb + 512 * j; STG[n] = (bf16_t)(cvt_pk_bf16(o[j].x, 0.f) & 0xffffu); STG[SEQ + n] = (bf16_t)(cvt_pk_bf16(o[j].y, 0.f) & 0xffffu); }
        __syncthreads();
        *(u32x4*)(Z + b0 * SEQ + tid * 8) = *(const LAS u32x4*)(STG + tid * 8); *(u32x4*)(Z + b1 * SEQ + tid * 8) = *(const LAS u32x4*)(STG + SEQ + tid * 8);
    }
    __syncthreads();
}
}

__device__ __forceinline__ void p3_hyena(Frame& F) {
    FT_DECL;
    __syncthreads();
    hy::setup_tables(F.lds, f_tid);
    __syncthreads();
    for (int c = F.vcu; c < HYW; c += F.G) hy::unit(F, c);
}

__device__ __forceinline__ void p4_hynorm(Frame& F) {
    FT_DECL;
    const bf16_t* Z = WSP(bf16_t, WS_Z2T); bf16_t* MIX = WSP(bf16_t, WS_MIX); const float* g = F.in[26];
    LAS bf16_t* T = (LAS bf16_t*)F.lds;
    LAS float* red = (LAS float*)(F.lds + 512 * 72 * 2);
    LAS float* rs = red + 512;
    for (int it = F.vcu; it < MROWS / 64; it += F.G) {
        const int tok0 = it * 64;
        __syncthreads();
#pragma unroll
        for (int j = 0; j < 8; ++j) { const int i = f_tid + 512 * j, row = i >> 3, ch = i & 7; const u32x4 v = *(const u32x4*)(Z + (size_t)row * MROWS + tok0 + ch * 8); *(LAS u32x4*)(T + row * 72 + ch * 8) = v; }
        __syncthreads();
        { const int tok = f_tid & 63, grp = f_tid >> 6; float ss = 0.f;
#pragma unroll 8
            for (int k = 0; k < 64; ++k) { const float v = bf2f(T[(grp * 64 + k) * 72 + tok]); ss += v * v; }
            red[grp * 64 + tok] = ss; }
        __syncthreads();
        if (f_tid < 64) { float ss = 0.f;
#pragma unroll
            for (int w = 0; w < 8; ++w) ss += red[w * 64 + f_tid];
            rs[f_tid] = rsqrtf(ss * (1.f / HYW) + EPS); }
        __syncthreads();
#pragma unroll
        for (int j = 0; j < 8; ++j) { const int i = f_tid + 512 * j, tok = i >> 6, c0 = (i & 63) * 8; const float r = rs[tok];
            float v[8];
#pragma unroll
            for (int e = 0; e < 8; ++e) v[e] = bf2f(T[(c0 + e) * 72 + tok]) * r * g[c0 + e];
            u32x4 w; w.x = cvt_pk_bf16(v[0], v[1]); w.y = cvt_pk_bf16(v[2], v[3]); w.z = cvt_pk_bf16(v[4], v[5]); w.w = cvt_pk_bf16(v[6], v[7]);
            *(u32x4*)(MIX + (size_t)(tok0 + tok) * DM + 512 + c0) = w; }
    }
}

__device__ __forceinline__ void p4_stub(Frame& F) {
    FT_DECL;
    bf16_t* MIX = WSP(bf16_t, WS_MIX);
    const size_t gt = (size_t)F.vcu * 512 + f_tid, NT = (size_t)F.G * 512;
    for (size_t i = gt; i < (size_t)MROWS * 64; i += NT) { const size_t row = i >> 6, ch = i & 63; *(u32x4*)(MIX + row * DM + 512 + ch * 8) = (u32x4){0u, 0u, 0u, 0u}; }
}


constexpr size_t RT_TOPI = 0;
constexpr size_t RT_GATE = 512 * 1024;
constexpr size_t RT_POS = 1024 * 1024;
constexpr size_t RT_WGCNT = 1536 * 1024;
constexpr size_t RT_META = 1600 * 1024;
constexpr size_t RT_LIST = 2048 * 1024;
constexpr size_t RT_GSLOT = 2048 * 1024 + 640 * 1024;
constexpr int MAXSLOT = MROWS * TOPK + NEXP * 256;
constexpr int MAXTILE = MAXSLOT / 256;
constexpr size_t WS_XS = WS_EO;
constexpr int RW_PITCH = 32;
constexpr int P6_LDS_TOPI = 1024 * RW_PITCH * 4;

__device__ __forceinline__ void p6_router(Frame& F) {
    FT_DECL;
#define in F.in
    LAS float* RW = (LAS float*)F.lds;
    LAS int* TI = (LAS int*)(F.lds + P6_LDS_TOPI);
    LAS int* PS = TI + 512;
    LAS int* SC = PS + 512;
    const float* rw = in[28];
    for (int i = f_tid; i < 1024 * 8; i += 512) { const int k = i >> 3, c4 = i & 7; const f32x4 v = *(const f32x4*)(rw + (size_t)k * 32 + c4 * 4);
        const int pi = (k & 3) * 256 + (k >> 2); *(LAS f32x4*)(RW + pi * RW_PITCH + ((c4 ^ ((pi >> 1) & 7)) * 4)) = v; }
    __syncthreads();
    const float* mod = WSP(float, WS_SMALL + SM_MOD); const float* g2n = in[7]; const float* rb = in[29];
    unsigned char* H2 = WSP(unsigned char, WS_H);
    int* topi_g = WSP(int, WS_ROUTE + RT_TOPI); float* gate_g = WSP(float, WS_ROUTE + RT_GATE); int* pos_g = WSP(int, WS_ROUTE + RT_POS); int* wgcnt = WSP(int, WS_ROUTE + RT_WGCNT);
    const int lane = f_lane;
    for (int blk = blockIdx.x; blk < MROWS / 128; blk += F.G) {
        for (int it = 0; it < 8; ++it) {
            const int rl = F.wave * 16 + 2 * it, r0 = blk * 128 + rl;
            const float* sh2 = mod + (size_t)(r0 >> 12) * (NMOD * DM) + 3 * DM; const float* sc2 = sh2 + DM;
            f32x4 h[2][4];
#pragma unroll
            for (int rr = 0; rr < 2; ++rr) {
                const GAS f32x4* xr = (const GAS f32x4*)(WSP(float, WS_XN) + (size_t)(r0 + rr) * DM) + lane; float ss = 0.f;
#pragma unroll
                for (int j = 0; j < 4; ++j) { h[rr][j] = xr[64 * j]; ss += (h[rr][j].x * h[rr][j].x + h[rr][j].y * h[rr][j].y) + (h[rr][j].z * h[rr][j].z + h[rr][j].w * h[rr][j].w); }
                const float rstd = rsqrtf(wave_sum(ss) * (1.f / DM) + EPS);
                GAS unsigned* o4 = (GAS unsigned*)(H2 + (size_t)(r0 + rr) * DM) + lane;
#pragma unroll
                for (int j = 0; j < 4; ++j) { const int c = 4 * lane + 256 * j;
                    const f32x4 g = *(const f32x4*)(g2n + c), a = *(const f32x4*)(sc2 + c), b = *(const f32x4*)(sh2 + c);
                    h[rr][j] = h[rr][j] * rstd * g * (a + 1.f) + b;
                    o4[64 * j] = pk4_fp8(h[rr][j].x, h[rr][j].y, h[rr][j].z, h[rr][j].w); }
            }
            float a0[32], a1[32]; int lb = lane; asm volatile("" : "+v"(lb)); const int sw = (lb >> 1) & 7;
#pragma unroll
            for (int e = 0; e < 32; ++e) { a0[e] = 0.f; a1[e] = 0.f; }
#pragma unroll
            for (int j = 0; j < 4; ++j)
#pragma unroll
                for (int i = 0; i < 4; ++i) { const LAS float* wp = RW + (i * 256 + 64 * j + lb) * RW_PITCH; const float x0 = h[0][j][i], x1 = h[1][j][i];
#pragma unroll
                    for (int c4 = 0; c4 < 8; ++c4) { const f32x4 w = *(const LAS f32x4*)(wp + 4 * (c4 ^ sw));
#pragma unroll
                        for (int e = 0; e < 4; ++e) { a0[4 * c4 + e] += x0 * w[e]; a1[4 * c4 + e] += x1 * w[e]; } } }
#define RS_STEP(A, CNT, MASK) _Pragma("unroll") for (int i = 0; i < CNT; ++i) { const bool up = (lane & MASK) != 0; const float send = up ? A[i] : A[CNT + i]; const float keep = up ? A[CNT + i] : A[i]; A[i] = keep + __shfl_xor(send, MASK); }
            RS_STEP(a0, 16, 32) RS_STEP(a0, 8, 16) RS_STEP(a0, 4, 8) RS_STEP(a0, 2, 4) RS_STEP(a0, 1, 2)
            RS_STEP(a1, 16, 32) RS_STEP(a1, 8, 16) RS_STEP(a1, 4, 8) RS_STEP(a1, 2, 4) RS_STEP(a1, 1, 2)
#undef RS_STEP
            const int me = lane >> 1; const float bias = rb[me];
            float lg[2]; lg[0] = a0[0] + __shfl_xor(a0[0], 1) + bias; lg[1] = a1[0] + __shfl_xor(a1[0], 1) + bias;
#pragma unroll
            for (int rr = 0; rr < 2; ++rr) {
                float v = lg[rr]; float tv[4]; int ti[4];
#pragma unroll
                for (int k = 0; k < 4; ++k) { float bv = v; int bi = me;
#pragma unroll
                    for (int o = 1; o < 64; o <<= 1) { const float ov = __shfl_xor(bv, o); const int oi = __shfl_xor(bi, o); if (ov > bv || (ov == bv && oi < bi)) { bv = ov; bi = oi; } }
                    tv[k] = bv; ti[k] = bi; if (me == bi) v = -INFINITY; }
                const float e1 = __expf(tv[1] - tv[0]), e2 = __expf(tv[2] - tv[0]), e3 = __expf(tv[3] - tv[0]); const float inv = 1.f / (1.f + e1 + e2 + e3);
                if (lane == 0) { const int r = r0 + rr;
                    *(int4*)(topi_g + (size_t)r * 4) = make_int4(ti[0], ti[1], ti[2], ti[3]);
                    *(f32x4*)(gate_g + (size_t)r * 4) = (f32x4){inv, e1 * inv, e2 * inv, e3 * inv};
                    TI[(rl + rr) * 4 + 0] = ti[0]; TI[(rl + rr) * 4 + 1] = ti[1]; TI[(rl + rr) * 4 + 2] = ti[2]; TI[(rl + rr) * 4 + 3] = ti[3]; }
            }
        }
        __syncthreads();
        { const int e = f_tid & 31, seg = f_tid >> 5; int cnt = 0;
#pragma unroll 4
            for (int i = 0; i < 32; ++i) cnt += (TI[seg * 32 + i] == e) ? 1 : 0;
            SC[seg * 32 + e] = cnt;
            __syncthreads();
            int pre = 0;
            for (int s2 = 0; s2 < seg; ++s2) pre += SC[s2 * 32 + e];
            if (seg == 15) wgcnt[blk * 32 + e] = pre + cnt;
            for (int i = 0; i < 32; ++i) if (TI[seg * 32 + i] == e) { PS[seg * 32 + i] = pre; ++pre; }
        }
        __syncthreads();
        pos_g[(size_t)blk * 512 + f_tid] = PS[f_tid];
        __syncthreads();
    }
#undef in
}

__device__ __forceinline__ void p7_scatter(Frame& F) {
    FT_DECL;
    LAS int* TOT = (LAS int*)F.lds;
    LAS int* BASE = TOT + 32;
    LAS int* PRE = BASE + 32;
    LAS int* PART = PRE + 32;
    const int* wgcnt = WSP(int, WS_ROUTE + RT_WGCNT); const int* topi_g = WSP(int, WS_ROUTE + RT_TOPI); const float* gate_g = WSP(float, WS_ROUTE + RT_GATE); const int* pos_g = WSP(int, WS_ROUTE + RT_POS);
    int* list = WSP(int, WS_ROUTE + RT_LIST); float* gslot = WSP(float, WS_ROUTE + RT_GSLOT); int* meta = WSP(int, WS_ROUTE + RT_META);
    const unsigned char* H2 = WSP(unsigned char, WS_H); unsigned char* XS = WSP(unsigned char, WS_XS);
    for (int blk = blockIdx.x; blk < MROWS / 128; blk += F.G) {
        __syncthreads();
        { const int e = f_tid & 31, part = f_tid >> 5; int st = 0, sp = 0;
            for (int w = part * 16; w < part * 16 + 16; ++w) { const int c = wgcnt[w * 32 + e]; st += c; if (w < blk) sp += c; }
            PART[part * 32 + e] = st; PART[512 + part * 32 + e] = sp; }
        __syncthreads();
        if (f_tid < 32) { int st = 0, sp = 0;
#pragma unroll
            for (int p = 0; p < 16; ++p) { st += PART[p * 32 + f_tid]; sp += PART[512 + p * 32 + f_tid]; }
            TOT[f_tid] = st; PRE[f_tid] = sp; }
        __syncthreads();
        if (f_tid == 0) { int b = 0; for (int e = 0; e < 32; ++e) { BASE[e] = b; b += (TOT[e] + 255) & ~255; }
            if (blk == 0) { int t = 0; for (int e = 0; e < 32; ++e) { meta[e] = TOT[e]; meta[32 + e] = BASE[e]; const int nt = (TOT[e] + 255) >> 8; for (int q = 0; q < nt; ++q) meta[128 + t + q] = e; t += nt; } meta[64] = t; } }
        __syncthreads();
        { const int a = f_tid, row = blk * 128 + (a >> 2); const int e = topi_g[(size_t)blk * 512 + a]; const int slot = BASE[e] + PRE[e] + pos_g[(size_t)blk * 512 + a];
            list[slot] = row * 4 + (a & 3); gslot[slot] = gate_g[(size_t)blk * 512 + a];
            PART[a] = slot; }
        __syncthreads();
        for (int a0 = F.wave * 8; a0 < 512; a0 += NWAVES * 8) { u32x4 v[8]; int sl[8];
#pragma unroll
            for (int q = 0; q < 8; ++q) { const int a = a0 + q; sl[q] = PART[a]; v[q] = ((const GAS u32x4*)(H2 + (size_t)(blk * 128 + (a >> 2)) * DM))[f_lane]; }
#pragma unroll
            for (int q = 0; q < 8; ++q) ((GAS u32x4*)(XS + (size_t)sl[q] * DM))[f_lane] = v[q]; }
        if (blk < NEXP) { const int e = blk, lo = BASE[e] + TOT[e], hi = BASE[e] + ((TOT[e] + 255) & ~255);
            for (int sl = lo + F.wave; sl < hi; sl += NWAVES) { if (f_lane == 0) { list[sl] = -1; gslot[sl] = 0.f; }
                ((GAS u32x4*)(XS + (size_t)sl * DM))[f_lane] = (u32x4){0u, 0u, 0u, 0u}; } }
    }
}

template <int NPN> struct SchedMoE {
    int G, c, nT; const char* A; const char* W; size_t wstride; const int* tileE;
    __device__ __forceinline__ bool next(int i, g8::Unit& u) const {
        const int L = i * G + c, xcd = L & 7, j = L >> 3, T = (j / NPN) * 8 + xcd, pn = j % NPN;
        if (T >= nT) return false;
        const int e = tileE[T];
        u.pm = T; u.pn = pn; u.kind = 0; u.ex = e; u.a = A + (size_t)T * 256 * DM; u.b = W + (size_t)e * wstride + (size_t)pn * 256 * DM; return true;
    }
};
struct EpiSwiGLU {
    unsigned char* ACT; const float* b1;
    __device__ __forceinline__ void operator()(f32x4 (&acc)[2][2][4][2], const g8::Unit& u, int wr, int wc, int fr, int fq) const {
        asm volatile("" : "+v"(fr), "+v"(fq));
        const int j0 = u.pn * 128 + wc * 32 + 8 * fq; const float* bp = b1 + (size_t)u.ex * 2 * DM + j0;
        f32x4 bg[2], bl[2];
#pragma unroll
        for (int n = 0; n < 2; ++n) { bg[n] = *(const f32x4*)(bp + 4 * n); bl[n] = *(const f32x4*)(bp + DM + 4 * n); }
#pragma unroll
        for (int ai = 0; ai < 2; ++ai)
#pragma unroll
            for (int m = 0; m < 4; ++m) { const size_t slot = (size_t)u.pm * 256 + ai * 128 + wr * 64 + m * 16 + fr; float o[8];
#pragma unroll
                for (int n = 0; n < 2; ++n)
#pragma unroll
                    for (int e = 0; e < 4; ++e) { float g = acc[ai][0][m][n][e] * (1.f / WSCALE) + bg[n][e], l = acc[ai][1][m][n][e] * (1.f / WSCALE) + bl[n][e];
                        g = fminf(g, 7.f); l = fminf(fmaxf(l, -7.f), 7.f);
                        const float sg = 1.f / (1.f + __expf(-1.702f * g)); o[4 * n + e] = (l + 1.f) * (g * sg); }
                u32x2 w; w.x = pk4_fp8(o[0], o[1], o[2], o[3]); w.y = pk4_fp8(o[4], o[5], o[6], o[7]);
                *(u32x2*)(ACT + slot * DM + j0) = w; }
    }
};
struct EpiDown {
    bf16_t* EO; const float* b2; const int* list; const float* gslot;
    __device__ __forceinline__ void operator()(f32x4 (&acc)[2][2][4][2], const g8::Unit& u, int wr, int wc, int fr, int fq) const {
        asm volatile("" : "+v"(fr), "+v"(fq));
        const int c0 = u.pn * 256 + wc * 32 + 8 * fq; const float* bp = b2 + (size_t)u.ex * DM + c0;
        f32x4 bb[2][2];
#pragma unroll
        for (int bj = 0; bj < 2; ++bj)
#pragma unroll
            for (int n = 0; n < 2; ++n) bb[bj][n] = *(const f32x4*)(bp + bj * 128 + 4 * n);
#pragma unroll
        for (int ai = 0; ai < 2; ++ai)
#pragma unroll
            for (int m = 0; m < 4; ++m) { const size_t slot = (size_t)u.pm * 256 + ai * 128 + wr * 64 + m * 16 + fr; const int li = list[slot]; const float gt = gslot[slot];
                if (li >= 0) { bf16_t* dst = EO + ((size_t)(li & 3) * MROWS + (li >> 2)) * DM + c0;
#pragma unroll
                    for (int bj = 0; bj < 2; ++bj) { const f32x4 v0 = (acc[ai][bj][m][0] * (1.f / WSCALE) + bb[bj][0]) * gt, v1 = (acc[ai][bj][m][1] * (1.f / WSCALE) + bb[bj][1]) * gt;
                        u32x4 w; w.x = cvt_pk_bf16(v0[0], v0[1]); w.y = cvt_pk_bf16(v0[2], v0[3]); w.z = cvt_pk_bf16(v1[0], v1[1]); w.w = cvt_pk_bf16(v1[2], v1[3]);
                        *(u32x4*)(dst + bj * 128) = w; } } }
    }
};
__device__ __forceinline__ const int* moe_tiles(Frame& F, int& nT) {
    FT_DECL;
    LAS int* TE = (LAS int*)(F.lds + RING_BYTES); const int* meta = WSP(int, WS_ROUTE + RT_META);
    __syncthreads();
    nT = meta[64]; if (nT > MAXTILE) nT = MAXTILE;
    for (int i = f_tid; i < MAXTILE; i += 512) TE[i] = (i < nT) ? meta[128 + i] : 0;
    __syncthreads();
    return (const int*)TE;
}

__device__ __forceinline__ void p10_combine(Frame& F) {
    FT_DECL;
    const float* mod = WSP(float, WS_SMALL + SM_MOD); const bf16_t* EO = WSP(bf16_t, WS_EO);
    const size_t gt = (size_t)F.vcu * 512 + f_tid, NTH = (size_t)F.G * 512;
    float pd = 0.f, pa = 0.f;
    if (MK_PROBE_A != -2) { const unsigned long long* st = (const unsigned long long*)(F.ws + WS_CTL + 8192);
        pd = (MK_PROBE_A < 0) ? 0.1f : (float)(st[MK_PA1] - st[MK_PA0]) * MK_PSA; pa = (float)(st[MK_PB1] - st[MK_PB0]) * MK_PSB; }
    constexpr int U = 4;
    for (size_t i0 = gt; i0 < (size_t)MROWS * 128; i0 += NTH * U) {
        u32x4 ev[U][4]; f32x4 xv[U][2], gv[U][2];
#pragma unroll
        for (int u = 0; u < U; ++u) { const size_t i = i0 + (size_t)u * NTH; const size_t row = i >> 7; const int c0 = (int)(i & 127) * 8;
            const float* g2 = mod + (size_t)(row >> 12) * (NMOD * DM) + 5 * DM + c0; const float* op = WSP(float, WS_XN) + row * DM + c0;
#pragma unroll
            for (int k = 0; k < 4; ++k) ev[u][k] = __builtin_nontemporal_load((const u32x4*)(EO + ((size_t)k * MROWS + row) * DM + c0));
            xv[u][0] = *(const f32x4*)op; xv[u][1] = *(const f32x4*)(op + 4); gv[u][0] = *(const f32x4*)g2; gv[u][1] = *(const f32x4*)(g2 + 4); }
#pragma unroll
        for (int u = 0; u < U; ++u) { const size_t i = i0 + (size_t)u * NTH; const size_t row = i >> 7; const int c0 = (int)(i & 127) * 8;
            float s[8];
#pragma unroll
            for (int e = 0; e < 8; ++e) s[e] = 0.f;
#pragma unroll
            for (int k = 0; k < 4; ++k) { const u32x4 v = ev[u][k];
                s[0] += __uint_as_float(v.x << 16); s[1] += __uint_as_float(v.x & 0xffff0000u); s[2] += __uint_as_float(v.y << 16); s[3] += __uint_as_float(v.y & 0xffff0000u);
                s[4] += __uint_as_float(v.z << 16); s[5] += __uint_as_float(v.z & 0xffff0000u); s[6] += __uint_as_float(v.w << 16); s[7] += __uint_as_float(v.w & 0xffff0000u); }
            f32x4 o0 = xv[u][0] + gv[u][0] * (f32x4){s[0], s[1], s[2], s[3]}, o1 = xv[u][1] + gv[u][1] * (f32x4){s[4], s[5], s[6], s[7]};
            if (MK_PROBE_A != -2) { o0 += pd; o1 += pd; if (i == 0) o0[0] += pa; }
            float* op = F.out + row * DM + c0;
            __builtin_nontemporal_store(o0, (f32x4*)op); __builtin_nontemporal_store(o1, (f32x4*)(op + 4)); }
    }
}

struct Args { const float* in[34]; float* out; unsigned char* ws; int ph_lo, ph_hi; };
constexpr int N_PHASES = 11;

__global__ void __launch_bounds__(512, 2) mega(Args args) {
    extern __shared__ __attribute__((aligned(16))) unsigned char lds[];
    Frame F;
    F.lds = (LAS unsigned char*)lds;
    F.MISC = (volatile LAS unsigned*)(F.lds + LDSCTL_OFF);
    F.wave = __builtin_amdgcn_readfirstlane(threadIdx.x >> 6);
    FT_DECL;
    F.G = gridDim.x; { const int bx = blockIdx.x; F.vcu = (F.G % 8 == 0) ? (bx % 8) * (F.G / 8) + bx / 8 : bx; }
    F.in = (kin_t)__builtin_amdgcn_kernarg_segment_ptr();
    F.out = args.out; F.ws = args.ws;
    F.ctl = (gu32*)(args.ws + WS_CTL);
    for (int u = f_tid; u < (LDS_BYTES - LDSCTL_OFF) / 4; u += NWAVES * 64) ((LAS unsigned*)(F.lds + LDSCTL_OFF))[u] = 0u;
    __syncthreads();
    const int lo = args.ph_lo, hi = args.ph_hi;
    XcdBarrier bar; bar.bar = (unsigned*)(F.ctl + CW_BAR); bar.x = 0; bar.st = nullptr;
    if (hi - lo > 1) bar = xcd_barrier_post((unsigned*)(F.ctl + CW_BAR), F.MISC + 8, f_tid == 0);
#define IN(k) (lo <= (k) && (k) < hi)
    unsigned long long* stamps = (unsigned long long*)(args.ws + WS_CTL + 8192);
#define STAMP(k) do { if (MK_PROBE_A != -2 && blockIdx.x == 0 && f_tid == 0) stamps[(k)] = __builtin_amdgcn_s_memrealtime(); } while (0)
    STAMP(0);
#define SEAM(k) do { if (IN(k) && IN((k) + 1)) xcd_barrier(bar, F.wave == 0 && lane_id() == 0); } while (0)

    if (IN(0)) { p0_prologue(F); } SEAM(0); STAMP(1);
    if (IN(1)) { p1_norm1(F); } SEAM(1); STAMP(2);
    if (IN(2)) {
        SchedInProj S{F.G, (int)blockIdx.x, (const char*)WSP(bf16_t, WS_H), (const char*)WSP(bf16_t, WS_WIN)};
        EpiInProj E{WSP(bf16_t, WS_Q), WSP(bf16_t, WS_K), WSP(bf16_t, WS_V), WSP(bf16_t, WS_UT), F.in[9], F.in[10], WSP(float, WS_SMALL + SM_ROPE)};
        g8::gemm_phase<false>(F.lds, DM, S, E, F.wave, lane_id());
    } SEAM(2); STAMP(3);
    if (IN(3)) { p3_attention(F); STAMP(12); p3_hyena(F); } SEAM(3); STAMP(4);
    if (IN(4)) { p4_hynorm(F); } SEAM(4); STAMP(5);
    if (IN(5)) {
        SchedStatic S{F.G, (int)blockIdx.x, MROWS / 256, DM / 256, (const char*)WSP(bf16_t, WS_MIX), (const char*)WSP(bf16_t, WS_WOUT)};
        EpiOutProj E{F.in[0], WSP(float, WS_XN), WSP(float, WS_SMALL + SM_MOD)};
        g8::gemm_phase<false>(F.lds, DM, S, E, F.wave, lane_id());
    } SEAM(5); STAMP(6);
    if (IN(6)) { p6_router(F); } SEAM(6); STAMP(7);
    if (IN(7)) { p7_scatter(F); } SEAM(7); STAMP(8);
    if (IN(8)) {
        int nT; const int* TE = moe_tiles(F, nT);
        SchedMoE<8> S{F.G, (int)blockIdx.x, nT, (const char*)WSP(char, WS_XS), (const char*)WSP(char, WS_W1), (size_t)2 * DM * DM, TE};
        EpiSwiGLU E{WSP(unsigned char, WS_ACT), F.in[31]};
        g8::gemm_phase<true>(F.lds, DM, S, E, F.wave, lane_id());
    } SEAM(8); STAMP(9);
    if (IN(9)) {
        int nT; const int* TE = moe_tiles(F, nT);
        SchedMoE<4> S{F.G, (int)blockIdx.x, nT, (const char*)WSP(char, WS_ACT), (const char*)WSP(char, WS_W2), (size_t)DM * DM, TE};
        EpiDown E{WSP(bf16_t, WS_EO), F.in[33], WSP(int, WS_ROUTE + RT_LIST), WSP(float, WS_ROUTE + RT_GSLOT)};
        g8::gemm_phase<true>(F.lds, DM, S, E, F.wave, lane_id());
    } SEAM(9); STAMP(10);
    if (IN(10)) { p10_combine(F); }
#undef IN
#undef SEAM
}

extern "C" void kernel_launch(void* const* d_in, const int* in_sizes, int n_in, void* d_out, int out_size, void* d_ws, size_t ws_size, hipStream_t stream) {
    static int grid = 0;
    if (grid == 0) {
        if (n_in != 34 || out_size != MROWS * DM || ws_size < WS_END) { fprintf(stderr, "kernel_launch: unexpected shapes: n_in %d out %d ws %zu (need %zu)\n", n_in, out_size, ws_size, (size_t)WS_END); grid = -1; return; }
        int dev = 0, cus = 0, per_cu = 0;
        if (hipGetDevice(&dev) != hipSuccess || hipDeviceGetAttribute(&cus, hipDeviceAttributeMultiprocessorCount, dev) != hipSuccess) { grid = -1; return; }
        if (hipFuncSetAttribute((const void*)mega, hipFuncAttributeMaxDynamicSharedMemorySize, LDS_BYTES) != hipSuccess) { fprintf(stderr, "kernel_launch: hipFuncSetAttribute failed\n"); grid = -1; return; }
        if (hipOccupancyMaxActiveBlocksPerMultiprocessor(&per_cu, (const void*)mega, NWAVES * 64, LDS_BYTES) != hipSuccess || per_cu < 1) { fprintf(stderr, "kernel_launch: occupancy query says %d\n", per_cu); per_cu = 1; }
        (void)hipGetLastError();
        grid = cus;
    }
    if (grid < 0) return;
    (void)hipMemsetAsync((char*)d_ws + WS_CTL, 0, CTL_ZERO_BYTES, stream);
    Args a{};
    for (int i = 0; i < 34; ++i) a.in[i] = (const float*)d_in[i];
    a.out = (float*)d_out; a.ws = (unsigned char*)d_ws;
    constexpr int LAST = MK_LAST_PHASE + 1;
    if (MK_N_LAUNCHES == 1) { a.ph_lo = 0; a.ph_hi = LAST; hipLaunchKernelGGL(mega, dim3(grid), dim3(NWAVES * 64), LDS_BYTES, stream, a); }
    else for (int p = 0; p < LAST; ++p) { a.ph_lo = p; a.ph_hi = p + 1; hipLaunchKernelGGL(mega, dim3(grid), dim3(NWAVES * 64), LDS_BYTES, stream, a); }
    const hipError_t le = hipPeekAtLastError();
    if (le != hipSuccess) fprintf(stderr, "kernel_launch: launch failed: %s\n", hipGetErrorName(le));
}
```

```cpp
#include <hip/hip_runtime.h>
#include <hip/hip_bf16.h>
#include <cstdio>
#include <cstdint>

#ifndef MK_N_LAUNCHES
#define MK_N_LAUNCHES 1
#endif
#ifndef MK_PROBE_A
#define MK_PROBE_A -2
#endif
#ifndef MK_PA0
#define MK_PA0 0
#define MK_PA1 1
#define MK_PB0 0
#define MK_PB1 1
#define MK_PSA 2e-6f
#define MK_PSB 1e-4f
#endif
#ifndef MK_LAST_PHASE
#define MK_LAST_PHASE 10
#endif

#define GAS __attribute__((address_space(1)))
#define LAS __attribute__((address_space(3)))
typedef unsigned short bf16_t;
typedef short bf16x8 __attribute__((ext_vector_type(8)));
typedef short s16x4 __attribute__((ext_vector_type(4)));
typedef float f32x2 __attribute__((ext_vector_type(2)));
typedef float f32x4 __attribute__((ext_vector_type(4)));
typedef float f32x16 __attribute__((ext_vector_type(16)));
typedef unsigned u32x2 __attribute__((ext_vector_type(2)));
typedef unsigned u32x4 __attribute__((ext_vector_type(4)));
typedef GAS unsigned gu32;

constexpr int NB = 8, SEQ = 4096, DM = 1024, MROWS = NB * SEQ, CTXL = 256, MCTX = NB * CTXL, MTOT = MROWS + MCTX;
constexpr int KVL = CTXL + SEQ;
constexpr int NHEAD = 4, QKW = 512;
constexpr int HYW = 512, HYC = 1536, INC = 3072, QKVC = 1536;
constexpr int NEXP = 32, TOPK = 4, NMOD = 6;
constexpr float EPS = 1e-6f;
constexpr float LAM_INIT = 0.2f;
constexpr float QSCALE = 0.125f * 1.4426950408889634f;

constexpr size_t MiB = 1u << 20;
constexpr size_t WS_CTL = 0, CTL_ZERO_BYTES = 1 * MiB;
constexpr size_t WS_SMALL = 1 * MiB;
constexpr size_t WS_WIN = 2 * MiB;
constexpr size_t WS_WOUT = 8 * MiB;
constexpr size_t WS_W1 = 10 * MiB;
constexpr size_t WS_W2 = 138 * MiB;
constexpr size_t WS_H = 202 * MiB;
constexpr size_t WS_Q = 270 * MiB;
constexpr size_t WS_K = 302 * MiB;
constexpr size_t WS_V = 336 * MiB;
constexpr size_t WS_UT = 370 * MiB;
constexpr size_t WS_FILT = 466 * MiB;
constexpr size_t WS_Z2T = 498 * MiB;
constexpr size_t WS_MIX = 530 * MiB;
constexpr size_t WS_ROUTE = 594 * MiB;
constexpr size_t WS_ACT = 270 * MiB;
constexpr size_t WS_EO = 598 * MiB;
constexpr size_t WS_XN = 870 * MiB;
constexpr size_t WS_END = 998 * MiB;
constexpr size_t SM_MOD = 0;
constexpr size_t SM_SCAL = 256 * 1024;
constexpr size_t SM_ROPE = 260 * 1024;
constexpr int CW_BAR = 4096;

constexpr int RING_BYTES = 131072;
constexpr int LDSCTL_OFF = 151552;
constexpr int LDS_BYTES = 152576;
constexpr int NWAVES = 8;

#define LDS_WAIT() asm volatile("s_waitcnt lgkmcnt(0)" ::: "memory")
#define VM_WAIT() asm volatile("s_waitcnt vmcnt(0)" ::: "memory")
#define RLX_AGENT __ATOMIC_RELAXED, __HIP_MEMORY_SCOPE_AGENT

__device__ __forceinline__ unsigned cvt_pk_bf16(float lo, float hi) { unsigned r; asm volatile("v_cvt_pk_bf16_f32 %0, %1, %2" : "=v"(r) : "v"(lo), "v"(hi)); return r; }
__device__ __forceinline__ float bf2f(bf16_t v) { return __uint_as_float(((unsigned)v) << 16); }
__device__ __forceinline__ float wave_sum(float v) {
#pragma unroll
    for (int o = 1; o < 64; o <<= 1) v += __shfl_xor(v, o);
    return v;
}

#define XB_TMO      128
#define XB_XCNT(j)  (256  + 64 * (j))
#define XB_XSUB(j)  (1280 + 64 * (j))
#define XB_XGEN(j)  (2304 + 64 * (j))
#define XB_TOP      3328
#define XB_TOPGEN   3392
#define XCD_BAR_WORDS 3456
#define XB_SPIN_CAP (1u << 22)
__device__ __forceinline__ unsigned xb_ld(unsigned* p)              { return __hip_atomic_load(p, __ATOMIC_RELAXED, __HIP_MEMORY_SCOPE_AGENT); }
__device__ __forceinline__ unsigned xb_add(unsigned* p, unsigned v) { return __hip_atomic_fetch_add(p, v, __ATOMIC_RELAXED, __HIP_MEMORY_SCOPE_AGENT); }
__device__ __forceinline__ unsigned xb_xcc_id() { return (unsigned)__builtin_amdgcn_s_getreg((3 << 11) | 20) & 0xFu; }
#define XB_SPIN(cond, bar) do { unsigned _sp = 0; while (cond) { __builtin_amdgcn_s_sleep(1); \
    if ((++_sp & 255u) == 0u) { if (xb_ld(&(bar)[XB_TMO])) break; if (_sp > XB_SPIN_CAP) { atomicAdd(&(bar)[XB_TMO], 1u); break; } } } } while (0)
struct XcdBarrier { unsigned* bar; unsigned x; volatile LAS unsigned* st; };
__device__ __forceinline__ XcdBarrier xcd_barrier_post(unsigned* bar, volatile LAS unsigned* st, bool leader) {
    XcdBarrier b; b.bar = bar; b.x = xb_xcc_id(); b.st = st;
    if (leader) (void)xb_add(&bar[XB_XCNT(b.x)], 1u);
    return b;
}
__device__ __forceinline__ void xcd_barrier_complete(unsigned* bar, unsigned x, unsigned& nloc, unsigned& nx) {
    const unsigned G = gridDim.x * gridDim.y * gridDim.z;
    unsigned sum, cnt, mine, sp = 0u;
    for (;;) {
        sum = 0u; cnt = 0u; mine = 0u;
#pragma unroll
        for (unsigned j = 0; j < 16; ++j) { const unsigned c = xb_ld(&bar[XB_XCNT(j)]); sum += c; cnt += (c > 0u) ? 1u : 0u; mine = (j == x) ? c : mine; }
        if (sum == G) break;
        __builtin_amdgcn_s_sleep(1);
        if ((++sp & 255u) == 0u) { if (xb_ld(&bar[XB_TMO])) break; if (sp > XB_SPIN_CAP) { atomicAdd(&bar[XB_TMO], 1u); break; } }
    }
    nloc = mine > 0u ? mine : 1u; nx = cnt > 0u ? cnt : 1u;
}
__device__ __forceinline__ void xcd_barrier(const XcdBarrier& b, bool leader) {
    asm volatile("s_waitcnt vmcnt(0)" ::: "memory");
    __syncthreads();
    if (leader) {
        unsigned* bar = b.bar;
        __builtin_amdgcn_s_waitcnt(0);
        unsigned nloc = b.st[0], nx = b.st[1];
        if (nloc == 0u) { xcd_barrier_complete(bar, b.x, nloc, nx); b.st[0] = nloc; b.st[1] = nx; }
        const unsigned old = xb_add(&bar[XB_XSUB(b.x)], 1u);
        const unsigned gen = old / nloc;
        if (old + 1u == (gen + 1u) * nloc) {
            __builtin_amdgcn_fence(__ATOMIC_RELEASE, "agent");
            asm volatile("s_waitcnt vmcnt(0)" ::: "memory");
            const unsigned og = xb_add(&bar[XB_TOP], 1u);
            const unsigned tg = og / nx;
            if (og + 1u == (tg + 1u) * nx) xb_add(&bar[XB_TOPGEN], 1u);
            else XB_SPIN(xb_ld(&bar[XB_TOPGEN]) == tg, bar);
            __builtin_amdgcn_fence(__ATOMIC_ACQUIRE, "agent");
            xb_add(&bar[XB_XGEN(b.x)], 1u);
            asm volatile("s_waitcnt vmcnt(0)" ::: "memory");
        } else {
            XB_SPIN(xb_ld(&bar[XB_XGEN(b.x)]) == gen, bar);
            __builtin_amdgcn_fence(__ATOMIC_ACQUIRE, "agent");
            asm volatile("s_waitcnt vmcnt(0)" ::: "memory");
        }
    }
    __syncthreads();
}

namespace g8 {
constexpr int BM = 256, BK = 64, HALF = 128, HTB = HALF * BK * 2, STAGE_BYTES = 8 * HTB, NXCD = 8, WGM = 8;
__host__ __device__ __forceinline__ int lds_byte(int r, int c) { const int st = (r >> 4) * 2 + (c >> 5), rr = r & 15, cc = c & 31, ob = rr * 64 + cc * 2; return st * 1024 + (ob ^ (((ob >> 9) & 1) << 5)); }
__host__ __device__ __forceinline__ void stage_rc(int b, int& R, int& C) { const int st = b / 1024, sb = b % 1024, swz = sb ^ (((sb >> 9) & 1) << 5); R = (st >> 1) * 16 + swz / 64; C = (st & 1) * 32 + (swz % 64) / 2; }
__host__ __device__ __forceinline__ int perm32(int rho) { const int n = rho >> 4, i = rho & 15; return 8 * (i >> 2) + 4 * n + (i & 3); }

struct Unit { const char* a; const char* b; int pm, pn, kind, ex; };

__device__ __forceinline__ void tile_of(int L, int nM, int nN, int& pm, int& pn) {
    const int nwg = nM * nN; int wgid = L;
    { const int q = nwg / NXCD, r = nwg % NXCD, xcd = wgid % NXCD, off = wgid / NXCD; wgid = (xcd < r ? xcd * (q + 1) : r * (q + 1) + (xcd - r) * q) + off; }
    const int nig = WGM * nN, gid = wgid / nig, fm = gid * WGM, gsz = (nM - fm) < WGM ? (nM - fm) : WGM;
    pm = fm + ((wgid % nig) % gsz); pn = (wgid % nig) / gsz;
}

typedef int i32x8 __attribute__((ext_vector_type(8)));
template <bool FP8, class Epi, class Sched>
__device__ __forceinline__ void gemm_phase(LAS unsigned char* lds, const int K, const Sched& S, const Epi& E, const int wid, const int lane) {
    const int tid = wid * 64 + lane, wr = wid >> 2, wc = wid & 3, fr = lane & 15, fq = lane >> 4;
    const int nt = FP8 ? K / 128 : K / BK;
    const int RP = FP8 ? K : 2 * K;
    unsigned voffA[2], voffB[2];
#pragma unroll
    for (int i = 0; i < 2; ++i) { int R, C; stage_rc(tid * 16 + i * 8192, R, C); const int Rb = (R & ~31) + perm32(R & 31);
        voffA[i] = (unsigned)(R * RP + C * 2); voffB[i] = (unsigned)(Rb * RP + C * 2); }
    const size_t kstep = (size_t)(BK * 2);
    const size_t hstep = (size_t)HALF * RP;
    const unsigned ldsw = (unsigned)wid * 1024u;
    const int aoff = lds_byte(wr * 64 + fr, FP8 ? fq * 16 : fq * 8), boff = lds_byte(wc * 32 + fr, FP8 ? fq * 16 : fq * 8);
    constexpr int KOFF = FP8 ? 16 : 1024;
#define PG8_SA(b, h) (((b) * 2 + (h)) * HTB)
#define PG8_SB(b, h) ((4 + (b) * 2 + (h)) * HTB)
#define PG8_STAGE(bufoff, gbase, voff) do { _Pragma("unroll") for (int _i = 0; _i < 2; ++_i) \
        __builtin_amdgcn_global_load_lds((const unsigned*)((const char*)(gbase) + (voff)[_i]), (LAS unsigned*)(lds + (bufoff) + ldsw + _i * 8192), 16, 0, 0); } while (0)
#define PG8_LD32(p) __builtin_bit_cast(i32x8, __builtin_shufflevector(*(const LAS u32x4*)(p), *(const LAS u32x4*)((p) + 16), 0, 1, 2, 3, 4, 5, 6, 7))
#define PG8_LDA8(dst, b, h) do { _Pragma("unroll") for (int m = 0; m < 4; ++m) dst[m] = PG8_LD32(lds + PG8_SA(b, h) + aoff + m * 2048); } while (0)
#define PG8_LDB8(dst, b, h) do { _Pragma("unroll") for (int n = 0; n < 2; ++n) dst[n] = PG8_LD32(lds + PG8_SB(b, h) + boff + n * 2048); } while (0)
#define PG8_LDA(dst, b, h) do { _Pragma("unroll") for (int m = 0; m < 4; ++m) _Pragma("unroll") for (int k = 0; k < 2; ++k) dst[m][k] = *(const LAS bf16x8*)(lds + PG8_SA(b, h) + aoff + m * 2048 + k * KOFF); } while (0)
#define PG8_LDB(dst, b, h) do { _Pragma("unroll") for (int n = 0; n < 2; ++n) _Pragma("unroll") for (int k = 0; k < 2; ++k) dst[n][k] = *(const LAS bf16x8*)(lds + PG8_SB(b, h) + boff + n * 2048 + k * KOFF); } while (0)
#define PG8_MMA(ai, bj, At, Bt) do { __builtin_amdgcn_s_setprio(1); _Pragma("unroll") for (int m = 0; m < 4; ++m) _Pragma("unroll") for (int n = 0; n < 2; ++n) _Pragma("unroll") for (int k = 0; k < 2; ++k) \
        acc[ai][bj][m][n] = __builtin_amdgcn_mfma_f32_16x16x32_bf16(Bt[n][k], At[m][k], acc[ai][bj][m][n], 0, 0, 0); __builtin_amdgcn_s_setprio(0); } while (0)
#define PG8_MMA8(ai, bj, At, Bt) do { __builtin_amdgcn_s_setprio(1); _Pragma("unroll") for (int m = 0; m < 4; ++m) _Pragma("unroll") for (int n = 0; n < 2; ++n) \
        asm volatile("v_mfma_scale_f32_16x16x128_f8f6f4 %0, %1, %2, %0, %3, %3 op_sel_hi:[0,0,0]" : "+v"(acc[ai][bj][m][n]) : "v"(Bt[n]), "v"(At[m]), "v"(one_scale)); __builtin_amdgcn_s_setprio(0); } while (0)
#define PG8_WAIT_V(n) asm volatile("s_waitcnt vmcnt(" #n ")" ::: "memory")
#define PG8_WAIT_L(n) asm volatile("s_waitcnt lgkmcnt(" #n ")" ::: "memory")
#define PG8_BAR __builtin_amdgcn_s_barrier()
#define PG8_SCHED __builtin_amdgcn_sched_barrier(0)
    Unit cur, nxt; int ui = 0;
    if (!S.next(0, cur)) return;
    f32x4 acc[2][2][4][2];
#pragma unroll
    for (int a = 0; a < 2; ++a)
#pragma unroll
        for (int b = 0; b < 2; ++b)
#pragma unroll
            for (int m = 0; m < 4; ++m)
#pragma unroll
                for (int n = 0; n < 2; ++n) acc[a][b][m][n] = (f32x4){0.f, 0.f, 0.f, 0.f};
    bf16x8 At[4][2], B0[2][2], B1[2][2];
    i32x8 At8[4], B08[2], B18[2];
    const unsigned one_scale = 0x7f7f7f7fu;
    const char* cA = cur.a; const char* cB = cur.b;
    PG8_STAGE(PG8_SB(0, 0), cB, voffB); PG8_STAGE(PG8_SB(0, 1), cB + hstep, voffB); PG8_STAGE(PG8_SA(0, 0), cA, voffA); PG8_STAGE(PG8_SA(0, 1), cA + hstep, voffA);
    if (wr == 1) PG8_BAR;
    PG8_WAIT_V(2); PG8_BAR;
    PG8_STAGE(PG8_SB(1, 0), cB + kstep, voffB); PG8_STAGE(PG8_SA(1, 0), cA + kstep, voffA); PG8_STAGE(PG8_SB(1, 1), cB + hstep + kstep, voffB);
    PG8_WAIT_V(6); PG8_BAR;
    for (;;) {
        const bool has_next = S.next(ui + 1, nxt);
        const char* nA = has_next ? nxt.a : cA; const char* nB = has_next ? nxt.b : cB;
#pragma unroll 1
        for (int t = 0; t < nt; t += 2) {
            const bool last = (t == nt - 2);
            const char* a1 = cA + (size_t)(t + 1) * kstep;
            const char* a2 = last ? nA : cA + (size_t)(t + 2) * kstep; const char* b2 = last ? nB : cB + (size_t)(t + 2) * kstep;
            const char* a3 = a2 + kstep; const char* b3 = b2 + kstep;
            if constexpr (FP8) {
            PG8_LDB8(B08, 0, 0); PG8_LDB8(B18, 0, 1); PG8_SCHED; PG8_LDA8(At8, 0, 0); PG8_STAGE(PG8_SA(1, 1), a1 + hstep, voffA);
            PG8_WAIT_V(8); PG8_WAIT_L(0); PG8_BAR; PG8_MMA8(0, 0, At8, B08); PG8_MMA8(0, 1, At8, B18); PG8_BAR; PG8_SCHED;
            PG8_LDA8(At8, 0, 1); PG8_STAGE(PG8_SB(0, 0), b2, voffB); PG8_STAGE(PG8_SB(0, 1), b2 + hstep, voffB); PG8_STAGE(PG8_SA(0, 0), a2, voffA);
            PG8_WAIT_V(8); PG8_WAIT_L(0); PG8_BAR; PG8_MMA8(1, 0, At8, B08); PG8_MMA8(1, 1, At8, B18); PG8_BAR; PG8_SCHED;
            PG8_LDB8(B08, 1, 0); PG8_LDB8(B18, 1, 1); PG8_SCHED; PG8_LDA8(At8, 1, 0); PG8_STAGE(PG8_SA(0, 1), a2 + hstep, voffA);
            PG8_WAIT_V(8); PG8_WAIT_L(0); PG8_BAR; PG8_MMA8(0, 0, At8, B08); PG8_MMA8(0, 1, At8, B18); PG8_BAR; PG8_SCHED;
            PG8_LDA8(At8, 1, 1); PG8_STAGE(PG8_SB(1, 0), b3, voffB); PG8_STAGE(PG8_SB(1, 1), b3 + hstep, voffB); PG8_STAGE(PG8_SA(1, 0), a3, voffA);
            PG8_WAIT_V(8); PG8_WAIT_L(0); PG8_BAR; PG8_MMA8(1, 0, At8, B08); PG8_MMA8(1, 1, At8, B18); PG8_BAR; PG8_SCHED;
            } else {
            PG8_LDB(B0, 0, 0); PG8_LDB(B1, 0, 1); PG8_SCHED; PG8_LDA(At, 0, 0); PG8_STAGE(PG8_SA(1, 1), a1 + hstep, voffA);
            PG8_WAIT_V(8); PG8_WAIT_L(0); PG8_BAR; PG8_MMA(0, 0, At, B0); PG8_MMA(0, 1, At, B1); PG8_BAR; PG8_SCHED;
            PG8_LDA(At, 0, 1); PG8_STAGE(PG8_SB(0, 0), b2, voffB); PG8_STAGE(PG8_SB(0, 1), b2 + hstep, voffB); PG8_STAGE(PG8_SA(0, 0), a2, voffA);
            PG8_WAIT_V(8); PG8_WAIT_L(0); PG8_BAR; PG8_MMA(1, 0, At, B0); PG8_MMA(1, 1, At, B1); PG8_BAR; PG8_SCHED;
            PG8_LDB(B0, 1, 0); PG8_LDB(B1, 1, 1); PG8_SCHED; PG8_LDA(At, 1, 0); PG8_STAGE(PG8_SA(0, 1), a2 + hstep, voffA);
            PG8_WAIT_V(8); PG8_WAIT_L(0); PG8_BAR; PG8_MMA(0, 0, At, B0); PG8_MMA(0, 1, At, B1); PG8_BAR; PG8_SCHED;
            PG8_LDA(At, 1, 1); PG8_STAGE(PG8_SB(1, 0), b3, voffB); PG8_STAGE(PG8_SB(1, 1), b3 + hstep, voffB); PG8_STAGE(PG8_SA(1, 0), a3, voffA);
            PG8_WAIT_V(8); PG8_WAIT_L(0); PG8_BAR; PG8_MMA(1, 0, At, B0); PG8_MMA(1, 1, At, B1); PG8_BAR; PG8_SCHED;
            }
        }
        if (wr == 0) PG8_BAR;
        if constexpr (FP8) asm volatile("s_nop 15\n\ts_nop 15" ::: "memory");
        E(acc, cur, wr, wc, fr, fq);
        if (!has_next) break;
#pragma unroll
        for (int a = 0; a < 2; ++a)
#pragma unroll
            for (int b = 0; b < 2; ++b)
#pragma unroll
                for (int m = 0; m < 4; ++m)
#pragma unroll
                    for (int n = 0; n < 2; ++n) acc[a][b][m][n] = (f32x4){0.f, 0.f, 0.f, 0.f};
        cur = nxt; cA = nA; cB = nB; ++ui;
        if (wr == 1) PG8_BAR;
    }
    PG8_WAIT_V(0);
    PG8_BAR;
#undef PG8_SA
#undef PG8_SB
#undef PG8_STAGE
#undef PG8_LDA
#undef PG8_LDB
#undef PG8_MMA
#undef PG8_MMA8
#undef PG8_LDA8
#undef PG8_LDB8
#undef PG8_LD32
#undef PG8_WAIT_V
#undef PG8_WAIT_L
#undef PG8_BAR
#undef PG8_SCHED
}
}

__device__ __forceinline__ int lane_id() { int l; asm volatile("v_mbcnt_lo_u32_b32 %0, -1, 0\n\tv_mbcnt_hi_u32_b32 %0, -1, %0" : "=v"(l)); return l; }
#define FT_DECL const int f_lane = lane_id(), f_tid = F.wave * 64 + f_lane; (void)f_tid; (void)f_lane
typedef const float* cfp_t;
typedef __attribute__((address_space(4))) cfp_t* kin_t;
struct Frame {
    LAS unsigned char* lds;
    volatile LAS unsigned* MISC;
    gu32* ctl;
    int wave, vcu, G;
    kin_t in;
    float* out;
    unsigned char* ws;
};
#define WSP(T, off) ((T*)(F.ws + (off)))

template <class RowMap>
__device__ __forceinline__ void p0_transpose_item(const float* W, int K, int N, bf16_t* WT, const RowMap& rowmap, const float* kscale, LAS float* scr, int item, int lane) {
    const int nblk = N / 32, kb = item / nblk, nb = item % nblk, k0 = 64 * kb, n0 = 32 * nb;
#pragma unroll 8
    for (int i = 0; i < 32; ++i) { const int kk = 2 * i + (lane >> 5); float v = W[(size_t)(k0 + kk) * N + n0 + (lane & 31)]; if (kscale) v *= kscale[k0 + kk]; scr[kk * 33 + (lane & 31)] = v; }
    LDS_WAIT(); asm volatile("" ::: "memory");
    const int c = lane & 7;
#pragma unroll
    for (int j = 0; j < 4; ++j) { const int n = (lane >> 3) + 8 * j; const LAS float* s = scr + (8 * c) * 33 + n;
        u32x4 o; o.x = cvt_pk_bf16(s[0 * 33], s[1 * 33]); o.y = cvt_pk_bf16(s[2 * 33], s[3 * 33]); o.z = cvt_pk_bf16(s[4 * 33], s[5 * 33]); o.w = cvt_pk_bf16(s[6 * 33], s[7 * 33]);
        *(GAS u32x4*)(WT + (size_t)rowmap(n0 + n) * K + k0 + 8 * c) = o; }
    LDS_WAIT(); asm volatile("" ::: "memory");
}

__device__ __forceinline__ unsigned pk4_fp8(float a, float b, float c, float d) { int r = __builtin_amdgcn_cvt_pk_fp8_f32(a, b, 0, false); r = __builtin_amdgcn_cvt_pk_fp8_f32(c, d, r, true); return (unsigned)r; }
constexpr float EOSCALE = 16.f;
constexpr float WSCALE = 32.f;
template <class RowMap>
__device__ __forceinline__ void p0_transpose_item_f8(const float* W, int K, int N, unsigned char* WT, const RowMap& rowmap, LAS float* scr, int item, int lane) {
    const int nblk = N / 32, kb = item / nblk, nb = item % nblk, k0 = 128 * kb, n0 = 32 * nb;
#pragma unroll
    for (int hh = 0; hh < 2; ++hh) { float v[32];
#pragma unroll
        for (int i = 0; i < 32; ++i) { const int kk = 2 * (32 * hh + i) + (lane >> 5); v[i] = __builtin_nontemporal_load(W + (size_t)(k0 + kk) * N + n0 + (lane & 31)); }
#pragma unroll
        for (int i = 0; i < 32; ++i) { const int kk = 2 * (32 * hh + i) + (lane >> 5); scr[kk * 33 + (lane & 31)] = v[i] * WSCALE; } }
    LDS_WAIT(); asm volatile("" ::: "memory");
    const int c = lane & 7;
#pragma unroll
    for (int j = 0; j < 4; ++j) { const int n = (lane >> 3) + 8 * j; const LAS float* sp = scr + (16 * c) * 33 + n;
        u32x4 o; o.x = pk4_fp8(sp[0 * 33], sp[1 * 33], sp[2 * 33], sp[3 * 33]); o.y = pk4_fp8(sp[4 * 33], sp[5 * 33], sp[6 * 33], sp[7 * 33]);
        o.z = pk4_fp8(sp[8 * 33], sp[9 * 33], sp[10 * 33], sp[11 * 33]); o.w = pk4_fp8(sp[12 * 33], sp[13 * 33], sp[14 * 33], sp[15 * 33]);
        *(GAS u32x4*)(WT + (size_t)rowmap(n0 + n) * K + k0 + 16 * c) = o; }
    LDS_WAIT(); asm volatile("" ::: "memory");
}
struct MapIdent { int off; __device__ __forceinline__ int operator()(int n) const { return off + n; } };
struct MapWin { __device__ __forceinline__ int operator()(int l) const {
    if (l >= QKVC) return l;
    const int t = l & ~255, r = l & 255, wc = r >> 6, blk = (r >> 5) & 1, bj = (r >> 4) & 1, low = r & 15;
    return t + 128 * bj + 32 * wc + 16 * blk + low; } };
struct MapW1 { int off; __device__ __forceinline__ int operator()(int jp) const { const int bj = jp >> 10, j = jp & 1023; return off + 256 * (j >> 7) + 128 * bj + (j & 127); } };


__device__ __forceinline__ void p0_filter_item(Frame& F, int item) {
    FT_DECL;
#define in F.in
    LAS float* h1s = (LAS float*)(F.lds);
    LAS float* h2s = (LAS float*)(F.lds + 4096);
    const int t0 = item * 16;
    {
        const int tt = f_tid >> 5, hh = (f_tid & 31) * 2; const float pos = (float)(t0 + tt);
        float feats[17]; feats[0] = pos * (1.f / SEQ);
#pragma unroll
        for (int i = 0; i < 8; ++i) { const float band = 1e-4f + (float)i * ((7.f - 1e-4f) / 7.f); const float ang = (6.283185307179586f / SEQ) * pos * band; feats[1 + i] = sinf(ang); feats[9 + i] = cosf(ang); }
#pragma unroll
        for (int u = 0; u < 2; ++u) { const int h = hh + u; float a = in[19][h];
#pragma unroll
            for (int k = 0; k < 17; ++k) a += feats[k] * in[18][k * 64 + h];
            h1s[tt * 64 + h] = sinf(in[20][h] * a); }
        __syncthreads();
#pragma unroll
        for (int u = 0; u < 2; ++u) { const int h = hh + u; float a = in[22][h];
#pragma unroll 8
            for (int k = 0; k < 64; ++k) a += h1s[tt * 64 + k] * in[21][k * 64 + h];
            h2s[tt * 64 + h] = sinf(in[23][h] * a); }
        __syncthreads();
    }
    f32x4 acc[16];
#pragma unroll
    for (int t = 0; t < 16; ++t) acc[t] = (f32x4){0.f, 0.f, 0.f, 0.f};
    const int o = 4 * f_tid;
    for (int k = 0; k < 64; ++k) { const f32x4 w = *(const f32x4*)(in[24] + (size_t)k * 2048 + o);
#pragma unroll
        for (int t = 0; t < 16; ++t) acc[t] += w * h2s[t * 64 + k]; }
    const int c0 = o & 511, od = o >> 9;
    float* dst = WSP(float, WS_FILT) + ((size_t)od * 512 + c0) * SEQ + t0;
#pragma unroll
    for (int e = 0; e < 4; ++e) { const float la = -3.0701134573253944f, lb = -15.350567286626972f; const float delta = fabsf(la + (float)(c0 + e) * ((lb - la) / 511.f));
#pragma unroll
        for (int q = 0; q < 4; ++q) { f32x4 v;
#pragma unroll
            for (int i = 0; i < 4; ++i) { const int t = 4 * q + i; const float tn = (float)(t0 + t) * (1.f / SEQ); v[i] = acc[t][e] * expf(-tn * delta); }
            *(f32x4*)(dst + (size_t)e * SEQ + 4 * q) = v; } }
    __syncthreads();
#undef in
}

__device__ __forceinline__ float silu_f(float v) { return v / (1.f + __expf(-v)); }

__device__ __forceinline__ void p0_prologue(Frame& F) {
    FT_DECL;
#define in F.in
    const int wg = blockIdx.x;
    if (wg < 96) {
        LAS float* sv = (LAS float*)F.lds;
        for (int i = f_tid; i < 9 * 1024; i += 512) { const int r = i >> 10, k = i & 1023; const float c = (r < 8) ? in[1][r * 1024 + k] : in[3][k]; sv[i] = silu_f(c); }
        __syncthreads();
        const int j = wg * 64 + f_lane; const float* wm = in[4];
        float acc[9];
#pragma unroll
        for (int r = 0; r < 9; ++r) acc[r] = 0.f;
        const int kbeg = F.wave * 128;
#pragma unroll 4
        for (int k = kbeg; k < kbeg + 128; ++k) { const float w = wm[(size_t)k * (NMOD * DM) + j];
#pragma unroll
            for (int r = 0; r < 9; ++r) acc[r] += sv[r * 1024 + k] * w; }
        LAS float* red = (LAS float*)(F.lds + 40960);
#pragma unroll
        for (int r = 0; r < 9; ++r) red[(F.wave * 9 + r) * 64 + f_lane] = acc[r];
        __syncthreads();
        for (int i = f_tid; i < 9 * 64; i += 512) { const int r = i >> 6, l = i & 63; float s = in[5][wg * 64 + l];
#pragma unroll
            for (int w = 0; w < 8; ++w) s += red[(w * 9 + r) * 64 + l];
            WSP(float, WS_SMALL + SM_MOD)[r * (NMOD * DM) + wg * 64 + l] = s; }
        __syncthreads();
    } else if (wg == 96) {
        if (F.wave == 0) {
            const float a = wave_sum(in[11][f_lane] * in[12][f_lane]), b = wave_sum(in[13][f_lane] * in[14][f_lane]);
            float gq = fabsf(in[9][f_lane]), gk = fabsf(in[10][f_lane]);
#pragma unroll
            for (int o = 1; o < 64; o <<= 1) { gq = fmaxf(gq, __shfl_xor(gq, o)); gk = fmaxf(gk, __shfl_xor(gk, o)); }
            if (f_lane == 0) { float* sc = WSP(float, WS_SMALL + SM_SCAL); sc[0] = expf(a) - expf(b) + LAM_INIT;
                sc[1] = (8.f * gq * gk * 1.02f + 0.05f) * 1.4426950408889634f; }
        }
        for (int i = f_tid; i < 64 * 16; i += 512) { const int pos = i >> 4, f = i & 15;
            const float inv = powf(10000.f, -(float)f / 16.f); const float ang = (float)pos * inv;
            float* rt = WSP(float, WS_SMALL + SM_ROPE); rt[2 * i] = cosf(ang); rt[2 * i + 1] = sinf(ang); }
    }
    __syncthreads();
    for (int it = wg; it < SEQ / 16; it += F.G) p0_filter_item(F, it);
    __syncthreads();
    {
        LAS float* scr = (LAS float*)(F.lds + F.wave * 16896);
        const int gw = F.vcu * NWAVES + F.wave, NGW = F.G * NWAVES;
        constexpr int I_IN = (DM / 64) * (INC / 32), I_OUT = (DM / 64) * (DM / 32), I_1 = (DM / 128) * (2 * DM / 32), I_2 = (DM / 128) * (DM / 32);
        constexpr int NITEMS = I_IN + I_OUT + NEXP * (I_1 + I_2);
        for (int it = gw; it < NITEMS; it += NGW) {
            int r = it;
            if (r < I_IN) { p0_transpose_item(in[8], DM, INC, WSP(bf16_t, WS_WIN), MapWin{}, nullptr, scr, r, f_lane); continue; } r -= I_IN;
            if (r < I_OUT) { p0_transpose_item(in[27], DM, DM, WSP(bf16_t, WS_WOUT), MapIdent{0}, nullptr, scr, r, f_lane); continue; } r -= I_OUT;
            const int e = r / (I_1 + I_2); r -= e * (I_1 + I_2);
            if (r < I_1) p0_transpose_item_f8(in[30] + (size_t)e * DM * 2 * DM, DM, 2 * DM, WSP(unsigned char, WS_W1) + (size_t)e * 2 * DM * DM, MapW1{0}, scr, r, f_lane);
            else p0_transpose_item_f8(in[32] + (size_t)e * DM * DM, DM, DM, WSP(unsigned char, WS_W2) + (size_t)e * DM * DM, MapIdent{0}, scr, r - I_1, f_lane);
        }
    }
}
#undef in

__device__ __forceinline__ void p1_norm1(Frame& F) {
    FT_DECL;
    const int gw = F.vcu * NWAVES + F.wave, NGW = F.G * NWAVES;
    const float* mod = WSP(float, WS_SMALL + SM_MOD); const float* g1 = F.in[6];
    bf16_t* H = WSP(bf16_t, WS_H);
    for (int m = gw; m < MTOT; m += NGW) {
        const float* xrow = (m < MROWS) ? F.in[0] + (size_t)m * DM : F.in[2] + (size_t)(m - MROWS) * DM;
        const int mb = (m < MROWS) ? (m >> 12) : 8;
        const float* sh = mod + (size_t)mb * (NMOD * DM); const float* sc = sh + DM;
        const GAS f32x4* xr = (const GAS f32x4*)xrow + f_lane;
        f32x4 v[4]; float s = 0.f;
#pragma unroll
        for (int j = 0; j < 4; ++j) { v[j] = xr[64 * j]; s += (v[j].x * v[j].x + v[j].y * v[j].y) + (v[j].z * v[j].z + v[j].w * v[j].w); }
        const float rstd = rsqrtf(wave_sum(s) * (1.f / DM) + EPS);
        GAS u32x2* o8 = (GAS u32x2*)(H + (size_t)m * DM) + f_lane;
#pragma unroll
        for (int j = 0; j < 4; ++j) { const int c = 4 * f_lane + 256 * j;
            const f32x4 g = *(const f32x4*)(g1 + c), a = *(const f32x4*)(sc + c), b = *(const f32x4*)(sh + c);
            const f32x4 y = v[j] * rstd * g * (a + 1.f) + b;
            u32x2 w; w.x = cvt_pk_bf16(y.x, y.y); w.y = cvt_pk_bf16(y.z, y.w); o8[64 * j] = w; }
    }
}

struct SchedInProj {
    int G, c; const char* H; const char* W;
    static constexpr int NA = 136 * 6, NBU = 6 * 128;
    __device__ __forceinline__ bool next(int i, g8::Unit& u) const {
        const long L = (long)i * G + c;
        if (L < NA) { g8::tile_of((int)L, 136, 6, u.pm, u.pn); u.a = H + (size_t)u.pm * 256 * DM * 2; u.b = W + (size_t)u.pn * 256 * DM * 2; u.kind = 0; u.ex = 0; return true; }
        if (L < NA + NBU) { g8::tile_of((int)L - NA, 6, 128, u.pm, u.pn); u.a = W + (size_t)(QKVC + u.pm * 256) * DM * 2; u.b = H + (size_t)u.pn * 256 * DM * 2; u.kind = 1; u.ex = 0; return true; }
        return false;
    }
};
struct EpiInProj {
    bf16_t *Q, *Kb, *Vb, *UT; const float *gq, *gk, *rope;
    __device__ __forceinline__ void operator()(f32x4 (&acc)[2][2][4][2], const g8::Unit& u, int wr, int wc, int fr, int fq) const {
        if (u.kind == 1) {
            const int row0 = u.pm * 256 + wr * 64 + fr, col0 = u.pn * 256 + wc * 32 + 8 * fq;
#pragma unroll
            for (int ai = 0; ai < 2; ++ai)
#pragma unroll
                for (int m = 0; m < 4; ++m) { bf16_t* rowp = UT + (size_t)(row0 + ai * 128 + m * 16) * MROWS + col0;
#pragma unroll
                    for (int bj = 0; bj < 2; ++bj) { const f32x4 v0 = acc[ai][bj][m][0], v1 = acc[ai][bj][m][1];
                        u32x4 w; w.x = cvt_pk_bf16(v0[0], v0[1]); w.y = cvt_pk_bf16(v0[2], v0[3]); w.z = cvt_pk_bf16(v1[0], v1[1]); w.w = cvt_pk_bf16(v1[2], v1[3]);
                        *(u32x4*)(rowp + bj * 128) = w; } }
            return;
        }
        const int blk = fq >> 1, f = fq & 1;
        const int sec = u.pn >> 1;
        const bool ctx = (u.pm >= 128);
        if (sec == 0 && ctx) return;
        const int colbase = (u.pn & 1) * 256 + wc * 64 + 32 * blk + 8 * f;
        float gg[2][2][4];
        if (sec < 2) { const float* gp = (sec == 0 ? gq : gk) + 32 * blk + 8 * f;
#pragma unroll
            for (int bj = 0; bj < 2; ++bj)
#pragma unroll
                for (int n = 0; n < 2; ++n) { const f32x4 t = *(const f32x4*)(gp + 16 * bj + 4 * n); gg[bj][n][0] = t[0]; gg[bj][n][1] = t[1]; gg[bj][n][2] = t[2]; gg[bj][n][3] = t[3]; } }
#pragma unroll
        for (int ai = 0; ai < 2; ++ai)
#pragma unroll
            for (int m = 0; m < 4; ++m) {
                const int rloc = ai * 128 + wr * 64 + m * 16 + fr; const int r = u.pm * 256 + rloc;
                f32x4 v[2][2];
#pragma unroll
                for (int bj = 0; bj < 2; ++bj)
#pragma unroll
                    for (int n = 0; n < 2; ++n) v[bj][n] = acc[ai][bj][m][n];
                size_t orow;
                if (sec == 0) orow = (size_t)r;
                else if (!ctx) orow = (size_t)(r >> 12) * KVL + CTXL + (r & 4095);
                else { const int j = r - MROWS; orow = (size_t)(j >> 8) * KVL + (j & 255); }
                if (sec < 2) {
                    float ss = 0.f;
#pragma unroll
                    for (int bj = 0; bj < 2; ++bj)
#pragma unroll
                        for (int n = 0; n < 2; ++n) ss += (v[bj][n][0] * v[bj][n][0] + v[bj][n][1] * v[bj][n][1]) + (v[bj][n][2] * v[bj][n][2] + v[bj][n][3] * v[bj][n][3]);
                    ss += __shfl_xor(ss, 16); ss += __shfl_xor(ss, 32);
                    const float rstd = rsqrtf(ss * (1.f / 64.f) + EPS);
#pragma unroll
                    for (int bj = 0; bj < 2; ++bj)
#pragma unroll
                        for (int n = 0; n < 2; ++n)
#pragma unroll
                            for (int e = 0; e < 4; ++e) v[bj][n][e] *= rstd * gg[bj][n][e];
                    if (!ctx) {
                        const int t = r & 4095; const int pos = blk ? (t & 63) : (t >> 6);
                        const float* rp = rope + (size_t)(pos * 16 + 8 * f) * 2;
#pragma unroll
                        for (int n = 0; n < 2; ++n) { const f32x4 c0 = *(const f32x4*)(rp + 8 * n), c1 = *(const f32x4*)(rp + 8 * n + 4);
                            const float cs[4] = {c0[0], c0[2], c1[0], c1[2]}, sn[4] = {c0[1], c0[3], c1[1], c1[3]};
#pragma unroll
                            for (int e = 0; e < 4; ++e) { const float x1 = v[0][n][e], x2 = v[1][n][e]; v[0][n][e] = x1 * cs[e] - x2 * sn[e]; v[1][n][e] = x2 * cs[e] + x1 * sn[e]; } }
                    }
                    if (sec == 0) {
#pragma unroll
                        for (int bj = 0; bj < 2; ++bj)
#pragma unroll
                            for (int n = 0; n < 2; ++n) v[bj][n] *= QSCALE;
                    }
                }
                bf16_t* dst = (sec == 0 ? Q : (sec == 1 ? Kb : Vb)) + orow * QKW + colbase;
#pragma unroll
                for (int bj = 0; bj < 2; ++bj) { u32x4 w; w.x = cvt_pk_bf16(v[bj][0][0], v[bj][0][1]); w.y = cvt_pk_bf16(v[bj][0][2], v[bj][0][3]); w.z = cvt_pk_bf16(v[bj][1][0], v[bj][1][1]); w.w = cvt_pk_bf16(v[bj][1][2], v[bj][1][3]);
                    *(u32x4*)(dst + 16 * bj) = w; }
            }
    }
};

struct SchedStatic {
    int G, c, nM, nN; const char* A; const char* B;
    __device__ __forceinline__ bool next(int i, g8::Unit& u) const {
        const long L = (long)i * G + c; if (L >= (long)nM * nN) return false;
        g8::tile_of((int)L, nM, nN, u.pm, u.pn); u.a = A + (size_t)u.pm * 256 * DM * 2; u.b = B + (size_t)u.pn * 256 * DM * 2; u.kind = 0; u.ex = 0; return true;
    }
};
struct EpiOutProj {
    const float* x; float* out; const float* mod;
    __device__ __forceinline__ void operator()(f32x4 (&acc)[2][2][4][2], const g8::Unit& u, int wr, int wc, int fr, int fq) const {
        const int col0 = u.pn * 256 + wc * 32 + 8 * fq;
#pragma unroll
        for (int ai = 0; ai < 2; ++ai)
#pragma unroll
            for (int m = 0; m < 4; ++m) { const int r = u.pm * 256 + ai * 128 + wr * 64 + m * 16 + fr; const float* g1 = mod + (size_t)(r >> 12) * (NMOD * DM) + 2 * DM;
                const size_t off = (size_t)r * DM + col0;
#pragma unroll
                for (int bj = 0; bj < 2; ++bj)
#pragma unroll
                    for (int n = 0; n < 2; ++n) { const int c = bj * 128 + 4 * n; const f32x4 xv = *(const f32x4*)(x + off + c), gv = *(const f32x4*)(g1 + col0 + c);
                        *(f32x4*)(out + off + c) = xv + gv * acc[ai][bj][m][n]; } }
    }
};

namespace att {
constexpr int KVBLK = 64, LDK = QKW, NT = KVL / KVBLK;
constexpr int SHM_V = KVBLK * 128 * 2, SHM_K = KVBLK * 128 * 2;
#define KSWZ(row, colB) ((row) * 256 + ((colB) ^ (((row) & 7) << 4)))
#define SBAR() __builtin_amdgcn_sched_barrier(0)
__device__ __forceinline__ int crow(int r, int hi) { return (r & 3) + 8 * (r >> 2) + 4 * hi; }
__device__ __forceinline__ void expA(f32x16& p) {
#pragma unroll
    for (int r = 0; r < 16; ++r) p[r] = __builtin_amdgcn_exp2f(p[r]);
}
__device__ __forceinline__ void finishSM(f32x16& p0, f32x16& p1, float& l_reg, bf16x8& pa0, bf16x8& pa1, bf16x8& pa2, bf16x8& pa3) {
#pragma unroll
    for (int r = 0; r < 16; ++r) p1[r] = __builtin_amdgcn_exp2f(p1[r]);
    float ps = 0;
#pragma unroll
    for (int r = 0; r < 16; ++r) ps += p0[r];
#pragma unroll
    for (int r = 0; r < 16; ++r) ps += p1[r];
    { auto rr = __builtin_amdgcn_permlane32_swap(__float_as_uint(ps), __float_as_uint(ps), false, false); ps = __uint_as_float(rr[0]) + __uint_as_float(rr[1]); }
    l_reg += ps;
#define PK4(P, BASE, OUT) do { unsigned a0 = cvt_pk_bf16(P[BASE + 0], P[BASE + 1]), a1 = cvt_pk_bf16(P[BASE + 2], P[BASE + 3]);   \
    unsigned b0 = cvt_pk_bf16(P[BASE + 4], P[BASE + 5]), b1 = cvt_pk_bf16(P[BASE + 6], P[BASE + 7]);                              \
    auto r0 = __builtin_amdgcn_permlane32_swap(a0, b0, false, false); auto r1 = __builtin_amdgcn_permlane32_swap(a1, b1, false, false); \
    u32x4 w = {r0[0], r1[0], r0[1], r1[1]}; OUT = *reinterpret_cast<bf16x8*>(&w); } while (0)
    PK4(p0, 0, pa0); PK4(p0, 8, pa1); PK4(p1, 0, pa2); PK4(p1, 8, pa3);
#undef PK4
}
__device__ __forceinline__ void qkt(f32x16& p0, f32x16& p1, const char* Ks, const bf16x8* qr, int r32, int hi, int sub, float negm) {
    (void)negm;
    const f32x16 z = {};
#pragma unroll
    for (int d0 = 0; d0 < 4; ++d0) { const int cb = (sub * 64 + d0 * 16 + hi * 8) * 2;
        const bf16x8 b0 = *reinterpret_cast<const bf16x8*>(Ks + KSWZ(r32, cb));
        const bf16x8 b1 = *reinterpret_cast<const bf16x8*>(Ks + KSWZ(32 + r32, cb));
        p0 = __builtin_amdgcn_mfma_f32_32x32x16_bf16(b0, qr[d0], d0 ? p0 : z, 0, 0, 0);
        p1 = __builtin_amdgcn_mfma_f32_32x32x16_bf16(b1, qr[d0], d0 ? p1 : z, 0, 0, 0); }
}
__device__ __forceinline__ int v_st(int k, int c) { const int kk = (k & ~0xC) | ((k & 4) << 1) | ((k & 8) >> 1); return ((kk >> 3) * 4 + (c >> 5)) * 512 + ((kk & 7) * 32 + (c & 31)) * 2; }
__device__ __forceinline__ int v_rd_base(int lane) { return ((lane & 3) << 3) | (((lane >> 2) & 3) << 6) | (((lane >> 4) & 1) << 5) | (((lane >> 5) & 1) << 8); }
constexpr int v_rd_off(int d0, int ks, int half) { return d0 * 512 + ks * 4096 + half * 2048; }
template <int OFF> __device__ __forceinline__ s16x4 tr_read(int vb) {
    s16x4 r; asm volatile("ds_read_b64_tr_b16 %0, %1 offset:%2" : "=&v"(r) : "v"(vb), "i"(OFF) : "memory"); return r;
}
template <int D0> __device__ __forceinline__ void pv_one(f32x16& od, int vb, bf16x8 pa0, bf16x8 pa1, bf16x8 pa2, bf16x8 pa3) {
    const s16x4 l0 = tr_read<v_rd_off(D0, 0, 0)>(vb), h0 = tr_read<v_rd_off(D0, 0, 1)>(vb), l1 = tr_read<v_rd_off(D0, 1, 0)>(vb), h1 = tr_read<v_rd_off(D0, 1, 1)>(vb);
    const s16x4 l2 = tr_read<v_rd_off(D0, 2, 0)>(vb), h2 = tr_read<v_rd_off(D0, 2, 1)>(vb), l3 = tr_read<v_rd_off(D0, 3, 0)>(vb), h3 = tr_read<v_rd_off(D0, 3, 1)>(vb);
    asm volatile("s_waitcnt lgkmcnt(0)" ::: "memory"); SBAR();
#define PK(L, H) (bf16x8){L[0], L[1], L[2], L[3], H[0], H[1], H[2], H[3]}
    od = __builtin_amdgcn_mfma_f32_32x32x16_bf16(pa0, PK(l0, h0), od, 0, 0, 0);
    od = __builtin_amdgcn_mfma_f32_32x32x16_bf16(pa1, PK(l1, h1), od, 0, 0, 0);
    od = __builtin_amdgcn_mfma_f32_32x32x16_bf16(pa2, PK(l2, h2), od, 0, 0, 0);
    od = __builtin_amdgcn_mfma_f32_32x32x16_bf16(pa3, PK(l3, h3), od, 0, 0, 0);
#undef PK
}
__device__ __forceinline__ void pv_d0(f32x16* o, int vb, bf16x8 pa0, bf16x8 pa1, bf16x8 pa2, bf16x8 pa3) {
    pv_one<0>(o[0], vb, pa0, pa1, pa2, pa3); pv_one<1>(o[1], vb, pa0, pa1, pa2, pa3); pv_one<2>(o[2], vb, pa0, pa1, pa2, pa3); pv_one<3>(o[3], vb, pa0, pa1, pa2, pa3);
}

__device__ __forceinline__ void attn_unit(const bf16_t* __restrict__ Qb, const bf16_t* __restrict__ Kh, const bf16_t* __restrict__ Vh, bf16_t* MIXo,
                                          const float lam, const float negm, const float* __restrict__ subg, char* lds, const int wid) {
    const int lane = lane_id(), tid = wid * 64 + lane, r32 = lane & 31, hi = lane >> 5;
    const int sub = wid >> 2, wq = wid & 3;
    char* V_lds = lds; char* K_lds = lds + 2 * SHM_V;
    float* wsf = (float*)(lds + 98304) + wid * 32;
    float l_reg = 0; f32x16 o[4] = {}; bf16x8 qr[4];
    const bf16_t* Qw = Qb + (long)(wq * 32 + r32) * LDK + sub * 64 + hi * 8;
#pragma unroll
    for (int d0 = 0; d0 < 4; ++d0) qr[d0] = *reinterpret_cast<const bf16x8*>(Qw + d0 * 16);
    const int sr = tid >> 4, sc = (tid & 15) * 8, vst0 = v_st(sr, sc), vst1 = v_st(32 + sr, sc);
    const int vb0 = (int)(uintptr_t)V_lds + v_rd_base(lane);
    struct { bf16x8 vs0, vs1, ks0, ks1; } sr_[2];
#define SLOAD(i, k0) do { sr_[i].vs0 = *(const bf16x8*)(&Vh[(long)((k0) + sr) * LDK + sc]); sr_[i].vs1 = *(const bf16x8*)(&Vh[(long)((k0) + 32 + sr) * LDK + sc]); \
    sr_[i].ks0 = *(const bf16x8*)(&Kh[(long)((k0) + sr) * LDK + sc]); sr_[i].ks1 = *(const bf16x8*)(&Kh[(long)((k0) + 32 + sr) * LDK + sc]); } while (0)
#define SWRITE(b, i) do { *(bf16x8*)(V_lds + (b) * SHM_V + vst0) = sr_[i].vs0;          \
    *(bf16x8*)(V_lds + (b) * SHM_V + vst1) = sr_[i].vs1; const int kc = sc * 2;               \
    *(bf16x8*)(K_lds + (b) * SHM_K + KSWZ(sr, kc)) = sr_[i].ks0;                       \
    *(bf16x8*)(K_lds + (b) * SHM_K + KSWZ(32 + sr, kc)) = sr_[i].ks1; } while (0)
#define SWAIT() asm volatile("s_waitcnt vmcnt(4)" ::: "memory")
    f32x16 pA0, pA1, pB0, pB1; bf16x8 pa0, pa1, pa2, pa3;
    constexpr int SE = 0, SO = 1;
    SLOAD(SE, 0); asm volatile("s_waitcnt vmcnt(0)" ::: "memory"); SWRITE(0, SE); __syncthreads();
    qkt(pA0, pA1, K_lds, qr, r32, hi, sub, negm); expA(pA0);
    SLOAD(SO, KVBLK); SLOAD(SE, 2 * KVBLK);
    SWAIT(); SWRITE(1, SO); __syncthreads();
    for (int j = 1; j + 1 < NT; j += 2) {
        SBAR(); qkt(pB0, pB1, K_lds + SHM_K, qr, r32, hi, sub, negm);
        finishSM(pA0, pA1, l_reg, pa0, pa1, pa2, pa3); SBAR();
        SLOAD(SO, (j + 2) * KVBLK); SBAR();
        pv_d0(o, vb0, pa0, pa1, pa2, pa3); expA(pB0);
        __syncthreads(); SWAIT(); SWRITE(0, SE);
        __syncthreads();
        SBAR(); qkt(pA0, pA1, K_lds, qr, r32, hi, sub, negm);
        finishSM(pB0, pB1, l_reg, pa0, pa1, pa2, pa3); SBAR();
        if (j + 3 < NT) SLOAD(SE, (j + 3) * KVBLK); SBAR();
        pv_d0(o, vb0 + SHM_V, pa0, pa1, pa2, pa3); expA(pA0);
        __syncthreads(); SWAIT(); SWRITE(1, SO);
        __syncthreads();
    }
    SBAR(); qkt(pB0, pB1, K_lds + SHM_K, qr, r32, hi, sub, negm);
    finishSM(pA0, pA1, l_reg, pa0, pa1, pa2, pa3); SBAR();
    pv_d0(o, vb0, pa0, pa1, pa2, pa3); expA(pB0);
    finishSM(pB0, pB1, l_reg, pa0, pa1, pa2, pa3); SBAR();
    pv_d0(o, vb0 + SHM_V, pa0, pa1, pa2, pa3);
#undef SLOAD
#undef SWRITE
#undef SWAIT
    if (hi == 0) wsf[r32] = l_reg;
    __syncthreads();
    float* X = (float*)lds;
    float rli[16];
#pragma unroll
    for (int r = 0; r < 16; ++r) rli[r] = __builtin_amdgcn_rcpf(wsf[crow(r, hi)]);
    if (sub == 1) {
#pragma unroll
        for (int r = 0; r < 16; ++r) { const int row = wq * 32 + crow(r, hi); const float s = lam * rli[r];
#pragma unroll
            for (int d0 = 0; d0 < 4; ++d0) X[row * 128 + d0 * 32 + r32] = o[d0][r] * s; }
    }
    __syncthreads();
    bf16_t* Y = (bf16_t*)(lds + 65536);
    if (sub == 0) {
        float sg[4];
#pragma unroll
        for (int d0 = 0; d0 < 4; ++d0) sg[d0] = subg[d0 * 32 + r32] * (1.f - LAM_INIT);
#pragma unroll
        for (int r = 0; r < 16; ++r) { const int row = wq * 32 + crow(r, hi);
            float v[4]; float ss = 0.f;
#pragma unroll
            for (int d0 = 0; d0 < 4; ++d0) { v[d0] = o[d0][r] * rli[r] - X[row * 128 + d0 * 32 + r32]; ss += v[d0] * v[d0]; }
            ss += __shfl_xor(ss, 1); ss += __shfl_xor(ss, 2); ss += __shfl_xor(ss, 4); ss += __shfl_xor(ss, 8); ss += __shfl_xor(ss, 16);
            const float rstd = rsqrtf(ss * (1.f / 128.f) + EPS);
#pragma unroll
            for (int d0 = 0; d0 < 4; ++d0) Y[row * 128 + d0 * 32 + r32] = (bf16_t)(cvt_pk_bf16(v[d0] * rstd * sg[d0], 0.f) & 0xffffu); }
    }
    __syncthreads();
    { const int row = tid >> 2, seg = (tid & 3) * 32;
#pragma unroll
        for (int i = 0; i < 4; ++i) { const u32x4 v = *(const u32x4*)(Y + row * 128 + seg + i * 8); *(u32x4*)(MIXo + (size_t)row * DM + seg + i * 8) = v; } }
    __syncthreads();
}
#undef KSWZ
#undef SBAR
}

__device__ __forceinline__ void p3_attention(Frame& F) {
    FT_DECL;
    const float* sc = WSP(float, WS_SMALL + SM_SCAL);
    const float lam = sc[0], negm = -sc[1];
    const bf16_t* Q = WSP(bf16_t, WS_Q); const bf16_t* Kb = WSP(bf16_t, WS_K); const bf16_t* Vb = WSP(bf16_t, WS_V); bf16_t* MIX = WSP(bf16_t, WS_MIX);
    const int c = blockIdx.x, xcd = c & 7, ci = c >> 3, per = F.G >> 3;
    for (int j = ci; j < 128; j += per) {
        const int pair = xcd * 4 + (j >> 5), qb = j & 31, b = pair >> 2, h = pair & 3;
        att::attn_unit(Q + ((size_t)b * SEQ + qb * 128) * QKW + h * 128, Kb + (size_t)b * KVL * QKW + h * 128, Vb + (size_t)b * KVL * QKW + h * 128,
                       MIX + ((size_t)b * SEQ + qb * 128) * DM + h * 128, lam, negm, F.in[15], (char*)F.lds, F.wave);
    }
}


namespace hy {
constexpr int RB_BYTES = 4352 * 8, IN_OFF = 2 * RB_BYTES, TW1_OFF = IN_OFF + 32768, TW2_OFF = TW1_OFF + 15 * 256 * 8, LDS_END = TW2_OFF + 15 * 16 * 8;
__device__ __forceinline__ f32x2 cmul(f32x2 a, f32x2 b) { return (f32x2){a.x * b.x - a.y * b.y, a.x * b.y + a.y * b.x}; }
__device__ __forceinline__ f32x2 cmulc(f32x2 a, f32x2 b) { return (f32x2){a.x * b.x + a.y * b.y, a.y * b.x - a.x * b.y}; }
__device__ __forceinline__ int P(int i) { return i + (i >> 4); }
template <bool INV> __device__ __forceinline__ void r4(f32x2& a, f32x2& b, f32x2& c, f32x2& d) {
    const f32x2 t0 = a + c, t1 = a - c, t2 = b + d, t3 = b - d;
    const f32x2 st3 = INV ? (f32x2){-t3.y, t3.x} : (f32x2){t3.y, -t3.x};
    a = t0 + t2; c = t0 - t2; b = t1 + st3; d = t1 - st3;
}
template <bool INV> __device__ __forceinline__ f32x2 tw(f32x2 v, float c, float s) {
    return INV ? (f32x2){v.x * c - v.y * s, v.y * c + v.x * s} : (f32x2){v.x * c + v.y * s, v.y * c - v.x * s};
}
template <bool INV> __device__ __forceinline__ void dft16(f32x2 (&v)[16]) {
    constexpr float C1 = 0.9238795325112867f, S1 = 0.3826834323650898f, R2 = 0.7071067811865476f;
    r4<INV>(v[0], v[4], v[8], v[12]); r4<INV>(v[1], v[5], v[9], v[13]); r4<INV>(v[2], v[6], v[10], v[14]); r4<INV>(v[3], v[7], v[11], v[15]);
    v[5] = tw<INV>(v[5], C1, S1);  v[9] = tw<INV>(v[9], R2, R2);    v[13] = tw<INV>(v[13], S1, C1);
    v[6] = tw<INV>(v[6], R2, R2);  v[10] = tw<INV>(v[10], 0.f, 1.f); v[14] = tw<INV>(v[14], -R2, R2);
    v[7] = tw<INV>(v[7], S1, C1);  v[11] = tw<INV>(v[11], -R2, R2);  v[15] = tw<INV>(v[15], -C1, -S1);
    r4<INV>(v[0], v[1], v[2], v[3]); r4<INV>(v[4], v[5], v[6], v[7]); r4<INV>(v[8], v[9], v[10], v[11]); r4<INV>(v[12], v[13], v[14], v[15]);
    f32x2 t;
    t = v[1]; v[1] = v[4]; v[4] = t;   t = v[2]; v[2] = v[8]; v[8] = t;    t = v[3]; v[3] = v[12]; v[12] = t;
    t = v[6]; v[6] = v[9]; v[9] = t;   t = v[7]; v[7] = v[13]; v[13] = t;  t = v[11]; v[11] = v[14]; v[14] = t;
}
struct Ctx { LAS f32x2* R; LAS f32x2* IN; LAS f32x2* TW1; LAS f32x2* TW2; int t, half; f32x2 wt; };
#define HY_OPAQUE(x) asm volatile("" : "+v"(x))
#define HY_W32(m) (f32x2){__builtin_cosf(-0.19634954084936207f * (m)), __builtin_sinf(-0.19634954084936207f * (m))}
template <int MODE> __device__ __forceinline__ void pass1_fwd(const Ctx& X) {
    f32x2 v[16]; int t = X.t; HY_OPAQUE(t);
#pragma unroll
    for (int m = 0; m < 16; ++m) { f32x2 a = X.IN[t + 256 * m]; if (MODE == 1) a = (f32x2){X.half ? a.y : a.x, 0.f}; v[m] = a; }
    if (X.half) {
#pragma unroll
        for (int m = 0; m < 16; ++m) v[m] = cmul(cmul(v[m], HY_W32(m)), X.wt);
    }
    dft16<false>(v);
#pragma unroll
    for (int q = 1; q < 16; ++q) v[q] = cmul(v[q], X.TW1[(q - 1) * 256 + t]);
    const int pb = t + (t >> 4);
#pragma unroll
    for (int q = 0; q < 16; ++q) X.R[pb + 272 * q] = v[q];
}
__device__ __forceinline__ void pass2_fwd(const Ctx& X) {
    int t = X.t; HY_OPAQUE(t);
    const int n2 = t & 15, pb = (t >> 4) * 272 + n2; f32x2 v[16];
#pragma unroll
    for (int m = 0; m < 16; ++m) v[m] = X.R[pb + 17 * m];
    dft16<false>(v);
#pragma unroll
    for (int q = 1; q < 16; ++q) v[q] = cmul(v[q], X.TW2[(q - 1) * 16 + n2]);
#pragma unroll
    for (int q = 0; q < 16; ++q) X.R[pb + 17 * q] = v[q];
}
template <bool FILTER> __device__ __forceinline__ void pass3(const Ctx& X, f32x2 (&H)[16]) {
    f32x2 v[16]; int t = X.t; HY_OPAQUE(t); const int pb = 17 * t;
#pragma unroll
    for (int m = 0; m < 16; ++m) v[m] = X.R[pb + m];
    dft16<false>(v);
    if (FILTER) {
#pragma unroll
        for (int q = 0; q < 16; ++q) H[q] = v[q] * (1.f / 8192.f);
    } else {
#pragma unroll
        for (int q = 0; q < 16; ++q) v[q] = cmul(v[q], H[q]);
        dft16<true>(v);
#pragma unroll
        for (int m = 0; m < 16; ++m) X.R[pb + m] = v[m];
    }
}
__device__ __forceinline__ void pass2_inv(const Ctx& X) {
    int t = X.t; HY_OPAQUE(t);
    const int n2 = t & 15, pb = (t >> 4) * 272 + n2; f32x2 v[16];
    v[0] = X.R[pb];
#pragma unroll
    for (int q = 1; q < 16; ++q) v[q] = cmulc(X.R[pb + 17 * q], X.TW2[(q - 1) * 16 + n2]);
    dft16<true>(v);
#pragma unroll
    for (int m = 0; m < 16; ++m) X.R[pb + 17 * m] = v[m];
}
__device__ __forceinline__ void pass1_inv(const Ctx& X) {
    f32x2 v[16]; int t = X.t; HY_OPAQUE(t); const int pb = t + (t >> 4);
    v[0] = X.R[pb];
#pragma unroll
    for (int q = 1; q < 16; ++q) v[q] = cmulc(X.R[pb + 272 * q], X.TW1[(q - 1) * 256 + t]);
    dft16<true>(v);
    if (X.half) {
#pragma unroll
        for (int m = 0; m < 16; ++m) v[m] = cmulc(cmulc(v[m], HY_W32(m)), X.wt);
    }
#pragma unroll
    for (int m = 0; m < 16; ++m) X.R[pb + 272 * m] = v[m];
}
__device__ __forceinline__ void conv_fft(const Ctx& X, f32x2 (&H)[16]) {
    __syncthreads(); pass1_fwd<0>(X); __syncthreads(); pass2_fwd(X); __syncthreads(); pass3<false>(X, H); __syncthreads(); pass2_inv(X); __syncthreads(); pass1_inv(X); __syncthreads();
}
constexpr int STG_OFF = LDS_END;
constexpr int LDS_END2 = STG_OFF + 2 * SEQ * 2;
static_assert(LDS_END2 <= LDSCTL_OFF, "hyena LDS map");
__device__ __forceinline__ float sconv_lds(const LAS bf16_t* stg, int bs, int n, float w0, float w1, float w2, float bias) {
    const LAS bf16_t* p = stg + bs * SEQ;
    const float c = bf2f(p[n]), lv = bf2f(p[n - ((n > 0) ? 1 : 0)]), rv = bf2f(p[n + ((n < SEQ - 1) ? 1 : 0)]);
    const float l = (n > 0) ? lv : 0.f, r = (n < SEQ - 1) ? rv : 0.f;
    return bias + w0 * l + w1 * c + w2 * r;
}
__device__ __forceinline__ void setup_tables(LAS unsigned char* lds, int tid) {
    LAS f32x2* TW1 = (LAS f32x2*)(lds + TW1_OFF); LAS f32x2* TW2 = (LAS f32x2*)(lds + TW2_OFF);
    for (int i = tid; i < 15 * 256; i += 512) { const int q = i / 256 + 1, t = i & 255; float s, c; sincosf(-6.283185307179586f * (float)((t * q) & 4095) * (1.f / 4096.f), &s, &c); TW1[i] = (f32x2){c, s}; }
    for (int i = tid; i < 15 * 16; i += 512) { const int q = i / 16 + 1, n2 = i & 15; float s, c; sincosf(-6.283185307179586f * (float)((n2 * q) & 255) * (1.f / 256.f), &s, &c); TW2[i] = (f32x2){c, s}; }
}
__device__ __forceinline__ void unit(Frame& F, int c) {
    FT_DECL;
    const int tid = f_tid; Ctx X; X.half = F.wave >> 2; X.t = tid & 255;
    X.R = (LAS f32x2*)(F.lds + X.half * RB_BYTES); X.IN = (LAS f32x2*)(F.lds + IN_OFF); X.TW1 = (LAS f32x2*)(F.lds + TW1_OFF); X.TW2 = (LAS f32x2*)(F.lds + TW2_OFF);
    { float s, cc; sincosf(-6.283185307179586f * (float)X.t * (1.f / 8192.f), &s, &cc); X.wt = (f32x2){cc, s}; }
    LAS f32x2* RB0 = (LAS f32x2*)(F.lds); LAS f32x2* RB1 = (LAS f32x2*)(F.lds + RB_BYTES);
    const float* FILT = WSP(float, WS_FILT);
    f32x2 H0[16], H1[16];
#pragma unroll
    for (int ord = 0; ord < 2; ++ord) {
        const float* hf = FILT + ((size_t)(ord * 2 + 0) * 512 + c) * SEQ; const float* hb = FILT + ((size_t)(ord * 2 + 1) * 512 + c) * SEQ;
        __syncthreads();
        int nb = tid; HY_OPAQUE(nb);
#pragma unroll
        for (int j = 0; j < 8; ++j) { const int n = nb + 512 * j; const float a = hf[n], b = hb[(SEQ - n) & (SEQ - 1)]; const float lo = (n == 0) ? a + b : a, hi = (n == 0) ? 0.f : b; X.IN[n] = (f32x2){lo + hi, lo - hi}; }
        __syncthreads(); pass1_fwd<1>(X); __syncthreads(); pass2_fwd(X); __syncthreads();
        if (ord == 0) pass3<true>(X, H0); else pass3<true>(X, H1);
    }
    const bf16_t* UT = WSP(bf16_t, WS_UT);
    const bf16_t* rv = UT + (size_t)c * MROWS; const bf16_t* r1 = UT + (size_t)(512 + c) * MROWS; const bf16_t* r2 = UT + (size_t)(1024 + c) * MROWS;
    const float* cw = F.in[16]; const float* cb = F.in[17];
    const float wv0 = cw[c], wv1 = cw[HYC + c], wv2 = cw[2 * HYC + c], bv = cb[c];
    const float wa0 = cw[512 + c], wa1 = cw[HYC + 512 + c], wa2 = cw[2 * HYC + 512 + c], ba = cb[512 + c];
    const float wb0 = cw[1024 + c], wb1 = cw[HYC + 1024 + c], wb2 = cw[2 * HYC + 1024 + c], bb = cb[1024 + c];
    const float sk0 = F.in[25][c], sk1 = F.in[25][512 + c];
    bf16_t* Z = WSP(bf16_t, WS_Z2T) + (size_t)c * MROWS;
    LAS bf16_t* STG = (LAS bf16_t*)(F.lds + STG_OFF);
    u32x4 g0 = *(const u32x4*)(rv + tid * 8), g1 = *(const u32x4*)(rv + SEQ + tid * 8);
    for (int pr = 0; pr < 4; ++pr) {
        const int b0 = 2 * pr, b1 = b0 + 1;
        f32x2 z[8]; int pc = tid + (tid >> 4); HY_OPAQUE(pc); int nb = tid; HY_OPAQUE(nb);
        __syncthreads();
        *(LAS u32x4*)(STG + tid * 8) = g0; *(LAS u32x4*)(STG + SEQ + tid * 8) = g1;
        __syncthreads();
#pragma unroll
        for (int j = 0; j < 8; ++j) { const int n = nb + 512 * j; z[j] = (f32x2){sconv_lds(STG, 0, n, wv0, wv1, wv2, bv), sconv_lds(STG, 1, n, wv0, wv1, wv2, bv)}; X.IN[n] = z[j]; }
        g0 = *(const u32x4*)(r1 + b0 * SEQ + tid * 8); g1 = *(const u32x4*)(r1 + b1 * SEQ + tid * 8);
        conv_fft(X, H0);
        *(LAS u32x4*)(STG + tid * 8) = g0; *(LAS u32x4*)(STG + SEQ + tid * 8) = g1;
        __syncthreads();
        HY_OPAQUE(nb); HY_OPAQUE(pc);
#pragma unroll
        for (int j = 0; j < 8; ++j) { const int n = nb + 512 * j; const f32x2 y = RB0[pc + 544 * j] + RB1[pc + 544 * j];
            const f32x2 g = (f32x2){sconv_lds(STG, 0, n, wa0, wa1, wa2, ba), sconv_lds(STG, 1, n, wa0, wa1, wa2, ba)};
            z[j] = g * (y + sk0 * z[j]); X.IN[n] = z[j]; }
        g0 = *(const u32x4*)(r2 + b0 * SEQ + tid * 8); g1 = *(const u32x4*)(r2 + b1 * SEQ + tid * 8);
        conv_fft(X, H1);
        *(LAS u32x4*)(STG + tid * 8) = g0; *(LAS u32x4*)(STG + SEQ + tid * 8) = g1;
        __syncthreads();
        if (pr < 3) { g0 = *(const u32x4*)(rv + (b0 + 2) * SEQ + tid * 8); g1 = *(const u32x4*)(rv + (b1 + 2) * SEQ + tid * 8); }
        HY_OPAQUE(nb); HY_OPAQUE(pc);
        f32x2 o[8];
#pragma unroll
        for (int j = 0; j < 8; ++j) { const int n = nb + 512 * j; const f32x2 y = RB0[pc + 544 * j] + RB1[pc + 544 * j];
            const f32x2 g = (f32x2){sconv_lds(STG, 0, n, wb0, wb1, wb2, bb), sconv_lds(STG, 1, n, wb0, wb1, wb2, bb)};
            o[j] = g * (y + sk1 * z[j]); }
        __syncthreads();
#pragma unroll
        for (int j = 0; j < 8; ++j) { const int n = nb + 512 * j; STG[n] = (bf16_t)(cvt_pk_bf16(o[j].x, 0.f) & 0xffffu); STG[SEQ + n] = (bf16_t)(cvt_pk_bf16(o[j].y, 0.f) & 0xffffu); }
        __syncthreads();
        *(u32x4*)(Z + b0 * SEQ + tid * 8) = *(const LAS u32x4*)(STG + tid * 8); *(u32x4*)(Z + b1 * SEQ + tid * 8) = *(const LAS u32x4*)(STG + SEQ + tid * 8);
    }
    __syncthreads();
}
}

__device__ __forceinline__ void p3_hyena(Frame& F) {
    FT_DECL;
    __syncthreads();
    hy::setup_tables(F.lds, f_tid);
    __syncthreads();
    for (int c = F.vcu; c < HYW; c += F.G) hy::unit(F, c);
}

__device__ __forceinline__ void p4_hynorm(Frame& F) {
    FT_DECL;
    const bf16_t* Z = WSP(bf16_t, WS_Z2T); bf16_t* MIX = WSP(bf16_t, WS_MIX); const float* g = F.in[26];
    LAS bf16_t* T = (LAS bf16_t*)F.lds;
    LAS float* red = (LAS float*)(F.lds + 512 * 72 * 2);
    LAS float* rs = red + 512;
    for (int it = F.vcu; it < MROWS / 64; it += F.G) {
        const int tok0 = it * 64;
        __syncthreads();
#pragma unroll
        for (int j = 0; j < 8; ++j) { const int i = f_tid + 512 * j, row = i >> 3, ch = i & 7; const u32x4 v = *(const u32x4*)(Z + (size_t)row * MROWS + tok0 + ch * 8); *(LAS u32x4*)(T + row * 72 + ch * 8) = v; }
        __syncthreads();
        { const int tok = f_tid & 63, grp = f_tid >> 6; float ss = 0.f;
#pragma unroll 8
            for (int k = 0; k < 64; ++k) { const float v = bf2f(T[(grp * 64 + k) * 72 + tok]); ss += v * v; }
            red[grp * 64 + tok] = ss; }
        __syncthreads();
        if (f_tid < 64) { float ss = 0.f;
#pragma unroll
            for (int w = 0; w < 8; ++w) ss += red[w * 64 + f_tid];
            rs[f_tid] = rsqrtf(ss * (1.f / HYW) + EPS); }
        __syncthreads();
#pragma unroll
        for (int j = 0; j < 8; ++j) { const int i = f_tid + 512 * j, tok = i >> 6, c0 = (i & 63) * 8; const float r = rs[tok];
            float v[8];
#pragma unroll
            for (int e = 0; e < 8; ++e) v[e] = bf2f(T[(c0 + e) * 72 + tok]) * r * g[c0 + e];
            u32x4 w; w.x = cvt_pk_bf16(v[0], v[1]); w.y = cvt_pk_bf16(v[2], v[3]); w.z = cvt_pk_bf16(v[4], v[5]); w.w = cvt_pk_bf16(v[6], v[7]);
            *(u32x4*)(MIX + (size_t)(tok0 + tok) * DM + 512 + c0) = w; }
    }
}

__device__ __forceinline__ void p4_stub(Frame& F) {
    FT_DECL;
    bf16_t* MIX = WSP(bf16_t, WS_MIX);
    const size_t gt = (size_t)F.vcu * 512 + f_tid, NT = (size_t)F.G * 512;
    for (size_t i = gt; i < (size_t)MROWS * 64; i += NT) { const size_t row = i >> 6, ch = i & 63; *(u32x4*)(MIX + row * DM + 512 + ch * 8) = (u32x4){0u, 0u, 0u, 0u}; }
}


constexpr size_t RT_TOPI = 0;
constexpr size_t RT_GATE = 512 * 1024;
constexpr size_t RT_POS = 1024 * 1024;
constexpr size_t RT_WGCNT = 1536 * 1024;
constexpr size_t RT_META = 1600 * 1024;
constexpr size_t RT_LIST = 2048 * 1024;
constexpr size_t RT_GSLOT = 2048 * 1024 + 640 * 1024;
constexpr int MAXSLOT = MROWS * TOPK + NEXP * 256;
constexpr int MAXTILE = MAXSLOT / 256;
constexpr size_t WS_XS = WS_EO;
constexpr int RW_PITCH = 32;
constexpr int P6_LDS_TOPI = 1024 * RW_PITCH * 4;

__device__ __forceinline__ void p6_router(Frame& F) {
    FT_DECL;
#define in F.in
    LAS float* RW = (LAS float*)F.lds;
    LAS int* TI = (LAS int*)(F.lds + P6_LDS_TOPI);
    LAS int* PS = TI + 512;
    LAS int* SC = PS + 512;
    const float* rw = in[28];
    for (int i = f_tid; i < 1024 * 8; i += 512) { const int k = i >> 3, c4 = i & 7; const f32x4 v = *(const f32x4*)(rw + (size_t)k * 32 + c4 * 4);
        const int pi = (k & 3) * 256 + (k >> 2); *(LAS f32x4*)(RW + pi * RW_PITCH + ((c4 ^ ((pi >> 1) & 7)) * 4)) = v; }
    __syncthreads();
    const float* mod = WSP(float, WS_SMALL + SM_MOD); const float* g2n = in[7]; const float* rb = in[29];
    unsigned char* H2 = WSP(unsigned char, WS_H);
    int* topi_g = WSP(int, WS_ROUTE + RT_TOPI); float* gate_g = WSP(float, WS_ROUTE + RT_GATE); int* pos_g = WSP(int, WS_ROUTE + RT_POS); int* wgcnt = WSP(int, WS_ROUTE + RT_WGCNT);
    const int lane = f_lane;
    for (int blk = blockIdx.x; blk < MROWS / 128; blk += F.G) {
        for (int it = 0; it < 8; ++it) {
            const int rl = F.wave * 16 + 2 * it, r0 = blk * 128 + rl;
            const float* sh2 = mod + (size_t)(r0 >> 12) * (NMOD * DM) + 3 * DM; const float* sc2 = sh2 + DM;
            f32x4 h[2][4];
#pragma unroll
            for (int rr = 0; rr < 2; ++rr) {
                const GAS f32x4* xr = (const GAS f32x4*)(WSP(float, WS_XN) + (size_t)(r0 + rr) * DM) + lane; float ss = 0.f;
#pragma unroll
                for (int j = 0; j < 4; ++j) { h[rr][j] = xr[64 * j]; ss += (h[rr][j].x * h[rr][j].x + h[rr][j].y * h[rr][j].y) + (h[rr][j].z * h[rr][j].z + h[rr][j].w * h[rr][j].w); }
                const float rstd = rsqrtf(wave_sum(ss) * (1.f / DM) + EPS);
                GAS unsigned* o4 = (GAS unsigned*)(H2 + (size_t)(r0 + rr) * DM) + lane;
#pragma unroll
                for (int j = 0; j < 4; ++j) { const int c = 4 * lane + 256 * j;
                    const f32x4 g = *(const f32x4*)(g2n + c), a = *(const f32x4*)(sc2 + c), b = *(const f32x4*)(sh2 + c);
                    h[rr][j] = h[rr][j] * rstd * g * (a + 1.f) + b;
                    o4[64 * j] = pk4_fp8(h[rr][j].x, h[rr][j].y, h[rr][j].z, h[rr][j].w); }
            }
            float a0[32], a1[32]; int lb = lane; asm volatile("" : "+v"(lb)); const int sw = (lb >> 1) & 7;
#pragma unroll
            for (int e = 0; e < 32; ++e) { a0[e] = 0.f; a1[e] = 0.f; }
#pragma unroll
            for (int j = 0; j < 4; ++j)
#pragma unroll
                for (int i = 0; i < 4; ++i) { const LAS float* wp = RW + (i * 256 + 64 * j + lb) * RW_PITCH; const float x0 = h[0][j][i], x1 = h[1][j][i];
#pragma unroll
                    for (int c4 = 0; c4 < 8; ++c4) { const f32x4 w = *(const LAS f32x4*)(wp + 4 * (c4 ^ sw));
#pragma unroll
                        for (int e = 0; e < 4; ++e) { a0[4 * c4 + e] += x0 * w[e]; a1[4 * c4 + e] += x1 * w[e]; } } }
#define RS_STEP(A, CNT, MASK) _Pragma("unroll") for (int i = 0; i < CNT; ++i) { const bool up = (lane & MASK) != 0; const float send = up ? A[i] : A[CNT + i]; const float keep = up ? A[CNT + i] : A[i]; A[i] = keep + __shfl_xor(send, MASK); }
            RS_STEP(a0, 16, 32) RS_STEP(a0, 8, 16) RS_STEP(a0, 4, 8) RS_STEP(a0, 2, 4) RS_STEP(a0, 1, 2)
            RS_STEP(a1, 16, 32) RS_STEP(a1, 8, 16) RS_STEP(a1, 4, 8) RS_STEP(a1, 2, 4) RS_STEP(a1, 1, 2)
#undef RS_STEP
            const int me = lane >> 1; const float bias = rb[me];
            float lg[2]; lg[0] = a0[0] + __shfl_xor(a0[0], 1) + bias; lg[1] = a1[0] + __shfl_xor(a1[0], 1) + bias;
            LAS float* WL = (LAS float*)(F.lds + P6_LDS_TOPI + 6144) + F.wave * 96;
            if ((lane & 1) == 0) { WL[me] = lg[0]; WL[32 + me] = lg[1]; }
            LDS_WAIT(); asm volatile("" ::: "memory");
#pragma unroll
            for (int rr = 0; rr < 2; ++rr) {
                const float v = lg[rr]; int rank = 0;
#pragma unroll
                for (int c4 = 0; c4 < 8; ++c4) { const f32x4 o = *(const LAS f32x4*)(WL + rr * 32 + 4 * c4);
#pragma unroll
                    for (int e = 0; e < 4; ++e) { const int oe = 4 * c4 + e; rank += (o[e] > v || (o[e] == v && oe < me)) ? 1 : 0; } }
                if ((lane & 1) == 0 && rank < 4) { WL[64 + rr * 4 + rank] = v; ((LAS int*)WL)[72 + rr * 4 + rank] = me; }
            }
            LDS_WAIT(); asm volatile("" ::: "memory");
            if (lane < 2) { const int rr = lane; const f32x4 tv = *(const LAS f32x4*)(WL + 64 + rr * 4); typedef int i32x4_t __attribute__((ext_vector_type(4))); const i32x4_t ti = *(const LAS i32x4_t*)((LAS int*)WL + 72 + rr * 4);
                const float e1 = __expf(tv[1] - tv[0]), e2 = __expf(tv[2] - tv[0]), e3 = __expf(tv[3] - tv[0]); const float inv = 1.f / (1.f + e1 + e2 + e3);
                const int r = r0 + rr;
                *(i32x4_t*)(topi_g + (size_t)r * 4) = ti;
                *(f32x4*)(gate_g + (size_t)r * 4) = (f32x4){inv, e1 * inv, e2 * inv, e3 * inv};
                *(LAS i32x4_t*)(TI + (rl + rr) * 4) = ti; }
            LDS_WAIT(); asm volatile("" ::: "memory");
        }
        __syncthreads();
        { const int e = f_tid & 31, seg = f_tid >> 5; int cnt = 0;
#pragma unroll 4
            for (int i = 0; i < 32; ++i) cnt += (TI[seg * 32 + i] == e) ? 1 : 0;
            SC[seg * 32 + e] = cnt;
            __syncthreads();
            int pre = 0;
            for (int s2 = 0; s2 < seg; ++s2) pre += SC[s2 * 32 + e];
            if (seg == 15) wgcnt[blk * 32 + e] = pre + cnt;
            for (int i = 0; i < 32; ++i) if (TI[seg * 32 + i] == e) { PS[seg * 32 + i] = pre; ++pre; }
        }
        __syncthreads();
        pos_g[(size_t)blk * 512 + f_tid] = PS[f_tid];
        __syncthreads();
    }
#undef in
}

__device__ __forceinline__ void p7_scatter(Frame& F) {
    FT_DECL;
    LAS int* TOT = (LAS int*)F.lds;
    LAS int* BASE = TOT + 32;
    LAS int* PRE = BASE + 32;
    LAS int* PART = PRE + 32;
    const int* wgcnt = WSP(int, WS_ROUTE + RT_WGCNT); const int* topi_g = WSP(int, WS_ROUTE + RT_TOPI); const float* gate_g = WSP(float, WS_ROUTE + RT_GATE); const int* pos_g = WSP(int, WS_ROUTE + RT_POS);
    int* list = WSP(int, WS_ROUTE + RT_LIST); float* gslot = WSP(float, WS_ROUTE + RT_GSLOT); int* meta = WSP(int, WS_ROUTE + RT_META);
    const unsigned char* H2 = WSP(unsigned char, WS_H); unsigned char* XS = WSP(unsigned char, WS_XS);
    for (int blk = blockIdx.x; blk < MROWS / 128; blk += F.G) {
        __syncthreads();
        { const int e = f_tid & 31, part = f_tid >> 5; int st = 0, sp = 0;
            for (int w = part * 16; w < part * 16 + 16; ++w) { const int c = wgcnt[w * 32 + e]; st += c; if (w < blk) sp += c; }
            PART[part * 32 + e] = st; PART[512 + part * 32 + e] = sp; }
        __syncthreads();
        if (f_tid < 32) { int st = 0, sp = 0;
#pragma unroll
            for (int p = 0; p < 16; ++p) { st += PART[p * 32 + f_tid]; sp += PART[512 + p * 32 + f_tid]; }
            TOT[f_tid] = st; PRE[f_tid] = sp; }
        __syncthreads();
        if (f_tid == 0) { int b = 0; for (int e = 0; e < 32; ++e) { BASE[e] = b; b += (TOT[e] + 255) & ~255; }
            if (blk == 0) { int t = 0; for (int e = 0; e < 32; ++e) { meta[e] = TOT[e]; meta[32 + e] = BASE[e]; const int nt = (TOT[e] + 255) >> 8; for (int q = 0; q < nt; ++q) meta[128 + t + q] = e; t += nt; } meta[64] = t; } }
        __syncthreads();
        { const int a = f_tid, row = blk * 128 + (a >> 2); const int e = topi_g[(size_t)blk * 512 + a]; const int slot = BASE[e] + PRE[e] + pos_g[(size_t)blk * 512 + a];
            list[slot] = row * 4 + (a & 3); gslot[slot] = gate_g[(size_t)blk * 512 + a];
            PART[a] = slot; }
        __syncthreads();
        for (int a0 = F.wave * 8; a0 < 512; a0 += NWAVES * 8) { u32x4 v[8]; int sl[8];
#pragma unroll
            for (int q = 0; q < 8; ++q) { const int a = a0 + q; sl[q] = PART[a]; v[q] = ((const GAS u32x4*)(H2 + (size_t)(blk * 128 + (a >> 2)) * DM))[f_lane]; }
#pragma unroll
            for (int q = 0; q < 8; ++q) ((GAS u32x4*)(XS + (size_t)sl[q] * DM))[f_lane] = v[q]; }
        if (blk < NEXP) { const int e = blk, lo = BASE[e] + TOT[e], hi = BASE[e] + ((TOT[e] + 255) & ~255);
            for (int sl = lo + F.wave; sl < hi; sl += NWAVES) { if (f_lane == 0) { list[sl] = -1; gslot[sl] = 0.f; }
                ((GAS u32x4*)(XS + (size_t)sl * DM))[f_lane] = (u32x4){0u, 0u, 0u, 0u}; } }
    }
}

template <int NPN> struct SchedMoE {
    int G, c, nT; const char* A; const char* W; size_t wstride; const LAS unsigned char* tileE;
    __device__ __forceinline__ bool next(int i, g8::Unit& u) const {
        const int L = i * G + c, xcd = L & 7, j = L >> 3, T = (j / NPN) * 8 + xcd, pn = j % NPN;
        if (T >= nT) return false;
        const int e = tileE[T];
        u.pm = T; u.pn = pn; u.kind = i; u.ex = e; u.a = A + (size_t)T * 256 * DM; u.b = W + (size_t)e * wstride + (size_t)pn * 256 * DM; return true;
    }
};
struct EpiSwiGLU {
    unsigned char* ACT; const float* b1;
    __device__ __forceinline__ void operator()(f32x4 (&acc)[2][2][4][2], const g8::Unit& u, int wr, int wc, int fr, int fq) const {
        asm volatile("" : "+v"(fr), "+v"(fq));
        const int j0 = u.pn * 128 + wc * 32 + 8 * fq; const float* bp = b1 + (size_t)u.ex * 2 * DM + j0;
        f32x4 bg[2], bl[2];
#pragma unroll
        for (int n = 0; n < 2; ++n) { bg[n] = *(const f32x4*)(bp + 4 * n); bl[n] = *(const f32x4*)(bp + DM + 4 * n); }
#pragma unroll
        for (int ai = 0; ai < 2; ++ai)
#pragma unroll
            for (int m = 0; m < 4; ++m) { const size_t slot = (size_t)u.pm * 256 + ai * 128 + wr * 64 + m * 16 + fr; float o[8];
#pragma unroll
                for (int n = 0; n < 2; ++n) { const f32x4 g4 = acc[ai][0][m][n] * (1.f / WSCALE) + bg[n], l4 = acc[ai][1][m][n] * (1.f / WSCALE) + bl[n];
#pragma unroll
                    for (int e = 0; e < 4; ++e) { const float g = fminf(g4[e], 7.f), l = __builtin_amdgcn_fmed3f(l4[e], -7.f, 7.f);
                        const float ex = __builtin_amdgcn_exp2f(g * (-1.702f * 1.4426950408889634f)); const float glu = g * __builtin_amdgcn_rcpf(1.f + ex);
                        o[4 * n + e] = fmaf(l, glu, glu); } }
                u32x2 w; w.x = pk4_fp8(o[0], o[1], o[2], o[3]); w.y = pk4_fp8(o[4], o[5], o[6], o[7]);
                *(u32x2*)(ACT + slot * DM + j0) = w; }
    }
};
struct EpiDown {
    unsigned char* EO; const float* b2; const LAS int* LL; int G, c;
    __device__ __forceinline__ void operator()(f32x4 (&acc)[2][2][4][2], const g8::Unit& u, int wr, int wc, int fr, int fq) const {
        asm volatile("" : "+v"(fr), "+v"(fq));
        const int c0 = u.pn * 256 + wc * 32 + 8 * fq; const float* bp = b2 + (size_t)u.ex * DM + c0;
        f32x4 bb[2][2];
#pragma unroll
        for (int bj = 0; bj < 2; ++bj)
#pragma unroll
            for (int n = 0; n < 2; ++n) bb[bj][n] = *(const f32x4*)(bp + bj * 128 + 4 * n);
        const LAS int* L = LL + u.kind * 512;
        int li[8]; float gt[8];
#pragma unroll
        for (int q = 0; q < 8; ++q) { const int rl = (q >> 2) * 128 + wr * 64 + (q & 3) * 16 + fr; li[q] = L[rl]; gt[q] = __int_as_float(L[256 + rl]) * (1.f / WSCALE); }
#pragma unroll
        for (int ai = 0; ai < 2; ++ai)
#pragma unroll
            for (int m = 0; m < 4; ++m) { const int l = li[ai * 4 + m]; const float g = gt[ai * 4 + m];
                unsigned char* dst = EO + ((size_t)(l & 3) * MROWS + (l >> 2)) * DM + c0;
                u32x2 w[2];
#pragma unroll
                for (int bj = 0; bj < 2; ++bj) { const f32x4 v0 = acc[ai][bj][m][0] * g + bb[bj][0] * (g * WSCALE), v1 = acc[ai][bj][m][1] * g + bb[bj][1] * (g * WSCALE);
                    w[bj].x = pk4_fp8(v0[0] * EOSCALE, v0[1] * EOSCALE, v0[2] * EOSCALE, v0[3] * EOSCALE); w[bj].y = pk4_fp8(v1[0] * EOSCALE, v1[1] * EOSCALE, v1[2] * EOSCALE, v1[3] * EOSCALE); }
                if (l >= 0) { *(u32x2*)dst = w[0]; *(u32x2*)(dst + 128) = w[1]; } }
    }
};
__device__ __forceinline__ const LAS unsigned char* moe_tiles(Frame& F, int& nT) {
    FT_DECL;
    LAS unsigned char* TE = (LAS unsigned char*)(F.lds + RING_BYTES); const int* meta = WSP(int, WS_ROUTE + RT_META);
    __syncthreads();
    nT = meta[64]; if (nT > MAXTILE) nT = MAXTILE;
    for (int i = f_tid; i < MAXTILE; i += 512) TE[i] = (unsigned char)((i < nT) ? meta[128 + i] : 0);
    __syncthreads();
    return (const LAS unsigned char*)TE;
}

__device__ __forceinline__ void p10_combine(Frame& F) {
    FT_DECL;
    const float* mod = WSP(float, WS_SMALL + SM_MOD); const unsigned char* EO = WSP(unsigned char, WS_EO);
    const size_t gt = (size_t)F.vcu * 512 + f_tid, NTH = (size_t)F.G * 512;
    float pd = 0.f, pa = 0.f;
    if (MK_PROBE_A != -2) { const unsigned long long* st = (const unsigned long long*)(F.ws + WS_CTL + 8192);
        pd = (MK_PROBE_A < 0) ? 0.1f : (float)(st[MK_PA1] - st[MK_PA0]) * MK_PSA; pa = (float)(st[MK_PB1] - st[MK_PB0]) * MK_PSB; }
    constexpr int U = 4;
    for (size_t i0 = gt; i0 < (size_t)MROWS * 128; i0 += NTH * U) {
        u32x2 ev[U][4]; f32x4 xv[U][2], gv[U][2];
#pragma unroll
        for (int u = 0; u < U; ++u) { const size_t i = i0 + (size_t)u * NTH; const size_t row = i >> 7; const int c0 = (int)(i & 127) * 8;
            const float* g2 = mod + (size_t)(row >> 12) * (NMOD * DM) + 5 * DM + c0; const float* op = WSP(float, WS_XN) + row * DM + c0;
#pragma unroll
            for (int k = 0; k < 4; ++k) ev[u][k] = __builtin_nontemporal_load((const u32x2*)(EO + ((size_t)k * MROWS + row) * DM + c0));
            xv[u][0] = *(const f32x4*)op; xv[u][1] = *(const f32x4*)(op + 4); gv[u][0] = *(const f32x4*)g2; gv[u][1] = *(const f32x4*)(g2 + 4); }
#pragma unroll
        for (int u = 0; u < U; ++u) { const size_t i = i0 + (size_t)u * NTH; const size_t row = i >> 7; const int c0 = (int)(i & 127) * 8;
            float s[8];
#pragma unroll
            for (int e = 0; e < 8; ++e) s[e] = 0.f;
#pragma unroll
            for (int k = 0; k < 4; ++k) { const u32x2 v = ev[u][k];
                const f32x2 a = __builtin_amdgcn_cvt_pk_f32_fp8((int)v.x, false), b = __builtin_amdgcn_cvt_pk_f32_fp8((int)v.x, true), c = __builtin_amdgcn_cvt_pk_f32_fp8((int)v.y, false), d = __builtin_amdgcn_cvt_pk_f32_fp8((int)v.y, true);
                s[0] += a.x; s[1] += a.y; s[2] += b.x; s[3] += b.y; s[4] += c.x; s[5] += c.y; s[6] += d.x; s[7] += d.y; }
#pragma unroll
            for (int e = 0; e < 8; ++e) s[e] *= (1.f / EOSCALE);
            f32x4 o0 = xv[u][0] + gv[u][0] * (f32x4){s[0], s[1], s[2], s[3]}, o1 = xv[u][1] + gv[u][1] * (f32x4){s[4], s[5], s[6], s[7]};
            if (MK_PROBE_A != -2) { o0 += pd; o1 += pd; if (i == 0) o0[0] += pa; }
            float* op = F.out + row * DM + c0;
            __builtin_nontemporal_store(o0, (f32x4*)op); __builtin_nontemporal_store(o1, (f32x4*)(op + 4)); }
    }
}

struct Args { const float* in[34]; float* out; unsigned char* ws; int ph_lo, ph_hi; };
constexpr int N_PHASES = 11;

__global__ void __launch_bounds__(512, 2) mega(Args args) {
    extern __shared__ __attribute__((aligned(16))) unsigned char lds[];
    Frame F;
    F.lds = (LAS unsigned char*)lds;
    F.MISC = (volatile LAS unsigned*)(F.lds + LDSCTL_OFF);
    F.wave = __builtin_amdgcn_readfirstlane(threadIdx.x >> 6);
    FT_DECL;
    F.G = gridDim.x; { const int bx = blockIdx.x; F.vcu = (F.G % 8 == 0) ? (bx % 8) * (F.G / 8) + bx / 8 : bx; }
    F.in = (kin_t)__builtin_amdgcn_kernarg_segment_ptr();
    F.out = args.out; F.ws = args.ws;
    F.ctl = (gu32*)(args.ws + WS_CTL);
    for (int u = f_tid; u < (LDS_BYTES - LDSCTL_OFF) / 4; u += NWAVES * 64) ((LAS unsigned*)(F.lds + LDSCTL_OFF))[u] = 0u;
    __syncthreads();
    const int lo = args.ph_lo, hi = args.ph_hi;
    XcdBarrier bar; bar.bar = (unsigned*)(F.ctl + CW_BAR); bar.x = 0; bar.st = nullptr;
    if (hi - lo > 1) bar = xcd_barrier_post((unsigned*)(F.ctl + CW_BAR), F.MISC + 8, f_tid == 0);
#define IN(k) (lo <= (k) && (k) < hi)
    unsigned long long* stamps = (unsigned long long*)(args.ws + WS_CTL + 8192);
#define STAMP(k) do { if (MK_PROBE_A != -2 && blockIdx.x == 0 && f_tid == 0) stamps[(k)] = __builtin_amdgcn_s_memrealtime(); } while (0)
    STAMP(0);
#define SEAM(k) do { if (IN(k) && IN((k) + 1)) xcd_barrier(bar, F.wave == 0 && lane_id() == 0); } while (0)

    if (IN(0)) { p0_prologue(F); } SEAM(0); STAMP(1);
    if (IN(1)) { p1_norm1(F); } SEAM(1); STAMP(2);
    if (IN(2)) {
        SchedInProj S{F.G, (int)blockIdx.x, (const char*)WSP(bf16_t, WS_H), (const char*)WSP(bf16_t, WS_WIN)};
        EpiInProj E{WSP(bf16_t, WS_Q), WSP(bf16_t, WS_K), WSP(bf16_t, WS_V), WSP(bf16_t, WS_UT), F.in[9], F.in[10], WSP(float, WS_SMALL + SM_ROPE)};
        g8::gemm_phase<false>(F.lds, DM, S, E, F.wave, lane_id());
    } SEAM(2); STAMP(3);
    if (IN(3)) { p3_attention(F); STAMP(12); p3_hyena(F); } SEAM(3); STAMP(4);
    if (IN(4)) { p4_hynorm(F); } SEAM(4); STAMP(5);
    if (IN(5)) {
        SchedStatic S{F.G, (int)blockIdx.x, MROWS / 256, DM / 256, (const char*)WSP(bf16_t, WS_MIX), (const char*)WSP(bf16_t, WS_WOUT)};
        EpiOutProj E{F.in[0], WSP(float, WS_XN), WSP(float, WS_SMALL + SM_MOD)};
        g8::gemm_phase<false>(F.lds, DM, S, E, F.wave, lane_id());
    } SEAM(5); STAMP(6);
    if (IN(6)) { p6_router(F); } SEAM(6); STAMP(7);
    if (IN(7)) { p7_scatter(F); } SEAM(7); STAMP(8);
    if (IN(8)) {
        int nT; const LAS unsigned char* TE = moe_tiles(F, nT);
        SchedMoE<8> S{F.G, (int)blockIdx.x, nT, (const char*)WSP(char, WS_XS), (const char*)WSP(char, WS_W1), (size_t)2 * DM * DM, TE};
        EpiSwiGLU E{WSP(unsigned char, WS_ACT), F.in[31]};
        g8::gemm_phase<true>(F.lds, DM, S, E, F.wave, lane_id());
    } SEAM(8); STAMP(9);
    if (IN(9)) {
        int nT; const LAS unsigned char* TE = moe_tiles(F, nT);
        SchedMoE<4> S{F.G, (int)blockIdx.x, nT, (const char*)WSP(char, WS_ACT), (const char*)WSP(char, WS_W2), (size_t)DM * DM, TE};
        LAS int* LL = (LAS int*)(F.lds + RING_BYTES + 1024);
        static_assert(RING_BYTES + 1024 + 9 * 2048 <= LDSCTL_OFF, "LDS map");
        { const int* list = WSP(int, WS_ROUTE + RT_LIST); const float* gslot = WSP(float, WS_ROUTE + RT_GSLOT);
            const int t9 = F.wave * 64 + lane_id();
            g8::Unit u; for (int i = 0; i < 9 && S.next(i, u); ++i) { const int t = t9 & 255; const size_t slot = (size_t)u.pm * 256 + t;
                LL[i * 512 + (t9 >> 8) * 256 + t] = (t9 < 256) ? list[slot] : __float_as_int(gslot[slot]); }
            __syncthreads(); }
        EpiDown E{WSP(unsigned char, WS_EO), F.in[33], LL, F.G, (int)blockIdx.x};
        g8::gemm_phase<true>(F.lds, DM, S, E, F.wave, lane_id());
    } SEAM(9); STAMP(10);
    if (IN(10)) { p10_combine(F); }
#undef IN
#undef SEAM
}

extern "C" void kernel_launch(void* const* d_in, const int* in_sizes, int n_in, void* d_out, int out_size, void* d_ws, size_t ws_size, hipStream_t stream) {
    static int grid = 0;
    if (grid == 0) {
        if (n_in != 34 || out_size != MROWS * DM || ws_size < WS_END) { fprintf(stderr, "kernel_launch: unexpected shapes: n_in %d out %d ws %zu (need %zu)\n", n_in, out_size, ws_size, (size_t)WS_END); grid = -1; return; }
        int dev = 0, cus = 0, per_cu = 0;
        if (hipGetDevice(&dev) != hipSuccess || hipDeviceGetAttribute(&cus, hipDeviceAttributeMultiprocessorCount, dev) != hipSuccess) { grid = -1; return; }
        if (hipFuncSetAttribute((const void*)mega, hipFuncAttributeMaxDynamicSharedMemorySize, LDS_BYTES) != hipSuccess) { fprintf(stderr, "kernel_launch: hipFuncSetAttribute failed\n"); grid = -1; return; }
        if (hipOccupancyMaxActiveBlocksPerMultiprocessor(&per_cu, (const void*)mega, NWAVES * 64, LDS_BYTES) != hipSuccess || per_cu < 1) { fprintf(stderr, "kernel_launch: occupancy query says %d\n", per_cu); per_cu = 1; }
        (void)hipGetLastError();
        grid = cus;
    }
    if (grid < 0) return;
    (void)hipMemsetAsync((char*)d_ws + WS_CTL, 0, CTL_ZERO_BYTES, stream);
    Args a{};
    for (int i = 0; i < 34; ++i) a.in[i] = (const float*)d_in[i];
    a.out = (float*)d_out; a.ws = (unsigned char*)d_ws;
    constexpr int LAST = MK_LAST_PHASE + 1;
    if (MK_N_LAUNCHES == 1) { a.ph_lo = 0; a.ph_hi = LAST; hipLaunchKernelGGL(mega, dim3(grid), dim3(NWAVES * 64), LDS_BYTES, stream, a); }
    else for (int p = 0; p < LAST; ++p) { a.ph_lo = p; a.ph_hi = p + 1; hipLaunchKernelGGL(mega, dim3(grid), dim3(NWAVES * 64), LDS_BYTES, stream, a); }
    const hipError_t le = hipPeekAtLastError();
    if (le != hipSuccess) fprintf(stderr, "kernel_launch: launch failed: %s\n", hipGetErrorName(le));
}
```

```cpp
#include <hip/hip_runtime.h>
#include <hip/hip_bf16.h>
#include <cstdio>
#include <cstdint>

#ifndef MK_N_LAUNCHES
#define MK_N_LAUNCHES 1
#endif
#ifndef MK_PROBE_A
#define MK_PROBE_A -2
#endif
#ifndef MK_PA0
#define MK_PA0 0
#define MK_PA1 1
#define MK_PB0 0
#define MK_PB1 1
#define MK_PSA 2e-6f
#define MK_PSB 1e-4f
#endif
#ifndef MK_LAST_PHASE
#define MK_LAST_PHASE 10
#endif

#define GAS __attribute__((address_space(1)))
#define LAS __attribute__((address_space(3)))
typedef unsigned short bf16_t;
typedef short bf16x8 __attribute__((ext_vector_type(8)));
typedef short s16x4 __attribute__((ext_vector_type(4)));
typedef float f32x2 __attribute__((ext_vector_type(2)));
typedef float f32x4 __attribute__((ext_vector_type(4)));
typedef float f32x16 __attribute__((ext_vector_type(16)));
typedef unsigned u32x2 __attribute__((ext_vector_type(2)));
typedef unsigned u32x4 __attribute__((ext_vector_type(4)));
typedef GAS unsigned gu32;

constexpr int NB = 8, SEQ = 4096, DM = 1024, MROWS = NB * SEQ, CTXL = 256, MCTX = NB * CTXL, MTOT = MROWS + MCTX;
constexpr int KVL = CTXL + SEQ;
constexpr int NHEAD = 4, QKW = 512;
constexpr int HYW = 512, HYC = 1536, INC = 3072, QKVC = 1536;
constexpr int NEXP = 32, TOPK = 4, NMOD = 6;
constexpr float EPS = 1e-6f;
constexpr float LAM_INIT = 0.2f;
constexpr float QSCALE = 0.125f * 1.4426950408889634f;

constexpr size_t MiB = 1u << 20;
constexpr size_t WS_CTL = 0, CTL_ZERO_BYTES = 1 * MiB;
constexpr size_t WS_SMALL = 1 * MiB;
constexpr size_t WS_WIN = 2 * MiB;
constexpr size_t WS_WOUT = 8 * MiB;
constexpr size_t WS_W1 = 10 * MiB;
constexpr size_t WS_W2 = 138 * MiB;
constexpr size_t WS_H = 202 * MiB;
constexpr size_t WS_Q = 270 * MiB;
constexpr size_t WS_K = 302 * MiB;
constexpr size_t WS_V = 336 * MiB;
constexpr size_t WS_UT = 370 * MiB;
constexpr size_t WS_FILT = 466 * MiB;
constexpr size_t WS_Z2T = 498 * MiB;
constexpr size_t WS_MIX = 530 * MiB;
constexpr size_t WS_ROUTE = 594 * MiB;
constexpr size_t WS_ACT = 270 * MiB;
constexpr size_t WS_EO = 598 * MiB;
constexpr size_t WS_XN = 870 * MiB;
constexpr size_t WS_END = 998 * MiB;
constexpr size_t SM_MOD = 0;
constexpr size_t SM_SCAL = 256 * 1024;
constexpr size_t SM_ROPE = 260 * 1024;
constexpr int CW_BAR = 4096;

constexpr int RING_BYTES = 131072;
constexpr int LDSCTL_OFF = 151552;
constexpr int LDS_BYTES = 152576;
constexpr int NWAVES = 8;

#define LDS_WAIT() asm volatile("s_waitcnt lgkmcnt(0)" ::: "memory")
#define VM_WAIT() asm volatile("s_waitcnt vmcnt(0)" ::: "memory")
#define RLX_AGENT __ATOMIC_RELAXED, __HIP_MEMORY_SCOPE_AGENT

__device__ __forceinline__ unsigned cvt_pk_bf16(float lo, float hi) { unsigned r; asm volatile("v_cvt_pk_bf16_f32 %0, %1, %2" : "=v"(r) : "v"(lo), "v"(hi)); return r; }
__device__ __forceinline__ float bf2f(bf16_t v) { return __uint_as_float(((unsigned)v) << 16); }
__device__ __forceinline__ float wave_sum(float v) {
#pragma unroll
    for (int o = 1; o < 64; o <<= 1) v += __shfl_xor(v, o);
    return v;
}

#define XB_TMO      128
#define XB_XCNT(j)  (256  + 64 * (j))
#define XB_XSUB(j)  (1280 + 64 * (j))
#define XB_XGEN(j)  (2304 + 64 * (j))
#define XB_TOP      3328
#define XB_TOPGEN   3392
#define XCD_BAR_WORDS 3456
#define XB_SPIN_CAP (1u << 22)
__device__ __forceinline__ unsigned xb_ld(unsigned* p)              { return __hip_atomic_load(p, __ATOMIC_RELAXED, __HIP_MEMORY_SCOPE_AGENT); }
__device__ __forceinline__ unsigned xb_add(unsigned* p, unsigned v) { return __hip_atomic_fetch_add(p, v, __ATOMIC_RELAXED, __HIP_MEMORY_SCOPE_AGENT); }
__device__ __forceinline__ unsigned xb_xcc_id() { return (unsigned)__builtin_amdgcn_s_getreg((3 << 11) | 20) & 0xFu; }
#define XB_SPIN(cond, bar) do { unsigned _sp = 0; while (cond) { __builtin_amdgcn_s_sleep(1); \
    if ((++_sp & 255u) == 0u) { if (xb_ld(&(bar)[XB_TMO])) break; if (_sp > XB_SPIN_CAP) { atomicAdd(&(bar)[XB_TMO], 1u); break; } } } } while (0)
struct XcdBarrier { unsigned* bar; unsigned x; volatile LAS unsigned* st; };
__device__ __forceinline__ XcdBarrier xcd_barrier_post(unsigned* bar, volatile LAS unsigned* st, bool leader) {
    XcdBarrier b; b.bar = bar; b.x = xb_xcc_id(); b.st = st;
    if (leader) (void)xb_add(&bar[XB_XCNT(b.x)], 1u);
    return b;
}
__device__ __forceinline__ void xcd_barrier_complete(unsigned* bar, unsigned x, unsigned& nloc, unsigned& nx) {
    const unsigned G = gridDim.x * gridDim.y * gridDim.z;
    unsigned sum, cnt, mine, sp = 0u;
    for (;;) {
        sum = 0u; cnt = 0u; mine = 0u;
#pragma unroll
        for (unsigned j = 0; j < 16; ++j) { const unsigned c = xb_ld(&bar[XB_XCNT(j)]); sum += c; cnt += (c > 0u) ? 1u : 0u; mine = (j == x) ? c : mine; }
        if (sum == G) break;
        __builtin_amdgcn_s_sleep(1);
        if ((++sp & 255u) == 0u) { if (xb_ld(&bar[XB_TMO])) break; if (sp > XB_SPIN_CAP) { atomicAdd(&bar[XB_TMO], 1u); break; } }
    }
    nloc = mine > 0u ? mine : 1u; nx = cnt > 0u ? cnt : 1u;
}
__device__ __forceinline__ void xcd_barrier(const XcdBarrier& b, bool leader) {
    asm volatile("s_waitcnt vmcnt(0)" ::: "memory");
    __syncthreads();
    if (leader) {
        unsigned* bar = b.bar;
        __builtin_amdgcn_s_waitcnt(0);
        unsigned nloc = b.st[0], nx = b.st[1];
        if (nloc == 0u) { xcd_barrier_complete(bar, b.x, nloc, nx); b.st[0] = nloc; b.st[1] = nx; }
        const unsigned old = xb_add(&bar[XB_XSUB(b.x)], 1u);
        const unsigned gen = old / nloc;
        if (old + 1u == (gen + 1u) * nloc) {
            __builtin_amdgcn_fence(__ATOMIC_RELEASE, "agent");
            asm volatile("s_waitcnt vmcnt(0)" ::: "memory");
            const unsigned og = xb_add(&bar[XB_TOP], 1u);
            const unsigned tg = og / nx;
            if (og + 1u == (tg + 1u) * nx) xb_add(&bar[XB_TOPGEN], 1u);
            else XB_SPIN(xb_ld(&bar[XB_TOPGEN]) == tg, bar);
            __builtin_amdgcn_fence(__ATOMIC_ACQUIRE, "agent");
            xb_add(&bar[XB_XGEN(b.x)], 1u);
            asm volatile("s_waitcnt vmcnt(0)" ::: "memory");
        } else {
            XB_SPIN(xb_ld(&bar[XB_XGEN(b.x)]) == gen, bar);
            __builtin_amdgcn_fence(__ATOMIC_ACQUIRE, "agent");
            asm volatile("s_waitcnt vmcnt(0)" ::: "memory");
        }
    }
    __syncthreads();
}

namespace g8 {
constexpr int BM = 256, BK = 64, HALF = 128, HTB = HALF * BK * 2, STAGE_BYTES = 8 * HTB, NXCD = 8, WGM = 8;
__host__ __device__ __forceinline__ int lds_byte(int r, int c) { const int st = (r >> 4) * 2 + (c >> 5), rr = r & 15, cc = c & 31, ob = rr * 64 + cc * 2; return st * 1024 + (ob ^ (((ob >> 9) & 1) << 5)); }
__host__ __device__ __forceinline__ void stage_rc(int b, int& R, int& C) { const int st = b / 1024, sb = b % 1024, swz = sb ^ (((sb >> 9) & 1) << 5); R = (st >> 1) * 16 + swz / 64; C = (st & 1) * 32 + (swz % 64) / 2; }
__host__ __device__ __forceinline__ int perm32(int rho) { const int n = rho >> 4, i = rho & 15; return 8 * (i >> 2) + 4 * n + (i & 3); }

struct Unit { const char* a; const char* b; int pm, pn, kind, ex; };

__device__ __forceinline__ void tile_of(int L, int nM, int nN, int& pm, int& pn) {
    const int nwg = nM * nN; int wgid = L;
    { const int q = nwg / NXCD, r = nwg % NXCD, xcd = wgid % NXCD, off = wgid / NXCD; wgid = (xcd < r ? xcd * (q + 1) : r * (q + 1) + (xcd - r) * q) + off; }
    const int nig = WGM * nN, gid = wgid / nig, fm = gid * WGM, gsz = (nM - fm) < WGM ? (nM - fm) : WGM;
    pm = fm + ((wgid % nig) % gsz); pn = (wgid % nig) / gsz;
}

typedef int i32x8 __attribute__((ext_vector_type(8)));
template <bool FP8, class Epi, class Sched>
__device__ __forceinline__ void gemm_phase(LAS unsigned char* lds, const int K, const Sched& S, const Epi& E, const int wid, const int lane) {
    const int tid = wid * 64 + lane, wr = wid >> 2, wc = wid & 3, fr = lane & 15, fq = lane >> 4;
    const int nt = FP8 ? K / 128 : K / BK;
    const int RP = FP8 ? K : 2 * K;
    unsigned voffA[2], voffB[2];
#pragma unroll
    for (int i = 0; i < 2; ++i) { int R, C; stage_rc(tid * 16 + i * 8192, R, C); const int Rb = (R & ~31) + perm32(R & 31);
        voffA[i] = (unsigned)(R * RP + C * 2); voffB[i] = (unsigned)(Rb * RP + C * 2); }
    const size_t kstep = (size_t)(BK * 2);
    const size_t hstep = (size_t)HALF * RP;
    const unsigned ldsw = (unsigned)wid * 1024u;
    const int aoff = lds_byte(wr * 64 + fr, FP8 ? fq * 16 : fq * 8), boff = lds_byte(wc * 32 + fr, FP8 ? fq * 16 : fq * 8);
    constexpr int KOFF = FP8 ? 16 : 1024;
#define PG8_SA(b, h) (((b) * 2 + (h)) * HTB)
#define PG8_SB(b, h) ((4 + (b) * 2 + (h)) * HTB)
#define PG8_STAGE(bufoff, gbase, voff) do { _Pragma("unroll") for (int _i = 0; _i < 2; ++_i) \
        __builtin_amdgcn_global_load_lds((const unsigned*)((const char*)(gbase) + (voff)[_i]), (LAS unsigned*)(lds + (bufoff) + ldsw + _i * 8192), 16, 0, 0); } while (0)
#define PG8_LD32(p) __builtin_bit_cast(i32x8, __builtin_shufflevector(*(const LAS u32x4*)(p), *(const LAS u32x4*)((p) + 16), 0, 1, 2, 3, 4, 5, 6, 7))
#define PG8_LDA8(dst, b, h) do { _Pragma("unroll") for (int m = 0; m < 4; ++m) dst[m] = PG8_LD32(lds + PG8_SA(b, h) + aoff + m * 2048); } while (0)
#define PG8_LDB8(dst, b, h) do { _Pragma("unroll") for (int n = 0; n < 2; ++n) dst[n] = PG8_LD32(lds + PG8_SB(b, h) + boff + n * 2048); } while (0)
#define PG8_LDA(dst, b, h) do { _Pragma("unroll") for (int m = 0; m < 4; ++m) _Pragma("unroll") for (int k = 0; k < 2; ++k) dst[m][k] = *(const LAS bf16x8*)(lds + PG8_SA(b, h) + aoff + m * 2048 + k * KOFF); } while (0)
#define PG8_LDB(dst, b, h) do { _Pragma("unroll") for (int n = 0; n < 2; ++n) _Pragma("unroll") for (int k = 0; k < 2; ++k) dst[n][k] = *(const LAS bf16x8*)(lds + PG8_SB(b, h) + boff + n * 2048 + k * KOFF); } while (0)
#define PG8_MMA(ai, bj, At, Bt) do { __builtin_amdgcn_s_setprio(1); _Pragma("unroll") for (int m = 0; m < 4; ++m) _Pragma("unroll") for (int n = 0; n < 2; ++n) _Pragma("unroll") for (int k = 0; k < 2; ++k) \
        acc[ai][bj][m][n] = __builtin_amdgcn_mfma_f32_16x16x32_bf16(Bt[n][k], At[m][k], acc[ai][bj][m][n], 0, 0, 0); __builtin_amdgcn_s_setprio(0); } while (0)
#define PG8_MMA8(ai, bj, At, Bt) do { __builtin_amdgcn_s_setprio(1); _Pragma("unroll") for (int m = 0; m < 4; ++m) _Pragma("unroll") for (int n = 0; n < 2; ++n) \
        asm volatile("v_mfma_scale_f32_16x16x128_f8f6f4 %0, %1, %2, %0, %3, %3 op_sel_hi:[0,0,0]" : "+v"(acc[ai][bj][m][n]) : "v"(Bt[n]), "v"(At[m]), "v"(one_scale)); __builtin_amdgcn_s_setprio(0); } while (0)
#define PG8_WAIT_V(n) asm volatile("s_waitcnt vmcnt(" #n ")" ::: "memory")
#define PG8_WAIT_L(n) asm volatile("s_waitcnt lgkmcnt(" #n ")" ::: "memory")
#define PG8_BAR __builtin_amdgcn_s_barrier()
#define PG8_SCHED __builtin_amdgcn_sched_barrier(0)
    Unit cur, nxt; int ui = 0;
    if (!S.next(0, cur)) return;
    f32x4 acc[2][2][4][2];
#pragma unroll
    for (int a = 0; a < 2; ++a)
#pragma unroll
        for (int b = 0; b < 2; ++b)
#pragma unroll
            for (int m = 0; m < 4; ++m)
#pragma unroll
                for (int n = 0; n < 2; ++n) acc[a][b][m][n] = (f32x4){0.f, 0.f, 0.f, 0.f};
    bf16x8 At[4][2], B0[2][2], B1[2][2];
    i32x8 At8[4], B08[2], B18[2];
    const unsigned one_scale = 0x7f7f7f7fu;
    const char* cA = cur.a; const char* cB = cur.b;
    PG8_STAGE(PG8_SB(0, 0), cB, voffB); PG8_STAGE(PG8_SB(0, 1), cB + hstep, voffB); PG8_STAGE(PG8_SA(0, 0), cA, voffA); PG8_STAGE(PG8_SA(0, 1), cA + hstep, voffA);
    if (wr == 1) PG8_BAR;
    PG8_WAIT_V(2); PG8_BAR;
    PG8_STAGE(PG8_SB(1, 0), cB + kstep, voffB); PG8_STAGE(PG8_SA(1, 0), cA + kstep, voffA); PG8_STAGE(PG8_SB(1, 1), cB + hstep + kstep, voffB);
    PG8_WAIT_V(6); PG8_BAR;
    for (;;) {
        const bool has_next = S.next(ui + 1, nxt);
        const char* nA = has_next ? nxt.a : cA; const char* nB = has_next ? nxt.b : cB;
#pragma unroll 1
        for (int t = 0; t < nt; t += 2) {
            const bool last = (t == nt - 2);
            const char* a1 = cA + (size_t)(t + 1) * kstep;
            const char* a2 = last ? nA : cA + (size_t)(t + 2) * kstep; const char* b2 = last ? nB : cB + (size_t)(t + 2) * kstep;
            const char* a3 = a2 + kstep; const char* b3 = b2 + kstep;
            if constexpr (FP8) {
            PG8_LDB8(B08, 0, 0); PG8_LDB8(B18, 0, 1); PG8_SCHED; PG8_LDA8(At8, 0, 0); PG8_STAGE(PG8_SA(1, 1), a1 + hstep, voffA);
            PG8_WAIT_V(8); PG8_WAIT_L(0); PG8_BAR; PG8_MMA8(0, 0, At8, B08); PG8_MMA8(0, 1, At8, B18); PG8_BAR; PG8_SCHED;
            PG8_LDA8(At8, 0, 1); PG8_STAGE(PG8_SB(0, 0), b2, voffB); PG8_STAGE(PG8_SB(0, 1), b2 + hstep, voffB); PG8_STAGE(PG8_SA(0, 0), a2, voffA);
            PG8_WAIT_V(8); PG8_WAIT_L(0); PG8_BAR; PG8_MMA8(1, 0, At8, B08); PG8_MMA8(1, 1, At8, B18); PG8_BAR; PG8_SCHED;
            PG8_LDB8(B08, 1, 0); PG8_LDB8(B18, 1, 1); PG8_SCHED; PG8_LDA8(At8, 1, 0); PG8_STAGE(PG8_SA(0, 1), a2 + hstep, voffA);
            PG8_WAIT_V(8); PG8_WAIT_L(0); PG8_BAR; PG8_MMA8(0, 0, At8, B08); PG8_MMA8(0, 1, At8, B18); PG8_BAR; PG8_SCHED;
            PG8_LDA8(At8, 1, 1); PG8_STAGE(PG8_SB(1, 0), b3, voffB); PG8_STAGE(PG8_SB(1, 1), b3 + hstep, voffB); PG8_STAGE(PG8_SA(1, 0), a3, voffA);
            PG8_WAIT_V(8); PG8_WAIT_L(0); PG8_BAR; PG8_MMA8(1, 0, At8, B08); PG8_MMA8(1, 1, At8, B18); PG8_BAR; PG8_SCHED;
            } else {
            PG8_LDB(B0, 0, 0); PG8_LDB(B1, 0, 1); PG8_SCHED; PG8_LDA(At, 0, 0); PG8_STAGE(PG8_SA(1, 1), a1 + hstep, voffA);
            PG8_WAIT_V(8); PG8_WAIT_L(0); PG8_BAR; PG8_MMA(0, 0, At, B0); PG8_MMA(0, 1, At, B1); PG8_BAR; PG8_SCHED;
            PG8_LDA(At, 0, 1); PG8_STAGE(PG8_SB(0, 0), b2, voffB); PG8_STAGE(PG8_SB(0, 1), b2 + hstep, voffB); PG8_STAGE(PG8_SA(0, 0), a2, voffA);
            PG8_WAIT_V(8); PG8_WAIT_L(0); PG8_BAR; PG8_MMA(1, 0, At, B0); PG8_MMA(1, 1, At, B1); PG8_BAR; PG8_SCHED;
            PG8_LDB(B0, 1, 0); PG8_LDB(B1, 1, 1); PG8_SCHED; PG8_LDA(At, 1, 0); PG8_STAGE(PG8_SA(0, 1), a2 + hstep, voffA);
            PG8_WAIT_V(8); PG8_WAIT_L(0); PG8_BAR; PG8_MMA(0, 0, At, B0); PG8_MMA(0, 1, At, B1); PG8_BAR; PG8_SCHED;
            PG8_LDA(At, 1, 1); PG8_STAGE(PG8_SB(1, 0), b3, voffB); PG8_STAGE(PG8_SB(1, 1), b3 + hstep, voffB); PG8_STAGE(PG8_SA(1, 0), a3, voffA);
            PG8_WAIT_V(8); PG8_WAIT_L(0); PG8_BAR; PG8_MMA(1, 0, At, B0); PG8_MMA(1, 1, At, B1); PG8_BAR; PG8_SCHED;
            }
        }
        if (wr == 0) PG8_BAR;
        if constexpr (FP8) asm volatile("s_nop 15\n\ts_nop 15" ::: "memory");
        E(acc, cur, wr, wc, fr, fq);
        if (!has_next) break;
#pragma unroll
        for (int a = 0; a < 2; ++a)
#pragma unroll
            for (int b = 0; b < 2; ++b)
#pragma unroll
                for (int m = 0; m < 4; ++m)
#pragma unroll
                    for (int n = 0; n < 2; ++n) acc[a][b][m][n] = (f32x4){0.f, 0.f, 0.f, 0.f};
        cur = nxt; cA = nA; cB = nB; ++ui;
        if (wr == 1) PG8_BAR;
    }
    PG8_WAIT_V(0);
    PG8_BAR;
#undef PG8_SA
#undef PG8_SB
#undef PG8_STAGE
#undef PG8_LDA
#undef PG8_LDB
#undef PG8_MMA
#undef PG8_MMA8
#undef PG8_LDA8
#undef PG8_LDB8
#undef PG8_LD32
#undef PG8_WAIT_V
#undef PG8_WAIT_L
#undef PG8_BAR
#undef PG8_SCHED
}
}

__device__ __forceinline__ int lane_id() { int l; asm volatile("v_mbcnt_lo_u32_b32 %0, -1, 0\n\tv_mbcnt_hi_u32_b32 %0, -1, %0" : "=v"(l)); return l; }
#define FT_DECL const int f_lane = lane_id(), f_tid = F.wave * 64 + f_lane; (void)f_tid; (void)f_lane
typedef const float* cfp_t;
typedef __attribute__((address_space(4))) cfp_t* kin_t;
struct Frame {
    LAS unsigned char* lds;
    volatile LAS unsigned* MISC;
    gu32* ctl;
    int wave, vcu, G;
    kin_t in;
    float* out;
    unsigned char* ws;
};
#define WSP(T, off) ((T*)(F.ws + (off)))

template <class RowMap>
__device__ __forceinline__ void p0_transpose_item(const float* W, int K, int N, bf16_t* WT, const RowMap& rowmap, const float* kscale, LAS float* scr, int item, int lane) {
    const int nblk = N / 32, kb = item / nblk, nb = item % nblk, k0 = 64 * kb, n0 = 32 * nb;
#pragma unroll 8
    for (int i = 0; i < 32; ++i) { const int kk = 2 * i + (lane >> 5); float v = W[(size_t)(k0 + kk) * N + n0 + (lane & 31)]; if (kscale) v *= kscale[k0 + kk]; scr[kk * 33 + (lane & 31)] = v; }
    LDS_WAIT(); asm volatile("" ::: "memory");
    const int c = lane & 7;
#pragma unroll
    for (int j = 0; j < 4; ++j) { const int n = (lane >> 3) + 8 * j; const LAS float* s = scr + (8 * c) * 33 + n;
        u32x4 o; o.x = cvt_pk_bf16(s[0 * 33], s[1 * 33]); o.y = cvt_pk_bf16(s[2 * 33], s[3 * 33]); o.z = cvt_pk_bf16(s[4 * 33], s[5 * 33]); o.w = cvt_pk_bf16(s[6 * 33], s[7 * 33]);
        *(GAS u32x4*)(WT + (size_t)rowmap(n0 + n) * K + k0 + 8 * c) = o; }
    LDS_WAIT(); asm volatile("" ::: "memory");
}

__device__ __forceinline__ unsigned pk4_fp8(float a, float b, float c, float d) { int r = __builtin_amdgcn_cvt_pk_fp8_f32(a, b, 0, false); r = __builtin_amdgcn_cvt_pk_fp8_f32(c, d, r, true); return (unsigned)r; }
constexpr float EOSCALE = 16.f;
constexpr float WSCALE = 32.f;
template <class RowMap>
__device__ __forceinline__ void p0_transpose_item_f8(const float* W, int K, int N, unsigned char* WT, const RowMap& rowmap, LAS float* scr, int item, int lane) {
    const int nblk = N / 32, kb = item / nblk, nb = item % nblk, k0 = 128 * kb, n0 = 32 * nb;
#pragma unroll
    for (int hh = 0; hh < 2; ++hh) { float v[32];
#pragma unroll
        for (int i = 0; i < 32; ++i) { const int kk = 2 * (32 * hh + i) + (lane >> 5); v[i] = __builtin_nontemporal_load(W + (size_t)(k0 + kk) * N + n0 + (lane & 31)); }
#pragma unroll
        for (int i = 0; i < 32; ++i) { const int kk = 2 * (32 * hh + i) + (lane >> 5); scr[kk * 33 + (lane & 31)] = v[i] * WSCALE; } }
    LDS_WAIT(); asm volatile("" ::: "memory");
    const int c = lane & 7;
#pragma unroll
    for (int j = 0; j < 4; ++j) { const int n = (lane >> 3) + 8 * j; const LAS float* sp = scr + (16 * c) * 33 + n;
        u32x4 o; o.x = pk4_fp8(sp[0 * 33], sp[1 * 33], sp[2 * 33], sp[3 * 33]); o.y = pk4_fp8(sp[4 * 33], sp[5 * 33], sp[6 * 33], sp[7 * 33]);
        o.z = pk4_fp8(sp[8 * 33], sp[9 * 33], sp[10 * 33], sp[11 * 33]); o.w = pk4_fp8(sp[12 * 33], sp[13 * 33], sp[14 * 33], sp[15 * 33]);
        *(GAS u32x4*)(WT + (size_t)rowmap(n0 + n) * K + k0 + 16 * c) = o; }
    LDS_WAIT(); asm volatile("" ::: "memory");
}
struct MapIdent { int off; __device__ __forceinline__ int operator()(int n) const { return off + n; } };
struct MapWin { __device__ __forceinline__ int operator()(int l) const {
    if (l >= QKVC) return l;
    const int t = l & ~255, r = l & 255, wc = r >> 6, blk = (r >> 5) & 1, bj = (r >> 4) & 1, low = r & 15;
    return t + 128 * bj + 32 * wc + 16 * blk + low; } };
struct MapW1 { int off; __device__ __forceinline__ int operator()(int jp) const { const int bj = jp >> 10, j = jp & 1023; return off + 256 * (j >> 7) + 128 * bj + (j & 127); } };


__device__ __forceinline__ void p0_filter_item(Frame& F, int item) {
    FT_DECL;
#define in F.in
    LAS float* h1s = (LAS float*)(F.lds);
    LAS float* h2s = (LAS float*)(F.lds + 4096);
    const int t0 = item * 16;
    {
        const int tt = f_tid >> 5, hh = (f_tid & 31) * 2; const float pos = (float)(t0 + tt);
        float feats[17]; feats[0] = pos * (1.f / SEQ);
#pragma unroll
        for (int i = 0; i < 8; ++i) { const float band = 1e-4f + (float)i * ((7.f - 1e-4f) / 7.f); const float ang = (6.283185307179586f / SEQ) * pos * band; feats[1 + i] = sinf(ang); feats[9 + i] = cosf(ang); }
#pragma unroll
        for (int u = 0; u < 2; ++u) { const int h = hh + u; float a = in[19][h];
#pragma unroll
            for (int k = 0; k < 17; ++k) a += feats[k] * in[18][k * 64 + h];
            h1s[tt * 64 + h] = sinf(in[20][h] * a); }
        __syncthreads();
#pragma unroll
        for (int u = 0; u < 2; ++u) { const int h = hh + u; float a = in[22][h];
#pragma unroll 8
            for (int k = 0; k < 64; ++k) a += h1s[tt * 64 + k] * in[21][k * 64 + h];
            h2s[tt * 64 + h] = sinf(in[23][h] * a); }
        __syncthreads();
    }
    f32x4 acc[16];
#pragma unroll
    for (int t = 0; t < 16; ++t) acc[t] = (f32x4){0.f, 0.f, 0.f, 0.f};
    const int o = 4 * f_tid;
    for (int k = 0; k < 64; ++k) { const f32x4 w = *(const f32x4*)(in[24] + (size_t)k * 2048 + o);
#pragma unroll
        for (int t = 0; t < 16; ++t) acc[t] += w * h2s[t * 64 + k]; }
    const int c0 = o & 511, od = o >> 9;
    float* dst = WSP(float, WS_FILT) + ((size_t)od * 512 + c0) * SEQ + t0;
#pragma unroll
    for (int e = 0; e < 4; ++e) { const float la = -3.0701134573253944f, lb = -15.350567286626972f; const float delta = fabsf(la + (float)(c0 + e) * ((lb - la) / 511.f));
#pragma unroll
        for (int q = 0; q < 4; ++q) { f32x4 v;
#pragma unroll
            for (int i = 0; i < 4; ++i) { const int t = 4 * q + i; const float tn = (float)(t0 + t) * (1.f / SEQ); v[i] = acc[t][e] * expf(-tn * delta); }
            *(f32x4*)(dst + (size_t)e * SEQ + 4 * q) = v; } }
    __syncthreads();
#undef in
}

__device__ __forceinline__ float silu_f(float v) { return v / (1.f + __expf(-v)); }

__device__ __forceinline__ void p0_prologue(Frame& F) {
    FT_DECL;
#define in F.in
    const int wg = blockIdx.x;
    if (wg < 96) {
        LAS float* sv = (LAS float*)F.lds;
        for (int i = f_tid; i < 9 * 1024; i += 512) { const int r = i >> 10, k = i & 1023; const float c = (r < 8) ? in[1][r * 1024 + k] : in[3][k]; sv[i] = silu_f(c); }
        __syncthreads();
        const int j = wg * 64 + f_lane; const float* wm = in[4];
        float acc[9];
#pragma unroll
        for (int r = 0; r < 9; ++r) acc[r] = 0.f;
        const int kbeg = F.wave * 128;
#pragma unroll 4
        for (int k = kbeg; k < kbeg + 128; ++k) { const float w = wm[(size_t)k * (NMOD * DM) + j];
#pragma unroll
            for (int r = 0; r < 9; ++r) acc[r] += sv[r * 1024 + k] * w; }
        LAS float* red = (LAS float*)(F.lds + 40960);
#pragma unroll
        for (int r = 0; r < 9; ++r) red[(F.wave * 9 + r) * 64 + f_lane] = acc[r];
        __syncthreads();
        for (int i = f_tid; i < 9 * 64; i += 512) { const int r = i >> 6, l = i & 63; float s = in[5][wg * 64 + l];
#pragma unroll
            for (int w = 0; w < 8; ++w) s += red[(w * 9 + r) * 64 + l];
            WSP(float, WS_SMALL + SM_MOD)[r * (NMOD * DM) + wg * 64 + l] = s; }
        __syncthreads();
    } else if (wg == 96) {
        if (F.wave == 0) {
            const float a = wave_sum(in[11][f_lane] * in[12][f_lane]), b = wave_sum(in[13][f_lane] * in[14][f_lane]);
            float gq = fabsf(in[9][f_lane]), gk = fabsf(in[10][f_lane]);
#pragma unroll
            for (int o = 1; o < 64; o <<= 1) { gq = fmaxf(gq, __shfl_xor(gq, o)); gk = fmaxf(gk, __shfl_xor(gk, o)); }
            if (f_lane == 0) { float* sc = WSP(float, WS_SMALL + SM_SCAL); sc[0] = expf(a) - expf(b) + LAM_INIT;
                sc[1] = (8.f * gq * gk * 1.02f + 0.05f) * 1.4426950408889634f; }
        }
        for (int i = f_tid; i < 64 * 16; i += 512) { const int pos = i >> 4, f = i & 15;
            const float inv = powf(10000.f, -(float)f / 16.f); const float ang = (float)pos * inv;
            float* rt = WSP(float, WS_SMALL + SM_ROPE); rt[2 * i] = cosf(ang); rt[2 * i + 1] = sinf(ang); }
    }
    __syncthreads();
    for (int it = wg; it < SEQ / 16; it += F.G) p0_filter_item(F, it);
    __syncthreads();
    {
        LAS float* scr = (LAS float*)(F.lds + F.wave * 16896);
        const int gw = F.vcu * NWAVES + F.wave, NGW = F.G * NWAVES;
        constexpr int I_IN = (DM / 64) * (INC / 32), I_OUT = (DM / 64) * (DM / 32), I_1 = (DM / 128) * (2 * DM / 32), I_2 = (DM / 128) * (DM / 32);
        constexpr int NITEMS = I_IN + I_OUT + NEXP * (I_1 + I_2);
        for (int it = gw; it < NITEMS; it += NGW) {
            int r = it;
            if (r < I_IN) { p0_transpose_item(in[8], DM, INC, WSP(bf16_t, WS_WIN), MapWin{}, nullptr, scr, r, f_lane); continue; } r -= I_IN;
            if (r < I_OUT) { p0_transpose_item(in[27], DM, DM, WSP(bf16_t, WS_WOUT), MapIdent{0}, nullptr, scr, r, f_lane); continue; } r -= I_OUT;
            const int e = r / (I_1 + I_2); r -= e * (I_1 + I_2);
            if (r < I_1) p0_transpose_item_f8(in[30] + (size_t)e * DM * 2 * DM, DM, 2 * DM, WSP(unsigned char, WS_W1) + (size_t)e * 2 * DM * DM, MapW1{0}, scr, r, f_lane);
            else p0_transpose_item_f8(in[32] + (size_t)e * DM * DM, DM, DM, WSP(unsigned char, WS_W2) + (size_t)e * DM * DM, MapIdent{0}, scr, r - I_1, f_lane);
        }
    }
}
#undef in

__device__ __forceinline__ void p1_norm1(Frame& F) {
    FT_DECL;
    const int gw = F.vcu * NWAVES + F.wave, NGW = F.G * NWAVES;
    const float* mod = WSP(float, WS_SMALL + SM_MOD); const float* g1 = F.in[6];
    bf16_t* H = WSP(bf16_t, WS_H);
    constexpr int RU = 4;
    for (int m0 = gw; m0 < MTOT; m0 += NGW * RU) {
        f32x4 v[RU][4];
#pragma unroll
        for (int u = 0; u < RU; ++u) { const int m = m0 + u * NGW; if (m < MTOT) {
            const float* xrow = (m < MROWS) ? F.in[0] + (size_t)m * DM : F.in[2] + (size_t)(m - MROWS) * DM; const GAS f32x4* xr = (const GAS f32x4*)xrow + f_lane;
#pragma unroll
            for (int j = 0; j < 4; ++j) v[u][j] = __builtin_nontemporal_load(xr + 64 * j); } }
#pragma unroll
        for (int u = 0; u < RU; ++u) { const int m = m0 + u * NGW; if (m < MTOT) {
            const int mb = (m < MROWS) ? (m >> 12) : 8;
            const float* sh = mod + (size_t)mb * (NMOD * DM); const float* sc = sh + DM;
            float s = 0.f;
#pragma unroll
            for (int j = 0; j < 4; ++j) s += (v[u][j].x * v[u][j].x + v[u][j].y * v[u][j].y) + (v[u][j].z * v[u][j].z + v[u][j].w * v[u][j].w);
            const float rstd = rsqrtf(wave_sum(s) * (1.f / DM) + EPS);
            GAS u32x2* o8 = (GAS u32x2*)(H + (size_t)m * DM) + f_lane;
#pragma unroll
            for (int j = 0; j < 4; ++j) { const int c = 4 * f_lane + 256 * j;
                const f32x4 g = *(const f32x4*)(g1 + c), a = *(const f32x4*)(sc + c), b = *(const f32x4*)(sh + c);
                const f32x4 y = v[u][j] * rstd * g * (a + 1.f) + b;
                u32x2 w; w.x = cvt_pk_bf16(y.x, y.y); w.y = cvt_pk_bf16(y.z, y.w); o8[64 * j] = w; } } }
    }
}

struct SchedInProj {
    int G, c; const char* H; const char* W;
    static constexpr int NA = 136 * 6, NBU = 6 * 128;
    __device__ __forceinline__ bool next(int i, g8::Unit& u) const {
        const long L = (long)i * G + c;
        if (L < NA) { g8::tile_of((int)L, 136, 6, u.pm, u.pn); u.a = H + (size_t)u.pm * 256 * DM * 2; u.b = W + (size_t)u.pn * 256 * DM * 2; u.kind = 0; u.ex = 0; return true; }
        if (L < NA + NBU) { g8::tile_of((int)L - NA, 6, 128, u.pm, u.pn); u.a = W + (size_t)(QKVC + u.pm * 256) * DM * 2; u.b = H + (size_t)u.pn * 256 * DM * 2; u.kind = 1; u.ex = 0; return true; }
        return false;
    }
};
struct EpiInProj {
    bf16_t *Q, *Kb, *Vb, *UT; const float *gq, *gk, *rope;
    __device__ __forceinline__ void operator()(f32x4 (&acc)[2][2][4][2], const g8::Unit& u, int wr, int wc, int fr, int fq) const {
        if (u.kind == 1) {
            const int row0 = u.pm * 256 + wr * 64 + fr, col0 = u.pn * 256 + wc * 32 + 8 * fq;
#pragma unroll
            for (int ai = 0; ai < 2; ++ai)
#pragma unroll
                for (int m = 0; m < 4; ++m) { bf16_t* rowp = UT + (size_t)(row0 + ai * 128 + m * 16) * MROWS + col0;
#pragma unroll
                    for (int bj = 0; bj < 2; ++bj) { const f32x4 v0 = acc[ai][bj][m][0], v1 = acc[ai][bj][m][1];
                        u32x4 w; w.x = cvt_pk_bf16(v0[0], v0[1]); w.y = cvt_pk_bf16(v0[2], v0[3]); w.z = cvt_pk_bf16(v1[0], v1[1]); w.w = cvt_pk_bf16(v1[2], v1[3]);
                        *(u32x4*)(rowp + bj * 128) = w; } }
            return;
        }
        const int blk = fq >> 1, f = fq & 1;
        const int sec = u.pn >> 1;
        const bool ctx = (u.pm >= 128);
        if (sec == 0 && ctx) return;
        const int colbase = (u.pn & 1) * 256 + wc * 64 + 32 * blk + 8 * f;
        float gg[2][2][4];
        if (sec < 2) { const float* gp = (sec == 0 ? gq : gk) + 32 * blk + 8 * f;
#pragma unroll
            for (int bj = 0; bj < 2; ++bj)
#pragma unroll
                for (int n = 0; n < 2; ++n) { const f32x4 t = *(const f32x4*)(gp + 16 * bj + 4 * n); gg[bj][n][0] = t[0]; gg[bj][n][1] = t[1]; gg[bj][n][2] = t[2]; gg[bj][n][3] = t[3]; } }
#pragma unroll
        for (int ai = 0; ai < 2; ++ai)
#pragma unroll
            for (int m = 0; m < 4; ++m) {
                const int rloc = ai * 128 + wr * 64 + m * 16 + fr; const int r = u.pm * 256 + rloc;
                f32x4 v[2][2];
#pragma unroll
                for (int bj = 0; bj < 2; ++bj)
#pragma unroll
                    for (int n = 0; n < 2; ++n) v[bj][n] = acc[ai][bj][m][n];
                size_t orow;
                if (sec == 0) orow = (size_t)r;
                else if (!ctx) orow = (size_t)(r >> 12) * KVL + CTXL + (r & 4095);
                else { const int j = r - MROWS; orow = (size_t)(j >> 8) * KVL + (j & 255); }
                if (sec < 2) {
                    float ss = 0.f;
#pragma unroll
                    for (int bj = 0; bj < 2; ++bj)
#pragma unroll
                        for (int n = 0; n < 2; ++n) ss += (v[bj][n][0] * v[bj][n][0] + v[bj][n][1] * v[bj][n][1]) + (v[bj][n][2] * v[bj][n][2] + v[bj][n][3] * v[bj][n][3]);
                    ss += __shfl_xor(ss, 16); ss += __shfl_xor(ss, 32);
                    const float rstd = rsqrtf(ss * (1.f / 64.f) + EPS);
#pragma unroll
                    for (int bj = 0; bj < 2; ++bj)
#pragma unroll
                        for (int n = 0; n < 2; ++n)
#pragma unroll
                            for (int e = 0; e < 4; ++e) v[bj][n][e] *= rstd * gg[bj][n][e];
                    if (!ctx) {
                        const int t = r & 4095; const int pos = blk ? (t & 63) : (t >> 6);
                        const float* rp = rope + (size_t)(pos * 16 + 8 * f) * 2;
#pragma unroll
                        for (int n = 0; n < 2; ++n) { const f32x4 c0 = *(const f32x4*)(rp + 8 * n), c1 = *(const f32x4*)(rp + 8 * n + 4);
                            const float cs[4] = {c0[0], c0[2], c1[0], c1[2]}, sn[4] = {c0[1], c0[3], c1[1], c1[3]};
#pragma unroll
                            for (int e = 0; e < 4; ++e) { const float x1 = v[0][n][e], x2 = v[1][n][e]; v[0][n][e] = x1 * cs[e] - x2 * sn[e]; v[1][n][e] = x2 * cs[e] + x1 * sn[e]; } }
                    }
                    if (sec == 0) {
#pragma unroll
                        for (int bj = 0; bj < 2; ++bj)
#pragma unroll
                            for (int n = 0; n < 2; ++n) v[bj][n] *= QSCALE;
                    }
                }
                bf16_t* dst = (sec == 0 ? Q : (sec == 1 ? Kb : Vb)) + orow * QKW + colbase;
#pragma unroll
                for (int bj = 0; bj < 2; ++bj) { u32x4 w; w.x = cvt_pk_bf16(v[bj][0][0], v[bj][0][1]); w.y = cvt_pk_bf16(v[bj][0][2], v[bj][0][3]); w.z = cvt_pk_bf16(v[bj][1][0], v[bj][1][1]); w.w = cvt_pk_bf16(v[bj][1][2], v[bj][1][3]);
                    *(u32x4*)(dst + 16 * bj) = w; }
            }
    }
};

struct SchedStatic {
    int G, c, nM, nN; const char* A; const char* B;
    __device__ __forceinline__ bool next(int i, g8::Unit& u) const {
        const long L = (long)i * G + c; if (L >= (long)nM * nN) return false;
        g8::tile_of((int)L, nM, nN, u.pm, u.pn); u.a = A + (size_t)u.pm * 256 * DM * 2; u.b = B + (size_t)u.pn * 256 * DM * 2; u.kind = 0; u.ex = 0; return true;
    }
};
struct EpiOutProj {
    const float* x; float* out; const float* mod;
    __device__ __forceinline__ void operator()(f32x4 (&acc)[2][2][4][2], const g8::Unit& u, int wr, int wc, int fr, int fq) const {
        const int col0 = u.pn * 256 + wc * 32 + 8 * fq;
#pragma unroll
        for (int ai = 0; ai < 2; ++ai)
#pragma unroll
            for (int m = 0; m < 4; ++m) { const int r = u.pm * 256 + ai * 128 + wr * 64 + m * 16 + fr; const float* g1 = mod + (size_t)(r >> 12) * (NMOD * DM) + 2 * DM;
                const size_t off = (size_t)r * DM + col0;
#pragma unroll
                for (int bj = 0; bj < 2; ++bj)
#pragma unroll
                    for (int n = 0; n < 2; ++n) { const int c = bj * 128 + 4 * n; const f32x4 xv = *(const f32x4*)(x + off + c), gv = *(const f32x4*)(g1 + col0 + c);
                        *(f32x4*)(out + off + c) = xv + gv * acc[ai][bj][m][n]; } }
    }
};

namespace att {
constexpr int KVBLK = 64, LDK = QKW, NT = KVL / KVBLK;
constexpr int SHM_V = KVBLK * 128 * 2, SHM_K = KVBLK * 128 * 2;
#define KSWZ(row, colB) ((row) * 256 + ((colB) ^ (((row) & 7) << 4)))
#define SBAR() __builtin_amdgcn_sched_barrier(0)
__device__ __forceinline__ int crow(int r, int hi) { return (r & 3) + 8 * (r >> 2) + 4 * hi; }
__device__ __forceinline__ void expA(f32x16& p) {
#pragma unroll
    for (int r = 0; r < 16; ++r) p[r] = __builtin_amdgcn_exp2f(p[r]);
}
__device__ __forceinline__ void finishSM(f32x16& p0, f32x16& p1, float& l_reg, bf16x8& pa0, bf16x8& pa1, bf16x8& pa2, bf16x8& pa3) {
#pragma unroll
    for (int r = 0; r < 16; ++r) p1[r] = __builtin_amdgcn_exp2f(p1[r]);
    float ps = 0;
#pragma unroll
    for (int r = 0; r < 16; ++r) ps += p0[r];
#pragma unroll
    for (int r = 0; r < 16; ++r) ps += p1[r];
    { auto rr = __builtin_amdgcn_permlane32_swap(__float_as_uint(ps), __float_as_uint(ps), false, false); ps = __uint_as_float(rr[0]) + __uint_as_float(rr[1]); }
    l_reg += ps;
#define PK4(P, BASE, OUT) do { unsigned a0 = cvt_pk_bf16(P[BASE + 0], P[BASE + 1]), a1 = cvt_pk_bf16(P[BASE + 2], P[BASE + 3]);   \
    unsigned b0 = cvt_pk_bf16(P[BASE + 4], P[BASE + 5]), b1 = cvt_pk_bf16(P[BASE + 6], P[BASE + 7]);                              \
    auto r0 = __builtin_amdgcn_permlane32_swap(a0, b0, false, false); auto r1 = __builtin_amdgcn_permlane32_swap(a1, b1, false, false); \
    u32x4 w = {r0[0], r1[0], r0[1], r1[1]}; OUT = *reinterpret_cast<bf16x8*>(&w); } while (0)
    PK4(p0, 0, pa0); PK4(p0, 8, pa1); PK4(p1, 0, pa2); PK4(p1, 8, pa3);
#undef PK4
}
__device__ __forceinline__ void qkt(f32x16& p0, f32x16& p1, const char* Ks, const bf16x8* qr, int r32, int hi, int sub, float negm) {
    (void)negm;
    const f32x16 z = {};
#pragma unroll
    for (int d0 = 0; d0 < 4; ++d0) { const int cb = (sub * 64 + d0 * 16 + hi * 8) * 2;
        const bf16x8 b0 = *reinterpret_cast<const bf16x8*>(Ks + KSWZ(r32, cb));
        const bf16x8 b1 = *reinterpret_cast<const bf16x8*>(Ks + KSWZ(32 + r32, cb));
        p0 = __builtin_amdgcn_mfma_f32_32x32x16_bf16(b0, qr[d0], d0 ? p0 : z, 0, 0, 0);
        p1 = __builtin_amdgcn_mfma_f32_32x32x16_bf16(b1, qr[d0], d0 ? p1 : z, 0, 0, 0); }
}
__device__ __forceinline__ int v_st(int k, int c) { const int kk = (k & ~0xC) | ((k & 4) << 1) | ((k & 8) >> 1); return ((kk >> 3) * 4 + (c >> 5)) * 512 + ((kk & 7) * 32 + (c & 31)) * 2; }
__device__ __forceinline__ int v_rd_base(int lane) { return ((lane & 3) << 3) | (((lane >> 2) & 3) << 6) | (((lane >> 4) & 1) << 5) | (((lane >> 5) & 1) << 8); }
constexpr int v_rd_off(int d0, int ks, int half) { return d0 * 512 + ks * 4096 + half * 2048; }
template <int OFF> __device__ __forceinline__ s16x4 tr_read(int vb) {
    s16x4 r; asm volatile("ds_read_b64_tr_b16 %0, %1 offset:%2" : "=&v"(r) : "v"(vb), "i"(OFF) : "memory"); return r;
}
template <int D0> __device__ __forceinline__ void pv_one(f32x16& od, int vb, bf16x8 pa0, bf16x8 pa1, bf16x8 pa2, bf16x8 pa3) {
    const s16x4 l0 = tr_read<v_rd_off(D0, 0, 0)>(vb), h0 = tr_read<v_rd_off(D0, 0, 1)>(vb), l1 = tr_read<v_rd_off(D0, 1, 0)>(vb), h1 = tr_read<v_rd_off(D0, 1, 1)>(vb);
    const s16x4 l2 = tr_read<v_rd_off(D0, 2, 0)>(vb), h2 = tr_read<v_rd_off(D0, 2, 1)>(vb), l3 = tr_read<v_rd_off(D0, 3, 0)>(vb), h3 = tr_read<v_rd_off(D0, 3, 1)>(vb);
    asm volatile("s_waitcnt lgkmcnt(0)" ::: "memory"); SBAR();
#define PK(L, H) (bf16x8){L[0], L[1], L[2], L[3], H[0], H[1], H[2], H[3]}
    od = __builtin_amdgcn_mfma_f32_32x32x16_bf16(pa0, PK(l0, h0), od, 0, 0, 0);
    od = __builtin_amdgcn_mfma_f32_32x32x16_bf16(pa1, PK(l1, h1), od, 0, 0, 0);
    od = __builtin_amdgcn_mfma_f32_32x32x16_bf16(pa2, PK(l2, h2), od, 0, 0, 0);
    od = __builtin_amdgcn_mfma_f32_32x32x16_bf16(pa3, PK(l3, h3), od, 0, 0, 0);
#undef PK
}
__device__ __forceinline__ void pv_d0(f32x16* o, int vb, bf16x8 pa0, bf16x8 pa1, bf16x8 pa2, bf16x8 pa3) {
    pv_one<0>(o[0], vb, pa0, pa1, pa2, pa3); pv_one<1>(o[1], vb, pa0, pa1, pa2, pa3); pv_one<2>(o[2], vb, pa0, pa1, pa2, pa3); pv_one<3>(o[3], vb, pa0, pa1, pa2, pa3);
}

__device__ __forceinline__ void attn_unit(const bf16_t* __restrict__ Qb, const bf16_t* __restrict__ Kh, const bf16_t* __restrict__ Vh, bf16_t* MIXo,
                                          const float lam, const float negm, const float* __restrict__ subg, char* lds, const int wid) {
    const int lane = lane_id(), tid = wid * 64 + lane, r32 = lane & 31, hi = lane >> 5;
    const int sub = wid >> 2, wq = wid & 3;
    char* V_lds = lds; char* K_lds = lds + 2 * SHM_V;
    float* wsf = (float*)(lds + 98304) + wid * 32;
    float l_reg = 0; f32x16 o[4] = {}; bf16x8 qr[4];
    const bf16_t* Qw = Qb + (long)(wq * 32 + r32) * LDK + sub * 64 + hi * 8;
#pragma unroll
    for (int d0 = 0; d0 < 4; ++d0) qr[d0] = *reinterpret_cast<const bf16x8*>(Qw + d0 * 16);
    const int sr = tid >> 4, sc = (tid & 15) * 8, vst0 = v_st(sr, sc), vst1 = v_st(32 + sr, sc);
    const int vb0 = (int)(uintptr_t)V_lds + v_rd_base(lane);
    struct { bf16x8 vs0, vs1, ks0, ks1; } sr_[2];
#define SLOAD(i, k0) do { sr_[i].vs0 = *(const bf16x8*)(&Vh[(long)((k0) + sr) * LDK + sc]); sr_[i].vs1 = *(const bf16x8*)(&Vh[(long)((k0) + 32 + sr) * LDK + sc]); \
    sr_[i].ks0 = *(const bf16x8*)(&Kh[(long)((k0) + sr) * LDK + sc]); sr_[i].ks1 = *(const bf16x8*)(&Kh[(long)((k0) + 32 + sr) * LDK + sc]); } while (0)
#define SWRITE(b, i) do { *(bf16x8*)(V_lds + (b) * SHM_V + vst0) = sr_[i].vs0;          \
    *(bf16x8*)(V_lds + (b) * SHM_V + vst1) = sr_[i].vs1; const int kc = sc * 2;               \
    *(bf16x8*)(K_lds + (b) * SHM_K + KSWZ(sr, kc)) = sr_[i].ks0;                       \
    *(bf16x8*)(K_lds + (b) * SHM_K + KSWZ(32 + sr, kc)) = sr_[i].ks1; } while (0)
#define SWAIT() asm volatile("s_waitcnt vmcnt(4)" ::: "memory")
    f32x16 pA0, pA1, pB0, pB1; bf16x8 pa0, pa1, pa2, pa3;
    constexpr int SE = 0, SO = 1;
    SLOAD(SE, 0); asm volatile("s_waitcnt vmcnt(0)" ::: "memory"); SWRITE(0, SE); __syncthreads();
    qkt(pA0, pA1, K_lds, qr, r32, hi, sub, negm); expA(pA0);
    SLOAD(SO, KVBLK); SLOAD(SE, 2 * KVBLK);
    SWAIT(); SWRITE(1, SO); __syncthreads();
    for (int j = 1; j + 1 < NT; j += 2) {
        SBAR(); qkt(pB0, pB1, K_lds + SHM_K, qr, r32, hi, sub, negm);
        finishSM(pA0, pA1, l_reg, pa0, pa1, pa2, pa3); SBAR();
        SLOAD(SO, (j + 2) * KVBLK); SBAR();
        pv_d0(o, vb0, pa0, pa1, pa2, pa3); expA(pB0);
        __syncthreads(); SWAIT(); SWRITE(0, SE);
        __syncthreads();
        SBAR(); qkt(pA0, pA1, K_lds, qr, r32, hi, sub, negm);
        finishSM(pB0, pB1, l_reg, pa0, pa1, pa2, pa3); SBAR();
        if (j + 3 < NT) SLOAD(SE, (j + 3) * KVBLK); SBAR();
        pv_d0(o, vb0 + SHM_V, pa0, pa1, pa2, pa3); expA(pA0);
        __syncthreads(); SWAIT(); SWRITE(1, SO);
        __syncthreads();
    }
    SBAR(); qkt(pB0, pB1, K_lds + SHM_K, qr, r32, hi, sub, negm);
    finishSM(pA0, pA1, l_reg, pa0, pa1, pa2, pa3); SBAR();
    pv_d0(o, vb0, pa0, pa1, pa2, pa3); expA(pB0);
    finishSM(pB0, pB1, l_reg, pa0, pa1, pa2, pa3); SBAR();
    pv_d0(o, vb0 + SHM_V, pa0, pa1, pa2, pa3);
#undef SLOAD
#undef SWRITE
#undef SWAIT
    if (hi == 0) wsf[r32] = l_reg;
    __syncthreads();
    float* X = (float*)lds;
    float rli[16];
#pragma unroll
    for (int r = 0; r < 16; ++r) rli[r] = __builtin_amdgcn_rcpf(wsf[crow(r, hi)]);
    if (sub == 1) {
#pragma unroll
        for (int r = 0; r < 16; ++r) { const int row = wq * 32 + crow(r, hi); const float s = lam * rli[r];
#pragma unroll
            for (int d0 = 0; d0 < 4; ++d0) X[row * 128 + d0 * 32 + r32] = o[d0][r] * s; }
    }
    __syncthreads();
    bf16_t* Y = (bf16_t*)(lds + 65536);
    if (sub == 0) {
        float sg[4];
#pragma unroll
        for (int d0 = 0; d0 < 4; ++d0) sg[d0] = subg[d0 * 32 + r32] * (1.f - LAM_INIT);
#pragma unroll
        for (int r = 0; r < 16; ++r) { const int row = wq * 32 + crow(r, hi);
            float v[4]; float ss = 0.f;
#pragma unroll
            for (int d0 = 0; d0 < 4; ++d0) { v[d0] = o[d0][r] * rli[r] - X[row * 128 + d0 * 32 + r32]; ss += v[d0] * v[d0]; }
            ss += __shfl_xor(ss, 1); ss += __shfl_xor(ss, 2); ss += __shfl_xor(ss, 4); ss += __shfl_xor(ss, 8); ss += __shfl_xor(ss, 16);
            const float rstd = rsqrtf(ss * (1.f / 128.f) + EPS);
#pragma unroll
            for (int d0 = 0; d0 < 4; ++d0) Y[row * 128 + d0 * 32 + r32] = (bf16_t)(cvt_pk_bf16(v[d0] * rstd * sg[d0], 0.f) & 0xffffu); }
    }
    __syncthreads();
    { const int row = tid >> 2, seg = (tid & 3) * 32;
#pragma unroll
        for (int i = 0; i < 4; ++i) { const u32x4 v = *(const u32x4*)(Y + row * 128 + seg + i * 8); *(u32x4*)(MIXo + (size_t)row * DM + seg + i * 8) = v; } }
    __syncthreads();
}
#undef KSWZ
#undef SBAR
}

__device__ __forceinline__ void p3_attention(Frame& F) {
    FT_DECL;
    const float* sc = WSP(float, WS_SMALL + SM_SCAL);
    const float lam = sc[0], negm = -sc[1];
    const bf16_t* Q = WSP(bf16_t, WS_Q); const bf16_t* Kb = WSP(bf16_t, WS_K); const bf16_t* Vb = WSP(bf16_t, WS_V); bf16_t* MIX = WSP(bf16_t, WS_MIX);
    const int c = blockIdx.x, xcd = c & 7, ci = c >> 3, per = F.G >> 3;
    for (int j = ci; j < 128; j += per) {
        const int pair = xcd * 4 + (j >> 5), qb = j & 31, b = pair >> 2, h = pair & 3;
        att::attn_unit(Q + ((size_t)b * SEQ + qb * 128) * QKW + h * 128, Kb + (size_t)b * KVL * QKW + h * 128, Vb + (size_t)b * KVL * QKW + h * 128,
                       MIX + ((size_t)b * SEQ + qb * 128) * DM + h * 128, lam, negm, F.in[15], (char*)F.lds, F.wave);
    }
}


namespace hy {
constexpr int RB_BYTES = 4352 * 8, IN_OFF = 2 * RB_BYTES, TW1_OFF = IN_OFF + 32768, TW2_OFF = TW1_OFF + 15 * 256 * 8, LDS_END = TW2_OFF + 15 * 16 * 8;
__device__ __forceinline__ f32x2 cmul(f32x2 a, f32x2 b) { return (f32x2){a.x * b.x - a.y * b.y, a.x * b.y + a.y * b.x}; }
__device__ __forceinline__ f32x2 cmulc(f32x2 a, f32x2 b) { return (f32x2){a.x * b.x + a.y * b.y, a.y * b.x - a.x * b.y}; }
__device__ __forceinline__ int P(int i) { return i + (i >> 4); }
template <bool INV> __device__ __forceinline__ void r4(f32x2& a, f32x2& b, f32x2& c, f32x2& d) {
    const f32x2 t0 = a + c, t1 = a - c, t2 = b + d, t3 = b - d;
    const f32x2 st3 = INV ? (f32x2){-t3.y, t3.x} : (f32x2){t3.y, -t3.x};
    a = t0 + t2; c = t0 - t2; b = t1 + st3; d = t1 - st3;
}
template <bool INV> __device__ __forceinline__ f32x2 tw(f32x2 v, float c, float s) {
    return INV ? (f32x2){v.x * c - v.y * s, v.y * c + v.x * s} : (f32x2){v.x * c + v.y * s, v.y * c - v.x * s};
}
template <bool INV> __device__ __forceinline__ void dft16(f32x2 (&v)[16]) {
    constexpr float C1 = 0.9238795325112867f, S1 = 0.3826834323650898f, R2 = 0.7071067811865476f;
    r4<INV>(v[0], v[4], v[8], v[12]); r4<INV>(v[1], v[5], v[9], v[13]); r4<INV>(v[2], v[6], v[10], v[14]); r4<INV>(v[3], v[7], v[11], v[15]);
    v[5] = tw<INV>(v[5], C1, S1);  v[9] = tw<INV>(v[9], R2, R2);    v[13] = tw<INV>(v[13], S1, C1);
    v[6] = tw<INV>(v[6], R2, R2);  v[10] = tw<INV>(v[10], 0.f, 1.f); v[14] = tw<INV>(v[14], -R2, R2);
    v[7] = tw<INV>(v[7], S1, C1);  v[11] = tw<INV>(v[11], -R2, R2);  v[15] = tw<INV>(v[15], -C1, -S1);
    r4<INV>(v[0], v[1], v[2], v[3]); r4<INV>(v[4], v[5], v[6], v[7]); r4<INV>(v[8], v[9], v[10], v[11]); r4<INV>(v[12], v[13], v[14], v[15]);
    f32x2 t;
    t = v[1]; v[1] = v[4]; v[4] = t;   t = v[2]; v[2] = v[8]; v[8] = t;    t = v[3]; v[3] = v[12]; v[12] = t;
    t = v[6]; v[6] = v[9]; v[9] = t;   t = v[7]; v[7] = v[13]; v[13] = t;  t = v[11]; v[11] = v[14]; v[14] = t;
}
struct Ctx { LAS f32x2* R; LAS f32x2* IN; LAS f32x2* TW1; LAS f32x2* TW2; int t, half; f32x2 wt; };
#define HY_OPAQUE(x) asm volatile("" : "+v"(x))
#define HY_W32(m) (f32x2){__builtin_cosf(-0.19634954084936207f * (m)), __builtin_sinf(-0.19634954084936207f * (m))}
template <int MODE> __device__ __forceinline__ void pass1_fwd(const Ctx& X) {
    f32x2 v[16]; int t = X.t; HY_OPAQUE(t);
#pragma unroll
    for (int m = 0; m < 16; ++m) { f32x2 a = X.IN[t + 256 * m]; if (MODE == 1) a = (f32x2){X.half ? a.y : a.x, 0.f}; v[m] = a; }
    if (X.half) {
#pragma unroll
        for (int m = 0; m < 16; ++m) v[m] = cmul(cmul(v[m], HY_W32(m)), X.wt);
    }
    dft16<false>(v);
#pragma unroll
    for (int q = 1; q < 16; ++q) v[q] = cmul(v[q], X.TW1[(q - 1) * 256 + t]);
    const int pb = t + (t >> 4);
#pragma unroll
    for (int q = 0; q < 16; ++q) X.R[pb + 272 * q] = v[q];
}
__device__ __forceinline__ void pass2_fwd(const Ctx& X) {
    int t = X.t; HY_OPAQUE(t);
    const int n2 = t & 15, pb = (t >> 4) * 272 + n2; f32x2 v[16];
#pragma unroll
    for (int m = 0; m < 16; ++m) v[m] = X.R[pb + 17 * m];
    dft16<false>(v);
#pragma unroll
    for (int q = 1; q < 16; ++q) v[q] = cmul(v[q], X.TW2[(q - 1) * 16 + n2]);
#pragma unroll
    for (int q = 0; q < 16; ++q) X.R[pb + 17 * q] = v[q];
}
template <bool FILTER> __device__ __forceinline__ void pass3(const Ctx& X, f32x2 (&H)[16]) {
    f32x2 v[16]; int t = X.t; HY_OPAQUE(t); const int pb = 17 * t;
#pragma unroll
    for (int m = 0; m < 16; ++m) v[m] = X.R[pb + m];
    dft16<false>(v);
    if (FILTER) {
#pragma unroll
        for (int q = 0; q < 16; ++q) H[q] = v[q] * (1.f / 8192.f);
    } else {
#pragma unroll
        for (int q = 0; q < 16; ++q) v[q] = cmul(v[q], H[q]);
        dft16<true>(v);
#pragma unroll
        for (int m = 0; m < 16; ++m) X.R[pb + m] = v[m];
    }
}
__device__ __forceinline__ void pass2_inv(const Ctx& X) {
    int t = X.t; HY_OPAQUE(t);
    const int n2 = t & 15, pb = (t >> 4) * 272 + n2; f32x2 v[16];
    v[0] = X.R[pb];
#pragma unroll
    for (int q = 1; q < 16; ++q) v[q] = cmulc(X.R[pb + 17 * q], X.TW2[(q - 1) * 16 + n2]);
    dft16<true>(v);
#pragma unroll
    for (int m = 0; m < 16; ++m) X.R[pb + 17 * m] = v[m];
}
__device__ __forceinline__ void pass1_inv(const Ctx& X) {
    f32x2 v[16]; int t = X.t; HY_OPAQUE(t); const int pb = t + (t >> 4);
    v[0] = X.R[pb];
#pragma unroll
    for (int q = 1; q < 16; ++q) v[q] = cmulc(X.R[pb + 272 * q], X.TW1[(q - 1) * 256 + t]);
    dft16<true>(v);
    if (X.half) {
#pragma unroll
        for (int m = 0; m < 16; ++m) v[m] = cmulc(cmulc(v[m], HY_W32(m)), X.wt);
    }
#pragma unroll
    for (int m = 0; m < 16; ++m) X.R[pb + 272 * m] = v[m];
}
__device__ __forceinline__ void conv_fft(const Ctx& X, f32x2 (&H)[16]) {
    __syncthreads(); pass1_fwd<0>(X); __syncthreads(); pass2_fwd(X); __syncthreads(); pass3<false>(X, H); __syncthreads(); pass2_inv(X); __syncthreads(); pass1_inv(X); __syncthreads();
}
constexpr int STG_OFF = LDS_END;
constexpr int LDS_END2 = STG_OFF + 2 * SEQ * 2;
static_assert(LDS_END2 <= LDSCTL_OFF, "hyena LDS map");
__device__ __forceinline__ float sconv_lds(const LAS bf16_t* stg, int bs, int n, float w0, float w1, float w2, float bias) {
    const LAS bf16_t* p = stg + bs * SEQ;
    const float c = bf2f(p[n]), lv = bf2f(p[n - ((n > 0) ? 1 : 0)]), rv = bf2f(p[n + ((n < SEQ - 1) ? 1 : 0)]);
    const float l = (n > 0) ? lv : 0.f, r = (n < SEQ - 1) ? rv : 0.f;
    return bias + w0 * l + w1 * c + w2 * r;
}
__device__ __forceinline__ void setup_tables(LAS unsigned char* lds, int tid) {
    LAS f32x2* TW1 = (LAS f32x2*)(lds + TW1_OFF); LAS f32x2* TW2 = (LAS f32x2*)(lds + TW2_OFF);
    for (int i = tid; i < 15 * 256; i += 512) { const int q = i / 256 + 1, t = i & 255; float s, c; sincosf(-6.283185307179586f * (float)((t * q) & 4095) * (1.f / 4096.f), &s, &c); TW1[i] = (f32x2){c, s}; }
    for (int i = tid; i < 15 * 16; i += 512) { const int q = i / 16 + 1, n2 = i & 15; float s, c; sincosf(-6.283185307179586f * (float)((n2 * q) & 255) * (1.f / 256.f), &s, &c); TW2[i] = (f32x2){c, s}; }
}
__device__ __forceinline__ void unit(Frame& F, int c) {
    FT_DECL;
    const int tid = f_tid; Ctx X; X.half = F.wave >> 2; X.t = tid & 255;
    X.R = (LAS f32x2*)(F.lds + X.half * RB_BYTES); X.IN = (LAS f32x2*)(F.lds + IN_OFF); X.TW1 = (LAS f32x2*)(F.lds + TW1_OFF); X.TW2 = (LAS f32x2*)(F.lds + TW2_OFF);
    { float s, cc; sincosf(-6.283185307179586f * (float)X.t * (1.f / 8192.f), &s, &cc); X.wt = (f32x2){cc, s}; }
    LAS f32x2* RB0 = (LAS f32x2*)(F.lds); LAS f32x2* RB1 = (LAS f32x2*)(F.lds + RB_BYTES);
    const float* FILT = WSP(float, WS_FILT);
    f32x2 H0[16], H1[16];
#pragma unroll
    for (int ord = 0; ord < 2; ++ord) {
        const float* hf = FILT + ((size_t)(ord * 2 + 0) * 512 + c) * SEQ; const float* hb = FILT + ((size_t)(ord * 2 + 1) * 512 + c) * SEQ;
        __syncthreads();
        int nb = tid; HY_OPAQUE(nb);
#pragma unroll
        for (int j = 0; j < 8; ++j) { const int n = nb + 512 * j; const float a = hf[n], b = hb[(SEQ - n) & (SEQ - 1)]; const float lo = (n == 0) ? a + b : a, hi = (n == 0) ? 0.f : b; X.IN[n] = (f32x2){lo + hi, lo - hi}; }
        __syncthreads(); pass1_fwd<1>(X); __syncthreads(); pass2_fwd(X); __syncthreads();
        if (ord == 0) pass3<true>(X, H0); else pass3<true>(X, H1);
    }
    const bf16_t* UT = WSP(bf16_t, WS_UT);
    const bf16_t* rv = UT + (size_t)c * MROWS; const bf16_t* r1 = UT + (size_t)(512 + c) * MROWS; const bf16_t* r2 = UT + (size_t)(1024 + c) * MROWS;
    const float* cw = F.in[16]; const float* cb = F.in[17];
    const float wv0 = cw[c], wv1 = cw[HYC + c], wv2 = cw[2 * HYC + c], bv = cb[c];
    const float wa0 = cw[512 + c], wa1 = cw[HYC + 512 + c], wa2 = cw[2 * HYC + 512 + c], ba = cb[512 + c];
    const float wb0 = cw[1024 + c], wb1 = cw[HYC + 1024 + c], wb2 = cw[2 * HYC + 1024 + c], bb = cb[1024 + c];
    const float sk0 = F.in[25][c], sk1 = F.in[25][512 + c];
    bf16_t* Z = WSP(bf16_t, WS_Z2T) + (size_t)c * MROWS;
    LAS bf16_t* STG = (LAS bf16_t*)(F.lds + STG_OFF);
    u32x4 g0 = *(const u32x4*)(rv + tid * 8), g1 = *(const u32x4*)(rv + SEQ + tid * 8);
    for (int pr = 0; pr < 4; ++pr) {
        const int b0 = 2 * pr, b1 = b0 + 1;
        f32x2 z[8]; int pc = tid + (tid >> 4); HY_OPAQUE(pc); int nb = tid; HY_OPAQUE(nb);
        __syncthreads();
        *(LAS u32x4*)(STG + tid * 8) = g0; *(LAS u32x4*)(STG + SEQ + tid * 8) = g1;
        __syncthreads();
#pragma unroll
        for (int j = 0; j < 8; ++j) { const int n = nb + 512 * j; z[j] = (f32x2){sconv_lds(STG, 0, n, wv0, wv1, wv2, bv), sconv_lds(STG, 1, n, wv0, wv1, wv2, bv)}; X.IN[n] = z[j]; }
        g0 = *(const u32x4*)(r1 + b0 * SEQ + tid * 8); g1 = *(const u32x4*)(r1 + b1 * SEQ + tid * 8);
        conv_fft(X, H0);
        *(LAS u32x4*)(STG + tid * 8) = g0; *(LAS u32x4*)(STG + SEQ + tid * 8) = g1;
        __syncthreads();
        HY_OPAQUE(nb); HY_OPAQUE(pc);
#pragma unroll
        for (int j = 0; j < 8; ++j) { const int n = nb + 512 * j; const f32x2 y = RB0[pc + 544 * j] + RB1[pc + 544 * j];
            const f32x2 g = (f32x2){sconv_lds(STG, 0, n, wa0, wa1, wa2, ba), sconv_lds(STG, 1, n, wa0, wa1, wa2, ba)};
            z[j] = g * (y + sk0 * z[j]); X.IN[n] = z[j]; }
        g0 = *(const u32x4*)(r2 + b0 * SEQ + tid * 8); g1 = *(const u32x4*)(r2 + b1 * SEQ + tid * 8);
        conv_fft(X, H1);
        *(LAS u32x4*)(STG + tid * 8) = g0; *(LAS u32x4*)(STG + SEQ + tid * 8) = g1;
        __syncthreads();
        if (pr < 3) { g0 = *(const u32x4*)(rv + (b0 + 2) * SEQ + tid * 8); g1 = *(const u32x4*)(rv + (b1 + 2) * SEQ + tid * 8); }
        HY_OPAQUE(nb); HY_OPAQUE(pc);
        f32x2 o[8];
#pragma unroll
        for (int j = 0; j < 8; ++j) { const int n = nb + 512 * j; const f32x2 y = RB0[pc + 544 * j] + RB1[pc + 544 * j];
            const f32x2 g = (f32x2){sconv_lds(STG, 0, n, wb0, wb1, wb2, bb), sconv_lds(STG, 1, n, wb0, wb1, wb2, bb)};
            o[j] = g * (y + sk1 * z[j]); }
        __syncthreads();
#pragma unroll
        for (int j = 0; j < 8; ++j) { const int n = nb + 512 * j; STG[n] = (bf16_t)(cvt_pk_bf16(o[j].x, 0.f) & 0xffffu); STG[SEQ + n] = (bf16_t)(cvt_pk_bf16(o[j].y, 0.f) & 0xffffu); }
        __syncthreads();
        *(u32x4*)(Z + b0 * SEQ + tid * 8) = *(const LAS u32x4*)(STG + tid * 8); *(u32x4*)(Z + b1 * SEQ + tid * 8) = *(const LAS u32x4*)(STG + SEQ + tid * 8);
    }
    __syncthreads();
}
}

__device__ __forceinline__ void p3_hyena(Frame& F) {
    FT_DECL;
    __syncthreads();
    hy::setup_tables(F.lds, f_tid);
    __syncthreads();
    for (int c = F.vcu; c < HYW; c += F.G) hy::unit(F, c);
}

__device__ __forceinline__ void p4_hynorm(Frame& F) {
    FT_DECL;
    const bf16_t* Z = WSP(bf16_t, WS_Z2T); bf16_t* MIX = WSP(bf16_t, WS_MIX); const float* g = F.in[26];
    LAS bf16_t* T = (LAS bf16_t*)F.lds;
    LAS float* red = (LAS float*)(F.lds + 512 * 72 * 2);
    LAS float* rs = red + 512;
    for (int it = F.vcu; it < MROWS / 64; it += F.G) {
        const int tok0 = it * 64;
        __syncthreads();
#pragma unroll
        for (int j = 0; j < 8; ++j) { const int i = f_tid + 512 * j, row = i >> 3, ch = i & 7; const u32x4 v = *(const u32x4*)(Z + (size_t)row * MROWS + tok0 + ch * 8); *(LAS u32x4*)(T + row * 72 + ch * 8) = v; }
        __syncthreads();
        { const int tok = f_tid & 63, grp = f_tid >> 6; float ss = 0.f;
#pragma unroll 8
            for (int k = 0; k < 64; ++k) { const float v = bf2f(T[(grp * 64 + k) * 72 + tok]); ss += v * v; }
            red[grp * 64 + tok] = ss; }
        __syncthreads();
        if (f_tid < 64) { float ss = 0.f;
#pragma unroll
            for (int w = 0; w < 8; ++w) ss += red[w * 64 + f_tid];
            rs[f_tid] = rsqrtf(ss * (1.f / HYW) + EPS); }
        __syncthreads();
#pragma unroll
        for (int j = 0; j < 8; ++j) { const int i = f_tid + 512 * j, tok = i >> 6, c0 = (i & 63) * 8; const float r = rs[tok];
            float v[8];
#pragma unroll
            for (int e = 0; e < 8; ++e) v[e] = bf2f(T[(c0 + e) * 72 + tok]) * r * g[c0 + e];
            u32x4 w; w.x = cvt_pk_bf16(v[0], v[1]); w.y = cvt_pk_bf16(v[2], v[3]); w.z = cvt_pk_bf16(v[4], v[5]); w.w = cvt_pk_bf16(v[6], v[7]);
            *(u32x4*)(MIX + (size_t)(tok0 + tok) * DM + 512 + c0) = w; }
    }
}

__device__ __forceinline__ void p4_stub(Frame& F) {
    FT_DECL;
    bf16_t* MIX = WSP(bf16_t, WS_MIX);
    const size_t gt = (size_t)F.vcu * 512 + f_tid, NT = (size_t)F.G * 512;
    for (size_t i = gt; i < (size_t)MROWS * 64; i += NT) { const size_t row = i >> 6, ch = i & 63; *(u32x4*)(MIX + row * DM + 512 + ch * 8) = (u32x4){0u, 0u, 0u, 0u}; }
}


constexpr size_t RT_TOPI = 0;
constexpr size_t RT_GATE = 512 * 1024;
constexpr size_t RT_POS = 1024 * 1024;
constexpr size_t RT_WGCNT = 1536 * 1024;
constexpr size_t RT_META = 1600 * 1024;
constexpr size_t RT_LIST = 2048 * 1024;
constexpr size_t RT_GSLOT = 2048 * 1024 + 640 * 1024;
constexpr int MAXSLOT = MROWS * TOPK + NEXP * 256;
constexpr int MAXTILE = MAXSLOT / 256;
constexpr size_t WS_XS = WS_EO;
constexpr int RW_PITCH = 32;
constexpr int P6_LDS_TOPI = 1024 * RW_PITCH * 4;

__device__ __forceinline__ void p6_router(Frame& F) {
    FT_DECL;
#define in F.in
    LAS float* RW = (LAS float*)F.lds;
    LAS int* TI = (LAS int*)(F.lds + P6_LDS_TOPI);
    LAS int* PS = TI + 512;
    LAS int* SC = PS + 512;
    const float* rw = in[28];
    for (int i = f_tid; i < 1024 * 8; i += 512) { const int k = i >> 3, c4 = i & 7; const f32x4 v = *(const f32x4*)(rw + (size_t)k * 32 + c4 * 4);
        const int pi = (k & 3) * 256 + (k >> 2); *(LAS f32x4*)(RW + pi * RW_PITCH + ((c4 ^ ((pi >> 1) & 7)) * 4)) = v; }
    __syncthreads();
    const float* mod = WSP(float, WS_SMALL + SM_MOD); const float* g2n = in[7]; const float* rb = in[29];
    unsigned char* H2 = WSP(unsigned char, WS_H);
    int* topi_g = WSP(int, WS_ROUTE + RT_TOPI); float* gate_g = WSP(float, WS_ROUTE + RT_GATE); int* pos_g = WSP(int, WS_ROUTE + RT_POS); int* wgcnt = WSP(int, WS_ROUTE + RT_WGCNT);
    const int lane = f_lane;
    for (int blk = blockIdx.x; blk < MROWS / 128; blk += F.G) {
        for (int it = 0; it < 8; ++it) {
            const int rl = F.wave * 16 + 2 * it, r0 = blk * 128 + rl;
            const float* sh2 = mod + (size_t)(r0 >> 12) * (NMOD * DM) + 3 * DM; const float* sc2 = sh2 + DM;
            f32x4 h[2][4];
#pragma unroll
            for (int rr = 0; rr < 2; ++rr) {
                const GAS f32x4* xr = (const GAS f32x4*)(WSP(float, WS_XN) + (size_t)(r0 + rr) * DM) + lane; float ss = 0.f;
#pragma unroll
                for (int j = 0; j < 4; ++j) { h[rr][j] = xr[64 * j]; ss += (h[rr][j].x * h[rr][j].x + h[rr][j].y * h[rr][j].y) + (h[rr][j].z * h[rr][j].z + h[rr][j].w * h[rr][j].w); }
                const float rstd = rsqrtf(wave_sum(ss) * (1.f / DM) + EPS);
                GAS unsigned* o4 = (GAS unsigned*)(H2 + (size_t)(r0 + rr) * DM) + lane;
#pragma unroll
                for (int j = 0; j < 4; ++j) { const int c = 4 * lane + 256 * j;
                    const f32x4 g = *(const f32x4*)(g2n + c), a = *(const f32x4*)(sc2 + c), b = *(const f32x4*)(sh2 + c);
                    h[rr][j] = h[rr][j] * rstd * g * (a + 1.f) + b;
                    o4[64 * j] = pk4_fp8(h[rr][j].x, h[rr][j].y, h[rr][j].z, h[rr][j].w); }
            }
            float a0[32], a1[32]; int lb = lane; asm volatile("" : "+v"(lb)); const int sw = (lb >> 1) & 7;
#pragma unroll
            for (int e = 0; e < 32; ++e) { a0[e] = 0.f; a1[e] = 0.f; }
            unsigned pb[8];
#pragma unroll
            for (int c = 0; c < 8; ++c) { pb[c] = (unsigned)(uintptr_t)RW + (unsigned)lb * 128u + (unsigned)((c ^ sw) * 16); asm volatile("" : "+v"(pb[c])); }
            f32x4 wb[2][4];
#define P6_OFF(hs) ((((((hs) >> 1) & 3) * 256 + 64 * ((hs) >> 3)) * 128) & 65535)
#define P6_HI(hs) ((((((hs) >> 1) & 3) * 256 + 64 * ((hs) >> 3)) * 128) >> 16)
#define P6_LOADW(buf, hs) _Pragma("unroll") for (int c = 0; c < 4; ++c) wb[buf][c] = *(const LAS f32x4*)(uintptr_t)(pb[4 * ((hs) & 1) + c] + (unsigned)(P6_HI(hs) * 65536 + P6_OFF(hs)))
#define P6_FMA(buf, hs) do { const float x0 = h[0][(hs) >> 3][((hs) >> 1) & 3], x1 = h[1][(hs) >> 3][((hs) >> 1) & 3]; _Pragma("unroll") for (int c = 0; c < 4; ++c) _Pragma("unroll") for (int e = 0; e < 4; ++e) { \
                a0[16 * ((hs) & 1) + 4 * c + e] += x0 * wb[buf][c][e]; a1[16 * ((hs) & 1) + 4 * c + e] += x1 * wb[buf][c][e]; } } while (0)
            P6_LOADW(0, 0);
#pragma unroll
            for (int hs = 0; hs < 32; hs += 2) {
                P6_LOADW(1, hs + 1); __builtin_amdgcn_sched_barrier(0); asm volatile("s_waitcnt lgkmcnt(4)" ::: "memory"); __builtin_amdgcn_sched_barrier(0);
                P6_FMA(0, hs); __builtin_amdgcn_sched_barrier(0);
                if (hs + 2 < 32) { P6_LOADW(0, hs + 2); __builtin_amdgcn_sched_barrier(0); asm volatile("s_waitcnt lgkmcnt(4)" ::: "memory"); } else { asm volatile("s_waitcnt lgkmcnt(0)" ::: "memory"); }
                __builtin_amdgcn_sched_barrier(0);
                P6_FMA(1, hs + 1); __builtin_amdgcn_sched_barrier(0);
            }
#undef P6_LOADW
#undef P6_FMA
#undef P6_OFF
#undef P6_HI
#define RS_STEP(A, CNT, MASK) _Pragma("unroll") for (int i = 0; i < CNT; ++i) { const bool up = (lane & MASK) != 0; const float send = up ? A[i] : A[CNT + i]; const float keep = up ? A[CNT + i] : A[i]; A[i] = keep + __shfl_xor(send, MASK); }
            RS_STEP(a0, 16, 32) RS_STEP(a0, 8, 16) RS_STEP(a0, 4, 8) RS_STEP(a0, 2, 4) RS_STEP(a0, 1, 2)
            RS_STEP(a1, 16, 32) RS_STEP(a1, 8, 16) RS_STEP(a1, 4, 8) RS_STEP(a1, 2, 4) RS_STEP(a1, 1, 2)
#undef RS_STEP
            const int me = lane >> 1; const float bias = rb[me];
            float lg[2]; lg[0] = a0[0] + __shfl_xor(a0[0], 1) + bias; lg[1] = a1[0] + __shfl_xor(a1[0], 1) + bias;
            LAS float* WL = (LAS float*)(F.lds + P6_LDS_TOPI + 6144) + F.wave * 96;
            if ((lane & 1) == 0) { WL[me] = lg[0]; WL[32 + me] = lg[1]; }
            LDS_WAIT(); asm volatile("" ::: "memory");
#pragma unroll
            for (int rr = 0; rr < 2; ++rr) {
                const float v = lg[rr]; int rank = 0;
#pragma unroll
                for (int c4 = 0; c4 < 8; ++c4) { const f32x4 o = *(const LAS f32x4*)(WL + rr * 32 + 4 * c4);
#pragma unroll
                    for (int e = 0; e < 4; ++e) { const int oe = 4 * c4 + e; rank += (o[e] > v || (o[e] == v && oe < me)) ? 1 : 0; } }
                if ((lane & 1) == 0 && rank < 4) { WL[64 + rr * 4 + rank] = v; ((LAS int*)WL)[72 + rr * 4 + rank] = me; }
            }
            LDS_WAIT(); asm volatile("" ::: "memory");
            if (lane < 2) { const int rr = lane; const f32x4 tv = *(const LAS f32x4*)(WL + 64 + rr * 4); typedef int i32x4_t __attribute__((ext_vector_type(4))); const i32x4_t ti = *(const LAS i32x4_t*)((LAS int*)WL + 72 + rr * 4);
                const float e1 = __expf(tv[1] - tv[0]), e2 = __expf(tv[2] - tv[0]), e3 = __expf(tv[3] - tv[0]); const float inv = 1.f / (1.f + e1 + e2 + e3);
                const int r = r0 + rr;
                *(i32x4_t*)(topi_g + (size_t)r * 4) = ti;
                *(f32x4*)(gate_g + (size_t)r * 4) = (f32x4){inv, e1 * inv, e2 * inv, e3 * inv};
                *(LAS i32x4_t*)(TI + (rl + rr) * 4) = ti; }
            LDS_WAIT(); asm volatile("" ::: "memory");
        }
        __syncthreads();
        { const int t2 = F.wave * 64 + lane_id(); const int e = t2 & 31, seg = t2 >> 5; int cnt = 0;
#pragma unroll 4
            for (int i = 0; i < 32; ++i) cnt += (TI[seg * 32 + i] == e) ? 1 : 0;
            SC[seg * 32 + e] = cnt;
            __syncthreads();
            int pre = 0;
            for (int s2 = 0; s2 < seg; ++s2) pre += SC[s2 * 32 + e];
            if (seg == 15) wgcnt[blk * 32 + e] = pre + cnt;
            for (int i = 0; i < 32; ++i) if (TI[seg * 32 + i] == e) { PS[seg * 32 + i] = pre; ++pre; }
        }
        __syncthreads();
        { const int t3 = F.wave * 64 + lane_id(); pos_g[(size_t)blk * 512 + t3] = PS[t3]; }
        __syncthreads();
    }
#undef in
}

__device__ __forceinline__ void p7_scatter(Frame& F) {
    FT_DECL;
    LAS int* TOT = (LAS int*)F.lds;
    LAS int* BASE = TOT + 32;
    LAS int* PRE = BASE + 32;
    LAS int* PART = PRE + 32;
    const int* wgcnt = WSP(int, WS_ROUTE + RT_WGCNT); const int* topi_g = WSP(int, WS_ROUTE + RT_TOPI); const float* gate_g = WSP(float, WS_ROUTE + RT_GATE); const int* pos_g = WSP(int, WS_ROUTE + RT_POS);
    int* list = WSP(int, WS_ROUTE + RT_LIST); float* gslot = WSP(float, WS_ROUTE + RT_GSLOT); int* meta = WSP(int, WS_ROUTE + RT_META);
    const unsigned char* H2 = WSP(unsigned char, WS_H); unsigned char* XS = WSP(unsigned char, WS_XS);
    for (int blk = blockIdx.x; blk < MROWS / 128; blk += F.G) {
        __syncthreads();
        { const int e = f_tid & 31, part = f_tid >> 5; int st = 0, sp = 0;
            for (int w = part * 16; w < part * 16 + 16; ++w) { const int c = wgcnt[w * 32 + e]; st += c; if (w < blk) sp += c; }
            PART[part * 32 + e] = st; PART[512 + part * 32 + e] = sp; }
        __syncthreads();
        if (f_tid < 32) { int st = 0, sp = 0;
#pragma unroll
            for (int p = 0; p < 16; ++p) { st += PART[p * 32 + f_tid]; sp += PART[512 + p * 32 + f_tid]; }
            TOT[f_tid] = st; PRE[f_tid] = sp; }
        __syncthreads();
        if (f_tid == 0) { int b = 0; for (int e = 0; e < 32; ++e) { BASE[e] = b; b += (TOT[e] + 255) & ~255; }
            if (blk == 0) { int t = 0; for (int e = 0; e < 32; ++e) { meta[e] = TOT[e]; meta[32 + e] = BASE[e]; const int nt = (TOT[e] + 255) >> 8; for (int q = 0; q < nt; ++q) meta[128 + t + q] = e; t += nt; } meta[64] = t; } }
        __syncthreads();
        { const int a = f_tid, row = blk * 128 + (a >> 2); const int e = topi_g[(size_t)blk * 512 + a]; const int slot = BASE[e] + PRE[e] + pos_g[(size_t)blk * 512 + a];
            list[slot] = row * 4 + (a & 3); gslot[slot] = gate_g[(size_t)blk * 512 + a];
            PART[a] = slot; }
        __syncthreads();
        for (int a0 = F.wave * 8; a0 < 512; a0 += NWAVES * 8) { u32x4 v[8]; int sl[8];
#pragma unroll
            for (int q = 0; q < 8; ++q) { const int a = a0 + q; sl[q] = PART[a]; v[q] = ((const GAS u32x4*)(H2 + (size_t)(blk * 128 + (a >> 2)) * DM))[f_lane]; }
#pragma unroll
            for (int q = 0; q < 8; ++q) ((GAS u32x4*)(XS + (size_t)sl[q] * DM))[f_lane] = v[q]; }
        if (blk < NEXP) { const int e = blk, lo = BASE[e] + TOT[e], hi = BASE[e] + ((TOT[e] + 255) & ~255);
            for (int sl = lo + F.wave; sl < hi; sl += NWAVES) { if (f_lane == 0) { list[sl] = -1; gslot[sl] = 0.f; }
                ((GAS u32x4*)(XS + (size_t)sl * DM))[f_lane] = (u32x4){0u, 0u, 0u, 0u}; } }
    }
}

template <int NPN> struct SchedMoE {
    int G, c, nT; const char* A; const char* W; size_t wstride; const LAS unsigned char* tileE;
    __device__ __forceinline__ bool next(int i, g8::Unit& u) const {
        const int L = i * G + c, xcd = L & 7, j = L >> 3, T = (j / NPN) * 8 + xcd, pn = j % NPN;
        if (T >= nT) return false;
        const int e = tileE[T];
        u.pm = T; u.pn = pn; u.kind = i; u.ex = e; u.a = A + (size_t)T * 256 * DM; u.b = W + (size_t)e * wstride + (size_t)pn * 256 * DM; return true;
    }
};
struct EpiSwiGLU {
    unsigned char* ACT; const float* b1;
    __device__ __forceinline__ void operator()(f32x4 (&acc)[2][2][4][2], const g8::Unit& u, int wr, int wc, int fr, int fq) const {
        asm volatile("" : "+v"(fr), "+v"(fq));
        const int j0 = u.pn * 128 + wc * 32 + 8 * fq; const float* bp = b1 + (size_t)u.ex * 2 * DM + j0;
        f32x4 bg[2], bl[2];
#pragma unroll
        for (int n = 0; n < 2; ++n) { bg[n] = *(const f32x4*)(bp + 4 * n); bl[n] = *(const f32x4*)(bp + DM + 4 * n); }
#pragma unroll
        for (int ai = 0; ai < 2; ++ai)
#pragma unroll
            for (int m = 0; m < 4; ++m) { const size_t slot = (size_t)u.pm * 256 + ai * 128 + wr * 64 + m * 16 + fr; float o[8];
#pragma unroll
                for (int n = 0; n < 2; ++n) { const f32x4 g4 = acc[ai][0][m][n] * (1.f / WSCALE) + bg[n], l4 = acc[ai][1][m][n] * (1.f / WSCALE) + bl[n];
#pragma unroll
                    for (int e = 0; e < 4; ++e) { const float g = fminf(g4[e], 7.f), l = __builtin_amdgcn_fmed3f(l4[e], -7.f, 7.f);
                        const float ex = __builtin_amdgcn_exp2f(g * (-1.702f * 1.4426950408889634f)); const float glu = g * __builtin_amdgcn_rcpf(1.f + ex);
                        o[4 * n + e] = fmaf(l, glu, glu); } }
                u32x2 w; w.x = pk4_fp8(o[0], o[1], o[2], o[3]); w.y = pk4_fp8(o[4], o[5], o[6], o[7]);
                *(u32x2*)(ACT + slot * DM + j0) = w; }
    }
};
struct EpiDown {
    unsigned char* EO; const float* b2; const LAS int* LL; int G, c;
    __device__ __forceinline__ void operator()(f32x4 (&acc)[2][2][4][2], const g8::Unit& u, int wr, int wc, int fr, int fq) const {
        asm volatile("" : "+v"(fr), "+v"(fq));
        const int c0 = u.pn * 256 + wc * 32 + 8 * fq; const float* bp = b2 + (size_t)u.ex * DM + c0;
        f32x4 bb[2][2];
#pragma unroll
        for (int bj = 0; bj < 2; ++bj)
#pragma unroll
            for (int n = 0; n < 2; ++n) bb[bj][n] = *(const f32x4*)(bp + bj * 128 + 4 * n);
        const LAS int* L = LL + u.kind * 512;
        int li[8]; float gt[8];
#pragma unroll
        for (int q = 0; q < 8; ++q) { const int rl = (q >> 2) * 128 + wr * 64 + (q & 3) * 16 + fr; li[q] = L[rl]; gt[q] = __int_as_float(L[256 + rl]) * (1.f / WSCALE); }
#pragma unroll
        for (int ai = 0; ai < 2; ++ai)
#pragma unroll
            for (int m = 0; m < 4; ++m) { const int l = li[ai * 4 + m]; const float g = gt[ai * 4 + m];
                unsigned char* dst = EO + ((size_t)(l & 3) * MROWS + (l >> 2)) * DM + c0;
                u32x2 w[2];
#pragma unroll
                for (int bj = 0; bj < 2; ++bj) { const f32x4 v0 = acc[ai][bj][m][0] * g + bb[bj][0] * (g * WSCALE), v1 = acc[ai][bj][m][1] * g + bb[bj][1] * (g * WSCALE);
                    w[bj].x = pk4_fp8(v0[0] * EOSCALE, v0[1] * EOSCALE, v0[2] * EOSCALE, v0[3] * EOSCALE); w[bj].y = pk4_fp8(v1[0] * EOSCALE, v1[1] * EOSCALE, v1[2] * EOSCALE, v1[3] * EOSCALE); }
                if (l >= 0) { *(u32x2*)dst = w[0]; *(u32x2*)(dst + 128) = w[1]; } }
    }
};
__device__ __forceinline__ const LAS unsigned char* moe_tiles(Frame& F, int& nT) {
    FT_DECL;
    LAS unsigned char* TE = (LAS unsigned char*)(F.lds + RING_BYTES); const int* meta = WSP(int, WS_ROUTE + RT_META);
    __syncthreads();
    nT = meta[64]; if (nT > MAXTILE) nT = MAXTILE;
    for (int i = f_tid; i < MAXTILE; i += 512) TE[i] = (unsigned char)((i < nT) ? meta[128 + i] : 0);
    __syncthreads();
    return (const LAS unsigned char*)TE;
}

__device__ __forceinline__ void p10_combine(Frame& F) {
    FT_DECL;
    const float* mod = WSP(float, WS_SMALL + SM_MOD); const unsigned char* EO = WSP(unsigned char, WS_EO);
    const size_t gt = (size_t)F.vcu * 512 + f_tid, NTH = (size_t)F.G * 512;
    float pd = 0.f, pa = 0.f;
    if (MK_PROBE_A != -2) { const unsigned long long* st = (const unsigned long long*)(F.ws + WS_CTL + 8192);
        pd = (MK_PROBE_A < 0) ? 0.1f : (float)(st[MK_PA1] - st[MK_PA0]) * MK_PSA; pa = (float)(st[MK_PB1] - st[MK_PB0]) * MK_PSB; }
    constexpr int U = 4;
    for (size_t i0 = gt; i0 < (size_t)MROWS * 128; i0 += NTH * U) {
        u32x2 ev[U][4]; f32x4 xv[U][2], gv[U][2];
#pragma unroll
        for (int u = 0; u < U; ++u) { const size_t i = i0 + (size_t)u * NTH; const size_t row = i >> 7; const int c0 = (int)(i & 127) * 8;
            const float* g2 = mod + (size_t)(row >> 12) * (NMOD * DM) + 5 * DM + c0; const float* op = WSP(float, WS_XN) + row * DM + c0;
#pragma unroll
            for (int k = 0; k < 4; ++k) ev[u][k] = __builtin_nontemporal_load((const u32x2*)(EO + ((size_t)k * MROWS + row) * DM + c0));
            xv[u][0] = *(const f32x4*)op; xv[u][1] = *(const f32x4*)(op + 4); gv[u][0] = *(const f32x4*)g2; gv[u][1] = *(const f32x4*)(g2 + 4); }
#pragma unroll
        for (int u = 0; u < U; ++u) { const size_t i = i0 + (size_t)u * NTH; const size_t row = i >> 7; const int c0 = (int)(i & 127) * 8;
            float s[8];
#pragma unroll
            for (int e = 0; e < 8; ++e) s[e] = 0.f;
#pragma unroll
            for (int k = 0; k < 4; ++k) { const u32x2 v = ev[u][k];
                const f32x2 a = __builtin_amdgcn_cvt_pk_f32_fp8((int)v.x, false), b = __builtin_amdgcn_cvt_pk_f32_fp8((int)v.x, true), c = __builtin_amdgcn_cvt_pk_f32_fp8((int)v.y, false), d = __builtin_amdgcn_cvt_pk_f32_fp8((int)v.y, true);
                s[0] += a.x; s[1] += a.y; s[2] += b.x; s[3] += b.y; s[4] += c.x; s[5] += c.y; s[6] += d.x; s[7] += d.y; }
#pragma unroll
            for (int e = 0; e < 8; ++e) s[e] *= (1.f / EOSCALE);
            f32x4 o0 = xv[u][0] + gv[u][0] * (f32x4){s[0], s[1], s[2], s[3]}, o1 = xv[u][1] + gv[u][1] * (f32x4){s[4], s[5], s[6], s[7]};
            if (MK_PROBE_A != -2) { o0 += pd; o1 += pd; if (i == 0) o0[0] += pa; }
            float* op = F.out + row * DM + c0;
            __builtin_nontemporal_store(o0, (f32x4*)op); __builtin_nontemporal_store(o1, (f32x4*)(op + 4)); }
    }
}

struct Args { const float* in[34]; float* out; unsigned char* ws; int ph_lo, ph_hi; };
constexpr int N_PHASES = 11;

__global__ void __launch_bounds__(512, 2) mega(Args args) {
    extern __shared__ __attribute__((aligned(16))) unsigned char lds[];
    Frame F;
    F.lds = (LAS unsigned char*)lds;
    F.MISC = (volatile LAS unsigned*)(F.lds + LDSCTL_OFF);
    F.wave = __builtin_amdgcn_readfirstlane(threadIdx.x >> 6);
    FT_DECL;
    F.G = gridDim.x; { const int bx = blockIdx.x; F.vcu = (F.G % 8 == 0) ? (bx % 8) * (F.G / 8) + bx / 8 : bx; }
    F.in = (kin_t)__builtin_amdgcn_kernarg_segment_ptr();
    F.out = args.out; F.ws = args.ws;
    F.ctl = (gu32*)(args.ws + WS_CTL);
    for (int u = f_tid; u < (LDS_BYTES - LDSCTL_OFF) / 4; u += NWAVES * 64) ((LAS unsigned*)(F.lds + LDSCTL_OFF))[u] = 0u;
    __syncthreads();
    const int lo = args.ph_lo, hi = args.ph_hi;
    XcdBarrier bar; bar.bar = (unsigned*)(F.ctl + CW_BAR); bar.x = 0; bar.st = nullptr;
    if (hi - lo > 1) bar = xcd_barrier_post((unsigned*)(F.ctl + CW_BAR), F.MISC + 8, f_tid == 0);
#define IN(k) (lo <= (k) && (k) < hi)
    unsigned long long* stamps = (unsigned long long*)(args.ws + WS_CTL + 8192);
#define STAMP(k) do { if (MK_PROBE_A != -2 && blockIdx.x == 0 && f_tid == 0) stamps[(k)] = __builtin_amdgcn_s_memrealtime(); } while (0)
    STAMP(0);
#define SEAM(k) do { if (IN(k) && IN((k) + 1)) xcd_barrier(bar, F.wave == 0 && lane_id() == 0); } while (0)

    if (IN(0)) { p0_prologue(F); } SEAM(0); STAMP(1);
    if (IN(1)) { p1_norm1(F); } SEAM(1); STAMP(2);
    if (IN(2)) {
        SchedInProj S{F.G, (int)blockIdx.x, (const char*)WSP(bf16_t, WS_H), (const char*)WSP(bf16_t, WS_WIN)};
        EpiInProj E{WSP(bf16_t, WS_Q), WSP(bf16_t, WS_K), WSP(bf16_t, WS_V), WSP(bf16_t, WS_UT), F.in[9], F.in[10], WSP(float, WS_SMALL + SM_ROPE)};
        g8::gemm_phase<false>(F.lds, DM, S, E, F.wave, lane_id());
    } SEAM(2); STAMP(3);
    if (IN(3)) { p3_attention(F); STAMP(12); p3_hyena(F); } SEAM(3); STAMP(4);
    if (IN(4)) { p4_hynorm(F); } SEAM(4); STAMP(5);
    if (IN(5)) {
        SchedStatic S{F.G, (int)blockIdx.x, MROWS / 256, DM / 256, (const char*)WSP(bf16_t, WS_MIX), (const char*)WSP(bf16_t, WS_WOUT)};
        EpiOutProj E{F.in[0], WSP(float, WS_XN), WSP(float, WS_SMALL + SM_MOD)};
        g8::gemm_phase<false>(F.lds, DM, S, E, F.wave, lane_id());
    } SEAM(5); STAMP(6);
    if (IN(6)) { p6_router(F); } SEAM(6); STAMP(7);
    if (IN(7)) { p7_scatter(F); } SEAM(7); STAMP(8);
    if (IN(8)) {
        int nT; const LAS unsigned char* TE = moe_tiles(F, nT);
        SchedMoE<8> S{F.G, (int)blockIdx.x, nT, (const char*)WSP(char, WS_XS), (const char*)WSP(char, WS_W1), (size_t)2 * DM * DM, TE};
        EpiSwiGLU E{WSP(unsigned char, WS_ACT), F.in[31]};
        g8::gemm_phase<true>(F.lds, DM, S, E, F.wave, lane_id());
    } SEAM(8); STAMP(9);
    if (IN(9)) {
        int nT; const LAS unsigned char* TE = moe_tiles(F, nT);
        SchedMoE<4> S{F.G, (int)blockIdx.x, nT, (const char*)WSP(char, WS_ACT), (const char*)WSP(char, WS_W2), (size_t)DM * DM, TE};
        LAS int* LL = (LAS int*)(F.lds + RING_BYTES + 1024);
        static_assert(RING_BYTES + 1024 + 9 * 2048 <= LDSCTL_OFF, "LDS map");
        { const int* list = WSP(int, WS_ROUTE + RT_LIST); const float* gslot = WSP(float, WS_ROUTE + RT_GSLOT);
            const int t9 = F.wave * 64 + lane_id();
            g8::Unit u; for (int i = 0; i < 9 && S.next(i, u); ++i) { const int t = t9 & 255; const size_t slot = (size_t)u.pm * 256 + t;
                LL[i * 512 + (t9 >> 8) * 256 + t] = (t9 < 256) ? list[slot] : __float_as_int(gslot[slot]); }
            __syncthreads(); }
        EpiDown E{WSP(unsigned char, WS_EO), F.in[33], LL, F.G, (int)blockIdx.x};
        g8::gemm_phase<true>(F.lds, DM, S, E, F.wave, lane_id());
    } SEAM(9); STAMP(10);
    if (IN(10)) { p10_combine(F); }
#undef IN
#undef SEAM
}

extern "C" void kernel_launch(void* const* d_in, const int* in_sizes, int n_in, void* d_out, int out_size, void* d_ws, size_t ws_size, hipStream_t stream) {
    static int grid = 0;
    if (grid == 0) {
        if (n_in != 34 || out_size != MROWS * DM || ws_size < WS_END) { fprintf(stderr, "kernel_launch: unexpected shapes: n_in %d out %d ws %zu (need %zu)\n", n_in, out_size, ws_size, (size_t)WS_END); grid = -1; return; }
        int dev = 0, cus = 0, per_cu = 0;
        if (hipGetDevice(&dev) != hipSuccess || hipDeviceGetAttribute(&cus, hipDeviceAttributeMultiprocessorCount, dev) != hipSuccess) { grid = -1; return; }
        if (hipFuncSetAttribute((const void*)mega, hipFuncAttributeMaxDynamicSharedMemorySize, LDS_BYTES) != hipSuccess) { fprintf(stderr, "kernel_launch: hipFuncSetAttribute failed\n"); grid = -1; return; }
        if (hipOccupancyMaxActiveBlocksPerMultiprocessor(&per_cu, (const void*)mega, NWAVES * 64, LDS_BYTES) != hipSuccess || per_cu < 1) { fprintf(stderr, "kernel_launch: occupancy query says %d\n", per_cu); per_cu = 1; }
        (void)hipGetLastError();
        grid = cus;
    }
    if (grid < 0) return;
    (void)hipMemsetAsync((char*)d_ws + WS_CTL, 0, CTL_ZERO_BYTES, stream);
    Args a{};
    for (int i = 0; i < 34; ++i) a.in[i] = (const float*)d_in[i];
    a.out = (float*)d_out; a.ws = (unsigned char*)d_ws;
    constexpr int LAST = MK_LAST_PHASE + 1;
    if (MK_N_LAUNCHES == 1) { a.ph_lo = 0; a.ph_hi = LAST; hipLaunchKernelGGL(mega, dim3(grid), dim3(NWAVES * 64), LDS_BYTES, stream, a); }
    else for (int p = 0; p < LAST; ++p) { a.ph_lo = p; a.ph_hi = p + 1; hipLaunchKernelGGL(mega, dim3(grid), dim3(NWAVES * 64), LDS_BYTES, stream, a); }
    const hipError_t le = hipPeekAtLastError();
    if (le != hipSuccess) fprintf(stderr, "kernel_launch: launch failed: %s\n", hipGetErrorName(le));
}
```

```cpp
#include <hip/hip_runtime.h>
#include <hip/hip_bf16.h>
#include <cstdio>
#include <cstdint>

#ifndef MK_N_LAUNCHES
#define MK_N_LAUNCHES 1
#endif
#ifndef MK_PROBE_A
#define MK_PROBE_A -2
#endif
#ifndef MK_PA0
#define MK_PA0 0
#define MK_PA1 1
#define MK_PB0 0
#define MK_PB1 1
#define MK_PSA 2e-6f
#define MK_PSB 1e-4f
#endif
#ifndef MK_LAST_PHASE
#define MK_LAST_PHASE 10
#endif

#define GAS __attribute__((address_space(1)))
#define LAS __attribute__((address_space(3)))
typedef unsigned short bf16_t;
typedef short bf16x8 __attribute__((ext_vector_type(8)));
typedef short s16x4 __attribute__((ext_vector_type(4)));
typedef float f32x2 __attribute__((ext_vector_type(2)));
typedef float f32x4 __attribute__((ext_vector_type(4)));
typedef float f32x16 __attribute__((ext_vector_type(16)));
typedef unsigned u32x2 __attribute__((ext_vector_type(2)));
typedef unsigned u32x4 __attribute__((ext_vector_type(4)));
typedef GAS unsigned gu32;

constexpr int NB = 8, SEQ = 4096, DM = 1024, MROWS = NB * SEQ, CTXL = 256, MCTX = NB * CTXL, MTOT = MROWS + MCTX;
constexpr int KVL = CTXL + SEQ;
constexpr int NHEAD = 4, QKW = 512;
constexpr int HYW = 512, HYC = 1536, INC = 3072, QKVC = 1536;
constexpr int NEXP = 32, TOPK = 4, NMOD = 6;
constexpr float EPS = 1e-6f;
constexpr float LAM_INIT = 0.2f;
constexpr float QSCALE = 0.125f * 1.4426950408889634f;

constexpr size_t MiB = 1u << 20;
constexpr size_t WS_CTL = 0, CTL_ZERO_BYTES = 1 * MiB;
constexpr size_t WS_SMALL = 1 * MiB;
constexpr size_t WS_WIN = 2 * MiB;
constexpr size_t WS_WOUT = 8 * MiB;
constexpr size_t WS_W1 = 10 * MiB;
constexpr size_t WS_W2 = 138 * MiB;
constexpr size_t WS_H = 202 * MiB;
constexpr size_t WS_Q = 270 * MiB;
constexpr size_t WS_K = 302 * MiB;
constexpr size_t WS_V = 336 * MiB;
constexpr size_t WS_UT = 370 * MiB;
constexpr size_t WS_FILT = 466 * MiB;
constexpr size_t WS_Z2T = 498 * MiB;
constexpr size_t WS_MIX = 530 * MiB;
constexpr size_t WS_ROUTE = 594 * MiB;
constexpr size_t WS_ACT = 270 * MiB;
constexpr size_t WS_EO = 598 * MiB;
constexpr size_t WS_XN = 870 * MiB;
constexpr size_t WS_END = 998 * MiB;
constexpr size_t SM_MOD = 0;
constexpr size_t SM_SCAL = 256 * 1024;
constexpr size_t SM_ROPE = 260 * 1024;
constexpr int CW_BAR = 4096;

constexpr int RING_BYTES = 131072;
constexpr int LDSCTL_OFF = 151552;
constexpr int LDS_BYTES = 152576;
constexpr int NWAVES = 8;

#define LDS_WAIT() asm volatile("s_waitcnt lgkmcnt(0)" ::: "memory")
#define VM_WAIT() asm volatile("s_waitcnt vmcnt(0)" ::: "memory")
#define RLX_AGENT __ATOMIC_RELAXED, __HIP_MEMORY_SCOPE_AGENT

__device__ __forceinline__ unsigned cvt_pk_bf16(float lo, float hi) { unsigned r; asm volatile("v_cvt_pk_bf16_f32 %0, %1, %2" : "=v"(r) : "v"(lo), "v"(hi)); return r; }
__device__ __forceinline__ float bf2f(bf16_t v) { return __uint_as_float(((unsigned)v) << 16); }
__device__ __forceinline__ float wave_sum(float v) {
#pragma unroll
    for (int o = 1; o < 64; o <<= 1) v += __shfl_xor(v, o);
    return v;
}

#define XB_TMO      128
#define XB_XCNT(j)  (256  + 64 * (j))
#define XB_XSUB(j)  (1280 + 64 * (j))
#define XB_XGEN(j)  (2304 + 64 * (j))
#define XB_TOP      3328
#define XB_TOPGEN   3392
#define XCD_BAR_WORDS 3456
#define XB_SPIN_CAP (1u << 22)
__device__ __forceinline__ unsigned xb_ld(unsigned* p)              { return __hip_atomic_load(p, __ATOMIC_RELAXED, __HIP_MEMORY_SCOPE_AGENT); }
__device__ __forceinline__ unsigned xb_add(unsigned* p, unsigned v) { return __hip_atomic_fetch_add(p, v, __ATOMIC_RELAXED, __HIP_MEMORY_SCOPE_AGENT); }
__device__ __forceinline__ unsigned xb_xcc_id() { return (unsigned)__builtin_amdgcn_s_getreg((3 << 11) | 20) & 0xFu; }
#define XB_SPIN(cond, bar) do { unsigned _sp = 0; while (cond) { __builtin_amdgcn_s_sleep(1); \
    if ((++_sp & 255u) == 0u) { if (xb_ld(&(bar)[XB_TMO])) break; if (_sp > XB_SPIN_CAP) { atomicAdd(&(bar)[XB_TMO], 1u); break; } } } } while (0)
struct XcdBarrier { unsigned* bar; unsigned x; volatile LAS unsigned* st; };
__device__ __forceinline__ XcdBarrier xcd_barrier_post(unsigned* bar, volatile LAS unsigned* st, bool leader) {
    XcdBarrier b; b.bar = bar; b.x = xb_xcc_id(); b.st = st;
    if (leader) (void)xb_add(&bar[XB_XCNT(b.x)], 1u);
    return b;
}
__device__ __forceinline__ void xcd_barrier_complete(unsigned* bar, unsigned x, unsigned& nloc, unsigned& nx) {
    const unsigned G = gridDim.x * gridDim.y * gridDim.z;
    unsigned sum, cnt, mine, sp = 0u;
    for (;;) {
        sum = 0u; cnt = 0u; mine = 0u;
#pragma unroll
        for (unsigned j = 0; j < 16; ++j) { const unsigned c = xb_ld(&bar[XB_XCNT(j)]); sum += c; cnt += (c > 0u) ? 1u : 0u; mine = (j == x) ? c : mine; }
        if (sum == G) break;
        __builtin_amdgcn_s_sleep(1);
        if ((++sp & 255u) == 0u) { if (xb_ld(&bar[XB_TMO])) break; if (sp > XB_SPIN_CAP) { atomicAdd(&bar[XB_TMO], 1u); break; } }
    }
    nloc = mine > 0u ? mine : 1u; nx = cnt > 0u ? cnt : 1u;
}
__device__ __forceinline__ void xcd_barrier(const XcdBarrier& b, bool leader) {
    asm volatile("s_waitcnt vmcnt(0)" ::: "memory");
    __syncthreads();
    if (leader) {
        unsigned* bar = b.bar;
        __builtin_amdgcn_s_waitcnt(0);
        unsigned nloc = b.st[0], nx = b.st[1];
        if (nloc == 0u) { xcd_barrier_complete(bar, b.x, nloc, nx); b.st[0] = nloc; b.st[1] = nx; }
        const unsigned old = xb_add(&bar[XB_XSUB(b.x)], 1u);
        const unsigned gen = old / nloc;
        if (old + 1u == (gen + 1u) * nloc) {
            __builtin_amdgcn_fence(__ATOMIC_RELEASE, "agent");
            asm volatile("s_waitcnt vmcnt(0)" ::: "memory");
            const unsigned og = xb_add(&bar[XB_TOP], 1u);
            const unsigned tg = og / nx;
            if (og + 1u == (tg + 1u) * nx) xb_add(&bar[XB_TOPGEN], 1u);
            else XB_SPIN(xb_ld(&bar[XB_TOPGEN]) == tg, bar);
            __builtin_amdgcn_fence(__ATOMIC_ACQUIRE, "agent");
            xb_add(&bar[XB_XGEN(b.x)], 1u);
            asm volatile("s_waitcnt vmcnt(0)" ::: "memory");
        } else {
            XB_SPIN(xb_ld(&bar[XB_XGEN(b.x)]) == gen, bar);
            __builtin_amdgcn_fence(__ATOMIC_ACQUIRE, "agent");
            asm volatile("s_waitcnt vmcnt(0)" ::: "memory");
        }
    }
    __syncthreads();
}

namespace g8 {
constexpr int BM = 256, BK = 64, HALF = 128, HTB = HALF * BK * 2, STAGE_BYTES = 8 * HTB, NXCD = 8, WGM = 8;
__host__ __device__ __forceinline__ int lds_byte(int r, int c) { const int st = (r >> 4) * 2 + (c >> 5), rr = r & 15, cc = c & 31, ob = rr * 64 + cc * 2; return st * 1024 + (ob ^ (((ob >> 9) & 1) << 5)); }
__host__ __device__ __forceinline__ void stage_rc(int b, int& R, int& C) { const int st = b / 1024, sb = b % 1024, swz = sb ^ (((sb >> 9) & 1) << 5); R = (st >> 1) * 16 + swz / 64; C = (st & 1) * 32 + (swz % 64) / 2; }
__host__ __device__ __forceinline__ int perm32(int rho) { const int n = rho >> 4, i = rho & 15; return 8 * (i >> 2) + 4 * n + (i & 3); }

struct Unit { const char* a; const char* b; int pm, pn, kind, ex; };

__device__ __forceinline__ void tile_of(int L, int nM, int nN, int& pm, int& pn) {
    const int nwg = nM * nN; int wgid = L;
    { const int q = nwg / NXCD, r = nwg % NXCD, xcd = wgid % NXCD, off = wgid / NXCD; wgid = (xcd < r ? xcd * (q + 1) : r * (q + 1) + (xcd - r) * q) + off; }
    const int nig = WGM * nN, gid = wgid / nig, fm = gid * WGM, gsz = (nM - fm) < WGM ? (nM - fm) : WGM;
    pm = fm + ((wgid % nig) % gsz); pn = (wgid % nig) / gsz;
}

typedef int i32x8 __attribute__((ext_vector_type(8)));
template <bool FP8, class Epi, class Sched>
__device__ __forceinline__ void gemm_phase(LAS unsigned char* lds, const int K, const Sched& S, const Epi& E, const int wid, const int lane) {
    const int tid = wid * 64 + lane, wr = wid >> 2, wc = wid & 3, fr = lane & 15, fq = lane >> 4;
    const int nt = FP8 ? K / 128 : K / BK;
    const int RP = FP8 ? K : 2 * K;
    unsigned voffA[2], voffB[2];
#pragma unroll
    for (int i = 0; i < 2; ++i) { int R, C; stage_rc(tid * 16 + i * 8192, R, C); const int Rb = (R & ~31) + perm32(R & 31);
        voffA[i] = (unsigned)(R * RP + C * 2); voffB[i] = (unsigned)(Rb * RP + C * 2); }
    const size_t kstep = (size_t)(BK * 2);
    const size_t hstep = (size_t)HALF * RP;
    const unsigned ldsw = (unsigned)wid * 1024u;
    const int aoff = lds_byte(wr * 64 + fr, FP8 ? fq * 16 : fq * 8), boff = lds_byte(wc * 32 + fr, FP8 ? fq * 16 : fq * 8);
    constexpr int KOFF = FP8 ? 16 : 1024;
#define PG8_SA(b, h) (((b) * 2 + (h)) * HTB)
#define PG8_SB(b, h) ((4 + (b) * 2 + (h)) * HTB)
#define PG8_STAGE(bufoff, gbase, voff) do { _Pragma("unroll") for (int _i = 0; _i < 2; ++_i) \
        __builtin_amdgcn_global_load_lds((const unsigned*)((const char*)(gbase) + (voff)[_i]), (LAS unsigned*)(lds + (bufoff) + ldsw + _i * 8192), 16, 0, 0); } while (0)
#define PG8_LD32(p) __builtin_bit_cast(i32x8, __builtin_shufflevector(*(const LAS u32x4*)(p), *(const LAS u32x4*)((p) + 16), 0, 1, 2, 3, 4, 5, 6, 7))
#define PG8_LDA8(dst, b, h) do { _Pragma("unroll") for (int m = 0; m < 4; ++m) dst[m] = PG8_LD32(lds + PG8_SA(b, h) + aoff + m * 2048); } while (0)
#define PG8_LDB8(dst, b, h) do { _Pragma("unroll") for (int n = 0; n < 2; ++n) dst[n] = PG8_LD32(lds + PG8_SB(b, h) + boff + n * 2048); } while (0)
#define PG8_LDA(dst, b, h) do { _Pragma("unroll") for (int m = 0; m < 4; ++m) _Pragma("unroll") for (int k = 0; k < 2; ++k) dst[m][k] = *(const LAS bf16x8*)(lds + PG8_SA(b, h) + aoff + m * 2048 + k * KOFF); } while (0)
#define PG8_LDB(dst, b, h) do { _Pragma("unroll") for (int n = 0; n < 2; ++n) _Pragma("unroll") for (int k = 0; k < 2; ++k) dst[n][k] = *(const LAS bf16x8*)(lds + PG8_SB(b, h) + boff + n * 2048 + k * KOFF); } while (0)
#define PG8_MMA(ai, bj, At, Bt) do { __builtin_amdgcn_s_setprio(1); _Pragma("unroll") for (int m = 0; m < 4; ++m) _Pragma("unroll") for (int n = 0; n < 2; ++n) _Pragma("unroll") for (int k = 0; k < 2; ++k) \
        acc[ai][bj][m][n] = __builtin_amdgcn_mfma_f32_16x16x32_bf16(Bt[n][k], At[m][k], acc[ai][bj][m][n], 0, 0, 0); __builtin_amdgcn_s_setprio(0); } while (0)
#define PG8_MMA8(ai, bj, At, Bt) do { __builtin_amdgcn_s_setprio(1); _Pragma("unroll") for (int m = 0; m < 4; ++m) _Pragma("unroll") for (int n = 0; n < 2; ++n) \
        asm volatile("v_mfma_scale_f32_16x16x128_f8f6f4 %0, %1, %2, %0, %3, %3 op_sel_hi:[0,0,0]" : "+v"(acc[ai][bj][m][n]) : "v"(Bt[n]), "v"(At[m]), "v"(one_scale)); __builtin_amdgcn_s_setprio(0); } while (0)
#define PG8_WAIT_V(n) asm volatile("s_waitcnt vmcnt(" #n ")" ::: "memory")
#define PG8_WAIT_L(n) asm volatile("s_waitcnt lgkmcnt(" #n ")" ::: "memory")
#define PG8_BAR __builtin_amdgcn_s_barrier()
#define PG8_SCHED __builtin_amdgcn_sched_barrier(0)
    Unit cur, nxt; int ui = 0;
    if (!S.next(0, cur)) return;
    f32x4 acc[2][2][4][2];
#pragma unroll
    for (int a = 0; a < 2; ++a)
#pragma unroll
        for (int b = 0; b < 2; ++b)
#pragma unroll
            for (int m = 0; m < 4; ++m)
#pragma unroll
                for (int n = 0; n < 2; ++n) acc[a][b][m][n] = (f32x4){0.f, 0.f, 0.f, 0.f};
    bf16x8 At[4][2], B0[2][2], B1[2][2];
    i32x8 At8[4], B08[2], B18[2];
    const unsigned one_scale = 0x7f7f7f7fu;
    const char* cA = cur.a; const char* cB = cur.b;
    PG8_STAGE(PG8_SB(0, 0), cB, voffB); PG8_STAGE(PG8_SB(0, 1), cB + hstep, voffB); PG8_STAGE(PG8_SA(0, 0), cA, voffA); PG8_STAGE(PG8_SA(0, 1), cA + hstep, voffA);
    if (wr == 1) PG8_BAR;
    PG8_WAIT_V(2); PG8_BAR;
    PG8_STAGE(PG8_SB(1, 0), cB + kstep, voffB); PG8_STAGE(PG8_SA(1, 0), cA + kstep, voffA); PG8_STAGE(PG8_SB(1, 1), cB + hstep + kstep, voffB);
    PG8_WAIT_V(6); PG8_BAR;
    for (;;) {
        const bool has_next = S.next(ui + 1, nxt);
        const char* nA = has_next ? nxt.a : cA; const char* nB = has_next ? nxt.b : cB;
#pragma unroll 1
        for (int t = 0; t < nt; t += 2) {
            const bool last = (t == nt - 2);
            const char* a1 = cA + (size_t)(t + 1) * kstep;
            const char* a2 = last ? nA : cA + (size_t)(t + 2) * kstep; const char* b2 = last ? nB : cB + (size_t)(t + 2) * kstep;
            const char* a3 = a2 + kstep; const char* b3 = b2 + kstep;
            if constexpr (FP8) {
            PG8_LDB8(B08, 0, 0); PG8_LDB8(B18, 0, 1); PG8_SCHED; PG8_LDA8(At8, 0, 0); PG8_STAGE(PG8_SA(1, 1), a1 + hstep, voffA);
            PG8_WAIT_V(8); PG8_WAIT_L(0); PG8_BAR; PG8_MMA8(0, 0, At8, B08); PG8_MMA8(0, 1, At8, B18); PG8_BAR; PG8_SCHED;
            PG8_LDA8(At8, 0, 1); PG8_STAGE(PG8_SB(0, 0), b2, voffB); PG8_STAGE(PG8_SB(0, 1), b2 + hstep, voffB); PG8_STAGE(PG8_SA(0, 0), a2, voffA);
            PG8_WAIT_V(8); PG8_WAIT_L(0); PG8_BAR; PG8_MMA8(1, 0, At8, B08); PG8_MMA8(1, 1, At8, B18); PG8_BAR; PG8_SCHED;
            PG8_LDB8(B08, 1, 0); PG8_LDB8(B18, 1, 1); PG8_SCHED; PG8_LDA8(At8, 1, 0); PG8_STAGE(PG8_SA(0, 1), a2 + hstep, voffA);
            PG8_WAIT_V(8); PG8_WAIT_L(0); PG8_BAR; PG8_MMA8(0, 0, At8, B08); PG8_MMA8(0, 1, At8, B18); PG8_BAR; PG8_SCHED;
            PG8_LDA8(At8, 1, 1); PG8_STAGE(PG8_SB(1, 0), b3, voffB); PG8_STAGE(PG8_SB(1, 1), b3 + hstep, voffB); PG8_STAGE(PG8_SA(1, 0), a3, voffA);
            PG8_WAIT_V(8); PG8_WAIT_L(0); PG8_BAR; PG8_MMA8(1, 0, At8, B08); PG8_MMA8(1, 1, At8, B18); PG8_BAR; PG8_SCHED;
            } else {
            PG8_LDB(B0, 0, 0); PG8_LDB(B1, 0, 1); PG8_SCHED; PG8_LDA(At, 0, 0); PG8_STAGE(PG8_SA(1, 1), a1 + hstep, voffA);
            PG8_WAIT_V(8); PG8_WAIT_L(0); PG8_BAR; PG8_MMA(0, 0, At, B0); PG8_MMA(0, 1, At, B1); PG8_BAR; PG8_SCHED;
            PG8_LDA(At, 0, 1); PG8_STAGE(PG8_SB(0, 0), b2, voffB); PG8_STAGE(PG8_SB(0, 1), b2 + hstep, voffB); PG8_STAGE(PG8_SA(0, 0), a2, voffA);
            PG8_WAIT_V(8); PG8_WAIT_L(0); PG8_BAR; PG8_MMA(1, 0, At, B0); PG8_MMA(1, 1, At, B1); PG8_BAR; PG8_SCHED;
            PG8_LDB(B0, 1, 0); PG8_LDB(B1, 1, 1); PG8_SCHED; PG8_LDA(At, 1, 0); PG8_STAGE(PG8_SA(0, 1), a2 + hstep, voffA);
            PG8_WAIT_V(8); PG8_WAIT_L(0); PG8_BAR; PG8_MMA(0, 0, At, B0); PG8_MMA(0, 1, At, B1); PG8_BAR; PG8_SCHED;
            PG8_LDA(At, 1, 1); PG8_STAGE(PG8_SB(1, 0), b3, voffB); PG8_STAGE(PG8_SB(1, 1), b3 + hstep, voffB); PG8_STAGE(PG8_SA(1, 0), a3, voffA);
            PG8_WAIT_V(8); PG8_WAIT_L(0); PG8_BAR; PG8_MMA(1, 0, At, B0); PG8_MMA(1, 1, At, B1); PG8_BAR; PG8_SCHED;
            }
        }
        if (wr == 0) PG8_BAR;
        if constexpr (FP8) asm volatile("s_nop 15\n\ts_nop 15" ::: "memory");
        E(acc, cur, wr, wc, fr, fq);
        if (!has_next) break;
#pragma unroll
        for (int a = 0; a < 2; ++a)
#pragma unroll
            for (int b = 0; b < 2; ++b)
#pragma unroll
                for (int m = 0; m < 4; ++m)
#pragma unroll
                    for (int n = 0; n < 2; ++n) acc[a][b][m][n] = (f32x4){0.f, 0.f, 0.f, 0.f};
        cur = nxt; cA = nA; cB = nB; ++ui;
        if (wr == 1) PG8_BAR;
    }
    PG8_WAIT_V(0);
    PG8_BAR;
#undef PG8_SA
#undef PG8_SB
#undef PG8_STAGE
#undef PG8_LDA
#undef PG8_LDB
#undef PG8_MMA
#undef PG8_MMA8
#undef PG8_LDA8
#undef PG8_LDB8
#undef PG8_LD32
#undef PG8_WAIT_V
#undef PG8_WAIT_L
#undef PG8_BAR
#undef PG8_SCHED
}
}

__device__ __forceinline__ int lane_id() { int l; asm volatile("v_mbcnt_lo_u32_b32 %0, -1, 0\n\tv_mbcnt_hi_u32_b32 %0, -1, %0" : "=v"(l)); return l; }
#define FT_DECL const int f_lane = lane_id(), f_tid = F.wave * 64 + f_lane; (void)f_tid; (void)f_lane
typedef const float* cfp_t;
typedef __attribute__((address_space(4))) cfp_t* kin_t;
struct Frame {
    LAS unsigned char* lds;
    volatile LAS unsigned* MISC;
    gu32* ctl;
    int wave, vcu, G;
    kin_t in;
    float* out;
    unsigned char* ws;
};
#define WSP(T, off) ((T*)(F.ws + (off)))

template <class RowMap>
__device__ __forceinline__ void p0_transpose_item(const float* W, int K, int N, bf16_t* WT, const RowMap& rowmap, const float* kscale, LAS float* scr, int item, int lane) {
    const int nblk = N / 32, kb = item / nblk, nb = item % nblk, k0 = 64 * kb, n0 = 32 * nb;
#pragma unroll 8
    for (int i = 0; i < 32; ++i) { const int kk = 2 * i + (lane >> 5); float v = W[(size_t)(k0 + kk) * N + n0 + (lane & 31)]; if (kscale) v *= kscale[k0 + kk]; scr[kk * 33 + (lane & 31)] = v; }
    LDS_WAIT(); asm volatile("" ::: "memory");
    const int c = lane & 7;
#pragma unroll
    for (int j = 0; j < 4; ++j) { const int n = (lane >> 3) + 8 * j; const LAS float* s = scr + (8 * c) * 33 + n;
        u32x4 o; o.x = cvt_pk_bf16(s[0 * 33], s[1 * 33]); o.y = cvt_pk_bf16(s[2 * 33], s[3 * 33]); o.z = cvt_pk_bf16(s[4 * 33], s[5 * 33]); o.w = cvt_pk_bf16(s[6 * 33], s[7 * 33]);
        *(GAS u32x4*)(WT + (size_t)rowmap(n0 + n) * K + k0 + 8 * c) = o; }
    LDS_WAIT(); asm volatile("" ::: "memory");
}

__device__ __forceinline__ unsigned pk4_fp8(float a, float b, float c, float d) { int r = __builtin_amdgcn_cvt_pk_fp8_f32(a, b, 0, false); r = __builtin_amdgcn_cvt_pk_fp8_f32(c, d, r, true); return (unsigned)r; }
constexpr float EOSCALE = 16.f;
constexpr float WSCALE = 32.f;
template <class RowMap>
__device__ __forceinline__ void p0_transpose_item_f8(const float* W, int K, int N, unsigned char* WT, const RowMap& rowmap, LAS float* scr, int item, int lane) {
    const int nblk = N / 32, kb = item / nblk, nb = item % nblk, k0 = 128 * kb, n0 = 32 * nb;
#pragma unroll
    for (int hh = 0; hh < 2; ++hh) { float v[32];
#pragma unroll
        for (int i = 0; i < 32; ++i) { const int kk = 2 * (32 * hh + i) + (lane >> 5); v[i] = __builtin_nontemporal_load(W + (size_t)(k0 + kk) * N + n0 + (lane & 31)); }
#pragma unroll
        for (int i = 0; i < 32; ++i) { const int kk = 2 * (32 * hh + i) + (lane >> 5); scr[kk * 33 + (lane & 31)] = v[i] * WSCALE; } }
    LDS_WAIT(); asm volatile("" ::: "memory");
    const int c = lane & 7;
#pragma unroll
    for (int j = 0; j < 4; ++j) { const int n = (lane >> 3) + 8 * j; const LAS float* sp = scr + (16 * c) * 33 + n;
        u32x4 o; o.x = pk4_fp8(sp[0 * 33], sp[1 * 33], sp[2 * 33], sp[3 * 33]); o.y = pk4_fp8(sp[4 * 33], sp[5 * 33], sp[6 * 33], sp[7 * 33]);
        o.z = pk4_fp8(sp[8 * 33], sp[9 * 33], sp[10 * 33], sp[11 * 33]); o.w = pk4_fp8(sp[12 * 33], sp[13 * 33], sp[14 * 33], sp[15 * 33]);
        *(GAS u32x4*)(WT + (size_t)rowmap(n0 + n) * K + k0 + 16 * c) = o; }
    LDS_WAIT(); asm volatile("" ::: "memory");
}
struct MapIdent { int off; __device__ __forceinline__ int operator()(int n) const { return off + n; } };
struct MapWin { __device__ __forceinline__ int operator()(int l) const {
    if (l >= QKVC) return l;
    const int t = l & ~255, r = l & 255, wc = r >> 6, blk = (r >> 5) & 1, bj = (r >> 4) & 1, low = r & 15;
    return t + 128 * bj + 32 * wc + 16 * blk + low; } };
struct MapW1 { int off; __device__ __forceinline__ int operator()(int jp) const { const int bj = jp >> 10, j = jp & 1023; return off + 256 * (j >> 7) + 128 * bj + (j & 127); } };


__device__ __forceinline__ void p0_filter_item(Frame& F, int item) {
    FT_DECL;
#define in F.in
    LAS float* h1s = (LAS float*)(F.lds);
    LAS float* h2s = (LAS float*)(F.lds + 4096);
    const int t0 = item * 16;
    {
        const int tt = f_tid >> 5, hh = (f_tid & 31) * 2; const float pos = (float)(t0 + tt);
        float feats[17]; feats[0] = pos * (1.f / SEQ);
#pragma unroll
        for (int i = 0; i < 8; ++i) { const float band = 1e-4f + (float)i * ((7.f - 1e-4f) / 7.f); const float ang = (6.283185307179586f / SEQ) * pos * band; feats[1 + i] = sinf(ang); feats[9 + i] = cosf(ang); }
#pragma unroll
        for (int u = 0; u < 2; ++u) { const int h = hh + u; float a = in[19][h];
#pragma unroll
            for (int k = 0; k < 17; ++k) a += feats[k] * in[18][k * 64 + h];
            h1s[tt * 64 + h] = sinf(in[20][h] * a); }
        __syncthreads();
#pragma unroll
        for (int u = 0; u < 2; ++u) { const int h = hh + u; float a = in[22][h];
#pragma unroll 8
            for (int k = 0; k < 64; ++k) a += h1s[tt * 64 + k] * in[21][k * 64 + h];
            h2s[tt * 64 + h] = sinf(in[23][h] * a); }
        __syncthreads();
    }
    f32x4 acc[16];
#pragma unroll
    for (int t = 0; t < 16; ++t) acc[t] = (f32x4){0.f, 0.f, 0.f, 0.f};
    const int o = 4 * f_tid;
    for (int k = 0; k < 64; ++k) { const f32x4 w = *(const f32x4*)(in[24] + (size_t)k * 2048 + o);
#pragma unroll
        for (int t = 0; t < 16; ++t) acc[t] += w * h2s[t * 64 + k]; }
    const int c0 = o & 511, od = o >> 9;
    float* dst = WSP(float, WS_FILT) + ((size_t)od * 512 + c0) * SEQ + t0;
#pragma unroll
    for (int e = 0; e < 4; ++e) { const float la = -3.0701134573253944f, lb = -15.350567286626972f; const float delta = fabsf(la + (float)(c0 + e) * ((lb - la) / 511.f));
#pragma unroll
        for (int q = 0; q < 4; ++q) { f32x4 v;
#pragma unroll
            for (int i = 0; i < 4; ++i) { const int t = 4 * q + i; const float tn = (float)(t0 + t) * (1.f / SEQ); v[i] = acc[t][e] * expf(-tn * delta); }
            *(f32x4*)(dst + (size_t)e * SEQ + 4 * q) = v; } }
    __syncthreads();
#undef in
}

__device__ __forceinline__ float silu_f(float v) { return v / (1.f + __expf(-v)); }

__device__ __forceinline__ void p0_prologue(Frame& F) {
    FT_DECL;
#define in F.in
    const int wg = blockIdx.x;
    if (wg < 96) {
        LAS float* sv = (LAS float*)F.lds;
        for (int i = f_tid; i < 9 * 1024; i += 512) { const int r = i >> 10, k = i & 1023; const float c = (r < 8) ? in[1][r * 1024 + k] : in[3][k]; sv[i] = silu_f(c); }
        __syncthreads();
        const int j = wg * 64 + f_lane; const float* wm = in[4];
        float acc[9];
#pragma unroll
        for (int r = 0; r < 9; ++r) acc[r] = 0.f;
        const int kbeg = F.wave * 128;
#pragma unroll 4
        for (int k = kbeg; k < kbeg + 128; ++k) { const float w = wm[(size_t)k * (NMOD * DM) + j];
#pragma unroll
            for (int r = 0; r < 9; ++r) acc[r] += sv[r * 1024 + k] * w; }
        LAS float* red = (LAS float*)(F.lds + 40960);
#pragma unroll
        for (int r = 0; r < 9; ++r) red[(F.wave * 9 + r) * 64 + f_lane] = acc[r];
        __syncthreads();
        for (int i = f_tid; i < 9 * 64; i += 512) { const int r = i >> 6, l = i & 63; float s = in[5][wg * 64 + l];
#pragma unroll
            for (int w = 0; w < 8; ++w) s += red[(w * 9 + r) * 64 + l];
            WSP(float, WS_SMALL + SM_MOD)[r * (NMOD * DM) + wg * 64 + l] = s; }
        __syncthreads();
    } else if (wg == 96) {
        if (F.wave == 0) {
            const float a = wave_sum(in[11][f_lane] * in[12][f_lane]), b = wave_sum(in[13][f_lane] * in[14][f_lane]);
            float gq = fabsf(in[9][f_lane]), gk = fabsf(in[10][f_lane]);
#pragma unroll
            for (int o = 1; o < 64; o <<= 1) { gq = fmaxf(gq, __shfl_xor(gq, o)); gk = fmaxf(gk, __shfl_xor(gk, o)); }
            if (f_lane == 0) { float* sc = WSP(float, WS_SMALL + SM_SCAL); sc[0] = expf(a) - expf(b) + LAM_INIT;
                sc[1] = (8.f * gq * gk * 1.02f + 0.05f) * 1.4426950408889634f; }
        }
        for (int i = f_tid; i < 64 * 16; i += 512) { const int pos = i >> 4, f = i & 15;
            const float inv = powf(10000.f, -(float)f / 16.f); const float ang = (float)pos * inv;
            float* rt = WSP(float, WS_SMALL + SM_ROPE); rt[2 * i] = cosf(ang); rt[2 * i + 1] = sinf(ang); }
    }
    __syncthreads();
    for (int it = wg; it < SEQ / 16; it += F.G) p0_filter_item(F, it);
    __syncthreads();
    {
        LAS float* scr = (LAS float*)(F.lds + F.wave * 16896);
        const int gw = F.vcu * NWAVES + F.wave, NGW = F.G * NWAVES;
        constexpr int I_IN = (DM / 64) * (INC / 32), I_OUT = (DM / 64) * (DM / 32), I_1 = (DM / 128) * (2 * DM / 32), I_2 = (DM / 128) * (DM / 32);
        constexpr int NITEMS = I_IN + I_OUT + NEXP * (I_1 + I_2);
        for (int it = gw; it < NITEMS; it += NGW) {
            int r = it;
            if (r < I_IN) { p0_transpose_item(in[8], DM, INC, WSP(bf16_t, WS_WIN), MapWin{}, nullptr, scr, r, f_lane); continue; } r -= I_IN;
            if (r < I_OUT) { p0_transpose_item(in[27], DM, DM, WSP(bf16_t, WS_WOUT), MapIdent{0}, nullptr, scr, r, f_lane); continue; } r -= I_OUT;
            const int e = r / (I_1 + I_2); r -= e * (I_1 + I_2);
            if (r < I_1) p0_transpose_item_f8(in[30] + (size_t)e * DM * 2 * DM, DM, 2 * DM, WSP(unsigned char, WS_W1) + (size_t)e * 2 * DM * DM, MapW1{0}, scr, r, f_lane);
            else p0_transpose_item_f8(in[32] + (size_t)e * DM * DM, DM, DM, WSP(unsigned char, WS_W2) + (size_t)e * DM * DM, MapIdent{0}, scr, r - I_1, f_lane);
        }
    }
}
#undef in

__device__ __forceinline__ void p1_norm1(Frame& F) {
    FT_DECL;
    const int gw = F.vcu * NWAVES + F.wave, NGW = F.G * NWAVES;
    const float* mod = WSP(float, WS_SMALL + SM_MOD); const float* g1 = F.in[6];
    bf16_t* H = WSP(bf16_t, WS_H);
    constexpr int RU = 4;
    for (int m0 = gw; m0 < MTOT; m0 += NGW * RU) {
        f32x4 v[RU][4];
#pragma unroll
        for (int u = 0; u < RU; ++u) { const int m = m0 + u * NGW; if (m < MTOT) {
            const float* xrow = (m < MROWS) ? F.in[0] + (size_t)m * DM : F.in[2] + (size_t)(m - MROWS) * DM; const GAS f32x4* xr = (const GAS f32x4*)xrow + f_lane;
#pragma unroll
            for (int j = 0; j < 4; ++j) v[u][j] = __builtin_nontemporal_load(xr + 64 * j); } }
#pragma unroll
        for (int u = 0; u < RU; ++u) { const int m = m0 + u * NGW; if (m < MTOT) {
            const int mb = (m < MROWS) ? (m >> 12) : 8;
            const float* sh = mod + (size_t)mb * (NMOD * DM); const float* sc = sh + DM;
            float s = 0.f;
#pragma unroll
            for (int j = 0; j < 4; ++j) s += (v[u][j].x * v[u][j].x + v[u][j].y * v[u][j].y) + (v[u][j].z * v[u][j].z + v[u][j].w * v[u][j].w);
            const float rstd = rsqrtf(wave_sum(s) * (1.f / DM) + EPS);
            GAS u32x2* o8 = (GAS u32x2*)(H + (size_t)m * DM) + f_lane;
#pragma unroll
            for (int j = 0; j < 4; ++j) { const int c = 4 * f_lane + 256 * j;
                const f32x4 g = *(const f32x4*)(g1 + c), a = *(const f32x4*)(sc + c), b = *(const f32x4*)(sh + c);
                const f32x4 y = v[u][j] * rstd * g * (a + 1.f) + b;
                u32x2 w; w.x = cvt_pk_bf16(y.x, y.y); w.y = cvt_pk_bf16(y.z, y.w); o8[64 * j] = w; } } }
    }
}

struct SchedInProj {
    int G, c; const char* H; const char* W;
    static constexpr int NA = 136 * 6, NBU = 6 * 128;
    __device__ __forceinline__ bool next(int i, g8::Unit& u) const {
        const long L = (long)i * G + c;
        if (L < NA) { g8::tile_of((int)L, 136, 6, u.pm, u.pn); u.a = H + (size_t)u.pm * 256 * DM * 2; u.b = W + (size_t)u.pn * 256 * DM * 2; u.kind = 0; u.ex = 0; return true; }
        if (L < NA + NBU) { g8::tile_of((int)L - NA, 6, 128, u.pm, u.pn); u.a = W + (size_t)(QKVC + u.pm * 256) * DM * 2; u.b = H + (size_t)u.pn * 256 * DM * 2; u.kind = 1; u.ex = 0; return true; }
        return false;
    }
};
struct EpiInProj {
    bf16_t *Q, *Kb, *Vb, *UT; const float *gq, *gk, *rope;
    __device__ __forceinline__ void operator()(f32x4 (&acc)[2][2][4][2], const g8::Unit& u, int wr, int wc, int fr, int fq) const {
        if (u.kind == 1) {
            const int row0 = u.pm * 256 + wr * 64 + fr, col0 = u.pn * 256 + wc * 32 + 8 * fq;
#pragma unroll
            for (int ai = 0; ai < 2; ++ai)
#pragma unroll
                for (int m = 0; m < 4; ++m) { bf16_t* rowp = UT + (size_t)(row0 + ai * 128 + m * 16) * MROWS + col0;
#pragma unroll
                    for (int bj = 0; bj < 2; ++bj) { const f32x4 v0 = acc[ai][bj][m][0], v1 = acc[ai][bj][m][1];
                        u32x4 w; w.x = cvt_pk_bf16(v0[0], v0[1]); w.y = cvt_pk_bf16(v0[2], v0[3]); w.z = cvt_pk_bf16(v1[0], v1[1]); w.w = cvt_pk_bf16(v1[2], v1[3]);
                        *(u32x4*)(rowp + bj * 128) = w; } }
            return;
        }
        const int blk = fq >> 1, f = fq & 1;
        const int sec = u.pn >> 1;
        const bool ctx = (u.pm >= 128);
        if (sec == 0 && ctx) return;
        const int colbase = (u.pn & 1) * 256 + wc * 64 + 32 * blk + 8 * f;
        float gg[2][2][4];
        if (sec < 2) { const float* gp = (sec == 0 ? gq : gk) + 32 * blk + 8 * f;
#pragma unroll
            for (int bj = 0; bj < 2; ++bj)
#pragma unroll
                for (int n = 0; n < 2; ++n) { const f32x4 t = *(const f32x4*)(gp + 16 * bj + 4 * n); gg[bj][n][0] = t[0]; gg[bj][n][1] = t[1]; gg[bj][n][2] = t[2]; gg[bj][n][3] = t[3]; } }
#pragma unroll
        for (int ai = 0; ai < 2; ++ai)
#pragma unroll
            for (int m = 0; m < 4; ++m) {
                const int rloc = ai * 128 + wr * 64 + m * 16 + fr; const int r = u.pm * 256 + rloc;
                f32x4 v[2][2];
#pragma unroll
                for (int bj = 0; bj < 2; ++bj)
#pragma unroll
                    for (int n = 0; n < 2; ++n) v[bj][n] = acc[ai][bj][m][n];
                size_t orow;
                if (sec == 0) orow = (size_t)r;
                else if (!ctx) orow = (size_t)(r >> 12) * KVL + CTXL + (r & 4095);
                else { const int j = r - MROWS; orow = (size_t)(j >> 8) * KVL + (j & 255); }
                if (sec < 2) {
                    float ss = 0.f;
#pragma unroll
                    for (int bj = 0; bj < 2; ++bj)
#pragma unroll
                        for (int n = 0; n < 2; ++n) ss += (v[bj][n][0] * v[bj][n][0] + v[bj][n][1] * v[bj][n][1]) + (v[bj][n][2] * v[bj][n][2] + v[bj][n][3] * v[bj][n][3]);
                    ss += __shfl_xor(ss, 16); ss += __shfl_xor(ss, 32);
                    const float rstd = rsqrtf(ss * (1.f / 64.f) + EPS);
#pragma unroll
                    for (int bj = 0; bj < 2; ++bj)
#pragma unroll
                        for (int n = 0; n < 2; ++n)
#pragma unroll
                            for (int e = 0; e < 4; ++e) v[bj][n][e] *= rstd * gg[bj][n][e];
                    if (!ctx) {
                        const int t = r & 4095; const int pos = blk ? (t & 63) : (t >> 6);
                        const float* rp = rope + (size_t)(pos * 16 + 8 * f) * 2;
#pragma unroll
                        for (int n = 0; n < 2; ++n) { const f32x4 c0 = *(const f32x4*)(rp + 8 * n), c1 = *(const f32x4*)(rp + 8 * n + 4);
                            const float cs[4] = {c0[0], c0[2], c1[0], c1[2]}, sn[4] = {c0[1], c0[3], c1[1], c1[3]};
#pragma unroll
                            for (int e = 0; e < 4; ++e) { const float x1 = v[0][n][e], x2 = v[1][n][e]; v[0][n][e] = x1 * cs[e] - x2 * sn[e]; v[1][n][e] = x2 * cs[e] + x1 * sn[e]; } }
                    }
                    if (sec == 0) {
#pragma unroll
                        for (int bj = 0; bj < 2; ++bj)
#pragma unroll
                            for (int n = 0; n < 2; ++n) v[bj][n] *= QSCALE;
                    }
                }
                bf16_t* dst = (sec == 0 ? Q : (sec == 1 ? Kb : Vb)) + orow * QKW + colbase;
#pragma unroll
                for (int bj = 0; bj < 2; ++bj) { u32x4 w; w.x = cvt_pk_bf16(v[bj][0][0], v[bj][0][1]); w.y = cvt_pk_bf16(v[bj][0][2], v[bj][0][3]); w.z = cvt_pk_bf16(v[bj][1][0], v[bj][1][1]); w.w = cvt_pk_bf16(v[bj][1][2], v[bj][1][3]);
                    *(u32x4*)(dst + 16 * bj) = w; }
            }
    }
};

struct SchedStatic {
    int G, c, nM, nN; const char* A; const char* B;
    __device__ __forceinline__ bool next(int i, g8::Unit& u) const {
        const long L = (long)i * G + c; if (L >= (long)nM * nN) return false;
        g8::tile_of((int)L, nM, nN, u.pm, u.pn); u.a = A + (size_t)u.pm * 256 * DM * 2; u.b = B + (size_t)u.pn * 256 * DM * 2; u.kind = 0; u.ex = 0; return true;
    }
};
struct EpiOutProj {
    const float* x; bf16_t* out; const float* mod;
    __device__ __forceinline__ void operator()(f32x4 (&acc)[2][2][4][2], const g8::Unit& u, int wr, int wc, int fr, int fq) const {
        const int col0 = u.pn * 256 + wc * 32 + 8 * fq;
#pragma unroll
        for (int ai = 0; ai < 2; ++ai)
#pragma unroll
            for (int m = 0; m < 4; ++m) { const int r = u.pm * 256 + ai * 128 + wr * 64 + m * 16 + fr; const float* g1 = mod + (size_t)(r >> 12) * (NMOD * DM) + 2 * DM;
                const size_t off = (size_t)r * DM + col0;
#pragma unroll
                for (int bj = 0; bj < 2; ++bj) { f32x4 o[2];
#pragma unroll
                    for (int n = 0; n < 2; ++n) { const int c = bj * 128 + 4 * n; const f32x4 xv = *(const f32x4*)(x + off + c), gv = *(const f32x4*)(g1 + col0 + c); o[n] = xv + gv * acc[ai][bj][m][n]; }
                    u32x4 w; w.x = cvt_pk_bf16(o[0][0], o[0][1]); w.y = cvt_pk_bf16(o[0][2], o[0][3]); w.z = cvt_pk_bf16(o[1][0], o[1][1]); w.w = cvt_pk_bf16(o[1][2], o[1][3]);
                    *(u32x4*)(out + off + bj * 128) = w; } }
    }
};

namespace att {
constexpr int KVBLK = 64, LDK = QKW, NT = KVL / KVBLK;
constexpr int SHM_V = KVBLK * 128 * 2, SHM_K = KVBLK * 128 * 2;
#define KSWZ(row, colB) ((row) * 256 + ((colB) ^ (((row) & 7) << 4)))
#define SBAR() __builtin_amdgcn_sched_barrier(0)
__device__ __forceinline__ int crow(int r, int hi) { return (r & 3) + 8 * (r >> 2) + 4 * hi; }
__device__ __forceinline__ void expA(f32x16& p) {
#pragma unroll
    for (int r = 0; r < 16; ++r) p[r] = __builtin_amdgcn_exp2f(p[r]);
}
__device__ __forceinline__ void finishSM(f32x16& p0, f32x16& p1, float& l_reg, bf16x8& pa0, bf16x8& pa1, bf16x8& pa2, bf16x8& pa3) {
#pragma unroll
    for (int r = 0; r < 16; ++r) p1[r] = __builtin_amdgcn_exp2f(p1[r]);
    float ps = 0;
#pragma unroll
    for (int r = 0; r < 16; ++r) ps += p0[r];
#pragma unroll
    for (int r = 0; r < 16; ++r) ps += p1[r];
    { auto rr = __builtin_amdgcn_permlane32_swap(__float_as_uint(ps), __float_as_uint(ps), false, false); ps = __uint_as_float(rr[0]) + __uint_as_float(rr[1]); }
    l_reg += ps;
#define PK4(P, BASE, OUT) do { unsigned a0 = cvt_pk_bf16(P[BASE + 0], P[BASE + 1]), a1 = cvt_pk_bf16(P[BASE + 2], P[BASE + 3]);   \
    unsigned b0 = cvt_pk_bf16(P[BASE + 4], P[BASE + 5]), b1 = cvt_pk_bf16(P[BASE + 6], P[BASE + 7]);                              \
    auto r0 = __builtin_amdgcn_permlane32_swap(a0, b0, false, false); auto r1 = __builtin_amdgcn_permlane32_swap(a1, b1, false, false); \
    u32x4 w = {r0[0], r1[0], r0[1], r1[1]}; OUT = *reinterpret_cast<bf16x8*>(&w); } while (0)
    PK4(p0, 0, pa0); PK4(p0, 8, pa1); PK4(p1, 0, pa2); PK4(p1, 8, pa3);
#undef PK4
}
__device__ __forceinline__ void qkt(f32x16& p0, f32x16& p1, const char* Ks, const bf16x8* qr, int r32, int hi, int sub, float negm) {
    (void)negm;
    const f32x16 z = {};
#pragma unroll
    for (int d0 = 0; d0 < 4; ++d0) { const int cb = (sub * 64 + d0 * 16 + hi * 8) * 2;
        const bf16x8 b0 = *reinterpret_cast<const bf16x8*>(Ks + KSWZ(r32, cb));
        const bf16x8 b1 = *reinterpret_cast<const bf16x8*>(Ks + KSWZ(32 + r32, cb));
        p0 = __builtin_amdgcn_mfma_f32_32x32x16_bf16(b0, qr[d0], d0 ? p0 : z, 0, 0, 0);
        p1 = __builtin_amdgcn_mfma_f32_32x32x16_bf16(b1, qr[d0], d0 ? p1 : z, 0, 0, 0); }
}
__device__ __forceinline__ int v_st(int k, int c) { const int kk = (k & ~0xC) | ((k & 4) << 1) | ((k & 8) >> 1); return ((kk >> 3) * 4 + (c >> 5)) * 512 + ((kk & 7) * 32 + (c & 31)) * 2; }
__device__ __forceinline__ int v_rd_base(int lane) { return ((lane & 3) << 3) | (((lane >> 2) & 3) << 6) | (((lane >> 4) & 1) << 5) | (((lane >> 5) & 1) << 8); }
constexpr int v_rd_off(int d0, int ks, int half) { return d0 * 512 + ks * 4096 + half * 2048; }
template <int OFF> __device__ __forceinline__ s16x4 tr_read(int vb) {
    s16x4 r; asm volatile("ds_read_b64_tr_b16 %0, %1 offset:%2" : "=&v"(r) : "v"(vb), "i"(OFF) : "memory"); return r;
}
template <int D0> __device__ __forceinline__ void pv_one(f32x16& od, int vb, bf16x8 pa0, bf16x8 pa1, bf16x8 pa2, bf16x8 pa3) {
    const s16x4 l0 = tr_read<v_rd_off(D0, 0, 0)>(vb), h0 = tr_read<v_rd_off(D0, 0, 1)>(vb), l1 = tr_read<v_rd_off(D0, 1, 0)>(vb), h1 = tr_read<v_rd_off(D0, 1, 1)>(vb);
    const s16x4 l2 = tr_read<v_rd_off(D0, 2, 0)>(vb), h2 = tr_read<v_rd_off(D0, 2, 1)>(vb), l3 = tr_read<v_rd_off(D0, 3, 0)>(vb), h3 = tr_read<v_rd_off(D0, 3, 1)>(vb);
    asm volatile("s_waitcnt lgkmcnt(0)" ::: "memory"); SBAR();
#define PK(L, H) (bf16x8){L[0], L[1], L[2], L[3], H[0], H[1], H[2], H[3]}
    od = __builtin_amdgcn_mfma_f32_32x32x16_bf16(pa0, PK(l0, h0), od, 0, 0, 0);
    od = __builtin_amdgcn_mfma_f32_32x32x16_bf16(pa1, PK(l1, h1), od, 0, 0, 0);
    od = __builtin_amdgcn_mfma_f32_32x32x16_bf16(pa2, PK(l2, h2), od, 0, 0, 0);
    od = __builtin_amdgcn_mfma_f32_32x32x16_bf16(pa3, PK(l3, h3), od, 0, 0, 0);
#undef PK
}
__device__ __forceinline__ void pv_d0(f32x16* o, int vb, bf16x8 pa0, bf16x8 pa1, bf16x8 pa2, bf16x8 pa3) {
    pv_one<0>(o[0], vb, pa0, pa1, pa2, pa3); pv_one<1>(o[1], vb, pa0, pa1, pa2, pa3); pv_one<2>(o[2], vb, pa0, pa1, pa2, pa3); pv_one<3>(o[3], vb, pa0, pa1, pa2, pa3);
}

__device__ __forceinline__ void attn_unit(const bf16_t* __restrict__ Qb, const bf16_t* __restrict__ Kh, const bf16_t* __restrict__ Vh, bf16_t* MIXo,
                                          const float lam, const float negm, const float* __restrict__ subg, char* lds, const int wid) {
    const int lane = lane_id(), tid = wid * 64 + lane, r32 = lane & 31, hi = lane >> 5;
    const int sub = wid >> 2, wq = wid & 3;
    char* V_lds = lds; char* K_lds = lds + 2 * SHM_V;
    float* wsf = (float*)(lds + 98304) + wid * 32;
    float l_reg = 0; f32x16 o[4] = {}; bf16x8 qr[4];
    const bf16_t* Qw = Qb + (long)(wq * 32 + r32) * LDK + sub * 64 + hi * 8;
#pragma unroll
    for (int d0 = 0; d0 < 4; ++d0) qr[d0] = *reinterpret_cast<const bf16x8*>(Qw + d0 * 16);
    const int sr = tid >> 4, sc = (tid & 15) * 8, vst0 = v_st(sr, sc), vst1 = v_st(32 + sr, sc);
    const int vb0 = (int)(uintptr_t)V_lds + v_rd_base(lane);
    struct { bf16x8 vs0, vs1, ks0, ks1; } sr_[2];
#define SLOAD(i, k0) do { sr_[i].vs0 = *(const bf16x8*)(&Vh[(long)((k0) + sr) * LDK + sc]); sr_[i].vs1 = *(const bf16x8*)(&Vh[(long)((k0) + 32 + sr) * LDK + sc]); \
    sr_[i].ks0 = *(const bf16x8*)(&Kh[(long)((k0) + sr) * LDK + sc]); sr_[i].ks1 = *(const bf16x8*)(&Kh[(long)((k0) + 32 + sr) * LDK + sc]); } while (0)
#define SWRITE(b, i) do { *(bf16x8*)(V_lds + (b) * SHM_V + vst0) = sr_[i].vs0;          \
    *(bf16x8*)(V_lds + (b) * SHM_V + vst1) = sr_[i].vs1; const int kc = sc * 2;               \
    *(bf16x8*)(K_lds + (b) * SHM_K + KSWZ(sr, kc)) = sr_[i].ks0;                       \
    *(bf16x8*)(K_lds + (b) * SHM_K + KSWZ(32 + sr, kc)) = sr_[i].ks1; } while (0)
#define SWAIT() asm volatile("s_waitcnt vmcnt(4)" ::: "memory")
    f32x16 pA0, pA1, pB0, pB1; bf16x8 pa0, pa1, pa2, pa3;
    constexpr int SE = 0, SO = 1;
    SLOAD(SE, 0); asm volatile("s_waitcnt vmcnt(0)" ::: "memory"); SWRITE(0, SE); __syncthreads();
    qkt(pA0, pA1, K_lds, qr, r32, hi, sub, negm); expA(pA0);
    SLOAD(SO, KVBLK); SLOAD(SE, 2 * KVBLK);
    SWAIT(); SWRITE(1, SO); __syncthreads();
    for (int j = 1; j + 1 < NT; j += 2) {
        SBAR(); qkt(pB0, pB1, K_lds + SHM_K, qr, r32, hi, sub, negm);
        finishSM(pA0, pA1, l_reg, pa0, pa1, pa2, pa3); SBAR();
        SLOAD(SO, (j + 2) * KVBLK); SBAR();
        pv_d0(o, vb0, pa0, pa1, pa2, pa3); expA(pB0);
        __syncthreads(); SWAIT(); SWRITE(0, SE);
        __syncthreads();
        SBAR(); qkt(pA0, pA1, K_lds, qr, r32, hi, sub, negm);
        finishSM(pB0, pB1, l_reg, pa0, pa1, pa2, pa3); SBAR();
        if (j + 3 < NT) SLOAD(SE, (j + 3) * KVBLK); SBAR();
        pv_d0(o, vb0 + SHM_V, pa0, pa1, pa2, pa3); expA(pA0);
        __syncthreads(); SWAIT(); SWRITE(1, SO);
        __syncthreads();
    }
    SBAR(); qkt(pB0, pB1, K_lds + SHM_K, qr, r32, hi, sub, negm);
    finishSM(pA0, pA1, l_reg, pa0, pa1, pa2, pa3); SBAR();
    pv_d0(o, vb0, pa0, pa1, pa2, pa3); expA(pB0);
    finishSM(pB0, pB1, l_reg, pa0, pa1, pa2, pa3); SBAR();
    pv_d0(o, vb0 + SHM_V, pa0, pa1, pa2, pa3);
#undef SLOAD
#undef SWRITE
#undef SWAIT
    if (hi == 0) wsf[r32] = l_reg;
    __syncthreads();
    float* X = (float*)lds;
    float rli[16];
#pragma unroll
    for (int r = 0; r < 16; ++r) rli[r] = __builtin_amdgcn_rcpf(wsf[crow(r, hi)]);
    if (sub == 1) {
#pragma unroll
        for (int r = 0; r < 16; ++r) { const int row = wq * 32 + crow(r, hi); const float s = lam * rli[r];
#pragma unroll
            for (int d0 = 0; d0 < 4; ++d0) X[row * 128 + d0 * 32 + r32] = o[d0][r] * s; }
    }
    __syncthreads();
    bf16_t* Y = (bf16_t*)(lds + 65536);
    if (sub == 0) {
        float sg[4];
#pragma unroll
        for (int d0 = 0; d0 < 4; ++d0) sg[d0] = subg[d0 * 32 + r32] * (1.f - LAM_INIT);
#pragma unroll
        for (int r = 0; r < 16; ++r) { const int row = wq * 32 + crow(r, hi);
            float v[4]; float ss = 0.f;
#pragma unroll
            for (int d0 = 0; d0 < 4; ++d0) { v[d0] = o[d0][r] * rli[r] - X[row * 128 + d0 * 32 + r32]; ss += v[d0] * v[d0]; }
            ss += __shfl_xor(ss, 1); ss += __shfl_xor(ss, 2); ss += __shfl_xor(ss, 4); ss += __shfl_xor(ss, 8); ss += __shfl_xor(ss, 16);
            const float rstd = rsqrtf(ss * (1.f / 128.f) + EPS);
#pragma unroll
            for (int d0 = 0; d0 < 4; ++d0) Y[row * 128 + d0 * 32 + r32] = (bf16_t)(cvt_pk_bf16(v[d0] * rstd * sg[d0], 0.f) & 0xffffu); }
    }
    __syncthreads();
    { const int row = tid >> 2, seg = (tid & 3) * 32;
#pragma unroll
        for (int i = 0; i < 4; ++i) { const u32x4 v = *(const u32x4*)(Y + row * 128 + seg + i * 8); *(u32x4*)(MIXo + (size_t)row * DM + seg + i * 8) = v; } }
    __syncthreads();
}
#undef KSWZ
#undef SBAR
}

__device__ __forceinline__ void p3_attention(Frame& F) {
    FT_DECL;
    const float* sc = WSP(float, WS_SMALL + SM_SCAL);
    const float lam = sc[0], negm = -sc[1];
    const bf16_t* Q = WSP(bf16_t, WS_Q); const bf16_t* Kb = WSP(bf16_t, WS_K); const bf16_t* Vb = WSP(bf16_t, WS_V); bf16_t* MIX = WSP(bf16_t, WS_MIX);
    const int c = blockIdx.x, xcd = c & 7, ci = c >> 3, per = F.G >> 3;
    for (int j = ci; j < 128; j += per) {
        const int pair = xcd * 4 + (j >> 5), qb = j & 31, b = pair >> 2, h = pair & 3;
        att::attn_unit(Q + ((size_t)b * SEQ + qb * 128) * QKW + h * 128, Kb + (size_t)b * KVL * QKW + h * 128, Vb + (size_t)b * KVL * QKW + h * 128,
                       MIX + ((size_t)b * SEQ + qb * 128) * DM + h * 128, lam, negm, F.in[15], (char*)F.lds, F.wave);
    }
}


namespace hy {
constexpr int RB_BYTES = 4352 * 8, IN_OFF = 2 * RB_BYTES, TW1_OFF = IN_OFF + 32768, TW2_OFF = TW1_OFF + 15 * 256 * 8, LDS_END = TW2_OFF + 15 * 16 * 8;
__device__ __forceinline__ f32x2 cmul(f32x2 a, f32x2 b) { return (f32x2){a.x * b.x - a.y * b.y, a.x * b.y + a.y * b.x}; }
__device__ __forceinline__ f32x2 cmulc(f32x2 a, f32x2 b) { return (f32x2){a.x * b.x + a.y * b.y, a.y * b.x - a.x * b.y}; }
__device__ __forceinline__ int P(int i) { return i + (i >> 4); }
template <bool INV> __device__ __forceinline__ void r4(f32x2& a, f32x2& b, f32x2& c, f32x2& d) {
    const f32x2 t0 = a + c, t1 = a - c, t2 = b + d, t3 = b - d;
    const f32x2 st3 = INV ? (f32x2){-t3.y, t3.x} : (f32x2){t3.y, -t3.x};
    a = t0 + t2; c = t0 - t2; b = t1 + st3; d = t1 - st3;
}
template <bool INV> __device__ __forceinline__ f32x2 tw(f32x2 v, float c, float s) {
    return INV ? (f32x2){v.x * c - v.y * s, v.y * c + v.x * s} : (f32x2){v.x * c + v.y * s, v.y * c - v.x * s};
}
template <bool INV> __device__ __forceinline__ void dft16(f32x2 (&v)[16]) {
    constexpr float C1 = 0.9238795325112867f, S1 = 0.3826834323650898f, R2 = 0.7071067811865476f;
    r4<INV>(v[0], v[4], v[8], v[12]); r4<INV>(v[1], v[5], v[9], v[13]); r4<INV>(v[2], v[6], v[10], v[14]); r4<INV>(v[3], v[7], v[11], v[15]);
    v[5] = tw<INV>(v[5], C1, S1);  v[9] = tw<INV>(v[9], R2, R2);    v[13] = tw<INV>(v[13], S1, C1);
    v[6] = tw<INV>(v[6], R2, R2);  v[10] = tw<INV>(v[10], 0.f, 1.f); v[14] = tw<INV>(v[14], -R2, R2);
    v[7] = tw<INV>(v[7], S1, C1);  v[11] = tw<INV>(v[11], -R2, R2);  v[15] = tw<INV>(v[15], -C1, -S1);
    r4<INV>(v[0], v[1], v[2], v[3]); r4<INV>(v[4], v[5], v[6], v[7]); r4<INV>(v[8], v[9], v[10], v[11]); r4<INV>(v[12], v[13], v[14], v[15]);
    f32x2 t;
    t = v[1]; v[1] = v[4]; v[4] = t;   t = v[2]; v[2] = v[8]; v[8] = t;    t = v[3]; v[3] = v[12]; v[12] = t;
    t = v[6]; v[6] = v[9]; v[9] = t;   t = v[7]; v[7] = v[13]; v[13] = t;  t = v[11]; v[11] = v[14]; v[14] = t;
}
struct Ctx { LAS f32x2* R; LAS f32x2* IN; LAS f32x2* TW1; LAS f32x2* TW2; int t, half; f32x2 wt; };
#define HY_OPAQUE(x) asm volatile("" : "+v"(x))
#define HY_W32(m) (f32x2){__builtin_cosf(-0.19634954084936207f * (m)), __builtin_sinf(-0.19634954084936207f * (m))}
template <int MODE> __device__ __forceinline__ void pass1_fwd(const Ctx& X) {
    f32x2 v[16]; int t = X.t; HY_OPAQUE(t);
#pragma unroll
    for (int m = 0; m < 16; ++m) { f32x2 a = X.IN[t + 256 * m]; if (MODE == 1) a = (f32x2){X.half ? a.y : a.x, 0.f}; v[m] = a; }
    if (X.half) {
#pragma unroll
        for (int m = 0; m < 16; ++m) v[m] = cmul(cmul(v[m], HY_W32(m)), X.wt);
    }
    dft16<false>(v);
#pragma unroll
    for (int q = 1; q < 16; ++q) v[q] = cmul(v[q], X.TW1[(q - 1) * 256 + t]);
    const int pb = t + (t >> 4);
#pragma unroll
    for (int q = 0; q < 16; ++q) X.R[pb + 272 * q] = v[q];
}
__device__ __forceinline__ void pass2_fwd(const Ctx& X) {
    int t = X.t; HY_OPAQUE(t);
    const int n2 = t & 15, pb = (t >> 4) * 272 + n2; f32x2 v[16];
#pragma unroll
    for (int m = 0; m < 16; ++m) v[m] = X.R[pb + 17 * m];
    dft16<false>(v);
#pragma unroll
    for (int q = 1; q < 16; ++q) v[q] = cmul(v[q], X.TW2[(q - 1) * 16 + n2]);
#pragma unroll
    for (int q = 0; q < 16; ++q) X.R[pb + 17 * q] = v[q];
}
template <bool FILTER> __device__ __forceinline__ void pass3(const Ctx& X, f32x2 (&H)[16]) {
    f32x2 v[16]; int t = X.t; HY_OPAQUE(t); const int pb = 17 * t;
#pragma unroll
    for (int m = 0; m < 16; ++m) v[m] = X.R[pb + m];
    dft16<false>(v);
    if (FILTER) {
#pragma unroll
        for (int q = 0; q < 16; ++q) H[q] = v[q] * (1.f / 8192.f);
    } else {
#pragma unroll
        for (int q = 0; q < 16; ++q) v[q] = cmul(v[q], H[q]);
        dft16<true>(v);
#pragma unroll
        for (int m = 0; m < 16; ++m) X.R[pb + m] = v[m];
    }
}
__device__ __forceinline__ void pass2_inv(const Ctx& X) {
    int t = X.t; HY_OPAQUE(t);
    const int n2 = t & 15, pb = (t >> 4) * 272 + n2; f32x2 v[16];
    v[0] = X.R[pb];
#pragma unroll
    for (int q = 1; q < 16; ++q) v[q] = cmulc(X.R[pb + 17 * q], X.TW2[(q - 1) * 16 + n2]);
    dft16<true>(v);
#pragma unroll
    for (int m = 0; m < 16; ++m) X.R[pb + 17 * m] = v[m];
}
__device__ __forceinline__ void pass1_inv(const Ctx& X) {
    f32x2 v[16]; int t = X.t; HY_OPAQUE(t); const int pb = t + (t >> 4);
    v[0] = X.R[pb];
#pragma unroll
    for (int q = 1; q < 16; ++q) v[q] = cmulc(X.R[pb + 272 * q], X.TW1[(q - 1) * 256 + t]);
    dft16<true>(v);
    if (X.half) {
#pragma unroll
        for (int m = 0; m < 16; ++m) v[m] = cmulc(cmulc(v[m], HY_W32(m)), X.wt);
    }
#pragma unroll
    for (int m = 0; m < 16; ++m) X.R[pb + 272 * m] = v[m];
}
__device__ __forceinline__ void conv_fft(const Ctx& X, f32x2 (&H)[16]) {
    __syncthreads(); pass1_fwd<0>(X); __syncthreads(); pass2_fwd(X); __syncthreads(); pass3<false>(X, H); __syncthreads(); pass2_inv(X); __syncthreads(); pass1_inv(X); __syncthreads();
}
constexpr int STG_OFF = LDS_END;
constexpr int LDS_END2 = STG_OFF + 2 * SEQ * 2;
static_assert(LDS_END2 <= LDSCTL_OFF, "hyena LDS map");
__device__ __forceinline__ float sconv_lds(const LAS bf16_t* stg, int bs, int n, float w0, float w1, float w2, float bias) {
    const LAS bf16_t* p = stg + bs * SEQ;
    const float c = bf2f(p[n]), lv = bf2f(p[n - ((n > 0) ? 1 : 0)]), rv = bf2f(p[n + ((n < SEQ - 1) ? 1 : 0)]);
    const float l = (n > 0) ? lv : 0.f, r = (n < SEQ - 1) ? rv : 0.f;
    return bias + w0 * l + w1 * c + w2 * r;
}
__device__ __forceinline__ void setup_tables(LAS unsigned char* lds, int tid) {
    LAS f32x2* TW1 = (LAS f32x2*)(lds + TW1_OFF); LAS f32x2* TW2 = (LAS f32x2*)(lds + TW2_OFF);
    for (int i = tid; i < 15 * 256; i += 512) { const int q = i / 256 + 1, t = i & 255; float s, c; sincosf(-6.283185307179586f * (float)((t * q) & 4095) * (1.f / 4096.f), &s, &c); TW1[i] = (f32x2){c, s}; }
    for (int i = tid; i < 15 * 16; i += 512) { const int q = i / 16 + 1, n2 = i & 15; float s, c; sincosf(-6.283185307179586f * (float)((n2 * q) & 255) * (1.f / 256.f), &s, &c); TW2[i] = (f32x2){c, s}; }
}
__device__ __forceinline__ void unit(Frame& F, int c) {
    FT_DECL;
    const int tid = f_tid; Ctx X; X.half = F.wave >> 2; X.t = tid & 255;
    X.R = (LAS f32x2*)(F.lds + X.half * RB_BYTES); X.IN = (LAS f32x2*)(F.lds + IN_OFF); X.TW1 = (LAS f32x2*)(F.lds + TW1_OFF); X.TW2 = (LAS f32x2*)(F.lds + TW2_OFF);
    { float s, cc; sincosf(-6.283185307179586f * (float)X.t * (1.f / 8192.f), &s, &cc); X.wt = (f32x2){cc, s}; }
    LAS f32x2* RB0 = (LAS f32x2*)(F.lds); LAS f32x2* RB1 = (LAS f32x2*)(F.lds + RB_BYTES);
    const float* FILT = WSP(float, WS_FILT);
    f32x2 H0[16], H1[16];
#pragma unroll
    for (int ord = 0; ord < 2; ++ord) {
        const float* hf = FILT + ((size_t)(ord * 2 + 0) * 512 + c) * SEQ; const float* hb = FILT + ((size_t)(ord * 2 + 1) * 512 + c) * SEQ;
        __syncthreads();
        int nb = tid; HY_OPAQUE(nb);
#pragma unroll
        for (int j = 0; j < 8; ++j) { const int n = nb + 512 * j; const float a = hf[n], b = hb[(SEQ - n) & (SEQ - 1)]; const float lo = (n == 0) ? a + b : a, hi = (n == 0) ? 0.f : b; X.IN[n] = (f32x2){lo + hi, lo - hi}; }
        __syncthreads(); pass1_fwd<1>(X); __syncthreads(); pass2_fwd(X); __syncthreads();
        if (ord == 0) pass3<true>(X, H0); else pass3<true>(X, H1);
    }
    const bf16_t* UT = WSP(bf16_t, WS_UT);
    const bf16_t* rv = UT + (size_t)c * MROWS; const bf16_t* r1 = UT + (size_t)(512 + c) * MROWS; const bf16_t* r2 = UT + (size_t)(1024 + c) * MROWS;
    const float* cw = F.in[16]; const float* cb = F.in[17];
    const float wv0 = cw[c], wv1 = cw[HYC + c], wv2 = cw[2 * HYC + c], bv = cb[c];
    const float wa0 = cw[512 + c], wa1 = cw[HYC + 512 + c], wa2 = cw[2 * HYC + 512 + c], ba = cb[512 + c];
    const float wb0 = cw[1024 + c], wb1 = cw[HYC + 1024 + c], wb2 = cw[2 * HYC + 1024 + c], bb = cb[1024 + c];
    const float sk0 = F.in[25][c], sk1 = F.in[25][512 + c];
    bf16_t* Z = WSP(bf16_t, WS_Z2T) + (size_t)c * MROWS;
    LAS bf16_t* STG = (LAS bf16_t*)(F.lds + STG_OFF);
    u32x4 g0 = *(const u32x4*)(rv + tid * 8), g1 = *(const u32x4*)(rv + SEQ + tid * 8);
    for (int pr = 0; pr < 4; ++pr) {
        const int b0 = 2 * pr, b1 = b0 + 1;
        f32x2 z[8]; int pc = tid + (tid >> 4); HY_OPAQUE(pc); int nb = tid; HY_OPAQUE(nb);
        __syncthreads();
        *(LAS u32x4*)(STG + tid * 8) = g0; *(LAS u32x4*)(STG + SEQ + tid * 8) = g1;
        __syncthreads();
#pragma unroll
        for (int j = 0; j < 8; ++j) { const int n = nb + 512 * j; z[j] = (f32x2){sconv_lds(STG, 0, n, wv0, wv1, wv2, bv), sconv_lds(STG, 1, n, wv0, wv1, wv2, bv)}; X.IN[n] = z[j]; }
        g0 = *(const u32x4*)(r1 + b0 * SEQ + tid * 8); g1 = *(const u32x4*)(r1 + b1 * SEQ + tid * 8);
        conv_fft(X, H0);
        *(LAS u32x4*)(STG + tid * 8) = g0; *(LAS u32x4*)(STG + SEQ + tid * 8) = g1;
        __syncthreads();
        HY_OPAQUE(nb); HY_OPAQUE(pc);
#pragma unroll
        for (int j = 0; j < 8; ++j) { const int n = nb + 512 * j; const f32x2 y = RB0[pc + 544 * j] + RB1[pc + 544 * j];
            const f32x2 g = (f32x2){sconv_lds(STG, 0, n, wa0, wa1, wa2, ba), sconv_lds(STG, 1, n, wa0, wa1, wa2, ba)};
            z[j] = g * (y + sk0 * z[j]); X.IN[n] = z[j]; }
        g0 = *(const u32x4*)(r2 + b0 * SEQ + tid * 8); g1 = *(const u32x4*)(r2 + b1 * SEQ + tid * 8);
        conv_fft(X, H1);
        *(LAS u32x4*)(STG + tid * 8) = g0; *(LAS u32x4*)(STG + SEQ + tid * 8) = g1;
        __syncthreads();
        if (pr < 3) { g0 = *(const u32x4*)(rv + (b0 + 2) * SEQ + tid * 8); g1 = *(const u32x4*)(rv + (b1 + 2) * SEQ + tid * 8); }
        HY_OPAQUE(nb); HY_OPAQUE(pc);
        f32x2 o[8];
#pragma unroll
        for (int j = 0; j < 8; ++j) { const int n = nb + 512 * j; const f32x2 y = RB0[pc + 544 * j] + RB1[pc + 544 * j];
            const f32x2 g = (f32x2){sconv_lds(STG, 0, n, wb0, wb1, wb2, bb), sconv_lds(STG, 1, n, wb0, wb1, wb2, bb)};
            o[j] = g * (y + sk1 * z[j]); }
        __syncthreads();
#pragma unroll
        for (int j = 0; j < 8; ++j) { const int n = nb + 512 * j; STG[n] = (bf16_t)(cvt_pk_bf16(o[j].x, 0.f) & 0xffffu); STG[SEQ + n] = (bf16_t)(cvt_pk_bf16(o[j].y, 0.f) & 0xffffu); }
        __syncthreads();
        *(u32x4*)(Z + b0 * SEQ + tid * 8) = *(const LAS u32x4*)(STG + tid * 8); *(u32x4*)(Z + b1 * SEQ + tid * 8) = *(const LAS u32x4*)(STG + SEQ + tid * 8);
    }
    __syncthreads();
}
}

__device__ __forceinline__ void p3_hyena(Frame& F) {
    FT_DECL;
    __syncthreads();
    hy::setup_tables(F.lds, f_tid);
    __syncthreads();
    for (int c = F.vcu; c < HYW; c += F.G) hy::unit(F, c);
}

__device__ __forceinline__ void p4_hynorm(Frame& F) {
    FT_DECL;
    const bf16_t* Z = WSP(bf16_t, WS_Z2T); bf16_t* MIX = WSP(bf16_t, WS_MIX); const float* g = F.in[26];
    LAS bf16_t* T = (LAS bf16_t*)F.lds;
    LAS float* red = (LAS float*)(F.lds + 512 * 72 * 2);
    LAS float* rs = red + 512;
    for (int it = F.vcu; it < MROWS / 64; it += F.G) {
        const int tok0 = it * 64;
        __syncthreads();
#pragma unroll
        for (int j = 0; j < 8; ++j) { const int i = f_tid + 512 * j, row = i >> 3, ch = i & 7; const u32x4 v = *(const u32x4*)(Z + (size_t)row * MROWS + tok0 + ch * 8); *(LAS u32x4*)(T + row * 72 + ch * 8) = v; }
        __syncthreads();
        { const int tok = f_tid & 63, grp = f_tid >> 6; float ss = 0.f;
#pragma unroll 8
            for (int k = 0; k < 64; ++k) { const float v = bf2f(T[(grp * 64 + k) * 72 + tok]); ss += v * v; }
            red[grp * 64 + tok] = ss; }
        __syncthreads();
        if (f_tid < 64) { float ss = 0.f;
#pragma unroll
            for (int w = 0; w < 8; ++w) ss += red[w * 64 + f_tid];
            rs[f_tid] = rsqrtf(ss * (1.f / HYW) + EPS); }
        __syncthreads();
#pragma unroll
        for (int j = 0; j < 8; ++j) { const int i = f_tid + 512 * j, tok = i >> 6, c0 = (i & 63) * 8; const float r = rs[tok];
            float v[8];
#pragma unroll
            for (int e = 0; e < 8; ++e) v[e] = bf2f(T[(c0 + e) * 72 + tok]) * r * g[c0 + e];
            u32x4 w; w.x = cvt_pk_bf16(v[0], v[1]); w.y = cvt_pk_bf16(v[2], v[3]); w.z = cvt_pk_bf16(v[4], v[5]); w.w = cvt_pk_bf16(v[6], v[7]);
            *(u32x4*)(MIX + (size_t)(tok0 + tok) * DM + 512 + c0) = w; }
    }
}

__device__ __forceinline__ void p4_stub(Frame& F) {
    FT_DECL;
    bf16_t* MIX = WSP(bf16_t, WS_MIX);
    const size_t gt = (size_t)F.vcu * 512 + f_tid, NT = (size_t)F.G * 512;
    for (size_t i = gt; i < (size_t)MROWS * 64; i += NT) { const size_t row = i >> 6, ch = i & 63; *(u32x4*)(MIX + row * DM + 512 + ch * 8) = (u32x4){0u, 0u, 0u, 0u}; }
}


constexpr size_t RT_TOPI = 0;
constexpr size_t RT_GATE = 512 * 1024;
constexpr size_t RT_POS = 1024 * 1024;
constexpr size_t RT_WGCNT = 1536 * 1024;
constexpr size_t RT_META = 1600 * 1024;
constexpr size_t RT_LIST = 2048 * 1024;
constexpr size_t RT_GSLOT = 2048 * 1024 + 640 * 1024;
constexpr int MAXSLOT = MROWS * TOPK + NEXP * 256;
constexpr int MAXTILE = MAXSLOT / 256;
constexpr size_t WS_XS = WS_EO;
constexpr int RW_PITCH = 32;
constexpr int P6_LDS_TOPI = 1024 * RW_PITCH * 4;

__device__ __forceinline__ void p6_router(Frame& F) {
    FT_DECL;
#define in F.in
    LAS float* RW = (LAS float*)F.lds;
    LAS int* TI = (LAS int*)(F.lds + P6_LDS_TOPI);
    LAS int* PS = TI + 512;
    LAS int* SC = PS + 512;
    const float* rw = in[28];
    for (int i = f_tid; i < 1024 * 8; i += 512) { const int k = i >> 3, c4 = i & 7; const f32x4 v = *(const f32x4*)(rw + (size_t)k * 32 + c4 * 4);
        const int pi = (k & 3) * 256 + (k >> 2); *(LAS f32x4*)(RW + pi * RW_PITCH + ((c4 ^ ((pi >> 1) & 7)) * 4)) = v; }
    __syncthreads();
    const float* mod = WSP(float, WS_SMALL + SM_MOD); const float* g2n = in[7]; const float* rb = in[29];
    unsigned char* H2 = WSP(unsigned char, WS_H);
    int* topi_g = WSP(int, WS_ROUTE + RT_TOPI); float* gate_g = WSP(float, WS_ROUTE + RT_GATE); int* pos_g = WSP(int, WS_ROUTE + RT_POS); int* wgcnt = WSP(int, WS_ROUTE + RT_WGCNT);
    const int lane = f_lane;
    for (int blk = blockIdx.x; blk < MROWS / 128; blk += F.G) {
        for (int it = 0; it < 8; ++it) {
            const int rl = F.wave * 16 + 2 * it, r0 = blk * 128 + rl;
            const float* sh2 = mod + (size_t)(r0 >> 12) * (NMOD * DM) + 3 * DM; const float* sc2 = sh2 + DM;
            f32x4 h[2][4];
#pragma unroll
            for (int rr = 0; rr < 2; ++rr) {
                const GAS u32x2* xr = (const GAS u32x2*)(WSP(bf16_t, WS_XN) + (size_t)(r0 + rr) * DM) + lane; float ss = 0.f;
#pragma unroll
                for (int j = 0; j < 4; ++j) { const u32x2 xb = xr[64 * j]; h[rr][j] = (f32x4){__uint_as_float(xb.x << 16), __uint_as_float(xb.x & 0xffff0000u), __uint_as_float(xb.y << 16), __uint_as_float(xb.y & 0xffff0000u)}; ss += (h[rr][j].x * h[rr][j].x + h[rr][j].y * h[rr][j].y) + (h[rr][j].z * h[rr][j].z + h[rr][j].w * h[rr][j].w); }
                const float rstd = rsqrtf(wave_sum(ss) * (1.f / DM) + EPS);
                GAS unsigned* o4 = (GAS unsigned*)(H2 + (size_t)(r0 + rr) * DM) + lane;
#pragma unroll
                for (int j = 0; j < 4; ++j) { const int c = 4 * lane + 256 * j;
                    const f32x4 g = *(const f32x4*)(g2n + c), a = *(const f32x4*)(sc2 + c), b = *(const f32x4*)(sh2 + c);
                    h[rr][j] = h[rr][j] * rstd * g * (a + 1.f) + b;
                    o4[64 * j] = pk4_fp8(h[rr][j].x, h[rr][j].y, h[rr][j].z, h[rr][j].w); }
            }
            float a0[32], a1[32]; int lb = lane; asm volatile("" : "+v"(lb)); const int sw = (lb >> 1) & 7;
#pragma unroll
            for (int e = 0; e < 32; ++e) { a0[e] = 0.f; a1[e] = 0.f; }
            unsigned pb[8];
#pragma unroll
            for (int c = 0; c < 8; ++c) { pb[c] = (unsigned)(uintptr_t)RW + (unsigned)lb * 128u + (unsigned)((c ^ sw) * 16); asm volatile("" : "+v"(pb[c])); }
            f32x4 wb[2][4];
#define P6_OFF(hs) ((((((hs) >> 1) & 3) * 256 + 64 * ((hs) >> 3)) * 128) & 65535)
#define P6_HI(hs) ((((((hs) >> 1) & 3) * 256 + 64 * ((hs) >> 3)) * 128) >> 16)
#define P6_LOADW(buf, hs) _Pragma("unroll") for (int c = 0; c < 4; ++c) wb[buf][c] = *(const LAS f32x4*)(uintptr_t)(pb[4 * ((hs) & 1) + c] + (unsigned)(P6_HI(hs) * 65536 + P6_OFF(hs)))
#define P6_FMA(buf, hs) do { const float x0 = h[0][(hs) >> 3][((hs) >> 1) & 3], x1 = h[1][(hs) >> 3][((hs) >> 1) & 3]; _Pragma("unroll") for (int c = 0; c < 4; ++c) _Pragma("unroll") for (int e = 0; e < 4; ++e) { \
                a0[16 * ((hs) & 1) + 4 * c + e] += x0 * wb[buf][c][e]; a1[16 * ((hs) & 1) + 4 * c + e] += x1 * wb[buf][c][e]; } } while (0)
            P6_LOADW(0, 0);
#pragma unroll
            for (int hs = 0; hs < 32; hs += 2) {
                P6_LOADW(1, hs + 1); __builtin_amdgcn_sched_barrier(0); asm volatile("s_waitcnt lgkmcnt(4)" ::: "memory"); __builtin_amdgcn_sched_barrier(0);
                P6_FMA(0, hs); __builtin_amdgcn_sched_barrier(0);
                if (hs + 2 < 32) { P6_LOADW(0, hs + 2); __builtin_amdgcn_sched_barrier(0); asm volatile("s_waitcnt lgkmcnt(4)" ::: "memory"); } else { asm volatile("s_waitcnt lgkmcnt(0)" ::: "memory"); }
                __builtin_amdgcn_sched_barrier(0);
                P6_FMA(1, hs + 1); __builtin_amdgcn_sched_barrier(0);
            }
#undef P6_LOADW
#undef P6_FMA
#undef P6_OFF
#undef P6_HI
#define RS_STEP(A, CNT, MASK) _Pragma("unroll") for (int i = 0; i < CNT; ++i) { const bool up = (lane & MASK) != 0; const float send = up ? A[i] : A[CNT + i]; const float keep = up ? A[CNT + i] : A[i]; A[i] = keep + __shfl_xor(send, MASK); }
            RS_STEP(a0, 16, 32) RS_STEP(a0, 8, 16) RS_STEP(a0, 4, 8) RS_STEP(a0, 2, 4) RS_STEP(a0, 1, 2)
            RS_STEP(a1, 16, 32) RS_STEP(a1, 8, 16) RS_STEP(a1, 4, 8) RS_STEP(a1, 2, 4) RS_STEP(a1, 1, 2)
#undef RS_STEP
            const int me = lane >> 1; const float bias = rb[me];
            float lg[2]; lg[0] = a0[0] + __shfl_xor(a0[0], 1) + bias; lg[1] = a1[0] + __shfl_xor(a1[0], 1) + bias;
            LAS float* WL = (LAS float*)(F.lds + P6_LDS_TOPI + 6144) + F.wave * 96;
            if ((lane & 1) == 0) { WL[me] = lg[0]; WL[32 + me] = lg[1]; }
            LDS_WAIT(); asm volatile("" ::: "memory");
#pragma unroll
            for (int rr = 0; rr < 2; ++rr) {
                const float v = lg[rr]; int rank = 0;
#pragma unroll
                for (int c4 = 0; c4 < 8; ++c4) { const f32x4 o = *(const LAS f32x4*)(WL + rr * 32 + 4 * c4);
#pragma unroll
                    for (int e = 0; e < 4; ++e) { const int oe = 4 * c4 + e; rank += (o[e] > v || (o[e] == v && oe < me)) ? 1 : 0; } }
                if ((lane & 1) == 0 && rank < 4) { WL[64 + rr * 4 + rank] = v; ((LAS int*)WL)[72 + rr * 4 + rank] = me; }
            }
            LDS_WAIT(); asm volatile("" ::: "memory");
            if (lane < 2) { const int rr = lane; const f32x4 tv = *(const LAS f32x4*)(WL + 64 + rr * 4); typedef int i32x4_t __attribute__((ext_vector_type(4))); const i32x4_t ti = *(const LAS i32x4_t*)((LAS int*)WL + 72 + rr * 4);
                const float e1 = __expf(tv[1] - tv[0]), e2 = __expf(tv[2] - tv[0]), e3 = __expf(tv[3] - tv[0]); const float inv = 1.f / (1.f + e1 + e2 + e3);
                const int r = r0 + rr;
                *(i32x4_t*)(topi_g + (size_t)r * 4) = ti;
                *(f32x4*)(gate_g + (size_t)r * 4) = (f32x4){inv, e1 * inv, e2 * inv, e3 * inv};
                *(LAS i32x4_t*)(TI + (rl + rr) * 4) = ti; }
            LDS_WAIT(); asm volatile("" ::: "memory");
        }
        __syncthreads();
        { const int t2 = F.wave * 64 + lane_id(); const int e = t2 & 31, seg = t2 >> 5; int cnt = 0;
#pragma unroll 4
            for (int i = 0; i < 32; ++i) cnt += (TI[seg * 32 + i] == e) ? 1 : 0;
            SC[seg * 32 + e] = cnt;
            __syncthreads();
            int pre = 0;
            for (int s2 = 0; s2 < seg; ++s2) pre += SC[s2 * 32 + e];
            if (seg == 15) wgcnt[blk * 32 + e] = pre + cnt;
            for (int i = 0; i < 32; ++i) if (TI[seg * 32 + i] == e) { PS[seg * 32 + i] = pre; ++pre; }
        }
        __syncthreads();
        { const int t3 = F.wave * 64 + lane_id(); pos_g[(size_t)blk * 512 + t3] = PS[t3]; }
        __syncthreads();
    }
#undef in
}

__device__ __forceinline__ void p7_scatter(Frame& F) {
    FT_DECL;
    LAS int* TOT = (LAS int*)F.lds;
    LAS int* BASE = TOT + 32;
    LAS int* PRE = BASE + 32;
    LAS int* PART = PRE + 32;
    const int* wgcnt = WSP(int, WS_ROUTE + RT_WGCNT); const int* topi_g = WSP(int, WS_ROUTE + RT_TOPI); const float* gate_g = WSP(float, WS_ROUTE + RT_GATE); const int* pos_g = WSP(int, WS_ROUTE + RT_POS);
    int* list = WSP(int, WS_ROUTE + RT_LIST); float* gslot = WSP(float, WS_ROUTE + RT_GSLOT); int* meta = WSP(int, WS_ROUTE + RT_META);
    const unsigned char* H2 = WSP(unsigned char, WS_H); unsigned char* XS = WSP(unsigned char, WS_XS);
    for (int blk = blockIdx.x; blk < MROWS / 128; blk += F.G) {
        __syncthreads();
        { const int e = f_tid & 31, part = f_tid >> 5; int st = 0, sp = 0;
            for (int w = part * 16; w < part * 16 + 16; ++w) { const int c = wgcnt[w * 32 + e]; st += c; if (w < blk) sp += c; }
            PART[part * 32 + e] = st; PART[512 + part * 32 + e] = sp; }
        __syncthreads();
        if (f_tid < 32) { int st = 0, sp = 0;
#pragma unroll
            for (int p = 0; p < 16; ++p) { st += PART[p * 32 + f_tid]; sp += PART[512 + p * 32 + f_tid]; }
            TOT[f_tid] = st; PRE[f_tid] = sp; }
        __syncthreads();
        if (f_tid == 0) { int b = 0; for (int e = 0; e < 32; ++e) { BASE[e] = b; b += (TOT[e] + 255) & ~255; }
            if (blk == 0) { int t = 0; for (int e = 0; e < 32; ++e) { meta[e] = TOT[e]; meta[32 + e] = BASE[e]; const int nt = (TOT[e] + 255) >> 8; for (int q = 0; q < nt; ++q) meta[128 + t + q] = e; t += nt; } meta[64] = t; } }
        __syncthreads();
        { const int a = f_tid, row = blk * 128 + (a >> 2); const int e = topi_g[(size_t)blk * 512 + a]; const int slot = BASE[e] + PRE[e] + pos_g[(size_t)blk * 512 + a];
            list[slot] = row * 4 + (a & 3); gslot[slot] = gate_g[(size_t)blk * 512 + a];
            PART[a] = slot; }
        __syncthreads();
        for (int a0 = F.wave * 8; a0 < 512; a0 += NWAVES * 8) { u32x4 v[8]; int sl[8];
#pragma unroll
            for (int q = 0; q < 8; ++q) { const int a = a0 + q; sl[q] = PART[a]; v[q] = ((const GAS u32x4*)(H2 + (size_t)(blk * 128 + (a >> 2)) * DM))[f_lane]; }
#pragma unroll
            for (int q = 0; q < 8; ++q) ((GAS u32x4*)(XS + (size_t)sl[q] * DM))[f_lane] = v[q]; }
        if (blk < NEXP) { const int e = blk, lo = BASE[e] + TOT[e], hi = BASE[e] + ((TOT[e] + 255) & ~255);
            for (int sl = lo + F.wave; sl < hi; sl += NWAVES) { if (f_lane == 0) { list[sl] = -1; gslot[sl] = 0.f; }
                ((GAS u32x4*)(XS + (size_t)sl * DM))[f_lane] = (u32x4){0u, 0u, 0u, 0u}; } }
    }
}

template <int NPN> struct SchedMoE {
    int G, c, nT; const char* A; const char* W; size_t wstride; const LAS unsigned char* tileE;
    __device__ __forceinline__ bool next(int i, g8::Unit& u) const {
        const int L = i * G + c, xcd = L & 7, j = L >> 3, T = (j / NPN) * 8 + xcd, pn = j % NPN;
        if (T >= nT) return false;
        const int e = tileE[T];
        u.pm = T; u.pn = pn; u.kind = i; u.ex = e; u.a = A + (size_t)T * 256 * DM; u.b = W + (size_t)e * wstride + (size_t)pn * 256 * DM; return true;
    }
};
struct EpiSwiGLU {
    unsigned char* ACT; const float* b1;
    __device__ __forceinline__ void operator()(f32x4 (&acc)[2][2][4][2], const g8::Unit& u, int wr, int wc, int fr, int fq) const {
        asm volatile("" : "+v"(fr), "+v"(fq));
        const int j0 = u.pn * 128 + wc * 32 + 8 * fq; const float* bp = b1 + (size_t)u.ex * 2 * DM + j0;
        f32x4 bg[2], bl[2];
#pragma unroll
        for (int n = 0; n < 2; ++n) { bg[n] = *(const f32x4*)(bp + 4 * n); bl[n] = *(const f32x4*)(bp + DM + 4 * n); }
#pragma unroll
        for (int ai = 0; ai < 2; ++ai)
#pragma unroll
            for (int m = 0; m < 4; ++m) { const size_t slot = (size_t)u.pm * 256 + ai * 128 + wr * 64 + m * 16 + fr; float o[8];
#pragma unroll
                for (int n = 0; n < 2; ++n) { const f32x4 g4 = acc[ai][0][m][n] * (1.f / WSCALE) + bg[n], l4 = acc[ai][1][m][n] * (1.f / WSCALE) + bl[n];
#pragma unroll
                    for (int e = 0; e < 4; ++e) { const float g = fminf(g4[e], 7.f), l = __builtin_amdgcn_fmed3f(l4[e], -7.f, 7.f);
                        const float ex = __builtin_amdgcn_exp2f(g * (-1.702f * 1.4426950408889634f)); const float glu = g * __builtin_amdgcn_rcpf(1.f + ex);
                        o[4 * n + e] = fmaf(l, glu, glu); } }
                u32x2 w; w.x = pk4_fp8(o[0], o[1], o[2], o[3]); w.y = pk4_fp8(o[4], o[5], o[6], o[7]);
                *(u32x2*)(ACT + slot * DM + j0) = w; }
    }
};
struct EpiDown {
    unsigned char* EO; const float* b2; const LAS int* LL; int G, c;
    __device__ __forceinline__ void operator()(f32x4 (&acc)[2][2][4][2], const g8::Unit& u, int wr, int wc, int fr, int fq) const {
        asm volatile("" : "+v"(fr), "+v"(fq));
        const int c0 = u.pn * 256 + wc * 32 + 8 * fq; const float* bp = b2 + (size_t)u.ex * DM + c0;
        f32x4 bb[2][2];
#pragma unroll
        for (int bj = 0; bj < 2; ++bj)
#pragma unroll
            for (int n = 0; n < 2; ++n) bb[bj][n] = *(const f32x4*)(bp + bj * 128 + 4 * n);
        const LAS int* L = LL + u.kind * 512;
        int li[8]; float gt[8];
#pragma unroll
        for (int q = 0; q < 8; ++q) { const int rl = (q >> 2) * 128 + wr * 64 + (q & 3) * 16 + fr; li[q] = L[rl]; gt[q] = __int_as_float(L[256 + rl]) * (1.f / WSCALE); }
#pragma unroll
        for (int ai = 0; ai < 2; ++ai)
#pragma unroll
            for (int m = 0; m < 4; ++m) { const int l = li[ai * 4 + m]; const float g = gt[ai * 4 + m];
                unsigned char* dst = EO + ((size_t)(l & 3) * MROWS + (l >> 2)) * DM + c0;
                u32x2 w[2];
#pragma unroll
                for (int bj = 0; bj < 2; ++bj) { const f32x4 v0 = acc[ai][bj][m][0] * g + bb[bj][0] * (g * WSCALE), v1 = acc[ai][bj][m][1] * g + bb[bj][1] * (g * WSCALE);
                    w[bj].x = pk4_fp8(v0[0] * EOSCALE, v0[1] * EOSCALE, v0[2] * EOSCALE, v0[3] * EOSCALE); w[bj].y = pk4_fp8(v1[0] * EOSCALE, v1[1] * EOSCALE, v1[2] * EOSCALE, v1[3] * EOSCALE); }
                if (l >= 0) { *(u32x2*)dst = w[0]; *(u32x2*)(dst + 128) = w[1]; } }
    }
};
__device__ __forceinline__ const LAS unsigned char* moe_tiles(Frame& F, int& nT) {
    FT_DECL;
    LAS unsigned char* TE = (LAS unsigned char*)(F.lds + RING_BYTES); const int* meta = WSP(int, WS_ROUTE + RT_META);
    __syncthreads();
    nT = meta[64]; if (nT > MAXTILE) nT = MAXTILE;
    for (int i = f_tid; i < MAXTILE; i += 512) TE[i] = (unsigned char)((i < nT) ? meta[128 + i] : 0);
    __syncthreads();
    return (const LAS unsigned char*)TE;
}

__device__ __forceinline__ void p10_combine(Frame& F) {
    FT_DECL;
    const float* mod = WSP(float, WS_SMALL + SM_MOD); const unsigned char* EO = WSP(unsigned char, WS_EO);
    const size_t gt = (size_t)F.vcu * 512 + f_tid, NTH = (size_t)F.G * 512;
    float pd = 0.f, pa = 0.f;
    if (MK_PROBE_A != -2) { const unsigned long long* st = (const unsigned long long*)(F.ws + WS_CTL + 8192);
        pd = (MK_PROBE_A < 0) ? 0.1f : (float)(st[MK_PA1] - st[MK_PA0]) * MK_PSA; pa = (float)(st[MK_PB1] - st[MK_PB0]) * MK_PSB; }
    constexpr int U = 4;
    for (size_t i0 = gt; i0 < (size_t)MROWS * 128; i0 += NTH * U) {
        u32x2 ev[U][4]; f32x4 xv[U][2], gv[U][2];
#pragma unroll
        for (int u = 0; u < U; ++u) { const size_t i = i0 + (size_t)u * NTH; const size_t row = i >> 7; const int c0 = (int)(i & 127) * 8;
            const float* g2 = mod + (size_t)(row >> 12) * (NMOD * DM) + 5 * DM + c0; const bf16_t* op = WSP(bf16_t, WS_XN) + row * DM + c0;
#pragma unroll
            for (int k = 0; k < 4; ++k) ev[u][k] = __builtin_nontemporal_load((const u32x2*)(EO + ((size_t)k * MROWS + row) * DM + c0));
            { const u32x4 xb = *(const u32x4*)op; xv[u][0] = (f32x4){__uint_as_float(xb.x << 16), __uint_as_float(xb.x & 0xffff0000u), __uint_as_float(xb.y << 16), __uint_as_float(xb.y & 0xffff0000u)};
              xv[u][1] = (f32x4){__uint_as_float(xb.z << 16), __uint_as_float(xb.z & 0xffff0000u), __uint_as_float(xb.w << 16), __uint_as_float(xb.w & 0xffff0000u)}; }
            gv[u][0] = *(const f32x4*)g2; gv[u][1] = *(const f32x4*)(g2 + 4); }
#pragma unroll
        for (int u = 0; u < U; ++u) { const size_t i = i0 + (size_t)u * NTH; const size_t row = i >> 7; const int c0 = (int)(i & 127) * 8;
            float s[8];
#pragma unroll
            for (int e = 0; e < 8; ++e) s[e] = 0.f;
#pragma unroll
            for (int k = 0; k < 4; ++k) { const u32x2 v = ev[u][k];
                const f32x2 a = __builtin_amdgcn_cvt_pk_f32_fp8((int)v.x, false), b = __builtin_amdgcn_cvt_pk_f32_fp8((int)v.x, true), c = __builtin_amdgcn_cvt_pk_f32_fp8((int)v.y, false), d = __builtin_amdgcn_cvt_pk_f32_fp8((int)v.y, true);
                s[0] += a.x; s[1] += a.y; s[2] += b.x; s[3] += b.y; s[4] += c.x; s[5] += c.y; s[6] += d.x; s[7] += d.y; }
#pragma unroll
            for (int e = 0; e < 8; ++e) s[e] *= (1.f / EOSCALE);
            f32x4 o0 = xv[u][0] + gv[u][0] * (f32x4){s[0], s[1], s[2], s[3]}, o1 = xv[u][1] + gv[u][1] * (f32x4){s[4], s[5], s[6], s[7]};
            if (MK_PROBE_A != -2) { o0 += pd; o1 += pd; if (i == 0) o0[0] += pa; }
            float* op = F.out + row * DM + c0;
            __builtin_nontemporal_store(o0, (f32x4*)op); __builtin_nontemporal_store(o1, (f32x4*)(op + 4)); }
    }
}

struct Args { const float* in[34]; float* out; unsigned char* ws; int ph_lo, ph_hi; };
constexpr int N_PHASES = 11;

__global__ void __launch_bounds__(512, 2) mega(Args args) {
    extern __shared__ __attribute__((aligned(16))) unsigned char lds[];
    Frame F;
    F.lds = (LAS unsigned char*)lds;
    F.MISC = (volatile LAS unsigned*)(F.lds + LDSCTL_OFF);
    F.wave = __builtin_amdgcn_readfirstlane(threadIdx.x >> 6);
    FT_DECL;
    F.G = gridDim.x; { const int bx = blockIdx.x; F.vcu = (F.G % 8 == 0) ? (bx % 8) * (F.G / 8) + bx / 8 : bx; }
    F.in = (kin_t)__builtin_amdgcn_kernarg_segment_ptr();
    F.out = args.out; F.ws = args.ws;
    F.ctl = (gu32*)(args.ws + WS_CTL);
    for (int u = f_tid; u < (LDS_BYTES - LDSCTL_OFF) / 4; u += NWAVES * 64) ((LAS unsigned*)(F.lds + LDSCTL_OFF))[u] = 0u;
    __syncthreads();
    const int lo = args.ph_lo, hi = args.ph_hi;
    XcdBarrier bar; bar.bar = (unsigned*)(F.ctl + CW_BAR); bar.x = 0; bar.st = nullptr;
    if (hi - lo > 1) bar = xcd_barrier_post((unsigned*)(F.ctl + CW_BAR), F.MISC + 8, f_tid == 0);
#define IN(k) (lo <= (k) && (k) < hi)
    unsigned long long* stamps = (unsigned long long*)(args.ws + WS_CTL + 8192);
#define STAMP(k) do { if (MK_PROBE_A != -2 && blockIdx.x == 0 && f_tid == 0) stamps[(k)] = __builtin_amdgcn_s_memrealtime(); } while (0)
    STAMP(0);
#define SEAM(k) do { if (IN(k) && IN((k) + 1)) xcd_barrier(bar, F.wave == 0 && lane_id() == 0); } while (0)

    if (IN(0)) { p0_prologue(F); } SEAM(0); STAMP(1);
    if (IN(1)) { p1_norm1(F); } SEAM(1); STAMP(2);
    if (IN(2)) {
        SchedInProj S{F.G, (int)blockIdx.x, (const char*)WSP(bf16_t, WS_H), (const char*)WSP(bf16_t, WS_WIN)};
        EpiInProj E{WSP(bf16_t, WS_Q), WSP(bf16_t, WS_K), WSP(bf16_t, WS_V), WSP(bf16_t, WS_UT), F.in[9], F.in[10], WSP(float, WS_SMALL + SM_ROPE)};
        g8::gemm_phase<false>(F.lds, DM, S, E, F.wave, lane_id());
    } SEAM(2); STAMP(3);
    if (IN(3)) { p3_attention(F); STAMP(12); p3_hyena(F); } SEAM(3); STAMP(4);
    if (IN(4)) { p4_hynorm(F); } SEAM(4); STAMP(5);
    if (IN(5)) {
        SchedStatic S{F.G, (int)blockIdx.x, MROWS / 256, DM / 256, (const char*)WSP(bf16_t, WS_MIX), (const char*)WSP(bf16_t, WS_WOUT)};
        EpiOutProj E{F.in[0], WSP(bf16_t, WS_XN), WSP(float, WS_SMALL + SM_MOD)};
        g8::gemm_phase<false>(F.lds, DM, S, E, F.wave, lane_id());
    } SEAM(5); STAMP(6);
    if (IN(6)) { p6_router(F); } SEAM(6); STAMP(7);
    if (IN(7)) { p7_scatter(F); } SEAM(7); STAMP(8);
    if (IN(8)) {
        int nT; const LAS unsigned char* TE = moe_tiles(F, nT);
        SchedMoE<8> S{F.G, (int)blockIdx.x, nT, (const char*)WSP(char, WS_XS), (const char*)WSP(char, WS_W1), (size_t)2 * DM * DM, TE};
        EpiSwiGLU E{WSP(unsigned char, WS_ACT), F.in[31]};
        g8::gemm_phase<true>(F.lds, DM, S, E, F.wave, lane_id());
    } SEAM(8); STAMP(9);
    if (IN(9)) {
        int nT; const LAS unsigned char* TE = moe_tiles(F, nT);
        SchedMoE<4> S{F.G, (int)blockIdx.x, nT, (const char*)WSP(char, WS_ACT), (const char*)WSP(char, WS_W2), (size_t)DM * DM, TE};
        LAS int* LL = (LAS int*)(F.lds + RING_BYTES + 1024);
        static_assert(RING_BYTES + 1024 + 9 * 2048 <= LDSCTL_OFF, "LDS map");
        { const int* list = WSP(int, WS_ROUTE + RT_LIST); const float* gslot = WSP(float, WS_ROUTE + RT_GSLOT);
            const int t9 = F.wave * 64 + lane_id();
            g8::Unit u; for (int i = 0; i < 9 && S.next(i, u); ++i) { const int t = t9 & 255; const size_t slot = (size_t)u.pm * 256 + t;
                LL[i * 512 + (t9 >> 8) * 256 + t] = (t9 < 256) ? list[slot] : __float_as_int(gslot[slot]); }
            __syncthreads(); }
        EpiDown E{WSP(unsigned char, WS_EO), F.in[33], LL, F.G, (int)blockIdx.x};
        g8::gemm_phase<true>(F.lds, DM, S, E, F.wave, lane_id());
    } SEAM(9); STAMP(10);
    if (IN(10)) { p10_combine(F); }
#undef IN
#undef SEAM
}

extern "C" void kernel_launch(void* const* d_in, const int* in_sizes, int n_in, void* d_out, int out_size, void* d_ws, size_t ws_size, hipStream_t stream) {
    static int grid = 0;
    if (grid == 0) {
        if (n_in != 34 || out_size != MROWS * DM || ws_size < WS_END) { fprintf(stderr, "kernel_launch: unexpected shapes: n_in %d out %d ws %zu (need %zu)\n", n_in, out_size, ws_size, (size_t)WS_END); grid = -1; return; }
        int dev = 0, cus = 0, per_cu = 0;
        if (hipGetDevice(&dev) != hipSuccess || hipDeviceGetAttribute(&cus, hipDeviceAttributeMultiprocessorCount, dev) != hipSuccess) { grid = -1; return; }
        if (hipFuncSetAttribute((const void*)mega, hipFuncAttributeMaxDynamicSharedMemorySize, LDS_BYTES) != hipSuccess) { fprintf(stderr, "kernel_launch: hipFuncSetAttribute failed\n"); grid = -1; return; }
        if (hipOccupancyMaxActiveBlocksPerMultiprocessor(&per_cu, (const void*)mega, NWAVES * 64, LDS_BYTES) != hipSuccess || per_cu < 1) { fprintf(stderr, "kernel_launch: occupancy query says %d\n", per_cu); per_cu = 1; }
        (void)hipGetLastError();
        grid = cus;
    }
    if (grid < 0) return;
    (void)hipMemsetAsync((char*)d_ws + WS_CTL, 0, CTL_ZERO_BYTES, stream);
    Args a{};
    for (int i = 0; i < 34; ++i) a.in[i] = (const float*)d_in[i];
    a.out = (float*)d_out; a.ws = (unsigned char*)d_ws;
    constexpr int LAST = MK_LAST_PHASE + 1;
    if (MK_N_LAUNCHES == 1) { a.ph_lo = 0; a.ph_hi = LAST; hipLaunchKernelGGL(mega, dim3(grid), dim3(NWAVES * 64), LDS_BYTES, stream, a); }
    else for (int p = 0; p < LAST; ++p) { a.ph_lo = p; a.ph_hi = p + 1; hipLaunchKernelGGL(mega, dim3(grid), dim3(NWAVES * 64), LDS_BYTES, stream, a); }
    const hipError_t le = hipPeekAtLastError();
    if (le != hipSuccess) fprintf(stderr, "kernel_launch: launch failed: %s\n", hipGetErrorName(le));
}
```

```cpp
#include <hip/hip_runtime.h>
#include <hip/hip_bf16.h>
#include <cstdio>
#include <cstdint>

#ifndef MK_N_LAUNCHES
#define MK_N_LAUNCHES 1
#endif
#ifndef MK_PROBE_A
#define MK_PROBE_A -2
#endif
#ifndef MK_PA0
#define MK_PA0 0
#define MK_PA1 1
#define MK_PB0 0
#define MK_PB1 1
#define MK_PSA 2e-6f
#define MK_PSB 1e-4f
#endif
#ifndef MK_LAST_PHASE
#define MK_LAST_PHASE 10
#endif

#define GAS __attribute__((address_space(1)))
#define LAS __attribute__((address_space(3)))
typedef unsigned short bf16_t;
typedef short bf16x8 __attribute__((ext_vector_type(8)));
typedef short s16x4 __attribute__((ext_vector_type(4)));
typedef float f32x2 __attribute__((ext_vector_type(2)));
typedef float f32x4 __attribute__((ext_vector_type(4)));
typedef float f32x16 __attribute__((ext_vector_type(16)));
typedef unsigned u32x2 __attribute__((ext_vector_type(2)));
typedef unsigned u32x4 __attribute__((ext_vector_type(4)));
typedef GAS unsigned gu32;

constexpr int NB = 8, SEQ = 4096, DM = 1024, MROWS = NB * SEQ, CTXL = 256, MCTX = NB * CTXL, MTOT = MROWS + MCTX;
constexpr int KVL = CTXL + SEQ;
constexpr int NHEAD = 4, QKW = 512;
constexpr int HYW = 512, HYC = 1536, INC = 3072, QKVC = 1536;
constexpr int NEXP = 32, TOPK = 4, NMOD = 6;
constexpr float EPS = 1e-6f;
constexpr float LAM_INIT = 0.2f;
constexpr float QSCALE = 0.125f * 1.4426950408889634f;

constexpr size_t MiB = 1u << 20;
constexpr size_t WS_CTL = 0, CTL_ZERO_BYTES = 1 * MiB;
constexpr size_t WS_SMALL = 1 * MiB;
constexpr size_t WS_WIN = 2 * MiB;
constexpr size_t WS_WOUT = 8 * MiB;
constexpr size_t WS_W1 = 10 * MiB;
constexpr size_t WS_W2 = 138 * MiB;
constexpr size_t WS_H = 202 * MiB;
constexpr size_t WS_Q = 270 * MiB;
constexpr size_t WS_K = 302 * MiB;
constexpr size_t WS_V = 336 * MiB;
constexpr size_t WS_UT = 370 * MiB;
constexpr size_t WS_FILT = 466 * MiB;
constexpr size_t WS_Z2T = 498 * MiB;
constexpr size_t WS_MIX = 530 * MiB;
constexpr size_t WS_ROUTE = 594 * MiB;
constexpr size_t WS_ACT = 270 * MiB;
constexpr size_t WS_EO = 598 * MiB;
constexpr size_t WS_XN = 870 * MiB;
constexpr size_t WS_END = 998 * MiB;
constexpr size_t SM_MOD = 0;
constexpr size_t SM_SCAL = 256 * 1024;
constexpr size_t SM_ROPE = 260 * 1024;
constexpr int CW_BAR = 4096;

constexpr int RING_BYTES = 131072;
constexpr int LDSCTL_OFF = 151552;
constexpr int LDS_BYTES = 152576;
constexpr int NWAVES = 8;

#define LDS_WAIT() asm volatile("s_waitcnt lgkmcnt(0)" ::: "memory")
#define VM_WAIT() asm volatile("s_waitcnt vmcnt(0)" ::: "memory")
#define RLX_AGENT __ATOMIC_RELAXED, __HIP_MEMORY_SCOPE_AGENT

__device__ __forceinline__ unsigned cvt_pk_bf16(float lo, float hi) { unsigned r; asm volatile("v_cvt_pk_bf16_f32 %0, %1, %2" : "=v"(r) : "v"(lo), "v"(hi)); return r; }
__device__ __forceinline__ float bf2f(bf16_t v) { return __uint_as_float(((unsigned)v) << 16); }
__device__ __forceinline__ float wave_sum(float v) {
#pragma unroll
    for (int o = 1; o < 64; o <<= 1) v += __shfl_xor(v, o);
    return v;
}

#define XB_TMO      128
#define XB_XCNT(j)  (256  + 64 * (j))
#define XB_XSUB(j)  (1280 + 64 * (j))
#define XB_XGEN(j)  (2304 + 64 * (j))
#define XB_TOP      3328
#define XB_TOPGEN   3392
#define XCD_BAR_WORDS 3456
#define XB_SPIN_CAP (1u << 22)
__device__ __forceinline__ unsigned xb_ld(unsigned* p)              { return __hip_atomic_load(p, __ATOMIC_RELAXED, __HIP_MEMORY_SCOPE_AGENT); }
__device__ __forceinline__ unsigned xb_add(unsigned* p, unsigned v) { return __hip_atomic_fetch_add(p, v, __ATOMIC_RELAXED, __HIP_MEMORY_SCOPE_AGENT); }
__device__ __forceinline__ unsigned xb_xcc_id() { return (unsigned)__builtin_amdgcn_s_getreg((3 << 11) | 20) & 0xFu; }
#define XB_SPIN(cond, bar) do { unsigned _sp = 0; while (cond) { __builtin_amdgcn_s_sleep(1); \
    if ((++_sp & 255u) == 0u) { if (xb_ld(&(bar)[XB_TMO])) break; if (_sp > XB_SPIN_CAP) { atomicAdd(&(bar)[XB_TMO], 1u); break; } } } } while (0)
struct XcdBarrier { unsigned* bar; unsigned x; volatile LAS unsigned* st; };
__device__ __forceinline__ XcdBarrier xcd_barrier_post(unsigned* bar, volatile LAS unsigned* st, bool leader) {
    XcdBarrier b; b.bar = bar; b.x = xb_xcc_id(); b.st = st;
    if (leader) (void)xb_add(&bar[XB_XCNT(b.x)], 1u);
    return b;
}
__device__ __forceinline__ void xcd_barrier_complete(unsigned* bar, unsigned x, unsigned& nloc, unsigned& nx) {
    const unsigned G = gridDim.x * gridDim.y * gridDim.z;
    unsigned sum, cnt, mine, sp = 0u;
    for (;;) {
        sum = 0u; cnt = 0u; mine = 0u;
#pragma unroll
        for (unsigned j = 0; j < 16; ++j) { const unsigned c = xb_ld(&bar[XB_XCNT(j)]); sum += c; cnt += (c > 0u) ? 1u : 0u; mine = (j == x) ? c : mine; }
        if (sum == G) break;
        __builtin_amdgcn_s_sleep(1);
        if ((++sp & 255u) == 0u) { if (xb_ld(&bar[XB_TMO])) break; if (sp > XB_SPIN_CAP) { atomicAdd(&bar[XB_TMO], 1u); break; } }
    }
    nloc = mine > 0u ? mine : 1u; nx = cnt > 0u ? cnt : 1u;
}
__device__ __forceinline__ void xcd_barrier(const XcdBarrier& b, bool leader) {
    asm volatile("s_waitcnt vmcnt(0)" ::: "memory");
    __syncthreads();
    if (leader) {
        unsigned* bar = b.bar;
        __builtin_amdgcn_s_waitcnt(0);
        unsigned nloc = b.st[0], nx = b.st[1];
        if (nloc == 0u) { xcd_barrier_complete(bar, b.x, nloc, nx); b.st[0] = nloc; b.st[1] = nx; }
        const unsigned old = xb_add(&bar[XB_XSUB(b.x)], 1u);
        const unsigned gen = old / nloc;
        if (old + 1u == (gen + 1u) * nloc) {
            __builtin_amdgcn_fence(__ATOMIC_RELEASE, "agent");
            asm volatile("s_waitcnt vmcnt(0)" ::: "memory");
            const unsigned og = xb_add(&bar[XB_TOP], 1u);
            const unsigned tg = og / nx;
            if (og + 1u == (tg + 1u) * nx) xb_add(&bar[XB_TOPGEN], 1u);
            else XB_SPIN(xb_ld(&bar[XB_TOPGEN]) == tg, bar);
            __builtin_amdgcn_fence(__ATOMIC_ACQUIRE, "agent");
            xb_add(&bar[XB_XGEN(b.x)], 1u);
            asm volatile("s_waitcnt vmcnt(0)" ::: "memory");
        } else {
            XB_SPIN(xb_ld(&bar[XB_XGEN(b.x)]) == gen, bar);
            __builtin_amdgcn_fence(__ATOMIC_ACQUIRE, "agent");
            asm volatile("s_waitcnt vmcnt(0)" ::: "memory");
        }
    }
    __syncthreads();
}

namespace g8 {
constexpr int BM = 256, BK = 64, HALF = 128, HTB = HALF * BK * 2, STAGE_BYTES = 8 * HTB, NXCD = 8, WGM = 8;
__host__ __device__ __forceinline__ int lds_byte(int r, int c) { const int st = (r >> 4) * 2 + (c >> 5), rr = r & 15, cc = c & 31, ob = rr * 64 + cc * 2; return st * 1024 + (ob ^ (((ob >> 9) & 1) << 5)); }
__host__ __device__ __forceinline__ void stage_rc(int b, int& R, int& C) { const int st = b / 1024, sb = b % 1024, swz = sb ^ (((sb >> 9) & 1) << 5); R = (st >> 1) * 16 + swz / 64; C = (st & 1) * 32 + (swz % 64) / 2; }
__host__ __device__ __forceinline__ int perm32(int rho) { const int n = rho >> 4, i = rho & 15; return 8 * (i >> 2) + 4 * n + (i & 3); }

struct Unit { const char* a; const char* b; int pm, pn, kind, ex; };

__device__ __forceinline__ void tile_of(int L, int nM, int nN, int& pm, int& pn) {
    const int nwg = nM * nN; int wgid = L;
    { const int q = nwg / NXCD, r = nwg % NXCD, xcd = wgid % NXCD, off = wgid / NXCD; wgid = (xcd < r ? xcd * (q + 1) : r * (q + 1) + (xcd - r) * q) + off; }
    const int nig = WGM * nN, gid = wgid / nig, fm = gid * WGM, gsz = (nM - fm) < WGM ? (nM - fm) : WGM;
    pm = fm + ((wgid % nig) % gsz); pn = (wgid % nig) / gsz;
}

typedef int i32x8 __attribute__((ext_vector_type(8)));
template <bool FP8, class Epi, class Sched>
__device__ __forceinline__ void gemm_phase(LAS unsigned char* lds, const int K, const Sched& S, const Epi& E, const int wid, const int lane) {
    const int tid = wid * 64 + lane, wr = wid >> 2, wc = wid & 3, fr = lane & 15, fq = lane >> 4;
    const int nt = FP8 ? K / 128 : K / BK;
    const int RP = FP8 ? K : 2 * K;
    unsigned voffA[2], voffB[2];
#pragma unroll
    for (int i = 0; i < 2; ++i) { int R, C; stage_rc(tid * 16 + i * 8192, R, C); const int Rb = (R & ~31) + perm32(R & 31);
        voffA[i] = (unsigned)(R * RP + C * 2); voffB[i] = (unsigned)(Rb * RP + C * 2); }
    const size_t kstep = (size_t)(BK * 2);
    const size_t hstep = (size_t)HALF * RP;
    const unsigned ldsw = (unsigned)wid * 1024u;
    const int aoff = lds_byte(wr * 64 + fr, FP8 ? fq * 16 : fq * 8), boff = lds_byte(wc * 32 + fr, FP8 ? fq * 16 : fq * 8);
    constexpr int KOFF = FP8 ? 16 : 1024;
#define PG8_SA(b, h) (((b) * 2 + (h)) * HTB)
#define PG8_SB(b, h) ((4 + (b) * 2 + (h)) * HTB)
#define PG8_STAGE(bufoff, gbase, voff) do { _Pragma("unroll") for (int _i = 0; _i < 2; ++_i) \
        __builtin_amdgcn_global_load_lds((const unsigned*)((const char*)(gbase) + (voff)[_i]), (LAS unsigned*)(lds + (bufoff) + ldsw + _i * 8192), 16, 0, 0); } while (0)
#define PG8_LD32(p) __builtin_bit_cast(i32x8, __builtin_shufflevector(*(const LAS u32x4*)(p), *(const LAS u32x4*)((p) + 16), 0, 1, 2, 3, 4, 5, 6, 7))
#define PG8_LDA8(dst, b, h) do { _Pragma("unroll") for (int m = 0; m < 4; ++m) dst[m] = PG8_LD32(lds + PG8_SA(b, h) + aoff + m * 2048); } while (0)
#define PG8_LDB8(dst, b, h) do { _Pragma("unroll") for (int n = 0; n < 2; ++n) dst[n] = PG8_LD32(lds + PG8_SB(b, h) + boff + n * 2048); } while (0)
#define PG8_LDA(dst, b, h) do { _Pragma("unroll") for (int m = 0; m < 4; ++m) _Pragma("unroll") for (int k = 0; k < 2; ++k) dst[m][k] = *(const LAS bf16x8*)(lds + PG8_SA(b, h) + aoff + m * 2048 + k * KOFF); } while (0)
#define PG8_LDB(dst, b, h) do { _Pragma("unroll") for (int n = 0; n < 2; ++n) _Pragma("unroll") for (int k = 0; k < 2; ++k) dst[n][k] = *(const LAS bf16x8*)(lds + PG8_SB(b, h) + boff + n * 2048 + k * KOFF); } while (0)
#define PG8_MMA(ai, bj, At, Bt) do { __builtin_amdgcn_s_setprio(1); _Pragma("unroll") for (int m = 0; m < 4; ++m) _Pragma("unroll") for (int n = 0; n < 2; ++n) _Pragma("unroll") for (int k = 0; k < 2; ++k) \
        acc[ai][bj][m][n] = __builtin_amdgcn_mfma_f32_16x16x32_bf16(Bt[n][k], At[m][k], acc[ai][bj][m][n], 0, 0, 0); __builtin_amdgcn_s_setprio(0); } while (0)
#define PG8_MMA8(ai, bj, At, Bt) do { __builtin_amdgcn_s_setprio(1); _Pragma("unroll") for (int m = 0; m < 4; ++m) _Pragma("unroll") for (int n = 0; n < 2; ++n) \
        asm volatile("v_mfma_scale_f32_16x16x128_f8f6f4 %0, %1, %2, %0, %3, %3 op_sel_hi:[0,0,0]" : "+v"(acc[ai][bj][m][n]) : "v"(Bt[n]), "v"(At[m]), "v"(one_scale)); __builtin_amdgcn_s_setprio(0); } while (0)
#define PG8_WAIT_V(n) asm volatile("s_waitcnt vmcnt(" #n ")" ::: "memory")
#define PG8_WAIT_L(n) asm volatile("s_waitcnt lgkmcnt(" #n ")" ::: "memory")
#define PG8_BAR __builtin_amdgcn_s_barrier()
#define PG8_SCHED __builtin_amdgcn_sched_barrier(0)
    Unit cur, nxt; int ui = 0;
    if (!S.next(0, cur)) return;
    f32x4 acc[2][2][4][2];
#pragma unroll
    for (int a = 0; a < 2; ++a)
#pragma unroll
        for (int b = 0; b < 2; ++b)
#pragma unroll
            for (int m = 0; m < 4; ++m)
#pragma unroll
                for (int n = 0; n < 2; ++n) acc[a][b][m][n] = (f32x4){0.f, 0.f, 0.f, 0.f};
    bf16x8 At[4][2], B0[2][2], B1[2][2];
    i32x8 At8[4], B08[2], B18[2];
    const unsigned one_scale = 0x7f7f7f7fu;
    const char* cA = cur.a; const char* cB = cur.b;
    PG8_STAGE(PG8_SB(0, 0), cB, voffB); PG8_STAGE(PG8_SB(0, 1), cB + hstep, voffB); PG8_STAGE(PG8_SA(0, 0), cA, voffA); PG8_STAGE(PG8_SA(0, 1), cA + hstep, voffA);
    if (wr == 1) PG8_BAR;
    PG8_WAIT_V(2); PG8_BAR;
    PG8_STAGE(PG8_SB(1, 0), cB + kstep, voffB); PG8_STAGE(PG8_SA(1, 0), cA + kstep, voffA); PG8_STAGE(PG8_SB(1, 1), cB + hstep + kstep, voffB);
    PG8_WAIT_V(6); PG8_BAR;
    for (;;) {
        const bool has_next = S.next(ui + 1, nxt);
        const char* nA = has_next ? nxt.a : cA; const char* nB = has_next ? nxt.b : cB;
#pragma unroll 1
        for (int t = 0; t < nt; t += 2) {
            const bool last = (t == nt - 2);
            const char* a1 = cA + (size_t)(t + 1) * kstep;
            const char* a2 = last ? nA : cA + (size_t)(t + 2) * kstep; const char* b2 = last ? nB : cB + (size_t)(t + 2) * kstep;
            const char* a3 = a2 + kstep; const char* b3 = b2 + kstep;
            if constexpr (FP8) {
            PG8_LDB8(B08, 0, 0); PG8_LDB8(B18, 0, 1); PG8_SCHED; PG8_LDA8(At8, 0, 0); PG8_STAGE(PG8_SA(1, 1), a1 + hstep, voffA);
            PG8_WAIT_V(8); PG8_WAIT_L(0); PG8_BAR; PG8_MMA8(0, 0, At8, B08); PG8_MMA8(0, 1, At8, B18); PG8_BAR; PG8_SCHED;
            PG8_LDA8(At8, 0, 1); PG8_STAGE(PG8_SB(0, 0), b2, voffB); PG8_STAGE(PG8_SB(0, 1), b2 + hstep, voffB); PG8_STAGE(PG8_SA(0, 0), a2, voffA);
            PG8_WAIT_V(8); PG8_WAIT_L(0); PG8_BAR; PG8_MMA8(1, 0, At8, B08); PG8_MMA8(1, 1, At8, B18); PG8_BAR; PG8_SCHED;
            PG8_LDB8(B08, 1, 0); PG8_LDB8(B18, 1, 1); PG8_SCHED; PG8_LDA8(At8, 1, 0); PG8_STAGE(PG8_SA(0, 1), a2 + hstep, voffA);
            PG8_WAIT_V(8); PG8_WAIT_L(0); PG8_BAR; PG8_MMA8(0, 0, At8, B08); PG8_MMA8(0, 1, At8, B18); PG8_BAR; PG8_SCHED;
            PG8_LDA8(At8, 1, 1); PG8_STAGE(PG8_SB(1, 0), b3, voffB); PG8_STAGE(PG8_SB(1, 1), b3 + hstep, voffB); PG8_STAGE(PG8_SA(1, 0), a3, voffA);
            PG8_WAIT_V(8); PG8_WAIT_L(0); PG8_BAR; PG8_MMA8(1, 0, At8, B08); PG8_MMA8(1, 1, At8, B18); PG8_BAR; PG8_SCHED;
            } else {
            PG8_LDB(B0, 0, 0); PG8_LDB(B1, 0, 1); PG8_SCHED; PG8_LDA(At, 0, 0); PG8_STAGE(PG8_SA(1, 1), a1 + hstep, voffA);
            PG8_WAIT_V(8); PG8_WAIT_L(0); PG8_BAR; PG8_MMA(0, 0, At, B0); PG8_MMA(0, 1, At, B1); PG8_BAR; PG8_SCHED;
            PG8_LDA(At, 0, 1); PG8_STAGE(PG8_SB(0, 0), b2, voffB); PG8_STAGE(PG8_SB(0, 1), b2 + hstep, voffB); PG8_STAGE(PG8_SA(0, 0), a2, voffA);
            PG8_WAIT_V(8); PG8_WAIT_L(0); PG8_BAR; PG8_MMA(1, 0, At, B0); PG8_MMA(1, 1, At, B1); PG8_BAR; PG8_SCHED;
            PG8_LDB(B0, 1, 0); PG8_LDB(B1, 1, 1); PG8_SCHED; PG8_LDA(At, 1, 0); PG8_STAGE(PG8_SA(0, 1), a2 + hstep, voffA);
            PG8_WAIT_V(8); PG8_WAIT_L(0); PG8_BAR; PG8_MMA(0, 0, At, B0); PG8_MMA(0, 1, At, B1); PG8_BAR; PG8_SCHED;
            PG8_LDA(At, 1, 1); PG8_STAGE(PG8_SB(1, 0), b3, voffB); PG8_STAGE(PG8_SB(1, 1), b3 + hstep, voffB); PG8_STAGE(PG8_SA(1, 0), a3, voffA);
            PG8_WAIT_V(8); PG8_WAIT_L(0); PG8_BAR; PG8_MMA(1, 0, At, B0); PG8_MMA(1, 1, At, B1); PG8_BAR; PG8_SCHED;
            }
        }
        if (wr == 0) PG8_BAR;
        if constexpr (FP8) asm volatile("s_nop 15\n\ts_nop 15" ::: "memory");
        E(acc, cur, wr, wc, fr, fq);
        if (!has_next) break;
#pragma unroll
        for (int a = 0; a < 2; ++a)
#pragma unroll
            for (int b = 0; b < 2; ++b)
#pragma unroll
                for (int m = 0; m < 4; ++m)
#pragma unroll
                    for (int n = 0; n < 2; ++n) acc[a][b][m][n] = (f32x4){0.f, 0.f, 0.f, 0.f};
        cur = nxt; cA = nA; cB = nB; ++ui;
        if (wr == 1) PG8_BAR;
    }
    PG8_WAIT_V(0);
    PG8_BAR;
#undef PG8_SA
#undef PG8_SB
#undef PG8_STAGE
#undef PG8_LDA
#undef PG8_LDB
#undef PG8_MMA
#undef PG8_MMA8
#undef PG8_LDA8
#undef PG8_LDB8
#undef PG8_LD32
#undef PG8_WAIT_V
#undef PG8_WAIT_L
#undef PG8_BAR
#undef PG8_SCHED
}
}

__device__ __forceinline__ int lane_id() { int l; asm volatile("v_mbcnt_lo_u32_b32 %0, -1, 0\n\tv_mbcnt_hi_u32_b32 %0, -1, %0" : "=v"(l)); return l; }
#define FT_DECL const int f_lane = lane_id(), f_tid = F.wave * 64 + f_lane; (void)f_tid; (void)f_lane
typedef const float* cfp_t;
typedef __attribute__((address_space(4))) cfp_t* kin_t;
struct Frame {
    LAS unsigned char* lds;
    volatile LAS unsigned* MISC;
    gu32* ctl;
    int wave, vcu, G;
    kin_t in;
    float* out;
    unsigned char* ws;
};
#define WSP(T, off) ((T*)(F.ws + (off)))

template <class RowMap>
__device__ __forceinline__ void p0_transpose_item(const float* W, int K, int N, bf16_t* WT, const RowMap& rowmap, const float* kscale, LAS float* scr, int item, int lane) {
    const int nblk = N / 32, kb = item / nblk, nb = item % nblk, k0 = 64 * kb, n0 = 32 * nb;
#pragma unroll 8
    for (int i = 0; i < 32; ++i) { const int kk = 2 * i + (lane >> 5); float v = W[(size_t)(k0 + kk) * N + n0 + (lane & 31)]; if (kscale) v *= kscale[k0 + kk]; scr[kk * 33 + (lane & 31)] = v; }
    LDS_WAIT(); asm volatile("" ::: "memory");
    const int c = lane & 7;
#pragma unroll
    for (int j = 0; j < 4; ++j) { const int n = (lane >> 3) + 8 * j; const LAS float* s = scr + (8 * c) * 33 + n;
        u32x4 o; o.x = cvt_pk_bf16(s[0 * 33], s[1 * 33]); o.y = cvt_pk_bf16(s[2 * 33], s[3 * 33]); o.z = cvt_pk_bf16(s[4 * 33], s[5 * 33]); o.w = cvt_pk_bf16(s[6 * 33], s[7 * 33]);
        *(GAS u32x4*)(WT + (size_t)rowmap(n0 + n) * K + k0 + 8 * c) = o; }
    LDS_WAIT(); asm volatile("" ::: "memory");
}

__device__ __forceinline__ unsigned pk4_fp8(float a, float b, float c, float d) { int r = __builtin_amdgcn_cvt_pk_fp8_f32(a, b, 0, false); r = __builtin_amdgcn_cvt_pk_fp8_f32(c, d, r, true); return (unsigned)r; }
constexpr float EOSCALE = 16.f;
constexpr float WSCALE = 32.f;
template <class RowMap>
__device__ __forceinline__ void p0_transpose_item_f8(const float* W, int K, int N, unsigned char* WT, const RowMap& rowmap, LAS float* scr, int item, int lane) {
    const int nblk = N / 32, kb = item / nblk, nb = item % nblk, k0 = 128 * kb, n0 = 32 * nb;
#pragma unroll
    for (int hh = 0; hh < 2; ++hh) { float v[32];
#pragma unroll
        for (int i = 0; i < 32; ++i) { const int kk = 2 * (32 * hh + i) + (lane >> 5); v[i] = __builtin_nontemporal_load(W + (size_t)(k0 + kk) * N + n0 + (lane & 31)); }
#pragma unroll
        for (int i = 0; i < 32; ++i) { const int kk = 2 * (32 * hh + i) + (lane >> 5); scr[kk * 33 + (lane & 31)] = v[i] * WSCALE; } }
    LDS_WAIT(); asm volatile("" ::: "memory");
    const int c = lane & 7;
#pragma unroll
    for (int j = 0; j < 4; ++j) { const int n = (lane >> 3) + 8 * j; const LAS float* sp = scr + (16 * c) * 33 + n;
        u32x4 o; o.x = pk4_fp8(sp[0 * 33], sp[1 * 33], sp[2 * 33], sp[3 * 33]); o.y = pk4_fp8(sp[4 * 33], sp[5 * 33], sp[6 * 33], sp[7 * 33]);
        o.z = pk4_fp8(sp[8 * 33], sp[9 * 33], sp[10 * 33], sp[11 * 33]); o.w = pk4_fp8(sp[12 * 33], sp[13 * 33], sp[14 * 33], sp[15 * 33]);
        *(GAS u32x4*)(WT + (size_t)rowmap(n0 + n) * K + k0 + 16 * c) = o; }
    LDS_WAIT(); asm volatile("" ::: "memory");
}
struct MapIdent { int off; __device__ __forceinline__ int operator()(int n) const { return off + n; } };
struct MapWin { __device__ __forceinline__ int operator()(int l) const {
    if (l >= QKVC) return l;
    const int t = l & ~255, r = l & 255, wc = r >> 6, blk = (r >> 5) & 1, bj = (r >> 4) & 1, low = r & 15;
    return t + 128 * bj + 32 * wc + 16 * blk + low; } };
struct MapW1 { int off; __device__ __forceinline__ int operator()(int jp) const { const int bj = jp >> 10, j = jp & 1023; return off + 256 * (j >> 7) + 128 * bj + (j & 127); } };


__device__ __forceinline__ void p0_filter_item(Frame& F, int item) {
    FT_DECL;
#define in F.in
    LAS float* h1s = (LAS float*)(F.lds);
    LAS float* h2s = (LAS float*)(F.lds + 4096);
    const int t0 = item * 16;
    {
        const int tt = f_tid >> 5, hh = (f_tid & 31) * 2; const float pos = (float)(t0 + tt);
        float feats[17]; feats[0] = pos * (1.f / SEQ);
#pragma unroll
        for (int i = 0; i < 8; ++i) { const float band = 1e-4f + (float)i * ((7.f - 1e-4f) / 7.f); const float ang = (6.283185307179586f / SEQ) * pos * band; feats[1 + i] = sinf(ang); feats[9 + i] = cosf(ang); }
#pragma unroll
        for (int u = 0; u < 2; ++u) { const int h = hh + u; float a = in[19][h];
#pragma unroll
            for (int k = 0; k < 17; ++k) a += feats[k] * in[18][k * 64 + h];
            h1s[tt * 64 + h] = sinf(in[20][h] * a); }
        __syncthreads();
#pragma unroll
        for (int u = 0; u < 2; ++u) { const int h = hh + u; float a = in[22][h];
#pragma unroll 8
            for (int k = 0; k < 64; ++k) a += h1s[tt * 64 + k] * in[21][k * 64 + h];
            h2s[tt * 64 + h] = sinf(in[23][h] * a); }
        __syncthreads();
    }
    f32x4 acc[16];
#pragma unroll
    for (int t = 0; t < 16; ++t) acc[t] = (f32x4){0.f, 0.f, 0.f, 0.f};
    const int o = 4 * f_tid;
    for (int k = 0; k < 64; ++k) { const f32x4 w = *(const f32x4*)(in[24] + (size_t)k * 2048 + o);
#pragma unroll
        for (int t = 0; t < 16; ++t) acc[t] += w * h2s[t * 64 + k]; }
    const int c0 = o & 511, od = o >> 9;
    float* dst = WSP(float, WS_FILT) + ((size_t)od * 512 + c0) * SEQ + t0;
#pragma unroll
    for (int e = 0; e < 4; ++e) { const float la = -3.0701134573253944f, lb = -15.350567286626972f; const float delta = fabsf(la + (float)(c0 + e) * ((lb - la) / 511.f));
#pragma unroll
        for (int q = 0; q < 4; ++q) { f32x4 v;
#pragma unroll
            for (int i = 0; i < 4; ++i) { const int t = 4 * q + i; const float tn = (float)(t0 + t) * (1.f / SEQ); v[i] = acc[t][e] * expf(-tn * delta); }
            *(f32x4*)(dst + (size_t)e * SEQ + 4 * q) = v; } }
    __syncthreads();
#undef in
}

__device__ __forceinline__ float silu_f(float v) { return v / (1.f + __expf(-v)); }

__device__ __forceinline__ void p0_prologue(Frame& F) {
    FT_DECL;
#define in F.in
    const int wg = blockIdx.x;
    if (wg < 96) {
        LAS float* sv = (LAS float*)F.lds;
        for (int i = f_tid; i < 9 * 1024; i += 512) { const int r = i >> 10, k = i & 1023; const float c = (r < 8) ? in[1][r * 1024 + k] : in[3][k]; sv[i] = silu_f(c); }
        __syncthreads();
        const int j = wg * 64 + f_lane; const float* wm = in[4];
        float acc[9];
#pragma unroll
        for (int r = 0; r < 9; ++r) acc[r] = 0.f;
        const int kbeg = F.wave * 128;
#pragma unroll 4
        for (int k = kbeg; k < kbeg + 128; ++k) { const float w = wm[(size_t)k * (NMOD * DM) + j];
#pragma unroll
            for (int r = 0; r < 9; ++r) acc[r] += sv[r * 1024 + k] * w; }
        LAS float* red = (LAS float*)(F.lds + 40960);
#pragma unroll
        for (int r = 0; r < 9; ++r) red[(F.wave * 9 + r) * 64 + f_lane] = acc[r];
        __syncthreads();
        for (int i = f_tid; i < 9 * 64; i += 512) { const int r = i >> 6, l = i & 63; float s = in[5][wg * 64 + l];
#pragma unroll
            for (int w = 0; w < 8; ++w) s += red[(w * 9 + r) * 64 + l];
            WSP(float, WS_SMALL + SM_MOD)[r * (NMOD * DM) + wg * 64 + l] = s; }
        __syncthreads();
    } else if (wg == 96) {
        if (F.wave == 0) {
            const float a = wave_sum(in[11][f_lane] * in[12][f_lane]), b = wave_sum(in[13][f_lane] * in[14][f_lane]);
            float gq = fabsf(in[9][f_lane]), gk = fabsf(in[10][f_lane]);
#pragma unroll
            for (int o = 1; o < 64; o <<= 1) { gq = fmaxf(gq, __shfl_xor(gq, o)); gk = fmaxf(gk, __shfl_xor(gk, o)); }
            if (f_lane == 0) { float* sc = WSP(float, WS_SMALL + SM_SCAL); sc[0] = expf(a) - expf(b) + LAM_INIT;
                sc[1] = (8.f * gq * gk * 1.02f + 0.05f) * 1.4426950408889634f; }
        }
        for (int i = f_tid; i < 64 * 16; i += 512) { const int pos = i >> 4, f = i & 15;
            const float inv = powf(10000.f, -(float)f / 16.f); const float ang = (float)pos * inv;
            float* rt = WSP(float, WS_SMALL + SM_ROPE); rt[2 * i] = cosf(ang); rt[2 * i + 1] = sinf(ang); }
    }
    __syncthreads();
    for (int it = wg; it < SEQ / 16; it += F.G) p0_filter_item(F, it);
    __syncthreads();
    {
        LAS float* scr = (LAS float*)(F.lds + F.wave * 16896);
        const int gw = F.vcu * NWAVES + F.wave, NGW = F.G * NWAVES;
        constexpr int I_IN = (DM / 64) * (INC / 32), I_OUT = (DM / 64) * (DM / 32), I_1 = (DM / 128) * (2 * DM / 32), I_2 = (DM / 128) * (DM / 32);
        constexpr int NITEMS = I_IN + I_OUT + NEXP * (I_1 + I_2);
        for (int it = gw; it < NITEMS; it += NGW) {
            int r = it;
            if (r < I_IN) { p0_transpose_item(in[8], DM, INC, WSP(bf16_t, WS_WIN), MapWin{}, nullptr, scr, r, f_lane); continue; } r -= I_IN;
            if (r < I_OUT) { p0_transpose_item(in[27], DM, DM, WSP(bf16_t, WS_WOUT), MapIdent{0}, nullptr, scr, r, f_lane); continue; } r -= I_OUT;
            const int e = r / (I_1 + I_2); r -= e * (I_1 + I_2);
            if (r < I_1) p0_transpose_item_f8(in[30] + (size_t)e * DM * 2 * DM, DM, 2 * DM, WSP(unsigned char, WS_W1) + (size_t)e * 2 * DM * DM, MapW1{0}, scr, r, f_lane);
            else p0_transpose_item_f8(in[32] + (size_t)e * DM * DM, DM, DM, WSP(unsigned char, WS_W2) + (size_t)e * DM * DM, MapIdent{0}, scr, r - I_1, f_lane);
        }
    }
}
#undef in

__device__ __forceinline__ void p1_norm1(Frame& F) {
    FT_DECL;
    const int gw = F.vcu * NWAVES + F.wave, NGW = F.G * NWAVES;
    const float* mod = WSP(float, WS_SMALL + SM_MOD); const float* g1 = F.in[6];
    bf16_t* H = WSP(bf16_t, WS_H);
    constexpr int RU = 4;
    for (int m0 = gw; m0 < MTOT; m0 += NGW * RU) {
        f32x4 v[RU][4];
#pragma unroll
        for (int u = 0; u < RU; ++u) { const int m = m0 + u * NGW; if (m < MTOT) {
            const float* xrow = (m < MROWS) ? F.in[0] + (size_t)m * DM : F.in[2] + (size_t)(m - MROWS) * DM; const GAS f32x4* xr = (const GAS f32x4*)xrow + f_lane;
#pragma unroll
            for (int j = 0; j < 4; ++j) v[u][j] = __builtin_nontemporal_load(xr + 64 * j); } }
#pragma unroll
        for (int u = 0; u < RU; ++u) { const int m = m0 + u * NGW; if (m < MTOT) {
            const int mb = (m < MROWS) ? (m >> 12) : 8;
            const float* sh = mod + (size_t)mb * (NMOD * DM); const float* sc = sh + DM;
            float s = 0.f;
#pragma unroll
            for (int j = 0; j < 4; ++j) s += (v[u][j].x * v[u][j].x + v[u][j].y * v[u][j].y) + (v[u][j].z * v[u][j].z + v[u][j].w * v[u][j].w);
            const float rstd = rsqrtf(wave_sum(s) * (1.f / DM) + EPS);
            GAS u32x2* o8 = (GAS u32x2*)(H + (size_t)m * DM) + f_lane;
#pragma unroll
            for (int j = 0; j < 4; ++j) { const int c = 4 * f_lane + 256 * j;
                const f32x4 g = *(const f32x4*)(g1 + c), a = *(const f32x4*)(sc + c), b = *(const f32x4*)(sh + c);
                const f32x4 y = v[u][j] * rstd * g * (a + 1.f) + b;
                u32x2 w; w.x = cvt_pk_bf16(y.x, y.y); w.y = cvt_pk_bf16(y.z, y.w); o8[64 * j] = w; } } }
    }
}

struct SchedInProj {
    int G, c; const char* H; const char* W;
    static constexpr int NA = 136 * 6, NBU = 6 * 128;
    __device__ __forceinline__ bool next(int i, g8::Unit& u) const {
        const long L = (long)i * G + c;
        if (L < NA) { g8::tile_of((int)L, 136, 6, u.pm, u.pn); u.a = H + (size_t)u.pm * 256 * DM * 2; u.b = W + (size_t)u.pn * 256 * DM * 2; u.kind = 0; u.ex = 0; return true; }
        if (L < NA + NBU) { g8::tile_of((int)L - NA, 6, 128, u.pm, u.pn); u.a = W + (size_t)(QKVC + u.pm * 256) * DM * 2; u.b = H + (size_t)u.pn * 256 * DM * 2; u.kind = 1; u.ex = 0; return true; }
        return false;
    }
};
struct EpiInProj {
    bf16_t *Q, *Kb, *Vb, *UT; const float *gq, *gk, *rope;
    __device__ __forceinline__ void operator()(f32x4 (&acc)[2][2][4][2], const g8::Unit& u, int wr, int wc, int fr, int fq) const {
        if (u.kind == 1) {
            const int row0 = u.pm * 256 + wr * 64 + fr, col0 = u.pn * 256 + wc * 32 + 8 * fq;
#pragma unroll
            for (int ai = 0; ai < 2; ++ai)
#pragma unroll
                for (int m = 0; m < 4; ++m) { bf16_t* rowp = UT + (size_t)(row0 + ai * 128 + m * 16) * MROWS + col0;
#pragma unroll
                    for (int bj = 0; bj < 2; ++bj) { const f32x4 v0 = acc[ai][bj][m][0], v1 = acc[ai][bj][m][1];
                        u32x4 w; w.x = cvt_pk_bf16(v0[0], v0[1]); w.y = cvt_pk_bf16(v0[2], v0[3]); w.z = cvt_pk_bf16(v1[0], v1[1]); w.w = cvt_pk_bf16(v1[2], v1[3]);
                        *(u32x4*)(rowp + bj * 128) = w; } }
            return;
        }
        const int blk = fq >> 1, f = fq & 1;
        const int sec = u.pn >> 1;
        const bool ctx = (u.pm >= 128);
        if (sec == 0 && ctx) return;
        const int colbase = (u.pn & 1) * 256 + wc * 64 + 32 * blk + 8 * f;
        float gg[2][2][4];
        if (sec < 2) { const float* gp = (sec == 0 ? gq : gk) + 32 * blk + 8 * f;
#pragma unroll
            for (int bj = 0; bj < 2; ++bj)
#pragma unroll
                for (int n = 0; n < 2; ++n) { const f32x4 t = *(const f32x4*)(gp + 16 * bj + 4 * n); gg[bj][n][0] = t[0]; gg[bj][n][1] = t[1]; gg[bj][n][2] = t[2]; gg[bj][n][3] = t[3]; } }
#pragma unroll
        for (int ai = 0; ai < 2; ++ai)
#pragma unroll
            for (int m = 0; m < 4; ++m) {
                const int rloc = ai * 128 + wr * 64 + m * 16 + fr; const int r = u.pm * 256 + rloc;
                f32x4 v[2][2];
#pragma unroll
                for (int bj = 0; bj < 2; ++bj)
#pragma unroll
                    for (int n = 0; n < 2; ++n) v[bj][n] = acc[ai][bj][m][n];
                size_t orow;
                if (sec == 0) orow = (size_t)r;
                else if (!ctx) orow = (size_t)(r >> 12) * KVL + CTXL + (r & 4095);
                else { const int j = r - MROWS; orow = (size_t)(j >> 8) * KVL + (j & 255); }
                if (sec < 2) {
                    float ss = 0.f;
#pragma unroll
                    for (int bj = 0; bj < 2; ++bj)
#pragma unroll
                        for (int n = 0; n < 2; ++n) ss += (v[bj][n][0] * v[bj][n][0] + v[bj][n][1] * v[bj][n][1]) + (v[bj][n][2] * v[bj][n][2] + v[bj][n][3] * v[bj][n][3]);
                    ss += __shfl_xor(ss, 16); ss += __shfl_xor(ss, 32);
                    const float rstd = rsqrtf(ss * (1.f / 64.f) + EPS);
#pragma unroll
                    for (int bj = 0; bj < 2; ++bj)
#pragma unroll
                        for (int n = 0; n < 2; ++n)
#pragma unroll
                            for (int e = 0; e < 4; ++e) v[bj][n][e] *= rstd * gg[bj][n][e];
                    if (!ctx) {
                        const int t = r & 4095; const int pos = blk ? (t & 63) : (t >> 6);
                        const float* rp = rope + (size_t)(pos * 16 + 8 * f) * 2;
#pragma unroll
                        for (int n = 0; n < 2; ++n) { const f32x4 c0 = *(const f32x4*)(rp + 8 * n), c1 = *(const f32x4*)(rp + 8 * n + 4);
                            const float cs[4] = {c0[0], c0[2], c1[0], c1[2]}, sn[4] = {c0[1], c0[3], c1[1], c1[3]};
#pragma unroll
                            for (int e = 0; e < 4; ++e) { const float x1 = v[0][n][e], x2 = v[1][n][e]; v[0][n][e] = x1 * cs[e] - x2 * sn[e]; v[1][n][e] = x2 * cs[e] + x1 * sn[e]; } }
                    }
                    if (sec == 0) {
#pragma unroll
                        for (int bj = 0; bj < 2; ++bj)
#pragma unroll
                            for (int n = 0; n < 2; ++n) v[bj][n] *= QSCALE;
                    }
                }
                bf16_t* dst = (sec == 0 ? Q : (sec == 1 ? Kb : Vb)) + orow * QKW + colbase;
#pragma unroll
                for (int bj = 0; bj < 2; ++bj) { u32x4 w; w.x = cvt_pk_bf16(v[bj][0][0], v[bj][0][1]); w.y = cvt_pk_bf16(v[bj][0][2], v[bj][0][3]); w.z = cvt_pk_bf16(v[bj][1][0], v[bj][1][1]); w.w = cvt_pk_bf16(v[bj][1][2], v[bj][1][3]);
                    *(u32x4*)(dst + 16 * bj) = w; }
            }
    }
};

struct SchedStatic {
    int G, c, nM, nN; const char* A; const char* B;
    __device__ __forceinline__ bool next(int i, g8::Unit& u) const {
        const long L = (long)i * G + c; if (L >= (long)nM * nN) return false;
        g8::tile_of((int)L, nM, nN, u.pm, u.pn); u.a = A + (size_t)u.pm * 256 * DM * 2; u.b = B + (size_t)u.pn * 256 * DM * 2; u.kind = 0; u.ex = 0; return true;
    }
};
struct EpiOutProj {
    const float* x; bf16_t* out; const float* mod;
    __device__ __forceinline__ void operator()(f32x4 (&acc)[2][2][4][2], const g8::Unit& u, int wr, int wc, int fr, int fq) const {
        const int col0 = u.pn * 256 + wc * 32 + 8 * fq;
#pragma unroll
        for (int ai = 0; ai < 2; ++ai)
#pragma unroll
            for (int m = 0; m < 4; ++m) { const int r = u.pm * 256 + ai * 128 + wr * 64 + m * 16 + fr; const float* g1 = mod + (size_t)(r >> 12) * (NMOD * DM) + 2 * DM;
                const size_t off = (size_t)r * DM + col0;
#pragma unroll
                for (int bj = 0; bj < 2; ++bj) { f32x4 o[2];
#pragma unroll
                    for (int n = 0; n < 2; ++n) { const int c = bj * 128 + 4 * n; const f32x4 xv = *(const f32x4*)(x + off + c), gv = *(const f32x4*)(g1 + col0 + c); o[n] = xv + gv * acc[ai][bj][m][n]; }
                    u32x4 w; w.x = cvt_pk_bf16(o[0][0], o[0][1]); w.y = cvt_pk_bf16(o[0][2], o[0][3]); w.z = cvt_pk_bf16(o[1][0], o[1][1]); w.w = cvt_pk_bf16(o[1][2], o[1][3]);
                    *(u32x4*)(out + off + bj * 128) = w; } }
    }
};

namespace att {
constexpr int KVBLK = 64, LDK = QKW, NT = KVL / KVBLK;
constexpr int SHM_V = KVBLK * 128 * 2, SHM_K = KVBLK * 128 * 2;
#define KSWZ(row, colB) ((row) * 256 + ((colB) ^ (((row) & 7) << 4)))
#define SBAR() __builtin_amdgcn_sched_barrier(0)
__device__ __forceinline__ int crow(int r, int hi) { return (r & 3) + 8 * (r >> 2) + 4 * hi; }
__device__ __forceinline__ void expA(f32x16& p) {
#pragma unroll
    for (int r = 0; r < 16; ++r) p[r] = __builtin_amdgcn_exp2f(p[r]);
}
__device__ __forceinline__ void finishSM(f32x16& p0, f32x16& p1, float& l_reg, bf16x8& pa0, bf16x8& pa1, bf16x8& pa2, bf16x8& pa3) {
#pragma unroll
    for (int r = 0; r < 16; ++r) p1[r] = __builtin_amdgcn_exp2f(p1[r]);
    float ps = 0;
#pragma unroll
    for (int r = 0; r < 16; ++r) ps += p0[r];
#pragma unroll
    for (int r = 0; r < 16; ++r) ps += p1[r];
    { auto rr = __builtin_amdgcn_permlane32_swap(__float_as_uint(ps), __float_as_uint(ps), false, false); ps = __uint_as_float(rr[0]) + __uint_as_float(rr[1]); }
    l_reg += ps;
#define PK4(P, BASE, OUT) do { unsigned a0 = cvt_pk_bf16(P[BASE + 0], P[BASE + 1]), a1 = cvt_pk_bf16(P[BASE + 2], P[BASE + 3]);   \
    unsigned b0 = cvt_pk_bf16(P[BASE + 4], P[BASE + 5]), b1 = cvt_pk_bf16(P[BASE + 6], P[BASE + 7]);                              \
    auto r0 = __builtin_amdgcn_permlane32_swap(a0, b0, false, false); auto r1 = __builtin_amdgcn_permlane32_swap(a1, b1, false, false); \
    u32x4 w = {r0[0], r1[0], r0[1], r1[1]}; OUT = *reinterpret_cast<bf16x8*>(&w); } while (0)
    PK4(p0, 0, pa0); PK4(p0, 8, pa1); PK4(p1, 0, pa2); PK4(p1, 8, pa3);
#undef PK4
}
__device__ __forceinline__ void qkt(f32x16& p0, f32x16& p1, const char* Ks, const bf16x8* qr, int r32, int hi, int sub, float negm) {
    (void)negm;
    const f32x16 z = {};
#pragma unroll
    for (int d0 = 0; d0 < 4; ++d0) { const int cb = (sub * 64 + d0 * 16 + hi * 8) * 2;
        const bf16x8 b0 = *reinterpret_cast<const bf16x8*>(Ks + KSWZ(r32, cb));
        const bf16x8 b1 = *reinterpret_cast<const bf16x8*>(Ks + KSWZ(32 + r32, cb));
        p0 = __builtin_amdgcn_mfma_f32_32x32x16_bf16(b0, qr[d0], d0 ? p0 : z, 0, 0, 0);
        p1 = __builtin_amdgcn_mfma_f32_32x32x16_bf16(b1, qr[d0], d0 ? p1 : z, 0, 0, 0); }
}
__device__ __forceinline__ int v_st(int k, int c) { const int kk = (k & ~0xC) | ((k & 4) << 1) | ((k & 8) >> 1); return ((kk >> 3) * 4 + (c >> 5)) * 512 + ((kk & 7) * 32 + (c & 31)) * 2; }
__device__ __forceinline__ int v_rd_base(int lane) { return ((lane & 3) << 3) | (((lane >> 2) & 3) << 6) | (((lane >> 4) & 1) << 5) | (((lane >> 5) & 1) << 8); }
constexpr int v_rd_off(int d0, int ks, int half) { return d0 * 512 + ks * 4096 + half * 2048; }
template <int OFF> __device__ __forceinline__ s16x4 tr_read(int vb) {
    s16x4 r; asm volatile("ds_read_b64_tr_b16 %0, %1 offset:%2" : "=&v"(r) : "v"(vb), "i"(OFF) : "memory"); return r;
}
template <int D0> __device__ __forceinline__ void pv_one(f32x16& od, int vb, bf16x8 pa0, bf16x8 pa1, bf16x8 pa2, bf16x8 pa3) {
    const s16x4 l0 = tr_read<v_rd_off(D0, 0, 0)>(vb), h0 = tr_read<v_rd_off(D0, 0, 1)>(vb), l1 = tr_read<v_rd_off(D0, 1, 0)>(vb), h1 = tr_read<v_rd_off(D0, 1, 1)>(vb);
    const s16x4 l2 = tr_read<v_rd_off(D0, 2, 0)>(vb), h2 = tr_read<v_rd_off(D0, 2, 1)>(vb), l3 = tr_read<v_rd_off(D0, 3, 0)>(vb), h3 = tr_read<v_rd_off(D0, 3, 1)>(vb);
    asm volatile("s_waitcnt lgkmcnt(0)" ::: "memory"); SBAR();
#define PK(L, H) (bf16x8){L[0], L[1], L[2], L[3], H[0], H[1], H[2], H[3]}
    od = __builtin_amdgcn_mfma_f32_32x32x16_bf16(pa0, PK(l0, h0), od, 0, 0, 0);
    od = __builtin_amdgcn_mfma_f32_32x32x16_bf16(pa1, PK(l1, h1), od, 0, 0, 0);
    od = __builtin_amdgcn_mfma_f32_32x32x16_bf16(pa2, PK(l2, h2), od, 0, 0, 0);
    od = __builtin_amdgcn_mfma_f32_32x32x16_bf16(pa3, PK(l3, h3), od, 0, 0, 0);
#undef PK
}
__device__ __forceinline__ void pv_d0(f32x16* o, int vb, bf16x8 pa0, bf16x8 pa1, bf16x8 pa2, bf16x8 pa3) {
    pv_one<0>(o[0], vb, pa0, pa1, pa2, pa3); pv_one<1>(o[1], vb, pa0, pa1, pa2, pa3); pv_one<2>(o[2], vb, pa0, pa1, pa2, pa3); pv_one<3>(o[3], vb, pa0, pa1, pa2, pa3);
}

__device__ __forceinline__ void attn_unit(const bf16_t* __restrict__ Qb, const bf16_t* __restrict__ Kh, const bf16_t* __restrict__ Vh, bf16_t* MIXo,
                                          const float lam, const float negm, const float* __restrict__ subg, char* lds, const int wid) {
    const int lane = lane_id(), tid = wid * 64 + lane, r32 = lane & 31, hi = lane >> 5;
    const int sub = wid >> 2, wq = wid & 3;
    char* V_lds = lds; char* K_lds = lds + 3 * SHM_V;
    float* wsf = (float*)(lds + 98304) + wid * 32;
    float l_reg = 0; f32x16 o[4] = {}; bf16x8 qr[4];
    const bf16_t* Qw = Qb + (long)(wq * 32 + r32) * LDK + sub * 64 + hi * 8;
#pragma unroll
    for (int d0 = 0; d0 < 4; ++d0) qr[d0] = *reinterpret_cast<const bf16x8*>(Qw + d0 * 16);
    const int vb0 = (int)(uintptr_t)V_lds + v_rd_base(lane);
    long ksrc[2], vsrc[2];
#pragma unroll
    for (int i = 0; i < 2; ++i) { const int p = 2 * wid + i;
        { const int r = 4 * p + (lane >> 4), c = (lane & 15) ^ (r & 7); ksrc[i] = (long)r * LDK + c * 8; }
        { const int st = 2 * p + (lane >> 5), kk = 8 * (st >> 2) + ((lane & 31) >> 2), k = (kk & ~0xC) | ((kk & 4) << 1) | ((kk & 8) >> 1), c = 32 * (st & 3) + 8 * (lane & 3); vsrc[i] = (long)k * LDK + c; } }
    const unsigned kdst = (unsigned)(uintptr_t)K_lds + (unsigned)wid * 2048u, vdst = (unsigned)(uintptr_t)V_lds + (unsigned)wid * 2048u;
#define DMA_TILE(t, boff) do { _Pragma("unroll") for (int i_ = 0; i_ < 2; ++i_) { \
        __builtin_amdgcn_global_load_lds((const unsigned*)(Kh + (long)(t) * KVBLK * LDK + ksrc[i_]), (LAS unsigned*)(uintptr_t)__builtin_amdgcn_readfirstlane(kdst + (unsigned)(boff) + i_ * 1024u), 16, 0, 0); \
        __builtin_amdgcn_global_load_lds((const unsigned*)(Vh + (long)(t) * KVBLK * LDK + vsrc[i_]), (LAS unsigned*)(uintptr_t)__builtin_amdgcn_readfirstlane(vdst + (unsigned)(boff) + i_ * 1024u), 16, 0, 0); } } while (0)
#define WBAR() do { asm volatile("s_waitcnt vmcnt(0) lgkmcnt(0)" ::: "memory"); __builtin_amdgcn_s_barrier(); asm volatile("" ::: "memory"); } while (0)
#define ROT3(x) ((x) == 2 * SHM_V ? 0 : (x) + SHM_V)
    f32x16 pA0, pA1, pB0, pB1; bf16x8 pa0, pa1, pa2, pa3;
    DMA_TILE(0, 0); WBAR();
    DMA_TILE(1, SHM_V);
    qkt(pA0, pA1, K_lds, qr, r32, hi, sub, negm); expA(pA0);
    WBAR();
    int bprev = 0, bcur = SHM_V, bnext = 2 * SHM_V;
    for (int j = 1; j + 1 < NT; j += 2) {
        DMA_TILE(j + 1, bnext);
        SBAR(); qkt(pB0, pB1, K_lds + bcur, qr, r32, hi, sub, negm);
        finishSM(pA0, pA1, l_reg, pa0, pa1, pa2, pa3); SBAR();
        pv_d0(o, vb0 + bprev, pa0, pa1, pa2, pa3); expA(pB0);
        WBAR();
        bprev = bcur; bcur = bnext; bnext = ROT3(bnext);
        if (j + 2 < NT) DMA_TILE(j + 2, bnext);
        SBAR(); qkt(pA0, pA1, K_lds + bcur, qr, r32, hi, sub, negm);
        finishSM(pB0, pB1, l_reg, pa0, pa1, pa2, pa3); SBAR();
        pv_d0(o, vb0 + bprev, pa0, pa1, pa2, pa3); expA(pA0);
        WBAR();
        bprev = bcur; bcur = bnext; bnext = ROT3(bnext);
    }
    SBAR(); qkt(pB0, pB1, K_lds + bcur, qr, r32, hi, sub, negm);
    finishSM(pA0, pA1, l_reg, pa0, pa1, pa2, pa3); SBAR();
    pv_d0(o, vb0 + bprev, pa0, pa1, pa2, pa3); expA(pB0);
    finishSM(pB0, pB1, l_reg, pa0, pa1, pa2, pa3); SBAR();
    pv_d0(o, vb0 + bcur, pa0, pa1, pa2, pa3);
#undef ROT3
#undef DMA_TILE
#undef WBAR
#define SLOAD(i, k0)
#define SWRITE(b, i)
#define SWAIT()
#undef SLOAD
#undef SWRITE
#undef SWAIT
    if (hi == 0) wsf[r32] = l_reg;
    __syncthreads();
    float* X = (float*)lds;
    float rli[16];
#pragma unroll
    for (int r = 0; r < 16; ++r) rli[r] = __builtin_amdgcn_rcpf(wsf[crow(r, hi)]);
    if (sub == 1) {
#pragma unroll
        for (int r = 0; r < 16; ++r) { const int row = wq * 32 + crow(r, hi); const float s = lam * rli[r];
#pragma unroll
            for (int d0 = 0; d0 < 4; ++d0) X[row * 128 + d0 * 32 + r32] = o[d0][r] * s; }
    }
    __syncthreads();
    bf16_t* Y = (bf16_t*)(lds + 65536);
    if (sub == 0) {
        float sg[4];
#pragma unroll
        for (int d0 = 0; d0 < 4; ++d0) sg[d0] = subg[d0 * 32 + r32] * (1.f - LAM_INIT);
#pragma unroll
        for (int r = 0; r < 16; ++r) { const int row = wq * 32 + crow(r, hi);
            float v[4]; float ss = 0.f;
#pragma unroll
            for (int d0 = 0; d0 < 4; ++d0) { v[d0] = o[d0][r] * rli[r] - X[row * 128 + d0 * 32 + r32]; ss += v[d0] * v[d0]; }
            ss += __shfl_xor(ss, 1); ss += __shfl_xor(ss, 2); ss += __shfl_xor(ss, 4); ss += __shfl_xor(ss, 8); ss += __shfl_xor(ss, 16);
            const float rstd = rsqrtf(ss * (1.f / 128.f) + EPS);
#pragma unroll
            for (int d0 = 0; d0 < 4; ++d0) Y[row * 128 + d0 * 32 + r32] = (bf16_t)(cvt_pk_bf16(v[d0] * rstd * sg[d0], 0.f) & 0xffffu); }
    }
    __syncthreads();
    { const int row = tid >> 2, seg = (tid & 3) * 32;
#pragma unroll
        for (int i = 0; i < 4; ++i) { const u32x4 v = *(const u32x4*)(Y + row * 128 + seg + i * 8); *(u32x4*)(MIXo + (size_t)row * DM + seg + i * 8) = v; } }
    __syncthreads();
}
#undef KSWZ
#undef SBAR
}

__device__ __forceinline__ void p3_attention(Frame& F) {
    FT_DECL;
    const float* sc = WSP(float, WS_SMALL + SM_SCAL);
    const float lam = sc[0], negm = -sc[1];
    const bf16_t* Q = WSP(bf16_t, WS_Q); const bf16_t* Kb = WSP(bf16_t, WS_K); const bf16_t* Vb = WSP(bf16_t, WS_V); bf16_t* MIX = WSP(bf16_t, WS_MIX);
    const int c = blockIdx.x, xcd = c & 7, ci = c >> 3, per = F.G >> 3;
    for (int j = ci; j < 128; j += per) {
        const int pair = xcd * 4 + (j >> 5), qb = j & 31, b = pair >> 2, h = pair & 3;
        att::attn_unit(Q + ((size_t)b * SEQ + qb * 128) * QKW + h * 128, Kb + (size_t)b * KVL * QKW + h * 128, Vb + (size_t)b * KVL * QKW + h * 128,
                       MIX + ((size_t)b * SEQ + qb * 128) * DM + h * 128, lam, negm, F.in[15], (char*)F.lds, F.wave);
    }
}


namespace hy {
constexpr int RB_BYTES = 4352 * 8, IN_OFF = 2 * RB_BYTES, TW1_OFF = IN_OFF + 32768, TW2_OFF = TW1_OFF + 15 * 256 * 8, LDS_END = TW2_OFF + 15 * 16 * 8;
__device__ __forceinline__ f32x2 cmul(f32x2 a, f32x2 b) { return (f32x2){a.x * b.x - a.y * b.y, a.x * b.y + a.y * b.x}; }
__device__ __forceinline__ f32x2 cmulc(f32x2 a, f32x2 b) { return (f32x2){a.x * b.x + a.y * b.y, a.y * b.x - a.x * b.y}; }
__device__ __forceinline__ int P(int i) { return i + (i >> 4); }
template <bool INV> __device__ __forceinline__ void r4(f32x2& a, f32x2& b, f32x2& c, f32x2& d) {
    const f32x2 t0 = a + c, t1 = a - c, t2 = b + d, t3 = b - d;
    const f32x2 st3 = INV ? (f32x2){-t3.y, t3.x} : (f32x2){t3.y, -t3.x};
    a = t0 + t2; c = t0 - t2; b = t1 + st3; d = t1 - st3;
}
template <bool INV> __device__ __forceinline__ f32x2 tw(f32x2 v, float c, float s) {
    return INV ? (f32x2){v.x * c - v.y * s, v.y * c + v.x * s} : (f32x2){v.x * c + v.y * s, v.y * c - v.x * s};
}
template <bool INV> __device__ __forceinline__ void dft16(f32x2 (&v)[16]) {
    constexpr float C1 = 0.9238795325112867f, S1 = 0.3826834323650898f, R2 = 0.7071067811865476f;
    r4<INV>(v[0], v[4], v[8], v[12]); r4<INV>(v[1], v[5], v[9], v[13]); r4<INV>(v[2], v[6], v[10], v[14]); r4<INV>(v[3], v[7], v[11], v[15]);
    v[5] = tw<INV>(v[5], C1, S1);  v[9] = tw<INV>(v[9], R2, R2);    v[13] = tw<INV>(v[13], S1, C1);
    v[6] = tw<INV>(v[6], R2, R2);  v[10] = tw<INV>(v[10], 0.f, 1.f); v[14] = tw<INV>(v[14], -R2, R2);
    v[7] = tw<INV>(v[7], S1, C1);  v[11] = tw<INV>(v[11], -R2, R2);  v[15] = tw<INV>(v[15], -C1, -S1);
    r4<INV>(v[0], v[1], v[2], v[3]); r4<INV>(v[4], v[5], v[6], v[7]); r4<INV>(v[8], v[9], v[10], v[11]); r4<INV>(v[12], v[13], v[14], v[15]);
    f32x2 t;
    t = v[1]; v[1] = v[4]; v[4] = t;   t = v[2]; v[2] = v[8]; v[8] = t;    t = v[3]; v[3] = v[12]; v[12] = t;
    t = v[6]; v[6] = v[9]; v[9] = t;   t = v[7]; v[7] = v[13]; v[13] = t;  t = v[11]; v[11] = v[14]; v[14] = t;
}
struct Ctx { LAS f32x2* R; LAS f32x2* IN; LAS f32x2* TW1; LAS f32x2* TW2; int t, half; f32x2 wt; };
#define HY_OPAQUE(x) asm volatile("" : "+v"(x))
#define HY_W32(m) (f32x2){__builtin_cosf(-0.19634954084936207f * (m)), __builtin_sinf(-0.19634954084936207f * (m))}
template <int MODE> __device__ __forceinline__ void pass1_fwd(const Ctx& X) {
    f32x2 v[16]; int t = X.t; HY_OPAQUE(t);
#pragma unroll
    for (int m = 0; m < 16; ++m) { f32x2 a = X.IN[t + 256 * m]; if (MODE == 1) a = (f32x2){X.half ? a.y : a.x, 0.f}; v[m] = a; }
    if (X.half) {
#pragma unroll
        for (int m = 0; m < 16; ++m) v[m] = cmul(cmul(v[m], HY_W32(m)), X.wt);
    }
    dft16<false>(v);
#pragma unroll
    for (int q = 1; q < 16; ++q) v[q] = cmul(v[q], X.TW1[(q - 1) * 256 + t]);
    const int pb = t + (t >> 4);
#pragma unroll
    for (int q = 0; q < 16; ++q) X.R[pb + 272 * q] = v[q];
}
__device__ __forceinline__ void pass2_fwd(const Ctx& X) {
    int t = X.t; HY_OPAQUE(t);
    const int n2 = t & 15, pb = (t >> 4) * 272 + n2; f32x2 v[16];
#pragma unroll
    for (int m = 0; m < 16; ++m) v[m] = X.R[pb + 17 * m];
    dft16<false>(v);
#pragma unroll
    for (int q = 1; q < 16; ++q) v[q] = cmul(v[q], X.TW2[(q - 1) * 16 + n2]);
#pragma unroll
    for (int q = 0; q < 16; ++q) X.R[pb + 17 * q] = v[q];
}
template <bool FILTER> __device__ __forceinline__ void pass3(const Ctx& X, f32x2 (&H)[16]) {
    f32x2 v[16]; int t = X.t; HY_OPAQUE(t); const int pb = 17 * t;
#pragma unroll
    for (int m = 0; m < 16; ++m) v[m] = X.R[pb + m];
    dft16<false>(v);
    if (FILTER) {
#pragma unroll
        for (int q = 0; q < 16; ++q) H[q] = v[q] * (1.f / 8192.f);
    } else {
#pragma unroll
        for (int q = 0; q < 16; ++q) v[q] = cmul(v[q], H[q]);
        dft16<true>(v);
#pragma unroll
        for (int m = 0; m < 16; ++m) X.R[pb + m] = v[m];
    }
}
__device__ __forceinline__ void pass2_inv(const Ctx& X) {
    int t = X.t; HY_OPAQUE(t);
    const int n2 = t & 15, pb = (t >> 4) * 272 + n2; f32x2 v[16];
    v[0] = X.R[pb];
#pragma unroll
    for (int q = 1; q < 16; ++q) v[q] = cmulc(X.R[pb + 17 * q], X.TW2[(q - 1) * 16 + n2]);
    dft16<true>(v);
#pragma unroll
    for (int m = 0; m < 16; ++m) X.R[pb + 17 * m] = v[m];
}
__device__ __forceinline__ void pass1_inv(const Ctx& X) {
    f32x2 v[16]; int t = X.t; HY_OPAQUE(t); const int pb = t + (t >> 4);
    v[0] = X.R[pb];
#pragma unroll
    for (int q = 1; q < 16; ++q) v[q] = cmulc(X.R[pb + 272 * q], X.TW1[(q - 1) * 256 + t]);
    dft16<true>(v);
    if (X.half) {
#pragma unroll
        for (int m = 0; m < 16; ++m) v[m] = cmulc(cmulc(v[m], HY_W32(m)), X.wt);
    }
#pragma unroll
    for (int m = 0; m < 16; ++m) X.R[pb + 272 * m] = v[m];
}
__device__ __forceinline__ void conv_fft(const Ctx& X, f32x2 (&H)[16]) {
    __syncthreads(); pass1_fwd<0>(X); __syncthreads(); pass2_fwd(X); __syncthreads(); pass3<false>(X, H); __syncthreads(); pass2_inv(X); __syncthreads(); pass1_inv(X); __syncthreads();
}
constexpr int STG_OFF = LDS_END;
constexpr int LDS_END2 = STG_OFF + 2 * SEQ * 2;
static_assert(LDS_END2 <= LDSCTL_OFF, "hyena LDS map");
__device__ __forceinline__ float sconv_lds(const LAS bf16_t* stg, int bs, int n, float w0, float w1, float w2, float bias) {
    const LAS bf16_t* p = stg + bs * SEQ;
    const float c = bf2f(p[n]), lv = bf2f(p[n - ((n > 0) ? 1 : 0)]), rv = bf2f(p[n + ((n < SEQ - 1) ? 1 : 0)]);
    const float l = (n > 0) ? lv : 0.f, r = (n < SEQ - 1) ? rv : 0.f;
    return bias + w0 * l + w1 * c + w2 * r;
}
__device__ __forceinline__ void setup_tables(LAS unsigned char* lds, int tid) {
    LAS f32x2* TW1 = (LAS f32x2*)(lds + TW1_OFF); LAS f32x2* TW2 = (LAS f32x2*)(lds + TW2_OFF);
    for (int i = tid; i < 15 * 256; i += 512) { const int q = i / 256 + 1, t = i & 255; float s, c; sincosf(-6.283185307179586f * (float)((t * q) & 4095) * (1.f / 4096.f), &s, &c); TW1[i] = (f32x2){c, s}; }
    for (int i = tid; i < 15 * 16; i += 512) { const int q = i / 16 + 1, n2 = i & 15; float s, c; sincosf(-6.283185307179586f * (float)((n2 * q) & 255) * (1.f / 256.f), &s, &c); TW2[i] = (f32x2){c, s}; }
}
__device__ __forceinline__ void unit(Frame& F, int c) {
    FT_DECL;
    const int tid = f_tid; Ctx X; X.half = F.wave >> 2; X.t = tid & 255;
    X.R = (LAS f32x2*)(F.lds + X.half * RB_BYTES); X.IN = (LAS f32x2*)(F.lds + IN_OFF); X.TW1 = (LAS f32x2*)(F.lds + TW1_OFF); X.TW2 = (LAS f32x2*)(F.lds + TW2_OFF);
    { float s, cc; sincosf(-6.283185307179586f * (float)X.t * (1.f / 8192.f), &s, &cc); X.wt = (f32x2){cc, s}; }
    LAS f32x2* RB0 = (LAS f32x2*)(F.lds); LAS f32x2* RB1 = (LAS f32x2*)(F.lds + RB_BYTES);
    const float* FILT = WSP(float, WS_FILT);
    f32x2 H0[16], H1[16];
#pragma unroll
    for (int ord = 0; ord < 2; ++ord) {
        const float* hf = FILT + ((size_t)(ord * 2 + 0) * 512 + c) * SEQ; const float* hb = FILT + ((size_t)(ord * 2 + 1) * 512 + c) * SEQ;
        __syncthreads();
        int nb = tid; HY_OPAQUE(nb);
#pragma unroll
        for (int j = 0; j < 8; ++j) { const int n = nb + 512 * j; const float a = hf[n], b = hb[(SEQ - n) & (SEQ - 1)]; const float lo = (n == 0) ? a + b : a, hi = (n == 0) ? 0.f : b; X.IN[n] = (f32x2){lo + hi, lo - hi}; }
        __syncthreads(); pass1_fwd<1>(X); __syncthreads(); pass2_fwd(X); __syncthreads();
        if (ord == 0) pass3<true>(X, H0); else pass3<true>(X, H1);
    }
    const bf16_t* UT = WSP(bf16_t, WS_UT);
    const bf16_t* rv = UT + (size_t)c * MROWS; const bf16_t* r1 = UT + (size_t)(512 + c) * MROWS; const bf16_t* r2 = UT + (size_t)(1024 + c) * MROWS;
    const float* cw = F.in[16]; const float* cb = F.in[17];
    const float wv0 = cw[c], wv1 = cw[HYC + c], wv2 = cw[2 * HYC + c], bv = cb[c];
    const float wa0 = cw[512 + c], wa1 = cw[HYC + 512 + c], wa2 = cw[2 * HYC + 512 + c], ba = cb[512 + c];
    const float wb0 = cw[1024 + c], wb1 = cw[HYC + 1024 + c], wb2 = cw[2 * HYC + 1024 + c], bb = cb[1024 + c];
    const float sk0 = F.in[25][c], sk1 = F.in[25][512 + c];
    bf16_t* Z = WSP(bf16_t, WS_Z2T) + (size_t)c * MROWS;
    LAS bf16_t* STG = (LAS bf16_t*)(F.lds + STG_OFF);
    u32x4 g0 = *(const u32x4*)(rv + tid * 8), g1 = *(const u32x4*)(rv + SEQ + tid * 8);
    for (int pr = 0; pr < 4; ++pr) {
        const int b0 = 2 * pr, b1 = b0 + 1;
        f32x2 z[8]; int pc = tid + (tid >> 4); HY_OPAQUE(pc); int nb = tid; HY_OPAQUE(nb);
        __syncthreads();
        *(LAS u32x4*)(STG + tid * 8) = g0; *(LAS u32x4*)(STG + SEQ + tid * 8) = g1;
        __syncthreads();
#pragma unroll
        for (int j = 0; j < 8; ++j) { const int n = nb + 512 * j; z[j] = (f32x2){sconv_lds(STG, 0, n, wv0, wv1, wv2, bv), sconv_lds(STG, 1, n, wv0, wv1, wv2, bv)}; X.IN[n] = z[j]; }
        g0 = *(const u32x4*)(r1 + b0 * SEQ + tid * 8); g1 = *(const u32x4*)(r1 + b1 * SEQ + tid * 8);
        conv_fft(X, H0);
        *(LAS u32x4*)(STG + tid * 8) = g0; *(LAS u32x4*)(STG + SEQ + tid * 8) = g1;
        __syncthreads();
        HY_OPAQUE(nb); HY_OPAQUE(pc);
#pragma unroll
        for (int j = 0; j < 8; ++j) { const int n = nb + 512 * j; const f32x2 y = RB0[pc + 544 * j] + RB1[pc + 544 * j];
            const f32x2 g = (f32x2){sconv_lds(STG, 0, n, wa0, wa1, wa2, ba), sconv_lds(STG, 1, n, wa0, wa1, wa2, ba)};
            z[j] = g * (y + sk0 * z[j]); X.IN[n] = z[j]; }
        g0 = *(const u32x4*)(r2 + b0 * SEQ + tid * 8); g1 = *(const u32x4*)(r2 + b1 * SEQ + tid * 8);
        conv_fft(X, H1);
        *(LAS u32x4*)(STG + tid * 8) = g0; *(LAS u32x4*)(STG + SEQ + tid * 8) = g1;
        __syncthreads();
        if (pr < 3) { g0 = *(const u32x4*)(rv + (b0 + 2) * SEQ + tid * 8); g1 = *(const u32x4*)(rv + (b1 + 2) * SEQ + tid * 8); }
        HY_OPAQUE(nb); HY_OPAQUE(pc);
        f32x2 o[8];
#pragma unroll
        for (int j = 0; j < 8; ++j) { const int n = nb + 512 * j; const f32x2 y = RB0[pc + 544 * j] + RB1[pc + 544 * j];
            const f32x2 g = (f32x2){sconv_lds(STG, 0, n, wb0, wb1, wb2, bb), sconv_lds(STG, 1, n, wb0, wb1, wb2, bb)};
            o[j] = g * (y + sk1 * z[j]); }
        __syncthreads();
#pragma unroll
        for (int j = 0; j < 8; ++j) { const int n = nb + 512 * j; STG[n] = (bf16_t)(cvt_pk_bf16(o[j].x, 0.f) & 0xffffu); STG[SEQ + n] = (bf16_t)(cvt_pk_bf16(o[j].y, 0.f) & 0xffffu); }
        __syncthreads();
        *(u32x4*)(Z + b0 * SEQ + tid * 8) = *(const LAS u32x4*)(STG + tid * 8); *(u32x4*)(Z + b1 * SEQ + tid * 8) = *(const LAS u32x4*)(STG + SEQ + tid * 8);
    }
    __syncthreads();
}
}

__device__ __forceinline__ void p3_hyena(Frame& F) {
    FT_DECL;
    __syncthreads();
    hy::setup_tables(F.lds, f_tid);
    __syncthreads();
    for (int c = F.vcu; c < HYW; c += F.G) hy::unit(F, c);
}

__device__ __forceinline__ void p4_hynorm(Frame& F) {
    FT_DECL;
    const bf16_t* Z = WSP(bf16_t, WS_Z2T); bf16_t* MIX = WSP(bf16_t, WS_MIX); const float* g = F.in[26];
    LAS bf16_t* T = (LAS bf16_t*)F.lds;
    LAS float* red = (LAS float*)(F.lds + 512 * 72 * 2);
    LAS float* rs = red + 512;
    for (int it = F.vcu; it < MROWS / 64; it += F.G) {
        const int tok0 = it * 64;
        __syncthreads();
#pragma unroll
        for (int j = 0; j < 8; ++j) { const int i = f_tid + 512 * j, row = i >> 3, ch = i & 7; const u32x4 v = *(const u32x4*)(Z + (size_t)row * MROWS + tok0 + ch * 8); *(LAS u32x4*)(T + row * 72 + ch * 8) = v; }
        __syncthreads();
        { const int tok = f_tid & 63, grp = f_tid >> 6; float ss = 0.f;
#pragma unroll 8
            for (int k = 0; k < 64; ++k) { const float v = bf2f(T[(grp * 64 + k) * 72 + tok]); ss += v * v; }
            red[grp * 64 + tok] = ss; }
        __syncthreads();
        if (f_tid < 64) { float ss = 0.f;
#pragma unroll
            for (int w = 0; w < 8; ++w) ss += red[w * 64 + f_tid];
            rs[f_tid] = rsqrtf(ss * (1.f / HYW) + EPS); }
        __syncthreads();
#pragma unroll
        for (int j = 0; j < 8; ++j) { const int i = f_tid + 512 * j, tok = i >> 6, c0 = (i & 63) * 8; const float r = rs[tok];
            float v[8];
#pragma unroll
            for (int e = 0; e < 8; ++e) v[e] = bf2f(T[(c0 + e) * 72 + tok]) * r * g[c0 + e];
            u32x4 w; w.x = cvt_pk_bf16(v[0], v[1]); w.y = cvt_pk_bf16(v[2], v[3]); w.z = cvt_pk_bf16(v[4], v[5]); w.w = cvt_pk_bf16(v[6], v[7]);
            *(u32x4*)(MIX + (size_t)(tok0 + tok) * DM + 512 + c0) = w; }
    }
}

__device__ __forceinline__ void p4_stub(Frame& F) {
    FT_DECL;
    bf16_t* MIX = WSP(bf16_t, WS_MIX);
    const size_t gt = (size_t)F.vcu * 512 + f_tid, NT = (size_t)F.G * 512;
    for (size_t i = gt; i < (size_t)MROWS * 64; i += NT) { const size_t row = i >> 6, ch = i & 63; *(u32x4*)(MIX + row * DM + 512 + ch * 8) = (u32x4){0u, 0u, 0u, 0u}; }
}


constexpr size_t RT_TOPI = 0;
constexpr size_t RT_GATE = 512 * 1024;
constexpr size_t RT_POS = 1024 * 1024;
constexpr size_t RT_WGCNT = 1536 * 1024;
constexpr size_t RT_META = 1600 * 1024;
constexpr size_t RT_LIST = 2048 * 1024;
constexpr size_t RT_GSLOT = 2048 * 1024 + 640 * 1024;
constexpr int MAXSLOT = MROWS * TOPK + NEXP * 256;
constexpr int MAXTILE = MAXSLOT / 256;
constexpr size_t WS_XS = WS_EO;
constexpr int RW_PITCH = 32;
constexpr int P6_LDS_TOPI = 1024 * RW_PITCH * 4;

__device__ __forceinline__ void p6_router(Frame& F) {
    FT_DECL;
#define in F.in
    LAS float* RW = (LAS float*)F.lds;
    LAS int* TI = (LAS int*)(F.lds + P6_LDS_TOPI);
    LAS int* PS = TI + 512;
    LAS int* SC = PS + 512;
    const float* rw = in[28];
    for (int i = f_tid; i < 1024 * 8; i += 512) { const int k = i >> 3, c4 = i & 7; const f32x4 v = *(const f32x4*)(rw + (size_t)k * 32 + c4 * 4);
        const int pi = (k & 3) * 256 + (k >> 2); *(LAS f32x4*)(RW + pi * RW_PITCH + ((c4 ^ ((pi >> 1) & 7)) * 4)) = v; }
    __syncthreads();
    const float* mod = WSP(float, WS_SMALL + SM_MOD); const float* g2n = in[7]; const float* rb = in[29];
    unsigned char* H2 = WSP(unsigned char, WS_H);
    int* topi_g = WSP(int, WS_ROUTE + RT_TOPI); float* gate_g = WSP(float, WS_ROUTE + RT_GATE); int* pos_g = WSP(int, WS_ROUTE + RT_POS); int* wgcnt = WSP(int, WS_ROUTE + RT_WGCNT);
    const int lane = f_lane;
    for (int blk = blockIdx.x; blk < MROWS / 128; blk += F.G) {
        for (int it = 0; it < 8; ++it) {
            const int rl = F.wave * 16 + 2 * it, r0 = blk * 128 + rl;
            const float* sh2 = mod + (size_t)(r0 >> 12) * (NMOD * DM) + 3 * DM; const float* sc2 = sh2 + DM;
            f32x4 h[2][4];
#pragma unroll
            for (int rr = 0; rr < 2; ++rr) {
                const GAS u32x2* xr = (const GAS u32x2*)(WSP(bf16_t, WS_XN) + (size_t)(r0 + rr) * DM) + lane; float ss = 0.f;
#pragma unroll
                for (int j = 0; j < 4; ++j) { const u32x2 xb = xr[64 * j]; h[rr][j] = (f32x4){__uint_as_float(xb.x << 16), __uint_as_float(xb.x & 0xffff0000u), __uint_as_float(xb.y << 16), __uint_as_float(xb.y & 0xffff0000u)}; ss += (h[rr][j].x * h[rr][j].x + h[rr][j].y * h[rr][j].y) + (h[rr][j].z * h[rr][j].z + h[rr][j].w * h[rr][j].w); }
                const float rstd = rsqrtf(wave_sum(ss) * (1.f / DM) + EPS);
                GAS unsigned* o4 = (GAS unsigned*)(H2 + (size_t)(r0 + rr) * DM) + lane;
#pragma unroll
                for (int j = 0; j < 4; ++j) { const int c = 4 * lane + 256 * j;
                    const f32x4 g = *(const f32x4*)(g2n + c), a = *(const f32x4*)(sc2 + c), b = *(const f32x4*)(sh2 + c);
                    h[rr][j] = h[rr][j] * rstd * g * (a + 1.f) + b;
                    o4[64 * j] = pk4_fp8(h[rr][j].x, h[rr][j].y, h[rr][j].z, h[rr][j].w); }
            }
            float a0[32], a1[32]; int lb = lane; asm volatile("" : "+v"(lb)); const int sw = (lb >> 1) & 7;
#pragma unroll
            for (int e = 0; e < 32; ++e) { a0[e] = 0.f; a1[e] = 0.f; }
            unsigned pb[8];
#pragma unroll
            for (int c = 0; c < 8; ++c) { pb[c] = (unsigned)(uintptr_t)RW + (unsigned)lb * 128u + (unsigned)((c ^ sw) * 16); asm volatile("" : "+v"(pb[c])); }
            f32x4 wb[2][4];
#define P6_OFF(hs) ((((((hs) >> 1) & 3) * 256 + 64 * ((hs) >> 3)) * 128) & 65535)
#define P6_HI(hs) ((((((hs) >> 1) & 3) * 256 + 64 * ((hs) >> 3)) * 128) >> 16)
#define P6_LOADW(buf, hs) _Pragma("unroll") for (int c = 0; c < 4; ++c) wb[buf][c] = *(const LAS f32x4*)(uintptr_t)(pb[4 * ((hs) & 1) + c] + (unsigned)(P6_HI(hs) * 65536 + P6_OFF(hs)))
#define P6_FMA(buf, hs) do { const float x0 = h[0][(hs) >> 3][((hs) >> 1) & 3], x1 = h[1][(hs) >> 3][((hs) >> 1) & 3]; _Pragma("unroll") for (int c = 0; c < 4; ++c) _Pragma("unroll") for (int e = 0; e < 4; ++e) { \
                a0[16 * ((hs) & 1) + 4 * c + e] += x0 * wb[buf][c][e]; a1[16 * ((hs) & 1) + 4 * c + e] += x1 * wb[buf][c][e]; } } while (0)
            P6_LOADW(0, 0);
#pragma unroll
            for (int hs = 0; hs < 32; hs += 2) {
                P6_LOADW(1, hs + 1); __builtin_amdgcn_sched_barrier(0); asm volatile("s_waitcnt lgkmcnt(4)" ::: "memory"); __builtin_amdgcn_sched_barrier(0);
                P6_FMA(0, hs); __builtin_amdgcn_sched_barrier(0);
                if (hs + 2 < 32) { P6_LOADW(0, hs + 2); __builtin_amdgcn_sched_barrier(0); asm volatile("s_waitcnt lgkmcnt(4)" ::: "memory"); } else { asm volatile("s_waitcnt lgkmcnt(0)" ::: "memory"); }
                __builtin_amdgcn_sched_barrier(0);
                P6_FMA(1, hs + 1); __builtin_amdgcn_sched_barrier(0);
            }
#undef P6_LOADW
#undef P6_FMA
#undef P6_OFF
#undef P6_HI
#define RS_STEP(A, CNT, MASK) _Pragma("unroll") for (int i = 0; i < CNT; ++i) { const bool up = (lane & MASK) != 0; const float send = up ? A[i] : A[CNT + i]; const float keep = up ? A[CNT + i] : A[i]; A[i] = keep + __shfl_xor(send, MASK); }
            RS_STEP(a0, 16, 32) RS_STEP(a0, 8, 16) RS_STEP(a0, 4, 8) RS_STEP(a0, 2, 4) RS_STEP(a0, 1, 2)
            RS_STEP(a1, 16, 32) RS_STEP(a1, 8, 16) RS_STEP(a1, 4, 8) RS_STEP(a1, 2, 4) RS_STEP(a1, 1, 2)
#undef RS_STEP
            const int me = lane >> 1; const float bias = rb[me];
            float lg[2]; lg[0] = a0[0] + __shfl_xor(a0[0], 1) + bias; lg[1] = a1[0] + __shfl_xor(a1[0], 1) + bias;
            LAS float* WL = (LAS float*)(F.lds + P6_LDS_TOPI + 6144) + F.wave * 96;
            if ((lane & 1) == 0) { WL[me] = lg[0]; WL[32 + me] = lg[1]; }
            LDS_WAIT(); asm volatile("" ::: "memory");
#pragma unroll
            for (int rr = 0; rr < 2; ++rr) {
                const float v = lg[rr]; int rank = 0;
#pragma unroll
                for (int c4 = 0; c4 < 8; ++c4) { const f32x4 o = *(const LAS f32x4*)(WL + rr * 32 + 4 * c4);
#pragma unroll
                    for (int e = 0; e < 4; ++e) { const int oe = 4 * c4 + e; rank += (o[e] > v || (o[e] == v && oe < me)) ? 1 : 0; } }
                if ((lane & 1) == 0 && rank < 4) { WL[64 + rr * 4 + rank] = v; ((LAS int*)WL)[72 + rr * 4 + rank] = me; }
            }
            LDS_WAIT(); asm volatile("" ::: "memory");
            if (lane < 2) { const int rr = lane; const f32x4 tv = *(const LAS f32x4*)(WL + 64 + rr * 4); typedef int i32x4_t __attribute__((ext_vector_type(4))); const i32x4_t ti = *(const LAS i32x4_t*)((LAS int*)WL + 72 + rr * 4);
                const float e1 = __expf(tv[1] - tv[0]), e2 = __expf(tv[2] - tv[0]), e3 = __expf(tv[3] - tv[0]); const float inv = 1.f / (1.f + e1 + e2 + e3);
                const int r = r0 + rr;
                *(i32x4_t*)(topi_g + (size_t)r * 4) = ti;
                *(f32x4*)(gate_g + (size_t)r * 4) = (f32x4){inv, e1 * inv, e2 * inv, e3 * inv};
                *(LAS i32x4_t*)(TI + (rl + rr) * 4) = ti; }
            LDS_WAIT(); asm volatile("" ::: "memory");
        }
        __syncthreads();
        { const int t2 = F.wave * 64 + lane_id(); const int e = t2 & 31, seg = t2 >> 5; int cnt = 0;
#pragma unroll 4
            for (int i = 0; i < 32; ++i) cnt += (TI[seg * 32 + i] == e) ? 1 : 0;
            SC[seg * 32 + e] = cnt;
            __syncthreads();
            int pre = 0;
            for (int s2 = 0; s2 < seg; ++s2) pre += SC[s2 * 32 + e];
            if (seg == 15) wgcnt[blk * 32 + e] = pre + cnt;
            for (int i = 0; i < 32; ++i) if (TI[seg * 32 + i] == e) { PS[seg * 32 + i] = pre; ++pre; }
        }
        __syncthreads();
        { const int t3 = F.wave * 64 + lane_id(); pos_g[(size_t)blk * 512 + t3] = PS[t3]; }
        __syncthreads();
    }
#undef in
}


__device__ __forceinline__ void p6_router_mfma(Frame& F) {
    FT_DECL;
#define in F.in
    LAS float* WP = (LAS float*)F.lds;
    LAS int* TI = (LAS int*)(F.lds + P6_LDS_TOPI);
    LAS int* PS = TI + 512;
    LAS int* SC = PS + 512;
    LAS float* RSTD = (LAS float*)(SC + 512);
    LAS float* BIAS = RSTD + 128;
    LAS float* SSX = BIAS + 32;
    const float* rw = in[28]; const float* mod = WSP(float, WS_SMALL + SM_MOD); const float* g2n = in[7]; const float* rb = in[29];
    const bf16_t* XN = WSP(bf16_t, WS_XN); unsigned char* H2 = WSP(unsigned char, WS_H);
    int* topi_g = WSP(int, WS_ROUTE + RT_TOPI); float* gate_g = WSP(float, WS_ROUTE + RT_GATE); int* pos_g = WSP(int, WS_ROUTE + RT_POS); int* wgcnt = WSP(int, WS_ROUTE + RT_WGCNT);
    for (int blk = blockIdx.x; blk < MROWS / 128; blk += F.G) {
        const float* sh2 = mod + (size_t)(blk >> 5) * (NMOD * DM) + 3 * DM; const float* sc2 = sh2 + DM;
        __syncthreads();
        for (int i = f_tid; i < 1024 * 8; i += 512) { const int k = i >> 3, c4 = i & 7; const float gm = g2n[k] * (1.f + sc2[k]);
            *(LAS f32x4*)(WP + k * 32 + c4 * 4) = *(const f32x4*)(rw + (size_t)k * 32 + c4 * 4) * gm; }
        { const int e = f_tid & 31, part = f_tid >> 5; float a = 0.f;
            for (int k = part * 64; k < part * 64 + 64; ++k) a += sh2[k] * rw[(size_t)k * 32 + e];
            ((LAS float*)SC)[part * 32 + e] = a; }
        __syncthreads();
        if (f_tid < 32) { float a = rb[f_tid];
#pragma unroll
            for (int p = 0; p < 16; ++p) a += ((LAS float*)SC)[p * 32 + f_tid];
            BIAS[f_tid] = a; }
        const int rg = F.wave & 3, kh = F.wave >> 2, j = f_lane & 31, hi = f_lane >> 5;
        f32x16 acc = {};
        float ss = 0.f;
        { const bf16_t* xrow = XN + (size_t)(blk * 128 + rg * 32 + j) * DM + 512 * kh + 8 * hi;
            const LAS float* wp = WP + (512 * kh + 8 * hi) * 32 + j;
#pragma unroll 4
            for (int c = 0; c < 32; ++c) { const u32x4 xb = *(const u32x4*)(xrow + 16 * c);
                float xf[8] = {__uint_as_float(xb.x << 16), __uint_as_float(xb.x & 0xffff0000u), __uint_as_float(xb.y << 16), __uint_as_float(xb.y & 0xffff0000u),
                               __uint_as_float(xb.z << 16), __uint_as_float(xb.z & 0xffff0000u), __uint_as_float(xb.w << 16), __uint_as_float(xb.w & 0xffff0000u)};
#pragma unroll
                for (int q = 0; q < 8; ++q) { ss += xf[q] * xf[q]; acc = __builtin_amdgcn_mfma_f32_32x32x2f32(wp[(16 * c + q) * 32], xf[q], acc, 0, 0, 0); } } }
        { auto rr = __builtin_amdgcn_permlane32_swap(__float_as_uint(ss), __float_as_uint(ss), false, false); ss = __uint_as_float(rr[0]) + __uint_as_float(rr[1]); }
        if (hi == 0) SSX[kh * 128 + rg * 32 + j] = ss;
        __syncthreads();
        if (kh == 1) {
#pragma unroll
            for (int r = 0; r < 16; ++r) WP[(rg * 16 + r) * 64 + f_lane] = acc[r]; }
        if (f_tid < 128) RSTD[f_tid] = rsqrtf((SSX[f_tid] + SSX[128 + f_tid]) * (1.f / DM) + EPS);
        __syncthreads();
        if (kh == 0) {
            const float rstd = RSTD[rg * 32 + j];
            float tv[4] = {-INFINITY, -INFINITY, -INFINITY, -INFINITY}; int ti[4] = {1 << 20, 1 << 20, 1 << 20, 1 << 20};
#define P6_INS(V, E) do { float cv = (V); int ce = (E); _Pragma("unroll") for (int q = 0; q < 4; ++q) { const bool b = cv > tv[q] || (cv == tv[q] && ce < ti[q]); \
                const float nv = b ? tv[q] : cv; const int ne = b ? ti[q] : ce; tv[q] = b ? cv : tv[q]; ti[q] = b ? ce : ti[q]; cv = nv; ce = ne; } } while (0)
#pragma unroll
            for (int r = 0; r < 16; ++r) { const int e = (r & 3) + 8 * (r >> 2) + 4 * hi; const float v = (acc[r] + WP[(rg * 16 + r) * 64 + f_lane]) * rstd + BIAS[e]; P6_INS(v, e); }
            float ov[4]; int oe[4];
#pragma unroll
            for (int q = 0; q < 4; ++q) { ov[q] = __shfl_xor(tv[q], 32); oe[q] = __shfl_xor(ti[q], 32); }
#pragma unroll
            for (int q = 0; q < 4; ++q) P6_INS(ov[q], oe[q]);
#undef P6_INS
            if (hi == 0) { const int rl = rg * 32 + j, r = blk * 128 + rl;
                const float e1 = __expf(tv[1] - tv[0]), e2 = __expf(tv[2] - tv[0]), e3 = __expf(tv[3] - tv[0]); const float inv = 1.f / (1.f + e1 + e2 + e3);
                typedef int i32x4_t __attribute__((ext_vector_type(4))); const i32x4_t t4 = {ti[0], ti[1], ti[2], ti[3]};
                *(i32x4_t*)(topi_g + (size_t)r * 4) = t4; *(f32x4*)(gate_g + (size_t)r * 4) = (f32x4){inv, e1 * inv, e2 * inv, e3 * inv};
                *(LAS i32x4_t*)(TI + rl * 4) = t4; }
        }
        __syncthreads();
        { const int t2 = F.wave * 64 + lane_id(); const int e = t2 & 31, seg = t2 >> 5; int cnt = 0;
#pragma unroll 4
            for (int i = 0; i < 32; ++i) cnt += (TI[seg * 32 + i] == e) ? 1 : 0;
            SC[seg * 32 + e] = cnt;
            __syncthreads();
            int pre = 0;
            for (int s2 = 0; s2 < seg; ++s2) pre += SC[s2 * 32 + e];
            if (seg == 15) wgcnt[blk * 32 + e] = pre + cnt;
            for (int i = 0; i < 32; ++i) if (TI[seg * 32 + i] == e) { PS[seg * 32 + i] = pre; ++pre; }
        }
        __syncthreads();
        { const int t3 = F.wave * 64 + lane_id(); pos_g[(size_t)blk * 512 + t3] = PS[t3]; }
        { const int lane = lane_id();
            for (int it = 0; it < 4; ++it) { u32x2 xb[4][4];
#pragma unroll
                for (int u = 0; u < 4; ++u) { const GAS u32x2* xr = (const GAS u32x2*)(XN + (size_t)(blk * 128 + F.wave * 16 + 4 * it + u) * DM) + lane;
#pragma unroll
                    for (int jj = 0; jj < 4; ++jj) xb[u][jj] = xr[64 * jj]; }
#pragma unroll
                for (int u = 0; u < 4; ++u) { const int rl = F.wave * 16 + 4 * it + u; const float rstd = RSTD[rl];
                    GAS unsigned* o4 = (GAS unsigned*)(H2 + (size_t)(blk * 128 + rl) * DM) + lane;
#pragma unroll
                    for (int jj = 0; jj < 4; ++jj) { const int c = 4 * lane + 256 * jj;
                        const f32x4 x = (f32x4){__uint_as_float(xb[u][jj].x << 16), __uint_as_float(xb[u][jj].x & 0xffff0000u), __uint_as_float(xb[u][jj].y << 16), __uint_as_float(xb[u][jj].y & 0xffff0000u)};
                        const f32x4 g = *(const f32x4*)(g2n + c), a = *(const f32x4*)(sc2 + c), b = *(const f32x4*)(sh2 + c);
                        const f32x4 h = x * rstd * g * (a + 1.f) + b;
                        o4[64 * jj] = pk4_fp8(h.x, h.y, h.z, h.w); } } }
        }
    }
#undef in
}

__device__ __forceinline__ void p7_scatter(Frame& F) {
    FT_DECL;
    LAS int* TOT = (LAS int*)F.lds;
    LAS int* BASE = TOT + 32;
    LAS int* PRE = BASE + 32;
    LAS int* PART = PRE + 32;
    const int* wgcnt = WSP(int, WS_ROUTE + RT_WGCNT); const int* topi_g = WSP(int, WS_ROUTE + RT_TOPI); const float* gate_g = WSP(float, WS_ROUTE + RT_GATE); const int* pos_g = WSP(int, WS_ROUTE + RT_POS);
    int* list = WSP(int, WS_ROUTE + RT_LIST); float* gslot = WSP(float, WS_ROUTE + RT_GSLOT); int* meta = WSP(int, WS_ROUTE + RT_META);
    const unsigned char* H2 = WSP(unsigned char, WS_H); unsigned char* XS = WSP(unsigned char, WS_XS);
    for (int blk = blockIdx.x; blk < MROWS / 128; blk += F.G) {
        __syncthreads();
        { const int e = f_tid & 31, part = f_tid >> 5; int st = 0, sp = 0;
            for (int w = part * 16; w < part * 16 + 16; ++w) { const int c = wgcnt[w * 32 + e]; st += c; if (w < blk) sp += c; }
            PART[part * 32 + e] = st; PART[512 + part * 32 + e] = sp; }
        __syncthreads();
        if (f_tid < 32) { int st = 0, sp = 0;
#pragma unroll
            for (int p = 0; p < 16; ++p) { st += PART[p * 32 + f_tid]; sp += PART[512 + p * 32 + f_tid]; }
            TOT[f_tid] = st; PRE[f_tid] = sp; }
        __syncthreads();
        if (f_tid == 0) { int b = 0; for (int e = 0; e < 32; ++e) { BASE[e] = b; b += (TOT[e] + 255) & ~255; }
            if (blk == 0) { int t = 0; for (int e = 0; e < 32; ++e) { meta[e] = TOT[e]; meta[32 + e] = BASE[e]; const int nt = (TOT[e] + 255) >> 8; for (int q = 0; q < nt; ++q) meta[128 + t + q] = e; t += nt; } meta[64] = t; } }
        __syncthreads();
        { const int a = f_tid, row = blk * 128 + (a >> 2); const int e = topi_g[(size_t)blk * 512 + a]; const int slot = BASE[e] + PRE[e] + pos_g[(size_t)blk * 512 + a];
            list[slot] = row * 4 + (a & 3); gslot[slot] = gate_g[(size_t)blk * 512 + a];
            PART[a] = slot; }
        __syncthreads();
        for (int a0 = F.wave * 8; a0 < 512; a0 += NWAVES * 8) { u32x4 v[8]; int sl[8];
#pragma unroll
            for (int q = 0; q < 8; ++q) { const int a = a0 + q; sl[q] = PART[a]; v[q] = ((const GAS u32x4*)(H2 + (size_t)(blk * 128 + (a >> 2)) * DM))[f_lane]; }
#pragma unroll
            for (int q = 0; q < 8; ++q) ((GAS u32x4*)(XS + (size_t)sl[q] * DM))[f_lane] = v[q]; }
        if (blk < NEXP) { const int e = blk, lo = BASE[e] + TOT[e], hi = BASE[e] + ((TOT[e] + 255) & ~255);
            for (int sl = lo + F.wave; sl < hi; sl += NWAVES) { if (f_lane == 0) { list[sl] = -1; gslot[sl] = 0.f; }
                ((GAS u32x4*)(XS + (size_t)sl * DM))[f_lane] = (u32x4){0u, 0u, 0u, 0u}; } }
    }
}

template <int NPN> struct SchedMoE {
    int G, c, nT; const char* A; const char* W; size_t wstride; const LAS unsigned char* tileE;
    __device__ __forceinline__ bool next(int i, g8::Unit& u) const {
        const int L = i * G + c, xcd = L & 7, j = L >> 3, T = (j / NPN) * 8 + xcd, pn = j % NPN;
        if (T >= nT) return false;
        const int e = tileE[T];
        u.pm = T; u.pn = pn; u.kind = i; u.ex = e; u.a = A + (size_t)T * 256 * DM; u.b = W + (size_t)e * wstride + (size_t)pn * 256 * DM; return true;
    }
};
struct EpiSwiGLU {
    unsigned char* ACT; const float* b1;
    __device__ __forceinline__ void operator()(f32x4 (&acc)[2][2][4][2], const g8::Unit& u, int wr, int wc, int fr, int fq) const {
        asm volatile("" : "+v"(fr), "+v"(fq));
        const int j0 = u.pn * 128 + wc * 32 + 8 * fq; const float* bp = b1 + (size_t)u.ex * 2 * DM + j0;
        f32x4 bg[2], bl[2];
#pragma unroll
        for (int n = 0; n < 2; ++n) { bg[n] = *(const f32x4*)(bp + 4 * n); bl[n] = *(const f32x4*)(bp + DM + 4 * n); }
#pragma unroll
        for (int ai = 0; ai < 2; ++ai)
#pragma unroll
            for (int m = 0; m < 4; ++m) { const size_t slot = (size_t)u.pm * 256 + ai * 128 + wr * 64 + m * 16 + fr; float o[8];
#pragma unroll
                for (int n = 0; n < 2; ++n) { const f32x4 g4 = acc[ai][0][m][n] * (1.f / WSCALE) + bg[n], l4 = acc[ai][1][m][n] * (1.f / WSCALE) + bl[n];
#pragma unroll
                    for (int e = 0; e < 4; ++e) { const float g = fminf(g4[e], 7.f), l = __builtin_amdgcn_fmed3f(l4[e], -7.f, 7.f);
                        const float ex = __builtin_amdgcn_exp2f(g * (-1.702f * 1.4426950408889634f)); const float glu = g * __builtin_amdgcn_rcpf(1.f + ex);
                        o[4 * n + e] = fmaf(l, glu, glu); } }
                u32x2 w; w.x = pk4_fp8(o[0], o[1], o[2], o[3]); w.y = pk4_fp8(o[4], o[5], o[6], o[7]);
                *(u32x2*)(ACT + slot * DM + j0) = w; }
    }
};
struct EpiDown {
    unsigned char* EO; const float* b2; const LAS int* LL; int G, c;
    __device__ __forceinline__ void operator()(f32x4 (&acc)[2][2][4][2], const g8::Unit& u, int wr, int wc, int fr, int fq) const {
        asm volatile("" : "+v"(fr), "+v"(fq));
        const int c0 = u.pn * 256 + wc * 32 + 8 * fq; const float* bp = b2 + (size_t)u.ex * DM + c0;
        f32x4 bb[2][2];
#pragma unroll
        for (int bj = 0; bj < 2; ++bj)
#pragma unroll
            for (int n = 0; n < 2; ++n) bb[bj][n] = *(const f32x4*)(bp + bj * 128 + 4 * n);
        const LAS int* L = LL + u.kind * 512;
        int li[8]; float gt[8];
#pragma unroll
        for (int q = 0; q < 8; ++q) { const int rl = (q >> 2) * 128 + wr * 64 + (q & 3) * 16 + fr; li[q] = L[rl]; gt[q] = __int_as_float(L[256 + rl]) * (1.f / WSCALE); }
#pragma unroll
        for (int ai = 0; ai < 2; ++ai)
#pragma unroll
            for (int m = 0; m < 4; ++m) { const int l = li[ai * 4 + m]; const float g = gt[ai * 4 + m];
                unsigned char* dst = EO + ((size_t)(l & 3) * MROWS + (l >> 2)) * DM + c0;
                u32x2 w[2];
#pragma unroll
                for (int bj = 0; bj < 2; ++bj) { const f32x4 v0 = acc[ai][bj][m][0] * g + bb[bj][0] * (g * WSCALE), v1 = acc[ai][bj][m][1] * g + bb[bj][1] * (g * WSCALE);
                    w[bj].x = pk4_fp8(v0[0] * EOSCALE, v0[1] * EOSCALE, v0[2] * EOSCALE, v0[3] * EOSCALE); w[bj].y = pk4_fp8(v1[0] * EOSCALE, v1[1] * EOSCALE, v1[2] * EOSCALE, v1[3] * EOSCALE); }
                if (l >= 0) { *(u32x2*)dst = w[0]; *(u32x2*)(dst + 128) = w[1]; } }
    }
};
__device__ __forceinline__ const LAS unsigned char* moe_tiles(Frame& F, int& nT) {
    FT_DECL;
    LAS unsigned char* TE = (LAS unsigned char*)(F.lds + RING_BYTES); const int* meta = WSP(int, WS_ROUTE + RT_META);
    __syncthreads();
    nT = meta[64]; if (nT > MAXTILE) nT = MAXTILE;
    for (int i = f_tid; i < MAXTILE; i += 512) TE[i] = (unsigned char)((i < nT) ? meta[128 + i] : 0);
    __syncthreads();
    return (const LAS unsigned char*)TE;
}

__device__ __forceinline__ void p10_combine(Frame& F) {
    FT_DECL;
    const float* mod = WSP(float, WS_SMALL + SM_MOD); const unsigned char* EO = WSP(unsigned char, WS_EO);
    const size_t gt = (size_t)F.vcu * 512 + f_tid, NTH = (size_t)F.G * 512;
    float pd = 0.f, pa = 0.f;
    if (MK_PROBE_A != -2) { const unsigned long long* st = (const unsigned long long*)(F.ws + WS_CTL + 8192);
        pd = (MK_PROBE_A < 0) ? 0.1f : (float)(st[MK_PA1] - st[MK_PA0]) * MK_PSA; pa = (float)(st[MK_PB1] - st[MK_PB0]) * MK_PSB; }
    constexpr int U = 4;
    for (size_t i0 = gt; i0 < (size_t)MROWS * 128; i0 += NTH * U) {
        u32x2 ev[U][4]; f32x4 xv[U][2], gv[U][2];
#pragma unroll
        for (int u = 0; u < U; ++u) { const size_t i = i0 + (size_t)u * NTH; const size_t row = i >> 7; const int c0 = (int)(i & 127) * 8;
            const float* g2 = mod + (size_t)(row >> 12) * (NMOD * DM) + 5 * DM + c0; const bf16_t* op = WSP(bf16_t, WS_XN) + row * DM + c0;
#pragma unroll
            for (int k = 0; k < 4; ++k) ev[u][k] = __builtin_nontemporal_load((const u32x2*)(EO + ((size_t)k * MROWS + row) * DM + c0));
            { const u32x4 xb = *(const u32x4*)op; xv[u][0] = (f32x4){__uint_as_float(xb.x << 16), __uint_as_float(xb.x & 0xffff0000u), __uint_as_float(xb.y << 16), __uint_as_float(xb.y & 0xffff0000u)};
              xv[u][1] = (f32x4){__uint_as_float(xb.z << 16), __uint_as_float(xb.z & 0xffff0000u), __uint_as_float(xb.w << 16), __uint_as_float(xb.w & 0xffff0000u)}; }
            gv[u][0] = *(const f32x4*)g2; gv[u][1] = *(const f32x4*)(g2 + 4); }
#pragma unroll
        for (int u = 0; u < U; ++u) { const size_t i = i0 + (size_t)u * NTH; const size_t row = i >> 7; const int c0 = (int)(i & 127) * 8;
            float s[8];
#pragma unroll
            for (int e = 0; e < 8; ++e) s[e] = 0.f;
#pragma unroll
            for (int k = 0; k < 4; ++k) { const u32x2 v = ev[u][k];
                const f32x2 a = __builtin_amdgcn_cvt_pk_f32_fp8((int)v.x, false), b = __builtin_amdgcn_cvt_pk_f32_fp8((int)v.x, true), c = __builtin_amdgcn_cvt_pk_f32_fp8((int)v.y, false), d = __builtin_amdgcn_cvt_pk_f32_fp8((int)v.y, true);
                s[0] += a.x; s[1] += a.y; s[2] += b.x; s[3] += b.y; s[4] += c.x; s[5] += c.y; s[6] += d.x; s[7] += d.y; }
#pragma unroll
            for (int e = 0; e < 8; ++e) s[e] *= (1.f / EOSCALE);
            f32x4 o0 = xv[u][0] + gv[u][0] * (f32x4){s[0], s[1], s[2], s[3]}, o1 = xv[u][1] + gv[u][1] * (f32x4){s[4], s[5], s[6], s[7]};
            if (MK_PROBE_A != -2) { o0 += pd; o1 += pd; if (i == 0) o0[0] += pa; }
            float* op = F.out + row * DM + c0;
            __builtin_nontemporal_store(o0, (f32x4*)op); __builtin_nontemporal_store(o1, (f32x4*)(op + 4)); }
    }
}

struct Args { const float* in[34]; float* out; unsigned char* ws; int ph_lo, ph_hi; };
constexpr int N_PHASES = 11;

__global__ void __launch_bounds__(512, 2) mega(Args args) {
    extern __shared__ __attribute__((aligned(16))) unsigned char lds[];
    Frame F;
    F.lds = (LAS unsigned char*)lds;
    F.MISC = (volatile LAS unsigned*)(F.lds + LDSCTL_OFF);
    F.wave = __builtin_amdgcn_readfirstlane(threadIdx.x >> 6);
    FT_DECL;
    F.G = gridDim.x; { const int bx = blockIdx.x; F.vcu = (F.G % 8 == 0) ? (bx % 8) * (F.G / 8) + bx / 8 : bx; }
    F.in = (kin_t)__builtin_amdgcn_kernarg_segment_ptr();
    F.out = args.out; F.ws = args.ws;
    F.ctl = (gu32*)(args.ws + WS_CTL);
    for (int u = f_tid; u < (LDS_BYTES - LDSCTL_OFF) / 4; u += NWAVES * 64) ((LAS unsigned*)(F.lds + LDSCTL_OFF))[u] = 0u;
    __syncthreads();
    const int lo = args.ph_lo, hi = args.ph_hi;
    XcdBarrier bar; bar.bar = (unsigned*)(F.ctl + CW_BAR); bar.x = 0; bar.st = nullptr;
    if (hi - lo > 1) bar = xcd_barrier_post((unsigned*)(F.ctl + CW_BAR), F.MISC + 8, f_tid == 0);
#define IN(k) (lo <= (k) && (k) < hi)
    unsigned long long* stamps = (unsigned long long*)(args.ws + WS_CTL + 8192);
#define STAMP(k) do { if (MK_PROBE_A != -2 && blockIdx.x == 0 && f_tid == 0) stamps[(k)] = __builtin_amdgcn_s_memrealtime(); } while (0)
    STAMP(0);
#define SEAM(k) do { if (IN(k) && IN((k) + 1)) xcd_barrier(bar, F.wave == 0 && lane_id() == 0); } while (0)

    if (IN(0)) { p0_prologue(F); } SEAM(0); STAMP(1);
    if (IN(1)) { p1_norm1(F); } SEAM(1); STAMP(2);
    if (IN(2)) {
        SchedInProj S{F.G, (int)blockIdx.x, (const char*)WSP(bf16_t, WS_H), (const char*)WSP(bf16_t, WS_WIN)};
        EpiInProj E{WSP(bf16_t, WS_Q), WSP(bf16_t, WS_K), WSP(bf16_t, WS_V), WSP(bf16_t, WS_UT), F.in[9], F.in[10], WSP(float, WS_SMALL + SM_ROPE)};
        g8::gemm_phase<false>(F.lds, DM, S, E, F.wave, lane_id());
    } SEAM(2); STAMP(3);
    if (IN(3)) { p3_attention(F); STAMP(12); p3_hyena(F); } SEAM(3); STAMP(4);
    if (IN(4)) { p4_hynorm(F); } SEAM(4); STAMP(5);
    if (IN(5)) {
        SchedStatic S{F.G, (int)blockIdx.x, MROWS / 256, DM / 256, (const char*)WSP(bf16_t, WS_MIX), (const char*)WSP(bf16_t, WS_WOUT)};
        EpiOutProj E{F.in[0], WSP(bf16_t, WS_XN), WSP(float, WS_SMALL + SM_MOD)};
        g8::gemm_phase<false>(F.lds, DM, S, E, F.wave, lane_id());
    } SEAM(5); STAMP(6);
    if (IN(6)) { p6_router_mfma(F); } SEAM(6); STAMP(7);
    if (IN(7)) { p7_scatter(F); } SEAM(7); STAMP(8);
    if (IN(8)) {
        int nT; const LAS unsigned char* TE = moe_tiles(F, nT);
        SchedMoE<8> S{F.G, (int)blockIdx.x, nT, (const char*)WSP(char, WS_XS), (const char*)WSP(char, WS_W1), (size_t)2 * DM * DM, TE};
        EpiSwiGLU E{WSP(unsigned char, WS_ACT), F.in[31]};
        g8::gemm_phase<true>(F.lds, DM, S, E, F.wave, lane_id());
    } SEAM(8); STAMP(9);
    if (IN(9)) {
        int nT; const LAS unsigned char* TE = moe_tiles(F, nT);
        SchedMoE<4> S{F.G, (int)blockIdx.x, nT, (const char*)WSP(char, WS_ACT), (const char*)WSP(char, WS_W2), (size_t)DM * DM, TE};
        LAS int* LL = (LAS int*)(F.lds + RING_BYTES + 1024);
        static_assert(RING_BYTES + 1024 + 9 * 2048 <= LDSCTL_OFF, "LDS map");
        { const int* list = WSP(int, WS_ROUTE + RT_LIST); const float* gslot = WSP(float, WS_ROUTE + RT_GSLOT);
            const int t9 = F.wave * 64 + lane_id();
            g8::Unit u; for (int i = 0; i < 9 && S.next(i, u); ++i) { const int t = t9 & 255; const size_t slot = (size_t)u.pm * 256 + t;
                LL[i * 512 + (t9 >> 8) * 256 + t] = (t9 < 256) ? list[slot] : __float_as_int(gslot[slot]); }
            __syncthreads(); }
        EpiDown E{WSP(unsigned char, WS_EO), F.in[33], LL, F.G, (int)blockIdx.x};
        g8::gemm_phase<true>(F.lds, DM, S, E, F.wave, lane_id());
    } SEAM(9); STAMP(10);
    if (IN(10)) { p10_combine(F); }
#undef IN
#undef SEAM
}

extern "C" void kernel_launch(void* const* d_in, const int* in_sizes, int n_in, void* d_out, int out_size, void* d_ws, size_t ws_size, hipStream_t stream) {
    static int grid = 0;
    if (grid == 0) {
        if (n_in != 34 || out_size != MROWS * DM || ws_size < WS_END) { fprintf(stderr, "kernel_launch: unexpected shapes: n_in %d out %d ws %zu (need %zu)\n", n_in, out_size, ws_size, (size_t)WS_END); grid = -1; return; }
        int dev = 0, cus = 0, per_cu = 0;
        if (hipGetDevice(&dev) != hipSuccess || hipDeviceGetAttribute(&cus, hipDeviceAttributeMultiprocessorCount, dev) != hipSuccess) { grid = -1; return; }
        if (hipFuncSetAttribute((const void*)mega, hipFuncAttributeMaxDynamicSharedMemorySize, LDS_BYTES) != hipSuccess) { fprintf(stderr, "kernel_launch: hipFuncSetAttribute failed\n"); grid = -1; return; }
        if (hipOccupancyMaxActiveBlocksPerMultiprocessor(&per_cu, (const void*)mega, NWAVES * 64, LDS_BYTES) != hipSuccess || per_cu < 1) { fprintf(stderr, "kernel_launch: occupancy query says %d\n", per_cu); per_cu = 1; }
        (void)hipGetLastError();
        grid = cus;
    }
    if (grid < 0) return;
    (void)hipMemsetAsync((char*)d_ws + WS_CTL, 0, CTL_ZERO_BYTES, stream);
    Args a{};
    for (int i = 0; i < 34; ++i) a.in[i] = (const float*)d_in[i];
    a.out = (float*)d_out; a.ws = (unsigned char*)d_ws;
    constexpr int LAST = MK_LAST_PHASE + 1;
    if (MK_N_LAUNCHES == 1) { a.ph_lo = 0; a.ph_hi = LAST; hipLaunchKernelGGL(mega, dim3(grid), dim3(NWAVES * 64), LDS_BYTES, stream, a); }
    else for (int p = 0; p < LAST; ++p) { a.ph_lo = p; a.ph_hi = p + 1; hipLaunchKernelGGL(mega, dim3(grid), dim3(NWAVES * 64), LDS_BYTES, stream, a); }
    const hipError_t le = hipPeekAtLastError();
    if (le != hipSuccess) fprintf(stderr, "kernel_launch: launch failed: %s\n", hipGetErrorName(le));
}
```

```cpp
#include <hip/hip_runtime.h>
#include <hip/hip_bf16.h>
#include <cstdio>
#include <cstdint>

#ifndef MK_N_LAUNCHES
#define MK_N_LAUNCHES 1
#endif
#ifndef MK_PROBE_A
#define MK_PROBE_A -2
#endif
#ifndef MK_PA0
#define MK_PA0 0
#define MK_PA1 1
#define MK_PB0 0
#define MK_PB1 1
#define MK_PSA 2e-6f
#define MK_PSB 1e-4f
#endif
#ifndef MK_LAST_PHASE
#define MK_LAST_PHASE 10
#endif

#define GAS __attribute__((address_space(1)))
#define LAS __attribute__((address_space(3)))
typedef unsigned short bf16_t;
typedef short bf16x8 __attribute__((ext_vector_type(8)));
typedef short s16x4 __attribute__((ext_vector_type(4)));
typedef float f32x2 __attribute__((ext_vector_type(2)));
typedef float f32x4 __attribute__((ext_vector_type(4)));
typedef float f32x16 __attribute__((ext_vector_type(16)));
typedef unsigned u32x2 __attribute__((ext_vector_type(2)));
typedef unsigned u32x4 __attribute__((ext_vector_type(4)));
typedef GAS unsigned gu32;

constexpr int NB = 8, SEQ = 4096, DM = 1024, MROWS = NB * SEQ, CTXL = 256, MCTX = NB * CTXL, MTOT = MROWS + MCTX;
constexpr int KVL = CTXL + SEQ;
constexpr int NHEAD = 4, QKW = 512;
constexpr int HYW = 512, HYC = 1536, INC = 3072, QKVC = 1536;
constexpr int NEXP = 32, TOPK = 4, NMOD = 6;
constexpr float EPS = 1e-6f;
constexpr float LAM_INIT = 0.2f;
constexpr float QSCALE = 0.125f * 1.4426950408889634f;

constexpr size_t MiB = 1u << 20;
constexpr size_t WS_CTL = 0, CTL_ZERO_BYTES = 1 * MiB;
constexpr size_t WS_SMALL = 1 * MiB;
constexpr size_t WS_WIN = 2 * MiB;
constexpr size_t WS_WOUT = 8 * MiB;
constexpr size_t WS_W1 = 10 * MiB;
constexpr size_t WS_W2 = 138 * MiB;
constexpr size_t WS_H = 202 * MiB;
constexpr size_t WS_Q = 270 * MiB;
constexpr size_t WS_K = 302 * MiB;
constexpr size_t WS_V = 336 * MiB;
constexpr size_t WS_UT = 370 * MiB;
constexpr size_t WS_FILT = 466 * MiB;
constexpr size_t WS_Z2T = 498 * MiB;
constexpr size_t WS_MIX = 530 * MiB;
constexpr size_t WS_ROUTE = 594 * MiB;
constexpr size_t WS_ACT = 270 * MiB;
constexpr size_t WS_EO = 598 * MiB;
constexpr size_t WS_XN = 870 * MiB;
constexpr size_t WS_END = 998 * MiB;
constexpr size_t SM_MOD = 0;
constexpr size_t SM_SCAL = 256 * 1024;
constexpr size_t SM_ROPE = 260 * 1024;
constexpr int CW_BAR = 4096;

constexpr int RING_BYTES = 131072;
constexpr int LDSCTL_OFF = 151552;
constexpr int LDS_BYTES = 152576;
constexpr int NWAVES = 8;

#define LDS_WAIT() asm volatile("s_waitcnt lgkmcnt(0)" ::: "memory")
#define VM_WAIT() asm volatile("s_waitcnt vmcnt(0)" ::: "memory")
#define RLX_AGENT __ATOMIC_RELAXED, __HIP_MEMORY_SCOPE_AGENT

__device__ __forceinline__ unsigned cvt_pk_bf16(float lo, float hi) { unsigned r; asm volatile("v_cvt_pk_bf16_f32 %0, %1, %2" : "=v"(r) : "v"(lo), "v"(hi)); return r; }
__device__ __forceinline__ float bf2f(bf16_t v) { return __uint_as_float(((unsigned)v) << 16); }
__device__ __forceinline__ float wave_sum(float v) {
#pragma unroll
    for (int o = 1; o < 64; o <<= 1) v += __shfl_xor(v, o);
    return v;
}

#define XB_TMO      128
#define XB_XCNT(j)  (256  + 64 * (j))
#define XB_XSUB(j)  (1280 + 64 * (j))
#define XB_XGEN(j)  (2304 + 64 * (j))
#define XB_TOP      3328
#define XB_TOPGEN   3392
#define XCD_BAR_WORDS 3456
#define XB_SPIN_CAP (1u << 22)
__device__ __forceinline__ unsigned xb_ld(unsigned* p)              { return __hip_atomic_load(p, __ATOMIC_RELAXED, __HIP_MEMORY_SCOPE_AGENT); }
__device__ __forceinline__ unsigned xb_add(unsigned* p, unsigned v) { return __hip_atomic_fetch_add(p, v, __ATOMIC_RELAXED, __HIP_MEMORY_SCOPE_AGENT); }
__device__ __forceinline__ unsigned xb_xcc_id() { return (unsigned)__builtin_amdgcn_s_getreg((3 << 11) | 20) & 0xFu; }
#define XB_SPIN(cond, bar) do { unsigned _sp = 0; while (cond) { __builtin_amdgcn_s_sleep(1); \
    if ((++_sp & 255u) == 0u) { if (xb_ld(&(bar)[XB_TMO])) break; if (_sp > XB_SPIN_CAP) { atomicAdd(&(bar)[XB_TMO], 1u); break; } } } } while (0)
struct XcdBarrier { unsigned* bar; unsigned x; volatile LAS unsigned* st; };
__device__ __forceinline__ XcdBarrier xcd_barrier_post(unsigned* bar, volatile LAS unsigned* st, bool leader) {
    XcdBarrier b; b.bar = bar; b.x = xb_xcc_id(); b.st = st;
    if (leader) (void)xb_add(&bar[XB_XCNT(b.x)], 1u);
    return b;
}
__device__ __forceinline__ void xcd_barrier_complete(unsigned* bar, unsigned x, unsigned& nloc, unsigned& nx) {
    const unsigned G = gridDim.x * gridDim.y * gridDim.z;
    unsigned sum, cnt, mine, sp = 0u;
    for (;;) {
        sum = 0u; cnt = 0u; mine = 0u;
#pragma unroll
        for (unsigned j = 0; j < 16; ++j) { const unsigned c = xb_ld(&bar[XB_XCNT(j)]); sum += c; cnt += (c > 0u) ? 1u : 0u; mine = (j == x) ? c : mine; }
        if (sum == G) break;
        __builtin_amdgcn_s_sleep(1);
        if ((++sp & 255u) == 0u) { if (xb_ld(&bar[XB_TMO])) break; if (sp > XB_SPIN_CAP) { atomicAdd(&bar[XB_TMO], 1u); break; } }
    }
    nloc = mine > 0u ? mine : 1u; nx = cnt > 0u ? cnt : 1u;
}
__device__ __forceinline__ void xcd_barrier(const XcdBarrier& b, bool leader) {
    asm volatile("s_waitcnt vmcnt(0)" ::: "memory");
    __syncthreads();
    if (leader) {
        unsigned* bar = b.bar;
        __builtin_amdgcn_s_waitcnt(0);
        unsigned nloc = b.st[0], nx = b.st[1];
        if (nloc == 0u) { xcd_barrier_complete(bar, b.x, nloc, nx); b.st[0] = nloc; b.st[1] = nx; }
        const unsigned old = xb_add(&bar[XB_XSUB(b.x)], 1u);
        const unsigned gen = old / nloc;
        if (old + 1u == (gen + 1u) * nloc) {
            __builtin_amdgcn_fence(__ATOMIC_RELEASE, "agent");
            asm volatile("s_waitcnt vmcnt(0)" ::: "memory");
            const unsigned og = xb_add(&bar[XB_TOP], 1u);
            const unsigned tg = og / nx;
            if (og + 1u == (tg + 1u) * nx) xb_add(&bar[XB_TOPGEN], 1u);
            else XB_SPIN(xb_ld(&bar[XB_TOPGEN]) == tg, bar);
            __builtin_amdgcn_fence(__ATOMIC_ACQUIRE, "agent");
            xb_add(&bar[XB_XGEN(b.x)], 1u);
            asm volatile("s_waitcnt vmcnt(0)" ::: "memory");
        } else {
            XB_SPIN(xb_ld(&bar[XB_XGEN(b.x)]) == gen, bar);
            __builtin_amdgcn_fence(__ATOMIC_ACQUIRE, "agent");
            asm volatile("s_waitcnt vmcnt(0)" ::: "memory");
        }
    }
    __syncthreads();
}

namespace g8 {
constexpr int BM = 256, BK = 64, HALF = 128, HTB = HALF * BK * 2, STAGE_BYTES = 8 * HTB, NXCD = 8, WGM = 8;
__host__ __device__ __forceinline__ int lds_byte(int r, int c) { const int st = (r >> 4) * 2 + (c >> 5), rr = r & 15, cc = c & 31, ob = rr * 64 + cc * 2; return st * 1024 + (ob ^ (((ob >> 9) & 1) << 5)); }
__host__ __device__ __forceinline__ void stage_rc(int b, int& R, int& C) { const int st = b / 1024, sb = b % 1024, swz = sb ^ (((sb >> 9) & 1) << 5); R = (st >> 1) * 16 + swz / 64; C = (st & 1) * 32 + (swz % 64) / 2; }
__host__ __device__ __forceinline__ int perm32(int rho) { const int n = rho >> 4, i = rho & 15; return 8 * (i >> 2) + 4 * n + (i & 3); }

struct Unit { const char* a; const char* b; int pm, pn, kind, ex; };

__device__ __forceinline__ void tile_of(int L, int nM, int nN, int& pm, int& pn) {
    const int nwg = nM * nN; int wgid = L;
    { const int q = nwg / NXCD, r = nwg % NXCD, xcd = wgid % NXCD, off = wgid / NXCD; wgid = (xcd < r ? xcd * (q + 1) : r * (q + 1) + (xcd - r) * q) + off; }
    const int nig = WGM * nN, gid = wgid / nig, fm = gid * WGM, gsz = (nM - fm) < WGM ? (nM - fm) : WGM;
    pm = fm + ((wgid % nig) % gsz); pn = (wgid % nig) / gsz;
}

typedef int i32x8 __attribute__((ext_vector_type(8)));
template <bool FP8, class Epi, class Sched>
__device__ __forceinline__ void gemm_phase(LAS unsigned char* lds, const int K, const Sched& S, const Epi& E, const int wid, const int lane) {
    const int tid = wid * 64 + lane, wr = wid >> 2, wc = wid & 3, fr = lane & 15, fq = lane >> 4;
    const int nt = FP8 ? K / 128 : K / BK;
    const int RP = FP8 ? K : 2 * K;
    unsigned voffA[2], voffB[2];
#pragma unroll
    for (int i = 0; i < 2; ++i) { int R, C; stage_rc(tid * 16 + i * 8192, R, C); const int Rb = (R & ~31) + perm32(R & 31);
        voffA[i] = (unsigned)(R * RP + C * 2); voffB[i] = (unsigned)(Rb * RP + C * 2); }
    const size_t kstep = (size_t)(BK * 2);
    const size_t hstep = (size_t)HALF * RP;
    const unsigned ldsw = (unsigned)wid * 1024u;
    const int aoff = lds_byte(wr * 64 + fr, FP8 ? fq * 16 : fq * 8), boff = lds_byte(wc * 32 + fr, FP8 ? fq * 16 : fq * 8);
    constexpr int KOFF = FP8 ? 16 : 1024;
#define PG8_SA(b, h) (((b) * 2 + (h)) * HTB)
#define PG8_SB(b, h) ((4 + (b) * 2 + (h)) * HTB)
#define PG8_STAGE(bufoff, gbase, voff) do { _Pragma("unroll") for (int _i = 0; _i < 2; ++_i) \
        __builtin_amdgcn_global_load_lds((const unsigned*)((const char*)(gbase) + (voff)[_i]), (LAS unsigned*)(lds + (bufoff) + ldsw + _i * 8192), 16, 0, 0); } while (0)
#define PG8_LD32(p) __builtin_bit_cast(i32x8, __builtin_shufflevector(*(const LAS u32x4*)(p), *(const LAS u32x4*)((p) + 16), 0, 1, 2, 3, 4, 5, 6, 7))
#define PG8_LDA8(dst, b, h) do { _Pragma("unroll") for (int m = 0; m < 4; ++m) dst[m] = PG8_LD32(lds + PG8_SA(b, h) + aoff + m * 2048); } while (0)
#define PG8_LDB8(dst, b, h) do { _Pragma("unroll") for (int n = 0; n < 2; ++n) dst[n] = PG8_LD32(lds + PG8_SB(b, h) + boff + n * 2048); } while (0)
#define PG8_LDA(dst, b, h) do { _Pragma("unroll") for (int m = 0; m < 4; ++m) _Pragma("unroll") for (int k = 0; k < 2; ++k) dst[m][k] = *(const LAS bf16x8*)(lds + PG8_SA(b, h) + aoff + m * 2048 + k * KOFF); } while (0)
#define PG8_LDB(dst, b, h) do { _Pragma("unroll") for (int n = 0; n < 2; ++n) _Pragma("unroll") for (int k = 0; k < 2; ++k) dst[n][k] = *(const LAS bf16x8*)(lds + PG8_SB(b, h) + boff + n * 2048 + k * KOFF); } while (0)
#define PG8_MMA(ai, bj, At, Bt) do { __builtin_amdgcn_s_setprio(1); _Pragma("unroll") for (int m = 0; m < 4; ++m) _Pragma("unroll") for (int n = 0; n < 2; ++n) _Pragma("unroll") for (int k = 0; k < 2; ++k) \
        acc[ai][bj][m][n] = __builtin_amdgcn_mfma_f32_16x16x32_bf16(Bt[n][k], At[m][k], acc[ai][bj][m][n], 0, 0, 0); __builtin_amdgcn_s_setprio(0); } while (0)
#define PG8_MMA8(ai, bj, At, Bt) do { __builtin_amdgcn_s_setprio(1); _Pragma("unroll") for (int m = 0; m < 4; ++m) _Pragma("unroll") for (int n = 0; n < 2; ++n) \
        asm volatile("v_mfma_scale_f32_16x16x128_f8f6f4 %0, %1, %2, %0, %3, %3 op_sel_hi:[0,0,0]" : "+v"(acc[ai][bj][m][n]) : "v"(Bt[n]), "v"(At[m]), "v"(one_scale)); __builtin_amdgcn_s_setprio(0); } while (0)
#define PG8_WAIT_V(n) asm volatile("s_waitcnt vmcnt(" #n ")" ::: "memory")
#define PG8_WAIT_L(n) asm volatile("s_waitcnt lgkmcnt(" #n ")" ::: "memory")
#define PG8_BAR __builtin_amdgcn_s_barrier()
#define PG8_SCHED __builtin_amdgcn_sched_barrier(0)
    Unit cur, nxt; int ui = 0;
    if (!S.next(0, cur)) return;
    f32x4 acc[2][2][4][2];
#pragma unroll
    for (int a = 0; a < 2; ++a)
#pragma unroll
        for (int b = 0; b < 2; ++b)
#pragma unroll
            for (int m = 0; m < 4; ++m)
#pragma unroll
                for (int n = 0; n < 2; ++n) acc[a][b][m][n] = (f32x4){0.f, 0.f, 0.f, 0.f};
    bf16x8 At[4][2], B0[2][2], B1[2][2];
    i32x8 At8[4], B08[2], B18[2];
    const unsigned one_scale = 0x7f7f7f7fu;
    const char* cA = cur.a; const char* cB = cur.b;
    PG8_STAGE(PG8_SB(0, 0), cB, voffB); PG8_STAGE(PG8_SB(0, 1), cB + hstep, voffB); PG8_STAGE(PG8_SA(0, 0), cA, voffA); PG8_STAGE(PG8_SA(0, 1), cA + hstep, voffA);
    if (wr == 1) PG8_BAR;
    PG8_WAIT_V(2); PG8_BAR;
    PG8_STAGE(PG8_SB(1, 0), cB + kstep, voffB); PG8_STAGE(PG8_SA(1, 0), cA + kstep, voffA); PG8_STAGE(PG8_SB(1, 1), cB + hstep + kstep, voffB);
    PG8_WAIT_V(6); PG8_BAR;
    for (;;) {
        const bool has_next = S.next(ui + 1, nxt);
        const char* nA = has_next ? nxt.a : cA; const char* nB = has_next ? nxt.b : cB;
#pragma unroll 1
        for (int t = 0; t < nt; t += 2) {
            const bool last = (t == nt - 2);
            const char* a1 = cA + (size_t)(t + 1) * kstep;
            const char* a2 = last ? nA : cA + (size_t)(t + 2) * kstep; const char* b2 = last ? nB : cB + (size_t)(t + 2) * kstep;
            const char* a3 = a2 + kstep; const char* b3 = b2 + kstep;
            if constexpr (FP8) {
            PG8_LDB8(B08, 0, 0); PG8_LDB8(B18, 0, 1); PG8_SCHED; PG8_LDA8(At8, 0, 0); PG8_STAGE(PG8_SA(1, 1), a1 + hstep, voffA);
            PG8_WAIT_V(8); PG8_WAIT_L(0); PG8_BAR; PG8_MMA8(0, 0, At8, B08); PG8_MMA8(0, 1, At8, B18); PG8_BAR; PG8_SCHED;
            PG8_LDA8(At8, 0, 1); PG8_STAGE(PG8_SB(0, 0), b2, voffB); PG8_STAGE(PG8_SB(0, 1), b2 + hstep, voffB); PG8_STAGE(PG8_SA(0, 0), a2, voffA);
            PG8_WAIT_V(8); PG8_WAIT_L(0); PG8_BAR; PG8_MMA8(1, 0, At8, B08); PG8_MMA8(1, 1, At8, B18); PG8_BAR; PG8_SCHED;
            PG8_LDB8(B08, 1, 0); PG8_LDB8(B18, 1, 1); PG8_SCHED; PG8_LDA8(At8, 1, 0); PG8_STAGE(PG8_SA(0, 1), a2 + hstep, voffA);
            PG8_WAIT_V(8); PG8_WAIT_L(0); PG8_BAR; PG8_MMA8(0, 0, At8, B08); PG8_MMA8(0, 1, At8, B18); PG8_BAR; PG8_SCHED;
            PG8_LDA8(At8, 1, 1); PG8_STAGE(PG8_SB(1, 0), b3, voffB); PG8_STAGE(PG8_SB(1, 1), b3 + hstep, voffB); PG8_STAGE(PG8_SA(1, 0), a3, voffA);
            PG8_WAIT_V(8); PG8_WAIT_L(0); PG8_BAR; PG8_MMA8(1, 0, At8, B08); PG8_MMA8(1, 1, At8, B18); PG8_BAR; PG8_SCHED;
            } else {
            PG8_LDB(B0, 0, 0); PG8_LDB(B1, 0, 1); PG8_SCHED; PG8_LDA(At, 0, 0); PG8_STAGE(PG8_SA(1, 1), a1 + hstep, voffA);
            PG8_WAIT_V(8); PG8_WAIT_L(0); PG8_BAR; PG8_MMA(0, 0, At, B0); PG8_MMA(0, 1, At, B1); PG8_BAR; PG8_SCHED;
            PG8_LDA(At, 0, 1); PG8_STAGE(PG8_SB(0, 0), b2, voffB); PG8_STAGE(PG8_SB(0, 1), b2 + hstep, voffB); PG8_STAGE(PG8_SA(0, 0), a2, voffA);
            PG8_WAIT_V(8); PG8_WAIT_L(0); PG8_BAR; PG8_MMA(1, 0, At, B0); PG8_MMA(1, 1, At, B1); PG8_BAR; PG8_SCHED;
            PG8_LDB(B0, 1, 0); PG8_LDB(B1, 1, 1); PG8_SCHED; PG8_LDA(At, 1, 0); PG8_STAGE(PG8_SA(0, 1), a2 + hstep, voffA);
            PG8_WAIT_V(8); PG8_WAIT_L(0); PG8_BAR; PG8_MMA(0, 0, At, B0); PG8_MMA(0, 1, At, B1); PG8_BAR; PG8_SCHED;
            PG8_LDA(At, 1, 1); PG8_STAGE(PG8_SB(1, 0), b3, voffB); PG8_STAGE(PG8_SB(1, 1), b3 + hstep, voffB); PG8_STAGE(PG8_SA(1, 0), a3, voffA);
            PG8_WAIT_V(8); PG8_WAIT_L(0); PG8_BAR; PG8_MMA(1, 0, At, B0); PG8_MMA(1, 1, At, B1); PG8_BAR; PG8_SCHED;
            }
        }
        if (wr == 0) PG8_BAR;
        if constexpr (FP8) asm volatile("s_nop 15\n\ts_nop 15" ::: "memory");
        E(acc, cur, wr, wc, fr, fq);
        if (!has_next) break;
#pragma unroll
        for (int a = 0; a < 2; ++a)
#pragma unroll
            for (int b = 0; b < 2; ++b)
#pragma unroll
                for (int m = 0; m < 4; ++m)
#pragma unroll
                    for (int n = 0; n < 2; ++n) acc[a][b][m][n] = (f32x4){0.f, 0.f, 0.f, 0.f};
        cur = nxt; cA = nA; cB = nB; ++ui;
        if (wr == 1) PG8_BAR;
    }
    PG8_WAIT_V(0);
    PG8_BAR;
#undef PG8_SA
#undef PG8_SB
#undef PG8_STAGE
#undef PG8_LDA
#undef PG8_LDB
#undef PG8_MMA
#undef PG8_MMA8
#undef PG8_LDA8
#undef PG8_LDB8
#undef PG8_LD32
#undef PG8_WAIT_V
#undef PG8_WAIT_L
#undef PG8_BAR
#undef PG8_SCHED
}
}

__device__ __forceinline__ int lane_id() { int l; asm volatile("v_mbcnt_lo_u32_b32 %0, -1, 0\n\tv_mbcnt_hi_u32_b32 %0, -1, %0" : "=v"(l)); return l; }
#define FT_DECL const int f_lane = lane_id(), f_tid = F.wave * 64 + f_lane; (void)f_tid; (void)f_lane
typedef const float* cfp_t;
typedef __attribute__((address_space(4))) cfp_t* kin_t;
struct Frame {
    LAS unsigned char* lds;
    volatile LAS unsigned* MISC;
    gu32* ctl;
    int wave, vcu, G;
    kin_t in;
    float* out;
    unsigned char* ws;
};
#define WSP(T, off) ((T*)(F.ws + (off)))

template <class RowMap>
__device__ __forceinline__ void p0_transpose_item(const float* W, int K, int N, bf16_t* WT, const RowMap& rowmap, const float* kscale, LAS float* scr, int item, int lane) {
    const int nblk = N / 32, kb = item / nblk, nb = item % nblk, k0 = 64 * kb, n0 = 32 * nb;
#pragma unroll 8
    for (int i = 0; i < 32; ++i) { const int kk = 2 * i + (lane >> 5); float v = W[(size_t)(k0 + kk) * N + n0 + (lane & 31)]; if (kscale) v *= kscale[k0 + kk]; scr[kk * 33 + (lane & 31)] = v; }
    LDS_WAIT(); asm volatile("" ::: "memory");
    const int c = lane & 7;
#pragma unroll
    for (int j = 0; j < 4; ++j) { const int n = (lane >> 3) + 8 * j; const LAS float* s = scr + (8 * c) * 33 + n;
        u32x4 o; o.x = cvt_pk_bf16(s[0 * 33], s[1 * 33]); o.y = cvt_pk_bf16(s[2 * 33], s[3 * 33]); o.z = cvt_pk_bf16(s[4 * 33], s[5 * 33]); o.w = cvt_pk_bf16(s[6 * 33], s[7 * 33]);
        *(GAS u32x4*)(WT + (size_t)rowmap(n0 + n) * K + k0 + 8 * c) = o; }
    LDS_WAIT(); asm volatile("" ::: "memory");
}

__device__ __forceinline__ unsigned pk4_fp8(float a, float b, float c, float d) { int r = __builtin_amdgcn_cvt_pk_fp8_f32(a, b, 0, false); r = __builtin_amdgcn_cvt_pk_fp8_f32(c, d, r, true); return (unsigned)r; }
constexpr float EOSCALE = 16.f;
constexpr float WSCALE = 32.f;
template <class RowMap>
__device__ __forceinline__ void p0_transpose_item_f8(const float* W, int K, int N, unsigned char* WT, const RowMap& rowmap, LAS float* scr, int item, int lane) {
    const int nblk = N / 32, kb = item / nblk, nb = item % nblk, k0 = 128 * kb, n0 = 32 * nb;
#pragma unroll
    for (int hh = 0; hh < 2; ++hh) { float v[32];
#pragma unroll
        for (int i = 0; i < 32; ++i) { const int kk = 2 * (32 * hh + i) + (lane >> 5); v[i] = __builtin_nontemporal_load(W + (size_t)(k0 + kk) * N + n0 + (lane & 31)); }
#pragma unroll
        for (int i = 0; i < 32; ++i) { const int kk = 2 * (32 * hh + i) + (lane >> 5); scr[kk * 33 + (lane & 31)] = v[i] * WSCALE; } }
    LDS_WAIT(); asm volatile("" ::: "memory");
    const int c = lane & 7;
#pragma unroll
    for (int j = 0; j < 4; ++j) { const int n = (lane >> 3) + 8 * j; const LAS float* sp = scr + (16 * c) * 33 + n;
        u32x4 o; o.x = pk4_fp8(sp[0 * 33], sp[1 * 33], sp[2 * 33], sp[3 * 33]); o.y = pk4_fp8(sp[4 * 33], sp[5 * 33], sp[6 * 33], sp[7 * 33]);
        o.z = pk4_fp8(sp[8 * 33], sp[9 * 33], sp[10 * 33], sp[11 * 33]); o.w = pk4_fp8(sp[12 * 33], sp[13 * 33], sp[14 * 33], sp[15 * 33]);
        *(GAS u32x4*)(WT + (size_t)rowmap(n0 + n) * K + k0 + 16 * c) = o; }
    LDS_WAIT(); asm volatile("" ::: "memory");
}
struct MapIdent { int off; __device__ __forceinline__ int operator()(int n) const { return off + n; } };
struct MapWin { __device__ __forceinline__ int operator()(int l) const {
    if (l >= QKVC) return l;
    const int t = l & ~255, r = l & 255, wc = r >> 6, blk = (r >> 5) & 1, bj = (r >> 4) & 1, low = r & 15;
    return t + 128 * bj + 32 * wc + 16 * blk + low; } };
struct MapW1 { int off; __device__ __forceinline__ int operator()(int jp) const { const int bj = jp >> 10, j = jp & 1023; return off + 256 * (j >> 7) + 128 * bj + (j & 127); } };


__device__ __forceinline__ void p0_filter_item(Frame& F, int item) {
    FT_DECL;
#define in F.in
    LAS float* h1s = (LAS float*)(F.lds);
    LAS float* h2s = (LAS float*)(F.lds + 4096);
    const int t0 = item * 16;
    {
        const int tt = f_tid >> 5, hh = (f_tid & 31) * 2; const float pos = (float)(t0 + tt);
        float feats[17]; feats[0] = pos * (1.f / SEQ);
#pragma unroll
        for (int i = 0; i < 8; ++i) { const float band = 1e-4f + (float)i * ((7.f - 1e-4f) / 7.f); const float ang = (6.283185307179586f / SEQ) * pos * band; feats[1 + i] = sinf(ang); feats[9 + i] = cosf(ang); }
#pragma unroll
        for (int u = 0; u < 2; ++u) { const int h = hh + u; float a = in[19][h];
#pragma unroll
            for (int k = 0; k < 17; ++k) a += feats[k] * in[18][k * 64 + h];
            h1s[tt * 64 + h] = sinf(in[20][h] * a); }
        __syncthreads();
#pragma unroll
        for (int u = 0; u < 2; ++u) { const int h = hh + u; float a = in[22][h];
#pragma unroll 8
            for (int k = 0; k < 64; ++k) a += h1s[tt * 64 + k] * in[21][k * 64 + h];
            h2s[tt * 64 + h] = sinf(in[23][h] * a); }
        __syncthreads();
    }
    f32x4 acc[16];
#pragma unroll
    for (int t = 0; t < 16; ++t) acc[t] = (f32x4){0.f, 0.f, 0.f, 0.f};
    const int o = 4 * f_tid;
    for (int k = 0; k < 64; ++k) { const f32x4 w = *(const f32x4*)(in[24] + (size_t)k * 2048 + o);
#pragma unroll
        for (int t = 0; t < 16; ++t) acc[t] += w * h2s[t * 64 + k]; }
    const int c0 = o & 511, od = o >> 9;
    float* dst = WSP(float, WS_FILT) + ((size_t)od * 512 + c0) * SEQ + t0;
#pragma unroll
    for (int e = 0; e < 4; ++e) { const float la = -3.0701134573253944f, lb = -15.350567286626972f; const float delta = fabsf(la + (float)(c0 + e) * ((lb - la) / 511.f));
#pragma unroll
        for (int q = 0; q < 4; ++q) { f32x4 v;
#pragma unroll
            for (int i = 0; i < 4; ++i) { const int t = 4 * q + i; const float tn = (float)(t0 + t) * (1.f / SEQ); v[i] = acc[t][e] * expf(-tn * delta); }
            *(f32x4*)(dst + (size_t)e * SEQ + 4 * q) = v; } }
    __syncthreads();
#undef in
}

__device__ __forceinline__ float silu_f(float v) { return v / (1.f + __expf(-v)); }

__device__ __forceinline__ void p0_prologue(Frame& F) {
    FT_DECL;
#define in F.in
    const int wg = blockIdx.x;
    if (wg < 96) {
        LAS float* sv = (LAS float*)F.lds;
        for (int i = f_tid; i < 9 * 1024; i += 512) { const int r = i >> 10, k = i & 1023; const float c = (r < 8) ? in[1][r * 1024 + k] : in[3][k]; sv[i] = silu_f(c); }
        __syncthreads();
        const int j = wg * 64 + f_lane; const float* wm = in[4];
        float acc[9];
#pragma unroll
        for (int r = 0; r < 9; ++r) acc[r] = 0.f;
        const int kbeg = F.wave * 128;
#pragma unroll 4
        for (int k = kbeg; k < kbeg + 128; ++k) { const float w = wm[(size_t)k * (NMOD * DM) + j];
#pragma unroll
            for (int r = 0; r < 9; ++r) acc[r] += sv[r * 1024 + k] * w; }
        LAS float* red = (LAS float*)(F.lds + 40960);
#pragma unroll
        for (int r = 0; r < 9; ++r) red[(F.wave * 9 + r) * 64 + f_lane] = acc[r];
        __syncthreads();
        for (int i = f_tid; i < 9 * 64; i += 512) { const int r = i >> 6, l = i & 63; float s = in[5][wg * 64 + l];
#pragma unroll
            for (int w = 0; w < 8; ++w) s += red[(w * 9 + r) * 64 + l];
            WSP(float, WS_SMALL + SM_MOD)[r * (NMOD * DM) + wg * 64 + l] = s; }
        __syncthreads();
    } else if (wg == 96) {
        if (F.wave == 0) {
            const float a = wave_sum(in[11][f_lane] * in[12][f_lane]), b = wave_sum(in[13][f_lane] * in[14][f_lane]);
            float gq = fabsf(in[9][f_lane]), gk = fabsf(in[10][f_lane]);
#pragma unroll
            for (int o = 1; o < 64; o <<= 1) { gq = fmaxf(gq, __shfl_xor(gq, o)); gk = fmaxf(gk, __shfl_xor(gk, o)); }
            if (f_lane == 0) { float* sc = WSP(float, WS_SMALL + SM_SCAL); sc[0] = expf(a) - expf(b) + LAM_INIT;
                sc[1] = (8.f * gq * gk * 1.02f + 0.05f) * 1.4426950408889634f; }
        }
        for (int i = f_tid; i < 64 * 16; i += 512) { const int pos = i >> 4, f = i & 15;
            const float inv = powf(10000.f, -(float)f / 16.f); const float ang = (float)pos * inv;
            float* rt = WSP(float, WS_SMALL + SM_ROPE); rt[2 * i] = cosf(ang); rt[2 * i + 1] = sinf(ang); }
    }
    __syncthreads();
    for (int it = wg; it < SEQ / 16; it += F.G) p0_filter_item(F, it);
    __syncthreads();
    {
        LAS float* scr = (LAS float*)(F.lds + F.wave * 16896);
        const int gw = F.vcu * NWAVES + F.wave, NGW = F.G * NWAVES;
        constexpr int I_IN = (DM / 64) * (INC / 32), I_OUT = (DM / 64) * (DM / 32), I_1 = (DM / 128) * (2 * DM / 32), I_2 = (DM / 128) * (DM / 32);
        constexpr int NITEMS = I_IN + I_OUT + NEXP * (I_1 + I_2);
        for (int it = gw; it < NITEMS; it += NGW) {
            int r = it;
            if (r < I_IN) { p0_transpose_item(in[8], DM, INC, WSP(bf16_t, WS_WIN), MapWin{}, nullptr, scr, r, f_lane); continue; } r -= I_IN;
            if (r < I_OUT) { p0_transpose_item(in[27], DM, DM, WSP(bf16_t, WS_WOUT), MapIdent{0}, nullptr, scr, r, f_lane); continue; } r -= I_OUT;
            const int e = r / (I_1 + I_2); r -= e * (I_1 + I_2);
            if (r < I_1) p0_transpose_item_f8(in[30] + (size_t)e * DM * 2 * DM, DM, 2 * DM, WSP(unsigned char, WS_W1) + (size_t)e * 2 * DM * DM, MapW1{0}, scr, r, f_lane);
            else p0_transpose_item_f8(in[32] + (size_t)e * DM * DM, DM, DM, WSP(unsigned char, WS_W2) + (size_t)e * DM * DM, MapIdent{0}, scr, r - I_1, f_lane);
        }
    }
}
#undef in

__device__ __forceinline__ void p1_norm1(Frame& F) {
    FT_DECL;
    const int gw = F.vcu * NWAVES + F.wave, NGW = F.G * NWAVES;
    const float* mod = WSP(float, WS_SMALL + SM_MOD); const float* g1 = F.in[6];
    bf16_t* H = WSP(bf16_t, WS_H);
    constexpr int RU = 4;
    for (int m0 = gw; m0 < MTOT; m0 += NGW * RU) {
        f32x4 v[RU][4];
#pragma unroll
        for (int u = 0; u < RU; ++u) { const int m = m0 + u * NGW; if (m < MTOT) {
            const float* xrow = (m < MROWS) ? F.in[0] + (size_t)m * DM : F.in[2] + (size_t)(m - MROWS) * DM; const GAS f32x4* xr = (const GAS f32x4*)xrow + f_lane;
#pragma unroll
            for (int j = 0; j < 4; ++j) v[u][j] = __builtin_nontemporal_load(xr + 64 * j); } }
#pragma unroll
        for (int u = 0; u < RU; ++u) { const int m = m0 + u * NGW; if (m < MTOT) {
            const int mb = (m < MROWS) ? (m >> 12) : 8;
            const float* sh = mod + (size_t)mb * (NMOD * DM); const float* sc = sh + DM;
            float s = 0.f;
#pragma unroll
            for (int j = 0; j < 4; ++j) s += (v[u][j].x * v[u][j].x + v[u][j].y * v[u][j].y) + (v[u][j].z * v[u][j].z + v[u][j].w * v[u][j].w);
            const float rstd = rsqrtf(wave_sum(s) * (1.f / DM) + EPS);
            GAS u32x2* o8 = (GAS u32x2*)(H + (size_t)m * DM) + f_lane;
#pragma unroll
            for (int j = 0; j < 4; ++j) { const int c = 4 * f_lane + 256 * j;
                const f32x4 g = *(const f32x4*)(g1 + c), a = *(const f32x4*)(sc + c), b = *(const f32x4*)(sh + c);
                const f32x4 y = v[u][j] * rstd * g * (a + 1.f) + b;
                u32x2 w; w.x = cvt_pk_bf16(y.x, y.y); w.y = cvt_pk_bf16(y.z, y.w); o8[64 * j] = w; } } }
    }
}

struct SchedInProj {
    int G, c; const char* H; const char* W;
    static constexpr int NA = 136 * 6, NBU = 6 * 128;
    __device__ __forceinline__ bool next(int i, g8::Unit& u) const {
        const long L = (long)i * G + c;
        if (L < NA) { g8::tile_of((int)L, 136, 6, u.pm, u.pn); u.a = H + (size_t)u.pm * 256 * DM * 2; u.b = W + (size_t)u.pn * 256 * DM * 2; u.kind = 0; u.ex = 0; return true; }
        if (L < NA + NBU) { g8::tile_of((int)L - NA, 6, 128, u.pm, u.pn); u.a = W + (size_t)(QKVC + u.pm * 256) * DM * 2; u.b = H + (size_t)u.pn * 256 * DM * 2; u.kind = 1; u.ex = 0; return true; }
        return false;
    }
};
struct EpiInProj {
    bf16_t *Q, *Kb, *Vb, *UT; const float *gq, *gk, *rope;
    __device__ __forceinline__ void operator()(f32x4 (&acc)[2][2][4][2], const g8::Unit& u, int wr, int wc, int fr, int fq) const {
        if (u.kind == 1) {
            const int row0 = u.pm * 256 + wr * 64 + fr, col0 = u.pn * 256 + wc * 32 + 8 * fq;
#pragma unroll
            for (int ai = 0; ai < 2; ++ai)
#pragma unroll
                for (int m = 0; m < 4; ++m) { bf16_t* rowp = UT + (size_t)(row0 + ai * 128 + m * 16) * MROWS + col0;
#pragma unroll
                    for (int bj = 0; bj < 2; ++bj) { const f32x4 v0 = acc[ai][bj][m][0], v1 = acc[ai][bj][m][1];
                        u32x4 w; w.x = cvt_pk_bf16(v0[0], v0[1]); w.y = cvt_pk_bf16(v0[2], v0[3]); w.z = cvt_pk_bf16(v1[0], v1[1]); w.w = cvt_pk_bf16(v1[2], v1[3]);
                        *(u32x4*)(rowp + bj * 128) = w; } }
            return;
        }
        const int blk = fq >> 1, f = fq & 1;
        const int sec = u.pn >> 1;
        const bool ctx = (u.pm >= 128);
        if (sec == 0 && ctx) return;
        const int colbase = (u.pn & 1) * 256 + wc * 64 + 32 * blk + 8 * f;
        float gg[2][2][4];
        if (sec < 2) { const float* gp = (sec == 0 ? gq : gk) + 32 * blk + 8 * f;
#pragma unroll
            for (int bj = 0; bj < 2; ++bj)
#pragma unroll
                for (int n = 0; n < 2; ++n) { const f32x4 t = *(const f32x4*)(gp + 16 * bj + 4 * n); gg[bj][n][0] = t[0]; gg[bj][n][1] = t[1]; gg[bj][n][2] = t[2]; gg[bj][n][3] = t[3]; } }
#pragma unroll
        for (int ai = 0; ai < 2; ++ai)
#pragma unroll
            for (int m = 0; m < 4; ++m) {
                const int rloc = ai * 128 + wr * 64 + m * 16 + fr; const int r = u.pm * 256 + rloc;
                f32x4 v[2][2];
#pragma unroll
                for (int bj = 0; bj < 2; ++bj)
#pragma unroll
                    for (int n = 0; n < 2; ++n) v[bj][n] = acc[ai][bj][m][n];
                size_t orow;
                if (sec == 0) orow = (size_t)r;
                else if (!ctx) orow = (size_t)(r >> 12) * KVL + CTXL + (r & 4095);
                else { const int j = r - MROWS; orow = (size_t)(j >> 8) * KVL + (j & 255); }
                if (sec < 2) {
                    float ss = 0.f;
#pragma unroll
                    for (int bj = 0; bj < 2; ++bj)
#pragma unroll
                        for (int n = 0; n < 2; ++n) ss += (v[bj][n][0] * v[bj][n][0] + v[bj][n][1] * v[bj][n][1]) + (v[bj][n][2] * v[bj][n][2] + v[bj][n][3] * v[bj][n][3]);
                    ss += __shfl_xor(ss, 16); ss += __shfl_xor(ss, 32);
                    const float rstd = rsqrtf(ss * (1.f / 64.f) + EPS);
#pragma unroll
                    for (int bj = 0; bj < 2; ++bj)
#pragma unroll
                        for (int n = 0; n < 2; ++n)
#pragma unroll
                            for (int e = 0; e < 4; ++e) v[bj][n][e] *= rstd * gg[bj][n][e];
                    if (!ctx) {
                        const int t = r & 4095; const int pos = blk ? (t & 63) : (t >> 6);
                        const float* rp = rope + (size_t)(pos * 16 + 8 * f) * 2;
#pragma unroll
                        for (int n = 0; n < 2; ++n) { const f32x4 c0 = *(const f32x4*)(rp + 8 * n), c1 = *(const f32x4*)(rp + 8 * n + 4);
                            const float cs[4] = {c0[0], c0[2], c1[0], c1[2]}, sn[4] = {c0[1], c0[3], c1[1], c1[3]};
#pragma unroll
                            for (int e = 0; e < 4; ++e) { const float x1 = v[0][n][e], x2 = v[1][n][e]; v[0][n][e] = x1 * cs[e] - x2 * sn[e]; v[1][n][e] = x2 * cs[e] + x1 * sn[e]; } }
                    }
                    if (sec == 0) {
#pragma unroll
                        for (int bj = 0; bj < 2; ++bj)
#pragma unroll
                            for (int n = 0; n < 2; ++n) v[bj][n] *= QSCALE;
                    }
                }
                bf16_t* dst = (sec == 0 ? Q : (sec == 1 ? Kb : Vb)) + orow * QKW + colbase;
#pragma unroll
                for (int bj = 0; bj < 2; ++bj) { u32x4 w; w.x = cvt_pk_bf16(v[bj][0][0], v[bj][0][1]); w.y = cvt_pk_bf16(v[bj][0][2], v[bj][0][3]); w.z = cvt_pk_bf16(v[bj][1][0], v[bj][1][1]); w.w = cvt_pk_bf16(v[bj][1][2], v[bj][1][3]);
                    *(u32x4*)(dst + 16 * bj) = w; }
            }
    }
};

struct SchedStatic {
    int G, c, nM, nN; const char* A; const char* B;
    __device__ __forceinline__ bool next(int i, g8::Unit& u) const {
        const long L = (long)i * G + c; if (L >= (long)nM * nN) return false;
        g8::tile_of((int)L, nM, nN, u.pm, u.pn); u.a = A + (size_t)u.pm * 256 * DM * 2; u.b = B + (size_t)u.pn * 256 * DM * 2; u.kind = 0; u.ex = 0; return true;
    }
};
struct EpiOutProj {
    const float* x; bf16_t* out; const float* mod;
    __device__ __forceinline__ void operator()(f32x4 (&acc)[2][2][4][2], const g8::Unit& u, int wr, int wc, int fr, int fq) const {
        const int col0 = u.pn * 256 + wc * 32 + 8 * fq;
#pragma unroll
        for (int ai = 0; ai < 2; ++ai)
#pragma unroll
            for (int m = 0; m < 4; ++m) { const int r = u.pm * 256 + ai * 128 + wr * 64 + m * 16 + fr; const float* g1 = mod + (size_t)(r >> 12) * (NMOD * DM) + 2 * DM;
                const size_t off = (size_t)r * DM + col0;
#pragma unroll
                for (int bj = 0; bj < 2; ++bj) { f32x4 o[2];
#pragma unroll
                    for (int n = 0; n < 2; ++n) { const int c = bj * 128 + 4 * n; const f32x4 xv = *(const f32x4*)(x + off + c), gv = *(const f32x4*)(g1 + col0 + c); o[n] = xv + gv * acc[ai][bj][m][n]; }
                    u32x4 w; w.x = cvt_pk_bf16(o[0][0], o[0][1]); w.y = cvt_pk_bf16(o[0][2], o[0][3]); w.z = cvt_pk_bf16(o[1][0], o[1][1]); w.w = cvt_pk_bf16(o[1][2], o[1][3]);
                    *(u32x4*)(out + off + bj * 128) = w; } }
    }
};

namespace att {
constexpr int KVBLK = 64, LDK = QKW, NT = KVL / KVBLK;
constexpr int SHM_V = KVBLK * 128 * 2, SHM_K = KVBLK * 128 * 2;
#define KSWZ(row, colB) ((row) * 256 + ((colB) ^ (((row) & 7) << 4)))
#define SBAR() __builtin_amdgcn_sched_barrier(0)
__device__ __forceinline__ int crow(int r, int hi) { return (r & 3) + 8 * (r >> 2) + 4 * hi; }
__device__ __forceinline__ void expA(f32x16& p) {
#pragma unroll
    for (int r = 0; r < 16; ++r) p[r] = __builtin_amdgcn_exp2f(p[r]);
}
__device__ __forceinline__ void finishSM(f32x16& p0, f32x16& p1, float& l_reg, bf16x8& pa0, bf16x8& pa1, bf16x8& pa2, bf16x8& pa3) {
#pragma unroll
    for (int r = 0; r < 16; ++r) p1[r] = __builtin_amdgcn_exp2f(p1[r]);
    float ps = 0;
#pragma unroll
    for (int r = 0; r < 16; ++r) ps += p0[r];
#pragma unroll
    for (int r = 0; r < 16; ++r) ps += p1[r];
    { auto rr = __builtin_amdgcn_permlane32_swap(__float_as_uint(ps), __float_as_uint(ps), false, false); ps = __uint_as_float(rr[0]) + __uint_as_float(rr[1]); }
    l_reg += ps;
#define PK4(P, BASE, OUT) do { unsigned a0 = cvt_pk_bf16(P[BASE + 0], P[BASE + 1]), a1 = cvt_pk_bf16(P[BASE + 2], P[BASE + 3]);   \
    unsigned b0 = cvt_pk_bf16(P[BASE + 4], P[BASE + 5]), b1 = cvt_pk_bf16(P[BASE + 6], P[BASE + 7]);                              \
    auto r0 = __builtin_amdgcn_permlane32_swap(a0, b0, false, false); auto r1 = __builtin_amdgcn_permlane32_swap(a1, b1, false, false); \
    u32x4 w = {r0[0], r1[0], r0[1], r1[1]}; OUT = *reinterpret_cast<bf16x8*>(&w); } while (0)
    PK4(p0, 0, pa0); PK4(p0, 8, pa1); PK4(p1, 0, pa2); PK4(p1, 8, pa3);
#undef PK4
}
__device__ __forceinline__ void qkt(f32x16& p0, f32x16& p1, const char* Ks, const bf16x8* qr, int r32, int hi, int sub, float negm) {
    (void)negm;
    const f32x16 z = {};
#pragma unroll
    for (int d0 = 0; d0 < 4; ++d0) { const int cb = (sub * 64 + d0 * 16 + hi * 8) * 2;
        const bf16x8 b0 = *reinterpret_cast<const bf16x8*>(Ks + KSWZ(r32, cb));
        const bf16x8 b1 = *reinterpret_cast<const bf16x8*>(Ks + KSWZ(32 + r32, cb));
        p0 = __builtin_amdgcn_mfma_f32_32x32x16_bf16(b0, qr[d0], d0 ? p0 : z, 0, 0, 0);
        p1 = __builtin_amdgcn_mfma_f32_32x32x16_bf16(b1, qr[d0], d0 ? p1 : z, 0, 0, 0); }
}
__device__ __forceinline__ int v_st(int k, int c) { const int kk = (k & ~0xC) | ((k & 4) << 1) | ((k & 8) >> 1); return ((kk >> 3) * 4 + (c >> 5)) * 512 + ((kk & 7) * 32 + (c & 31)) * 2; }
__device__ __forceinline__ int v_rd_base(int lane) { return ((lane & 3) << 3) | (((lane >> 2) & 3) << 6) | (((lane >> 4) & 1) << 5) | (((lane >> 5) & 1) << 8); }
constexpr int v_rd_off(int d0, int ks, int half) { return d0 * 512 + ks * 4096 + half * 2048; }
template <int OFF> __device__ __forceinline__ s16x4 tr_read(int vb) {
    s16x4 r; asm volatile("ds_read_b64_tr_b16 %0, %1 offset:%2" : "=&v"(r) : "v"(vb), "i"(OFF) : "memory"); return r;
}
template <int D0> __device__ __forceinline__ void pv_one(f32x16& od, int vb, bf16x8 pa0, bf16x8 pa1, bf16x8 pa2, bf16x8 pa3) {
    const s16x4 l0 = tr_read<v_rd_off(D0, 0, 0)>(vb), h0 = tr_read<v_rd_off(D0, 0, 1)>(vb), l1 = tr_read<v_rd_off(D0, 1, 0)>(vb), h1 = tr_read<v_rd_off(D0, 1, 1)>(vb);
    const s16x4 l2 = tr_read<v_rd_off(D0, 2, 0)>(vb), h2 = tr_read<v_rd_off(D0, 2, 1)>(vb), l3 = tr_read<v_rd_off(D0, 3, 0)>(vb), h3 = tr_read<v_rd_off(D0, 3, 1)>(vb);
    asm volatile("s_waitcnt lgkmcnt(0)" ::: "memory"); SBAR();
#define PK(L, H) (bf16x8){L[0], L[1], L[2], L[3], H[0], H[1], H[2], H[3]}
    od = __builtin_amdgcn_mfma_f32_32x32x16_bf16(pa0, PK(l0, h0), od, 0, 0, 0);
    od = __builtin_amdgcn_mfma_f32_32x32x16_bf16(pa1, PK(l1, h1), od, 0, 0, 0);
    od = __builtin_amdgcn_mfma_f32_32x32x16_bf16(pa2, PK(l2, h2), od, 0, 0, 0);
    od = __builtin_amdgcn_mfma_f32_32x32x16_bf16(pa3, PK(l3, h3), od, 0, 0, 0);
#undef PK
}
__device__ __forceinline__ void pv_d0(f32x16* o, int vb, bf16x8 pa0, bf16x8 pa1, bf16x8 pa2, bf16x8 pa3) {
    pv_one<0>(o[0], vb, pa0, pa1, pa2, pa3); pv_one<1>(o[1], vb, pa0, pa1, pa2, pa3); pv_one<2>(o[2], vb, pa0, pa1, pa2, pa3); pv_one<3>(o[3], vb, pa0, pa1, pa2, pa3);
}

__device__ __forceinline__ void attn_unit(const bf16_t* __restrict__ Qb, const bf16_t* __restrict__ Kh, const bf16_t* __restrict__ Vh, bf16_t* MIXo,
                                          const float lam, const float negm, const float* __restrict__ subg, char* lds, const int wid) {
    const int lane = lane_id(), tid = wid * 64 + lane, r32 = lane & 31, hi = lane >> 5;
    const int sub = wid >> 2, wq = wid & 3;
    char* V_lds = lds; char* K_lds = lds + 3 * SHM_V;
    float* wsf = (float*)(lds + 98304) + wid * 32;
    float l_reg = 0; f32x16 o[4] = {}; bf16x8 qr[4];
    const bf16_t* Qw = Qb + (long)(wq * 32 + r32) * LDK + sub * 64 + hi * 8;
#pragma unroll
    for (int d0 = 0; d0 < 4; ++d0) qr[d0] = *reinterpret_cast<const bf16x8*>(Qw + d0 * 16);
    const int vb0 = (int)(uintptr_t)V_lds + v_rd_base(lane);
    long ksrc[2], vsrc[2];
#pragma unroll
    for (int i = 0; i < 2; ++i) { const int p = 2 * wid + i;
        { const int r = 4 * p + (lane >> 4), c = (lane & 15) ^ (r & 7); ksrc[i] = (long)r * LDK + c * 8; }
        { const int st = 2 * p + (lane >> 5), kk = 8 * (st >> 2) + ((lane & 31) >> 2), k = (kk & ~0xC) | ((kk & 4) << 1) | ((kk & 8) >> 1), c = 32 * (st & 3) + 8 * (lane & 3); vsrc[i] = (long)k * LDK + c; } }
    const unsigned kdst = (unsigned)(uintptr_t)K_lds + (unsigned)wid * 2048u, vdst = (unsigned)(uintptr_t)V_lds + (unsigned)wid * 2048u;
#define DMA_TILE(t, boff) do { _Pragma("unroll") for (int i_ = 0; i_ < 2; ++i_) { \
        __builtin_amdgcn_global_load_lds((const unsigned*)(Kh + (long)(t) * KVBLK * LDK + ksrc[i_]), (LAS unsigned*)(uintptr_t)__builtin_amdgcn_readfirstlane(kdst + (unsigned)(boff) + i_ * 1024u), 16, 0, 0); \
        __builtin_amdgcn_global_load_lds((const unsigned*)(Vh + (long)(t) * KVBLK * LDK + vsrc[i_]), (LAS unsigned*)(uintptr_t)__builtin_amdgcn_readfirstlane(vdst + (unsigned)(boff) + i_ * 1024u), 16, 0, 0); } } while (0)
#define WBAR() do { asm volatile("s_waitcnt vmcnt(0) lgkmcnt(0)" ::: "memory"); __builtin_amdgcn_s_barrier(); asm volatile("" ::: "memory"); } while (0)
#define ROT3(x) ((x) == 2 * SHM_V ? 0 : (x) + SHM_V)
    f32x16 pA0, pA1, pB0, pB1; bf16x8 pa0, pa1, pa2, pa3;
    DMA_TILE(0, 0); WBAR();
    DMA_TILE(1, SHM_V);
    qkt(pA0, pA1, K_lds, qr, r32, hi, sub, negm); expA(pA0);
    WBAR();
    int bprev = 0, bcur = SHM_V, bnext = 2 * SHM_V;
    for (int j = 1; j + 1 < NT; j += 2) {
        DMA_TILE(j + 1, bnext);
        SBAR(); qkt(pB0, pB1, K_lds + bcur, qr, r32, hi, sub, negm);
        finishSM(pA0, pA1, l_reg, pa0, pa1, pa2, pa3); SBAR();
        pv_d0(o, vb0 + bprev, pa0, pa1, pa2, pa3); expA(pB0);
        WBAR();
        bprev = bcur; bcur = bnext; bnext = ROT3(bnext);
        if (j + 2 < NT) DMA_TILE(j + 2, bnext);
        SBAR(); qkt(pA0, pA1, K_lds + bcur, qr, r32, hi, sub, negm);
        finishSM(pB0, pB1, l_reg, pa0, pa1, pa2, pa3); SBAR();
        pv_d0(o, vb0 + bprev, pa0, pa1, pa2, pa3); expA(pA0);
        WBAR();
        bprev = bcur; bcur = bnext; bnext = ROT3(bnext);
    }
    SBAR(); qkt(pB0, pB1, K_lds + bcur, qr, r32, hi, sub, negm);
    finishSM(pA0, pA1, l_reg, pa0, pa1, pa2, pa3); SBAR();
    pv_d0(o, vb0 + bprev, pa0, pa1, pa2, pa3); expA(pB0);
    finishSM(pB0, pB1, l_reg, pa0, pa1, pa2, pa3); SBAR();
    pv_d0(o, vb0 + bcur, pa0, pa1, pa2, pa3);
#undef ROT3
#undef DMA_TILE
#undef WBAR
#define SLOAD(i, k0)
#define SWRITE(b, i)
#define SWAIT()
#undef SLOAD
#undef SWRITE
#undef SWAIT
    if (hi == 0) wsf[r32] = l_reg;
    __syncthreads();
    float* X = (float*)lds;
    float rli[16];
#pragma unroll
    for (int r = 0; r < 16; ++r) rli[r] = __builtin_amdgcn_rcpf(wsf[crow(r, hi)]);
    if (sub == 1) {
#pragma unroll
        for (int r = 0; r < 16; ++r) { const int row = wq * 32 + crow(r, hi); const float s = lam * rli[r];
#pragma unroll
            for (int d0 = 0; d0 < 4; ++d0) X[row * 128 + d0 * 32 + r32] = o[d0][r] * s; }
    }
    __syncthreads();
    bf16_t* Y = (bf16_t*)(lds + 65536);
    if (sub == 0) {
        float sg[4];
#pragma unroll
        for (int d0 = 0; d0 < 4; ++d0) sg[d0] = subg[d0 * 32 + r32] * (1.f - LAM_INIT);
#pragma unroll
        for (int r = 0; r < 16; ++r) { const int row = wq * 32 + crow(r, hi);
            float v[4]; float ss = 0.f;
#pragma unroll
            for (int d0 = 0; d0 < 4; ++d0) { v[d0] = o[d0][r] * rli[r] - X[row * 128 + d0 * 32 + r32]; ss += v[d0] * v[d0]; }
            ss += __shfl_xor(ss, 1); ss += __shfl_xor(ss, 2); ss += __shfl_xor(ss, 4); ss += __shfl_xor(ss, 8); ss += __shfl_xor(ss, 16);
            const float rstd = rsqrtf(ss * (1.f / 128.f) + EPS);
#pragma unroll
            for (int d0 = 0; d0 < 4; ++d0) Y[row * 128 + d0 * 32 + r32] = (bf16_t)(cvt_pk_bf16(v[d0] * rstd * sg[d0], 0.f) & 0xffffu); }
    }
    __syncthreads();
    { const int row = tid >> 2, seg = (tid & 3) * 32;
#pragma unroll
        for (int i = 0; i < 4; ++i) { const u32x4 v = *(const u32x4*)(Y + row * 128 + seg + i * 8); *(u32x4*)(MIXo + (size_t)row * DM + seg + i * 8) = v; } }
    __syncthreads();
}
#undef KSWZ
#undef SBAR
}

__device__ __forceinline__ void p3_attention(Frame& F) {
    FT_DECL;
    const float* sc = WSP(float, WS_SMALL + SM_SCAL);
    const float lam = sc[0], negm = -sc[1];
    const bf16_t* Q = WSP(bf16_t, WS_Q); const bf16_t* Kb = WSP(bf16_t, WS_K); const bf16_t* Vb = WSP(bf16_t, WS_V); bf16_t* MIX = WSP(bf16_t, WS_MIX);
    const int c = blockIdx.x, xcd = c & 7, ci = c >> 3, per = F.G >> 3;
    for (int j = ci; j < 128; j += per) {
        const int pair = xcd * 4 + (j >> 5), qb = j & 31, b = pair >> 2, h = pair & 3;
        att::attn_unit(Q + ((size_t)b * SEQ + qb * 128) * QKW + h * 128, Kb + (size_t)b * KVL * QKW + h * 128, Vb + (size_t)b * KVL * QKW + h * 128,
                       MIX + ((size_t)b * SEQ + qb * 128) * DM + h * 128, lam, negm, F.in[15], (char*)F.lds, F.wave);
    }
}


namespace hy {
constexpr int RB_BYTES = 4352 * 8, IN_OFF = 2 * RB_BYTES, TW1_OFF = IN_OFF + 32768, TW2_OFF = TW1_OFF + 15 * 256 * 8, LDS_END = TW2_OFF + 15 * 16 * 8;
__device__ __forceinline__ f32x2 cmul(f32x2 a, f32x2 b) { return (f32x2){a.x * b.x - a.y * b.y, a.x * b.y + a.y * b.x}; }
__device__ __forceinline__ f32x2 cmulc(f32x2 a, f32x2 b) { return (f32x2){a.x * b.x + a.y * b.y, a.y * b.x - a.x * b.y}; }
__device__ __forceinline__ int P(int i) { return i + (i >> 4); }
template <bool INV> __device__ __forceinline__ void r4(f32x2& a, f32x2& b, f32x2& c, f32x2& d) {
    const f32x2 t0 = a + c, t1 = a - c, t2 = b + d, t3 = b - d;
    const f32x2 st3 = INV ? (f32x2){-t3.y, t3.x} : (f32x2){t3.y, -t3.x};
    a = t0 + t2; c = t0 - t2; b = t1 + st3; d = t1 - st3;
}
template <bool INV> __device__ __forceinline__ f32x2 tw(f32x2 v, float c, float s) {
    return INV ? (f32x2){v.x * c - v.y * s, v.y * c + v.x * s} : (f32x2){v.x * c + v.y * s, v.y * c - v.x * s};
}
template <bool INV> __device__ __forceinline__ void dft16(f32x2 (&v)[16]) {
    constexpr float C1 = 0.9238795325112867f, S1 = 0.3826834323650898f, R2 = 0.7071067811865476f;
    r4<INV>(v[0], v[4], v[8], v[12]); r4<INV>(v[1], v[5], v[9], v[13]); r4<INV>(v[2], v[6], v[10], v[14]); r4<INV>(v[3], v[7], v[11], v[15]);
    v[5] = tw<INV>(v[5], C1, S1);  v[9] = tw<INV>(v[9], R2, R2);    v[13] = tw<INV>(v[13], S1, C1);
    v[6] = tw<INV>(v[6], R2, R2);  v[10] = tw<INV>(v[10], 0.f, 1.f); v[14] = tw<INV>(v[14], -R2, R2);
    v[7] = tw<INV>(v[7], S1, C1);  v[11] = tw<INV>(v[11], -R2, R2);  v[15] = tw<INV>(v[15], -C1, -S1);
    r4<INV>(v[0], v[1], v[2], v[3]); r4<INV>(v[4], v[5], v[6], v[7]); r4<INV>(v[8], v[9], v[10], v[11]); r4<INV>(v[12], v[13], v[14], v[15]);
    f32x2 t;
    t = v[1]; v[1] = v[4]; v[4] = t;   t = v[2]; v[2] = v[8]; v[8] = t;    t = v[3]; v[3] = v[12]; v[12] = t;
    t = v[6]; v[6] = v[9]; v[9] = t;   t = v[7]; v[7] = v[13]; v[13] = t;  t = v[11]; v[11] = v[14]; v[14] = t;
}
struct Ctx { LAS f32x2* R; LAS f32x2* IN; LAS f32x2* TW1; LAS f32x2* TW2; int t, half; f32x2 wt; };
#define HY_OPAQUE(x) asm volatile("" : "+v"(x))
#define HY_W32(m) (f32x2){__builtin_cosf(-0.19634954084936207f * (m)), __builtin_sinf(-0.19634954084936207f * (m))}
template <int MODE> __device__ __forceinline__ void pass1_fwd(const Ctx& X) {
    f32x2 v[16]; int t = X.t; HY_OPAQUE(t);
#pragma unroll
    for (int m = 0; m < 16; ++m) { f32x2 a = X.IN[t + 256 * m]; if (MODE == 1) a = (f32x2){X.half ? a.y : a.x, 0.f}; v[m] = a; }
    if (X.half) {
#pragma unroll
        for (int m = 0; m < 16; ++m) v[m] = cmul(cmul(v[m], HY_W32(m)), X.wt);
    }
    dft16<false>(v);
#pragma unroll
    for (int q = 1; q < 16; ++q) v[q] = cmul(v[q], X.TW1[(q - 1) * 256 + t]);
    const int pb = t + (t >> 4);
#pragma unroll
    for (int q = 0; q < 16; ++q) X.R[pb + 272 * q] = v[q];
}
__device__ __forceinline__ void pass2_fwd(const Ctx& X) {
    int t = X.t; HY_OPAQUE(t);
    const int n2 = t & 15, pb = (t >> 4) * 272 + n2; f32x2 v[16];
#pragma unroll
    for (int m = 0; m < 16; ++m) v[m] = X.R[pb + 17 * m];
    dft16<false>(v);
#pragma unroll
    for (int q = 1; q < 16; ++q) v[q] = cmul(v[q], X.TW2[(q - 1) * 16 + n2]);
#pragma unroll
    for (int q = 0; q < 16; ++q) X.R[pb + 17 * q] = v[q];
}
template <bool FILTER> __device__ __forceinline__ void pass3(const Ctx& X, f32x2 (&H)[16]) {
    f32x2 v[16]; int t = X.t; HY_OPAQUE(t); const int pb = 17 * t;
#pragma unroll
    for (int m = 0; m < 16; ++m) v[m] = X.R[pb + m];
    dft16<false>(v);
    if (FILTER) {
#pragma unroll
        for (int q = 0; q < 16; ++q) H[q] = v[q] * (1.f / 8192.f);
    } else {
#pragma unroll
        for (int q = 0; q < 16; ++q) v[q] = cmul(v[q], H[q]);
        dft16<true>(v);
#pragma unroll
        for (int m = 0; m < 16; ++m) X.R[pb + m] = v[m];
    }
}
__device__ __forceinline__ void pass2_inv(const Ctx& X) {
    int t = X.t; HY_OPAQUE(t);
    const int n2 = t & 15, pb = (t >> 4) * 272 + n2; f32x2 v[16];
    v[0] = X.R[pb];
#pragma unroll
    for (int q = 1; q < 16; ++q) v[q] = cmulc(X.R[pb + 17 * q], X.TW2[(q - 1) * 16 + n2]);
    dft16<true>(v);
#pragma unroll
    for (int m = 0; m < 16; ++m) X.R[pb + 17 * m] = v[m];
}
__device__ __forceinline__ void pass1_inv(const Ctx& X) {
    f32x2 v[16]; int t = X.t; HY_OPAQUE(t); const int pb = t + (t >> 4);
    v[0] = X.R[pb];
#pragma unroll
    for (int q = 1; q < 16; ++q) v[q] = cmulc(X.R[pb + 272 * q], X.TW1[(q - 1) * 256 + t]);
    dft16<true>(v);
    if (X.half) {
#pragma unroll
        for (int m = 0; m < 16; ++m) v[m] = cmulc(cmulc(v[m], HY_W32(m)), X.wt);
    }
#pragma unroll
    for (int m = 0; m < 16; ++m) X.R[pb + 272 * m] = v[m];
}
#define HY_WSYNC() asm volatile("s_waitcnt lgkmcnt(0)" ::: "memory")
__device__ __forceinline__ void conv_fft(const Ctx& X, f32x2 (&H)[16]) {
    __syncthreads(); pass1_fwd<0>(X); __syncthreads(); pass2_fwd(X); HY_WSYNC(); pass3<false>(X, H); HY_WSYNC(); pass2_inv(X); __syncthreads(); pass1_inv(X); __syncthreads();
}
constexpr int STG_OFF = LDS_END;
constexpr int LDS_END2 = STG_OFF + 2 * SEQ * 2;
static_assert(LDS_END2 <= LDSCTL_OFF, "hyena LDS map");
__device__ __forceinline__ float sconv_lds(const LAS bf16_t* stg, int bs, int n, float w0, float w1, float w2, float bias) {
    const LAS bf16_t* p = stg + bs * SEQ;
    const float c = bf2f(p[n]), lv = bf2f(p[n - ((n > 0) ? 1 : 0)]), rv = bf2f(p[n + ((n < SEQ - 1) ? 1 : 0)]);
    const float l = (n > 0) ? lv : 0.f, r = (n < SEQ - 1) ? rv : 0.f;
    return bias + w0 * l + w1 * c + w2 * r;
}
__device__ __forceinline__ void setup_tables(LAS unsigned char* lds, int tid) {
    LAS f32x2* TW1 = (LAS f32x2*)(lds + TW1_OFF); LAS f32x2* TW2 = (LAS f32x2*)(lds + TW2_OFF);
    for (int i = tid; i < 15 * 256; i += 512) { const int q = i / 256 + 1, t = i & 255; float s, c; sincosf(-6.283185307179586f * (float)((t * q) & 4095) * (1.f / 4096.f), &s, &c); TW1[i] = (f32x2){c, s}; }
    for (int i = tid; i < 15 * 16; i += 512) { const int q = i / 16 + 1, n2 = i & 15; float s, c; sincosf(-6.283185307179586f * (float)((n2 * q) & 255) * (1.f / 256.f), &s, &c); TW2[i] = (f32x2){c, s}; }
}
__device__ __forceinline__ void unit(Frame& F, int c) {
    FT_DECL;
    const int tid = f_tid; Ctx X; X.half = F.wave >> 2; X.t = tid & 255;
    X.R = (LAS f32x2*)(F.lds + X.half * RB_BYTES); X.IN = (LAS f32x2*)(F.lds + IN_OFF); X.TW1 = (LAS f32x2*)(F.lds + TW1_OFF); X.TW2 = (LAS f32x2*)(F.lds + TW2_OFF);
    { float s, cc; sincosf(-6.283185307179586f * (float)X.t * (1.f / 8192.f), &s, &cc); X.wt = (f32x2){cc, s}; }
    LAS f32x2* RB0 = (LAS f32x2*)(F.lds); LAS f32x2* RB1 = (LAS f32x2*)(F.lds + RB_BYTES);
    const float* FILT = WSP(float, WS_FILT);
    f32x2 H0[16], H1[16];
#pragma unroll
    for (int ord = 0; ord < 2; ++ord) {
        const float* hf = FILT + ((size_t)(ord * 2 + 0) * 512 + c) * SEQ; const float* hb = FILT + ((size_t)(ord * 2 + 1) * 512 + c) * SEQ;
        __syncthreads();
        int nb = tid; HY_OPAQUE(nb);
#pragma unroll
        for (int j = 0; j < 8; ++j) { const int n = nb + 512 * j; const float a = hf[n], b = hb[(SEQ - n) & (SEQ - 1)]; const float lo = (n == 0) ? a + b : a, hi = (n == 0) ? 0.f : b; X.IN[n] = (f32x2){lo + hi, lo - hi}; }
        __syncthreads(); pass1_fwd<1>(X); __syncthreads(); pass2_fwd(X); HY_WSYNC();
        if (ord == 0) pass3<true>(X, H0); else pass3<true>(X, H1);
    }
    const bf16_t* UT = WSP(bf16_t, WS_UT);
    const bf16_t* rv = UT + (size_t)c * MROWS; const bf16_t* r1 = UT + (size_t)(512 + c) * MROWS; const bf16_t* r2 = UT + (size_t)(1024 + c) * MROWS;
    const float* cw = F.in[16]; const float* cb = F.in[17];
    const float wv0 = cw[c], wv1 = cw[HYC + c], wv2 = cw[2 * HYC + c], bv = cb[c];
    const float wa0 = cw[512 + c], wa1 = cw[HYC + 512 + c], wa2 = cw[2 * HYC + 512 + c], ba = cb[512 + c];
    const float wb0 = cw[1024 + c], wb1 = cw[HYC + 1024 + c], wb2 = cw[2 * HYC + 1024 + c], bb = cb[1024 + c];
    const float sk0 = F.in[25][c], sk1 = F.in[25][512 + c];
    bf16_t* Z = WSP(bf16_t, WS_Z2T) + (size_t)c * MROWS;
    LAS bf16_t* STG = (LAS bf16_t*)(F.lds + STG_OFF);
    u32x4 g0 = *(const u32x4*)(rv + tid * 8), g1 = *(const u32x4*)(rv + SEQ + tid * 8);
    for (int pr = 0; pr < 4; ++pr) {
        const int b0 = 2 * pr, b1 = b0 + 1;
        f32x2 z[8]; int pc = tid + (tid >> 4); HY_OPAQUE(pc); int nb = tid; HY_OPAQUE(nb);
        __syncthreads();
        *(LAS u32x4*)(STG + tid * 8) = g0; *(LAS u32x4*)(STG + SEQ + tid * 8) = g1;
        __syncthreads();
#pragma unroll
        for (int j = 0; j < 8; ++j) { const int n = nb + 512 * j; z[j] = (f32x2){sconv_lds(STG, 0, n, wv0, wv1, wv2, bv), sconv_lds(STG, 1, n, wv0, wv1, wv2, bv)}; X.IN[n] = z[j]; }
        g0 = *(const u32x4*)(r1 + b0 * SEQ + tid * 8); g1 = *(const u32x4*)(r1 + b1 * SEQ + tid * 8);
        conv_fft(X, H0);
        *(LAS u32x4*)(STG + tid * 8) = g0; *(LAS u32x4*)(STG + SEQ + tid * 8) = g1;
        __syncthreads();
        HY_OPAQUE(nb); HY_OPAQUE(pc);
#pragma unroll
        for (int j = 0; j < 8; ++j) { const int n = nb + 512 * j; const f32x2 y = RB0[pc + 544 * j] + RB1[pc + 544 * j];
            const f32x2 g = (f32x2){sconv_lds(STG, 0, n, wa0, wa1, wa2, ba), sconv_lds(STG, 1, n, wa0, wa1, wa2, ba)};
            z[j] = g * (y + sk0 * z[j]); X.IN[n] = z[j]; }
        g0 = *(const u32x4*)(r2 + b0 * SEQ + tid * 8); g1 = *(const u32x4*)(r2 + b1 * SEQ + tid * 8);
        conv_fft(X, H1);
        *(LAS u32x4*)(STG + tid * 8) = g0; *(LAS u32x4*)(STG + SEQ + tid * 8) = g1;
        __syncthreads();
        if (pr < 3) { g0 = *(const u32x4*)(rv + (b0 + 2) * SEQ + tid * 8); g1 = *(const u32x4*)(rv + (b1 + 2) * SEQ + tid * 8); }
        HY_OPAQUE(nb); HY_OPAQUE(pc);
        f32x2 o[8];
#pragma unroll
        for (int j = 0; j < 8; ++j) { const int n = nb + 512 * j; const f32x2 y = RB0[pc + 544 * j] + RB1[pc + 544 * j];
            const f32x2 g = (f32x2){sconv_lds(STG, 0, n, wb0, wb1, wb2, bb), sconv_lds(STG, 1, n, wb0, wb1, wb2, bb)};
            o[j] = g * (y + sk1 * z[j]); }
        __syncthreads();
#pragma unroll
        for (int j = 0; j < 8; ++j) { const int n = nb + 512 * j; STG[n] = (bf16_t)(cvt_pk_bf16(o[j].x, 0.f) & 0xffffu); STG[SEQ + n] = (bf16_t)(cvt_pk_bf16(o[j].y, 0.f) & 0xffffu); }
        __syncthreads();
        *(u32x4*)(Z + b0 * SEQ + tid * 8) = *(const LAS u32x4*)(STG + tid * 8); *(u32x4*)(Z + b1 * SEQ + tid * 8) = *(const LAS u32x4*)(STG + SEQ + tid * 8);
    }
    __syncthreads();
}
}

__device__ __forceinline__ void p3_hyena(Frame& F) {
    FT_DECL;
    __syncthreads();
    hy::setup_tables(F.lds, f_tid);
    __syncthreads();
    for (int c = F.vcu; c < HYW; c += F.G) hy::unit(F, c);
}

__device__ __forceinline__ void p4_hynorm(Frame& F) {
    FT_DECL;
    const bf16_t* Z = WSP(bf16_t, WS_Z2T); bf16_t* MIX = WSP(bf16_t, WS_MIX); const float* g = F.in[26];
    LAS bf16_t* T = (LAS bf16_t*)F.lds;
    LAS float* red = (LAS float*)(F.lds + 512 * 72 * 2);
    LAS float* rs = red + 512;
    for (int it = F.vcu; it < MROWS / 64; it += F.G) {
        const int tok0 = it * 64;
        __syncthreads();
#pragma unroll
        for (int j = 0; j < 8; ++j) { const int i = f_tid + 512 * j, row = i >> 3, ch = i & 7; const u32x4 v = *(const u32x4*)(Z + (size_t)row * MROWS + tok0 + ch * 8); *(LAS u32x4*)(T + row * 72 + ch * 8) = v; }
        __syncthreads();
        { const int tok = f_tid & 63, grp = f_tid >> 6; float ss = 0.f;
#pragma unroll 8
            for (int k = 0; k < 64; ++k) { const float v = bf2f(T[(grp * 64 + k) * 72 + tok]); ss += v * v; }
            red[grp * 64 + tok] = ss; }
        __syncthreads();
        if (f_tid < 64) { float ss = 0.f;
#pragma unroll
            for (int w = 0; w < 8; ++w) ss += red[w * 64 + f_tid];
            rs[f_tid] = rsqrtf(ss * (1.f / HYW) + EPS); }
        __syncthreads();
#pragma unroll
        for (int j = 0; j < 8; ++j) { const int i = f_tid + 512 * j, tok = i >> 6, c0 = (i & 63) * 8; const float r = rs[tok];
            float v[8];
#pragma unroll
            for (int e = 0; e < 8; ++e) v[e] = bf2f(T[(c0 + e) * 72 + tok]) * r * g[c0 + e];
            u32x4 w; w.x = cvt_pk_bf16(v[0], v[1]); w.y = cvt_pk_bf16(v[2], v[3]); w.z = cvt_pk_bf16(v[4], v[5]); w.w = cvt_pk_bf16(v[6], v[7]);
            *(u32x4*)(MIX + (size_t)(tok0 + tok) * DM + 512 + c0) = w; }
    }
}

__device__ __forceinline__ void p4_stub(Frame& F) {
    FT_DECL;
    bf16_t* MIX = WSP(bf16_t, WS_MIX);
    const size_t gt = (size_t)F.vcu * 512 + f_tid, NT = (size_t)F.G * 512;
    for (size_t i = gt; i < (size_t)MROWS * 64; i += NT) { const size_t row = i >> 6, ch = i & 63; *(u32x4*)(MIX + row * DM + 512 + ch * 8) = (u32x4){0u, 0u, 0u, 0u}; }
}


constexpr size_t RT_TOPI = 0;
constexpr size_t RT_GATE = 512 * 1024;
constexpr size_t RT_POS = 1024 * 1024;
constexpr size_t RT_WGCNT = 1536 * 1024;
constexpr size_t RT_META = 1600 * 1024;
constexpr size_t RT_LIST = 2048 * 1024;
constexpr size_t RT_GSLOT = 2048 * 1024 + 640 * 1024;
constexpr int MAXSLOT = MROWS * TOPK + NEXP * 256;
constexpr int MAXTILE = MAXSLOT / 256;
constexpr size_t WS_XS = WS_EO;
constexpr int RW_PITCH = 32;
constexpr int P6_LDS_TOPI = 1024 * RW_PITCH * 4;

__device__ __forceinline__ void p6_router(Frame& F) {
    FT_DECL;
#define in F.in
    LAS float* RW = (LAS float*)F.lds;
    LAS int* TI = (LAS int*)(F.lds + P6_LDS_TOPI);
    LAS int* PS = TI + 512;
    LAS int* SC = PS + 512;
    const float* rw = in[28];
    for (int i = f_tid; i < 1024 * 8; i += 512) { const int k = i >> 3, c4 = i & 7; const f32x4 v = *(const f32x4*)(rw + (size_t)k * 32 + c4 * 4);
        const int pi = (k & 3) * 256 + (k >> 2); *(LAS f32x4*)(RW + pi * RW_PITCH + ((c4 ^ ((pi >> 1) & 7)) * 4)) = v; }
    __syncthreads();
    const float* mod = WSP(float, WS_SMALL + SM_MOD); const float* g2n = in[7]; const float* rb = in[29];
    unsigned char* H2 = WSP(unsigned char, WS_H);
    int* topi_g = WSP(int, WS_ROUTE + RT_TOPI); float* gate_g = WSP(float, WS_ROUTE + RT_GATE); int* pos_g = WSP(int, WS_ROUTE + RT_POS); int* wgcnt = WSP(int, WS_ROUTE + RT_WGCNT);
    const int lane = f_lane;
    for (int blk = blockIdx.x; blk < MROWS / 128; blk += F.G) {
        for (int it = 0; it < 8; ++it) {
            const int rl = F.wave * 16 + 2 * it, r0 = blk * 128 + rl;
            const float* sh2 = mod + (size_t)(r0 >> 12) * (NMOD * DM) + 3 * DM; const float* sc2 = sh2 + DM;
            f32x4 h[2][4];
#pragma unroll
            for (int rr = 0; rr < 2; ++rr) {
                const GAS u32x2* xr = (const GAS u32x2*)(WSP(bf16_t, WS_XN) + (size_t)(r0 + rr) * DM) + lane; float ss = 0.f;
#pragma unroll
                for (int j = 0; j < 4; ++j) { const u32x2 xb = xr[64 * j]; h[rr][j] = (f32x4){__uint_as_float(xb.x << 16), __uint_as_float(xb.x & 0xffff0000u), __uint_as_float(xb.y << 16), __uint_as_float(xb.y & 0xffff0000u)}; ss += (h[rr][j].x * h[rr][j].x + h[rr][j].y * h[rr][j].y) + (h[rr][j].z * h[rr][j].z + h[rr][j].w * h[rr][j].w); }
                const float rstd = rsqrtf(wave_sum(ss) * (1.f / DM) + EPS);
                GAS unsigned* o4 = (GAS unsigned*)(H2 + (size_t)(r0 + rr) * DM) + lane;
#pragma unroll
                for (int j = 0; j < 4; ++j) { const int c = 4 * lane + 256 * j;
                    const f32x4 g = *(const f32x4*)(g2n + c), a = *(const f32x4*)(sc2 + c), b = *(const f32x4*)(sh2 + c);
                    h[rr][j] = h[rr][j] * rstd * g * (a + 1.f) + b;
                    o4[64 * j] = pk4_fp8(h[rr][j].x, h[rr][j].y, h[rr][j].z, h[rr][j].w); }
            }
            float a0[32], a1[32]; int lb = lane; asm volatile("" : "+v"(lb)); const int sw = (lb >> 1) & 7;
#pragma unroll
            for (int e = 0; e < 32; ++e) { a0[e] = 0.f; a1[e] = 0.f; }
            unsigned pb[8];
#pragma unroll
            for (int c = 0; c < 8; ++c) { pb[c] = (unsigned)(uintptr_t)RW + (unsigned)lb * 128u + (unsigned)((c ^ sw) * 16); asm volatile("" : "+v"(pb[c])); }
            f32x4 wb[2][4];
#define P6_OFF(hs) ((((((hs) >> 1) & 3) * 256 + 64 * ((hs) >> 3)) * 128) & 65535)
#define P6_HI(hs) ((((((hs) >> 1) & 3) * 256 + 64 * ((hs) >> 3)) * 128) >> 16)
#define P6_LOADW(buf, hs) _Pragma("unroll") for (int c = 0; c < 4; ++c) wb[buf][c] = *(const LAS f32x4*)(uintptr_t)(pb[4 * ((hs) & 1) + c] + (unsigned)(P6_HI(hs) * 65536 + P6_OFF(hs)))
#define P6_FMA(buf, hs) do { const float x0 = h[0][(hs) >> 3][((hs) >> 1) & 3], x1 = h[1][(hs) >> 3][((hs) >> 1) & 3]; _Pragma("unroll") for (int c = 0; c < 4; ++c) _Pragma("unroll") for (int e = 0; e < 4; ++e) { \
                a0[16 * ((hs) & 1) + 4 * c + e] += x0 * wb[buf][c][e]; a1[16 * ((hs) & 1) + 4 * c + e] += x1 * wb[buf][c][e]; } } while (0)
            P6_LOADW(0, 0);
#pragma unroll
            for (int hs = 0; hs < 32; hs += 2) {
                P6_LOADW(1, hs + 1); __builtin_amdgcn_sched_barrier(0); asm volatile("s_waitcnt lgkmcnt(4)" ::: "memory"); __builtin_amdgcn_sched_barrier(0);
                P6_FMA(0, hs); __builtin_amdgcn_sched_barrier(0);
                if (hs + 2 < 32) { P6_LOADW(0, hs + 2); __builtin_amdgcn_sched_barrier(0); asm volatile("s_waitcnt lgkmcnt(4)" ::: "memory"); } else { asm volatile("s_waitcnt lgkmcnt(0)" ::: "memory"); }
                __builtin_amdgcn_sched_barrier(0);
                P6_FMA(1, hs + 1); __builtin_amdgcn_sched_barrier(0);
            }
#undef P6_LOADW
#undef P6_FMA
#undef P6_OFF
#undef P6_HI
#define RS_STEP(A, CNT, MASK) _Pragma("unroll") for (int i = 0; i < CNT; ++i) { const bool up = (lane & MASK) != 0; const float send = up ? A[i] : A[CNT + i]; const float keep = up ? A[CNT + i] : A[i]; A[i] = keep + __shfl_xor(send, MASK); }
            RS_STEP(a0, 16, 32) RS_STEP(a0, 8, 16) RS_STEP(a0, 4, 8) RS_STEP(a0, 2, 4) RS_STEP(a0, 1, 2)
            RS_STEP(a1, 16, 32) RS_STEP(a1, 8, 16) RS_STEP(a1, 4, 8) RS_STEP(a1, 2, 4) RS_STEP(a1, 1, 2)
#undef RS_STEP
            const int me = lane >> 1; const float bias = rb[me];
            float lg[2]; lg[0] = a0[0] + __shfl_xor(a0[0], 1) + bias; lg[1] = a1[0] + __shfl_xor(a1[0], 1) + bias;
            LAS float* WL = (LAS float*)(F.lds + P6_LDS_TOPI + 6144) + F.wave * 96;
            if ((lane & 1) == 0) { WL[me] = lg[0]; WL[32 + me] = lg[1]; }
            LDS_WAIT(); asm volatile("" ::: "memory");
#pragma unroll
            for (int rr = 0; rr < 2; ++rr) {
                const float v = lg[rr]; int rank = 0;
#pragma unroll
                for (int c4 = 0; c4 < 8; ++c4) { const f32x4 o = *(const LAS f32x4*)(WL + rr * 32 + 4 * c4);
#pragma unroll
                    for (int e = 0; e < 4; ++e) { const int oe = 4 * c4 + e; rank += (o[e] > v || (o[e] == v && oe < me)) ? 1 : 0; } }
                if ((lane & 1) == 0 && rank < 4) { WL[64 + rr * 4 + rank] = v; ((LAS int*)WL)[72 + rr * 4 + rank] = me; }
            }
            LDS_WAIT(); asm volatile("" ::: "memory");
            if (lane < 2) { const int rr = lane; const f32x4 tv = *(const LAS f32x4*)(WL + 64 + rr * 4); typedef int i32x4_t __attribute__((ext_vector_type(4))); const i32x4_t ti = *(const LAS i32x4_t*)((LAS int*)WL + 72 + rr * 4);
                const float e1 = __expf(tv[1] - tv[0]), e2 = __expf(tv[2] - tv[0]), e3 = __expf(tv[3] - tv[0]); const float inv = 1.f / (1.f + e1 + e2 + e3);
                const int r = r0 + rr;
                *(i32x4_t*)(topi_g + (size_t)r * 4) = ti;
                *(f32x4*)(gate_g + (size_t)r * 4) = (f32x4){inv, e1 * inv, e2 * inv, e3 * inv};
                *(LAS i32x4_t*)(TI + (rl + rr) * 4) = ti; }
            LDS_WAIT(); asm volatile("" ::: "memory");
        }
        __syncthreads();
        { const int t2 = F.wave * 64 + lane_id(); const int e = t2 & 31, seg = t2 >> 5; int cnt = 0;
#pragma unroll 4
            for (int i = 0; i < 32; ++i) cnt += (TI[seg * 32 + i] == e) ? 1 : 0;
            SC[seg * 32 + e] = cnt;
            __syncthreads();
            int pre = 0;
            for (int s2 = 0; s2 < seg; ++s2) pre += SC[s2 * 32 + e];
            if (seg == 15) wgcnt[blk * 32 + e] = pre + cnt;
            for (int i = 0; i < 32; ++i) if (TI[seg * 32 + i] == e) { PS[seg * 32 + i] = pre; ++pre; }
        }
        __syncthreads();
        { const int t3 = F.wave * 64 + lane_id(); pos_g[(size_t)blk * 512 + t3] = PS[t3]; }
        __syncthreads();
    }
#undef in
}


__device__ __forceinline__ void p6_router_mfma(Frame& F) {
    FT_DECL;
#define in F.in
    LAS float* WP = (LAS float*)F.lds;
    LAS int* TI = (LAS int*)(F.lds + P6_LDS_TOPI);
    LAS int* PS = TI + 512;
    LAS int* SC = PS + 512;
    LAS float* RSTD = (LAS float*)(SC + 512);
    LAS float* BIAS = RSTD + 128;
    LAS float* SSX = BIAS + 32;
    const float* rw = in[28]; const float* mod = WSP(float, WS_SMALL + SM_MOD); const float* g2n = in[7]; const float* rb = in[29];
    const bf16_t* XN = WSP(bf16_t, WS_XN); unsigned char* H2 = WSP(unsigned char, WS_H);
    int* topi_g = WSP(int, WS_ROUTE + RT_TOPI); float* gate_g = WSP(float, WS_ROUTE + RT_GATE); int* pos_g = WSP(int, WS_ROUTE + RT_POS); int* wgcnt = WSP(int, WS_ROUTE + RT_WGCNT);
    for (int blk = blockIdx.x; blk < MROWS / 128; blk += F.G) {
        const float* sh2 = mod + (size_t)(blk >> 5) * (NMOD * DM) + 3 * DM; const float* sc2 = sh2 + DM;
        __syncthreads();
        for (int i = f_tid; i < 1024 * 8; i += 512) { const int k = i >> 3, c4 = i & 7; const float gm = g2n[k] * (1.f + sc2[k]);
            *(LAS f32x4*)(WP + k * 32 + c4 * 4) = *(const f32x4*)(rw + (size_t)k * 32 + c4 * 4) * gm; }
        { const int e = f_tid & 31, part = f_tid >> 5; float a = 0.f;
            for (int k = part * 64; k < part * 64 + 64; ++k) a += sh2[k] * rw[(size_t)k * 32 + e];
            ((LAS float*)SC)[part * 32 + e] = a; }
        __syncthreads();
        if (f_tid < 32) { float a = rb[f_tid];
#pragma unroll
            for (int p = 0; p < 16; ++p) a += ((LAS float*)SC)[p * 32 + f_tid];
            BIAS[f_tid] = a; }
        const int rg = F.wave & 3, kh = F.wave >> 2, j = f_lane & 31, hi = f_lane >> 5;
        f32x16 acc = {};
        float ss = 0.f;
        { const bf16_t* xrow = XN + (size_t)(blk * 128 + rg * 32 + j) * DM + 512 * kh + 8 * hi;
            const LAS float* wp = WP + (512 * kh + 8 * hi) * 32 + j;
#pragma unroll 4
            for (int c = 0; c < 32; ++c) { const u32x4 xb = *(const u32x4*)(xrow + 16 * c);
                float xf[8] = {__uint_as_float(xb.x << 16), __uint_as_float(xb.x & 0xffff0000u), __uint_as_float(xb.y << 16), __uint_as_float(xb.y & 0xffff0000u),
                               __uint_as_float(xb.z << 16), __uint_as_float(xb.z & 0xffff0000u), __uint_as_float(xb.w << 16), __uint_as_float(xb.w & 0xffff0000u)};
#pragma unroll
                for (int q = 0; q < 8; ++q) { ss += xf[q] * xf[q]; acc = __builtin_amdgcn_mfma_f32_32x32x2f32(wp[(16 * c + q) * 32], xf[q], acc, 0, 0, 0); } } }
        { auto rr = __builtin_amdgcn_permlane32_swap(__float_as_uint(ss), __float_as_uint(ss), false, false); ss = __uint_as_float(rr[0]) + __uint_as_float(rr[1]); }
        if (hi == 0) SSX[kh * 128 + rg * 32 + j] = ss;
        __syncthreads();
        if (kh == 1) {
#pragma unroll
            for (int r = 0; r < 16; ++r) WP[(rg * 16 + r) * 64 + f_lane] = acc[r]; }
        if (f_tid < 128) RSTD[f_tid] = rsqrtf((SSX[f_tid] + SSX[128 + f_tid]) * (1.f / DM) + EPS);
        __syncthreads();
        if (kh == 0) {
            const float rstd = RSTD[rg * 32 + j];
            float tv[4] = {-INFINITY, -INFINITY, -INFINITY, -INFINITY}; int ti[4] = {1 << 20, 1 << 20, 1 << 20, 1 << 20};
#define P6_INS(V, E) do { float cv = (V); int ce = (E); _Pragma("unroll") for (int q = 0; q < 4; ++q) { const bool b = cv > tv[q] || (cv == tv[q] && ce < ti[q]); \
                const float nv = b ? tv[q] : cv; const int ne = b ? ti[q] : ce; tv[q] = b ? cv : tv[q]; ti[q] = b ? ce : ti[q]; cv = nv; ce = ne; } } while (0)
#pragma unroll
            for (int r = 0; r < 16; ++r) { const int e = (r & 3) + 8 * (r >> 2) + 4 * hi; const float v = (acc[r] + WP[(rg * 16 + r) * 64 + f_lane]) * rstd + BIAS[e]; P6_INS(v, e); }
            float ov[4]; int oe[4];
#pragma unroll
            for (int q = 0; q < 4; ++q) { ov[q] = __shfl_xor(tv[q], 32); oe[q] = __shfl_xor(ti[q], 32); }
#pragma unroll
            for (int q = 0; q < 4; ++q) P6_INS(ov[q], oe[q]);
#undef P6_INS
            if (hi == 0) { const int rl = rg * 32 + j, r = blk * 128 + rl;
                const float e1 = __expf(tv[1] - tv[0]), e2 = __expf(tv[2] - tv[0]), e3 = __expf(tv[3] - tv[0]); const float inv = 1.f / (1.f + e1 + e2 + e3);
                typedef int i32x4_t __attribute__((ext_vector_type(4))); const i32x4_t t4 = {ti[0], ti[1], ti[2], ti[3]};
                *(i32x4_t*)(topi_g + (size_t)r * 4) = t4; *(f32x4*)(gate_g + (size_t)r * 4) = (f32x4){inv, e1 * inv, e2 * inv, e3 * inv};
                *(LAS i32x4_t*)(TI + rl * 4) = t4; }
        }
        __syncthreads();
        { const int t2 = F.wave * 64 + lane_id(); const int e = t2 & 31, seg = t2 >> 5; int cnt = 0;
#pragma unroll 4
            for (int i = 0; i < 32; ++i) cnt += (TI[seg * 32 + i] == e) ? 1 : 0;
            SC[seg * 32 + e] = cnt;
            __syncthreads();
            int pre = 0;
            for (int s2 = 0; s2 < seg; ++s2) pre += SC[s2 * 32 + e];
            if (seg == 15) wgcnt[blk * 32 + e] = pre + cnt;
            for (int i = 0; i < 32; ++i) if (TI[seg * 32 + i] == e) { PS[seg * 32 + i] = pre; ++pre; }
        }
        __syncthreads();
        { const int t3 = F.wave * 64 + lane_id(); pos_g[(size_t)blk * 512 + t3] = PS[t3]; }
        { const int lane = lane_id();
            for (int it = 0; it < 4; ++it) { u32x2 xb[4][4];
#pragma unroll
                for (int u = 0; u < 4; ++u) { const GAS u32x2* xr = (const GAS u32x2*)(XN + (size_t)(blk * 128 + F.wave * 16 + 4 * it + u) * DM) + lane;
#pragma unroll
                    for (int jj = 0; jj < 4; ++jj) xb[u][jj] = xr[64 * jj]; }
#pragma unroll
                for (int u = 0; u < 4; ++u) { const int rl = F.wave * 16 + 4 * it + u; const float rstd = RSTD[rl];
                    GAS unsigned* o4 = (GAS unsigned*)(H2 + (size_t)(blk * 128 + rl) * DM) + lane;
#pragma unroll
                    for (int jj = 0; jj < 4; ++jj) { const int c = 4 * lane + 256 * jj;
                        const f32x4 x = (f32x4){__uint_as_float(xb[u][jj].x << 16), __uint_as_float(xb[u][jj].x & 0xffff0000u), __uint_as_float(xb[u][jj].y << 16), __uint_as_float(xb[u][jj].y & 0xffff0000u)};
                        const f32x4 g = *(const f32x4*)(g2n + c), a = *(const f32x4*)(sc2 + c), b = *(const f32x4*)(sh2 + c);
                        const f32x4 h = x * rstd * g * (a + 1.f) + b;
                        o4[64 * jj] = pk4_fp8(h.x, h.y, h.z, h.w); } } }
        }
    }
#undef in
}

__device__ __forceinline__ void p7_scatter(Frame& F) {
    FT_DECL;
    LAS int* TOT = (LAS int*)F.lds;
    LAS int* BASE = TOT + 32;
    LAS int* PRE = BASE + 32;
    LAS int* PART = PRE + 32;
    const int* wgcnt = WSP(int, WS_ROUTE + RT_WGCNT); const int* topi_g = WSP(int, WS_ROUTE + RT_TOPI); const float* gate_g = WSP(float, WS_ROUTE + RT_GATE); const int* pos_g = WSP(int, WS_ROUTE + RT_POS);
    int* list = WSP(int, WS_ROUTE + RT_LIST); float* gslot = WSP(float, WS_ROUTE + RT_GSLOT); int* meta = WSP(int, WS_ROUTE + RT_META);
    const unsigned char* H2 = WSP(unsigned char, WS_H); unsigned char* XS = WSP(unsigned char, WS_XS);
    for (int blk = blockIdx.x; blk < MROWS / 128; blk += F.G) {
        __syncthreads();
        { const int e = f_tid & 31, part = f_tid >> 5; int st = 0, sp = 0;
            for (int w = part * 16; w < part * 16 + 16; ++w) { const int c = wgcnt[w * 32 + e]; st += c; if (w < blk) sp += c; }
            PART[part * 32 + e] = st; PART[512 + part * 32 + e] = sp; }
        __syncthreads();
        if (f_tid < 32) { int st = 0, sp = 0;
#pragma unroll
            for (int p = 0; p < 16; ++p) { st += PART[p * 32 + f_tid]; sp += PART[512 + p * 32 + f_tid]; }
            TOT[f_tid] = st; PRE[f_tid] = sp; }
        __syncthreads();
        if (f_tid == 0) { int b = 0; for (int e = 0; e < 32; ++e) { BASE[e] = b; b += (TOT[e] + 255) & ~255; }
            if (blk == 0) { int t = 0; for (int e = 0; e < 32; ++e) { meta[e] = TOT[e]; meta[32 + e] = BASE[e]; const int nt = (TOT[e] + 255) >> 8; for (int q = 0; q < nt; ++q) meta[128 + t + q] = e; t += nt; } meta[64] = t; } }
        __syncthreads();
        { const int a = f_tid, row = blk * 128 + (a >> 2); const int e = topi_g[(size_t)blk * 512 + a]; const int slot = BASE[e] + PRE[e] + pos_g[(size_t)blk * 512 + a];
            list[slot] = row * 4 + (a & 3); gslot[slot] = gate_g[(size_t)blk * 512 + a];
            PART[a] = slot; }
        __syncthreads();
        for (int a0 = F.wave * 8; a0 < 512; a0 += NWAVES * 8) { u32x4 v[8]; int sl[8];
#pragma unroll
            for (int q = 0; q < 8; ++q) { const int a = a0 + q; sl[q] = PART[a]; v[q] = ((const GAS u32x4*)(H2 + (size_t)(blk * 128 + (a >> 2)) * DM))[f_lane]; }
#pragma unroll
            for (int q = 0; q < 8; ++q) ((GAS u32x4*)(XS + (size_t)sl[q] * DM))[f_lane] = v[q]; }
        if (blk < NEXP) { const int e = blk, lo = BASE[e] + TOT[e], hi = BASE[e] + ((TOT[e] + 255) & ~255);
            for (int sl = lo + F.wave; sl < hi; sl += NWAVES) { if (f_lane == 0) { list[sl] = -1; gslot[sl] = 0.f; }
                ((GAS u32x4*)(XS + (size_t)sl * DM))[f_lane] = (u32x4){0u, 0u, 0u, 0u}; } }
    }
}

template <int NPN> struct SchedMoE {
    int G, c, nT; const char* A; const char* W; size_t wstride; const LAS unsigned char* tileE;
    __device__ __forceinline__ bool next(int i, g8::Unit& u) const {
        const int L = i * G + c, xcd = L & 7, j = L >> 3, T = (j / NPN) * 8 + xcd, pn = j % NPN;
        if (T >= nT) return false;
        const int e = tileE[T];
        u.pm = T; u.pn = pn; u.kind = i; u.ex = e; u.a = A + (size_t)T * 256 * DM; u.b = W + (size_t)e * wstride + (size_t)pn * 256 * DM; return true;
    }
};
struct EpiSwiGLU {
    unsigned char* ACT; const float* b1;
    __device__ __forceinline__ void operator()(f32x4 (&acc)[2][2][4][2], const g8::Unit& u, int wr, int wc, int fr, int fq) const {
        asm volatile("" : "+v"(fr), "+v"(fq));
        const int j0 = u.pn * 128 + wc * 32 + 8 * fq; const float* bp = b1 + (size_t)u.ex * 2 * DM + j0;
        f32x4 bg[2], bl[2];
#pragma unroll
        for (int n = 0; n < 2; ++n) { bg[n] = *(const f32x4*)(bp + 4 * n); bl[n] = *(const f32x4*)(bp + DM + 4 * n); }
#pragma unroll
        for (int ai = 0; ai < 2; ++ai)
#pragma unroll
            for (int m = 0; m < 4; ++m) { const size_t slot = (size_t)u.pm * 256 + ai * 128 + wr * 64 + m * 16 + fr; float o[8];
#pragma unroll
                for (int n = 0; n < 2; ++n) { const f32x4 g4 = acc[ai][0][m][n] * (1.f / WSCALE) + bg[n], l4 = acc[ai][1][m][n] * (1.f / WSCALE) + bl[n];
#pragma unroll
                    for (int e = 0; e < 4; ++e) { const float g = fminf(g4[e], 7.f), l = __builtin_amdgcn_fmed3f(l4[e], -7.f, 7.f);
                        const float ex = __builtin_amdgcn_exp2f(g * (-1.702f * 1.4426950408889634f)); const float glu = g * __builtin_amdgcn_rcpf(1.f + ex);
                        o[4 * n + e] = fmaf(l, glu, glu); } }
                u32x2 w; w.x = pk4_fp8(o[0], o[1], o[2], o[3]); w.y = pk4_fp8(o[4], o[5], o[6], o[7]);
                *(u32x2*)(ACT + slot * DM + j0) = w; }
    }
};
struct EpiDown {
    unsigned char* EO; const float* b2; const LAS int* LL; int G, c;
    __device__ __forceinline__ void operator()(f32x4 (&acc)[2][2][4][2], const g8::Unit& u, int wr, int wc, int fr, int fq) const {
        asm volatile("" : "+v"(fr), "+v"(fq));
        const int c0 = u.pn * 256 + wc * 32 + 8 * fq; const float* bp = b2 + (size_t)u.ex * DM + c0;
        f32x4 bb[2][2];
#pragma unroll
        for (int bj = 0; bj < 2; ++bj)
#pragma unroll
            for (int n = 0; n < 2; ++n) bb[bj][n] = *(const f32x4*)(bp + bj * 128 + 4 * n);
        const LAS int* L = LL + u.kind * 512;
        int li[8]; float gt[8];
#pragma unroll
        for (int q = 0; q < 8; ++q) { const int rl = (q >> 2) * 128 + wr * 64 + (q & 3) * 16 + fr; li[q] = L[rl]; gt[q] = __int_as_float(L[256 + rl]) * (1.f / WSCALE); }
#pragma unroll
        for (int ai = 0; ai < 2; ++ai)
#pragma unroll
            for (int m = 0; m < 4; ++m) { const int l = li[ai * 4 + m]; const float g = gt[ai * 4 + m];
                unsigned char* dst = EO + ((size_t)(l & 3) * MROWS + (l >> 2)) * DM + c0;
                u32x2 w[2];
#pragma unroll
                for (int bj = 0; bj < 2; ++bj) { const f32x4 v0 = acc[ai][bj][m][0] * g + bb[bj][0] * (g * WSCALE), v1 = acc[ai][bj][m][1] * g + bb[bj][1] * (g * WSCALE);
                    w[bj].x = pk4_fp8(v0[0] * EOSCALE, v0[1] * EOSCALE, v0[2] * EOSCALE, v0[3] * EOSCALE); w[bj].y = pk4_fp8(v1[0] * EOSCALE, v1[1] * EOSCALE, v1[2] * EOSCALE, v1[3] * EOSCALE); }
                if (l >= 0) { *(u32x2*)dst = w[0]; *(u32x2*)(dst + 128) = w[1]; } }
    }
};
__device__ __forceinline__ const LAS unsigned char* moe_tiles(Frame& F, int& nT) {
    FT_DECL;
    LAS unsigned char* TE = (LAS unsigned char*)(F.lds + RING_BYTES); const int* meta = WSP(int, WS_ROUTE + RT_META);
    __syncthreads();
    nT = meta[64]; if (nT > MAXTILE) nT = MAXTILE;
    for (int i = f_tid; i < MAXTILE; i += 512) TE[i] = (unsigned char)((i < nT) ? meta[128 + i] : 0);
    __syncthreads();
    return (const LAS unsigned char*)TE;
}

__device__ __forceinline__ void p10_combine(Frame& F) {
    FT_DECL;
    const float* mod = WSP(float, WS_SMALL + SM_MOD); const unsigned char* EO = WSP(unsigned char, WS_EO);
    const size_t gt = (size_t)F.vcu * 512 + f_tid, NTH = (size_t)F.G * 512;
    float pd = 0.f, pa = 0.f;
    if (MK_PROBE_A != -2) { const unsigned long long* st = (const unsigned long long*)(F.ws + WS_CTL + 8192);
        pd = (MK_PROBE_A < 0) ? 0.1f : (float)(st[MK_PA1] - st[MK_PA0]) * MK_PSA; pa = (float)(st[MK_PB1] - st[MK_PB0]) * MK_PSB; }
    constexpr int U = 4;
    for (size_t i0 = gt; i0 < (size_t)MROWS * 128; i0 += NTH * U) {
        u32x2 ev[U][4]; f32x4 xv[U][2], gv[U][2];
#pragma unroll
        for (int u = 0; u < U; ++u) { const size_t i = i0 + (size_t)u * NTH; const size_t row = i >> 7; const int c0 = (int)(i & 127) * 8;
            const float* g2 = mod + (size_t)(row >> 12) * (NMOD * DM) + 5 * DM + c0; const bf16_t* op = WSP(bf16_t, WS_XN) + row * DM + c0;
#pragma unroll
            for (int k = 0; k < 4; ++k) ev[u][k] = __builtin_nontemporal_load((const u32x2*)(EO + ((size_t)k * MROWS + row) * DM + c0));
            { const u32x4 xb = *(const u32x4*)op; xv[u][0] = (f32x4){__uint_as_float(xb.x << 16), __uint_as_float(xb.x & 0xffff0000u), __uint_as_float(xb.y << 16), __uint_as_float(xb.y & 0xffff0000u)};
              xv[u][1] = (f32x4){__uint_as_float(xb.z << 16), __uint_as_float(xb.z & 0xffff0000u), __uint_as_float(xb.w << 16), __uint_as_float(xb.w & 0xffff0000u)}; }
            gv[u][0] = *(const f32x4*)g2; gv[u][1] = *(const f32x4*)(g2 + 4); }
#pragma unroll
        for (int u = 0; u < U; ++u) { const size_t i = i0 + (size_t)u * NTH; const size_t row = i >> 7; const int c0 = (int)(i & 127) * 8;
            float s[8];
#pragma unroll
            for (int e = 0; e < 8; ++e) s[e] = 0.f;
#pragma unroll
            for (int k = 0; k < 4; ++k) { const u32x2 v = ev[u][k];
                const f32x2 a = __builtin_amdgcn_cvt_pk_f32_fp8((int)v.x, false), b = __builtin_amdgcn_cvt_pk_f32_fp8((int)v.x, true), c = __builtin_amdgcn_cvt_pk_f32_fp8((int)v.y, false), d = __builtin_amdgcn_cvt_pk_f32_fp8((int)v.y, true);
                s[0] += a.x; s[1] += a.y; s[2] += b.x; s[3] += b.y; s[4] += c.x; s[5] += c.y; s[6] += d.x; s[7] += d.y; }
#pragma unroll
            for (int e = 0; e < 8; ++e) s[e] *= (1.f / EOSCALE);
            f32x4 o0 = xv[u][0] + gv[u][0] * (f32x4){s[0], s[1], s[2], s[3]}, o1 = xv[u][1] + gv[u][1] * (f32x4){s[4], s[5], s[6], s[7]};
            if (MK_PROBE_A != -2) { o0 += pd; o1 += pd; if (i == 0) o0[0] += pa; }
            float* op = F.out + row * DM + c0;
            __builtin_nontemporal_store(o0, (f32x4*)op); __builtin_nontemporal_store(o1, (f32x4*)(op + 4)); }
    }
}

struct Args { const float* in[34]; float* out; unsigned char* ws; int ph_lo, ph_hi; };
constexpr int N_PHASES = 11;

__global__ void __launch_bounds__(512, 2) mega(Args args) {
    extern __shared__ __attribute__((aligned(16))) unsigned char lds[];
    Frame F;
    F.lds = (LAS unsigned char*)lds;
    F.MISC = (volatile LAS unsigned*)(F.lds + LDSCTL_OFF);
    F.wave = __builtin_amdgcn_readfirstlane(threadIdx.x >> 6);
    FT_DECL;
    F.G = gridDim.x; { const int bx = blockIdx.x; F.vcu = (F.G % 8 == 0) ? (bx % 8) * (F.G / 8) + bx / 8 : bx; }
    F.in = (kin_t)__builtin_amdgcn_kernarg_segment_ptr();
    F.out = args.out; F.ws = args.ws;
    F.ctl = (gu32*)(args.ws + WS_CTL);
    for (int u = f_tid; u < (LDS_BYTES - LDSCTL_OFF) / 4; u += NWAVES * 64) ((LAS unsigned*)(F.lds + LDSCTL_OFF))[u] = 0u;
    __syncthreads();
    const int lo = args.ph_lo, hi = args.ph_hi;
    XcdBarrier bar; bar.bar = (unsigned*)(F.ctl + CW_BAR); bar.x = 0; bar.st = nullptr;
    if (hi - lo > 1) bar = xcd_barrier_post((unsigned*)(F.ctl + CW_BAR), F.MISC + 8, f_tid == 0);
#define IN(k) (lo <= (k) && (k) < hi)
    unsigned long long* stamps = (unsigned long long*)(args.ws + WS_CTL + 8192);
#define STAMP(k) do { if (MK_PROBE_A != -2 && blockIdx.x == 0 && f_tid == 0) stamps[(k)] = __builtin_amdgcn_s_memrealtime(); } while (0)
    STAMP(0);
#define SEAM(k) do { if (IN(k) && IN((k) + 1)) xcd_barrier(bar, F.wave == 0 && lane_id() == 0); } while (0)

    if (IN(0)) { p0_prologue(F); } SEAM(0); STAMP(1);
    if (IN(1)) { p1_norm1(F); } SEAM(1); STAMP(2);
    if (IN(2)) {
        SchedInProj S{F.G, (int)blockIdx.x, (const char*)WSP(bf16_t, WS_H), (const char*)WSP(bf16_t, WS_WIN)};
        EpiInProj E{WSP(bf16_t, WS_Q), WSP(bf16_t, WS_K), WSP(bf16_t, WS_V), WSP(bf16_t, WS_UT), F.in[9], F.in[10], WSP(float, WS_SMALL + SM_ROPE)};
        g8::gemm_phase<false>(F.lds, DM, S, E, F.wave, lane_id());
    } SEAM(2); STAMP(3);
    if (IN(3)) { p3_attention(F); STAMP(12); p3_hyena(F); } SEAM(3); STAMP(4);
    if (IN(4)) { p4_hynorm(F); } SEAM(4); STAMP(5);
    if (IN(5)) {
        SchedStatic S{F.G, (int)blockIdx.x, MROWS / 256, DM / 256, (const char*)WSP(bf16_t, WS_MIX), (const char*)WSP(bf16_t, WS_WOUT)};
        EpiOutProj E{F.in[0], WSP(bf16_t, WS_XN), WSP(float, WS_SMALL + SM_MOD)};
        g8::gemm_phase<false>(F.lds, DM, S, E, F.wave, lane_id());
    } SEAM(5); STAMP(6);
    if (IN(6)) { p6_router_mfma(F); } SEAM(6); STAMP(7);
    if (IN(7)) { p7_scatter(F); } SEAM(7); STAMP(8);
    if (IN(8)) {
        int nT; const LAS unsigned char* TE = moe_tiles(F, nT);
        SchedMoE<8> S{F.G, (int)blockIdx.x, nT, (const char*)WSP(char, WS_XS), (const char*)WSP(char, WS_W1), (size_t)2 * DM * DM, TE};
        EpiSwiGLU E{WSP(unsigned char, WS_ACT), F.in[31]};
        g8::gemm_phase<true>(F.lds, DM, S, E, F.wave, lane_id());
    } SEAM(8); STAMP(9);
    if (IN(9)) {
        int nT; const LAS unsigned char* TE = moe_tiles(F, nT);
        SchedMoE<4> S{F.G, (int)blockIdx.x, nT, (const char*)WSP(char, WS_ACT), (const char*)WSP(char, WS_W2), (size_t)DM * DM, TE};
        LAS int* LL = (LAS int*)(F.lds + RING_BYTES + 1024);
        static_assert(RING_BYTES + 1024 + 9 * 2048 <= LDSCTL_OFF, "LDS map");
        { const int* list = WSP(int, WS_ROUTE + RT_LIST); const float* gslot = WSP(float, WS_ROUTE + RT_GSLOT);
            const int t9 = F.wave * 64 + lane_id();
            g8::Unit u; for (int i = 0; i < 9 && S.next(i, u); ++i) { const int t = t9 & 255; const size_t slot = (size_t)u.pm * 256 + t;
                LL[i * 512 + (t9 >> 8) * 256 + t] = (t9 < 256) ? list[slot] : __float_as_int(gslot[slot]); }
            __syncthreads(); }
        EpiDown E{WSP(unsigned char, WS_EO), F.in[33], LL, F.G, (int)blockIdx.x};
        g8::gemm_phase<true>(F.lds, DM, S, E, F.wave, lane_id());
    } SEAM(9); STAMP(10);
    if (IN(10)) { p10_combine(F); }
#undef IN
#undef SEAM
}

extern "C" void kernel_launch(void* const* d_in, const int* in_sizes, int n_in, void* d_out, int out_size, void* d_ws, size_t ws_size, hipStream_t stream) {
    static int grid = 0;
    if (grid == 0) {
        if (n_in != 34 || out_size != MROWS * DM || ws_size < WS_END) { fprintf(stderr, "kernel_launch: unexpected shapes: n_in %d out %d ws %zu (need %zu)\n", n_in, out_size, ws_size, (size_t)WS_END); grid = -1; return; }
        int dev = 0, cus = 0, per_cu = 0;
        if (hipGetDevice(&dev) != hipSuccess || hipDeviceGetAttribute(&cus, hipDeviceAttributeMultiprocessorCount, dev) != hipSuccess) { grid = -1; return; }
        if (hipFuncSetAttribute((const void*)mega, hipFuncAttributeMaxDynamicSharedMemorySize, LDS_BYTES) != hipSuccess) { fprintf(stderr, "kernel_launch: hipFuncSetAttribute failed\n"); grid = -1; return; }
        if (hipOccupancyMaxActiveBlocksPerMultiprocessor(&per_cu, (const void*)mega, NWAVES * 64, LDS_BYTES) != hipSuccess || per_cu < 1) { fprintf(stderr, "kernel_launch: occupancy query says %d\n", per_cu); per_cu = 1; }
        (void)hipGetLastError();
        grid = cus;
    }
    if (grid < 0) return;
    (void)hipMemsetAsync((char*)d_ws + WS_CTL, 0, CTL_ZERO_BYTES, stream);
    Args a{};
    for (int i = 0; i < 34; ++i) a.in[i] = (const float*)d_in[i];
    a.out = (float*)d_out; a.ws = (unsigned char*)d_ws;
    constexpr int LAST = MK_LAST_PHASE + 1;
    if (MK_N_LAUNCHES == 1) { a.ph_lo = 0; a.ph_hi = LAST; hipLaunchKernelGGL(mega, dim3(grid), dim3(NWAVES * 64), LDS_BYTES, stream, a); }
    else for (int p = 0; p < LAST; ++p) { a.ph_lo = p; a.ph_hi = p + 1; hipLaunchKernelGGL(mega, dim3(grid), dim3(NWAVES * 64), LDS_BYTES, stream, a); }
    const hipError_t le = hipPeekAtLastError();
    if (le != hipSuccess) fprintf(stderr, "kernel_launch: launch failed: %s\n", hipGetErrorName(le));
}
```

```cpp
#include <hip/hip_runtime.h>
#include <hip/hip_bf16.h>
#include <cstdio>
#include <cstdint>

#ifndef MK_N_LAUNCHES
#define MK_N_LAUNCHES 1
#endif
#ifndef MK_PROBE_A
#define MK_PROBE_A -2
#endif
#ifndef MK_PA0
#define MK_PA0 0
#define MK_PA1 1
#define MK_PB0 0
#define MK_PB1 1
#define MK_PSA 2e-6f
#define MK_PSB 1e-4f
#endif
#ifndef MK_LAST_PHASE
#define MK_LAST_PHASE 10
#endif

#define GAS __attribute__((address_space(1)))
#define LAS __attribute__((address_space(3)))
typedef unsigned short bf16_t;
typedef short bf16x8 __attribute__((ext_vector_type(8)));
typedef short s16x4 __attribute__((ext_vector_type(4)));
typedef float f32x2 __attribute__((ext_vector_type(2)));
typedef float f32x4 __attribute__((ext_vector_type(4)));
typedef float f32x16 __attribute__((ext_vector_type(16)));
typedef unsigned u32x2 __attribute__((ext_vector_type(2)));
typedef unsigned u32x4 __attribute__((ext_vector_type(4)));
typedef GAS unsigned gu32;

constexpr int NB = 8, SEQ = 4096, DM = 1024, MROWS = NB * SEQ, CTXL = 256, MCTX = NB * CTXL, MTOT = MROWS + MCTX;
constexpr int KVL = CTXL + SEQ;
constexpr int NHEAD = 4, QKW = 512;
constexpr int HYW = 512, HYC = 1536, INC = 3072, QKVC = 1536;
constexpr int NEXP = 32, TOPK = 4, NMOD = 6;
constexpr float EPS = 1e-6f;
constexpr float LAM_INIT = 0.2f;
constexpr float QSCALE = 0.125f * 1.4426950408889634f;

constexpr size_t MiB = 1u << 20;
constexpr size_t WS_CTL = 0, CTL_ZERO_BYTES = 1 * MiB;
constexpr size_t WS_SMALL = 1 * MiB;
constexpr size_t WS_WIN = 2 * MiB;
constexpr size_t WS_WOUT = 8 * MiB;
constexpr size_t WS_W1 = 10 * MiB;
constexpr size_t WS_W2 = 138 * MiB;
constexpr size_t WS_H = 202 * MiB;
constexpr size_t WS_Q = 270 * MiB;
constexpr size_t WS_K = 302 * MiB;
constexpr size_t WS_V = 336 * MiB;
constexpr size_t WS_UT = 370 * MiB;
constexpr size_t WS_FILT = 466 * MiB;
constexpr size_t WS_Z2T = 498 * MiB;
constexpr size_t WS_MIX = 530 * MiB;
constexpr size_t WS_ROUTE = 594 * MiB;
constexpr size_t WS_ACT = 270 * MiB;
constexpr size_t WS_EO = 598 * MiB;
constexpr size_t WS_XN = 870 * MiB;
constexpr size_t WS_END = 998 * MiB;
constexpr size_t SM_MOD = 0;
constexpr size_t SM_SCAL = 256 * 1024;
constexpr size_t SM_ROPE = 260 * 1024;
constexpr int CW_BAR = 4096;

constexpr int RING_BYTES = 131072;
constexpr int LDSCTL_OFF = 151552;
constexpr int LDS_BYTES = 152576;
constexpr int NWAVES = 8;

#define LDS_WAIT() asm volatile("s_waitcnt lgkmcnt(0)" ::: "memory")
#define VM_WAIT() asm volatile("s_waitcnt vmcnt(0)" ::: "memory")
#define RLX_AGENT __ATOMIC_RELAXED, __HIP_MEMORY_SCOPE_AGENT

__device__ __forceinline__ unsigned cvt_pk_bf16(float lo, float hi) { unsigned r; asm volatile("v_cvt_pk_bf16_f32 %0, %1, %2" : "=v"(r) : "v"(lo), "v"(hi)); return r; }
__device__ __forceinline__ float bf2f(bf16_t v) { return __uint_as_float(((unsigned)v) << 16); }
__device__ __forceinline__ float wave_sum(float v) {
#pragma unroll
    for (int o = 1; o < 64; o <<= 1) v += __shfl_xor(v, o);
    return v;
}

#define XB_TMO      128
#define XB_XCNT(j)  (256  + 64 * (j))
#define XB_XSUB(j)  (1280 + 64 * (j))
#define XB_XGEN(j)  (2304 + 64 * (j))
#define XB_TOP      3328
#define XB_TOPGEN   3392
#define XCD_BAR_WORDS 3456
#define XB_SPIN_CAP (1u << 22)
__device__ __forceinline__ unsigned xb_ld(unsigned* p)              { return __hip_atomic_load(p, __ATOMIC_RELAXED, __HIP_MEMORY_SCOPE_AGENT); }
__device__ __forceinline__ unsigned xb_add(unsigned* p, unsigned v) { return __hip_atomic_fetch_add(p, v, __ATOMIC_RELAXED, __HIP_MEMORY_SCOPE_AGENT); }
__device__ __forceinline__ unsigned xb_xcc_id() { return (unsigned)__builtin_amdgcn_s_getreg((3 << 11) | 20) & 0xFu; }
#define XB_SPIN(cond, bar) do { unsigned _sp = 0; while (cond) { __builtin_amdgcn_s_sleep(1); \
    if ((++_sp & 255u) == 0u) { if (xb_ld(&(bar)[XB_TMO])) break; if (_sp > XB_SPIN_CAP) { atomicAdd(&(bar)[XB_TMO], 1u); break; } } } } while (0)
struct XcdBarrier { unsigned* bar; unsigned x; volatile LAS unsigned* st; };
__device__ __forceinline__ XcdBarrier xcd_barrier_post(unsigned* bar, volatile LAS unsigned* st, bool leader) {
    XcdBarrier b; b.bar = bar; b.x = xb_xcc_id(); b.st = st;
    if (leader) (void)xb_add(&bar[XB_XCNT(b.x)], 1u);
    return b;
}
__device__ __forceinline__ void xcd_barrier_complete(unsigned* bar, unsigned x, unsigned& nloc, unsigned& nx) {
    const unsigned G = gridDim.x * gridDim.y * gridDim.z;
    unsigned sum, cnt, mine, sp = 0u;
    for (;;) {
        sum = 0u; cnt = 0u; mine = 0u;
#pragma unroll
        for (unsigned j = 0; j < 16; ++j) { const unsigned c = xb_ld(&bar[XB_XCNT(j)]); sum += c; cnt += (c > 0u) ? 1u : 0u; mine = (j == x) ? c : mine; }
        if (sum == G) break;
        __builtin_amdgcn_s_sleep(1);
        if ((++sp & 255u) == 0u) { if (xb_ld(&bar[XB_TMO])) break; if (sp > XB_SPIN_CAP) { atomicAdd(&bar[XB_TMO], 1u); break; } }
    }
    nloc = mine > 0u ? mine : 1u; nx = cnt > 0u ? cnt : 1u;
}
__device__ __forceinline__ void xcd_barrier(const XcdBarrier& b, bool leader) {
    asm volatile("s_waitcnt vmcnt(0)" ::: "memory");
    __syncthreads();
    if (leader) {
        unsigned* bar = b.bar;
        __builtin_amdgcn_s_waitcnt(0);
        unsigned nloc = b.st[0], nx = b.st[1];
        if (nloc == 0u) { xcd_barrier_complete(bar, b.x, nloc, nx); b.st[0] = nloc; b.st[1] = nx; }
        const unsigned old = xb_add(&bar[XB_XSUB(b.x)], 1u);
        const unsigned gen = old / nloc;
        if (old + 1u == (gen + 1u) * nloc) {
            __builtin_amdgcn_fence(__ATOMIC_RELEASE, "agent");
            asm volatile("s_waitcnt vmcnt(0)" ::: "memory");
            const unsigned og = xb_add(&bar[XB_TOP], 1u);
            const unsigned tg = og / nx;
            if (og + 1u == (tg + 1u) * nx) xb_add(&bar[XB_TOPGEN], 1u);
            else XB_SPIN(xb_ld(&bar[XB_TOPGEN]) == tg, bar);
            __builtin_amdgcn_fence(__ATOMIC_ACQUIRE, "agent");
            xb_add(&bar[XB_XGEN(b.x)], 1u);
            asm volatile("s_waitcnt vmcnt(0)" ::: "memory");
        } else {
            XB_SPIN(xb_ld(&bar[XB_XGEN(b.x)]) == gen, bar);
            __builtin_amdgcn_fence(__ATOMIC_ACQUIRE, "agent");
            asm volatile("s_waitcnt vmcnt(0)" ::: "memory");
        }
    }
    __syncthreads();
}

namespace g8 {
constexpr int BM = 256, BK = 64, HALF = 128, HTB = HALF * BK * 2, STAGE_BYTES = 8 * HTB, NXCD = 8, WGM = 8;
__host__ __device__ __forceinline__ int lds_byte(int r, int c) { const int st = (r >> 4) * 2 + (c >> 5), rr = r & 15, cc = c & 31, ob = rr * 64 + cc * 2; return st * 1024 + (ob ^ (((ob >> 9) & 1) << 5)); }
__host__ __device__ __forceinline__ void stage_rc(int b, int& R, int& C) { const int st = b / 1024, sb = b % 1024, swz = sb ^ (((sb >> 9) & 1) << 5); R = (st >> 1) * 16 + swz / 64; C = (st & 1) * 32 + (swz % 64) / 2; }
__host__ __device__ __forceinline__ int perm32(int rho) { const int n = rho >> 4, i = rho & 15; return 8 * (i >> 2) + 4 * n + (i & 3); }

struct Unit { const char* a; const char* b; int pm, pn, kind, ex; };

__device__ __forceinline__ void tile_of(int L, int nM, int nN, int& pm, int& pn) {
    const int nwg = nM * nN; int wgid = L;
    { const int q = nwg / NXCD, r = nwg % NXCD, xcd = wgid % NXCD, off = wgid / NXCD; wgid = (xcd < r ? xcd * (q + 1) : r * (q + 1) + (xcd - r) * q) + off; }
    const int nig = WGM * nN, gid = wgid / nig, fm = gid * WGM, gsz = (nM - fm) < WGM ? (nM - fm) : WGM;
    pm = fm + ((wgid % nig) % gsz); pn = (wgid % nig) / gsz;
}

typedef int i32x8 __attribute__((ext_vector_type(8)));
template <bool FP8, class Epi, class Sched>
__device__ __forceinline__ void gemm_phase(LAS unsigned char* lds, const int K, const Sched& S, const Epi& E, const int wid, const int lane) {
    const int tid = wid * 64 + lane, wr = wid >> 2, wc = wid & 3, fr = lane & 15, fq = lane >> 4;
    const int nt = FP8 ? K / 128 : K / BK;
    const int RP = FP8 ? K : 2 * K;
    unsigned voffA[2], voffB[2];
#pragma unroll
    for (int i = 0; i < 2; ++i) { int R, C; stage_rc(tid * 16 + i * 8192, R, C); const int Rb = (R & ~31) + perm32(R & 31);
        voffA[i] = (unsigned)(R * RP + C * 2); voffB[i] = (unsigned)(Rb * RP + C * 2); }
    const size_t kstep = (size_t)(BK * 2);
    const size_t hstep = (size_t)HALF * RP;
    const unsigned ldsw = (unsigned)wid * 1024u;
    const int aoff = lds_byte(wr * 64 + fr, FP8 ? fq * 16 : fq * 8), boff = lds_byte(wc * 32 + fr, FP8 ? fq * 16 : fq * 8);
    constexpr int KOFF = FP8 ? 16 : 1024;
#define PG8_SA(b, h) (((b) * 2 + (h)) * HTB)
#define PG8_SB(b, h) ((4 + (b) * 2 + (h)) * HTB)
#define PG8_STAGE(bufoff, gbase, voff) do { _Pragma("unroll") for (int _i = 0; _i < 2; ++_i) \
        __builtin_amdgcn_global_load_lds((const unsigned*)((const char*)(gbase) + (voff)[_i]), (LAS unsigned*)(lds + (bufoff) + ldsw + _i * 8192), 16, 0, 0); } while (0)
#define PG8_LD32(p) __builtin_bit_cast(i32x8, __builtin_shufflevector(*(const LAS u32x4*)(p), *(const LAS u32x4*)((p) + 16), 0, 1, 2, 3, 4, 5, 6, 7))
#define PG8_LDA8(dst, b, h) do { _Pragma("unroll") for (int m = 0; m < 4; ++m) dst[m] = PG8_LD32(lds + PG8_SA(b, h) + aoff + m * 2048); } while (0)
#define PG8_LDB8(dst, b, h) do { _Pragma("unroll") for (int n = 0; n < 2; ++n) dst[n] = PG8_LD32(lds + PG8_SB(b, h) + boff + n * 2048); } while (0)
#define PG8_LDA(dst, b, h) do { _Pragma("unroll") for (int m = 0; m < 4; ++m) _Pragma("unroll") for (int k = 0; k < 2; ++k) dst[m][k] = *(const LAS bf16x8*)(lds + PG8_SA(b, h) + aoff + m * 2048 + k * KOFF); } while (0)
#define PG8_LDB(dst, b, h) do { _Pragma("unroll") for (int n = 0; n < 2; ++n) _Pragma("unroll") for (int k = 0; k < 2; ++k) dst[n][k] = *(const LAS bf16x8*)(lds + PG8_SB(b, h) + boff + n * 2048 + k * KOFF); } while (0)
#define PG8_MMA(ai, bj, At, Bt) do { __builtin_amdgcn_s_setprio(1); _Pragma("unroll") for (int m = 0; m < 4; ++m) _Pragma("unroll") for (int n = 0; n < 2; ++n) _Pragma("unroll") for (int k = 0; k < 2; ++k) \
        acc[ai][bj][m][n] = __builtin_amdgcn_mfma_f32_16x16x32_bf16(Bt[n][k], At[m][k], acc[ai][bj][m][n], 0, 0, 0); __builtin_amdgcn_s_setprio(0); } while (0)
#define PG8_MMA8(ai, bj, At, Bt) do { __builtin_amdgcn_s_setprio(1); _Pragma("unroll") for (int m = 0; m < 4; ++m) _Pragma("unroll") for (int n = 0; n < 2; ++n) \
        asm volatile("v_mfma_scale_f32_16x16x128_f8f6f4 %0, %1, %2, %0, %3, %3 op_sel_hi:[0,0,0]" : "+v"(acc[ai][bj][m][n]) : "v"(Bt[n]), "v"(At[m]), "v"(one_scale)); __builtin_amdgcn_s_setprio(0); } while (0)
#define PG8_WAIT_V(n) asm volatile("s_waitcnt vmcnt(" #n ")" ::: "memory")
#define PG8_WAIT_L(n) asm volatile("s_waitcnt lgkmcnt(" #n ")" ::: "memory")
#define PG8_BAR __builtin_amdgcn_s_barrier()
#define PG8_SCHED __builtin_amdgcn_sched_barrier(0)
    Unit cur, nxt; int ui = 0;
    if (!S.next(0, cur)) return;
    f32x4 acc[2][2][4][2];
#pragma unroll
    for (int a = 0; a < 2; ++a)
#pragma unroll
        for (int b = 0; b < 2; ++b)
#pragma unroll
            for (int m = 0; m < 4; ++m)
#pragma unroll
                for (int n = 0; n < 2; ++n) acc[a][b][m][n] = (f32x4){0.f, 0.f, 0.f, 0.f};
    bf16x8 At[4][2], B0[2][2], B1[2][2];
    i32x8 At8[4], B08[2], B18[2];
    const unsigned one_scale = 0x7f7f7f7fu;
    const char* cA = cur.a; const char* cB = cur.b;
    PG8_STAGE(PG8_SB(0, 0), cB, voffB); PG8_STAGE(PG8_SB(0, 1), cB + hstep, voffB); PG8_STAGE(PG8_SA(0, 0), cA, voffA); PG8_STAGE(PG8_SA(0, 1), cA + hstep, voffA);
    if (wr == 1) PG8_BAR;
    PG8_WAIT_V(2); PG8_BAR;
    PG8_STAGE(PG8_SB(1, 0), cB + kstep, voffB); PG8_STAGE(PG8_SA(1, 0), cA + kstep, voffA); PG8_STAGE(PG8_SB(1, 1), cB + hstep + kstep, voffB);
    PG8_WAIT_V(6); PG8_BAR;
    for (;;) {
        const bool has_next = S.next(ui + 1, nxt);
        const char* nA = has_next ? nxt.a : cA; const char* nB = has_next ? nxt.b : cB;
#pragma unroll 1
        for (int t = 0; t < nt; t += 2) {
            const bool last = (t == nt - 2);
            const char* a1 = cA + (size_t)(t + 1) * kstep;
            const char* a2 = last ? nA : cA + (size_t)(t + 2) * kstep; const char* b2 = last ? nB : cB + (size_t)(t + 2) * kstep;
            const char* a3 = a2 + kstep; const char* b3 = b2 + kstep;
            if constexpr (FP8) {
            PG8_LDB8(B08, 0, 0); PG8_LDB8(B18, 0, 1); PG8_SCHED; PG8_LDA8(At8, 0, 0); PG8_STAGE(PG8_SA(1, 1), a1 + hstep, voffA);
            PG8_WAIT_V(8); PG8_WAIT_L(0); PG8_BAR; PG8_MMA8(0, 0, At8, B08); PG8_MMA8(0, 1, At8, B18); PG8_BAR; PG8_SCHED;
            PG8_LDA8(At8, 0, 1); PG8_STAGE(PG8_SB(0, 0), b2, voffB); PG8_STAGE(PG8_SB(0, 1), b2 + hstep, voffB); PG8_STAGE(PG8_SA(0, 0), a2, voffA);
            PG8_WAIT_V(8); PG8_WAIT_L(0); PG8_BAR; PG8_MMA8(1, 0, At8, B08); PG8_MMA8(1, 1, At8, B18); PG8_BAR; PG8_SCHED;
            PG8_LDB8(B08, 1, 0); PG8_LDB8(B18, 1, 1); PG8_SCHED; PG8_LDA8(At8, 1, 0); PG8_STAGE(PG8_SA(0, 1), a2 + hstep, voffA);
            PG8_WAIT_V(8); PG8_WAIT_L(0); PG8_BAR; PG8_MMA8(0, 0, At8, B08); PG8_MMA8(0, 1, At8, B18); PG8_BAR; PG8_SCHED;
            PG8_LDA8(At8, 1, 1); PG8_STAGE(PG8_SB(1, 0), b3, voffB); PG8_STAGE(PG8_SB(1, 1), b3 + hstep, voffB); PG8_STAGE(PG8_SA(1, 0), a3, voffA);
            PG8_WAIT_V(8); PG8_WAIT_L(0); PG8_BAR; PG8_MMA8(1, 0, At8, B08); PG8_MMA8(1, 1, At8, B18); PG8_BAR; PG8_SCHED;
            } else {
            PG8_LDB(B0, 0, 0); PG8_LDB(B1, 0, 1); PG8_SCHED; PG8_LDA(At, 0, 0); PG8_STAGE(PG8_SA(1, 1), a1 + hstep, voffA);
            PG8_WAIT_V(8); PG8_WAIT_L(0); PG8_BAR; PG8_MMA(0, 0, At, B0); PG8_MMA(0, 1, At, B1); PG8_BAR; PG8_SCHED;
            PG8_LDA(At, 0, 1); PG8_STAGE(PG8_SB(0, 0), b2, voffB); PG8_STAGE(PG8_SB(0, 1), b2 + hstep, voffB); PG8_STAGE(PG8_SA(0, 0), a2, voffA);
            PG8_WAIT_V(8); PG8_WAIT_L(0); PG8_BAR; PG8_MMA(1, 0, At, B0); PG8_MMA(1, 1, At, B1); PG8_BAR; PG8_SCHED;
            PG8_LDB(B0, 1, 0); PG8_LDB(B1, 1, 1); PG8_SCHED; PG8_LDA(At, 1, 0); PG8_STAGE(PG8_SA(0, 1), a2 + hstep, voffA);
            PG8_WAIT_V(8); PG8_WAIT_L(0); PG8_BAR; PG8_MMA(0, 0, At, B0); PG8_MMA(0, 1, At, B1); PG8_BAR; PG8_SCHED;
            PG8_LDA(At, 1, 1); PG8_STAGE(PG8_SB(1, 0), b3, voffB); PG8_STAGE(PG8_SB(1, 1), b3 + hstep, voffB); PG8_STAGE(PG8_SA(1, 0), a3, voffA);
            PG8_WAIT_V(8); PG8_WAIT_L(0); PG8_BAR; PG8_MMA(1, 0, At, B0); PG8_MMA(1, 1, At, B1); PG8_BAR; PG8_SCHED;
            }
        }
        if (wr == 0) PG8_BAR;
        if constexpr (FP8) asm volatile("s_nop 15\n\ts_nop 15" ::: "memory");
        E(acc, cur, wr, wc, fr, fq);
        if (!has_next) break;
#pragma unroll
        for (int a = 0; a < 2; ++a)
#pragma unroll
            for (int b = 0; b < 2; ++b)
#pragma unroll
                for (int m = 0; m < 4; ++m)
#pragma unroll
                    for (int n = 0; n < 2; ++n) acc[a][b][m][n] = (f32x4){0.f, 0.f, 0.f, 0.f};
        cur = nxt; cA = nA; cB = nB; ++ui;
        if (wr == 1) PG8_BAR;
    }
    PG8_WAIT_V(0);
    PG8_BAR;
#undef PG8_SA
#undef PG8_SB
#undef PG8_STAGE
#undef PG8_LDA
#undef PG8_LDB
#undef PG8_MMA
#undef PG8_MMA8
#undef PG8_LDA8
#undef PG8_LDB8
#undef PG8_LD32
#undef PG8_WAIT_V
#undef PG8_WAIT_L
#undef PG8_BAR
#undef PG8_SCHED
}
}

__device__ __forceinline__ int lane_id() { int l; asm volatile("v_mbcnt_lo_u32_b32 %0, -1, 0\n\tv_mbcnt_hi_u32_b32 %0, -1, %0" : "=v"(l)); return l; }
#define FT_DECL const int f_lane = lane_id(), f_tid = F.wave * 64 + f_lane; (void)f_tid; (void)f_lane
typedef const float* cfp_t;
typedef __attribute__((address_space(4))) cfp_t* kin_t;
struct Frame {
    LAS unsigned char* lds;
    volatile LAS unsigned* MISC;
    gu32* ctl;
    int wave, vcu, G;
    kin_t in;
    float* out;
    unsigned char* ws;
};
#define WSP(T, off) ((T*)(F.ws + (off)))

template <class RowMap>
__device__ __forceinline__ void p0_transpose_item(const float* W, int K, int N, bf16_t* WT, const RowMap& rowmap, const float* kscale, LAS float* scr, int item, int lane) {
    const int nblk = N / 32, kb = item / nblk, nb = item % nblk, k0 = 64 * kb, n0 = 32 * nb;
#pragma unroll 8
    for (int i = 0; i < 32; ++i) { const int kk = 2 * i + (lane >> 5); float v = W[(size_t)(k0 + kk) * N + n0 + (lane & 31)]; if (kscale) v *= kscale[k0 + kk]; scr[kk * 33 + (lane & 31)] = v; }
    LDS_WAIT(); asm volatile("" ::: "memory");
    const int c = lane & 7;
#pragma unroll
    for (int j = 0; j < 4; ++j) { const int n = (lane >> 3) + 8 * j; const LAS float* s = scr + (8 * c) * 33 + n;
        u32x4 o; o.x = cvt_pk_bf16(s[0 * 33], s[1 * 33]); o.y = cvt_pk_bf16(s[2 * 33], s[3 * 33]); o.z = cvt_pk_bf16(s[4 * 33], s[5 * 33]); o.w = cvt_pk_bf16(s[6 * 33], s[7 * 33]);
        *(GAS u32x4*)(WT + (size_t)rowmap(n0 + n) * K + k0 + 8 * c) = o; }
    LDS_WAIT(); asm volatile("" ::: "memory");
}

__device__ __forceinline__ unsigned pk4_fp8(float a, float b, float c, float d) { int r = __builtin_amdgcn_cvt_pk_fp8_f32(a, b, 0, false); r = __builtin_amdgcn_cvt_pk_fp8_f32(c, d, r, true); return (unsigned)r; }
constexpr float EOSCALE = 16.f;
constexpr float WSCALE = 32.f;
template <class RowMap>
__device__ __forceinline__ void p0_transpose_item_f8(const float* W, int K, int N, unsigned char* WT, const RowMap& rowmap, LAS float* scr, int item, int lane) {
    const int nblk = N / 32, kb = item / nblk, nb = item % nblk, k0 = 128 * kb, n0 = 32 * nb;
#pragma unroll
    for (int hh = 0; hh < 2; ++hh) { float v[32];
#pragma unroll
        for (int i = 0; i < 32; ++i) { const int kk = 2 * (32 * hh + i) + (lane >> 5); v[i] = __builtin_nontemporal_load(W + (size_t)(k0 + kk) * N + n0 + (lane & 31)); }
#pragma unroll
        for (int i = 0; i < 32; ++i) { const int kk = 2 * (32 * hh + i) + (lane >> 5); scr[kk * 33 + (lane & 31)] = v[i] * WSCALE; } }
    LDS_WAIT(); asm volatile("" ::: "memory");
    const int c = lane & 7;
#pragma unroll
    for (int j = 0; j < 4; ++j) { const int n = (lane >> 3) + 8 * j; const LAS float* sp = scr + (16 * c) * 33 + n;
        u32x4 o; o.x = pk4_fp8(sp[0 * 33], sp[1 * 33], sp[2 * 33], sp[3 * 33]); o.y = pk4_fp8(sp[4 * 33], sp[5 * 33], sp[6 * 33], sp[7 * 33]);
        o.z = pk4_fp8(sp[8 * 33], sp[9 * 33], sp[10 * 33], sp[11 * 33]); o.w = pk4_fp8(sp[12 * 33], sp[13 * 33], sp[14 * 33], sp[15 * 33]);
        *(GAS u32x4*)(WT + (size_t)rowmap(n0 + n) * K + k0 + 16 * c) = o; }
    LDS_WAIT(); asm volatile("" ::: "memory");
}
struct MapIdent { int off; __device__ __forceinline__ int operator()(int n) const { return off + n; } };
struct MapWin { __device__ __forceinline__ int operator()(int l) const {
    if (l >= 1024) return l;
    const int t = l & ~255, r = l & 255, wc = r >> 6, blk = (r >> 5) & 1, bj = (r >> 4) & 1, low = r & 15;
    return t + 128 * bj + 32 * wc + 16 * blk + low; } };
struct MapW1 { int off; __device__ __forceinline__ int operator()(int jp) const { const int bj = jp >> 10, j = jp & 1023; return off + 256 * (j >> 7) + 128 * bj + (j & 127); } };


__device__ __forceinline__ void p0_filter_item(Frame& F, int item) {
    FT_DECL;
#define in F.in
    LAS float* h1s = (LAS float*)(F.lds);
    LAS float* h2s = (LAS float*)(F.lds + 4096);
    const int t0 = item * 16;
    {
        const int tt = f_tid >> 5, hh = (f_tid & 31) * 2; const float pos = (float)(t0 + tt);
        float feats[17]; feats[0] = pos * (1.f / SEQ);
#pragma unroll
        for (int i = 0; i < 8; ++i) { const float band = 1e-4f + (float)i * ((7.f - 1e-4f) / 7.f); const float ang = (6.283185307179586f / SEQ) * pos * band; feats[1 + i] = sinf(ang); feats[9 + i] = cosf(ang); }
#pragma unroll
        for (int u = 0; u < 2; ++u) { const int h = hh + u; float a = in[19][h];
#pragma unroll
            for (int k = 0; k < 17; ++k) a += feats[k] * in[18][k * 64 + h];
            h1s[tt * 64 + h] = sinf(in[20][h] * a); }
        __syncthreads();
#pragma unroll
        for (int u = 0; u < 2; ++u) { const int h = hh + u; float a = in[22][h];
#pragma unroll 8
            for (int k = 0; k < 64; ++k) a += h1s[tt * 64 + k] * in[21][k * 64 + h];
            h2s[tt * 64 + h] = sinf(in[23][h] * a); }
        __syncthreads();
    }
    f32x4 acc[16];
#pragma unroll
    for (int t = 0; t < 16; ++t) acc[t] = (f32x4){0.f, 0.f, 0.f, 0.f};
    const int o = 4 * f_tid;
    for (int k = 0; k < 64; ++k) { const f32x4 w = *(const f32x4*)(in[24] + (size_t)k * 2048 + o);
#pragma unroll
        for (int t = 0; t < 16; ++t) acc[t] += w * h2s[t * 64 + k]; }
    const int c0 = o & 511, od = o >> 9;
    float* dst = WSP(float, WS_FILT) + ((size_t)od * 512 + c0) * SEQ + t0;
#pragma unroll
    for (int e = 0; e < 4; ++e) { const float la = -3.0701134573253944f, lb = -15.350567286626972f; const float delta = fabsf(la + (float)(c0 + e) * ((lb - la) / 511.f));
#pragma unroll
        for (int q = 0; q < 4; ++q) { f32x4 v;
#pragma unroll
            for (int i = 0; i < 4; ++i) { const int t = 4 * q + i; const float tn = (float)(t0 + t) * (1.f / SEQ); v[i] = acc[t][e] * expf(-tn * delta); }
            *(f32x4*)(dst + (size_t)e * SEQ + 4 * q) = v; } }
    __syncthreads();
#undef in
}

__device__ __forceinline__ float silu_f(float v) { return v / (1.f + __expf(-v)); }

__device__ __forceinline__ void p0_prologue(Frame& F) {
    FT_DECL;
#define in F.in
    const int wg = blockIdx.x;
    if (wg < 96) {
        LAS float* sv = (LAS float*)F.lds;
        for (int i = f_tid; i < 9 * 1024; i += 512) { const int r = i >> 10, k = i & 1023; const float c = (r < 8) ? in[1][r * 1024 + k] : in[3][k]; sv[i] = silu_f(c); }
        __syncthreads();
        const int j = wg * 64 + f_lane; const float* wm = in[4];
        float acc[9];
#pragma unroll
        for (int r = 0; r < 9; ++r) acc[r] = 0.f;
        const int kbeg = F.wave * 128;
#pragma unroll 4
        for (int k = kbeg; k < kbeg + 128; ++k) { const float w = wm[(size_t)k * (NMOD * DM) + j];
#pragma unroll
            for (int r = 0; r < 9; ++r) acc[r] += sv[r * 1024 + k] * w; }
        LAS float* red = (LAS float*)(F.lds + 40960);
#pragma unroll
        for (int r = 0; r < 9; ++r) red[(F.wave * 9 + r) * 64 + f_lane] = acc[r];
        __syncthreads();
        for (int i = f_tid; i < 9 * 64; i += 512) { const int r = i >> 6, l = i & 63; float s = in[5][wg * 64 + l];
#pragma unroll
            for (int w = 0; w < 8; ++w) s += red[(w * 9 + r) * 64 + l];
            WSP(float, WS_SMALL + SM_MOD)[r * (NMOD * DM) + wg * 64 + l] = s; }
        __syncthreads();
    } else if (wg == 96) {
        if (F.wave == 0) {
            const float a = wave_sum(in[11][f_lane] * in[12][f_lane]), b = wave_sum(in[13][f_lane] * in[14][f_lane]);
            float gq = fabsf(in[9][f_lane]), gk = fabsf(in[10][f_lane]);
#pragma unroll
            for (int o = 1; o < 64; o <<= 1) { gq = fmaxf(gq, __shfl_xor(gq, o)); gk = fmaxf(gk, __shfl_xor(gk, o)); }
            if (f_lane == 0) { float* sc = WSP(float, WS_SMALL + SM_SCAL); sc[0] = expf(a) - expf(b) + LAM_INIT;
                sc[1] = (8.f * gq * gk * 1.02f + 0.05f) * 1.4426950408889634f; }
        }
        for (int i = f_tid; i < 64 * 16; i += 512) { const int pos = i >> 4, f = i & 15;
            const float inv = powf(10000.f, -(float)f / 16.f); const float ang = (float)pos * inv;
            float* rt = WSP(float, WS_SMALL + SM_ROPE); rt[2 * i] = cosf(ang); rt[2 * i + 1] = sinf(ang); }
    }
    __syncthreads();
    for (int it = wg; it < SEQ / 16; it += F.G) p0_filter_item(F, it);
    __syncthreads();
    {
        LAS float* scr = (LAS float*)(F.lds + F.wave * 16896);
        const int gw = F.vcu * NWAVES + F.wave, NGW = F.G * NWAVES;
        constexpr int I_IN = (DM / 64) * (INC / 32), I_OUT = (DM / 64) * (DM / 32), I_1 = (DM / 128) * (2 * DM / 32), I_2 = (DM / 128) * (DM / 32);
        constexpr int NITEMS = I_IN + I_OUT + NEXP * (I_1 + I_2);
        for (int it = gw; it < NITEMS; it += NGW) {
            int r = it;
            if (r < I_IN) { p0_transpose_item(in[8], DM, INC, WSP(bf16_t, WS_WIN), MapWin{}, nullptr, scr, r, f_lane); continue; } r -= I_IN;
            if (r < I_OUT) { p0_transpose_item(in[27], DM, DM, WSP(bf16_t, WS_WOUT), MapIdent{0}, nullptr, scr, r, f_lane); continue; } r -= I_OUT;
            const int e = r / (I_1 + I_2); r -= e * (I_1 + I_2);
            if (r < I_1) p0_transpose_item_f8(in[30] + (size_t)e * DM * 2 * DM, DM, 2 * DM, WSP(unsigned char, WS_W1) + (size_t)e * 2 * DM * DM, MapW1{0}, scr, r, f_lane);
            else p0_transpose_item_f8(in[32] + (size_t)e * DM * DM, DM, DM, WSP(unsigned char, WS_W2) + (size_t)e * DM * DM, MapIdent{0}, scr, r - I_1, f_lane);
        }
    }
}
#undef in

__device__ __forceinline__ void p1_norm1(Frame& F) {
    FT_DECL;
    const int gw = F.vcu * NWAVES + F.wave, NGW = F.G * NWAVES;
    const float* mod = WSP(float, WS_SMALL + SM_MOD); const float* g1 = F.in[6];
    bf16_t* H = WSP(bf16_t, WS_H);
    constexpr int RU = 4;
    for (int m0 = gw; m0 < MTOT; m0 += NGW * RU) {
        f32x4 v[RU][4];
#pragma unroll
        for (int u = 0; u < RU; ++u) { const int m = m0 + u * NGW; if (m < MTOT) {
            const float* xrow = (m < MROWS) ? F.in[0] + (size_t)m * DM : F.in[2] + (size_t)(m - MROWS) * DM; const GAS f32x4* xr = (const GAS f32x4*)xrow + f_lane;
#pragma unroll
            for (int j = 0; j < 4; ++j) v[u][j] = __builtin_nontemporal_load(xr + 64 * j); } }
#pragma unroll
        for (int u = 0; u < RU; ++u) { const int m = m0 + u * NGW; if (m < MTOT) {
            const int mb = (m < MROWS) ? (m >> 12) : 8;
            const float* sh = mod + (size_t)mb * (NMOD * DM); const float* sc = sh + DM;
            float s = 0.f;
#pragma unroll
            for (int j = 0; j < 4; ++j) s += (v[u][j].x * v[u][j].x + v[u][j].y * v[u][j].y) + (v[u][j].z * v[u][j].z + v[u][j].w * v[u][j].w);
            const float rstd = rsqrtf(wave_sum(s) * (1.f / DM) + EPS);
            GAS u32x2* o8 = (GAS u32x2*)(H + (size_t)m * DM) + f_lane;
#pragma unroll
            for (int j = 0; j < 4; ++j) { const int c = 4 * f_lane + 256 * j;
                const f32x4 g = *(const f32x4*)(g1 + c), a = *(const f32x4*)(sc + c), b = *(const f32x4*)(sh + c);
                const f32x4 y = v[u][j] * rstd * g * (a + 1.f) + b;
                u32x2 w; w.x = cvt_pk_bf16(y.x, y.y); w.y = cvt_pk_bf16(y.z, y.w); o8[64 * j] = w; } } }
    }
}

struct SchedInProj {
    int G, c; const char* H; const char* W;
    static constexpr int NA = 136 * 4, NV = 2 * 136, NBU = 6 * 128;
    __device__ __forceinline__ bool next(int i, g8::Unit& u) const {
        const long L = (long)i * G + c;
        if (L < NA) { g8::tile_of((int)L, 136, 4, u.pm, u.pn); u.a = H + (size_t)u.pm * 256 * DM * 2; u.b = W + (size_t)u.pn * 256 * DM * 2; u.kind = 0; u.ex = 0; return true; }
        if (L < NA + NV) { g8::tile_of((int)L - NA, 2, 136, u.pm, u.pn); u.a = W + (size_t)(1024 + u.pm * 256) * DM * 2; u.b = H + (size_t)u.pn * 256 * DM * 2; u.kind = 2; u.ex = 0; return true; }
        if (L < NA + NV + NBU) { g8::tile_of((int)L - NA - NV, 6, 128, u.pm, u.pn); u.a = W + (size_t)(QKVC + u.pm * 256) * DM * 2; u.b = H + (size_t)u.pn * 256 * DM * 2; u.kind = 1; u.ex = 0; return true; }
        return false;
    }
};
constexpr float Q8SCALE = 16.f;
struct EpiInProj {
    unsigned char *Q8, *K8, *VT8; bf16_t* UT; const float *gq, *gk, *rope;
    __device__ __forceinline__ void operator()(f32x4 (&acc)[2][2][4][2], const g8::Unit& u, int wr, int wc, int fr, int fq) const {
        asm volatile("" : "+v"(fr), "+v"(fq));
        if (u.kind == 1) {
            const int row0 = u.pm * 256 + wr * 64 + fr, col0 = u.pn * 256 + wc * 32 + 8 * fq;
#pragma unroll
            for (int ai = 0; ai < 2; ++ai)
#pragma unroll
                for (int m = 0; m < 4; ++m) { bf16_t* rowp = UT + (size_t)(row0 + ai * 128 + m * 16) * MROWS + col0;
#pragma unroll
                    for (int bj = 0; bj < 2; ++bj) { const f32x4 v0 = acc[ai][bj][m][0], v1 = acc[ai][bj][m][1];
                        u32x4 w; w.x = cvt_pk_bf16(v0[0], v0[1]); w.y = cvt_pk_bf16(v0[2], v0[3]); w.z = cvt_pk_bf16(v1[0], v1[1]); w.w = cvt_pk_bf16(v1[2], v1[3]);
                        *(u32x4*)(rowp + bj * 128) = w; } }
            return;
        }
        if (u.kind == 2) {
#pragma unroll
            for (int bj = 0; bj < 2; ++bj) { const int t8 = u.pn * 256 + bj * 128 + wc * 32 + 8 * fq;
                int b, key; if (t8 < MROWS) { b = t8 >> 12; key = CTXL + (t8 & 4095); } else { const int j = t8 - MROWS; b = j >> 8; key = j & 255; }
                const int tile = key >> 6, k = key & 63, ipos = (k < 32) ? 4 * (k >> 3) : 16 + 4 * ((k - 32) >> 3);
#pragma unroll
                for (int ai = 0; ai < 2; ++ai)
#pragma unroll
                    for (int m = 0; m < 4; ++m) { const int ch = u.pm * 256 + ai * 128 + wr * 64 + m * 16 + fr;
                        unsigned char* dst = VT8 + ((((size_t)(b * NHEAD + (ch >> 7)) * 68 + tile) * 128 + (ch & 127)) * 64) + ipos;
                        const f32x4 v0 = acc[ai][bj][m][0], v1 = acc[ai][bj][m][1];
                        *(unsigned*)dst = pk4_fp8(v0[0], v0[1], v0[2], v0[3]); *(unsigned*)(dst + 32) = pk4_fp8(v1[0], v1[1], v1[2], v1[3]); } }
            return;
        }
        const int blk = fq >> 1, f = fq & 1;
        const int sec = u.pn >> 1;
        const bool ctx = (u.pm >= 128);
        if (sec == 0 && ctx) return;
        const int colbase = (u.pn & 1) * 256 + wc * 64 + 32 * blk + 8 * f;
        float gg[2][2][4];
        { const float* gp = (sec == 0 ? gq : gk) + 32 * blk + 8 * f;
#pragma unroll
            for (int bj = 0; bj < 2; ++bj)
#pragma unroll
                for (int n = 0; n < 2; ++n) { const f32x4 t = *(const f32x4*)(gp + 16 * bj + 4 * n); gg[bj][n][0] = t[0]; gg[bj][n][1] = t[1]; gg[bj][n][2] = t[2]; gg[bj][n][3] = t[3]; } }
#pragma unroll
        for (int ai = 0; ai < 2; ++ai)
#pragma unroll
            for (int m = 0; m < 4; ++m) {
                const int rloc = ai * 128 + wr * 64 + m * 16 + fr; const int r = u.pm * 256 + rloc;
                f32x4 v[2][2];
#pragma unroll
                for (int bj = 0; bj < 2; ++bj)
#pragma unroll
                    for (int n = 0; n < 2; ++n) v[bj][n] = acc[ai][bj][m][n];
                size_t orow;
                if (sec == 0) orow = (size_t)r;
                else if (!ctx) orow = (size_t)(r >> 12) * KVL + CTXL + (r & 4095);
                else { const int j = r - MROWS; orow = (size_t)(j >> 8) * KVL + (j & 255); }
                float ss = 0.f;
#pragma unroll
                for (int bj = 0; bj < 2; ++bj)
#pragma unroll
                    for (int n = 0; n < 2; ++n) ss += (v[bj][n][0] * v[bj][n][0] + v[bj][n][1] * v[bj][n][1]) + (v[bj][n][2] * v[bj][n][2] + v[bj][n][3] * v[bj][n][3]);
                ss += __shfl_xor(ss, 16); ss += __shfl_xor(ss, 32);
                const float rstd = rsqrtf(ss * (1.f / 64.f) + EPS) * (sec == 0 ? QSCALE * Q8SCALE : 1.f);
#pragma unroll
                for (int bj = 0; bj < 2; ++bj)
#pragma unroll
                    for (int n = 0; n < 2; ++n)
#pragma unroll
                        for (int e = 0; e < 4; ++e) v[bj][n][e] *= rstd * gg[bj][n][e];
                if (!ctx) {
                    const int t = r & 4095; const int pos = blk ? (t & 63) : (t >> 6);
                    const float* rp = rope + (size_t)(pos * 16 + 8 * f) * 2;
#pragma unroll
                    for (int n = 0; n < 2; ++n) { const f32x4 c0 = *(const f32x4*)(rp + 8 * n), c1 = *(const f32x4*)(rp + 8 * n + 4);
                        const float cs[4] = {c0[0], c0[2], c1[0], c1[2]}, sn[4] = {c0[1], c0[3], c1[1], c1[3]};
#pragma unroll
                        for (int e = 0; e < 4; ++e) { const float x1 = v[0][n][e], x2 = v[1][n][e]; v[0][n][e] = x1 * cs[e] - x2 * sn[e]; v[1][n][e] = x2 * cs[e] + x1 * sn[e]; } }
                }
                unsigned char* dst = (sec == 0 ? Q8 : K8) + orow * QKW + colbase;
#pragma unroll
                for (int bj = 0; bj < 2; ++bj) { u32x2 w; w.x = pk4_fp8(v[bj][0][0], v[bj][0][1], v[bj][0][2], v[bj][0][3]); w.y = pk4_fp8(v[bj][1][0], v[bj][1][1], v[bj][1][2], v[bj][1][3]);
                    *(u32x2*)(dst + 16 * bj) = w; }
            }
    }
};

struct SchedStatic {
    int G, c, nM, nN; const char* A; const char* B;
    __device__ __forceinline__ bool next(int i, g8::Unit& u) const {
        const long L = (long)i * G + c; if (L >= (long)nM * nN) return false;
        g8::tile_of((int)L, nM, nN, u.pm, u.pn); u.a = A + (size_t)u.pm * 256 * DM * 2; u.b = B + (size_t)u.pn * 256 * DM * 2; u.kind = 0; u.ex = 0; return true;
    }
};
struct EpiOutProj {
    const float* x; bf16_t* out; const float* mod;
    __device__ __forceinline__ void operator()(f32x4 (&acc)[2][2][4][2], const g8::Unit& u, int wr, int wc, int fr, int fq) const {
        const int col0 = u.pn * 256 + wc * 32 + 8 * fq;
#pragma unroll
        for (int ai = 0; ai < 2; ++ai)
#pragma unroll
            for (int m = 0; m < 4; ++m) { const int r = u.pm * 256 + ai * 128 + wr * 64 + m * 16 + fr; const float* g1 = mod + (size_t)(r >> 12) * (NMOD * DM) + 2 * DM;
                const size_t off = (size_t)r * DM + col0;
#pragma unroll
                for (int bj = 0; bj < 2; ++bj) { f32x4 o[2];
#pragma unroll
                    for (int n = 0; n < 2; ++n) { const int c = bj * 128 + 4 * n; const f32x4 xv = *(const f32x4*)(x + off + c), gv = *(const f32x4*)(g1 + col0 + c); o[n] = xv + gv * acc[ai][bj][m][n]; }
                    u32x4 w; w.x = cvt_pk_bf16(o[0][0], o[0][1]); w.y = cvt_pk_bf16(o[0][2], o[0][3]); w.z = cvt_pk_bf16(o[1][0], o[1][1]); w.w = cvt_pk_bf16(o[1][2], o[1][3]);
                    *(u32x4*)(out + off + bj * 128) = w; } }
    }
};

namespace att {
constexpr int KVBLK = 64, LDK = QKW, NT = KVL / KVBLK;
constexpr int SHM_V = KVBLK * 128 * 2, SHM_K = KVBLK * 128 * 2;
#define KSWZ(row, colB) ((row) * 256 + ((colB) ^ (((row) & 7) << 4)))
#define SBAR() __builtin_amdgcn_sched_barrier(0)
__device__ __forceinline__ int crow(int r, int hi) { return (r & 3) + 8 * (r >> 2) + 4 * hi; }
__device__ __forceinline__ void expA(f32x16& p) {
#pragma unroll
    for (int r = 0; r < 16; ++r) p[r] = __builtin_amdgcn_exp2f(p[r]);
}
__device__ __forceinline__ void finishSM(f32x16& p0, f32x16& p1, float& l_reg, bf16x8& pa0, bf16x8& pa1, bf16x8& pa2, bf16x8& pa3) {
#pragma unroll
    for (int r = 0; r < 16; ++r) p1[r] = __builtin_amdgcn_exp2f(p1[r]);
    float ps = 0;
#pragma unroll
    for (int r = 0; r < 16; ++r) ps += p0[r];
#pragma unroll
    for (int r = 0; r < 16; ++r) ps += p1[r];
    { auto rr = __builtin_amdgcn_permlane32_swap(__float_as_uint(ps), __float_as_uint(ps), false, false); ps = __uint_as_float(rr[0]) + __uint_as_float(rr[1]); }
    l_reg += ps;
#define PK4(P, BASE, OUT) do { unsigned a0 = cvt_pk_bf16(P[BASE + 0], P[BASE + 1]), a1 = cvt_pk_bf16(P[BASE + 2], P[BASE + 3]);   \
    unsigned b0 = cvt_pk_bf16(P[BASE + 4], P[BASE + 5]), b1 = cvt_pk_bf16(P[BASE + 6], P[BASE + 7]);                              \
    auto r0 = __builtin_amdgcn_permlane32_swap(a0, b0, false, false); auto r1 = __builtin_amdgcn_permlane32_swap(a1, b1, false, false); \
    u32x4 w = {r0[0], r1[0], r0[1], r1[1]}; OUT = *reinterpret_cast<bf16x8*>(&w); } while (0)
    PK4(p0, 0, pa0); PK4(p0, 8, pa1); PK4(p1, 0, pa2); PK4(p1, 8, pa3);
#undef PK4
}
__device__ __forceinline__ void qkt(f32x16& p0, f32x16& p1, const char* Ks, const bf16x8* qr, int r32, int hi, int sub, float negm) {
    (void)negm;
    const f32x16 z = {};
#pragma unroll
    for (int d0 = 0; d0 < 4; ++d0) { const int cb = (sub * 64 + d0 * 16 + hi * 8) * 2;
        const bf16x8 b0 = *reinterpret_cast<const bf16x8*>(Ks + KSWZ(r32, cb));
        const bf16x8 b1 = *reinterpret_cast<const bf16x8*>(Ks + KSWZ(32 + r32, cb));
        p0 = __builtin_amdgcn_mfma_f32_32x32x16_bf16(b0, qr[d0], d0 ? p0 : z, 0, 0, 0);
        p1 = __builtin_amdgcn_mfma_f32_32x32x16_bf16(b1, qr[d0], d0 ? p1 : z, 0, 0, 0); }
}
__device__ __forceinline__ int v_st(int k, int c) { const int kk = (k & ~0xC) | ((k & 4) << 1) | ((k & 8) >> 1); return ((kk >> 3) * 4 + (c >> 5)) * 512 + ((kk & 7) * 32 + (c & 31)) * 2; }
__device__ __forceinline__ int v_rd_base(int lane) { return ((lane & 3) << 3) | (((lane >> 2) & 3) << 6) | (((lane >> 4) & 1) << 5) | (((lane >> 5) & 1) << 8); }
constexpr int v_rd_off(int d0, int ks, int half) { return d0 * 512 + ks * 4096 + half * 2048; }
template <int OFF> __device__ __forceinline__ s16x4 tr_read(int vb) {
    s16x4 r; asm volatile("ds_read_b64_tr_b16 %0, %1 offset:%2" : "=&v"(r) : "v"(vb), "i"(OFF) : "memory"); return r;
}
template <int D0> __device__ __forceinline__ void pv_one(f32x16& od, int vb, bf16x8 pa0, bf16x8 pa1, bf16x8 pa2, bf16x8 pa3) {
    const s16x4 l0 = tr_read<v_rd_off(D0, 0, 0)>(vb), h0 = tr_read<v_rd_off(D0, 0, 1)>(vb), l1 = tr_read<v_rd_off(D0, 1, 0)>(vb), h1 = tr_read<v_rd_off(D0, 1, 1)>(vb);
    const s16x4 l2 = tr_read<v_rd_off(D0, 2, 0)>(vb), h2 = tr_read<v_rd_off(D0, 2, 1)>(vb), l3 = tr_read<v_rd_off(D0, 3, 0)>(vb), h3 = tr_read<v_rd_off(D0, 3, 1)>(vb);
    asm volatile("s_waitcnt lgkmcnt(0)" ::: "memory"); SBAR();
#define PK(L, H) (bf16x8){L[0], L[1], L[2], L[3], H[0], H[1], H[2], H[3]}
    od = __builtin_amdgcn_mfma_f32_32x32x16_bf16(pa0, PK(l0, h0), od, 0, 0, 0);
    od = __builtin_amdgcn_mfma_f32_32x32x16_bf16(pa1, PK(l1, h1), od, 0, 0, 0);
    od = __builtin_amdgcn_mfma_f32_32x32x16_bf16(pa2, PK(l2, h2), od, 0, 0, 0);
    od = __builtin_amdgcn_mfma_f32_32x32x16_bf16(pa3, PK(l3, h3), od, 0, 0, 0);
#undef PK
}
__device__ __forceinline__ void pv_d0(f32x16* o, int vb, bf16x8 pa0, bf16x8 pa1, bf16x8 pa2, bf16x8 pa3) {
    pv_one<0>(o[0], vb, pa0, pa1, pa2, pa3); pv_one<1>(o[1], vb, pa0, pa1, pa2, pa3); pv_one<2>(o[2], vb, pa0, pa1, pa2, pa3); pv_one<3>(o[3], vb, pa0, pa1, pa2, pa3);
}

__device__ __forceinline__ void attn_unit(const bf16_t* __restrict__ Qb, const bf16_t* __restrict__ Kh, const bf16_t* __restrict__ Vh, bf16_t* MIXo,
                                          const float lam, const float negm, const float* __restrict__ subg, char* lds, const int wid) {
    const int lane = lane_id(), tid = wid * 64 + lane, r32 = lane & 31, hi = lane >> 5;
    const int sub = wid >> 2, wq = wid & 3;
    char* V_lds = lds; char* K_lds = lds + 3 * SHM_V;
    float* wsf = (float*)(lds + 98304) + wid * 32;
    float l_reg = 0; f32x16 o[4] = {}; bf16x8 qr[4];
    const bf16_t* Qw = Qb + (long)(wq * 32 + r32) * LDK + sub * 64 + hi * 8;
#pragma unroll
    for (int d0 = 0; d0 < 4; ++d0) qr[d0] = *reinterpret_cast<const bf16x8*>(Qw + d0 * 16);
    const int vb0 = (int)(uintptr_t)V_lds + v_rd_base(lane);
    long ksrc[2], vsrc[2];
#pragma unroll
    for (int i = 0; i < 2; ++i) { const int p = 2 * wid + i;
        { const int r = 4 * p + (lane >> 4), c = (lane & 15) ^ (r & 7); ksrc[i] = (long)r * LDK + c * 8; }
        { const int st = 2 * p + (lane >> 5), kk = 8 * (st >> 2) + ((lane & 31) >> 2), k = (kk & ~0xC) | ((kk & 4) << 1) | ((kk & 8) >> 1), c = 32 * (st & 3) + 8 * (lane & 3); vsrc[i] = (long)k * LDK + c; } }
    const unsigned kdst = (unsigned)(uintptr_t)K_lds + (unsigned)wid * 2048u, vdst = (unsigned)(uintptr_t)V_lds + (unsigned)wid * 2048u;
#define DMA_TILE(t, boff) do { _Pragma("unroll") for (int i_ = 0; i_ < 2; ++i_) { \
        __builtin_amdgcn_global_load_lds((const unsigned*)(Kh + (long)(t) * KVBLK * LDK + ksrc[i_]), (LAS unsigned*)(uintptr_t)__builtin_amdgcn_readfirstlane(kdst + (unsigned)(boff) + i_ * 1024u), 16, 0, 0); \
        __builtin_amdgcn_global_load_lds((const unsigned*)(Vh + (long)(t) * KVBLK * LDK + vsrc[i_]), (LAS unsigned*)(uintptr_t)__builtin_amdgcn_readfirstlane(vdst + (unsigned)(boff) + i_ * 1024u), 16, 0, 0); } } while (0)
#define WBAR() do { asm volatile("s_waitcnt vmcnt(0) lgkmcnt(0)" ::: "memory"); __builtin_amdgcn_s_barrier(); asm volatile("" ::: "memory"); } while (0)
#define ROT3(x) ((x) == 2 * SHM_V ? 0 : (x) + SHM_V)
    f32x16 pA0, pA1, pB0, pB1; bf16x8 pa0, pa1, pa2, pa3;
    DMA_TILE(0, 0); WBAR();
    DMA_TILE(1, SHM_V);
    qkt(pA0, pA1, K_lds, qr, r32, hi, sub, negm); expA(pA0);
    WBAR();
    int bprev = 0, bcur = SHM_V, bnext = 2 * SHM_V;
    for (int j = 1; j + 1 < NT; j += 2) {
        DMA_TILE(j + 1, bnext);
        SBAR(); qkt(pB0, pB1, K_lds + bcur, qr, r32, hi, sub, negm);
        finishSM(pA0, pA1, l_reg, pa0, pa1, pa2, pa3); SBAR();
        pv_d0(o, vb0 + bprev, pa0, pa1, pa2, pa3); expA(pB0);
        WBAR();
        bprev = bcur; bcur = bnext; bnext = ROT3(bnext);
        if (j + 2 < NT) DMA_TILE(j + 2, bnext);
        SBAR(); qkt(pA0, pA1, K_lds + bcur, qr, r32, hi, sub, negm);
        finishSM(pB0, pB1, l_reg, pa0, pa1, pa2, pa3); SBAR();
        pv_d0(o, vb0 + bprev, pa0, pa1, pa2, pa3); expA(pA0);
        WBAR();
        bprev = bcur; bcur = bnext; bnext = ROT3(bnext);
    }
    SBAR(); qkt(pB0, pB1, K_lds + bcur, qr, r32, hi, sub, negm);
    finishSM(pA0, pA1, l_reg, pa0, pa1, pa2, pa3); SBAR();
    pv_d0(o, vb0 + bprev, pa0, pa1, pa2, pa3); expA(pB0);
    finishSM(pB0, pB1, l_reg, pa0, pa1, pa2, pa3); SBAR();
    pv_d0(o, vb0 + bcur, pa0, pa1, pa2, pa3);
#undef ROT3
#undef DMA_TILE
#undef WBAR
#define SLOAD(i, k0)
#define SWRITE(b, i)
#define SWAIT()
#undef SLOAD
#undef SWRITE
#undef SWAIT
    if (hi == 0) wsf[r32] = l_reg;
    __syncthreads();
    float* X = (float*)lds;
    float rli[16];
#pragma unroll
    for (int r = 0; r < 16; ++r) rli[r] = __builtin_amdgcn_rcpf(wsf[crow(r, hi)]);
    if (sub == 1) {
#pragma unroll
        for (int r = 0; r < 16; ++r) { const int row = wq * 32 + crow(r, hi); const float s = lam * rli[r];
#pragma unroll
            for (int d0 = 0; d0 < 4; ++d0) X[row * 128 + d0 * 32 + r32] = o[d0][r] * s; }
    }
    __syncthreads();
    bf16_t* Y = (bf16_t*)(lds + 65536);
    if (sub == 0) {
        float sg[4];
#pragma unroll
        for (int d0 = 0; d0 < 4; ++d0) sg[d0] = subg[d0 * 32 + r32] * (1.f - LAM_INIT);
#pragma unroll
        for (int r = 0; r < 16; ++r) { const int row = wq * 32 + crow(r, hi);
            float v[4]; float ss = 0.f;
#pragma unroll
            for (int d0 = 0; d0 < 4; ++d0) { v[d0] = o[d0][r] * rli[r] - X[row * 128 + d0 * 32 + r32]; ss += v[d0] * v[d0]; }
            ss += __shfl_xor(ss, 1); ss += __shfl_xor(ss, 2); ss += __shfl_xor(ss, 4); ss += __shfl_xor(ss, 8); ss += __shfl_xor(ss, 16);
            const float rstd = rsqrtf(ss * (1.f / 128.f) + EPS);
#pragma unroll
            for (int d0 = 0; d0 < 4; ++d0) Y[row * 128 + d0 * 32 + r32] = (bf16_t)(cvt_pk_bf16(v[d0] * rstd * sg[d0], 0.f) & 0xffffu); }
    }
    __syncthreads();
    { const int row = tid >> 2, seg = (tid & 3) * 32;
#pragma unroll
        for (int i = 0; i < 4; ++i) { const u32x4 v = *(const u32x4*)(Y + row * 128 + seg + i * 8); *(u32x4*)(MIXo + (size_t)row * DM + seg + i * 8) = v; } }
    __syncthreads();
}
#undef KSWZ
#undef SBAR
}

__device__ __forceinline__ void p3_attention(Frame& F) {
    FT_DECL;
    const float* sc = WSP(float, WS_SMALL + SM_SCAL);
    const float lam = sc[0], negm = -sc[1];
    const bf16_t* Q = WSP(bf16_t, WS_Q); const bf16_t* Kb = WSP(bf16_t, WS_K); const bf16_t* Vb = WSP(bf16_t, WS_V); bf16_t* MIX = WSP(bf16_t, WS_MIX);
    const int c = blockIdx.x, xcd = c & 7, ci = c >> 3, per = F.G >> 3;
    for (int j = ci; j < 128; j += per) {
        const int pair = xcd * 4 + (j >> 5), qb = j & 31, b = pair >> 2, h = pair & 3;
        att::attn_unit(Q + ((size_t)b * SEQ + qb * 128) * QKW + h * 128, Kb + (size_t)b * KVL * QKW + h * 128, Vb + (size_t)b * KVL * QKW + h * 128,
                       MIX + ((size_t)b * SEQ + qb * 128) * DM + h * 128, lam, negm, F.in[15], (char*)F.lds, F.wave);
    }
}


namespace att8 {
constexpr int NT = KVL / 64, SHMB = 8192, LDS_V0 = 3 * SHMB;
typedef int i32x8 __attribute__((ext_vector_type(8)));
#define SBAR() __builtin_amdgcn_sched_barrier(0)
__device__ __forceinline__ int crow(int r, int hi) { return (r & 3) + 8 * (r >> 2) + 4 * hi; }
__device__ __forceinline__ i32x8 ld32(const LAS unsigned char* p0, const LAS unsigned char* p1) {
    const u32x4 a = *(const LAS u32x4*)p0, b = *(const LAS u32x4*)p1; return (i32x8){(int)a.x, (int)a.y, (int)a.z, (int)a.w, (int)b.x, (int)b.y, (int)b.z, (int)b.w}; }
__device__ __forceinline__ void mfma_qk(f32x16& p, const i32x8& kf, const i32x8& qf, const f32x16& negc) {
    const unsigned s1 = 0x7f7f7f7fu, sq = 0x7b7b7b7bu;
    asm volatile("s_nop 1\n\tv_mfma_scale_f32_32x32x64_f8f6f4 %0, %1, %2, %3, %4, %5 op_sel_hi:[0,0,0]" : "=&v"(p) : "v"(kf), "v"(qf), "v"(negc), "v"(s1), "v"(sq));
}
__device__ __forceinline__ void mfma_pv(f32x16& o, const i32x8& pa, const i32x8& vf) {
    const unsigned s1 = 0x7f7f7f7fu;
    asm volatile("s_nop 2\n\tv_mfma_scale_f32_32x32x64_f8f6f4 %0, %1, %2, %0, %3, %3 op_sel_hi:[0,0,0]" : "+v"(o) : "v"(pa), "v"(vf), "v"(s1));
}
__device__ __forceinline__ void qkt(f32x16& p0, f32x16& p1, const LAS unsigned char* Kb, const i32x8& qf, const f32x16& negc, int r32, int hi, int sub) {
    const int c0 = sub * 4 + hi * 2;
    const int k0 = r32, k1 = 32 + r32;
    const i32x8 kf0 = ld32(Kb + k0 * 128 + ((c0 ^ ((k0 >> 1) & 7)) << 4), Kb + k0 * 128 + (((c0 + 1) ^ ((k0 >> 1) & 7)) << 4));
    const i32x8 kf1 = ld32(Kb + k1 * 128 + ((c0 ^ ((k1 >> 1) & 7)) << 4), Kb + k1 * 128 + (((c0 + 1) ^ ((k1 >> 1) & 7)) << 4));
    mfma_qk(p0, kf0, qf, negc); mfma_qk(p1, kf1, qf, negc);
}
__device__ __forceinline__ void mfma_wait(f32x16& p0, f32x16& p1) { asm volatile("s_nop 15\n\ts_nop 3" : "+v"(p0), "+v"(p1)); }
__device__ __forceinline__ void expA(f32x16& p) {
#pragma unroll
    for (int r = 0; r < 16; ++r) p[r] = __builtin_amdgcn_exp2f(p[r]);
}
__device__ __forceinline__ void finishSM(f32x16& p0, f32x16& p1, float& l_reg, i32x8& pa) {
#pragma unroll
    for (int r = 0; r < 16; ++r) p1[r] = __builtin_amdgcn_exp2f(p1[r]);
    float ps = 0;
#pragma unroll
    for (int r = 0; r < 16; ++r) ps += p0[r];
#pragma unroll
    for (int r = 0; r < 16; ++r) ps += p1[r];
    { auto rr = __builtin_amdgcn_permlane32_swap(__float_as_uint(ps), __float_as_uint(ps), false, false); ps = __uint_as_float(rr[0]) + __uint_as_float(rr[1]); }
    l_reg += ps;
#pragma unroll
    for (int j = 0; j < 4; ++j) { pa[j] = (int)pk4_fp8(p0[4 * j], p0[4 * j + 1], p0[4 * j + 2], p0[4 * j + 3]); pa[4 + j] = (int)pk4_fp8(p1[4 * j], p1[4 * j + 1], p1[4 * j + 2], p1[4 * j + 3]); }
}
__device__ __forceinline__ void pv(f32x16* o, const LAS unsigned char* Vb, const i32x8& pa, int r32, int hi) {
#pragma unroll
    for (int d0 = 0; d0 < 4; ++d0) { const int d = 32 * d0 + r32, sw = (d >> 2) & 3;
        const i32x8 vf = ld32(Vb + d * 64 + (((2 * hi) ^ sw) << 4), Vb + d * 64 + (((2 * hi + 1) ^ sw) << 4));
        mfma_pv(o[d0], pa, vf); }
}
__device__ __forceinline__ void attn_unit(const unsigned char* __restrict__ Qb, const unsigned char* __restrict__ Kh, const unsigned char* __restrict__ VTh, bf16_t* MIXo,
                                          const float lam, const float* __restrict__ subg, char* lds, const int wid) {
    const int lane = lane_id(), tid = wid * 64 + lane, r32 = lane & 31, hi = lane >> 5;
    const int sub = wid >> 2, wq = wid & 3;
    const LAS unsigned char* L = (const LAS unsigned char*)(uintptr_t)(unsigned)(uintptr_t)lds;
    float* wsf = (float*)(lds + 98304) + wid * 32;
    float l_reg = 0; f32x16 o[4] = {};
    i32x8 qf; { const unsigned char* qp = Qb + (size_t)(wq * 32 + r32) * QKW + sub * 64 + 32 * hi; const u32x4 a = *(const u32x4*)qp, b = *(const u32x4*)(qp + 16);
        qf = (i32x8){(int)a.x, (int)a.y, (int)a.z, (int)a.w, (int)b.x, (int)b.y, (int)b.z, (int)b.w}; }
    f32x16 negc;
#pragma unroll
    for (int r = 0; r < 16; ++r) negc[r] = -5.f;
    asm volatile("" : "+v"(negc));
    long ksrc, vsrc;
    { const int r = 8 * wid + (lane >> 3), c = (lane & 7) ^ ((r >> 1) & 7); ksrc = (long)r * QKW + c * 16; }
    { const int d = 16 * wid + (lane >> 2), c = (lane & 3) ^ ((d >> 2) & 3); vsrc = (long)d * 64 + c * 16; }
    const unsigned ldsb = (unsigned)(uintptr_t)lds, kdst = ldsb + (unsigned)wid * 1024u, vdst = ldsb + LDS_V0 + (unsigned)wid * 1024u;
#define DMA_TILE(t, boff) do { \
        __builtin_amdgcn_global_load_lds((const unsigned*)(Kh + (long)(t) * 64 * QKW + ksrc), (LAS unsigned*)(uintptr_t)__builtin_amdgcn_readfirstlane(kdst + (unsigned)(boff)), 16, 0, 0); \
        __builtin_amdgcn_global_load_lds((const unsigned*)(VTh + (long)(t) * 8192 + vsrc), (LAS unsigned*)(uintptr_t)__builtin_amdgcn_readfirstlane(vdst + (unsigned)(boff)), 16, 0, 0); } while (0)
#define WBAR() do { asm volatile("s_waitcnt vmcnt(0) lgkmcnt(0)" ::: "memory"); __builtin_amdgcn_s_barrier(); asm volatile("" ::: "memory"); } while (0)
#define ROT3(x) ((x) == 2 * SHMB ? 0 : (x) + SHMB)
    f32x16 pA0, pA1, pB0, pB1; i32x8 pa;
    DMA_TILE(0, 0); WBAR();
    DMA_TILE(1, SHMB);
    qkt(pA0, pA1, L, qf, negc, r32, hi, sub); mfma_wait(pA0, pA1); expA(pA0);
    WBAR();
    int bprev = 0, bcur = SHMB, bnext = 2 * SHMB;
    for (int j = 1; j + 1 < NT; j += 2) {
        DMA_TILE(j + 1, bnext);
        SBAR(); qkt(pB0, pB1, L + bcur, qf, negc, r32, hi, sub);
        finishSM(pA0, pA1, l_reg, pa); SBAR();
        pv(o, L + LDS_V0 + bprev, pa, r32, hi); mfma_wait(pB0, pB1); expA(pB0);
        WBAR();
        bprev = bcur; bcur = bnext; bnext = ROT3(bnext);
        if (j + 2 < NT) DMA_TILE(j + 2, bnext);
        SBAR(); qkt(pA0, pA1, L + bcur, qf, negc, r32, hi, sub);
        finishSM(pB0, pB1, l_reg, pa); SBAR();
        pv(o, L + LDS_V0 + bprev, pa, r32, hi); mfma_wait(pA0, pA1); expA(pA0);
        WBAR();
        bprev = bcur; bcur = bnext; bnext = ROT3(bnext);
    }
    SBAR(); qkt(pB0, pB1, L + bcur, qf, negc, r32, hi, sub);
    finishSM(pA0, pA1, l_reg, pa); SBAR();
    pv(o, L + LDS_V0 + bprev, pa, r32, hi); mfma_wait(pB0, pB1); expA(pB0);
    finishSM(pB0, pB1, l_reg, pa); SBAR();
    pv(o, L + LDS_V0 + bcur, pa, r32, hi);
    asm volatile("s_nop 15\n\ts_nop 3" : "+v"(o[0]), "+v"(o[1]), "+v"(o[2]), "+v"(o[3]));
#undef ROT3
#undef DMA_TILE
#undef WBAR
    if (hi == 0) wsf[r32] = l_reg;
    __syncthreads();
    float* X = (float*)lds;
    float rli[16];
#pragma unroll
    for (int r = 0; r < 16; ++r) rli[r] = __builtin_amdgcn_rcpf(wsf[crow(r, hi)]);
    if (sub == 1) {
#pragma unroll
        for (int r = 0; r < 16; ++r) { const int row = wq * 32 + crow(r, hi); const float sc = lam * rli[r];
#pragma unroll
            for (int d0 = 0; d0 < 4; ++d0) X[row * 128 + d0 * 32 + r32] = o[d0][r] * sc; }
    }
    __syncthreads();
    bf16_t* Y = (bf16_t*)(lds + 65536);
    if (sub == 0) {
        float sg[4];
#pragma unroll
        for (int d0 = 0; d0 < 4; ++d0) sg[d0] = subg[d0 * 32 + r32] * (1.f - LAM_INIT);
#pragma unroll
        for (int r = 0; r < 16; ++r) { const int row = wq * 32 + crow(r, hi);
            float v[4]; float ss = 0.f;
#pragma unroll
            for (int d0 = 0; d0 < 4; ++d0) { v[d0] = o[d0][r] * rli[r] - X[row * 128 + d0 * 32 + r32]; ss += v[d0] * v[d0]; }
            ss += __shfl_xor(ss, 1); ss += __shfl_xor(ss, 2); ss += __shfl_xor(ss, 4); ss += __shfl_xor(ss, 8); ss += __shfl_xor(ss, 16);
            const float rstd = rsqrtf(ss * (1.f / 128.f) + EPS);
#pragma unroll
            for (int d0 = 0; d0 < 4; ++d0) Y[row * 128 + d0 * 32 + r32] = (bf16_t)(cvt_pk_bf16(v[d0] * rstd * sg[d0], 0.f) & 0xffffu); }
    }
    __syncthreads();
    { const int row = tid >> 2, seg = (tid & 3) * 32;
#pragma unroll
        for (int i = 0; i < 4; ++i) { const u32x4 v = *(const u32x4*)(Y + row * 128 + seg + i * 8); *(u32x4*)(MIXo + (size_t)row * DM + seg + i * 8) = v; } }
    __syncthreads();
}
#undef SBAR
}

__device__ __forceinline__ void p3_attention8(Frame& F) {
    FT_DECL;
    const float* sc = WSP(float, WS_SMALL + SM_SCAL);
    const float lam = sc[0];
    const unsigned char* Q8 = WSP(unsigned char, WS_Q); const unsigned char* K8 = WSP(unsigned char, WS_K); const unsigned char* VT8 = WSP(unsigned char, WS_V); bf16_t* MIX = WSP(bf16_t, WS_MIX);
    const int c = blockIdx.x, xcd = c & 7, ci = c >> 3, per = F.G >> 3;
    for (int j = ci; j < 128; j += per) {
        const int pair = xcd * 4 + (j >> 5), qb = j & 31, b = pair >> 2, h = pair & 3;
        att8::attn_unit(Q8 + ((size_t)b * SEQ + qb * 128) * QKW + h * 128, K8 + (size_t)b * KVL * QKW + h * 128, VT8 + (size_t)(b * NHEAD + h) * 68 * 8192,
                        MIX + ((size_t)b * SEQ + qb * 128) * DM + h * 128, lam, F.in[15], (char*)F.lds, F.wave);
    }
}

namespace hy {
constexpr int RB_BYTES = 4352 * 8, IN_OFF = 2 * RB_BYTES, TW1_OFF = IN_OFF + 32768, TW2_OFF = TW1_OFF + 15 * 256 * 8, LDS_END = TW2_OFF + 15 * 16 * 8;
__device__ __forceinline__ f32x2 cmul(f32x2 a, f32x2 b) { return (f32x2){a.x * b.x - a.y * b.y, a.x * b.y + a.y * b.x}; }
__device__ __forceinline__ f32x2 cmulc(f32x2 a, f32x2 b) { return (f32x2){a.x * b.x + a.y * b.y, a.y * b.x - a.x * b.y}; }
__device__ __forceinline__ int P(int i) { return i + (i >> 4); }
template <bool INV> __device__ __forceinline__ void r4(f32x2& a, f32x2& b, f32x2& c, f32x2& d) {
    const f32x2 t0 = a + c, t1 = a - c, t2 = b + d, t3 = b - d;
    const f32x2 st3 = INV ? (f32x2){-t3.y, t3.x} : (f32x2){t3.y, -t3.x};
    a = t0 + t2; c = t0 - t2; b = t1 + st3; d = t1 - st3;
}
template <bool INV> __device__ __forceinline__ f32x2 tw(f32x2 v, float c, float s) {
    return INV ? (f32x2){v.x * c - v.y * s, v.y * c + v.x * s} : (f32x2){v.x * c + v.y * s, v.y * c - v.x * s};
}
template <bool INV> __device__ __forceinline__ void dft16(f32x2 (&v)[16]) {
    constexpr float C1 = 0.9238795325112867f, S1 = 0.3826834323650898f, R2 = 0.7071067811865476f;
    r4<INV>(v[0], v[4], v[8], v[12]); r4<INV>(v[1], v[5], v[9], v[13]); r4<INV>(v[2], v[6], v[10], v[14]); r4<INV>(v[3], v[7], v[11], v[15]);
    v[5] = tw<INV>(v[5], C1, S1);  v[9] = tw<INV>(v[9], R2, R2);    v[13] = tw<INV>(v[13], S1, C1);
    v[6] = tw<INV>(v[6], R2, R2);  v[10] = tw<INV>(v[10], 0.f, 1.f); v[14] = tw<INV>(v[14], -R2, R2);
    v[7] = tw<INV>(v[7], S1, C1);  v[11] = tw<INV>(v[11], -R2, R2);  v[15] = tw<INV>(v[15], -C1, -S1);
    r4<INV>(v[0], v[1], v[2], v[3]); r4<INV>(v[4], v[5], v[6], v[7]); r4<INV>(v[8], v[9], v[10], v[11]); r4<INV>(v[12], v[13], v[14], v[15]);
    f32x2 t;
    t = v[1]; v[1] = v[4]; v[4] = t;   t = v[2]; v[2] = v[8]; v[8] = t;    t = v[3]; v[3] = v[12]; v[12] = t;
    t = v[6]; v[6] = v[9]; v[9] = t;   t = v[7]; v[7] = v[13]; v[13] = t;  t = v[11]; v[11] = v[14]; v[14] = t;
}
struct Ctx { LAS f32x2* R; LAS f32x2* IN; LAS f32x2* TW1; LAS f32x2* TW2; int t, half; f32x2 wt; };
#define HY_OPAQUE(x) asm volatile("" : "+v"(x))
#define HY_W32(m) (f32x2){__builtin_cosf(-0.19634954084936207f * (m)), __builtin_sinf(-0.19634954084936207f * (m))}
template <int MODE> __device__ __forceinline__ void pass1_fwd(const Ctx& X) {
    f32x2 v[16]; int t = X.t; HY_OPAQUE(t);
#pragma unroll
    for (int m = 0; m < 16; ++m) { f32x2 a = X.IN[t + 256 * m]; if (MODE == 1) a = (f32x2){X.half ? a.y : a.x, 0.f}; v[m] = a; }
    if (X.half) {
#pragma unroll
        for (int m = 0; m < 16; ++m) v[m] = cmul(cmul(v[m], HY_W32(m)), X.wt);
    }
    dft16<false>(v);
#pragma unroll
    for (int q = 1; q < 16; ++q) v[q] = cmul(v[q], X.TW1[(q - 1) * 256 + t]);
    const int pb = t + (t >> 4);
#pragma unroll
    for (int q = 0; q < 16; ++q) X.R[pb + 272 * q] = v[q];
}
__device__ __forceinline__ void pass2_fwd(const Ctx& X) {
    int t = X.t; HY_OPAQUE(t);
    const int n2 = t & 15, pb = (t >> 4) * 272 + n2; f32x2 v[16];
#pragma unroll
    for (int m = 0; m < 16; ++m) v[m] = X.R[pb + 17 * m];
    dft16<false>(v);
#pragma unroll
    for (int q = 1; q < 16; ++q) v[q] = cmul(v[q], X.TW2[(q - 1) * 16 + n2]);
#pragma unroll
    for (int q = 0; q < 16; ++q) X.R[pb + 17 * q] = v[q];
}
template <bool FILTER> __device__ __forceinline__ void pass3(const Ctx& X, f32x2 (&H)[16]) {
    f32x2 v[16]; int t = X.t; HY_OPAQUE(t); const int pb = 17 * t;
#pragma unroll
    for (int m = 0; m < 16; ++m) v[m] = X.R[pb + m];
    dft16<false>(v);
    if (FILTER) {
#pragma unroll
        for (int q = 0; q < 16; ++q) H[q] = v[q] * (1.f / 8192.f);
    } else {
#pragma unroll
        for (int q = 0; q < 16; ++q) v[q] = cmul(v[q], H[q]);
        dft16<true>(v);
#pragma unroll
        for (int m = 0; m < 16; ++m) X.R[pb + m] = v[m];
    }
}
__device__ __forceinline__ void pass2_inv(const Ctx& X) {
    int t = X.t; HY_OPAQUE(t);
    const int n2 = t & 15, pb = (t >> 4) * 272 + n2; f32x2 v[16];
    v[0] = X.R[pb];
#pragma unroll
    for (int q = 1; q < 16; ++q) v[q] = cmulc(X.R[pb + 17 * q], X.TW2[(q - 1) * 16 + n2]);
    dft16<true>(v);
#pragma unroll
    for (int m = 0; m < 16; ++m) X.R[pb + 17 * m] = v[m];
}
__device__ __forceinline__ void pass1_inv(const Ctx& X) {
    f32x2 v[16]; int t = X.t; HY_OPAQUE(t); const int pb = t + (t >> 4);
    v[0] = X.R[pb];
#pragma unroll
    for (int q = 1; q < 16; ++q) v[q] = cmulc(X.R[pb + 272 * q], X.TW1[(q - 1) * 256 + t]);
    dft16<true>(v);
    if (X.half) {
#pragma unroll
        for (int m = 0; m < 16; ++m) v[m] = cmulc(cmulc(v[m], HY_W32(m)), X.wt);
    }
#pragma unroll
    for (int m = 0; m < 16; ++m) X.R[pb + 272 * m] = v[m];
}
#define HY_WSYNC() asm volatile("s_waitcnt lgkmcnt(0)" ::: "memory")
__device__ __forceinline__ void conv_fft(const Ctx& X, f32x2 (&H)[16]) {
    __syncthreads(); pass1_fwd<0>(X); __syncthreads(); pass2_fwd(X); HY_WSYNC(); pass3<false>(X, H); HY_WSYNC(); pass2_inv(X); __syncthreads(); pass1_inv(X); __syncthreads();
}
constexpr int STG_OFF = LDS_END;
constexpr int LDS_END2 = STG_OFF + 2 * SEQ * 2;
static_assert(LDS_END2 <= LDSCTL_OFF, "hyena LDS map");
__device__ __forceinline__ float sconv_lds(const LAS bf16_t* stg, int bs, int n, float w0, float w1, float w2, float bias) {
    const LAS bf16_t* p = stg + bs * SEQ;
    const float c = bf2f(p[n]), lv = bf2f(p[n - ((n > 0) ? 1 : 0)]), rv = bf2f(p[n + ((n < SEQ - 1) ? 1 : 0)]);
    const float l = (n > 0) ? lv : 0.f, r = (n < SEQ - 1) ? rv : 0.f;
    return bias + w0 * l + w1 * c + w2 * r;
}
__device__ __forceinline__ void setup_tables(LAS unsigned char* lds, int tid) {
    LAS f32x2* TW1 = (LAS f32x2*)(lds + TW1_OFF); LAS f32x2* TW2 = (LAS f32x2*)(lds + TW2_OFF);
    for (int i = tid; i < 15 * 256; i += 512) { const int q = i / 256 + 1, t = i & 255; float s, c; sincosf(-6.283185307179586f * (float)((t * q) & 4095) * (1.f / 4096.f), &s, &c); TW1[i] = (f32x2){c, s}; }
    for (int i = tid; i < 15 * 16; i += 512) { const int q = i / 16 + 1, n2 = i & 15; float s, c; sincosf(-6.283185307179586f * (float)((n2 * q) & 255) * (1.f / 256.f), &s, &c); TW2[i] = (f32x2){c, s}; }
}
__device__ __forceinline__ void unit(Frame& F, int c) {
    FT_DECL;
    const int tid = f_tid; Ctx X; X.half = F.wave >> 2; X.t = tid & 255;
    X.R = (LAS f32x2*)(F.lds + X.half * RB_BYTES); X.IN = (LAS f32x2*)(F.lds + IN_OFF); X.TW1 = (LAS f32x2*)(F.lds + TW1_OFF); X.TW2 = (LAS f32x2*)(F.lds + TW2_OFF);
    { float s, cc; sincosf(-6.283185307179586f * (float)X.t * (1.f / 8192.f), &s, &cc); X.wt = (f32x2){cc, s}; }
    LAS f32x2* RB0 = (LAS f32x2*)(F.lds); LAS f32x2* RB1 = (LAS f32x2*)(F.lds + RB_BYTES);
    const float* FILT = WSP(float, WS_FILT);
    f32x2 H0[16], H1[16];
#pragma unroll
    for (int ord = 0; ord < 2; ++ord) {
        const float* hf = FILT + ((size_t)(ord * 2 + 0) * 512 + c) * SEQ; const float* hb = FILT + ((size_t)(ord * 2 + 1) * 512 + c) * SEQ;
        __syncthreads();
        int nb = tid; HY_OPAQUE(nb);
#pragma unroll
        for (int j = 0; j < 8; ++j) { const int n = nb + 512 * j; const float a = hf[n], b = hb[(SEQ - n) & (SEQ - 1)]; const float lo = (n == 0) ? a + b : a, hi = (n == 0) ? 0.f : b; X.IN[n] = (f32x2){lo + hi, lo - hi}; }
        __syncthreads(); pass1_fwd<1>(X); __syncthreads(); pass2_fwd(X); HY_WSYNC();
        if (ord == 0) pass3<true>(X, H0); else pass3<true>(X, H1);
    }
    const bf16_t* UT = WSP(bf16_t, WS_UT);
    const bf16_t* rv = UT + (size_t)c * MROWS; const bf16_t* r1 = UT + (size_t)(512 + c) * MROWS; const bf16_t* r2 = UT + (size_t)(1024 + c) * MROWS;
    const float* cw = F.in[16]; const float* cb = F.in[17];
    const float wv0 = cw[c], wv1 = cw[HYC + c], wv2 = cw[2 * HYC + c], bv = cb[c];
    const float wa0 = cw[512 + c], wa1 = cw[HYC + 512 + c], wa2 = cw[2 * HYC + 512 + c], ba = cb[512 + c];
    const float wb0 = cw[1024 + c], wb1 = cw[HYC + 1024 + c], wb2 = cw[2 * HYC + 1024 + c], bb = cb[1024 + c];
    const float sk0 = F.in[25][c], sk1 = F.in[25][512 + c];
    bf16_t* Z = WSP(bf16_t, WS_Z2T) + (size_t)c * MROWS;
    LAS bf16_t* STG = (LAS bf16_t*)(F.lds + STG_OFF);
    u32x4 g0 = *(const u32x4*)(rv + tid * 8), g1 = *(const u32x4*)(rv + SEQ + tid * 8);
    for (int pr = 0; pr < 4; ++pr) {
        const int b0 = 2 * pr, b1 = b0 + 1;
        f32x2 z[8]; int pc = tid + (tid >> 4); HY_OPAQUE(pc); int nb = tid; HY_OPAQUE(nb);
        __syncthreads();
        *(LAS u32x4*)(STG + tid * 8) = g0; *(LAS u32x4*)(STG + SEQ + tid * 8) = g1;
        __syncthreads();
#pragma unroll
        for (int j = 0; j < 8; ++j) { const int n = nb + 512 * j; z[j] = (f32x2){sconv_lds(STG, 0, n, wv0, wv1, wv2, bv), sconv_lds(STG, 1, n, wv0, wv1, wv2, bv)}; X.IN[n] = z[j]; }
        g0 = *(const u32x4*)(r1 + b0 * SEQ + tid * 8); g1 = *(const u32x4*)(r1 + b1 * SEQ + tid * 8);
        conv_fft(X, H0);
        *(LAS u32x4*)(STG + tid * 8) = g0; *(LAS u32x4*)(STG + SEQ + tid * 8) = g1;
        __syncthreads();
        HY_OPAQUE(nb); HY_OPAQUE(pc);
#pragma unroll
        for (int j = 0; j < 8; ++j) { const int n = nb + 512 * j; const f32x2 y = RB0[pc + 544 * j] + RB1[pc + 544 * j];
            const f32x2 g = (f32x2){sconv_lds(STG, 0, n, wa0, wa1, wa2, ba), sconv_lds(STG, 1, n, wa0, wa1, wa2, ba)};
            z[j] = g * (y + sk0 * z[j]); X.IN[n] = z[j]; }
        g0 = *(const u32x4*)(r2 + b0 * SEQ + tid * 8); g1 = *(const u32x4*)(r2 + b1 * SEQ + tid * 8);
        conv_fft(X, H1);
        *(LAS u32x4*)(STG + tid * 8) = g0; *(LAS u32x4*)(STG + SEQ + tid * 8) = g1;
        __syncthreads();
        if (pr < 3) { g0 = *(const u32x4*)(rv + (b0 + 2) * SEQ + tid * 8); g1 = *(const u32x4*)(rv + (b1 + 2) * SEQ + tid * 8); }
        HY_OPAQUE(nb); HY_OPAQUE(pc);
        f32x2 o[8];
#pragma unroll
        for (int j = 0; j < 8; ++j) { const int n = nb + 512 * j; const f32x2 y = RB0[pc + 544 * j] + RB1[pc + 544 * j];
            const f32x2 g = (f32x2){sconv_lds(STG, 0, n, wb0, wb1, wb2, bb), sconv_lds(STG, 1, n, wb0, wb1, wb2, bb)};
            o[j] = g * (y + sk1 * z[j]); }
        __syncthreads();
#pragma unroll
        for (int j = 0; j < 8; ++j) { const int n = nb + 512 * j; STG[n] = (bf16_t)(cvt_pk_bf16(o[j].x, 0.f) & 0xffffu); STG[SEQ + n] = (bf16_t)(cvt_pk_bf16(o[j].y, 0.f) & 0xffffu); }
        __syncthreads();
        *(u32x4*)(Z + b0 * SEQ + tid * 8) = *(const LAS u32x4*)(STG + tid * 8); *(u32x4*)(Z + b1 * SEQ + tid * 8) = *(const LAS u32x4*)(STG + SEQ + tid * 8);
    }
    __syncthreads();
}
}

__device__ __forceinline__ void p3_hyena(Frame& F) {
    FT_DECL;
    __syncthreads();
    hy::setup_tables(F.lds, f_tid);
    __syncthreads();
    for (int c = F.vcu; c < HYW; c += F.G) hy::unit(F, c);
}

__device__ __forceinline__ void p4_hynorm(Frame& F) {
    FT_DECL;
    const bf16_t* Z = WSP(bf16_t, WS_Z2T); bf16_t* MIX = WSP(bf16_t, WS_MIX); const float* g = F.in[26];
    LAS bf16_t* T = (LAS bf16_t*)F.lds;
    LAS float* red = (LAS float*)(F.lds + 512 * 72 * 2);
    LAS float* rs = red + 512;
    for (int it = F.vcu; it < MROWS / 64; it += F.G) {
        const int tok0 = it * 64;
        __syncthreads();
#pragma unroll
        for (int j = 0; j < 8; ++j) { const int i = f_tid + 512 * j, row = i >> 3, ch = i & 7; const u32x4 v = *(const u32x4*)(Z + (size_t)row * MROWS + tok0 + ch * 8); *(LAS u32x4*)(T + row * 72 + ch * 8) = v; }
        __syncthreads();
        { const int tok = f_tid & 63, grp = f_tid >> 6; float ss = 0.f;
#pragma unroll 8
            for (int k = 0; k < 64; ++k) { const float v = bf2f(T[(grp * 64 + k) * 72 + tok]); ss += v * v; }
            red[grp * 64 + tok] = ss; }
        __syncthreads();
        if (f_tid < 64) { float ss = 0.f;
#pragma unroll
            for (int w = 0; w < 8; ++w) ss += red[w * 64 + f_tid];
            rs[f_tid] = rsqrtf(ss * (1.f / HYW) + EPS); }
        __syncthreads();
#pragma unroll
        for (int j = 0; j < 8; ++j) { const int i = f_tid + 512 * j, tok = i >> 6, c0 = (i & 63) * 8; const float r = rs[tok];
            float v[8];
#pragma unroll
            for (int e = 0; e < 8; ++e) v[e] = bf2f(T[(c0 + e) * 72 + tok]) * r * g[c0 + e];
            u32x4 w; w.x = cvt_pk_bf16(v[0], v[1]); w.y = cvt_pk_bf16(v[2], v[3]); w.z = cvt_pk_bf16(v[4], v[5]); w.w = cvt_pk_bf16(v[6], v[7]);
            *(u32x4*)(MIX + (size_t)(tok0 + tok) * DM + 512 + c0) = w; }
    }
}

__device__ __forceinline__ void p4_stub(Frame& F) {
    FT_DECL;
    bf16_t* MIX = WSP(bf16_t, WS_MIX);
    const size_t gt = (size_t)F.vcu * 512 + f_tid, NT = (size_t)F.G * 512;
    for (size_t i = gt; i < (size_t)MROWS * 64; i += NT) { const size_t row = i >> 6, ch = i & 63; *(u32x4*)(MIX + row * DM + 512 + ch * 8) = (u32x4){0u, 0u, 0u, 0u}; }
}


constexpr size_t RT_TOPI = 0;
constexpr size_t RT_GATE = 512 * 1024;
constexpr size_t RT_POS = 1024 * 1024;
constexpr size_t RT_WGCNT = 1536 * 1024;
constexpr size_t RT_META = 1600 * 1024;
constexpr size_t RT_LIST = 2048 * 1024;
constexpr size_t RT_GSLOT = 2048 * 1024 + 640 * 1024;
constexpr int MAXSLOT = MROWS * TOPK + NEXP * 256;
constexpr int MAXTILE = MAXSLOT / 256;
constexpr size_t WS_XS = WS_EO;
constexpr int RW_PITCH = 32;
constexpr int P6_LDS_TOPI = 1024 * RW_PITCH * 4;

__device__ __forceinline__ void p6_router(Frame& F) {
    FT_DECL;
#define in F.in
    LAS float* RW = (LAS float*)F.lds;
    LAS int* TI = (LAS int*)(F.lds + P6_LDS_TOPI);
    LAS int* PS = TI + 512;
    LAS int* SC = PS + 512;
    const float* rw = in[28];
    for (int i = f_tid; i < 1024 * 8; i += 512) { const int k = i >> 3, c4 = i & 7; const f32x4 v = *(const f32x4*)(rw + (size_t)k * 32 + c4 * 4);
        const int pi = (k & 3) * 256 + (k >> 2); *(LAS f32x4*)(RW + pi * RW_PITCH + ((c4 ^ ((pi >> 1) & 7)) * 4)) = v; }
    __syncthreads();
    const float* mod = WSP(float, WS_SMALL + SM_MOD); const float* g2n = in[7]; const float* rb = in[29];
    unsigned char* H2 = WSP(unsigned char, WS_H);
    int* topi_g = WSP(int, WS_ROUTE + RT_TOPI); float* gate_g = WSP(float, WS_ROUTE + RT_GATE); int* pos_g = WSP(int, WS_ROUTE + RT_POS); int* wgcnt = WSP(int, WS_ROUTE + RT_WGCNT);
    const int lane = f_lane;
    for (int blk = blockIdx.x; blk < MROWS / 128; blk += F.G) {
        for (int it = 0; it < 8; ++it) {
            const int rl = F.wave * 16 + 2 * it, r0 = blk * 128 + rl;
            const float* sh2 = mod + (size_t)(r0 >> 12) * (NMOD * DM) + 3 * DM; const float* sc2 = sh2 + DM;
            f32x4 h[2][4];
#pragma unroll
            for (int rr = 0; rr < 2; ++rr) {
                const GAS u32x2* xr = (const GAS u32x2*)(WSP(bf16_t, WS_XN) + (size_t)(r0 + rr) * DM) + lane; float ss = 0.f;
#pragma unroll
                for (int j = 0; j < 4; ++j) { const u32x2 xb = xr[64 * j]; h[rr][j] = (f32x4){__uint_as_float(xb.x << 16), __uint_as_float(xb.x & 0xffff0000u), __uint_as_float(xb.y << 16), __uint_as_float(xb.y & 0xffff0000u)}; ss += (h[rr][j].x * h[rr][j].x + h[rr][j].y * h[rr][j].y) + (h[rr][j].z * h[rr][j].z + h[rr][j].w * h[rr][j].w); }
                const float rstd = rsqrtf(wave_sum(ss) * (1.f / DM) + EPS);
                GAS unsigned* o4 = (GAS unsigned*)(H2 + (size_t)(r0 + rr) * DM) + lane;
#pragma unroll
                for (int j = 0; j < 4; ++j) { const int c = 4 * lane + 256 * j;
                    const f32x4 g = *(const f32x4*)(g2n + c), a = *(const f32x4*)(sc2 + c), b = *(const f32x4*)(sh2 + c);
                    h[rr][j] = h[rr][j] * rstd * g * (a + 1.f) + b;
                    o4[64 * j] = pk4_fp8(h[rr][j].x, h[rr][j].y, h[rr][j].z, h[rr][j].w); }
            }
            float a0[32], a1[32]; int lb = lane; asm volatile("" : "+v"(lb)); const int sw = (lb >> 1) & 7;
#pragma unroll
            for (int e = 0; e < 32; ++e) { a0[e] = 0.f; a1[e] = 0.f; }
            unsigned pb[8];
#pragma unroll
            for (int c = 0; c < 8; ++c) { pb[c] = (unsigned)(uintptr_t)RW + (unsigned)lb * 128u + (unsigned)((c ^ sw) * 16); asm volatile("" : "+v"(pb[c])); }
            f32x4 wb[2][4];
#define P6_OFF(hs) ((((((hs) >> 1) & 3) * 256 + 64 * ((hs) >> 3)) * 128) & 65535)
#define P6_HI(hs) ((((((hs) >> 1) & 3) * 256 + 64 * ((hs) >> 3)) * 128) >> 16)
#define P6_LOADW(buf, hs) _Pragma("unroll") for (int c = 0; c < 4; ++c) wb[buf][c] = *(const LAS f32x4*)(uintptr_t)(pb[4 * ((hs) & 1) + c] + (unsigned)(P6_HI(hs) * 65536 + P6_OFF(hs)))
#define P6_FMA(buf, hs) do { const float x0 = h[0][(hs) >> 3][((hs) >> 1) & 3], x1 = h[1][(hs) >> 3][((hs) >> 1) & 3]; _Pragma("unroll") for (int c = 0; c < 4; ++c) _Pragma("unroll") for (int e = 0; e < 4; ++e) { \
                a0[16 * ((hs) & 1) + 4 * c + e] += x0 * wb[buf][c][e]; a1[16 * ((hs) & 1) + 4 * c + e] += x1 * wb[buf][c][e]; } } while (0)
            P6_LOADW(0, 0);
#pragma unroll
            for (int hs = 0; hs < 32; hs += 2) {
                P6_LOADW(1, hs + 1); __builtin_amdgcn_sched_barrier(0); asm volatile("s_waitcnt lgkmcnt(4)" ::: "memory"); __builtin_amdgcn_sched_barrier(0);
                P6_FMA(0, hs); __builtin_amdgcn_sched_barrier(0);
                if (hs + 2 < 32) { P6_LOADW(0, hs + 2); __builtin_amdgcn_sched_barrier(0); asm volatile("s_waitcnt lgkmcnt(4)" ::: "memory"); } else { asm volatile("s_waitcnt lgkmcnt(0)" ::: "memory"); }
                __builtin_amdgcn_sched_barrier(0);
                P6_FMA(1, hs + 1); __builtin_amdgcn_sched_barrier(0);
            }
#undef P6_LOADW
#undef P6_FMA
#undef P6_OFF
#undef P6_HI
#define RS_STEP(A, CNT, MASK) _Pragma("unroll") for (int i = 0; i < CNT; ++i) { const bool up = (lane & MASK) != 0; const float send = up ? A[i] : A[CNT + i]; const float keep = up ? A[CNT + i] : A[i]; A[i] = keep + __shfl_xor(send, MASK); }
            RS_STEP(a0, 16, 32) RS_STEP(a0, 8, 16) RS_STEP(a0, 4, 8) RS_STEP(a0, 2, 4) RS_STEP(a0, 1, 2)
            RS_STEP(a1, 16, 32) RS_STEP(a1, 8, 16) RS_STEP(a1, 4, 8) RS_STEP(a1, 2, 4) RS_STEP(a1, 1, 2)
#undef RS_STEP
            const int me = lane >> 1; const float bias = rb[me];
            float lg[2]; lg[0] = a0[0] + __shfl_xor(a0[0], 1) + bias; lg[1] = a1[0] + __shfl_xor(a1[0], 1) + bias;
            LAS float* WL = (LAS float*)(F.lds + P6_LDS_TOPI + 6144) + F.wave * 96;
            if ((lane & 1) == 0) { WL[me] = lg[0]; WL[32 + me] = lg[1]; }
            LDS_WAIT(); asm volatile("" ::: "memory");
#pragma unroll
            for (int rr = 0; rr < 2; ++rr) {
                const float v = lg[rr]; int rank = 0;
#pragma unroll
                for (int c4 = 0; c4 < 8; ++c4) { const f32x4 o = *(const LAS f32x4*)(WL + rr * 32 + 4 * c4);
#pragma unroll
                    for (int e = 0; e < 4; ++e) { const int oe = 4 * c4 + e; rank += (o[e] > v || (o[e] == v && oe < me)) ? 1 : 0; } }
                if ((lane & 1) == 0 && rank < 4) { WL[64 + rr * 4 + rank] = v; ((LAS int*)WL)[72 + rr * 4 + rank] = me; }
            }
            LDS_WAIT(); asm volatile("" ::: "memory");
            if (lane < 2) { const int rr = lane; const f32x4 tv = *(const LAS f32x4*)(WL + 64 + rr * 4); typedef int i32x4_t __attribute__((ext_vector_type(4))); const i32x4_t ti = *(const LAS i32x4_t*)((LAS int*)WL + 72 + rr * 4);
                const float e1 = __expf(tv[1] - tv[0]), e2 = __expf(tv[2] - tv[0]), e3 = __expf(tv[3] - tv[0]); const float inv = 1.f / (1.f + e1 + e2 + e3);
                const int r = r0 + rr;
                *(i32x4_t*)(topi_g + (size_t)r * 4) = ti;
                *(f32x4*)(gate_g + (size_t)r * 4) = (f32x4){inv, e1 * inv, e2 * inv, e3 * inv};
                *(LAS i32x4_t*)(TI + (rl + rr) * 4) = ti; }
            LDS_WAIT(); asm volatile("" ::: "memory");
        }
        __syncthreads();
        { const int t2 = F.wave * 64 + lane_id(); const int e = t2 & 31, seg = t2 >> 5; int cnt = 0;
#pragma unroll 4
            for (int i = 0; i < 32; ++i) cnt += (TI[seg * 32 + i] == e) ? 1 : 0;
            SC[seg * 32 + e] = cnt;
            __syncthreads();
            int pre = 0;
            for (int s2 = 0; s2 < seg; ++s2) pre += SC[s2 * 32 + e];
            if (seg == 15) wgcnt[blk * 32 + e] = pre + cnt;
            for (int i = 0; i < 32; ++i) if (TI[seg * 32 + i] == e) { PS[seg * 32 + i] = pre; ++pre; }
        }
        __syncthreads();
        { const int t3 = F.wave * 64 + lane_id(); pos_g[(size_t)blk * 512 + t3] = PS[t3]; }
        __syncthreads();
    }
#undef in
}


__device__ __forceinline__ void p6_router_mfma(Frame& F) {
    FT_DECL;
#define in F.in
    LAS float* WP = (LAS float*)F.lds;
    LAS int* TI = (LAS int*)(F.lds + P6_LDS_TOPI);
    LAS int* PS = TI + 512;
    LAS int* SC = PS + 512;
    LAS float* RSTD = (LAS float*)(SC + 512);
    LAS float* BIAS = RSTD + 128;
    LAS float* SSX = BIAS + 32;
    const float* rw = in[28]; const float* mod = WSP(float, WS_SMALL + SM_MOD); const float* g2n = in[7]; const float* rb = in[29];
    const bf16_t* XN = WSP(bf16_t, WS_XN); unsigned char* H2 = WSP(unsigned char, WS_H);
    int* topi_g = WSP(int, WS_ROUTE + RT_TOPI); float* gate_g = WSP(float, WS_ROUTE + RT_GATE); int* pos_g = WSP(int, WS_ROUTE + RT_POS); int* wgcnt = WSP(int, WS_ROUTE + RT_WGCNT);
    for (int blk = blockIdx.x; blk < MROWS / 128; blk += F.G) {
        const float* sh2 = mod + (size_t)(blk >> 5) * (NMOD * DM) + 3 * DM; const float* sc2 = sh2 + DM;
        __syncthreads();
        for (int i = f_tid; i < 1024 * 8; i += 512) { const int k = i >> 3, c4 = i & 7; const float gm = g2n[k] * (1.f + sc2[k]);
            *(LAS f32x4*)(WP + k * 32 + c4 * 4) = *(const f32x4*)(rw + (size_t)k * 32 + c4 * 4) * gm; }
        { const int e = f_tid & 31, part = f_tid >> 5; float a = 0.f;
            for (int k = part * 64; k < part * 64 + 64; ++k) a += sh2[k] * rw[(size_t)k * 32 + e];
            ((LAS float*)SC)[part * 32 + e] = a; }
        __syncthreads();
        if (f_tid < 32) { float a = rb[f_tid];
#pragma unroll
            for (int p = 0; p < 16; ++p) a += ((LAS float*)SC)[p * 32 + f_tid];
            BIAS[f_tid] = a; }
        const int rg = F.wave & 3, kh = F.wave >> 2, j = f_lane & 31, hi = f_lane >> 5;
        f32x16 acc = {};
        float ss = 0.f;
        { const bf16_t* xrow = XN + (size_t)(blk * 128 + rg * 32 + j) * DM + 512 * kh + 8 * hi;
            const LAS float* wp = WP + (512 * kh + 8 * hi) * 32 + j;
#pragma unroll 4
            for (int c = 0; c < 32; ++c) { const u32x4 xb = *(const u32x4*)(xrow + 16 * c);
                float xf[8] = {__uint_as_float(xb.x << 16), __uint_as_float(xb.x & 0xffff0000u), __uint_as_float(xb.y << 16), __uint_as_float(xb.y & 0xffff0000u),
                               __uint_as_float(xb.z << 16), __uint_as_float(xb.z & 0xffff0000u), __uint_as_float(xb.w << 16), __uint_as_float(xb.w & 0xffff0000u)};
#pragma unroll
                for (int q = 0; q < 8; ++q) { ss += xf[q] * xf[q]; acc = __builtin_amdgcn_mfma_f32_32x32x2f32(wp[(16 * c + q) * 32], xf[q], acc, 0, 0, 0); } } }
        { auto rr = __builtin_amdgcn_permlane32_swap(__float_as_uint(ss), __float_as_uint(ss), false, false); ss = __uint_as_float(rr[0]) + __uint_as_float(rr[1]); }
        if (hi == 0) SSX[kh * 128 + rg * 32 + j] = ss;
        __syncthreads();
        if (kh == 1) {
#pragma unroll
            for (int r = 0; r < 16; ++r) WP[(rg * 16 + r) * 64 + f_lane] = acc[r]; }
        if (f_tid < 128) RSTD[f_tid] = rsqrtf((SSX[f_tid] + SSX[128 + f_tid]) * (1.f / DM) + EPS);
        __syncthreads();
        if (kh == 0) {
            const float rstd = RSTD[rg * 32 + j];
            float tv[4] = {-INFINITY, -INFINITY, -INFINITY, -INFINITY}; int ti[4] = {1 << 20, 1 << 20, 1 << 20, 1 << 20};
#define P6_INS(V, E) do { float cv = (V); int ce = (E); _Pragma("unroll") for (int q = 0; q < 4; ++q) { const bool b = cv > tv[q] || (cv == tv[q] && ce < ti[q]); \
                const float nv = b ? tv[q] : cv; const int ne = b ? ti[q] : ce; tv[q] = b ? cv : tv[q]; ti[q] = b ? ce : ti[q]; cv = nv; ce = ne; } } while (0)
#pragma unroll
            for (int r = 0; r < 16; ++r) { const int e = (r & 3) + 8 * (r >> 2) + 4 * hi; const float v = (acc[r] + WP[(rg * 16 + r) * 64 + f_lane]) * rstd + BIAS[e]; P6_INS(v, e); }
            float ov[4]; int oe[4];
#pragma unroll
            for (int q = 0; q < 4; ++q) { ov[q] = __shfl_xor(tv[q], 32); oe[q] = __shfl_xor(ti[q], 32); }
#pragma unroll
            for (int q = 0; q < 4; ++q) P6_INS(ov[q], oe[q]);
#undef P6_INS
            if (hi == 0) { const int rl = rg * 32 + j, r = blk * 128 + rl;
                const float e1 = __expf(tv[1] - tv[0]), e2 = __expf(tv[2] - tv[0]), e3 = __expf(tv[3] - tv[0]); const float inv = 1.f / (1.f + e1 + e2 + e3);
                typedef int i32x4_t __attribute__((ext_vector_type(4))); const i32x4_t t4 = {ti[0], ti[1], ti[2], ti[3]};
                *(i32x4_t*)(topi_g + (size_t)r * 4) = t4; *(f32x4*)(gate_g + (size_t)r * 4) = (f32x4){inv, e1 * inv, e2 * inv, e3 * inv};
                *(LAS i32x4_t*)(TI + rl * 4) = t4; }
        }
        __syncthreads();
        { const int t2 = F.wave * 64 + lane_id(); const int e = t2 & 31, seg = t2 >> 5; int cnt = 0;
#pragma unroll 4
            for (int i = 0; i < 32; ++i) cnt += (TI[seg * 32 + i] == e) ? 1 : 0;
            SC[seg * 32 + e] = cnt;
            __syncthreads();
            int pre = 0;
            for (int s2 = 0; s2 < seg; ++s2) pre += SC[s2 * 32 + e];
            if (seg == 15) wgcnt[blk * 32 + e] = pre + cnt;
            for (int i = 0; i < 32; ++i) if (TI[seg * 32 + i] == e) { PS[seg * 32 + i] = pre; ++pre; }
        }
        __syncthreads();
        { const int t3 = F.wave * 64 + lane_id(); pos_g[(size_t)blk * 512 + t3] = PS[t3]; }
        { const int lane = lane_id();
            for (int it = 0; it < 4; ++it) { u32x2 xb[4][4];
#pragma unroll
                for (int u = 0; u < 4; ++u) { const GAS u32x2* xr = (const GAS u32x2*)(XN + (size_t)(blk * 128 + F.wave * 16 + 4 * it + u) * DM) + lane;
#pragma unroll
                    for (int jj = 0; jj < 4; ++jj) xb[u][jj] = xr[64 * jj]; }
#pragma unroll
                for (int u = 0; u < 4; ++u) { const int rl = F.wave * 16 + 4 * it + u; const float rstd = RSTD[rl];
                    GAS unsigned* o4 = (GAS unsigned*)(H2 + (size_t)(blk * 128 + rl) * DM) + lane;
#pragma unroll
                    for (int jj = 0; jj < 4; ++jj) { const int c = 4 * lane + 256 * jj;
                        const f32x4 x = (f32x4){__uint_as_float(xb[u][jj].x << 16), __uint_as_float(xb[u][jj].x & 0xffff0000u), __uint_as_float(xb[u][jj].y << 16), __uint_as_float(xb[u][jj].y & 0xffff0000u)};
                        const f32x4 g = *(const f32x4*)(g2n + c), a = *(const f32x4*)(sc2 + c), b = *(const f32x4*)(sh2 + c);
                        const f32x4 h = x * rstd * g * (a + 1.f) + b;
                        o4[64 * jj] = pk4_fp8(h.x, h.y, h.z, h.w); } } }
        }
    }
#undef in
}

__device__ __forceinline__ void p7_scatter(Frame& F) {
    FT_DECL;
    LAS int* TOT = (LAS int*)F.lds;
    LAS int* BASE = TOT + 32;
    LAS int* PRE = BASE + 32;
    LAS int* PART = PRE + 32;
    const int* wgcnt = WSP(int, WS_ROUTE + RT_WGCNT); const int* topi_g = WSP(int, WS_ROUTE + RT_TOPI); const float* gate_g = WSP(float, WS_ROUTE + RT_GATE); const int* pos_g = WSP(int, WS_ROUTE + RT_POS);
    int* list = WSP(int, WS_ROUTE + RT_LIST); float* gslot = WSP(float, WS_ROUTE + RT_GSLOT); int* meta = WSP(int, WS_ROUTE + RT_META);
    const unsigned char* H2 = WSP(unsigned char, WS_H); unsigned char* XS = WSP(unsigned char, WS_XS);
    for (int blk = blockIdx.x; blk < MROWS / 128; blk += F.G) {
        __syncthreads();
        { const int e = f_tid & 31, part = f_tid >> 5; int st = 0, sp = 0;
            for (int w = part * 16; w < part * 16 + 16; ++w) { const int c = wgcnt[w * 32 + e]; st += c; if (w < blk) sp += c; }
            PART[part * 32 + e] = st; PART[512 + part * 32 + e] = sp; }
        __syncthreads();
        if (f_tid < 32) { int st = 0, sp = 0;
#pragma unroll
            for (int p = 0; p < 16; ++p) { st += PART[p * 32 + f_tid]; sp += PART[512 + p * 32 + f_tid]; }
            TOT[f_tid] = st; PRE[f_tid] = sp; }
        __syncthreads();
        if (f_tid == 0) { int b = 0; for (int e = 0; e < 32; ++e) { BASE[e] = b; b += (TOT[e] + 255) & ~255; }
            if (blk == 0) { int t = 0; for (int e = 0; e < 32; ++e) { meta[e] = TOT[e]; meta[32 + e] = BASE[e]; const int nt = (TOT[e] + 255) >> 8; for (int q = 0; q < nt; ++q) meta[128 + t + q] = e; t += nt; } meta[64] = t; } }
        __syncthreads();
        { const int a = f_tid, row = blk * 128 + (a >> 2); const int e = topi_g[(size_t)blk * 512 + a]; const int slot = BASE[e] + PRE[e] + pos_g[(size_t)blk * 512 + a];
            list[slot] = row * 4 + (a & 3); gslot[slot] = gate_g[(size_t)blk * 512 + a];
            PART[a] = slot; }
        __syncthreads();
        for (int a0 = F.wave * 8; a0 < 512; a0 += NWAVES * 8) { u32x4 v[8]; int sl[8];
#pragma unroll
            for (int q = 0; q < 8; ++q) { const int a = a0 + q; sl[q] = PART[a]; v[q] = ((const GAS u32x4*)(H2 + (size_t)(blk * 128 + (a >> 2)) * DM))[f_lane]; }
#pragma unroll
            for (int q = 0; q < 8; ++q) ((GAS u32x4*)(XS + (size_t)sl[q] * DM))[f_lane] = v[q]; }
        if (blk < NEXP) { const int e = blk, lo = BASE[e] + TOT[e], hi = BASE[e] + ((TOT[e] + 255) & ~255);
            for (int sl = lo + F.wave; sl < hi; sl += NWAVES) { if (f_lane == 0) { list[sl] = -1; gslot[sl] = 0.f; }
                ((GAS u32x4*)(XS + (size_t)sl * DM))[f_lane] = (u32x4){0u, 0u, 0u, 0u}; } }
    }
}

template <int NPN> struct SchedMoE {
    int G, c, nT; const char* A; const char* W; size_t wstride; const LAS unsigned char* tileE;
    __device__ __forceinline__ bool next(int i, g8::Unit& u) const {
        const int L = i * G + c, xcd = L & 7, j = L >> 3, T = (j / NPN) * 8 + xcd, pn = j % NPN;
        if (T >= nT) return false;
        const int e = tileE[T];
        u.pm = T; u.pn = pn; u.kind = i; u.ex = e; u.a = A + (size_t)T * 256 * DM; u.b = W + (size_t)e * wstride + (size_t)pn * 256 * DM; return true;
    }
};
struct EpiSwiGLU {
    unsigned char* ACT; const float* b1;
    __device__ __forceinline__ void operator()(f32x4 (&acc)[2][2][4][2], const g8::Unit& u, int wr, int wc, int fr, int fq) const {
        asm volatile("" : "+v"(fr), "+v"(fq));
        const int j0 = u.pn * 128 + wc * 32 + 8 * fq; const float* bp = b1 + (size_t)u.ex * 2 * DM + j0;
        f32x4 bg[2], bl[2];
#pragma unroll
        for (int n = 0; n < 2; ++n) { bg[n] = *(const f32x4*)(bp + 4 * n); bl[n] = *(const f32x4*)(bp + DM + 4 * n); }
#pragma unroll
        for (int ai = 0; ai < 2; ++ai)
#pragma unroll
            for (int m = 0; m < 4; ++m) { const size_t slot = (size_t)u.pm * 256 + ai * 128 + wr * 64 + m * 16 + fr; float o[8];
#pragma unroll
                for (int n = 0; n < 2; ++n) { const f32x4 g4 = acc[ai][0][m][n] * (1.f / WSCALE) + bg[n], l4 = acc[ai][1][m][n] * (1.f / WSCALE) + bl[n];
#pragma unroll
                    for (int e = 0; e < 4; ++e) { const float g = fminf(g4[e], 7.f), l = __builtin_amdgcn_fmed3f(l4[e], -7.f, 7.f);
                        const float ex = __builtin_amdgcn_exp2f(g * (-1.702f * 1.4426950408889634f)); const float glu = g * __builtin_amdgcn_rcpf(1.f + ex);
                        o[4 * n + e] = fmaf(l, glu, glu); } }
                u32x2 w; w.x = pk4_fp8(o[0], o[1], o[2], o[3]); w.y = pk4_fp8(o[4], o[5], o[6], o[7]);
                *(u32x2*)(ACT + slot * DM + j0) = w; }
    }
};
struct EpiDown {
    unsigned char* EO; const float* b2; const LAS int* LL; int G, c;
    __device__ __forceinline__ void operator()(f32x4 (&acc)[2][2][4][2], const g8::Unit& u, int wr, int wc, int fr, int fq) const {
        asm volatile("" : "+v"(fr), "+v"(fq));
        const int c0 = u.pn * 256 + wc * 32 + 8 * fq; const float* bp = b2 + (size_t)u.ex * DM + c0;
        f32x4 bb[2][2];
#pragma unroll
        for (int bj = 0; bj < 2; ++bj)
#pragma unroll
            for (int n = 0; n < 2; ++n) bb[bj][n] = *(const f32x4*)(bp + bj * 128 + 4 * n);
        const LAS int* L = LL + u.kind * 512;
        int li[8]; float gt[8];
#pragma unroll
        for (int q = 0; q < 8; ++q) { const int rl = (q >> 2) * 128 + wr * 64 + (q & 3) * 16 + fr; li[q] = L[rl]; gt[q] = __int_as_float(L[256 + rl]) * (1.f / WSCALE); }
#pragma unroll
        for (int ai = 0; ai < 2; ++ai)
#pragma unroll
            for (int m = 0; m < 4; ++m) { const int l = li[ai * 4 + m]; const float g = gt[ai * 4 + m];
                unsigned char* dst = EO + ((size_t)(l & 3) * MROWS + (l >> 2)) * DM + c0;
                u32x2 w[2];
#pragma unroll
                for (int bj = 0; bj < 2; ++bj) { const f32x4 v0 = acc[ai][bj][m][0] * g + bb[bj][0] * (g * WSCALE), v1 = acc[ai][bj][m][1] * g + bb[bj][1] * (g * WSCALE);
                    w[bj].x = pk4_fp8(v0[0] * EOSCALE, v0[1] * EOSCALE, v0[2] * EOSCALE, v0[3] * EOSCALE); w[bj].y = pk4_fp8(v1[0] * EOSCALE, v1[1] * EOSCALE, v1[2] * EOSCALE, v1[3] * EOSCALE); }
                if (l >= 0) { *(u32x2*)dst = w[0]; *(u32x2*)(dst + 128) = w[1]; } }
    }
};
__device__ __forceinline__ const LAS unsigned char* moe_tiles(Frame& F, int& nT) {
    FT_DECL;
    LAS unsigned char* TE = (LAS unsigned char*)(F.lds + RING_BYTES); const int* meta = WSP(int, WS_ROUTE + RT_META);
    __syncthreads();
    nT = meta[64]; if (nT > MAXTILE) nT = MAXTILE;
    for (int i = f_tid; i < MAXTILE; i += 512) TE[i] = (unsigned char)((i < nT) ? meta[128 + i] : 0);
    __syncthreads();
    return (const LAS unsigned char*)TE;
}

__device__ __forceinline__ void p10_combine(Frame& F) {
    FT_DECL;
    const float* mod = WSP(float, WS_SMALL + SM_MOD); const unsigned char* EO = WSP(unsigned char, WS_EO);
    const size_t gt = (size_t)F.vcu * 512 + f_tid, NTH = (size_t)F.G * 512;
    float pd = 0.f, pa = 0.f;
    if (MK_PROBE_A != -2) { const unsigned long long* st = (const unsigned long long*)(F.ws + WS_CTL + 8192);
        pd = (MK_PROBE_A < 0) ? 0.1f : (float)(st[MK_PA1] - st[MK_PA0]) * MK_PSA; pa = (float)(st[MK_PB1] - st[MK_PB0]) * MK_PSB; }
    constexpr int U = 4;
    for (size_t i0 = gt; i0 < (size_t)MROWS * 128; i0 += NTH * U) {
        u32x2 ev[U][4]; f32x4 xv[U][2], gv[U][2];
#pragma unroll
        for (int u = 0; u < U; ++u) { const size_t i = i0 + (size_t)u * NTH; const size_t row = i >> 7; const int c0 = (int)(i & 127) * 8;
            const float* g2 = mod + (size_t)(row >> 12) * (NMOD * DM) + 5 * DM + c0; const bf16_t* op = WSP(bf16_t, WS_XN) + row * DM + c0;
#pragma unroll
            for (int k = 0; k < 4; ++k) ev[u][k] = __builtin_nontemporal_load((const u32x2*)(EO + ((size_t)k * MROWS + row) * DM + c0));
            { const u32x4 xb = *(const u32x4*)op; xv[u][0] = (f32x4){__uint_as_float(xb.x << 16), __uint_as_float(xb.x & 0xffff0000u), __uint_as_float(xb.y << 16), __uint_as_float(xb.y & 0xffff0000u)};
              xv[u][1] = (f32x4){__uint_as_float(xb.z << 16), __uint_as_float(xb.z & 0xffff0000u), __uint_as_float(xb.w << 16), __uint_as_float(xb.w & 0xffff0000u)}; }
            gv[u][0] = *(const f32x4*)g2; gv[u][1] = *(const f32x4*)(g2 + 4); }
#pragma unroll
        for (int u = 0; u < U; ++u) { const size_t i = i0 + (size_t)u * NTH; const size_t row = i >> 7; const int c0 = (int)(i & 127) * 8;
            float s[8];
#pragma unroll
            for (int e = 0; e < 8; ++e) s[e] = 0.f;
#pragma unroll
            for (int k = 0; k < 4; ++k) { const u32x2 v = ev[u][k];
                const f32x2 a = __builtin_amdgcn_cvt_pk_f32_fp8((int)v.x, false), b = __builtin_amdgcn_cvt_pk_f32_fp8((int)v.x, true), c = __builtin_amdgcn_cvt_pk_f32_fp8((int)v.y, false), d = __builtin_amdgcn_cvt_pk_f32_fp8((int)v.y, true);
                s[0] += a.x; s[1] += a.y; s[2] += b.x; s[3] += b.y; s[4] += c.x; s[5] += c.y; s[6] += d.x; s[7] += d.y; }
#pragma unroll
            for (int e = 0; e < 8; ++e) s[e] *= (1.f / EOSCALE);
            f32x4 o0 = xv[u][0] + gv[u][0] * (f32x4){s[0], s[1], s[2], s[3]}, o1 = xv[u][1] + gv[u][1] * (f32x4){s[4], s[5], s[6], s[7]};
            if (MK_PROBE_A != -2) { o0 += pd; o1 += pd; if (i == 0) o0[0] += pa; }
            float* op = F.out + row * DM + c0;
            __builtin_nontemporal_store(o0, (f32x4*)op); __builtin_nontemporal_store(o1, (f32x4*)(op + 4)); }
    }
}

struct Args { const float* in[34]; float* out; unsigned char* ws; int ph_lo, ph_hi; };
constexpr int N_PHASES = 11;

__global__ void __launch_bounds__(512, 2) mega(Args args) {
    extern __shared__ __attribute__((aligned(16))) unsigned char lds[];
    Frame F;
    F.lds = (LAS unsigned char*)lds;
    F.MISC = (volatile LAS unsigned*)(F.lds + LDSCTL_OFF);
    F.wave = __builtin_amdgcn_readfirstlane(threadIdx.x >> 6);
    FT_DECL;
    F.G = gridDim.x; { const int bx = blockIdx.x; F.vcu = (F.G % 8 == 0) ? (bx % 8) * (F.G / 8) + bx / 8 : bx; }
    F.in = (kin_t)__builtin_amdgcn_kernarg_segment_ptr();
    F.out = args.out; F.ws = args.ws;
    F.ctl = (gu32*)(args.ws + WS_CTL);
    for (int u = f_tid; u < (LDS_BYTES - LDSCTL_OFF) / 4; u += NWAVES * 64) ((LAS unsigned*)(F.lds + LDSCTL_OFF))[u] = 0u;
    __syncthreads();
    const int lo = args.ph_lo, hi = args.ph_hi;
    XcdBarrier bar; bar.bar = (unsigned*)(F.ctl + CW_BAR); bar.x = 0; bar.st = nullptr;
    if (hi - lo > 1) bar = xcd_barrier_post((unsigned*)(F.ctl + CW_BAR), F.MISC + 8, f_tid == 0);
#define IN(k) (lo <= (k) && (k) < hi)
    unsigned long long* stamps = (unsigned long long*)(args.ws + WS_CTL + 8192);
#define STAMP(k) do { if (MK_PROBE_A != -2 && blockIdx.x == 0 && f_tid == 0) stamps[(k)] = __builtin_amdgcn_s_memrealtime(); } while (0)
    STAMP(0);
#define SEAM(k) do { if (IN(k) && IN((k) + 1)) xcd_barrier(bar, F.wave == 0 && lane_id() == 0); } while (0)

    if (IN(0)) { p0_prologue(F); } SEAM(0); STAMP(1);
    if (IN(1)) { p1_norm1(F); } SEAM(1); STAMP(2);
    if (IN(2)) {
        SchedInProj S{F.G, (int)blockIdx.x, (const char*)WSP(bf16_t, WS_H), (const char*)WSP(bf16_t, WS_WIN)};
        EpiInProj E{WSP(unsigned char, WS_Q), WSP(unsigned char, WS_K), WSP(unsigned char, WS_V), WSP(bf16_t, WS_UT), F.in[9], F.in[10], WSP(float, WS_SMALL + SM_ROPE)};
        g8::gemm_phase<false>(F.lds, DM, S, E, F.wave, lane_id());
    } SEAM(2); STAMP(3);
    if (IN(3)) { p3_attention8(F); STAMP(12); p3_hyena(F); } SEAM(3); STAMP(4);
    if (IN(4)) { p4_hynorm(F); } SEAM(4); STAMP(5);
    if (IN(5)) {
        SchedStatic S{F.G, (int)blockIdx.x, MROWS / 256, DM / 256, (const char*)WSP(bf16_t, WS_MIX), (const char*)WSP(bf16_t, WS_WOUT)};
        EpiOutProj E{F.in[0], WSP(bf16_t, WS_XN), WSP(float, WS_SMALL + SM_MOD)};
        g8::gemm_phase<false>(F.lds, DM, S, E, F.wave, lane_id());
    } SEAM(5); STAMP(6);
    if (IN(6)) { p6_router_mfma(F); } SEAM(6); STAMP(7);
    if (IN(7)) { p7_scatter(F); } SEAM(7); STAMP(8);
    if (IN(8)) {
        int nT; const LAS unsigned char* TE = moe_tiles(F, nT);
        SchedMoE<8> S{F.G, (int)blockIdx.x, nT, (const char*)WSP(char, WS_XS), (const char*)WSP(char, WS_W1), (size_t)2 * DM * DM, TE};
        EpiSwiGLU E{WSP(unsigned char, WS_ACT), F.in[31]};
        g8::gemm_phase<true>(F.lds, DM, S, E, F.wave, lane_id());
    } SEAM(8); STAMP(9);
    if (IN(9)) {
        int nT; const LAS unsigned char* TE = moe_tiles(F, nT);
        SchedMoE<4> S{F.G, (int)blockIdx.x, nT, (const char*)WSP(char, WS_ACT), (const char*)WSP(char, WS_W2), (size_t)DM * DM, TE};
        LAS int* LL = (LAS int*)(F.lds + RING_BYTES + 1024);
        static_assert(RING_BYTES + 1024 + 9 * 2048 <= LDSCTL_OFF, "LDS map");
        { const int* list = WSP(int, WS_ROUTE + RT_LIST); const float* gslot = WSP(float, WS_ROUTE + RT_GSLOT);
            const int t9 = F.wave * 64 + lane_id();
            g8::Unit u; for (int i = 0; i < 9 && S.next(i, u); ++i) { const int t = t9 & 255; const size_t slot = (size_t)u.pm * 256 + t;
                LL[i * 512 + (t9 >> 8) * 256 + t] = (t9 < 256) ? list[slot] : __float_as_int(gslot[slot]); }
            __syncthreads(); }
        EpiDown E{WSP(unsigned char, WS_EO), F.in[33], LL, F.G, (int)blockIdx.x};
        g8::gemm_phase<true>(F.lds, DM, S, E, F.wave, lane_id());
    } SEAM(9); STAMP(10);
    if (IN(10)) { p10_combine(F); }
#undef IN
#undef SEAM
}

extern "C" void kernel_launch(void* const* d_in, const int* in_sizes, int n_in, void* d_out, int out_size, void* d_ws, size_t ws_size, hipStream_t stream) {
    static int grid = 0;
    if (grid == 0) {
        if (n_in != 34 || out_size != MROWS * DM || ws_size < WS_END) { fprintf(stderr, "kernel_launch: unexpected shapes: n_in %d out %d ws %zu (need %zu)\n", n_in, out_size, ws_size, (size_t)WS_END); grid = -1; return; }
        int dev = 0, cus = 0, per_cu = 0;
        if (hipGetDevice(&dev) != hipSuccess || hipDeviceGetAttribute(&cus, hipDeviceAttributeMultiprocessorCount, dev) != hipSuccess) { grid = -1; return; }
        if (hipFuncSetAttribute((const void*)mega, hipFuncAttributeMaxDynamicSharedMemorySize, LDS_BYTES) != hipSuccess) { fprintf(stderr, "kernel_launch: hipFuncSetAttribute failed\n"); grid = -1; return; }
        if (hipOccupancyMaxActiveBlocksPerMultiprocessor(&per_cu, (const void*)mega, NWAVES * 64, LDS_BYTES) != hipSuccess || per_cu < 1) { fprintf(stderr, "kernel_launch: occupancy query says %d\n", per_cu); per_cu = 1; }
        (void)hipGetLastError();
        grid = cus;
    }
    if (grid < 0) return;
    (void)hipMemsetAsync((char*)d_ws + WS_CTL, 0, CTL_ZERO_BYTES, stream);
    Args a{};
    for (int i = 0; i < 34; ++i) a.in[i] = (const float*)d_in[i];
    a.out = (float*)d_out; a.ws = (unsigned char*)d_ws;
    constexpr int LAST = MK_LAST_PHASE + 1;
    if (MK_N_LAUNCHES == 1) { a.ph_lo = 0; a.ph_hi = LAST; hipLaunchKernelGGL(mega, dim3(grid), dim3(NWAVES * 64), LDS_BYTES, stream, a); }
    else for (int p = 0; p < LAST; ++p) { a.ph_lo = p; a.ph_hi = p + 1; hipLaunchKernelGGL(mega, dim3(grid), dim3(NWAVES * 64), LDS_BYTES, stream, a); }
    const hipError_t le = hipPeekAtLastError();
    if (le != hipSuccess) fprintf(stderr, "kernel_launch: launch failed: %s\n", hipGetErrorName(le));
}
```

```cpp
#include <hip/hip_runtime.h>
#include <hip/hip_bf16.h>
#include <cstdio>
#include <cstdint>

#ifndef MK_N_LAUNCHES
#define MK_N_LAUNCHES 1
#endif
#ifndef MK_PROBE_A
#define MK_PROBE_A -2
#endif
#ifndef MK_PA0
#define MK_PA0 0
#define MK_PA1 1
#define MK_PB0 0
#define MK_PB1 1
#define MK_PSA 2e-6f
#define MK_PSB 1e-4f
#endif
#ifndef MK_LAST_PHASE
#define MK_LAST_PHASE 10
#endif

#define GAS __attribute__((address_space(1)))
#define LAS __attribute__((address_space(3)))
typedef unsigned short bf16_t;
typedef short bf16x8 __attribute__((ext_vector_type(8)));
typedef short s16x4 __attribute__((ext_vector_type(4)));
typedef float f32x2 __attribute__((ext_vector_type(2)));
typedef float f32x4 __attribute__((ext_vector_type(4)));
typedef float f32x16 __attribute__((ext_vector_type(16)));
typedef unsigned u32x2 __attribute__((ext_vector_type(2)));
typedef unsigned u32x4 __attribute__((ext_vector_type(4)));
typedef GAS unsigned gu32;

constexpr int NB = 8, SEQ = 4096, DM = 1024, MROWS = NB * SEQ, CTXL = 256, MCTX = NB * CTXL, MTOT = MROWS + MCTX;
constexpr int KVL = CTXL + SEQ;
constexpr int NHEAD = 4, QKW = 512;
constexpr int HYW = 512, HYC = 1536, INC = 3072, QKVC = 1536;
constexpr int NEXP = 32, TOPK = 4, NMOD = 6;
constexpr float EPS = 1e-6f;
constexpr float LAM_INIT = 0.2f;
constexpr float QSCALE = 0.125f * 1.4426950408889634f;

constexpr size_t MiB = 1u << 20;
constexpr size_t WS_CTL = 0, CTL_ZERO_BYTES = 1 * MiB;
constexpr size_t WS_SMALL = 1 * MiB;
constexpr size_t WS_WIN = 2 * MiB;
constexpr size_t WS_WOUT = 8 * MiB;
constexpr size_t WS_W1 = 10 * MiB;
constexpr size_t WS_W2 = 138 * MiB;
constexpr size_t WS_H = 202 * MiB;
constexpr size_t WS_Q = 270 * MiB;
constexpr size_t WS_K = 302 * MiB;
constexpr size_t WS_V = 336 * MiB;
constexpr size_t WS_UT = 370 * MiB;
constexpr size_t WS_FILT = 466 * MiB;
constexpr size_t WS_Z2T = 498 * MiB;
constexpr size_t WS_MIX = 530 * MiB;
constexpr size_t WS_ROUTE = 594 * MiB;
constexpr size_t WS_ACT = 270 * MiB;
constexpr size_t WS_EO = 598 * MiB;
constexpr size_t WS_XN = 870 * MiB;
constexpr size_t WS_END = 998 * MiB;
constexpr size_t SM_MOD = 0;
constexpr size_t SM_SCAL = 256 * 1024;
constexpr size_t SM_ROPE = 260 * 1024;
constexpr int CW_BAR = 4096;

constexpr int RING_BYTES = 131072;
constexpr int LDSCTL_OFF = 151552;
constexpr int LDS_BYTES = 152576;
constexpr int NWAVES = 8;

#define LDS_WAIT() asm volatile("s_waitcnt lgkmcnt(0)" ::: "memory")
#define VM_WAIT() asm volatile("s_waitcnt vmcnt(0)" ::: "memory")
#define RLX_AGENT __ATOMIC_RELAXED, __HIP_MEMORY_SCOPE_AGENT

__device__ __forceinline__ unsigned cvt_pk_bf16(float lo, float hi) { unsigned r; asm volatile("v_cvt_pk_bf16_f32 %0, %1, %2" : "=v"(r) : "v"(lo), "v"(hi)); return r; }
__device__ __forceinline__ float bf2f(bf16_t v) { return __uint_as_float(((unsigned)v) << 16); }
__device__ __forceinline__ float wave_sum(float v) {
#pragma unroll
    for (int o = 1; o < 64; o <<= 1) v += __shfl_xor(v, o);
    return v;
}

#define XB_TMO      128
#define XB_XCNT(j)  (256  + 64 * (j))
#define XB_XSUB(j)  (1280 + 64 * (j))
#define XB_XGEN(j)  (2304 + 64 * (j))
#define XB_TOP      3328
#define XB_TOPGEN   3392
#define XCD_BAR_WORDS 3456
#define XB_SPIN_CAP (1u << 22)
__device__ __forceinline__ unsigned xb_ld(unsigned* p)              { return __hip_atomic_load(p, __ATOMIC_RELAXED, __HIP_MEMORY_SCOPE_AGENT); }
__device__ __forceinline__ unsigned xb_add(unsigned* p, unsigned v) { return __hip_atomic_fetch_add(p, v, __ATOMIC_RELAXED, __HIP_MEMORY_SCOPE_AGENT); }
__device__ __forceinline__ unsigned xb_xcc_id() { return (unsigned)__builtin_amdgcn_s_getreg((3 << 11) | 20) & 0xFu; }
#define XB_SPIN(cond, bar) do { unsigned _sp = 0; while (cond) { __builtin_amdgcn_s_sleep(1); \
    if ((++_sp & 255u) == 0u) { if (xb_ld(&(bar)[XB_TMO])) break; if (_sp > XB_SPIN_CAP) { atomicAdd(&(bar)[XB_TMO], 1u); break; } } } } while (0)
struct XcdBarrier { unsigned* bar; unsigned x; volatile LAS unsigned* st; };
__device__ __forceinline__ XcdBarrier xcd_barrier_post(unsigned* bar, volatile LAS unsigned* st, bool leader) {
    XcdBarrier b; b.bar = bar; b.x = xb_xcc_id(); b.st = st;
    if (leader) (void)xb_add(&bar[XB_XCNT(b.x)], 1u);
    return b;
}
__device__ __forceinline__ void xcd_barrier_complete(unsigned* bar, unsigned x, unsigned& nloc, unsigned& nx) {
    const unsigned G = gridDim.x * gridDim.y * gridDim.z;
    unsigned sum, cnt, mine, sp = 0u;
    for (;;) {
        sum = 0u; cnt = 0u; mine = 0u;
#pragma unroll
        for (unsigned j = 0; j < 16; ++j) { const unsigned c = xb_ld(&bar[XB_XCNT(j)]); sum += c; cnt += (c > 0u) ? 1u : 0u; mine = (j == x) ? c : mine; }
        if (sum == G) break;
        __builtin_amdgcn_s_sleep(1);
        if ((++sp & 255u) == 0u) { if (xb_ld(&bar[XB_TMO])) break; if (sp > XB_SPIN_CAP) { atomicAdd(&bar[XB_TMO], 1u); break; } }
    }
    nloc = mine > 0u ? mine : 1u; nx = cnt > 0u ? cnt : 1u;
}
__device__ __forceinline__ void xcd_barrier(const XcdBarrier& b, bool leader) {
    asm volatile("s_waitcnt vmcnt(0)" ::: "memory");
    __syncthreads();
    if (leader) {
        unsigned* bar = b.bar;
        __builtin_amdgcn_s_waitcnt(0);
        unsigned nloc = b.st[0], nx = b.st[1];
        if (nloc == 0u) { xcd_barrier_complete(bar, b.x, nloc, nx); b.st[0] = nloc; b.st[1] = nx; }
        const unsigned old = xb_add(&bar[XB_XSUB(b.x)], 1u);
        const unsigned gen = old / nloc;
        if (old + 1u == (gen + 1u) * nloc) {
            __builtin_amdgcn_fence(__ATOMIC_RELEASE, "agent");
            asm volatile("s_waitcnt vmcnt(0)" ::: "memory");
            const unsigned og = xb_add(&bar[XB_TOP], 1u);
            const unsigned tg = og / nx;
            if (og + 1u == (tg + 1u) * nx) xb_add(&bar[XB_TOPGEN], 1u);
            else XB_SPIN(xb_ld(&bar[XB_TOPGEN]) == tg, bar);
            __builtin_amdgcn_fence(__ATOMIC_ACQUIRE, "agent");
            xb_add(&bar[XB_XGEN(b.x)], 1u);
            asm volatile("s_waitcnt vmcnt(0)" ::: "memory");
        } else {
            XB_SPIN(xb_ld(&bar[XB_XGEN(b.x)]) == gen, bar);
            __builtin_amdgcn_fence(__ATOMIC_ACQUIRE, "agent");
            asm volatile("s_waitcnt vmcnt(0)" ::: "memory");
        }
    }
    __syncthreads();
}

namespace g8 {
constexpr int BM = 256, BK = 64, HALF = 128, HTB = HALF * BK * 2, STAGE_BYTES = 8 * HTB, NXCD = 8, WGM = 8;
__host__ __device__ __forceinline__ int lds_byte(int r, int c) { const int st = (r >> 4) * 2 + (c >> 5), rr = r & 15, cc = c & 31, ob = rr * 64 + cc * 2; return st * 1024 + (ob ^ (((ob >> 9) & 1) << 5)); }
__host__ __device__ __forceinline__ void stage_rc(int b, int& R, int& C) { const int st = b / 1024, sb = b % 1024, swz = sb ^ (((sb >> 9) & 1) << 5); R = (st >> 1) * 16 + swz / 64; C = (st & 1) * 32 + (swz % 64) / 2; }
__host__ __device__ __forceinline__ int perm32(int rho) { const int n = rho >> 4, i = rho & 15; return 8 * (i >> 2) + 4 * n + (i & 3); }

struct Unit { const char* a; const char* b; int pm, pn, kind, ex; };

__device__ __forceinline__ void tile_of(int L, int nM, int nN, int& pm, int& pn) {
    const int nwg = nM * nN; int wgid = L;
    { const int q = nwg / NXCD, r = nwg % NXCD, xcd = wgid % NXCD, off = wgid / NXCD; wgid = (xcd < r ? xcd * (q + 1) : r * (q + 1) + (xcd - r) * q) + off; }
    const int nig = WGM * nN, gid = wgid / nig, fm = gid * WGM, gsz = (nM - fm) < WGM ? (nM - fm) : WGM;
    pm = fm + ((wgid % nig) % gsz); pn = (wgid % nig) / gsz;
}

typedef int i32x8 __attribute__((ext_vector_type(8)));
template <bool FP8, class Epi, class Sched>
__device__ __forceinline__ void gemm_phase(LAS unsigned char* lds, const int K, const Sched& S, const Epi& E, const int wid, const int lane) {
    const int tid = wid * 64 + lane, wr = wid >> 2, wc = wid & 3, fr = lane & 15, fq = lane >> 4;
    const int nt = FP8 ? K / 128 : K / BK;
    const int RP = FP8 ? K : 2 * K;
    unsigned voffA[2], voffB[2];
#pragma unroll
    for (int i = 0; i < 2; ++i) { int R, C; stage_rc(tid * 16 + i * 8192, R, C); const int Rb = (R & ~31) + perm32(R & 31);
        voffA[i] = (unsigned)(R * RP + C * 2); voffB[i] = (unsigned)(Rb * RP + C * 2); }
    const size_t kstep = (size_t)(BK * 2);
    const size_t hstep = (size_t)HALF * RP;
    const unsigned ldsw = (unsigned)wid * 1024u;
    const int aoff = lds_byte(wr * 64 + fr, FP8 ? fq * 16 : fq * 8), boff = lds_byte(wc * 32 + fr, FP8 ? fq * 16 : fq * 8);
    constexpr int KOFF = FP8 ? 16 : 1024;
#define PG8_SA(b, h) (((b) * 2 + (h)) * HTB)
#define PG8_SB(b, h) ((4 + (b) * 2 + (h)) * HTB)
#define PG8_STAGE(bufoff, gbase, voff) do { _Pragma("unroll") for (int _i = 0; _i < 2; ++_i) \
        __builtin_amdgcn_global_load_lds((const unsigned*)((const char*)(gbase) + (voff)[_i]), (LAS unsigned*)(lds + (bufoff) + ldsw + _i * 8192), 16, 0, 0); } while (0)
#define PG8_LD32(p) __builtin_bit_cast(i32x8, __builtin_shufflevector(*(const LAS u32x4*)(p), *(const LAS u32x4*)((p) + 16), 0, 1, 2, 3, 4, 5, 6, 7))
#define PG8_LDA8(dst, b, h) do { _Pragma("unroll") for (int m = 0; m < 4; ++m) dst[m] = PG8_LD32(lds + PG8_SA(b, h) + aoff + m * 2048); } while (0)
#define PG8_LDB8(dst, b, h) do { _Pragma("unroll") for (int n = 0; n < 2; ++n) dst[n] = PG8_LD32(lds + PG8_SB(b, h) + boff + n * 2048); } while (0)
#define PG8_LDA(dst, b, h) do { _Pragma("unroll") for (int m = 0; m < 4; ++m) _Pragma("unroll") for (int k = 0; k < 2; ++k) dst[m][k] = *(const LAS bf16x8*)(lds + PG8_SA(b, h) + aoff + m * 2048 + k * KOFF); } while (0)
#define PG8_LDB(dst, b, h) do { _Pragma("unroll") for (int n = 0; n < 2; ++n) _Pragma("unroll") for (int k = 0; k < 2; ++k) dst[n][k] = *(const LAS bf16x8*)(lds + PG8_SB(b, h) + boff + n * 2048 + k * KOFF); } while (0)
#define PG8_MMA(ai, bj, At, Bt) do { __builtin_amdgcn_s_setprio(1); _Pragma("unroll") for (int m = 0; m < 4; ++m) _Pragma("unroll") for (int n = 0; n < 2; ++n) _Pragma("unroll") for (int k = 0; k < 2; ++k) \
        acc[ai][bj][m][n] = __builtin_amdgcn_mfma_f32_16x16x32_bf16(Bt[n][k], At[m][k], acc[ai][bj][m][n], 0, 0, 0); __builtin_amdgcn_s_setprio(0); } while (0)
#define PG8_MMA8(ai, bj, At, Bt) do { __builtin_amdgcn_s_setprio(1); _Pragma("unroll") for (int m = 0; m < 4; ++m) _Pragma("unroll") for (int n = 0; n < 2; ++n) \
        asm volatile("v_mfma_scale_f32_16x16x128_f8f6f4 %0, %1, %2, %0, %3, %3 op_sel_hi:[0,0,0]" : "+v"(acc[ai][bj][m][n]) : "v"(Bt[n]), "v"(At[m]), "v"(one_scale)); __builtin_amdgcn_s_setprio(0); } while (0)
#define PG8_WAIT_V(n) asm volatile("s_waitcnt vmcnt(" #n ")" ::: "memory")
#define PG8_WAIT_L(n) asm volatile("s_waitcnt lgkmcnt(" #n ")" ::: "memory")
#define PG8_BAR __builtin_amdgcn_s_barrier()
#define PG8_SCHED __builtin_amdgcn_sched_barrier(0)
    Unit cur, nxt; int ui = 0;
    if (!S.next(0, cur)) return;
    f32x4 acc[2][2][4][2];
#pragma unroll
    for (int a = 0; a < 2; ++a)
#pragma unroll
        for (int b = 0; b < 2; ++b)
#pragma unroll
            for (int m = 0; m < 4; ++m)
#pragma unroll
                for (int n = 0; n < 2; ++n) acc[a][b][m][n] = (f32x4){0.f, 0.f, 0.f, 0.f};
    bf16x8 At[4][2], B0[2][2], B1[2][2];
    i32x8 At8[4], B08[2], B18[2];
    const unsigned one_scale = 0x7f7f7f7fu;
    const char* cA = cur.a; const char* cB = cur.b;
    PG8_STAGE(PG8_SB(0, 0), cB, voffB); PG8_STAGE(PG8_SB(0, 1), cB + hstep, voffB); PG8_STAGE(PG8_SA(0, 0), cA, voffA); PG8_STAGE(PG8_SA(0, 1), cA + hstep, voffA);
    if (wr == 1) PG8_BAR;
    PG8_WAIT_V(2); PG8_BAR;
    PG8_STAGE(PG8_SB(1, 0), cB + kstep, voffB); PG8_STAGE(PG8_SA(1, 0), cA + kstep, voffA); PG8_STAGE(PG8_SB(1, 1), cB + hstep + kstep, voffB);
    PG8_WAIT_V(6); PG8_BAR;
    for (;;) {
        const bool has_next = S.next(ui + 1, nxt);
        const char* nA = has_next ? nxt.a : cA; const char* nB = has_next ? nxt.b : cB;
#pragma unroll 1
        for (int t = 0; t < nt; t += 2) {
            const bool last = (t == nt - 2);
            const char* a1 = cA + (size_t)(t + 1) * kstep;
            const char* a2 = last ? nA : cA + (size_t)(t + 2) * kstep; const char* b2 = last ? nB : cB + (size_t)(t + 2) * kstep;
            const char* a3 = a2 + kstep; const char* b3 = b2 + kstep;
            if constexpr (FP8) {
            PG8_LDB8(B08, 0, 0); PG8_LDB8(B18, 0, 1); PG8_SCHED; PG8_LDA8(At8, 0, 0); PG8_STAGE(PG8_SA(1, 1), a1 + hstep, voffA);
            PG8_WAIT_V(8); PG8_WAIT_L(0); PG8_BAR; PG8_MMA8(0, 0, At8, B08); PG8_MMA8(0, 1, At8, B18); PG8_BAR; PG8_SCHED;
            PG8_LDA8(At8, 0, 1); PG8_STAGE(PG8_SB(0, 0), b2, voffB); PG8_STAGE(PG8_SB(0, 1), b2 + hstep, voffB); PG8_STAGE(PG8_SA(0, 0), a2, voffA);
            PG8_WAIT_V(8); PG8_WAIT_L(0); PG8_BAR; PG8_MMA8(1, 0, At8, B08); PG8_MMA8(1, 1, At8, B18); PG8_BAR; PG8_SCHED;
            PG8_LDB8(B08, 1, 0); PG8_LDB8(B18, 1, 1); PG8_SCHED; PG8_LDA8(At8, 1, 0); PG8_STAGE(PG8_SA(0, 1), a2 + hstep, voffA);
            PG8_WAIT_V(8); PG8_WAIT_L(0); PG8_BAR; PG8_MMA8(0, 0, At8, B08); PG8_MMA8(0, 1, At8, B18); PG8_BAR; PG8_SCHED;
            PG8_LDA8(At8, 1, 1); PG8_STAGE(PG8_SB(1, 0), b3, voffB); PG8_STAGE(PG8_SB(1, 1), b3 + hstep, voffB); PG8_STAGE(PG8_SA(1, 0), a3, voffA);
            PG8_WAIT_V(8); PG8_WAIT_L(0); PG8_BAR; PG8_MMA8(1, 0, At8, B08); PG8_MMA8(1, 1, At8, B18); PG8_BAR; PG8_SCHED;
            } else {
            PG8_LDB(B0, 0, 0); PG8_LDB(B1, 0, 1); PG8_SCHED; PG8_LDA(At, 0, 0); PG8_STAGE(PG8_SA(1, 1), a1 + hstep, voffA);
            PG8_WAIT_V(8); PG8_WAIT_L(0); PG8_BAR; PG8_MMA(0, 0, At, B0); PG8_MMA(0, 1, At, B1); PG8_BAR; PG8_SCHED;
            PG8_LDA(At, 0, 1); PG8_STAGE(PG8_SB(0, 0), b2, voffB); PG8_STAGE(PG8_SB(0, 1), b2 + hstep, voffB); PG8_STAGE(PG8_SA(0, 0), a2, voffA);
            PG8_WAIT_V(8); PG8_WAIT_L(0); PG8_BAR; PG8_MMA(1, 0, At, B0); PG8_MMA(1, 1, At, B1); PG8_BAR; PG8_SCHED;
            PG8_LDB(B0, 1, 0); PG8_LDB(B1, 1, 1); PG8_SCHED; PG8_LDA(At, 1, 0); PG8_STAGE(PG8_SA(0, 1), a2 + hstep, voffA);
            PG8_WAIT_V(8); PG8_WAIT_L(0); PG8_BAR; PG8_MMA(0, 0, At, B0); PG8_MMA(0, 1, At, B1); PG8_BAR; PG8_SCHED;
            PG8_LDA(At, 1, 1); PG8_STAGE(PG8_SB(1, 0), b3, voffB); PG8_STAGE(PG8_SB(1, 1), b3 + hstep, voffB); PG8_STAGE(PG8_SA(1, 0), a3, voffA);
            PG8_WAIT_V(8); PG8_WAIT_L(0); PG8_BAR; PG8_MMA(1, 0, At, B0); PG8_MMA(1, 1, At, B1); PG8_BAR; PG8_SCHED;
            }
        }
        if (wr == 0) PG8_BAR;
        if constexpr (FP8) asm volatile("s_nop 15\n\ts_nop 15" ::: "memory");
        E(acc, cur, wr, wc, fr, fq);
        if (!has_next) break;
#pragma unroll
        for (int a = 0; a < 2; ++a)
#pragma unroll
            for (int b = 0; b < 2; ++b)
#pragma unroll
                for (int m = 0; m < 4; ++m)
#pragma unroll
                    for (int n = 0; n < 2; ++n) acc[a][b][m][n] = (f32x4){0.f, 0.f, 0.f, 0.f};
        cur = nxt; cA = nA; cB = nB; ++ui;
        if (wr == 1) PG8_BAR;
    }
    PG8_WAIT_V(0);
    PG8_BAR;
#undef PG8_SA
#undef PG8_SB
#undef PG8_STAGE
#undef PG8_LDA
#undef PG8_LDB
#undef PG8_MMA
#undef PG8_MMA8
#undef PG8_LDA8
#undef PG8_LDB8
#undef PG8_LD32
#undef PG8_WAIT_V
#undef PG8_WAIT_L
#undef PG8_BAR
#undef PG8_SCHED
}
}

__device__ __forceinline__ int lane_id() { int l; asm volatile("v_mbcnt_lo_u32_b32 %0, -1, 0\n\tv_mbcnt_hi_u32_b32 %0, -1, %0" : "=v"(l)); return l; }
#define FT_DECL const int f_lane = lane_id(), f_tid = F.wave * 64 + f_lane; (void)f_tid; (void)f_lane
typedef const float* cfp_t;
typedef __attribute__((address_space(4))) cfp_t* kin_t;
struct Frame {
    LAS unsigned char* lds;
    volatile LAS unsigned* MISC;
    gu32* ctl;
    int wave, vcu, G;
    kin_t in;
    float* out;
    unsigned char* ws;
};
#define WSP(T, off) ((T*)(F.ws + (off)))

template <class RowMap>
__device__ __forceinline__ void p0_transpose_item(const float* W, int K, int N, bf16_t* WT, const RowMap& rowmap, const float* kscale, LAS float* scr, int item, int lane) {
    const int nblk = N / 32, kb = item / nblk, nb = item % nblk, k0 = 64 * kb, n0 = 32 * nb;
#pragma unroll 8
    for (int i = 0; i < 32; ++i) { const int kk = 2 * i + (lane >> 5); float v = W[(size_t)(k0 + kk) * N + n0 + (lane & 31)]; if (kscale) v *= kscale[k0 + kk]; scr[kk * 33 + (lane & 31)] = v; }
    LDS_WAIT(); asm volatile("" ::: "memory");
    const int c = lane & 7;
#pragma unroll
    for (int j = 0; j < 4; ++j) { const int n = (lane >> 3) + 8 * j; const LAS float* s = scr + (8 * c) * 33 + n;
        u32x4 o; o.x = cvt_pk_bf16(s[0 * 33], s[1 * 33]); o.y = cvt_pk_bf16(s[2 * 33], s[3 * 33]); o.z = cvt_pk_bf16(s[4 * 33], s[5 * 33]); o.w = cvt_pk_bf16(s[6 * 33], s[7 * 33]);
        *(GAS u32x4*)(WT + (size_t)rowmap(n0 + n) * K + k0 + 8 * c) = o; }
    LDS_WAIT(); asm volatile("" ::: "memory");
}

__device__ __forceinline__ unsigned pk4_fp8(float a, float b, float c, float d) { int r = __builtin_amdgcn_cvt_pk_fp8_f32(a, b, 0, false); r = __builtin_amdgcn_cvt_pk_fp8_f32(c, d, r, true); return (unsigned)r; }
constexpr float EOSCALE = 16.f;
constexpr float WSCALE = 32.f;
template <class RowMap>
__device__ __forceinline__ void p0_transpose_item_f8(const float* W, int K, int N, unsigned char* WT, const RowMap& rowmap, LAS float* scr, int item, int lane) {
    const int nblk = N / 32, kb = item / nblk, nb = item % nblk, k0 = 128 * kb, n0 = 32 * nb;
#pragma unroll
    for (int hh = 0; hh < 2; ++hh) { float v[32];
#pragma unroll
        for (int i = 0; i < 32; ++i) { const int kk = 2 * (32 * hh + i) + (lane >> 5); v[i] = __builtin_nontemporal_load(W + (size_t)(k0 + kk) * N + n0 + (lane & 31)); }
#pragma unroll
        for (int i = 0; i < 32; ++i) { const int kk = 2 * (32 * hh + i) + (lane >> 5); scr[kk * 33 + (lane & 31)] = v[i] * WSCALE; } }
    LDS_WAIT(); asm volatile("" ::: "memory");
    const int c = lane & 7;
#pragma unroll
    for (int j = 0; j < 4; ++j) { const int n = (lane >> 3) + 8 * j; const LAS float* sp = scr + (16 * c) * 33 + n;
        u32x4 o; o.x = pk4_fp8(sp[0 * 33], sp[1 * 33], sp[2 * 33], sp[3 * 33]); o.y = pk4_fp8(sp[4 * 33], sp[5 * 33], sp[6 * 33], sp[7 * 33]);
        o.z = pk4_fp8(sp[8 * 33], sp[9 * 33], sp[10 * 33], sp[11 * 33]); o.w = pk4_fp8(sp[12 * 33], sp[13 * 33], sp[14 * 33], sp[15 * 33]);
        *(GAS u32x4*)(WT + (size_t)rowmap(n0 + n) * K + k0 + 16 * c) = o; }
    LDS_WAIT(); asm volatile("" ::: "memory");
}
struct MapIdent { int off; __device__ __forceinline__ int operator()(int n) const { return off + n; } };
struct MapWin { __device__ __forceinline__ int operator()(int l) const {
    if (l >= 1024) return l;
    const int t = l & ~255, r = l & 255, wc = r >> 6, blk = (r >> 5) & 1, bj = (r >> 4) & 1, low = r & 15;
    return t + 128 * bj + 32 * wc + 16 * blk + low; } };
struct MapW1 { int off; __device__ __forceinline__ int operator()(int jp) const { const int bj = jp >> 10, j = jp & 1023; return off + 256 * (j >> 7) + 128 * bj + (j & 127); } };


__device__ __forceinline__ void p0_filter_item(Frame& F, int item) {
    FT_DECL;
#define in F.in
    LAS float* h1s = (LAS float*)(F.lds);
    LAS float* h2s = (LAS float*)(F.lds + 4096);
    const int t0 = item * 16;
    {
        const int tt = f_tid >> 5, hh = (f_tid & 31) * 2; const float pos = (float)(t0 + tt);
        float feats[17]; feats[0] = pos * (1.f / SEQ);
#pragma unroll
        for (int i = 0; i < 8; ++i) { const float band = 1e-4f + (float)i * ((7.f - 1e-4f) / 7.f); const float ang = (6.283185307179586f / SEQ) * pos * band; feats[1 + i] = sinf(ang); feats[9 + i] = cosf(ang); }
#pragma unroll
        for (int u = 0; u < 2; ++u) { const int h = hh + u; float a = in[19][h];
#pragma unroll
            for (int k = 0; k < 17; ++k) a += feats[k] * in[18][k * 64 + h];
            h1s[tt * 64 + h] = sinf(in[20][h] * a); }
        __syncthreads();
#pragma unroll
        for (int u = 0; u < 2; ++u) { const int h = hh + u; float a = in[22][h];
#pragma unroll 8
            for (int k = 0; k < 64; ++k) a += h1s[tt * 64 + k] * in[21][k * 64 + h];
            h2s[tt * 64 + h] = sinf(in[23][h] * a); }
        __syncthreads();
    }
    f32x4 acc[16];
#pragma unroll
    for (int t = 0; t < 16; ++t) acc[t] = (f32x4){0.f, 0.f, 0.f, 0.f};
    const int o = 4 * f_tid;
    for (int k = 0; k < 64; ++k) { const f32x4 w = *(const f32x4*)(in[24] + (size_t)k * 2048 + o);
#pragma unroll
        for (int t = 0; t < 16; ++t) acc[t] += w * h2s[t * 64 + k]; }
    const int c0 = o & 511, od = o >> 9;
    float* dst = WSP(float, WS_FILT) + ((size_t)od * 512 + c0) * SEQ + t0;
#pragma unroll
    for (int e = 0; e < 4; ++e) { const float la = -3.0701134573253944f, lb = -15.350567286626972f; const float delta = fabsf(la + (float)(c0 + e) * ((lb - la) / 511.f));
#pragma unroll
        for (int q = 0; q < 4; ++q) { f32x4 v;
#pragma unroll
            for (int i = 0; i < 4; ++i) { const int t = 4 * q + i; const float tn = (float)(t0 + t) * (1.f / SEQ); v[i] = acc[t][e] * expf(-tn * delta); }
            *(f32x4*)(dst + (size_t)e * SEQ + 4 * q) = v; } }
    __syncthreads();
#undef in
}

__device__ __forceinline__ float silu_f(float v) { return v / (1.f + __expf(-v)); }

__device__ __forceinline__ void p0_prologue(Frame& F) {
    FT_DECL;
#define in F.in
    const int wg = blockIdx.x;
    if (wg < 96) {
        LAS float* sv = (LAS float*)F.lds;
        for (int i = f_tid; i < 9 * 1024; i += 512) { const int r = i >> 10, k = i & 1023; const float c = (r < 8) ? in[1][r * 1024 + k] : in[3][k]; sv[i] = silu_f(c); }
        __syncthreads();
        const int j = wg * 64 + f_lane; const float* wm = in[4];
        float acc[9];
#pragma unroll
        for (int r = 0; r < 9; ++r) acc[r] = 0.f;
        const int kbeg = F.wave * 128;
#pragma unroll 4
        for (int k = kbeg; k < kbeg + 128; ++k) { const float w = wm[(size_t)k * (NMOD * DM) + j];
#pragma unroll
            for (int r = 0; r < 9; ++r) acc[r] += sv[r * 1024 + k] * w; }
        LAS float* red = (LAS float*)(F.lds + 40960);
#pragma unroll
        for (int r = 0; r < 9; ++r) red[(F.wave * 9 + r) * 64 + f_lane] = acc[r];
        __syncthreads();
        for (int i = f_tid; i < 9 * 64; i += 512) { const int r = i >> 6, l = i & 63; float s = in[5][wg * 64 + l];
#pragma unroll
            for (int w = 0; w < 8; ++w) s += red[(w * 9 + r) * 64 + l];
            WSP(float, WS_SMALL + SM_MOD)[r * (NMOD * DM) + wg * 64 + l] = s; }
        __syncthreads();
    } else if (wg == 96) {
        if (F.wave == 0) {
            const float a = wave_sum(in[11][f_lane] * in[12][f_lane]), b = wave_sum(in[13][f_lane] * in[14][f_lane]);
            float gq = fabsf(in[9][f_lane]), gk = fabsf(in[10][f_lane]);
#pragma unroll
            for (int o = 1; o < 64; o <<= 1) { gq = fmaxf(gq, __shfl_xor(gq, o)); gk = fmaxf(gk, __shfl_xor(gk, o)); }
            if (f_lane == 0) { float* sc = WSP(float, WS_SMALL + SM_SCAL); sc[0] = expf(a) - expf(b) + LAM_INIT;
                sc[1] = (8.f * gq * gk * 1.02f + 0.05f) * 1.4426950408889634f; }
        }
        for (int i = f_tid; i < 64 * 16; i += 512) { const int pos = i >> 4, f = i & 15;
            const float inv = powf(10000.f, -(float)f / 16.f); const float ang = (float)pos * inv;
            float* rt = WSP(float, WS_SMALL + SM_ROPE); rt[2 * i] = cosf(ang); rt[2 * i + 1] = sinf(ang); }
    }
    __syncthreads();
    for (int it = wg; it < SEQ / 16; it += F.G) p0_filter_item(F, it);
    __syncthreads();
    {
        LAS float* scr = (LAS float*)(F.lds + F.wave * 16896);
        const int gw = F.vcu * NWAVES + F.wave, NGW = F.G * NWAVES;
        constexpr int I_IN = (DM / 64) * (INC / 32), I_OUT = (DM / 64) * (DM / 32), I_1 = (DM / 128) * (2 * DM / 32), I_2 = (DM / 128) * (DM / 32);
        constexpr int NITEMS = I_IN + I_OUT + NEXP * (I_1 + I_2);
        for (int it = gw; it < NITEMS; it += NGW) {
            int r = it;
            if (r < I_IN) { p0_transpose_item(in[8], DM, INC, WSP(bf16_t, WS_WIN), MapWin{}, nullptr, scr, r, f_lane); continue; } r -= I_IN;
            if (r < I_OUT) { p0_transpose_item(in[27], DM, DM, WSP(bf16_t, WS_WOUT), MapIdent{0}, nullptr, scr, r, f_lane); continue; } r -= I_OUT;
            const int e = r / (I_1 + I_2); r -= e * (I_1 + I_2);
            if (r < I_1) p0_transpose_item_f8(in[30] + (size_t)e * DM * 2 * DM, DM, 2 * DM, WSP(unsigned char, WS_W1) + (size_t)e * 2 * DM * DM, MapW1{0}, scr, r, f_lane);
            else p0_transpose_item_f8(in[32] + (size_t)e * DM * DM, DM, DM, WSP(unsigned char, WS_W2) + (size_t)e * DM * DM, MapIdent{0}, scr, r - I_1, f_lane);
        }
    }
}
#undef in

__device__ __forceinline__ void p1_norm1(Frame& F) {
    FT_DECL;
    const int gw = F.vcu * NWAVES + F.wave, NGW = F.G * NWAVES;
    const float* mod = WSP(float, WS_SMALL + SM_MOD); const float* g1 = F.in[6];
    bf16_t* H = WSP(bf16_t, WS_H);
    constexpr int RU = 4;
    for (int m0 = gw; m0 < MTOT; m0 += NGW * RU) {
        f32x4 v[RU][4];
#pragma unroll
        for (int u = 0; u < RU; ++u) { const int m = m0 + u * NGW; if (m < MTOT) {
            const float* xrow = (m < MROWS) ? F.in[0] + (size_t)m * DM : F.in[2] + (size_t)(m - MROWS) * DM; const GAS f32x4* xr = (const GAS f32x4*)xrow + f_lane;
#pragma unroll
            for (int j = 0; j < 4; ++j) v[u][j] = __builtin_nontemporal_load(xr + 64 * j); } }
#pragma unroll
        for (int u = 0; u < RU; ++u) { const int m = m0 + u * NGW; if (m < MTOT) {
            const int mb = (m < MROWS) ? (m >> 12) : 8;
            const float* sh = mod + (size_t)mb * (NMOD * DM); const float* sc = sh + DM;
            float s = 0.f;
#pragma unroll
            for (int j = 0; j < 4; ++j) s += (v[u][j].x * v[u][j].x + v[u][j].y * v[u][j].y) + (v[u][j].z * v[u][j].z + v[u][j].w * v[u][j].w);
            const float rstd = rsqrtf(wave_sum(s) * (1.f / DM) + EPS);
            GAS u32x2* o8 = (GAS u32x2*)(H + (size_t)m * DM) + f_lane;
#pragma unroll
            for (int j = 0; j < 4; ++j) { const int c = 4 * f_lane + 256 * j;
                const f32x4 g = *(const f32x4*)(g1 + c), a = *(const f32x4*)(sc + c), b = *(const f32x4*)(sh + c);
                const f32x4 y = v[u][j] * rstd * g * (a + 1.f) + b;
                u32x2 w; w.x = cvt_pk_bf16(y.x, y.y); w.y = cvt_pk_bf16(y.z, y.w); o8[64 * j] = w; } } }
    }
}

struct SchedInProj {
    int G, c; const char* H; const char* W;
    static constexpr int NA = 136 * 4, NV = 2 * 136, NBU = 6 * 128;
    __device__ __forceinline__ bool next(int i, g8::Unit& u) const {
        const long L = (long)i * G + c;
        if (L < NA) { g8::tile_of((int)L, 136, 4, u.pm, u.pn); u.a = H + (size_t)u.pm * 256 * DM * 2; u.b = W + (size_t)u.pn * 256 * DM * 2; u.kind = 0; u.ex = 0; return true; }
        if (L < NA + NV) { g8::tile_of((int)L - NA, 2, 136, u.pm, u.pn); u.a = W + (size_t)(1024 + u.pm * 256) * DM * 2; u.b = H + (size_t)u.pn * 256 * DM * 2; u.kind = 2; u.ex = 0; return true; }
        if (L < NA + NV + NBU) { g8::tile_of((int)L - NA - NV, 6, 128, u.pm, u.pn); u.a = W + (size_t)(QKVC + u.pm * 256) * DM * 2; u.b = H + (size_t)u.pn * 256 * DM * 2; u.kind = 1; u.ex = 0; return true; }
        return false;
    }
};
constexpr float Q8SCALE = 16.f;
struct EpiInProj {
    unsigned char *Q8, *K8, *VT8; bf16_t* UT; const float *gq, *gk, *rope;
    __device__ __forceinline__ void operator()(f32x4 (&acc)[2][2][4][2], const g8::Unit& u, int wr, int wc, int fr, int fq) const {
        asm volatile("" : "+v"(fr), "+v"(fq));
        if (u.kind == 1) {
            const int row0 = u.pm * 256 + wr * 64 + fr, col0 = u.pn * 256 + wc * 32 + 8 * fq;
#pragma unroll
            for (int ai = 0; ai < 2; ++ai)
#pragma unroll
                for (int m = 0; m < 4; ++m) { bf16_t* rowp = UT + (size_t)(row0 + ai * 128 + m * 16) * MROWS + col0;
#pragma unroll
                    for (int bj = 0; bj < 2; ++bj) { const f32x4 v0 = acc[ai][bj][m][0], v1 = acc[ai][bj][m][1];
                        u32x4 w; w.x = cvt_pk_bf16(v0[0], v0[1]); w.y = cvt_pk_bf16(v0[2], v0[3]); w.z = cvt_pk_bf16(v1[0], v1[1]); w.w = cvt_pk_bf16(v1[2], v1[3]);
                        *(u32x4*)(rowp + bj * 128) = w; } }
            return;
        }
        if (u.kind == 2) {
#pragma unroll
            for (int bj = 0; bj < 2; ++bj) { const int t8 = u.pn * 256 + bj * 128 + wc * 32 + 8 * fq;
                int b, key; if (t8 < MROWS) { b = t8 >> 12; key = CTXL + (t8 & 4095); } else { const int j = t8 - MROWS; b = j >> 8; key = j & 255; }
                const int tile = key >> 6, k = key & 63, ipos = (k < 32) ? 4 * (k >> 3) : 16 + 4 * ((k - 32) >> 3);
#pragma unroll
                for (int ai = 0; ai < 2; ++ai)
#pragma unroll
                    for (int m = 0; m < 4; ++m) { const int ch = u.pm * 256 + ai * 128 + wr * 64 + m * 16 + fr;
                        unsigned char* dst = VT8 + ((((size_t)(b * NHEAD + (ch >> 7)) * 68 + tile) * 128 + (ch & 127)) * 64) + ipos;
                        const f32x4 v0 = acc[ai][bj][m][0], v1 = acc[ai][bj][m][1];
                        *(unsigned*)dst = pk4_fp8(v0[0], v0[1], v0[2], v0[3]); *(unsigned*)(dst + 32) = pk4_fp8(v1[0], v1[1], v1[2], v1[3]); } }
            return;
        }
        const int blk = fq >> 1, f = fq & 1;
        const int sec = u.pn >> 1;
        const bool ctx = (u.pm >= 128);
        if (sec == 0 && ctx) return;
        const int colbase = (u.pn & 1) * 256 + wc * 64 + 32 * blk + 8 * f;
        float gg[2][2][4];
        { const float* gp = (sec == 0 ? gq : gk) + 32 * blk + 8 * f;
#pragma unroll
            for (int bj = 0; bj < 2; ++bj)
#pragma unroll
                for (int n = 0; n < 2; ++n) { const f32x4 t = *(const f32x4*)(gp + 16 * bj + 4 * n); gg[bj][n][0] = t[0]; gg[bj][n][1] = t[1]; gg[bj][n][2] = t[2]; gg[bj][n][3] = t[3]; } }
#pragma unroll
        for (int ai = 0; ai < 2; ++ai)
#pragma unroll
            for (int m = 0; m < 4; ++m) {
                const int rloc = ai * 128 + wr * 64 + m * 16 + fr; const int r = u.pm * 256 + rloc;
                f32x4 v[2][2];
#pragma unroll
                for (int bj = 0; bj < 2; ++bj)
#pragma unroll
                    for (int n = 0; n < 2; ++n) v[bj][n] = acc[ai][bj][m][n];
                size_t orow;
                if (sec == 0) orow = (size_t)r;
                else if (!ctx) orow = (size_t)(r >> 12) * KVL + CTXL + (r & 4095);
                else { const int j = r - MROWS; orow = (size_t)(j >> 8) * KVL + (j & 255); }
                float ss = 0.f;
#pragma unroll
                for (int bj = 0; bj < 2; ++bj)
#pragma unroll
                    for (int n = 0; n < 2; ++n) ss += (v[bj][n][0] * v[bj][n][0] + v[bj][n][1] * v[bj][n][1]) + (v[bj][n][2] * v[bj][n][2] + v[bj][n][3] * v[bj][n][3]);
                ss += __shfl_xor(ss, 16); ss += __shfl_xor(ss, 32);
                const float rstd = rsqrtf(ss * (1.f / 64.f) + EPS) * (sec == 0 ? QSCALE * Q8SCALE : 1.f);
#pragma unroll
                for (int bj = 0; bj < 2; ++bj)
#pragma unroll
                    for (int n = 0; n < 2; ++n)
#pragma unroll
                        for (int e = 0; e < 4; ++e) v[bj][n][e] *= rstd * gg[bj][n][e];
                if (!ctx) {
                    const int t = r & 4095; const int pos = blk ? (t & 63) : (t >> 6);
                    const float* rp = rope + (size_t)(pos * 16 + 8 * f) * 2;
#pragma unroll
                    for (int n = 0; n < 2; ++n) { const f32x4 c0 = *(const f32x4*)(rp + 8 * n), c1 = *(const f32x4*)(rp + 8 * n + 4);
                        const float cs[4] = {c0[0], c0[2], c1[0], c1[2]}, sn[4] = {c0[1], c0[3], c1[1], c1[3]};
#pragma unroll
                        for (int e = 0; e < 4; ++e) { const float x1 = v[0][n][e], x2 = v[1][n][e]; v[0][n][e] = x1 * cs[e] - x2 * sn[e]; v[1][n][e] = x2 * cs[e] + x1 * sn[e]; } }
                }
                unsigned char* dst = (sec == 0 ? Q8 : K8) + orow * QKW + colbase;
#pragma unroll
                for (int bj = 0; bj < 2; ++bj) { u32x2 w; w.x = pk4_fp8(v[bj][0][0], v[bj][0][1], v[bj][0][2], v[bj][0][3]); w.y = pk4_fp8(v[bj][1][0], v[bj][1][1], v[bj][1][2], v[bj][1][3]);
                    *(u32x2*)(dst + 16 * bj) = w; }
            }
    }
};

struct SchedStatic {
    int G, c, nM, nN; const char* A; const char* B;
    __device__ __forceinline__ bool next(int i, g8::Unit& u) const {
        const long L = (long)i * G + c; if (L >= (long)nM * nN) return false;
        g8::tile_of((int)L, nM, nN, u.pm, u.pn); u.a = A + (size_t)u.pm * 256 * DM * 2; u.b = B + (size_t)u.pn * 256 * DM * 2; u.kind = 0; u.ex = 0; return true;
    }
};
struct EpiOutProj {
    const float* x; bf16_t* out; const float* mod;
    __device__ __forceinline__ void operator()(f32x4 (&acc)[2][2][4][2], const g8::Unit& u, int wr, int wc, int fr, int fq) const {
        const int col0 = u.pn * 256 + wc * 32 + 8 * fq;
#pragma unroll
        for (int ai = 0; ai < 2; ++ai)
#pragma unroll
            for (int m = 0; m < 4; ++m) { const int r = u.pm * 256 + ai * 128 + wr * 64 + m * 16 + fr; const float* g1 = mod + (size_t)(r >> 12) * (NMOD * DM) + 2 * DM;
                const size_t off = (size_t)r * DM + col0;
#pragma unroll
                for (int bj = 0; bj < 2; ++bj) { f32x4 o[2];
#pragma unroll
                    for (int n = 0; n < 2; ++n) { const int c = bj * 128 + 4 * n; const f32x4 xv = *(const f32x4*)(x + off + c), gv = *(const f32x4*)(g1 + col0 + c); o[n] = xv + gv * acc[ai][bj][m][n]; }
                    u32x4 w; w.x = cvt_pk_bf16(o[0][0], o[0][1]); w.y = cvt_pk_bf16(o[0][2], o[0][3]); w.z = cvt_pk_bf16(o[1][0], o[1][1]); w.w = cvt_pk_bf16(o[1][2], o[1][3]);
                    *(u32x4*)(out + off + bj * 128) = w; } }
    }
};

namespace att {
constexpr int KVBLK = 64, LDK = QKW, NT = KVL / KVBLK;
constexpr int SHM_V = KVBLK * 128 * 2, SHM_K = KVBLK * 128 * 2;
#define KSWZ(row, colB) ((row) * 256 + ((colB) ^ (((row) & 7) << 4)))
#define SBAR() __builtin_amdgcn_sched_barrier(0)
__device__ __forceinline__ int crow(int r, int hi) { return (r & 3) + 8 * (r >> 2) + 4 * hi; }
__device__ __forceinline__ void expA(f32x16& p) {
#pragma unroll
    for (int r = 0; r < 16; ++r) p[r] = __builtin_amdgcn_exp2f(p[r]);
}
__device__ __forceinline__ void finishSM(f32x16& p0, f32x16& p1, float& l_reg, bf16x8& pa0, bf16x8& pa1, bf16x8& pa2, bf16x8& pa3) {
#pragma unroll
    for (int r = 0; r < 16; ++r) p1[r] = __builtin_amdgcn_exp2f(p1[r]);
    float ps = 0;
#pragma unroll
    for (int r = 0; r < 16; ++r) ps += p0[r];
#pragma unroll
    for (int r = 0; r < 16; ++r) ps += p1[r];
    { auto rr = __builtin_amdgcn_permlane32_swap(__float_as_uint(ps), __float_as_uint(ps), false, false); ps = __uint_as_float(rr[0]) + __uint_as_float(rr[1]); }
    l_reg += ps;
#define PK4(P, BASE, OUT) do { unsigned a0 = cvt_pk_bf16(P[BASE + 0], P[BASE + 1]), a1 = cvt_pk_bf16(P[BASE + 2], P[BASE + 3]);   \
    unsigned b0 = cvt_pk_bf16(P[BASE + 4], P[BASE + 5]), b1 = cvt_pk_bf16(P[BASE + 6], P[BASE + 7]);                              \
    auto r0 = __builtin_amdgcn_permlane32_swap(a0, b0, false, false); auto r1 = __builtin_amdgcn_permlane32_swap(a1, b1, false, false); \
    u32x4 w = {r0[0], r1[0], r0[1], r1[1]}; OUT = *reinterpret_cast<bf16x8*>(&w); } while (0)
    PK4(p0, 0, pa0); PK4(p0, 8, pa1); PK4(p1, 0, pa2); PK4(p1, 8, pa3);
#undef PK4
}
__device__ __forceinline__ void qkt(f32x16& p0, f32x16& p1, const char* Ks, const bf16x8* qr, int r32, int hi, int sub, float negm) {
    (void)negm;
    const f32x16 z = {};
#pragma unroll
    for (int d0 = 0; d0 < 4; ++d0) { const int cb = (sub * 64 + d0 * 16 + hi * 8) * 2;
        const bf16x8 b0 = *reinterpret_cast<const bf16x8*>(Ks + KSWZ(r32, cb));
        const bf16x8 b1 = *reinterpret_cast<const bf16x8*>(Ks + KSWZ(32 + r32, cb));
        p0 = __builtin_amdgcn_mfma_f32_32x32x16_bf16(b0, qr[d0], d0 ? p0 : z, 0, 0, 0);
        p1 = __builtin_amdgcn_mfma_f32_32x32x16_bf16(b1, qr[d0], d0 ? p1 : z, 0, 0, 0); }
}
__device__ __forceinline__ int v_st(int k, int c) { const int kk = (k & ~0xC) | ((k & 4) << 1) | ((k & 8) >> 1); return ((kk >> 3) * 4 + (c >> 5)) * 512 + ((kk & 7) * 32 + (c & 31)) * 2; }
__device__ __forceinline__ int v_rd_base(int lane) { return ((lane & 3) << 3) | (((lane >> 2) & 3) << 6) | (((lane >> 4) & 1) << 5) | (((lane >> 5) & 1) << 8); }
constexpr int v_rd_off(int d0, int ks, int half) { return d0 * 512 + ks * 4096 + half * 2048; }
template <int OFF> __device__ __forceinline__ s16x4 tr_read(int vb) {
    s16x4 r; asm volatile("ds_read_b64_tr_b16 %0, %1 offset:%2" : "=&v"(r) : "v"(vb), "i"(OFF) : "memory"); return r;
}
template <int D0> __device__ __forceinline__ void pv_one(f32x16& od, int vb, bf16x8 pa0, bf16x8 pa1, bf16x8 pa2, bf16x8 pa3) {
    const s16x4 l0 = tr_read<v_rd_off(D0, 0, 0)>(vb), h0 = tr_read<v_rd_off(D0, 0, 1)>(vb), l1 = tr_read<v_rd_off(D0, 1, 0)>(vb), h1 = tr_read<v_rd_off(D0, 1, 1)>(vb);
    const s16x4 l2 = tr_read<v_rd_off(D0, 2, 0)>(vb), h2 = tr_read<v_rd_off(D0, 2, 1)>(vb), l3 = tr_read<v_rd_off(D0, 3, 0)>(vb), h3 = tr_read<v_rd_off(D0, 3, 1)>(vb);
    asm volatile("s_waitcnt lgkmcnt(0)" ::: "memory"); SBAR();
#define PK(L, H) (bf16x8){L[0], L[1], L[2], L[3], H[0], H[1], H[2], H[3]}
    od = __builtin_amdgcn_mfma_f32_32x32x16_bf16(pa0, PK(l0, h0), od, 0, 0, 0);
    od = __builtin_amdgcn_mfma_f32_32x32x16_bf16(pa1, PK(l1, h1), od, 0, 0, 0);
    od = __builtin_amdgcn_mfma_f32_32x32x16_bf16(pa2, PK(l2, h2), od, 0, 0, 0);
    od = __builtin_amdgcn_mfma_f32_32x32x16_bf16(pa3, PK(l3, h3), od, 0, 0, 0);
#undef PK
}
__device__ __forceinline__ void pv_d0(f32x16* o, int vb, bf16x8 pa0, bf16x8 pa1, bf16x8 pa2, bf16x8 pa3) {
    pv_one<0>(o[0], vb, pa0, pa1, pa2, pa3); pv_one<1>(o[1], vb, pa0, pa1, pa2, pa3); pv_one<2>(o[2], vb, pa0, pa1, pa2, pa3); pv_one<3>(o[3], vb, pa0, pa1, pa2, pa3);
}

__device__ __forceinline__ void attn_unit(const bf16_t* __restrict__ Qb, const bf16_t* __restrict__ Kh, const bf16_t* __restrict__ Vh, bf16_t* MIXo,
                                          const float lam, const float negm, const float* __restrict__ subg, char* lds, const int wid) {
    const int lane = lane_id(), tid = wid * 64 + lane, r32 = lane & 31, hi = lane >> 5;
    const int sub = wid >> 2, wq = wid & 3;
    char* V_lds = lds; char* K_lds = lds + 3 * SHM_V;
    float* wsf = (float*)(lds + 98304) + wid * 32;
    float l_reg = 0; f32x16 o[4] = {}; bf16x8 qr[4];
    const bf16_t* Qw = Qb + (long)(wq * 32 + r32) * LDK + sub * 64 + hi * 8;
#pragma unroll
    for (int d0 = 0; d0 < 4; ++d0) qr[d0] = *reinterpret_cast<const bf16x8*>(Qw + d0 * 16);
    const int vb0 = (int)(uintptr_t)V_lds + v_rd_base(lane);
    long ksrc[2], vsrc[2];
#pragma unroll
    for (int i = 0; i < 2; ++i) { const int p = 2 * wid + i;
        { const int r = 4 * p + (lane >> 4), c = (lane & 15) ^ (r & 7); ksrc[i] = (long)r * LDK + c * 8; }
        { const int st = 2 * p + (lane >> 5), kk = 8 * (st >> 2) + ((lane & 31) >> 2), k = (kk & ~0xC) | ((kk & 4) << 1) | ((kk & 8) >> 1), c = 32 * (st & 3) + 8 * (lane & 3); vsrc[i] = (long)k * LDK + c; } }
    const unsigned kdst = (unsigned)(uintptr_t)K_lds + (unsigned)wid * 2048u, vdst = (unsigned)(uintptr_t)V_lds + (unsigned)wid * 2048u;
#define DMA_TILE(t, boff) do { _Pragma("unroll") for (int i_ = 0; i_ < 2; ++i_) { \
        __builtin_amdgcn_global_load_lds((const unsigned*)(Kh + (long)(t) * KVBLK * LDK + ksrc[i_]), (LAS unsigned*)(uintptr_t)__builtin_amdgcn_readfirstlane(kdst + (unsigned)(boff) + i_ * 1024u), 16, 0, 0); \
        __builtin_amdgcn_global_load_lds((const unsigned*)(Vh + (long)(t) * KVBLK * LDK + vsrc[i_]), (LAS unsigned*)(uintptr_t)__builtin_amdgcn_readfirstlane(vdst + (unsigned)(boff) + i_ * 1024u), 16, 0, 0); } } while (0)
#define WBAR() do { asm volatile("s_waitcnt vmcnt(0) lgkmcnt(0)" ::: "memory"); __builtin_amdgcn_s_barrier(); asm volatile("" ::: "memory"); } while (0)
#define ROT3(x) ((x) == 2 * SHM_V ? 0 : (x) + SHM_V)
    f32x16 pA0, pA1, pB0, pB1; bf16x8 pa0, pa1, pa2, pa3;
    DMA_TILE(0, 0); WBAR();
    DMA_TILE(1, SHM_V);
    qkt(pA0, pA1, K_lds, qr, r32, hi, sub, negm); expA(pA0);
    WBAR();
    int bprev = 0, bcur = SHM_V, bnext = 2 * SHM_V;
    for (int j = 1; j + 1 < NT; j += 2) {
        DMA_TILE(j + 1, bnext);
        SBAR(); qkt(pB0, pB1, K_lds + bcur, qr, r32, hi, sub, negm);
        finishSM(pA0, pA1, l_reg, pa0, pa1, pa2, pa3); SBAR();
        pv_d0(o, vb0 + bprev, pa0, pa1, pa2, pa3); expA(pB0);
        WBAR();
        bprev = bcur; bcur = bnext; bnext = ROT3(bnext);
        if (j + 2 < NT) DMA_TILE(j + 2, bnext);
        SBAR(); qkt(pA0, pA1, K_lds + bcur, qr, r32, hi, sub, negm);
        finishSM(pB0, pB1, l_reg, pa0, pa1, pa2, pa3); SBAR();
        pv_d0(o, vb0 + bprev, pa0, pa1, pa2, pa3); expA(pA0);
        WBAR();
        bprev = bcur; bcur = bnext; bnext = ROT3(bnext);
    }
    SBAR(); qkt(pB0, pB1, K_lds + bcur, qr, r32, hi, sub, negm);
    finishSM(pA0, pA1, l_reg, pa0, pa1, pa2, pa3); SBAR();
    pv_d0(o, vb0 + bprev, pa0, pa1, pa2, pa3); expA(pB0);
    finishSM(pB0, pB1, l_reg, pa0, pa1, pa2, pa3); SBAR();
    pv_d0(o, vb0 + bcur, pa0, pa1, pa2, pa3);
#undef ROT3
#undef DMA_TILE
#undef WBAR
#define SLOAD(i, k0)
#define SWRITE(b, i)
#define SWAIT()
#undef SLOAD
#undef SWRITE
#undef SWAIT
    if (hi == 0) wsf[r32] = l_reg;
    __syncthreads();
    float* X = (float*)lds;
    float rli[16];
#pragma unroll
    for (int r = 0; r < 16; ++r) rli[r] = __builtin_amdgcn_rcpf(wsf[crow(r, hi)]);
    if (sub == 1) {
#pragma unroll
        for (int r = 0; r < 16; ++r) { const int row = wq * 32 + crow(r, hi); const float s = lam * rli[r];
#pragma unroll
            for (int d0 = 0; d0 < 4; ++d0) X[row * 128 + d0 * 32 + r32] = o[d0][r] * s; }
    }
    __syncthreads();
    bf16_t* Y = (bf16_t*)(lds + 65536);
    if (sub == 0) {
        float sg[4];
#pragma unroll
        for (int d0 = 0; d0 < 4; ++d0) sg[d0] = subg[d0 * 32 + r32] * (1.f - LAM_INIT);
#pragma unroll
        for (int r = 0; r < 16; ++r) { const int row = wq * 32 + crow(r, hi);
            float v[4]; float ss = 0.f;
#pragma unroll
            for (int d0 = 0; d0 < 4; ++d0) { v[d0] = o[d0][r] * rli[r] - X[row * 128 + d0 * 32 + r32]; ss += v[d0] * v[d0]; }
            ss += __shfl_xor(ss, 1); ss += __shfl_xor(ss, 2); ss += __shfl_xor(ss, 4); ss += __shfl_xor(ss, 8); ss += __shfl_xor(ss, 16);
            const float rstd = rsqrtf(ss * (1.f / 128.f) + EPS);
#pragma unroll
            for (int d0 = 0; d0 < 4; ++d0) Y[row * 128 + d0 * 32 + r32] = (bf16_t)(cvt_pk_bf16(v[d0] * rstd * sg[d0], 0.f) & 0xffffu); }
    }
    __syncthreads();
    { const int row = tid >> 2, seg = (tid & 3) * 32;
#pragma unroll
        for (int i = 0; i < 4; ++i) { const u32x4 v = *(const u32x4*)(Y + row * 128 + seg + i * 8); *(u32x4*)(MIXo + (size_t)row * DM + seg + i * 8) = v; } }
    __syncthreads();
}
#undef KSWZ
#undef SBAR
}

__device__ __forceinline__ void p3_attention(Frame& F) {
    FT_DECL;
    const float* sc = WSP(float, WS_SMALL + SM_SCAL);
    const float lam = sc[0], negm = -sc[1];
    const bf16_t* Q = WSP(bf16_t, WS_Q); const bf16_t* Kb = WSP(bf16_t, WS_K); const bf16_t* Vb = WSP(bf16_t, WS_V); bf16_t* MIX = WSP(bf16_t, WS_MIX);
    const int c = blockIdx.x, xcd = c & 7, ci = c >> 3, per = F.G >> 3;
    for (int j = ci; j < 128; j += per) {
        const int pair = xcd * 4 + (j >> 5), qb = j & 31, b = pair >> 2, h = pair & 3;
        att::attn_unit(Q + ((size_t)b * SEQ + qb * 128) * QKW + h * 128, Kb + (size_t)b * KVL * QKW + h * 128, Vb + (size_t)b * KVL * QKW + h * 128,
                       MIX + ((size_t)b * SEQ + qb * 128) * DM + h * 128, lam, negm, F.in[15], (char*)F.lds, F.wave);
    }
}


namespace att8 {
constexpr int NT = KVL / 64, SHMB = 8192, LDS_V0 = 3 * SHMB;
typedef int i32x8 __attribute__((ext_vector_type(8)));
#define SBAR() __builtin_amdgcn_sched_barrier(0)
__device__ __forceinline__ int crow(int r, int hi) { return (r & 3) + 8 * (r >> 2) + 4 * hi; }
__device__ __forceinline__ i32x8 ld32(const LAS unsigned char* p0, const LAS unsigned char* p1) {
    const u32x4 a = *(const LAS u32x4*)p0, b = *(const LAS u32x4*)p1; return (i32x8){(int)a.x, (int)a.y, (int)a.z, (int)a.w, (int)b.x, (int)b.y, (int)b.z, (int)b.w}; }
__device__ __forceinline__ void mfma_qk(f32x16& p, const i32x8& kf, const i32x8& qf, const f32x16& negc) {
    const unsigned s1 = 0x7f7f7f7fu, sq = 0x7b7b7b7bu;
    asm volatile("s_nop 1\n\tv_mfma_scale_f32_32x32x64_f8f6f4 %0, %1, %2, %3, %4, %5 op_sel_hi:[0,0,0]" : "=&v"(p) : "v"(kf), "v"(qf), "v"(negc), "v"(s1), "v"(sq));
}
__device__ __forceinline__ void mfma_pv(f32x16& o, const i32x8& pa, const i32x8& vf) {
    const unsigned s1 = 0x7f7f7f7fu;
    asm volatile("s_nop 2\n\tv_mfma_scale_f32_32x32x64_f8f6f4 %0, %1, %2, %0, %3, %3 op_sel_hi:[0,0,0]" : "+v"(o) : "v"(pa), "v"(vf), "v"(s1));
}
__device__ __forceinline__ void qkt(f32x16& p0, f32x16& p1, const LAS unsigned char* Kb, const i32x8& qf, const f32x16& negc, int r32, int hi, int sub) {
    const int c0 = sub * 4 + hi * 2;
    const int k0 = r32, k1 = 32 + r32;
    const i32x8 kf0 = ld32(Kb + k0 * 128 + ((c0 ^ ((k0 >> 1) & 7)) << 4), Kb + k0 * 128 + (((c0 + 1) ^ ((k0 >> 1) & 7)) << 4));
    const i32x8 kf1 = ld32(Kb + k1 * 128 + ((c0 ^ ((k1 >> 1) & 7)) << 4), Kb + k1 * 128 + (((c0 + 1) ^ ((k1 >> 1) & 7)) << 4));
    mfma_qk(p0, kf0, qf, negc); mfma_qk(p1, kf1, qf, negc);
}
__device__ __forceinline__ void mfma_wait(f32x16& p0, f32x16& p1) { asm volatile("s_nop 15\n\ts_nop 3" : "+v"(p0), "+v"(p1)); }
__device__ __forceinline__ void expA(f32x16& p) {
#pragma unroll
    for (int r = 0; r < 16; ++r) p[r] = __builtin_amdgcn_exp2f(p[r]);
}
__device__ __forceinline__ void finishSM(f32x16& p0, f32x16& p1, i32x8& pa) {
#pragma unroll
    for (int r = 0; r < 16; ++r) p1[r] = __builtin_amdgcn_exp2f(p1[r]);
#pragma unroll
    for (int j = 0; j < 4; ++j) { pa[j] = (int)pk4_fp8(p0[4 * j], p0[4 * j + 1], p0[4 * j + 2], p0[4 * j + 3]); pa[4 + j] = (int)pk4_fp8(p1[4 * j], p1[4 * j + 1], p1[4 * j + 2], p1[4 * j + 3]); }
}
__device__ __forceinline__ void pv(f32x16* o, f32x16& ol, const i32x8& ones, const LAS unsigned char* Vb, const i32x8& pa, int r32, int hi) {
    mfma_pv(ol, pa, ones);
#pragma unroll
    for (int d0 = 0; d0 < 4; ++d0) { const int d = 32 * d0 + r32, sw = (d >> 2) & 3;
        const i32x8 vf = ld32(Vb + d * 64 + (((2 * hi) ^ sw) << 4), Vb + d * 64 + (((2 * hi + 1) ^ sw) << 4));
        mfma_pv(o[d0], pa, vf); }
}
__device__ __forceinline__ void attn_unit(const unsigned char* __restrict__ Qb, const unsigned char* __restrict__ Kh, const unsigned char* __restrict__ VTh, bf16_t* MIXo,
                                          const float lam, const float* __restrict__ subg, char* lds, const int wid) {
    const int lane = lane_id(), tid = wid * 64 + lane, r32 = lane & 31, hi = lane >> 5;
    const int sub = wid >> 2, wq = wid & 3;
    const LAS unsigned char* L = (const LAS unsigned char*)(uintptr_t)(unsigned)(uintptr_t)lds;
    f32x16 o[4] = {}; f32x16 ol = {};
    i32x8 ones; { int c1 = 0x38383838; asm volatile("" : "+v"(c1)); ones = (i32x8){c1, c1, c1, c1, c1, c1, c1, c1}; }
    i32x8 qf; { const unsigned char* qp = Qb + (size_t)(wq * 32 + r32) * QKW + sub * 64 + 32 * hi; const u32x4 a = *(const u32x4*)qp, b = *(const u32x4*)(qp + 16);
        qf = (i32x8){(int)a.x, (int)a.y, (int)a.z, (int)a.w, (int)b.x, (int)b.y, (int)b.z, (int)b.w}; }
    f32x16 negc;
#pragma unroll
    for (int r = 0; r < 16; ++r) negc[r] = -5.f;
    asm volatile("" : "+v"(negc));
    long ksrc, vsrc;
    { const int r = 8 * wid + (lane >> 3), c = (lane & 7) ^ ((r >> 1) & 7); ksrc = (long)r * QKW + c * 16; }
    { const int d = 16 * wid + (lane >> 2), c = (lane & 3) ^ ((d >> 2) & 3); vsrc = (long)d * 64 + c * 16; }
    const unsigned ldsb = (unsigned)(uintptr_t)lds, kdst = ldsb + (unsigned)wid * 1024u, vdst = ldsb + LDS_V0 + (unsigned)wid * 1024u;
#define DMA_TILE(t, boff) do { \
        __builtin_amdgcn_global_load_lds((const unsigned*)(Kh + (long)(t) * 64 * QKW + ksrc), (LAS unsigned*)(uintptr_t)__builtin_amdgcn_readfirstlane(kdst + (unsigned)(boff)), 16, 0, 0); \
        __builtin_amdgcn_global_load_lds((const unsigned*)(VTh + (long)(t) * 8192 + vsrc), (LAS unsigned*)(uintptr_t)__builtin_amdgcn_readfirstlane(vdst + (unsigned)(boff)), 16, 0, 0); } while (0)
#define WBAR() do { asm volatile("s_waitcnt vmcnt(0) lgkmcnt(0)" ::: "memory"); __builtin_amdgcn_s_barrier(); asm volatile("" ::: "memory"); } while (0)
#define ROT3(x) ((x) == 2 * SHMB ? 0 : (x) + SHMB)
    f32x16 pA0, pA1, pB0, pB1; i32x8 pa;
    DMA_TILE(0, 0); WBAR();
    DMA_TILE(1, SHMB);
    qkt(pA0, pA1, L, qf, negc, r32, hi, sub); mfma_wait(pA0, pA1); expA(pA0);
    WBAR();
    int bprev = 0, bcur = SHMB, bnext = 2 * SHMB;
    for (int j = 1; j + 1 < NT; j += 2) {
        DMA_TILE(j + 1, bnext);
        SBAR(); qkt(pB0, pB1, L + bcur, qf, negc, r32, hi, sub);
        finishSM(pA0, pA1, pa); SBAR();
        pv(o, ol, ones, L + LDS_V0 + bprev, pa, r32, hi); mfma_wait(pB0, pB1); expA(pB0);
        WBAR();
        bprev = bcur; bcur = bnext; bnext = ROT3(bnext);
        if (j + 2 < NT) DMA_TILE(j + 2, bnext);
        SBAR(); qkt(pA0, pA1, L + bcur, qf, negc, r32, hi, sub);
        finishSM(pB0, pB1, pa); SBAR();
        pv(o, ol, ones, L + LDS_V0 + bprev, pa, r32, hi); mfma_wait(pA0, pA1); expA(pA0);
        WBAR();
        bprev = bcur; bcur = bnext; bnext = ROT3(bnext);
    }
    SBAR(); qkt(pB0, pB1, L + bcur, qf, negc, r32, hi, sub);
    finishSM(pA0, pA1, pa); SBAR();
    pv(o, ol, ones, L + LDS_V0 + bprev, pa, r32, hi); mfma_wait(pB0, pB1); expA(pB0);
    finishSM(pB0, pB1, pa); SBAR();
    pv(o, ol, ones, L + LDS_V0 + bcur, pa, r32, hi);
    asm volatile("s_nop 15\n\ts_nop 3" : "+v"(o[0]), "+v"(o[1]), "+v"(o[2]), "+v"(o[3]), "+v"(ol));
#undef ROT3
#undef DMA_TILE
#undef WBAR
    __syncthreads();
    float* X = (float*)lds;
    float rli[16];
#pragma unroll
    for (int r = 0; r < 16; ++r) rli[r] = __builtin_amdgcn_rcpf(ol[r]);
    if (sub == 1) {
#pragma unroll
        for (int r = 0; r < 16; ++r) { const int row = wq * 32 + crow(r, hi); const float sc = lam * rli[r];
#pragma unroll
            for (int d0 = 0; d0 < 4; ++d0) X[row * 128 + d0 * 32 + r32] = o[d0][r] * sc; }
    }
    __syncthreads();
    bf16_t* Y = (bf16_t*)(lds + 65536);
    if (sub == 0) {
        float sg[4];
#pragma unroll
        for (int d0 = 0; d0 < 4; ++d0) sg[d0] = subg[d0 * 32 + r32] * (1.f - LAM_INIT);
#pragma unroll
        for (int r = 0; r < 16; ++r) { const int row = wq * 32 + crow(r, hi);
            float v[4]; float ss = 0.f;
#pragma unroll
            for (int d0 = 0; d0 < 4; ++d0) { v[d0] = o[d0][r] * rli[r] - X[row * 128 + d0 * 32 + r32]; ss += v[d0] * v[d0]; }
            ss += __shfl_xor(ss, 1); ss += __shfl_xor(ss, 2); ss += __shfl_xor(ss, 4); ss += __shfl_xor(ss, 8); ss += __shfl_xor(ss, 16);
            const float rstd = rsqrtf(ss * (1.f / 128.f) + EPS);
#pragma unroll
            for (int d0 = 0; d0 < 4; ++d0) Y[row * 128 + d0 * 32 + r32] = (bf16_t)(cvt_pk_bf16(v[d0] * rstd * sg[d0], 0.f) & 0xffffu); }
    }
    __syncthreads();
    { const int row = tid >> 2, seg = (tid & 3) * 32;
#pragma unroll
        for (int i = 0; i < 4; ++i) { const u32x4 v = *(const u32x4*)(Y + row * 128 + seg + i * 8); *(u32x4*)(MIXo + (size_t)row * DM + seg + i * 8) = v; } }
    __syncthreads();
}
#undef SBAR
}

__device__ __forceinline__ void p3_attention8(Frame& F) {
    FT_DECL;
    const float* sc = WSP(float, WS_SMALL + SM_SCAL);
    const float lam = sc[0];
    const unsigned char* Q8 = WSP(unsigned char, WS_Q); const unsigned char* K8 = WSP(unsigned char, WS_K); const unsigned char* VT8 = WSP(unsigned char, WS_V); bf16_t* MIX = WSP(bf16_t, WS_MIX);
    const int c = blockIdx.x, xcd = c & 7, ci = c >> 3, per = F.G >> 3;
    for (int j = ci; j < 128; j += per) {
        const int pair = xcd * 4 + (j >> 5), qb = j & 31, b = pair >> 2, h = pair & 3;
        att8::attn_unit(Q8 + ((size_t)b * SEQ + qb * 128) * QKW + h * 128, K8 + (size_t)b * KVL * QKW + h * 128, VT8 + (size_t)(b * NHEAD + h) * 68 * 8192,
                        MIX + ((size_t)b * SEQ + qb * 128) * DM + h * 128, lam, F.in[15], (char*)F.lds, F.wave);
    }
}

namespace hy {
constexpr int RB_BYTES = 4352 * 8, IN_OFF = 2 * RB_BYTES, TW1_OFF = IN_OFF + 32768, TW2_OFF = TW1_OFF + 15 * 256 * 8, LDS_END = TW2_OFF + 15 * 16 * 8;
__device__ __forceinline__ f32x2 cmul(f32x2 a, f32x2 b) { return (f32x2){a.x * b.x - a.y * b.y, a.x * b.y + a.y * b.x}; }
__device__ __forceinline__ f32x2 cmulc(f32x2 a, f32x2 b) { return (f32x2){a.x * b.x + a.y * b.y, a.y * b.x - a.x * b.y}; }
__device__ __forceinline__ int P(int i) { return i + (i >> 4); }
template <bool INV> __device__ __forceinline__ void r4(f32x2& a, f32x2& b, f32x2& c, f32x2& d) {
    const f32x2 t0 = a + c, t1 = a - c, t2 = b + d, t3 = b - d;
    const f32x2 st3 = INV ? (f32x2){-t3.y, t3.x} : (f32x2){t3.y, -t3.x};
    a = t0 + t2; c = t0 - t2; b = t1 + st3; d = t1 - st3;
}
template <bool INV> __device__ __forceinline__ f32x2 tw(f32x2 v, float c, float s) {
    return INV ? (f32x2){v.x * c - v.y * s, v.y * c + v.x * s} : (f32x2){v.x * c + v.y * s, v.y * c - v.x * s};
}
template <bool INV> __device__ __forceinline__ void dft16(f32x2 (&v)[16]) {
    constexpr float C1 = 0.9238795325112867f, S1 = 0.3826834323650898f, R2 = 0.7071067811865476f;
    r4<INV>(v[0], v[4], v[8], v[12]); r4<INV>(v[1], v[5], v[9], v[13]); r4<INV>(v[2], v[6], v[10], v[14]); r4<INV>(v[3], v[7], v[11], v[15]);
    v[5] = tw<INV>(v[5], C1, S1);  v[9] = tw<INV>(v[9], R2, R2);    v[13] = tw<INV>(v[13], S1, C1);
    v[6] = tw<INV>(v[6], R2, R2);  v[10] = tw<INV>(v[10], 0.f, 1.f); v[14] = tw<INV>(v[14], -R2, R2);
    v[7] = tw<INV>(v[7], S1, C1);  v[11] = tw<INV>(v[11], -R2, R2);  v[15] = tw<INV>(v[15], -C1, -S1);
    r4<INV>(v[0], v[1], v[2], v[3]); r4<INV>(v[4], v[5], v[6], v[7]); r4<INV>(v[8], v[9], v[10], v[11]); r4<INV>(v[12], v[13], v[14], v[15]);
    f32x2 t;
    t = v[1]; v[1] = v[4]; v[4] = t;   t = v[2]; v[2] = v[8]; v[8] = t;    t = v[3]; v[3] = v[12]; v[12] = t;
    t = v[6]; v[6] = v[9]; v[9] = t;   t = v[7]; v[7] = v[13]; v[13] = t;  t = v[11]; v[11] = v[14]; v[14] = t;
}
struct Ctx { LAS f32x2* R; LAS f32x2* IN; LAS f32x2* TW1; LAS f32x2* TW2; int t, half; f32x2 wt; };
#define HY_OPAQUE(x) asm volatile("" : "+v"(x))
#define HY_W32(m) (f32x2){__builtin_cosf(-0.19634954084936207f * (m)), __builtin_sinf(-0.19634954084936207f * (m))}
template <int MODE> __device__ __forceinline__ void pass1_fwd(const Ctx& X) {
    f32x2 v[16]; int t = X.t; HY_OPAQUE(t);
#pragma unroll
    for (int m = 0; m < 16; ++m) { f32x2 a = X.IN[t + 256 * m]; if (MODE == 1) a = (f32x2){X.half ? a.y : a.x, 0.f}; v[m] = a; }
    if (X.half) {
#pragma unroll
        for (int m = 0; m < 16; ++m) v[m] = cmul(cmul(v[m], HY_W32(m)), X.wt);
    }
    dft16<false>(v);
#pragma unroll
    for (int q = 1; q < 16; ++q) v[q] = cmul(v[q], X.TW1[(q - 1) * 256 + t]);
    const int pb = t + (t >> 4);
#pragma unroll
    for (int q = 0; q < 16; ++q) X.R[pb + 272 * q] = v[q];
}
__device__ __forceinline__ void pass2_fwd(const Ctx& X) {
    int t = X.t; HY_OPAQUE(t);
    const int n2 = t & 15, pb = (t >> 4) * 272 + n2; f32x2 v[16];
#pragma unroll
    for (int m = 0; m < 16; ++m) v[m] = X.R[pb + 17 * m];
    dft16<false>(v);
#pragma unroll
    for (int q = 1; q < 16; ++q) v[q] = cmul(v[q], X.TW2[(q - 1) * 16 + n2]);
#pragma unroll
    for (int q = 0; q < 16; ++q) X.R[pb + 17 * q] = v[q];
}
template <bool FILTER> __device__ __forceinline__ void pass3(const Ctx& X, f32x2 (&H)[16]) {
    f32x2 v[16]; int t = X.t; HY_OPAQUE(t); const int pb = 17 * t;
#pragma unroll
    for (int m = 0; m < 16; ++m) v[m] = X.R[pb + m];
    dft16<false>(v);
    if (FILTER) {
#pragma unroll
        for (int q = 0; q < 16; ++q) H[q] = v[q] * (1.f / 8192.f);
    } else {
#pragma unroll
        for (int q = 0; q < 16; ++q) v[q] = cmul(v[q], H[q]);
        dft16<true>(v);
#pragma unroll
        for (int m = 0; m < 16; ++m) X.R[pb + m] = v[m];
    }
}
__device__ __forceinline__ void pass2_inv(const Ctx& X) {
    int t = X.t; HY_OPAQUE(t);
    const int n2 = t & 15, pb = (t >> 4) * 272 + n2; f32x2 v[16];
    v[0] = X.R[pb];
#pragma unroll
    for (int q = 1; q < 16; ++q) v[q] = cmulc(X.R[pb + 17 * q], X.TW2[(q - 1) * 16 + n2]);
    dft16<true>(v);
#pragma unroll
    for (int m = 0; m < 16; ++m) X.R[pb + 17 * m] = v[m];
}
__device__ __forceinline__ void pass1_inv(const Ctx& X) {
    f32x2 v[16]; int t = X.t; HY_OPAQUE(t); const int pb = t + (t >> 4);
    v[0] = X.R[pb];
#pragma unroll
    for (int q = 1; q < 16; ++q) v[q] = cmulc(X.R[pb + 272 * q], X.TW1[(q - 1) * 256 + t]);
    dft16<true>(v);
    if (X.half) {
#pragma unroll
        for (int m = 0; m < 16; ++m) v[m] = cmulc(cmulc(v[m], HY_W32(m)), X.wt);
    }
#pragma unroll
    for (int m = 0; m < 16; ++m) X.R[pb + 272 * m] = v[m];
}
#define HY_WSYNC() asm volatile("s_waitcnt lgkmcnt(0)" ::: "memory")
__device__ __forceinline__ void conv_fft(const Ctx& X, f32x2 (&H)[16]) {
    __syncthreads(); pass1_fwd<0>(X); __syncthreads(); pass2_fwd(X); HY_WSYNC(); pass3<false>(X, H); HY_WSYNC(); pass2_inv(X); __syncthreads(); pass1_inv(X); __syncthreads();
}
constexpr int STG_OFF = LDS_END;
constexpr int LDS_END2 = STG_OFF + 2 * SEQ * 2;
static_assert(LDS_END2 <= LDSCTL_OFF, "hyena LDS map");
__device__ __forceinline__ float sconv_lds(const LAS bf16_t* stg, int bs, int n, float w0, float w1, float w2, float bias) {
    const LAS bf16_t* p = stg + bs * SEQ;
    const float c = bf2f(p[n]), lv = bf2f(p[n - ((n > 0) ? 1 : 0)]), rv = bf2f(p[n + ((n < SEQ - 1) ? 1 : 0)]);
    const float l = (n > 0) ? lv : 0.f, r = (n < SEQ - 1) ? rv : 0.f;
    return bias + w0 * l + w1 * c + w2 * r;
}
__device__ __forceinline__ void setup_tables(LAS unsigned char* lds, int tid) {
    LAS f32x2* TW1 = (LAS f32x2*)(lds + TW1_OFF); LAS f32x2* TW2 = (LAS f32x2*)(lds + TW2_OFF);
    for (int i = tid; i < 15 * 256; i += 512) { const int q = i / 256 + 1, t = i & 255; float s, c; sincosf(-6.283185307179586f * (float)((t * q) & 4095) * (1.f / 4096.f), &s, &c); TW1[i] = (f32x2){c, s}; }
    for (int i = tid; i < 15 * 16; i += 512) { const int q = i / 16 + 1, n2 = i & 15; float s, c; sincosf(-6.283185307179586f * (float)((n2 * q) & 255) * (1.f / 256.f), &s, &c); TW2[i] = (f32x2){c, s}; }
}
__device__ __forceinline__ void unit(Frame& F, int c) {
    FT_DECL;
    const int tid = f_tid; Ctx X; X.half = F.wave >> 2; X.t = tid & 255;
    X.R = (LAS f32x2*)(F.lds + X.half * RB_BYTES); X.IN = (LAS f32x2*)(F.lds + IN_OFF); X.TW1 = (LAS f32x2*)(F.lds + TW1_OFF); X.TW2 = (LAS f32x2*)(F.lds + TW2_OFF);
    { float s, cc; sincosf(-6.283185307179586f * (float)X.t * (1.f / 8192.f), &s, &cc); X.wt = (f32x2){cc, s}; }
    LAS f32x2* RB0 = (LAS f32x2*)(F.lds); LAS f32x2* RB1 = (LAS f32x2*)(F.lds + RB_BYTES);
    const float* FILT = WSP(float, WS_FILT);
    f32x2 H0[16], H1[16];
#pragma unroll
    for (int ord = 0; ord < 2; ++ord) {
        const float* hf = FILT + ((size_t)(ord * 2 + 0) * 512 + c) * SEQ; const float* hb = FILT + ((size_t)(ord * 2 + 1) * 512 + c) * SEQ;
        __syncthreads();
        int nb = tid; HY_OPAQUE(nb);
#pragma unroll
        for (int j = 0; j < 8; ++j) { const int n = nb + 512 * j; const float a = hf[n], b = hb[(SEQ - n) & (SEQ - 1)]; const float lo = (n == 0) ? a + b : a, hi = (n == 0) ? 0.f : b; X.IN[n] = (f32x2){lo + hi, lo - hi}; }
        __syncthreads(); pass1_fwd<1>(X); __syncthreads(); pass2_fwd(X); HY_WSYNC();
        if (ord == 0) pass3<true>(X, H0); else pass3<true>(X, H1);
    }
    const bf16_t* UT = WSP(bf16_t, WS_UT);
    const bf16_t* rv = UT + (size_t)c * MROWS; const bf16_t* r1 = UT + (size_t)(512 + c) * MROWS; const bf16_t* r2 = UT + (size_t)(1024 + c) * MROWS;
    const float* cw = F.in[16]; const float* cb = F.in[17];
    const float wv0 = cw[c], wv1 = cw[HYC + c], wv2 = cw[2 * HYC + c], bv = cb[c];
    const float wa0 = cw[512 + c], wa1 = cw[HYC + 512 + c], wa2 = cw[2 * HYC + 512 + c], ba = cb[512 + c];
    const float wb0 = cw[1024 + c], wb1 = cw[HYC + 1024 + c], wb2 = cw[2 * HYC + 1024 + c], bb = cb[1024 + c];
    const float sk0 = F.in[25][c], sk1 = F.in[25][512 + c];
    bf16_t* Z = WSP(bf16_t, WS_Z2T) + (size_t)c * MROWS;
    LAS bf16_t* STG = (LAS bf16_t*)(F.lds + STG_OFF);
    u32x4 g0 = *(const u32x4*)(rv + tid * 8), g1 = *(const u32x4*)(rv + SEQ + tid * 8);
    for (int pr = 0; pr < 4; ++pr) {
        const int b0 = 2 * pr, b1 = b0 + 1;
        f32x2 z[8]; int pc = tid + (tid >> 4); HY_OPAQUE(pc); int nb = tid; HY_OPAQUE(nb);
        __syncthreads();
        *(LAS u32x4*)(STG + tid * 8) = g0; *(LAS u32x4*)(STG + SEQ + tid * 8) = g1;
        __syncthreads();
#pragma unroll
        for (int j = 0; j < 8; ++j) { const int n = nb + 512 * j; z[j] = (f32x2){sconv_lds(STG, 0, n, wv0, wv1, wv2, bv), sconv_lds(STG, 1, n, wv0, wv1, wv2, bv)}; X.IN[n] = z[j]; }
        g0 = *(const u32x4*)(r1 + b0 * SEQ + tid * 8); g1 = *(const u32x4*)(r1 + b1 * SEQ + tid * 8);
        conv_fft(X, H0);
        *(LAS u32x4*)(STG + tid * 8) = g0; *(LAS u32x4*)(STG + SEQ + tid * 8) = g1;
        __syncthreads();
        HY_OPAQUE(nb); HY_OPAQUE(pc);
#pragma unroll
        for (int j = 0; j < 8; ++j) { const int n = nb + 512 * j; const f32x2 y = RB0[pc + 544 * j] + RB1[pc + 544 * j];
            const f32x2 g = (f32x2){sconv_lds(STG, 0, n, wa0, wa1, wa2, ba), sconv_lds(STG, 1, n, wa0, wa1, wa2, ba)};
            z[j] = g * (y + sk0 * z[j]); X.IN[n] = z[j]; }
        g0 = *(const u32x4*)(r2 + b0 * SEQ + tid * 8); g1 = *(const u32x4*)(r2 + b1 * SEQ + tid * 8);
        conv_fft(X, H1);
        *(LAS u32x4*)(STG + tid * 8) = g0; *(LAS u32x4*)(STG + SEQ + tid * 8) = g1;
        __syncthreads();
        if (pr < 3) { g0 = *(const u32x4*)(rv + (b0 + 2) * SEQ + tid * 8); g1 = *(const u32x4*)(rv + (b1 + 2) * SEQ + tid * 8); }
        HY_OPAQUE(nb); HY_OPAQUE(pc);
        f32x2 o[8];
#pragma unroll
        for (int j = 0; j < 8; ++j) { const int n = nb + 512 * j; const f32x2 y = RB0[pc + 544 * j] + RB1[pc + 544 * j];
            const f32x2 g = (f32x2){sconv_lds(STG, 0, n, wb0, wb1, wb2, bb), sconv_lds(STG, 1, n, wb0, wb1, wb2, bb)};
            o[j] = g * (y + sk1 * z[j]); }
        __syncthreads();
#pragma unroll
        for (int j = 0; j < 8; ++j) { const int n = nb + 512 * j; STG[n] = (bf16_t)(cvt_pk_bf16(o[j].x, 0.f) & 0xffffu); STG[SEQ + n] = (bf16_t)(cvt_pk_bf16(o[j].y, 0.f) & 0xffffu); }
        __syncthreads();
        *(u32x4*)(Z + b0 * SEQ + tid * 8) = *(const LAS u32x4*)(STG + tid * 8); *(u32x4*)(Z + b1 * SEQ + tid * 8) = *(const LAS u32x4*)(STG + SEQ + tid * 8);
    }
    __syncthreads();
}
}

__device__ __forceinline__ void p3_hyena(Frame& F) {
    FT_DECL;
    __syncthreads();
    hy::setup_tables(F.lds, f_tid);
    __syncthreads();
    for (int c = F.vcu; c < HYW; c += F.G) hy::unit(F, c);
}

__device__ __forceinline__ void p4_hynorm(Frame& F) {
    FT_DECL;
    const bf16_t* Z = WSP(bf16_t, WS_Z2T); bf16_t* MIX = WSP(bf16_t, WS_MIX); const float* g = F.in[26];
    LAS bf16_t* T = (LAS bf16_t*)F.lds;
    LAS float* red = (LAS float*)(F.lds + 512 * 72 * 2);
    LAS float* rs = red + 512;
    for (int it = F.vcu; it < MROWS / 64; it += F.G) {
        const int tok0 = it * 64;
        __syncthreads();
#pragma unroll
        for (int j = 0; j < 8; ++j) { const int i = f_tid + 512 * j, row = i >> 3, ch = i & 7; const u32x4 v = *(const u32x4*)(Z + (size_t)row * MROWS + tok0 + ch * 8); *(LAS u32x4*)(T + row * 72 + ch * 8) = v; }
        __syncthreads();
        { const int tok = f_tid & 63, grp = f_tid >> 6; float ss = 0.f;
#pragma unroll 8
            for (int k = 0; k < 64; ++k) { const float v = bf2f(T[(grp * 64 + k) * 72 + tok]); ss += v * v; }
            red[grp * 64 + tok] = ss; }
        __syncthreads();
        if (f_tid < 64) { float ss = 0.f;
#pragma unroll
            for (int w = 0; w < 8; ++w) ss += red[w * 64 + f_tid];
            rs[f_tid] = rsqrtf(ss * (1.f / HYW) + EPS); }
        __syncthreads();
#pragma unroll
        for (int j = 0; j < 8; ++j) { const int i = f_tid + 512 * j, tok = i >> 6, c0 = (i & 63) * 8; const float r = rs[tok];
            float v[8];
#pragma unroll
            for (int e = 0; e < 8; ++e) v[e] = bf2f(T[(c0 + e) * 72 + tok]) * r * g[c0 + e];
            u32x4 w; w.x = cvt_pk_bf16(v[0], v[1]); w.y = cvt_pk_bf16(v[2], v[3]); w.z = cvt_pk_bf16(v[4], v[5]); w.w = cvt_pk_bf16(v[6], v[7]);
            *(u32x4*)(MIX + (size_t)(tok0 + tok) * DM + 512 + c0) = w; }
    }
}

__device__ __forceinline__ void p4_stub(Frame& F) {
    FT_DECL;
    bf16_t* MIX = WSP(bf16_t, WS_MIX);
    const size_t gt = (size_t)F.vcu * 512 + f_tid, NT = (size_t)F.G * 512;
    for (size_t i = gt; i < (size_t)MROWS * 64; i += NT) { const size_t row = i >> 6, ch = i & 63; *(u32x4*)(MIX + row * DM + 512 + ch * 8) = (u32x4){0u, 0u, 0u, 0u}; }
}


constexpr size_t RT_TOPI = 0;
constexpr size_t RT_GATE = 512 * 1024;
constexpr size_t RT_POS = 1024 * 1024;
constexpr size_t RT_WGCNT = 1536 * 1024;
constexpr size_t RT_META = 1600 * 1024;
constexpr size_t RT_LIST = 2048 * 1024;
constexpr size_t RT_GSLOT = 2048 * 1024 + 640 * 1024;
constexpr int MAXSLOT = MROWS * TOPK + NEXP * 256;
constexpr int MAXTILE = MAXSLOT / 256;
constexpr size_t WS_XS = WS_EO;
constexpr int RW_PITCH = 32;
constexpr int P6_LDS_TOPI = 1024 * RW_PITCH * 4;

__device__ __forceinline__ void p6_router(Frame& F) {
    FT_DECL;
#define in F.in
    LAS float* RW = (LAS float*)F.lds;
    LAS int* TI = (LAS int*)(F.lds + P6_LDS_TOPI);
    LAS int* PS = TI + 512;
    LAS int* SC = PS + 512;
    const float* rw = in[28];
    for (int i = f_tid; i < 1024 * 8; i += 512) { const int k = i >> 3, c4 = i & 7; const f32x4 v = *(const f32x4*)(rw + (size_t)k * 32 + c4 * 4);
        const int pi = (k & 3) * 256 + (k >> 2); *(LAS f32x4*)(RW + pi * RW_PITCH + ((c4 ^ ((pi >> 1) & 7)) * 4)) = v; }
    __syncthreads();
    const float* mod = WSP(float, WS_SMALL + SM_MOD); const float* g2n = in[7]; const float* rb = in[29];
    unsigned char* H2 = WSP(unsigned char, WS_H);
    int* topi_g = WSP(int, WS_ROUTE + RT_TOPI); float* gate_g = WSP(float, WS_ROUTE + RT_GATE); int* pos_g = WSP(int, WS_ROUTE + RT_POS); int* wgcnt = WSP(int, WS_ROUTE + RT_WGCNT);
    const int lane = f_lane;
    for (int blk = blockIdx.x; blk < MROWS / 128; blk += F.G) {
        for (int it = 0; it < 8; ++it) {
            const int rl = F.wave * 16 + 2 * it, r0 = blk * 128 + rl;
            const float* sh2 = mod + (size_t)(r0 >> 12) * (NMOD * DM) + 3 * DM; const float* sc2 = sh2 + DM;
            f32x4 h[2][4];
#pragma unroll
            for (int rr = 0; rr < 2; ++rr) {
                const GAS u32x2* xr = (const GAS u32x2*)(WSP(bf16_t, WS_XN) + (size_t)(r0 + rr) * DM) + lane; float ss = 0.f;
#pragma unroll
                for (int j = 0; j < 4; ++j) { const u32x2 xb = xr[64 * j]; h[rr][j] = (f32x4){__uint_as_float(xb.x << 16), __uint_as_float(xb.x & 0xffff0000u), __uint_as_float(xb.y << 16), __uint_as_float(xb.y & 0xffff0000u)}; ss += (h[rr][j].x * h[rr][j].x + h[rr][j].y * h[rr][j].y) + (h[rr][j].z * h[rr][j].z + h[rr][j].w * h[rr][j].w); }
                const float rstd = rsqrtf(wave_sum(ss) * (1.f / DM) + EPS);
                GAS unsigned* o4 = (GAS unsigned*)(H2 + (size_t)(r0 + rr) * DM) + lane;
#pragma unroll
                for (int j = 0; j < 4; ++j) { const int c = 4 * lane + 256 * j;
                    const f32x4 g = *(const f32x4*)(g2n + c), a = *(const f32x4*)(sc2 + c), b = *(const f32x4*)(sh2 + c);
                    h[rr][j] = h[rr][j] * rstd * g * (a + 1.f) + b;
                    o4[64 * j] = pk4_fp8(h[rr][j].x, h[rr][j].y, h[rr][j].z, h[rr][j].w); }
            }
            float a0[32], a1[32]; int lb = lane; asm volatile("" : "+v"(lb)); const int sw = (lb >> 1) & 7;
#pragma unroll
            for (int e = 0; e < 32; ++e) { a0[e] = 0.f; a1[e] = 0.f; }
            unsigned pb[8];
#pragma unroll
            for (int c = 0; c < 8; ++c) { pb[c] = (unsigned)(uintptr_t)RW + (unsigned)lb * 128u + (unsigned)((c ^ sw) * 16); asm volatile("" : "+v"(pb[c])); }
            f32x4 wb[2][4];
#define P6_OFF(hs) ((((((hs) >> 1) & 3) * 256 + 64 * ((hs) >> 3)) * 128) & 65535)
#define P6_HI(hs) ((((((hs) >> 1) & 3) * 256 + 64 * ((hs) >> 3)) * 128) >> 16)
#define P6_LOADW(buf, hs) _Pragma("unroll") for (int c = 0; c < 4; ++c) wb[buf][c] = *(const LAS f32x4*)(uintptr_t)(pb[4 * ((hs) & 1) + c] + (unsigned)(P6_HI(hs) * 65536 + P6_OFF(hs)))
#define P6_FMA(buf, hs) do { const float x0 = h[0][(hs) >> 3][((hs) >> 1) & 3], x1 = h[1][(hs) >> 3][((hs) >> 1) & 3]; _Pragma("unroll") for (int c = 0; c < 4; ++c) _Pragma("unroll") for (int e = 0; e < 4; ++e) { \
                a0[16 * ((hs) & 1) + 4 * c + e] += x0 * wb[buf][c][e]; a1[16 * ((hs) & 1) + 4 * c + e] += x1 * wb[buf][c][e]; } } while (0)
            P6_LOADW(0, 0);
#pragma unroll
            for (int hs = 0; hs < 32; hs += 2) {
                P6_LOADW(1, hs + 1); __builtin_amdgcn_sched_barrier(0); asm volatile("s_waitcnt lgkmcnt(4)" ::: "memory"); __builtin_amdgcn_sched_barrier(0);
                P6_FMA(0, hs); __builtin_amdgcn_sched_barrier(0);
                if (hs + 2 < 32) { P6_LOADW(0, hs + 2); __builtin_amdgcn_sched_barrier(0); asm volatile("s_waitcnt lgkmcnt(4)" ::: "memory"); } else { asm volatile("s_waitcnt lgkmcnt(0)" ::: "memory"); }
                __builtin_amdgcn_sched_barrier(0);
                P6_FMA(1, hs + 1); __builtin_amdgcn_sched_barrier(0);
            }
#undef P6_LOADW
#undef P6_FMA
#undef P6_OFF
#undef P6_HI
#define RS_STEP(A, CNT, MASK) _Pragma("unroll") for (int i = 0; i < CNT; ++i) { const bool up = (lane & MASK) != 0; const float send = up ? A[i] : A[CNT + i]; const float keep = up ? A[CNT + i] : A[i]; A[i] = keep + __shfl_xor(send, MASK); }
            RS_STEP(a0, 16, 32) RS_STEP(a0, 8, 16) RS_STEP(a0, 4, 8) RS_STEP(a0, 2, 4) RS_STEP(a0, 1, 2)
            RS_STEP(a1, 16, 32) RS_STEP(a1, 8, 16) RS_STEP(a1, 4, 8) RS_STEP(a1, 2, 4) RS_STEP(a1, 1, 2)
#undef RS_STEP
            const int me = lane >> 1; const float bias = rb[me];
            float lg[2]; lg[0] = a0[0] + __shfl_xor(a0[0], 1) + bias; lg[1] = a1[0] + __shfl_xor(a1[0], 1) + bias;
            LAS float* WL = (LAS float*)(F.lds + P6_LDS_TOPI + 6144) + F.wave * 96;
            if ((lane & 1) == 0) { WL[me] = lg[0]; WL[32 + me] = lg[1]; }
            LDS_WAIT(); asm volatile("" ::: "memory");
#pragma unroll
            for (int rr = 0; rr < 2; ++rr) {
                const float v = lg[rr]; int rank = 0;
#pragma unroll
                for (int c4 = 0; c4 < 8; ++c4) { const f32x4 o = *(const LAS f32x4*)(WL + rr * 32 + 4 * c4);
#pragma unroll
                    for (int e = 0; e < 4; ++e) { const int oe = 4 * c4 + e; rank += (o[e] > v || (o[e] == v && oe < me)) ? 1 : 0; } }
                if ((lane & 1) == 0 && rank < 4) { WL[64 + rr * 4 + rank] = v; ((LAS int*)WL)[72 + rr * 4 + rank] = me; }
            }
            LDS_WAIT(); asm volatile("" ::: "memory");
            if (lane < 2) { const int rr = lane; const f32x4 tv = *(const LAS f32x4*)(WL + 64 + rr * 4); typedef int i32x4_t __attribute__((ext_vector_type(4))); const i32x4_t ti = *(const LAS i32x4_t*)((LAS int*)WL + 72 + rr * 4);
                const float e1 = __expf(tv[1] - tv[0]), e2 = __expf(tv[2] - tv[0]), e3 = __expf(tv[3] - tv[0]); const float inv = 1.f / (1.f + e1 + e2 + e3);
                const int r = r0 + rr;
                *(i32x4_t*)(topi_g + (size_t)r * 4) = ti;
                *(f32x4*)(gate_g + (size_t)r * 4) = (f32x4){inv, e1 * inv, e2 * inv, e3 * inv};
                *(LAS i32x4_t*)(TI + (rl + rr) * 4) = ti; }
            LDS_WAIT(); asm volatile("" ::: "memory");
        }
        __syncthreads();
        { const int t2 = F.wave * 64 + lane_id(); const int e = t2 & 31, seg = t2 >> 5; int cnt = 0;
#pragma unroll 4
            for (int i = 0; i < 32; ++i) cnt += (TI[seg * 32 + i] == e) ? 1 : 0;
            SC[seg * 32 + e] = cnt;
            __syncthreads();
            int pre = 0;
            for (int s2 = 0; s2 < seg; ++s2) pre += SC[s2 * 32 + e];
            if (seg == 15) wgcnt[blk * 32 + e] = pre + cnt;
            for (int i = 0; i < 32; ++i) if (TI[seg * 32 + i] == e) { PS[seg * 32 + i] = pre; ++pre; }
        }
        __syncthreads();
        { const int t3 = F.wave * 64 + lane_id(); pos_g[(size_t)blk * 512 + t3] = PS[t3]; }
        __syncthreads();
    }
#undef in
}


__device__ __forceinline__ void p6_router_mfma(Frame& F) {
    FT_DECL;
#define in F.in
    LAS float* WP = (LAS float*)F.lds;
    LAS int* TI = (LAS int*)(F.lds + P6_LDS_TOPI);
    LAS int* PS = TI + 512;
    LAS int* SC = PS + 512;
    LAS float* RSTD = (LAS float*)(SC + 512);
    LAS float* BIAS = RSTD + 128;
    LAS float* SSX = BIAS + 32;
    const float* rw = in[28]; const float* mod = WSP(float, WS_SMALL + SM_MOD); const float* g2n = in[7]; const float* rb = in[29];
    const bf16_t* XN = WSP(bf16_t, WS_XN); unsigned char* H2 = WSP(unsigned char, WS_H);
    int* topi_g = WSP(int, WS_ROUTE + RT_TOPI); float* gate_g = WSP(float, WS_ROUTE + RT_GATE); int* pos_g = WSP(int, WS_ROUTE + RT_POS); int* wgcnt = WSP(int, WS_ROUTE + RT_WGCNT);
    for (int blk = blockIdx.x; blk < MROWS / 128; blk += F.G) {
        const float* sh2 = mod + (size_t)(blk >> 5) * (NMOD * DM) + 3 * DM; const float* sc2 = sh2 + DM;
        __syncthreads();
        for (int i = f_tid; i < 1024 * 8; i += 512) { const int k = i >> 3, c4 = i & 7; const float gm = g2n[k] * (1.f + sc2[k]);
            *(LAS f32x4*)(WP + k * 32 + c4 * 4) = *(const f32x4*)(rw + (size_t)k * 32 + c4 * 4) * gm; }
        { const int e = f_tid & 31, part = f_tid >> 5; float a = 0.f;
            for (int k = part * 64; k < part * 64 + 64; ++k) a += sh2[k] * rw[(size_t)k * 32 + e];
            ((LAS float*)SC)[part * 32 + e] = a; }
        __syncthreads();
        if (f_tid < 32) { float a = rb[f_tid];
#pragma unroll
            for (int p = 0; p < 16; ++p) a += ((LAS float*)SC)[p * 32 + f_tid];
            BIAS[f_tid] = a; }
        const int rg = F.wave & 3, kh = F.wave >> 2, j = f_lane & 31, hi = f_lane >> 5;
        f32x16 acc = {};
        float ss = 0.f;
        { const bf16_t* xrow = XN + (size_t)(blk * 128 + rg * 32 + j) * DM + 512 * kh + 8 * hi;
            const LAS float* wp = WP + (512 * kh + 8 * hi) * 32 + j;
#pragma unroll 4
            for (int c = 0; c < 32; ++c) { const u32x4 xb = *(const u32x4*)(xrow + 16 * c);
                float xf[8] = {__uint_as_float(xb.x << 16), __uint_as_float(xb.x & 0xffff0000u), __uint_as_float(xb.y << 16), __uint_as_float(xb.y & 0xffff0000u),
                               __uint_as_float(xb.z << 16), __uint_as_float(xb.z & 0xffff0000u), __uint_as_float(xb.w << 16), __uint_as_float(xb.w & 0xffff0000u)};
#pragma unroll
                for (int q = 0; q < 8; ++q) { ss += xf[q] * xf[q]; acc = __builtin_amdgcn_mfma_f32_32x32x2f32(wp[(16 * c + q) * 32], xf[q], acc, 0, 0, 0); } } }
        { auto rr = __builtin_amdgcn_permlane32_swap(__float_as_uint(ss), __float_as_uint(ss), false, false); ss = __uint_as_float(rr[0]) + __uint_as_float(rr[1]); }
        if (hi == 0) SSX[kh * 128 + rg * 32 + j] = ss;
        __syncthreads();
        if (kh == 1) {
#pragma unroll
            for (int r = 0; r < 16; ++r) WP[(rg * 16 + r) * 64 + f_lane] = acc[r]; }
        if (f_tid < 128) RSTD[f_tid] = rsqrtf((SSX[f_tid] + SSX[128 + f_tid]) * (1.f / DM) + EPS);
        __syncthreads();
        if (kh == 0) {
            const float rstd = RSTD[rg * 32 + j];
            float tv[4] = {-INFINITY, -INFINITY, -INFINITY, -INFINITY}; int ti[4] = {1 << 20, 1 << 20, 1 << 20, 1 << 20};
#define P6_INS(V, E) do { float cv = (V); int ce = (E); _Pragma("unroll") for (int q = 0; q < 4; ++q) { const bool b = cv > tv[q] || (cv == tv[q] && ce < ti[q]); \
                const float nv = b ? tv[q] : cv; const int ne = b ? ti[q] : ce; tv[q] = b ? cv : tv[q]; ti[q] = b ? ce : ti[q]; cv = nv; ce = ne; } } while (0)
#pragma unroll
            for (int r = 0; r < 16; ++r) { const int e = (r & 3) + 8 * (r >> 2) + 4 * hi; const float v = (acc[r] + WP[(rg * 16 + r) * 64 + f_lane]) * rstd + BIAS[e]; P6_INS(v, e); }
            float ov[4]; int oe[4];
#pragma unroll
            for (int q = 0; q < 4; ++q) { ov[q] = __shfl_xor(tv[q], 32); oe[q] = __shfl_xor(ti[q], 32); }
#pragma unroll
            for (int q = 0; q < 4; ++q) P6_INS(ov[q], oe[q]);
#undef P6_INS
            if (hi == 0) { const int rl = rg * 32 + j, r = blk * 128 + rl;
                const float e1 = __expf(tv[1] - tv[0]), e2 = __expf(tv[2] - tv[0]), e3 = __expf(tv[3] - tv[0]); const float inv = 1.f / (1.f + e1 + e2 + e3);
                typedef int i32x4_t __attribute__((ext_vector_type(4))); const i32x4_t t4 = {ti[0], ti[1], ti[2], ti[3]};
                *(i32x4_t*)(topi_g + (size_t)r * 4) = t4; *(f32x4*)(gate_g + (size_t)r * 4) = (f32x4){inv, e1 * inv, e2 * inv, e3 * inv};
                *(LAS i32x4_t*)(TI + rl * 4) = t4; }
        }
        __syncthreads();
        { const int t2 = F.wave * 64 + lane_id(); const int e = t2 & 31, seg = t2 >> 5; int cnt = 0;
#pragma unroll 4
            for (int i = 0; i < 32; ++i) cnt += (TI[seg * 32 + i] == e) ? 1 : 0;
            SC[seg * 32 + e] = cnt;
            __syncthreads();
            int pre = 0;
            for (int s2 = 0; s2 < seg; ++s2) pre += SC[s2 * 32 + e];
            if (seg == 15) wgcnt[blk * 32 + e] = pre + cnt;
            for (int i = 0; i < 32; ++i) if (TI[seg * 32 + i] == e) { PS[seg * 32 + i] = pre; ++pre; }
        }
        __syncthreads();
        { const int t3 = F.wave * 64 + lane_id(); pos_g[(size_t)blk * 512 + t3] = PS[t3]; }
        { const int lane = lane_id();
            for (int it = 0; it < 4; ++it) { u32x2 xb[4][4];
#pragma unroll
                for (int u = 0; u < 4; ++u) { const GAS u32x2* xr = (const GAS u32x2*)(XN + (size_t)(blk * 128 + F.wave * 16 + 4 * it + u) * DM) + lane;
#pragma unroll
                    for (int jj = 0; jj < 4; ++jj) xb[u][jj] = xr[64 * jj]; }
#pragma unroll
                for (int u = 0; u < 4; ++u) { const int rl = F.wave * 16 + 4 * it + u; const float rstd = RSTD[rl];
                    GAS unsigned* o4 = (GAS unsigned*)(H2 + (size_t)(blk * 128 + rl) * DM) + lane;
#pragma unroll
                    for (int jj = 0; jj < 4; ++jj) { const int c = 4 * lane + 256 * jj;
                        const f32x4 x = (f32x4){__uint_as_float(xb[u][jj].x << 16), __uint_as_float(xb[u][jj].x & 0xffff0000u), __uint_as_float(xb[u][jj].y << 16), __uint_as_float(xb[u][jj].y & 0xffff0000u)};
                        const f32x4 g = *(const f32x4*)(g2n + c), a = *(const f32x4*)(sc2 + c), b = *(const f32x4*)(sh2 + c);
                        const f32x4 h = x * rstd * g * (a + 1.f) + b;
                        o4[64 * jj] = pk4_fp8(h.x, h.y, h.z, h.w); } } }
        }
    }
#undef in
}

__device__ __forceinline__ void p7_scatter(Frame& F) {
    FT_DECL;
    LAS int* TOT = (LAS int*)F.lds;
    LAS int* BASE = TOT + 32;
    LAS int* PRE = BASE + 32;
    LAS int* PART = PRE + 32;
    const int* wgcnt = WSP(int, WS_ROUTE + RT_WGCNT); const int* topi_g = WSP(int, WS_ROUTE + RT_TOPI); const float* gate_g = WSP(float, WS_ROUTE + RT_GATE); const int* pos_g = WSP(int, WS_ROUTE + RT_POS);
    int* list = WSP(int, WS_ROUTE + RT_LIST); float* gslot = WSP(float, WS_ROUTE + RT_GSLOT); int* meta = WSP(int, WS_ROUTE + RT_META);
    const unsigned char* H2 = WSP(unsigned char, WS_H); unsigned char* XS = WSP(unsigned char, WS_XS);
    for (int blk = blockIdx.x; blk < MROWS / 128; blk += F.G) {
        __syncthreads();
        { const int e = f_tid & 31, part = f_tid >> 5; int st = 0, sp = 0;
            for (int w = part * 16; w < part * 16 + 16; ++w) { const int c = wgcnt[w * 32 + e]; st += c; if (w < blk) sp += c; }
            PART[part * 32 + e] = st; PART[512 + part * 32 + e] = sp; }
        __syncthreads();
        if (f_tid < 32) { int st = 0, sp = 0;
#pragma unroll
            for (int p = 0; p < 16; ++p) { st += PART[p * 32 + f_tid]; sp += PART[512 + p * 32 + f_tid]; }
            TOT[f_tid] = st; PRE[f_tid] = sp; }
        __syncthreads();
        if (f_tid == 0) { int b = 0; for (int e = 0; e < 32; ++e) { BASE[e] = b; b += (TOT[e] + 255) & ~255; }
            if (blk == 0) { int t = 0; for (int e = 0; e < 32; ++e) { meta[e] = TOT[e]; meta[32 + e] = BASE[e]; const int nt = (TOT[e] + 255) >> 8; for (int q = 0; q < nt; ++q) meta[128 + t + q] = e; t += nt; } meta[64] = t; } }
        __syncthreads();
        { const int a = f_tid, row = blk * 128 + (a >> 2); const int e = topi_g[(size_t)blk * 512 + a]; const int slot = BASE[e] + PRE[e] + pos_g[(size_t)blk * 512 + a];
            list[slot] = row * 4 + (a & 3); gslot[slot] = gate_g[(size_t)blk * 512 + a];
            PART[a] = slot; }
        __syncthreads();
        for (int a0 = F.wave * 8; a0 < 512; a0 += NWAVES * 8) { u32x4 v[8]; int sl[8];
#pragma unroll
            for (int q = 0; q < 8; ++q) { const int a = a0 + q; sl[q] = PART[a]; v[q] = ((const GAS u32x4*)(H2 + (size_t)(blk * 128 + (a >> 2)) * DM))[f_lane]; }
#pragma unroll
            for (int q = 0; q < 8; ++q) ((GAS u32x4*)(XS + (size_t)sl[q] * DM))[f_lane] = v[q]; }
        if (blk < NEXP) { const int e = blk, lo = BASE[e] + TOT[e], hi = BASE[e] + ((TOT[e] + 255) & ~255);
            for (int sl = lo + F.wave; sl < hi; sl += NWAVES) { if (f_lane == 0) { list[sl] = -1; gslot[sl] = 0.f; }
                ((GAS u32x4*)(XS + (size_t)sl * DM))[f_lane] = (u32x4){0u, 0u, 0u, 0u}; } }
    }
}

template <int NPN> struct SchedMoE {
    int G, c, nT; const char* A; const char* W; size_t wstride; const LAS unsigned char* tileE;
    __device__ __forceinline__ bool next(int i, g8::Unit& u) const {
        const int L = i * G + c, xcd = L & 7, j = L >> 3, T = (j / NPN) * 8 + xcd, pn = j % NPN;
        if (T >= nT) return false;
        const int e = tileE[T];
        u.pm = T; u.pn = pn; u.kind = i; u.ex = e; u.a = A + (size_t)T * 256 * DM; u.b = W + (size_t)e * wstride + (size_t)pn * 256 * DM; return true;
    }
};
struct EpiSwiGLU {
    unsigned char* ACT; const float* b1;
    __device__ __forceinline__ void operator()(f32x4 (&acc)[2][2][4][2], const g8::Unit& u, int wr, int wc, int fr, int fq) const {
        asm volatile("" : "+v"(fr), "+v"(fq));
        const int j0 = u.pn * 128 + wc * 32 + 8 * fq; const float* bp = b1 + (size_t)u.ex * 2 * DM + j0;
        f32x4 bg[2], bl[2];
#pragma unroll
        for (int n = 0; n < 2; ++n) { bg[n] = *(const f32x4*)(bp + 4 * n); bl[n] = *(const f32x4*)(bp + DM + 4 * n); }
#pragma unroll
        for (int ai = 0; ai < 2; ++ai)
#pragma unroll
            for (int m = 0; m < 4; ++m) { const size_t slot = (size_t)u.pm * 256 + ai * 128 + wr * 64 + m * 16 + fr; float o[8];
#pragma unroll
                for (int n = 0; n < 2; ++n) { const f32x4 g4 = acc[ai][0][m][n] * (1.f / WSCALE) + bg[n], l4 = acc[ai][1][m][n] * (1.f / WSCALE) + bl[n];
#pragma unroll
                    for (int e = 0; e < 4; ++e) { const float g = fminf(g4[e], 7.f), l = __builtin_amdgcn_fmed3f(l4[e], -7.f, 7.f);
                        const float ex = __builtin_amdgcn_exp2f(g * (-1.702f * 1.4426950408889634f)); const float glu = g * __builtin_amdgcn_rcpf(1.f + ex);
                        o[4 * n + e] = fmaf(l, glu, glu); } }
                u32x2 w; w.x = pk4_fp8(o[0], o[1], o[2], o[3]); w.y = pk4_fp8(o[4], o[5], o[6], o[7]);
                *(u32x2*)(ACT + slot * DM + j0) = w; }
    }
};
struct EpiDown {
    unsigned char* EO; const float* b2; const LAS int* LL; int G, c;
    __device__ __forceinline__ void operator()(f32x4 (&acc)[2][2][4][2], const g8::Unit& u, int wr, int wc, int fr, int fq) const {
        asm volatile("" : "+v"(fr), "+v"(fq));
        const int c0 = u.pn * 256 + wc * 32 + 8 * fq; const float* bp = b2 + (size_t)u.ex * DM + c0;
        f32x4 bb[2][2];
#pragma unroll
        for (int bj = 0; bj < 2; ++bj)
#pragma unroll
            for (int n = 0; n < 2; ++n) bb[bj][n] = *(const f32x4*)(bp + bj * 128 + 4 * n);
        const LAS int* L = LL + u.kind * 512;
        int li[8]; float gt[8];
#pragma unroll
        for (int q = 0; q < 8; ++q) { const int rl = (q >> 2) * 128 + wr * 64 + (q & 3) * 16 + fr; li[q] = L[rl]; gt[q] = __int_as_float(L[256 + rl]) * (1.f / WSCALE); }
#pragma unroll
        for (int ai = 0; ai < 2; ++ai)
#pragma unroll
            for (int m = 0; m < 4; ++m) { const int l = li[ai * 4 + m]; const float g = gt[ai * 4 + m];
                unsigned char* dst = EO + ((size_t)(l & 3) * MROWS + (l >> 2)) * DM + c0;
                u32x2 w[2];
#pragma unroll
                for (int bj = 0; bj < 2; ++bj) { const f32x4 v0 = acc[ai][bj][m][0] * g + bb[bj][0] * (g * WSCALE), v1 = acc[ai][bj][m][1] * g + bb[bj][1] * (g * WSCALE);
                    w[bj].x = pk4_fp8(v0[0] * EOSCALE, v0[1] * EOSCALE, v0[2] * EOSCALE, v0[3] * EOSCALE); w[bj].y = pk4_fp8(v1[0] * EOSCALE, v1[1] * EOSCALE, v1[2] * EOSCALE, v1[3] * EOSCALE); }
                if (l >= 0) { *(u32x2*)dst = w[0]; *(u32x2*)(dst + 128) = w[1]; } }
    }
};
__device__ __forceinline__ const LAS unsigned char* moe_tiles(Frame& F, int& nT) {
    FT_DECL;
    LAS unsigned char* TE = (LAS unsigned char*)(F.lds + RING_BYTES); const int* meta = WSP(int, WS_ROUTE + RT_META);
    __syncthreads();
    nT = meta[64]; if (nT > MAXTILE) nT = MAXTILE;
    for (int i = f_tid; i < MAXTILE; i += 512) TE[i] = (unsigned char)((i < nT) ? meta[128 + i] : 0);
    __syncthreads();
    return (const LAS unsigned char*)TE;
}

__device__ __forceinline__ void p10_combine(Frame& F) {
    FT_DECL;
    const float* mod = WSP(float, WS_SMALL + SM_MOD); const unsigned char* EO = WSP(unsigned char, WS_EO);
    const size_t gt = (size_t)F.vcu * 512 + f_tid, NTH = (size_t)F.G * 512;
    float pd = 0.f, pa = 0.f;
    if (MK_PROBE_A != -2) { const unsigned long long* st = (const unsigned long long*)(F.ws + WS_CTL + 8192);
        pd = (MK_PROBE_A < 0) ? 0.1f : (float)(st[MK_PA1] - st[MK_PA0]) * MK_PSA; pa = (float)(st[MK_PB1] - st[MK_PB0]) * MK_PSB; }
    constexpr int U = 4;
    for (size_t i0 = gt; i0 < (size_t)MROWS * 128; i0 += NTH * U) {
        u32x2 ev[U][4]; f32x4 xv[U][2], gv[U][2];
#pragma unroll
        for (int u = 0; u < U; ++u) { const size_t i = i0 + (size_t)u * NTH; const size_t row = i >> 7; const int c0 = (int)(i & 127) * 8;
            const float* g2 = mod + (size_t)(row >> 12) * (NMOD * DM) + 5 * DM + c0; const bf16_t* op = WSP(bf16_t, WS_XN) + row * DM + c0;
#pragma unroll
            for (int k = 0; k < 4; ++k) ev[u][k] = __builtin_nontemporal_load((const u32x2*)(EO + ((size_t)k * MROWS + row) * DM + c0));
            { const u32x4 xb = *(const u32x4*)op; xv[u][0] = (f32x4){__uint_as_float(xb.x << 16), __uint_as_float(xb.x & 0xffff0000u), __uint_as_float(xb.y << 16), __uint_as_float(xb.y & 0xffff0000u)};
              xv[u][1] = (f32x4){__uint_as_float(xb.z << 16), __uint_as_float(xb.z & 0xffff0000u), __uint_as_float(xb.w << 16), __uint_as_float(xb.w & 0xffff0000u)}; }
            gv[u][0] = *(const f32x4*)g2; gv[u][1] = *(const f32x4*)(g2 + 4); }
#pragma unroll
        for (int u = 0; u < U; ++u) { const size_t i = i0 + (size_t)u * NTH; const size_t row = i >> 7; const int c0 = (int)(i & 127) * 8;
            float s[8];
#pragma unroll
            for (int e = 0; e < 8; ++e) s[e] = 0.f;
#pragma unroll
            for (int k = 0; k < 4; ++k) { const u32x2 v = ev[u][k];
                const f32x2 a = __builtin_amdgcn_cvt_pk_f32_fp8((int)v.x, false), b = __builtin_amdgcn_cvt_pk_f32_fp8((int)v.x, true), c = __builtin_amdgcn_cvt_pk_f32_fp8((int)v.y, false), d = __builtin_amdgcn_cvt_pk_f32_fp8((int)v.y, true);
                s[0] += a.x; s[1] += a.y; s[2] += b.x; s[3] += b.y; s[4] += c.x; s[5] += c.y; s[6] += d.x; s[7] += d.y; }
#pragma unroll
            for (int e = 0; e < 8; ++e) s[e] *= (1.f / EOSCALE);
            f32x4 o0 = xv[u][0] + gv[u][0] * (f32x4){s[0], s[1], s[2], s[3]}, o1 = xv[u][1] + gv[u][1] * (f32x4){s[4], s[5], s[6], s[7]};
            if (MK_PROBE_A != -2) { o0 += pd; o1 += pd; if (i == 0) o0[0] += pa; }
            float* op = F.out + row * DM + c0;
            __builtin_nontemporal_store(o0, (f32x4*)op); __builtin_nontemporal_store(o1, (f32x4*)(op + 4)); }
    }
}

struct Args { const float* in[34]; float* out; unsigned char* ws; int ph_lo, ph_hi; };
constexpr int N_PHASES = 11;

__global__ void __launch_bounds__(512, 2) mega(Args args) {
    extern __shared__ __attribute__((aligned(16))) unsigned char lds[];
    Frame F;
    F.lds = (LAS unsigned char*)lds;
    F.MISC = (volatile LAS unsigned*)(F.lds + LDSCTL_OFF);
    F.wave = __builtin_amdgcn_readfirstlane(threadIdx.x >> 6);
    FT_DECL;
    F.G = gridDim.x; { const int bx = blockIdx.x; F.vcu = (F.G % 8 == 0) ? (bx % 8) * (F.G / 8) + bx / 8 : bx; }
    F.in = (kin_t)__builtin_amdgcn_kernarg_segment_ptr();
    F.out = args.out; F.ws = args.ws;
    F.ctl = (gu32*)(args.ws + WS_CTL);
    for (int u = f_tid; u < (LDS_BYTES - LDSCTL_OFF) / 4; u += NWAVES * 64) ((LAS unsigned*)(F.lds + LDSCTL_OFF))[u] = 0u;
    __syncthreads();
    const int lo = args.ph_lo, hi = args.ph_hi;
    XcdBarrier bar; bar.bar = (unsigned*)(F.ctl + CW_BAR); bar.x = 0; bar.st = nullptr;
    if (hi - lo > 1) bar = xcd_barrier_post((unsigned*)(F.ctl + CW_BAR), F.MISC + 8, f_tid == 0);
#define IN(k) (lo <= (k) && (k) < hi)
    unsigned long long* stamps = (unsigned long long*)(args.ws + WS_CTL + 8192);
#define STAMP(k) do { if (MK_PROBE_A != -2 && blockIdx.x == 0 && f_tid == 0) stamps[(k)] = __builtin_amdgcn_s_memrealtime(); } while (0)
    STAMP(0);
#define SEAM(k) do { if (IN(k) && IN((k) + 1)) xcd_barrier(bar, F.wave == 0 && lane_id() == 0); } while (0)

    if (IN(0)) { p0_prologue(F); } SEAM(0); STAMP(1);
    if (IN(1)) { p1_norm1(F); } SEAM(1); STAMP(2);
    if (IN(2)) {
        SchedInProj S{F.G, (int)blockIdx.x, (const char*)WSP(bf16_t, WS_H), (const char*)WSP(bf16_t, WS_WIN)};
        EpiInProj E{WSP(unsigned char, WS_Q), WSP(unsigned char, WS_K), WSP(unsigned char, WS_V), WSP(bf16_t, WS_UT), F.in[9], F.in[10], WSP(float, WS_SMALL + SM_ROPE)};
        g8::gemm_phase<false>(F.lds, DM, S, E, F.wave, lane_id());
    } SEAM(2); STAMP(3);
    if (IN(3)) { p3_attention8(F); STAMP(12); p3_hyena(F); } SEAM(3); STAMP(4);
    if (IN(4)) { p4_hynorm(F); } SEAM(4); STAMP(5);
    if (IN(5)) {
        SchedStatic S{F.G, (int)blockIdx.x, MROWS / 256, DM / 256, (const char*)WSP(bf16_t, WS_MIX), (const char*)WSP(bf16_t, WS_WOUT)};
        EpiOutProj E{F.in[0], WSP(bf16_t, WS_XN), WSP(float, WS_SMALL + SM_MOD)};
        g8::gemm_phase<false>(F.lds, DM, S, E, F.wave, lane_id());
    } SEAM(5); STAMP(6);
    if (IN(6)) { p6_router_mfma(F); } SEAM(6); STAMP(7);
    if (IN(7)) { p7_scatter(F); } SEAM(7); STAMP(8);
    if (IN(8)) {
        int nT; const LAS unsigned char* TE = moe_tiles(F, nT);
        SchedMoE<8> S{F.G, (int)blockIdx.x, nT, (const char*)WSP(char, WS_XS), (const char*)WSP(char, WS_W1), (size_t)2 * DM * DM, TE};
        EpiSwiGLU E{WSP(unsigned char, WS_ACT), F.in[31]};
        g8::gemm_phase<true>(F.lds, DM, S, E, F.wave, lane_id());
    } SEAM(8); STAMP(9);
    if (IN(9)) {
        int nT; const LAS unsigned char* TE = moe_tiles(F, nT);
        SchedMoE<4> S{F.G, (int)blockIdx.x, nT, (const char*)WSP(char, WS_ACT), (const char*)WSP(char, WS_W2), (size_t)DM * DM, TE};
        LAS int* LL = (LAS int*)(F.lds + RING_BYTES + 1024);
        static_assert(RING_BYTES + 1024 + 9 * 2048 <= LDSCTL_OFF, "LDS map");
        { const int* list = WSP(int, WS_ROUTE + RT_LIST); const float* gslot = WSP(float, WS_ROUTE + RT_GSLOT);
            const int t9 = F.wave * 64 + lane_id();
            g8::Unit u; for (int i = 0; i < 9 && S.next(i, u); ++i) { const int t = t9 & 255; const size_t slot = (size_t)u.pm * 256 + t;
                LL[i * 512 + (t9 >> 8) * 256 + t] = (t9 < 256) ? list[slot] : __float_as_int(gslot[slot]); }
            __syncthreads(); }
        EpiDown E{WSP(unsigned char, WS_EO), F.in[33], LL, F.G, (int)blockIdx.x};
        g8::gemm_phase<true>(F.lds, DM, S, E, F.wave, lane_id());
    } SEAM(9); STAMP(10);
    if (IN(10)) { p10_combine(F); }
#undef IN
#undef SEAM
}

extern "C" void kernel_launch(void* const* d_in, const int* in_sizes, int n_in, void* d_out, int out_size, void* d_ws, size_t ws_size, hipStream_t stream) {
    static int grid = 0;
    if (grid == 0) {
        if (n_in != 34 || out_size != MROWS * DM || ws_size < WS_END) { fprintf(stderr, "kernel_launch: unexpected shapes: n_in %d out %d ws %zu (need %zu)\n", n_in, out_size, ws_size, (size_t)WS_END); grid = -1; return; }
        int dev = 0, cus = 0, per_cu = 0;
        if (hipGetDevice(&dev) != hipSuccess || hipDeviceGetAttribute(&cus, hipDeviceAttributeMultiprocessorCount, dev) != hipSuccess) { grid = -1; return; }
        if (hipFuncSetAttribute((const void*)mega, hipFuncAttributeMaxDynamicSharedMemorySize, LDS_BYTES) != hipSuccess) { fprintf(stderr, "kernel_launch: hipFuncSetAttribute failed\n"); grid = -1; return; }
        if (hipOccupancyMaxActiveBlocksPerMultiprocessor(&per_cu, (const void*)mega, NWAVES * 64, LDS_BYTES) != hipSuccess || per_cu < 1) { fprintf(stderr, "kernel_launch: occupancy query says %d\n", per_cu); per_cu = 1; }
        (void)hipGetLastError();
        grid = cus;
    }
    if (grid < 0) return;
    (void)hipMemsetAsync((char*)d_ws + WS_CTL, 0, CTL_ZERO_BYTES, stream);
    Args a{};
    for (int i = 0; i < 34; ++i) a.in[i] = (const float*)d_in[i];
    a.out = (float*)d_out; a.ws = (unsigned char*)d_ws;
    constexpr int LAST = MK_LAST_PHASE + 1;
    if (MK_N_LAUNCHES == 1) { a.ph_lo = 0; a.ph_hi = LAST; hipLaunchKernelGGL(mega, dim3(grid), dim3(NWAVES * 64), LDS_BYTES, stream, a); }
    else for (int p = 0; p < LAST; ++p) { a.ph_lo = p; a.ph_hi = p + 1; hipLaunchKernelGGL(mega, dim3(grid), dim3(NWAVES * 64), LDS_BYTES, stream, a); }
    const hipError_t le = hipPeekAtLastError();
    if (le != hipSuccess) fprintf(stderr, "kernel_launch: launch failed: %s\n", hipGetErrorName(le));
}
```

```cpp
#include <hip/hip_runtime.h>
#include <hip/hip_bf16.h>
#include <cstdio>
#include <cstdint>

#ifndef MK_N_LAUNCHES
#define MK_N_LAUNCHES 1
#endif
#ifndef MK_PROBE_A
#define MK_PROBE_A -2
#endif
#ifndef MK_PA0
#define MK_PA0 0
#define MK_PA1 1
#define MK_PB0 0
#define MK_PB1 1
#define MK_PSA 2e-6f
#define MK_PSB 1e-4f
#endif
#ifndef MK_LAST_PHASE
#define MK_LAST_PHASE 10
#endif

#define GAS __attribute__((address_space(1)))
#define LAS __attribute__((address_space(3)))
typedef unsigned short bf16_t;
typedef short bf16x8 __attribute__((ext_vector_type(8)));
typedef short s16x4 __attribute__((ext_vector_type(4)));
typedef float f32x2 __attribute__((ext_vector_type(2)));
typedef float f32x4 __attribute__((ext_vector_type(4)));
typedef float f32x16 __attribute__((ext_vector_type(16)));
typedef unsigned u32x2 __attribute__((ext_vector_type(2)));
typedef unsigned u32x4 __attribute__((ext_vector_type(4)));
typedef GAS unsigned gu32;

constexpr int NB = 8, SEQ = 4096, DM = 1024, MROWS = NB * SEQ, CTXL = 256, MCTX = NB * CTXL, MTOT = MROWS + MCTX;
constexpr int KVL = CTXL + SEQ;
constexpr int NHEAD = 4, QKW = 512;
constexpr int HYW = 512, HYC = 1536, INC = 3072, QKVC = 1536;
constexpr int NEXP = 32, TOPK = 4, NMOD = 6;
constexpr float EPS = 1e-6f;
constexpr float LAM_INIT = 0.2f;
constexpr float QSCALE = 0.125f * 1.4426950408889634f;

constexpr size_t MiB = 1u << 20;
constexpr size_t WS_CTL = 0, CTL_ZERO_BYTES = 1 * MiB;
constexpr size_t WS_SMALL = 1 * MiB;
constexpr size_t WS_WIN = 2 * MiB;
constexpr size_t WS_WOUT = 8 * MiB;
constexpr size_t WS_W1 = 10 * MiB;
constexpr size_t WS_W2 = 138 * MiB;
constexpr size_t WS_H = 202 * MiB;
constexpr size_t WS_Q = 270 * MiB;
constexpr size_t WS_K = 302 * MiB;
constexpr size_t WS_V = 336 * MiB;
constexpr size_t WS_UT = 370 * MiB;
constexpr size_t WS_FILT = 466 * MiB;
constexpr size_t WS_Z2T = 498 * MiB;
constexpr size_t WS_MIX = 530 * MiB;
constexpr size_t WS_ROUTE = 594 * MiB;
constexpr size_t WS_ACT = 270 * MiB;
constexpr size_t WS_EO = 598 * MiB;
constexpr size_t WS_XN = 870 * MiB;
constexpr size_t WS_END = 998 * MiB;
constexpr size_t SM_MOD = 0;
constexpr size_t SM_SCAL = 256 * 1024;
constexpr size_t SM_ROPE = 260 * 1024;
constexpr int CW_BAR = 4096;

constexpr int RING_BYTES = 131072;
constexpr int LDSCTL_OFF = 151552;
constexpr int LDS_BYTES = 152576;
constexpr int NWAVES = 8;

#define LDS_WAIT() asm volatile("s_waitcnt lgkmcnt(0)" ::: "memory")
#define VM_WAIT() asm volatile("s_waitcnt vmcnt(0)" ::: "memory")
#define RLX_AGENT __ATOMIC_RELAXED, __HIP_MEMORY_SCOPE_AGENT

__device__ __forceinline__ unsigned cvt_pk_bf16(float lo, float hi) { unsigned r; asm volatile("v_cvt_pk_bf16_f32 %0, %1, %2" : "=v"(r) : "v"(lo), "v"(hi)); return r; }
__device__ __forceinline__ float bf2f(bf16_t v) { return __uint_as_float(((unsigned)v) << 16); }
__device__ __forceinline__ float wave_sum(float v) {
#pragma unroll
    for (int o = 1; o < 64; o <<= 1) v += __shfl_xor(v, o);
    return v;
}

#define XB_TMO      128
#define XB_XCNT(j)  (256  + 64 * (j))
#define XB_XSUB(j)  (1280 + 64 * (j))
#define XB_XGEN(j)  (2304 + 64 * (j))
#define XB_TOP      3328
#define XB_TOPGEN   3392
#define XCD_BAR_WORDS 3456
#define XB_SPIN_CAP (1u << 22)
__device__ __forceinline__ unsigned xb_ld(unsigned* p)              { return __hip_atomic_load(p, __ATOMIC_RELAXED, __HIP_MEMORY_SCOPE_AGENT); }
__device__ __forceinline__ unsigned xb_add(unsigned* p, unsigned v) { return __hip_atomic_fetch_add(p, v, __ATOMIC_RELAXED, __HIP_MEMORY_SCOPE_AGENT); }
__device__ __forceinline__ unsigned xb_xcc_id() { return (unsigned)__builtin_amdgcn_s_getreg((3 << 11) | 20) & 0xFu; }
#define XB_SPIN(cond, bar) do { unsigned _sp = 0; while (cond) { __builtin_amdgcn_s_sleep(1); \
    if ((++_sp & 255u) == 0u) { if (xb_ld(&(bar)[XB_TMO])) break; if (_sp > XB_SPIN_CAP) { atomicAdd(&(bar)[XB_TMO], 1u); break; } } } } while (0)
struct XcdBarrier { unsigned* bar; unsigned x; volatile LAS unsigned* st; };
__device__ __forceinline__ XcdBarrier xcd_barrier_post(unsigned* bar, volatile LAS unsigned* st, bool leader) {
    XcdBarrier b; b.bar = bar; b.x = xb_xcc_id(); b.st = st;
    if (leader) (void)xb_add(&bar[XB_XCNT(b.x)], 1u);
    return b;
}
__device__ __forceinline__ void xcd_barrier_complete(unsigned* bar, unsigned x, unsigned& nloc, unsigned& nx) {
    const unsigned G = gridDim.x * gridDim.y * gridDim.z;
    unsigned sum, cnt, mine, sp = 0u;
    for (;;) {
        sum = 0u; cnt = 0u; mine = 0u;
#pragma unroll
        for (unsigned j = 0; j < 16; ++j) { const unsigned c = xb_ld(&bar[XB_XCNT(j)]); sum += c; cnt += (c > 0u) ? 1u : 0u; mine = (j == x) ? c : mine; }
        if (sum == G) break;
        __builtin_amdgcn_s_sleep(1);
        if ((++sp & 255u) == 0u) { if (xb_ld(&bar[XB_TMO])) break; if (sp > XB_SPIN_CAP) { atomicAdd(&bar[XB_TMO], 1u); break; } }
    }
    nloc = mine > 0u ? mine : 1u; nx = cnt > 0u ? cnt : 1u;
}
__device__ __forceinline__ void xcd_barrier(const XcdBarrier& b, bool leader) {
    asm volatile("s_waitcnt vmcnt(0)" ::: "memory");
    __syncthreads();
    if (leader) {
        unsigned* bar = b.bar;
        __builtin_amdgcn_s_waitcnt(0);
        unsigned nloc = b.st[0], nx = b.st[1];
        if (nloc == 0u) { xcd_barrier_complete(bar, b.x, nloc, nx); b.st[0] = nloc; b.st[1] = nx; }
        const unsigned old = xb_add(&bar[XB_XSUB(b.x)], 1u);
        const unsigned gen = old / nloc;
        if (old + 1u == (gen + 1u) * nloc) {
            __builtin_amdgcn_fence(__ATOMIC_RELEASE, "agent");
            asm volatile("s_waitcnt vmcnt(0)" ::: "memory");
            const unsigned og = xb_add(&bar[XB_TOP], 1u);
            const unsigned tg = og / nx;
            if (og + 1u == (tg + 1u) * nx) xb_add(&bar[XB_TOPGEN], 1u);
            else XB_SPIN(xb_ld(&bar[XB_TOPGEN]) == tg, bar);
            __builtin_amdgcn_fence(__ATOMIC_ACQUIRE, "agent");
            xb_add(&bar[XB_XGEN(b.x)], 1u);
            asm volatile("s_waitcnt vmcnt(0)" ::: "memory");
        } else {
            XB_SPIN(xb_ld(&bar[XB_XGEN(b.x)]) == gen, bar);
            __builtin_amdgcn_fence(__ATOMIC_ACQUIRE, "agent");
            asm volatile("s_waitcnt vmcnt(0)" ::: "memory");
        }
    }
    __syncthreads();
}

namespace g8 {
constexpr int BM = 256, BK = 64, HALF = 128, HTB = HALF * BK * 2, STAGE_BYTES = 8 * HTB, NXCD = 8, WGM = 8;
__host__ __device__ __forceinline__ int lds_byte(int r, int c) { const int st = (r >> 4) * 2 + (c >> 5), rr = r & 15, cc = c & 31, ob = rr * 64 + cc * 2; return st * 1024 + (ob ^ (((ob >> 9) & 1) << 5)); }
__host__ __device__ __forceinline__ void stage_rc(int b, int& R, int& C) { const int st = b / 1024, sb = b % 1024, swz = sb ^ (((sb >> 9) & 1) << 5); R = (st >> 1) * 16 + swz / 64; C = (st & 1) * 32 + (swz % 64) / 2; }
__host__ __device__ __forceinline__ int perm32(int rho) { const int n = rho >> 4, i = rho & 15; return 8 * (i >> 2) + 4 * n + (i & 3); }

struct Unit { const char* a; const char* b; int pm, pn, kind, ex; };

__device__ __forceinline__ void tile_of(int L, int nM, int nN, int& pm, int& pn) {
    const int nwg = nM * nN; int wgid = L;
    { const int q = nwg / NXCD, r = nwg % NXCD, xcd = wgid % NXCD, off = wgid / NXCD; wgid = (xcd < r ? xcd * (q + 1) : r * (q + 1) + (xcd - r) * q) + off; }
    const int nig = WGM * nN, gid = wgid / nig, fm = gid * WGM, gsz = (nM - fm) < WGM ? (nM - fm) : WGM;
    pm = fm + ((wgid % nig) % gsz); pn = (wgid % nig) / gsz;
}

typedef int i32x8 __attribute__((ext_vector_type(8)));
template <bool FP8, class Epi, class Sched>
__device__ __forceinline__ void gemm_phase(LAS unsigned char* lds, const int K, const Sched& S, const Epi& E, const int wid, const int lane) {
    const int tid = wid * 64 + lane, wr = wid >> 2, wc = wid & 3, fr = lane & 15, fq = lane >> 4;
    const int nt = FP8 ? K / 128 : K / BK;
    const int RP = FP8 ? K : 2 * K;
    unsigned voffA[2], voffB[2];
#pragma unroll
    for (int i = 0; i < 2; ++i) { int R, C; stage_rc(tid * 16 + i * 8192, R, C); const int Rb = (R & ~31) + perm32(R & 31);
        voffA[i] = (unsigned)(R * RP + C * 2); voffB[i] = (unsigned)(Rb * RP + C * 2); }
    const size_t kstep = (size_t)(BK * 2);
    const size_t hstep = (size_t)HALF * RP;
    const unsigned ldsw = (unsigned)wid * 1024u;
    const int aoff = lds_byte(wr * 64 + fr, FP8 ? fq * 16 : fq * 8), boff = lds_byte(wc * 32 + fr, FP8 ? fq * 16 : fq * 8);
    constexpr int KOFF = FP8 ? 16 : 1024;
#define PG8_SA(b, h) (((b) * 2 + (h)) * HTB)
#define PG8_SB(b, h) ((4 + (b) * 2 + (h)) * HTB)
#define PG8_STAGE(bufoff, gbase, voff) do { _Pragma("unroll") for (int _i = 0; _i < 2; ++_i) \
        __builtin_amdgcn_global_load_lds((const unsigned*)((const char*)(gbase) + (voff)[_i]), (LAS unsigned*)(lds + (bufoff) + ldsw + _i * 8192), 16, 0, 0); } while (0)
#define PG8_LD32(p) __builtin_bit_cast(i32x8, __builtin_shufflevector(*(const LAS u32x4*)(p), *(const LAS u32x4*)((p) + 16), 0, 1, 2, 3, 4, 5, 6, 7))
#define PG8_LDA8(dst, b, h) do { _Pragma("unroll") for (int m = 0; m < 4; ++m) dst[m] = PG8_LD32(lds + PG8_SA(b, h) + aoff + m * 2048); } while (0)
#define PG8_LDB8(dst, b, h) do { _Pragma("unroll") for (int n = 0; n < 2; ++n) dst[n] = PG8_LD32(lds + PG8_SB(b, h) + boff + n * 2048); } while (0)
#define PG8_LDA(dst, b, h) do { _Pragma("unroll") for (int m = 0; m < 4; ++m) _Pragma("unroll") for (int k = 0; k < 2; ++k) dst[m][k] = *(const LAS bf16x8*)(lds + PG8_SA(b, h) + aoff + m * 2048 + k * KOFF); } while (0)
#define PG8_LDB(dst, b, h) do { _Pragma("unroll") for (int n = 0; n < 2; ++n) _Pragma("unroll") for (int k = 0; k < 2; ++k) dst[n][k] = *(const LAS bf16x8*)(lds + PG8_SB(b, h) + boff + n * 2048 + k * KOFF); } while (0)
#define PG8_MMA(ai, bj, At, Bt) do { __builtin_amdgcn_s_setprio(1); _Pragma("unroll") for (int m = 0; m < 4; ++m) _Pragma("unroll") for (int n = 0; n < 2; ++n) _Pragma("unroll") for (int k = 0; k < 2; ++k) \
        acc[ai][bj][m][n] = __builtin_amdgcn_mfma_f32_16x16x32_bf16(Bt[n][k], At[m][k], acc[ai][bj][m][n], 0, 0, 0); __builtin_amdgcn_s_setprio(0); } while (0)
#define PG8_MMA8(ai, bj, At, Bt) do { __builtin_amdgcn_s_setprio(1); _Pragma("unroll") for (int m = 0; m < 4; ++m) _Pragma("unroll") for (int n = 0; n < 2; ++n) \
        asm volatile("v_mfma_scale_f32_16x16x128_f8f6f4 %0, %1, %2, %0, %3, %3 op_sel_hi:[0,0,0]" : "+v"(acc[ai][bj][m][n]) : "v"(Bt[n]), "v"(At[m]), "v"(one_scale)); __builtin_amdgcn_s_setprio(0); } while (0)
#define PG8_WAIT_V(n) asm volatile("s_waitcnt vmcnt(" #n ")" ::: "memory")
#define PG8_WAIT_L(n) asm volatile("s_waitcnt lgkmcnt(" #n ")" ::: "memory")
#define PG8_BAR __builtin_amdgcn_s_barrier()
#define PG8_SCHED __builtin_amdgcn_sched_barrier(0)
    Unit cur, nxt; int ui = 0;
    if (!S.next(0, cur)) return;
    f32x4 acc[2][2][4][2];
#pragma unroll
    for (int a = 0; a < 2; ++a)
#pragma unroll
        for (int b = 0; b < 2; ++b)
#pragma unroll
            for (int m = 0; m < 4; ++m)
#pragma unroll
                for (int n = 0; n < 2; ++n) acc[a][b][m][n] = (f32x4){0.f, 0.f, 0.f, 0.f};
    bf16x8 At[4][2], B0[2][2], B1[2][2];
    i32x8 At8[4], B08[2], B18[2];
    const unsigned one_scale = 0x7f7f7f7fu;
    const char* cA = cur.a; const char* cB = cur.b;
    PG8_STAGE(PG8_SB(0, 0), cB, voffB); PG8_STAGE(PG8_SB(0, 1), cB + hstep, voffB); PG8_STAGE(PG8_SA(0, 0), cA, voffA); PG8_STAGE(PG8_SA(0, 1), cA + hstep, voffA);
    if (wr == 1) PG8_BAR;
    PG8_WAIT_V(2); PG8_BAR;
    PG8_STAGE(PG8_SB(1, 0), cB + kstep, voffB); PG8_STAGE(PG8_SA(1, 0), cA + kstep, voffA); PG8_STAGE(PG8_SB(1, 1), cB + hstep + kstep, voffB);
    PG8_WAIT_V(6); PG8_BAR;
    for (;;) {
        const bool has_next = S.next(ui + 1, nxt);
        const char* nA = has_next ? nxt.a : cA; const char* nB = has_next ? nxt.b : cB;
#pragma unroll 1
        for (int t = 0; t < nt; t += 2) {
            const bool last = (t == nt - 2);
            const char* a1 = cA + (size_t)(t + 1) * kstep;
            const char* a2 = last ? nA : cA + (size_t)(t + 2) * kstep; const char* b2 = last ? nB : cB + (size_t)(t + 2) * kstep;
            const char* a3 = a2 + kstep; const char* b3 = b2 + kstep;
            if constexpr (FP8) {
            PG8_LDB8(B08, 0, 0); PG8_LDB8(B18, 0, 1); PG8_SCHED; PG8_LDA8(At8, 0, 0); PG8_STAGE(PG8_SA(1, 1), a1 + hstep, voffA);
            PG8_WAIT_V(8); PG8_WAIT_L(0); PG8_BAR; PG8_MMA8(0, 0, At8, B08); PG8_MMA8(0, 1, At8, B18); PG8_BAR; PG8_SCHED;
            PG8_LDA8(At8, 0, 1); PG8_STAGE(PG8_SB(0, 0), b2, voffB); PG8_STAGE(PG8_SB(0, 1), b2 + hstep, voffB); PG8_STAGE(PG8_SA(0, 0), a2, voffA);
            PG8_WAIT_V(8); PG8_WAIT_L(0); PG8_BAR; PG8_MMA8(1, 0, At8, B08); PG8_MMA8(1, 1, At8, B18); PG8_BAR; PG8_SCHED;
            PG8_LDB8(B08, 1, 0); PG8_LDB8(B18, 1, 1); PG8_SCHED; PG8_LDA8(At8, 1, 0); PG8_STAGE(PG8_SA(0, 1), a2 + hstep, voffA);
            PG8_WAIT_V(8); PG8_WAIT_L(0); PG8_BAR; PG8_MMA8(0, 0, At8, B08); PG8_MMA8(0, 1, At8, B18); PG8_BAR; PG8_SCHED;
            PG8_LDA8(At8, 1, 1); PG8_STAGE(PG8_SB(1, 0), b3, voffB); PG8_STAGE(PG8_SB(1, 1), b3 + hstep, voffB); PG8_STAGE(PG8_SA(1, 0), a3, voffA);
            PG8_WAIT_V(8); PG8_WAIT_L(0); PG8_BAR; PG8_MMA8(1, 0, At8, B08); PG8_MMA8(1, 1, At8, B18); PG8_BAR; PG8_SCHED;
            } else {
            PG8_LDB(B0, 0, 0); PG8_LDB(B1, 0, 1); PG8_SCHED; PG8_LDA(At, 0, 0); PG8_STAGE(PG8_SA(1, 1), a1 + hstep, voffA);
            PG8_WAIT_V(8); PG8_WAIT_L(0); PG8_BAR; PG8_MMA(0, 0, At, B0); PG8_MMA(0, 1, At, B1); PG8_BAR; PG8_SCHED;
            PG8_LDA(At, 0, 1); PG8_STAGE(PG8_SB(0, 0), b2, voffB); PG8_STAGE(PG8_SB(0, 1), b2 + hstep, voffB); PG8_STAGE(PG8_SA(0, 0), a2, voffA);
            PG8_WAIT_V(8); PG8_WAIT_L(0); PG8_BAR; PG8_MMA(1, 0, At, B0); PG8_MMA(1, 1, At, B1); PG8_BAR; PG8_SCHED;
            PG8_LDB(B0, 1, 0); PG8_LDB(B1, 1, 1); PG8_SCHED; PG8_LDA(At, 1, 0); PG8_STAGE(PG8_SA(0, 1), a2 + hstep, voffA);
            PG8_WAIT_V(8); PG8_WAIT_L(0); PG8_BAR; PG8_MMA(0, 0, At, B0); PG8_MMA(0, 1, At, B1); PG8_BAR; PG8_SCHED;
            PG8_LDA(At, 1, 1); PG8_STAGE(PG8_SB(1, 0), b3, voffB); PG8_STAGE(PG8_SB(1, 1), b3 + hstep, voffB); PG8_STAGE(PG8_SA(1, 0), a3, voffA);
            PG8_WAIT_V(8); PG8_WAIT_L(0); PG8_BAR; PG8_MMA(1, 0, At, B0); PG8_MMA(1, 1, At, B1); PG8_BAR; PG8_SCHED;
            }
        }
        if (wr == 0) PG8_BAR;
        if constexpr (FP8) asm volatile("s_nop 15\n\ts_nop 15" ::: "memory");
        E(acc, cur, wr, wc, fr, fq);
        if (!has_next) break;
#pragma unroll
        for (int a = 0; a < 2; ++a)
#pragma unroll
            for (int b = 0; b < 2; ++b)
#pragma unroll
                for (int m = 0; m < 4; ++m)
#pragma unroll
                    for (int n = 0; n < 2; ++n) acc[a][b][m][n] = (f32x4){0.f, 0.f, 0.f, 0.f};
        cur = nxt; cA = nA; cB = nB; ++ui;
        if (wr == 1) PG8_BAR;
    }
    PG8_WAIT_V(0);
    PG8_BAR;
#undef PG8_SA
#undef PG8_SB
#undef PG8_STAGE
#undef PG8_LDA
#undef PG8_LDB
#undef PG8_MMA
#undef PG8_MMA8
#undef PG8_LDA8
#undef PG8_LDB8
#undef PG8_LD32
#undef PG8_WAIT_V
#undef PG8_WAIT_L
#undef PG8_BAR
#undef PG8_SCHED
}
}

__device__ __forceinline__ int lane_id() { int l; asm volatile("v_mbcnt_lo_u32_b32 %0, -1, 0\n\tv_mbcnt_hi_u32_b32 %0, -1, %0" : "=v"(l)); return l; }
#define FT_DECL const int f_lane = lane_id(), f_tid = F.wave * 64 + f_lane; (void)f_tid; (void)f_lane
typedef const float* cfp_t;
typedef __attribute__((address_space(4))) cfp_t* kin_t;
struct Frame {
    LAS unsigned char* lds;
    volatile LAS unsigned* MISC;
    gu32* ctl;
    int wave, vcu, G;
    kin_t in;
    float* out;
    unsigned char* ws;
};
#define WSP(T, off) ((T*)(F.ws + (off)))

template <class RowMap>
__device__ __forceinline__ void p0_transpose_item(const float* W, int K, int N, bf16_t* WT, const RowMap& rowmap, const float* kscale, LAS float* scr, int item, int lane) {
    const int nblk = N / 32, kb = item / nblk, nb = item % nblk, k0 = 64 * kb, n0 = 32 * nb;
#pragma unroll 8
    for (int i = 0; i < 32; ++i) { const int kk = 2 * i + (lane >> 5); float v = W[(size_t)(k0 + kk) * N + n0 + (lane & 31)]; if (kscale) v *= kscale[k0 + kk]; scr[kk * 33 + (lane & 31)] = v; }
    LDS_WAIT(); asm volatile("" ::: "memory");
    const int c = lane & 7;
#pragma unroll
    for (int j = 0; j < 4; ++j) { const int n = (lane >> 3) + 8 * j; const LAS float* s = scr + (8 * c) * 33 + n;
        u32x4 o; o.x = cvt_pk_bf16(s[0 * 33], s[1 * 33]); o.y = cvt_pk_bf16(s[2 * 33], s[3 * 33]); o.z = cvt_pk_bf16(s[4 * 33], s[5 * 33]); o.w = cvt_pk_bf16(s[6 * 33], s[7 * 33]);
        *(GAS u32x4*)(WT + (size_t)rowmap(n0 + n) * K + k0 + 8 * c) = o; }
    LDS_WAIT(); asm volatile("" ::: "memory");
}

__device__ __forceinline__ unsigned pk4_fp8(float a, float b, float c, float d) { int r = __builtin_amdgcn_cvt_pk_fp8_f32(a, b, 0, false); r = __builtin_amdgcn_cvt_pk_fp8_f32(c, d, r, true); return (unsigned)r; }
constexpr float EOSCALE = 16.f;
constexpr float WSCALE = 32.f;
template <class RowMap>
__device__ __forceinline__ void p0_transpose_item_f8(const float* W, int K, int N, unsigned char* WT, const RowMap& rowmap, LAS float* scr, int item, int lane) {
    const int nblk = N / 32, kb = item / nblk, nb = item % nblk, k0 = 128 * kb, n0 = 32 * nb;
#pragma unroll
    for (int hh = 0; hh < 2; ++hh) { float v[32];
#pragma unroll
        for (int i = 0; i < 32; ++i) { const int kk = 2 * (32 * hh + i) + (lane >> 5); v[i] = __builtin_nontemporal_load(W + (size_t)(k0 + kk) * N + n0 + (lane & 31)); }
#pragma unroll
        for (int i = 0; i < 32; ++i) { const int kk = 2 * (32 * hh + i) + (lane >> 5); scr[kk * 33 + (lane & 31)] = v[i] * WSCALE; } }
    LDS_WAIT(); asm volatile("" ::: "memory");
    const int c = lane & 7;
#pragma unroll
    for (int j = 0; j < 4; ++j) { const int n = (lane >> 3) + 8 * j; const LAS float* sp = scr + (16 * c) * 33 + n;
        u32x4 o; o.x = pk4_fp8(sp[0 * 33], sp[1 * 33], sp[2 * 33], sp[3 * 33]); o.y = pk4_fp8(sp[4 * 33], sp[5 * 33], sp[6 * 33], sp[7 * 33]);
        o.z = pk4_fp8(sp[8 * 33], sp[9 * 33], sp[10 * 33], sp[11 * 33]); o.w = pk4_fp8(sp[12 * 33], sp[13 * 33], sp[14 * 33], sp[15 * 33]);
        *(GAS u32x4*)(WT + (size_t)rowmap(n0 + n) * K + k0 + 16 * c) = o; }
    LDS_WAIT(); asm volatile("" ::: "memory");
}
struct MapW2 { __device__ __forceinline__ int operator()(int l) const { const int t = l & ~255, r = l & 255, wc = r >> 6, fq = (r >> 4) & 3, bj = (r >> 3) & 1, low = r & 7; return t + 128 * bj + 32 * wc + 8 * fq + low; } };
struct MapIdent { int off; __device__ __forceinline__ int operator()(int n) const { return off + n; } };
struct MapWin { __device__ __forceinline__ int operator()(int l) const {
    if (l >= 1024) return l;
    const int t = l & ~255, r = l & 255, wc = r >> 6, blk = (r >> 5) & 1, bj = (r >> 4) & 1, low = r & 15;
    return t + 128 * bj + 32 * wc + 16 * blk + low; } };
struct MapW1 { int off; __device__ __forceinline__ int operator()(int jp) const { const int bj = jp >> 10, j = jp & 1023; return off + 256 * (j >> 7) + 128 * bj + (j & 127); } };


__device__ __forceinline__ void p0_filter_item(Frame& F, int item) {
    FT_DECL;
#define in F.in
    LAS float* h1s = (LAS float*)(F.lds);
    LAS float* h2s = (LAS float*)(F.lds + 4096);
    const int t0 = item * 16;
    {
        const int tt = f_tid >> 5, hh = (f_tid & 31) * 2; const float pos = (float)(t0 + tt);
        float feats[17]; feats[0] = pos * (1.f / SEQ);
#pragma unroll
        for (int i = 0; i < 8; ++i) { const float band = 1e-4f + (float)i * ((7.f - 1e-4f) / 7.f); const float ang = (6.283185307179586f / SEQ) * pos * band; feats[1 + i] = sinf(ang); feats[9 + i] = cosf(ang); }
#pragma unroll
        for (int u = 0; u < 2; ++u) { const int h = hh + u; float a = in[19][h];
#pragma unroll
            for (int k = 0; k < 17; ++k) a += feats[k] * in[18][k * 64 + h];
            h1s[tt * 64 + h] = sinf(in[20][h] * a); }
        __syncthreads();
#pragma unroll
        for (int u = 0; u < 2; ++u) { const int h = hh + u; float a = in[22][h];
#pragma unroll 8
            for (int k = 0; k < 64; ++k) a += h1s[tt * 64 + k] * in[21][k * 64 + h];
            h2s[tt * 64 + h] = sinf(in[23][h] * a); }
        __syncthreads();
    }
    f32x4 acc[16];
#pragma unroll
    for (int t = 0; t < 16; ++t) acc[t] = (f32x4){0.f, 0.f, 0.f, 0.f};
    const int o = 4 * f_tid;
    for (int k = 0; k < 64; ++k) { const f32x4 w = *(const f32x4*)(in[24] + (size_t)k * 2048 + o);
#pragma unroll
        for (int t = 0; t < 16; ++t) acc[t] += w * h2s[t * 64 + k]; }
    const int c0 = o & 511, od = o >> 9;
    float* dst = WSP(float, WS_FILT) + ((size_t)od * 512 + c0) * SEQ + t0;
#pragma unroll
    for (int e = 0; e < 4; ++e) { const float la = -3.0701134573253944f, lb = -15.350567286626972f; const float delta = fabsf(la + (float)(c0 + e) * ((lb - la) / 511.f));
#pragma unroll
        for (int q = 0; q < 4; ++q) { f32x4 v;
#pragma unroll
            for (int i = 0; i < 4; ++i) { const int t = 4 * q + i; const float tn = (float)(t0 + t) * (1.f / SEQ); v[i] = acc[t][e] * expf(-tn * delta); }
            *(f32x4*)(dst + (size_t)e * SEQ + 4 * q) = v; } }
    __syncthreads();
#undef in
}

__device__ __forceinline__ float silu_f(float v) { return v / (1.f + __expf(-v)); }

__device__ __forceinline__ void p0_prologue(Frame& F) {
    FT_DECL;
#define in F.in
    const int wg = blockIdx.x;
    if (wg < 96) {
        LAS float* sv = (LAS float*)F.lds;
        for (int i = f_tid; i < 9 * 1024; i += 512) { const int r = i >> 10, k = i & 1023; const float c = (r < 8) ? in[1][r * 1024 + k] : in[3][k]; sv[i] = silu_f(c); }
        __syncthreads();
        const int j = wg * 64 + f_lane; const float* wm = in[4];
        float acc[9];
#pragma unroll
        for (int r = 0; r < 9; ++r) acc[r] = 0.f;
        const int kbeg = F.wave * 128;
#pragma unroll 4
        for (int k = kbeg; k < kbeg + 128; ++k) { const float w = wm[(size_t)k * (NMOD * DM) + j];
#pragma unroll
            for (int r = 0; r < 9; ++r) acc[r] += sv[r * 1024 + k] * w; }
        LAS float* red = (LAS float*)(F.lds + 40960);
#pragma unroll
        for (int r = 0; r < 9; ++r) red[(F.wave * 9 + r) * 64 + f_lane] = acc[r];
        __syncthreads();
        for (int i = f_tid; i < 9 * 64; i += 512) { const int r = i >> 6, l = i & 63; float s = in[5][wg * 64 + l];
#pragma unroll
            for (int w = 0; w < 8; ++w) s += red[(w * 9 + r) * 64 + l];
            WSP(float, WS_SMALL + SM_MOD)[r * (NMOD * DM) + wg * 64 + l] = s; }
        __syncthreads();
    } else if (wg == 96) {
        if (F.wave == 0) {
            const float a = wave_sum(in[11][f_lane] * in[12][f_lane]), b = wave_sum(in[13][f_lane] * in[14][f_lane]);
            float gq = fabsf(in[9][f_lane]), gk = fabsf(in[10][f_lane]);
#pragma unroll
            for (int o = 1; o < 64; o <<= 1) { gq = fmaxf(gq, __shfl_xor(gq, o)); gk = fmaxf(gk, __shfl_xor(gk, o)); }
            if (f_lane == 0) { float* sc = WSP(float, WS_SMALL + SM_SCAL); sc[0] = expf(a) - expf(b) + LAM_INIT;
                sc[1] = (8.f * gq * gk * 1.02f + 0.05f) * 1.4426950408889634f; }
        }
        for (int i = f_tid; i < 64 * 16; i += 512) { const int pos = i >> 4, f = i & 15;
            const float inv = powf(10000.f, -(float)f / 16.f); const float ang = (float)pos * inv;
            float* rt = WSP(float, WS_SMALL + SM_ROPE); rt[2 * i] = cosf(ang); rt[2 * i + 1] = sinf(ang); }
    }
    __syncthreads();
    for (int it = wg; it < SEQ / 16; it += F.G) p0_filter_item(F, it);
    __syncthreads();
    {
        LAS float* scr = (LAS float*)(F.lds + F.wave * 16896);
        const int gw = F.vcu * NWAVES + F.wave, NGW = F.G * NWAVES;
        constexpr int I_IN = (DM / 64) * (INC / 32), I_OUT = (DM / 64) * (DM / 32), I_1 = (DM / 128) * (2 * DM / 32), I_2 = (DM / 128) * (DM / 32);
        constexpr int NITEMS = I_IN + I_OUT + NEXP * (I_1 + I_2);
        for (int it = gw; it < NITEMS; it += NGW) {
            int r = it;
            if (r < I_IN) { p0_transpose_item(in[8], DM, INC, WSP(bf16_t, WS_WIN), MapWin{}, nullptr, scr, r, f_lane); continue; } r -= I_IN;
            if (r < I_OUT) { p0_transpose_item(in[27], DM, DM, WSP(bf16_t, WS_WOUT), MapIdent{0}, nullptr, scr, r, f_lane); continue; } r -= I_OUT;
            const int e = r / (I_1 + I_2); r -= e * (I_1 + I_2);
            if (r < I_1) p0_transpose_item_f8(in[30] + (size_t)e * DM * 2 * DM, DM, 2 * DM, WSP(unsigned char, WS_W1) + (size_t)e * 2 * DM * DM, MapW1{0}, scr, r, f_lane);
            else p0_transpose_item_f8(in[32] + (size_t)e * DM * DM, DM, DM, WSP(unsigned char, WS_W2) + (size_t)e * DM * DM, MapW2{}, scr, r - I_1, f_lane);
        }
    }
}
#undef in

__device__ __forceinline__ void p1_norm1(Frame& F) {
    FT_DECL;
    const int gw = F.vcu * NWAVES + F.wave, NGW = F.G * NWAVES;
    const float* mod = WSP(float, WS_SMALL + SM_MOD); const float* g1 = F.in[6];
    bf16_t* H = WSP(bf16_t, WS_H);
    constexpr int RU = 4;
    for (int m0 = gw; m0 < MTOT; m0 += NGW * RU) {
        f32x4 v[RU][4];
#pragma unroll
        for (int u = 0; u < RU; ++u) { const int m = m0 + u * NGW; if (m < MTOT) {
            const float* xrow = (m < MROWS) ? F.in[0] + (size_t)m * DM : F.in[2] + (size_t)(m - MROWS) * DM; const GAS f32x4* xr = (const GAS f32x4*)xrow + f_lane;
#pragma unroll
            for (int j = 0; j < 4; ++j) v[u][j] = __builtin_nontemporal_load(xr + 64 * j); } }
#pragma unroll
        for (int u = 0; u < RU; ++u) { const int m = m0 + u * NGW; if (m < MTOT) {
            const int mb = (m < MROWS) ? (m >> 12) : 8;
            const float* sh = mod + (size_t)mb * (NMOD * DM); const float* sc = sh + DM;
            float s = 0.f;
#pragma unroll
            for (int j = 0; j < 4; ++j) s += (v[u][j].x * v[u][j].x + v[u][j].y * v[u][j].y) + (v[u][j].z * v[u][j].z + v[u][j].w * v[u][j].w);
            const float rstd = rsqrtf(wave_sum(s) * (1.f / DM) + EPS);
            GAS u32x2* o8 = (GAS u32x2*)(H + (size_t)m * DM) + f_lane;
#pragma unroll
            for (int j = 0; j < 4; ++j) { const int c = 4 * f_lane + 256 * j;
                const f32x4 g = *(const f32x4*)(g1 + c), a = *(const f32x4*)(sc + c), b = *(const f32x4*)(sh + c);
                const f32x4 y = v[u][j] * rstd * g * (a + 1.f) + b;
                u32x2 w; w.x = cvt_pk_bf16(y.x, y.y); w.y = cvt_pk_bf16(y.z, y.w); o8[64 * j] = w; } } }
    }
}

struct SchedInProj {
    int G, c; const char* H; const char* W;
    static constexpr int NA = 136 * 4, NV = 2 * 136, NBU = 6 * 128;
    __device__ __forceinline__ bool next(int i, g8::Unit& u) const {
        const long L = (long)i * G + c;
        if (L < NA) { g8::tile_of((int)L, 136, 4, u.pm, u.pn); u.a = H + (size_t)u.pm * 256 * DM * 2; u.b = W + (size_t)u.pn * 256 * DM * 2; u.kind = 0; u.ex = 0; return true; }
        if (L < NA + NV) { g8::tile_of((int)L - NA, 2, 136, u.pm, u.pn); u.a = W + (size_t)(1024 + u.pm * 256) * DM * 2; u.b = H + (size_t)u.pn * 256 * DM * 2; u.kind = 2; u.ex = 0; return true; }
        if (L < NA + NV + NBU) { g8::tile_of((int)L - NA - NV, 6, 128, u.pm, u.pn); u.a = W + (size_t)(QKVC + u.pm * 256) * DM * 2; u.b = H + (size_t)u.pn * 256 * DM * 2; u.kind = 1; u.ex = 0; return true; }
        return false;
    }
};
constexpr float Q8SCALE = 16.f;
struct EpiInProj {
    unsigned char *Q8, *K8, *VT8; bf16_t* UT; const float *gq, *gk, *rope;
    __device__ __forceinline__ void operator()(f32x4 (&acc)[2][2][4][2], const g8::Unit& u, int wr, int wc, int fr, int fq) const {
        asm volatile("" : "+v"(fr), "+v"(fq));
        if (u.kind == 1) {
            const int row0 = u.pm * 256 + wr * 64 + fr, col0 = u.pn * 256 + wc * 32 + 8 * fq;
#pragma unroll
            for (int ai = 0; ai < 2; ++ai)
#pragma unroll
                for (int m = 0; m < 4; ++m) { bf16_t* rowp = UT + (size_t)(row0 + ai * 128 + m * 16) * MROWS + col0;
#pragma unroll
                    for (int bj = 0; bj < 2; ++bj) { const f32x4 v0 = acc[ai][bj][m][0], v1 = acc[ai][bj][m][1];
                        u32x4 w; w.x = cvt_pk_bf16(v0[0], v0[1]); w.y = cvt_pk_bf16(v0[2], v0[3]); w.z = cvt_pk_bf16(v1[0], v1[1]); w.w = cvt_pk_bf16(v1[2], v1[3]);
                        *(u32x4*)(rowp + bj * 128) = w; } }
            return;
        }
        if (u.kind == 2) {
#pragma unroll
            for (int bj = 0; bj < 2; ++bj) { const int t8 = u.pn * 256 + bj * 128 + wc * 32 + 8 * fq;
                int b, key; if (t8 < MROWS) { b = t8 >> 12; key = CTXL + (t8 & 4095); } else { const int j = t8 - MROWS; b = j >> 8; key = j & 255; }
                const int tile = key >> 6, k = key & 63, ipos = (k < 32) ? 4 * (k >> 3) : 16 + 4 * ((k - 32) >> 3);
#pragma unroll
                for (int ai = 0; ai < 2; ++ai)
#pragma unroll
                    for (int m = 0; m < 4; ++m) { const int ch = u.pm * 256 + ai * 128 + wr * 64 + m * 16 + fr;
                        unsigned char* dst = VT8 + ((((size_t)(b * NHEAD + (ch >> 7)) * 68 + tile) * 128 + (ch & 127)) * 64) + ipos;
                        const f32x4 v0 = acc[ai][bj][m][0], v1 = acc[ai][bj][m][1];
                        *(unsigned*)dst = pk4_fp8(v0[0], v0[1], v0[2], v0[3]); *(unsigned*)(dst + 32) = pk4_fp8(v1[0], v1[1], v1[2], v1[3]); } }
            return;
        }
        const int blk = fq >> 1, f = fq & 1;
        const int sec = u.pn >> 1;
        const bool ctx = (u.pm >= 128);
        if (sec == 0 && ctx) return;
        const int colbase = (u.pn & 1) * 256 + wc * 64 + 32 * blk + 8 * f;
        float gg[2][2][4];
        { const float* gp = (sec == 0 ? gq : gk) + 32 * blk + 8 * f;
#pragma unroll
            for (int bj = 0; bj < 2; ++bj)
#pragma unroll
                for (int n = 0; n < 2; ++n) { const f32x4 t = *(const f32x4*)(gp + 16 * bj + 4 * n); gg[bj][n][0] = t[0]; gg[bj][n][1] = t[1]; gg[bj][n][2] = t[2]; gg[bj][n][3] = t[3]; } }
#pragma unroll
        for (int ai = 0; ai < 2; ++ai)
#pragma unroll
            for (int m = 0; m < 4; ++m) {
                const int rloc = ai * 128 + wr * 64 + m * 16 + fr; const int r = u.pm * 256 + rloc;
                f32x4 v[2][2];
#pragma unroll
                for (int bj = 0; bj < 2; ++bj)
#pragma unroll
                    for (int n = 0; n < 2; ++n) v[bj][n] = acc[ai][bj][m][n];
                size_t orow;
                if (sec == 0) orow = (size_t)r;
                else if (!ctx) orow = (size_t)(r >> 12) * KVL + CTXL + (r & 4095);
                else { const int j = r - MROWS; orow = (size_t)(j >> 8) * KVL + (j & 255); }
                float ss = 0.f;
#pragma unroll
                for (int bj = 0; bj < 2; ++bj)
#pragma unroll
                    for (int n = 0; n < 2; ++n) ss += (v[bj][n][0] * v[bj][n][0] + v[bj][n][1] * v[bj][n][1]) + (v[bj][n][2] * v[bj][n][2] + v[bj][n][3] * v[bj][n][3]);
                ss += __shfl_xor(ss, 16); ss += __shfl_xor(ss, 32);
                const float rstd = rsqrtf(ss * (1.f / 64.f) + EPS) * (sec == 0 ? QSCALE * Q8SCALE : 1.f);
#pragma unroll
                for (int bj = 0; bj < 2; ++bj)
#pragma unroll
                    for (int n = 0; n < 2; ++n)
#pragma unroll
                        for (int e = 0; e < 4; ++e) v[bj][n][e] *= rstd * gg[bj][n][e];
                if (!ctx) {
                    const int t = r & 4095; const int pos = blk ? (t & 63) : (t >> 6);
                    const float* rp = rope + (size_t)(pos * 16 + 8 * f) * 2;
#pragma unroll
                    for (int n = 0; n < 2; ++n) { const f32x4 c0 = *(const f32x4*)(rp + 8 * n), c1 = *(const f32x4*)(rp + 8 * n + 4);
                        const float cs[4] = {c0[0], c0[2], c1[0], c1[2]}, sn[4] = {c0[1], c0[3], c1[1], c1[3]};
#pragma unroll
                        for (int e = 0; e < 4; ++e) { const float x1 = v[0][n][e], x2 = v[1][n][e]; v[0][n][e] = x1 * cs[e] - x2 * sn[e]; v[1][n][e] = x2 * cs[e] + x1 * sn[e]; } }
                }
                unsigned char* dst = (sec == 0 ? Q8 : K8) + orow * QKW + colbase;
#pragma unroll
                for (int bj = 0; bj < 2; ++bj) { u32x2 w; w.x = pk4_fp8(v[bj][0][0], v[bj][0][1], v[bj][0][2], v[bj][0][3]); w.y = pk4_fp8(v[bj][1][0], v[bj][1][1], v[bj][1][2], v[bj][1][3]);
                    *(u32x2*)(dst + 16 * bj) = w; }
            }
    }
};

struct SchedStatic {
    int G, c, nM, nN; const char* A; const char* B;
    __device__ __forceinline__ bool next(int i, g8::Unit& u) const {
        const long L = (long)i * G + c; if (L >= (long)nM * nN) return false;
        g8::tile_of((int)L, nM, nN, u.pm, u.pn); u.a = A + (size_t)u.pm * 256 * DM * 2; u.b = B + (size_t)u.pn * 256 * DM * 2; u.kind = 0; u.ex = 0; return true;
    }
};
struct EpiOutProj {
    const float* x; bf16_t* out; const float* mod;
    __device__ __forceinline__ void operator()(f32x4 (&acc)[2][2][4][2], const g8::Unit& u, int wr, int wc, int fr, int fq) const {
        const int col0 = u.pn * 256 + wc * 32 + 8 * fq;
#pragma unroll
        for (int ai = 0; ai < 2; ++ai)
#pragma unroll
            for (int m = 0; m < 4; ++m) { const int r = u.pm * 256 + ai * 128 + wr * 64 + m * 16 + fr; const float* g1 = mod + (size_t)(r >> 12) * (NMOD * DM) + 2 * DM;
                const size_t off = (size_t)r * DM + col0;
#pragma unroll
                for (int bj = 0; bj < 2; ++bj) { f32x4 o[2];
#pragma unroll
                    for (int n = 0; n < 2; ++n) { const int c = bj * 128 + 4 * n; const f32x4 xv = *(const f32x4*)(x + off + c), gv = *(const f32x4*)(g1 + col0 + c); o[n] = xv + gv * acc[ai][bj][m][n]; }
                    u32x4 w; w.x = cvt_pk_bf16(o[0][0], o[0][1]); w.y = cvt_pk_bf16(o[0][2], o[0][3]); w.z = cvt_pk_bf16(o[1][0], o[1][1]); w.w = cvt_pk_bf16(o[1][2], o[1][3]);
                    *(u32x4*)(out + off + bj * 128) = w; } }
    }
};

namespace att {
constexpr int KVBLK = 64, LDK = QKW, NT = KVL / KVBLK;
constexpr int SHM_V = KVBLK * 128 * 2, SHM_K = KVBLK * 128 * 2;
#define KSWZ(row, colB) ((row) * 256 + ((colB) ^ (((row) & 7) << 4)))
#define SBAR() __builtin_amdgcn_sched_barrier(0)
__device__ __forceinline__ int crow(int r, int hi) { return (r & 3) + 8 * (r >> 2) + 4 * hi; }
__device__ __forceinline__ void expA(f32x16& p) {
#pragma unroll
    for (int r = 0; r < 16; ++r) p[r] = __builtin_amdgcn_exp2f(p[r]);
}
__device__ __forceinline__ void finishSM(f32x16& p0, f32x16& p1, float& l_reg, bf16x8& pa0, bf16x8& pa1, bf16x8& pa2, bf16x8& pa3) {
#pragma unroll
    for (int r = 0; r < 16; ++r) p1[r] = __builtin_amdgcn_exp2f(p1[r]);
    float ps = 0;
#pragma unroll
    for (int r = 0; r < 16; ++r) ps += p0[r];
#pragma unroll
    for (int r = 0; r < 16; ++r) ps += p1[r];
    { auto rr = __builtin_amdgcn_permlane32_swap(__float_as_uint(ps), __float_as_uint(ps), false, false); ps = __uint_as_float(rr[0]) + __uint_as_float(rr[1]); }
    l_reg += ps;
#define PK4(P, BASE, OUT) do { unsigned a0 = cvt_pk_bf16(P[BASE + 0], P[BASE + 1]), a1 = cvt_pk_bf16(P[BASE + 2], P[BASE + 3]);   \
    unsigned b0 = cvt_pk_bf16(P[BASE + 4], P[BASE + 5]), b1 = cvt_pk_bf16(P[BASE + 6], P[BASE + 7]);                              \
    auto r0 = __builtin_amdgcn_permlane32_swap(a0, b0, false, false); auto r1 = __builtin_amdgcn_permlane32_swap(a1, b1, false, false); \
    u32x4 w = {r0[0], r1[0], r0[1], r1[1]}; OUT = *reinterpret_cast<bf16x8*>(&w); } while (0)
    PK4(p0, 0, pa0); PK4(p0, 8, pa1); PK4(p1, 0, pa2); PK4(p1, 8, pa3);
#undef PK4
}
__device__ __forceinline__ void qkt(f32x16& p0, f32x16& p1, const char* Ks, const bf16x8* qr, int r32, int hi, int sub, float negm) {
    (void)negm;
    const f32x16 z = {};
#pragma unroll
    for (int d0 = 0; d0 < 4; ++d0) { const int cb = (sub * 64 + d0 * 16 + hi * 8) * 2;
        const bf16x8 b0 = *reinterpret_cast<const bf16x8*>(Ks + KSWZ(r32, cb));
        const bf16x8 b1 = *reinterpret_cast<const bf16x8*>(Ks + KSWZ(32 + r32, cb));
        p0 = __builtin_amdgcn_mfma_f32_32x32x16_bf16(b0, qr[d0], d0 ? p0 : z, 0, 0, 0);
        p1 = __builtin_amdgcn_mfma_f32_32x32x16_bf16(b1, qr[d0], d0 ? p1 : z, 0, 0, 0); }
}
__device__ __forceinline__ int v_st(int k, int c) { const int kk = (k & ~0xC) | ((k & 4) << 1) | ((k & 8) >> 1); return ((kk >> 3) * 4 + (c >> 5)) * 512 + ((kk & 7) * 32 + (c & 31)) * 2; }
__device__ __forceinline__ int v_rd_base(int lane) { return ((lane & 3) << 3) | (((lane >> 2) & 3) << 6) | (((lane >> 4) & 1) << 5) | (((lane >> 5) & 1) << 8); }
constexpr int v_rd_off(int d0, int ks, int half) { return d0 * 512 + ks * 4096 + half * 2048; }
template <int OFF> __device__ __forceinline__ s16x4 tr_read(int vb) {
    s16x4 r; asm volatile("ds_read_b64_tr_b16 %0, %1 offset:%2" : "=&v"(r) : "v"(vb), "i"(OFF) : "memory"); return r;
}
template <int D0> __device__ __forceinline__ void pv_one(f32x16& od, int vb, bf16x8 pa0, bf16x8 pa1, bf16x8 pa2, bf16x8 pa3) {
    const s16x4 l0 = tr_read<v_rd_off(D0, 0, 0)>(vb), h0 = tr_read<v_rd_off(D0, 0, 1)>(vb), l1 = tr_read<v_rd_off(D0, 1, 0)>(vb), h1 = tr_read<v_rd_off(D0, 1, 1)>(vb);
    const s16x4 l2 = tr_read<v_rd_off(D0, 2, 0)>(vb), h2 = tr_read<v_rd_off(D0, 2, 1)>(vb), l3 = tr_read<v_rd_off(D0, 3, 0)>(vb), h3 = tr_read<v_rd_off(D0, 3, 1)>(vb);
    asm volatile("s_waitcnt lgkmcnt(0)" ::: "memory"); SBAR();
#define PK(L, H) (bf16x8){L[0], L[1], L[2], L[3], H[0], H[1], H[2], H[3]}
    od = __builtin_amdgcn_mfma_f32_32x32x16_bf16(pa0, PK(l0, h0), od, 0, 0, 0);
    od = __builtin_amdgcn_mfma_f32_32x32x16_bf16(pa1, PK(l1, h1), od, 0, 0, 0);
    od = __builtin_amdgcn_mfma_f32_32x32x16_bf16(pa2, PK(l2, h2), od, 0, 0, 0);
    od = __builtin_amdgcn_mfma_f32_32x32x16_bf16(pa3, PK(l3, h3), od, 0, 0, 0);
#undef PK
}
__device__ __forceinline__ void pv_d0(f32x16* o, int vb, bf16x8 pa0, bf16x8 pa1, bf16x8 pa2, bf16x8 pa3) {
    pv_one<0>(o[0], vb, pa0, pa1, pa2, pa3); pv_one<1>(o[1], vb, pa0, pa1, pa2, pa3); pv_one<2>(o[2], vb, pa0, pa1, pa2, pa3); pv_one<3>(o[3], vb, pa0, pa1, pa2, pa3);
}

__device__ __forceinline__ void attn_unit(const bf16_t* __restrict__ Qb, const bf16_t* __restrict__ Kh, const bf16_t* __restrict__ Vh, bf16_t* MIXo,
                                          const float lam, const float negm, const float* __restrict__ subg, char* lds, const int wid) {
    const int lane = lane_id(), tid = wid * 64 + lane, r32 = lane & 31, hi = lane >> 5;
    const int sub = wid >> 2, wq = wid & 3;
    char* V_lds = lds; char* K_lds = lds + 3 * SHM_V;
    float* wsf = (float*)(lds + 98304) + wid * 32;
    float l_reg = 0; f32x16 o[4] = {}; bf16x8 qr[4];
    const bf16_t* Qw = Qb + (long)(wq * 32 + r32) * LDK + sub * 64 + hi * 8;
#pragma unroll
    for (int d0 = 0; d0 < 4; ++d0) qr[d0] = *reinterpret_cast<const bf16x8*>(Qw + d0 * 16);
    const int vb0 = (int)(uintptr_t)V_lds + v_rd_base(lane);
    long ksrc[2], vsrc[2];
#pragma unroll
    for (int i = 0; i < 2; ++i) { const int p = 2 * wid + i;
        { const int r = 4 * p + (lane >> 4), c = (lane & 15) ^ (r & 7); ksrc[i] = (long)r * LDK + c * 8; }
        { const int st = 2 * p + (lane >> 5), kk = 8 * (st >> 2) + ((lane & 31) >> 2), k = (kk & ~0xC) | ((kk & 4) << 1) | ((kk & 8) >> 1), c = 32 * (st & 3) + 8 * (lane & 3); vsrc[i] = (long)k * LDK + c; } }
    const unsigned kdst = (unsigned)(uintptr_t)K_lds + (unsigned)wid * 2048u, vdst = (unsigned)(uintptr_t)V_lds + (unsigned)wid * 2048u;
#define DMA_TILE(t, boff) do { _Pragma("unroll") for (int i_ = 0; i_ < 2; ++i_) { \
        __builtin_amdgcn_global_load_lds((const unsigned*)(Kh + (long)(t) * KVBLK * LDK + ksrc[i_]), (LAS unsigned*)(uintptr_t)__builtin_amdgcn_readfirstlane(kdst + (unsigned)(boff) + i_ * 1024u), 16, 0, 0); \
        __builtin_amdgcn_global_load_lds((const unsigned*)(Vh + (long)(t) * KVBLK * LDK + vsrc[i_]), (LAS unsigned*)(uintptr_t)__builtin_amdgcn_readfirstlane(vdst + (unsigned)(boff) + i_ * 1024u), 16, 0, 0); } } while (0)
#define WBAR() do { asm volatile("s_waitcnt vmcnt(0) lgkmcnt(0)" ::: "memory"); __builtin_amdgcn_s_barrier(); asm volatile("" ::: "memory"); } while (0)
#define ROT3(x) ((x) == 2 * SHM_V ? 0 : (x) + SHM_V)
    f32x16 pA0, pA1, pB0, pB1; bf16x8 pa0, pa1, pa2, pa3;
    DMA_TILE(0, 0); WBAR();
    DMA_TILE(1, SHM_V);
    qkt(pA0, pA1, K_lds, qr, r32, hi, sub, negm); expA(pA0);
    WBAR();
    int bprev = 0, bcur = SHM_V, bnext = 2 * SHM_V;
    for (int j = 1; j + 1 < NT; j += 2) {
        DMA_TILE(j + 1, bnext);
        SBAR(); qkt(pB0, pB1, K_lds + bcur, qr, r32, hi, sub, negm);
        finishSM(pA0, pA1, l_reg, pa0, pa1, pa2, pa3); SBAR();
        pv_d0(o, vb0 + bprev, pa0, pa1, pa2, pa3); expA(pB0);
        WBAR();
        bprev = bcur; bcur = bnext; bnext = ROT3(bnext);
        if (j + 2 < NT) DMA_TILE(j + 2, bnext);
        SBAR(); qkt(pA0, pA1, K_lds + bcur, qr, r32, hi, sub, negm);
        finishSM(pB0, pB1, l_reg, pa0, pa1, pa2, pa3); SBAR();
        pv_d0(o, vb0 + bprev, pa0, pa1, pa2, pa3); expA(pA0);
        WBAR();
        bprev = bcur; bcur = bnext; bnext = ROT3(bnext);
    }
    SBAR(); qkt(pB0, pB1, K_lds + bcur, qr, r32, hi, sub, negm);
    finishSM(pA0, pA1, l_reg, pa0, pa1, pa2, pa3); SBAR();
    pv_d0(o, vb0 + bprev, pa0, pa1, pa2, pa3); expA(pB0);
    finishSM(pB0, pB1, l_reg, pa0, pa1, pa2, pa3); SBAR();
    pv_d0(o, vb0 + bcur, pa0, pa1, pa2, pa3);
#undef ROT3
#undef DMA_TILE
#undef WBAR
#define SLOAD(i, k0)
#define SWRITE(b, i)
#define SWAIT()
#undef SLOAD
#undef SWRITE
#undef SWAIT
    if (hi == 0) wsf[r32] = l_reg;
    __syncthreads();
    float* X = (float*)lds;
    float rli[16];
#pragma unroll
    for (int r = 0; r < 16; ++r) rli[r] = __builtin_amdgcn_rcpf(wsf[crow(r, hi)]);
    if (sub == 1) {
#pragma unroll
        for (int r = 0; r < 16; ++r) { const int row = wq * 32 + crow(r, hi); const float s = lam * rli[r];
#pragma unroll
            for (int d0 = 0; d0 < 4; ++d0) X[row * 128 + d0 * 32 + r32] = o[d0][r] * s; }
    }
    __syncthreads();
    bf16_t* Y = (bf16_t*)(lds + 65536);
    if (sub == 0) {
        float sg[4];
#pragma unroll
        for (int d0 = 0; d0 < 4; ++d0) sg[d0] = subg[d0 * 32 + r32] * (1.f - LAM_INIT);
#pragma unroll
        for (int r = 0; r < 16; ++r) { const int row = wq * 32 + crow(r, hi);
            float v[4]; float ss = 0.f;
#pragma unroll
            for (int d0 = 0; d0 < 4; ++d0) { v[d0] = o[d0][r] * rli[r] - X[row * 128 + d0 * 32 + r32]; ss += v[d0] * v[d0]; }
            ss += __shfl_xor(ss, 1); ss += __shfl_xor(ss, 2); ss += __shfl_xor(ss, 4); ss += __shfl_xor(ss, 8); ss += __shfl_xor(ss, 16);
            const float rstd = rsqrtf(ss * (1.f / 128.f) + EPS);
#pragma unroll
            for (int d0 = 0; d0 < 4; ++d0) Y[row * 128 + d0 * 32 + r32] = (bf16_t)(cvt_pk_bf16(v[d0] * rstd * sg[d0], 0.f) & 0xffffu); }
    }
    __syncthreads();
    { const int row = tid >> 2, seg = (tid & 3) * 32;
#pragma unroll
        for (int i = 0; i < 4; ++i) { const u32x4 v = *(const u32x4*)(Y + row * 128 + seg + i * 8); *(u32x4*)(MIXo + (size_t)row * DM + seg + i * 8) = v; } }
    __syncthreads();
}
#undef KSWZ
#undef SBAR
}

__device__ __forceinline__ void p3_attention(Frame& F) {
    FT_DECL;
    const float* sc = WSP(float, WS_SMALL + SM_SCAL);
    const float lam = sc[0], negm = -sc[1];
    const bf16_t* Q = WSP(bf16_t, WS_Q); const bf16_t* Kb = WSP(bf16_t, WS_K); const bf16_t* Vb = WSP(bf16_t, WS_V); bf16_t* MIX = WSP(bf16_t, WS_MIX);
    const int c = blockIdx.x, xcd = c & 7, ci = c >> 3, per = F.G >> 3;
    for (int j = ci; j < 128; j += per) {
        const int pair = xcd * 4 + (j >> 5), qb = j & 31, b = pair >> 2, h = pair & 3;
        att::attn_unit(Q + ((size_t)b * SEQ + qb * 128) * QKW + h * 128, Kb + (size_t)b * KVL * QKW + h * 128, Vb + (size_t)b * KVL * QKW + h * 128,
                       MIX + ((size_t)b * SEQ + qb * 128) * DM + h * 128, lam, negm, F.in[15], (char*)F.lds, F.wave);
    }
}


namespace att8 {
constexpr int NT = KVL / 64, SHMB = 8192, LDS_V0 = 3 * SHMB;
typedef int i32x8 __attribute__((ext_vector_type(8)));
#define SBAR() __builtin_amdgcn_sched_barrier(0)
__device__ __forceinline__ int crow(int r, int hi) { return (r & 3) + 8 * (r >> 2) + 4 * hi; }
__device__ __forceinline__ i32x8 ld32(const LAS unsigned char* p0, const LAS unsigned char* p1) {
    const u32x4 a = *(const LAS u32x4*)p0, b = *(const LAS u32x4*)p1; return (i32x8){(int)a.x, (int)a.y, (int)a.z, (int)a.w, (int)b.x, (int)b.y, (int)b.z, (int)b.w}; }
__device__ __forceinline__ void mfma_qk(f32x16& p, const i32x8& kf, const i32x8& qf, const f32x16& negc) {
    const unsigned s1 = 0x7f7f7f7fu, sq = 0x7b7b7b7bu;
    asm volatile("s_nop 1\n\tv_mfma_scale_f32_32x32x64_f8f6f4 %0, %1, %2, %3, %4, %5 op_sel_hi:[0,0,0]" : "=&v"(p) : "v"(kf), "v"(qf), "v"(negc), "v"(s1), "v"(sq));
}
__device__ __forceinline__ void mfma_pv(f32x16& o, const i32x8& pa, const i32x8& vf) {
    const unsigned s1 = 0x7f7f7f7fu;
    asm volatile("s_nop 2\n\tv_mfma_scale_f32_32x32x64_f8f6f4 %0, %1, %2, %0, %3, %3 op_sel_hi:[0,0,0]" : "+v"(o) : "v"(pa), "v"(vf), "v"(s1));
}
__device__ __forceinline__ void qkt(f32x16& p0, f32x16& p1, const LAS unsigned char* Kb, const i32x8& qf, const f32x16& negc, int r32, int hi, int sub) {
    const int c0 = sub * 4 + hi * 2;
    const int k0 = r32, k1 = 32 + r32;
    const i32x8 kf0 = ld32(Kb + k0 * 128 + ((c0 ^ ((k0 >> 1) & 7)) << 4), Kb + k0 * 128 + (((c0 + 1) ^ ((k0 >> 1) & 7)) << 4));
    const i32x8 kf1 = ld32(Kb + k1 * 128 + ((c0 ^ ((k1 >> 1) & 7)) << 4), Kb + k1 * 128 + (((c0 + 1) ^ ((k1 >> 1) & 7)) << 4));
    mfma_qk(p0, kf0, qf, negc); mfma_qk(p1, kf1, qf, negc);
}
__device__ __forceinline__ void mfma_wait(f32x16& p0, f32x16& p1) { asm volatile("s_nop 15\n\ts_nop 3" : "+v"(p0), "+v"(p1)); }
__device__ __forceinline__ void expA(f32x16& p) {
#pragma unroll
    for (int r = 0; r < 16; ++r) p[r] = __builtin_amdgcn_exp2f(p[r]);
}
__device__ __forceinline__ void finishSM(f32x16& p0, f32x16& p1, i32x8& pa) {
#pragma unroll
    for (int r = 0; r < 16; ++r) p1[r] = __builtin_amdgcn_exp2f(p1[r]);
#pragma unroll
    for (int j = 0; j < 4; ++j) { pa[j] = (int)pk4_fp8(p0[4 * j], p0[4 * j + 1], p0[4 * j + 2], p0[4 * j + 3]); pa[4 + j] = (int)pk4_fp8(p1[4 * j], p1[4 * j + 1], p1[4 * j + 2], p1[4 * j + 3]); }
}
__device__ __forceinline__ void pv(f32x16* o, f32x16& ol, const i32x8& ones, const LAS unsigned char* Vb, const i32x8& pa, int r32, int hi) {
    mfma_pv(ol, pa, ones);
#pragma unroll
    for (int d0 = 0; d0 < 4; ++d0) { const int d = 32 * d0 + r32, sw = (d >> 2) & 3;
        const i32x8 vf = ld32(Vb + d * 64 + (((2 * hi) ^ sw) << 4), Vb + d * 64 + (((2 * hi + 1) ^ sw) << 4));
        mfma_pv(o[d0], pa, vf); }
}
__device__ __forceinline__ void attn_unit(const unsigned char* __restrict__ Qb, const unsigned char* __restrict__ Kh, const unsigned char* __restrict__ VTh, bf16_t* MIXo,
                                          const float lam, const float* __restrict__ subg, char* lds, const int wid) {
    const int lane = lane_id(), tid = wid * 64 + lane, r32 = lane & 31, hi = lane >> 5;
    const int sub = wid >> 2, wq = wid & 3;
    const LAS unsigned char* L = (const LAS unsigned char*)(uintptr_t)(unsigned)(uintptr_t)lds;
    f32x16 o[4] = {}; f32x16 ol = {};
    i32x8 ones; { int c1 = 0x38383838; asm volatile("" : "+v"(c1)); ones = (i32x8){c1, c1, c1, c1, c1, c1, c1, c1}; }
    i32x8 qf; { const unsigned char* qp = Qb + (size_t)(wq * 32 + r32) * QKW + sub * 64 + 32 * hi; const u32x4 a = *(const u32x4*)qp, b = *(const u32x4*)(qp + 16);
        qf = (i32x8){(int)a.x, (int)a.y, (int)a.z, (int)a.w, (int)b.x, (int)b.y, (int)b.z, (int)b.w}; }
    f32x16 negc;
#pragma unroll
    for (int r = 0; r < 16; ++r) negc[r] = -5.f;
    asm volatile("" : "+v"(negc));
    long ksrc, vsrc;
    { const int r = 8 * wid + (lane >> 3), c = (lane & 7) ^ ((r >> 1) & 7); ksrc = (long)r * QKW + c * 16; }
    { const int d = 16 * wid + (lane >> 2), c = (lane & 3) ^ ((d >> 2) & 3); vsrc = (long)d * 64 + c * 16; }
    const unsigned ldsb = (unsigned)(uintptr_t)lds, kdst = ldsb + (unsigned)wid * 1024u, vdst = ldsb + LDS_V0 + (unsigned)wid * 1024u;
#define DMA_TILE(t, boff) do { \
        __builtin_amdgcn_global_load_lds((const unsigned*)(Kh + (long)(t) * 64 * QKW + ksrc), (LAS unsigned*)(uintptr_t)__builtin_amdgcn_readfirstlane(kdst + (unsigned)(boff)), 16, 0, 0); \
        __builtin_amdgcn_global_load_lds((const unsigned*)(VTh + (long)(t) * 8192 + vsrc), (LAS unsigned*)(uintptr_t)__builtin_amdgcn_readfirstlane(vdst + (unsigned)(boff)), 16, 0, 0); } while (0)
#define WBAR() do { asm volatile("s_waitcnt vmcnt(0) lgkmcnt(0)" ::: "memory"); __builtin_amdgcn_s_barrier(); asm volatile("" ::: "memory"); } while (0)
#define ROT3(x) ((x) == 2 * SHMB ? 0 : (x) + SHMB)
    f32x16 pA0, pA1, pB0, pB1; i32x8 pa;
    DMA_TILE(0, 0); WBAR();
    DMA_TILE(1, SHMB);
    qkt(pA0, pA1, L, qf, negc, r32, hi, sub); mfma_wait(pA0, pA1); expA(pA0);
    WBAR();
    int bprev = 0, bcur = SHMB, bnext = 2 * SHMB;
    for (int j = 1; j + 1 < NT; j += 2) {
        DMA_TILE(j + 1, bnext);
        SBAR(); qkt(pB0, pB1, L + bcur, qf, negc, r32, hi, sub);
        finishSM(pA0, pA1, pa); SBAR();
        pv(o, ol, ones, L + LDS_V0 + bprev, pa, r32, hi); mfma_wait(pB0, pB1); expA(pB0);
        WBAR();
        bprev = bcur; bcur = bnext; bnext = ROT3(bnext);
        if (j + 2 < NT) DMA_TILE(j + 2, bnext);
        SBAR(); qkt(pA0, pA1, L + bcur, qf, negc, r32, hi, sub);
        finishSM(pB0, pB1, pa); SBAR();
        pv(o, ol, ones, L + LDS_V0 + bprev, pa, r32, hi); mfma_wait(pA0, pA1); expA(pA0);
        WBAR();
        bprev = bcur; bcur = bnext; bnext = ROT3(bnext);
    }
    SBAR(); qkt(pB0, pB1, L + bcur, qf, negc, r32, hi, sub);
    finishSM(pA0, pA1, pa); SBAR();
    pv(o, ol, ones, L + LDS_V0 + bprev, pa, r32, hi); mfma_wait(pB0, pB1); expA(pB0);
    finishSM(pB0, pB1, pa); SBAR();
    pv(o, ol, ones, L + LDS_V0 + bcur, pa, r32, hi);
    asm volatile("s_nop 15\n\ts_nop 3" : "+v"(o[0]), "+v"(o[1]), "+v"(o[2]), "+v"(o[3]), "+v"(ol));
#undef ROT3
#undef DMA_TILE
#undef WBAR
    __syncthreads();
    float* X = (float*)lds;
    float rli[16];
#pragma unroll
    for (int r = 0; r < 16; ++r) rli[r] = __builtin_amdgcn_rcpf(ol[r]);
    if (sub == 1) {
#pragma unroll
        for (int r = 0; r < 16; ++r) { const int row = wq * 32 + crow(r, hi); const float sc = lam * rli[r];
#pragma unroll
            for (int d0 = 0; d0 < 4; ++d0) X[row * 128 + d0 * 32 + r32] = o[d0][r] * sc; }
    }
    __syncthreads();
    bf16_t* Y = (bf16_t*)(lds + 65536);
    if (sub == 0) {
        float sg[4];
#pragma unroll
        for (int d0 = 0; d0 < 4; ++d0) sg[d0] = subg[d0 * 32 + r32] * (1.f - LAM_INIT);
#pragma unroll
        for (int r = 0; r < 16; ++r) { const int row = wq * 32 + crow(r, hi);
            float v[4]; float ss = 0.f;
#pragma unroll
            for (int d0 = 0; d0 < 4; ++d0) { v[d0] = o[d0][r] * rli[r] - X[row * 128 + d0 * 32 + r32]; ss += v[d0] * v[d0]; }
            ss += __shfl_xor(ss, 1); ss += __shfl_xor(ss, 2); ss += __shfl_xor(ss, 4); ss += __shfl_xor(ss, 8); ss += __shfl_xor(ss, 16);
            const float rstd = rsqrtf(ss * (1.f / 128.f) + EPS);
#pragma unroll
            for (int d0 = 0; d0 < 4; ++d0) Y[row * 128 + d0 * 32 + r32] = (bf16_t)(cvt_pk_bf16(v[d0] * rstd * sg[d0], 0.f) & 0xffffu); }
    }
    __syncthreads();
    { const int row = tid >> 2, seg = (tid & 3) * 32;
#pragma unroll
        for (int i = 0; i < 4; ++i) { const u32x4 v = *(const u32x4*)(Y + row * 128 + seg + i * 8); *(u32x4*)(MIXo + (size_t)row * DM + seg + i * 8) = v; } }
    __syncthreads();
}
#undef SBAR
}

__device__ __forceinline__ void p3_attention8(Frame& F) {
    FT_DECL;
    const float* sc = WSP(float, WS_SMALL + SM_SCAL);
    const float lam = sc[0];
    const unsigned char* Q8 = WSP(unsigned char, WS_Q); const unsigned char* K8 = WSP(unsigned char, WS_K); const unsigned char* VT8 = WSP(unsigned char, WS_V); bf16_t* MIX = WSP(bf16_t, WS_MIX);
    const int c = blockIdx.x, xcd = c & 7, ci = c >> 3, per = F.G >> 3;
    for (int j = ci; j < 128; j += per) {
        const int pair = xcd * 4 + (j >> 5), qb = j & 31, b = pair >> 2, h = pair & 3;
        att8::attn_unit(Q8 + ((size_t)b * SEQ + qb * 128) * QKW + h * 128, K8 + (size_t)b * KVL * QKW + h * 128, VT8 + (size_t)(b * NHEAD + h) * 68 * 8192,
                        MIX + ((size_t)b * SEQ + qb * 128) * DM + h * 128, lam, F.in[15], (char*)F.lds, F.wave);
    }
}

namespace hy {
constexpr int RB_BYTES = 4352 * 8, IN_OFF = 2 * RB_BYTES, TW1_OFF = IN_OFF + 32768, TW2_OFF = TW1_OFF + 15 * 256 * 8, LDS_END = TW2_OFF + 15 * 16 * 8;
__device__ __forceinline__ f32x2 cmul(f32x2 a, f32x2 b) { return (f32x2){a.x * b.x - a.y * b.y, a.x * b.y + a.y * b.x}; }
__device__ __forceinline__ f32x2 cmulc(f32x2 a, f32x2 b) { return (f32x2){a.x * b.x + a.y * b.y, a.y * b.x - a.x * b.y}; }
__device__ __forceinline__ int P(int i) { return i + (i >> 4); }
template <bool INV> __device__ __forceinline__ void r4(f32x2& a, f32x2& b, f32x2& c, f32x2& d) {
    const f32x2 t0 = a + c, t1 = a - c, t2 = b + d, t3 = b - d;
    const f32x2 st3 = INV ? (f32x2){-t3.y, t3.x} : (f32x2){t3.y, -t3.x};
    a = t0 + t2; c = t0 - t2; b = t1 + st3; d = t1 - st3;
}
template <bool INV> __device__ __forceinline__ f32x2 tw(f32x2 v, float c, float s) {
    return INV ? (f32x2){v.x * c - v.y * s, v.y * c + v.x * s} : (f32x2){v.x * c + v.y * s, v.y * c - v.x * s};
}
template <bool INV> __device__ __forceinline__ void dft16(f32x2 (&v)[16]) {
    constexpr float C1 = 0.9238795325112867f, S1 = 0.3826834323650898f, R2 = 0.7071067811865476f;
    r4<INV>(v[0], v[4], v[8], v[12]); r4<INV>(v[1], v[5], v[9], v[13]); r4<INV>(v[2], v[6], v[10], v[14]); r4<INV>(v[3], v[7], v[11], v[15]);
    v[5] = tw<INV>(v[5], C1, S1);  v[9] = tw<INV>(v[9], R2, R2);    v[13] = tw<INV>(v[13], S1, C1);
    v[6] = tw<INV>(v[6], R2, R2);  v[10] = tw<INV>(v[10], 0.f, 1.f); v[14] = tw<INV>(v[14], -R2, R2);
    v[7] = tw<INV>(v[7], S1, C1);  v[11] = tw<INV>(v[11], -R2, R2);  v[15] = tw<INV>(v[15], -C1, -S1);
    r4<INV>(v[0], v[1], v[2], v[3]); r4<INV>(v[4], v[5], v[6], v[7]); r4<INV>(v[8], v[9], v[10], v[11]); r4<INV>(v[12], v[13], v[14], v[15]);
    f32x2 t;
    t = v[1]; v[1] = v[4]; v[4] = t;   t = v[2]; v[2] = v[8]; v[8] = t;    t = v[3]; v[3] = v[12]; v[12] = t;
    t = v[6]; v[6] = v[9]; v[9] = t;   t = v[7]; v[7] = v[13]; v[13] = t;  t = v[11]; v[11] = v[14]; v[14] = t;
}
struct Ctx { LAS f32x2* R; LAS f32x2* IN; LAS f32x2* TW1; LAS f32x2* TW2; int t, half; f32x2 wt; };
#define HY_OPAQUE(x) asm volatile("" : "+v"(x))
#define HY_W32(m) (f32x2){__builtin_cosf(-0.19634954084936207f * (m)), __builtin_sinf(-0.19634954084936207f * (m))}
template <int MODE> __device__ __forceinline__ void pass1_fwd(const Ctx& X) {
    f32x2 v[16]; int t = X.t; HY_OPAQUE(t);
#pragma unroll
    for (int m = 0; m < 16; ++m) { f32x2 a = X.IN[t + 256 * m]; if (MODE == 1) a = (f32x2){X.half ? a.y : a.x, 0.f}; v[m] = a; }
    if (X.half) {
#pragma unroll
        for (int m = 0; m < 16; ++m) v[m] = cmul(cmul(v[m], HY_W32(m)), X.wt);
    }
    dft16<false>(v);
#pragma unroll
    for (int q = 1; q < 16; ++q) v[q] = cmul(v[q], X.TW1[(q - 1) * 256 + t]);
    const int pb = t + (t >> 4);
#pragma unroll
    for (int q = 0; q < 16; ++q) X.R[pb + 272 * q] = v[q];
}
__device__ __forceinline__ void pass2_fwd(const Ctx& X) {
    int t = X.t; HY_OPAQUE(t);
    const int n2 = t & 15, pb = (t >> 4) * 272 + n2; f32x2 v[16];
#pragma unroll
    for (int m = 0; m < 16; ++m) v[m] = X.R[pb + 17 * m];
    dft16<false>(v);
#pragma unroll
    for (int q = 1; q < 16; ++q) v[q] = cmul(v[q], X.TW2[(q - 1) * 16 + n2]);
#pragma unroll
    for (int q = 0; q < 16; ++q) X.R[pb + 17 * q] = v[q];
}
template <bool FILTER> __device__ __forceinline__ void pass3(const Ctx& X, f32x2 (&H)[16]) {
    f32x2 v[16]; int t = X.t; HY_OPAQUE(t); const int pb = 17 * t;
#pragma unroll
    for (int m = 0; m < 16; ++m) v[m] = X.R[pb + m];
    dft16<false>(v);
    if (FILTER) {
#pragma unroll
        for (int q = 0; q < 16; ++q) H[q] = v[q] * (1.f / 8192.f);
    } else {
#pragma unroll
        for (int q = 0; q < 16; ++q) v[q] = cmul(v[q], H[q]);
        dft16<true>(v);
#pragma unroll
        for (int m = 0; m < 16; ++m) X.R[pb + m] = v[m];
    }
}
__device__ __forceinline__ void pass2_inv(const Ctx& X) {
    int t = X.t; HY_OPAQUE(t);
    const int n2 = t & 15, pb = (t >> 4) * 272 + n2; f32x2 v[16];
    v[0] = X.R[pb];
#pragma unroll
    for (int q = 1; q < 16; ++q) v[q] = cmulc(X.R[pb + 17 * q], X.TW2[(q - 1) * 16 + n2]);
    dft16<true>(v);
#pragma unroll
    for (int m = 0; m < 16; ++m) X.R[pb + 17 * m] = v[m];
}
__device__ __forceinline__ void pass1_inv(const Ctx& X) {
    f32x2 v[16]; int t = X.t; HY_OPAQUE(t); const int pb = t + (t >> 4);
    v[0] = X.R[pb];
#pragma unroll
    for (int q = 1; q < 16; ++q) v[q] = cmulc(X.R[pb + 272 * q], X.TW1[(q - 1) * 256 + t]);
    dft16<true>(v);
    if (X.half) {
#pragma unroll
        for (int m = 0; m < 16; ++m) v[m] = cmulc(cmulc(v[m], HY_W32(m)), X.wt);
    }
#pragma unroll
    for (int m = 0; m < 16; ++m) X.R[pb + 272 * m] = v[m];
}
#define HY_WSYNC() asm volatile("s_waitcnt lgkmcnt(0)" ::: "memory")
__device__ __forceinline__ void conv_fft(const Ctx& X, f32x2 (&H)[16]) {
    __syncthreads(); pass1_fwd<0>(X); __syncthreads(); pass2_fwd(X); HY_WSYNC(); pass3<false>(X, H); HY_WSYNC(); pass2_inv(X); __syncthreads(); pass1_inv(X); __syncthreads();
}
constexpr int STG_OFF = LDS_END;
constexpr int LDS_END2 = STG_OFF + 2 * SEQ * 2;
static_assert(LDS_END2 <= LDSCTL_OFF, "hyena LDS map");
__device__ __forceinline__ float sconv_lds(const LAS bf16_t* stg, int bs, int n, float w0, float w1, float w2, float bias) {
    const LAS bf16_t* p = stg + bs * SEQ;
    const float c = bf2f(p[n]), lv = bf2f(p[n - ((n > 0) ? 1 : 0)]), rv = bf2f(p[n + ((n < SEQ - 1) ? 1 : 0)]);
    const float l = (n > 0) ? lv : 0.f, r = (n < SEQ - 1) ? rv : 0.f;
    return bias + w0 * l + w1 * c + w2 * r;
}
__device__ __forceinline__ void setup_tables(LAS unsigned char* lds, int tid) {
    LAS f32x2* TW1 = (LAS f32x2*)(lds + TW1_OFF); LAS f32x2* TW2 = (LAS f32x2*)(lds + TW2_OFF);
    for (int i = tid; i < 15 * 256; i += 512) { const int q = i / 256 + 1, t = i & 255; float s, c; sincosf(-6.283185307179586f * (float)((t * q) & 4095) * (1.f / 4096.f), &s, &c); TW1[i] = (f32x2){c, s}; }
    for (int i = tid; i < 15 * 16; i += 512) { const int q = i / 16 + 1, n2 = i & 15; float s, c; sincosf(-6.283185307179586f * (float)((n2 * q) & 255) * (1.f / 256.f), &s, &c); TW2[i] = (f32x2){c, s}; }
}
__device__ __forceinline__ void unit(Frame& F, int c) {
    FT_DECL;
    const int tid = f_tid; Ctx X; X.half = F.wave >> 2; X.t = tid & 255;
    X.R = (LAS f32x2*)(F.lds + X.half * RB_BYTES); X.IN = (LAS f32x2*)(F.lds + IN_OFF); X.TW1 = (LAS f32x2*)(F.lds + TW1_OFF); X.TW2 = (LAS f32x2*)(F.lds + TW2_OFF);
    { float s, cc; sincosf(-6.283185307179586f * (float)X.t * (1.f / 8192.f), &s, &cc); X.wt = (f32x2){cc, s}; }
    LAS f32x2* RB0 = (LAS f32x2*)(F.lds); LAS f32x2* RB1 = (LAS f32x2*)(F.lds + RB_BYTES);
    const float* FILT = WSP(float, WS_FILT);
    f32x2 H0[16], H1[16];
#pragma unroll
    for (int ord = 0; ord < 2; ++ord) {
        const float* hf = FILT + ((size_t)(ord * 2 + 0) * 512 + c) * SEQ; const float* hb = FILT + ((size_t)(ord * 2 + 1) * 512 + c) * SEQ;
        __syncthreads();
        int nb = tid; HY_OPAQUE(nb);
#pragma unroll
        for (int j = 0; j < 8; ++j) { const int n = nb + 512 * j; const float a = hf[n], b = hb[(SEQ - n) & (SEQ - 1)]; const float lo = (n == 0) ? a + b : a, hi = (n == 0) ? 0.f : b; X.IN[n] = (f32x2){lo + hi, lo - hi}; }
        __syncthreads(); pass1_fwd<1>(X); __syncthreads(); pass2_fwd(X); HY_WSYNC();
        if (ord == 0) pass3<true>(X, H0); else pass3<true>(X, H1);
    }
    const bf16_t* UT = WSP(bf16_t, WS_UT);
    const bf16_t* rv = UT + (size_t)c * MROWS; const bf16_t* r1 = UT + (size_t)(512 + c) * MROWS; const bf16_t* r2 = UT + (size_t)(1024 + c) * MROWS;
    const float* cw = F.in[16]; const float* cb = F.in[17];
    const float wv0 = cw[c], wv1 = cw[HYC + c], wv2 = cw[2 * HYC + c], bv = cb[c];
    const float wa0 = cw[512 + c], wa1 = cw[HYC + 512 + c], wa2 = cw[2 * HYC + 512 + c], ba = cb[512 + c];
    const float wb0 = cw[1024 + c], wb1 = cw[HYC + 1024 + c], wb2 = cw[2 * HYC + 1024 + c], bb = cb[1024 + c];
    const float sk0 = F.in[25][c], sk1 = F.in[25][512 + c];
    bf16_t* Z = WSP(bf16_t, WS_Z2T) + (size_t)c * MROWS;
    LAS bf16_t* STG = (LAS bf16_t*)(F.lds + STG_OFF);
    u32x4 g0 = *(const u32x4*)(rv + tid * 8), g1 = *(const u32x4*)(rv + SEQ + tid * 8);
    for (int pr = 0; pr < 4; ++pr) {
        const int b0 = 2 * pr, b1 = b0 + 1;
        f32x2 z[8]; int pc = tid + (tid >> 4); HY_OPAQUE(pc); int nb = tid; HY_OPAQUE(nb);
        __syncthreads();
        *(LAS u32x4*)(STG + tid * 8) = g0; *(LAS u32x4*)(STG + SEQ + tid * 8) = g1;
        __syncthreads();
#pragma unroll
        for (int j = 0; j < 8; ++j) { const int n = nb + 512 * j; z[j] = (f32x2){sconv_lds(STG, 0, n, wv0, wv1, wv2, bv), sconv_lds(STG, 1, n, wv0, wv1, wv2, bv)}; X.IN[n] = z[j]; }
        g0 = *(const u32x4*)(r1 + b0 * SEQ + tid * 8); g1 = *(const u32x4*)(r1 + b1 * SEQ + tid * 8);
        conv_fft(X, H0);
        *(LAS u32x4*)(STG + tid * 8) = g0; *(LAS u32x4*)(STG + SEQ + tid * 8) = g1;
        __syncthreads();
        HY_OPAQUE(nb); HY_OPAQUE(pc);
#pragma unroll
        for (int j = 0; j < 8; ++j) { const int n = nb + 512 * j; const f32x2 y = RB0[pc + 544 * j] + RB1[pc + 544 * j];
            const f32x2 g = (f32x2){sconv_lds(STG, 0, n, wa0, wa1, wa2, ba), sconv_lds(STG, 1, n, wa0, wa1, wa2, ba)};
            z[j] = g * (y + sk0 * z[j]); X.IN[n] = z[j]; }
        g0 = *(const u32x4*)(r2 + b0 * SEQ + tid * 8); g1 = *(const u32x4*)(r2 + b1 * SEQ + tid * 8);
        conv_fft(X, H1);
        *(LAS u32x4*)(STG + tid * 8) = g0; *(LAS u32x4*)(STG + SEQ + tid * 8) = g1;
        __syncthreads();
        if (pr < 3) { g0 = *(const u32x4*)(rv + (b0 + 2) * SEQ + tid * 8); g1 = *(const u32x4*)(rv + (b1 + 2) * SEQ + tid * 8); }
        HY_OPAQUE(nb); HY_OPAQUE(pc);
        f32x2 o[8];
#pragma unroll
        for (int j = 0; j < 8; ++j) { const int n = nb + 512 * j; const f32x2 y = RB0[pc + 544 * j] + RB1[pc + 544 * j];
            const f32x2 g = (f32x2){sconv_lds(STG, 0, n, wb0, wb1, wb2, bb), sconv_lds(STG, 1, n, wb0, wb1, wb2, bb)};
            o[j] = g * (y + sk1 * z[j]); }
        __syncthreads();
#pragma unroll
        for (int j = 0; j < 8; ++j) { const int n = nb + 512 * j; STG[n] = (bf16_t)(cvt_pk_bf16(o[j].x, 0.f) & 0xffffu); STG[SEQ + n] = (bf16_t)(cvt_pk_bf16(o[j].y, 0.f) & 0xffffu); }
        __syncthreads();
        *(u32x4*)(Z + b0 * SEQ + tid * 8) = *(const LAS u32x4*)(STG + tid * 8); *(u32x4*)(Z + b1 * SEQ + tid * 8) = *(const LAS u32x4*)(STG + SEQ + tid * 8);
    }
    __syncthreads();
}
}

__device__ __forceinline__ void p3_hyena(Frame& F) {
    FT_DECL;
    __syncthreads();
    hy::setup_tables(F.lds, f_tid);
    __syncthreads();
    for (int c = F.vcu; c < HYW; c += F.G) hy::unit(F, c);
}

__device__ __forceinline__ void p4_hynorm(Frame& F) {
    FT_DECL;
    const bf16_t* Z = WSP(bf16_t, WS_Z2T); bf16_t* MIX = WSP(bf16_t, WS_MIX); const float* g = F.in[26];
    LAS bf16_t* T = (LAS bf16_t*)F.lds;
    LAS float* red = (LAS float*)(F.lds + 512 * 72 * 2);
    LAS float* rs = red + 512;
    for (int it = F.vcu; it < MROWS / 64; it += F.G) {
        const int tok0 = it * 64;
        __syncthreads();
#pragma unroll
        for (int j = 0; j < 8; ++j) { const int i = f_tid + 512 * j, row = i >> 3, ch = i & 7; const u32x4 v = *(const u32x4*)(Z + (size_t)row * MROWS + tok0 + ch * 8); *(LAS u32x4*)(T + row * 72 + ch * 8) = v; }
        __syncthreads();
        { const int tok = f_tid & 63, grp = f_tid >> 6; float ss = 0.f;
#pragma unroll 8
            for (int k = 0; k < 64; ++k) { const float v = bf2f(T[(grp * 64 + k) * 72 + tok]); ss += v * v; }
            red[grp * 64 + tok] = ss; }
        __syncthreads();
        if (f_tid < 64) { float ss = 0.f;
#pragma unroll
            for (int w = 0; w < 8; ++w) ss += red[w * 64 + f_tid];
            rs[f_tid] = rsqrtf(ss * (1.f / HYW) + EPS); }
        __syncthreads();
#pragma unroll
        for (int j = 0; j < 8; ++j) { const int i = f_tid + 512 * j, tok = i >> 6, c0 = (i & 63) * 8; const float r = rs[tok];
            float v[8];
#pragma unroll
            for (int e = 0; e < 8; ++e) v[e] = bf2f(T[(c0 + e) * 72 + tok]) * r * g[c0 + e];
            u32x4 w; w.x = cvt_pk_bf16(v[0], v[1]); w.y = cvt_pk_bf16(v[2], v[3]); w.z = cvt_pk_bf16(v[4], v[5]); w.w = cvt_pk_bf16(v[6], v[7]);
            *(u32x4*)(MIX + (size_t)(tok0 + tok) * DM + 512 + c0) = w; }
    }
}

__device__ __forceinline__ void p4_stub(Frame& F) {
    FT_DECL;
    bf16_t* MIX = WSP(bf16_t, WS_MIX);
    const size_t gt = (size_t)F.vcu * 512 + f_tid, NT = (size_t)F.G * 512;
    for (size_t i = gt; i < (size_t)MROWS * 64; i += NT) { const size_t row = i >> 6, ch = i & 63; *(u32x4*)(MIX + row * DM + 512 + ch * 8) = (u32x4){0u, 0u, 0u, 0u}; }
}


constexpr size_t RT_TOPI = 0;
constexpr size_t RT_GATE = 512 * 1024;
constexpr size_t RT_POS = 1024 * 1024;
constexpr size_t RT_WGCNT = 1536 * 1024;
constexpr size_t RT_META = 1600 * 1024;
constexpr size_t RT_LIST = 2048 * 1024;
constexpr size_t RT_GSLOT = 2048 * 1024 + 640 * 1024;
constexpr int MAXSLOT = MROWS * TOPK + NEXP * 256;
constexpr int MAXTILE = MAXSLOT / 256;
constexpr size_t WS_XS = WS_EO;
constexpr int RW_PITCH = 32;
constexpr int P6_LDS_TOPI = 1024 * RW_PITCH * 4;

__device__ __forceinline__ void p6_router(Frame& F) {
    FT_DECL;
#define in F.in
    LAS float* RW = (LAS float*)F.lds;
    LAS int* TI = (LAS int*)(F.lds + P6_LDS_TOPI);
    LAS int* PS = TI + 512;
    LAS int* SC = PS + 512;
    const float* rw = in[28];
    for (int i = f_tid; i < 1024 * 8; i += 512) { const int k = i >> 3, c4 = i & 7; const f32x4 v = *(const f32x4*)(rw + (size_t)k * 32 + c4 * 4);
        const int pi = (k & 3) * 256 + (k >> 2); *(LAS f32x4*)(RW + pi * RW_PITCH + ((c4 ^ ((pi >> 1) & 7)) * 4)) = v; }
    __syncthreads();
    const float* mod = WSP(float, WS_SMALL + SM_MOD); const float* g2n = in[7]; const float* rb = in[29];
    unsigned char* H2 = WSP(unsigned char, WS_H);
    int* topi_g = WSP(int, WS_ROUTE + RT_TOPI); float* gate_g = WSP(float, WS_ROUTE + RT_GATE); int* pos_g = WSP(int, WS_ROUTE + RT_POS); int* wgcnt = WSP(int, WS_ROUTE + RT_WGCNT);
    const int lane = f_lane;
    for (int blk = blockIdx.x; blk < MROWS / 128; blk += F.G) {
        for (int it = 0; it < 8; ++it) {
            const int rl = F.wave * 16 + 2 * it, r0 = blk * 128 + rl;
            const float* sh2 = mod + (size_t)(r0 >> 12) * (NMOD * DM) + 3 * DM; const float* sc2 = sh2 + DM;
            f32x4 h[2][4];
#pragma unroll
            for (int rr = 0; rr < 2; ++rr) {
                const GAS u32x2* xr = (const GAS u32x2*)(WSP(bf16_t, WS_XN) + (size_t)(r0 + rr) * DM) + lane; float ss = 0.f;
#pragma unroll
                for (int j = 0; j < 4; ++j) { const u32x2 xb = xr[64 * j]; h[rr][j] = (f32x4){__uint_as_float(xb.x << 16), __uint_as_float(xb.x & 0xffff0000u), __uint_as_float(xb.y << 16), __uint_as_float(xb.y & 0xffff0000u)}; ss += (h[rr][j].x * h[rr][j].x + h[rr][j].y * h[rr][j].y) + (h[rr][j].z * h[rr][j].z + h[rr][j].w * h[rr][j].w); }
                const float rstd = rsqrtf(wave_sum(ss) * (1.f / DM) + EPS);
                GAS unsigned* o4 = (GAS unsigned*)(H2 + (size_t)(r0 + rr) * DM) + lane;
#pragma unroll
                for (int j = 0; j < 4; ++j) { const int c = 4 * lane + 256 * j;
                    const f32x4 g = *(const f32x4*)(g2n + c), a = *(const f32x4*)(sc2 + c), b = *(const f32x4*)(sh2 + c);
                    h[rr][j] = h[rr][j] * rstd * g * (a + 1.f) + b;
                    o4[64 * j] = pk4_fp8(h[rr][j].x, h[rr][j].y, h[rr][j].z, h[rr][j].w); }
            }
            float a0[32], a1[32]; int lb = lane; asm volatile("" : "+v"(lb)); const int sw = (lb >> 1) & 7;
#pragma unroll
            for (int e = 0; e < 32; ++e) { a0[e] = 0.f; a1[e] = 0.f; }
            unsigned pb[8];
#pragma unroll
            for (int c = 0; c < 8; ++c) { pb[c] = (unsigned)(uintptr_t)RW + (unsigned)lb * 128u + (unsigned)((c ^ sw) * 16); asm volatile("" : "+v"(pb[c])); }
            f32x4 wb[2][4];
#define P6_OFF(hs) ((((((hs) >> 1) & 3) * 256 + 64 * ((hs) >> 3)) * 128) & 65535)
#define P6_HI(hs) ((((((hs) >> 1) & 3) * 256 + 64 * ((hs) >> 3)) * 128) >> 16)
#define P6_LOADW(buf, hs) _Pragma("unroll") for (int c = 0; c < 4; ++c) wb[buf][c] = *(const LAS f32x4*)(uintptr_t)(pb[4 * ((hs) & 1) + c] + (unsigned)(P6_HI(hs) * 65536 + P6_OFF(hs)))
#define P6_FMA(buf, hs) do { const float x0 = h[0][(hs) >> 3][((hs) >> 1) & 3], x1 = h[1][(hs) >> 3][((hs) >> 1) & 3]; _Pragma("unroll") for (int c = 0; c < 4; ++c) _Pragma("unroll") for (int e = 0; e < 4; ++e) { \
                a0[16 * ((hs) & 1) + 4 * c + e] += x0 * wb[buf][c][e]; a1[16 * ((hs) & 1) + 4 * c + e] += x1 * wb[buf][c][e]; } } while (0)
            P6_LOADW(0, 0);
#pragma unroll
            for (int hs = 0; hs < 32; hs += 2) {
                P6_LOADW(1, hs + 1); __builtin_amdgcn_sched_barrier(0); asm volatile("s_waitcnt lgkmcnt(4)" ::: "memory"); __builtin_amdgcn_sched_barrier(0);
                P6_FMA(0, hs); __builtin_amdgcn_sched_barrier(0);
                if (hs + 2 < 32) { P6_LOADW(0, hs + 2); __builtin_amdgcn_sched_barrier(0); asm volatile("s_waitcnt lgkmcnt(4)" ::: "memory"); } else { asm volatile("s_waitcnt lgkmcnt(0)" ::: "memory"); }
                __builtin_amdgcn_sched_barrier(0);
                P6_FMA(1, hs + 1); __builtin_amdgcn_sched_barrier(0);
            }
#undef P6_LOADW
#undef P6_FMA
#undef P6_OFF
#undef P6_HI
#define RS_STEP(A, CNT, MASK) _Pragma("unroll") for (int i = 0; i < CNT; ++i) { const bool up = (lane & MASK) != 0; const float send = up ? A[i] : A[CNT + i]; const float keep = up ? A[CNT + i] : A[i]; A[i] = keep + __shfl_xor(send, MASK); }
            RS_STEP(a0, 16, 32) RS_STEP(a0, 8, 16) RS_STEP(a0, 4, 8) RS_STEP(a0, 2, 4) RS_STEP(a0, 1, 2)
            RS_STEP(a1, 16, 32) RS_STEP(a1, 8, 16) RS_STEP(a1, 4, 8) RS_STEP(a1, 2, 4) RS_STEP(a1, 1, 2)
#undef RS_STEP
            const int me = lane >> 1; const float bias = rb[me];
            float lg[2]; lg[0] = a0[0] + __shfl_xor(a0[0], 1) + bias; lg[1] = a1[0] + __shfl_xor(a1[0], 1) + bias;
            LAS float* WL = (LAS float*)(F.lds + P6_LDS_TOPI + 6144) + F.wave * 96;
            if ((lane & 1) == 0) { WL[me] = lg[0]; WL[32 + me] = lg[1]; }
            LDS_WAIT(); asm volatile("" ::: "memory");
#pragma unroll
            for (int rr = 0; rr < 2; ++rr) {
                const float v = lg[rr]; int rank = 0;
#pragma unroll
                for (int c4 = 0; c4 < 8; ++c4) { const f32x4 o = *(const LAS f32x4*)(WL + rr * 32 + 4 * c4);
#pragma unroll
                    for (int e = 0; e < 4; ++e) { const int oe = 4 * c4 + e; rank += (o[e] > v || (o[e] == v && oe < me)) ? 1 : 0; } }
                if ((lane & 1) == 0 && rank < 4) { WL[64 + rr * 4 + rank] = v; ((LAS int*)WL)[72 + rr * 4 + rank] = me; }
            }
            LDS_WAIT(); asm volatile("" ::: "memory");
            if (lane < 2) { const int rr = lane; const f32x4 tv = *(const LAS f32x4*)(WL + 64 + rr * 4); typedef int i32x4_t __attribute__((ext_vector_type(4))); const i32x4_t ti = *(const LAS i32x4_t*)((LAS int*)WL + 72 + rr * 4);
                const float e1 = __expf(tv[1] - tv[0]), e2 = __expf(tv[2] - tv[0]), e3 = __expf(tv[3] - tv[0]); const float inv = 1.f / (1.f + e1 + e2 + e3);
                const int r = r0 + rr;
                *(i32x4_t*)(topi_g + (size_t)r * 4) = ti;
                *(f32x4*)(gate_g + (size_t)r * 4) = (f32x4){inv, e1 * inv, e2 * inv, e3 * inv};
                *(LAS i32x4_t*)(TI + (rl + rr) * 4) = ti; }
            LDS_WAIT(); asm volatile("" ::: "memory");
        }
        __syncthreads();
        { const int t2 = F.wave * 64 + lane_id(); const int e = t2 & 31, seg = t2 >> 5; int cnt = 0;
#pragma unroll 4
            for (int i = 0; i < 32; ++i) cnt += (TI[seg * 32 + i] == e) ? 1 : 0;
            SC[seg * 32 + e] = cnt;
            __syncthreads();
            int pre = 0;
            for (int s2 = 0; s2 < seg; ++s2) pre += SC[s2 * 32 + e];
            if (seg == 15) wgcnt[blk * 32 + e] = pre + cnt;
            for (int i = 0; i < 32; ++i) if (TI[seg * 32 + i] == e) { PS[seg * 32 + i] = pre; ++pre; }
        }
        __syncthreads();
        { const int t3 = F.wave * 64 + lane_id(); pos_g[(size_t)blk * 512 + t3] = PS[t3]; }
        __syncthreads();
    }
#undef in
}


__device__ __forceinline__ void p6_router_mfma(Frame& F) {
    FT_DECL;
#define in F.in
    LAS float* WP = (LAS float*)F.lds;
    LAS int* TI = (LAS int*)(F.lds + P6_LDS_TOPI);
    LAS int* PS = TI + 512;
    LAS int* SC = PS + 512;
    LAS float* RSTD = (LAS float*)(SC + 512);
    LAS float* BIAS = RSTD + 128;
    LAS float* SSX = BIAS + 32;
    const float* rw = in[28]; const float* mod = WSP(float, WS_SMALL + SM_MOD); const float* g2n = in[7]; const float* rb = in[29];
    const bf16_t* XN = WSP(bf16_t, WS_XN); unsigned char* H2 = WSP(unsigned char, WS_H);
    int* topi_g = WSP(int, WS_ROUTE + RT_TOPI); float* gate_g = WSP(float, WS_ROUTE + RT_GATE); int* pos_g = WSP(int, WS_ROUTE + RT_POS); int* wgcnt = WSP(int, WS_ROUTE + RT_WGCNT);
    for (int blk = blockIdx.x; blk < MROWS / 128; blk += F.G) {
        const float* sh2 = mod + (size_t)(blk >> 5) * (NMOD * DM) + 3 * DM; const float* sc2 = sh2 + DM;
        __syncthreads();
        for (int i = f_tid; i < 1024 * 8; i += 512) { const int k = i >> 3, c4 = i & 7; const float gm = g2n[k] * (1.f + sc2[k]);
            *(LAS f32x4*)(WP + k * 32 + c4 * 4) = *(const f32x4*)(rw + (size_t)k * 32 + c4 * 4) * gm; }
        { const int e = f_tid & 31, part = f_tid >> 5; float a = 0.f;
            for (int k = part * 64; k < part * 64 + 64; ++k) a += sh2[k] * rw[(size_t)k * 32 + e];
            ((LAS float*)SC)[part * 32 + e] = a; }
        __syncthreads();
        if (f_tid < 32) { float a = rb[f_tid];
#pragma unroll
            for (int p = 0; p < 16; ++p) a += ((LAS float*)SC)[p * 32 + f_tid];
            BIAS[f_tid] = a; }
        const int rg = F.wave & 3, kh = F.wave >> 2, j = f_lane & 31, hi = f_lane >> 5;
        f32x16 acc = {};
        float ss = 0.f;
        { const bf16_t* xrow = XN + (size_t)(blk * 128 + rg * 32 + j) * DM + 512 * kh + 8 * hi;
            const LAS float* wp = WP + (512 * kh + 8 * hi) * 32 + j;
#pragma unroll 4
            for (int c = 0; c < 32; ++c) { const u32x4 xb = *(const u32x4*)(xrow + 16 * c);
                float xf[8] = {__uint_as_float(xb.x << 16), __uint_as_float(xb.x & 0xffff0000u), __uint_as_float(xb.y << 16), __uint_as_float(xb.y & 0xffff0000u),
                               __uint_as_float(xb.z << 16), __uint_as_float(xb.z & 0xffff0000u), __uint_as_float(xb.w << 16), __uint_as_float(xb.w & 0xffff0000u)};
#pragma unroll
                for (int q = 0; q < 8; ++q) { ss += xf[q] * xf[q]; acc = __builtin_amdgcn_mfma_f32_32x32x2f32(wp[(16 * c + q) * 32], xf[q], acc, 0, 0, 0); } } }
        { auto rr = __builtin_amdgcn_permlane32_swap(__float_as_uint(ss), __float_as_uint(ss), false, false); ss = __uint_as_float(rr[0]) + __uint_as_float(rr[1]); }
        if (hi == 0) SSX[kh * 128 + rg * 32 + j] = ss;
        __syncthreads();
        if (kh == 1) {
#pragma unroll
            for (int r = 0; r < 16; ++r) WP[(rg * 16 + r) * 64 + f_lane] = acc[r]; }
        if (f_tid < 128) RSTD[f_tid] = rsqrtf((SSX[f_tid] + SSX[128 + f_tid]) * (1.f / DM) + EPS);
        __syncthreads();
        if (kh == 0) {
            const float rstd = RSTD[rg * 32 + j];
            float tv[4] = {-INFINITY, -INFINITY, -INFINITY, -INFINITY}; int ti[4] = {1 << 20, 1 << 20, 1 << 20, 1 << 20};
#define P6_INS(V, E) do { float cv = (V); int ce = (E); _Pragma("unroll") for (int q = 0; q < 4; ++q) { const bool b = cv > tv[q] || (cv == tv[q] && ce < ti[q]); \
                const float nv = b ? tv[q] : cv; const int ne = b ? ti[q] : ce; tv[q] = b ? cv : tv[q]; ti[q] = b ? ce : ti[q]; cv = nv; ce = ne; } } while (0)
#pragma unroll
            for (int r = 0; r < 16; ++r) { const int e = (r & 3) + 8 * (r >> 2) + 4 * hi; const float v = (acc[r] + WP[(rg * 16 + r) * 64 + f_lane]) * rstd + BIAS[e]; P6_INS(v, e); }
            float ov[4]; int oe[4];
#pragma unroll
            for (int q = 0; q < 4; ++q) { ov[q] = __shfl_xor(tv[q], 32); oe[q] = __shfl_xor(ti[q], 32); }
#pragma unroll
            for (int q = 0; q < 4; ++q) P6_INS(ov[q], oe[q]);
#undef P6_INS
            if (hi == 0) { const int rl = rg * 32 + j, r = blk * 128 + rl;
                const float e1 = __expf(tv[1] - tv[0]), e2 = __expf(tv[2] - tv[0]), e3 = __expf(tv[3] - tv[0]); const float inv = 1.f / (1.f + e1 + e2 + e3);
                typedef int i32x4_t __attribute__((ext_vector_type(4))); const i32x4_t t4 = {ti[0], ti[1], ti[2], ti[3]};
                *(i32x4_t*)(topi_g + (size_t)r * 4) = t4; *(f32x4*)(gate_g + (size_t)r * 4) = (f32x4){inv, e1 * inv, e2 * inv, e3 * inv};
                *(LAS i32x4_t*)(TI + rl * 4) = t4; }
        }
        __syncthreads();
        { const int t2 = F.wave * 64 + lane_id(); const int e = t2 & 31, seg = t2 >> 5; int cnt = 0;
#pragma unroll 4
            for (int i = 0; i < 32; ++i) cnt += (TI[seg * 32 + i] == e) ? 1 : 0;
            SC[seg * 32 + e] = cnt;
            __syncthreads();
            int pre = 0;
            for (int s2 = 0; s2 < seg; ++s2) pre += SC[s2 * 32 + e];
            if (seg == 15) wgcnt[blk * 32 + e] = pre + cnt;
            for (int i = 0; i < 32; ++i) if (TI[seg * 32 + i] == e) { PS[seg * 32 + i] = pre; ++pre; }
        }
        __syncthreads();
        { const int t3 = F.wave * 64 + lane_id(); pos_g[(size_t)blk * 512 + t3] = PS[t3]; }
        { const int lane = lane_id();
            for (int it = 0; it < 4; ++it) { u32x2 xb[4][4];
#pragma unroll
                for (int u = 0; u < 4; ++u) { const GAS u32x2* xr = (const GAS u32x2*)(XN + (size_t)(blk * 128 + F.wave * 16 + 4 * it + u) * DM) + lane;
#pragma unroll
                    for (int jj = 0; jj < 4; ++jj) xb[u][jj] = xr[64 * jj]; }
#pragma unroll
                for (int u = 0; u < 4; ++u) { const int rl = F.wave * 16 + 4 * it + u; const float rstd = RSTD[rl];
                    GAS unsigned* o4 = (GAS unsigned*)(H2 + (size_t)(blk * 128 + rl) * DM) + lane;
#pragma unroll
                    for (int jj = 0; jj < 4; ++jj) { const int c = 4 * lane + 256 * jj;
                        const f32x4 x = (f32x4){__uint_as_float(xb[u][jj].x << 16), __uint_as_float(xb[u][jj].x & 0xffff0000u), __uint_as_float(xb[u][jj].y << 16), __uint_as_float(xb[u][jj].y & 0xffff0000u)};
                        const f32x4 g = *(const f32x4*)(g2n + c), a = *(const f32x4*)(sc2 + c), b = *(const f32x4*)(sh2 + c);
                        const f32x4 h = x * rstd * g * (a + 1.f) + b;
                        o4[64 * jj] = pk4_fp8(h.x, h.y, h.z, h.w); } } }
        }
    }
#undef in
}

__device__ __forceinline__ void p7_scatter(Frame& F) {
    FT_DECL;
    LAS int* TOT = (LAS int*)F.lds;
    LAS int* BASE = TOT + 32;
    LAS int* PRE = BASE + 32;
    LAS int* PART = PRE + 32;
    const int* wgcnt = WSP(int, WS_ROUTE + RT_WGCNT); const int* topi_g = WSP(int, WS_ROUTE + RT_TOPI); const float* gate_g = WSP(float, WS_ROUTE + RT_GATE); const int* pos_g = WSP(int, WS_ROUTE + RT_POS);
    int* list = WSP(int, WS_ROUTE + RT_LIST); float* gslot = WSP(float, WS_ROUTE + RT_GSLOT); int* meta = WSP(int, WS_ROUTE + RT_META);
    const unsigned char* H2 = WSP(unsigned char, WS_H); unsigned char* XS = WSP(unsigned char, WS_XS);
    for (int blk = blockIdx.x; blk < MROWS / 128; blk += F.G) {
        __syncthreads();
        { const int e = f_tid & 31, part = f_tid >> 5; int st = 0, sp = 0;
            for (int w = part * 16; w < part * 16 + 16; ++w) { const int c = wgcnt[w * 32 + e]; st += c; if (w < blk) sp += c; }
            PART[part * 32 + e] = st; PART[512 + part * 32 + e] = sp; }
        __syncthreads();
        if (f_tid < 32) { int st = 0, sp = 0;
#pragma unroll
            for (int p = 0; p < 16; ++p) { st += PART[p * 32 + f_tid]; sp += PART[512 + p * 32 + f_tid]; }
            TOT[f_tid] = st; PRE[f_tid] = sp; }
        __syncthreads();
        if (f_tid == 0) { int b = 0; for (int e = 0; e < 32; ++e) { BASE[e] = b; b += (TOT[e] + 255) & ~255; }
            if (blk == 0) { int t = 0; for (int e = 0; e < 32; ++e) { meta[e] = TOT[e]; meta[32 + e] = BASE[e]; const int nt = (TOT[e] + 255) >> 8; for (int q = 0; q < nt; ++q) meta[128 + t + q] = e; t += nt; } meta[64] = t; } }
        __syncthreads();
        { const int a = f_tid, row = blk * 128 + (a >> 2); const int e = topi_g[(size_t)blk * 512 + a]; const int slot = BASE[e] + PRE[e] + pos_g[(size_t)blk * 512 + a];
            list[slot] = row * 4 + (a & 3); gslot[slot] = gate_g[(size_t)blk * 512 + a];
            PART[a] = slot; }
        __syncthreads();
        for (int a0 = F.wave * 8; a0 < 512; a0 += NWAVES * 8) { u32x4 v[8]; int sl[8];
#pragma unroll
            for (int q = 0; q < 8; ++q) { const int a = a0 + q; sl[q] = PART[a]; v[q] = ((const GAS u32x4*)(H2 + (size_t)(blk * 128 + (a >> 2)) * DM))[f_lane]; }
#pragma unroll
            for (int q = 0; q < 8; ++q) ((GAS u32x4*)(XS + (size_t)sl[q] * DM))[f_lane] = v[q]; }
        if (blk < NEXP) { const int e = blk, lo = BASE[e] + TOT[e], hi = BASE[e] + ((TOT[e] + 255) & ~255);
            for (int sl = lo + F.wave; sl < hi; sl += NWAVES) { if (f_lane == 0) { list[sl] = -1; gslot[sl] = 0.f; }
                ((GAS u32x4*)(XS + (size_t)sl * DM))[f_lane] = (u32x4){0u, 0u, 0u, 0u}; } }
    }
}

template <int NPN> struct SchedMoE {
    int G, c, nT; const char* A; const char* W; size_t wstride; const LAS unsigned char* tileE;
    __device__ __forceinline__ bool next(int i, g8::Unit& u) const {
        const int L = i * G + c, xcd = L & 7, j = L >> 3, T = (j / NPN) * 8 + xcd, pn = j % NPN;
        if (T >= nT) return false;
        const int e = tileE[T];
        u.pm = T; u.pn = pn; u.kind = i; u.ex = e; u.a = A + (size_t)T * 256 * DM; u.b = W + (size_t)e * wstride + (size_t)pn * 256 * DM; return true;
    }
};
struct EpiSwiGLU {
    unsigned char* ACT; const float* b1;
    __device__ __forceinline__ void operator()(f32x4 (&acc)[2][2][4][2], const g8::Unit& u, int wr, int wc, int fr, int fq) const {
        asm volatile("" : "+v"(fr), "+v"(fq));
        const int j0 = u.pn * 128 + wc * 32 + 8 * fq; const float* bp = b1 + (size_t)u.ex * 2 * DM + j0;
        f32x4 bg[2], bl[2];
#pragma unroll
        for (int n = 0; n < 2; ++n) { bg[n] = *(const f32x4*)(bp + 4 * n); bl[n] = *(const f32x4*)(bp + DM + 4 * n); }
#pragma unroll
        for (int ai = 0; ai < 2; ++ai)
#pragma unroll
            for (int m = 0; m < 4; ++m) { const size_t slot = (size_t)u.pm * 256 + ai * 128 + wr * 64 + m * 16 + fr; float o[8];
#pragma unroll
                for (int n = 0; n < 2; ++n) { const f32x4 g4 = acc[ai][0][m][n] * (1.f / WSCALE) + bg[n], l4 = acc[ai][1][m][n] * (1.f / WSCALE) + bl[n];
#pragma unroll
                    for (int e = 0; e < 4; ++e) { const float g = fminf(g4[e], 7.f), l = __builtin_amdgcn_fmed3f(l4[e], -7.f, 7.f);
                        const float ex = __builtin_amdgcn_exp2f(g * (-1.702f * 1.4426950408889634f)); const float glu = g * __builtin_amdgcn_rcpf(1.f + ex);
                        o[4 * n + e] = fmaf(l, glu, glu); } }
                u32x2 w; w.x = pk4_fp8(o[0], o[1], o[2], o[3]); w.y = pk4_fp8(o[4], o[5], o[6], o[7]);
                *(u32x2*)(ACT + slot * DM + j0) = w; }
    }
};
struct EpiDown {
    unsigned char* EO; const float* b2; const LAS int* LL; int G, c;
    __device__ __forceinline__ void operator()(f32x4 (&acc)[2][2][4][2], const g8::Unit& u, int wr, int wc, int fr, int fq) const {
        asm volatile("" : "+v"(fr), "+v"(fq));
        const int c0 = u.pn * 256 + wc * 64 + 16 * fq; const float* bp = b2 + (size_t)u.ex * DM + c0;
        f32x4 bb[2][2];
#pragma unroll
        for (int bj = 0; bj < 2; ++bj)
#pragma unroll
            for (int n = 0; n < 2; ++n) bb[bj][n] = *(const f32x4*)(bp + bj * 8 + 4 * n);
        const LAS int* L = LL + u.kind * 512;
        int li[8]; float gt[8];
#pragma unroll
        for (int q = 0; q < 8; ++q) { const int rl = (q >> 2) * 128 + wr * 64 + (q & 3) * 16 + fr; li[q] = L[rl]; gt[q] = __int_as_float(L[256 + rl]) * (1.f / WSCALE); }
#pragma unroll
        for (int ai = 0; ai < 2; ++ai)
#pragma unroll
            for (int m = 0; m < 4; ++m) { const int l = li[ai * 4 + m]; const float g = gt[ai * 4 + m];
                unsigned char* dst = EO + ((size_t)(l & 3) * MROWS + (l >> 2)) * DM + c0;
                u32x4 w;
                { const f32x4 v0 = acc[ai][0][m][0] * g + bb[0][0] * (g * WSCALE), v1 = acc[ai][0][m][1] * g + bb[0][1] * (g * WSCALE);
                  w.x = pk4_fp8(v0[0] * EOSCALE, v0[1] * EOSCALE, v0[2] * EOSCALE, v0[3] * EOSCALE); w.y = pk4_fp8(v1[0] * EOSCALE, v1[1] * EOSCALE, v1[2] * EOSCALE, v1[3] * EOSCALE); }
                { const f32x4 v0 = acc[ai][1][m][0] * g + bb[1][0] * (g * WSCALE), v1 = acc[ai][1][m][1] * g + bb[1][1] * (g * WSCALE);
                  w.z = pk4_fp8(v0[0] * EOSCALE, v0[1] * EOSCALE, v0[2] * EOSCALE, v0[3] * EOSCALE); w.w = pk4_fp8(v1[0] * EOSCALE, v1[1] * EOSCALE, v1[2] * EOSCALE, v1[3] * EOSCALE); }
                if (l >= 0) *(u32x4*)dst = w; }
    }
};
__device__ __forceinline__ const LAS unsigned char* moe_tiles(Frame& F, int& nT) {
    FT_DECL;
    LAS unsigned char* TE = (LAS unsigned char*)(F.lds + RING_BYTES); const int* meta = WSP(int, WS_ROUTE + RT_META);
    __syncthreads();
    nT = meta[64]; if (nT > MAXTILE) nT = MAXTILE;
    for (int i = f_tid; i < MAXTILE; i += 512) TE[i] = (unsigned char)((i < nT) ? meta[128 + i] : 0);
    __syncthreads();
    return (const LAS unsigned char*)TE;
}

__device__ __forceinline__ void p10_combine(Frame& F) {
    FT_DECL;
    const float* mod = WSP(float, WS_SMALL + SM_MOD); const unsigned char* EO = WSP(unsigned char, WS_EO);
    const size_t gt = (size_t)F.vcu * 512 + f_tid, NTH = (size_t)F.G * 512;
    float pd = 0.f, pa = 0.f;
    if (MK_PROBE_A != -2) { const unsigned long long* st = (const unsigned long long*)(F.ws + WS_CTL + 8192);
        pd = (MK_PROBE_A < 0) ? 0.1f : (float)(st[MK_PA1] - st[MK_PA0]) * MK_PSA; pa = (float)(st[MK_PB1] - st[MK_PB0]) * MK_PSB; }
    constexpr int U = 4;
    for (size_t i0 = gt; i0 < (size_t)MROWS * 128; i0 += NTH * U) {
        u32x2 ev[U][4]; f32x4 xv[U][2], gv[U][2];
#pragma unroll
        for (int u = 0; u < U; ++u) { const size_t i = i0 + (size_t)u * NTH; const size_t row = i >> 7; const int c0 = (int)(i & 127) * 8;
            const float* g2 = mod + (size_t)(row >> 12) * (NMOD * DM) + 5 * DM + c0; const bf16_t* op = WSP(bf16_t, WS_XN) + row * DM + c0;
#pragma unroll
            for (int k = 0; k < 4; ++k) ev[u][k] = __builtin_nontemporal_load((const u32x2*)(EO + ((size_t)k * MROWS + row) * DM + c0));
            { const u32x4 xb = *(const u32x4*)op; xv[u][0] = (f32x4){__uint_as_float(xb.x << 16), __uint_as_float(xb.x & 0xffff0000u), __uint_as_float(xb.y << 16), __uint_as_float(xb.y & 0xffff0000u)};
              xv[u][1] = (f32x4){__uint_as_float(xb.z << 16), __uint_as_float(xb.z & 0xffff0000u), __uint_as_float(xb.w << 16), __uint_as_float(xb.w & 0xffff0000u)}; }
            gv[u][0] = *(const f32x4*)g2; gv[u][1] = *(const f32x4*)(g2 + 4); }
#pragma unroll
        for (int u = 0; u < U; ++u) { const size_t i = i0 + (size_t)u * NTH; const size_t row = i >> 7; const int c0 = (int)(i & 127) * 8;
            float s[8];
#pragma unroll
            for (int e = 0; e < 8; ++e) s[e] = 0.f;
#pragma unroll
            for (int k = 0; k < 4; ++k) { const u32x2 v = ev[u][k];
                const f32x2 a = __builtin_amdgcn_cvt_pk_f32_fp8((int)v.x, false), b = __builtin_amdgcn_cvt_pk_f32_fp8((int)v.x, true), c = __builtin_amdgcn_cvt_pk_f32_fp8((int)v.y, false), d = __builtin_amdgcn_cvt_pk_f32_fp8((int)v.y, true);
                s[0] += a.x; s[1] += a.y; s[2] += b.x; s[3] += b.y; s[4] += c.x; s[5] += c.y; s[6] += d.x; s[7] += d.y; }
#pragma unroll
            for (int e = 0; e < 8; ++e) s[e] *= (1.f / EOSCALE);
            f32x4 o0 = xv[u][0] + gv[u][0] * (f32x4){s[0], s[1], s[2], s[3]}, o1 = xv[u][1] + gv[u][1] * (f32x4){s[4], s[5], s[6], s[7]};
            if (MK_PROBE_A != -2) { o0 += pd; o1 += pd; if (i == 0) o0[0] += pa; }
            float* op = F.out + row * DM + c0;
            __builtin_nontemporal_store(o0, (f32x4*)op); __builtin_nontemporal_store(o1, (f32x4*)(op + 4)); }
    }
}

struct Args { const float* in[34]; float* out; unsigned char* ws; int ph_lo, ph_hi; };
constexpr int N_PHASES = 11;

__global__ void __launch_bounds__(512, 2) mega(Args args) {
    extern __shared__ __attribute__((aligned(16))) unsigned char lds[];
    Frame F;
    F.lds = (LAS unsigned char*)lds;
    F.MISC = (volatile LAS unsigned*)(F.lds + LDSCTL_OFF);
    F.wave = __builtin_amdgcn_readfirstlane(threadIdx.x >> 6);
    FT_DECL;
    F.G = gridDim.x; { const int bx = blockIdx.x; F.vcu = (F.G % 8 == 0) ? (bx % 8) * (F.G / 8) + bx / 8 : bx; }
    F.in = (kin_t)__builtin_amdgcn_kernarg_segment_ptr();
    F.out = args.out; F.ws = args.ws;
    F.ctl = (gu32*)(args.ws + WS_CTL);
    for (int u = f_tid; u < (LDS_BYTES - LDSCTL_OFF) / 4; u += NWAVES * 64) ((LAS unsigned*)(F.lds + LDSCTL_OFF))[u] = 0u;
    __syncthreads();
    const int lo = args.ph_lo, hi = args.ph_hi;
    XcdBarrier bar; bar.bar = (unsigned*)(F.ctl + CW_BAR); bar.x = 0; bar.st = nullptr;
    if (hi - lo > 1) bar = xcd_barrier_post((unsigned*)(F.ctl + CW_BAR), F.MISC + 8, f_tid == 0);
#define IN(k) (lo <= (k) && (k) < hi)
    unsigned long long* stamps = (unsigned long long*)(args.ws + WS_CTL + 8192);
#define STAMP(k) do { if (MK_PROBE_A != -2 && blockIdx.x == 0 && f_tid == 0) stamps[(k)] = __builtin_amdgcn_s_memrealtime(); } while (0)
    STAMP(0);
#define SEAM(k) do { if (IN(k) && IN((k) + 1)) xcd_barrier(bar, F.wave == 0 && lane_id() == 0); } while (0)

    if (IN(0)) { p0_prologue(F); } SEAM(0); STAMP(1);
    if (IN(1)) { p1_norm1(F); } SEAM(1); STAMP(2);
    if (IN(2)) {
        SchedInProj S{F.G, (int)blockIdx.x, (const char*)WSP(bf16_t, WS_H), (const char*)WSP(bf16_t, WS_WIN)};
        EpiInProj E{WSP(unsigned char, WS_Q), WSP(unsigned char, WS_K), WSP(unsigned char, WS_V), WSP(bf16_t, WS_UT), F.in[9], F.in[10], WSP(float, WS_SMALL + SM_ROPE)};
        g8::gemm_phase<false>(F.lds, DM, S, E, F.wave, lane_id());
    } SEAM(2); STAMP(3);
    if (IN(3)) { p3_attention8(F); STAMP(12); p3_hyena(F); } SEAM(3); STAMP(4);
    if (IN(4)) { p4_hynorm(F); } SEAM(4); STAMP(5);
    if (IN(5)) {
        SchedStatic S{F.G, (int)blockIdx.x, MROWS / 256, DM / 256, (const char*)WSP(bf16_t, WS_MIX), (const char*)WSP(bf16_t, WS_WOUT)};
        EpiOutProj E{F.in[0], WSP(bf16_t, WS_XN), WSP(float, WS_SMALL + SM_MOD)};
        g8::gemm_phase<false>(F.lds, DM, S, E, F.wave, lane_id());
    } SEAM(5); STAMP(6);
    if (IN(6)) { p6_router_mfma(F); } SEAM(6); STAMP(7);
    if (IN(7)) { p7_scatter(F); } SEAM(7); STAMP(8);
    if (IN(8)) {
        int nT; const LAS unsigned char* TE = moe_tiles(F, nT);
        SchedMoE<8> S{F.G, (int)blockIdx.x, nT, (const char*)WSP(char, WS_XS), (const char*)WSP(char, WS_W1), (size_t)2 * DM * DM, TE};
        EpiSwiGLU E{WSP(unsigned char, WS_ACT), F.in[31]};
        g8::gemm_phase<true>(F.lds, DM, S, E, F.wave, lane_id());
    } SEAM(8); STAMP(9);
    if (IN(9)) {
        int nT; const LAS unsigned char* TE = moe_tiles(F, nT);
        SchedMoE<4> S{F.G, (int)blockIdx.x, nT, (const char*)WSP(char, WS_ACT), (const char*)WSP(char, WS_W2), (size_t)DM * DM, TE};
        LAS int* LL = (LAS int*)(F.lds + RING_BYTES + 1024);
        static_assert(RING_BYTES + 1024 + 9 * 2048 <= LDSCTL_OFF, "LDS map");
        { const int* list = WSP(int, WS_ROUTE + RT_LIST); const float* gslot = WSP(float, WS_ROUTE + RT_GSLOT);
            const int t9 = F.wave * 64 + lane_id();
            g8::Unit u; for (int i = 0; i < 9 && S.next(i, u); ++i) { const int t = t9 & 255; const size_t slot = (size_t)u.pm * 256 + t;
                LL[i * 512 + (t9 >> 8) * 256 + t] = (t9 < 256) ? list[slot] : __float_as_int(gslot[slot]); }
            __syncthreads(); }
        EpiDown E{WSP(unsigned char, WS_EO), F.in[33], LL, F.G, (int)blockIdx.x};
        g8::gemm_phase<true>(F.lds, DM, S, E, F.wave, lane_id());
    } SEAM(9); STAMP(10);
    if (IN(10)) { p10_combine(F); }
#undef IN
#undef SEAM
}

extern "C" void kernel_launch(void* const* d_in, const int* in_sizes, int n_in, void* d_out, int out_size, void* d_ws, size_t ws_size, hipStream_t stream) {
    static int grid = 0;
    if (grid == 0) {
        if (n_in != 34 || out_size != MROWS * DM || ws_size < WS_END) { fprintf(stderr, "kernel_launch: unexpected shapes: n_in %d out %d ws %zu (need %zu)\n", n_in, out_size, ws_size, (size_t)WS_END); grid = -1; return; }
        int dev = 0, cus = 0, per_cu = 0;
        if (hipGetDevice(&dev) != hipSuccess || hipDeviceGetAttribute(&cus, hipDeviceAttributeMultiprocessorCount, dev) != hipSuccess) { grid = -1; return; }
        if (hipFuncSetAttribute((const void*)mega, hipFuncAttributeMaxDynamicSharedMemorySize, LDS_BYTES) != hipSuccess) { fprintf(stderr, "kernel_launch: hipFuncSetAttribute failed\n"); grid = -1; return; }
        if (hipOccupancyMaxActiveBlocksPerMultiprocessor(&per_cu, (const void*)mega, NWAVES * 64, LDS_BYTES) != hipSuccess || per_cu < 1) { fprintf(stderr, "kernel_launch: occupancy query says %d\n", per_cu); per_cu = 1; }
        (void)hipGetLastError();
        grid = cus;
    }
    if (grid < 0) return;
    (void)hipMemsetAsync((char*)d_ws + WS_CTL, 0, CTL_ZERO_BYTES, stream);
    Args a{};
    for (int i = 0; i < 34; ++i) a.in[i] = (const float*)d_in[i];
    a.out = (float*)d_out; a.ws = (unsigned char*)d_ws;
    constexpr int LAST = MK_LAST_PHASE + 1;
    if (MK_N_LAUNCHES == 1) { a.ph_lo = 0; a.ph_hi = LAST; hipLaunchKernelGGL(mega, dim3(grid), dim3(NWAVES * 64), LDS_BYTES, stream, a); }
    else for (int p = 0; p < LAST; ++p) { a.ph_lo = p; a.ph_hi = p + 1; hipLaunchKernelGGL(mega, dim3(grid), dim3(NWAVES * 64), LDS_BYTES, stream, a); }
    const hipError_t le = hipPeekAtLastError();
    if (le != hipSuccess) fprintf(stderr, "kernel_launch: launch failed: %s\n", hipGetErrorName(le));
}
```

```cpp
#include <hip/hip_runtime.h>
#include <hip/hip_bf16.h>
#include <cstdio>
#include <cstdint>

#ifndef MK_N_LAUNCHES
#define MK_N_LAUNCHES 1
#endif
#ifndef MK_LAST_PHASE
#define MK_LAST_PHASE 10
#endif

#define GAS __attribute__((address_space(1)))
#define LAS __attribute__((address_space(3)))
typedef unsigned short bf16_t;
typedef short bf16x8 __attribute__((ext_vector_type(8)));
typedef short s16x4 __attribute__((ext_vector_type(4)));
typedef float f32x2 __attribute__((ext_vector_type(2)));
typedef float f32x4 __attribute__((ext_vector_type(4)));
typedef float f32x16 __attribute__((ext_vector_type(16)));
typedef unsigned u32x2 __attribute__((ext_vector_type(2)));
typedef unsigned u32x4 __attribute__((ext_vector_type(4)));
typedef GAS unsigned gu32;

constexpr int NB = 8, SEQ = 4096, DM = 1024, MROWS = NB * SEQ, CTXL = 256, MCTX = NB * CTXL, MTOT = MROWS + MCTX;
constexpr int KVL = CTXL + SEQ;
constexpr int NHEAD = 4, QKW = 512;
constexpr int HYW = 512, HYC = 1536, INC = 3072, QKVC = 1536;
constexpr int NEXP = 32, TOPK = 4, NMOD = 6;
constexpr float EPS = 1e-6f;
constexpr float LAM_INIT = 0.2f;
constexpr float QSCALE = 0.125f * 1.4426950408889634f;

constexpr size_t MiB = 1u << 20;
constexpr size_t WS_CTL = 0, CTL_ZERO_BYTES = 64 * 1024;
constexpr size_t WS_SMALL = 1 * MiB;
constexpr size_t WS_WIN = 2 * MiB;
constexpr size_t WS_WOUT = 8 * MiB;
constexpr size_t WS_W1 = 10 * MiB;
constexpr size_t WS_W2 = 138 * MiB;
constexpr size_t WS_H = 202 * MiB;
constexpr size_t WS_Q = 270 * MiB;
constexpr size_t WS_K = 302 * MiB;
constexpr size_t WS_V = 336 * MiB;
constexpr size_t WS_UT = 370 * MiB;
constexpr size_t WS_FILT = 466 * MiB;
constexpr size_t WS_Z2T = 498 * MiB;
constexpr size_t WS_MIX = 530 * MiB;
constexpr size_t WS_ROUTE = 594 * MiB;
constexpr size_t WS_ACT = 270 * MiB;
constexpr size_t WS_EO = 598 * MiB;
constexpr size_t WS_XN = 870 * MiB;
constexpr size_t WS_END = 998 * MiB;
constexpr size_t SM_MOD = 0;
constexpr size_t SM_SCAL = 256 * 1024;
constexpr size_t SM_ROPE = 260 * 1024;
constexpr int CW_BAR = 4096;

constexpr int RING_BYTES = 131072;
constexpr int LDSCTL_OFF = 151552;
constexpr int LDS_BYTES = 152576;
constexpr int NWAVES = 8;

#define LDS_WAIT() asm volatile("s_waitcnt lgkmcnt(0)" ::: "memory")
#define VM_WAIT() asm volatile("s_waitcnt vmcnt(0)" ::: "memory")
#define RLX_AGENT __ATOMIC_RELAXED, __HIP_MEMORY_SCOPE_AGENT

__device__ __forceinline__ unsigned cvt_pk_bf16(float lo, float hi) { unsigned r; asm volatile("v_cvt_pk_bf16_f32 %0, %1, %2" : "=v"(r) : "v"(lo), "v"(hi)); return r; }
__device__ __forceinline__ float bf2f(bf16_t v) { return __uint_as_float(((unsigned)v) << 16); }
__device__ __forceinline__ float wave_sum(float v) {
#pragma unroll
    for (int o = 1; o < 64; o <<= 1) v += __shfl_xor(v, o);
    return v;
}

#define XB_TMO      128
#define XB_XCNT(j)  (256  + 64 * (j))
#define XB_XSUB(j)  (1280 + 64 * (j))
#define XB_XGEN(j)  (2304 + 64 * (j))
#define XB_TOP      3328
#define XB_TOPGEN   3392
#define XCD_BAR_WORDS 3456
#define XB_SPIN_CAP (1u << 22)
__device__ __forceinline__ unsigned xb_ld(unsigned* p)              { return __hip_atomic_load(p, __ATOMIC_RELAXED, __HIP_MEMORY_SCOPE_AGENT); }
__device__ __forceinline__ unsigned xb_add(unsigned* p, unsigned v) { return __hip_atomic_fetch_add(p, v, __ATOMIC_RELAXED, __HIP_MEMORY_SCOPE_AGENT); }
__device__ __forceinline__ unsigned xb_xcc_id() { return (unsigned)__builtin_amdgcn_s_getreg((3 << 11) | 20) & 0xFu; }
#define XB_SPIN(cond, bar) do { unsigned _sp = 0; while (cond) { __builtin_amdgcn_s_sleep(1); \
    if ((++_sp & 255u) == 0u) { if (xb_ld(&(bar)[XB_TMO])) break; if (_sp > XB_SPIN_CAP) { atomicAdd(&(bar)[XB_TMO], 1u); break; } } } } while (0)
struct XcdBarrier { unsigned* bar; unsigned x; volatile LAS unsigned* st; };
__device__ __forceinline__ XcdBarrier xcd_barrier_post(unsigned* bar, volatile LAS unsigned* st, bool leader) {
    XcdBarrier b; b.bar = bar; b.x = xb_xcc_id(); b.st = st;
    if (leader) (void)xb_add(&bar[XB_XCNT(b.x)], 1u);
    return b;
}
__device__ __forceinline__ void xcd_barrier_complete(unsigned* bar, unsigned x, unsigned& nloc, unsigned& nx) {
    const unsigned G = gridDim.x * gridDim.y * gridDim.z;
    unsigned sum, cnt, mine, sp = 0u;
    for (;;) {
        sum = 0u; cnt = 0u; mine = 0u;
#pragma unroll
        for (unsigned j = 0; j < 16; ++j) { const unsigned c = xb_ld(&bar[XB_XCNT(j)]); sum += c; cnt += (c > 0u) ? 1u : 0u; mine = (j == x) ? c : mine; }
        if (sum == G) break;
        __builtin_amdgcn_s_sleep(1);
        if ((++sp & 255u) == 0u) { if (xb_ld(&bar[XB_TMO])) break; if (sp > XB_SPIN_CAP) { atomicAdd(&bar[XB_TMO], 1u); break; } }
    }
    nloc = mine > 0u ? mine : 1u; nx = cnt > 0u ? cnt : 1u;
}
__device__ __forceinline__ void xcd_barrier(const XcdBarrier& b, bool leader) {
    asm volatile("s_waitcnt vmcnt(0)" ::: "memory");
    __syncthreads();
    if (leader) {
        unsigned* bar = b.bar;
        __builtin_amdgcn_s_waitcnt(0);
        unsigned nloc = b.st[0], nx = b.st[1];
        if (nloc == 0u) { xcd_barrier_complete(bar, b.x, nloc, nx); b.st[0] = nloc; b.st[1] = nx; }
        const unsigned old = xb_add(&bar[XB_XSUB(b.x)], 1u);
        const unsigned gen = old / nloc;
        if (old + 1u == (gen + 1u) * nloc) {
            __builtin_amdgcn_fence(__ATOMIC_RELEASE, "agent");
            asm volatile("s_waitcnt vmcnt(0)" ::: "memory");
            const unsigned og = xb_add(&bar[XB_TOP], 1u);
            const unsigned tg = og / nx;
            if (og + 1u == (tg + 1u) * nx) xb_add(&bar[XB_TOPGEN], 1u);
            else XB_SPIN(xb_ld(&bar[XB_TOPGEN]) == tg, bar);
            __builtin_amdgcn_fence(__ATOMIC_ACQUIRE, "agent");
            xb_add(&bar[XB_XGEN(b.x)], 1u);
            asm volatile("s_waitcnt vmcnt(0)" ::: "memory");
        } else {
            XB_SPIN(xb_ld(&bar[XB_XGEN(b.x)]) == gen, bar);
            __builtin_amdgcn_fence(__ATOMIC_ACQUIRE, "agent");
            asm volatile("s_waitcnt vmcnt(0)" ::: "memory");
        }
    }
    __syncthreads();
}

namespace g8 {
constexpr int BM = 256, BK = 64, HALF = 128, HTB = HALF * BK * 2, STAGE_BYTES = 8 * HTB, NXCD = 8, WGM = 8;
__host__ __device__ __forceinline__ int lds_byte(int r, int c) { const int st = (r >> 4) * 2 + (c >> 5), rr = r & 15, cc = c & 31, ob = rr * 64 + cc * 2; return st * 1024 + (ob ^ (((ob >> 9) & 1) << 5)); }
__host__ __device__ __forceinline__ void stage_rc(int b, int& R, int& C) { const int st = b / 1024, sb = b % 1024, swz = sb ^ (((sb >> 9) & 1) << 5); R = (st >> 1) * 16 + swz / 64; C = (st & 1) * 32 + (swz % 64) / 2; }
__host__ __device__ __forceinline__ int perm32(int rho) { const int n = rho >> 4, i = rho & 15; return 8 * (i >> 2) + 4 * n + (i & 3); }

struct Unit { const char* a; const char* b; int pm, pn, kind, ex; };

__device__ __forceinline__ void tile_of(int L, int nM, int nN, int& pm, int& pn) {
    const int nwg = nM * nN; int wgid = L;
    { const int q = nwg / NXCD, r = nwg % NXCD, xcd = wgid % NXCD, off = wgid / NXCD; wgid = (xcd < r ? xcd * (q + 1) : r * (q + 1) + (xcd - r) * q) + off; }
    const int nig = WGM * nN, gid = wgid / nig, fm = gid * WGM, gsz = (nM - fm) < WGM ? (nM - fm) : WGM;
    pm = fm + ((wgid % nig) % gsz); pn = (wgid % nig) / gsz;
}

typedef int i32x8 __attribute__((ext_vector_type(8)));
template <bool FP8, class Epi, class Sched>
__device__ __forceinline__ void gemm_phase(LAS unsigned char* lds, const int K, const Sched& S, const Epi& E, const int wid, const int lane) {
    const int tid = wid * 64 + lane, wr = wid >> 2, wc = wid & 3, fr = lane & 15, fq = lane >> 4;
    const int nt = FP8 ? K / 128 : K / BK;
    const int RP = FP8 ? K : 2 * K;
    unsigned voffA[2], voffB[2];
#pragma unroll
    for (int i = 0; i < 2; ++i) { int R, C; stage_rc(tid * 16 + i * 8192, R, C); const int Rb = (R & ~31) + perm32(R & 31);
        voffA[i] = (unsigned)(R * RP + C * 2); voffB[i] = (unsigned)(Rb * RP + C * 2); }
    const size_t kstep = (size_t)(BK * 2);
    const size_t hstep = (size_t)HALF * RP;
    const unsigned ldsw = (unsigned)wid * 1024u;
    const int aoff = lds_byte(wr * 64 + fr, FP8 ? fq * 16 : fq * 8), boff = lds_byte(wc * 32 + fr, FP8 ? fq * 16 : fq * 8);
    constexpr int KOFF = FP8 ? 16 : 1024;
#define PG8_SA(b, h) (((b) * 2 + (h)) * HTB)
#define PG8_SB(b, h) ((4 + (b) * 2 + (h)) * HTB)
#define PG8_STAGE(bufoff, gbase, voff) do { _Pragma("unroll") for (int _i = 0; _i < 2; ++_i) \
        __builtin_amdgcn_global_load_lds((const unsigned*)((const char*)(gbase) + (voff)[_i]), (LAS unsigned*)(lds + (bufoff) + ldsw + _i * 8192), 16, 0, 0); } while (0)
#define PG8_LD32(p) __builtin_bit_cast(i32x8, __builtin_shufflevector(*(const LAS u32x4*)(p), *(const LAS u32x4*)((p) + 16), 0, 1, 2, 3, 4, 5, 6, 7))
#define PG8_LDA8(dst, b, h) do { _Pragma("unroll") for (int m = 0; m < 4; ++m) dst[m] = PG8_LD32(lds + PG8_SA(b, h) + aoff + m * 2048); } while (0)
#define PG8_LDB8(dst, b, h) do { _Pragma("unroll") for (int n = 0; n < 2; ++n) dst[n] = PG8_LD32(lds + PG8_SB(b, h) + boff + n * 2048); } while (0)
#define PG8_LDA(dst, b, h) do { _Pragma("unroll") for (int m = 0; m < 4; ++m) _Pragma("unroll") for (int k = 0; k < 2; ++k) dst[m][k] = *(const LAS bf16x8*)(lds + PG8_SA(b, h) + aoff + m * 2048 + k * KOFF); } while (0)
#define PG8_LDB(dst, b, h) do { _Pragma("unroll") for (int n = 0; n < 2; ++n) _Pragma("unroll") for (int k = 0; k < 2; ++k) dst[n][k] = *(const LAS bf16x8*)(lds + PG8_SB(b, h) + boff + n * 2048 + k * KOFF); } while (0)
#define PG8_MMA(ai, bj, At, Bt) do { __builtin_amdgcn_s_setprio(1); _Pragma("unroll") for (int m = 0; m < 4; ++m) _Pragma("unroll") for (int n = 0; n < 2; ++n) _Pragma("unroll") for (int k = 0; k < 2; ++k) \
        acc[ai][bj][m][n] = __builtin_amdgcn_mfma_f32_16x16x32_bf16(Bt[n][k], At[m][k], acc[ai][bj][m][n], 0, 0, 0); __builtin_amdgcn_s_setprio(0); } while (0)
#define PG8_MMA8(ai, bj, At, Bt) do { __builtin_amdgcn_s_setprio(1); _Pragma("unroll") for (int m = 0; m < 4; ++m) _Pragma("unroll") for (int n = 0; n < 2; ++n) \
        asm volatile("v_mfma_scale_f32_16x16x128_f8f6f4 %0, %1, %2, %0, %3, %3 op_sel_hi:[0,0,0]" : "+v"(acc[ai][bj][m][n]) : "v"(Bt[n]), "v"(At[m]), "v"(one_scale)); __builtin_amdgcn_s_setprio(0); } while (0)
#define PG8_WAIT_V(n) asm volatile("s_waitcnt vmcnt(" #n ")" ::: "memory")
#define PG8_WAIT_L(n) asm volatile("s_waitcnt lgkmcnt(" #n ")" ::: "memory")
#define PG8_BAR __builtin_amdgcn_s_barrier()
#define PG8_SCHED __builtin_amdgcn_sched_barrier(0)
    Unit cur, nxt; int ui = 0;
    if (!S.next(0, cur)) return;
    f32x4 acc[2][2][4][2];
#pragma unroll
    for (int a = 0; a < 2; ++a)
#pragma unroll
        for (int b = 0; b < 2; ++b)
#pragma unroll
            for (int m = 0; m < 4; ++m)
#pragma unroll
                for (int n = 0; n < 2; ++n) acc[a][b][m][n] = (f32x4){0.f, 0.f, 0.f, 0.f};
    bf16x8 At[4][2], B0[2][2], B1[2][2];
    i32x8 At8[4], B08[2], B18[2];
    const unsigned one_scale = 0x7f7f7f7fu;
    const char* cA = cur.a; const char* cB = cur.b;
    PG8_STAGE(PG8_SB(0, 0), cB, voffB); PG8_STAGE(PG8_SB(0, 1), cB + hstep, voffB); PG8_STAGE(PG8_SA(0, 0), cA, voffA); PG8_STAGE(PG8_SA(0, 1), cA + hstep, voffA);
    if (wr == 1) PG8_BAR;
    PG8_WAIT_V(2); PG8_BAR;
    PG8_STAGE(PG8_SB(1, 0), cB + kstep, voffB); PG8_STAGE(PG8_SA(1, 0), cA + kstep, voffA); PG8_STAGE(PG8_SB(1, 1), cB + hstep + kstep, voffB);
    PG8_WAIT_V(6); PG8_BAR;
    for (;;) {
        const bool has_next = S.next(ui + 1, nxt);
        const char* nA = has_next ? nxt.a : cA; const char* nB = has_next ? nxt.b : cB;
#pragma unroll 1
        for (int t = 0; t < nt; t += 2) {
            const bool last = (t == nt - 2);
            const char* a1 = cA + (size_t)(t + 1) * kstep;
            const char* a2 = last ? nA : cA + (size_t)(t + 2) * kstep; const char* b2 = last ? nB : cB + (size_t)(t + 2) * kstep;
            const char* a3 = a2 + kstep; const char* b3 = b2 + kstep;
            if constexpr (FP8) {
            PG8_LDB8(B08, 0, 0); PG8_LDB8(B18, 0, 1); PG8_SCHED; PG8_LDA8(At8, 0, 0); PG8_STAGE(PG8_SA(1, 1), a1 + hstep, voffA);
            PG8_WAIT_V(8); PG8_WAIT_L(0); PG8_BAR; PG8_MMA8(0, 0, At8, B08); PG8_MMA8(0, 1, At8, B18); PG8_BAR; PG8_SCHED;
            PG8_LDA8(At8, 0, 1); PG8_STAGE(PG8_SB(0, 0), b2, voffB); PG8_STAGE(PG8_SB(0, 1), b2 + hstep, voffB); PG8_STAGE(PG8_SA(0, 0), a2, voffA);
            PG8_WAIT_V(8); PG8_WAIT_L(0); PG8_BAR; PG8_MMA8(1, 0, At8, B08); PG8_MMA8(1, 1, At8, B18); PG8_BAR; PG8_SCHED;
            PG8_LDB8(B08, 1, 0); PG8_LDB8(B18, 1, 1); PG8_SCHED; PG8_LDA8(At8, 1, 0); PG8_STAGE(PG8_SA(0, 1), a2 + hstep, voffA);
            PG8_WAIT_V(8); PG8_WAIT_L(0); PG8_BAR; PG8_MMA8(0, 0, At8, B08); PG8_MMA8(0, 1, At8, B18); PG8_BAR; PG8_SCHED;
            PG8_LDA8(At8, 1, 1); PG8_STAGE(PG8_SB(1, 0), b3, voffB); PG8_STAGE(PG8_SB(1, 1), b3 + hstep, voffB); PG8_STAGE(PG8_SA(1, 0), a3, voffA);
            PG8_WAIT_V(8); PG8_WAIT_L(0); PG8_BAR; PG8_MMA8(1, 0, At8, B08); PG8_MMA8(1, 1, At8, B18); PG8_BAR; PG8_SCHED;
            } else {
            PG8_LDB(B0, 0, 0); PG8_LDB(B1, 0, 1); PG8_SCHED; PG8_LDA(At, 0, 0); PG8_STAGE(PG8_SA(1, 1), a1 + hstep, voffA);
            PG8_WAIT_V(8); PG8_WAIT_L(0); PG8_BAR; PG8_MMA(0, 0, At, B0); PG8_MMA(0, 1, At, B1); PG8_BAR; PG8_SCHED;
            PG8_LDA(At, 0, 1); PG8_STAGE(PG8_SB(0, 0), b2, voffB); PG8_STAGE(PG8_SB(0, 1), b2 + hstep, voffB); PG8_STAGE(PG8_SA(0, 0), a2, voffA);
            PG8_WAIT_V(8); PG8_WAIT_L(0); PG8_BAR; PG8_MMA(1, 0, At, B0); PG8_MMA(1, 1, At, B1); PG8_BAR; PG8_SCHED;
            PG8_LDB(B0, 1, 0); PG8_LDB(B1, 1, 1); PG8_SCHED; PG8_LDA(At, 1, 0); PG8_STAGE(PG8_SA(0, 1), a2 + hstep, voffA);
            PG8_WAIT_V(8); PG8_WAIT_L(0); PG8_BAR; PG8_MMA(0, 0, At, B0); PG8_MMA(0, 1, At, B1); PG8_BAR; PG8_SCHED;
            PG8_LDA(At, 1, 1); PG8_STAGE(PG8_SB(1, 0), b3, voffB); PG8_STAGE(PG8_SB(1, 1), b3 + hstep, voffB); PG8_STAGE(PG8_SA(1, 0), a3, voffA);
            PG8_WAIT_V(8); PG8_WAIT_L(0); PG8_BAR; PG8_MMA(1, 0, At, B0); PG8_MMA(1, 1, At, B1); PG8_BAR; PG8_SCHED;
            }
        }
        if (wr == 0) PG8_BAR;
        if constexpr (FP8) asm volatile("s_nop 15\n\ts_nop 15" ::: "memory");
        E(acc, cur, wr, wc, fr, fq);
        if (!has_next) break;
#pragma unroll
        for (int a = 0; a < 2; ++a)
#pragma unroll
            for (int b = 0; b < 2; ++b)
#pragma unroll
                for (int m = 0; m < 4; ++m)
#pragma unroll
                    for (int n = 0; n < 2; ++n) acc[a][b][m][n] = (f32x4){0.f, 0.f, 0.f, 0.f};
        cur = nxt; cA = nA; cB = nB; ++ui;
        if (wr == 1) PG8_BAR;
    }
    PG8_WAIT_V(0);
    PG8_BAR;
#undef PG8_SA
#undef PG8_SB
#undef PG8_STAGE
#undef PG8_LDA
#undef PG8_LDB
#undef PG8_MMA
#undef PG8_MMA8
#undef PG8_LDA8
#undef PG8_LDB8
#undef PG8_LD32
#undef PG8_WAIT_V
#undef PG8_WAIT_L
#undef PG8_BAR
#undef PG8_SCHED
}
}

__device__ __forceinline__ int lane_id() { int l; asm volatile("v_mbcnt_lo_u32_b32 %0, -1, 0\n\tv_mbcnt_hi_u32_b32 %0, -1, %0" : "=v"(l)); return l; }
#define FT_DECL const int f_lane = lane_id(), f_tid = F.wave * 64 + f_lane; (void)f_tid; (void)f_lane
typedef const float* cfp_t;
typedef __attribute__((address_space(4))) cfp_t* kin_t;
struct Frame {
    LAS unsigned char* lds;
    volatile LAS unsigned* MISC;
    gu32* ctl;
    int wave, vcu, G;
    kin_t in;
    float* out;
    unsigned char* ws;
};
#define WSP(T, off) ((T*)(F.ws + (off)))

template <class RowMap>
__device__ __forceinline__ void p0_transpose_item(const float* W, int K, int N, bf16_t* WT, const RowMap& rowmap, const float* kscale, LAS float* scr, int item, int lane) {
    const int nblk = N / 32, kb = item / nblk, nb = item % nblk, k0 = 64 * kb, n0 = 32 * nb;
#pragma unroll 8
    for (int i = 0; i < 32; ++i) { const int kk = 2 * i + (lane >> 5); float v = W[(size_t)(k0 + kk) * N + n0 + (lane & 31)]; if (kscale) v *= kscale[k0 + kk]; scr[kk * 33 + (lane & 31)] = v; }
    LDS_WAIT(); asm volatile("" ::: "memory");
    const int c = lane & 7;
#pragma unroll
    for (int j = 0; j < 4; ++j) { const int n = (lane >> 3) + 8 * j; const LAS float* s = scr + (8 * c) * 33 + n;
        u32x4 o; o.x = cvt_pk_bf16(s[0 * 33], s[1 * 33]); o.y = cvt_pk_bf16(s[2 * 33], s[3 * 33]); o.z = cvt_pk_bf16(s[4 * 33], s[5 * 33]); o.w = cvt_pk_bf16(s[6 * 33], s[7 * 33]);
        *(GAS u32x4*)(WT + (size_t)rowmap(n0 + n) * K + k0 + 8 * c) = o; }
    LDS_WAIT(); asm volatile("" ::: "memory");
}

__device__ __forceinline__ unsigned pk4_fp8(float a, float b, float c, float d) { int r = __builtin_amdgcn_cvt_pk_fp8_f32(a, b, 0, false); r = __builtin_amdgcn_cvt_pk_fp8_f32(c, d, r, true); return (unsigned)r; }
constexpr float EOSCALE = 16.f;
constexpr float WSCALE = 32.f;
template <class RowMap>
__device__ __forceinline__ void p0_transpose_item_f8(const float* W, int K, int N, unsigned char* WT, const RowMap& rowmap, LAS float* scr, int item, int lane) {
    const int nblk = N / 32, kb = item / nblk, nb = item % nblk, k0 = 128 * kb, n0 = 32 * nb;
#pragma unroll
    for (int hh = 0; hh < 2; ++hh) { float v[32];
#pragma unroll
        for (int i = 0; i < 32; ++i) { const int kk = 2 * (32 * hh + i) + (lane >> 5); v[i] = __builtin_nontemporal_load(W + (size_t)(k0 + kk) * N + n0 + (lane & 31)); }
#pragma unroll
        for (int i = 0; i < 32; ++i) { const int kk = 2 * (32 * hh + i) + (lane >> 5); scr[kk * 33 + (lane & 31)] = v[i] * WSCALE; } }
    LDS_WAIT(); asm volatile("" ::: "memory");
    const int c = lane & 7;
#pragma unroll
    for (int j = 0; j < 4; ++j) { const int n = (lane >> 3) + 8 * j; const LAS float* sp = scr + (16 * c) * 33 + n;
        u32x4 o; o.x = pk4_fp8(sp[0 * 33], sp[1 * 33], sp[2 * 33], sp[3 * 33]); o.y = pk4_fp8(sp[4 * 33], sp[5 * 33], sp[6 * 33], sp[7 * 33]);
        o.z = pk4_fp8(sp[8 * 33], sp[9 * 33], sp[10 * 33], sp[11 * 33]); o.w = pk4_fp8(sp[12 * 33], sp[13 * 33], sp[14 * 33], sp[15 * 33]);
        *(GAS u32x4*)(WT + (size_t)rowmap(n0 + n) * K + k0 + 16 * c) = o; }
    LDS_WAIT(); asm volatile("" ::: "memory");
}
struct MapW2 { __device__ __forceinline__ int operator()(int l) const { const int t = l & ~255, r = l & 255, wc = r >> 6, fq = (r >> 4) & 3, bj = (r >> 3) & 1, low = r & 7; return t + 128 * bj + 32 * wc + 8 * fq + low; } };
struct MapIdent { int off; __device__ __forceinline__ int operator()(int n) const { return off + n; } };
struct MapWin { __device__ __forceinline__ int operator()(int l) const {
    if (l >= 1024) return l;
    const int t = l & ~255, r = l & 255, wc = r >> 6, blk = (r >> 5) & 1, bj = (r >> 4) & 1, low = r & 15;
    return t + 128 * bj + 32 * wc + 16 * blk + low; } };
struct MapW1 { int off; __device__ __forceinline__ int operator()(int jp) const { const int bj = jp >> 10, j = jp & 1023; return off + 256 * (j >> 7) + 128 * bj + (j & 127); } };


__device__ __forceinline__ void p0_filter_item(Frame& F, int item) {
    FT_DECL;
#define in F.in
    LAS float* h1s = (LAS float*)(F.lds);
    LAS float* h2s = (LAS float*)(F.lds + 4096);
    const int t0 = item * 16;
    {
        const int tt = f_tid >> 5, hh = (f_tid & 31) * 2; const float pos = (float)(t0 + tt);
        float feats[17]; feats[0] = pos * (1.f / SEQ);
#pragma unroll
        for (int i = 0; i < 8; ++i) { const float band = 1e-4f + (float)i * ((7.f - 1e-4f) / 7.f); const float ang = (6.283185307179586f / SEQ) * pos * band; feats[1 + i] = __sinf(ang); feats[9 + i] = __cosf(ang); }
#pragma unroll
        for (int u = 0; u < 2; ++u) { const int h = hh + u; float a = in[19][h];
#pragma unroll
            for (int k = 0; k < 17; ++k) a += feats[k] * in[18][k * 64 + h];
            h1s[tt * 64 + h] = __sinf(in[20][h] * a); }
        __syncthreads();
#pragma unroll
        for (int u = 0; u < 2; ++u) { const int h = hh + u; float a = in[22][h];
#pragma unroll 8
            for (int k = 0; k < 64; ++k) a += h1s[tt * 64 + k] * in[21][k * 64 + h];
            h2s[tt * 64 + h] = __sinf(in[23][h] * a); }
        __syncthreads();
    }
    f32x4 acc[16];
#pragma unroll
    for (int t = 0; t < 16; ++t) acc[t] = (f32x4){0.f, 0.f, 0.f, 0.f};
    const int o = 4 * f_tid;
    for (int k0 = 0; k0 < 64; k0 += 4) { f32x4 w[4];
#pragma unroll
        for (int q = 0; q < 4; ++q) w[q] = *(const f32x4*)(in[24] + (size_t)(k0 + q) * 2048 + o);
#pragma unroll
        for (int t = 0; t < 16; ++t) { const f32x4 hv = *(const LAS f32x4*)(h2s + t * 64 + k0); acc[t] += w[0] * hv[0] + w[1] * hv[1] + w[2] * hv[2] + w[3] * hv[3]; } }
    const int c0 = o & 511, od = o >> 9;
    float* dst = WSP(float, WS_FILT) + ((size_t)od * 512 + c0) * SEQ + t0;
#pragma unroll
    for (int e = 0; e < 4; ++e) { const float la = -3.0701134573253944f, lb = -15.350567286626972f; const float delta = fabsf(la + (float)(c0 + e) * ((lb - la) / 511.f));
#pragma unroll
        for (int q = 0; q < 4; ++q) { f32x4 v;
#pragma unroll
            for (int i = 0; i < 4; ++i) { const int t = 4 * q + i; const float tn = (float)(t0 + t) * (1.f / SEQ); v[i] = acc[t][e] * __expf(-tn * delta); }
            *(f32x4*)(dst + (size_t)e * SEQ + 4 * q) = v; } }
    __syncthreads();
#undef in
}

__device__ __forceinline__ float silu_f(float v) { return v / (1.f + __expf(-v)); }

__device__ __forceinline__ void p0_prologue(Frame& F) {
    FT_DECL;
#define in F.in
    const int wg = blockIdx.x;
    if (wg < 96) {
        LAS float* sv = (LAS float*)F.lds;
        for (int i = f_tid; i < 9 * 1024; i += 512) { const int r = i >> 10, k = i & 1023; const float c = (r < 8) ? in[1][r * 1024 + k] : in[3][k]; sv[i] = silu_f(c); }
        __syncthreads();
        const int j = wg * 64 + f_lane; const float* wm = in[4];
        float acc[9];
#pragma unroll
        for (int r = 0; r < 9; ++r) acc[r] = 0.f;
        const int kbeg = F.wave * 128;
#pragma unroll 4
        for (int k = kbeg; k < kbeg + 128; ++k) { const float w = wm[(size_t)k * (NMOD * DM) + j];
#pragma unroll
            for (int r = 0; r < 9; ++r) acc[r] += sv[r * 1024 + k] * w; }
        LAS float* red = (LAS float*)(F.lds + 40960);
#pragma unroll
        for (int r = 0; r < 9; ++r) red[(F.wave * 9 + r) * 64 + f_lane] = acc[r];
        __syncthreads();
        for (int i = f_tid; i < 9 * 64; i += 512) { const int r = i >> 6, l = i & 63; float s = in[5][wg * 64 + l];
#pragma unroll
            for (int w = 0; w < 8; ++w) s += red[(w * 9 + r) * 64 + l];
            WSP(float, WS_SMALL + SM_MOD)[r * (NMOD * DM) + wg * 64 + l] = s; }
        __syncthreads();
    } else if (wg == 96) {
        if (F.wave == 0) {
            const float a = wave_sum(in[11][f_lane] * in[12][f_lane]), b = wave_sum(in[13][f_lane] * in[14][f_lane]);
            float gq = fabsf(in[9][f_lane]), gk = fabsf(in[10][f_lane]);
#pragma unroll
            for (int o = 1; o < 64; o <<= 1) { gq = fmaxf(gq, __shfl_xor(gq, o)); gk = fmaxf(gk, __shfl_xor(gk, o)); }
            if (f_lane == 0) { float* sc = WSP(float, WS_SMALL + SM_SCAL); sc[0] = expf(a) - expf(b) + LAM_INIT;
                sc[1] = (8.f * gq * gk * 1.02f + 0.05f) * 1.4426950408889634f; }
        }
        for (int i = f_tid; i < 64 * 16; i += 512) { const int pos = i >> 4, f = i & 15;
            const float inv = powf(10000.f, -(float)f / 16.f); const float ang = (float)pos * inv;
            float* rt = WSP(float, WS_SMALL + SM_ROPE); rt[2 * i] = cosf(ang); rt[2 * i + 1] = sinf(ang); }
    }
    __syncthreads();
    for (int it = wg; it < SEQ / 16; it += F.G) p0_filter_item(F, it);
    __syncthreads();
    {
        LAS float* scr = (LAS float*)(F.lds + F.wave * 16896);
        const int gw = F.vcu * NWAVES + F.wave, NGW = F.G * NWAVES;
        constexpr int I_IN = (DM / 64) * (INC / 32), I_OUT = (DM / 64) * (DM / 32), I_1 = (DM / 128) * (2 * DM / 32), I_2 = (DM / 128) * (DM / 32);
        constexpr int NITEMS = I_IN + I_OUT + NEXP * (I_1 + I_2);
        for (int it = gw; it < NITEMS; it += NGW) {
            int r = it;
            if (r < I_IN) { p0_transpose_item(in[8], DM, INC, WSP(bf16_t, WS_WIN), MapWin{}, nullptr, scr, r, f_lane); continue; } r -= I_IN;
            if (r < I_OUT) { p0_transpose_item(in[27], DM, DM, WSP(bf16_t, WS_WOUT), MapIdent{0}, nullptr, scr, r, f_lane); continue; } r -= I_OUT;
            const int e = r / (I_1 + I_2); r -= e * (I_1 + I_2);
            if (r < I_1) p0_transpose_item_f8(in[30] + (size_t)e * DM * 2 * DM, DM, 2 * DM, WSP(unsigned char, WS_W1) + (size_t)e * 2 * DM * DM, MapW1{0}, scr, r, f_lane);
            else p0_transpose_item_f8(in[32] + (size_t)e * DM * DM, DM, DM, WSP(unsigned char, WS_W2) + (size_t)e * DM * DM, MapW2{}, scr, r - I_1, f_lane);
        }
    }
}
#undef in

__device__ __forceinline__ void p1_norm1(Frame& F) {
    FT_DECL;
    const int gw = F.vcu * NWAVES + F.wave, NGW = F.G * NWAVES;
    const float* mod = WSP(float, WS_SMALL + SM_MOD); const float* g1 = F.in[6];
    bf16_t* H = WSP(bf16_t, WS_H);
    constexpr int RU = 4;
    for (int m0 = gw; m0 < MTOT; m0 += NGW * RU) {
        f32x4 v[RU][4];
#pragma unroll
        for (int u = 0; u < RU; ++u) { const int m = m0 + u * NGW; if (m < MTOT) {
            const float* xrow = (m < MROWS) ? F.in[0] + (size_t)m * DM : F.in[2] + (size_t)(m - MROWS) * DM; const GAS f32x4* xr = (const GAS f32x4*)xrow + f_lane;
#pragma unroll
            for (int j = 0; j < 4; ++j) v[u][j] = __builtin_nontemporal_load(xr + 64 * j); } }
#pragma unroll
        for (int u = 0; u < RU; ++u) { const int m = m0 + u * NGW; if (m < MTOT) {
            const int mb = (m < MROWS) ? (m >> 12) : 8;
            const float* sh = mod + (size_t)mb * (NMOD * DM); const float* sc = sh + DM;
            float s = 0.f;
#pragma unroll
            for (int j = 0; j < 4; ++j) s += (v[u][j].x * v[u][j].x + v[u][j].y * v[u][j].y) + (v[u][j].z * v[u][j].z + v[u][j].w * v[u][j].w);
            const float rstd = rsqrtf(wave_sum(s) * (1.f / DM) + EPS);
            GAS u32x2* o8 = (GAS u32x2*)(H + (size_t)m * DM) + f_lane;
#pragma unroll
            for (int j = 0; j < 4; ++j) { const int c = 4 * f_lane + 256 * j;
                const f32x4 g = *(const f32x4*)(g1 + c), a = *(const f32x4*)(sc + c), b = *(const f32x4*)(sh + c);
                const f32x4 y = v[u][j] * rstd * g * (a + 1.f) + b;
                u32x2 w; w.x = cvt_pk_bf16(y.x, y.y); w.y = cvt_pk_bf16(y.z, y.w); o8[64 * j] = w; } } }
    }
}

struct SchedInProj {
    int G, c; const char* H; const char* W;
    static constexpr int NA = 136 * 4, NV = 2 * 136, NBU = 6 * 128;
    __device__ __forceinline__ bool next(int i, g8::Unit& u) const {
        const long L = (long)i * G + c;
        if (L < NA) { g8::tile_of((int)L, 136, 4, u.pm, u.pn); u.a = H + (size_t)u.pm * 256 * DM * 2; u.b = W + (size_t)u.pn * 256 * DM * 2; u.kind = 0; u.ex = 0; return true; }
        if (L < NA + NV) { g8::tile_of((int)L - NA, 2, 136, u.pm, u.pn); u.a = W + (size_t)(1024 + u.pm * 256) * DM * 2; u.b = H + (size_t)u.pn * 256 * DM * 2; u.kind = 2; u.ex = 0; return true; }
        if (L < NA + NV + NBU) { g8::tile_of((int)L - NA - NV, 6, 128, u.pm, u.pn); u.a = W + (size_t)(QKVC + u.pm * 256) * DM * 2; u.b = H + (size_t)u.pn * 256 * DM * 2; u.kind = 1; u.ex = 0; return true; }
        return false;
    }
};
constexpr float Q8SCALE = 16.f;
struct EpiInProj {
    unsigned char *Q8, *K8, *VT8; bf16_t* UT; const float *gq, *gk, *rope;
    __device__ __forceinline__ void operator()(f32x4 (&acc)[2][2][4][2], const g8::Unit& u, int wr, int wc, int fr, int fq) const {
        asm volatile("" : "+v"(fr), "+v"(fq));
        if (u.kind == 1) {
            const int row0 = u.pm * 256 + wr * 64 + fr, col0 = u.pn * 256 + wc * 32 + 8 * fq;
#pragma unroll
            for (int ai = 0; ai < 2; ++ai)
#pragma unroll
                for (int m = 0; m < 4; ++m) { bf16_t* rowp = UT + (size_t)(row0 + ai * 128 + m * 16) * MROWS + col0;
#pragma unroll
                    for (int bj = 0; bj < 2; ++bj) { const f32x4 v0 = acc[ai][bj][m][0], v1 = acc[ai][bj][m][1];
                        u32x4 w; w.x = cvt_pk_bf16(v0[0], v0[1]); w.y = cvt_pk_bf16(v0[2], v0[3]); w.z = cvt_pk_bf16(v1[0], v1[1]); w.w = cvt_pk_bf16(v1[2], v1[3]);
                        *(u32x4*)(rowp + bj * 128) = w; } }
            return;
        }
        if (u.kind == 2) {
#pragma unroll
            for (int bj = 0; bj < 2; ++bj) { const int t8 = u.pn * 256 + bj * 128 + wc * 32 + 8 * fq;
                int b, key; if (t8 < MROWS) { b = t8 >> 12; key = CTXL + (t8 & 4095); } else { const int j = t8 - MROWS; b = j >> 8; key = j & 255; }
                const int tile = key >> 6, k = key & 63, ipos = (k < 32) ? 4 * (k >> 3) : 16 + 4 * ((k - 32) >> 3);
#pragma unroll
                for (int ai = 0; ai < 2; ++ai)
#pragma unroll
                    for (int m = 0; m < 4; ++m) { const int ch = u.pm * 256 + ai * 128 + wr * 64 + m * 16 + fr;
                        unsigned char* dst = VT8 + ((((size_t)(b * NHEAD + (ch >> 7)) * 68 + tile) * 128 + (ch & 127)) * 64) + ipos;
                        const f32x4 v0 = acc[ai][bj][m][0], v1 = acc[ai][bj][m][1];
                        *(unsigned*)dst = pk4_fp8(v0[0], v0[1], v0[2], v0[3]); *(unsigned*)(dst + 32) = pk4_fp8(v1[0], v1[1], v1[2], v1[3]); } }
            return;
        }
        const int blk = fq >> 1, f = fq & 1;
        const int sec = u.pn >> 1;
        const bool ctx = (u.pm >= 128);
        if (sec == 0 && ctx) return;
        const int colbase = (u.pn & 1) * 256 + wc * 64 + 32 * blk + 8 * f;
        float gg[2][2][4];
        { const float* gp = (sec == 0 ? gq : gk) + 32 * blk + 8 * f;
#pragma unroll
            for (int bj = 0; bj < 2; ++bj)
#pragma unroll
                for (int n = 0; n < 2; ++n) { const f32x4 t = *(const f32x4*)(gp + 16 * bj + 4 * n); gg[bj][n][0] = t[0]; gg[bj][n][1] = t[1]; gg[bj][n][2] = t[2]; gg[bj][n][3] = t[3]; } }
#pragma unroll
        for (int ai = 0; ai < 2; ++ai)
#pragma unroll
            for (int m = 0; m < 4; ++m) {
                const int rloc = ai * 128 + wr * 64 + m * 16 + fr; const int r = u.pm * 256 + rloc;
                f32x4 v[2][2];
#pragma unroll
                for (int bj = 0; bj < 2; ++bj)
#pragma unroll
                    for (int n = 0; n < 2; ++n) v[bj][n] = acc[ai][bj][m][n];
                size_t orow;
                if (sec == 0) orow = (size_t)r;
                else if (!ctx) orow = (size_t)(r >> 12) * KVL + CTXL + (r & 4095);
                else { const int j = r - MROWS; orow = (size_t)(j >> 8) * KVL + (j & 255); }
                float ss = 0.f;
#pragma unroll
                for (int bj = 0; bj < 2; ++bj)
#pragma unroll
                    for (int n = 0; n < 2; ++n) ss += (v[bj][n][0] * v[bj][n][0] + v[bj][n][1] * v[bj][n][1]) + (v[bj][n][2] * v[bj][n][2] + v[bj][n][3] * v[bj][n][3]);
                ss += __shfl_xor(ss, 16); ss += __shfl_xor(ss, 32);
                const float rstd = rsqrtf(ss * (1.f / 64.f) + EPS) * (sec == 0 ? QSCALE * Q8SCALE : 1.f);
#pragma unroll
                for (int bj = 0; bj < 2; ++bj)
#pragma unroll
                    for (int n = 0; n < 2; ++n)
#pragma unroll
                        for (int e = 0; e < 4; ++e) v[bj][n][e] *= rstd * gg[bj][n][e];
                if (!ctx) {
                    const int t = r & 4095; const int pos = blk ? (t & 63) : (t >> 6);
                    const float* rp = rope + (size_t)(pos * 16 + 8 * f) * 2;
#pragma unroll
                    for (int n = 0; n < 2; ++n) { const f32x4 c0 = *(const f32x4*)(rp + 8 * n), c1 = *(const f32x4*)(rp + 8 * n + 4);
                        const float cs[4] = {c0[0], c0[2], c1[0], c1[2]}, sn[4] = {c0[1], c0[3], c1[1], c1[3]};
#pragma unroll
                        for (int e = 0; e < 4; ++e) { const float x1 = v[0][n][e], x2 = v[1][n][e]; v[0][n][e] = x1 * cs[e] - x2 * sn[e]; v[1][n][e] = x2 * cs[e] + x1 * sn[e]; } }
                }
                unsigned char* dst = (sec == 0 ? Q8 : K8) + orow * QKW + colbase;
#pragma unroll
                for (int bj = 0; bj < 2; ++bj) { u32x2 w; w.x = pk4_fp8(v[bj][0][0], v[bj][0][1], v[bj][0][2], v[bj][0][3]); w.y = pk4_fp8(v[bj][1][0], v[bj][1][1], v[bj][1][2], v[bj][1][3]);
                    *(u32x2*)(dst + 16 * bj) = w; }
            }
    }
};

struct SchedStatic {
    int G, c, nM, nN; const char* A; const char* B;
    __device__ __forceinline__ bool next(int i, g8::Unit& u) const {
        const long L = (long)i * G + c; if (L >= (long)nM * nN) return false;
        g8::tile_of((int)L, nM, nN, u.pm, u.pn); u.a = A + (size_t)u.pm * 256 * DM * 2; u.b = B + (size_t)u.pn * 256 * DM * 2; u.kind = 0; u.ex = 0; return true;
    }
};
struct EpiOutProj {
    const float* x; bf16_t* out; const float* mod;
    __device__ __forceinline__ void operator()(f32x4 (&acc)[2][2][4][2], const g8::Unit& u, int wr, int wc, int fr, int fq) const {
        const int col0 = u.pn * 256 + wc * 32 + 8 * fq;
#pragma unroll
        for (int ai = 0; ai < 2; ++ai)
#pragma unroll
            for (int m = 0; m < 4; ++m) { const int r = u.pm * 256 + ai * 128 + wr * 64 + m * 16 + fr; const float* g1 = mod + (size_t)(r >> 12) * (NMOD * DM) + 2 * DM;
                const size_t off = (size_t)r * DM + col0;
#pragma unroll
                for (int bj = 0; bj < 2; ++bj) { f32x4 o[2];
#pragma unroll
                    for (int n = 0; n < 2; ++n) { const int c = bj * 128 + 4 * n; const f32x4 xv = *(const f32x4*)(x + off + c), gv = *(const f32x4*)(g1 + col0 + c); o[n] = xv + gv * acc[ai][bj][m][n]; }
                    u32x4 w; w.x = cvt_pk_bf16(o[0][0], o[0][1]); w.y = cvt_pk_bf16(o[0][2], o[0][3]); w.z = cvt_pk_bf16(o[1][0], o[1][1]); w.w = cvt_pk_bf16(o[1][2], o[1][3]);
                    *(u32x4*)(out + off + bj * 128) = w; } }
    }
};

namespace att8 {
constexpr int NT = KVL / 64, SHMB = 8192, LDS_V0 = 3 * SHMB;
typedef int i32x8 __attribute__((ext_vector_type(8)));
#define SBAR() __builtin_amdgcn_sched_barrier(0)
__device__ __forceinline__ int crow(int r, int hi) { return (r & 3) + 8 * (r >> 2) + 4 * hi; }
__device__ __forceinline__ i32x8 ld32(const LAS unsigned char* p0, const LAS unsigned char* p1) {
    const u32x4 a = *(const LAS u32x4*)p0, b = *(const LAS u32x4*)p1; return (i32x8){(int)a.x, (int)a.y, (int)a.z, (int)a.w, (int)b.x, (int)b.y, (int)b.z, (int)b.w}; }
__device__ __forceinline__ void mfma_qk(f32x16& p, const i32x8& kf, const i32x8& qf, const f32x16& negc) {
    const unsigned s1 = 0x7f7f7f7fu, sq = 0x7b7b7b7bu;
    asm volatile("s_nop 1\n\tv_mfma_scale_f32_32x32x64_f8f6f4 %0, %1, %2, %3, %4, %5 op_sel_hi:[0,0,0]" : "=&v"(p) : "v"(kf), "v"(qf), "v"(negc), "v"(s1), "v"(sq));
}
__device__ __forceinline__ void mfma_pv(f32x16& o, const i32x8& pa, const i32x8& vf) {
    const unsigned s1 = 0x7f7f7f7fu;
    asm volatile("s_nop 2\n\tv_mfma_scale_f32_32x32x64_f8f6f4 %0, %1, %2, %0, %3, %3 op_sel_hi:[0,0,0]" : "+v"(o) : "v"(pa), "v"(vf), "v"(s1));
}
__device__ __forceinline__ void qkt(f32x16& p0, f32x16& p1, const LAS unsigned char* Kb, const i32x8& qf, const f32x16& negc, int r32, int hi, int sub) {
    const int c0 = sub * 4 + hi * 2;
    const int k0 = r32, k1 = 32 + r32;
    const i32x8 kf0 = ld32(Kb + k0 * 128 + ((c0 ^ ((k0 >> 1) & 7)) << 4), Kb + k0 * 128 + (((c0 + 1) ^ ((k0 >> 1) & 7)) << 4));
    const i32x8 kf1 = ld32(Kb + k1 * 128 + ((c0 ^ ((k1 >> 1) & 7)) << 4), Kb + k1 * 128 + (((c0 + 1) ^ ((k1 >> 1) & 7)) << 4));
    mfma_qk(p0, kf0, qf, negc); mfma_qk(p1, kf1, qf, negc);
}
__device__ __forceinline__ void mfma_wait(f32x16& p0, f32x16& p1) { asm volatile("s_nop 15\n\ts_nop 3" : "+v"(p0), "+v"(p1)); }
__device__ __forceinline__ void expA(f32x16& p) {
#pragma unroll
    for (int r = 0; r < 16; ++r) p[r] = __builtin_amdgcn_exp2f(p[r]);
}
__device__ __forceinline__ void finishSM(f32x16& p0, f32x16& p1, i32x8& pa) {
#pragma unroll
    for (int r = 0; r < 16; ++r) p1[r] = __builtin_amdgcn_exp2f(p1[r]);
#pragma unroll
    for (int j = 0; j < 4; ++j) { pa[j] = (int)pk4_fp8(p0[4 * j], p0[4 * j + 1], p0[4 * j + 2], p0[4 * j + 3]); pa[4 + j] = (int)pk4_fp8(p1[4 * j], p1[4 * j + 1], p1[4 * j + 2], p1[4 * j + 3]); }
}
__device__ __forceinline__ void pv(f32x16* o, f32x16& ol, const i32x8& ones, const LAS unsigned char* Vb, const i32x8& pa, int r32, int hi) {
    mfma_pv(ol, pa, ones);
#pragma unroll
    for (int d0 = 0; d0 < 4; ++d0) { const int d = 32 * d0 + r32, sw = (d >> 2) & 3;
        const i32x8 vf = ld32(Vb + d * 64 + (((2 * hi) ^ sw) << 4), Vb + d * 64 + (((2 * hi + 1) ^ sw) << 4));
        mfma_pv(o[d0], pa, vf); }
}
__device__ __forceinline__ void attn_unit(const unsigned char* __restrict__ Qb, const unsigned char* __restrict__ Kh, const unsigned char* __restrict__ VTh, bf16_t* MIXo,
                                          const float lam, const float* __restrict__ subg, char* lds, const int wid) {
    const int lane = lane_id(), tid = wid * 64 + lane, r32 = lane & 31, hi = lane >> 5;
    const int sub = wid >> 2, wq = wid & 3;
    const LAS unsigned char* L = (const LAS unsigned char*)(uintptr_t)(unsigned)(uintptr_t)lds;
    f32x16 o[4] = {}; f32x16 ol = {};
    i32x8 ones; { int c1 = 0x38383838; asm volatile("" : "+v"(c1)); ones = (i32x8){c1, c1, c1, c1, c1, c1, c1, c1}; }
    i32x8 qf; { const unsigned char* qp = Qb + (size_t)(wq * 32 + r32) * QKW + sub * 64 + 32 * hi; const u32x4 a = *(const u32x4*)qp, b = *(const u32x4*)(qp + 16);
        qf = (i32x8){(int)a.x, (int)a.y, (int)a.z, (int)a.w, (int)b.x, (int)b.y, (int)b.z, (int)b.w}; }
    f32x16 negc;
#pragma unroll
    for (int r = 0; r < 16; ++r) negc[r] = -5.f;
    asm volatile("" : "+v"(negc));
    long ksrc, vsrc;
    { const int r = 8 * wid + (lane >> 3), c = (lane & 7) ^ ((r >> 1) & 7); ksrc = (long)r * QKW + c * 16; }
    { const int d = 16 * wid + (lane >> 2), c = (lane & 3) ^ ((d >> 2) & 3); vsrc = (long)d * 64 + c * 16; }
    const unsigned ldsb = (unsigned)(uintptr_t)lds, kdst = ldsb + (unsigned)wid * 1024u, vdst = ldsb + LDS_V0 + (unsigned)wid * 1024u;
#define DMA_TILE(t, boff) do { \
        __builtin_amdgcn_global_load_lds((const unsigned*)(Kh + (long)(t) * 64 * QKW + ksrc), (LAS unsigned*)(uintptr_t)__builtin_amdgcn_readfirstlane(kdst + (unsigned)(boff)), 16, 0, 0); \
        __builtin_amdgcn_global_load_lds((const unsigned*)(VTh + (long)(t) * 8192 + vsrc), (LAS unsigned*)(uintptr_t)__builtin_amdgcn_readfirstlane(vdst + (unsigned)(boff)), 16, 0, 0); } while (0)
#define WBAR() do { asm volatile("s_waitcnt vmcnt(0) lgkmcnt(0)" ::: "memory"); __builtin_amdgcn_s_barrier(); asm volatile("" ::: "memory"); } while (0)
#define ROT3(x) ((x) == 2 * SHMB ? 0 : (x) + SHMB)
    f32x16 pA0, pA1, pB0, pB1; i32x8 pa;
    DMA_TILE(0, 0); WBAR();
    DMA_TILE(1, SHMB);
    qkt(pA0, pA1, L, qf, negc, r32, hi, sub); mfma_wait(pA0, pA1); expA(pA0);
    WBAR();
    int bprev = 0, bcur = SHMB, bnext = 2 * SHMB;
    for (int j = 1; j + 1 < NT; j += 2) {
        DMA_TILE(j + 1, bnext);
        SBAR(); qkt(pB0, pB1, L + bcur, qf, negc, r32, hi, sub);
        finishSM(pA0, pA1, pa); SBAR();
        pv(o, ol, ones, L + LDS_V0 + bprev, pa, r32, hi); mfma_wait(pB0, pB1); expA(pB0);
        WBAR();
        bprev = bcur; bcur = bnext; bnext = ROT3(bnext);
        if (j + 2 < NT) DMA_TILE(j + 2, bnext);
        SBAR(); qkt(pA0, pA1, L + bcur, qf, negc, r32, hi, sub);
        finishSM(pB0, pB1, pa); SBAR();
        pv(o, ol, ones, L + LDS_V0 + bprev, pa, r32, hi); mfma_wait(pA0, pA1); expA(pA0);
        WBAR();
        bprev = bcur; bcur = bnext; bnext = ROT3(bnext);
    }
    SBAR(); qkt(pB0, pB1, L + bcur, qf, negc, r32, hi, sub);
    finishSM(pA0, pA1, pa); SBAR();
    pv(o, ol, ones, L + LDS_V0 + bprev, pa, r32, hi); mfma_wait(pB0, pB1); expA(pB0);
    finishSM(pB0, pB1, pa); SBAR();
    pv(o, ol, ones, L + LDS_V0 + bcur, pa, r32, hi);
    asm volatile("s_nop 15\n\ts_nop 3" : "+v"(o[0]), "+v"(o[1]), "+v"(o[2]), "+v"(o[3]), "+v"(ol));
#undef ROT3
#undef DMA_TILE
#undef WBAR
    __syncthreads();
    float* X = (float*)lds;
    float rli[16];
#pragma unroll
    for (int r = 0; r < 16; ++r) rli[r] = __builtin_amdgcn_rcpf(ol[r]);
    if (sub == 1) {
#pragma unroll
        for (int r = 0; r < 16; ++r) { const int row = wq * 32 + crow(r, hi); const float sc = lam * rli[r];
#pragma unroll
            for (int d0 = 0; d0 < 4; ++d0) X[row * 128 + d0 * 32 + r32] = o[d0][r] * sc; }
    }
    __syncthreads();
    bf16_t* Y = (bf16_t*)(lds + 65536);
    if (sub == 0) {
        float sg[4];
#pragma unroll
        for (int d0 = 0; d0 < 4; ++d0) sg[d0] = subg[d0 * 32 + r32] * (1.f - LAM_INIT);
#pragma unroll
        for (int r = 0; r < 16; ++r) { const int row = wq * 32 + crow(r, hi);
            float v[4]; float ss = 0.f;
#pragma unroll
            for (int d0 = 0; d0 < 4; ++d0) { v[d0] = o[d0][r] * rli[r] - X[row * 128 + d0 * 32 + r32]; ss += v[d0] * v[d0]; }
            ss += __shfl_xor(ss, 1); ss += __shfl_xor(ss, 2); ss += __shfl_xor(ss, 4); ss += __shfl_xor(ss, 8); ss += __shfl_xor(ss, 16);
            const float rstd = rsqrtf(ss * (1.f / 128.f) + EPS);
#pragma unroll
            for (int d0 = 0; d0 < 4; ++d0) Y[row * 128 + d0 * 32 + r32] = (bf16_t)(cvt_pk_bf16(v[d0] * rstd * sg[d0], 0.f) & 0xffffu); }
    }
    __syncthreads();
    { const int row = tid >> 2, seg = (tid & 3) * 32;
#pragma unroll
        for (int i = 0; i < 4; ++i) { const u32x4 v = *(const u32x4*)(Y + row * 128 + seg + i * 8); *(u32x4*)(MIXo + (size_t)row * DM + seg + i * 8) = v; } }
    __syncthreads();
}
#undef SBAR
}

__device__ __forceinline__ void p3_attention8(Frame& F) {
    FT_DECL;
    const float* sc = WSP(float, WS_SMALL + SM_SCAL);
    const float lam = sc[0];
    const unsigned char* Q8 = WSP(unsigned char, WS_Q); const unsigned char* K8 = WSP(unsigned char, WS_K); const unsigned char* VT8 = WSP(unsigned char, WS_V); bf16_t* MIX = WSP(bf16_t, WS_MIX);
    const int c = blockIdx.x, xcd = c & 7, ci = c >> 3, per = F.G >> 3;
    for (int j = ci; j < 128; j += per) {
        const int pair = xcd * 4 + (j >> 5), qb = j & 31, b = pair >> 2, h = pair & 3;
        att8::attn_unit(Q8 + ((size_t)b * SEQ + qb * 128) * QKW + h * 128, K8 + (size_t)b * KVL * QKW + h * 128, VT8 + (size_t)(b * NHEAD + h) * 68 * 8192,
                        MIX + ((size_t)b * SEQ + qb * 128) * DM + h * 128, lam, F.in[15], (char*)F.lds, F.wave);
    }
}

namespace hy {
constexpr int RB_BYTES = 4352 * 8, IN_OFF = 2 * RB_BYTES, TW1_OFF = IN_OFF + 32768, TW2_OFF = TW1_OFF + 15 * 256 * 8, LDS_END = TW2_OFF + 15 * 16 * 8;
__device__ __forceinline__ f32x2 cmul(f32x2 a, f32x2 b) { return (f32x2){a.x * b.x - a.y * b.y, a.x * b.y + a.y * b.x}; }
__device__ __forceinline__ f32x2 cmulc(f32x2 a, f32x2 b) { return (f32x2){a.x * b.x + a.y * b.y, a.y * b.x - a.x * b.y}; }
__device__ __forceinline__ int P(int i) { return i + (i >> 4); }
template <bool INV> __device__ __forceinline__ void r4(f32x2& a, f32x2& b, f32x2& c, f32x2& d) {
    const f32x2 t0 = a + c, t1 = a - c, t2 = b + d, t3 = b - d;
    const f32x2 st3 = INV ? (f32x2){-t3.y, t3.x} : (f32x2){t3.y, -t3.x};
    a = t0 + t2; c = t0 - t2; b = t1 + st3; d = t1 - st3;
}
template <bool INV> __device__ __forceinline__ f32x2 tw(f32x2 v, float c, float s) {
    return INV ? (f32x2){v.x * c - v.y * s, v.y * c + v.x * s} : (f32x2){v.x * c + v.y * s, v.y * c - v.x * s};
}
template <bool INV> __device__ __forceinline__ void dft16(f32x2 (&v)[16]) {
    constexpr float C1 = 0.9238795325112867f, S1 = 0.3826834323650898f, R2 = 0.7071067811865476f;
    r4<INV>(v[0], v[4], v[8], v[12]); r4<INV>(v[1], v[5], v[9], v[13]); r4<INV>(v[2], v[6], v[10], v[14]); r4<INV>(v[3], v[7], v[11], v[15]);
    v[5] = tw<INV>(v[5], C1, S1);  v[9] = tw<INV>(v[9], R2, R2);    v[13] = tw<INV>(v[13], S1, C1);
    v[6] = tw<INV>(v[6], R2, R2);  v[10] = tw<INV>(v[10], 0.f, 1.f); v[14] = tw<INV>(v[14], -R2, R2);
    v[7] = tw<INV>(v[7], S1, C1);  v[11] = tw<INV>(v[11], -R2, R2);  v[15] = tw<INV>(v[15], -C1, -S1);
    r4<INV>(v[0], v[1], v[2], v[3]); r4<INV>(v[4], v[5], v[6], v[7]); r4<INV>(v[8], v[9], v[10], v[11]); r4<INV>(v[12], v[13], v[14], v[15]);
    f32x2 t;
    t = v[1]; v[1] = v[4]; v[4] = t;   t = v[2]; v[2] = v[8]; v[8] = t;    t = v[3]; v[3] = v[12]; v[12] = t;
    t = v[6]; v[6] = v[9]; v[9] = t;   t = v[7]; v[7] = v[13]; v[13] = t;  t = v[11]; v[11] = v[14]; v[14] = t;
}
struct Ctx { LAS f32x2* R; LAS f32x2* IN; LAS f32x2* TW1; LAS f32x2* TW2; int t, half; f32x2 wt; };
#define HY_OPAQUE(x) asm volatile("" : "+v"(x))
#define HY_W32(m) (f32x2){__builtin_cosf(-0.19634954084936207f * (m)), __builtin_sinf(-0.19634954084936207f * (m))}
template <int MODE> __device__ __forceinline__ void pass1_fwd(const Ctx& X) {
    f32x2 v[16]; int t = X.t; HY_OPAQUE(t);
#pragma unroll
    for (int m = 0; m < 16; ++m) { f32x2 a = X.IN[t + 256 * m]; if (MODE == 1) a = (f32x2){X.half ? a.y : a.x, 0.f}; v[m] = a; }
    if (X.half) {
#pragma unroll
        for (int m = 0; m < 16; ++m) v[m] = cmul(cmul(v[m], HY_W32(m)), X.wt);
    }
    dft16<false>(v);
#pragma unroll
    for (int q = 1; q < 16; ++q) v[q] = cmul(v[q], X.TW1[(q - 1) * 256 + t]);
    const int pb = t + (t >> 4);
#pragma unroll
    for (int q = 0; q < 16; ++q) X.R[pb + 272 * q] = v[q];
}
__device__ __forceinline__ void pass2_fwd(const Ctx& X) {
    int t = X.t; HY_OPAQUE(t);
    const int n2 = t & 15, pb = (t >> 4) * 272 + n2; f32x2 v[16];
#pragma unroll
    for (int m = 0; m < 16; ++m) v[m] = X.R[pb + 17 * m];
    dft16<false>(v);
#pragma unroll
    for (int q = 1; q < 16; ++q) v[q] = cmul(v[q], X.TW2[(q - 1) * 16 + n2]);
#pragma unroll
    for (int q = 0; q < 16; ++q) X.R[pb + 17 * q] = v[q];
}
template <bool FILTER> __device__ __forceinline__ void pass3(const Ctx& X, f32x2 (&H)[16]) {
    f32x2 v[16]; int t = X.t; HY_OPAQUE(t); const int pb = 17 * t;
#pragma unroll
    for (int m = 0; m < 16; ++m) v[m] = X.R[pb + m];
    dft16<false>(v);
    if (FILTER) {
#pragma unroll
        for (int q = 0; q < 16; ++q) H[q] = v[q] * (1.f / 8192.f);
    } else {
#pragma unroll
        for (int q = 0; q < 16; ++q) v[q] = cmul(v[q], H[q]);
        dft16<true>(v);
#pragma unroll
        for (int m = 0; m < 16; ++m) X.R[pb + m] = v[m];
    }
}
__device__ __forceinline__ void pass2_inv(const Ctx& X) {
    int t = X.t; HY_OPAQUE(t);
    const int n2 = t & 15, pb = (t >> 4) * 272 + n2; f32x2 v[16];
    v[0] = X.R[pb];
#pragma unroll
    for (int q = 1; q < 16; ++q) v[q] = cmulc(X.R[pb + 17 * q], X.TW2[(q - 1) * 16 + n2]);
    dft16<true>(v);
#pragma unroll
    for (int m = 0; m < 16; ++m) X.R[pb + 17 * m] = v[m];
}
__device__ __forceinline__ void pass1_inv(const Ctx& X) {
    f32x2 v[16]; int t = X.t; HY_OPAQUE(t); const int pb = t + (t >> 4);
    v[0] = X.R[pb];
#pragma unroll
    for (int q = 1; q < 16; ++q) v[q] = cmulc(X.R[pb + 272 * q], X.TW1[(q - 1) * 256 + t]);
    dft16<true>(v);
    if (X.half) {
#pragma unroll
        for (int m = 0; m < 16; ++m) v[m] = cmulc(cmulc(v[m], HY_W32(m)), X.wt);
    }
#pragma unroll
    for (int m = 0; m < 16; ++m) X.R[pb + 272 * m] = v[m];
}
#define HY_WSYNC() asm volatile("s_waitcnt lgkmcnt(0)" ::: "memory")
__device__ __forceinline__ void conv_fft(const Ctx& X, f32x2 (&H)[16]) {
    __syncthreads(); pass1_fwd<0>(X); __syncthreads(); pass2_fwd(X); HY_WSYNC(); pass3<false>(X, H); HY_WSYNC(); pass2_inv(X); __syncthreads(); pass1_inv(X); __syncthreads();
}
constexpr int STG_OFF = LDS_END;
constexpr int LDS_END2 = STG_OFF + 2 * SEQ * 2;
static_assert(LDS_END2 <= LDSCTL_OFF, "hyena LDS map");
__device__ __forceinline__ float sconv_lds(const LAS bf16_t* stg, int bs, int n, float w0, float w1, float w2, float bias) {
    const LAS bf16_t* p = stg + bs * SEQ;
    const float c = bf2f(p[n]), lv = bf2f(p[n - ((n > 0) ? 1 : 0)]), rv = bf2f(p[n + ((n < SEQ - 1) ? 1 : 0)]);
    const float l = (n > 0) ? lv : 0.f, r = (n < SEQ - 1) ? rv : 0.f;
    return bias + w0 * l + w1 * c + w2 * r;
}
__device__ __forceinline__ void setup_tables(LAS unsigned char* lds, int tid) {
    LAS f32x2* TW1 = (LAS f32x2*)(lds + TW1_OFF); LAS f32x2* TW2 = (LAS f32x2*)(lds + TW2_OFF);
    for (int i = tid; i < 15 * 256; i += 512) { const int q = i / 256 + 1, t = i & 255; float s, c; sincosf(-6.283185307179586f * (float)((t * q) & 4095) * (1.f / 4096.f), &s, &c); TW1[i] = (f32x2){c, s}; }
    for (int i = tid; i < 15 * 16; i += 512) { const int q = i / 16 + 1, n2 = i & 15; float s, c; sincosf(-6.283185307179586f * (float)((n2 * q) & 255) * (1.f / 256.f), &s, &c); TW2[i] = (f32x2){c, s}; }
}
__device__ __forceinline__ void unit(Frame& F, int c) {
    FT_DECL;
    const int tid = f_tid; Ctx X; X.half = F.wave >> 2; X.t = tid & 255;
    X.R = (LAS f32x2*)(F.lds + X.half * RB_BYTES); X.IN = (LAS f32x2*)(F.lds + IN_OFF); X.TW1 = (LAS f32x2*)(F.lds + TW1_OFF); X.TW2 = (LAS f32x2*)(F.lds + TW2_OFF);
    { float s, cc; sincosf(-6.283185307179586f * (float)X.t * (1.f / 8192.f), &s, &cc); X.wt = (f32x2){cc, s}; }
    LAS f32x2* RB0 = (LAS f32x2*)(F.lds); LAS f32x2* RB1 = (LAS f32x2*)(F.lds + RB_BYTES);
    const float* FILT = WSP(float, WS_FILT);
    f32x2 H0[16], H1[16];
#pragma unroll
    for (int ord = 0; ord < 2; ++ord) {
        const float* hf = FILT + ((size_t)(ord * 2 + 0) * 512 + c) * SEQ; const float* hb = FILT + ((size_t)(ord * 2 + 1) * 512 + c) * SEQ;
        __syncthreads();
        int nb = tid; HY_OPAQUE(nb);
#pragma unroll
        for (int j = 0; j < 8; ++j) { const int n = nb + 512 * j; const float a = hf[n], b = hb[(SEQ - n) & (SEQ - 1)]; const float lo = (n == 0) ? a + b : a, hi = (n == 0) ? 0.f : b; X.IN[n] = (f32x2){lo + hi, lo - hi}; }
        __syncthreads(); pass1_fwd<1>(X); __syncthreads(); pass2_fwd(X); HY_WSYNC();
        if (ord == 0) pass3<true>(X, H0); else pass3<true>(X, H1);
    }
    const bf16_t* UT = WSP(bf16_t, WS_UT);
    const bf16_t* rv = UT + (size_t)c * MROWS; const bf16_t* r1 = UT + (size_t)(512 + c) * MROWS; const bf16_t* r2 = UT + (size_t)(1024 + c) * MROWS;
    const float* cw = F.in[16]; const float* cb = F.in[17];
    const float wv0 = cw[c], wv1 = cw[HYC + c], wv2 = cw[2 * HYC + c], bv = cb[c];
    const float wa0 = cw[512 + c], wa1 = cw[HYC + 512 + c], wa2 = cw[2 * HYC + 512 + c], ba = cb[512 + c];
    const float wb0 = cw[1024 + c], wb1 = cw[HYC + 1024 + c], wb2 = cw[2 * HYC + 1024 + c], bb = cb[1024 + c];
    const float sk0 = F.in[25][c], sk1 = F.in[25][512 + c];
    bf16_t* Z = WSP(bf16_t, WS_Z2T) + (size_t)c * MROWS;
    LAS bf16_t* STG = (LAS bf16_t*)(F.lds + STG_OFF);
    u32x4 g0 = *(const u32x4*)(rv + tid * 8), g1 = *(const u32x4*)(rv + SEQ + tid * 8);
    for (int pr = 0; pr < 4; ++pr) {
        const int b0 = 2 * pr, b1 = b0 + 1;
        f32x2 z[8]; int pc = tid + (tid >> 4); HY_OPAQUE(pc); int nb = tid; HY_OPAQUE(nb);
        __syncthreads();
        *(LAS u32x4*)(STG + tid * 8) = g0; *(LAS u32x4*)(STG + SEQ + tid * 8) = g1;
        __syncthreads();
#pragma unroll
        for (int j = 0; j < 8; ++j) { const int n = nb + 512 * j; z[j] = (f32x2){sconv_lds(STG, 0, n, wv0, wv1, wv2, bv), sconv_lds(STG, 1, n, wv0, wv1, wv2, bv)}; X.IN[n] = z[j]; }
        g0 = *(const u32x4*)(r1 + b0 * SEQ + tid * 8); g1 = *(const u32x4*)(r1 + b1 * SEQ + tid * 8);
        conv_fft(X, H0);
        *(LAS u32x4*)(STG + tid * 8) = g0; *(LAS u32x4*)(STG + SEQ + tid * 8) = g1;
        __syncthreads();
        HY_OPAQUE(nb); HY_OPAQUE(pc);
#pragma unroll
        for (int j = 0; j < 8; ++j) { const int n = nb + 512 * j; const f32x2 y = RB0[pc + 544 * j] + RB1[pc + 544 * j];
            const f32x2 g = (f32x2){sconv_lds(STG, 0, n, wa0, wa1, wa2, ba), sconv_lds(STG, 1, n, wa0, wa1, wa2, ba)};
            z[j] = g * (y + sk0 * z[j]); X.IN[n] = z[j]; }
        g0 = *(const u32x4*)(r2 + b0 * SEQ + tid * 8); g1 = *(const u32x4*)(r2 + b1 * SEQ + tid * 8);
        conv_fft(X, H1);
        *(LAS u32x4*)(STG + tid * 8) = g0; *(LAS u32x4*)(STG + SEQ + tid * 8) = g1;
        __syncthreads();
        if (pr < 3) { g0 = *(const u32x4*)(rv + (b0 + 2) * SEQ + tid * 8); g1 = *(const u32x4*)(rv + (b1 + 2) * SEQ + tid * 8); }
        HY_OPAQUE(nb); HY_OPAQUE(pc);
        f32x2 o[8];
#pragma unroll
        for (int j = 0; j < 8; ++j) { const int n = nb + 512 * j; const f32x2 y = RB0[pc + 544 * j] + RB1[pc + 544 * j];
            const f32x2 g = (f32x2){sconv_lds(STG, 0, n, wb0, wb1, wb2, bb), sconv_lds(STG, 1, n, wb0, wb1, wb2, bb)};
            o[j] = g * (y + sk1 * z[j]); }
        __syncthreads();
#pragma unroll
        for (int j = 0; j < 8; ++j) { const int n = nb + 512 * j; STG[n] = (bf16_t)(cvt_pk_bf16(o[j].x, 0.f) & 0xffffu); STG[SEQ + n] = (bf16_t)(cvt_pk_bf16(o[j].y, 0.f) & 0xffffu); }
        __syncthreads();
        *(u32x4*)(Z + b0 * SEQ + tid * 8) = *(const LAS u32x4*)(STG + tid * 8); *(u32x4*)(Z + b1 * SEQ + tid * 8) = *(const LAS u32x4*)(STG + SEQ + tid * 8);
    }
    __syncthreads();
}
}

__device__ __forceinline__ void p3_hyena(Frame& F) {
    FT_DECL;
    __syncthreads();
    hy::setup_tables(F.lds, f_tid);
    __syncthreads();
    for (int c = F.vcu; c < HYW; c += F.G) hy::unit(F, c);
}

__device__ __forceinline__ void p4_hynorm(Frame& F) {
    FT_DECL;
    const bf16_t* Z = WSP(bf16_t, WS_Z2T); bf16_t* MIX = WSP(bf16_t, WS_MIX); const float* g = F.in[26];
    LAS bf16_t* T = (LAS bf16_t*)F.lds;
    LAS float* red = (LAS float*)(F.lds + 512 * 72 * 2);
    LAS float* rs = red + 512;
    for (int it = F.vcu; it < MROWS / 64; it += F.G) {
        const int tok0 = it * 64;
        __syncthreads();
#pragma unroll
        for (int j = 0; j < 8; ++j) { const int i = f_tid + 512 * j, row = i >> 3, ch = i & 7; const u32x4 v = *(const u32x4*)(Z + (size_t)row * MROWS + tok0 + ch * 8); *(LAS u32x4*)(T + row * 72 + ch * 8) = v; }
        __syncthreads();
        { const int tok = f_tid & 63, grp = f_tid >> 6; float ss = 0.f;
#pragma unroll 8
            for (int k = 0; k < 64; ++k) { const float v = bf2f(T[(grp * 64 + k) * 72 + tok]); ss += v * v; }
            red[grp * 64 + tok] = ss; }
        __syncthreads();
        if (f_tid < 64) { float ss = 0.f;
#pragma unroll
            for (int w = 0; w < 8; ++w) ss += red[w * 64 + f_tid];
            rs[f_tid] = rsqrtf(ss * (1.f / HYW) + EPS); }
        __syncthreads();
#pragma unroll
        for (int j = 0; j < 8; ++j) { const int i = f_tid + 512 * j, tok = i >> 6, c0 = (i & 63) * 8; const float r = rs[tok];
            float v[8];
#pragma unroll
            for (int e = 0; e < 8; ++e) v[e] = bf2f(T[(c0 + e) * 72 + tok]) * r * g[c0 + e];
            u32x4 w; w.x = cvt_pk_bf16(v[0], v[1]); w.y = cvt_pk_bf16(v[2], v[3]); w.z = cvt_pk_bf16(v[4], v[5]); w.w = cvt_pk_bf16(v[6], v[7]);
            *(u32x4*)(MIX + (size_t)(tok0 + tok) * DM + 512 + c0) = w; }
    }
}

constexpr size_t RT_TOPI = 0;
constexpr size_t RT_GATE = 512 * 1024;
constexpr size_t RT_POS = 1024 * 1024;
constexpr size_t RT_WGCNT = 1536 * 1024;
constexpr size_t RT_META = 1600 * 1024;
constexpr size_t RT_LIST = 2048 * 1024;
constexpr size_t RT_GSLOT = 2048 * 1024 + 640 * 1024;
constexpr int MAXSLOT = MROWS * TOPK + NEXP * 256;
constexpr int MAXTILE = MAXSLOT / 256;
constexpr size_t WS_XS = WS_EO;
constexpr int RW_PITCH = 32;
constexpr int P6_LDS_TOPI = 1024 * RW_PITCH * 4;

__device__ __forceinline__ void p6_router_mfma(Frame& F) {
    FT_DECL;
#define in F.in
    LAS float* WP = (LAS float*)F.lds;
    LAS int* TI = (LAS int*)(F.lds + P6_LDS_TOPI);
    LAS int* PS = TI + 512;
    LAS int* SC = PS + 512;
    LAS float* RSTD = (LAS float*)(SC + 512);
    LAS float* BIAS = RSTD + 128;
    LAS float* SSX = BIAS + 32;
    const float* rw = in[28]; const float* mod = WSP(float, WS_SMALL + SM_MOD); const float* g2n = in[7]; const float* rb = in[29];
    const bf16_t* XN = WSP(bf16_t, WS_XN); unsigned char* H2 = WSP(unsigned char, WS_H);
    int* topi_g = WSP(int, WS_ROUTE + RT_TOPI); float* gate_g = WSP(float, WS_ROUTE + RT_GATE); int* pos_g = WSP(int, WS_ROUTE + RT_POS); int* wgcnt = WSP(int, WS_ROUTE + RT_WGCNT);
    for (int blk = blockIdx.x; blk < MROWS / 128; blk += F.G) {
        const float* sh2 = mod + (size_t)(blk >> 5) * (NMOD * DM) + 3 * DM; const float* sc2 = sh2 + DM;
        __syncthreads();
        for (int i = f_tid; i < 1024 * 8; i += 512) { const int k = i >> 3, c4 = i & 7; const float gm = g2n[k] * (1.f + sc2[k]);
            *(LAS f32x4*)(WP + k * 32 + c4 * 4) = *(const f32x4*)(rw + (size_t)k * 32 + c4 * 4) * gm; }
        { const int e = f_tid & 31, part = f_tid >> 5; float a = 0.f;
            for (int k = part * 64; k < part * 64 + 64; ++k) a += sh2[k] * rw[(size_t)k * 32 + e];
            ((LAS float*)SC)[part * 32 + e] = a; }
        __syncthreads();
        if (f_tid < 32) { float a = rb[f_tid];
#pragma unroll
            for (int p = 0; p < 16; ++p) a += ((LAS float*)SC)[p * 32 + f_tid];
            BIAS[f_tid] = a; }
        const int rg = F.wave & 3, kh = F.wave >> 2, j = f_lane & 31, hi = f_lane >> 5;
        f32x16 acc = {};
        float ss = 0.f;
        { const bf16_t* xrow = XN + (size_t)(blk * 128 + rg * 32 + j) * DM + 512 * kh + 8 * hi;
            const LAS float* wp = WP + (512 * kh + 8 * hi) * 32 + j;
#pragma unroll 4
            for (int c = 0; c < 32; ++c) { const u32x4 xb = *(const u32x4*)(xrow + 16 * c);
                float xf[8] = {__uint_as_float(xb.x << 16), __uint_as_float(xb.x & 0xffff0000u), __uint_as_float(xb.y << 16), __uint_as_float(xb.y & 0xffff0000u),
                               __uint_as_float(xb.z << 16), __uint_as_float(xb.z & 0xffff0000u), __uint_as_float(xb.w << 16), __uint_as_float(xb.w & 0xffff0000u)};
#pragma unroll
                for (int q = 0; q < 8; ++q) { ss += xf[q] * xf[q]; acc = __builtin_amdgcn_mfma_f32_32x32x2f32(wp[(16 * c + q) * 32], xf[q], acc, 0, 0, 0); } } }
        { auto rr = __builtin_amdgcn_permlane32_swap(__float_as_uint(ss), __float_as_uint(ss), false, false); ss = __uint_as_float(rr[0]) + __uint_as_float(rr[1]); }
        if (hi == 0) SSX[kh * 128 + rg * 32 + j] = ss;
        __syncthreads();
        if (kh == 1) {
#pragma unroll
            for (int r = 0; r < 16; ++r) WP[(rg * 16 + r) * 64 + f_lane] = acc[r]; }
        if (f_tid < 128) RSTD[f_tid] = rsqrtf((SSX[f_tid] + SSX[128 + f_tid]) * (1.f / DM) + EPS);
        __syncthreads();
        if (kh == 0) {
            const float rstd = RSTD[rg * 32 + j];
            float tv[4] = {-INFINITY, -INFINITY, -INFINITY, -INFINITY}; int ti[4] = {1 << 20, 1 << 20, 1 << 20, 1 << 20};
#define P6_INS(V, E) do { float cv = (V); int ce = (E); _Pragma("unroll") for (int q = 0; q < 4; ++q) { const bool b = cv > tv[q] || (cv == tv[q] && ce < ti[q]); \
                const float nv = b ? tv[q] : cv; const int ne = b ? ti[q] : ce; tv[q] = b ? cv : tv[q]; ti[q] = b ? ce : ti[q]; cv = nv; ce = ne; } } while (0)
#pragma unroll
            for (int r = 0; r < 16; ++r) { const int e = (r & 3) + 8 * (r >> 2) + 4 * hi; const float v = (acc[r] + WP[(rg * 16 + r) * 64 + f_lane]) * rstd + BIAS[e]; P6_INS(v, e); }
            float ov[4]; int oe[4];
#pragma unroll
            for (int q = 0; q < 4; ++q) { ov[q] = __shfl_xor(tv[q], 32); oe[q] = __shfl_xor(ti[q], 32); }
#pragma unroll
            for (int q = 0; q < 4; ++q) P6_INS(ov[q], oe[q]);
#undef P6_INS
            if (hi == 0) { const int rl = rg * 32 + j, r = blk * 128 + rl;
                const float e1 = __expf(tv[1] - tv[0]), e2 = __expf(tv[2] - tv[0]), e3 = __expf(tv[3] - tv[0]); const float inv = 1.f / (1.f + e1 + e2 + e3);
                typedef int i32x4_t __attribute__((ext_vector_type(4))); const i32x4_t t4 = {ti[0], ti[1], ti[2], ti[3]};
                *(i32x4_t*)(topi_g + (size_t)r * 4) = t4; *(f32x4*)(gate_g + (size_t)r * 4) = (f32x4){inv, e1 * inv, e2 * inv, e3 * inv};
                *(LAS i32x4_t*)(TI + rl * 4) = t4; }
        }
        __syncthreads();
        { const int t2 = F.wave * 64 + lane_id(); const int e = t2 & 31, seg = t2 >> 5; int cnt = 0;
#pragma unroll 4
            for (int i = 0; i < 32; ++i) cnt += (TI[seg * 32 + i] == e) ? 1 : 0;
            SC[seg * 32 + e] = cnt;
            __syncthreads();
            int pre = 0;
            for (int s2 = 0; s2 < seg; ++s2) pre += SC[s2 * 32 + e];
            if (seg == 15) wgcnt[blk * 32 + e] = pre + cnt;
            for (int i = 0; i < 32; ++i) if (TI[seg * 32 + i] == e) { PS[seg * 32 + i] = pre; ++pre; }
        }
        __syncthreads();
        { const int t3 = F.wave * 64 + lane_id(); pos_g[(size_t)blk * 512 + t3] = PS[t3]; }
        { const int lane = lane_id();
            for (int it = 0; it < 4; ++it) { u32x2 xb[4][4];
#pragma unroll
                for (int u = 0; u < 4; ++u) { const GAS u32x2* xr = (const GAS u32x2*)(XN + (size_t)(blk * 128 + F.wave * 16 + 4 * it + u) * DM) + lane;
#pragma unroll
                    for (int jj = 0; jj < 4; ++jj) xb[u][jj] = xr[64 * jj]; }
#pragma unroll
                for (int u = 0; u < 4; ++u) { const int rl = F.wave * 16 + 4 * it + u; const float rstd = RSTD[rl];
                    GAS unsigned* o4 = (GAS unsigned*)(H2 + (size_t)(blk * 128 + rl) * DM) + lane;
#pragma unroll
                    for (int jj = 0; jj < 4; ++jj) { const int c = 4 * lane + 256 * jj;
                        const f32x4 x = (f32x4){__uint_as_float(xb[u][jj].x << 16), __uint_as_float(xb[u][jj].x & 0xffff0000u), __uint_as_float(xb[u][jj].y << 16), __uint_as_float(xb[u][jj].y & 0xffff0000u)};
                        const f32x4 g = *(const f32x4*)(g2n + c), a = *(const f32x4*)(sc2 + c), b = *(const f32x4*)(sh2 + c);
                        const f32x4 h = x * rstd * g * (a + 1.f) + b;
                        o4[64 * jj] = pk4_fp8(h.x, h.y, h.z, h.w); } } }
        }
    }
#undef in
}

__device__ __forceinline__ void p7_scatter(Frame& F) {
    FT_DECL;
    LAS int* TOT = (LAS int*)F.lds;
    LAS int* BASE = TOT + 32;
    LAS int* PRE = BASE + 32;
    LAS int* PART = PRE + 32;
    const int* wgcnt = WSP(int, WS_ROUTE + RT_WGCNT); const int* topi_g = WSP(int, WS_ROUTE + RT_TOPI); const float* gate_g = WSP(float, WS_ROUTE + RT_GATE); const int* pos_g = WSP(int, WS_ROUTE + RT_POS);
    int* list = WSP(int, WS_ROUTE + RT_LIST); float* gslot = WSP(float, WS_ROUTE + RT_GSLOT); int* meta = WSP(int, WS_ROUTE + RT_META);
    const unsigned char* H2 = WSP(unsigned char, WS_H); unsigned char* XS = WSP(unsigned char, WS_XS);
    for (int blk = blockIdx.x; blk < MROWS / 128; blk += F.G) {
        __syncthreads();
        { const int e = f_tid & 31, part = f_tid >> 5; int st = 0, sp = 0;
            for (int w = part * 16; w < part * 16 + 16; ++w) { const int c = wgcnt[w * 32 + e]; st += c; if (w < blk) sp += c; }
            PART[part * 32 + e] = st; PART[512 + part * 32 + e] = sp; }
        __syncthreads();
        if (f_tid < 32) { int st = 0, sp = 0;
#pragma unroll
            for (int p = 0; p < 16; ++p) { st += PART[p * 32 + f_tid]; sp += PART[512 + p * 32 + f_tid]; }
            TOT[f_tid] = st; PRE[f_tid] = sp; }
        __syncthreads();
        if (f_tid == 0) { int b = 0; for (int e = 0; e < 32; ++e) { BASE[e] = b; b += (TOT[e] + 255) & ~255; }
            if (blk == 0) { int t = 0; for (int e = 0; e < 32; ++e) { meta[e] = TOT[e]; meta[32 + e] = BASE[e]; const int nt = (TOT[e] + 255) >> 8; for (int q = 0; q < nt; ++q) meta[128 + t + q] = e; t += nt; } meta[64] = t; } }
        __syncthreads();
        { const int a = f_tid, row = blk * 128 + (a >> 2); const int e = topi_g[(size_t)blk * 512 + a]; const int slot = BASE[e] + PRE[e] + pos_g[(size_t)blk * 512 + a];
            list[slot] = row * 4 + (a & 3); gslot[slot] = gate_g[(size_t)blk * 512 + a];
            PART[a] = slot; }
        __syncthreads();
        for (int a0 = F.wave * 8; a0 < 512; a0 += NWAVES * 8) { u32x4 v[8]; int sl[8];
#pragma unroll
            for (int q = 0; q < 8; ++q) { const int a = a0 + q; sl[q] = PART[a]; v[q] = ((const GAS u32x4*)(H2 + (size_t)(blk * 128 + (a >> 2)) * DM))[f_lane]; }
#pragma unroll
            for (int q = 0; q < 8; ++q) ((GAS u32x4*)(XS + (size_t)sl[q] * DM))[f_lane] = v[q]; }
        if (blk < NEXP) { const int e = blk, lo = BASE[e] + TOT[e], hi = BASE[e] + ((TOT[e] + 255) & ~255);
            for (int sl = lo + F.wave; sl < hi; sl += NWAVES) { if (f_lane == 0) { list[sl] = -1; gslot[sl] = 0.f; }
                ((GAS u32x4*)(XS + (size_t)sl * DM))[f_lane] = (u32x4){0u, 0u, 0u, 0u}; } }
    }
}

template <int NPN> struct SchedMoE {
    int G, c, nT; const char* A; const char* W; size_t wstride; const LAS unsigned char* tileE;
    __device__ __forceinline__ bool next(int i, g8::Unit& u) const {
        const int L = i * G + c, xcd = L & 7, j = L >> 3, T = (j / NPN) * 8 + xcd, pn = j % NPN;
        if (T >= nT) return false;
        const int e = tileE[T];
        u.pm = T; u.pn = pn; u.kind = i; u.ex = e; u.a = A + (size_t)T * 256 * DM; u.b = W + (size_t)e * wstride + (size_t)pn * 256 * DM; return true;
    }
};
struct EpiSwiGLU {
    unsigned char* ACT; const float* b1;
    __device__ __forceinline__ void operator()(f32x4 (&acc)[2][2][4][2], const g8::Unit& u, int wr, int wc, int fr, int fq) const {
        asm volatile("" : "+v"(fr), "+v"(fq));
        const int j0 = u.pn * 128 + wc * 32 + 8 * fq; const float* bp = b1 + (size_t)u.ex * 2 * DM + j0;
        f32x4 bg[2], bl[2];
#pragma unroll
        for (int n = 0; n < 2; ++n) { bg[n] = *(const f32x4*)(bp + 4 * n); bl[n] = *(const f32x4*)(bp + DM + 4 * n); }
#pragma unroll
        for (int ai = 0; ai < 2; ++ai)
#pragma unroll
            for (int m = 0; m < 4; ++m) { const size_t slot = (size_t)u.pm * 256 + ai * 128 + wr * 64 + m * 16 + fr; float o[8];
#pragma unroll
                for (int n = 0; n < 2; ++n) { const f32x4 g4 = acc[ai][0][m][n] * (1.f / WSCALE) + bg[n], l4 = acc[ai][1][m][n] * (1.f / WSCALE) + bl[n];
#pragma unroll
                    for (int e = 0; e < 4; ++e) { const float g = fminf(g4[e], 7.f), l = __builtin_amdgcn_fmed3f(l4[e], -7.f, 7.f);
                        const float ex = __builtin_amdgcn_exp2f(g * (-1.702f * 1.4426950408889634f)); const float glu = g * __builtin_amdgcn_rcpf(1.f + ex);
                        o[4 * n + e] = fmaf(l, glu, glu); } }
                u32x2 w; w.x = pk4_fp8(o[0], o[1], o[2], o[3]); w.y = pk4_fp8(o[4], o[5], o[6], o[7]);
                *(u32x2*)(ACT + slot * DM + j0) = w; }
    }
};
struct EpiDown {
    unsigned char* EO; const float* b2; const LAS int* LL; int G, c;
    __device__ __forceinline__ void operator()(f32x4 (&acc)[2][2][4][2], const g8::Unit& u, int wr, int wc, int fr, int fq) const {
        asm volatile("" : "+v"(fr), "+v"(fq));
        const int c0 = u.pn * 256 + wc * 64 + 16 * fq; const float* bp = b2 + (size_t)u.ex * DM + c0;
        f32x4 bb[2][2];
#pragma unroll
        for (int bj = 0; bj < 2; ++bj)
#pragma unroll
            for (int n = 0; n < 2; ++n) bb[bj][n] = *(const f32x4*)(bp + bj * 8 + 4 * n);
        const LAS int* L = LL + u.kind * 512;
        int li[8]; float gt[8];
#pragma unroll
        for (int q = 0; q < 8; ++q) { const int rl = (q >> 2) * 128 + wr * 64 + (q & 3) * 16 + fr; li[q] = L[rl]; gt[q] = __int_as_float(L[256 + rl]) * (1.f / WSCALE); }
#pragma unroll
        for (int ai = 0; ai < 2; ++ai)
#pragma unroll
            for (int m = 0; m < 4; ++m) { const int l = li[ai * 4 + m]; const float g = gt[ai * 4 + m];
                unsigned char* dst = EO + ((size_t)(l & 3) * MROWS + (l >> 2)) * DM + c0;
                u32x4 w;
                { const f32x4 v0 = acc[ai][0][m][0] * g + bb[0][0] * (g * WSCALE), v1 = acc[ai][0][m][1] * g + bb[0][1] * (g * WSCALE);
                  w.x = pk4_fp8(v0[0] * EOSCALE, v0[1] * EOSCALE, v0[2] * EOSCALE, v0[3] * EOSCALE); w.y = pk4_fp8(v1[0] * EOSCALE, v1[1] * EOSCALE, v1[2] * EOSCALE, v1[3] * EOSCALE); }
                { const f32x4 v0 = acc[ai][1][m][0] * g + bb[1][0] * (g * WSCALE), v1 = acc[ai][1][m][1] * g + bb[1][1] * (g * WSCALE);
                  w.z = pk4_fp8(v0[0] * EOSCALE, v0[1] * EOSCALE, v0[2] * EOSCALE, v0[3] * EOSCALE); w.w = pk4_fp8(v1[0] * EOSCALE, v1[1] * EOSCALE, v1[2] * EOSCALE, v1[3] * EOSCALE); }
                if (l >= 0) *(u32x4*)dst = w; }
    }
};
__device__ __forceinline__ const LAS unsigned char* moe_tiles(Frame& F, int& nT) {
    FT_DECL;
    LAS unsigned char* TE = (LAS unsigned char*)(F.lds + RING_BYTES); const int* meta = WSP(int, WS_ROUTE + RT_META);
    __syncthreads();
    nT = meta[64]; if (nT > MAXTILE) nT = MAXTILE;
    for (int i = f_tid; i < MAXTILE; i += 512) TE[i] = (unsigned char)((i < nT) ? meta[128 + i] : 0);
    __syncthreads();
    return (const LAS unsigned char*)TE;
}

__device__ __forceinline__ void p10_combine(Frame& F) {
    FT_DECL;
    const float* mod = WSP(float, WS_SMALL + SM_MOD); const unsigned char* EO = WSP(unsigned char, WS_EO);
    const size_t gt = (size_t)F.vcu * 512 + f_tid, NTH = (size_t)F.G * 512;
    constexpr int U = 4;
    for (size_t i0 = gt; i0 < (size_t)MROWS * 128; i0 += NTH * U) {
        u32x2 ev[U][4]; f32x4 xv[U][2], gv[U][2];
#pragma unroll
        for (int u = 0; u < U; ++u) { const size_t i = i0 + (size_t)u * NTH; const size_t row = i >> 7; const int c0 = (int)(i & 127) * 8;
            const float* g2 = mod + (size_t)(row >> 12) * (NMOD * DM) + 5 * DM + c0; const bf16_t* op = WSP(bf16_t, WS_XN) + row * DM + c0;
#pragma unroll
            for (int k = 0; k < 4; ++k) ev[u][k] = __builtin_nontemporal_load((const u32x2*)(EO + ((size_t)k * MROWS + row) * DM + c0));
            { const u32x4 xb = *(const u32x4*)op; xv[u][0] = (f32x4){__uint_as_float(xb.x << 16), __uint_as_float(xb.x & 0xffff0000u), __uint_as_float(xb.y << 16), __uint_as_float(xb.y & 0xffff0000u)};
              xv[u][1] = (f32x4){__uint_as_float(xb.z << 16), __uint_as_float(xb.z & 0xffff0000u), __uint_as_float(xb.w << 16), __uint_as_float(xb.w & 0xffff0000u)}; }
            gv[u][0] = *(const f32x4*)g2; gv[u][1] = *(const f32x4*)(g2 + 4); }
#pragma unroll
        for (int u = 0; u < U; ++u) { const size_t i = i0 + (size_t)u * NTH; const size_t row = i >> 7; const int c0 = (int)(i & 127) * 8;
            float s[8];
#pragma unroll
            for (int e = 0; e < 8; ++e) s[e] = 0.f;
#pragma unroll
            for (int k = 0; k < 4; ++k) { const u32x2 v = ev[u][k];
                const f32x2 a = __builtin_amdgcn_cvt_pk_f32_fp8((int)v.x, false), b = __builtin_amdgcn_cvt_pk_f32_fp8((int)v.x, true), c = __builtin_amdgcn_cvt_pk_f32_fp8((int)v.y, false), d = __builtin_amdgcn_cvt_pk_f32_fp8((int)v.y, true);
                s[0] += a.x; s[1] += a.y; s[2] += b.x; s[3] += b.y; s[4] += c.x; s[5] += c.y; s[6] += d.x; s[7] += d.y; }
#pragma unroll
            for (int e = 0; e < 8; ++e) s[e] *= (1.f / EOSCALE);
            f32x4 o0 = xv[u][0] + gv[u][0] * (f32x4){s[0], s[1], s[2], s[3]}, o1 = xv[u][1] + gv[u][1] * (f32x4){s[4], s[5], s[6], s[7]};
            float* op = F.out + row * DM + c0;
            __builtin_nontemporal_store(o0, (f32x4*)op); __builtin_nontemporal_store(o1, (f32x4*)(op + 4)); }
    }
}

struct Args { const float* in[34]; float* out; unsigned char* ws; int ph_lo, ph_hi; };
constexpr int N_PHASES = 11;

__global__ void __launch_bounds__(512, 2) mega(Args args) {
    extern __shared__ __attribute__((aligned(16))) unsigned char lds[];
    Frame F;
    F.lds = (LAS unsigned char*)lds;
    F.MISC = (volatile LAS unsigned*)(F.lds + LDSCTL_OFF);
    F.wave = __builtin_amdgcn_readfirstlane(threadIdx.x >> 6);
    FT_DECL;
    F.G = gridDim.x; { const int bx = blockIdx.x; F.vcu = (F.G % 8 == 0) ? (bx % 8) * (F.G / 8) + bx / 8 : bx; }
    F.in = (kin_t)__builtin_amdgcn_kernarg_segment_ptr();
    F.out = args.out; F.ws = args.ws;
    F.ctl = (gu32*)(args.ws + WS_CTL);
    for (int u = f_tid; u < (LDS_BYTES - LDSCTL_OFF) / 4; u += NWAVES * 64) ((LAS unsigned*)(F.lds + LDSCTL_OFF))[u] = 0u;
    __syncthreads();
    const int lo = args.ph_lo, hi = args.ph_hi;
    XcdBarrier bar; bar.bar = (unsigned*)(F.ctl + CW_BAR); bar.x = 0; bar.st = nullptr;
    if (hi - lo > 1) bar = xcd_barrier_post((unsigned*)(F.ctl + CW_BAR), F.MISC + 8, f_tid == 0);
#define IN(k) (lo <= (k) && (k) < hi)
#define SEAM(k) do { if (IN(k) && IN((k) + 1)) xcd_barrier(bar, F.wave == 0 && lane_id() == 0); } while (0)

    if (IN(0)) { p0_prologue(F); } SEAM(0);
    if (IN(1)) { p1_norm1(F); } SEAM(1);
    if (IN(2)) {
        SchedInProj S{F.G, (int)blockIdx.x, (const char*)WSP(bf16_t, WS_H), (const char*)WSP(bf16_t, WS_WIN)};
        EpiInProj E{WSP(unsigned char, WS_Q), WSP(unsigned char, WS_K), WSP(unsigned char, WS_V), WSP(bf16_t, WS_UT), F.in[9], F.in[10], WSP(float, WS_SMALL + SM_ROPE)};
        g8::gemm_phase<false>(F.lds, DM, S, E, F.wave, lane_id());
    } SEAM(2);
    if (IN(3)) { p3_attention8(F); p3_hyena(F); } SEAM(3);
    if (IN(4)) { p4_hynorm(F); } SEAM(4);
    if (IN(5)) {
        SchedStatic S{F.G, (int)blockIdx.x, MROWS / 256, DM / 256, (const char*)WSP(bf16_t, WS_MIX), (const char*)WSP(bf16_t, WS_WOUT)};
        EpiOutProj E{F.in[0], WSP(bf16_t, WS_XN), WSP(float, WS_SMALL + SM_MOD)};
        g8::gemm_phase<false>(F.lds, DM, S, E, F.wave, lane_id());
    } SEAM(5);
    if (IN(6)) { p6_router_mfma(F); } SEAM(6);
    if (IN(7)) { p7_scatter(F); } SEAM(7);
    if (IN(8)) {
        int nT; const LAS unsigned char* TE = moe_tiles(F, nT);
        SchedMoE<8> S{F.G, (int)blockIdx.x, nT, (const char*)WSP(char, WS_XS), (const char*)WSP(char, WS_W1), (size_t)2 * DM * DM, TE};
        EpiSwiGLU E{WSP(unsigned char, WS_ACT), F.in[31]};
        g8::gemm_phase<true>(F.lds, DM, S, E, F.wave, lane_id());
    } SEAM(8);
    if (IN(9)) {
        int nT; const LAS unsigned char* TE = moe_tiles(F, nT);
        SchedMoE<4> S{F.G, (int)blockIdx.x, nT, (const char*)WSP(char, WS_ACT), (const char*)WSP(char, WS_W2), (size_t)DM * DM, TE};
        LAS int* LL = (LAS int*)(F.lds + RING_BYTES + 1024);
        static_assert(RING_BYTES + 1024 + 9 * 2048 <= LDSCTL_OFF, "LDS map");
        { const int* list = WSP(int, WS_ROUTE + RT_LIST); const float* gslot = WSP(float, WS_ROUTE + RT_GSLOT);
            const int t9 = F.wave * 64 + lane_id();
            g8::Unit u; for (int i = 0; i < 9 && S.next(i, u); ++i) { const int t = t9 & 255; const size_t slot = (size_t)u.pm * 256 + t;
                LL[i * 512 + (t9 >> 8) * 256 + t] = (t9 < 256) ? list[slot] : __float_as_int(gslot[slot]); }
            __syncthreads(); }
        EpiDown E{WSP(unsigned char, WS_EO), F.in[33], LL, F.G, (int)blockIdx.x};
        g8::gemm_phase<true>(F.lds, DM, S, E, F.wave, lane_id());
    } SEAM(9);
    if (IN(10)) { p10_combine(F); }
#undef IN
#undef SEAM
}

extern "C" void kernel_launch(void* const* d_in, const int* in_sizes, int n_in, void* d_out, int out_size, void* d_ws, size_t ws_size, hipStream_t stream) {
    static int grid = 0;
    if (grid == 0) {
        if (n_in != 34 || out_size != MROWS * DM || ws_size < WS_END) { fprintf(stderr, "kernel_launch: unexpected shapes: n_in %d out %d ws %zu (need %zu)\n", n_in, out_size, ws_size, (size_t)WS_END); grid = -1; return; }
        int dev = 0, cus = 0, per_cu = 0;
        if (hipGetDevice(&dev) != hipSuccess || hipDeviceGetAttribute(&cus, hipDeviceAttributeMultiprocessorCount, dev) != hipSuccess) { grid = -1; return; }
        if (hipFuncSetAttribute((const void*)mega, hipFuncAttributeMaxDynamicSharedMemorySize, LDS_BYTES) != hipSuccess) { fprintf(stderr, "kernel_launch: hipFuncSetAttribute failed\n"); grid = -1; return; }
        if (hipOccupancyMaxActiveBlocksPerMultiprocessor(&per_cu, (const void*)mega, NWAVES * 64, LDS_BYTES) != hipSuccess || per_cu < 1) { fprintf(stderr, "kernel_launch: occupancy query says %d\n", per_cu); per_cu = 1; }
        (void)hipGetLastError();
        grid = cus;
    }
    if (grid < 0) return;
    (void)hipMemsetAsync((char*)d_ws + WS_CTL, 0, CTL_ZERO_BYTES, stream);
    Args a{};
    for (int i = 0; i < 34; ++i) a.in[i] = (const float*)d_in[i];
    a.out = (float*)d_out; a.ws = (unsigned char*)d_ws;
    constexpr int LAST = MK_LAST_PHASE + 1;
    if (MK_N_LAUNCHES == 1) { a.ph_lo = 0; a.ph_hi = LAST; hipLaunchKernelGGL(mega, dim3(grid), dim3(NWAVES * 64), LDS_BYTES, stream, a); }
    else for (int p = 0; p < LAST; ++p) { a.ph_lo = p; a.ph_hi = p + 1; hipLaunchKernelGGL(mega, dim3(grid), dim3(NWAVES * 64), LDS_BYTES, stream, a); }
    const hipError_t le = hipPeekAtLastError();
    if (le != hipSuccess) fprintf(stderr, "kernel_launch: launch failed: %s\n", hipGetErrorName(le));
}
```

```cpp
#include <hip/hip_runtime.h>
#include <hip/hip_bf16.h>
#include <cstdio>
#include <cstdint>

#ifndef MK_N_LAUNCHES
#define MK_N_LAUNCHES 1
#endif
#ifndef MK_LAST_PHASE
#define MK_LAST_PHASE 10
#endif

#define GAS __attribute__((address_space(1)))
#define LAS __attribute__((address_space(3)))
typedef unsigned short bf16_t;
typedef short bf16x8 __attribute__((ext_vector_type(8)));
typedef short s16x4 __attribute__((ext_vector_type(4)));
typedef float f32x2 __attribute__((ext_vector_type(2)));
typedef float f32x4 __attribute__((ext_vector_type(4)));
typedef float f32x16 __attribute__((ext_vector_type(16)));
typedef unsigned u32x2 __attribute__((ext_vector_type(2)));
typedef unsigned u32x4 __attribute__((ext_vector_type(4)));
typedef GAS unsigned gu32;

constexpr int NB = 8, SEQ = 4096, DM = 1024, MROWS = NB * SEQ, CTXL = 256, MCTX = NB * CTXL, MTOT = MROWS + MCTX;
constexpr int KVL = CTXL + SEQ;
constexpr int NHEAD = 4, QKW = 512;
constexpr int HYW = 512, HYC = 1536, INC = 3072, QKVC = 1536;
constexpr int NEXP = 32, TOPK = 4, NMOD = 6;
constexpr float EPS = 1e-6f;
constexpr float LAM_INIT = 0.2f;
constexpr float QSCALE = 0.125f * 1.4426950408889634f;

constexpr size_t MiB = 1u << 20;
constexpr size_t WS_CTL = 0, CTL_ZERO_BYTES = 64 * 1024;
constexpr size_t WS_SMALL = 1 * MiB;
constexpr size_t WS_WIN = 2 * MiB;
constexpr size_t WS_WOUT = 8 * MiB;
constexpr size_t WS_W1 = 10 * MiB;
constexpr size_t WS_W2 = 138 * MiB;
constexpr size_t WS_H = 202 * MiB;
constexpr size_t WS_Q = 270 * MiB;
constexpr size_t WS_K = 302 * MiB;
constexpr size_t WS_V = 336 * MiB;
constexpr size_t WS_UT = 370 * MiB;
constexpr size_t WS_FILT = 466 * MiB;
constexpr size_t WS_Z2T = 498 * MiB;
constexpr size_t WS_MIX = 530 * MiB;
constexpr size_t WS_ROUTE = 594 * MiB;
constexpr size_t WS_ACT = 270 * MiB;
constexpr size_t WS_EO = 598 * MiB;
constexpr size_t WS_XN = 870 * MiB;
constexpr size_t WS_END = 998 * MiB;
constexpr size_t SM_MOD = 0;
constexpr size_t SM_SCAL = 256 * 1024;
constexpr size_t SM_ROPE = 260 * 1024;
constexpr int CW_BAR = 4096;

constexpr int RING_BYTES = 131072;
constexpr int LDSCTL_OFF = 151552;
constexpr int LDS_BYTES = 152576;
constexpr int NWAVES = 8;

#define LDS_WAIT() asm volatile("s_waitcnt lgkmcnt(0)" ::: "memory")
#define VM_WAIT() asm volatile("s_waitcnt vmcnt(0)" ::: "memory")
#define RLX_AGENT __ATOMIC_RELAXED, __HIP_MEMORY_SCOPE_AGENT

__device__ __forceinline__ unsigned cvt_pk_bf16(float lo, float hi) { unsigned r; asm volatile("v_cvt_pk_bf16_f32 %0, %1, %2" : "=v"(r) : "v"(lo), "v"(hi)); return r; }
__device__ __forceinline__ float bf2f(bf16_t v) { return __uint_as_float(((unsigned)v) << 16); }
__device__ __forceinline__ float wave_sum(float v) {
#pragma unroll
    for (int o = 1; o < 64; o <<= 1) v += __shfl_xor(v, o);
    return v;
}

#define XB_TMO      128
#define XB_XCNT(j)  (256  + 64 * (j))
#define XB_XSUB(j)  (1280 + 64 * (j))
#define XB_XGEN(j)  (2304 + 64 * (j))
#define XB_TOP      3328
#define XB_TOPGEN   3392
#define XCD_BAR_WORDS 3456
#define XB_SPIN_CAP (1u << 22)
__device__ __forceinline__ unsigned xb_ld(unsigned* p)              { return __hip_atomic_load(p, __ATOMIC_RELAXED, __HIP_MEMORY_SCOPE_AGENT); }
__device__ __forceinline__ unsigned xb_add(unsigned* p, unsigned v) { return __hip_atomic_fetch_add(p, v, __ATOMIC_RELAXED, __HIP_MEMORY_SCOPE_AGENT); }
__device__ __forceinline__ unsigned xb_xcc_id() { return (unsigned)__builtin_amdgcn_s_getreg((3 << 11) | 20) & 0xFu; }
#define XB_SPIN(cond, bar) do { unsigned _sp = 0; while (cond) { __builtin_amdgcn_s_sleep(1); \
    if ((++_sp & 255u) == 0u) { if (xb_ld(&(bar)[XB_TMO])) break; if (_sp > XB_SPIN_CAP) { atomicAdd(&(bar)[XB_TMO], 1u); break; } } } } while (0)
struct XcdBarrier { unsigned* bar; unsigned x; volatile LAS unsigned* st; };
__device__ __forceinline__ XcdBarrier xcd_barrier_post(unsigned* bar, volatile LAS unsigned* st, bool leader) {
    XcdBarrier b; b.bar = bar; b.x = xb_xcc_id(); b.st = st;
    if (leader) (void)xb_add(&bar[XB_XCNT(b.x)], 1u);
    return b;
}
__device__ __forceinline__ void xcd_barrier_complete(unsigned* bar, unsigned x, unsigned& nloc, unsigned& nx) {
    const unsigned G = gridDim.x * gridDim.y * gridDim.z;
    unsigned sum, cnt, mine, sp = 0u;
    for (;;) {
        sum = 0u; cnt = 0u; mine = 0u;
#pragma unroll
        for (unsigned j = 0; j < 16; ++j) { const unsigned c = xb_ld(&bar[XB_XCNT(j)]); sum += c; cnt += (c > 0u) ? 1u : 0u; mine = (j == x) ? c : mine; }
        if (sum == G) break;
        __builtin_amdgcn_s_sleep(1);
        if ((++sp & 255u) == 0u) { if (xb_ld(&bar[XB_TMO])) break; if (sp > XB_SPIN_CAP) { atomicAdd(&bar[XB_TMO], 1u); break; } }
    }
    nloc = mine > 0u ? mine : 1u; nx = cnt > 0u ? cnt : 1u;
}
__device__ __forceinline__ void xcd_barrier(const XcdBarrier& b, bool leader) {
    asm volatile("s_waitcnt vmcnt(0)" ::: "memory");
    __syncthreads();
    if (leader) {
        unsigned* bar = b.bar;
        __builtin_amdgcn_s_waitcnt(0);
        unsigned nloc = b.st[0], nx = b.st[1];
        if (nloc == 0u) { xcd_barrier_complete(bar, b.x, nloc, nx); b.st[0] = nloc; b.st[1] = nx; }
        const unsigned old = xb_add(&bar[XB_XSUB(b.x)], 1u);
        const unsigned gen = old / nloc;
        if (old + 1u == (gen + 1u) * nloc) {
            __builtin_amdgcn_fence(__ATOMIC_RELEASE, "agent");
            asm volatile("s_waitcnt vmcnt(0)" ::: "memory");
            const unsigned og = xb_add(&bar[XB_TOP], 1u);
            const unsigned tg = og / nx;
            if (og + 1u == (tg + 1u) * nx) xb_add(&bar[XB_TOPGEN], 1u);
            else XB_SPIN(xb_ld(&bar[XB_TOPGEN]) == tg, bar);
            __builtin_amdgcn_fence(__ATOMIC_ACQUIRE, "agent");
            xb_add(&bar[XB_XGEN(b.x)], 1u);
            asm volatile("s_waitcnt vmcnt(0)" ::: "memory");
        } else {
            XB_SPIN(xb_ld(&bar[XB_XGEN(b.x)]) == gen, bar);
            __builtin_amdgcn_fence(__ATOMIC_ACQUIRE, "agent");
            asm volatile("s_waitcnt vmcnt(0)" ::: "memory");
        }
    }
    __syncthreads();
}

namespace g8 {
constexpr int BM = 256, BK = 64, HALF = 128, HTB = HALF * BK * 2, STAGE_BYTES = 8 * HTB, NXCD = 8, WGM = 8;
__host__ __device__ __forceinline__ int lds_byte(int r, int c) { const int st = (r >> 4) * 2 + (c >> 5), rr = r & 15, cc = c & 31, ob = rr * 64 + cc * 2; return st * 1024 + (ob ^ (((ob >> 9) & 1) << 5)); }
__host__ __device__ __forceinline__ void stage_rc(int b, int& R, int& C) { const int st = b / 1024, sb = b % 1024, swz = sb ^ (((sb >> 9) & 1) << 5); R = (st >> 1) * 16 + swz / 64; C = (st & 1) * 32 + (swz % 64) / 2; }
__host__ __device__ __forceinline__ int perm32(int rho) { const int n = rho >> 4, i = rho & 15; return 8 * (i >> 2) + 4 * n + (i & 3); }

struct Unit { const char* a; const char* b; int pm, pn, kind, ex; };

__device__ __forceinline__ void tile_of(int L, int nM, int nN, int& pm, int& pn) {
    const int nwg = nM * nN; int wgid = L;
    { const int q = nwg / NXCD, r = nwg % NXCD, xcd = wgid % NXCD, off = wgid / NXCD; wgid = (xcd < r ? xcd * (q + 1) : r * (q + 1) + (xcd - r) * q) + off; }
    const int nig = WGM * nN, gid = wgid / nig, fm = gid * WGM, gsz = (nM - fm) < WGM ? (nM - fm) : WGM;
    pm = fm + ((wgid % nig) % gsz); pn = (wgid % nig) / gsz;
}

typedef int i32x8 __attribute__((ext_vector_type(8)));
template <bool FP8, bool GATHER, class Epi, class Sched>
__device__ __forceinline__ void gemm_phase_g(LAS unsigned char* lds, const int K, const Sched& S, const Epi& E, const int wid, const int lane) {
    const int tid = wid * 64 + lane, wr = wid >> 2, wc = wid & 3, fr = lane & 15, fq = lane >> 4;
    const int nt = FP8 ? K / 128 : K / BK;
    const int RP = FP8 ? K : 2 * K;
    unsigned voffA[2], voffB[2]; int srow[2], scol[2];
#pragma unroll
    for (int i = 0; i < 2; ++i) { int R, C; stage_rc(tid * 16 + i * 8192, R, C); const int Rb = (R & ~31) + perm32(R & 31);
        voffA[i] = (unsigned)(R * RP + C * 2); voffB[i] = (unsigned)(Rb * RP + C * 2); srow[i] = R; scol[i] = C * 2; }
    const size_t kstep = (size_t)(BK * 2);
    const size_t hstep = (size_t)HALF * RP;
    const unsigned ldsw = (unsigned)wid * 1024u;
    unsigned cO0[2], cO1[2], nO0[2], nO1[2];
#define PG8_GOFF(D0, D1, ui_) do { if constexpr (GATHER) { const LAS int* rw_ = S.rows(ui_); _Pragma("unroll") for (int i_ = 0; i_ < 2; ++i_) { \
        D0[i_] = (unsigned)rw_[srow[i_]] * (unsigned)RP + (unsigned)scol[i_]; D1[i_] = (unsigned)rw_[128 + srow[i_]] * (unsigned)RP + (unsigned)scol[i_]; } } \
      else { _Pragma("unroll") for (int i_ = 0; i_ < 2; ++i_) { D0[i_] = voffA[i_]; D1[i_] = voffA[i_] + (unsigned)hstep; } } } while (0)
    const int aoff = lds_byte(wr * 64 + fr, FP8 ? fq * 16 : fq * 8), boff = lds_byte(wc * 32 + fr, FP8 ? fq * 16 : fq * 8);
    constexpr int KOFF = FP8 ? 16 : 1024;
#define PG8_SA(b, h) (((b) * 2 + (h)) * HTB)
#define PG8_SB(b, h) ((4 + (b) * 2 + (h)) * HTB)
#define PG8_STAGE(bufoff, gbase, voff) do { _Pragma("unroll") for (int _i = 0; _i < 2; ++_i) \
        __builtin_amdgcn_global_load_lds((const unsigned*)((const char*)(gbase) + (voff)[_i]), (LAS unsigned*)(lds + (bufoff) + ldsw + _i * 8192), 16, 0, 0); } while (0)
#define PG8_LD32(p) __builtin_bit_cast(i32x8, __builtin_shufflevector(*(const LAS u32x4*)(p), *(const LAS u32x4*)((p) + 16), 0, 1, 2, 3, 4, 5, 6, 7))
#define PG8_LDA8(dst, b, h) do { _Pragma("unroll") for (int m = 0; m < 4; ++m) dst[m] = PG8_LD32(lds + PG8_SA(b, h) + aoff + m * 2048); } while (0)
#define PG8_LDB8(dst, b, h) do { _Pragma("unroll") for (int n = 0; n < 2; ++n) dst[n] = PG8_LD32(lds + PG8_SB(b, h) + boff + n * 2048); } while (0)
#define PG8_LDA(dst, b, h) do { _Pragma("unroll") for (int m = 0; m < 4; ++m) _Pragma("unroll") for (int k = 0; k < 2; ++k) dst[m][k] = *(const LAS bf16x8*)(lds + PG8_SA(b, h) + aoff + m * 2048 + k * KOFF); } while (0)
#define PG8_LDB(dst, b, h) do { _Pragma("unroll") for (int n = 0; n < 2; ++n) _Pragma("unroll") for (int k = 0; k < 2; ++k) dst[n][k] = *(const LAS bf16x8*)(lds + PG8_SB(b, h) + boff + n * 2048 + k * KOFF); } while (0)
#define PG8_MMA(ai, bj, At, Bt) do { __builtin_amdgcn_s_setprio(1); _Pragma("unroll") for (int m = 0; m < 4; ++m) _Pragma("unroll") for (int n = 0; n < 2; ++n) _Pragma("unroll") for (int k = 0; k < 2; ++k) \
        acc[ai][bj][m][n] = __builtin_amdgcn_mfma_f32_16x16x32_bf16(Bt[n][k], At[m][k], acc[ai][bj][m][n], 0, 0, 0); __builtin_amdgcn_s_setprio(0); } while (0)
#define PG8_MMA8(ai, bj, At, Bt) do { __builtin_amdgcn_s_setprio(1); _Pragma("unroll") for (int m = 0; m < 4; ++m) _Pragma("unroll") for (int n = 0; n < 2; ++n) \
        asm volatile("v_mfma_scale_f32_16x16x128_f8f6f4 %0, %1, %2, %0, %3, %3 op_sel_hi:[0,0,0]" : "+v"(acc[ai][bj][m][n]) : "v"(Bt[n]), "v"(At[m]), "v"(one_scale)); __builtin_amdgcn_s_setprio(0); } while (0)
#define PG8_WAIT_V(n) asm volatile("s_waitcnt vmcnt(" #n ")" ::: "memory")
#define PG8_WAIT_L(n) asm volatile("s_waitcnt lgkmcnt(" #n ")" ::: "memory")
#define PG8_BAR __builtin_amdgcn_s_barrier()
#define PG8_SCHED __builtin_amdgcn_sched_barrier(0)
    Unit cur, nxt; int ui = 0;
    if (!S.next(0, cur)) return;
    f32x4 acc[2][2][4][2];
#pragma unroll
    for (int a = 0; a < 2; ++a)
#pragma unroll
        for (int b = 0; b < 2; ++b)
#pragma unroll
            for (int m = 0; m < 4; ++m)
#pragma unroll
                for (int n = 0; n < 2; ++n) acc[a][b][m][n] = (f32x4){0.f, 0.f, 0.f, 0.f};
    bf16x8 At[4][2], B0[2][2], B1[2][2];
    i32x8 At8[4], B08[2], B18[2];
    const unsigned one_scale = 0x7f7f7f7fu;
    const char* cA = cur.a; const char* cB = cur.b;
    PG8_GOFF(cO0, cO1, 0);
    PG8_STAGE(PG8_SB(0, 0), cB, voffB); PG8_STAGE(PG8_SB(0, 1), cB + hstep, voffB); PG8_STAGE(PG8_SA(0, 0), cA, cO0); PG8_STAGE(PG8_SA(0, 1), cA, cO1);
    if (wr == 1) PG8_BAR;
    PG8_WAIT_V(2); PG8_BAR;
    PG8_STAGE(PG8_SB(1, 0), cB + kstep, voffB); PG8_STAGE(PG8_SA(1, 0), cA + kstep, cO0); PG8_STAGE(PG8_SB(1, 1), cB + hstep + kstep, voffB);
    PG8_WAIT_V(6); PG8_BAR;
    for (;;) {
        const bool has_next = S.next(ui + 1, nxt);
        const char* nA = has_next ? nxt.a : cA; const char* nB = has_next ? nxt.b : cB;
        if (has_next) PG8_GOFF(nO0, nO1, ui + 1); else { _Pragma("unroll") for (int i_ = 0; i_ < 2; ++i_) { nO0[i_] = cO0[i_]; nO1[i_] = cO1[i_]; } }
#pragma unroll 1
        for (int t = 0; t < nt; t += 2) {
            const bool last = (t == nt - 2);
            const char* a1 = cA + (size_t)(t + 1) * kstep;
            const char* a2 = last ? nA : cA + (size_t)(t + 2) * kstep; const char* b2 = last ? nB : cB + (size_t)(t + 2) * kstep;
            const char* a3 = a2 + kstep; const char* b3 = b2 + kstep;
            unsigned o20[2], o21[2];
#pragma unroll
            for (int i_ = 0; i_ < 2; ++i_) { o20[i_] = last ? nO0[i_] : cO0[i_]; o21[i_] = last ? nO1[i_] : cO1[i_]; }
            if constexpr (FP8) {
            PG8_LDB8(B08, 0, 0); PG8_LDB8(B18, 0, 1); PG8_SCHED; PG8_LDA8(At8, 0, 0); PG8_STAGE(PG8_SA(1, 1), a1, cO1);
            PG8_WAIT_V(8); PG8_WAIT_L(0); PG8_BAR; PG8_MMA8(0, 0, At8, B08); PG8_MMA8(0, 1, At8, B18); PG8_BAR; PG8_SCHED;
            PG8_LDA8(At8, 0, 1); PG8_STAGE(PG8_SB(0, 0), b2, voffB); PG8_STAGE(PG8_SB(0, 1), b2 + hstep, voffB); PG8_STAGE(PG8_SA(0, 0), a2, o20);
            PG8_WAIT_V(8); PG8_WAIT_L(0); PG8_BAR; PG8_MMA8(1, 0, At8, B08); PG8_MMA8(1, 1, At8, B18); PG8_BAR; PG8_SCHED;
            PG8_LDB8(B08, 1, 0); PG8_LDB8(B18, 1, 1); PG8_SCHED; PG8_LDA8(At8, 1, 0); PG8_STAGE(PG8_SA(0, 1), a2, o21);
            PG8_WAIT_V(8); PG8_WAIT_L(0); PG8_BAR; PG8_MMA8(0, 0, At8, B08); PG8_MMA8(0, 1, At8, B18); PG8_BAR; PG8_SCHED;
            PG8_LDA8(At8, 1, 1); PG8_STAGE(PG8_SB(1, 0), b3, voffB); PG8_STAGE(PG8_SB(1, 1), b3 + hstep, voffB); PG8_STAGE(PG8_SA(1, 0), a3, o20);
            PG8_WAIT_V(8); PG8_WAIT_L(0); PG8_BAR; PG8_MMA8(1, 0, At8, B08); PG8_MMA8(1, 1, At8, B18); PG8_BAR; PG8_SCHED;
            } else {
            PG8_LDB(B0, 0, 0); PG8_LDB(B1, 0, 1); PG8_SCHED; PG8_LDA(At, 0, 0); PG8_STAGE(PG8_SA(1, 1), a1, cO1);
            PG8_WAIT_V(8); PG8_WAIT_L(0); PG8_BAR; PG8_MMA(0, 0, At, B0); PG8_MMA(0, 1, At, B1); PG8_BAR; PG8_SCHED;
            PG8_LDA(At, 0, 1); PG8_STAGE(PG8_SB(0, 0), b2, voffB); PG8_STAGE(PG8_SB(0, 1), b2 + hstep, voffB); PG8_STAGE(PG8_SA(0, 0), a2, o20);
            PG8_WAIT_V(8); PG8_WAIT_L(0); PG8_BAR; PG8_MMA(1, 0, At, B0); PG8_MMA(1, 1, At, B1); PG8_BAR; PG8_SCHED;
            PG8_LDB(B0, 1, 0); PG8_LDB(B1, 1, 1); PG8_SCHED; PG8_LDA(At, 1, 0); PG8_STAGE(PG8_SA(0, 1), a2, o21);
            PG8_WAIT_V(8); PG8_WAIT_L(0); PG8_BAR; PG8_MMA(0, 0, At, B0); PG8_MMA(0, 1, At, B1); PG8_BAR; PG8_SCHED;
            PG8_LDA(At, 1, 1); PG8_STAGE(PG8_SB(1, 0), b3, voffB); PG8_STAGE(PG8_SB(1, 1), b3 + hstep, voffB); PG8_STAGE(PG8_SA(1, 0), a3, o20);
            PG8_WAIT_V(8); PG8_WAIT_L(0); PG8_BAR; PG8_MMA(1, 0, At, B0); PG8_MMA(1, 1, At, B1); PG8_BAR; PG8_SCHED;
            }
        }
        if (wr == 0) PG8_BAR;
        if constexpr (FP8) asm volatile("s_nop 15\n\ts_nop 15" ::: "memory");
        E(acc, cur, wr, wc, fr, fq);
        if (!has_next) break;
#pragma unroll
        for (int a = 0; a < 2; ++a)
#pragma unroll
            for (int b = 0; b < 2; ++b)
#pragma unroll
                for (int m = 0; m < 4; ++m)
#pragma unroll
                    for (int n = 0; n < 2; ++n) acc[a][b][m][n] = (f32x4){0.f, 0.f, 0.f, 0.f};
        cur = nxt; cA = nA; cB = nB; ++ui;
#pragma unroll
        for (int i_ = 0; i_ < 2; ++i_) { cO0[i_] = nO0[i_]; cO1[i_] = nO1[i_]; }
        if (wr == 1) PG8_BAR;
    }
    PG8_WAIT_V(0);
    PG8_BAR;
#undef PG8_SA
#undef PG8_GOFF
#undef PG8_SB
#undef PG8_STAGE
#undef PG8_LDA
#undef PG8_LDB
#undef PG8_MMA
#undef PG8_MMA8
#undef PG8_LDA8
#undef PG8_LDB8
#undef PG8_LD32
#undef PG8_WAIT_V
#undef PG8_WAIT_L
#undef PG8_BAR
#undef PG8_SCHED
}
template <bool FP8, class Epi, class Sched>
__device__ __forceinline__ void gemm_phase(LAS unsigned char* lds, const int K, const Sched& S, const Epi& E, const int wid, const int lane) { gemm_phase_g<FP8, false>(lds, K, S, E, wid, lane); }
}

__device__ __forceinline__ int lane_id() { int l; asm volatile("v_mbcnt_lo_u32_b32 %0, -1, 0\n\tv_mbcnt_hi_u32_b32 %0, -1, %0" : "=v"(l)); return l; }
#define FT_DECL const int f_lane = lane_id(), f_tid = F.wave * 64 + f_lane; (void)f_tid; (void)f_lane
typedef const float* cfp_t;
typedef __attribute__((address_space(4))) cfp_t* kin_t;
struct Frame {
    LAS unsigned char* lds;
    volatile LAS unsigned* MISC;
    gu32* ctl;
    int wave, vcu, G;
    kin_t in;
    float* out;
    unsigned char* ws;
};
#define WSP(T, off) ((T*)(F.ws + (off)))

template <class RowMap>
__device__ __forceinline__ void p0_transpose_item(const float* W, int K, int N, bf16_t* WT, const RowMap& rowmap, const float* kscale, LAS float* scr, int item, int lane) {
    const int nblk = N / 32, kb = item / nblk, nb = item % nblk, k0 = 64 * kb, n0 = 32 * nb;
#pragma unroll 8
    for (int i = 0; i < 32; ++i) { const int kk = 2 * i + (lane >> 5); float v = W[(size_t)(k0 + kk) * N + n0 + (lane & 31)]; if (kscale) v *= kscale[k0 + kk]; scr[kk * 33 + (lane & 31)] = v; }
    LDS_WAIT(); asm volatile("" ::: "memory");
    const int c = lane & 7;
#pragma unroll
    for (int j = 0; j < 4; ++j) { const int n = (lane >> 3) + 8 * j; const LAS float* s = scr + (8 * c) * 33 + n;
        u32x4 o; o.x = cvt_pk_bf16(s[0 * 33], s[1 * 33]); o.y = cvt_pk_bf16(s[2 * 33], s[3 * 33]); o.z = cvt_pk_bf16(s[4 * 33], s[5 * 33]); o.w = cvt_pk_bf16(s[6 * 33], s[7 * 33]);
        *(GAS u32x4*)(WT + (size_t)rowmap(n0 + n) * K + k0 + 8 * c) = o; }
    LDS_WAIT(); asm volatile("" ::: "memory");
}

__device__ __forceinline__ unsigned pk4_fp8(float a, float b, float c, float d) { int r = __builtin_amdgcn_cvt_pk_fp8_f32(a, b, 0, false); r = __builtin_amdgcn_cvt_pk_fp8_f32(c, d, r, true); return (unsigned)r; }
constexpr float EOSCALE = 16.f;
constexpr float WSCALE = 32.f;
template <class RowMap>
__device__ __forceinline__ void p0_transpose_item_f8(const float* W, int K, int N, unsigned char* WT, const RowMap& rowmap, LAS float* scr, int item, int lane) {
    const int nblk = N / 32, kb = item / nblk, nb = item % nblk, k0 = 128 * kb, n0 = 32 * nb;
#pragma unroll
    for (int hh = 0; hh < 2; ++hh) { float v[32];
#pragma unroll
        for (int i = 0; i < 32; ++i) { const int kk = 2 * (32 * hh + i) + (lane >> 5); v[i] = __builtin_nontemporal_load(W + (size_t)(k0 + kk) * N + n0 + (lane & 31)); }
#pragma unroll
        for (int i = 0; i < 32; ++i) { const int kk = 2 * (32 * hh + i) + (lane >> 5); scr[kk * 33 + (lane & 31)] = v[i] * WSCALE; } }
    LDS_WAIT(); asm volatile("" ::: "memory");
    const int c = lane & 7;
#pragma unroll
    for (int j = 0; j < 4; ++j) { const int n = (lane >> 3) + 8 * j; const LAS float* sp = scr + (16 * c) * 33 + n;
        u32x4 o; o.x = pk4_fp8(sp[0 * 33], sp[1 * 33], sp[2 * 33], sp[3 * 33]); o.y = pk4_fp8(sp[4 * 33], sp[5 * 33], sp[6 * 33], sp[7 * 33]);
        o.z = pk4_fp8(sp[8 * 33], sp[9 * 33], sp[10 * 33], sp[11 * 33]); o.w = pk4_fp8(sp[12 * 33], sp[13 * 33], sp[14 * 33], sp[15 * 33]);
        *(GAS u32x4*)(WT + (size_t)rowmap(n0 + n) * K + k0 + 16 * c) = o; }
    LDS_WAIT(); asm volatile("" ::: "memory");
}
struct MapW2 { __device__ __forceinline__ int operator()(int l) const { const int t = l & ~255, r = l & 255, wc = r >> 6, fq = (r >> 4) & 3, bj = (r >> 3) & 1, low = r & 7; return t + 128 * bj + 32 * wc + 8 * fq + low; } };
struct MapIdent { int off; __device__ __forceinline__ int operator()(int n) const { return off + n; } };
struct MapWin { __device__ __forceinline__ int operator()(int l) const {
    if (l >= 1024) return l;
    const int t = l & ~255, r = l & 255, wc = r >> 6, blk = (r >> 5) & 1, bj = (r >> 4) & 1, low = r & 15;
    return t + 128 * bj + 32 * wc + 16 * blk + low; } };
struct MapW1 { int off; __device__ __forceinline__ int operator()(int jp) const { const int bj = jp >> 10, j = jp & 1023; return off + 256 * (j >> 7) + 128 * bj + (j & 127); } };


__device__ __forceinline__ void p0_filter_item(Frame& F, int item) {
    FT_DECL;
#define in F.in
    LAS float* h1s = (LAS float*)(F.lds);
    LAS float* h2s = (LAS float*)(F.lds + 4096);
    const int t0 = item * 16;
    {
        const int tt = f_tid >> 5, hh = (f_tid & 31) * 2; const float pos = (float)(t0 + tt);
        float feats[17]; feats[0] = pos * (1.f / SEQ);
#pragma unroll
        for (int i = 0; i < 8; ++i) { const float band = 1e-4f + (float)i * ((7.f - 1e-4f) / 7.f); const float ang = (6.283185307179586f / SEQ) * pos * band; feats[1 + i] = __sinf(ang); feats[9 + i] = __cosf(ang); }
#pragma unroll
        for (int u = 0; u < 2; ++u) { const int h = hh + u; float a = in[19][h];
#pragma unroll
            for (int k = 0; k < 17; ++k) a += feats[k] * in[18][k * 64 + h];
            h1s[tt * 64 + h] = __sinf(in[20][h] * a); }
        __syncthreads();
#pragma unroll
        for (int u = 0; u < 2; ++u) { const int h = hh + u; float a = in[22][h];
#pragma unroll 8
            for (int k = 0; k < 64; ++k) a += h1s[tt * 64 + k] * in[21][k * 64 + h];
            h2s[tt * 64 + h] = __sinf(in[23][h] * a); }
        __syncthreads();
    }
    f32x4 acc[16];
#pragma unroll
    for (int t = 0; t < 16; ++t) acc[t] = (f32x4){0.f, 0.f, 0.f, 0.f};
    const int o = 4 * f_tid;
    for (int k0 = 0; k0 < 64; k0 += 4) { f32x4 w[4];
#pragma unroll
        for (int q = 0; q < 4; ++q) w[q] = *(const f32x4*)(in[24] + (size_t)(k0 + q) * 2048 + o);
#pragma unroll
        for (int t = 0; t < 16; ++t) { const f32x4 hv = *(const LAS f32x4*)(h2s + t * 64 + k0); acc[t] += w[0] * hv[0] + w[1] * hv[1] + w[2] * hv[2] + w[3] * hv[3]; } }
    const int c0 = o & 511, od = o >> 9;
    float* dst = WSP(float, WS_FILT) + ((size_t)od * 512 + c0) * SEQ + t0;
#pragma unroll
    for (int e = 0; e < 4; ++e) { const float la = -3.0701134573253944f, lb = -15.350567286626972f; const float delta = fabsf(la + (float)(c0 + e) * ((lb - la) / 511.f));
#pragma unroll
        for (int q = 0; q < 4; ++q) { f32x4 v;
#pragma unroll
            for (int i = 0; i < 4; ++i) { const int t = 4 * q + i; const float tn = (float)(t0 + t) * (1.f / SEQ); v[i] = acc[t][e] * __expf(-tn * delta); }
            *(f32x4*)(dst + (size_t)e * SEQ + 4 * q) = v; } }
    __syncthreads();
#undef in
}

__device__ __forceinline__ float silu_f(float v) { return v / (1.f + __expf(-v)); }

__device__ __forceinline__ void p0_prologue(Frame& F) {
    FT_DECL;
#define in F.in
    const int wg = blockIdx.x;
    if (wg < 96) {
        LAS float* sv = (LAS float*)F.lds;
        for (int i = f_tid; i < 9 * 1024; i += 512) { const int r = i >> 10, k = i & 1023; const float c = (r < 8) ? in[1][r * 1024 + k] : in[3][k]; sv[i] = silu_f(c); }
        __syncthreads();
        const int j = wg * 64 + f_lane; const float* wm = in[4];
        float acc[9];
#pragma unroll
        for (int r = 0; r < 9; ++r) acc[r] = 0.f;
        const int kbeg = F.wave * 128;
#pragma unroll 4
        for (int k = kbeg; k < kbeg + 128; ++k) { const float w = wm[(size_t)k * (NMOD * DM) + j];
#pragma unroll
            for (int r = 0; r < 9; ++r) acc[r] += sv[r * 1024 + k] * w; }
        LAS float* red = (LAS float*)(F.lds + 40960);
#pragma unroll
        for (int r = 0; r < 9; ++r) red[(F.wave * 9 + r) * 64 + f_lane] = acc[r];
        __syncthreads();
        for (int i = f_tid; i < 9 * 64; i += 512) { const int r = i >> 6, l = i & 63; float s = in[5][wg * 64 + l];
#pragma unroll
            for (int w = 0; w < 8; ++w) s += red[(w * 9 + r) * 64 + l];
            WSP(float, WS_SMALL + SM_MOD)[r * (NMOD * DM) + wg * 64 + l] = s; }
        __syncthreads();
    } else if (wg == 96) {
        if (F.wave == 0) {
            const float a = wave_sum(in[11][f_lane] * in[12][f_lane]), b = wave_sum(in[13][f_lane] * in[14][f_lane]);
            float gq = fabsf(in[9][f_lane]), gk = fabsf(in[10][f_lane]);
#pragma unroll
            for (int o = 1; o < 64; o <<= 1) { gq = fmaxf(gq, __shfl_xor(gq, o)); gk = fmaxf(gk, __shfl_xor(gk, o)); }
            if (f_lane == 0) { float* sc = WSP(float, WS_SMALL + SM_SCAL); sc[0] = expf(a) - expf(b) + LAM_INIT;
                sc[1] = (8.f * gq * gk * 1.02f + 0.05f) * 1.4426950408889634f; }
        }
        for (int i = f_tid; i < 64 * 16; i += 512) { const int pos = i >> 4, f = i & 15;
            const float inv = powf(10000.f, -(float)f / 16.f); const float ang = (float)pos * inv;
            float* rt = WSP(float, WS_SMALL + SM_ROPE); rt[2 * i] = cosf(ang); rt[2 * i + 1] = sinf(ang); }
    }
    __syncthreads();
    for (int it = wg; it < SEQ / 16; it += F.G) p0_filter_item(F, it);
    __syncthreads();
    {
        LAS float* scr = (LAS float*)(F.lds + F.wave * 16896);
        const int gw = F.vcu * NWAVES + F.wave, NGW = F.G * NWAVES;
        constexpr int I_IN = (DM / 64) * (INC / 32), I_OUT = (DM / 64) * (DM / 32), I_1 = (DM / 128) * (2 * DM / 32), I_2 = (DM / 128) * (DM / 32);
        constexpr int NITEMS = I_IN + I_OUT + NEXP * (I_1 + I_2);
        for (int it = gw; it < NITEMS; it += NGW) {
            int r = it;
            if (r < I_IN) { p0_transpose_item(in[8], DM, INC, WSP(bf16_t, WS_WIN), MapWin{}, nullptr, scr, r, f_lane); continue; } r -= I_IN;
            if (r < I_OUT) { p0_transpose_item(in[27], DM, DM, WSP(bf16_t, WS_WOUT), MapIdent{0}, nullptr, scr, r, f_lane); continue; } r -= I_OUT;
            const int e = r / (I_1 + I_2); r -= e * (I_1 + I_2);
            if (r < I_1) p0_transpose_item_f8(in[30] + (size_t)e * DM * 2 * DM, DM, 2 * DM, WSP(unsigned char, WS_W1) + (size_t)e * 2 * DM * DM, MapW1{0}, scr, r, f_lane);
            else p0_transpose_item_f8(in[32] + (size_t)e * DM * DM, DM, DM, WSP(unsigned char, WS_W2) + (size_t)e * DM * DM, MapW2{}, scr, r - I_1, f_lane);
        }
    }
}
#undef in

__device__ __forceinline__ void p1_norm1(Frame& F) {
    FT_DECL;
    const int gw = F.vcu * NWAVES + F.wave, NGW = F.G * NWAVES;
    const float* mod = WSP(float, WS_SMALL + SM_MOD); const float* g1 = F.in[6];
    bf16_t* H = WSP(bf16_t, WS_H);
    constexpr int RU = 4;
    for (int m0 = gw; m0 < MTOT; m0 += NGW * RU) {
        f32x4 v[RU][4];
#pragma unroll
        for (int u = 0; u < RU; ++u) { const int m = m0 + u * NGW; if (m < MTOT) {
            const float* xrow = (m < MROWS) ? F.in[0] + (size_t)m * DM : F.in[2] + (size_t)(m - MROWS) * DM; const GAS f32x4* xr = (const GAS f32x4*)xrow + f_lane;
#pragma unroll
            for (int j = 0; j < 4; ++j) v[u][j] = __builtin_nontemporal_load(xr + 64 * j); } }
#pragma unroll
        for (int u = 0; u < RU; ++u) { const int m = m0 + u * NGW; if (m < MTOT) {
            const int mb = (m < MROWS) ? (m >> 12) : 8;
            const float* sh = mod + (size_t)mb * (NMOD * DM); const float* sc = sh + DM;
            float s = 0.f;
#pragma unroll
            for (int j = 0; j < 4; ++j) s += (v[u][j].x * v[u][j].x + v[u][j].y * v[u][j].y) + (v[u][j].z * v[u][j].z + v[u][j].w * v[u][j].w);
            const float rstd = rsqrtf(wave_sum(s) * (1.f / DM) + EPS);
            GAS u32x2* o8 = (GAS u32x2*)(H + (size_t)m * DM) + f_lane;
#pragma unroll
            for (int j = 0; j < 4; ++j) { const int c = 4 * f_lane + 256 * j;
                const f32x4 g = *(const f32x4*)(g1 + c), a = *(const f32x4*)(sc + c), b = *(const f32x4*)(sh + c);
                const f32x4 y = v[u][j] * rstd * g * (a + 1.f) + b;
                u32x2 w; w.x = cvt_pk_bf16(y.x, y.y); w.y = cvt_pk_bf16(y.z, y.w); o8[64 * j] = w; } } }
    }
}

struct SchedInProj {
    int G, c; const char* H; const char* W;
    static constexpr int NA = 136 * 4, NV = 2 * 136, NBU = 6 * 128;
    __device__ __forceinline__ bool next(int i, g8::Unit& u) const {
        const long L = (long)i * G + c;
        if (L < NA) { g8::tile_of((int)L, 136, 4, u.pm, u.pn); u.a = H + (size_t)u.pm * 256 * DM * 2; u.b = W + (size_t)u.pn * 256 * DM * 2; u.kind = 0; u.ex = 0; return true; }
        if (L < NA + NV) { g8::tile_of((int)L - NA, 2, 136, u.pm, u.pn); u.a = W + (size_t)(1024 + u.pm * 256) * DM * 2; u.b = H + (size_t)u.pn * 256 * DM * 2; u.kind = 2; u.ex = 0; return true; }
        if (L < NA + NV + NBU) { g8::tile_of((int)L - NA - NV, 6, 128, u.pm, u.pn); u.a = W + (size_t)(QKVC + u.pm * 256) * DM * 2; u.b = H + (size_t)u.pn * 256 * DM * 2; u.kind = 1; u.ex = 0; return true; }
        return false;
    }
};
constexpr float Q8SCALE = 16.f;
struct EpiInProj {
    unsigned char *Q8, *K8, *VT8; bf16_t* UT; const float *gq, *gk, *rope;
    __device__ __forceinline__ void operator()(f32x4 (&acc)[2][2][4][2], const g8::Unit& u, int wr, int wc, int fr, int fq) const {
        asm volatile("" : "+v"(fr), "+v"(fq));
        if (u.kind == 1) {
            const int row0 = u.pm * 256 + wr * 64 + fr, col0 = u.pn * 256 + wc * 32 + 8 * fq;
#pragma unroll
            for (int ai = 0; ai < 2; ++ai)
#pragma unroll
                for (int m = 0; m < 4; ++m) { bf16_t* rowp = UT + (size_t)(row0 + ai * 128 + m * 16) * MROWS + col0;
#pragma unroll
                    for (int bj = 0; bj < 2; ++bj) { const f32x4 v0 = acc[ai][bj][m][0], v1 = acc[ai][bj][m][1];
                        u32x4 w; w.x = cvt_pk_bf16(v0[0], v0[1]); w.y = cvt_pk_bf16(v0[2], v0[3]); w.z = cvt_pk_bf16(v1[0], v1[1]); w.w = cvt_pk_bf16(v1[2], v1[3]);
                        *(u32x4*)(rowp + bj * 128) = w; } }
            return;
        }
        if (u.kind == 2) {
#pragma unroll
            for (int bj = 0; bj < 2; ++bj) { const int t8 = u.pn * 256 + bj * 128 + wc * 32 + 8 * fq;
                int b, key; if (t8 < MROWS) { b = t8 >> 12; key = CTXL + (t8 & 4095); } else { const int j = t8 - MROWS; b = j >> 8; key = j & 255; }
                const int tile = key >> 6, k = key & 63, ipos = (k < 32) ? 4 * (k >> 3) : 16 + 4 * ((k - 32) >> 3);
#pragma unroll
                for (int ai = 0; ai < 2; ++ai)
#pragma unroll
                    for (int m = 0; m < 4; ++m) { const int ch = u.pm * 256 + ai * 128 + wr * 64 + m * 16 + fr;
                        unsigned char* dst = VT8 + ((((size_t)(b * NHEAD + (ch >> 7)) * 68 + tile) * 128 + (ch & 127)) * 64) + ipos;
                        const f32x4 v0 = acc[ai][bj][m][0], v1 = acc[ai][bj][m][1];
                        *(unsigned*)dst = pk4_fp8(v0[0], v0[1], v0[2], v0[3]); *(unsigned*)(dst + 32) = pk4_fp8(v1[0], v1[1], v1[2], v1[3]); } }
            return;
        }
        const int blk = fq >> 1, f = fq & 1;
        const int sec = u.pn >> 1;
        const bool ctx = (u.pm >= 128);
        if (sec == 0 && ctx) return;
        const int colbase = (u.pn & 1) * 256 + wc * 64 + 32 * blk + 8 * f;
        float gg[2][2][4];
        { const float* gp = (sec == 0 ? gq : gk) + 32 * blk + 8 * f;
#pragma unroll
            for (int bj = 0; bj < 2; ++bj)
#pragma unroll
                for (int n = 0; n < 2; ++n) { const f32x4 t = *(const f32x4*)(gp + 16 * bj + 4 * n); gg[bj][n][0] = t[0]; gg[bj][n][1] = t[1]; gg[bj][n][2] = t[2]; gg[bj][n][3] = t[3]; } }
#pragma unroll
        for (int ai = 0; ai < 2; ++ai)
#pragma unroll
            for (int m = 0; m < 4; ++m) {
                const int rloc = ai * 128 + wr * 64 + m * 16 + fr; const int r = u.pm * 256 + rloc;
                f32x4 v[2][2];
#pragma unroll
                for (int bj = 0; bj < 2; ++bj)
#pragma unroll
                    for (int n = 0; n < 2; ++n) v[bj][n] = acc[ai][bj][m][n];
                size_t orow;
                if (sec == 0) orow = (size_t)r;
                else if (!ctx) orow = (size_t)(r >> 12) * KVL + CTXL + (r & 4095);
                else { const int j = r - MROWS; orow = (size_t)(j >> 8) * KVL + (j & 255); }
                float ss = 0.f;
#pragma unroll
                for (int bj = 0; bj < 2; ++bj)
#pragma unroll
                    for (int n = 0; n < 2; ++n) ss += (v[bj][n][0] * v[bj][n][0] + v[bj][n][1] * v[bj][n][1]) + (v[bj][n][2] * v[bj][n][2] + v[bj][n][3] * v[bj][n][3]);
                ss += __shfl_xor(ss, 16); ss += __shfl_xor(ss, 32);
                const float rstd = rsqrtf(ss * (1.f / 64.f) + EPS) * (sec == 0 ? QSCALE * Q8SCALE : 1.f);
#pragma unroll
                for (int bj = 0; bj < 2; ++bj)
#pragma unroll
                    for (int n = 0; n < 2; ++n)
#pragma unroll
                        for (int e = 0; e < 4; ++e) v[bj][n][e] *= rstd * gg[bj][n][e];
                if (!ctx) {
                    const int t = r & 4095; const int pos = blk ? (t & 63) : (t >> 6);
                    const float* rp = rope + (size_t)(pos * 16 + 8 * f) * 2;
#pragma unroll
                    for (int n = 0; n < 2; ++n) { const f32x4 c0 = *(const f32x4*)(rp + 8 * n), c1 = *(const f32x4*)(rp + 8 * n + 4);
                        const float cs[4] = {c0[0], c0[2], c1[0], c1[2]}, sn[4] = {c0[1], c0[3], c1[1], c1[3]};
#pragma unroll
                        for (int e = 0; e < 4; ++e) { const float x1 = v[0][n][e], x2 = v[1][n][e]; v[0][n][e] = x1 * cs[e] - x2 * sn[e]; v[1][n][e] = x2 * cs[e] + x1 * sn[e]; } }
                }
                unsigned char* dst = (sec == 0 ? Q8 : K8) + orow * QKW + colbase;
#pragma unroll
                for (int bj = 0; bj < 2; ++bj) { u32x2 w; w.x = pk4_fp8(v[bj][0][0], v[bj][0][1], v[bj][0][2], v[bj][0][3]); w.y = pk4_fp8(v[bj][1][0], v[bj][1][1], v[bj][1][2], v[bj][1][3]);
                    *(u32x2*)(dst + 16 * bj) = w; }
            }
    }
};

struct SchedStatic {
    int G, c, nM, nN; const char* A; const char* B;
    __device__ __forceinline__ bool next(int i, g8::Unit& u) const {
        const long L = (long)i * G + c; if (L >= (long)nM * nN) return false;
        g8::tile_of((int)L, nM, nN, u.pm, u.pn); u.a = A + (size_t)u.pm * 256 * DM * 2; u.b = B + (size_t)u.pn * 256 * DM * 2; u.kind = 0; u.ex = 0; return true;
    }
};
struct EpiOutProj {
    const float* x; bf16_t* out; const float* mod;
    __device__ __forceinline__ void operator()(f32x4 (&acc)[2][2][4][2], const g8::Unit& u, int wr, int wc, int fr, int fq) const {
        const int col0 = u.pn * 256 + wc * 32 + 8 * fq;
#pragma unroll
        for (int ai = 0; ai < 2; ++ai)
#pragma unroll
            for (int m = 0; m < 4; ++m) { const int r = u.pm * 256 + ai * 128 + wr * 64 + m * 16 + fr; const float* g1 = mod + (size_t)(r >> 12) * (NMOD * DM) + 2 * DM;
                const size_t off = (size_t)r * DM + col0;
#pragma unroll
                for (int bj = 0; bj < 2; ++bj) { f32x4 o[2];
#pragma unroll
                    for (int n = 0; n < 2; ++n) { const int c = bj * 128 + 4 * n; const f32x4 xv = *(const f32x4*)(x + off + c), gv = *(const f32x4*)(g1 + col0 + c); o[n] = xv + gv * acc[ai][bj][m][n]; }
                    u32x4 w; w.x = cvt_pk_bf16(o[0][0], o[0][1]); w.y = cvt_pk_bf16(o[0][2], o[0][3]); w.z = cvt_pk_bf16(o[1][0], o[1][1]); w.w = cvt_pk_bf16(o[1][2], o[1][3]);
                    *(u32x4*)(out + off + bj * 128) = w; } }
    }
};

namespace att8 {
constexpr int NT = KVL / 64, SHMB = 8192, LDS_V0 = 3 * SHMB;
typedef int i32x8 __attribute__((ext_vector_type(8)));
#define SBAR() __builtin_amdgcn_sched_barrier(0)
__device__ __forceinline__ int crow(int r, int hi) { return (r & 3) + 8 * (r >> 2) + 4 * hi; }
__device__ __forceinline__ i32x8 ld32(const LAS unsigned char* p0, const LAS unsigned char* p1) {
    const u32x4 a = *(const LAS u32x4*)p0, b = *(const LAS u32x4*)p1; return (i32x8){(int)a.x, (int)a.y, (int)a.z, (int)a.w, (int)b.x, (int)b.y, (int)b.z, (int)b.w}; }
__device__ __forceinline__ void mfma_qk(f32x16& p, const i32x8& kf, const i32x8& qf, const f32x16& negc) {
    const unsigned s1 = 0x7f7f7f7fu, sq = 0x7b7b7b7bu;
    asm volatile("s_nop 1\n\tv_mfma_scale_f32_32x32x64_f8f6f4 %0, %1, %2, %3, %4, %5 op_sel_hi:[0,0,0]" : "=&v"(p) : "v"(kf), "v"(qf), "v"(negc), "v"(s1), "v"(sq));
}
__device__ __forceinline__ void mfma_pv(f32x16& o, const i32x8& pa, const i32x8& vf) {
    const unsigned s1 = 0x7f7f7f7fu;
    asm volatile("s_nop 2\n\tv_mfma_scale_f32_32x32x64_f8f6f4 %0, %1, %2, %0, %3, %3 op_sel_hi:[0,0,0]" : "+v"(o) : "v"(pa), "v"(vf), "v"(s1));
}
__device__ __forceinline__ void qkt(f32x16& p0, f32x16& p1, const LAS unsigned char* Kb, const i32x8& qf, const f32x16& negc, int r32, int hi, int sub) {
    const int c0 = sub * 4 + hi * 2;
    const int k0 = r32, k1 = 32 + r32;
    const i32x8 kf0 = ld32(Kb + k0 * 128 + ((c0 ^ ((k0 >> 1) & 7)) << 4), Kb + k0 * 128 + (((c0 + 1) ^ ((k0 >> 1) & 7)) << 4));
    const i32x8 kf1 = ld32(Kb + k1 * 128 + ((c0 ^ ((k1 >> 1) & 7)) << 4), Kb + k1 * 128 + (((c0 + 1) ^ ((k1 >> 1) & 7)) << 4));
    mfma_qk(p0, kf0, qf, negc); mfma_qk(p1, kf1, qf, negc);
}
__device__ __forceinline__ void mfma_wait(f32x16& p0, f32x16& p1) { asm volatile("s_nop 15\n\ts_nop 3" : "+v"(p0), "+v"(p1)); }
__device__ __forceinline__ void expA(f32x16& p) {
#pragma unroll
    for (int r = 0; r < 16; ++r) p[r] = __builtin_amdgcn_exp2f(p[r]);
}
__device__ __forceinline__ void finishSM(f32x16& p0, f32x16& p1, i32x8& pa) {
#pragma unroll
    for (int r = 0; r < 16; ++r) p1[r] = __builtin_amdgcn_exp2f(p1[r]);
#pragma unroll
    for (int j = 0; j < 4; ++j) { pa[j] = (int)pk4_fp8(p0[4 * j], p0[4 * j + 1], p0[4 * j + 2], p0[4 * j + 3]); pa[4 + j] = (int)pk4_fp8(p1[4 * j], p1[4 * j + 1], p1[4 * j + 2], p1[4 * j + 3]); }
}
__device__ __forceinline__ void pv(f32x16* o, f32x16& ol, const i32x8& ones, const LAS unsigned char* Vb, const i32x8& pa, int r32, int hi) {
    mfma_pv(ol, pa, ones);
#pragma unroll
    for (int d0 = 0; d0 < 4; ++d0) { const int d = 32 * d0 + r32, sw = (d >> 2) & 3;
        const i32x8 vf = ld32(Vb + d * 64 + (((2 * hi) ^ sw) << 4), Vb + d * 64 + (((2 * hi + 1) ^ sw) << 4));
        mfma_pv(o[d0], pa, vf); }
}
__device__ __forceinline__ void attn_unit(const unsigned char* __restrict__ Qb, const unsigned char* __restrict__ Kh, const unsigned char* __restrict__ VTh, bf16_t* MIXo,
                                          const float lam, const float* __restrict__ subg, char* lds, const int wid) {
    const int lane = lane_id(), tid = wid * 64 + lane, r32 = lane & 31, hi = lane >> 5;
    const int sub = wid >> 2, wq = wid & 3;
    const LAS unsigned char* L = (const LAS unsigned char*)(uintptr_t)(unsigned)(uintptr_t)lds;
    f32x16 o[4] = {}; f32x16 ol = {};
    i32x8 ones; { int c1 = 0x38383838; asm volatile("" : "+v"(c1)); ones = (i32x8){c1, c1, c1, c1, c1, c1, c1, c1}; }
    i32x8 qf; { const unsigned char* qp = Qb + (size_t)(wq * 32 + r32) * QKW + sub * 64 + 32 * hi; const u32x4 a = *(const u32x4*)qp, b = *(const u32x4*)(qp + 16);
        qf = (i32x8){(int)a.x, (int)a.y, (int)a.z, (int)a.w, (int)b.x, (int)b.y, (int)b.z, (int)b.w}; }
    f32x16 negc;
#pragma unroll
    for (int r = 0; r < 16; ++r) negc[r] = -5.f;
    asm volatile("" : "+v"(negc));
    long ksrc, vsrc;
    { const int r = 8 * wid + (lane >> 3), c = (lane & 7) ^ ((r >> 1) & 7); ksrc = (long)r * QKW + c * 16; }
    { const int d = 16 * wid + (lane >> 2), c = (lane & 3) ^ ((d >> 2) & 3); vsrc = (long)d * 64 + c * 16; }
    const unsigned ldsb = (unsigned)(uintptr_t)lds, kdst = ldsb + (unsigned)wid * 1024u, vdst = ldsb + LDS_V0 + (unsigned)wid * 1024u;
#define DMA_TILE(t, boff) do { \
        __builtin_amdgcn_global_load_lds((const unsigned*)(Kh + (long)(t) * 64 * QKW + ksrc), (LAS unsigned*)(uintptr_t)__builtin_amdgcn_readfirstlane(kdst + (unsigned)(boff)), 16, 0, 0); \
        __builtin_amdgcn_global_load_lds((const unsigned*)(VTh + (long)(t) * 8192 + vsrc), (LAS unsigned*)(uintptr_t)__builtin_amdgcn_readfirstlane(vdst + (unsigned)(boff)), 16, 0, 0); } while (0)
#define WBAR() do { asm volatile("s_waitcnt vmcnt(0) lgkmcnt(0)" ::: "memory"); __builtin_amdgcn_s_barrier(); asm volatile("" ::: "memory"); } while (0)
#define ROT3(x) ((x) == 2 * SHMB ? 0 : (x) + SHMB)
    f32x16 pA0, pA1, pB0, pB1; i32x8 pa;
    DMA_TILE(0, 0); WBAR();
    DMA_TILE(1, SHMB);
    qkt(pA0, pA1, L, qf, negc, r32, hi, sub); mfma_wait(pA0, pA1); expA(pA0);
    WBAR();
    int bprev = 0, bcur = SHMB, bnext = 2 * SHMB;
    for (int j = 1; j + 1 < NT; j += 2) {
        DMA_TILE(j + 1, bnext);
        SBAR(); qkt(pB0, pB1, L + bcur, qf, negc, r32, hi, sub);
        finishSM(pA0, pA1, pa); SBAR();
        pv(o, ol, ones, L + LDS_V0 + bprev, pa, r32, hi); mfma_wait(pB0, pB1); expA(pB0);
        WBAR();
        bprev = bcur; bcur = bnext; bnext = ROT3(bnext);
        if (j + 2 < NT) DMA_TILE(j + 2, bnext);
        SBAR(); qkt(pA0, pA1, L + bcur, qf, negc, r32, hi, sub);
        finishSM(pB0, pB1, pa); SBAR();
        pv(o, ol, ones, L + LDS_V0 + bprev, pa, r32, hi); mfma_wait(pA0, pA1); expA(pA0);
        WBAR();
        bprev = bcur; bcur = bnext; bnext = ROT3(bnext);
    }
    SBAR(); qkt(pB0, pB1, L + bcur, qf, negc, r32, hi, sub);
    finishSM(pA0, pA1, pa); SBAR();
    pv(o, ol, ones, L + LDS_V0 + bprev, pa, r32, hi); mfma_wait(pB0, pB1); expA(pB0);
    finishSM(pB0, pB1, pa); SBAR();
    pv(o, ol, ones, L + LDS_V0 + bcur, pa, r32, hi);
    asm volatile("s_nop 15\n\ts_nop 3" : "+v"(o[0]), "+v"(o[1]), "+v"(o[2]), "+v"(o[3]), "+v"(ol));
#undef ROT3
#undef DMA_TILE
#undef WBAR
    __syncthreads();
    float* X = (float*)lds;
    float rli[16];
#pragma unroll
    for (int r = 0; r < 16; ++r) rli[r] = __builtin_amdgcn_rcpf(ol[r]);
    if (sub == 1) {
#pragma unroll
        for (int r = 0; r < 16; ++r) { const int row = wq * 32 + crow(r, hi); const float sc = lam * rli[r];
#pragma unroll
            for (int d0 = 0; d0 < 4; ++d0) X[row * 128 + d0 * 32 + r32] = o[d0][r] * sc; }
    }
    __syncthreads();
    bf16_t* Y = (bf16_t*)(lds + 65536);
    if (sub == 0) {
        float sg[4];
#pragma unroll
        for (int d0 = 0; d0 < 4; ++d0) sg[d0] = subg[d0 * 32 + r32] * (1.f - LAM_INIT);
#pragma unroll
        for (int r = 0; r < 16; ++r) { const int row = wq * 32 + crow(r, hi);
            float v[4]; float ss = 0.f;
#pragma unroll
            for (int d0 = 0; d0 < 4; ++d0) { v[d0] = o[d0][r] * rli[r] - X[row * 128 + d0 * 32 + r32]; ss += v[d0] * v[d0]; }
            ss += __shfl_xor(ss, 1); ss += __shfl_xor(ss, 2); ss += __shfl_xor(ss, 4); ss += __shfl_xor(ss, 8); ss += __shfl_xor(ss, 16);
            const float rstd = rsqrtf(ss * (1.f / 128.f) + EPS);
#pragma unroll
            for (int d0 = 0; d0 < 4; ++d0) Y[row * 128 + d0 * 32 + r32] = (bf16_t)(cvt_pk_bf16(v[d0] * rstd * sg[d0], 0.f) & 0xffffu); }
    }
    __syncthreads();
    { const int row = tid >> 2, seg = (tid & 3) * 32;
#pragma unroll
        for (int i = 0; i < 4; ++i) { const u32x4 v = *(const u32x4*)(Y + row * 128 + seg + i * 8); *(u32x4*)(MIXo + (size_t)row * DM + seg + i * 8) = v; } }
    __syncthreads();
}
#undef SBAR
}

__device__ __forceinline__ void p3_attention8(Frame& F) {
    FT_DECL;
    const float* sc = WSP(float, WS_SMALL + SM_SCAL);
    const float lam = sc[0];
    const unsigned char* Q8 = WSP(unsigned char, WS_Q); const unsigned char* K8 = WSP(unsigned char, WS_K); const unsigned char* VT8 = WSP(unsigned char, WS_V); bf16_t* MIX = WSP(bf16_t, WS_MIX);
    const int c = blockIdx.x, xcd = c & 7, ci = c >> 3, per = F.G >> 3;
    for (int j = ci; j < 128; j += per) {
        const int pair = xcd * 4 + (j >> 5), qb = j & 31, b = pair >> 2, h = pair & 3;
        att8::attn_unit(Q8 + ((size_t)b * SEQ + qb * 128) * QKW + h * 128, K8 + (size_t)b * KVL * QKW + h * 128, VT8 + (size_t)(b * NHEAD + h) * 68 * 8192,
                        MIX + ((size_t)b * SEQ + qb * 128) * DM + h * 128, lam, F.in[15], (char*)F.lds, F.wave);
    }
}

namespace hy {
constexpr int RB_BYTES = 4352 * 8, IN_OFF = 2 * RB_BYTES, TW1_OFF = IN_OFF + 32768, TW2_OFF = TW1_OFF + 15 * 256 * 8, LDS_END = TW2_OFF + 15 * 16 * 8;
__device__ __forceinline__ f32x2 cmul(f32x2 a, f32x2 b) { return (f32x2){a.x * b.x - a.y * b.y, a.x * b.y + a.y * b.x}; }
__device__ __forceinline__ f32x2 cmulc(f32x2 a, f32x2 b) { return (f32x2){a.x * b.x + a.y * b.y, a.y * b.x - a.x * b.y}; }
__device__ __forceinline__ int P(int i) { return i + (i >> 4); }
template <bool INV> __device__ __forceinline__ void r4(f32x2& a, f32x2& b, f32x2& c, f32x2& d) {
    const f32x2 t0 = a + c, t1 = a - c, t2 = b + d, t3 = b - d;
    const f32x2 st3 = INV ? (f32x2){-t3.y, t3.x} : (f32x2){t3.y, -t3.x};
    a = t0 + t2; c = t0 - t2; b = t1 + st3; d = t1 - st3;
}
template <bool INV> __device__ __forceinline__ f32x2 tw(f32x2 v, float c, float s) {
    return INV ? (f32x2){v.x * c - v.y * s, v.y * c + v.x * s} : (f32x2){v.x * c + v.y * s, v.y * c - v.x * s};
}
template <bool INV> __device__ __forceinline__ void dft16(f32x2 (&v)[16]) {
    constexpr float C1 = 0.9238795325112867f, S1 = 0.3826834323650898f, R2 = 0.7071067811865476f;
    r4<INV>(v[0], v[4], v[8], v[12]); r4<INV>(v[1], v[5], v[9], v[13]); r4<INV>(v[2], v[6], v[10], v[14]); r4<INV>(v[3], v[7], v[11], v[15]);
    v[5] = tw<INV>(v[5], C1, S1);  v[9] = tw<INV>(v[9], R2, R2);    v[13] = tw<INV>(v[13], S1, C1);
    v[6] = tw<INV>(v[6], R2, R2);  v[10] = tw<INV>(v[10], 0.f, 1.f); v[14] = tw<INV>(v[14], -R2, R2);
    v[7] = tw<INV>(v[7], S1, C1);  v[11] = tw<INV>(v[11], -R2, R2);  v[15] = tw<INV>(v[15], -C1, -S1);
    r4<INV>(v[0], v[1], v[2], v[3]); r4<INV>(v[4], v[5], v[6], v[7]); r4<INV>(v[8], v[9], v[10], v[11]); r4<INV>(v[12], v[13], v[14], v[15]);
    f32x2 t;
    t = v[1]; v[1] = v[4]; v[4] = t;   t = v[2]; v[2] = v[8]; v[8] = t;    t = v[3]; v[3] = v[12]; v[12] = t;
    t = v[6]; v[6] = v[9]; v[9] = t;   t = v[7]; v[7] = v[13]; v[13] = t;  t = v[11]; v[11] = v[14]; v[14] = t;
}
struct Ctx { LAS f32x2* R; LAS f32x2* IN; LAS f32x2* TW1; LAS f32x2* TW2; int t, half; f32x2 wt; };
#define HY_OPAQUE(x) asm volatile("" : "+v"(x))
#define HY_W32(m) (f32x2){__builtin_cosf(-0.19634954084936207f * (m)), __builtin_sinf(-0.19634954084936207f * (m))}
template <int MODE> __device__ __forceinline__ void pass1_fwd(const Ctx& X) {
    f32x2 v[16]; int t = X.t; HY_OPAQUE(t);
#pragma unroll
    for (int m = 0; m < 16; ++m) { f32x2 a = X.IN[t + 256 * m]; if (MODE == 1) a = (f32x2){X.half ? a.y : a.x, 0.f}; v[m] = a; }
    if (X.half) {
#pragma unroll
        for (int m = 0; m < 16; ++m) v[m] = cmul(cmul(v[m], HY_W32(m)), X.wt);
    }
    dft16<false>(v);
#pragma unroll
    for (int q = 1; q < 16; ++q) v[q] = cmul(v[q], X.TW1[(q - 1) * 256 + t]);
    const int pb = t + (t >> 4);
#pragma unroll
    for (int q = 0; q < 16; ++q) X.R[pb + 272 * q] = v[q];
}
__device__ __forceinline__ void pass2_fwd(const Ctx& X) {
    int t = X.t; HY_OPAQUE(t);
    const int n2 = t & 15, pb = (t >> 4) * 272 + n2; f32x2 v[16];
#pragma unroll
    for (int m = 0; m < 16; ++m) v[m] = X.R[pb + 17 * m];
    dft16<false>(v);
#pragma unroll
    for (int q = 1; q < 16; ++q) v[q] = cmul(v[q], X.TW2[(q - 1) * 16 + n2]);
#pragma unroll
    for (int q = 0; q < 16; ++q) X.R[pb + 17 * q] = v[q];
}
template <bool FILTER> __device__ __forceinline__ void pass3(const Ctx& X, f32x2 (&H)[16]) {
    f32x2 v[16]; int t = X.t; HY_OPAQUE(t); const int pb = 17 * t;
#pragma unroll
    for (int m = 0; m < 16; ++m) v[m] = X.R[pb + m];
    dft16<false>(v);
    if (FILTER) {
#pragma unroll
        for (int q = 0; q < 16; ++q) H[q] = v[q] * (1.f / 8192.f);
    } else {
#pragma unroll
        for (int q = 0; q < 16; ++q) v[q] = cmul(v[q], H[q]);
        dft16<true>(v);
#pragma unroll
        for (int m = 0; m < 16; ++m) X.R[pb + m] = v[m];
    }
}
__device__ __forceinline__ void pass2_inv(const Ctx& X) {
    int t = X.t; HY_OPAQUE(t);
    const int n2 = t & 15, pb = (t >> 4) * 272 + n2; f32x2 v[16];
    v[0] = X.R[pb];
#pragma unroll
    for (int q = 1; q < 16; ++q) v[q] = cmulc(X.R[pb + 17 * q], X.TW2[(q - 1) * 16 + n2]);
    dft16<true>(v);
#pragma unroll
    for (int m = 0; m < 16; ++m) X.R[pb + 17 * m] = v[m];
}
__device__ __forceinline__ void pass1_inv(const Ctx& X) {
    f32x2 v[16]; int t = X.t; HY_OPAQUE(t); const int pb = t + (t >> 4);
    v[0] = X.R[pb];
#pragma unroll
    for (int q = 1; q < 16; ++q) v[q] = cmulc(X.R[pb + 272 * q], X.TW1[(q - 1) * 256 + t]);
    dft16<true>(v);
    if (X.half) {
#pragma unroll
        for (int m = 0; m < 16; ++m) v[m] = cmulc(cmulc(v[m], HY_W32(m)), X.wt);
    }
#pragma unroll
    for (int m = 0; m < 16; ++m) X.R[pb + 272 * m] = v[m];
}
#define HY_WSYNC() asm volatile("s_waitcnt lgkmcnt(0)" ::: "memory")
__device__ __forceinline__ void conv_fft(const Ctx& X, f32x2 (&H)[16]) {
    __syncthreads(); pass1_fwd<0>(X); __syncthreads(); pass2_fwd(X); HY_WSYNC(); pass3<false>(X, H); HY_WSYNC(); pass2_inv(X); __syncthreads(); pass1_inv(X); __syncthreads();
}
constexpr int STG_OFF = LDS_END;
constexpr int LDS_END2 = STG_OFF + 2 * SEQ * 2;
static_assert(LDS_END2 <= LDSCTL_OFF, "hyena LDS map");
__device__ __forceinline__ float sconv_lds(const LAS bf16_t* stg, int bs, int n, float w0, float w1, float w2, float bias) {
    const LAS bf16_t* p = stg + bs * SEQ;
    const float c = bf2f(p[n]), lv = bf2f(p[n - ((n > 0) ? 1 : 0)]), rv = bf2f(p[n + ((n < SEQ - 1) ? 1 : 0)]);
    const float l = (n > 0) ? lv : 0.f, r = (n < SEQ - 1) ? rv : 0.f;
    return bias + w0 * l + w1 * c + w2 * r;
}
__device__ __forceinline__ void setup_tables(LAS unsigned char* lds, int tid) {
    LAS f32x2* TW1 = (LAS f32x2*)(lds + TW1_OFF); LAS f32x2* TW2 = (LAS f32x2*)(lds + TW2_OFF);
    for (int i = tid; i < 15 * 256; i += 512) { const int q = i / 256 + 1, t = i & 255; float s, c; sincosf(-6.283185307179586f * (float)((t * q) & 4095) * (1.f / 4096.f), &s, &c); TW1[i] = (f32x2){c, s}; }
    for (int i = tid; i < 15 * 16; i += 512) { const int q = i / 16 + 1, n2 = i & 15; float s, c; sincosf(-6.283185307179586f * (float)((n2 * q) & 255) * (1.f / 256.f), &s, &c); TW2[i] = (f32x2){c, s}; }
}
__device__ __forceinline__ void unit(Frame& F, int c) {
    FT_DECL;
    const int tid = f_tid; Ctx X; X.half = F.wave >> 2; X.t = tid & 255;
    X.R = (LAS f32x2*)(F.lds + X.half * RB_BYTES); X.IN = (LAS f32x2*)(F.lds + IN_OFF); X.TW1 = (LAS f32x2*)(F.lds + TW1_OFF); X.TW2 = (LAS f32x2*)(F.lds + TW2_OFF);
    { float s, cc; sincosf(-6.283185307179586f * (float)X.t * (1.f / 8192.f), &s, &cc); X.wt = (f32x2){cc, s}; }
    LAS f32x2* RB0 = (LAS f32x2*)(F.lds); LAS f32x2* RB1 = (LAS f32x2*)(F.lds + RB_BYTES);
    const float* FILT = WSP(float, WS_FILT);
    f32x2 H0[16], H1[16];
#pragma unroll
    for (int ord = 0; ord < 2; ++ord) {
        const float* hf = FILT + ((size_t)(ord * 2 + 0) * 512 + c) * SEQ; const float* hb = FILT + ((size_t)(ord * 2 + 1) * 512 + c) * SEQ;
        __syncthreads();
        int nb = tid; HY_OPAQUE(nb);
#pragma unroll
        for (int j = 0; j < 8; ++j) { const int n = nb + 512 * j; const float a = hf[n], b = hb[(SEQ - n) & (SEQ - 1)]; const float lo = (n == 0) ? a + b : a, hi = (n == 0) ? 0.f : b; X.IN[n] = (f32x2){lo + hi, lo - hi}; }
        __syncthreads(); pass1_fwd<1>(X); __syncthreads(); pass2_fwd(X); HY_WSYNC();
        if (ord == 0) pass3<true>(X, H0); else pass3<true>(X, H1);
    }
    const bf16_t* UT = WSP(bf16_t, WS_UT);
    const bf16_t* rv = UT + (size_t)c * MROWS; const bf16_t* r1 = UT + (size_t)(512 + c) * MROWS; const bf16_t* r2 = UT + (size_t)(1024 + c) * MROWS;
    const float* cw = F.in[16]; const float* cb = F.in[17];
    const float wv0 = cw[c], wv1 = cw[HYC + c], wv2 = cw[2 * HYC + c], bv = cb[c];
    const float wa0 = cw[512 + c], wa1 = cw[HYC + 512 + c], wa2 = cw[2 * HYC + 512 + c], ba = cb[512 + c];
    const float wb0 = cw[1024 + c], wb1 = cw[HYC + 1024 + c], wb2 = cw[2 * HYC + 1024 + c], bb = cb[1024 + c];
    const float sk0 = F.in[25][c], sk1 = F.in[25][512 + c];
    bf16_t* Z = WSP(bf16_t, WS_Z2T) + (size_t)c * MROWS;
    LAS bf16_t* STG = (LAS bf16_t*)(F.lds + STG_OFF);
    u32x4 g0 = *(const u32x4*)(rv + tid * 8), g1 = *(const u32x4*)(rv + SEQ + tid * 8);
    for (int pr = 0; pr < 4; ++pr) {
        const int b0 = 2 * pr, b1 = b0 + 1;
        f32x2 z[8]; int pc = tid + (tid >> 4); HY_OPAQUE(pc); int nb = tid; HY_OPAQUE(nb);
        __syncthreads();
        *(LAS u32x4*)(STG + tid * 8) = g0; *(LAS u32x4*)(STG + SEQ + tid * 8) = g1;
        __syncthreads();
#pragma unroll
        for (int j = 0; j < 8; ++j) { const int n = nb + 512 * j; z[j] = (f32x2){sconv_lds(STG, 0, n, wv0, wv1, wv2, bv), sconv_lds(STG, 1, n, wv0, wv1, wv2, bv)}; X.IN[n] = z[j]; }
        g0 = *(const u32x4*)(r1 + b0 * SEQ + tid * 8); g1 = *(const u32x4*)(r1 + b1 * SEQ + tid * 8);
        conv_fft(X, H0);
        *(LAS u32x4*)(STG + tid * 8) = g0; *(LAS u32x4*)(STG + SEQ + tid * 8) = g1;
        __syncthreads();
        HY_OPAQUE(nb); HY_OPAQUE(pc);
#pragma unroll
        for (int j = 0; j < 8; ++j) { const int n = nb + 512 * j; const f32x2 y = RB0[pc + 544 * j] + RB1[pc + 544 * j];
            const f32x2 g = (f32x2){sconv_lds(STG, 0, n, wa0, wa1, wa2, ba), sconv_lds(STG, 1, n, wa0, wa1, wa2, ba)};
            z[j] = g * (y + sk0 * z[j]); X.IN[n] = z[j]; }
        g0 = *(const u32x4*)(r2 + b0 * SEQ + tid * 8); g1 = *(const u32x4*)(r2 + b1 * SEQ + tid * 8);
        conv_fft(X, H1);
        *(LAS u32x4*)(STG + tid * 8) = g0; *(LAS u32x4*)(STG + SEQ + tid * 8) = g1;
        __syncthreads();
        if (pr < 3) { g0 = *(const u32x4*)(rv + (b0 + 2) * SEQ + tid * 8); g1 = *(const u32x4*)(rv + (b1 + 2) * SEQ + tid * 8); }
        HY_OPAQUE(nb); HY_OPAQUE(pc);
        f32x2 o[8];
#pragma unroll
        for (int j = 0; j < 8; ++j) { const int n = nb + 512 * j; const f32x2 y = RB0[pc + 544 * j] + RB1[pc + 544 * j];
            const f32x2 g = (f32x2){sconv_lds(STG, 0, n, wb0, wb1, wb2, bb), sconv_lds(STG, 1, n, wb0, wb1, wb2, bb)};
            o[j] = g * (y + sk1 * z[j]); }
        __syncthreads();
#pragma unroll
        for (int j = 0; j < 8; ++j) { const int n = nb + 512 * j; STG[n] = (bf16_t)(cvt_pk_bf16(o[j].x, 0.f) & 0xffffu); STG[SEQ + n] = (bf16_t)(cvt_pk_bf16(o[j].y, 0.f) & 0xffffu); }
        __syncthreads();
        *(u32x4*)(Z + b0 * SEQ + tid * 8) = *(const LAS u32x4*)(STG + tid * 8); *(u32x4*)(Z + b1 * SEQ + tid * 8) = *(const LAS u32x4*)(STG + SEQ + tid * 8);
    }
    __syncthreads();
}
}

__device__ __forceinline__ void p3_hyena(Frame& F) {
    FT_DECL;
    __syncthreads();
    hy::setup_tables(F.lds, f_tid);
    __syncthreads();
    for (int c = F.vcu; c < HYW; c += F.G) hy::unit(F, c);
}

__device__ __forceinline__ void p4_hynorm(Frame& F) {
    FT_DECL;
    const bf16_t* Z = WSP(bf16_t, WS_Z2T); bf16_t* MIX = WSP(bf16_t, WS_MIX); const float* g = F.in[26];
    LAS bf16_t* T = (LAS bf16_t*)F.lds;
    LAS float* red = (LAS float*)(F.lds + 512 * 72 * 2);
    LAS float* rs = red + 512;
    for (int it = F.vcu; it < MROWS / 64; it += F.G) {
        const int tok0 = it * 64;
        __syncthreads();
#pragma unroll
        for (int j = 0; j < 8; ++j) { const int i = f_tid + 512 * j, row = i >> 3, ch = i & 7; const u32x4 v = *(const u32x4*)(Z + (size_t)row * MROWS + tok0 + ch * 8); *(LAS u32x4*)(T + row * 72 + ch * 8) = v; }
        __syncthreads();
        { const int tok = f_tid & 63, grp = f_tid >> 6; float ss = 0.f;
#pragma unroll 8
            for (int k = 0; k < 64; ++k) { const float v = bf2f(T[(grp * 64 + k) * 72 + tok]); ss += v * v; }
            red[grp * 64 + tok] = ss; }
        __syncthreads();
        if (f_tid < 64) { float ss = 0.f;
#pragma unroll
            for (int w = 0; w < 8; ++w) ss += red[w * 64 + f_tid];
            rs[f_tid] = rsqrtf(ss * (1.f / HYW) + EPS); }
        __syncthreads();
#pragma unroll
        for (int j = 0; j < 8; ++j) { const int i = f_tid + 512 * j, tok = i >> 6, c0 = (i & 63) * 8; const float r = rs[tok];
            float v[8];
#pragma unroll
            for (int e = 0; e < 8; ++e) v[e] = bf2f(T[(c0 + e) * 72 + tok]) * r * g[c0 + e];
            u32x4 w; w.x = cvt_pk_bf16(v[0], v[1]); w.y = cvt_pk_bf16(v[2], v[3]); w.z = cvt_pk_bf16(v[4], v[5]); w.w = cvt_pk_bf16(v[6], v[7]);
            *(u32x4*)(MIX + (size_t)(tok0 + tok) * DM + 512 + c0) = w; }
    }
}

constexpr size_t RT_TOPI = 0;
constexpr size_t RT_GATE = 512 * 1024;
constexpr size_t RT_POS = 1024 * 1024;
constexpr size_t RT_WGCNT = 1536 * 1024;
constexpr size_t RT_META = 1600 * 1024;
constexpr size_t RT_LIST = 2048 * 1024;
constexpr size_t RT_GSLOT = 2048 * 1024 + 640 * 1024;
constexpr int MAXSLOT = MROWS * TOPK + NEXP * 256;
constexpr int MAXTILE = MAXSLOT / 256;
constexpr size_t WS_XS = WS_EO;
constexpr int RW_PITCH = 32;
constexpr int P6_LDS_TOPI = 1024 * RW_PITCH * 4;

__device__ __forceinline__ void p6_router_mfma(Frame& F) {
    FT_DECL;
#define in F.in
    LAS float* WP = (LAS float*)F.lds;
    LAS int* TI = (LAS int*)(F.lds + P6_LDS_TOPI);
    LAS int* PS = TI + 512;
    LAS int* SC = PS + 512;
    LAS float* RSTD = (LAS float*)(SC + 512);
    LAS float* BIAS = RSTD + 128;
    LAS float* SSX = BIAS + 32;
    const float* rw = in[28]; const float* mod = WSP(float, WS_SMALL + SM_MOD); const float* g2n = in[7]; const float* rb = in[29];
    const bf16_t* XN = WSP(bf16_t, WS_XN); unsigned char* H2 = WSP(unsigned char, WS_H);
    int* topi_g = WSP(int, WS_ROUTE + RT_TOPI); float* gate_g = WSP(float, WS_ROUTE + RT_GATE); int* pos_g = WSP(int, WS_ROUTE + RT_POS); int* wgcnt = WSP(int, WS_ROUTE + RT_WGCNT);
    for (int blk = blockIdx.x; blk < MROWS / 128; blk += F.G) {
        const float* sh2 = mod + (size_t)(blk >> 5) * (NMOD * DM) + 3 * DM; const float* sc2 = sh2 + DM;
        __syncthreads();
        for (int i = f_tid; i < 1024 * 8; i += 512) { const int k = i >> 3, c4 = i & 7; const float gm = g2n[k] * (1.f + sc2[k]);
            *(LAS f32x4*)(WP + k * 32 + c4 * 4) = *(const f32x4*)(rw + (size_t)k * 32 + c4 * 4) * gm; }
        { const int e = f_tid & 31, part = f_tid >> 5; float a = 0.f;
            for (int k = part * 64; k < part * 64 + 64; ++k) a += sh2[k] * rw[(size_t)k * 32 + e];
            ((LAS float*)SC)[part * 32 + e] = a; }
        __syncthreads();
        if (f_tid < 32) { float a = rb[f_tid];
#pragma unroll
            for (int p = 0; p < 16; ++p) a += ((LAS float*)SC)[p * 32 + f_tid];
            BIAS[f_tid] = a; }
        const int rg = F.wave & 3, kh = F.wave >> 2, j = f_lane & 31, hi = f_lane >> 5;
        f32x16 acc = {};
        float ss = 0.f;
        { const bf16_t* xrow = XN + (size_t)(blk * 128 + rg * 32 + j) * DM + 512 * kh + 8 * hi;
            const LAS float* wp = WP + (512 * kh + 8 * hi) * 32 + j;
#pragma unroll 4
            for (int c = 0; c < 32; ++c) { const u32x4 xb = *(const u32x4*)(xrow + 16 * c);
                float xf[8] = {__uint_as_float(xb.x << 16), __uint_as_float(xb.x & 0xffff0000u), __uint_as_float(xb.y << 16), __uint_as_float(xb.y & 0xffff0000u),
                               __uint_as_float(xb.z << 16), __uint_as_float(xb.z & 0xffff0000u), __uint_as_float(xb.w << 16), __uint_as_float(xb.w & 0xffff0000u)};
#pragma unroll
                for (int q = 0; q < 8; ++q) { ss += xf[q] * xf[q]; acc = __builtin_amdgcn_mfma_f32_32x32x2f32(wp[(16 * c + q) * 32], xf[q], acc, 0, 0, 0); } } }
        { auto rr = __builtin_amdgcn_permlane32_swap(__float_as_uint(ss), __float_as_uint(ss), false, false); ss = __uint_as_float(rr[0]) + __uint_as_float(rr[1]); }
        if (hi == 0) SSX[kh * 128 + rg * 32 + j] = ss;
        __syncthreads();
        if (kh == 1) {
#pragma unroll
            for (int r = 0; r < 16; ++r) WP[(rg * 16 + r) * 64 + f_lane] = acc[r]; }
        if (f_tid < 128) RSTD[f_tid] = rsqrtf((SSX[f_tid] + SSX[128 + f_tid]) * (1.f / DM) + EPS);
        __syncthreads();
        if (kh == 0) {
            const float rstd = RSTD[rg * 32 + j];
            float tv[4] = {-INFINITY, -INFINITY, -INFINITY, -INFINITY}; int ti[4] = {1 << 20, 1 << 20, 1 << 20, 1 << 20};
#define P6_INS(V, E) do { float cv = (V); int ce = (E); _Pragma("unroll") for (int q = 0; q < 4; ++q) { const bool b = cv > tv[q] || (cv == tv[q] && ce < ti[q]); \
                const float nv = b ? tv[q] : cv; const int ne = b ? ti[q] : ce; tv[q] = b ? cv : tv[q]; ti[q] = b ? ce : ti[q]; cv = nv; ce = ne; } } while (0)
#pragma unroll
            for (int r = 0; r < 16; ++r) { const int e = (r & 3) + 8 * (r >> 2) + 4 * hi; const float v = (acc[r] + WP[(rg * 16 + r) * 64 + f_lane]) * rstd + BIAS[e]; P6_INS(v, e); }
            float ov[4]; int oe[4];
#pragma unroll
            for (int q = 0; q < 4; ++q) { ov[q] = __shfl_xor(tv[q], 32); oe[q] = __shfl_xor(ti[q], 32); }
#pragma unroll
            for (int q = 0; q < 4; ++q) P6_INS(ov[q], oe[q]);
#undef P6_INS
            if (hi == 0) { const int rl = rg * 32 + j, r = blk * 128 + rl;
                const float e1 = __expf(tv[1] - tv[0]), e2 = __expf(tv[2] - tv[0]), e3 = __expf(tv[3] - tv[0]); const float inv = 1.f / (1.f + e1 + e2 + e3);
                typedef int i32x4_t __attribute__((ext_vector_type(4))); const i32x4_t t4 = {ti[0], ti[1], ti[2], ti[3]};
                *(i32x4_t*)(topi_g + (size_t)r * 4) = t4; *(f32x4*)(gate_g + (size_t)r * 4) = (f32x4){inv, e1 * inv, e2 * inv, e3 * inv};
                *(LAS i32x4_t*)(TI + rl * 4) = t4; }
        }
        __syncthreads();
        { const int t2 = F.wave * 64 + lane_id(); const int e = t2 & 31, seg = t2 >> 5; int cnt = 0;
#pragma unroll 4
            for (int i = 0; i < 32; ++i) cnt += (TI[seg * 32 + i] == e) ? 1 : 0;
            SC[seg * 32 + e] = cnt;
            __syncthreads();
            int pre = 0;
            for (int s2 = 0; s2 < seg; ++s2) pre += SC[s2 * 32 + e];
            if (seg == 15) wgcnt[blk * 32 + e] = pre + cnt;
            for (int i = 0; i < 32; ++i) if (TI[seg * 32 + i] == e) { PS[seg * 32 + i] = pre; ++pre; }
        }
        __syncthreads();
        { const int t3 = F.wave * 64 + lane_id(); pos_g[(size_t)blk * 512 + t3] = PS[t3]; }
        { const int lane = lane_id();
            for (int it = 0; it < 4; ++it) { u32x2 xb[4][4];
#pragma unroll
                for (int u = 0; u < 4; ++u) { const GAS u32x2* xr = (const GAS u32x2*)(XN + (size_t)(blk * 128 + F.wave * 16 + 4 * it + u) * DM) + lane;
#pragma unroll
                    for (int jj = 0; jj < 4; ++jj) xb[u][jj] = xr[64 * jj]; }
#pragma unroll
                for (int u = 0; u < 4; ++u) { const int rl = F.wave * 16 + 4 * it + u; const float rstd = RSTD[rl];
                    GAS unsigned* o4 = (GAS unsigned*)(H2 + (size_t)(blk * 128 + rl) * DM) + lane;
#pragma unroll
                    for (int jj = 0; jj < 4; ++jj) { const int c = 4 * lane + 256 * jj;
                        const f32x4 x = (f32x4){__uint_as_float(xb[u][jj].x << 16), __uint_as_float(xb[u][jj].x & 0xffff0000u), __uint_as_float(xb[u][jj].y << 16), __uint_as_float(xb[u][jj].y & 0xffff0000u)};
                        const f32x4 g = *(const f32x4*)(g2n + c), a = *(const f32x4*)(sc2 + c), b = *(const f32x4*)(sh2 + c);
                        const f32x4 h = x * rstd * g * (a + 1.f) + b;
                        o4[64 * jj] = pk4_fp8(h.x, h.y, h.z, h.w); } } }
        }
    }
#undef in
}

__device__ __forceinline__ void p7_scatter(Frame& F) {
    FT_DECL;
    LAS int* TOT = (LAS int*)F.lds;
    LAS int* BASE = TOT + 32;
    LAS int* PRE = BASE + 32;
    LAS int* PART = PRE + 32;
    const int* wgcnt = WSP(int, WS_ROUTE + RT_WGCNT); const int* topi_g = WSP(int, WS_ROUTE + RT_TOPI); const float* gate_g = WSP(float, WS_ROUTE + RT_GATE); const int* pos_g = WSP(int, WS_ROUTE + RT_POS);
    int* list = WSP(int, WS_ROUTE + RT_LIST); float* gslot = WSP(float, WS_ROUTE + RT_GSLOT); int* meta = WSP(int, WS_ROUTE + RT_META);
    for (int blk = blockIdx.x; blk < MROWS / 128; blk += F.G) {
        __syncthreads();
        { const int e = f_tid & 31, part = f_tid >> 5; int st = 0, sp = 0;
            for (int w = part * 16; w < part * 16 + 16; ++w) { const int c = wgcnt[w * 32 + e]; st += c; if (w < blk) sp += c; }
            PART[part * 32 + e] = st; PART[512 + part * 32 + e] = sp; }
        __syncthreads();
        if (f_tid < 32) { int st = 0, sp = 0;
#pragma unroll
            for (int p = 0; p < 16; ++p) { st += PART[p * 32 + f_tid]; sp += PART[512 + p * 32 + f_tid]; }
            TOT[f_tid] = st; PRE[f_tid] = sp; }
        __syncthreads();
        if (f_tid == 0) { int b = 0; for (int e = 0; e < 32; ++e) { BASE[e] = b; b += (TOT[e] + 255) & ~255; }
            if (blk == 0) { int t = 0; for (int e = 0; e < 32; ++e) { meta[e] = TOT[e]; meta[32 + e] = BASE[e]; const int nt = (TOT[e] + 255) >> 8; for (int q = 0; q < nt; ++q) meta[128 + t + q] = e; t += nt; } meta[64] = t; } }
        __syncthreads();
        { const int a = f_tid, row = blk * 128 + (a >> 2); const int e = topi_g[(size_t)blk * 512 + a]; const int slot = BASE[e] + PRE[e] + pos_g[(size_t)blk * 512 + a];
            list[slot] = row * 4 + (a & 3); gslot[slot] = gate_g[(size_t)blk * 512 + a];
            PART[a] = slot; }
        __syncthreads();
        if (blk < NEXP) { const int e = blk, lo = BASE[e] + TOT[e], hi = BASE[e] + ((TOT[e] + 255) & ~255);
            for (int sl = lo + f_tid; sl < hi; sl += 512) { list[sl] = -1; gslot[sl] = 0.f; } }
    }
}

template <int NPN> struct SchedMoE {
    int G, c, nT; const char* A; const char* W; size_t wstride; const LAS unsigned char* tileE; const LAS int* RW; bool gath;
    __device__ __forceinline__ const LAS int* rows(int i) const { return RW + i * 256; }
    __device__ __forceinline__ bool next(int i, g8::Unit& u) const {
        const int L = i * G + c, xcd = L & 7, j = L >> 3, T = (j / NPN) * 8 + xcd, pn = j % NPN;
        if (T >= nT) return false;
        const int e = tileE[T];
        u.pm = T; u.pn = pn; u.kind = i; u.ex = e; u.a = gath ? A : A + (size_t)T * 256 * DM; u.b = W + (size_t)e * wstride + (size_t)pn * 256 * DM; return true;
    }
};
struct EpiSwiGLU {
    unsigned char* ACT; const float* b1;
    __device__ __forceinline__ void operator()(f32x4 (&acc)[2][2][4][2], const g8::Unit& u, int wr, int wc, int fr, int fq) const {
        asm volatile("" : "+v"(fr), "+v"(fq));
        const int j0 = u.pn * 128 + wc * 32 + 8 * fq; const float* bp = b1 + (size_t)u.ex * 2 * DM + j0;
        f32x4 bg[2], bl[2];
#pragma unroll
        for (int n = 0; n < 2; ++n) { bg[n] = *(const f32x4*)(bp + 4 * n); bl[n] = *(const f32x4*)(bp + DM + 4 * n); }
#pragma unroll
        for (int ai = 0; ai < 2; ++ai)
#pragma unroll
            for (int m = 0; m < 4; ++m) { const size_t slot = (size_t)u.pm * 256 + ai * 128 + wr * 64 + m * 16 + fr; float o[8];
#pragma unroll
                for (int n = 0; n < 2; ++n) { const f32x4 g4 = acc[ai][0][m][n] * (1.f / WSCALE) + bg[n], l4 = acc[ai][1][m][n] * (1.f / WSCALE) + bl[n];
#pragma unroll
                    for (int e = 0; e < 4; ++e) { const float g = fminf(g4[e], 7.f), l = __builtin_amdgcn_fmed3f(l4[e], -7.f, 7.f);
                        const float ex = __builtin_amdgcn_exp2f(g * (-1.702f * 1.4426950408889634f)); const float glu = g * __builtin_amdgcn_rcpf(1.f + ex);
                        o[4 * n + e] = fmaf(l, glu, glu); } }
                u32x2 w; w.x = pk4_fp8(o[0], o[1], o[2], o[3]); w.y = pk4_fp8(o[4], o[5], o[6], o[7]);
                *(u32x2*)(ACT + slot * DM + j0) = w; }
    }
};
struct EpiDown {
    unsigned char* EO; const float* b2; const LAS int* LL; int G, c;
    __device__ __forceinline__ void operator()(f32x4 (&acc)[2][2][4][2], const g8::Unit& u, int wr, int wc, int fr, int fq) const {
        asm volatile("" : "+v"(fr), "+v"(fq));
        const int c0 = u.pn * 256 + wc * 64 + 16 * fq; const float* bp = b2 + (size_t)u.ex * DM + c0;
        f32x4 bb[2][2];
#pragma unroll
        for (int bj = 0; bj < 2; ++bj)
#pragma unroll
            for (int n = 0; n < 2; ++n) bb[bj][n] = *(const f32x4*)(bp + bj * 8 + 4 * n);
        const LAS int* L = LL + u.kind * 512;
        int li[8]; float gt[8];
#pragma unroll
        for (int q = 0; q < 8; ++q) { const int rl = (q >> 2) * 128 + wr * 64 + (q & 3) * 16 + fr; li[q] = L[rl]; gt[q] = __int_as_float(L[256 + rl]) * (1.f / WSCALE); }
#pragma unroll
        for (int ai = 0; ai < 2; ++ai)
#pragma unroll
            for (int m = 0; m < 4; ++m) { const int l = li[ai * 4 + m]; const float g = gt[ai * 4 + m];
                unsigned char* dst = EO + ((size_t)(l & 3) * MROWS + (l >> 2)) * DM + c0;
                u32x4 w;
                { const f32x4 v0 = acc[ai][0][m][0] * g + bb[0][0] * (g * WSCALE), v1 = acc[ai][0][m][1] * g + bb[0][1] * (g * WSCALE);
                  w.x = pk4_fp8(v0[0] * EOSCALE, v0[1] * EOSCALE, v0[2] * EOSCALE, v0[3] * EOSCALE); w.y = pk4_fp8(v1[0] * EOSCALE, v1[1] * EOSCALE, v1[2] * EOSCALE, v1[3] * EOSCALE); }
                { const f32x4 v0 = acc[ai][1][m][0] * g + bb[1][0] * (g * WSCALE), v1 = acc[ai][1][m][1] * g + bb[1][1] * (g * WSCALE);
                  w.z = pk4_fp8(v0[0] * EOSCALE, v0[1] * EOSCALE, v0[2] * EOSCALE, v0[3] * EOSCALE); w.w = pk4_fp8(v1[0] * EOSCALE, v1[1] * EOSCALE, v1[2] * EOSCALE, v1[3] * EOSCALE); }
                if (l >= 0) *(u32x4*)dst = w; }
    }
};
__device__ __forceinline__ const LAS unsigned char* moe_tiles(Frame& F, int& nT) {
    FT_DECL;
    LAS unsigned char* TE = (LAS unsigned char*)(F.lds + RING_BYTES); const int* meta = WSP(int, WS_ROUTE + RT_META);
    __syncthreads();
    nT = meta[64]; if (nT > MAXTILE) nT = MAXTILE;
    for (int i = f_tid; i < MAXTILE; i += 512) TE[i] = (unsigned char)((i < nT) ? meta[128 + i] : 0);
    __syncthreads();
    return (const LAS unsigned char*)TE;
}

__device__ __forceinline__ void p10_combine(Frame& F) {
    FT_DECL;
    const float* mod = WSP(float, WS_SMALL + SM_MOD); const unsigned char* EO = WSP(unsigned char, WS_EO);
    const size_t gt = (size_t)F.vcu * 512 + f_tid, NTH = (size_t)F.G * 512;
    constexpr int U = 4;
    for (size_t i0 = gt; i0 < (size_t)MROWS * 128; i0 += NTH * U) {
        u32x2 ev[U][4]; f32x4 xv[U][2], gv[U][2];
#pragma unroll
        for (int u = 0; u < U; ++u) { const size_t i = i0 + (size_t)u * NTH; const size_t row = i >> 7; const int c0 = (int)(i & 127) * 8;
            const float* g2 = mod + (size_t)(row >> 12) * (NMOD * DM) + 5 * DM + c0; const bf16_t* op = WSP(bf16_t, WS_XN) + row * DM + c0;
#pragma unroll
            for (int k = 0; k < 4; ++k) ev[u][k] = __builtin_nontemporal_load((const u32x2*)(EO + ((size_t)k * MROWS + row) * DM + c0));
            { const u32x4 xb = *(const u32x4*)op; xv[u][0] = (f32x4){__uint_as_float(xb.x << 16), __uint_as_float(xb.x & 0xffff0000u), __uint_as_float(xb.y << 16), __uint_as_float(xb.y & 0xffff0000u)};
              xv[u][1] = (f32x4){__uint_as_float(xb.z << 16), __uint_as_float(xb.z & 0xffff0000u), __uint_as_float(xb.w << 16), __uint_as_float(xb.w & 0xffff0000u)}; }
            gv[u][0] = *(const f32x4*)g2; gv[u][1] = *(const f32x4*)(g2 + 4); }
#pragma unroll
        for (int u = 0; u < U; ++u) { const size_t i = i0 + (size_t)u * NTH; const size_t row = i >> 7; const int c0 = (int)(i & 127) * 8;
            float s[8];
#pragma unroll
            for (int e = 0; e < 8; ++e) s[e] = 0.f;
#pragma unroll
            for (int k = 0; k < 4; ++k) { const u32x2 v = ev[u][k];
                const f32x2 a = __builtin_amdgcn_cvt_pk_f32_fp8((int)v.x, false), b = __builtin_amdgcn_cvt_pk_f32_fp8((int)v.x, true), c = __builtin_amdgcn_cvt_pk_f32_fp8((int)v.y, false), d = __builtin_amdgcn_cvt_pk_f32_fp8((int)v.y, true);
                s[0] += a.x; s[1] += a.y; s[2] += b.x; s[3] += b.y; s[4] += c.x; s[5] += c.y; s[6] += d.x; s[7] += d.y; }
#pragma unroll
            for (int e = 0; e < 8; ++e) s[e] *= (1.f / EOSCALE);
            f32x4 o0 = xv[u][0] + gv[u][0] * (f32x4){s[0], s[1], s[2], s[3]}, o1 = xv[u][1] + gv[u][1] * (f32x4){s[4], s[5], s[6], s[7]};
            float* op = F.out + row * DM + c0;
            __builtin_nontemporal_store(o0, (f32x4*)op); __builtin_nontemporal_store(o1, (f32x4*)(op + 4)); }
    }
}

struct Args { const float* in[34]; float* out; unsigned char* ws; int ph_lo, ph_hi; };
constexpr int N_PHASES = 11;

__global__ void __launch_bounds__(512, 2) mega(Args args) {
    extern __shared__ __attribute__((aligned(16))) unsigned char lds[];
    Frame F;
    F.lds = (LAS unsigned char*)lds;
    F.MISC = (volatile LAS unsigned*)(F.lds + LDSCTL_OFF);
    F.wave = __builtin_amdgcn_readfirstlane(threadIdx.x >> 6);
    FT_DECL;
    F.G = gridDim.x; { const int bx = blockIdx.x; F.vcu = (F.G % 8 == 0) ? (bx % 8) * (F.G / 8) + bx / 8 : bx; }
    F.in = (kin_t)__builtin_amdgcn_kernarg_segment_ptr();
    F.out = args.out; F.ws = args.ws;
    F.ctl = (gu32*)(args.ws + WS_CTL);
    for (int u = f_tid; u < (LDS_BYTES - LDSCTL_OFF) / 4; u += NWAVES * 64) ((LAS unsigned*)(F.lds + LDSCTL_OFF))[u] = 0u;
    __syncthreads();
    const int lo = args.ph_lo, hi = args.ph_hi;
    XcdBarrier bar; bar.bar = (unsigned*)(F.ctl + CW_BAR); bar.x = 0; bar.st = nullptr;
    if (hi - lo > 1) bar = xcd_barrier_post((unsigned*)(F.ctl + CW_BAR), F.MISC + 8, f_tid == 0);
#define IN(k) (lo <= (k) && (k) < hi)
#define SEAM(k) do { if (IN(k) && IN((k) + 1)) xcd_barrier(bar, F.wave == 0 && lane_id() == 0); } while (0)

    if (IN(0)) { p0_prologue(F); } SEAM(0);
    if (IN(1)) { p1_norm1(F); } SEAM(1);
    if (IN(2)) {
        SchedInProj S{F.G, (int)blockIdx.x, (const char*)WSP(bf16_t, WS_H), (const char*)WSP(bf16_t, WS_WIN)};
        EpiInProj E{WSP(unsigned char, WS_Q), WSP(unsigned char, WS_K), WSP(unsigned char, WS_V), WSP(bf16_t, WS_UT), F.in[9], F.in[10], WSP(float, WS_SMALL + SM_ROPE)};
        g8::gemm_phase<false>(F.lds, DM, S, E, F.wave, lane_id());
    } SEAM(2);
    if (IN(3)) { p3_attention8(F); p3_hyena(F); } SEAM(3);
    if (IN(4)) { p4_hynorm(F); } SEAM(4);
    if (IN(5)) {
        SchedStatic S{F.G, (int)blockIdx.x, MROWS / 256, DM / 256, (const char*)WSP(bf16_t, WS_MIX), (const char*)WSP(bf16_t, WS_WOUT)};
        EpiOutProj E{F.in[0], WSP(bf16_t, WS_XN), WSP(float, WS_SMALL + SM_MOD)};
        g8::gemm_phase<false>(F.lds, DM, S, E, F.wave, lane_id());
    } SEAM(5);
    if (IN(6)) { p6_router_mfma(F); } SEAM(6);
    if (IN(7)) { p7_scatter(F); } SEAM(7);
    if (IN(8)) {
        int nT; const LAS unsigned char* TE = moe_tiles(F, nT);
        LAS int* RWL = (LAS int*)(F.lds + RING_BYTES + 1024);
        static_assert(RING_BYTES + 1024 + 17 * 1024 <= LDSCTL_OFF, "LDS map");
        SchedMoE<8> S{F.G, (int)blockIdx.x, nT, (const char*)WSP(char, WS_H), (const char*)WSP(char, WS_W1), (size_t)2 * DM * DM, TE, RWL, true};
        { const int* list = WSP(int, WS_ROUTE + RT_LIST); const int t8 = F.wave * 64 + lane_id();
            g8::Unit u; for (int i = 0; i < 17 && S.next(i, u); i += 2) { const int ii = i + (t8 >> 8); g8::Unit u2; if (S.next(ii, u2)) { const int li = list[(size_t)u2.pm * 256 + (t8 & 255)]; RWL[ii * 256 + (t8 & 255)] = (li >= 0) ? (li >> 2) : 0; } }
            __syncthreads(); }
        EpiSwiGLU E{WSP(unsigned char, WS_ACT), F.in[31]};
        g8::gemm_phase_g<true, true>(F.lds, DM, S, E, F.wave, lane_id());
    } SEAM(8);
    if (IN(9)) {
        int nT; const LAS unsigned char* TE = moe_tiles(F, nT);
        SchedMoE<4> S{F.G, (int)blockIdx.x, nT, (const char*)WSP(char, WS_ACT), (const char*)WSP(char, WS_W2), (size_t)DM * DM, TE, nullptr, false};
        LAS int* LL = (LAS int*)(F.lds + RING_BYTES + 1024);
        static_assert(RING_BYTES + 1024 + 9 * 2048 <= LDSCTL_OFF, "LDS map");
        { const int* list = WSP(int, WS_ROUTE + RT_LIST); const float* gslot = WSP(float, WS_ROUTE + RT_GSLOT);
            const int t9 = F.wave * 64 + lane_id();
            g8::Unit u; for (int i = 0; i < 9 && S.next(i, u); ++i) { const int t = t9 & 255; const size_t slot = (size_t)u.pm * 256 + t;
                LL[i * 512 + (t9 >> 8) * 256 + t] = (t9 < 256) ? list[slot] : __float_as_int(gslot[slot]); }
            __syncthreads(); }
        EpiDown E{WSP(unsigned char, WS_EO), F.in[33], LL, F.G, (int)blockIdx.x};
        g8::gemm_phase<true>(F.lds, DM, S, E, F.wave, lane_id());
    } SEAM(9);
    if (IN(10)) { p10_combine(F); }
#undef IN
#undef SEAM
}

extern "C" void kernel_launch(void* const* d_in, const int* in_sizes, int n_in, void* d_out, int out_size, void* d_ws, size_t ws_size, hipStream_t stream) {
    static int grid = 0;
    if (grid == 0) {
        if (n_in != 34 || out_size != MROWS * DM || ws_size < WS_END) { fprintf(stderr, "kernel_launch: unexpected shapes: n_in %d out %d ws %zu (need %zu)\n", n_in, out_size, ws_size, (size_t)WS_END); grid = -1; return; }
        int dev = 0, cus = 0, per_cu = 0;
        if (hipGetDevice(&dev) != hipSuccess || hipDeviceGetAttribute(&cus, hipDeviceAttributeMultiprocessorCount, dev) != hipSuccess) { grid = -1; return; }
        if (hipFuncSetAttribute((const void*)mega, hipFuncAttributeMaxDynamicSharedMemorySize, LDS_BYTES) != hipSuccess) { fprintf(stderr, "kernel_launch: hipFuncSetAttribute failed\n"); grid = -1; return; }
        if (hipOccupancyMaxActiveBlocksPerMultiprocessor(&per_cu, (const void*)mega, NWAVES * 64, LDS_BYTES) != hipSuccess || per_cu < 1) { fprintf(stderr, "kernel_launch: occupancy query says %d\n", per_cu); per_cu = 1; }
        (void)hipGetLastError();
        grid = cus;
    }
    if (grid < 0) return;
    (void)hipMemsetAsync((char*)d_ws + WS_CTL, 0, CTL_ZERO_BYTES, stream);
    Args a{};
    for (int i = 0; i < 34; ++i) a.in[i] = (const float*)d_in[i];
    a.out = (float*)d_out; a.ws = (unsigned char*)d_ws;
    constexpr int LAST = MK_LAST_PHASE + 1;
    if (MK_N_LAUNCHES == 1) { a.ph_lo = 0; a.ph_hi = LAST; hipLaunchKernelGGL(mega, dim3(grid), dim3(NWAVES * 64), LDS_BYTES, stream, a); }
    else for (int p = 0; p < LAST; ++p) { a.ph_lo = p; a.ph_hi = p + 1; hipLaunchKernelGGL(mega, dim3(grid), dim3(NWAVES * 64), LDS_BYTES, stream, a); }
    const hipError_t le = hipPeekAtLastError();
    if (le != hipSuccess) fprintf(stderr, "kernel_launch: launch failed: %s\n", hipGetErrorName(le));
}
```

```cpp
#include <hip/hip_runtime.h>
#include <hip/hip_bf16.h>
#include <cstdio>
#include <cstdint>

#ifndef MK_N_LAUNCHES
#define MK_N_LAUNCHES 1
#endif
#ifndef MK_LAST_PHASE
#define MK_LAST_PHASE 10
#endif

#define GAS __attribute__((address_space(1)))
#define LAS __attribute__((address_space(3)))
typedef unsigned short bf16_t;
typedef short bf16x8 __attribute__((ext_vector_type(8)));
typedef short s16x4 __attribute__((ext_vector_type(4)));
typedef float f32x2 __attribute__((ext_vector_type(2)));
typedef float f32x4 __attribute__((ext_vector_type(4)));
typedef float f32x16 __attribute__((ext_vector_type(16)));
typedef unsigned u32x2 __attribute__((ext_vector_type(2)));
typedef unsigned u32x4 __attribute__((ext_vector_type(4)));
typedef GAS unsigned gu32;

constexpr int NB = 8, SEQ = 4096, DM = 1024, MROWS = NB * SEQ, CTXL = 256, MCTX = NB * CTXL, MTOT = MROWS + MCTX;
constexpr int KVL = CTXL + SEQ;
constexpr int NHEAD = 4, QKW = 512;
constexpr int HYW = 512, HYC = 1536, INC = 3072, QKVC = 1536;
constexpr int NEXP = 32, TOPK = 4, NMOD = 6;
constexpr float EPS = 1e-6f;
constexpr float LAM_INIT = 0.2f;
constexpr float QSCALE = 0.125f * 1.4426950408889634f;

constexpr size_t MiB = 1u << 20;
constexpr size_t WS_CTL = 0, CTL_ZERO_BYTES = 64 * 1024;
constexpr size_t WS_SMALL = 1 * MiB;
constexpr size_t WS_WIN = 2 * MiB;
constexpr size_t WS_WOUT = 8 * MiB;
constexpr size_t WS_W1 = 10 * MiB;
constexpr size_t WS_W2 = 138 * MiB;
constexpr size_t WS_H = 202 * MiB;
constexpr size_t WS_Q = 270 * MiB;
constexpr size_t WS_K = 302 * MiB;
constexpr size_t WS_V = 336 * MiB;
constexpr size_t WS_UT = 370 * MiB;
constexpr size_t WS_FILT = 466 * MiB;
constexpr size_t WS_Z2T = 498 * MiB;
constexpr size_t WS_MIX = 530 * MiB;
constexpr size_t WS_ROUTE = 594 * MiB;
constexpr size_t WS_ACT = 270 * MiB;
constexpr size_t WS_EO = 598 * MiB;
constexpr size_t WS_XN = 870 * MiB;
constexpr size_t WS_END = 998 * MiB;
constexpr size_t SM_MOD = 0;
constexpr size_t SM_SCAL = 256 * 1024;
constexpr size_t SM_ROPE = 260 * 1024;
constexpr int CW_BAR = 4096;

constexpr int RING_BYTES = 131072;
constexpr int LDSCTL_OFF = 151552;
constexpr int LDS_BYTES = 152576;
constexpr int NWAVES = 8;

#define LDS_WAIT() asm volatile("s_waitcnt lgkmcnt(0)" ::: "memory")
#define VM_WAIT() asm volatile("s_waitcnt vmcnt(0)" ::: "memory")
#define RLX_AGENT __ATOMIC_RELAXED, __HIP_MEMORY_SCOPE_AGENT

__device__ __forceinline__ unsigned cvt_pk_bf16(float lo, float hi) { unsigned r; asm volatile("v_cvt_pk_bf16_f32 %0, %1, %2" : "=v"(r) : "v"(lo), "v"(hi)); return r; }
__device__ __forceinline__ float bf2f(bf16_t v) { return __uint_as_float(((unsigned)v) << 16); }
__device__ __forceinline__ float wave_sum(float v) {
#pragma unroll
    for (int o = 1; o < 64; o <<= 1) v += __shfl_xor(v, o);
    return v;
}

#define XB_TMO      128
#define XB_XCNT(j)  (256  + 64 * (j))
#define XB_XSUB(j)  (1280 + 64 * (j))
#define XB_XGEN(j)  (2304 + 64 * (j))
#define XB_TOP      3328
#define XB_TOPGEN   3392
#define XCD_BAR_WORDS 3456
#define XB_SPIN_CAP (1u << 22)
__device__ __forceinline__ unsigned xb_ld(unsigned* p)              { return __hip_atomic_load(p, __ATOMIC_RELAXED, __HIP_MEMORY_SCOPE_AGENT); }
__device__ __forceinline__ unsigned xb_add(unsigned* p, unsigned v) { return __hip_atomic_fetch_add(p, v, __ATOMIC_RELAXED, __HIP_MEMORY_SCOPE_AGENT); }
__device__ __forceinline__ unsigned xb_xcc_id() { return (unsigned)__builtin_amdgcn_s_getreg((3 << 11) | 20) & 0xFu; }
#define XB_SPIN(cond, bar) do { unsigned _sp = 0; while (cond) { __builtin_amdgcn_s_sleep(1); \
    if ((++_sp & 255u) == 0u) { if (xb_ld(&(bar)[XB_TMO])) break; if (_sp > XB_SPIN_CAP) { atomicAdd(&(bar)[XB_TMO], 1u); break; } } } } while (0)
struct XcdBarrier { unsigned* bar; unsigned x; volatile LAS unsigned* st; };
__device__ __forceinline__ XcdBarrier xcd_barrier_post(unsigned* bar, volatile LAS unsigned* st, bool leader) {
    XcdBarrier b; b.bar = bar; b.x = xb_xcc_id(); b.st = st;
    if (leader) (void)xb_add(&bar[XB_XCNT(b.x)], 1u);
    return b;
}
__device__ __forceinline__ void xcd_barrier_complete(unsigned* bar, unsigned x, unsigned& nloc, unsigned& nx) {
    const unsigned G = gridDim.x * gridDim.y * gridDim.z;
    unsigned sum, cnt, mine, sp = 0u;
    for (;;) {
        sum = 0u; cnt = 0u; mine = 0u;
#pragma unroll
        for (unsigned j = 0; j < 16; ++j) { const unsigned c = xb_ld(&bar[XB_XCNT(j)]); sum += c; cnt += (c > 0u) ? 1u : 0u; mine = (j == x) ? c : mine; }
        if (sum == G) break;
        __builtin_amdgcn_s_sleep(1);
        if ((++sp & 255u) == 0u) { if (xb_ld(&bar[XB_TMO])) break; if (sp > XB_SPIN_CAP) { atomicAdd(&bar[XB_TMO], 1u); break; } }
    }
    nloc = mine > 0u ? mine : 1u; nx = cnt > 0u ? cnt : 1u;
}
__device__ __forceinline__ void xcd_barrier(const XcdBarrier& b, bool leader) {
    asm volatile("s_waitcnt vmcnt(0)" ::: "memory");
    __syncthreads();
    if (leader) {
        unsigned* bar = b.bar;
        __builtin_amdgcn_s_waitcnt(0);
        unsigned nloc = b.st[0], nx = b.st[1];
        if (nloc == 0u) { xcd_barrier_complete(bar, b.x, nloc, nx); b.st[0] = nloc; b.st[1] = nx; }
        const unsigned old = xb_add(&bar[XB_XSUB(b.x)], 1u);
        const unsigned gen = old / nloc;
        if (old + 1u == (gen + 1u) * nloc) {
            __builtin_amdgcn_fence(__ATOMIC_RELEASE, "agent");
            asm volatile("s_waitcnt vmcnt(0)" ::: "memory");
            const unsigned og = xb_add(&bar[XB_TOP], 1u);
            const unsigned tg = og / nx;
            if (og + 1u == (tg + 1u) * nx) xb_add(&bar[XB_TOPGEN], 1u);
            else XB_SPIN(xb_ld(&bar[XB_TOPGEN]) == tg, bar);
            __builtin_amdgcn_fence(__ATOMIC_ACQUIRE, "agent");
            xb_add(&bar[XB_XGEN(b.x)], 1u);
            asm volatile("s_waitcnt vmcnt(0)" ::: "memory");
        } else {
            XB_SPIN(xb_ld(&bar[XB_XGEN(b.x)]) == gen, bar);
            __builtin_amdgcn_fence(__ATOMIC_ACQUIRE, "agent");
            asm volatile("s_waitcnt vmcnt(0)" ::: "memory");
        }
    }
    __syncthreads();
}

namespace g8 {
constexpr int BM = 256, BK = 64, HALF = 128, HTB = HALF * BK * 2, STAGE_BYTES = 8 * HTB, NXCD = 8, WGM = 8;
__host__ __device__ __forceinline__ int lds_byte(int r, int c) { const int st = (r >> 4) * 2 + (c >> 5), rr = r & 15, cc = c & 31, ob = rr * 64 + cc * 2; return st * 1024 + (ob ^ (((ob >> 9) & 1) << 5)); }
__host__ __device__ __forceinline__ void stage_rc(int b, int& R, int& C) { const int st = b / 1024, sb = b % 1024, swz = sb ^ (((sb >> 9) & 1) << 5); R = (st >> 1) * 16 + swz / 64; C = (st & 1) * 32 + (swz % 64) / 2; }
__host__ __device__ __forceinline__ int perm32(int rho) { const int n = rho >> 4, i = rho & 15; return 8 * (i >> 2) + 4 * n + (i & 3); }

struct Unit { const char* a; const char* b; int pm, pn, kind, ex; };

__device__ __forceinline__ void tile_of(int L, int nM, int nN, int& pm, int& pn) {
    const int nwg = nM * nN; int wgid = L;
    { const int q = nwg / NXCD, r = nwg % NXCD, xcd = wgid % NXCD, off = wgid / NXCD; wgid = (xcd < r ? xcd * (q + 1) : r * (q + 1) + (xcd - r) * q) + off; }
    const int nig = WGM * nN, gid = wgid / nig, fm = gid * WGM, gsz = (nM - fm) < WGM ? (nM - fm) : WGM;
    pm = fm + ((wgid % nig) % gsz); pn = (wgid % nig) / gsz;
}

typedef int i32x8 __attribute__((ext_vector_type(8)));
template <bool FP8, bool GATHER, class Epi, class Sched>
__device__ __forceinline__ void gemm_phase_g(LAS unsigned char* lds, const int K, const Sched& S, const Epi& E, const int wid, const int lane) {
    const int tid = wid * 64 + lane, wr = wid >> 2, wc = wid & 3, fr = lane & 15, fq = lane >> 4;
    const int nt = FP8 ? K / 128 : K / BK;
    const int RP = FP8 ? K : 2 * K;
    unsigned voffA[2], voffB[2]; int srow[2], scol[2];
#pragma unroll
    for (int i = 0; i < 2; ++i) { int R, C; stage_rc(tid * 16 + i * 8192, R, C); const int Rb = (R & ~31) + perm32(R & 31);
        voffA[i] = (unsigned)(R * RP + C * 2); voffB[i] = (unsigned)(Rb * RP + C * 2); srow[i] = R; scol[i] = C * 2; }
    const size_t kstep = (size_t)(BK * 2);
    const size_t hstep = (size_t)HALF * RP;
    const unsigned ldsw = (unsigned)wid * 1024u;
    unsigned cO0[2], cO1[2], nO0[2], nO1[2];
#define PG8_GOFF(D0, D1, ui_) do { if constexpr (GATHER) { const LAS int* rw_ = S.rows(ui_); _Pragma("unroll") for (int i_ = 0; i_ < 2; ++i_) { \
        D0[i_] = (unsigned)rw_[srow[i_]] * (unsigned)RP + (unsigned)scol[i_]; D1[i_] = (unsigned)rw_[128 + srow[i_]] * (unsigned)RP + (unsigned)scol[i_]; } } \
      else { _Pragma("unroll") for (int i_ = 0; i_ < 2; ++i_) { D0[i_] = voffA[i_]; D1[i_] = voffA[i_] + (unsigned)hstep; } } } while (0)
    const int aoff = lds_byte(wr * 64 + fr, FP8 ? fq * 16 : fq * 8), boff = lds_byte(wc * 32 + fr, FP8 ? fq * 16 : fq * 8);
    constexpr int KOFF = FP8 ? 16 : 1024;
#define PG8_SA(b, h) (((b) * 2 + (h)) * HTB)
#define PG8_SB(b, h) ((4 + (b) * 2 + (h)) * HTB)
#define PG8_STAGE(bufoff, gbase, voff) do { _Pragma("unroll") for (int _i = 0; _i < 2; ++_i) \
        __builtin_amdgcn_global_load_lds((const unsigned*)((const char*)(gbase) + (voff)[_i]), (LAS unsigned*)(lds + (bufoff) + ldsw + _i * 8192), 16, 0, 0); } while (0)
#define PG8_LD32(p) __builtin_bit_cast(i32x8, __builtin_shufflevector(*(const LAS u32x4*)(p), *(const LAS u32x4*)((p) + 16), 0, 1, 2, 3, 4, 5, 6, 7))
#define PG8_LDA8(dst, b, h) do { _Pragma("unroll") for (int m = 0; m < 4; ++m) dst[m] = PG8_LD32(lds + PG8_SA(b, h) + aoff + m * 2048); } while (0)
#define PG8_LDB8(dst, b, h) do { _Pragma("unroll") for (int n = 0; n < 2; ++n) dst[n] = PG8_LD32(lds + PG8_SB(b, h) + boff + n * 2048); } while (0)
#define PG8_LDA(dst, b, h) do { _Pragma("unroll") for (int m = 0; m < 4; ++m) _Pragma("unroll") for (int k = 0; k < 2; ++k) dst[m][k] = *(const LAS bf16x8*)(lds + PG8_SA(b, h) + aoff + m * 2048 + k * KOFF); } while (0)
#define PG8_LDB(dst, b, h) do { _Pragma("unroll") for (int n = 0; n < 2; ++n) _Pragma("unroll") for (int k = 0; k < 2; ++k) dst[n][k] = *(const LAS bf16x8*)(lds + PG8_SB(b, h) + boff + n * 2048 + k * KOFF); } while (0)
#define PG8_MMA(ai, bj, At, Bt) do { __builtin_amdgcn_s_setprio(1); _Pragma("unroll") for (int m = 0; m < 4; ++m) _Pragma("unroll") for (int n = 0; n < 2; ++n) _Pragma("unroll") for (int k = 0; k < 2; ++k) \
        acc[ai][bj][m][n] = __builtin_amdgcn_mfma_f32_16x16x32_bf16(Bt[n][k], At[m][k], acc[ai][bj][m][n], 0, 0, 0); __builtin_amdgcn_s_setprio(0); } while (0)
#define PG8_MMA8(ai, bj, At, Bt) do { __builtin_amdgcn_s_setprio(1); _Pragma("unroll") for (int m = 0; m < 4; ++m) _Pragma("unroll") for (int n = 0; n < 2; ++n) \
        asm volatile("v_mfma_scale_f32_16x16x128_f8f6f4 %0, %1, %2, %0, %3, %3 op_sel_hi:[0,0,0]" : "+v"(acc[ai][bj][m][n]) : "v"(Bt[n]), "v"(At[m]), "v"(one_scale)); __builtin_amdgcn_s_setprio(0); } while (0)
#define PG8_WAIT_V(n) asm volatile("s_waitcnt vmcnt(" #n ")" ::: "memory")
#define PG8_WAIT_L(n) asm volatile("s_waitcnt lgkmcnt(" #n ")" ::: "memory")
#define PG8_BAR __builtin_amdgcn_s_barrier()
#define PG8_SCHED __builtin_amdgcn_sched_barrier(0)
    Unit cur, nxt; int ui = 0;
    if (!S.next(0, cur)) return;
    f32x4 acc[2][2][4][2];
#pragma unroll
    for (int a = 0; a < 2; ++a)
#pragma unroll
        for (int b = 0; b < 2; ++b)
#pragma unroll
            for (int m = 0; m < 4; ++m)
#pragma unroll
                for (int n = 0; n < 2; ++n) acc[a][b][m][n] = (f32x4){0.f, 0.f, 0.f, 0.f};
    bf16x8 At[4][2], B0[2][2], B1[2][2];
    i32x8 At8[4], B08[2], B18[2];
    const unsigned one_scale = 0x7f7f7f7fu;
    const char* cA = cur.a; const char* cB = cur.b;
    PG8_GOFF(cO0, cO1, 0);
    PG8_STAGE(PG8_SB(0, 0), cB, voffB); PG8_STAGE(PG8_SB(0, 1), cB + hstep, voffB); PG8_STAGE(PG8_SA(0, 0), cA, cO0); PG8_STAGE(PG8_SA(0, 1), cA, cO1);
    if (wr == 1) PG8_BAR;
    PG8_WAIT_V(2); PG8_BAR;
    PG8_STAGE(PG8_SB(1, 0), cB + kstep, voffB); PG8_STAGE(PG8_SA(1, 0), cA + kstep, cO0); PG8_STAGE(PG8_SB(1, 1), cB + hstep + kstep, voffB);
    PG8_WAIT_V(6); PG8_BAR;
    for (;;) {
        const bool has_next = S.next(ui + 1, nxt);
        const char* nA = has_next ? nxt.a : cA; const char* nB = has_next ? nxt.b : cB;
        if (has_next) PG8_GOFF(nO0, nO1, ui + 1); else { _Pragma("unroll") for (int i_ = 0; i_ < 2; ++i_) { nO0[i_] = cO0[i_]; nO1[i_] = cO1[i_]; } }
#pragma unroll 1
        for (int t = 0; t < nt; t += 2) {
            const bool last = (t == nt - 2);
            const char* a1 = cA + (size_t)(t + 1) * kstep;
            const char* a2 = last ? nA : cA + (size_t)(t + 2) * kstep; const char* b2 = last ? nB : cB + (size_t)(t + 2) * kstep;
            const char* a3 = a2 + kstep; const char* b3 = b2 + kstep;
            unsigned o20[2], o21[2];
#pragma unroll
            for (int i_ = 0; i_ < 2; ++i_) { o20[i_] = last ? nO0[i_] : cO0[i_]; o21[i_] = last ? nO1[i_] : cO1[i_]; }
            if constexpr (FP8) {
            PG8_LDB8(B08, 0, 0); PG8_LDB8(B18, 0, 1); PG8_SCHED; PG8_LDA8(At8, 0, 0); PG8_STAGE(PG8_SA(1, 1), a1, cO1);
            PG8_WAIT_V(8); PG8_WAIT_L(0); PG8_BAR; PG8_MMA8(0, 0, At8, B08); PG8_MMA8(0, 1, At8, B18); PG8_BAR; PG8_SCHED;
            PG8_LDA8(At8, 0, 1); PG8_STAGE(PG8_SB(0, 0), b2, voffB); PG8_STAGE(PG8_SB(0, 1), b2 + hstep, voffB); PG8_STAGE(PG8_SA(0, 0), a2, o20);
            PG8_WAIT_V(8); PG8_WAIT_L(0); PG8_BAR; PG8_MMA8(1, 0, At8, B08); PG8_MMA8(1, 1, At8, B18); PG8_BAR; PG8_SCHED;
            PG8_LDB8(B08, 1, 0); PG8_LDB8(B18, 1, 1); PG8_SCHED; PG8_LDA8(At8, 1, 0); PG8_STAGE(PG8_SA(0, 1), a2, o21);
            PG8_WAIT_V(8); PG8_WAIT_L(0); PG8_BAR; PG8_MMA8(0, 0, At8, B08); PG8_MMA8(0, 1, At8, B18); PG8_BAR; PG8_SCHED;
            PG8_LDA8(At8, 1, 1); PG8_STAGE(PG8_SB(1, 0), b3, voffB); PG8_STAGE(PG8_SB(1, 1), b3 + hstep, voffB); PG8_STAGE(PG8_SA(1, 0), a3, o20);
            PG8_WAIT_V(8); PG8_WAIT_L(0); PG8_BAR; PG8_MMA8(1, 0, At8, B08); PG8_MMA8(1, 1, At8, B18); PG8_BAR; PG8_SCHED;
            } else {
            PG8_LDB(B0, 0, 0); PG8_LDB(B1, 0, 1); PG8_SCHED; PG8_LDA(At, 0, 0); PG8_STAGE(PG8_SA(1, 1), a1, cO1);
            PG8_WAIT_V(8); PG8_WAIT_L(0); PG8_BAR; PG8_MMA(0, 0, At, B0); PG8_MMA(0, 1, At, B1); PG8_BAR; PG8_SCHED;
            PG8_LDA(At, 0, 1); PG8_STAGE(PG8_SB(0, 0), b2, voffB); PG8_STAGE(PG8_SB(0, 1), b2 + hstep, voffB); PG8_STAGE(PG8_SA(0, 0), a2, o20);
            PG8_WAIT_V(8); PG8_WAIT_L(0); PG8_BAR; PG8_MMA(1, 0, At, B0); PG8_MMA(1, 1, At, B1); PG8_BAR; PG8_SCHED;
            PG8_LDB(B0, 1, 0); PG8_LDB(B1, 1, 1); PG8_SCHED; PG8_LDA(At, 1, 0); PG8_STAGE(PG8_SA(0, 1), a2, o21);
            PG8_WAIT_V(8); PG8_WAIT_L(0); PG8_BAR; PG8_MMA(0, 0, At, B0); PG8_MMA(0, 1, At, B1); PG8_BAR; PG8_SCHED;
            PG8_LDA(At, 1, 1); PG8_STAGE(PG8_SB(1, 0), b3, voffB); PG8_STAGE(PG8_SB(1, 1), b3 + hstep, voffB); PG8_STAGE(PG8_SA(1, 0), a3, o20);
            PG8_WAIT_V(8); PG8_WAIT_L(0); PG8_BAR; PG8_MMA(1, 0, At, B0); PG8_MMA(1, 1, At, B1); PG8_BAR; PG8_SCHED;
            }
        }
        if (wr == 0) PG8_BAR;
        if constexpr (FP8) asm volatile("s_nop 15\n\ts_nop 15" ::: "memory");
        E(acc, cur, wr, wc, fr, fq);
        if (!has_next) break;
#pragma unroll
        for (int a = 0; a < 2; ++a)
#pragma unroll
            for (int b = 0; b < 2; ++b)
#pragma unroll
                for (int m = 0; m < 4; ++m)
#pragma unroll
                    for (int n = 0; n < 2; ++n) acc[a][b][m][n] = (f32x4){0.f, 0.f, 0.f, 0.f};
        cur = nxt; cA = nA; cB = nB; ++ui;
#pragma unroll
        for (int i_ = 0; i_ < 2; ++i_) { cO0[i_] = nO0[i_]; cO1[i_] = nO1[i_]; }
        if (wr == 1) PG8_BAR;
    }
    PG8_WAIT_V(0);
    PG8_BAR;
#undef PG8_SA
#undef PG8_GOFF
#undef PG8_SB
#undef PG8_STAGE
#undef PG8_LDA
#undef PG8_LDB
#undef PG8_MMA
#undef PG8_MMA8
#undef PG8_LDA8
#undef PG8_LDB8
#undef PG8_LD32
#undef PG8_WAIT_V
#undef PG8_WAIT_L
#undef PG8_BAR
#undef PG8_SCHED
}
template <bool FP8, class Epi, class Sched>
__device__ __forceinline__ void gemm_phase(LAS unsigned char* lds, const int K, const Sched& S, const Epi& E, const int wid, const int lane) { gemm_phase_g<FP8, false>(lds, K, S, E, wid, lane); }
}

__device__ __forceinline__ int lane_id() { int l; asm volatile("v_mbcnt_lo_u32_b32 %0, -1, 0\n\tv_mbcnt_hi_u32_b32 %0, -1, %0" : "=v"(l)); return l; }
#define FT_DECL const int f_lane = lane_id(), f_tid = F.wave * 64 + f_lane; (void)f_tid; (void)f_lane
typedef const float* cfp_t;
typedef __attribute__((address_space(4))) cfp_t* kin_t;
struct Frame {
    LAS unsigned char* lds;
    volatile LAS unsigned* MISC;
    gu32* ctl;
    int wave, vcu, G;
    kin_t in;
    float* out;
    unsigned char* ws;
};
#define WSP(T, off) ((T*)(F.ws + (off)))

template <class RowMap>
__device__ __forceinline__ void p0_transpose_item(const float* W, int K, int N, bf16_t* WT, const RowMap& rowmap, const float* kscale, LAS float* scr, int item, int lane) {
    const int nblk = N / 32, kb = item / nblk, nb = item % nblk, k0 = 64 * kb, n0 = 32 * nb;
#pragma unroll 8
    for (int i = 0; i < 32; ++i) { const int kk = 2 * i + (lane >> 5); float v = W[(size_t)(k0 + kk) * N + n0 + (lane & 31)]; if (kscale) v *= kscale[k0 + kk]; scr[kk * 33 + (lane & 31)] = v; }
    LDS_WAIT(); asm volatile("" ::: "memory");
    const int c = lane & 7;
#pragma unroll
    for (int j = 0; j < 4; ++j) { const int n = (lane >> 3) + 8 * j; const LAS float* s = scr + (8 * c) * 33 + n;
        u32x4 o; o.x = cvt_pk_bf16(s[0 * 33], s[1 * 33]); o.y = cvt_pk_bf16(s[2 * 33], s[3 * 33]); o.z = cvt_pk_bf16(s[4 * 33], s[5 * 33]); o.w = cvt_pk_bf16(s[6 * 33], s[7 * 33]);
        *(GAS u32x4*)(WT + (size_t)rowmap(n0 + n) * K + k0 + 8 * c) = o; }
    LDS_WAIT(); asm volatile("" ::: "memory");
}

__device__ __forceinline__ unsigned pk4_fp8(float a, float b, float c, float d) { int r = __builtin_amdgcn_cvt_pk_fp8_f32(a, b, 0, false); r = __builtin_amdgcn_cvt_pk_fp8_f32(c, d, r, true); return (unsigned)r; }
constexpr float EOSCALE = 16.f;
constexpr float WSCALE = 32.f;
template <class RowMap>
__device__ __forceinline__ void p0_transpose_item_f8(const float* W, int K, int N, unsigned char* WT, const RowMap& rowmap, LAS float* scr, int item, int lane) {
    const int nblk = N / 32, kb = item / nblk, nb = item % nblk, k0 = 128 * kb, n0 = 32 * nb;
#pragma unroll
    for (int hh = 0; hh < 2; ++hh) { float v[32];
#pragma unroll
        for (int i = 0; i < 32; ++i) { const int kk = 2 * (32 * hh + i) + (lane >> 5); v[i] = __builtin_nontemporal_load(W + (size_t)(k0 + kk) * N + n0 + (lane & 31)); }
#pragma unroll
        for (int i = 0; i < 32; ++i) { const int kk = 2 * (32 * hh + i) + (lane >> 5); scr[kk * 33 + (lane & 31)] = v[i] * WSCALE; } }
    LDS_WAIT(); asm volatile("" ::: "memory");
    const int c = lane & 7;
#pragma unroll
    for (int j = 0; j < 4; ++j) { const int n = (lane >> 3) + 8 * j; const LAS float* sp = scr + (16 * c) * 33 + n;
        u32x4 o; o.x = pk4_fp8(sp[0 * 33], sp[1 * 33], sp[2 * 33], sp[3 * 33]); o.y = pk4_fp8(sp[4 * 33], sp[5 * 33], sp[6 * 33], sp[7 * 33]);
        o.z = pk4_fp8(sp[8 * 33], sp[9 * 33], sp[10 * 33], sp[11 * 33]); o.w = pk4_fp8(sp[12 * 33], sp[13 * 33], sp[14 * 33], sp[15 * 33]);
        *(GAS u32x4*)(WT + (size_t)rowmap(n0 + n) * K + k0 + 16 * c) = o; }
    LDS_WAIT(); asm volatile("" ::: "memory");
}
struct MapW2 { __device__ __forceinline__ int operator()(int l) const { const int t = l & ~255, r = l & 255, wc = r >> 6, fq = (r >> 4) & 3, bj = (r >> 3) & 1, low = r & 7; return t + 128 * bj + 32 * wc + 8 * fq + low; } };
struct MapIdent { int off; __device__ __forceinline__ int operator()(int n) const { return off + n; } };
struct MapWin { __device__ __forceinline__ int operator()(int l) const {
    if (l >= 1024) return l;
    const int t = l & ~255, r = l & 255, wc = r >> 6, blk = (r >> 5) & 1, bj = (r >> 4) & 1, low = r & 15;
    return t + 128 * bj + 32 * wc + 16 * blk + low; } };
struct MapW1 { int off; __device__ __forceinline__ int operator()(int jp) const { const int bj = jp >> 10, j = jp & 1023; return off + 256 * (j >> 7) + 128 * bj + (j & 127); } };


__device__ __forceinline__ void p0_filter_item(Frame& F, int item) {
    FT_DECL;
#define in F.in
    LAS float* h1s = (LAS float*)(F.lds);
    LAS float* h2s = (LAS float*)(F.lds + 4096);
    const int t0 = item * 16;
    {
        const int tt = f_tid >> 5, hh = (f_tid & 31) * 2; const float pos = (float)(t0 + tt);
        float feats[17]; feats[0] = pos * (1.f / SEQ);
#pragma unroll
        for (int i = 0; i < 8; ++i) { const float band = 1e-4f + (float)i * ((7.f - 1e-4f) / 7.f); const float ang = (6.283185307179586f / SEQ) * pos * band; feats[1 + i] = __sinf(ang); feats[9 + i] = __cosf(ang); }
#pragma unroll
        for (int u = 0; u < 2; ++u) { const int h = hh + u; float a = in[19][h];
#pragma unroll
            for (int k = 0; k < 17; ++k) a += feats[k] * in[18][k * 64 + h];
            h1s[tt * 64 + h] = __sinf(in[20][h] * a); }
        __syncthreads();
#pragma unroll
        for (int u = 0; u < 2; ++u) { const int h = hh + u; float a = in[22][h];
#pragma unroll 8
            for (int k = 0; k < 64; ++k) a += h1s[tt * 64 + k] * in[21][k * 64 + h];
            h2s[tt * 64 + h] = __sinf(in[23][h] * a); }
        __syncthreads();
    }
    f32x4 acc[16];
#pragma unroll
    for (int t = 0; t < 16; ++t) acc[t] = (f32x4){0.f, 0.f, 0.f, 0.f};
    const int o = 4 * f_tid;
    for (int k0 = 0; k0 < 64; k0 += 4) { f32x4 w[4];
#pragma unroll
        for (int q = 0; q < 4; ++q) w[q] = *(const f32x4*)(in[24] + (size_t)(k0 + q) * 2048 + o);
#pragma unroll
        for (int t = 0; t < 16; ++t) { const f32x4 hv = *(const LAS f32x4*)(h2s + t * 64 + k0); acc[t] += w[0] * hv[0] + w[1] * hv[1] + w[2] * hv[2] + w[3] * hv[3]; } }
    const int c0 = o & 511, od = o >> 9;
    float* dst = WSP(float, WS_FILT) + ((size_t)od * 512 + c0) * SEQ + t0;
#pragma unroll
    for (int e = 0; e < 4; ++e) { const float la = -3.0701134573253944f, lb = -15.350567286626972f; const float delta = fabsf(la + (float)(c0 + e) * ((lb - la) / 511.f));
#pragma unroll
        for (int q = 0; q < 4; ++q) { f32x4 v;
#pragma unroll
            for (int i = 0; i < 4; ++i) { const int t = 4 * q + i; const float tn = (float)(t0 + t) * (1.f / SEQ); v[i] = acc[t][e] * __expf(-tn * delta); }
            *(f32x4*)(dst + (size_t)e * SEQ + 4 * q) = v; } }
    __syncthreads();
#undef in
}

__device__ __forceinline__ float silu_f(float v) { return v / (1.f + __expf(-v)); }

__device__ __forceinline__ void p0_prologue(Frame& F) {
    FT_DECL;
#define in F.in
    const int wg = blockIdx.x;
    if (wg < 96) {
        LAS float* sv = (LAS float*)F.lds;
        for (int i = f_tid; i < 9 * 1024; i += 512) { const int r = i >> 10, k = i & 1023; const float c = (r < 8) ? in[1][r * 1024 + k] : in[3][k]; sv[i] = silu_f(c); }
        __syncthreads();
        const int j = wg * 64 + f_lane; const float* wm = in[4];
        float acc[9];
#pragma unroll
        for (int r = 0; r < 9; ++r) acc[r] = 0.f;
        const int kbeg = F.wave * 128;
        for (int k0 = kbeg; k0 < kbeg + 128; k0 += 16) { float w[16];
#pragma unroll
            for (int q = 0; q < 16; ++q) w[q] = __builtin_nontemporal_load(wm + (size_t)(k0 + q) * (NMOD * DM) + j);
#pragma unroll
            for (int q = 0; q < 16; ++q)
#pragma unroll
                for (int r = 0; r < 9; ++r) acc[r] += sv[r * 1024 + k0 + q] * w[q]; }
        LAS float* red = (LAS float*)(F.lds + 40960);
#pragma unroll
        for (int r = 0; r < 9; ++r) red[(F.wave * 9 + r) * 64 + f_lane] = acc[r];
        __syncthreads();
        for (int i = f_tid; i < 9 * 64; i += 512) { const int r = i >> 6, l = i & 63; float s = in[5][wg * 64 + l];
#pragma unroll
            for (int w = 0; w < 8; ++w) s += red[(w * 9 + r) * 64 + l];
            WSP(float, WS_SMALL + SM_MOD)[r * (NMOD * DM) + wg * 64 + l] = s; }
        __syncthreads();
    } else if (wg == 96) {
        if (F.wave == 0) {
            const float a = wave_sum(in[11][f_lane] * in[12][f_lane]), b = wave_sum(in[13][f_lane] * in[14][f_lane]);
            float gq = fabsf(in[9][f_lane]), gk = fabsf(in[10][f_lane]);
#pragma unroll
            for (int o = 1; o < 64; o <<= 1) { gq = fmaxf(gq, __shfl_xor(gq, o)); gk = fmaxf(gk, __shfl_xor(gk, o)); }
            if (f_lane == 0) { float* sc = WSP(float, WS_SMALL + SM_SCAL); sc[0] = expf(a) - expf(b) + LAM_INIT;
                sc[1] = (8.f * gq * gk * 1.02f + 0.05f) * 1.4426950408889634f; }
        }
        for (int i = f_tid; i < 64 * 16; i += 512) { const int pos = i >> 4, f = i & 15;
            const float inv = powf(10000.f, -(float)f / 16.f); const float ang = (float)pos * inv;
            float* rt = WSP(float, WS_SMALL + SM_ROPE); rt[2 * i] = cosf(ang); rt[2 * i + 1] = sinf(ang); }
    }
    __syncthreads();
    for (int it = wg; it < SEQ / 16; it += F.G) p0_filter_item(F, it);
    __syncthreads();
    {
        LAS float* scr = (LAS float*)(F.lds + F.wave * 16896);
        const int gw = F.vcu * NWAVES + F.wave, NGW = F.G * NWAVES;
        constexpr int I_IN = (DM / 64) * (INC / 32), I_OUT = (DM / 64) * (DM / 32), I_1 = (DM / 128) * (2 * DM / 32), I_2 = (DM / 128) * (DM / 32);
        constexpr int NITEMS = I_IN + I_OUT + NEXP * (I_1 + I_2);
        for (int it = gw; it < NITEMS; it += NGW) {
            int r = it;
            if (r < I_IN) { p0_transpose_item(in[8], DM, INC, WSP(bf16_t, WS_WIN), MapWin{}, nullptr, scr, r, f_lane); continue; } r -= I_IN;
            if (r < I_OUT) { p0_transpose_item(in[27], DM, DM, WSP(bf16_t, WS_WOUT), MapIdent{0}, nullptr, scr, r, f_lane); continue; } r -= I_OUT;
            const int e = r / (I_1 + I_2); r -= e * (I_1 + I_2);
            if (r < I_1) p0_transpose_item_f8(in[30] + (size_t)e * DM * 2 * DM, DM, 2 * DM, WSP(unsigned char, WS_W1) + (size_t)e * 2 * DM * DM, MapW1{0}, scr, r, f_lane);
            else p0_transpose_item_f8(in[32] + (size_t)e * DM * DM, DM, DM, WSP(unsigned char, WS_W2) + (size_t)e * DM * DM, MapW2{}, scr, r - I_1, f_lane);
        }
    }
}
#undef in

__device__ __forceinline__ void p1_norm1(Frame& F) {
    FT_DECL;
    const int gw = F.vcu * NWAVES + F.wave, NGW = F.G * NWAVES;
    const float* mod = WSP(float, WS_SMALL + SM_MOD); const float* g1 = F.in[6];
    bf16_t* H = WSP(bf16_t, WS_H);
    constexpr int RPW = MTOT / (256 * NWAVES);
    for (int run = gw; run * RPW < MTOT; run += NGW) {
        const int r0 = run * RPW, r1 = (r0 + RPW < MTOT) ? r0 + RPW : MTOT;
        int curb = -1; f32x4 PA[4], PB[4];
        for (int m0 = r0; m0 < r1; m0 += 4) {
            f32x4 v[4][4];
#pragma unroll
            for (int u = 0; u < 4; ++u) { const int m = m0 + u; if (m < r1) {
                const float* xrow = (m < MROWS) ? F.in[0] + (size_t)m * DM : F.in[2] + (size_t)(m - MROWS) * DM; const GAS f32x4* xr = (const GAS f32x4*)xrow + f_lane;
#pragma unroll
                for (int j = 0; j < 4; ++j) v[u][j] = __builtin_nontemporal_load(xr + 64 * j); } }
#pragma unroll
            for (int u = 0; u < 4; ++u) { const int m = m0 + u; if (m < r1) {
                const int mb = (m < MROWS) ? (m >> 12) : 8;
                if (mb != curb) { curb = mb; const float* sh = mod + (size_t)mb * (NMOD * DM); const float* sc = sh + DM;
#pragma unroll
                    for (int j = 0; j < 4; ++j) { const int c = 4 * f_lane + 256 * j; PA[j] = *(const f32x4*)(g1 + c) * (*(const f32x4*)(sc + c) + 1.f); PB[j] = *(const f32x4*)(sh + c); } }
                float s = 0.f;
#pragma unroll
                for (int j = 0; j < 4; ++j) s += (v[u][j].x * v[u][j].x + v[u][j].y * v[u][j].y) + (v[u][j].z * v[u][j].z + v[u][j].w * v[u][j].w);
                const float rstd = rsqrtf(wave_sum(s) * (1.f / DM) + EPS);
                GAS u32x2* o8 = (GAS u32x2*)(H + (size_t)m * DM) + f_lane;
#pragma unroll
                for (int j = 0; j < 4; ++j) { const f32x4 y = v[u][j] * rstd * PA[j] + PB[j];
                    u32x2 w; w.x = cvt_pk_bf16(y.x, y.y); w.y = cvt_pk_bf16(y.z, y.w); o8[64 * j] = w; } } }
        }
    }
}

struct SchedInProj {
    int G, c; const char* H; const char* W;
    static constexpr int NA = 136 * 4, NV = 2 * 136, NBU = 6 * 128;
    __device__ __forceinline__ bool next(int i, g8::Unit& u) const {
        const long L = (long)i * G + c;
        if (L < NA) { g8::tile_of((int)L, 136, 4, u.pm, u.pn); u.a = H + (size_t)u.pm * 256 * DM * 2; u.b = W + (size_t)u.pn * 256 * DM * 2; u.kind = 0; u.ex = 0; return true; }
        if (L < NA + NV) { g8::tile_of((int)L - NA, 2, 136, u.pm, u.pn); u.a = W + (size_t)(1024 + u.pm * 256) * DM * 2; u.b = H + (size_t)u.pn * 256 * DM * 2; u.kind = 2; u.ex = 0; return true; }
        if (L < NA + NV + NBU) { g8::tile_of((int)L - NA - NV, 6, 128, u.pm, u.pn); u.a = W + (size_t)(QKVC + u.pm * 256) * DM * 2; u.b = H + (size_t)u.pn * 256 * DM * 2; u.kind = 1; u.ex = 0; return true; }
        return false;
    }
};
constexpr float Q8SCALE = 16.f;
struct EpiInProj {
    unsigned char *Q8, *K8, *VT8; bf16_t* UT; const float *gq, *gk, *rope;
    __device__ __forceinline__ void operator()(f32x4 (&acc)[2][2][4][2], const g8::Unit& u, int wr, int wc, int fr, int fq) const {
        asm volatile("" : "+v"(fr), "+v"(fq));
        if (u.kind == 1) {
            const int row0 = u.pm * 256 + wr * 64 + fr, col0 = u.pn * 256 + wc * 32 + 8 * fq;
#pragma unroll
            for (int ai = 0; ai < 2; ++ai)
#pragma unroll
                for (int m = 0; m < 4; ++m) { bf16_t* rowp = UT + (size_t)(row0 + ai * 128 + m * 16) * MROWS + col0;
#pragma unroll
                    for (int bj = 0; bj < 2; ++bj) { const f32x4 v0 = acc[ai][bj][m][0], v1 = acc[ai][bj][m][1];
                        u32x4 w; w.x = cvt_pk_bf16(v0[0], v0[1]); w.y = cvt_pk_bf16(v0[2], v0[3]); w.z = cvt_pk_bf16(v1[0], v1[1]); w.w = cvt_pk_bf16(v1[2], v1[3]);
                        *(u32x4*)(rowp + bj * 128) = w; } }
            return;
        }
        if (u.kind == 2) {
#pragma unroll
            for (int bj = 0; bj < 2; ++bj) { const int t8 = u.pn * 256 + bj * 128 + wc * 32 + 8 * fq;
                int b, key; if (t8 < MROWS) { b = t8 >> 12; key = CTXL + (t8 & 4095); } else { const int j = t8 - MROWS; b = j >> 8; key = j & 255; }
                const int tile = key >> 6, k = key & 63, ipos = (k < 32) ? 4 * (k >> 3) : 16 + 4 * ((k - 32) >> 3);
#pragma unroll
                for (int ai = 0; ai < 2; ++ai)
#pragma unroll
                    for (int m = 0; m < 4; ++m) { const int ch = u.pm * 256 + ai * 128 + wr * 64 + m * 16 + fr;
                        unsigned char* dst = VT8 + ((((size_t)(b * NHEAD + (ch >> 7)) * 68 + tile) * 128 + (ch & 127)) * 64) + ipos;
                        const f32x4 v0 = acc[ai][bj][m][0], v1 = acc[ai][bj][m][1];
                        *(unsigned*)dst = pk4_fp8(v0[0], v0[1], v0[2], v0[3]); *(unsigned*)(dst + 32) = pk4_fp8(v1[0], v1[1], v1[2], v1[3]); } }
            return;
        }
        const int blk = fq >> 1, f = fq & 1;
        const int sec = u.pn >> 1;
        const bool ctx = (u.pm >= 128);
        if (sec == 0 && ctx) return;
        const int colbase = (u.pn & 1) * 256 + wc * 64 + 32 * blk + 8 * f;
        float gg[2][2][4];
        { const float* gp = (sec == 0 ? gq : gk) + 32 * blk + 8 * f;
#pragma unroll
            for (int bj = 0; bj < 2; ++bj)
#pragma unroll
                for (int n = 0; n < 2; ++n) { const f32x4 t = *(const f32x4*)(gp + 16 * bj + 4 * n); gg[bj][n][0] = t[0]; gg[bj][n][1] = t[1]; gg[bj][n][2] = t[2]; gg[bj][n][3] = t[3]; } }
#pragma unroll
        for (int ai = 0; ai < 2; ++ai)
#pragma unroll
            for (int m = 0; m < 4; ++m) {
                const int rloc = ai * 128 + wr * 64 + m * 16 + fr; const int r = u.pm * 256 + rloc;
                f32x4 v[2][2];
#pragma unroll
                for (int bj = 0; bj < 2; ++bj)
#pragma unroll
                    for (int n = 0; n < 2; ++n) v[bj][n] = acc[ai][bj][m][n];
                size_t orow;
                if (sec == 0) orow = (size_t)r;
                else if (!ctx) orow = (size_t)(r >> 12) * KVL + CTXL + (r & 4095);
                else { const int j = r - MROWS; orow = (size_t)(j >> 8) * KVL + (j & 255); }
                float ss = 0.f;
#pragma unroll
                for (int bj = 0; bj < 2; ++bj)
#pragma unroll
                    for (int n = 0; n < 2; ++n) ss += (v[bj][n][0] * v[bj][n][0] + v[bj][n][1] * v[bj][n][1]) + (v[bj][n][2] * v[bj][n][2] + v[bj][n][3] * v[bj][n][3]);
                ss += __shfl_xor(ss, 16); ss += __shfl_xor(ss, 32);
                const float rstd = rsqrtf(ss * (1.f / 64.f) + EPS) * (sec == 0 ? QSCALE * Q8SCALE : 1.f);
#pragma unroll
                for (int bj = 0; bj < 2; ++bj)
#pragma unroll
                    for (int n = 0; n < 2; ++n)
#pragma unroll
                        for (int e = 0; e < 4; ++e) v[bj][n][e] *= rstd * gg[bj][n][e];
                if (!ctx) {
                    const int t = r & 4095; const int pos = blk ? (t & 63) : (t >> 6);
                    const float* rp = rope + (size_t)(pos * 16 + 8 * f) * 2;
#pragma unroll
                    for (int n = 0; n < 2; ++n) { const f32x4 c0 = *(const f32x4*)(rp + 8 * n), c1 = *(const f32x4*)(rp + 8 * n + 4);
                        const float cs[4] = {c0[0], c0[2], c1[0], c1[2]}, sn[4] = {c0[1], c0[3], c1[1], c1[3]};
#pragma unroll
                        for (int e = 0; e < 4; ++e) { const float x1 = v[0][n][e], x2 = v[1][n][e]; v[0][n][e] = x1 * cs[e] - x2 * sn[e]; v[1][n][e] = x2 * cs[e] + x1 * sn[e]; } }
                }
                unsigned char* dst = (sec == 0 ? Q8 : K8) + orow * QKW + colbase;
#pragma unroll
                for (int bj = 0; bj < 2; ++bj) { u32x2 w; w.x = pk4_fp8(v[bj][0][0], v[bj][0][1], v[bj][0][2], v[bj][0][3]); w.y = pk4_fp8(v[bj][1][0], v[bj][1][1], v[bj][1][2], v[bj][1][3]);
                    *(u32x2*)(dst + 16 * bj) = w; }
            }
    }
};

struct SchedStatic {
    int G, c, nM, nN; const char* A; const char* B;
    __device__ __forceinline__ bool next(int i, g8::Unit& u) const {
        const long L = (long)i * G + c; if (L >= (long)nM * nN) return false;
        g8::tile_of((int)L, nM, nN, u.pm, u.pn); u.a = A + (size_t)u.pm * 256 * DM * 2; u.b = B + (size_t)u.pn * 256 * DM * 2; u.kind = 0; u.ex = 0; return true;
    }
};
struct EpiOutProj {
    const float* x; bf16_t* out; const float* mod;
    __device__ __forceinline__ void operator()(f32x4 (&acc)[2][2][4][2], const g8::Unit& u, int wr, int wc, int fr, int fq) const {
        asm volatile("" : "+v"(fr), "+v"(fq));
        const int col0 = u.pn * 256 + wc * 32 + 8 * fq;
        const float* g1 = mod + (size_t)((u.pm * 256) >> 12) * (NMOD * DM) + 2 * DM + col0;
        f32x4 gv[2][2];
#pragma unroll
        for (int bj = 0; bj < 2; ++bj)
#pragma unroll
            for (int n = 0; n < 2; ++n) gv[bj][n] = *(const f32x4*)(g1 + bj * 128 + 4 * n);
#pragma unroll
        for (int ai = 0; ai < 2; ++ai)
#pragma unroll
            for (int m = 0; m < 4; ++m) { const int r = u.pm * 256 + ai * 128 + wr * 64 + m * 16 + fr;
                const size_t off = (size_t)r * DM + col0;
#pragma unroll
                for (int bj = 0; bj < 2; ++bj) { f32x4 o[2];
#pragma unroll
                    for (int n = 0; n < 2; ++n) { const f32x4 xv = __builtin_nontemporal_load((const f32x4*)(x + off + bj * 128 + 4 * n)); o[n] = xv + gv[bj][n] * acc[ai][bj][m][n]; }
                    u32x4 w; w.x = cvt_pk_bf16(o[0][0], o[0][1]); w.y = cvt_pk_bf16(o[0][2], o[0][3]); w.z = cvt_pk_bf16(o[1][0], o[1][1]); w.w = cvt_pk_bf16(o[1][2], o[1][3]);
                    *(u32x4*)(out + off + bj * 128) = w; } }
    }
};

namespace att8 {
constexpr int NT = KVL / 64, SHMB = 8192, LDS_V0 = 3 * SHMB;
typedef int i32x8 __attribute__((ext_vector_type(8)));
#define SBAR() __builtin_amdgcn_sched_barrier(0)
__device__ __forceinline__ int crow(int r, int hi) { return (r & 3) + 8 * (r >> 2) + 4 * hi; }
__device__ __forceinline__ i32x8 ld32(const LAS unsigned char* p0, const LAS unsigned char* p1) {
    const u32x4 a = *(const LAS u32x4*)p0, b = *(const LAS u32x4*)p1; return (i32x8){(int)a.x, (int)a.y, (int)a.z, (int)a.w, (int)b.x, (int)b.y, (int)b.z, (int)b.w}; }
__device__ __forceinline__ void mfma_qk(f32x16& p, const i32x8& kf, const i32x8& qf, const f32x16& negc) {
    const unsigned s1 = 0x7f7f7f7fu, sq = 0x7b7b7b7bu;
    asm volatile("s_nop 1\n\tv_mfma_scale_f32_32x32x64_f8f6f4 %0, %1, %2, %3, %4, %5 op_sel_hi:[0,0,0]" : "=&v"(p) : "v"(kf), "v"(qf), "v"(negc), "v"(s1), "v"(sq));
}
__device__ __forceinline__ void mfma_pv(f32x16& o, const i32x8& pa, const i32x8& vf) {
    const unsigned s1 = 0x7f7f7f7fu;
    asm volatile("s_nop 2\n\tv_mfma_scale_f32_32x32x64_f8f6f4 %0, %1, %2, %0, %3, %3 op_sel_hi:[0,0,0]" : "+v"(o) : "v"(pa), "v"(vf), "v"(s1));
}
__device__ __forceinline__ void qkt(f32x16& p0, f32x16& p1, const LAS unsigned char* Kb, const i32x8& qf, const f32x16& negc, int r32, int hi, int sub) {
    const int c0 = sub * 4 + hi * 2;
    const int k0 = r32, k1 = 32 + r32;
    const i32x8 kf0 = ld32(Kb + k0 * 128 + ((c0 ^ ((k0 >> 1) & 7)) << 4), Kb + k0 * 128 + (((c0 + 1) ^ ((k0 >> 1) & 7)) << 4));
    const i32x8 kf1 = ld32(Kb + k1 * 128 + ((c0 ^ ((k1 >> 1) & 7)) << 4), Kb + k1 * 128 + (((c0 + 1) ^ ((k1 >> 1) & 7)) << 4));
    mfma_qk(p0, kf0, qf, negc); mfma_qk(p1, kf1, qf, negc);
}
__device__ __forceinline__ void mfma_wait(f32x16& p0, f32x16& p1) { asm volatile("s_nop 15\n\ts_nop 3" : "+v"(p0), "+v"(p1)); }
__device__ __forceinline__ void expA(f32x16& p) {
#pragma unroll
    for (int r = 0; r < 16; ++r) p[r] = __builtin_amdgcn_exp2f(p[r]);
}
__device__ __forceinline__ void finishSM(f32x16& p0, f32x16& p1, i32x8& pa) {
#pragma unroll
    for (int r = 0; r < 16; ++r) p1[r] = __builtin_amdgcn_exp2f(p1[r]);
#pragma unroll
    for (int j = 0; j < 4; ++j) { pa[j] = (int)pk4_fp8(p0[4 * j], p0[4 * j + 1], p0[4 * j + 2], p0[4 * j + 3]); pa[4 + j] = (int)pk4_fp8(p1[4 * j], p1[4 * j + 1], p1[4 * j + 2], p1[4 * j + 3]); }
}
__device__ __forceinline__ void pv(f32x16* o, f32x16& ol, const i32x8& ones, const LAS unsigned char* Vb, const i32x8& pa, int r32, int hi) {
    mfma_pv(ol, pa, ones);
#pragma unroll
    for (int d0 = 0; d0 < 4; ++d0) { const int d = 32 * d0 + r32, sw = (d >> 2) & 3;
        const i32x8 vf = ld32(Vb + d * 64 + (((2 * hi) ^ sw) << 4), Vb + d * 64 + (((2 * hi + 1) ^ sw) << 4));
        mfma_pv(o[d0], pa, vf); }
}
__device__ __forceinline__ void attn_unit(const unsigned char* __restrict__ Qb, const unsigned char* __restrict__ Kh, const unsigned char* __restrict__ VTh, bf16_t* MIXo,
                                          const float lam, const float* __restrict__ subg, char* lds, const int wid) {
    const int lane = lane_id(), tid = wid * 64 + lane, r32 = lane & 31, hi = lane >> 5;
    const int sub = wid >> 2, wq = wid & 3;
    const LAS unsigned char* L = (const LAS unsigned char*)(uintptr_t)(unsigned)(uintptr_t)lds;
    f32x16 o[4] = {}; f32x16 ol = {};
    i32x8 ones; { int c1 = 0x38383838; asm volatile("" : "+v"(c1)); ones = (i32x8){c1, c1, c1, c1, c1, c1, c1, c1}; }
    i32x8 qf; { const unsigned char* qp = Qb + (size_t)(wq * 32 + r32) * QKW + sub * 64 + 32 * hi; const u32x4 a = *(const u32x4*)qp, b = *(const u32x4*)(qp + 16);
        qf = (i32x8){(int)a.x, (int)a.y, (int)a.z, (int)a.w, (int)b.x, (int)b.y, (int)b.z, (int)b.w}; }
    f32x16 negc;
#pragma unroll
    for (int r = 0; r < 16; ++r) negc[r] = -5.f;
    asm volatile("" : "+v"(negc));
    long ksrc, vsrc;
    { const int r = 8 * wid + (lane >> 3), c = (lane & 7) ^ ((r >> 1) & 7); ksrc = (long)r * QKW + c * 16; }
    { const int d = 16 * wid + (lane >> 2), c = (lane & 3) ^ ((d >> 2) & 3); vsrc = (long)d * 64 + c * 16; }
    const unsigned ldsb = (unsigned)(uintptr_t)lds, kdst = ldsb + (unsigned)wid * 1024u, vdst = ldsb + LDS_V0 + (unsigned)wid * 1024u;
#define DMA_TILE(t, boff) do { \
        __builtin_amdgcn_global_load_lds((const unsigned*)(Kh + (long)(t) * 64 * QKW + ksrc), (LAS unsigned*)(uintptr_t)__builtin_amdgcn_readfirstlane(kdst + (unsigned)(boff)), 16, 0, 0); \
        __builtin_amdgcn_global_load_lds((const unsigned*)(VTh + (long)(t) * 8192 + vsrc), (LAS unsigned*)(uintptr_t)__builtin_amdgcn_readfirstlane(vdst + (unsigned)(boff)), 16, 0, 0); } while (0)
#define WBAR() do { asm volatile("s_waitcnt vmcnt(0) lgkmcnt(0)" ::: "memory"); __builtin_amdgcn_s_barrier(); asm volatile("" ::: "memory"); } while (0)
#define ROT3(x) ((x) == 2 * SHMB ? 0 : (x) + SHMB)
    f32x16 pA0, pA1, pB0, pB1; i32x8 pa;
    DMA_TILE(0, 0); WBAR();
    DMA_TILE(1, SHMB);
    qkt(pA0, pA1, L, qf, negc, r32, hi, sub); mfma_wait(pA0, pA1); expA(pA0);
    WBAR();
    int bprev = 0, bcur = SHMB, bnext = 2 * SHMB;
    for (int j = 1; j + 1 < NT; j += 2) {
        DMA_TILE(j + 1, bnext);
        SBAR(); qkt(pB0, pB1, L + bcur, qf, negc, r32, hi, sub);
        finishSM(pA0, pA1, pa); SBAR();
        pv(o, ol, ones, L + LDS_V0 + bprev, pa, r32, hi); mfma_wait(pB0, pB1); expA(pB0);
        WBAR();
        bprev = bcur; bcur = bnext; bnext = ROT3(bnext);
        if (j + 2 < NT) DMA_TILE(j + 2, bnext);
        SBAR(); qkt(pA0, pA1, L + bcur, qf, negc, r32, hi, sub);
        finishSM(pB0, pB1, pa); SBAR();
        pv(o, ol, ones, L + LDS_V0 + bprev, pa, r32, hi); mfma_wait(pA0, pA1); expA(pA0);
        WBAR();
        bprev = bcur; bcur = bnext; bnext = ROT3(bnext);
    }
    SBAR(); qkt(pB0, pB1, L + bcur, qf, negc, r32, hi, sub);
    finishSM(pA0, pA1, pa); SBAR();
    pv(o, ol, ones, L + LDS_V0 + bprev, pa, r32, hi); mfma_wait(pB0, pB1); expA(pB0);
    finishSM(pB0, pB1, pa); SBAR();
    pv(o, ol, ones, L + LDS_V0 + bcur, pa, r32, hi);
    asm volatile("s_nop 15\n\ts_nop 3" : "+v"(o[0]), "+v"(o[1]), "+v"(o[2]), "+v"(o[3]), "+v"(ol));
#undef ROT3
#undef DMA_TILE
#undef WBAR
    __syncthreads();
    float* X = (float*)lds;
    float rli[16];
#pragma unroll
    for (int r = 0; r < 16; ++r) rli[r] = __builtin_amdgcn_rcpf(ol[r]);
    if (sub == 1) {
#pragma unroll
        for (int r = 0; r < 16; ++r) { const int row = wq * 32 + crow(r, hi); const float sc = lam * rli[r];
#pragma unroll
            for (int d0 = 0; d0 < 4; ++d0) X[row * 128 + d0 * 32 + r32] = o[d0][r] * sc; }
    }
    __syncthreads();
    bf16_t* Y = (bf16_t*)(lds + 65536);
    if (sub == 0) {
        float sg[4];
#pragma unroll
        for (int d0 = 0; d0 < 4; ++d0) sg[d0] = subg[d0 * 32 + r32] * (1.f - LAM_INIT);
#pragma unroll
        for (int r = 0; r < 16; ++r) { const int row = wq * 32 + crow(r, hi);
            float v[4]; float ss = 0.f;
#pragma unroll
            for (int d0 = 0; d0 < 4; ++d0) { v[d0] = o[d0][r] * rli[r] - X[row * 128 + d0 * 32 + r32]; ss += v[d0] * v[d0]; }
            ss += __shfl_xor(ss, 1); ss += __shfl_xor(ss, 2); ss += __shfl_xor(ss, 4); ss += __shfl_xor(ss, 8); ss += __shfl_xor(ss, 16);
            const float rstd = rsqrtf(ss * (1.f / 128.f) + EPS);
#pragma unroll
            for (int d0 = 0; d0 < 4; ++d0) Y[row * 128 + d0 * 32 + r32] = (bf16_t)(cvt_pk_bf16(v[d0] * rstd * sg[d0], 0.f) & 0xffffu); }
    }
    __syncthreads();
    { const int row = tid >> 2, seg = (tid & 3) * 32;
#pragma unroll
        for (int i = 0; i < 4; ++i) { const u32x4 v = *(const u32x4*)(Y + row * 128 + seg + i * 8); *(u32x4*)(MIXo + (size_t)row * DM + seg + i * 8) = v; } }
    __syncthreads();
}
#undef SBAR
}

__device__ __forceinline__ void p3_attention8(Frame& F) {
    FT_DECL;
    const float* sc = WSP(float, WS_SMALL + SM_SCAL);
    const float lam = sc[0];
    const unsigned char* Q8 = WSP(unsigned char, WS_Q); const unsigned char* K8 = WSP(unsigned char, WS_K); const unsigned char* VT8 = WSP(unsigned char, WS_V); bf16_t* MIX = WSP(bf16_t, WS_MIX);
    const int c = blockIdx.x, xcd = c & 7, ci = c >> 3, per = F.G >> 3;
    for (int j = ci; j < 128; j += per) {
        const int pair = xcd * 4 + (j >> 5), qb = j & 31, b = pair >> 2, h = pair & 3;
        att8::attn_unit(Q8 + ((size_t)b * SEQ + qb * 128) * QKW + h * 128, K8 + (size_t)b * KVL * QKW + h * 128, VT8 + (size_t)(b * NHEAD + h) * 68 * 8192,
                        MIX + ((size_t)b * SEQ + qb * 128) * DM + h * 128, lam, F.in[15], (char*)F.lds, F.wave);
    }
}

namespace hy {
constexpr int RB_BYTES = 4352 * 8, IN_OFF = 2 * RB_BYTES, TW1_OFF = IN_OFF + 32768, TW2_OFF = TW1_OFF + 15 * 256 * 8, LDS_END = TW2_OFF + 15 * 16 * 8;
__device__ __forceinline__ f32x2 cmul(f32x2 a, f32x2 b) { return (f32x2){a.x * b.x - a.y * b.y, a.x * b.y + a.y * b.x}; }
__device__ __forceinline__ f32x2 cmulc(f32x2 a, f32x2 b) { return (f32x2){a.x * b.x + a.y * b.y, a.y * b.x - a.x * b.y}; }
__device__ __forceinline__ int P(int i) { return i + (i >> 4); }
template <bool INV> __device__ __forceinline__ void r4(f32x2& a, f32x2& b, f32x2& c, f32x2& d) {
    const f32x2 t0 = a + c, t1 = a - c, t2 = b + d, t3 = b - d;
    const f32x2 st3 = INV ? (f32x2){-t3.y, t3.x} : (f32x2){t3.y, -t3.x};
    a = t0 + t2; c = t0 - t2; b = t1 + st3; d = t1 - st3;
}
template <bool INV> __device__ __forceinline__ f32x2 tw(f32x2 v, float c, float s) {
    return INV ? (f32x2){v.x * c - v.y * s, v.y * c + v.x * s} : (f32x2){v.x * c + v.y * s, v.y * c - v.x * s};
}
template <bool INV> __device__ __forceinline__ void dft16(f32x2 (&v)[16]) {
    constexpr float C1 = 0.9238795325112867f, S1 = 0.3826834323650898f, R2 = 0.7071067811865476f;
    r4<INV>(v[0], v[4], v[8], v[12]); r4<INV>(v[1], v[5], v[9], v[13]); r4<INV>(v[2], v[6], v[10], v[14]); r4<INV>(v[3], v[7], v[11], v[15]);
    v[5] = tw<INV>(v[5], C1, S1);  v[9] = tw<INV>(v[9], R2, R2);    v[13] = tw<INV>(v[13], S1, C1);
    v[6] = tw<INV>(v[6], R2, R2);  v[10] = tw<INV>(v[10], 0.f, 1.f); v[14] = tw<INV>(v[14], -R2, R2);
    v[7] = tw<INV>(v[7], S1, C1);  v[11] = tw<INV>(v[11], -R2, R2);  v[15] = tw<INV>(v[15], -C1, -S1);
    r4<INV>(v[0], v[1], v[2], v[3]); r4<INV>(v[4], v[5], v[6], v[7]); r4<INV>(v[8], v[9], v[10], v[11]); r4<INV>(v[12], v[13], v[14], v[15]);
    f32x2 t;
    t = v[1]; v[1] = v[4]; v[4] = t;   t = v[2]; v[2] = v[8]; v[8] = t;    t = v[3]; v[3] = v[12]; v[12] = t;
    t = v[6]; v[6] = v[9]; v[9] = t;   t = v[7]; v[7] = v[13]; v[13] = t;  t = v[11]; v[11] = v[14]; v[14] = t;
}
struct Ctx { LAS f32x2* R; LAS f32x2* IN; LAS f32x2* TW1; LAS f32x2* TW2; int t, half; f32x2 wt; };
#define HY_OPAQUE(x) asm volatile("" : "+v"(x))
#define HY_W32(m) (f32x2){__builtin_cosf(-0.19634954084936207f * (m)), __builtin_sinf(-0.19634954084936207f * (m))}
template <int MODE> __device__ __forceinline__ void pass1_fwd(const Ctx& X) {
    f32x2 v[16]; int t = X.t; HY_OPAQUE(t);
#pragma unroll
    for (int m = 0; m < 16; ++m) { f32x2 a = X.IN[t + 256 * m]; if (MODE == 1) a = (f32x2){X.half ? a.y : a.x, 0.f}; v[m] = a; }
    if (X.half) {
#pragma unroll
        for (int m = 0; m < 16; ++m) v[m] = cmul(cmul(v[m], HY_W32(m)), X.wt);
    }
    dft16<false>(v);
#pragma unroll
    for (int q = 1; q < 16; ++q) v[q] = cmul(v[q], X.TW1[(q - 1) * 256 + t]);
    const int pb = t + (t >> 4);
#pragma unroll
    for (int q = 0; q < 16; ++q) X.R[pb + 272 * q] = v[q];
}
__device__ __forceinline__ void pass2_fwd(const Ctx& X) {
    int t = X.t; HY_OPAQUE(t);
    const int n2 = t & 15, pb = (t >> 4) * 272 + n2; f32x2 v[16];
#pragma unroll
    for (int m = 0; m < 16; ++m) v[m] = X.R[pb + 17 * m];
    dft16<false>(v);
#pragma unroll
    for (int q = 1; q < 16; ++q) v[q] = cmul(v[q], X.TW2[(q - 1) * 16 + n2]);
#pragma unroll
    for (int q = 0; q < 16; ++q) X.R[pb + 17 * q] = v[q];
}
template <bool FILTER> __device__ __forceinline__ void pass3(const Ctx& X, f32x2 (&H)[16]) {
    f32x2 v[16]; int t = X.t; HY_OPAQUE(t); const int pb = 17 * t;
#pragma unroll
    for (int m = 0; m < 16; ++m) v[m] = X.R[pb + m];
    dft16<false>(v);
    if (FILTER) {
#pragma unroll
        for (int q = 0; q < 16; ++q) H[q] = v[q] * (1.f / 8192.f);
    } else {
#pragma unroll
        for (int q = 0; q < 16; ++q) v[q] = cmul(v[q], H[q]);
        dft16<true>(v);
#pragma unroll
        for (int m = 0; m < 16; ++m) X.R[pb + m] = v[m];
    }
}
__device__ __forceinline__ void pass2_inv(const Ctx& X) {
    int t = X.t; HY_OPAQUE(t);
    const int n2 = t & 15, pb = (t >> 4) * 272 + n2; f32x2 v[16];
    v[0] = X.R[pb];
#pragma unroll
    for (int q = 1; q < 16; ++q) v[q] = cmulc(X.R[pb + 17 * q], X.TW2[(q - 1) * 16 + n2]);
    dft16<true>(v);
#pragma unroll
    for (int m = 0; m < 16; ++m) X.R[pb + 17 * m] = v[m];
}
__device__ __forceinline__ void pass1_inv(const Ctx& X) {
    f32x2 v[16]; int t = X.t; HY_OPAQUE(t); const int pb = t + (t >> 4);
    v[0] = X.R[pb];
#pragma unroll
    for (int q = 1; q < 16; ++q) v[q] = cmulc(X.R[pb + 272 * q], X.TW1[(q - 1) * 256 + t]);
    dft16<true>(v);
    if (X.half) {
#pragma unroll
        for (int m = 0; m < 16; ++m) v[m] = cmulc(cmulc(v[m], HY_W32(m)), X.wt);
    }
#pragma unroll
    for (int m = 0; m < 16; ++m) X.R[pb + 272 * m] = v[m];
}
#define HY_WSYNC() asm volatile("s_waitcnt lgkmcnt(0)" ::: "memory")
__device__ __forceinline__ void conv_fft(const Ctx& X, f32x2 (&H)[16]) {
    __syncthreads(); pass1_fwd<0>(X); __syncthreads(); pass2_fwd(X); HY_WSYNC(); pass3<false>(X, H); HY_WSYNC(); pass2_inv(X); __syncthreads(); pass1_inv(X); __syncthreads();
}
constexpr int STG_OFF = LDS_END;
constexpr int LDS_END2 = STG_OFF + 2 * SEQ * 2;
static_assert(LDS_END2 <= LDSCTL_OFF, "hyena LDS map");
__device__ __forceinline__ float sconv_lds(const LAS bf16_t* stg, int bs, int n, float w0, float w1, float w2, float bias) {
    const LAS bf16_t* p = stg + bs * SEQ;
    const float c = bf2f(p[n]), lv = bf2f(p[n - ((n > 0) ? 1 : 0)]), rv = bf2f(p[n + ((n < SEQ - 1) ? 1 : 0)]);
    const float l = (n > 0) ? lv : 0.f, r = (n < SEQ - 1) ? rv : 0.f;
    return bias + w0 * l + w1 * c + w2 * r;
}
__device__ __forceinline__ void setup_tables(LAS unsigned char* lds, int tid) {
    LAS f32x2* TW1 = (LAS f32x2*)(lds + TW1_OFF); LAS f32x2* TW2 = (LAS f32x2*)(lds + TW2_OFF);
    for (int i = tid; i < 15 * 256; i += 512) { const int q = i / 256 + 1, t = i & 255; float s, c; sincosf(-6.283185307179586f * (float)((t * q) & 4095) * (1.f / 4096.f), &s, &c); TW1[i] = (f32x2){c, s}; }
    for (int i = tid; i < 15 * 16; i += 512) { const int q = i / 16 + 1, n2 = i & 15; float s, c; sincosf(-6.283185307179586f * (float)((n2 * q) & 255) * (1.f / 256.f), &s, &c); TW2[i] = (f32x2){c, s}; }
}
__device__ __forceinline__ void unit(Frame& F, int c) {
    FT_DECL;
    const int tid = f_tid; Ctx X; X.half = F.wave >> 2; X.t = tid & 255;
    X.R = (LAS f32x2*)(F.lds + X.half * RB_BYTES); X.IN = (LAS f32x2*)(F.lds + IN_OFF); X.TW1 = (LAS f32x2*)(F.lds + TW1_OFF); X.TW2 = (LAS f32x2*)(F.lds + TW2_OFF);
    { float s, cc; sincosf(-6.283185307179586f * (float)X.t * (1.f / 8192.f), &s, &cc); X.wt = (f32x2){cc, s}; }
    LAS f32x2* RB0 = (LAS f32x2*)(F.lds); LAS f32x2* RB1 = (LAS f32x2*)(F.lds + RB_BYTES);
    const float* FILT = WSP(float, WS_FILT);
    f32x2 H0[16], H1[16];
#pragma unroll
    for (int ord = 0; ord < 2; ++ord) {
        const float* hf = FILT + ((size_t)(ord * 2 + 0) * 512 + c) * SEQ; const float* hb = FILT + ((size_t)(ord * 2 + 1) * 512 + c) * SEQ;
        __syncthreads();
        int nb = tid; HY_OPAQUE(nb);
#pragma unroll
        for (int j = 0; j < 8; ++j) { const int n = nb + 512 * j; const float a = hf[n], b = hb[(SEQ - n) & (SEQ - 1)]; const float lo = (n == 0) ? a + b : a, hi = (n == 0) ? 0.f : b; X.IN[n] = (f32x2){lo + hi, lo - hi}; }
        __syncthreads(); pass1_fwd<1>(X); __syncthreads(); pass2_fwd(X); HY_WSYNC();
        if (ord == 0) pass3<true>(X, H0); else pass3<true>(X, H1);
    }
    const bf16_t* UT = WSP(bf16_t, WS_UT);
    const bf16_t* rv = UT + (size_t)c * MROWS; const bf16_t* r1 = UT + (size_t)(512 + c) * MROWS; const bf16_t* r2 = UT + (size_t)(1024 + c) * MROWS;
    const float* cw = F.in[16]; const float* cb = F.in[17];
    const float wv0 = cw[c], wv1 = cw[HYC + c], wv2 = cw[2 * HYC + c], bv = cb[c];
    const float wa0 = cw[512 + c], wa1 = cw[HYC + 512 + c], wa2 = cw[2 * HYC + 512 + c], ba = cb[512 + c];
    const float wb0 = cw[1024 + c], wb1 = cw[HYC + 1024 + c], wb2 = cw[2 * HYC + 1024 + c], bb = cb[1024 + c];
    const float sk0 = F.in[25][c], sk1 = F.in[25][512 + c];
    bf16_t* Z = WSP(bf16_t, WS_Z2T) + (size_t)c * MROWS;
    LAS bf16_t* STG = (LAS bf16_t*)(F.lds + STG_OFF);
    u32x4 g0 = *(const u32x4*)(rv + tid * 8), g1 = *(const u32x4*)(rv + SEQ + tid * 8);
    for (int pr = 0; pr < 4; ++pr) {
        const int b0 = 2 * pr, b1 = b0 + 1;
        f32x2 z[8]; int pc = tid + (tid >> 4); HY_OPAQUE(pc); int nb = tid; HY_OPAQUE(nb);
        __syncthreads();
        *(LAS u32x4*)(STG + tid * 8) = g0; *(LAS u32x4*)(STG + SEQ + tid * 8) = g1;
        __syncthreads();
#pragma unroll
        for (int j = 0; j < 8; ++j) { const int n = nb + 512 * j; z[j] = (f32x2){sconv_lds(STG, 0, n, wv0, wv1, wv2, bv), sconv_lds(STG, 1, n, wv0, wv1, wv2, bv)}; X.IN[n] = z[j]; }
        g0 = *(const u32x4*)(r1 + b0 * SEQ + tid * 8); g1 = *(const u32x4*)(r1 + b1 * SEQ + tid * 8);
        conv_fft(X, H0);
        *(LAS u32x4*)(STG + tid * 8) = g0; *(LAS u32x4*)(STG + SEQ + tid * 8) = g1;
        __syncthreads();
        HY_OPAQUE(nb); HY_OPAQUE(pc);
#pragma unroll
        for (int j = 0; j < 8; ++j) { const int n = nb + 512 * j; const f32x2 y = RB0[pc + 544 * j] + RB1[pc + 544 * j];
            const f32x2 g = (f32x2){sconv_lds(STG, 0, n, wa0, wa1, wa2, ba), sconv_lds(STG, 1, n, wa0, wa1, wa2, ba)};
            z[j] = g * (y + sk0 * z[j]); X.IN[n] = z[j]; }
        g0 = *(const u32x4*)(r2 + b0 * SEQ + tid * 8); g1 = *(const u32x4*)(r2 + b1 * SEQ + tid * 8);
        conv_fft(X, H1);
        *(LAS u32x4*)(STG + tid * 8) = g0; *(LAS u32x4*)(STG + SEQ + tid * 8) = g1;
        __syncthreads();
        if (pr < 3) { g0 = *(const u32x4*)(rv + (b0 + 2) * SEQ + tid * 8); g1 = *(const u32x4*)(rv + (b1 + 2) * SEQ + tid * 8); }
        HY_OPAQUE(nb); HY_OPAQUE(pc);
        f32x2 o[8];
#pragma unroll
        for (int j = 0; j < 8; ++j) { const int n = nb + 512 * j; const f32x2 y = RB0[pc + 544 * j] + RB1[pc + 544 * j];
            const f32x2 g = (f32x2){sconv_lds(STG, 0, n, wb0, wb1, wb2, bb), sconv_lds(STG, 1, n, wb0, wb1, wb2, bb)};
            o[j] = g * (y + sk1 * z[j]); }
        __syncthreads();
#pragma unroll
        for (int j = 0; j < 8; ++j) { const int n = nb + 512 * j; STG[n] = (bf16_t)(cvt_pk_bf16(o[j].x, 0.f) & 0xffffu); STG[SEQ + n] = (bf16_t)(cvt_pk_bf16(o[j].y, 0.f) & 0xffffu); }
        __syncthreads();
        *(u32x4*)(Z + b0 * SEQ + tid * 8) = *(const LAS u32x4*)(STG + tid * 8); *(u32x4*)(Z + b1 * SEQ + tid * 8) = *(const LAS u32x4*)(STG + SEQ + tid * 8);
    }
    __syncthreads();
}
}

__device__ __forceinline__ void p3_hyena(Frame& F) {
    FT_DECL;
    __syncthreads();
    hy::setup_tables(F.lds, f_tid);
    __syncthreads();
    for (int c = F.vcu; c < HYW; c += F.G) hy::unit(F, c);
}

__device__ __forceinline__ void p4_hynorm(Frame& F) {
    FT_DECL;
    const bf16_t* Z = WSP(bf16_t, WS_Z2T); bf16_t* MIX = WSP(bf16_t, WS_MIX); const float* g = F.in[26];
    LAS bf16_t* T = (LAS bf16_t*)F.lds;
    LAS float* red = (LAS float*)(F.lds + 512 * 72 * 2);
    LAS float* rs = red + 512;
    for (int it = F.vcu; it < MROWS / 64; it += F.G) {
        const int tok0 = it * 64;
        __syncthreads();
#pragma unroll
        for (int j = 0; j < 8; ++j) { const int i = f_tid + 512 * j, row = i >> 3, ch = i & 7; const u32x4 v = *(const u32x4*)(Z + (size_t)row * MROWS + tok0 + ch * 8); *(LAS u32x4*)(T + row * 72 + ch * 8) = v; }
        __syncthreads();
        { const int tok = f_tid & 63, grp = f_tid >> 6; float ss = 0.f;
#pragma unroll 8
            for (int k = 0; k < 64; ++k) { const float v = bf2f(T[(grp * 64 + k) * 72 + tok]); ss += v * v; }
            red[grp * 64 + tok] = ss; }
        __syncthreads();
        if (f_tid < 64) { float ss = 0.f;
#pragma unroll
            for (int w = 0; w < 8; ++w) ss += red[w * 64 + f_tid];
            rs[f_tid] = rsqrtf(ss * (1.f / HYW) + EPS); }
        __syncthreads();
#pragma unroll
        for (int j = 0; j < 8; ++j) { const int i = f_tid + 512 * j, tok = i >> 6, c0 = (i & 63) * 8; const float r = rs[tok];
            float v[8];
#pragma unroll
            for (int e = 0; e < 8; ++e) v[e] = bf2f(T[(c0 + e) * 72 + tok]) * r * g[c0 + e];
            u32x4 w; w.x = cvt_pk_bf16(v[0], v[1]); w.y = cvt_pk_bf16(v[2], v[3]); w.z = cvt_pk_bf16(v[4], v[5]); w.w = cvt_pk_bf16(v[6], v[7]);
            *(u32x4*)(MIX + (size_t)(tok0 + tok) * DM + 512 + c0) = w; }
    }
}

constexpr size_t RT_TOPI = 0;
constexpr size_t RT_GATE = 512 * 1024;
constexpr size_t RT_POS = 1024 * 1024;
constexpr size_t RT_WGCNT = 1536 * 1024;
constexpr size_t RT_META = 1600 * 1024;
constexpr size_t RT_LIST = 2048 * 1024;
constexpr size_t RT_GSLOT = 2048 * 1024 + 640 * 1024;
constexpr int MAXSLOT = MROWS * TOPK + NEXP * 256;
constexpr int MAXTILE = MAXSLOT / 256;
constexpr size_t WS_XS = WS_EO;
constexpr int RW_PITCH = 32;
constexpr int P6_LDS_TOPI = 1024 * RW_PITCH * 4;

__device__ __forceinline__ void p6_router_mfma(Frame& F) {
    FT_DECL;
#define in F.in
    LAS float* WP = (LAS float*)F.lds;
    LAS int* TI = (LAS int*)(F.lds + P6_LDS_TOPI);
    LAS int* PS = TI + 512;
    LAS int* SC = PS + 512;
    LAS float* RSTD = (LAS float*)(SC + 512);
    LAS float* BIAS = RSTD + 128;
    LAS float* SSX = BIAS + 32;
    const float* rw = in[28]; const float* mod = WSP(float, WS_SMALL + SM_MOD); const float* g2n = in[7]; const float* rb = in[29];
    const bf16_t* XN = WSP(bf16_t, WS_XN); unsigned char* H2 = WSP(unsigned char, WS_H);
    int* topi_g = WSP(int, WS_ROUTE + RT_TOPI); float* gate_g = WSP(float, WS_ROUTE + RT_GATE); int* pos_g = WSP(int, WS_ROUTE + RT_POS); int* wgcnt = WSP(int, WS_ROUTE + RT_WGCNT);
    for (int blk = blockIdx.x; blk < MROWS / 128; blk += F.G) {
        const float* sh2 = mod + (size_t)(blk >> 5) * (NMOD * DM) + 3 * DM; const float* sc2 = sh2 + DM;
        __syncthreads();
        for (int i = f_tid; i < 1024 * 8; i += 512) { const int k = i >> 3, c4 = i & 7; const float gm = g2n[k] * (1.f + sc2[k]);
            *(LAS f32x4*)(WP + k * 32 + c4 * 4) = *(const f32x4*)(rw + (size_t)k * 32 + c4 * 4) * gm; }
        { const int e = f_tid & 31, part = f_tid >> 5; float a = 0.f;
            for (int k = part * 64; k < part * 64 + 64; ++k) a += sh2[k] * rw[(size_t)k * 32 + e];
            ((LAS float*)SC)[part * 32 + e] = a; }
        __syncthreads();
        if (f_tid < 32) { float a = rb[f_tid];
#pragma unroll
            for (int p = 0; p < 16; ++p) a += ((LAS float*)SC)[p * 32 + f_tid];
            BIAS[f_tid] = a; }
        const int rg = F.wave & 3, kh = F.wave >> 2, j = f_lane & 31, hi = f_lane >> 5;
        f32x16 acc = {};
        float ss = 0.f;
        { const bf16_t* xrow = XN + (size_t)(blk * 128 + rg * 32 + j) * DM + 512 * kh + 8 * hi;
            const LAS float* wp = WP + (512 * kh + 8 * hi) * 32 + j;
#pragma unroll 4
            for (int c = 0; c < 32; ++c) { const u32x4 xb = *(const u32x4*)(xrow + 16 * c);
                float xf[8] = {__uint_as_float(xb.x << 16), __uint_as_float(xb.x & 0xffff0000u), __uint_as_float(xb.y << 16), __uint_as_float(xb.y & 0xffff0000u),
                               __uint_as_float(xb.z << 16), __uint_as_float(xb.z & 0xffff0000u), __uint_as_float(xb.w << 16), __uint_as_float(xb.w & 0xffff0000u)};
#pragma unroll
                for (int q = 0; q < 8; ++q) { ss += xf[q] * xf[q]; acc = __builtin_amdgcn_mfma_f32_32x32x2f32(wp[(16 * c + q) * 32], xf[q], acc, 0, 0, 0); } } }
        { auto rr = __builtin_amdgcn_permlane32_swap(__float_as_uint(ss), __float_as_uint(ss), false, false); ss = __uint_as_float(rr[0]) + __uint_as_float(rr[1]); }
        if (hi == 0) SSX[kh * 128 + rg * 32 + j] = ss;
        __syncthreads();
        if (kh == 1) {
#pragma unroll
            for (int r = 0; r < 16; ++r) WP[(rg * 16 + r) * 64 + f_lane] = acc[r]; }
        if (f_tid < 128) RSTD[f_tid] = rsqrtf((SSX[f_tid] + SSX[128 + f_tid]) * (1.f / DM) + EPS);
        __syncthreads();
        if (kh == 0) {
            const float rstd = RSTD[rg * 32 + j];
            float tv[4] = {-INFINITY, -INFINITY, -INFINITY, -INFINITY}; int ti[4] = {1 << 20, 1 << 20, 1 << 20, 1 << 20};
#define P6_INS(V, E) do { float cv = (V); int ce = (E); _Pragma("unroll") for (int q = 0; q < 4; ++q) { const bool b = cv > tv[q] || (cv == tv[q] && ce < ti[q]); \
                const float nv = b ? tv[q] : cv; const int ne = b ? ti[q] : ce; tv[q] = b ? cv : tv[q]; ti[q] = b ? ce : ti[q]; cv = nv; ce = ne; } } while (0)
#pragma unroll
            for (int r = 0; r < 16; ++r) { const int e = (r & 3) + 8 * (r >> 2) + 4 * hi; const float v = (acc[r] + WP[(rg * 16 + r) * 64 + f_lane]) * rstd + BIAS[e]; P6_INS(v, e); }
            float ov[4]; int oe[4];
#pragma unroll
            for (int q = 0; q < 4; ++q) { ov[q] = __shfl_xor(tv[q], 32); oe[q] = __shfl_xor(ti[q], 32); }
#pragma unroll
            for (int q = 0; q < 4; ++q) P6_INS(ov[q], oe[q]);
#undef P6_INS
            if (hi == 0) { const int rl = rg * 32 + j, r = blk * 128 + rl;
                const float e1 = __expf(tv[1] - tv[0]), e2 = __expf(tv[2] - tv[0]), e3 = __expf(tv[3] - tv[0]); const float inv = 1.f / (1.f + e1 + e2 + e3);
                typedef int i32x4_t __attribute__((ext_vector_type(4))); const i32x4_t t4 = {ti[0], ti[1], ti[2], ti[3]};
                *(i32x4_t*)(topi_g + (size_t)r * 4) = t4; *(f32x4*)(gate_g + (size_t)r * 4) = (f32x4){inv, e1 * inv, e2 * inv, e3 * inv};
                *(LAS i32x4_t*)(TI + rl * 4) = t4; }
        }
        __syncthreads();
        { const int t2 = F.wave * 64 + lane_id(); const int e = t2 & 31, seg = t2 >> 5; int cnt = 0;
#pragma unroll 4
            for (int i = 0; i < 32; ++i) cnt += (TI[seg * 32 + i] == e) ? 1 : 0;
            SC[seg * 32 + e] = cnt;
            __syncthreads();
            int pre = 0;
            for (int s2 = 0; s2 < seg; ++s2) pre += SC[s2 * 32 + e];
            if (seg == 15) wgcnt[blk * 32 + e] = pre + cnt;
            for (int i = 0; i < 32; ++i) if (TI[seg * 32 + i] == e) { PS[seg * 32 + i] = pre; ++pre; }
        }
        __syncthreads();
        { const int t3 = F.wave * 64 + lane_id(); pos_g[(size_t)blk * 512 + t3] = PS[t3]; }
        { const int lane = lane_id();
            f32x4 PA[4], PB[4];
#pragma unroll
            for (int jj = 0; jj < 4; ++jj) { const int c = 4 * lane + 256 * jj; PA[jj] = *(const f32x4*)(g2n + c) * (*(const f32x4*)(sc2 + c) + 1.f); PB[jj] = *(const f32x4*)(sh2 + c); }
            for (int it = 0; it < 4; ++it) { u32x2 xb[4][4];
#pragma unroll
                for (int u = 0; u < 4; ++u) { const GAS u32x2* xr = (const GAS u32x2*)(XN + (size_t)(blk * 128 + F.wave * 16 + 4 * it + u) * DM) + lane;
#pragma unroll
                    for (int jj = 0; jj < 4; ++jj) xb[u][jj] = xr[64 * jj]; }
#pragma unroll
                for (int u = 0; u < 4; ++u) { const int rl = F.wave * 16 + 4 * it + u; const float rstd = RSTD[rl];
                    GAS unsigned* o4 = (GAS unsigned*)(H2 + (size_t)(blk * 128 + rl) * DM) + lane;
#pragma unroll
                    for (int jj = 0; jj < 4; ++jj) {
                        const f32x4 x = (f32x4){__uint_as_float(xb[u][jj].x << 16), __uint_as_float(xb[u][jj].x & 0xffff0000u), __uint_as_float(xb[u][jj].y << 16), __uint_as_float(xb[u][jj].y & 0xffff0000u)};
                        const f32x4 h = x * rstd * PA[jj] + PB[jj];
                        o4[64 * jj] = pk4_fp8(h.x, h.y, h.z, h.w); } } }
        }
    }
#undef in
}

__device__ __forceinline__ void p7_scatter(Frame& F) {
    FT_DECL;
    LAS int* TOT = (LAS int*)F.lds;
    LAS int* BASE = TOT + 32;
    LAS int* PRE = BASE + 32;
    LAS int* PART = PRE + 32;
    const int* wgcnt = WSP(int, WS_ROUTE + RT_WGCNT); const int* topi_g = WSP(int, WS_ROUTE + RT_TOPI); const float* gate_g = WSP(float, WS_ROUTE + RT_GATE); const int* pos_g = WSP(int, WS_ROUTE + RT_POS);
    int* list = WSP(int, WS_ROUTE + RT_LIST); float* gslot = WSP(float, WS_ROUTE + RT_GSLOT); int* meta = WSP(int, WS_ROUTE + RT_META);
    for (int blk = blockIdx.x; blk < MROWS / 128; blk += F.G) {
        __syncthreads();
        { const int e = f_tid & 31, part = f_tid >> 5; int st = 0, sp = 0;
            for (int w = part * 16; w < part * 16 + 16; ++w) { const int c = wgcnt[w * 32 + e]; st += c; if (w < blk) sp += c; }
            PART[part * 32 + e] = st; PART[512 + part * 32 + e] = sp; }
        __syncthreads();
        if (f_tid < 32) { int st = 0, sp = 0;
#pragma unroll
            for (int p = 0; p < 16; ++p) { st += PART[p * 32 + f_tid]; sp += PART[512 + p * 32 + f_tid]; }
            TOT[f_tid] = st; PRE[f_tid] = sp; }
        __syncthreads();
        if (f_tid == 0) { int b = 0; for (int e = 0; e < 32; ++e) { BASE[e] = b; b += (TOT[e] + 255) & ~255; }
            if (blk == 0) { int t = 0; for (int e = 0; e < 32; ++e) { meta[e] = TOT[e]; meta[32 + e] = BASE[e]; const int nt = (TOT[e] + 255) >> 8; for (int q = 0; q < nt; ++q) meta[128 + t + q] = e; t += nt; } meta[64] = t; } }
        __syncthreads();
        { const int a = f_tid, row = blk * 128 + (a >> 2); const int e = topi_g[(size_t)blk * 512 + a]; const int slot = BASE[e] + PRE[e] + pos_g[(size_t)blk * 512 + a];
            list[slot] = row * 4 + (a & 3); gslot[slot] = gate_g[(size_t)blk * 512 + a];
            PART[a] = slot; }
        __syncthreads();
        if (blk < NEXP) { const int e = blk, lo = BASE[e] + TOT[e], hi = BASE[e] + ((TOT[e] + 255) & ~255);
            for (int sl = lo + f_tid; sl < hi; sl += 512) { list[sl] = -1; gslot[sl] = 0.f; } }
    }
}

template <int NPN> struct SchedMoE {
    int G, c, nT; const char* A; const char* W; size_t wstride; const LAS unsigned char* tileE; const LAS int* RW; bool gath;
    __device__ __forceinline__ const LAS int* rows(int i) const { return RW + i * 256; }
    __device__ __forceinline__ bool next(int i, g8::Unit& u) const {
        const int L = i * G + c, xcd = L & 7, j = L >> 3, T = (j / NPN) * 8 + xcd, pn = j % NPN;
        if (T >= nT) return false;
        const int e = tileE[T];
        u.pm = T; u.pn = pn; u.kind = i; u.ex = e; u.a = gath ? A : A + (size_t)T * 256 * DM; u.b = W + (size_t)e * wstride + (size_t)pn * 256 * DM; return true;
    }
};
struct EpiSwiGLU {
    unsigned char* ACT; const float* b1;
    __device__ __forceinline__ void operator()(f32x4 (&acc)[2][2][4][2], const g8::Unit& u, int wr, int wc, int fr, int fq) const {
        asm volatile("" : "+v"(fr), "+v"(fq));
        const int j0 = u.pn * 128 + wc * 32 + 8 * fq; const float* bp = b1 + (size_t)u.ex * 2 * DM + j0;
        f32x4 bg[2], bl[2];
#pragma unroll
        for (int n = 0; n < 2; ++n) { bg[n] = *(const f32x4*)(bp + 4 * n); bl[n] = *(const f32x4*)(bp + DM + 4 * n); }
#pragma unroll
        for (int ai = 0; ai < 2; ++ai)
#pragma unroll
            for (int m = 0; m < 4; ++m) { const size_t slot = (size_t)u.pm * 256 + ai * 128 + wr * 64 + m * 16 + fr; float o[8];
#pragma unroll
                for (int n = 0; n < 2; ++n) { const f32x4 g4 = acc[ai][0][m][n] * (1.f / WSCALE) + bg[n], l4 = acc[ai][1][m][n] * (1.f / WSCALE) + bl[n];
#pragma unroll
                    for (int e = 0; e < 4; ++e) { const float g = fminf(g4[e], 7.f), l = __builtin_amdgcn_fmed3f(l4[e], -7.f, 7.f);
                        const float ex = __builtin_amdgcn_exp2f(g * (-1.702f * 1.4426950408889634f)); const float glu = g * __builtin_amdgcn_rcpf(1.f + ex);
                        o[4 * n + e] = fmaf(l, glu, glu); } }
                u32x2 w; w.x = pk4_fp8(o[0], o[1], o[2], o[3]); w.y = pk4_fp8(o[4], o[5], o[6], o[7]);
                *(u32x2*)(ACT + slot * DM + j0) = w; }
    }
};
struct EpiDown {
    unsigned char* EO; const float* b2; const LAS int* LL; int G, c;
    __device__ __forceinline__ void operator()(f32x4 (&acc)[2][2][4][2], const g8::Unit& u, int wr, int wc, int fr, int fq) const {
        asm volatile("" : "+v"(fr), "+v"(fq));
        const int c0 = u.pn * 256 + wc * 64 + 16 * fq; const float* bp = b2 + (size_t)u.ex * DM + c0;
        f32x4 bb[2][2];
#pragma unroll
        for (int bj = 0; bj < 2; ++bj)
#pragma unroll
            for (int n = 0; n < 2; ++n) bb[bj][n] = *(const f32x4*)(bp + bj * 8 + 4 * n);
        const LAS int* L = LL + u.kind * 512;
        int li[8]; float gt[8];
#pragma unroll
        for (int q = 0; q < 8; ++q) { const int rl = (q >> 2) * 128 + wr * 64 + (q & 3) * 16 + fr; li[q] = L[rl]; gt[q] = __int_as_float(L[256 + rl]) * (1.f / WSCALE); }
#pragma unroll
        for (int ai = 0; ai < 2; ++ai)
#pragma unroll
            for (int m = 0; m < 4; ++m) { const int l = li[ai * 4 + m]; const float g = gt[ai * 4 + m];
                unsigned char* dst = EO + ((size_t)(l & 3) * MROWS + (l >> 2)) * DM + c0;
                u32x4 w;
                { const f32x4 v0 = acc[ai][0][m][0] * g + bb[0][0] * (g * WSCALE), v1 = acc[ai][0][m][1] * g + bb[0][1] * (g * WSCALE);
                  w.x = pk4_fp8(v0[0] * EOSCALE, v0[1] * EOSCALE, v0[2] * EOSCALE, v0[3] * EOSCALE); w.y = pk4_fp8(v1[0] * EOSCALE, v1[1] * EOSCALE, v1[2] * EOSCALE, v1[3] * EOSCALE); }
                { const f32x4 v0 = acc[ai][1][m][0] * g + bb[1][0] * (g * WSCALE), v1 = acc[ai][1][m][1] * g + bb[1][1] * (g * WSCALE);
                  w.z = pk4_fp8(v0[0] * EOSCALE, v0[1] * EOSCALE, v0[2] * EOSCALE, v0[3] * EOSCALE); w.w = pk4_fp8(v1[0] * EOSCALE, v1[1] * EOSCALE, v1[2] * EOSCALE, v1[3] * EOSCALE); }
                if (l >= 0) *(u32x4*)dst = w; }
    }
};
__device__ __forceinline__ const LAS unsigned char* moe_tiles(Frame& F, int& nT) {
    FT_DECL;
    LAS unsigned char* TE = (LAS unsigned char*)(F.lds + RING_BYTES); const int* meta = WSP(int, WS_ROUTE + RT_META);
    __syncthreads();
    nT = meta[64]; if (nT > MAXTILE) nT = MAXTILE;
    for (int i = f_tid; i < MAXTILE; i += 512) TE[i] = (unsigned char)((i < nT) ? meta[128 + i] : 0);
    __syncthreads();
    return (const LAS unsigned char*)TE;
}

__device__ __forceinline__ void p10_combine(Frame& F) {
    FT_DECL;
    const float* mod = WSP(float, WS_SMALL + SM_MOD); const unsigned char* EO = WSP(unsigned char, WS_EO);
    const size_t gt = (size_t)F.vcu * 512 + f_tid, NTH = (size_t)F.G * 512;
    constexpr int U = 4;
    for (size_t i0 = gt; i0 < (size_t)MROWS * 128; i0 += NTH * U) {
        u32x2 ev[U][4]; f32x4 xv[U][2], gv[U][2];
#pragma unroll
        for (int u = 0; u < U; ++u) { const size_t i = i0 + (size_t)u * NTH; const size_t row = i >> 7; const int c0 = (int)(i & 127) * 8;
            const float* g2 = mod + (size_t)(row >> 12) * (NMOD * DM) + 5 * DM + c0; const bf16_t* op = WSP(bf16_t, WS_XN) + row * DM + c0;
#pragma unroll
            for (int k = 0; k < 4; ++k) ev[u][k] = __builtin_nontemporal_load((const u32x2*)(EO + ((size_t)k * MROWS + row) * DM + c0));
            { const u32x4 xb = *(const u32x4*)op; xv[u][0] = (f32x4){__uint_as_float(xb.x << 16), __uint_as_float(xb.x & 0xffff0000u), __uint_as_float(xb.y << 16), __uint_as_float(xb.y & 0xffff0000u)};
              xv[u][1] = (f32x4){__uint_as_float(xb.z << 16), __uint_as_float(xb.z & 0xffff0000u), __uint_as_float(xb.w << 16), __uint_as_float(xb.w & 0xffff0000u)}; }
            gv[u][0] = *(const f32x4*)g2; gv[u][1] = *(const f32x4*)(g2 + 4); }
#pragma unroll
        for (int u = 0; u < U; ++u) { const size_t i = i0 + (size_t)u * NTH; const size_t row = i >> 7; const int c0 = (int)(i & 127) * 8;
            float s[8];
#pragma unroll
            for (int e = 0; e < 8; ++e) s[e] = 0.f;
#pragma unroll
            for (int k = 0; k < 4; ++k) { const u32x2 v = ev[u][k];
                const f32x2 a = __builtin_amdgcn_cvt_pk_f32_fp8((int)v.x, false), b = __builtin_amdgcn_cvt_pk_f32_fp8((int)v.x, true), c = __builtin_amdgcn_cvt_pk_f32_fp8((int)v.y, false), d = __builtin_amdgcn_cvt_pk_f32_fp8((int)v.y, true);
                s[0] += a.x; s[1] += a.y; s[2] += b.x; s[3] += b.y; s[4] += c.x; s[5] += c.y; s[6] += d.x; s[7] += d.y; }
#pragma unroll
            for (int e = 0; e < 8; ++e) s[e] *= (1.f / EOSCALE);
            f32x4 o0 = xv[u][0] + gv[u][0] * (f32x4){s[0], s[1], s[2], s[3]}, o1 = xv[u][1] + gv[u][1] * (f32x4){s[4], s[5], s[6], s[7]};
            float* op = F.out + row * DM + c0;
            __builtin_nontemporal_store(o0, (f32x4*)op); __builtin_nontemporal_store(o1, (f32x4*)(op + 4)); }
    }
}

struct Args { const float* in[34]; float* out; unsigned char* ws; int ph_lo, ph_hi; };
constexpr int N_PHASES = 11;

__global__ void __launch_bounds__(512, 2) mega(Args args) {
    extern __shared__ __attribute__((aligned(16))) unsigned char lds[];
    Frame F;
    F.lds = (LAS unsigned char*)lds;
    F.MISC = (volatile LAS unsigned*)(F.lds + LDSCTL_OFF);
    F.wave = __builtin_amdgcn_readfirstlane(threadIdx.x >> 6);
    FT_DECL;
    F.G = gridDim.x; { const int bx = blockIdx.x; F.vcu = (F.G % 8 == 0) ? (bx % 8) * (F.G / 8) + bx / 8 : bx; }
    F.in = (kin_t)__builtin_amdgcn_kernarg_segment_ptr();
    F.out = args.out; F.ws = args.ws;
    F.ctl = (gu32*)(args.ws + WS_CTL);
    for (int u = f_tid; u < (LDS_BYTES - LDSCTL_OFF) / 4; u += NWAVES * 64) ((LAS unsigned*)(F.lds + LDSCTL_OFF))[u] = 0u;
    __syncthreads();
    const int lo = args.ph_lo, hi = args.ph_hi;
    XcdBarrier bar; bar.bar = (unsigned*)(F.ctl + CW_BAR); bar.x = 0; bar.st = nullptr;
    if (hi - lo > 1) bar = xcd_barrier_post((unsigned*)(F.ctl + CW_BAR), F.MISC + 8, f_tid == 0);
#define IN(k) (lo <= (k) && (k) < hi)
#define SEAM(k) do { if (IN(k) && IN((k) + 1)) xcd_barrier(bar, F.wave == 0 && lane_id() == 0); } while (0)

    if (IN(0)) { p0_prologue(F); } SEAM(0);
    if (IN(1)) { p1_norm1(F); } SEAM(1);
    if (IN(2)) {
        SchedInProj S{F.G, (int)blockIdx.x, (const char*)WSP(bf16_t, WS_H), (const char*)WSP(bf16_t, WS_WIN)};
        EpiInProj E{WSP(unsigned char, WS_Q), WSP(unsigned char, WS_K), WSP(unsigned char, WS_V), WSP(bf16_t, WS_UT), F.in[9], F.in[10], WSP(float, WS_SMALL + SM_ROPE)};
        g8::gemm_phase<false>(F.lds, DM, S, E, F.wave, lane_id());
    } SEAM(2);
    if (IN(3)) { p3_attention8(F); p3_hyena(F); } SEAM(3);
    if (IN(4)) { p4_hynorm(F); } SEAM(4);
    if (IN(5)) {
        SchedStatic S{F.G, (int)blockIdx.x, MROWS / 256, DM / 256, (const char*)WSP(bf16_t, WS_MIX), (const char*)WSP(bf16_t, WS_WOUT)};
        EpiOutProj E{F.in[0], WSP(bf16_t, WS_XN), WSP(float, WS_SMALL + SM_MOD)};
        g8::gemm_phase<false>(F.lds, DM, S, E, F.wave, lane_id());
    } SEAM(5);
    if (IN(6)) { p6_router_mfma(F); } SEAM(6);
    if (IN(7)) { p7_scatter(F); } SEAM(7);
    if (IN(8)) {
        int nT; const LAS unsigned char* TE = moe_tiles(F, nT);
        LAS int* RWL = (LAS int*)(F.lds + RING_BYTES + 1024);
        static_assert(RING_BYTES + 1024 + 17 * 1024 <= LDSCTL_OFF, "LDS map");
        SchedMoE<8> S{F.G, (int)blockIdx.x, nT, (const char*)WSP(char, WS_H), (const char*)WSP(char, WS_W1), (size_t)2 * DM * DM, TE, RWL, true};
        { const int* list = WSP(int, WS_ROUTE + RT_LIST); const int t8 = F.wave * 64 + lane_id();
            g8::Unit u; for (int i = 0; i < 17 && S.next(i, u); i += 2) { const int ii = i + (t8 >> 8); g8::Unit u2; if (S.next(ii, u2)) { const int li = list[(size_t)u2.pm * 256 + (t8 & 255)]; RWL[ii * 256 + (t8 & 255)] = (li >= 0) ? (li >> 2) : 0; } }
            __syncthreads(); }
        EpiSwiGLU E{WSP(unsigned char, WS_ACT), F.in[31]};
        g8::gemm_phase_g<true, true>(F.lds, DM, S, E, F.wave, lane_id());
    } SEAM(8);
    if (IN(9)) {
        int nT; const LAS unsigned char* TE = moe_tiles(F, nT);
        SchedMoE<4> S{F.G, (int)blockIdx.x, nT, (const char*)WSP(char, WS_ACT), (const char*)WSP(char, WS_W2), (size_t)DM * DM, TE, nullptr, false};
        LAS int* LL = (LAS int*)(F.lds + RING_BYTES + 1024);
        static_assert(RING_BYTES + 1024 + 9 * 2048 <= LDSCTL_OFF, "LDS map");
        { const int* list = WSP(int, WS_ROUTE + RT_LIST); const float* gslot = WSP(float, WS_ROUTE + RT_GSLOT);
            const int t9 = F.wave * 64 + lane_id();
            g8::Unit u; for (int i = 0; i < 9 && S.next(i, u); ++i) { const int t = t9 & 255; const size_t slot = (size_t)u.pm * 256 + t;
                LL[i * 512 + (t9 >> 8) * 256 + t] = (t9 < 256) ? list[slot] : __float_as_int(gslot[slot]); }
            __syncthreads(); }
        EpiDown E{WSP(unsigned char, WS_EO), F.in[33], LL, F.G, (int)blockIdx.x};
        g8::gemm_phase<true>(F.lds, DM, S, E, F.wave, lane_id());
    } SEAM(9);
    if (IN(10)) { p10_combine(F); }
#undef IN
#undef SEAM
}

extern "C" void kernel_launch(void* const* d_in, const int* in_sizes, int n_in, void* d_out, int out_size, void* d_ws, size_t ws_size, hipStream_t stream) {
    static int grid = 0;
    if (grid == 0) {
        if (n_in != 34 || out_size != MROWS * DM || ws_size < WS_END) { fprintf(stderr, "kernel_launch: unexpected shapes: n_in %d out %d ws %zu (need %zu)\n", n_in, out_size, ws_size, (size_t)WS_END); grid = -1; return; }
        int dev = 0, cus = 0, per_cu = 0;
        if (hipGetDevice(&dev) != hipSuccess || hipDeviceGetAttribute(&cus, hipDeviceAttributeMultiprocessorCount, dev) != hipSuccess) { grid = -1; return; }
        if (hipFuncSetAttribute((const void*)mega, hipFuncAttributeMaxDynamicSharedMemorySize, LDS_BYTES) != hipSuccess) { fprintf(stderr, "kernel_launch: hipFuncSetAttribute failed\n"); grid = -1; return; }
        if (hipOccupancyMaxActiveBlocksPerMultiprocessor(&per_cu, (const void*)mega, NWAVES * 64, LDS_BYTES) != hipSuccess || per_cu < 1) { fprintf(stderr, "kernel_launch: occupancy query says %d\n", per_cu); per_cu = 1; }
        (void)hipGetLastError();
        grid = cus;
    }
    if (grid < 0) return;
    (void)hipMemsetAsync((char*)d_ws + WS_CTL, 0, CTL_ZERO_BYTES, stream);
    Args a{};
    for (int i = 0; i < 34; ++i) a.in[i] = (const float*)d_in[i];
    a.out = (float*)d_out; a.ws = (unsigned char*)d_ws;
    constexpr int LAST = MK_LAST_PHASE + 1;
    if (MK_N_LAUNCHES == 1) { a.ph_lo = 0; a.ph_hi = LAST; hipLaunchKernelGGL(mega, dim3(grid), dim3(NWAVES * 64), LDS_BYTES, stream, a); }
    else for (int p = 0; p < LAST; ++p) { a.ph_lo = p; a.ph_hi = p + 1; hipLaunchKernelGGL(mega, dim3(grid), dim3(NWAVES * 64), LDS_BYTES, stream, a); }
    const hipError_t le = hipPeekAtLastError();
    if (le != hipSuccess) fprintf(stderr, "kernel_launch: launch failed: %s\n", hipGetErrorName(le));
}
```

```cpp
#include <hip/hip_runtime.h>
#include <hip/hip_bf16.h>
#include <cstdio>
#include <cstdint>

#ifndef MK_N_LAUNCHES
#define MK_N_LAUNCHES 1
#endif
#ifndef MK_LAST_PHASE
#define MK_LAST_PHASE 10
#endif

#define GAS __attribute__((address_space(1)))
#define LAS __attribute__((address_space(3)))
typedef unsigned short bf16_t;
typedef short bf16x8 __attribute__((ext_vector_type(8)));
typedef short s16x4 __attribute__((ext_vector_type(4)));
typedef float f32x2 __attribute__((ext_vector_type(2)));
typedef float f32x4 __attribute__((ext_vector_type(4)));
typedef float f32x16 __attribute__((ext_vector_type(16)));
typedef unsigned u32x2 __attribute__((ext_vector_type(2)));
typedef unsigned u32x4 __attribute__((ext_vector_type(4)));
typedef GAS unsigned gu32;

constexpr int NB = 8, SEQ = 4096, DM = 1024, MROWS = NB * SEQ, CTXL = 256, MCTX = NB * CTXL, MTOT = MROWS + MCTX;
constexpr int KVL = CTXL + SEQ;
constexpr int NHEAD = 4, QKW = 512;
constexpr int HYW = 512, HYC = 1536, INC = 3072, QKVC = 1536;
constexpr int NEXP = 32, TOPK = 4, NMOD = 6;
constexpr float EPS = 1e-6f;
constexpr float LAM_INIT = 0.2f;
constexpr float QSCALE = 0.125f * 1.4426950408889634f;

constexpr size_t MiB = 1u << 20;
constexpr size_t WS_CTL = 0, CTL_ZERO_BYTES = 64 * 1024;
constexpr size_t WS_SMALL = 1 * MiB;
constexpr size_t WS_WIN = 2 * MiB;
constexpr size_t WS_WOUT = 8 * MiB;
constexpr size_t WS_W1 = 10 * MiB;
constexpr size_t WS_W2 = 138 * MiB;
constexpr size_t WS_H = 202 * MiB;
constexpr size_t WS_Q = 270 * MiB;
constexpr size_t WS_K = 302 * MiB;
constexpr size_t WS_V = 336 * MiB;
constexpr size_t WS_UT = 370 * MiB;
constexpr size_t WS_FILT = 466 * MiB;
constexpr size_t WS_Z2T = 498 * MiB;
constexpr size_t WS_MIX = 530 * MiB;
constexpr size_t WS_ROUTE = 594 * MiB;
constexpr size_t WS_ACT = 270 * MiB;
constexpr size_t WS_EO = 598 * MiB;
constexpr size_t WS_XN = 870 * MiB;
constexpr size_t WS_END = 998 * MiB;
constexpr size_t SM_MOD = 0;
constexpr size_t SM_SCAL = 256 * 1024;
constexpr size_t SM_ROPE = 260 * 1024;
constexpr int CW_BAR = 4096;

constexpr int RING_BYTES = 131072;
constexpr int LDSCTL_OFF = 151552;
constexpr int LDS_BYTES = 152576;
constexpr int NWAVES = 8;

#define LDS_WAIT() asm volatile("s_waitcnt lgkmcnt(0)" ::: "memory")
#define VM_WAIT() asm volatile("s_waitcnt vmcnt(0)" ::: "memory")
#define RLX_AGENT __ATOMIC_RELAXED, __HIP_MEMORY_SCOPE_AGENT

__device__ __forceinline__ unsigned cvt_pk_bf16(float lo, float hi) { unsigned r; asm volatile("v_cvt_pk_bf16_f32 %0, %1, %2" : "=v"(r) : "v"(lo), "v"(hi)); return r; }
__device__ __forceinline__ float bf2f(bf16_t v) { return __uint_as_float(((unsigned)v) << 16); }
__device__ __forceinline__ float wave_sum(float v) {
#pragma unroll
    for (int o = 1; o < 64; o <<= 1) v += __shfl_xor(v, o);
    return v;
}

#define XB_TMO      128
#define XB_XCNT(j)  (256  + 64 * (j))
#define XB_XSUB(j)  (1280 + 64 * (j))
#define XB_XGEN(j)  (2304 + 64 * (j))
#define XB_TOP      3328
#define XB_TOPGEN   3392
#define XCD_BAR_WORDS 3456
#define XB_SPIN_CAP (1u << 22)
__device__ __forceinline__ unsigned xb_ld(unsigned* p)              { return __hip_atomic_load(p, __ATOMIC_RELAXED, __HIP_MEMORY_SCOPE_AGENT); }
__device__ __forceinline__ unsigned xb_add(unsigned* p, unsigned v) { return __hip_atomic_fetch_add(p, v, __ATOMIC_RELAXED, __HIP_MEMORY_SCOPE_AGENT); }
__device__ __forceinline__ unsigned xb_xcc_id() { return (unsigned)__builtin_amdgcn_s_getreg((3 << 11) | 20) & 0xFu; }
#define XB_SPIN(cond, bar) do { unsigned _sp = 0; while (cond) { __builtin_amdgcn_s_sleep(1); \
    if ((++_sp & 255u) == 0u) { if (xb_ld(&(bar)[XB_TMO])) break; if (_sp > XB_SPIN_CAP) { atomicAdd(&(bar)[XB_TMO], 1u); break; } } } } while (0)
struct XcdBarrier { unsigned* bar; unsigned x; volatile LAS unsigned* st; };
__device__ __forceinline__ XcdBarrier xcd_barrier_post(unsigned* bar, volatile LAS unsigned* st, bool leader) {
    XcdBarrier b; b.bar = bar; b.x = xb_xcc_id(); b.st = st;
    if (leader) (void)xb_add(&bar[XB_XCNT(b.x)], 1u);
    return b;
}
__device__ __forceinline__ void xcd_barrier_complete(unsigned* bar, unsigned x, unsigned& nloc, unsigned& nx) {
    const unsigned G = gridDim.x * gridDim.y * gridDim.z;
    unsigned sum, cnt, mine, sp = 0u;
    for (;;) {
        sum = 0u; cnt = 0u; mine = 0u;
#pragma unroll
        for (unsigned j = 0; j < 16; ++j) { const unsigned c = xb_ld(&bar[XB_XCNT(j)]); sum += c; cnt += (c > 0u) ? 1u : 0u; mine = (j == x) ? c : mine; }
        if (sum == G) break;
        __builtin_amdgcn_s_sleep(1);
        if ((++sp & 255u) == 0u) { if (xb_ld(&bar[XB_TMO])) break; if (sp > XB_SPIN_CAP) { atomicAdd(&bar[XB_TMO], 1u); break; } }
    }
    nloc = mine > 0u ? mine : 1u; nx = cnt > 0u ? cnt : 1u;
}
__device__ __forceinline__ void xcd_barrier(const XcdBarrier& b, bool leader) {
    asm volatile("s_waitcnt vmcnt(0)" ::: "memory");
    __syncthreads();
    if (leader) {
        unsigned* bar = b.bar;
        __builtin_amdgcn_s_waitcnt(0);
        unsigned nloc = b.st[0], nx = b.st[1];
        if (nloc == 0u) { xcd_barrier_complete(bar, b.x, nloc, nx); b.st[0] = nloc; b.st[1] = nx; }
        const unsigned old = xb_add(&bar[XB_XSUB(b.x)], 1u);
        const unsigned gen = old / nloc;
        if (old + 1u == (gen + 1u) * nloc) {
            __builtin_amdgcn_fence(__ATOMIC_RELEASE, "agent");
            asm volatile("s_waitcnt vmcnt(0)" ::: "memory");
            const unsigned og = xb_add(&bar[XB_TOP], 1u);
            const unsigned tg = og / nx;
            if (og + 1u == (tg + 1u) * nx) xb_add(&bar[XB_TOPGEN], 1u);
            else XB_SPIN(xb_ld(&bar[XB_TOPGEN]) == tg, bar);
            __builtin_amdgcn_fence(__ATOMIC_ACQUIRE, "agent");
            xb_add(&bar[XB_XGEN(b.x)], 1u);
            asm volatile("s_waitcnt vmcnt(0)" ::: "memory");
        } else {
            XB_SPIN(xb_ld(&bar[XB_XGEN(b.x)]) == gen, bar);
            __builtin_amdgcn_fence(__ATOMIC_ACQUIRE, "agent");
            asm volatile("s_waitcnt vmcnt(0)" ::: "memory");
        }
    }
    __syncthreads();
}

namespace g8 {
constexpr int BM = 256, BK = 64, HALF = 128, HTB = HALF * BK * 2, STAGE_BYTES = 8 * HTB, NXCD = 8, WGM = 8;
__host__ __device__ __forceinline__ int lds_byte(int r, int c) { const int st = (r >> 4) * 2 + (c >> 5), rr = r & 15, cc = c & 31, ob = rr * 64 + cc * 2; return st * 1024 + (ob ^ (((ob >> 9) & 1) << 5)); }
__host__ __device__ __forceinline__ void stage_rc(int b, int& R, int& C) { const int st = b / 1024, sb = b % 1024, swz = sb ^ (((sb >> 9) & 1) << 5); R = (st >> 1) * 16 + swz / 64; C = (st & 1) * 32 + (swz % 64) / 2; }
__host__ __device__ __forceinline__ int perm32(int rho) { const int n = rho >> 4, i = rho & 15; return 8 * (i >> 2) + 4 * n + (i & 3); }

struct Unit { const char* a; const char* b; int pm, pn, kind, ex; };

__device__ __forceinline__ void tile_of(int L, int nM, int nN, int& pm, int& pn) {
    const int nwg = nM * nN; int wgid = L;
    { const int q = nwg / NXCD, r = nwg % NXCD, xcd = wgid % NXCD, off = wgid / NXCD; wgid = (xcd < r ? xcd * (q + 1) : r * (q + 1) + (xcd - r) * q) + off; }
    const int nig = WGM * nN, gid = wgid / nig, fm = gid * WGM, gsz = (nM - fm) < WGM ? (nM - fm) : WGM;
    pm = fm + ((wgid % nig) % gsz); pn = (wgid % nig) / gsz;
}

typedef int i32x8 __attribute__((ext_vector_type(8)));
template <bool FP8, bool GATHER, class Epi, class Sched>
__device__ __forceinline__ void gemm_phase_g(LAS unsigned char* lds, const int K, const Sched& S, const Epi& E, const int wid, const int lane) {
    const int tid = wid * 64 + lane, wr = wid >> 2, wc = wid & 3, fr = lane & 15, fq = lane >> 4;
    const int nt = FP8 ? K / 128 : K / BK;
    const int RP = FP8 ? K : 2 * K;
    unsigned voffA[2], voffB[2]; int srow[2], scol[2];
#pragma unroll
    for (int i = 0; i < 2; ++i) { int R, C; stage_rc(tid * 16 + i * 8192, R, C); const int Rb = (R & ~31) + perm32(R & 31);
        voffA[i] = (unsigned)(R * RP + C * 2); voffB[i] = (unsigned)(Rb * RP + C * 2); srow[i] = R; scol[i] = C * 2; }
    const size_t kstep = (size_t)(BK * 2);
    const size_t hstep = (size_t)HALF * RP;
    const unsigned ldsw = (unsigned)wid * 1024u;
    unsigned cO0[2], cO1[2], nO0[2], nO1[2];
#define PG8_GOFF(D0, D1, ui_) do { if constexpr (GATHER) { const LAS int* rw_ = S.rows(ui_); _Pragma("unroll") for (int i_ = 0; i_ < 2; ++i_) { \
        D0[i_] = (unsigned)rw_[srow[i_]] * (unsigned)RP + (unsigned)scol[i_]; D1[i_] = (unsigned)rw_[128 + srow[i_]] * (unsigned)RP + (unsigned)scol[i_]; } } \
      else { _Pragma("unroll") for (int i_ = 0; i_ < 2; ++i_) { D0[i_] = voffA[i_]; D1[i_] = voffA[i_] + (unsigned)hstep; } } } while (0)
    const int aoff = lds_byte(wr * 64 + fr, FP8 ? fq * 16 : fq * 8), boff = lds_byte(wc * 32 + fr, FP8 ? fq * 16 : fq * 8);
    constexpr int KOFF = FP8 ? 16 : 1024;
#define PG8_SA(b, h) (((b) * 2 + (h)) * HTB)
#define PG8_SB(b, h) ((4 + (b) * 2 + (h)) * HTB)
#define PG8_STAGE(bufoff, gbase, voff) do { _Pragma("unroll") for (int _i = 0; _i < 2; ++_i) \
        __builtin_amdgcn_global_load_lds((const unsigned*)((const char*)(gbase) + (voff)[_i]), (LAS unsigned*)(lds + (bufoff) + ldsw + _i * 8192), 16, 0, 0); } while (0)
#define PG8_LD32(p) __builtin_bit_cast(i32x8, __builtin_shufflevector(*(const LAS u32x4*)(p), *(const LAS u32x4*)((p) + 16), 0, 1, 2, 3, 4, 5, 6, 7))
#define PG8_LDA8(dst, b, h) do { _Pragma("unroll") for (int m = 0; m < 4; ++m) dst[m] = PG8_LD32(lds + PG8_SA(b, h) + aoff + m * 2048); } while (0)
#define PG8_LDB8(dst, b, h) do { _Pragma("unroll") for (int n = 0; n < 2; ++n) dst[n] = PG8_LD32(lds + PG8_SB(b, h) + boff + n * 2048); } while (0)
#define PG8_LDA(dst, b, h) do { _Pragma("unroll") for (int m = 0; m < 4; ++m) _Pragma("unroll") for (int k = 0; k < 2; ++k) dst[m][k] = *(const LAS bf16x8*)(lds + PG8_SA(b, h) + aoff + m * 2048 + k * KOFF); } while (0)
#define PG8_LDB(dst, b, h) do { _Pragma("unroll") for (int n = 0; n < 2; ++n) _Pragma("unroll") for (int k = 0; k < 2; ++k) dst[n][k] = *(const LAS bf16x8*)(lds + PG8_SB(b, h) + boff + n * 2048 + k * KOFF); } while (0)
#define PG8_MMA(ai, bj, At, Bt) do { __builtin_amdgcn_s_setprio(1); _Pragma("unroll") for (int m = 0; m < 4; ++m) _Pragma("unroll") for (int n = 0; n < 2; ++n) _Pragma("unroll") for (int k = 0; k < 2; ++k) \
        acc[ai][bj][m][n] = __builtin_amdgcn_mfma_f32_16x16x32_bf16(Bt[n][k], At[m][k], acc[ai][bj][m][n], 0, 0, 0); __builtin_amdgcn_s_setprio(0); } while (0)
#define PG8_MMA8(ai, bj, At, Bt) do { __builtin_amdgcn_s_setprio(1); _Pragma("unroll") for (int m = 0; m < 4; ++m) _Pragma("unroll") for (int n = 0; n < 2; ++n) \
        asm volatile("v_mfma_scale_f32_16x16x128_f8f6f4 %0, %1, %2, %0, %3, %3 op_sel_hi:[0,0,0]" : "+v"(acc[ai][bj][m][n]) : "v"(Bt[n]), "v"(At[m]), "v"(one_scale)); __builtin_amdgcn_s_setprio(0); } while (0)
#define PG8_WAIT_V(n) asm volatile("s_waitcnt vmcnt(" #n ")" ::: "memory")
#define PG8_WAIT_L(n) asm volatile("s_waitcnt lgkmcnt(" #n ")" ::: "memory")
#define PG8_BAR __builtin_amdgcn_s_barrier()
#define PG8_SCHED __builtin_amdgcn_sched_barrier(0)
    Unit cur, nxt; int ui = 0;
    if (!S.next(0, cur)) return;
    f32x4 acc[2][2][4][2];
#pragma unroll
    for (int a = 0; a < 2; ++a)
#pragma unroll
        for (int b = 0; b < 2; ++b)
#pragma unroll
            for (int m = 0; m < 4; ++m)
#pragma unroll
                for (int n = 0; n < 2; ++n) acc[a][b][m][n] = (f32x4){0.f, 0.f, 0.f, 0.f};
    bf16x8 At[4][2], B0[2][2], B1[2][2];
    i32x8 At8[4], B08[2], B18[2];
    const unsigned one_scale = 0x7f7f7f7fu;
    const char* cA = cur.a; const char* cB = cur.b;
    PG8_GOFF(cO0, cO1, 0);
    PG8_STAGE(PG8_SB(0, 0), cB, voffB); PG8_STAGE(PG8_SB(0, 1), cB + hstep, voffB); PG8_STAGE(PG8_SA(0, 0), cA, cO0); PG8_STAGE(PG8_SA(0, 1), cA, cO1);
    if (wr == 1) PG8_BAR;
    PG8_WAIT_V(2); PG8_BAR;
    PG8_STAGE(PG8_SB(1, 0), cB + kstep, voffB); PG8_STAGE(PG8_SA(1, 0), cA + kstep, cO0); PG8_STAGE(PG8_SB(1, 1), cB + hstep + kstep, voffB);
    PG8_WAIT_V(6); PG8_BAR;
    for (;;) {
        const bool has_next = S.next(ui + 1, nxt);
        const char* nA = has_next ? nxt.a : cA; const char* nB = has_next ? nxt.b : cB;
        if (has_next) PG8_GOFF(nO0, nO1, ui + 1); else { _Pragma("unroll") for (int i_ = 0; i_ < 2; ++i_) { nO0[i_] = cO0[i_]; nO1[i_] = cO1[i_]; } }
#pragma unroll 1
        for (int t = 0; t < nt; t += 2) {
            const bool last = (t == nt - 2);
            const char* a1 = cA + (size_t)(t + 1) * kstep;
            const char* a2 = last ? nA : cA + (size_t)(t + 2) * kstep; const char* b2 = last ? nB : cB + (size_t)(t + 2) * kstep;
            const char* a3 = a2 + kstep; const char* b3 = b2 + kstep;
            unsigned o20[2], o21[2];
#pragma unroll
            for (int i_ = 0; i_ < 2; ++i_) { o20[i_] = last ? nO0[i_] : cO0[i_]; o21[i_] = last ? nO1[i_] : cO1[i_]; }
            if constexpr (FP8) {
            PG8_LDB8(B08, 0, 0); PG8_LDB8(B18, 0, 1); PG8_SCHED; PG8_LDA8(At8, 0, 0); PG8_STAGE(PG8_SA(1, 1), a1, cO1);
            PG8_WAIT_V(8); PG8_WAIT_L(0); PG8_BAR; PG8_MMA8(0, 0, At8, B08); PG8_MMA8(0, 1, At8, B18); PG8_BAR; PG8_SCHED;
            PG8_LDA8(At8, 0, 1); PG8_STAGE(PG8_SB(0, 0), b2, voffB); PG8_STAGE(PG8_SB(0, 1), b2 + hstep, voffB); PG8_STAGE(PG8_SA(0, 0), a2, o20);
            PG8_WAIT_V(8); PG8_WAIT_L(0); PG8_BAR; PG8_MMA8(1, 0, At8, B08); PG8_MMA8(1, 1, At8, B18); PG8_BAR; PG8_SCHED;
            PG8_LDB8(B08, 1, 0); PG8_LDB8(B18, 1, 1); PG8_SCHED; PG8_LDA8(At8, 1, 0); PG8_STAGE(PG8_SA(0, 1), a2, o21);
            PG8_WAIT_V(8); PG8_WAIT_L(0); PG8_BAR; PG8_MMA8(0, 0, At8, B08); PG8_MMA8(0, 1, At8, B18); PG8_BAR; PG8_SCHED;
            PG8_LDA8(At8, 1, 1); PG8_STAGE(PG8_SB(1, 0), b3, voffB); PG8_STAGE(PG8_SB(1, 1), b3 + hstep, voffB); PG8_STAGE(PG8_SA(1, 0), a3, o20);
            PG8_WAIT_V(8); PG8_WAIT_L(0); PG8_BAR; PG8_MMA8(1, 0, At8, B08); PG8_MMA8(1, 1, At8, B18); PG8_BAR; PG8_SCHED;
            } else {
            PG8_LDB(B0, 0, 0); PG8_LDB(B1, 0, 1); PG8_SCHED; PG8_LDA(At, 0, 0); PG8_STAGE(PG8_SA(1, 1), a1, cO1);
            PG8_WAIT_V(8); PG8_WAIT_L(0); PG8_BAR; PG8_MMA(0, 0, At, B0); PG8_MMA(0, 1, At, B1); PG8_BAR; PG8_SCHED;
            PG8_LDA(At, 0, 1); PG8_STAGE(PG8_SB(0, 0), b2, voffB); PG8_STAGE(PG8_SB(0, 1), b2 + hstep, voffB); PG8_STAGE(PG8_SA(0, 0), a2, o20);
            PG8_WAIT_V(8); PG8_WAIT_L(0); PG8_BAR; PG8_MMA(1, 0, At, B0); PG8_MMA(1, 1, At, B1); PG8_BAR; PG8_SCHED;
            PG8_LDB(B0, 1, 0); PG8_LDB(B1, 1, 1); PG8_SCHED; PG8_LDA(At, 1, 0); PG8_STAGE(PG8_SA(0, 1), a2, o21);
            PG8_WAIT_V(8); PG8_WAIT_L(0); PG8_BAR; PG8_MMA(0, 0, At, B0); PG8_MMA(0, 1, At, B1); PG8_BAR; PG8_SCHED;
            PG8_LDA(At, 1, 1); PG8_STAGE(PG8_SB(1, 0), b3, voffB); PG8_STAGE(PG8_SB(1, 1), b3 + hstep, voffB); PG8_STAGE(PG8_SA(1, 0), a3, o20);
            PG8_WAIT_V(8); PG8_WAIT_L(0); PG8_BAR; PG8_MMA(1, 0, At, B0); PG8_MMA(1, 1, At, B1); PG8_BAR; PG8_SCHED;
            }
        }
        if (wr == 0) PG8_BAR;
        if constexpr (FP8) asm volatile("s_nop 15\n\ts_nop 15" ::: "memory");
        E(acc, cur, wr, wc, fr, fq);
        if (!has_next) break;
#pragma unroll
        for (int a = 0; a < 2; ++a)
#pragma unroll
            for (int b = 0; b < 2; ++b)
#pragma unroll
                for (int m = 0; m < 4; ++m)
#pragma unroll
                    for (int n = 0; n < 2; ++n) acc[a][b][m][n] = (f32x4){0.f, 0.f, 0.f, 0.f};
        cur = nxt; cA = nA; cB = nB; ++ui;
#pragma unroll
        for (int i_ = 0; i_ < 2; ++i_) { cO0[i_] = nO0[i_]; cO1[i_] = nO1[i_]; }
        if (wr == 1) PG8_BAR;
    }
    PG8_WAIT_V(0);
    PG8_BAR;
#undef PG8_SA
#undef PG8_GOFF
#undef PG8_SB
#undef PG8_STAGE
#undef PG8_LDA
#undef PG8_LDB
#undef PG8_MMA
#undef PG8_MMA8
#undef PG8_LDA8
#undef PG8_LDB8
#undef PG8_LD32
#undef PG8_WAIT_V
#undef PG8_WAIT_L
#undef PG8_BAR
#undef PG8_SCHED
}
template <bool FP8, class Epi, class Sched>
__device__ __forceinline__ void gemm_phase(LAS unsigned char* lds, const int K, const Sched& S, const Epi& E, const int wid, const int lane) { gemm_phase_g<FP8, false>(lds, K, S, E, wid, lane); }
}

__device__ __forceinline__ int lane_id() { int l; asm volatile("v_mbcnt_lo_u32_b32 %0, -1, 0\n\tv_mbcnt_hi_u32_b32 %0, -1, %0" : "=v"(l)); return l; }
#define FT_DECL const int f_lane = lane_id(), f_tid = F.wave * 64 + f_lane; (void)f_tid; (void)f_lane
typedef const float* cfp_t;
typedef __attribute__((address_space(4))) cfp_t* kin_t;
struct Frame {
    LAS unsigned char* lds;
    volatile LAS unsigned* MISC;
    gu32* ctl;
    int wave, vcu, G;
    kin_t in;
    float* out;
    unsigned char* ws;
};
#define WSP(T, off) ((T*)(F.ws + (off)))

template <class RowMap>
__device__ __forceinline__ void p0_transpose_item(const float* W, int K, int N, bf16_t* WT, const RowMap& rowmap, const float* kscale, LAS float* scr, int item, int lane, bool kperm = false) {
    const int nblk = N / 32, kb = item / nblk, nb = item % nblk, k0 = 64 * kb, n0 = 32 * nb;
#pragma unroll 8
    for (int i = 0; i < 32; ++i) { const int kk = 2 * i + (lane >> 5); int ks = k0 + kk; if (kperm && ks >= K / 2) { const int j = ks - K / 2; ks = K / 2 + (j >> 3) + 64 * (j & 7); }
        float v = W[(size_t)ks * N + n0 + (lane & 31)]; if (kscale) v *= kscale[k0 + kk]; scr[kk * 33 + (lane & 31)] = v; }
    LDS_WAIT(); asm volatile("" ::: "memory");
    const int c = lane & 7;
#pragma unroll
    for (int j = 0; j < 4; ++j) { const int n = (lane >> 3) + 8 * j; const LAS float* s = scr + (8 * c) * 33 + n;
        u32x4 o; o.x = cvt_pk_bf16(s[0 * 33], s[1 * 33]); o.y = cvt_pk_bf16(s[2 * 33], s[3 * 33]); o.z = cvt_pk_bf16(s[4 * 33], s[5 * 33]); o.w = cvt_pk_bf16(s[6 * 33], s[7 * 33]);
        *(GAS u32x4*)(WT + (size_t)rowmap(n0 + n) * K + k0 + 8 * c) = o; }
    LDS_WAIT(); asm volatile("" ::: "memory");
}

__device__ __forceinline__ unsigned pk4_fp8(float a, float b, float c, float d) { int r = __builtin_amdgcn_cvt_pk_fp8_f32(a, b, 0, false); r = __builtin_amdgcn_cvt_pk_fp8_f32(c, d, r, true); return (unsigned)r; }
constexpr float EOSCALE = 16.f;
constexpr float WSCALE = 32.f;
template <class RowMap>
__device__ __forceinline__ void p0_transpose_item_f8(const float* W, int K, int N, unsigned char* WT, const RowMap& rowmap, LAS float* scr, int item, int lane) {
    const int nblk = N / 32, kb = item / nblk, nb = item % nblk, k0 = 128 * kb, n0 = 32 * nb;
#pragma unroll
    for (int hh = 0; hh < 2; ++hh) { float v[32];
#pragma unroll
        for (int i = 0; i < 32; ++i) { const int kk = 2 * (32 * hh + i) + (lane >> 5); v[i] = __builtin_nontemporal_load(W + (size_t)(k0 + kk) * N + n0 + (lane & 31)); }
#pragma unroll
        for (int i = 0; i < 32; ++i) { const int kk = 2 * (32 * hh + i) + (lane >> 5); scr[kk * 33 + (lane & 31)] = v[i] * WSCALE; } }
    LDS_WAIT(); asm volatile("" ::: "memory");
    const int c = lane & 7;
#pragma unroll
    for (int j = 0; j < 4; ++j) { const int n = (lane >> 3) + 8 * j; const LAS float* sp = scr + (16 * c) * 33 + n;
        u32x4 o; o.x = pk4_fp8(sp[0 * 33], sp[1 * 33], sp[2 * 33], sp[3 * 33]); o.y = pk4_fp8(sp[4 * 33], sp[5 * 33], sp[6 * 33], sp[7 * 33]);
        o.z = pk4_fp8(sp[8 * 33], sp[9 * 33], sp[10 * 33], sp[11 * 33]); o.w = pk4_fp8(sp[12 * 33], sp[13 * 33], sp[14 * 33], sp[15 * 33]);
        *(GAS u32x4*)(WT + (size_t)rowmap(n0 + n) * K + k0 + 16 * c) = o; }
    LDS_WAIT(); asm volatile("" ::: "memory");
}
struct MapW2 { __device__ __forceinline__ int operator()(int l) const { const int t = l & ~255, r = l & 255, wc = r >> 6, fq = (r >> 4) & 3, bj = (r >> 3) & 1, low = r & 7; return t + 128 * bj + 32 * wc + 8 * fq + low; } };
struct MapIdent { int off; __device__ __forceinline__ int operator()(int n) const { return off + n; } };
struct MapWin { __device__ __forceinline__ int operator()(int l) const {
    if (l >= 1024) return l;
    const int t = l & ~255, r = l & 255, wc = r >> 6, blk = (r >> 5) & 1, bj = (r >> 4) & 1, low = r & 15;
    return t + 128 * bj + 32 * wc + 16 * blk + low; } };
struct MapW1 { int off; __device__ __forceinline__ int operator()(int jp) const { const int bj = jp >> 10, j = jp & 1023; return off + 256 * (j >> 7) + 128 * bj + (j & 127); } };


__device__ __forceinline__ void p0_filter_item(Frame& F, int item) {
    FT_DECL;
#define in F.in
    LAS float* h1s = (LAS float*)(F.lds);
    LAS float* h2s = (LAS float*)(F.lds + 4096);
    const int t0 = item * 16;
    {
        const int tt = f_tid >> 5, hh = (f_tid & 31) * 2; const float pos = (float)(t0 + tt);
        float feats[17]; feats[0] = pos * (1.f / SEQ);
#pragma unroll
        for (int i = 0; i < 8; ++i) { const float band = 1e-4f + (float)i * ((7.f - 1e-4f) / 7.f); const float ang = (6.283185307179586f / SEQ) * pos * band; feats[1 + i] = __sinf(ang); feats[9 + i] = __cosf(ang); }
#pragma unroll
        for (int u = 0; u < 2; ++u) { const int h = hh + u; float a = in[19][h];
#pragma unroll
            for (int k = 0; k < 17; ++k) a += feats[k] * in[18][k * 64 + h];
            h1s[tt * 64 + h] = __sinf(in[20][h] * a); }
        __syncthreads();
#pragma unroll
        for (int u = 0; u < 2; ++u) { const int h = hh + u; float a = in[22][h];
#pragma unroll 8
            for (int k = 0; k < 64; ++k) a += h1s[tt * 64 + k] * in[21][k * 64 + h];
            h2s[tt * 64 + h] = __sinf(in[23][h] * a); }
        __syncthreads();
    }
    f32x4 acc[16];
#pragma unroll
    for (int t = 0; t < 16; ++t) acc[t] = (f32x4){0.f, 0.f, 0.f, 0.f};
    const int o = 4 * f_tid;
    for (int k0 = 0; k0 < 64; k0 += 4) { f32x4 w[4];
#pragma unroll
        for (int q = 0; q < 4; ++q) w[q] = *(const f32x4*)(in[24] + (size_t)(k0 + q) * 2048 + o);
#pragma unroll
        for (int t = 0; t < 16; ++t) { const f32x4 hv = *(const LAS f32x4*)(h2s + t * 64 + k0); acc[t] += w[0] * hv[0] + w[1] * hv[1] + w[2] * hv[2] + w[3] * hv[3]; } }
    const int c0 = o & 511, od = o >> 9;
    float* dst = WSP(float, WS_FILT) + ((size_t)od * 512 + c0) * SEQ + t0;
#pragma unroll
    for (int e = 0; e < 4; ++e) { const float la = -3.0701134573253944f, lb = -15.350567286626972f; const float delta = fabsf(la + (float)(c0 + e) * ((lb - la) / 511.f));
#pragma unroll
        for (int q = 0; q < 4; ++q) { f32x4 v;
#pragma unroll
            for (int i = 0; i < 4; ++i) { const int t = 4 * q + i; const float tn = (float)(t0 + t) * (1.f / SEQ); v[i] = acc[t][e] * __expf(-tn * delta); }
            *(f32x4*)(dst + (size_t)e * SEQ + 4 * q) = v; } }
    __syncthreads();
#undef in
}

__device__ __forceinline__ float silu_f(float v) { return v / (1.f + __expf(-v)); }

__device__ __forceinline__ void p0_prologue(Frame& F) {
    FT_DECL;
#define in F.in
    const int wg = blockIdx.x;
    if (wg < 96) {
        LAS float* sv = (LAS float*)F.lds;
        for (int i = f_tid; i < 9 * 1024; i += 512) { const int r = i >> 10, k = i & 1023; const float c = (r < 8) ? in[1][r * 1024 + k] : in[3][k]; sv[i] = silu_f(c); }
        __syncthreads();
        const int j = wg * 64 + f_lane; const float* wm = in[4];
        float acc[9];
#pragma unroll
        for (int r = 0; r < 9; ++r) acc[r] = 0.f;
        const int kbeg = F.wave * 128;
        for (int k0 = kbeg; k0 < kbeg + 128; k0 += 16) { float w[16];
#pragma unroll
            for (int q = 0; q < 16; ++q) w[q] = __builtin_nontemporal_load(wm + (size_t)(k0 + q) * (NMOD * DM) + j);
#pragma unroll
            for (int q = 0; q < 16; ++q)
#pragma unroll
                for (int r = 0; r < 9; ++r) acc[r] += sv[r * 1024 + k0 + q] * w[q]; }
        LAS float* red = (LAS float*)(F.lds + 40960);
#pragma unroll
        for (int r = 0; r < 9; ++r) red[(F.wave * 9 + r) * 64 + f_lane] = acc[r];
        __syncthreads();
        for (int i = f_tid; i < 9 * 64; i += 512) { const int r = i >> 6, l = i & 63; float s = in[5][wg * 64 + l];
#pragma unroll
            for (int w = 0; w < 8; ++w) s += red[(w * 9 + r) * 64 + l];
            WSP(float, WS_SMALL + SM_MOD)[r * (NMOD * DM) + wg * 64 + l] = s; }
        __syncthreads();
    } else if (wg == 96) {
        if (F.wave == 0) {
            const float a = wave_sum(in[11][f_lane] * in[12][f_lane]), b = wave_sum(in[13][f_lane] * in[14][f_lane]);
            float gq = fabsf(in[9][f_lane]), gk = fabsf(in[10][f_lane]);
#pragma unroll
            for (int o = 1; o < 64; o <<= 1) { gq = fmaxf(gq, __shfl_xor(gq, o)); gk = fmaxf(gk, __shfl_xor(gk, o)); }
            if (f_lane == 0) { float* sc = WSP(float, WS_SMALL + SM_SCAL); sc[0] = expf(a) - expf(b) + LAM_INIT;
                sc[1] = (8.f * gq * gk * 1.02f + 0.05f) * 1.4426950408889634f; }
        }
        for (int i = f_tid; i < 64 * 16; i += 512) { const int pos = i >> 4, f = i & 15;
            const float inv = powf(10000.f, -(float)f / 16.f); const float ang = (float)pos * inv;
            float* rt = WSP(float, WS_SMALL + SM_ROPE); rt[2 * i] = cosf(ang); rt[2 * i + 1] = sinf(ang); }
    }
    __syncthreads();
    for (int it = wg; it < SEQ / 16; it += F.G) p0_filter_item(F, it);
    __syncthreads();
    {
        LAS float* scr = (LAS float*)(F.lds + F.wave * 16896);
        const int gw = F.vcu * NWAVES + F.wave, NGW = F.G * NWAVES;
        constexpr int I_IN = (DM / 64) * (INC / 32), I_OUT = (DM / 64) * (DM / 32), I_1 = (DM / 128) * (2 * DM / 32), I_2 = (DM / 128) * (DM / 32);
        constexpr int NITEMS = I_IN + I_OUT + NEXP * (I_1 + I_2);
        for (int it = gw; it < NITEMS; it += NGW) {
            int r = it;
            if (r < I_IN) { p0_transpose_item(in[8], DM, INC, WSP(bf16_t, WS_WIN), MapWin{}, nullptr, scr, r, f_lane); continue; } r -= I_IN;
            if (r < I_OUT) { p0_transpose_item(in[27], DM, DM, WSP(bf16_t, WS_WOUT), MapIdent{0}, nullptr, scr, r, f_lane, true); continue; } r -= I_OUT;
            const int e = r / (I_1 + I_2); r -= e * (I_1 + I_2);
            if (r < I_1) p0_transpose_item_f8(in[30] + (size_t)e * DM * 2 * DM, DM, 2 * DM, WSP(unsigned char, WS_W1) + (size_t)e * 2 * DM * DM, MapW1{0}, scr, r, f_lane);
            else p0_transpose_item_f8(in[32] + (size_t)e * DM * DM, DM, DM, WSP(unsigned char, WS_W2) + (size_t)e * DM * DM, MapW2{}, scr, r - I_1, f_lane);
        }
    }
}
#undef in

__device__ __forceinline__ void p1_norm1(Frame& F) {
    FT_DECL;
    const int gw = F.vcu * NWAVES + F.wave, NGW = F.G * NWAVES;
    const float* mod = WSP(float, WS_SMALL + SM_MOD); const float* g1 = F.in[6];
    bf16_t* H = WSP(bf16_t, WS_H);
    constexpr int RPW = MTOT / (256 * NWAVES);
    for (int run = gw; run * RPW < MTOT; run += NGW) {
        const int r0 = run * RPW, r1 = (r0 + RPW < MTOT) ? r0 + RPW : MTOT;
        int curb = -1; f32x4 PA[4], PB[4];
        for (int m0 = r0; m0 < r1; m0 += 4) {
            f32x4 v[4][4];
#pragma unroll
            for (int u = 0; u < 4; ++u) { const int m = m0 + u; if (m < r1) {
                const float* xrow = (m < MROWS) ? F.in[0] + (size_t)m * DM : F.in[2] + (size_t)(m - MROWS) * DM; const GAS f32x4* xr = (const GAS f32x4*)xrow + f_lane;
#pragma unroll
                for (int j = 0; j < 4; ++j) v[u][j] = __builtin_nontemporal_load(xr + 64 * j); } }
#pragma unroll
            for (int u = 0; u < 4; ++u) { const int m = m0 + u; if (m < r1) {
                const int mb = (m < MROWS) ? (m >> 12) : 8;
                if (mb != curb) { curb = mb; const float* sh = mod + (size_t)mb * (NMOD * DM); const float* sc = sh + DM;
#pragma unroll
                    for (int j = 0; j < 4; ++j) { const int c = 4 * f_lane + 256 * j; PA[j] = *(const f32x4*)(g1 + c) * (*(const f32x4*)(sc + c) + 1.f); PB[j] = *(const f32x4*)(sh + c); } }
                float s = 0.f;
#pragma unroll
                for (int j = 0; j < 4; ++j) s += (v[u][j].x * v[u][j].x + v[u][j].y * v[u][j].y) + (v[u][j].z * v[u][j].z + v[u][j].w * v[u][j].w);
                const float rstd = rsqrtf(wave_sum(s) * (1.f / DM) + EPS);
                GAS u32x2* o8 = (GAS u32x2*)(H + (size_t)m * DM) + f_lane;
#pragma unroll
                for (int j = 0; j < 4; ++j) { const f32x4 y = v[u][j] * rstd * PA[j] + PB[j];
                    u32x2 w; w.x = cvt_pk_bf16(y.x, y.y); w.y = cvt_pk_bf16(y.z, y.w); o8[64 * j] = w; } } }
        }
    }
}

struct SchedInProj {
    int G, c; const char* H; const char* W;
    static constexpr int NA = 136 * 4, NV = 2 * 136, NBU = 6 * 128;
    __device__ __forceinline__ bool next(int i, g8::Unit& u) const {
        const long L = (long)i * G + c;
        if (L < NA) { g8::tile_of((int)L, 136, 4, u.pm, u.pn); u.a = H + (size_t)u.pm * 256 * DM * 2; u.b = W + (size_t)u.pn * 256 * DM * 2; u.kind = 0; u.ex = 0; return true; }
        if (L < NA + NV) { g8::tile_of((int)L - NA, 2, 136, u.pm, u.pn); u.a = W + (size_t)(1024 + u.pm * 256) * DM * 2; u.b = H + (size_t)u.pn * 256 * DM * 2; u.kind = 2; u.ex = 0; return true; }
        if (L < NA + NV + NBU) { g8::tile_of((int)L - NA - NV, 6, 128, u.pm, u.pn); u.a = W + (size_t)(QKVC + u.pm * 256) * DM * 2; u.b = H + (size_t)u.pn * 256 * DM * 2; u.kind = 1; u.ex = 0; return true; }
        return false;
    }
};
constexpr float Q8SCALE = 16.f;
struct EpiInProj {
    unsigned char *Q8, *K8, *VT8; bf16_t* UT; const float *gq, *gk, *rope;
    __device__ __forceinline__ void operator()(f32x4 (&acc)[2][2][4][2], const g8::Unit& u, int wr, int wc, int fr, int fq) const {
        asm volatile("" : "+v"(fr), "+v"(fq));
        if (u.kind == 1) {
            const int row0 = u.pm * 256 + wr * 64 + fr, col0 = u.pn * 256 + wc * 32 + 8 * fq;
#pragma unroll
            for (int ai = 0; ai < 2; ++ai)
#pragma unroll
                for (int m = 0; m < 4; ++m) { const int ch = row0 + ai * 128 + m * 16;
#pragma unroll
                    for (int bj = 0; bj < 2; ++bj) { const int tok = col0 + bj * 128; const f32x4 v0 = acc[ai][bj][m][0], v1 = acc[ai][bj][m][1];
                        u32x4 w; w.x = cvt_pk_bf16(v0[0], v0[1]); w.y = cvt_pk_bf16(v0[2], v0[3]); w.z = cvt_pk_bf16(v1[0], v1[1]); w.w = cvt_pk_bf16(v1[2], v1[3]);
                        *(u32x4*)(UT + ((size_t)(tok >> 7) * HYC + ch) * 128 + (tok & 127)) = w; } }
            return;
        }
        if (u.kind == 2) {
#pragma unroll
            for (int bj = 0; bj < 2; ++bj) { const int t8 = u.pn * 256 + bj * 128 + wc * 32 + 8 * fq;
                int b, key; if (t8 < MROWS) { b = t8 >> 12; key = CTXL + (t8 & 4095); } else { const int j = t8 - MROWS; b = j >> 8; key = j & 255; }
                const int tile = key >> 6, k = key & 63, ipos = (k < 32) ? 4 * (k >> 3) : 16 + 4 * ((k - 32) >> 3);
#pragma unroll
                for (int ai = 0; ai < 2; ++ai)
#pragma unroll
                    for (int m = 0; m < 4; ++m) { const int ch = u.pm * 256 + ai * 128 + wr * 64 + m * 16 + fr;
                        unsigned char* dst = VT8 + ((((size_t)(b * NHEAD + (ch >> 7)) * 68 + tile) * 128 + (ch & 127)) * 64) + ipos;
                        const f32x4 v0 = acc[ai][bj][m][0], v1 = acc[ai][bj][m][1];
                        *(unsigned*)dst = pk4_fp8(v0[0], v0[1], v0[2], v0[3]); *(unsigned*)(dst + 32) = pk4_fp8(v1[0], v1[1], v1[2], v1[3]); } }
            return;
        }
        const int blk = fq >> 1, f = fq & 1;
        const int sec = u.pn >> 1;
        const bool ctx = (u.pm >= 128);
        if (sec == 0 && ctx) return;
        const int colbase = (u.pn & 1) * 256 + wc * 64 + 32 * blk + 8 * f;
        float gg[2][2][4];
        { const float* gp = (sec == 0 ? gq : gk) + 32 * blk + 8 * f;
#pragma unroll
            for (int bj = 0; bj < 2; ++bj)
#pragma unroll
                for (int n = 0; n < 2; ++n) { const f32x4 t = *(const f32x4*)(gp + 16 * bj + 4 * n); gg[bj][n][0] = t[0]; gg[bj][n][1] = t[1]; gg[bj][n][2] = t[2]; gg[bj][n][3] = t[3]; } }
#pragma unroll
        for (int ai = 0; ai < 2; ++ai)
#pragma unroll
            for (int m = 0; m < 4; ++m) {
                const int rloc = ai * 128 + wr * 64 + m * 16 + fr; const int r = u.pm * 256 + rloc;
                f32x4 v[2][2];
#pragma unroll
                for (int bj = 0; bj < 2; ++bj)
#pragma unroll
                    for (int n = 0; n < 2; ++n) v[bj][n] = acc[ai][bj][m][n];
                size_t orow;
                if (sec == 0) orow = (size_t)r;
                else if (!ctx) orow = (size_t)(r >> 12) * KVL + CTXL + (r & 4095);
                else { const int j = r - MROWS; orow = (size_t)(j >> 8) * KVL + (j & 255); }
                float ss = 0.f;
#pragma unroll
                for (int bj = 0; bj < 2; ++bj)
#pragma unroll
                    for (int n = 0; n < 2; ++n) ss += (v[bj][n][0] * v[bj][n][0] + v[bj][n][1] * v[bj][n][1]) + (v[bj][n][2] * v[bj][n][2] + v[bj][n][3] * v[bj][n][3]);
                ss += __shfl_xor(ss, 16); ss += __shfl_xor(ss, 32);
                const float rstd = rsqrtf(ss * (1.f / 64.f) + EPS) * (sec == 0 ? QSCALE * Q8SCALE : 1.f);
#pragma unroll
                for (int bj = 0; bj < 2; ++bj)
#pragma unroll
                    for (int n = 0; n < 2; ++n)
#pragma unroll
                        for (int e = 0; e < 4; ++e) v[bj][n][e] *= rstd * gg[bj][n][e];
                if (!ctx) {
                    const int t = r & 4095; const int pos = blk ? (t & 63) : (t >> 6);
                    const float* rp = rope + (size_t)(pos * 16 + 8 * f) * 2;
#pragma unroll
                    for (int n = 0; n < 2; ++n) { const f32x4 c0 = *(const f32x4*)(rp + 8 * n), c1 = *(const f32x4*)(rp + 8 * n + 4);
                        const float cs[4] = {c0[0], c0[2], c1[0], c1[2]}, sn[4] = {c0[1], c0[3], c1[1], c1[3]};
#pragma unroll
                        for (int e = 0; e < 4; ++e) { const float x1 = v[0][n][e], x2 = v[1][n][e]; v[0][n][e] = x1 * cs[e] - x2 * sn[e]; v[1][n][e] = x2 * cs[e] + x1 * sn[e]; } }
                }
                unsigned char* dst = (sec == 0 ? Q8 : K8) + orow * QKW + colbase;
#pragma unroll
                for (int bj = 0; bj < 2; ++bj) { u32x2 w; w.x = pk4_fp8(v[bj][0][0], v[bj][0][1], v[bj][0][2], v[bj][0][3]); w.y = pk4_fp8(v[bj][1][0], v[bj][1][1], v[bj][1][2], v[bj][1][3]);
                    *(u32x2*)(dst + 16 * bj) = w; }
            }
    }
};

struct SchedStatic {
    int G, c, nM, nN; const char* A; const char* B;
    __device__ __forceinline__ bool next(int i, g8::Unit& u) const {
        const long L = (long)i * G + c; if (L >= (long)nM * nN) return false;
        g8::tile_of((int)L, nM, nN, u.pm, u.pn); u.a = A + (size_t)u.pm * 256 * DM * 2; u.b = B + (size_t)u.pn * 256 * DM * 2; u.kind = 0; u.ex = 0; return true;
    }
};
struct EpiOutProj {
    const float* x; bf16_t* out; const float* mod;
    __device__ __forceinline__ void operator()(f32x4 (&acc)[2][2][4][2], const g8::Unit& u, int wr, int wc, int fr, int fq) const {
        asm volatile("" : "+v"(fr), "+v"(fq));
        const int col0 = u.pn * 256 + wc * 32 + 8 * fq;
        const float* g1 = mod + (size_t)((u.pm * 256) >> 12) * (NMOD * DM) + 2 * DM + col0;
        f32x4 gv[2][2];
#pragma unroll
        for (int bj = 0; bj < 2; ++bj)
#pragma unroll
            for (int n = 0; n < 2; ++n) gv[bj][n] = *(const f32x4*)(g1 + bj * 128 + 4 * n);
#pragma unroll
        for (int ai = 0; ai < 2; ++ai)
#pragma unroll
            for (int m = 0; m < 4; ++m) { const int r = u.pm * 256 + ai * 128 + wr * 64 + m * 16 + fr;
                const size_t off = (size_t)r * DM + col0;
#pragma unroll
                for (int bj = 0; bj < 2; ++bj) { f32x4 o[2];
#pragma unroll
                    for (int n = 0; n < 2; ++n) { const f32x4 xv = __builtin_nontemporal_load((const f32x4*)(x + off + bj * 128 + 4 * n)); o[n] = xv + gv[bj][n] * acc[ai][bj][m][n]; }
                    u32x4 w; w.x = cvt_pk_bf16(o[0][0], o[0][1]); w.y = cvt_pk_bf16(o[0][2], o[0][3]); w.z = cvt_pk_bf16(o[1][0], o[1][1]); w.w = cvt_pk_bf16(o[1][2], o[1][3]);
                    *(u32x4*)(out + off + bj * 128) = w; } }
    }
};

namespace att8 {
constexpr int NT = KVL / 64, SHMB = 8192, LDS_V0 = 3 * SHMB;
typedef int i32x8 __attribute__((ext_vector_type(8)));
#define SBAR() __builtin_amdgcn_sched_barrier(0)
__device__ __forceinline__ int crow(int r, int hi) { return (r & 3) + 8 * (r >> 2) + 4 * hi; }
__device__ __forceinline__ i32x8 ld32(const LAS unsigned char* p0, const LAS unsigned char* p1) {
    const u32x4 a = *(const LAS u32x4*)p0, b = *(const LAS u32x4*)p1; return (i32x8){(int)a.x, (int)a.y, (int)a.z, (int)a.w, (int)b.x, (int)b.y, (int)b.z, (int)b.w}; }
__device__ __forceinline__ void mfma_qk(f32x16& p, const i32x8& kf, const i32x8& qf, const f32x16& negc) {
    const unsigned s1 = 0x7f7f7f7fu, sq = 0x7b7b7b7bu;
    asm volatile("s_nop 1\n\tv_mfma_scale_f32_32x32x64_f8f6f4 %0, %1, %2, %3, %4, %5 op_sel_hi:[0,0,0]" : "=&v"(p) : "v"(kf), "v"(qf), "v"(negc), "v"(s1), "v"(sq));
}
__device__ __forceinline__ void mfma_pv(f32x16& o, const i32x8& pa, const i32x8& vf) {
    const unsigned s1 = 0x7f7f7f7fu;
    asm volatile("s_nop 2\n\tv_mfma_scale_f32_32x32x64_f8f6f4 %0, %1, %2, %0, %3, %3 op_sel_hi:[0,0,0]" : "+v"(o) : "v"(pa), "v"(vf), "v"(s1));
}
__device__ __forceinline__ void qkt(f32x16& p0, f32x16& p1, const LAS unsigned char* Kb, const i32x8& qf, const f32x16& negc, int r32, int hi, int sub) {
    const int c0 = sub * 4 + hi * 2;
    const int k0 = r32, k1 = 32 + r32;
    const i32x8 kf0 = ld32(Kb + k0 * 128 + ((c0 ^ ((k0 >> 1) & 7)) << 4), Kb + k0 * 128 + (((c0 + 1) ^ ((k0 >> 1) & 7)) << 4));
    const i32x8 kf1 = ld32(Kb + k1 * 128 + ((c0 ^ ((k1 >> 1) & 7)) << 4), Kb + k1 * 128 + (((c0 + 1) ^ ((k1 >> 1) & 7)) << 4));
    mfma_qk(p0, kf0, qf, negc); mfma_qk(p1, kf1, qf, negc);
}
__device__ __forceinline__ void mfma_wait(f32x16& p0, f32x16& p1) { asm volatile("s_nop 15\n\ts_nop 3" : "+v"(p0), "+v"(p1)); }
__device__ __forceinline__ void expA(f32x16& p) {
#pragma unroll
    for (int r = 0; r < 16; ++r) p[r] = __builtin_amdgcn_exp2f(p[r]);
}
__device__ __forceinline__ void finishSM(f32x16& p0, f32x16& p1, i32x8& pa) {
#pragma unroll
    for (int r = 0; r < 16; ++r) p1[r] = __builtin_amdgcn_exp2f(p1[r]);
#pragma unroll
    for (int j = 0; j < 4; ++j) { pa[j] = (int)pk4_fp8(p0[4 * j], p0[4 * j + 1], p0[4 * j + 2], p0[4 * j + 3]); pa[4 + j] = (int)pk4_fp8(p1[4 * j], p1[4 * j + 1], p1[4 * j + 2], p1[4 * j + 3]); }
}
__device__ __forceinline__ void pv(f32x16* o, f32x16& ol, const i32x8& ones, const LAS unsigned char* Vb, const i32x8& pa, int r32, int hi) {
    mfma_pv(ol, pa, ones);
#pragma unroll
    for (int d0 = 0; d0 < 4; ++d0) { const int d = 32 * d0 + r32, sw = (d >> 2) & 3;
        const i32x8 vf = ld32(Vb + d * 64 + (((2 * hi) ^ sw) << 4), Vb + d * 64 + (((2 * hi + 1) ^ sw) << 4));
        mfma_pv(o[d0], pa, vf); }
}
__device__ __forceinline__ void attn_unit(const unsigned char* __restrict__ Qb, const unsigned char* __restrict__ Kh, const unsigned char* __restrict__ VTh, bf16_t* MIXo,
                                          const float lam, const float* __restrict__ subg, char* lds, const int wid) {
    const int lane = lane_id(), tid = wid * 64 + lane, r32 = lane & 31, hi = lane >> 5;
    const int sub = wid >> 2, wq = wid & 3;
    const LAS unsigned char* L = (const LAS unsigned char*)(uintptr_t)(unsigned)(uintptr_t)lds;
    f32x16 o[4] = {}; f32x16 ol = {};
    i32x8 ones; { int c1 = 0x38383838; asm volatile("" : "+v"(c1)); ones = (i32x8){c1, c1, c1, c1, c1, c1, c1, c1}; }
    i32x8 qf; { const unsigned char* qp = Qb + (size_t)(wq * 32 + r32) * QKW + sub * 64 + 32 * hi; const u32x4 a = *(const u32x4*)qp, b = *(const u32x4*)(qp + 16);
        qf = (i32x8){(int)a.x, (int)a.y, (int)a.z, (int)a.w, (int)b.x, (int)b.y, (int)b.z, (int)b.w}; }
    f32x16 negc;
#pragma unroll
    for (int r = 0; r < 16; ++r) negc[r] = -5.f;
    asm volatile("" : "+v"(negc));
    long ksrc, vsrc;
    { const int r = 8 * wid + (lane >> 3), c = (lane & 7) ^ ((r >> 1) & 7); ksrc = (long)r * QKW + c * 16; }
    { const int d = 16 * wid + (lane >> 2), c = (lane & 3) ^ ((d >> 2) & 3); vsrc = (long)d * 64 + c * 16; }
    const unsigned ldsb = (unsigned)(uintptr_t)lds, kdst = ldsb + (unsigned)wid * 1024u, vdst = ldsb + LDS_V0 + (unsigned)wid * 1024u;
#define DMA_TILE(t, boff) do { \
        __builtin_amdgcn_global_load_lds((const unsigned*)(Kh + (long)(t) * 64 * QKW + ksrc), (LAS unsigned*)(uintptr_t)__builtin_amdgcn_readfirstlane(kdst + (unsigned)(boff)), 16, 0, 0); \
        __builtin_amdgcn_global_load_lds((const unsigned*)(VTh + (long)(t) * 8192 + vsrc), (LAS unsigned*)(uintptr_t)__builtin_amdgcn_readfirstlane(vdst + (unsigned)(boff)), 16, 0, 0); } while (0)
#define WBAR() do { asm volatile("s_waitcnt vmcnt(0) lgkmcnt(0)" ::: "memory"); __builtin_amdgcn_s_barrier(); asm volatile("" ::: "memory"); } while (0)
#define ROT3(x) ((x) == 2 * SHMB ? 0 : (x) + SHMB)
    f32x16 pA0, pA1, pB0, pB1; i32x8 pa;
    DMA_TILE(0, 0); WBAR();
    DMA_TILE(1, SHMB);
    qkt(pA0, pA1, L, qf, negc, r32, hi, sub); mfma_wait(pA0, pA1); expA(pA0);
    WBAR();
    int bprev = 0, bcur = SHMB, bnext = 2 * SHMB;
    for (int j = 1; j + 1 < NT; j += 2) {
        DMA_TILE(j + 1, bnext);
        SBAR(); qkt(pB0, pB1, L + bcur, qf, negc, r32, hi, sub);
        finishSM(pA0, pA1, pa); SBAR();
        pv(o, ol, ones, L + LDS_V0 + bprev, pa, r32, hi); mfma_wait(pB0, pB1); expA(pB0);
        WBAR();
        bprev = bcur; bcur = bnext; bnext = ROT3(bnext);
        if (j + 2 < NT) DMA_TILE(j + 2, bnext);
        SBAR(); qkt(pA0, pA1, L + bcur, qf, negc, r32, hi, sub);
        finishSM(pB0, pB1, pa); SBAR();
        pv(o, ol, ones, L + LDS_V0 + bprev, pa, r32, hi); mfma_wait(pA0, pA1); expA(pA0);
        WBAR();
        bprev = bcur; bcur = bnext; bnext = ROT3(bnext);
    }
    SBAR(); qkt(pB0, pB1, L + bcur, qf, negc, r32, hi, sub);
    finishSM(pA0, pA1, pa); SBAR();
    pv(o, ol, ones, L + LDS_V0 + bprev, pa, r32, hi); mfma_wait(pB0, pB1); expA(pB0);
    finishSM(pB0, pB1, pa); SBAR();
    pv(o, ol, ones, L + LDS_V0 + bcur, pa, r32, hi);
    asm volatile("s_nop 15\n\ts_nop 3" : "+v"(o[0]), "+v"(o[1]), "+v"(o[2]), "+v"(o[3]), "+v"(ol));
#undef ROT3
#undef DMA_TILE
#undef WBAR
    __syncthreads();
    float* X = (float*)lds;
    float rli[16];
#pragma unroll
    for (int r = 0; r < 16; ++r) rli[r] = __builtin_amdgcn_rcpf(ol[r]);
    if (sub == 1) {
#pragma unroll
        for (int r = 0; r < 16; ++r) { const int row = wq * 32 + crow(r, hi); const float sc = lam * rli[r];
#pragma unroll
            for (int d0 = 0; d0 < 4; ++d0) X[row * 128 + d0 * 32 + r32] = o[d0][r] * sc; }
    }
    __syncthreads();
    bf16_t* Y = (bf16_t*)(lds + 65536);
    if (sub == 0) {
        float sg[4];
#pragma unroll
        for (int d0 = 0; d0 < 4; ++d0) sg[d0] = subg[d0 * 32 + r32] * (1.f - LAM_INIT);
#pragma unroll
        for (int r = 0; r < 16; ++r) { const int row = wq * 32 + crow(r, hi);
            float v[4]; float ss = 0.f;
#pragma unroll
            for (int d0 = 0; d0 < 4; ++d0) { v[d0] = o[d0][r] * rli[r] - X[row * 128 + d0 * 32 + r32]; ss += v[d0] * v[d0]; }
            ss += __shfl_xor(ss, 1); ss += __shfl_xor(ss, 2); ss += __shfl_xor(ss, 4); ss += __shfl_xor(ss, 8); ss += __shfl_xor(ss, 16);
            const float rstd = rsqrtf(ss * (1.f / 128.f) + EPS);
#pragma unroll
            for (int d0 = 0; d0 < 4; ++d0) Y[row * 128 + d0 * 32 + r32] = (bf16_t)(cvt_pk_bf16(v[d0] * rstd * sg[d0], 0.f) & 0xffffu); }
    }
    __syncthreads();
    { const int row = tid >> 2, seg = (tid & 3) * 32;
#pragma unroll
        for (int i = 0; i < 4; ++i) { const u32x4 v = *(const u32x4*)(Y + row * 128 + seg + i * 8); *(u32x4*)(MIXo + (size_t)row * DM + seg + i * 8) = v; } }
    __syncthreads();
}
#undef SBAR
}

__device__ __forceinline__ void p3_attention8(Frame& F) {
    FT_DECL;
    const float* sc = WSP(float, WS_SMALL + SM_SCAL);
    const float lam = sc[0];
    const unsigned char* Q8 = WSP(unsigned char, WS_Q); const unsigned char* K8 = WSP(unsigned char, WS_K); const unsigned char* VT8 = WSP(unsigned char, WS_V); bf16_t* MIX = WSP(bf16_t, WS_MIX);
    const int c = blockIdx.x, xcd = c & 7, ci = c >> 3, per = F.G >> 3;
    for (int j = ci; j < 128; j += per) {
        const int pair = xcd * 4 + (j >> 5), qb = j & 31, b = pair >> 2, h = pair & 3;
        att8::attn_unit(Q8 + ((size_t)b * SEQ + qb * 128) * QKW + h * 128, K8 + (size_t)b * KVL * QKW + h * 128, VT8 + (size_t)(b * NHEAD + h) * 68 * 8192,
                        MIX + ((size_t)b * SEQ + qb * 128) * DM + h * 128, lam, F.in[15], (char*)F.lds, F.wave);
    }
}

namespace hy {
constexpr int RB_BYTES = 4352 * 8, IN_OFF = 2 * RB_BYTES, TW1_OFF = IN_OFF + 32768, TW2_OFF = TW1_OFF + 15 * 256 * 8, LDS_END = TW2_OFF + 15 * 16 * 8;
__device__ __forceinline__ f32x2 cmul(f32x2 a, f32x2 b) { return (f32x2){a.x * b.x - a.y * b.y, a.x * b.y + a.y * b.x}; }
__device__ __forceinline__ f32x2 cmulc(f32x2 a, f32x2 b) { return (f32x2){a.x * b.x + a.y * b.y, a.y * b.x - a.x * b.y}; }
__device__ __forceinline__ int P(int i) { return i + (i >> 4); }
template <bool INV> __device__ __forceinline__ void r4(f32x2& a, f32x2& b, f32x2& c, f32x2& d) {
    const f32x2 t0 = a + c, t1 = a - c, t2 = b + d, t3 = b - d;
    const f32x2 st3 = INV ? (f32x2){-t3.y, t3.x} : (f32x2){t3.y, -t3.x};
    a = t0 + t2; c = t0 - t2; b = t1 + st3; d = t1 - st3;
}
template <bool INV> __device__ __forceinline__ f32x2 tw(f32x2 v, float c, float s) {
    return INV ? (f32x2){v.x * c - v.y * s, v.y * c + v.x * s} : (f32x2){v.x * c + v.y * s, v.y * c - v.x * s};
}
template <bool INV> __device__ __forceinline__ void dft16(f32x2 (&v)[16]) {
    constexpr float C1 = 0.9238795325112867f, S1 = 0.3826834323650898f, R2 = 0.7071067811865476f;
    r4<INV>(v[0], v[4], v[8], v[12]); r4<INV>(v[1], v[5], v[9], v[13]); r4<INV>(v[2], v[6], v[10], v[14]); r4<INV>(v[3], v[7], v[11], v[15]);
    v[5] = tw<INV>(v[5], C1, S1);  v[9] = tw<INV>(v[9], R2, R2);    v[13] = tw<INV>(v[13], S1, C1);
    v[6] = tw<INV>(v[6], R2, R2);  v[10] = tw<INV>(v[10], 0.f, 1.f); v[14] = tw<INV>(v[14], -R2, R2);
    v[7] = tw<INV>(v[7], S1, C1);  v[11] = tw<INV>(v[11], -R2, R2);  v[15] = tw<INV>(v[15], -C1, -S1);
    r4<INV>(v[0], v[1], v[2], v[3]); r4<INV>(v[4], v[5], v[6], v[7]); r4<INV>(v[8], v[9], v[10], v[11]); r4<INV>(v[12], v[13], v[14], v[15]);
    f32x2 t;
    t = v[1]; v[1] = v[4]; v[4] = t;   t = v[2]; v[2] = v[8]; v[8] = t;    t = v[3]; v[3] = v[12]; v[12] = t;
    t = v[6]; v[6] = v[9]; v[9] = t;   t = v[7]; v[7] = v[13]; v[13] = t;  t = v[11]; v[11] = v[14]; v[14] = t;
}
struct Ctx { LAS f32x2* R; LAS f32x2* IN; LAS f32x2* TW1; LAS f32x2* TW2; int t, half; f32x2 wt; };
#define HY_OPAQUE(x) asm volatile("" : "+v"(x))
#define HY_W32(m) (f32x2){__builtin_cosf(-0.19634954084936207f * (m)), __builtin_sinf(-0.19634954084936207f * (m))}
template <int MODE> __device__ __forceinline__ void pass1_fwd(const Ctx& X) {
    f32x2 v[16]; int t = X.t; HY_OPAQUE(t);
#pragma unroll
    for (int m = 0; m < 16; ++m) { f32x2 a = X.IN[t + 256 * m]; if (MODE == 1) a = (f32x2){X.half ? a.y : a.x, 0.f}; v[m] = a; }
    if (X.half) {
#pragma unroll
        for (int m = 0; m < 16; ++m) v[m] = cmul(cmul(v[m], HY_W32(m)), X.wt);
    }
    dft16<false>(v);
#pragma unroll
    for (int q = 1; q < 16; ++q) v[q] = cmul(v[q], X.TW1[(q - 1) * 256 + t]);
    const int pb = t + (t >> 4);
#pragma unroll
    for (int q = 0; q < 16; ++q) X.R[pb + 272 * q] = v[q];
}
__device__ __forceinline__ void pass2_fwd(const Ctx& X) {
    int t = X.t; HY_OPAQUE(t);
    const int n2 = t & 15, pb = (t >> 4) * 272 + n2; f32x2 v[16];
#pragma unroll
    for (int m = 0; m < 16; ++m) v[m] = X.R[pb + 17 * m];
    dft16<false>(v);
#pragma unroll
    for (int q = 1; q < 16; ++q) v[q] = cmul(v[q], X.TW2[(q - 1) * 16 + n2]);
#pragma unroll
    for (int q = 0; q < 16; ++q) X.R[pb + 17 * q] = v[q];
}
template <bool FILTER> __device__ __forceinline__ void pass3(const Ctx& X, f32x2 (&H)[16]) {
    f32x2 v[16]; int t = X.t; HY_OPAQUE(t); const int pb = 17 * t;
#pragma unroll
    for (int m = 0; m < 16; ++m) v[m] = X.R[pb + m];
    dft16<false>(v);
    if (FILTER) {
#pragma unroll
        for (int q = 0; q < 16; ++q) H[q] = v[q] * (1.f / 8192.f);
    } else {
#pragma unroll
        for (int q = 0; q < 16; ++q) v[q] = cmul(v[q], H[q]);
        dft16<true>(v);
#pragma unroll
        for (int m = 0; m < 16; ++m) X.R[pb + m] = v[m];
    }
}
__device__ __forceinline__ void pass2_inv(const Ctx& X) {
    int t = X.t; HY_OPAQUE(t);
    const int n2 = t & 15, pb = (t >> 4) * 272 + n2; f32x2 v[16];
    v[0] = X.R[pb];
#pragma unroll
    for (int q = 1; q < 16; ++q) v[q] = cmulc(X.R[pb + 17 * q], X.TW2[(q - 1) * 16 + n2]);
    dft16<true>(v);
#pragma unroll
    for (int m = 0; m < 16; ++m) X.R[pb + 17 * m] = v[m];
}
__device__ __forceinline__ void pass1_inv(const Ctx& X) {
    f32x2 v[16]; int t = X.t; HY_OPAQUE(t); const int pb = t + (t >> 4);
    v[0] = X.R[pb];
#pragma unroll
    for (int q = 1; q < 16; ++q) v[q] = cmulc(X.R[pb + 272 * q], X.TW1[(q - 1) * 256 + t]);
    dft16<true>(v);
    if (X.half) {
#pragma unroll
        for (int m = 0; m < 16; ++m) v[m] = cmulc(cmulc(v[m], HY_W32(m)), X.wt);
    }
#pragma unroll
    for (int m = 0; m < 16; ++m) X.R[pb + 272 * m] = v[m];
}
#define HY_WSYNC() asm volatile("s_waitcnt lgkmcnt(0)" ::: "memory")
__device__ __forceinline__ void conv_fft(const Ctx& X, f32x2 (&H)[16]) {
    __syncthreads(); pass1_fwd<0>(X); __syncthreads(); pass2_fwd(X); HY_WSYNC(); pass3<false>(X, H); HY_WSYNC(); pass2_inv(X); __syncthreads(); pass1_inv(X); __syncthreads();
}
constexpr int STG_OFF = LDS_END;
constexpr int LDS_END2 = STG_OFF + 2 * SEQ * 2;
static_assert(LDS_END2 <= LDSCTL_OFF, "hyena LDS map");
__device__ __forceinline__ float sconv_lds(const LAS bf16_t* stg, int bs, int n, float w0, float w1, float w2, float bias) {
    const LAS bf16_t* p = stg + bs * SEQ;
    const float c = bf2f(p[n]), lv = bf2f(p[n - ((n > 0) ? 1 : 0)]), rv = bf2f(p[n + ((n < SEQ - 1) ? 1 : 0)]);
    const float l = (n > 0) ? lv : 0.f, r = (n < SEQ - 1) ? rv : 0.f;
    return bias + w0 * l + w1 * c + w2 * r;
}
__device__ __forceinline__ void setup_tables(LAS unsigned char* lds, int tid) {
    LAS f32x2* TW1 = (LAS f32x2*)(lds + TW1_OFF); LAS f32x2* TW2 = (LAS f32x2*)(lds + TW2_OFF);
    for (int i = tid; i < 15 * 256; i += 512) { const int q = i / 256 + 1, t = i & 255; float s, c; sincosf(-6.283185307179586f * (float)((t * q) & 4095) * (1.f / 4096.f), &s, &c); TW1[i] = (f32x2){c, s}; }
    for (int i = tid; i < 15 * 16; i += 512) { const int q = i / 16 + 1, n2 = i & 15; float s, c; sincosf(-6.283185307179586f * (float)((n2 * q) & 255) * (1.f / 256.f), &s, &c); TW2[i] = (f32x2){c, s}; }
}
__device__ __forceinline__ void unit(Frame& F, int c) {
    FT_DECL;
    const int tid = f_tid; Ctx X; X.half = F.wave >> 2; X.t = tid & 255;
    X.R = (LAS f32x2*)(F.lds + X.half * RB_BYTES); X.IN = (LAS f32x2*)(F.lds + IN_OFF); X.TW1 = (LAS f32x2*)(F.lds + TW1_OFF); X.TW2 = (LAS f32x2*)(F.lds + TW2_OFF);
    { float s, cc; sincosf(-6.283185307179586f * (float)X.t * (1.f / 8192.f), &s, &cc); X.wt = (f32x2){cc, s}; }
    LAS f32x2* RB0 = (LAS f32x2*)(F.lds); LAS f32x2* RB1 = (LAS f32x2*)(F.lds + RB_BYTES);
    const float* FILT = WSP(float, WS_FILT);
    f32x2 H0[16], H1[16];
#pragma unroll
    for (int ord = 0; ord < 2; ++ord) {
        const float* hf = FILT + ((size_t)(ord * 2 + 0) * 512 + c) * SEQ; const float* hb = FILT + ((size_t)(ord * 2 + 1) * 512 + c) * SEQ;
        __syncthreads();
        int nb = tid; HY_OPAQUE(nb);
#pragma unroll
        for (int j = 0; j < 8; ++j) { const int n = nb + 512 * j; const float a = hf[n], b = hb[(SEQ - n) & (SEQ - 1)]; const float lo = (n == 0) ? a + b : a, hi = (n == 0) ? 0.f : b; X.IN[n] = (f32x2){lo + hi, lo - hi}; }
        __syncthreads(); pass1_fwd<1>(X); __syncthreads(); pass2_fwd(X); HY_WSYNC();
        if (ord == 0) pass3<true>(X, H0); else pass3<true>(X, H1);
    }
    const bf16_t* UT = WSP(bf16_t, WS_UT);
    const bf16_t* rv = UT + (size_t)c * 128; const bf16_t* r1 = UT + (size_t)(512 + c) * 128; const bf16_t* r2 = UT + (size_t)(1024 + c) * 128;
#define HY_LD(rowp, t) (*(const u32x4*)((rowp) + (size_t)((t) >> 7) * (HYC * 128) + ((t) & 127)))
    const float* cw = F.in[16]; const float* cb = F.in[17];
    const float wv0 = cw[c], wv1 = cw[HYC + c], wv2 = cw[2 * HYC + c], bv = cb[c];
    const float wa0 = cw[512 + c], wa1 = cw[HYC + 512 + c], wa2 = cw[2 * HYC + 512 + c], ba = cb[512 + c];
    const float wb0 = cw[1024 + c], wb1 = cw[HYC + 1024 + c], wb2 = cw[2 * HYC + 1024 + c], bb = cb[1024 + c];
    const float sk0 = F.in[25][c], sk1 = F.in[25][512 + c];
    bf16_t* Z = WSP(bf16_t, WS_Z2T) + (size_t)c * 128;
    LAS bf16_t* STG = (LAS bf16_t*)(F.lds + STG_OFF);
    u32x4 g0 = HY_LD(rv, tid * 8), g1 = HY_LD(rv, SEQ + tid * 8);
    for (int pr = 0; pr < 4; ++pr) {
        const int b0 = 2 * pr, b1 = b0 + 1;
        f32x2 z[8]; int pc = tid + (tid >> 4); HY_OPAQUE(pc); int nb = tid; HY_OPAQUE(nb);
        __syncthreads();
        *(LAS u32x4*)(STG + tid * 8) = g0; *(LAS u32x4*)(STG + SEQ + tid * 8) = g1;
        __syncthreads();
#pragma unroll
        for (int j = 0; j < 8; ++j) { const int n = nb + 512 * j; z[j] = (f32x2){sconv_lds(STG, 0, n, wv0, wv1, wv2, bv), sconv_lds(STG, 1, n, wv0, wv1, wv2, bv)}; X.IN[n] = z[j]; }
        g0 = HY_LD(r1, b0 * SEQ + tid * 8); g1 = HY_LD(r1, b1 * SEQ + tid * 8);
        conv_fft(X, H0);
        *(LAS u32x4*)(STG + tid * 8) = g0; *(LAS u32x4*)(STG + SEQ + tid * 8) = g1;
        __syncthreads();
        HY_OPAQUE(nb); HY_OPAQUE(pc);
#pragma unroll
        for (int j = 0; j < 8; ++j) { const int n = nb + 512 * j; const f32x2 y = RB0[pc + 544 * j] + RB1[pc + 544 * j];
            const f32x2 g = (f32x2){sconv_lds(STG, 0, n, wa0, wa1, wa2, ba), sconv_lds(STG, 1, n, wa0, wa1, wa2, ba)};
            z[j] = g * (y + sk0 * z[j]); X.IN[n] = z[j]; }
        g0 = HY_LD(r2, b0 * SEQ + tid * 8); g1 = HY_LD(r2, b1 * SEQ + tid * 8);
        conv_fft(X, H1);
        *(LAS u32x4*)(STG + tid * 8) = g0; *(LAS u32x4*)(STG + SEQ + tid * 8) = g1;
        __syncthreads();
        if (pr < 3) { g0 = HY_LD(rv, (b0 + 2) * SEQ + tid * 8); g1 = HY_LD(rv, (b1 + 2) * SEQ + tid * 8); }
        HY_OPAQUE(nb); HY_OPAQUE(pc);
        f32x2 o[8];
#pragma unroll
        for (int j = 0; j < 8; ++j) { const int n = nb + 512 * j; const f32x2 y = RB0[pc + 544 * j] + RB1[pc + 544 * j];
            const f32x2 g = (f32x2){sconv_lds(STG, 0, n, wb0, wb1, wb2, bb), sconv_lds(STG, 1, n, wb0, wb1, wb2, bb)};
            o[j] = g * (y + sk1 * z[j]); }
        __syncthreads();
#pragma unroll
        for (int j = 0; j < 8; ++j) { const int n = nb + 512 * j; STG[n] = (bf16_t)(cvt_pk_bf16(o[j].x, 0.f) & 0xffffu); STG[SEQ + n] = (bf16_t)(cvt_pk_bf16(o[j].y, 0.f) & 0xffffu); }
        __syncthreads();
        { const int t0 = b0 * SEQ + tid * 8, t1 = b1 * SEQ + tid * 8;
          *(u32x4*)(Z + (size_t)(t0 >> 7) * (HYW * 128) + (t0 & 127)) = *(const LAS u32x4*)(STG + tid * 8); *(u32x4*)(Z + (size_t)(t1 >> 7) * (HYW * 128) + (t1 & 127)) = *(const LAS u32x4*)(STG + SEQ + tid * 8); }
    }
    __syncthreads();
}
}

__device__ __forceinline__ void p3_hyena(Frame& F) {
    FT_DECL;
    __syncthreads();
    hy::setup_tables(F.lds, f_tid);
    __syncthreads();
    for (int c = F.vcu; c < HYW; c += F.G) hy::unit(F, c);
}

__device__ __forceinline__ void p4_hynorm(Frame& F) {
    FT_DECL;
    const bf16_t* Z = WSP(bf16_t, WS_Z2T); bf16_t* MIX = WSP(bf16_t, WS_MIX); const float* g = F.in[26];
    constexpr int TP = 132;
    LAS bf16_t* T = (LAS bf16_t*)F.lds;
    LAS float* red = (LAS float*)(F.lds + 512 * TP * 2);
    LAS float* rs = red + 512;
    float gl[8];
#pragma unroll
    for (int e = 0; e < 8; ++e) gl[e] = g[(f_tid & 63) + 64 * e];
    for (int it = F.vcu; it < MROWS / 128; it += F.G) {
        const int tok0 = it * 128; const bf16_t* zt = Z + (size_t)it * (HYW * 128);
        __syncthreads();
        u32x4 v[16];
#pragma unroll
        for (int j = 0; j < 16; ++j) v[j] = __builtin_nontemporal_load((const u32x4*)(zt + (size_t)(f_tid + 512 * j) * 8));
#pragma unroll
        for (int j = 0; j < 16; ++j) { const int i = f_tid + 512 * j; LAS u32x2* d = (LAS u32x2*)(T + (i >> 4) * TP + (i & 15) * 8); d[0] = (u32x2){v[j].x, v[j].y}; d[1] = (u32x2){v[j].z, v[j].w}; }
        __syncthreads();
        { const int tok = f_tid & 127, grp = f_tid >> 7; float ss = 0.f;
#pragma unroll 8
            for (int k = 0; k < 128; ++k) { const float x = bf2f(T[(grp * 128 + k) * TP + tok]); ss += x * x; }
            red[grp * 128 + tok] = ss; }
        __syncthreads();
        if (f_tid < 128) rs[f_tid] = rsqrtf(((red[f_tid] + red[128 + f_tid]) + (red[256 + f_tid] + red[384 + f_tid])) * (1.f / HYW) + EPS);
        __syncthreads();
#pragma unroll
        for (int j = 0; j < 16; ++j) { const int i = f_tid + 512 * j, tok = i >> 6, l = i & 63; const float r = rs[tok];
            float x[8];
#pragma unroll
            for (int e = 0; e < 8; ++e) x[e] = bf2f(T[(l + 64 * e) * TP + tok]) * r * gl[e];
            u32x4 w; w.x = cvt_pk_bf16(x[0], x[1]); w.y = cvt_pk_bf16(x[2], x[3]); w.z = cvt_pk_bf16(x[4], x[5]); w.w = cvt_pk_bf16(x[6], x[7]);
            *(u32x4*)(MIX + (size_t)(tok0 + tok) * DM + 512 + 8 * l) = w; }
    }
}

constexpr size_t RT_TOPI = 0;
constexpr size_t RT_GATE = 512 * 1024;
constexpr size_t RT_POS = 1024 * 1024;
constexpr size_t RT_WGCNT = 1536 * 1024;
constexpr size_t RT_META = 1600 * 1024;
constexpr size_t RT_LIST = 2048 * 1024;
constexpr size_t RT_GSLOT = 2048 * 1024 + 640 * 1024;
constexpr int MAXSLOT = MROWS * TOPK + NEXP * 256;
constexpr int MAXTILE = MAXSLOT / 256;
constexpr size_t WS_XS = WS_EO;
constexpr int RW_PITCH = 32;
constexpr int P6_LDS_TOPI = 1024 * RW_PITCH * 4;

__device__ __forceinline__ void p6_router_mfma(Frame& F) {
    FT_DECL;
#define in F.in
    LAS float* WP = (LAS float*)F.lds;
    LAS int* TI = (LAS int*)(F.lds + P6_LDS_TOPI);
    LAS int* PS = TI + 512;
    LAS int* SC = PS + 512;
    LAS float* RSTD = (LAS float*)(SC + 512);
    LAS float* BIAS = RSTD + 128;
    LAS float* SSX = BIAS + 32;
    const float* rw = in[28]; const float* mod = WSP(float, WS_SMALL + SM_MOD); const float* g2n = in[7]; const float* rb = in[29];
    const bf16_t* XN = WSP(bf16_t, WS_XN); unsigned char* H2 = WSP(unsigned char, WS_H);
    int* topi_g = WSP(int, WS_ROUTE + RT_TOPI); float* gate_g = WSP(float, WS_ROUTE + RT_GATE); int* pos_g = WSP(int, WS_ROUTE + RT_POS); int* wgcnt = WSP(int, WS_ROUTE + RT_WGCNT);
    for (int blk = blockIdx.x; blk < MROWS / 128; blk += F.G) {
        const float* sh2 = mod + (size_t)(blk >> 5) * (NMOD * DM) + 3 * DM; const float* sc2 = sh2 + DM;
        __syncthreads();
        for (int i = f_tid; i < 1024 * 8; i += 512) { const int k = i >> 3, c4 = i & 7; const float gm = g2n[k] * (1.f + sc2[k]);
            *(LAS f32x4*)(WP + k * 32 + c4 * 4) = *(const f32x4*)(rw + (size_t)k * 32 + c4 * 4) * gm; }
        { const int e = f_tid & 31, part = f_tid >> 5; float a = 0.f;
            for (int k = part * 64; k < part * 64 + 64; ++k) a += sh2[k] * rw[(size_t)k * 32 + e];
            ((LAS float*)SC)[part * 32 + e] = a; }
        __syncthreads();
        if (f_tid < 32) { float a = rb[f_tid];
#pragma unroll
            for (int p = 0; p < 16; ++p) a += ((LAS float*)SC)[p * 32 + f_tid];
            BIAS[f_tid] = a; }
        const int rg = F.wave & 3, kh = F.wave >> 2, j = f_lane & 31, hi = f_lane >> 5;
        f32x16 acc = {};
        float ss = 0.f;
        { const bf16_t* xrow = XN + (size_t)(blk * 128 + rg * 32 + j) * DM + 512 * kh + 8 * hi;
            const LAS float* wp = WP + (512 * kh + 8 * hi) * 32 + j;
#pragma unroll 4
            for (int c = 0; c < 32; ++c) { const u32x4 xb = *(const u32x4*)(xrow + 16 * c);
                float xf[8] = {__uint_as_float(xb.x << 16), __uint_as_float(xb.x & 0xffff0000u), __uint_as_float(xb.y << 16), __uint_as_float(xb.y & 0xffff0000u),
                               __uint_as_float(xb.z << 16), __uint_as_float(xb.z & 0xffff0000u), __uint_as_float(xb.w << 16), __uint_as_float(xb.w & 0xffff0000u)};
#pragma unroll
                for (int q = 0; q < 8; ++q) { ss += xf[q] * xf[q]; acc = __builtin_amdgcn_mfma_f32_32x32x2f32(wp[(16 * c + q) * 32], xf[q], acc, 0, 0, 0); } } }
        { auto rr = __builtin_amdgcn_permlane32_swap(__float_as_uint(ss), __float_as_uint(ss), false, false); ss = __uint_as_float(rr[0]) + __uint_as_float(rr[1]); }
        if (hi == 0) SSX[kh * 128 + rg * 32 + j] = ss;
        __syncthreads();
        if (kh == 1) {
#pragma unroll
            for (int r = 0; r < 16; ++r) WP[(rg * 16 + r) * 64 + f_lane] = acc[r]; }
        if (f_tid < 128) RSTD[f_tid] = rsqrtf((SSX[f_tid] + SSX[128 + f_tid]) * (1.f / DM) + EPS);
        __syncthreads();
        if (kh == 0) {
            const float rstd = RSTD[rg * 32 + j];
            float tv[4] = {-INFINITY, -INFINITY, -INFINITY, -INFINITY}; int ti[4] = {1 << 20, 1 << 20, 1 << 20, 1 << 20};
#define P6_INS(V, E) do { float cv = (V); int ce = (E); _Pragma("unroll") for (int q = 0; q < 4; ++q) { const bool b = cv > tv[q] || (cv == tv[q] && ce < ti[q]); \
                const float nv = b ? tv[q] : cv; const int ne = b ? ti[q] : ce; tv[q] = b ? cv : tv[q]; ti[q] = b ? ce : ti[q]; cv = nv; ce = ne; } } while (0)
#pragma unroll
            for (int r = 0; r < 16; ++r) { const int e = (r & 3) + 8 * (r >> 2) + 4 * hi; const float v = (acc[r] + WP[(rg * 16 + r) * 64 + f_lane]) * rstd + BIAS[e]; P6_INS(v, e); }
            float ov[4]; int oe[4];
#pragma unroll
            for (int q = 0; q < 4; ++q) { ov[q] = __shfl_xor(tv[q], 32); oe[q] = __shfl_xor(ti[q], 32); }
#pragma unroll
            for (int q = 0; q < 4; ++q) P6_INS(ov[q], oe[q]);
#undef P6_INS
            if (hi == 0) { const int rl = rg * 32 + j, r = blk * 128 + rl;
                const float e1 = __expf(tv[1] - tv[0]), e2 = __expf(tv[2] - tv[0]), e3 = __expf(tv[3] - tv[0]); const float inv = 1.f / (1.f + e1 + e2 + e3);
                typedef int i32x4_t __attribute__((ext_vector_type(4))); const i32x4_t t4 = {ti[0], ti[1], ti[2], ti[3]};
                *(i32x4_t*)(topi_g + (size_t)r * 4) = t4; *(f32x4*)(gate_g + (size_t)r * 4) = (f32x4){inv, e1 * inv, e2 * inv, e3 * inv};
                *(LAS i32x4_t*)(TI + rl * 4) = t4; }
        }
        __syncthreads();
        { const int t2 = F.wave * 64 + lane_id(); const int e = t2 & 31, seg = t2 >> 5; int cnt = 0;
#pragma unroll 4
            for (int i = 0; i < 32; ++i) cnt += (TI[seg * 32 + i] == e) ? 1 : 0;
            SC[seg * 32 + e] = cnt;
            __syncthreads();
            int pre = 0;
            for (int s2 = 0; s2 < seg; ++s2) pre += SC[s2 * 32 + e];
            if (seg == 15) wgcnt[blk * 32 + e] = pre + cnt;
            for (int i = 0; i < 32; ++i) if (TI[seg * 32 + i] == e) { PS[seg * 32 + i] = pre; ++pre; }
        }
        __syncthreads();
        { const int t3 = F.wave * 64 + lane_id(); pos_g[(size_t)blk * 512 + t3] = PS[t3]; }
        { const int lane = lane_id();
            f32x4 PA[4], PB[4];
#pragma unroll
            for (int jj = 0; jj < 4; ++jj) { const int c = 4 * lane + 256 * jj; PA[jj] = *(const f32x4*)(g2n + c) * (*(const f32x4*)(sc2 + c) + 1.f); PB[jj] = *(const f32x4*)(sh2 + c); }
            for (int it = 0; it < 4; ++it) { u32x2 xb[4][4];
#pragma unroll
                for (int u = 0; u < 4; ++u) { const GAS u32x2* xr = (const GAS u32x2*)(XN + (size_t)(blk * 128 + F.wave * 16 + 4 * it + u) * DM) + lane;
#pragma unroll
                    for (int jj = 0; jj < 4; ++jj) xb[u][jj] = xr[64 * jj]; }
#pragma unroll
                for (int u = 0; u < 4; ++u) { const int rl = F.wave * 16 + 4 * it + u; const float rstd = RSTD[rl];
                    GAS unsigned* o4 = (GAS unsigned*)(H2 + (size_t)(blk * 128 + rl) * DM) + lane;
#pragma unroll
                    for (int jj = 0; jj < 4; ++jj) {
                        const f32x4 x = (f32x4){__uint_as_float(xb[u][jj].x << 16), __uint_as_float(xb[u][jj].x & 0xffff0000u), __uint_as_float(xb[u][jj].y << 16), __uint_as_float(xb[u][jj].y & 0xffff0000u)};
                        const f32x4 h = x * rstd * PA[jj] + PB[jj];
                        o4[64 * jj] = pk4_fp8(h.x, h.y, h.z, h.w); } } }
        }
    }
#undef in
}

__device__ __forceinline__ void p7_scatter(Frame& F) {
    FT_DECL;
    LAS int* TOT = (LAS int*)F.lds;
    LAS int* BASE = TOT + 32;
    LAS int* PRE = BASE + 32;
    LAS int* PART = PRE + 32;
    const int* wgcnt = WSP(int, WS_ROUTE + RT_WGCNT); const int* topi_g = WSP(int, WS_ROUTE + RT_TOPI); const float* gate_g = WSP(float, WS_ROUTE + RT_GATE); const int* pos_g = WSP(int, WS_ROUTE + RT_POS);
    int* list = WSP(int, WS_ROUTE + RT_LIST); float* gslot = WSP(float, WS_ROUTE + RT_GSLOT); int* meta = WSP(int, WS_ROUTE + RT_META);
    for (int blk = blockIdx.x; blk < MROWS / 128; blk += F.G) {
        __syncthreads();
        { const int e = f_tid & 31, part = f_tid >> 5; int st = 0, sp = 0;
            for (int w = part * 16; w < part * 16 + 16; ++w) { const int c = wgcnt[w * 32 + e]; st += c; if (w < blk) sp += c; }
            PART[part * 32 + e] = st; PART[512 + part * 32 + e] = sp; }
        __syncthreads();
        if (f_tid < 32) { int st = 0, sp = 0;
#pragma unroll
            for (int p = 0; p < 16; ++p) { st += PART[p * 32 + f_tid]; sp += PART[512 + p * 32 + f_tid]; }
            TOT[f_tid] = st; PRE[f_tid] = sp; }
        __syncthreads();
        if (f_tid == 0) { int b = 0; for (int e = 0; e < 32; ++e) { BASE[e] = b; b += (TOT[e] + 255) & ~255; }
            if (blk == 0) { int t = 0; for (int e = 0; e < 32; ++e) { meta[e] = TOT[e]; meta[32 + e] = BASE[e]; const int nt = (TOT[e] + 255) >> 8; for (int q = 0; q < nt; ++q) meta[128 + t + q] = e; t += nt; } meta[64] = t; } }
        __syncthreads();
        { const int a = f_tid, row = blk * 128 + (a >> 2); const int e = topi_g[(size_t)blk * 512 + a]; const int slot = BASE[e] + PRE[e] + pos_g[(size_t)blk * 512 + a];
            list[slot] = row * 4 + (a & 3); gslot[slot] = gate_g[(size_t)blk * 512 + a];
            PART[a] = slot; }
        __syncthreads();
        if (blk < NEXP) { const int e = blk, lo = BASE[e] + TOT[e], hi = BASE[e] + ((TOT[e] + 255) & ~255);
            for (int sl = lo + f_tid; sl < hi; sl += 512) { list[sl] = -1; gslot[sl] = 0.f; } }
    }
}

template <int NPN> struct SchedMoE {
    int G, c, nT; const char* A; const char* W; size_t wstride; const LAS unsigned char* tileE; const LAS int* RW; bool gath;
    __device__ __forceinline__ const LAS int* rows(int i) const { return RW + i * 256; }
    __device__ __forceinline__ bool next(int i, g8::Unit& u) const {
        const int L = i * G + c, xcd = L & 7, j = L >> 3, T = (j / NPN) * 8 + xcd, pn = j % NPN;
        if (T >= nT) return false;
        const int e = tileE[T];
        u.pm = T; u.pn = pn; u.kind = i; u.ex = e; u.a = gath ? A : A + (size_t)T * 256 * DM; u.b = W + (size_t)e * wstride + (size_t)pn * 256 * DM; return true;
    }
};
struct EpiSwiGLU {
    unsigned char* ACT; const float* b1;
    __device__ __forceinline__ void operator()(f32x4 (&acc)[2][2][4][2], const g8::Unit& u, int wr, int wc, int fr, int fq) const {
        asm volatile("" : "+v"(fr), "+v"(fq));
        const int j0 = u.pn * 128 + wc * 32 + 8 * fq; const float* bp = b1 + (size_t)u.ex * 2 * DM + j0;
        f32x4 bg[2], bl[2];
#pragma unroll
        for (int n = 0; n < 2; ++n) { bg[n] = *(const f32x4*)(bp + 4 * n); bl[n] = *(const f32x4*)(bp + DM + 4 * n); }
#pragma unroll
        for (int ai = 0; ai < 2; ++ai)
#pragma unroll
            for (int m = 0; m < 4; ++m) { const size_t slot = (size_t)u.pm * 256 + ai * 128 + wr * 64 + m * 16 + fr; float o[8];
#pragma unroll
                for (int n = 0; n < 2; ++n) { const f32x4 g4 = acc[ai][0][m][n] * (1.f / WSCALE) + bg[n], l4 = acc[ai][1][m][n] * (1.f / WSCALE) + bl[n];
#pragma unroll
                    for (int e = 0; e < 4; ++e) { const float g = fminf(g4[e], 7.f), l = __builtin_amdgcn_fmed3f(l4[e], -7.f, 7.f);
                        const float ex = __builtin_amdgcn_exp2f(g * (-1.702f * 1.4426950408889634f)); const float glu = g * __builtin_amdgcn_rcpf(1.f + ex);
                        o[4 * n + e] = fmaf(l, glu, glu); } }
                u32x2 w; w.x = pk4_fp8(o[0], o[1], o[2], o[3]); w.y = pk4_fp8(o[4], o[5], o[6], o[7]);
                *(u32x2*)(ACT + slot * DM + j0) = w; }
    }
};
struct EpiDown {
    unsigned char* EO; const float* b2; const LAS int* LL; int G, c;
    __device__ __forceinline__ void operator()(f32x4 (&acc)[2][2][4][2], const g8::Unit& u, int wr, int wc, int fr, int fq) const {
        asm volatile("" : "+v"(fr), "+v"(fq));
        const int c0 = u.pn * 256 + wc * 64 + 16 * fq; const float* bp = b2 + (size_t)u.ex * DM + c0;
        f32x4 bb[2][2];
#pragma unroll
        for (int bj = 0; bj < 2; ++bj)
#pragma unroll
            for (int n = 0; n < 2; ++n) bb[bj][n] = *(const f32x4*)(bp + bj * 8 + 4 * n);
        const LAS int* L = LL + u.kind * 512;
        int li[8]; float gt[8];
#pragma unroll
        for (int q = 0; q < 8; ++q) { const int rl = (q >> 2) * 128 + wr * 64 + (q & 3) * 16 + fr; li[q] = L[rl]; gt[q] = __int_as_float(L[256 + rl]) * (1.f / WSCALE); }
#pragma unroll
        for (int ai = 0; ai < 2; ++ai)
#pragma unroll
            for (int m = 0; m < 4; ++m) { const int l = li[ai * 4 + m]; const float g = gt[ai * 4 + m];
                unsigned char* dst = EO + ((size_t)(l & 3) * MROWS + (l >> 2)) * DM + c0;
                u32x4 w;
                { const f32x4 v0 = acc[ai][0][m][0] * g + bb[0][0] * (g * WSCALE), v1 = acc[ai][0][m][1] * g + bb[0][1] * (g * WSCALE);
                  w.x = pk4_fp8(v0[0] * EOSCALE, v0[1] * EOSCALE, v0[2] * EOSCALE, v0[3] * EOSCALE); w.y = pk4_fp8(v1[0] * EOSCALE, v1[1] * EOSCALE, v1[2] * EOSCALE, v1[3] * EOSCALE); }
                { const f32x4 v0 = acc[ai][1][m][0] * g + bb[1][0] * (g * WSCALE), v1 = acc[ai][1][m][1] * g + bb[1][1] * (g * WSCALE);
                  w.z = pk4_fp8(v0[0] * EOSCALE, v0[1] * EOSCALE, v0[2] * EOSCALE, v0[3] * EOSCALE); w.w = pk4_fp8(v1[0] * EOSCALE, v1[1] * EOSCALE, v1[2] * EOSCALE, v1[3] * EOSCALE); }
                if (l >= 0) *(u32x4*)dst = w; }
    }
};
__device__ __forceinline__ const LAS unsigned char* moe_tiles(Frame& F, int& nT) {
    FT_DECL;
    LAS unsigned char* TE = (LAS unsigned char*)(F.lds + RING_BYTES); const int* meta = WSP(int, WS_ROUTE + RT_META);
    __syncthreads();
    nT = meta[64]; if (nT > MAXTILE) nT = MAXTILE;
    for (int i = f_tid; i < MAXTILE; i += 512) TE[i] = (unsigned char)((i < nT) ? meta[128 + i] : 0);
    __syncthreads();
    return (const LAS unsigned char*)TE;
}

__device__ __forceinline__ void p10_combine(Frame& F) {
    FT_DECL;
    const float* mod = WSP(float, WS_SMALL + SM_MOD); const unsigned char* EO = WSP(unsigned char, WS_EO);
    const size_t gt = (size_t)F.vcu * 512 + f_tid, NTH = (size_t)F.G * 512;
    constexpr int U = 4;
    for (size_t i0 = gt; i0 < (size_t)MROWS * 128; i0 += NTH * U) {
        u32x2 ev[U][4]; f32x4 xv[U][2], gv[U][2];
#pragma unroll
        for (int u = 0; u < U; ++u) { const size_t i = i0 + (size_t)u * NTH; const size_t row = i >> 7; const int c0 = (int)(i & 127) * 8;
            const float* g2 = mod + (size_t)(row >> 12) * (NMOD * DM) + 5 * DM + c0; const bf16_t* op = WSP(bf16_t, WS_XN) + row * DM + c0;
#pragma unroll
            for (int k = 0; k < 4; ++k) ev[u][k] = __builtin_nontemporal_load((const u32x2*)(EO + ((size_t)k * MROWS + row) * DM + c0));
            { const u32x4 xb = *(const u32x4*)op; xv[u][0] = (f32x4){__uint_as_float(xb.x << 16), __uint_as_float(xb.x & 0xffff0000u), __uint_as_float(xb.y << 16), __uint_as_float(xb.y & 0xffff0000u)};
              xv[u][1] = (f32x4){__uint_as_float(xb.z << 16), __uint_as_float(xb.z & 0xffff0000u), __uint_as_float(xb.w << 16), __uint_as_float(xb.w & 0xffff0000u)}; }
            gv[u][0] = *(const f32x4*)g2; gv[u][1] = *(const f32x4*)(g2 + 4); }
#pragma unroll
        for (int u = 0; u < U; ++u) { const size_t i = i0 + (size_t)u * NTH; const size_t row = i >> 7; const int c0 = (int)(i & 127) * 8;
            float s[8];
#pragma unroll
            for (int e = 0; e < 8; ++e) s[e] = 0.f;
#pragma unroll
            for (int k = 0; k < 4; ++k) { const u32x2 v = ev[u][k];
                const f32x2 a = __builtin_amdgcn_cvt_pk_f32_fp8((int)v.x, false), b = __builtin_amdgcn_cvt_pk_f32_fp8((int)v.x, true), c = __builtin_amdgcn_cvt_pk_f32_fp8((int)v.y, false), d = __builtin_amdgcn_cvt_pk_f32_fp8((int)v.y, true);
                s[0] += a.x; s[1] += a.y; s[2] += b.x; s[3] += b.y; s[4] += c.x; s[5] += c.y; s[6] += d.x; s[7] += d.y; }
#pragma unroll
            for (int e = 0; e < 8; ++e) s[e] *= (1.f / EOSCALE);
            f32x4 o0 = xv[u][0] + gv[u][0] * (f32x4){s[0], s[1], s[2], s[3]}, o1 = xv[u][1] + gv[u][1] * (f32x4){s[4], s[5], s[6], s[7]};
            float* op = F.out + row * DM + c0;
            __builtin_nontemporal_store(o0, (f32x4*)op); __builtin_nontemporal_store(o1, (f32x4*)(op + 4)); }
    }
}

struct Args { const float* in[34]; float* out; unsigned char* ws; int ph_lo, ph_hi; };
constexpr int N_PHASES = 11;

__global__ void __launch_bounds__(512, 2) mega(Args args) {
    extern __shared__ __attribute__((aligned(16))) unsigned char lds[];
    Frame F;
    F.lds = (LAS unsigned char*)lds;
    F.MISC = (volatile LAS unsigned*)(F.lds + LDSCTL_OFF);
    F.wave = __builtin_amdgcn_readfirstlane(threadIdx.x >> 6);
    FT_DECL;
    F.G = gridDim.x; { const int bx = blockIdx.x; F.vcu = (F.G % 8 == 0) ? (bx % 8) * (F.G / 8) + bx / 8 : bx; }
    F.in = (kin_t)__builtin_amdgcn_kernarg_segment_ptr();
    F.out = args.out; F.ws = args.ws;
    F.ctl = (gu32*)(args.ws + WS_CTL);
    for (int u = f_tid; u < (LDS_BYTES - LDSCTL_OFF) / 4; u += NWAVES * 64) ((LAS unsigned*)(F.lds + LDSCTL_OFF))[u] = 0u;
    __syncthreads();
    const int lo = args.ph_lo, hi = args.ph_hi;
    XcdBarrier bar; bar.bar = (unsigned*)(F.ctl + CW_BAR); bar.x = 0; bar.st = nullptr;
    if (hi - lo > 1) bar = xcd_barrier_post((unsigned*)(F.ctl + CW_BAR), F.MISC + 8, f_tid == 0);
#define IN(k) (lo <= (k) && (k) < hi)
#define SEAM(k) do { if (IN(k) && IN((k) + 1)) xcd_barrier(bar, F.wave == 0 && lane_id() == 0); } while (0)

    if (IN(0)) { p0_prologue(F); } SEAM(0);
    if (IN(1)) { p1_norm1(F); } SEAM(1);
    if (IN(2)) {
        SchedInProj S{F.G, (int)blockIdx.x, (const char*)WSP(bf16_t, WS_H), (const char*)WSP(bf16_t, WS_WIN)};
        EpiInProj E{WSP(unsigned char, WS_Q), WSP(unsigned char, WS_K), WSP(unsigned char, WS_V), WSP(bf16_t, WS_UT), F.in[9], F.in[10], WSP(float, WS_SMALL + SM_ROPE)};
        g8::gemm_phase<false>(F.lds, DM, S, E, F.wave, lane_id());
    } SEAM(2);
    if (IN(3)) { p3_attention8(F); p3_hyena(F); } SEAM(3);
    if (IN(4)) { p4_hynorm(F); } SEAM(4);
    if (IN(5)) {
        SchedStatic S{F.G, (int)blockIdx.x, MROWS / 256, DM / 256, (const char*)WSP(bf16_t, WS_MIX), (const char*)WSP(bf16_t, WS_WOUT)};
        EpiOutProj E{F.in[0], WSP(bf16_t, WS_XN), WSP(float, WS_SMALL + SM_MOD)};
        g8::gemm_phase<false>(F.lds, DM, S, E, F.wave, lane_id());
    } SEAM(5);
    if (IN(6)) { p6_router_mfma(F); } SEAM(6);
    if (IN(7)) { p7_scatter(F); } SEAM(7);
    if (IN(8)) {
        int nT; const LAS unsigned char* TE = moe_tiles(F, nT);
        LAS int* RWL = (LAS int*)(F.lds + RING_BYTES + 1024);
        static_assert(RING_BYTES + 1024 + 17 * 1024 <= LDSCTL_OFF, "LDS map");
        SchedMoE<8> S{F.G, (int)blockIdx.x, nT, (const char*)WSP(char, WS_H), (const char*)WSP(char, WS_W1), (size_t)2 * DM * DM, TE, RWL, true};
        { const int* list = WSP(int, WS_ROUTE + RT_LIST); const int t8 = F.wave * 64 + lane_id();
            g8::Unit u; for (int i = 0; i < 17 && S.next(i, u); i += 2) { const int ii = i + (t8 >> 8); g8::Unit u2; if (S.next(ii, u2)) { const int li = list[(size_t)u2.pm * 256 + (t8 & 255)]; RWL[ii * 256 + (t8 & 255)] = (li >= 0) ? (li >> 2) : 0; } }
            __syncthreads(); }
        EpiSwiGLU E{WSP(unsigned char, WS_ACT), F.in[31]};
        g8::gemm_phase_g<true, true>(F.lds, DM, S, E, F.wave, lane_id());
    } SEAM(8);
    if (IN(9)) {
        int nT; const LAS unsigned char* TE = moe_tiles(F, nT);
        SchedMoE<4> S{F.G, (int)blockIdx.x, nT, (const char*)WSP(char, WS_ACT), (const char*)WSP(char, WS_W2), (size_t)DM * DM, TE, nullptr, false};
        LAS int* LL = (LAS int*)(F.lds + RING_BYTES + 1024);
        static_assert(RING_BYTES + 1024 + 9 * 2048 <= LDSCTL_OFF, "LDS map");
        { const int* list = WSP(int, WS_ROUTE + RT_LIST); const float* gslot = WSP(float, WS_ROUTE + RT_GSLOT);
            const int t9 = F.wave * 64 + lane_id();
            g8::Unit u; for (int i = 0; i < 9 && S.next(i, u); ++i) { const int t = t9 & 255; const size_t slot = (size_t)u.pm * 256 + t;
                LL[i * 512 + (t9 >> 8) * 256 + t] = (t9 < 256) ? list[slot] : __float_as_int(gslot[slot]); }
            __syncthreads(); }
        EpiDown E{WSP(unsigned char, WS_EO), F.in[33], LL, F.G, (int)blockIdx.x};
        g8::gemm_phase<true>(F.lds, DM, S, E, F.wave, lane_id());
    } SEAM(9);
    if (IN(10)) { p10_combine(F); }
#undef IN
#undef SEAM
}

extern "C" void kernel_launch(void* const* d_in, const int* in_sizes, int n_in, void* d_out, int out_size, void* d_ws, size_t ws_size, hipStream_t stream) {
    static int grid = 0;
    if (grid == 0) {
        if (n_in != 34 || out_size != MROWS * DM || ws_size < WS_END) { fprintf(stderr, "kernel_launch: unexpected shapes: n_in %d out %d ws %zu (need %zu)\n", n_in, out_size, ws_size, (size_t)WS_END); grid = -1; return; }
        int dev = 0, cus = 0, per_cu = 0;
        if (hipGetDevice(&dev) != hipSuccess || hipDeviceGetAttribute(&cus, hipDeviceAttributeMultiprocessorCount, dev) != hipSuccess) { grid = -1; return; }
        if (hipFuncSetAttribute((const void*)mega, hipFuncAttributeMaxDynamicSharedMemorySize, LDS_BYTES) != hipSuccess) { fprintf(stderr, "kernel_launch: hipFuncSetAttribute failed\n"); grid = -1; return; }
        if (hipOccupancyMaxActiveBlocksPerMultiprocessor(&per_cu, (const void*)mega, NWAVES * 64, LDS_BYTES) != hipSuccess || per_cu < 1) { fprintf(stderr, "kernel_launch: occupancy query says %d\n", per_cu); per_cu = 1; }
        (void)hipGetLastError();
        grid = cus;
    }
    if (grid < 0) return;
    (void)hipMemsetAsync((char*)d_ws + WS_CTL, 0, CTL_ZERO_BYTES, stream);
    Args a{};
    for (int i = 0; i < 34; ++i) a.in[i] = (const float*)d_in[i];
    a.out = (float*)d_out; a.ws = (unsigned char*)d_ws;
    constexpr int LAST = MK_LAST_PHASE + 1;
    if (MK_N_LAUNCHES == 1) { a.ph_lo = 0; a.ph_hi = LAST; hipLaunchKernelGGL(mega, dim3(grid), dim3(NWAVES * 64), LDS_BYTES, stream, a); }
    else for (int p = 0; p < LAST; ++p) { a.ph_lo = p; a.ph_hi = p + 1; hipLaunchKernelGGL(mega, dim3(grid), dim3(NWAVES * 64), LDS_BYTES, stream, a); }
    const hipError_t le = hipPeekAtLastError();
    if (le != hipSuccess) fprintf(stderr, "kernel_launch: launch failed: %s\n", hipGetErrorName(le));
}
```

```cpp
#include <hip/hip_runtime.h>
#include <hip/hip_bf16.h>
#include <cstdio>
#include <cstdint>

#ifndef MK_N_LAUNCHES
#define MK_N_LAUNCHES 1
#endif
#ifndef MK_LAST_PHASE
#define MK_LAST_PHASE 10
#endif

#define GAS __attribute__((address_space(1)))
#define LAS __attribute__((address_space(3)))
typedef unsigned short bf16_t;
typedef short bf16x8 __attribute__((ext_vector_type(8)));
typedef short s16x4 __attribute__((ext_vector_type(4)));
typedef float f32x2 __attribute__((ext_vector_type(2)));
typedef float f32x4 __attribute__((ext_vector_type(4)));
typedef float f32x16 __attribute__((ext_vector_type(16)));
typedef unsigned u32x2 __attribute__((ext_vector_type(2)));
typedef unsigned u32x4 __attribute__((ext_vector_type(4)));
typedef GAS unsigned gu32;

constexpr int NB = 8, SEQ = 4096, DM = 1024, MROWS = NB * SEQ, CTXL = 256, MCTX = NB * CTXL, MTOT = MROWS + MCTX;
constexpr int KVL = CTXL + SEQ;
constexpr int NHEAD = 4, QKW = 512;
constexpr int HYW = 512, HYC = 1536, INC = 3072, QKVC = 1536;
constexpr int NEXP = 32, TOPK = 4, NMOD = 6;
constexpr float EPS = 1e-6f;
constexpr float LAM_INIT = 0.2f;
constexpr float QSCALE = 0.125f * 1.4426950408889634f;

constexpr size_t MiB = 1u << 20;
constexpr size_t WS_CTL = 0, CTL_ZERO_BYTES = 64 * 1024;
constexpr size_t WS_SMALL = 1 * MiB;
constexpr size_t WS_WIN = 2 * MiB;
constexpr size_t WS_WOUT = 8 * MiB;
constexpr size_t WS_W1 = 10 * MiB;
constexpr size_t WS_W2 = 138 * MiB;
constexpr size_t WS_H = 202 * MiB;
constexpr size_t WS_Q = 270 * MiB;
constexpr size_t WS_K = 302 * MiB;
constexpr size_t WS_V = 336 * MiB;
constexpr size_t WS_UT = 370 * MiB;
constexpr size_t WS_FILT = 466 * MiB;
constexpr size_t WS_Z2T = 498 * MiB;
constexpr size_t WS_MIX = 530 * MiB;
constexpr size_t WS_ROUTE = 594 * MiB;
constexpr size_t WS_ACT = 270 * MiB;
constexpr size_t WS_EO = 598 * MiB;
constexpr size_t WS_XN = 870 * MiB;
constexpr size_t WS_END = 998 * MiB;
constexpr size_t SM_MOD = 0;
constexpr size_t SM_SCAL = 256 * 1024;
constexpr size_t SM_ROPE = 260 * 1024;
constexpr int CW_BAR = 4096;

constexpr int RING_BYTES = 131072;
constexpr int LDSCTL_OFF = 151552;
constexpr int LDS_BYTES = 152576;
constexpr int NWAVES = 8;

#define LDS_WAIT() asm volatile("s_waitcnt lgkmcnt(0)" ::: "memory")
#define VM_WAIT() asm volatile("s_waitcnt vmcnt(0)" ::: "memory")
#define RLX_AGENT __ATOMIC_RELAXED, __HIP_MEMORY_SCOPE_AGENT

__device__ __forceinline__ unsigned cvt_pk_bf16(float lo, float hi) { unsigned r; asm volatile("v_cvt_pk_bf16_f32 %0, %1, %2" : "=v"(r) : "v"(lo), "v"(hi)); return r; }
__device__ __forceinline__ float bf2f(bf16_t v) { return __uint_as_float(((unsigned)v) << 16); }
__device__ __forceinline__ float wave_sum(float v) {
#pragma unroll
    for (int o = 1; o < 64; o <<= 1) v += __shfl_xor(v, o);
    return v;
}

#define XB_TMO      128
#define XB_XCNT(j)  (256  + 64 * (j))
#define XB_XSUB(j)  (1280 + 64 * (j))
#define XB_XGEN(j)  (2304 + 64 * (j))
#define XB_TOP      3328
#define XB_TOPGEN   3392
#define XCD_BAR_WORDS 3456
#define XB_SPIN_CAP (1u << 22)
__device__ __forceinline__ unsigned xb_ld(unsigned* p)              { return __hip_atomic_load(p, __ATOMIC_RELAXED, __HIP_MEMORY_SCOPE_AGENT); }
__device__ __forceinline__ unsigned xb_add(unsigned* p, unsigned v) { return __hip_atomic_fetch_add(p, v, __ATOMIC_RELAXED, __HIP_MEMORY_SCOPE_AGENT); }
__device__ __forceinline__ unsigned xb_xcc_id() { return (unsigned)__builtin_amdgcn_s_getreg((3 << 11) | 20) & 0xFu; }
#define XB_SPIN(cond, bar) do { unsigned _sp = 0; while (cond) { __builtin_amdgcn_s_sleep(1); \
    if ((++_sp & 255u) == 0u) { if (xb_ld(&(bar)[XB_TMO])) break; if (_sp > XB_SPIN_CAP) { atomicAdd(&(bar)[XB_TMO], 1u); break; } } } } while (0)
struct XcdBarrier { unsigned* bar; unsigned x; volatile LAS unsigned* st; };
__device__ __forceinline__ XcdBarrier xcd_barrier_post(unsigned* bar, volatile LAS unsigned* st, bool leader) {
    XcdBarrier b; b.bar = bar; b.x = xb_xcc_id(); b.st = st;
    if (leader) (void)xb_add(&bar[XB_XCNT(b.x)], 1u);
    return b;
}
__device__ __forceinline__ void xcd_barrier_complete(unsigned* bar, unsigned x, unsigned& nloc, unsigned& nx) {
    const unsigned G = gridDim.x * gridDim.y * gridDim.z;
    unsigned sum, cnt, mine, sp = 0u;
    for (;;) {
        sum = 0u; cnt = 0u; mine = 0u;
#pragma unroll
        for (unsigned j = 0; j < 16; ++j) { const unsigned c = xb_ld(&bar[XB_XCNT(j)]); sum += c; cnt += (c > 0u) ? 1u : 0u; mine = (j == x) ? c : mine; }
        if (sum == G) break;
        __builtin_amdgcn_s_sleep(1);
        if ((++sp & 255u) == 0u) { if (xb_ld(&bar[XB_TMO])) break; if (sp > XB_SPIN_CAP) { atomicAdd(&bar[XB_TMO], 1u); break; } }
    }
    nloc = mine > 0u ? mine : 1u; nx = cnt > 0u ? cnt : 1u;
}
__device__ __forceinline__ void xcd_barrier(const XcdBarrier& b, bool leader) {
    asm volatile("s_waitcnt vmcnt(0)" ::: "memory");
    __syncthreads();
    if (leader) {
        unsigned* bar = b.bar;
        __builtin_amdgcn_s_waitcnt(0);
        unsigned nloc = b.st[0], nx = b.st[1];
        if (nloc == 0u) { xcd_barrier_complete(bar, b.x, nloc, nx); b.st[0] = nloc; b.st[1] = nx; }
        const unsigned old = xb_add(&bar[XB_XSUB(b.x)], 1u);
        const unsigned gen = old / nloc;
        if (old + 1u == (gen + 1u) * nloc) {
            __builtin_amdgcn_fence(__ATOMIC_RELEASE, "agent");
            asm volatile("s_waitcnt vmcnt(0)" ::: "memory");
            const unsigned og = xb_add(&bar[XB_TOP], 1u);
            const unsigned tg = og / nx;
            if (og + 1u == (tg + 1u) * nx) xb_add(&bar[XB_TOPGEN], 1u);
            else XB_SPIN(xb_ld(&bar[XB_TOPGEN]) == tg, bar);
            __builtin_amdgcn_fence(__ATOMIC_ACQUIRE, "agent");
            xb_add(&bar[XB_XGEN(b.x)], 1u);
            asm volatile("s_waitcnt vmcnt(0)" ::: "memory");
        } else {
            XB_SPIN(xb_ld(&bar[XB_XGEN(b.x)]) == gen, bar);
            __builtin_amdgcn_fence(__ATOMIC_ACQUIRE, "agent");
            asm volatile("s_waitcnt vmcnt(0)" ::: "memory");
        }
    }
    __syncthreads();
}

namespace g8 {
constexpr int BM = 256, BK = 64, HALF = 128, HTB = HALF * BK * 2, STAGE_BYTES = 8 * HTB, NXCD = 8, WGM = 8;
__host__ __device__ __forceinline__ int lds_byte(int r, int c) { const int st = (r >> 4) * 2 + (c >> 5), rr = r & 15, cc = c & 31, ob = rr * 64 + cc * 2; return st * 1024 + (ob ^ (((ob >> 9) & 1) << 5)); }
__host__ __device__ __forceinline__ void stage_rc(int b, int& R, int& C) { const int st = b / 1024, sb = b % 1024, swz = sb ^ (((sb >> 9) & 1) << 5); R = (st >> 1) * 16 + swz / 64; C = (st & 1) * 32 + (swz % 64) / 2; }
__host__ __device__ __forceinline__ int perm32(int rho) { const int n = rho >> 4, i = rho & 15; return 8 * (i >> 2) + 4 * n + (i & 3); }

struct Unit { const char* a; const char* b; int pm, pn, kind, ex; };

__device__ __forceinline__ void tile_of(int L, int nM, int nN, int& pm, int& pn) {
    const int nwg = nM * nN; int wgid = L;
    { const int q = nwg / NXCD, r = nwg % NXCD, xcd = wgid % NXCD, off = wgid / NXCD; wgid = (xcd < r ? xcd * (q + 1) : r * (q + 1) + (xcd - r) * q) + off; }
    const int nig = WGM * nN, gid = wgid / nig, fm = gid * WGM, gsz = (nM - fm) < WGM ? (nM - fm) : WGM;
    pm = fm + ((wgid % nig) % gsz); pn = (wgid % nig) / gsz;
}

typedef int i32x8 __attribute__((ext_vector_type(8)));
template <bool FP8, bool GATHER, class Epi, class Sched>
__device__ __forceinline__ void gemm_phase_g(LAS unsigned char* lds, const int K, const Sched& S, const Epi& E, const int wid, const int lane) {
    const int tid = wid * 64 + lane, wr = wid >> 2, wc = wid & 3, fr = lane & 15, fq = lane >> 4;
    const int nt = FP8 ? K / 128 : K / BK;
    const int RP = FP8 ? K : 2 * K;
    unsigned voffA[2], voffB[2]; int srow[2], scol[2];
#pragma unroll
    for (int i = 0; i < 2; ++i) { int R, C; stage_rc(tid * 16 + i * 8192, R, C); const int Rb = (R & ~31) + perm32(R & 31);
        voffA[i] = (unsigned)(R * RP + C * 2); voffB[i] = (unsigned)(Rb * RP + C * 2); srow[i] = R; scol[i] = C * 2; }
    const size_t kstep = (size_t)(BK * 2);
    const size_t hstep = (size_t)HALF * RP;
    const unsigned ldsw = (unsigned)wid * 1024u;
    unsigned cO0[2], cO1[2], nO0[2], nO1[2];
#define PG8_GOFF(D0, D1, ui_) do { if constexpr (GATHER) { const LAS int* rw_ = S.rows(ui_); _Pragma("unroll") for (int i_ = 0; i_ < 2; ++i_) { \
        D0[i_] = (unsigned)rw_[srow[i_]] * (unsigned)RP + (unsigned)scol[i_]; D1[i_] = (unsigned)rw_[128 + srow[i_]] * (unsigned)RP + (unsigned)scol[i_]; } } \
      else { _Pragma("unroll") for (int i_ = 0; i_ < 2; ++i_) { D0[i_] = voffA[i_]; D1[i_] = voffA[i_] + (unsigned)hstep; } } } while (0)
    const int aoff = lds_byte(wr * 64 + fr, FP8 ? fq * 16 : fq * 8), boff = lds_byte(wc * 32 + fr, FP8 ? fq * 16 : fq * 8);
    constexpr int KOFF = FP8 ? 16 : 1024;
#define PG8_SA(b, h) (((b) * 2 + (h)) * HTB)
#define PG8_SB(b, h) ((4 + (b) * 2 + (h)) * HTB)
#define PG8_STAGE(bufoff, gbase, voff) do { _Pragma("unroll") for (int _i = 0; _i < 2; ++_i) \
        __builtin_amdgcn_global_load_lds((const unsigned*)((const char*)(gbase) + (voff)[_i]), (LAS unsigned*)(lds + (bufoff) + ldsw + _i * 8192), 16, 0, 0); } while (0)
#define PG8_LD32(p) __builtin_bit_cast(i32x8, __builtin_shufflevector(*(const LAS u32x4*)(p), *(const LAS u32x4*)((p) + 16), 0, 1, 2, 3, 4, 5, 6, 7))
#define PG8_LDA8(dst, b, h) do { _Pragma("unroll") for (int m = 0; m < 4; ++m) dst[m] = PG8_LD32(lds + PG8_SA(b, h) + aoff + m * 2048); } while (0)
#define PG8_LDB8(dst, b, h) do { _Pragma("unroll") for (int n = 0; n < 2; ++n) dst[n] = PG8_LD32(lds + PG8_SB(b, h) + boff + n * 2048); } while (0)
#define PG8_LDA(dst, b, h) do { _Pragma("unroll") for (int m = 0; m < 4; ++m) _Pragma("unroll") for (int k = 0; k < 2; ++k) dst[m][k] = *(const LAS bf16x8*)(lds + PG8_SA(b, h) + aoff + m * 2048 + k * KOFF); } while (0)
#define PG8_LDB(dst, b, h) do { _Pragma("unroll") for (int n = 0; n < 2; ++n) _Pragma("unroll") for (int k = 0; k < 2; ++k) dst[n][k] = *(const LAS bf16x8*)(lds + PG8_SB(b, h) + boff + n * 2048 + k * KOFF); } while (0)
#define PG8_MMA(ai, bj, At, Bt) do { __builtin_amdgcn_s_setprio(1); _Pragma("unroll") for (int m = 0; m < 4; ++m) _Pragma("unroll") for (int n = 0; n < 2; ++n) _Pragma("unroll") for (int k = 0; k < 2; ++k) \
        acc[ai][bj][m][n] = __builtin_amdgcn_mfma_f32_16x16x32_bf16(Bt[n][k], At[m][k], acc[ai][bj][m][n], 0, 0, 0); __builtin_amdgcn_s_setprio(0); } while (0)
#define PG8_MMA8(ai, bj, At, Bt) do { __builtin_amdgcn_s_setprio(1); _Pragma("unroll") for (int m = 0; m < 4; ++m) _Pragma("unroll") for (int n = 0; n < 2; ++n) \
        asm volatile("v_mfma_scale_f32_16x16x128_f8f6f4 %0, %1, %2, %0, %3, %3 op_sel_hi:[0,0,0]" : "+v"(acc[ai][bj][m][n]) : "v"(Bt[n]), "v"(At[m]), "v"(one_scale)); __builtin_amdgcn_s_setprio(0); } while (0)
#define PG8_WAIT_V(n) asm volatile("s_waitcnt vmcnt(" #n ")" ::: "memory")
#define PG8_WAIT_L(n) asm volatile("s_waitcnt lgkmcnt(" #n ")" ::: "memory")
#define PG8_BAR __builtin_amdgcn_s_barrier()
#define PG8_SCHED __builtin_amdgcn_sched_barrier(0)
    Unit cur, nxt; int ui = 0;
    if (!S.next(0, cur)) return;
    f32x4 acc[2][2][4][2];
#pragma unroll
    for (int a = 0; a < 2; ++a)
#pragma unroll
        for (int b = 0; b < 2; ++b)
#pragma unroll
            for (int m = 0; m < 4; ++m)
#pragma unroll
                for (int n = 0; n < 2; ++n) acc[a][b][m][n] = (f32x4){0.f, 0.f, 0.f, 0.f};
    bf16x8 At[4][2], B0[2][2], B1[2][2];
    i32x8 At8[4], B08[2], B18[2];
    const unsigned one_scale = 0x7f7f7f7fu;
    const char* cA = cur.a; const char* cB = cur.b;
    PG8_GOFF(cO0, cO1, 0);
    PG8_STAGE(PG8_SB(0, 0), cB, voffB); PG8_STAGE(PG8_SB(0, 1), cB + hstep, voffB); PG8_STAGE(PG8_SA(0, 0), cA, cO0); PG8_STAGE(PG8_SA(0, 1), cA, cO1);
    if (wr == 1) PG8_BAR;
    PG8_WAIT_V(2); PG8_BAR;
    PG8_STAGE(PG8_SB(1, 0), cB + kstep, voffB); PG8_STAGE(PG8_SA(1, 0), cA + kstep, cO0); PG8_STAGE(PG8_SB(1, 1), cB + hstep + kstep, voffB);
    PG8_WAIT_V(6); PG8_BAR;
    for (;;) {
        const bool has_next = S.next(ui + 1, nxt);
        const char* nA = has_next ? nxt.a : cA; const char* nB = has_next ? nxt.b : cB;
        if (has_next) PG8_GOFF(nO0, nO1, ui + 1); else { _Pragma("unroll") for (int i_ = 0; i_ < 2; ++i_) { nO0[i_] = cO0[i_]; nO1[i_] = cO1[i_]; } }
#pragma unroll 1
        for (int t = 0; t < nt; t += 2) {
            const bool last = (t == nt - 2);
            const char* a1 = cA + (size_t)(t + 1) * kstep;
            const char* a2 = last ? nA : cA + (size_t)(t + 2) * kstep; const char* b2 = last ? nB : cB + (size_t)(t + 2) * kstep;
            const char* a3 = a2 + kstep; const char* b3 = b2 + kstep;
            unsigned o20[2], o21[2];
#pragma unroll
            for (int i_ = 0; i_ < 2; ++i_) { o20[i_] = last ? nO0[i_] : cO0[i_]; o21[i_] = last ? nO1[i_] : cO1[i_]; }
            if constexpr (FP8) {
            PG8_LDB8(B08, 0, 0); PG8_LDB8(B18, 0, 1); PG8_SCHED; PG8_LDA8(At8, 0, 0); PG8_STAGE(PG8_SA(1, 1), a1, cO1);
            PG8_WAIT_V(8); PG8_WAIT_L(0); PG8_BAR; PG8_MMA8(0, 0, At8, B08); PG8_MMA8(0, 1, At8, B18); PG8_BAR; PG8_SCHED;
            PG8_LDA8(At8, 0, 1); PG8_STAGE(PG8_SB(0, 0), b2, voffB); PG8_STAGE(PG8_SB(0, 1), b2 + hstep, voffB); PG8_STAGE(PG8_SA(0, 0), a2, o20);
            PG8_WAIT_V(8); PG8_WAIT_L(0); PG8_BAR; PG8_MMA8(1, 0, At8, B08); PG8_MMA8(1, 1, At8, B18); PG8_BAR; PG8_SCHED;
            PG8_LDB8(B08, 1, 0); PG8_LDB8(B18, 1, 1); PG8_SCHED; PG8_LDA8(At8, 1, 0); PG8_STAGE(PG8_SA(0, 1), a2, o21);
            PG8_WAIT_V(8); PG8_WAIT_L(0); PG8_BAR; PG8_MMA8(0, 0, At8, B08); PG8_MMA8(0, 1, At8, B18); PG8_BAR; PG8_SCHED;
            PG8_LDA8(At8, 1, 1); PG8_STAGE(PG8_SB(1, 0), b3, voffB); PG8_STAGE(PG8_SB(1, 1), b3 + hstep, voffB); PG8_STAGE(PG8_SA(1, 0), a3, o20);
            PG8_WAIT_V(8); PG8_WAIT_L(0); PG8_BAR; PG8_MMA8(1, 0, At8, B08); PG8_MMA8(1, 1, At8, B18); PG8_BAR; PG8_SCHED;
            } else {
            PG8_LDB(B0, 0, 0); PG8_LDB(B1, 0, 1); PG8_SCHED; PG8_LDA(At, 0, 0); PG8_STAGE(PG8_SA(1, 1), a1, cO1);
            PG8_WAIT_V(8); PG8_WAIT_L(0); PG8_BAR; PG8_MMA(0, 0, At, B0); PG8_MMA(0, 1, At, B1); PG8_BAR; PG8_SCHED;
            PG8_LDA(At, 0, 1); PG8_STAGE(PG8_SB(0, 0), b2, voffB); PG8_STAGE(PG8_SB(0, 1), b2 + hstep, voffB); PG8_STAGE(PG8_SA(0, 0), a2, o20);
            PG8_WAIT_V(8); PG8_WAIT_L(0); PG8_BAR; PG8_MMA(1, 0, At, B0); PG8_MMA(1, 1, At, B1); PG8_BAR; PG8_SCHED;
            PG8_LDB(B0, 1, 0); PG8_LDB(B1, 1, 1); PG8_SCHED; PG8_LDA(At, 1, 0); PG8_STAGE(PG8_SA(0, 1), a2, o21);
            PG8_WAIT_V(8); PG8_WAIT_L(0); PG8_BAR; PG8_MMA(0, 0, At, B0); PG8_MMA(0, 1, At, B1); PG8_BAR; PG8_SCHED;
            PG8_LDA(At, 1, 1); PG8_STAGE(PG8_SB(1, 0), b3, voffB); PG8_STAGE(PG8_SB(1, 1), b3 + hstep, voffB); PG8_STAGE(PG8_SA(1, 0), a3, o20);
            PG8_WAIT_V(8); PG8_WAIT_L(0); PG8_BAR; PG8_MMA(1, 0, At, B0); PG8_MMA(1, 1, At, B1); PG8_BAR; PG8_SCHED;
            }
        }
        if (wr == 0) PG8_BAR;
        if constexpr (FP8) asm volatile("s_nop 15\n\ts_nop 15" ::: "memory");
        E(acc, cur, wr, wc, fr, fq);
        if (!has_next) break;
#pragma unroll
        for (int a = 0; a < 2; ++a)
#pragma unroll
            for (int b = 0; b < 2; ++b)
#pragma unroll
                for (int m = 0; m < 4; ++m)
#pragma unroll
                    for (int n = 0; n < 2; ++n) acc[a][b][m][n] = (f32x4){0.f, 0.f, 0.f, 0.f};
        cur = nxt; cA = nA; cB = nB; ++ui;
#pragma unroll
        for (int i_ = 0; i_ < 2; ++i_) { cO0[i_] = nO0[i_]; cO1[i_] = nO1[i_]; }
        if (wr == 1) PG8_BAR;
    }
    PG8_WAIT_V(0);
    PG8_BAR;
#undef PG8_SA
#undef PG8_GOFF
#undef PG8_SB
#undef PG8_STAGE
#undef PG8_LDA
#undef PG8_LDB
#undef PG8_MMA
#undef PG8_MMA8
#undef PG8_LDA8
#undef PG8_LDB8
#undef PG8_LD32
#undef PG8_WAIT_V
#undef PG8_WAIT_L
#undef PG8_BAR
#undef PG8_SCHED
}
template <bool FP8, class Epi, class Sched>
__device__ __forceinline__ void gemm_phase(LAS unsigned char* lds, const int K, const Sched& S, const Epi& E, const int wid, const int lane) { gemm_phase_g<FP8, false>(lds, K, S, E, wid, lane); }
}

__device__ __forceinline__ int lane_id() { int l; asm volatile("v_mbcnt_lo_u32_b32 %0, -1, 0\n\tv_mbcnt_hi_u32_b32 %0, -1, %0" : "=v"(l)); return l; }
#define FT_DECL const int f_lane = lane_id(), f_tid = F.wave * 64 + f_lane; (void)f_tid; (void)f_lane
typedef const float* cfp_t;
typedef __attribute__((address_space(4))) cfp_t* kin_t;
struct Frame {
    LAS unsigned char* lds;
    volatile LAS unsigned* MISC;
    gu32* ctl;
    int wave, vcu, G;
    kin_t in;
    float* out;
    unsigned char* ws;
};
#define WSP(T, off) ((T*)(F.ws + (off)))

template <class RowMap>
__device__ __forceinline__ void p0_transpose_item(const float* W, int K, int N, bf16_t* WT, const RowMap& rowmap, const float* kscale, LAS float* scr, int item, int lane, bool kperm = false) {
    const int nblk = N / 32, kb = item / nblk, nb = item % nblk, k0 = 64 * kb, n0 = 32 * nb;
#pragma unroll 8
    for (int i = 0; i < 32; ++i) { const int kk = 2 * i + (lane >> 5); int ks = k0 + kk; if (kperm && ks >= K / 2) { const int j = ks - K / 2; ks = K / 2 + (j >> 3) + 64 * (j & 7); }
        float v = W[(size_t)ks * N + n0 + (lane & 31)]; if (kscale) v *= kscale[k0 + kk]; scr[kk * 33 + (lane & 31)] = v; }
    LDS_WAIT(); asm volatile("" ::: "memory");
    const int c = lane & 7;
#pragma unroll
    for (int j = 0; j < 4; ++j) { const int n = (lane >> 3) + 8 * j; const LAS float* s = scr + (8 * c) * 33 + n;
        u32x4 o; o.x = cvt_pk_bf16(s[0 * 33], s[1 * 33]); o.y = cvt_pk_bf16(s[2 * 33], s[3 * 33]); o.z = cvt_pk_bf16(s[4 * 33], s[5 * 33]); o.w = cvt_pk_bf16(s[6 * 33], s[7 * 33]);
        *(GAS u32x4*)(WT + (size_t)rowmap(n0 + n) * K + k0 + 8 * c) = o; }
    LDS_WAIT(); asm volatile("" ::: "memory");
}

__device__ __forceinline__ unsigned pk4_fp8(float a, float b, float c, float d) { int r = __builtin_amdgcn_cvt_pk_fp8_f32(a, b, 0, false); r = __builtin_amdgcn_cvt_pk_fp8_f32(c, d, r, true); return (unsigned)r; }
constexpr float EOSCALE = 16.f;
constexpr float WSCALE = 32.f;
template <class RowMap>
__device__ __forceinline__ void p0_transpose_item_f8(const float* W, int K, int N, unsigned char* WT, const RowMap& rowmap, LAS float* scr, int item, int lane) {
    const int nblk = N / 32, kb = item / nblk, nb = item % nblk, k0 = 128 * kb, n0 = 32 * nb;
#pragma unroll
    for (int hh = 0; hh < 2; ++hh) { float v[32];
#pragma unroll
        for (int i = 0; i < 32; ++i) { const int kk = 2 * (32 * hh + i) + (lane >> 5); v[i] = __builtin_nontemporal_load(W + (size_t)(k0 + kk) * N + n0 + (lane & 31)); }
#pragma unroll
        for (int i = 0; i < 32; ++i) { const int kk = 2 * (32 * hh + i) + (lane >> 5); scr[kk * 33 + (lane & 31)] = v[i] * WSCALE; } }
    LDS_WAIT(); asm volatile("" ::: "memory");
    const int c = lane & 7;
#pragma unroll
    for (int j = 0; j < 4; ++j) { const int n = (lane >> 3) + 8 * j; const LAS float* sp = scr + (16 * c) * 33 + n;
        u32x4 o; o.x = pk4_fp8(sp[0 * 33], sp[1 * 33], sp[2 * 33], sp[3 * 33]); o.y = pk4_fp8(sp[4 * 33], sp[5 * 33], sp[6 * 33], sp[7 * 33]);
        o.z = pk4_fp8(sp[8 * 33], sp[9 * 33], sp[10 * 33], sp[11 * 33]); o.w = pk4_fp8(sp[12 * 33], sp[13 * 33], sp[14 * 33], sp[15 * 33]);
        *(GAS u32x4*)(WT + (size_t)rowmap(n0 + n) * K + k0 + 16 * c) = o; }
    LDS_WAIT(); asm volatile("" ::: "memory");
}
struct MapW2 { __device__ __forceinline__ int operator()(int l) const { const int t = l & ~255, r = l & 255, wc = r >> 6, fq = (r >> 4) & 3, bj = (r >> 3) & 1, low = r & 7; return t + 128 * bj + 32 * wc + 8 * fq + low; } };
struct MapIdent { int off; __device__ __forceinline__ int operator()(int n) const { return off + n; } };
struct MapWin { __device__ __forceinline__ int operator()(int l) const {
    if (l >= 1024) return l;
    const int t = l & ~255, r = l & 255, wc = r >> 6, blk = (r >> 5) & 1, bj = (r >> 4) & 1, low = r & 15;
    return t + 128 * bj + 32 * wc + 16 * blk + low; } };
struct MapW1 { int off; __device__ __forceinline__ int operator()(int jp) const { const int bj = jp >> 10, j = jp & 1023; return off + 256 * (j >> 7) + 128 * bj + (j & 127); } };


__device__ __forceinline__ void p0_filter_item(Frame& F, int item) {
    FT_DECL;
#define in F.in
    LAS float* h1s = (LAS float*)(F.lds);
    LAS float* h2s = (LAS float*)(F.lds + 4096);
    const int t0 = item * 16;
    {
        const int tt = f_tid >> 5, hh = (f_tid & 31) * 2; const float pos = (float)(t0 + tt);
        float feats[17]; feats[0] = pos * (1.f / SEQ);
#pragma unroll
        for (int i = 0; i < 8; ++i) { const float band = 1e-4f + (float)i * ((7.f - 1e-4f) / 7.f); const float ang = (6.283185307179586f / SEQ) * pos * band; feats[1 + i] = __sinf(ang); feats[9 + i] = __cosf(ang); }
#pragma unroll
        for (int u = 0; u < 2; ++u) { const int h = hh + u; float a = in[19][h];
#pragma unroll
            for (int k = 0; k < 17; ++k) a += feats[k] * in[18][k * 64 + h];
            h1s[tt * 64 + h] = __sinf(in[20][h] * a); }
        __syncthreads();
#pragma unroll
        for (int u = 0; u < 2; ++u) { const int h = hh + u; float a = in[22][h];
#pragma unroll 8
            for (int k = 0; k < 64; ++k) a += h1s[tt * 64 + k] * in[21][k * 64 + h];
            h2s[tt * 64 + h] = __sinf(in[23][h] * a); }
        __syncthreads();
    }
    f32x4 acc[16];
#pragma unroll
    for (int t = 0; t < 16; ++t) acc[t] = (f32x4){0.f, 0.f, 0.f, 0.f};
    const int o = 4 * f_tid;
    for (int k0 = 0; k0 < 64; k0 += 4) { f32x4 w[4];
#pragma unroll
        for (int q = 0; q < 4; ++q) w[q] = *(const f32x4*)(in[24] + (size_t)(k0 + q) * 2048 + o);
#pragma unroll
        for (int t = 0; t < 16; ++t) { const f32x4 hv = *(const LAS f32x4*)(h2s + t * 64 + k0); acc[t] += w[0] * hv[0] + w[1] * hv[1] + w[2] * hv[2] + w[3] * hv[3]; } }
    const int c0 = o & 511, od = o >> 9;
    float* dst = WSP(float, WS_FILT) + ((size_t)od * 512 + c0) * SEQ + t0;
#pragma unroll
    for (int e = 0; e < 4; ++e) { const float la = -3.0701134573253944f, lb = -15.350567286626972f; const float delta = fabsf(la + (float)(c0 + e) * ((lb - la) / 511.f));
#pragma unroll
        for (int q = 0; q < 4; ++q) { f32x4 v;
#pragma unroll
            for (int i = 0; i < 4; ++i) { const int t = 4 * q + i; const float tn = (float)(t0 + t) * (1.f / SEQ); v[i] = acc[t][e] * __expf(-tn * delta); }
            *(f32x4*)(dst + (size_t)e * SEQ + 4 * q) = v; } }
    __syncthreads();
#undef in
}

__device__ __forceinline__ float silu_f(float v) { return v / (1.f + __expf(-v)); }

__device__ __forceinline__ void p0_prologue(Frame& F) {
    FT_DECL;
#define in F.in
    const int wg = blockIdx.x;
    if (wg < 96) {
        LAS float* sv = (LAS float*)F.lds;
        for (int i = f_tid; i < 9 * 1024; i += 512) { const int r = i >> 10, k = i & 1023; const float c = (r < 8) ? in[1][r * 1024 + k] : in[3][k]; sv[i] = silu_f(c); }
        __syncthreads();
        const int j = wg * 64 + f_lane; const float* wm = in[4];
        float acc[9];
#pragma unroll
        for (int r = 0; r < 9; ++r) acc[r] = 0.f;
        const int kbeg = F.wave * 128;
        for (int k0 = kbeg; k0 < kbeg + 128; k0 += 16) { float w[16];
#pragma unroll
            for (int q = 0; q < 16; ++q) w[q] = __builtin_nontemporal_load(wm + (size_t)(k0 + q) * (NMOD * DM) + j);
#pragma unroll
            for (int q = 0; q < 16; ++q)
#pragma unroll
                for (int r = 0; r < 9; ++r) acc[r] += sv[r * 1024 + k0 + q] * w[q]; }
        LAS float* red = (LAS float*)(F.lds + 40960);
#pragma unroll
        for (int r = 0; r < 9; ++r) red[(F.wave * 9 + r) * 64 + f_lane] = acc[r];
        __syncthreads();
        for (int i = f_tid; i < 9 * 64; i += 512) { const int r = i >> 6, l = i & 63; float s = in[5][wg * 64 + l];
#pragma unroll
            for (int w = 0; w < 8; ++w) s += red[(w * 9 + r) * 64 + l];
            WSP(float, WS_SMALL + SM_MOD)[r * (NMOD * DM) + wg * 64 + l] = s; }
        __syncthreads();
    } else if (wg == 96) {
        if (F.wave == 0) {
            const float a = wave_sum(in[11][f_lane] * in[12][f_lane]), b = wave_sum(in[13][f_lane] * in[14][f_lane]);
            float gq = fabsf(in[9][f_lane]), gk = fabsf(in[10][f_lane]);
#pragma unroll
            for (int o = 1; o < 64; o <<= 1) { gq = fmaxf(gq, __shfl_xor(gq, o)); gk = fmaxf(gk, __shfl_xor(gk, o)); }
            if (f_lane == 0) { float* sc = WSP(float, WS_SMALL + SM_SCAL); sc[0] = expf(a) - expf(b) + LAM_INIT;
                sc[1] = (8.f * gq * gk * 1.02f + 0.05f) * 1.4426950408889634f; }
        }
        for (int i = f_tid; i < 64 * 16; i += 512) { const int pos = i >> 4, f = i & 15;
            const float inv = powf(10000.f, -(float)f / 16.f); const float ang = (float)pos * inv;
            float* rt = WSP(float, WS_SMALL + SM_ROPE); rt[2 * i] = cosf(ang); rt[2 * i + 1] = sinf(ang); }
    }
    __syncthreads();
    for (int it = wg; it < SEQ / 16; it += F.G) p0_filter_item(F, it);
    __syncthreads();
    {
        LAS float* scr = (LAS float*)(F.lds + F.wave * 16896);
        const int gw = F.vcu * NWAVES + F.wave, NGW = F.G * NWAVES;
        constexpr int I_IN = (DM / 64) * (INC / 32), I_OUT = (DM / 64) * (DM / 32), I_1 = (DM / 128) * (2 * DM / 32), I_2 = (DM / 128) * (DM / 32);
        constexpr int NITEMS = I_IN + I_OUT + NEXP * (I_1 + I_2);
        for (int it = gw; it < NITEMS; it += NGW) {
            int r = it;
            if (r < I_IN) { p0_transpose_item(in[8], DM, INC, WSP(bf16_t, WS_WIN), MapWin{}, nullptr, scr, r, f_lane); continue; } r -= I_IN;
            if (r < I_OUT) { p0_transpose_item(in[27], DM, DM, WSP(bf16_t, WS_WOUT), MapIdent{0}, nullptr, scr, r, f_lane, true); continue; } r -= I_OUT;
            const int e = r / (I_1 + I_2); r -= e * (I_1 + I_2);
            if (r < I_1) p0_transpose_item_f8(in[30] + (size_t)e * DM * 2 * DM, DM, 2 * DM, WSP(unsigned char, WS_W1) + (size_t)e * 2 * DM * DM, MapW1{0}, scr, r, f_lane);
            else p0_transpose_item_f8(in[32] + (size_t)e * DM * DM, DM, DM, WSP(unsigned char, WS_W2) + (size_t)e * DM * DM, MapW2{}, scr, r - I_1, f_lane);
        }
    }
}
#undef in

__device__ __forceinline__ void p1_norm1(Frame& F) {
    FT_DECL;
    const int gw = F.vcu * NWAVES + F.wave, NGW = F.G * NWAVES;
    const float* mod = WSP(float, WS_SMALL + SM_MOD); const float* g1 = F.in[6];
    bf16_t* H = WSP(bf16_t, WS_H);
    constexpr int RPW = MTOT / (256 * NWAVES);
    for (int run = gw; run * RPW < MTOT; run += NGW) {
        const int r0 = run * RPW, r1 = (r0 + RPW < MTOT) ? r0 + RPW : MTOT;
        int curb = -1; f32x4 PA[4], PB[4];
        for (int m0 = r0; m0 < r1; m0 += 4) {
            f32x4 v[4][4];
#pragma unroll
            for (int u = 0; u < 4; ++u) { const int m = m0 + u; if (m < r1) {
                const float* xrow = (m < MROWS) ? F.in[0] + (size_t)m * DM : F.in[2] + (size_t)(m - MROWS) * DM; const GAS f32x4* xr = (const GAS f32x4*)xrow + f_lane;
#pragma unroll
                for (int j = 0; j < 4; ++j) v[u][j] = __builtin_nontemporal_load(xr + 64 * j); } }
#pragma unroll
            for (int u = 0; u < 4; ++u) { const int m = m0 + u; if (m < r1) {
                const int mb = (m < MROWS) ? (m >> 12) : 8;
                if (mb != curb) { curb = mb; const float* sh = mod + (size_t)mb * (NMOD * DM); const float* sc = sh + DM;
#pragma unroll
                    for (int j = 0; j < 4; ++j) { const int c = 4 * f_lane + 256 * j; PA[j] = *(const f32x4*)(g1 + c) * (*(const f32x4*)(sc + c) + 1.f); PB[j] = *(const f32x4*)(sh + c); } }
                float s = 0.f;
#pragma unroll
                for (int j = 0; j < 4; ++j) s += (v[u][j].x * v[u][j].x + v[u][j].y * v[u][j].y) + (v[u][j].z * v[u][j].z + v[u][j].w * v[u][j].w);
                const float rstd = rsqrtf(wave_sum(s) * (1.f / DM) + EPS);
                GAS u32x2* o8 = (GAS u32x2*)(H + (size_t)m * DM) + f_lane;
#pragma unroll
                for (int j = 0; j < 4; ++j) { const f32x4 y = v[u][j] * rstd * PA[j] + PB[j];
                    u32x2 w; w.x = cvt_pk_bf16(y.x, y.y); w.y = cvt_pk_bf16(y.z, y.w); o8[64 * j] = w; } } }
        }
    }
}

struct SchedInProj {
    int G, c; const char* H; const char* W;
    static constexpr int NA = 136 * 4, NV = 2 * 136, NBU = 6 * 128;
    __device__ __forceinline__ bool next(int i, g8::Unit& u) const {
        const long L = (long)i * G + c;
        if (L < NA) { g8::tile_of((int)L, 136, 4, u.pm, u.pn); u.a = H + (size_t)u.pm * 256 * DM * 2; u.b = W + (size_t)u.pn * 256 * DM * 2; u.kind = 0; u.ex = 0; return true; }
        if (L < NA + NV) { g8::tile_of((int)L - NA, 2, 136, u.pm, u.pn); u.a = W + (size_t)(1024 + u.pm * 256) * DM * 2; u.b = H + (size_t)u.pn * 256 * DM * 2; u.kind = 2; u.ex = 0; return true; }
        if (L < NA + NV + NBU) { g8::tile_of((int)L - NA - NV, 6, 128, u.pm, u.pn); u.a = W + (size_t)(QKVC + u.pm * 256) * DM * 2; u.b = H + (size_t)u.pn * 256 * DM * 2; u.kind = 1; u.ex = 0; return true; }
        return false;
    }
};
constexpr float Q8SCALE = 16.f;
struct EpiInProj {
    unsigned char *Q8, *K8, *VT8; bf16_t* UT; const float *gq, *gk, *rope;
    __device__ __forceinline__ void operator()(f32x4 (&acc)[2][2][4][2], const g8::Unit& u, int wr, int wc, int fr, int fq) const {
        asm volatile("" : "+v"(fr), "+v"(fq));
        if (u.kind == 1) {
            const int row0 = u.pm * 256 + wr * 64 + fr, col0 = u.pn * 256 + wc * 32 + 8 * fq;
#pragma unroll
            for (int ai = 0; ai < 2; ++ai)
#pragma unroll
                for (int m = 0; m < 4; ++m) { const int ch = row0 + ai * 128 + m * 16;
#pragma unroll
                    for (int bj = 0; bj < 2; ++bj) { const int tok = col0 + bj * 128; const f32x4 v0 = acc[ai][bj][m][0], v1 = acc[ai][bj][m][1];
                        u32x4 w; w.x = cvt_pk_bf16(v0[0], v0[1]); w.y = cvt_pk_bf16(v0[2], v0[3]); w.z = cvt_pk_bf16(v1[0], v1[1]); w.w = cvt_pk_bf16(v1[2], v1[3]);
                        *(u32x4*)(UT + ((size_t)(tok >> 7) * HYC + ch) * 128 + (tok & 127)) = w; } }
            return;
        }
        if (u.kind == 2) {
#pragma unroll
            for (int bj = 0; bj < 2; ++bj) { const int t8 = u.pn * 256 + bj * 128 + wc * 32 + 8 * fq;
                int b, key; if (t8 < MROWS) { b = t8 >> 12; key = CTXL + (t8 & 4095); } else { const int j = t8 - MROWS; b = j >> 8; key = j & 255; }
                const int tile = key >> 6, k = key & 63, ipos = (k < 32) ? 4 * (k >> 3) : 16 + 4 * ((k - 32) >> 3);
#pragma unroll
                for (int ai = 0; ai < 2; ++ai)
#pragma unroll
                    for (int m = 0; m < 4; ++m) { const int ch = u.pm * 256 + ai * 128 + wr * 64 + m * 16 + fr;
                        unsigned char* dst = VT8 + ((((size_t)(b * NHEAD + (ch >> 7)) * 68 + tile) * 128 + (ch & 127)) * 64) + ipos;
                        const f32x4 v0 = acc[ai][bj][m][0], v1 = acc[ai][bj][m][1];
                        *(unsigned*)dst = pk4_fp8(v0[0], v0[1], v0[2], v0[3]); *(unsigned*)(dst + 32) = pk4_fp8(v1[0], v1[1], v1[2], v1[3]); } }
            return;
        }
        const int blk = fq >> 1, f = fq & 1;
        const int sec = u.pn >> 1;
        const bool ctx = (u.pm >= 128);
        if (sec == 0 && ctx) return;
        const int colbase = (u.pn & 1) * 256 + wc * 64 + 32 * blk + 8 * f;
        float gg[2][2][4];
        { const float* gp = (sec == 0 ? gq : gk) + 32 * blk + 8 * f;
#pragma unroll
            for (int bj = 0; bj < 2; ++bj)
#pragma unroll
                for (int n = 0; n < 2; ++n) { const f32x4 t = *(const f32x4*)(gp + 16 * bj + 4 * n); gg[bj][n][0] = t[0]; gg[bj][n][1] = t[1]; gg[bj][n][2] = t[2]; gg[bj][n][3] = t[3]; } }
#pragma unroll
        for (int ai = 0; ai < 2; ++ai)
#pragma unroll
            for (int m = 0; m < 4; ++m) {
                const int rloc = ai * 128 + wr * 64 + m * 16 + fr; const int r = u.pm * 256 + rloc;
                f32x4 v[2][2];
#pragma unroll
                for (int bj = 0; bj < 2; ++bj)
#pragma unroll
                    for (int n = 0; n < 2; ++n) v[bj][n] = acc[ai][bj][m][n];
                size_t orow;
                if (sec == 0) orow = (size_t)r;
                else if (!ctx) orow = (size_t)(r >> 12) * KVL + CTXL + (r & 4095);
                else { const int j = r - MROWS; orow = (size_t)(j >> 8) * KVL + (j & 255); }
                float ss = 0.f;
#pragma unroll
                for (int bj = 0; bj < 2; ++bj)
#pragma unroll
                    for (int n = 0; n < 2; ++n) ss += (v[bj][n][0] * v[bj][n][0] + v[bj][n][1] * v[bj][n][1]) + (v[bj][n][2] * v[bj][n][2] + v[bj][n][3] * v[bj][n][3]);
                ss += __shfl_xor(ss, 16); ss += __shfl_xor(ss, 32);
                const float rstd = rsqrtf(ss * (1.f / 64.f) + EPS) * (sec == 0 ? QSCALE * Q8SCALE : 1.f);
#pragma unroll
                for (int bj = 0; bj < 2; ++bj)
#pragma unroll
                    for (int n = 0; n < 2; ++n)
#pragma unroll
                        for (int e = 0; e < 4; ++e) v[bj][n][e] *= rstd * gg[bj][n][e];
                if (!ctx) {
                    const int t = r & 4095; const int pos = blk ? (t & 63) : (t >> 6);
                    const float* rp = rope + (size_t)(pos * 16 + 8 * f) * 2;
#pragma unroll
                    for (int n = 0; n < 2; ++n) { const f32x4 c0 = *(const f32x4*)(rp + 8 * n), c1 = *(const f32x4*)(rp + 8 * n + 4);
                        const float cs[4] = {c0[0], c0[2], c1[0], c1[2]}, sn[4] = {c0[1], c0[3], c1[1], c1[3]};
#pragma unroll
                        for (int e = 0; e < 4; ++e) { const float x1 = v[0][n][e], x2 = v[1][n][e]; v[0][n][e] = x1 * cs[e] - x2 * sn[e]; v[1][n][e] = x2 * cs[e] + x1 * sn[e]; } }
                }
                unsigned char* dst = (sec == 0 ? Q8 : K8) + orow * QKW + colbase;
#pragma unroll
                for (int bj = 0; bj < 2; ++bj) { u32x2 w; w.x = pk4_fp8(v[bj][0][0], v[bj][0][1], v[bj][0][2], v[bj][0][3]); w.y = pk4_fp8(v[bj][1][0], v[bj][1][1], v[bj][1][2], v[bj][1][3]);
                    *(u32x2*)(dst + 16 * bj) = w; }
            }
    }
};

struct SchedStatic {
    int G, c, nM, nN; const char* A; const char* B;
    __device__ __forceinline__ bool next(int i, g8::Unit& u) const {
        const long L = (long)i * G + c; if (L >= (long)nM * nN) return false;
        g8::tile_of((int)L, nM, nN, u.pm, u.pn); u.a = A + (size_t)u.pm * 256 * DM * 2; u.b = B + (size_t)u.pn * 256 * DM * 2; u.kind = 0; u.ex = 0; return true;
    }
};
struct EpiOutProj {
    const float* x; bf16_t* out; const float* mod;
    __device__ __forceinline__ void operator()(f32x4 (&acc)[2][2][4][2], const g8::Unit& u, int wr, int wc, int fr, int fq) const {
        asm volatile("" : "+v"(fr), "+v"(fq));
        const int col0 = u.pn * 256 + wc * 32 + 8 * fq;
        const float* g1 = mod + (size_t)((u.pm * 256) >> 12) * (NMOD * DM) + 2 * DM + col0;
        f32x4 gv[2][2];
#pragma unroll
        for (int bj = 0; bj < 2; ++bj)
#pragma unroll
            for (int n = 0; n < 2; ++n) gv[bj][n] = *(const f32x4*)(g1 + bj * 128 + 4 * n);
#pragma unroll
        for (int ai = 0; ai < 2; ++ai)
#pragma unroll
            for (int m = 0; m < 4; ++m) { const int r = u.pm * 256 + ai * 128 + wr * 64 + m * 16 + fr;
                const size_t off = (size_t)r * DM + col0;
#pragma unroll
                for (int bj = 0; bj < 2; ++bj) { f32x4 o[2];
#pragma unroll
                    for (int n = 0; n < 2; ++n) { const f32x4 xv = __builtin_nontemporal_load((const f32x4*)(x + off + bj * 128 + 4 * n)); o[n] = xv + gv[bj][n] * acc[ai][bj][m][n]; }
                    u32x4 w; w.x = cvt_pk_bf16(o[0][0], o[0][1]); w.y = cvt_pk_bf16(o[0][2], o[0][3]); w.z = cvt_pk_bf16(o[1][0], o[1][1]); w.w = cvt_pk_bf16(o[1][2], o[1][3]);
                    *(u32x4*)(out + off + bj * 128) = w; } }
    }
};

namespace att8 {
constexpr int NT = KVL / 64, SHMB = 8192, LDS_V0 = 3 * SHMB;
typedef int i32x8 __attribute__((ext_vector_type(8)));
#define SBAR() __builtin_amdgcn_sched_barrier(0)
__device__ __forceinline__ int crow(int r, int hi) { return (r & 3) + 8 * (r >> 2) + 4 * hi; }
__device__ __forceinline__ i32x8 ld32(const LAS unsigned char* p0, const LAS unsigned char* p1) {
    const u32x4 a = *(const LAS u32x4*)p0, b = *(const LAS u32x4*)p1; return (i32x8){(int)a.x, (int)a.y, (int)a.z, (int)a.w, (int)b.x, (int)b.y, (int)b.z, (int)b.w}; }
__device__ __forceinline__ void mfma_qk(f32x16& p, const i32x8& kf, const i32x8& qf, const f32x16& negc) {
    const unsigned s1 = 0x7f7f7f7fu, sq = 0x7b7b7b7bu;
    asm volatile("s_nop 1\n\tv_mfma_scale_f32_32x32x64_f8f6f4 %0, %1, %2, %3, %4, %5 op_sel_hi:[0,0,0]" : "=&v"(p) : "v"(kf), "v"(qf), "v"(negc), "v"(s1), "v"(sq));
}
__device__ __forceinline__ void mfma_pv(f32x16& o, const i32x8& pa, const i32x8& vf) {
    const unsigned s1 = 0x7f7f7f7fu;
    asm volatile("s_nop 2\n\tv_mfma_scale_f32_32x32x64_f8f6f4 %0, %1, %2, %0, %3, %3 op_sel_hi:[0,0,0]" : "+v"(o) : "v"(pa), "v"(vf), "v"(s1));
}
__device__ __forceinline__ void qkt(f32x16& p0, f32x16& p1, const LAS unsigned char* Kb, const i32x8& qf, const f32x16& negc, int r32, int hi, int sub) {
    const int c0 = sub * 4 + hi * 2;
    const int k0 = r32, k1 = 32 + r32;
    const i32x8 kf0 = ld32(Kb + k0 * 128 + ((c0 ^ ((k0 >> 1) & 7)) << 4), Kb + k0 * 128 + (((c0 + 1) ^ ((k0 >> 1) & 7)) << 4));
    const i32x8 kf1 = ld32(Kb + k1 * 128 + ((c0 ^ ((k1 >> 1) & 7)) << 4), Kb + k1 * 128 + (((c0 + 1) ^ ((k1 >> 1) & 7)) << 4));
    mfma_qk(p0, kf0, qf, negc); mfma_qk(p1, kf1, qf, negc);
}
__device__ __forceinline__ void mfma_wait(f32x16& p0, f32x16& p1) { asm volatile("s_nop 15\n\ts_nop 3" : "+v"(p0), "+v"(p1)); }
__device__ __forceinline__ void expA(f32x16& p) {
#pragma unroll
    for (int r = 0; r < 16; ++r) p[r] = __builtin_amdgcn_exp2f(p[r]);
}
__device__ __forceinline__ void finishSM(f32x16& p0, f32x16& p1, i32x8& pa) {
#pragma unroll
    for (int r = 0; r < 16; ++r) p1[r] = __builtin_amdgcn_exp2f(p1[r]);
#pragma unroll
    for (int j = 0; j < 4; ++j) { pa[j] = (int)pk4_fp8(p0[4 * j], p0[4 * j + 1], p0[4 * j + 2], p0[4 * j + 3]); pa[4 + j] = (int)pk4_fp8(p1[4 * j], p1[4 * j + 1], p1[4 * j + 2], p1[4 * j + 3]); }
}
__device__ __forceinline__ void pv(f32x16* o, f32x16& ol, const i32x8& ones, const LAS unsigned char* Vb, const i32x8& pa, int r32, int hi) {
    mfma_pv(ol, pa, ones);
#pragma unroll
    for (int d0 = 0; d0 < 4; ++d0) { const int d = 32 * d0 + r32, sw = (d >> 2) & 3;
        const i32x8 vf = ld32(Vb + d * 64 + (((2 * hi) ^ sw) << 4), Vb + d * 64 + (((2 * hi + 1) ^ sw) << 4));
        mfma_pv(o[d0], pa, vf); }
}
__device__ __forceinline__ void attn_unit(const unsigned char* __restrict__ Qb, const unsigned char* __restrict__ Kh, const unsigned char* __restrict__ VTh, bf16_t* MIXo,
                                          const float lam, const float* __restrict__ subg, char* lds, const int wid) {
    const int lane = lane_id(), tid = wid * 64 + lane, r32 = lane & 31, hi = lane >> 5;
    const int sub = wid >> 2, wq = wid & 3;
    const LAS unsigned char* L = (const LAS unsigned char*)(uintptr_t)(unsigned)(uintptr_t)lds;
    f32x16 o[4] = {}; f32x16 ol = {};
    i32x8 ones; { int c1 = 0x38383838; asm volatile("" : "+v"(c1)); ones = (i32x8){c1, c1, c1, c1, c1, c1, c1, c1}; }
    i32x8 qf; { const unsigned char* qp = Qb + (size_t)(wq * 32 + r32) * QKW + sub * 64 + 32 * hi; const u32x4 a = *(const u32x4*)qp, b = *(const u32x4*)(qp + 16);
        qf = (i32x8){(int)a.x, (int)a.y, (int)a.z, (int)a.w, (int)b.x, (int)b.y, (int)b.z, (int)b.w}; }
    f32x16 negc;
#pragma unroll
    for (int r = 0; r < 16; ++r) negc[r] = -5.f;
    asm volatile("" : "+v"(negc));
    long ksrc, vsrc;
    { const int r = 8 * wid + (lane >> 3), c = (lane & 7) ^ ((r >> 1) & 7); ksrc = (long)r * QKW + c * 16; }
    { const int d = 16 * wid + (lane >> 2), c = (lane & 3) ^ ((d >> 2) & 3); vsrc = (long)d * 64 + c * 16; }
    const unsigned ldsb = (unsigned)(uintptr_t)lds, kdst = ldsb + (unsigned)wid * 1024u, vdst = ldsb + LDS_V0 + (unsigned)wid * 1024u;
#define DMA_TILE(t, boff) do { \
        __builtin_amdgcn_global_load_lds((const unsigned*)(Kh + (long)(t) * 64 * QKW + ksrc), (LAS unsigned*)(uintptr_t)__builtin_amdgcn_readfirstlane(kdst + (unsigned)(boff)), 16, 0, 0); \
        __builtin_amdgcn_global_load_lds((const unsigned*)(VTh + (long)(t) * 8192 + vsrc), (LAS unsigned*)(uintptr_t)__builtin_amdgcn_readfirstlane(vdst + (unsigned)(boff)), 16, 0, 0); } while (0)
#define WBAR() do { asm volatile("s_waitcnt vmcnt(0) lgkmcnt(0)" ::: "memory"); __builtin_amdgcn_s_barrier(); asm volatile("" ::: "memory"); } while (0)
#define ROT3(x) ((x) == 2 * SHMB ? 0 : (x) + SHMB)
    f32x16 pA0, pA1, pB0, pB1; i32x8 pa;
    DMA_TILE(0, 0); WBAR();
    DMA_TILE(1, SHMB);
    qkt(pA0, pA1, L, qf, negc, r32, hi, sub); mfma_wait(pA0, pA1); expA(pA0);
    WBAR();
    int bprev = 0, bcur = SHMB, bnext = 2 * SHMB;
    for (int j = 1; j + 1 < NT; j += 2) {
        DMA_TILE(j + 1, bnext);
        SBAR(); qkt(pB0, pB1, L + bcur, qf, negc, r32, hi, sub);
        finishSM(pA0, pA1, pa); SBAR();
        pv(o, ol, ones, L + LDS_V0 + bprev, pa, r32, hi); mfma_wait(pB0, pB1); expA(pB0);
        WBAR();
        bprev = bcur; bcur = bnext; bnext = ROT3(bnext);
        if (j + 2 < NT) DMA_TILE(j + 2, bnext);
        SBAR(); qkt(pA0, pA1, L + bcur, qf, negc, r32, hi, sub);
        finishSM(pB0, pB1, pa); SBAR();
        pv(o, ol, ones, L + LDS_V0 + bprev, pa, r32, hi); mfma_wait(pA0, pA1); expA(pA0);
        WBAR();
        bprev = bcur; bcur = bnext; bnext = ROT3(bnext);
    }
    SBAR(); qkt(pB0, pB1, L + bcur, qf, negc, r32, hi, sub);
    finishSM(pA0, pA1, pa); SBAR();
    pv(o, ol, ones, L + LDS_V0 + bprev, pa, r32, hi); mfma_wait(pB0, pB1); expA(pB0);
    finishSM(pB0, pB1, pa); SBAR();
    pv(o, ol, ones, L + LDS_V0 + bcur, pa, r32, hi);
    asm volatile("s_nop 15\n\ts_nop 3" : "+v"(o[0]), "+v"(o[1]), "+v"(o[2]), "+v"(o[3]), "+v"(ol));
#undef ROT3
#undef DMA_TILE
#undef WBAR
    __syncthreads();
    float* X = (float*)lds;
    float rli[16];
#pragma unroll
    for (int r = 0; r < 16; ++r) rli[r] = __builtin_amdgcn_rcpf(ol[r]);
    if (sub == 1) {
#pragma unroll
        for (int r = 0; r < 16; ++r) { const int row = wq * 32 + crow(r, hi); const float sc = lam * rli[r];
#pragma unroll
            for (int d0 = 0; d0 < 4; ++d0) X[row * 128 + d0 * 32 + r32] = o[d0][r] * sc; }
    }
    __syncthreads();
    bf16_t* Y = (bf16_t*)(lds + 65536);
    if (sub == 0) {
        float sg[4];
#pragma unroll
        for (int d0 = 0; d0 < 4; ++d0) sg[d0] = subg[d0 * 32 + r32] * (1.f - LAM_INIT);
#pragma unroll
        for (int r = 0; r < 16; ++r) { const int row = wq * 32 + crow(r, hi);
            float v[4]; float ss = 0.f;
#pragma unroll
            for (int d0 = 0; d0 < 4; ++d0) { v[d0] = o[d0][r] * rli[r] - X[row * 128 + d0 * 32 + r32]; ss += v[d0] * v[d0]; }
            ss += __shfl_xor(ss, 1); ss += __shfl_xor(ss, 2); ss += __shfl_xor(ss, 4); ss += __shfl_xor(ss, 8); ss += __shfl_xor(ss, 16);
            const float rstd = rsqrtf(ss * (1.f / 128.f) + EPS);
#pragma unroll
            for (int d0 = 0; d0 < 4; ++d0) Y[row * 128 + d0 * 32 + r32] = (bf16_t)(cvt_pk_bf16(v[d0] * rstd * sg[d0], 0.f) & 0xffffu); }
    }
    __syncthreads();
    { const int row = tid >> 2, seg = (tid & 3) * 32;
#pragma unroll
        for (int i = 0; i < 4; ++i) { const u32x4 v = *(const u32x4*)(Y + row * 128 + seg + i * 8); *(u32x4*)(MIXo + (size_t)row * DM + seg + i * 8) = v; } }
    __syncthreads();
}
#undef SBAR
}

__device__ __forceinline__ void p3_attention8(Frame& F) {
    FT_DECL;
    const float* sc = WSP(float, WS_SMALL + SM_SCAL);
    const float lam = sc[0];
    const unsigned char* Q8 = WSP(unsigned char, WS_Q); const unsigned char* K8 = WSP(unsigned char, WS_K); const unsigned char* VT8 = WSP(unsigned char, WS_V); bf16_t* MIX = WSP(bf16_t, WS_MIX);
    const int c = blockIdx.x, xcd = c & 7, ci = c >> 3, per = F.G >> 3;
    for (int j = ci; j < 128; j += per) {
        const int pair = xcd * 4 + (j >> 5), qb = j & 31, b = pair >> 2, h = pair & 3;
        att8::attn_unit(Q8 + ((size_t)b * SEQ + qb * 128) * QKW + h * 128, K8 + (size_t)b * KVL * QKW + h * 128, VT8 + (size_t)(b * NHEAD + h) * 68 * 8192,
                        MIX + ((size_t)b * SEQ + qb * 128) * DM + h * 128, lam, F.in[15], (char*)F.lds, F.wave);
    }
}

namespace hy {
constexpr int RB_BYTES = 4352 * 8, IN_OFF = 2 * RB_BYTES, TW1_OFF = IN_OFF + 32768, TW2_OFF = TW1_OFF + 15 * 256 * 8, LDS_END = TW2_OFF + 15 * 16 * 8;
__device__ __forceinline__ f32x2 cmul(f32x2 a, f32x2 b) { return (f32x2){a.x * b.x - a.y * b.y, a.x * b.y + a.y * b.x}; }
__device__ __forceinline__ f32x2 cmulc(f32x2 a, f32x2 b) { return (f32x2){a.x * b.x + a.y * b.y, a.y * b.x - a.x * b.y}; }
__device__ __forceinline__ int P(int i) { return i + (i >> 4); }
template <bool INV> __device__ __forceinline__ void r4(f32x2& a, f32x2& b, f32x2& c, f32x2& d) {
    const f32x2 t0 = a + c, t1 = a - c, t2 = b + d, t3 = b - d;
    const f32x2 st3 = INV ? (f32x2){-t3.y, t3.x} : (f32x2){t3.y, -t3.x};
    a = t0 + t2; c = t0 - t2; b = t1 + st3; d = t1 - st3;
}
template <bool INV> __device__ __forceinline__ f32x2 tw(f32x2 v, float c, float s) {
    return INV ? (f32x2){v.x * c - v.y * s, v.y * c + v.x * s} : (f32x2){v.x * c + v.y * s, v.y * c - v.x * s};
}
template <bool INV> __device__ __forceinline__ void dft16(f32x2 (&v)[16]) {
    constexpr float C1 = 0.9238795325112867f, S1 = 0.3826834323650898f, R2 = 0.7071067811865476f;
    r4<INV>(v[0], v[4], v[8], v[12]); r4<INV>(v[1], v[5], v[9], v[13]); r4<INV>(v[2], v[6], v[10], v[14]); r4<INV>(v[3], v[7], v[11], v[15]);
    v[5] = tw<INV>(v[5], C1, S1);  v[9] = tw<INV>(v[9], R2, R2);    v[13] = tw<INV>(v[13], S1, C1);
    v[6] = tw<INV>(v[6], R2, R2);  v[10] = tw<INV>(v[10], 0.f, 1.f); v[14] = tw<INV>(v[14], -R2, R2);
    v[7] = tw<INV>(v[7], S1, C1);  v[11] = tw<INV>(v[11], -R2, R2);  v[15] = tw<INV>(v[15], -C1, -S1);
    r4<INV>(v[0], v[1], v[2], v[3]); r4<INV>(v[4], v[5], v[6], v[7]); r4<INV>(v[8], v[9], v[10], v[11]); r4<INV>(v[12], v[13], v[14], v[15]);
    f32x2 t;
    t = v[1]; v[1] = v[4]; v[4] = t;   t = v[2]; v[2] = v[8]; v[8] = t;    t = v[3]; v[3] = v[12]; v[12] = t;
    t = v[6]; v[6] = v[9]; v[9] = t;   t = v[7]; v[7] = v[13]; v[13] = t;  t = v[11]; v[11] = v[14]; v[14] = t;
}
struct Ctx { LAS f32x2* R; LAS f32x2* IN; LAS f32x2* TW1; LAS f32x2* TW2; int t, half; f32x2 wt; };
#define HY_OPAQUE(x) asm volatile("" : "+v"(x))
#define HY_W32(m) (f32x2){__builtin_cosf(-0.19634954084936207f * (m)), __builtin_sinf(-0.19634954084936207f * (m))}
template <int MODE> __device__ __forceinline__ void pass1_fwd(const Ctx& X) {
    f32x2 v[16]; int t = X.t; HY_OPAQUE(t);
#pragma unroll
    for (int m = 0; m < 16; ++m) { f32x2 a = X.IN[t + 256 * m]; if (MODE == 1) a = (f32x2){X.half ? a.y : a.x, 0.f}; v[m] = a; }
    if (X.half) {
#pragma unroll
        for (int m = 0; m < 16; ++m) v[m] = cmul(cmul(v[m], HY_W32(m)), X.wt);
    }
    dft16<false>(v);
#pragma unroll
    for (int q = 1; q < 16; ++q) v[q] = cmul(v[q], X.TW1[(q - 1) * 256 + t]);
    const int pb = t + (t >> 4);
#pragma unroll
    for (int q = 0; q < 16; ++q) X.R[pb + 272 * q] = v[q];
}
__device__ __forceinline__ void pass2_fwd(const Ctx& X) {
    int t = X.t; HY_OPAQUE(t);
    const int n2 = t & 15, pb = (t >> 4) * 272 + n2; f32x2 v[16];
#pragma unroll
    for (int m = 0; m < 16; ++m) v[m] = X.R[pb + 17 * m];
    dft16<false>(v);
#pragma unroll
    for (int q = 1; q < 16; ++q) v[q] = cmul(v[q], X.TW2[(q - 1) * 16 + n2]);
#pragma unroll
    for (int q = 0; q < 16; ++q) X.R[pb + 17 * q] = v[q];
}
template <bool FILTER> __device__ __forceinline__ void pass3(const Ctx& X, f32x2 (&H)[16]) {
    f32x2 v[16]; int t = X.t; HY_OPAQUE(t); const int pb = 17 * t;
#pragma unroll
    for (int m = 0; m < 16; ++m) v[m] = X.R[pb + m];
    dft16<false>(v);
    if (FILTER) {
#pragma unroll
        for (int q = 0; q < 16; ++q) H[q] = v[q] * (1.f / 8192.f);
    } else {
#pragma unroll
        for (int q = 0; q < 16; ++q) v[q] = cmul(v[q], H[q]);
        dft16<true>(v);
#pragma unroll
        for (int m = 0; m < 16; ++m) X.R[pb + m] = v[m];
    }
}
__device__ __forceinline__ void pass2_inv(const Ctx& X) {
    int t = X.t; HY_OPAQUE(t);
    const int n2 = t & 15, pb = (t >> 4) * 272 + n2; f32x2 v[16];
    v[0] = X.R[pb];
#pragma unroll
    for (int q = 1; q < 16; ++q) v[q] = cmulc(X.R[pb + 17 * q], X.TW2[(q - 1) * 16 + n2]);
    dft16<true>(v);
#pragma unroll
    for (int m = 0; m < 16; ++m) X.R[pb + 17 * m] = v[m];
}
__device__ __forceinline__ void pass1_inv(const Ctx& X) {
    f32x2 v[16]; int t = X.t; HY_OPAQUE(t); const int pb = t + (t >> 4);
    v[0] = X.R[pb];
#pragma unroll
    for (int q = 1; q < 16; ++q) v[q] = cmulc(X.R[pb + 272 * q], X.TW1[(q - 1) * 256 + t]);
    dft16<true>(v);
    if (X.half) {
#pragma unroll
        for (int m = 0; m < 16; ++m) v[m] = cmulc(cmulc(v[m], HY_W32(m)), X.wt);
    }
#pragma unroll
    for (int m = 0; m < 16; ++m) X.R[pb + 272 * m] = v[m];
}
#define HY_WSYNC() asm volatile("s_waitcnt lgkmcnt(0)" ::: "memory")
__device__ __forceinline__ void conv_fft(const Ctx& X, f32x2 (&H)[16]) {
    __syncthreads(); pass1_fwd<0>(X); __syncthreads(); pass2_fwd(X); HY_WSYNC(); pass3<false>(X, H); HY_WSYNC(); pass2_inv(X); __syncthreads(); pass1_inv(X); __syncthreads();
}
constexpr int STG_OFF = LDS_END;
constexpr int LDS_END2 = STG_OFF + 2 * SEQ * 2;
static_assert(LDS_END2 <= LDSCTL_OFF, "hyena LDS map");
__device__ __forceinline__ float sconv_lds(const LAS bf16_t* stg, int bs, int n, float w0, float w1, float w2, float bias) {
    const LAS bf16_t* p = stg + bs * SEQ;
    const float c = bf2f(p[n]), lv = bf2f(p[n - ((n > 0) ? 1 : 0)]), rv = bf2f(p[n + ((n < SEQ - 1) ? 1 : 0)]);
    const float l = (n > 0) ? lv : 0.f, r = (n < SEQ - 1) ? rv : 0.f;
    return bias + w0 * l + w1 * c + w2 * r;
}
__device__ __forceinline__ void setup_tables(LAS unsigned char* lds, int tid) {
    LAS f32x2* TW1 = (LAS f32x2*)(lds + TW1_OFF); LAS f32x2* TW2 = (LAS f32x2*)(lds + TW2_OFF);
    for (int i = tid; i < 15 * 256; i += 512) { const int q = i / 256 + 1, t = i & 255; float s, c; sincosf(-6.283185307179586f * (float)((t * q) & 4095) * (1.f / 4096.f), &s, &c); TW1[i] = (f32x2){c, s}; }
    for (int i = tid; i < 15 * 16; i += 512) { const int q = i / 16 + 1, n2 = i & 15; float s, c; sincosf(-6.283185307179586f * (float)((n2 * q) & 255) * (1.f / 256.f), &s, &c); TW2[i] = (f32x2){c, s}; }
}
__device__ __forceinline__ void unit(Frame& F, int c) {
    FT_DECL;
    const int tid = f_tid; Ctx X; X.half = F.wave >> 2; X.t = tid & 255;
    X.R = (LAS f32x2*)(F.lds + X.half * RB_BYTES); X.IN = (LAS f32x2*)(F.lds + IN_OFF); X.TW1 = (LAS f32x2*)(F.lds + TW1_OFF); X.TW2 = (LAS f32x2*)(F.lds + TW2_OFF);
    { float s, cc; sincosf(-6.283185307179586f * (float)X.t * (1.f / 8192.f), &s, &cc); X.wt = (f32x2){cc, s}; }
    LAS f32x2* RB0 = (LAS f32x2*)(F.lds); LAS f32x2* RB1 = (LAS f32x2*)(F.lds + RB_BYTES);
    const float* FILT = WSP(float, WS_FILT);
    f32x2 H0[16], H1[16];
#pragma unroll
    for (int ord = 0; ord < 2; ++ord) {
        const float* hf = FILT + ((size_t)(ord * 2 + 0) * 512 + c) * SEQ; const float* hb = FILT + ((size_t)(ord * 2 + 1) * 512 + c) * SEQ;
        __syncthreads();
        int nb = tid; HY_OPAQUE(nb);
#pragma unroll
        for (int j = 0; j < 8; ++j) { const int n = nb + 512 * j; const float a = hf[n], b = hb[(SEQ - n) & (SEQ - 1)]; const float lo = (n == 0) ? a + b : a, hi = (n == 0) ? 0.f : b; X.IN[n] = (f32x2){lo + hi, lo - hi}; }
        __syncthreads(); pass1_fwd<1>(X); __syncthreads(); pass2_fwd(X); HY_WSYNC();
        if (ord == 0) pass3<true>(X, H0); else pass3<true>(X, H1);
    }
    const bf16_t* UT = WSP(bf16_t, WS_UT);
    const bf16_t* rv = UT + (size_t)c * 128; const bf16_t* r1 = UT + (size_t)(512 + c) * 128; const bf16_t* r2 = UT + (size_t)(1024 + c) * 128;
#define HY_LD(rowp, t) (*(const u32x4*)((rowp) + (size_t)((t) >> 7) * (HYC * 128) + ((t) & 127)))
    const float* cw = F.in[16]; const float* cb = F.in[17];
    const float wv0 = cw[c], wv1 = cw[HYC + c], wv2 = cw[2 * HYC + c], bv = cb[c];
    const float wa0 = cw[512 + c], wa1 = cw[HYC + 512 + c], wa2 = cw[2 * HYC + 512 + c], ba = cb[512 + c];
    const float wb0 = cw[1024 + c], wb1 = cw[HYC + 1024 + c], wb2 = cw[2 * HYC + 1024 + c], bb = cb[1024 + c];
    const float sk0 = F.in[25][c], sk1 = F.in[25][512 + c];
    bf16_t* Z = WSP(bf16_t, WS_Z2T) + (size_t)c * 128;
    LAS bf16_t* STG = (LAS bf16_t*)(F.lds + STG_OFF);
    u32x4 g0 = HY_LD(rv, tid * 8), g1 = HY_LD(rv, SEQ + tid * 8);
    for (int pr = 0; pr < 4; ++pr) {
        const int b0 = 2 * pr, b1 = b0 + 1;
        f32x2 z[8]; int pc = tid + (tid >> 4); HY_OPAQUE(pc); int nb = tid; HY_OPAQUE(nb);
        __syncthreads();
        *(LAS u32x4*)(STG + tid * 8) = g0; *(LAS u32x4*)(STG + SEQ + tid * 8) = g1;
        __syncthreads();
#pragma unroll
        for (int j = 0; j < 8; ++j) { const int n = nb + 512 * j; z[j] = (f32x2){sconv_lds(STG, 0, n, wv0, wv1, wv2, bv), sconv_lds(STG, 1, n, wv0, wv1, wv2, bv)}; X.IN[n] = z[j]; }
        g0 = HY_LD(r1, b0 * SEQ + tid * 8); g1 = HY_LD(r1, b1 * SEQ + tid * 8);
        conv_fft(X, H0);
        *(LAS u32x4*)(STG + tid * 8) = g0; *(LAS u32x4*)(STG + SEQ + tid * 8) = g1;
        __syncthreads();
        HY_OPAQUE(nb); HY_OPAQUE(pc);
#pragma unroll
        for (int j = 0; j < 8; ++j) { const int n = nb + 512 * j; const f32x2 y = RB0[pc + 544 * j] + RB1[pc + 544 * j];
            const f32x2 g = (f32x2){sconv_lds(STG, 0, n, wa0, wa1, wa2, ba), sconv_lds(STG, 1, n, wa0, wa1, wa2, ba)};
            z[j] = g * (y + sk0 * z[j]); X.IN[n] = z[j]; }
        g0 = HY_LD(r2, b0 * SEQ + tid * 8); g1 = HY_LD(r2, b1 * SEQ + tid * 8);
        conv_fft(X, H1);
        *(LAS u32x4*)(STG + tid * 8) = g0; *(LAS u32x4*)(STG + SEQ + tid * 8) = g1;
        __syncthreads();
        if (pr < 3) { g0 = HY_LD(rv, (b0 + 2) * SEQ + tid * 8); g1 = HY_LD(rv, (b1 + 2) * SEQ + tid * 8); }
        HY_OPAQUE(nb); HY_OPAQUE(pc);
        f32x2 o[8];
#pragma unroll
        for (int j = 0; j < 8; ++j) { const int n = nb + 512 * j; const f32x2 y = RB0[pc + 544 * j] + RB1[pc + 544 * j];
            const f32x2 g = (f32x2){sconv_lds(STG, 0, n, wb0, wb1, wb2, bb), sconv_lds(STG, 1, n, wb0, wb1, wb2, bb)};
            o[j] = g * (y + sk1 * z[j]); }
        __syncthreads();
#pragma unroll
        for (int j = 0; j < 8; ++j) { const int n = nb + 512 * j; STG[n] = (bf16_t)(cvt_pk_bf16(o[j].x, 0.f) & 0xffffu); STG[SEQ + n] = (bf16_t)(cvt_pk_bf16(o[j].y, 0.f) & 0xffffu); }
        __syncthreads();
        { const int t0 = b0 * SEQ + tid * 8, t1 = b1 * SEQ + tid * 8;
          *(u32x4*)(Z + (size_t)(t0 >> 7) * (HYW * 128) + (t0 & 127)) = *(const LAS u32x4*)(STG + tid * 8); *(u32x4*)(Z + (size_t)(t1 >> 7) * (HYW * 128) + (t1 & 127)) = *(const LAS u32x4*)(STG + SEQ + tid * 8); }
    }
    __syncthreads();
}
}

__device__ __forceinline__ void p3_hyena(Frame& F) {
    FT_DECL;
    __syncthreads();
    hy::setup_tables(F.lds, f_tid);
    __syncthreads();
    for (int c = F.vcu; c < HYW; c += F.G) hy::unit(F, c);
}

__device__ __forceinline__ void p4_hynorm(Frame& F) {
    FT_DECL;
    const bf16_t* Z = WSP(bf16_t, WS_Z2T); bf16_t* MIX = WSP(bf16_t, WS_MIX); const float* g = F.in[26];
    constexpr int TP = 132;
    LAS bf16_t* T = (LAS bf16_t*)F.lds;
    LAS float* red = (LAS float*)(F.lds + 512 * TP * 2);
    LAS float* rs = red + 512;
    float gl[8];
#pragma unroll
    for (int e = 0; e < 8; ++e) gl[e] = g[(f_tid & 63) + 64 * e];
    for (int it = F.vcu; it < MROWS / 128; it += F.G) {
        const int tok0 = it * 128; const bf16_t* zt = Z + (size_t)it * (HYW * 128);
        __syncthreads();
        u32x4 v[16];
#pragma unroll
        for (int j = 0; j < 16; ++j) v[j] = __builtin_nontemporal_load((const u32x4*)(zt + (size_t)(f_tid + 512 * j) * 8));
#pragma unroll
        for (int j = 0; j < 16; ++j) { const int i = f_tid + 512 * j; LAS u32x2* d = (LAS u32x2*)(T + (i >> 4) * TP + (i & 15) * 8); d[0] = (u32x2){v[j].x, v[j].y}; d[1] = (u32x2){v[j].z, v[j].w}; }
        __syncthreads();
        { const int tok = f_tid & 127, grp = f_tid >> 7; float ss = 0.f;
#pragma unroll 8
            for (int k = 0; k < 128; ++k) { const float x = bf2f(T[(grp * 128 + k) * TP + tok]); ss += x * x; }
            red[grp * 128 + tok] = ss; }
        __syncthreads();
        if (f_tid < 128) rs[f_tid] = rsqrtf(((red[f_tid] + red[128 + f_tid]) + (red[256 + f_tid] + red[384 + f_tid])) * (1.f / HYW) + EPS);
        __syncthreads();
#pragma unroll
        for (int j = 0; j < 16; ++j) { const int i = f_tid + 512 * j, tok = i >> 6, l = i & 63; const float r = rs[tok];
            float x[8];
#pragma unroll
            for (int e = 0; e < 8; ++e) x[e] = bf2f(T[(l + 64 * e) * TP + tok]) * r * gl[e];
            u32x4 w; w.x = cvt_pk_bf16(x[0], x[1]); w.y = cvt_pk_bf16(x[2], x[3]); w.z = cvt_pk_bf16(x[4], x[5]); w.w = cvt_pk_bf16(x[6], x[7]);
            *(u32x4*)(MIX + (size_t)(tok0 + tok) * DM + 512 + 8 * l) = w; }
    }
}

constexpr size_t RT_TOPI = 0;
constexpr size_t RT_GATE = 512 * 1024;
constexpr size_t RT_POS = 1024 * 1024;
constexpr size_t RT_WGCNT = 1536 * 1024;
constexpr size_t RT_META = 1600 * 1024;
constexpr size_t RT_LIST = 2048 * 1024;
constexpr size_t RT_GSLOT = 2048 * 1024 + 640 * 1024;
constexpr int MAXSLOT = MROWS * TOPK + NEXP * 256;
constexpr int MAXTILE = MAXSLOT / 256;
constexpr size_t WS_XS = WS_EO;
constexpr int RW_PITCH = 32;
constexpr int P6_LDS_TOPI = 1024 * RW_PITCH * 4;

__device__ __forceinline__ void p6_router_mfma(Frame& F) {
    FT_DECL;
#define in F.in
    LAS float* WP = (LAS float*)F.lds;
    LAS int* TI = (LAS int*)(F.lds + P6_LDS_TOPI);
    LAS int* PS = TI + 512;
    LAS int* SC = PS + 512;
    LAS float* RSTD = (LAS float*)(SC + 512);
    LAS float* BIAS = RSTD + 128;
    LAS float* SSX = BIAS + 32;
    const float* rw = in[28]; const float* mod = WSP(float, WS_SMALL + SM_MOD); const float* g2n = in[7]; const float* rb = in[29];
    const bf16_t* XN = WSP(bf16_t, WS_XN); unsigned char* H2 = WSP(unsigned char, WS_H);
    int* topi_g = WSP(int, WS_ROUTE + RT_TOPI); float* gate_g = WSP(float, WS_ROUTE + RT_GATE); int* pos_g = WSP(int, WS_ROUTE + RT_POS); int* wgcnt = WSP(int, WS_ROUTE + RT_WGCNT);
    for (int blk = blockIdx.x; blk < MROWS / 128; blk += F.G) {
        const float* sh2 = mod + (size_t)(blk >> 5) * (NMOD * DM) + 3 * DM; const float* sc2 = sh2 + DM;
        __syncthreads();
#pragma unroll 1
        for (int hb = 0; hb < 2; ++hb) { f32x4 wv[8]; float gm[8];
#pragma unroll
            for (int q = 0; q < 8; ++q) { const int i = f_tid + 512 * (8 * hb + q), k = i >> 3, c4 = i & 7; wv[q] = *(const f32x4*)(rw + (size_t)k * 32 + c4 * 4); gm[q] = g2n[k] * (1.f + sc2[k]); }
#pragma unroll
            for (int q = 0; q < 8; ++q) { const int i = f_tid + 512 * (8 * hb + q), k = i >> 3, c4 = i & 7; *(LAS f32x4*)(WP + k * 32 + c4 * 4) = wv[q] * gm[q]; } }
        { const int e = f_tid & 31, part = f_tid >> 5; float a = 0.f;
#pragma unroll 1
            for (int k0 = part * 64; k0 < part * 64 + 64; k0 += 8) { float w[8], sh[8];
#pragma unroll
                for (int q = 0; q < 8; ++q) { w[q] = rw[(size_t)(k0 + q) * 32 + e]; sh[q] = sh2[k0 + q]; }
#pragma unroll
                for (int q = 0; q < 8; ++q) a += sh[q] * w[q]; }
            ((LAS float*)SC)[part * 32 + e] = a; }
        __syncthreads();
        if (f_tid < 32) { float a = rb[f_tid];
#pragma unroll
            for (int p = 0; p < 16; ++p) a += ((LAS float*)SC)[p * 32 + f_tid];
            BIAS[f_tid] = a; }
        const int rg = F.wave & 3, kh = F.wave >> 2, j = f_lane & 31, hi = f_lane >> 5;
        f32x16 acc = {};
        float ss = 0.f;
        { const bf16_t* xrow = XN + (size_t)(blk * 128 + rg * 32 + j) * DM + 512 * kh + 8 * hi;
            const LAS float* wp = WP + (512 * kh + 8 * hi) * 32 + j;
#pragma unroll 8
            for (int c = 0; c < 32; ++c) { const u32x4 xb = *(const u32x4*)(xrow + 16 * c);
                float xf[8] = {__uint_as_float(xb.x << 16), __uint_as_float(xb.x & 0xffff0000u), __uint_as_float(xb.y << 16), __uint_as_float(xb.y & 0xffff0000u),
                               __uint_as_float(xb.z << 16), __uint_as_float(xb.z & 0xffff0000u), __uint_as_float(xb.w << 16), __uint_as_float(xb.w & 0xffff0000u)};
#pragma unroll
                for (int q = 0; q < 8; ++q) { ss += xf[q] * xf[q]; acc = __builtin_amdgcn_mfma_f32_32x32x2f32(wp[(16 * c + q) * 32], xf[q], acc, 0, 0, 0); } } }
        { auto rr = __builtin_amdgcn_permlane32_swap(__float_as_uint(ss), __float_as_uint(ss), false, false); ss = __uint_as_float(rr[0]) + __uint_as_float(rr[1]); }
        if (hi == 0) SSX[kh * 128 + rg * 32 + j] = ss;
        __syncthreads();
        if (kh == 1) {
#pragma unroll
            for (int r = 0; r < 16; ++r) WP[(rg * 16 + r) * 64 + f_lane] = acc[r]; }
        if (f_tid < 128) RSTD[f_tid] = rsqrtf((SSX[f_tid] + SSX[128 + f_tid]) * (1.f / DM) + EPS);
        __syncthreads();
        if (kh == 0) {
            const float rstd = RSTD[rg * 32 + j];
            float tv[4] = {-INFINITY, -INFINITY, -INFINITY, -INFINITY}; int ti[4] = {1 << 20, 1 << 20, 1 << 20, 1 << 20};
#define P6_INS(V, E) do { float cv = (V); int ce = (E); _Pragma("unroll") for (int q = 0; q < 4; ++q) { const bool b = cv > tv[q] || (cv == tv[q] && ce < ti[q]); \
                const float nv = b ? tv[q] : cv; const int ne = b ? ti[q] : ce; tv[q] = b ? cv : tv[q]; ti[q] = b ? ce : ti[q]; cv = nv; ce = ne; } } while (0)
#pragma unroll
            for (int r = 0; r < 16; ++r) { const int e = (r & 3) + 8 * (r >> 2) + 4 * hi; const float v = (acc[r] + WP[(rg * 16 + r) * 64 + f_lane]) * rstd + BIAS[e]; P6_INS(v, e); }
            float ov[4]; int oe[4];
#pragma unroll
            for (int q = 0; q < 4; ++q) { ov[q] = __shfl_xor(tv[q], 32); oe[q] = __shfl_xor(ti[q], 32); }
#pragma unroll
            for (int q = 0; q < 4; ++q) P6_INS(ov[q], oe[q]);
#undef P6_INS
            if (hi == 0) { const int rl = rg * 32 + j, r = blk * 128 + rl;
                const float e1 = __expf(tv[1] - tv[0]), e2 = __expf(tv[2] - tv[0]), e3 = __expf(tv[3] - tv[0]); const float inv = 1.f / (1.f + e1 + e2 + e3);
                typedef int i32x4_t __attribute__((ext_vector_type(4))); const i32x4_t t4 = {ti[0], ti[1], ti[2], ti[3]};
                *(i32x4_t*)(topi_g + (size_t)r * 4) = t4; *(f32x4*)(gate_g + (size_t)r * 4) = (f32x4){inv, e1 * inv, e2 * inv, e3 * inv};
                *(LAS i32x4_t*)(TI + rl * 4) = t4; }
        }
        __syncthreads();
        { const int t2 = F.wave * 64 + lane_id(); const int e = t2 & 31, seg = t2 >> 5; int cnt = 0;
#pragma unroll 4
            for (int i = 0; i < 32; ++i) cnt += (TI[seg * 32 + i] == e) ? 1 : 0;
            SC[seg * 32 + e] = cnt;
            __syncthreads();
            int pre = 0;
            for (int s2 = 0; s2 < seg; ++s2) pre += SC[s2 * 32 + e];
            if (seg == 15) wgcnt[blk * 32 + e] = pre + cnt;
            for (int i = 0; i < 32; ++i) if (TI[seg * 32 + i] == e) { PS[seg * 32 + i] = pre; ++pre; }
        }
        __syncthreads();
        { const int t3 = F.wave * 64 + lane_id(); pos_g[(size_t)blk * 512 + t3] = PS[t3]; }
        { const int lane = lane_id();
            f32x4 PA[4], PB[4];
#pragma unroll
            for (int jj = 0; jj < 4; ++jj) { const int c = 4 * lane + 256 * jj; PA[jj] = *(const f32x4*)(g2n + c) * (*(const f32x4*)(sc2 + c) + 1.f); PB[jj] = *(const f32x4*)(sh2 + c); }
            for (int it = 0; it < 4; ++it) { u32x2 xb[4][4];
#pragma unroll
                for (int u = 0; u < 4; ++u) { const GAS u32x2* xr = (const GAS u32x2*)(XN + (size_t)(blk * 128 + F.wave * 16 + 4 * it + u) * DM) + lane;
#pragma unroll
                    for (int jj = 0; jj < 4; ++jj) xb[u][jj] = xr[64 * jj]; }
#pragma unroll
                for (int u = 0; u < 4; ++u) { const int rl = F.wave * 16 + 4 * it + u; const float rstd = RSTD[rl];
                    GAS unsigned* o4 = (GAS unsigned*)(H2 + (size_t)(blk * 128 + rl) * DM) + lane;
#pragma unroll
                    for (int jj = 0; jj < 4; ++jj) {
                        const f32x4 x = (f32x4){__uint_as_float(xb[u][jj].x << 16), __uint_as_float(xb[u][jj].x & 0xffff0000u), __uint_as_float(xb[u][jj].y << 16), __uint_as_float(xb[u][jj].y & 0xffff0000u)};
                        const f32x4 h = x * rstd * PA[jj] + PB[jj];
                        o4[64 * jj] = pk4_fp8(h.x, h.y, h.z, h.w); } } }
        }
    }
#undef in
}

__device__ __forceinline__ void p7_scatter(Frame& F) {
    FT_DECL;
    LAS int* TOT = (LAS int*)F.lds;
    LAS int* BASE = TOT + 32;
    LAS int* PRE = BASE + 32;
    LAS int* PART = PRE + 32;
    const int* wgcnt = WSP(int, WS_ROUTE + RT_WGCNT); const int* topi_g = WSP(int, WS_ROUTE + RT_TOPI); const float* gate_g = WSP(float, WS_ROUTE + RT_GATE); const int* pos_g = WSP(int, WS_ROUTE + RT_POS);
    int* list = WSP(int, WS_ROUTE + RT_LIST); float* gslot = WSP(float, WS_ROUTE + RT_GSLOT); int* meta = WSP(int, WS_ROUTE + RT_META);
    for (int blk = blockIdx.x; blk < MROWS / 128; blk += F.G) {
        __syncthreads();
        { const int e = f_tid & 31, part = f_tid >> 5; int st = 0, sp = 0;
            for (int w = part * 16; w < part * 16 + 16; ++w) { const int c = wgcnt[w * 32 + e]; st += c; if (w < blk) sp += c; }
            PART[part * 32 + e] = st; PART[512 + part * 32 + e] = sp; }
        __syncthreads();
        if (f_tid < 32) { int st = 0, sp = 0;
#pragma unroll
            for (int p = 0; p < 16; ++p) { st += PART[p * 32 + f_tid]; sp += PART[512 + p * 32 + f_tid]; }
            TOT[f_tid] = st; PRE[f_tid] = sp; }
        __syncthreads();
        if (f_tid == 0) { int b = 0; for (int e = 0; e < 32; ++e) { BASE[e] = b; b += (TOT[e] + 255) & ~255; }
            if (blk == 0) { int t = 0; for (int e = 0; e < 32; ++e) { meta[e] = TOT[e]; meta[32 + e] = BASE[e]; const int nt = (TOT[e] + 255) >> 8; for (int q = 0; q < nt; ++q) meta[128 + t + q] = e; t += nt; } meta[64] = t; } }
        __syncthreads();
        { const int a = f_tid, row = blk * 128 + (a >> 2); const int e = topi_g[(size_t)blk * 512 + a]; const int slot = BASE[e] + PRE[e] + pos_g[(size_t)blk * 512 + a];
            list[slot] = row * 4 + (a & 3); gslot[slot] = gate_g[(size_t)blk * 512 + a];
            PART[a] = slot; }
        __syncthreads();
        if (blk < NEXP) { const int e = blk, lo = BASE[e] + TOT[e], hi = BASE[e] + ((TOT[e] + 255) & ~255);
            for (int sl = lo + f_tid; sl < hi; sl += 512) { list[sl] = -1; gslot[sl] = 0.f; } }
    }
}

template <int NPN> struct SchedMoE {
    int G, c, nT; const char* A; const char* W; size_t wstride; const LAS unsigned char* tileE; const LAS int* RW; bool gath;
    __device__ __forceinline__ const LAS int* rows(int i) const { return RW + i * 256; }
    __device__ __forceinline__ bool next(int i, g8::Unit& u) const {
        const int L = i * G + c, xcd = L & 7, j = L >> 3, T = (j / NPN) * 8 + xcd, pn = j % NPN;
        if (T >= nT) return false;
        const int e = tileE[T];
        u.pm = T; u.pn = pn; u.kind = i; u.ex = e; u.a = gath ? A : A + (size_t)T * 256 * DM; u.b = W + (size_t)e * wstride + (size_t)pn * 256 * DM; return true;
    }
};
struct EpiSwiGLU {
    unsigned char* ACT; const float* b1;
    __device__ __forceinline__ void operator()(f32x4 (&acc)[2][2][4][2], const g8::Unit& u, int wr, int wc, int fr, int fq) const {
        asm volatile("" : "+v"(fr), "+v"(fq));
        const int j0 = u.pn * 128 + wc * 32 + 8 * fq; const float* bp = b1 + (size_t)u.ex * 2 * DM + j0;
        f32x4 bg[2], bl[2];
#pragma unroll
        for (int n = 0; n < 2; ++n) { bg[n] = *(const f32x4*)(bp + 4 * n); bl[n] = *(const f32x4*)(bp + DM + 4 * n); }
#pragma unroll
        for (int ai = 0; ai < 2; ++ai)
#pragma unroll
            for (int m = 0; m < 4; ++m) { const size_t slot = (size_t)u.pm * 256 + ai * 128 + wr * 64 + m * 16 + fr; float o[8];
#pragma unroll
                for (int n = 0; n < 2; ++n) { const f32x4 g4 = acc[ai][0][m][n] * (1.f / WSCALE) + bg[n], l4 = acc[ai][1][m][n] * (1.f / WSCALE) + bl[n];
#pragma unroll
                    for (int e = 0; e < 4; ++e) { const float g = fminf(g4[e], 7.f), l = __builtin_amdgcn_fmed3f(l4[e], -7.f, 7.f);
                        const float ex = __builtin_amdgcn_exp2f(g * (-1.702f * 1.4426950408889634f)); const float glu = g * __builtin_amdgcn_rcpf(1.f + ex);
                        o[4 * n + e] = fmaf(l, glu, glu); } }
                u32x2 w; w.x = pk4_fp8(o[0], o[1], o[2], o[3]); w.y = pk4_fp8(o[4], o[5], o[6], o[7]);
                *(u32x2*)(ACT + slot * DM + j0) = w; }
    }
};
struct EpiDown {
    unsigned char* EO; const float* b2; const LAS int* LL; int G, c;
    __device__ __forceinline__ void operator()(f32x4 (&acc)[2][2][4][2], const g8::Unit& u, int wr, int wc, int fr, int fq) const {
        asm volatile("" : "+v"(fr), "+v"(fq));
        const int c0 = u.pn * 256 + wc * 64 + 16 * fq; const float* bp = b2 + (size_t)u.ex * DM + c0;
        f32x4 bb[2][2];
#pragma unroll
        for (int bj = 0; bj < 2; ++bj)
#pragma unroll
            for (int n = 0; n < 2; ++n) bb[bj][n] = *(const f32x4*)(bp + bj * 8 + 4 * n);
        const LAS int* L = LL + u.kind * 512;
        int li[8]; float gt[8];
#pragma unroll
        for (int q = 0; q < 8; ++q) { const int rl = (q >> 2) * 128 + wr * 64 + (q & 3) * 16 + fr; li[q] = L[rl]; gt[q] = __int_as_float(L[256 + rl]) * (1.f / WSCALE); }
#pragma unroll
        for (int ai = 0; ai < 2; ++ai)
#pragma unroll
            for (int m = 0; m < 4; ++m) { const int l = li[ai * 4 + m]; const float g = gt[ai * 4 + m];
                unsigned char* dst = EO + ((size_t)(l & 3) * MROWS + (l >> 2)) * DM + c0;
                u32x4 w;
                { const f32x4 v0 = acc[ai][0][m][0] * g + bb[0][0] * (g * WSCALE), v1 = acc[ai][0][m][1] * g + bb[0][1] * (g * WSCALE);
                  w.x = pk4_fp8(v0[0] * EOSCALE, v0[1] * EOSCALE, v0[2] * EOSCALE, v0[3] * EOSCALE); w.y = pk4_fp8(v1[0] * EOSCALE, v1[1] * EOSCALE, v1[2] * EOSCALE, v1[3] * EOSCALE); }
                { const f32x4 v0 = acc[ai][1][m][0] * g + bb[1][0] * (g * WSCALE), v1 = acc[ai][1][m][1] * g + bb[1][1] * (g * WSCALE);
                  w.z = pk4_fp8(v0[0] * EOSCALE, v0[1] * EOSCALE, v0[2] * EOSCALE, v0[3] * EOSCALE); w.w = pk4_fp8(v1[0] * EOSCALE, v1[1] * EOSCALE, v1[2] * EOSCALE, v1[3] * EOSCALE); }
                if (l >= 0) *(u32x4*)dst = w; }
    }
};
__device__ __forceinline__ const LAS unsigned char* moe_tiles(Frame& F, int& nT) {
    FT_DECL;
    LAS unsigned char* TE = (LAS unsigned char*)(F.lds + RING_BYTES); const int* meta = WSP(int, WS_ROUTE + RT_META);
    __syncthreads();
    nT = meta[64]; if (nT > MAXTILE) nT = MAXTILE;
    for (int i = f_tid; i < MAXTILE; i += 512) TE[i] = (unsigned char)((i < nT) ? meta[128 + i] : 0);
    __syncthreads();
    return (const LAS unsigned char*)TE;
}

__device__ __forceinline__ void p10_combine(Frame& F) {
    FT_DECL;
    const float* mod = WSP(float, WS_SMALL + SM_MOD); const unsigned char* EO = WSP(unsigned char, WS_EO);
    const size_t gt = (size_t)F.vcu * 512 + f_tid, NTH = (size_t)F.G * 512;
    constexpr int U = 4;
    for (size_t i0 = gt; i0 < (size_t)MROWS * 128; i0 += NTH * U) {
        u32x2 ev[U][4]; f32x4 xv[U][2], gv[U][2];
#pragma unroll
        for (int u = 0; u < U; ++u) { const size_t i = i0 + (size_t)u * NTH; const size_t row = i >> 7; const int c0 = (int)(i & 127) * 8;
            const float* g2 = mod + (size_t)(row >> 12) * (NMOD * DM) + 5 * DM + c0; const bf16_t* op = WSP(bf16_t, WS_XN) + row * DM + c0;
#pragma unroll
            for (int k = 0; k < 4; ++k) ev[u][k] = __builtin_nontemporal_load((const u32x2*)(EO + ((size_t)k * MROWS + row) * DM + c0));
            { const u32x4 xb = *(const u32x4*)op; xv[u][0] = (f32x4){__uint_as_float(xb.x << 16), __uint_as_float(xb.x & 0xffff0000u), __uint_as_float(xb.y << 16), __uint_as_float(xb.y & 0xffff0000u)};
              xv[u][1] = (f32x4){__uint_as_float(xb.z << 16), __uint_as_float(xb.z & 0xffff0000u), __uint_as_float(xb.w << 16), __uint_as_float(xb.w & 0xffff0000u)}; }
            gv[u][0] = *(const f32x4*)g2; gv[u][1] = *(const f32x4*)(g2 + 4); }
#pragma unroll
        for (int u = 0; u < U; ++u) { const size_t i = i0 + (size_t)u * NTH; const size_t row = i >> 7; const int c0 = (int)(i & 127) * 8;
            float s[8];
#pragma unroll
            for (int e = 0; e < 8; ++e) s[e] = 0.f;
#pragma unroll
            for (int k = 0; k < 4; ++k) { const u32x2 v = ev[u][k];
                const f32x2 a = __builtin_amdgcn_cvt_pk_f32_fp8((int)v.x, false), b = __builtin_amdgcn_cvt_pk_f32_fp8((int)v.x, true), c = __builtin_amdgcn_cvt_pk_f32_fp8((int)v.y, false), d = __builtin_amdgcn_cvt_pk_f32_fp8((int)v.y, true);
                s[0] += a.x; s[1] += a.y; s[2] += b.x; s[3] += b.y; s[4] += c.x; s[5] += c.y; s[6] += d.x; s[7] += d.y; }
#pragma unroll
            for (int e = 0; e < 8; ++e) s[e] *= (1.f / EOSCALE);
            f32x4 o0 = xv[u][0] + gv[u][0] * (f32x4){s[0], s[1], s[2], s[3]}, o1 = xv[u][1] + gv[u][1] * (f32x4){s[4], s[5], s[6], s[7]};
            float* op = F.out + row * DM + c0;
            __builtin_nontemporal_store(o0, (f32x4*)op); __builtin_nontemporal_store(o1, (f32x4*)(op + 4)); }
    }
}

struct Args { const float* in[34]; float* out; unsigned char* ws; int ph_lo, ph_hi; };
constexpr int N_PHASES = 11;

__global__ void __launch_bounds__(512, 2) mega(Args args) {
    extern __shared__ __attribute__((aligned(16))) unsigned char lds[];
    Frame F;
    F.lds = (LAS unsigned char*)lds;
    F.MISC = (volatile LAS unsigned*)(F.lds + LDSCTL_OFF);
    F.wave = __builtin_amdgcn_readfirstlane(threadIdx.x >> 6);
    FT_DECL;
    F.G = gridDim.x; { const int bx = blockIdx.x; F.vcu = (F.G % 8 == 0) ? (bx % 8) * (F.G / 8) + bx / 8 : bx; }
    F.in = (kin_t)__builtin_amdgcn_kernarg_segment_ptr();
    F.out = args.out; F.ws = args.ws;
    F.ctl = (gu32*)(args.ws + WS_CTL);
    for (int u = f_tid; u < (LDS_BYTES - LDSCTL_OFF) / 4; u += NWAVES * 64) ((LAS unsigned*)(F.lds + LDSCTL_OFF))[u] = 0u;
    __syncthreads();
    const int lo = args.ph_lo, hi = args.ph_hi;
    XcdBarrier bar; bar.bar = (unsigned*)(F.ctl + CW_BAR); bar.x = 0; bar.st = nullptr;
    if (hi - lo > 1) bar = xcd_barrier_post((unsigned*)(F.ctl + CW_BAR), F.MISC + 8, f_tid == 0);
#define IN(k) (lo <= (k) && (k) < hi)
#define SEAM(k) do { if (IN(k) && IN((k) + 1)) xcd_barrier(bar, F.wave == 0 && lane_id() == 0); } while (0)

    if (IN(0)) { p0_prologue(F); } SEAM(0);
    if (IN(1)) { p1_norm1(F); } SEAM(1);
    if (IN(2)) {
        SchedInProj S{F.G, (int)blockIdx.x, (const char*)WSP(bf16_t, WS_H), (const char*)WSP(bf16_t, WS_WIN)};
        EpiInProj E{WSP(unsigned char, WS_Q), WSP(unsigned char, WS_K), WSP(unsigned char, WS_V), WSP(bf16_t, WS_UT), F.in[9], F.in[10], WSP(float, WS_SMALL + SM_ROPE)};
        g8::gemm_phase<false>(F.lds, DM, S, E, F.wave, lane_id());
    } SEAM(2);
    if (IN(3)) { p3_attention8(F); p3_hyena(F); } SEAM(3);
    if (IN(4)) { p4_hynorm(F); } SEAM(4);
    if (IN(5)) {
        SchedStatic S{F.G, (int)blockIdx.x, MROWS / 256, DM / 256, (const char*)WSP(bf16_t, WS_MIX), (const char*)WSP(bf16_t, WS_WOUT)};
        EpiOutProj E{F.in[0], WSP(bf16_t, WS_XN), WSP(float, WS_SMALL + SM_MOD)};
        g8::gemm_phase<false>(F.lds, DM, S, E, F.wave, lane_id());
    } SEAM(5);
    if (IN(6)) { p6_router_mfma(F); } SEAM(6);
    if (IN(7)) { p7_scatter(F); } SEAM(7);
    if (IN(8)) {
        int nT; const LAS unsigned char* TE = moe_tiles(F, nT);
        LAS int* RWL = (LAS int*)(F.lds + RING_BYTES + 1024);
        static_assert(RING_BYTES + 1024 + 17 * 1024 <= LDSCTL_OFF, "LDS map");
        SchedMoE<8> S{F.G, (int)blockIdx.x, nT, (const char*)WSP(char, WS_H), (const char*)WSP(char, WS_W1), (size_t)2 * DM * DM, TE, RWL, true};
        { const int* list = WSP(int, WS_ROUTE + RT_LIST); const int t8 = F.wave * 64 + lane_id();
            g8::Unit u; for (int i = 0; i < 17 && S.next(i, u); i += 2) { const int ii = i + (t8 >> 8); g8::Unit u2; if (S.next(ii, u2)) { const int li = list[(size_t)u2.pm * 256 + (t8 & 255)]; RWL[ii * 256 + (t8 & 255)] = (li >= 0) ? (li >> 2) : 0; } }
            __syncthreads(); }
        EpiSwiGLU E{WSP(unsigned char, WS_ACT), F.in[31]};
        g8::gemm_phase_g<true, true>(F.lds, DM, S, E, F.wave, lane_id());
    } SEAM(8);
    if (IN(9)) {
        int nT; const LAS unsigned char* TE = moe_tiles(F, nT);
        SchedMoE<4> S{F.G, (int)blockIdx.x, nT, (const char*)WSP(char, WS_ACT), (const char*)WSP(char, WS_W2), (size_t)DM * DM, TE, nullptr, false};
        LAS int* LL = (LAS int*)(F.lds + RING_BYTES + 1024);
        static_assert(RING_BYTES + 1024 + 9 * 2048 <= LDSCTL_OFF, "LDS map");
        { const int* list = WSP(int, WS_ROUTE + RT_LIST); const float* gslot = WSP(float, WS_ROUTE + RT_GSLOT);
            const int t9 = F.wave * 64 + lane_id();
            g8::Unit u; for (int i = 0; i < 9 && S.next(i, u); ++i) { const int t = t9 & 255; const size_t slot = (size_t)u.pm * 256 + t;
                LL[i * 512 + (t9 >> 8) * 256 + t] = (t9 < 256) ? list[slot] : __float_as_int(gslot[slot]); }
            __syncthreads(); }
        EpiDown E{WSP(unsigned char, WS_EO), F.in[33], LL, F.G, (int)blockIdx.x};
        g8::gemm_phase<true>(F.lds, DM, S, E, F.wave, lane_id());
    } SEAM(9);
    if (IN(10)) { p10_combine(F); }
#undef IN
#undef SEAM
}

extern "C" void kernel_launch(void* const* d_in, const int* in_sizes, int n_in, void* d_out, int out_size, void* d_ws, size_t ws_size, hipStream_t stream) {
    static int grid = 0;
    if (grid == 0) {
        if (n_in != 34 || out_size != MROWS * DM || ws_size < WS_END) { fprintf(stderr, "kernel_launch: unexpected shapes: n_in %d out %d ws %zu (need %zu)\n", n_in, out_size, ws_size, (size_t)WS_END); grid = -1; return; }
        int dev = 0, cus = 0, per_cu = 0;
        if (hipGetDevice(&dev) != hipSuccess || hipDeviceGetAttribute(&cus, hipDeviceAttributeMultiprocessorCount, dev) != hipSuccess) { grid = -1; return; }
        if (hipFuncSetAttribute((const void*)mega, hipFuncAttributeMaxDynamicSharedMemorySize, LDS_BYTES) != hipSuccess) { fprintf(stderr, "kernel_launch: hipFuncSetAttribute failed\n"); grid = -1; return; }
        if (hipOccupancyMaxActiveBlocksPerMultiprocessor(&per_cu, (const void*)mega, NWAVES * 64, LDS_BYTES) != hipSuccess || per_cu < 1) { fprintf(stderr, "kernel_launch: occupancy query says %d\n", per_cu); per_cu = 1; }
        (void)hipGetLastError();
        grid = cus;
    }
    if (grid < 0) return;
    (void)hipMemsetAsync((char*)d_ws + WS_CTL, 0, CTL_ZERO_BYTES, stream);
    Args a{};
    for (int i = 0; i < 34; ++i) a.in[i] = (const float*)d_in[i];
    a.out = (float*)d_out; a.ws = (unsigned char*)d_ws;
    constexpr int LAST = MK_LAST_PHASE + 1;
    if (MK_N_LAUNCHES == 1) { a.ph_lo = 0; a.ph_hi = LAST; hipLaunchKernelGGL(mega, dim3(grid), dim3(NWAVES * 64), LDS_BYTES, stream, a); }
    else for (int p = 0; p < LAST; ++p) { a.ph_lo = p; a.ph_hi = p + 1; hipLaunchKernelGGL(mega, dim3(grid), dim3(NWAVES * 64), LDS_BYTES, stream, a); }
    const hipError_t le = hipPeekAtLastError();
    if (le != hipSuccess) fprintf(stderr, "kernel_launch: launch failed: %s\n", hipGetErrorName(le));
}
```

```cpp
#include <hip/hip_runtime.h>
#include <hip/hip_bf16.h>
#include <cstdio>
#include <cstdint>

#ifndef MK_N_LAUNCHES
#define MK_N_LAUNCHES 1
#endif
#ifndef MK_LAST_PHASE
#define MK_LAST_PHASE 10
#endif

#define GAS __attribute__((address_space(1)))
#define LAS __attribute__((address_space(3)))
typedef unsigned short bf16_t;
typedef short bf16x8 __attribute__((ext_vector_type(8)));
typedef short s16x4 __attribute__((ext_vector_type(4)));
typedef float f32x2 __attribute__((ext_vector_type(2)));
typedef float f32x4 __attribute__((ext_vector_type(4)));
typedef float f32x16 __attribute__((ext_vector_type(16)));
typedef unsigned u32x2 __attribute__((ext_vector_type(2)));
typedef unsigned u32x4 __attribute__((ext_vector_type(4)));
typedef GAS unsigned gu32;

constexpr int NB = 8, SEQ = 4096, DM = 1024, MROWS = NB * SEQ, CTXL = 256, MCTX = NB * CTXL, MTOT = MROWS + MCTX;
constexpr int KVL = CTXL + SEQ;
constexpr int NHEAD = 4, QKW = 512;
constexpr int HYW = 512, HYC = 1536, INC = 3072, QKVC = 1536;
constexpr int NEXP = 32, TOPK = 4, NMOD = 6;
constexpr float EPS = 1e-6f;
constexpr float LAM_INIT = 0.2f;
constexpr float QSCALE = 0.125f * 1.4426950408889634f;

constexpr size_t MiB = 1u << 20;
constexpr size_t WS_CTL = 0, CTL_ZERO_BYTES = 64 * 1024;
constexpr size_t WS_SMALL = 1 * MiB;
constexpr size_t WS_WIN = 2 * MiB;
constexpr size_t WS_WOUT = 8 * MiB;
constexpr size_t WS_W1 = 10 * MiB;
constexpr size_t WS_W2 = 138 * MiB;
constexpr size_t WS_H = 202 * MiB;
constexpr size_t WS_Q = 270 * MiB;
constexpr size_t WS_K = 302 * MiB;
constexpr size_t WS_V = 336 * MiB;
constexpr size_t WS_UT = 370 * MiB;
constexpr size_t WS_FILT = 466 * MiB;
constexpr size_t WS_Z2T = 498 * MiB;
constexpr size_t WS_MIX = 530 * MiB;
constexpr size_t WS_ROUTE = 594 * MiB;
constexpr size_t WS_ACT = 270 * MiB;
constexpr size_t WS_EO = 598 * MiB;
constexpr size_t WS_XN = 870 * MiB;
constexpr size_t WS_END = 998 * MiB;
constexpr size_t SM_MOD = 0;
constexpr size_t SM_SCAL = 256 * 1024;
constexpr size_t SM_ROPE = 260 * 1024;
constexpr int CW_BAR = 4096;

constexpr int RING_BYTES = 131072;
constexpr int LDSCTL_OFF = 151552;
constexpr int LDS_BYTES = 152576;
constexpr int NWAVES = 8;

#define LDS_WAIT() asm volatile("s_waitcnt lgkmcnt(0)" ::: "memory")
#define VM_WAIT() asm volatile("s_waitcnt vmcnt(0)" ::: "memory")
#define RLX_AGENT __ATOMIC_RELAXED, __HIP_MEMORY_SCOPE_AGENT

__device__ __forceinline__ unsigned cvt_pk_bf16(float lo, float hi) { unsigned r; asm volatile("v_cvt_pk_bf16_f32 %0, %1, %2" : "=v"(r) : "v"(lo), "v"(hi)); return r; }
__device__ __forceinline__ float bf2f(bf16_t v) { return __uint_as_float(((unsigned)v) << 16); }
__device__ __forceinline__ float wave_sum(float v) {
#pragma unroll
    for (int o = 1; o < 64; o <<= 1) v += __shfl_xor(v, o);
    return v;
}

#define XB_TMO      128
#define XB_XCNT(j)  (256  + 64 * (j))
#define XB_XSUB(j)  (1280 + 64 * (j))
#define XB_XGEN(j)  (2304 + 64 * (j))
#define XB_TOP      3328
#define XB_TOPGEN   3392
#define XCD_BAR_WORDS 3456
#define XB_SPIN_CAP (1u << 22)
__device__ __forceinline__ unsigned xb_ld(unsigned* p)              { return __hip_atomic_load(p, __ATOMIC_RELAXED, __HIP_MEMORY_SCOPE_AGENT); }
__device__ __forceinline__ unsigned xb_add(unsigned* p, unsigned v) { return __hip_atomic_fetch_add(p, v, __ATOMIC_RELAXED, __HIP_MEMORY_SCOPE_AGENT); }
__device__ __forceinline__ unsigned xb_xcc_id() { return (unsigned)__builtin_amdgcn_s_getreg((3 << 11) | 20) & 0xFu; }
#define XB_SPIN(cond, bar) do { unsigned _sp = 0; while (cond) { __builtin_amdgcn_s_sleep(1); \
    if ((++_sp & 255u) == 0u) { if (xb_ld(&(bar)[XB_TMO])) break; if (_sp > XB_SPIN_CAP) { atomicAdd(&(bar)[XB_TMO], 1u); break; } } } } while (0)
struct XcdBarrier { unsigned* bar; unsigned x; volatile LAS unsigned* st; };
__device__ __forceinline__ XcdBarrier xcd_barrier_post(unsigned* bar, volatile LAS unsigned* st, bool leader) {
    XcdBarrier b; b.bar = bar; b.x = xb_xcc_id(); b.st = st;
    if (leader) (void)xb_add(&bar[XB_XCNT(b.x)], 1u);
    return b;
}
__device__ __forceinline__ void xcd_barrier_complete(unsigned* bar, unsigned x, unsigned& nloc, unsigned& nx) {
    const unsigned G = gridDim.x * gridDim.y * gridDim.z;
    unsigned sum, cnt, mine, sp = 0u;
    for (;;) {
        sum = 0u; cnt = 0u; mine = 0u;
#pragma unroll
        for (unsigned j = 0; j < 16; ++j) { const unsigned c = xb_ld(&bar[XB_XCNT(j)]); sum += c; cnt += (c > 0u) ? 1u : 0u; mine = (j == x) ? c : mine; }
        if (sum == G) break;
        __builtin_amdgcn_s_sleep(1);
        if ((++sp & 255u) == 0u) { if (xb_ld(&bar[XB_TMO])) break; if (sp > XB_SPIN_CAP) { atomicAdd(&bar[XB_TMO], 1u); break; } }
    }
    nloc = mine > 0u ? mine : 1u; nx = cnt > 0u ? cnt : 1u;
}
__device__ __forceinline__ void xcd_barrier(const XcdBarrier& b, bool leader) {
    asm volatile("s_waitcnt vmcnt(0)" ::: "memory");
    __syncthreads();
    if (leader) {
        unsigned* bar = b.bar;
        __builtin_amdgcn_s_waitcnt(0);
        unsigned nloc = b.st[0], nx = b.st[1];
        if (nloc == 0u) { xcd_barrier_complete(bar, b.x, nloc, nx); b.st[0] = nloc; b.st[1] = nx; }
        const unsigned old = xb_add(&bar[XB_XSUB(b.x)], 1u);
        const unsigned gen = old / nloc;
        if (old + 1u == (gen + 1u) * nloc) {
            __builtin_amdgcn_fence(__ATOMIC_RELEASE, "agent");
            asm volatile("s_waitcnt vmcnt(0)" ::: "memory");
            const unsigned og = xb_add(&bar[XB_TOP], 1u);
            const unsigned tg = og / nx;
            if (og + 1u == (tg + 1u) * nx) xb_add(&bar[XB_TOPGEN], 1u);
            else XB_SPIN(xb_ld(&bar[XB_TOPGEN]) == tg, bar);
            __builtin_amdgcn_fence(__ATOMIC_ACQUIRE, "agent");
            xb_add(&bar[XB_XGEN(b.x)], 1u);
            asm volatile("s_waitcnt vmcnt(0)" ::: "memory");
        } else {
            XB_SPIN(xb_ld(&bar[XB_XGEN(b.x)]) == gen, bar);
            __builtin_amdgcn_fence(__ATOMIC_ACQUIRE, "agent");
            asm volatile("s_waitcnt vmcnt(0)" ::: "memory");
        }
    }
    __syncthreads();
}

namespace g8 {
constexpr int BM = 256, BK = 64, HALF = 128, HTB = HALF * BK * 2, STAGE_BYTES = 8 * HTB, NXCD = 8, WGM = 8;
__host__ __device__ __forceinline__ int lds_byte(int r, int c) { const int st = (r >> 4) * 2 + (c >> 5), rr = r & 15, cc = c & 31, ob = rr * 64 + cc * 2; return st * 1024 + (ob ^ (((ob >> 9) & 1) << 5)); }
__host__ __device__ __forceinline__ void stage_rc(int b, int& R, int& C) { const int st = b / 1024, sb = b % 1024, swz = sb ^ (((sb >> 9) & 1) << 5); R = (st >> 1) * 16 + swz / 64; C = (st & 1) * 32 + (swz % 64) / 2; }
__host__ __device__ __forceinline__ int perm32(int rho) { const int n = rho >> 4, i = rho & 15; return 8 * (i >> 2) + 4 * n + (i & 3); }

struct Unit { const char* a; const char* b; int pm, pn, kind, ex; };

__device__ __forceinline__ void tile_of(int L, int nM, int nN, int& pm, int& pn) {
    const int nwg = nM * nN; int wgid = L;
    { const int q = nwg / NXCD, r = nwg % NXCD, xcd = wgid % NXCD, off = wgid / NXCD; wgid = (xcd < r ? xcd * (q + 1) : r * (q + 1) + (xcd - r) * q) + off; }
    const int nig = WGM * nN, gid = wgid / nig, fm = gid * WGM, gsz = (nM - fm) < WGM ? (nM - fm) : WGM;
    pm = fm + ((wgid % nig) % gsz); pn = (wgid % nig) / gsz;
}

typedef int i32x8 __attribute__((ext_vector_type(8)));
template <bool FP8, bool GATHER, bool SP2, class Epi, class Sched>
__device__ __forceinline__ void gemm_phase_s(LAS unsigned char* lds, const int K, const Sched& S, const Epi& E, const int wid, const int lane) {
    const int tid = wid * 64 + lane, wr = wid >> 2, wc = wid & 3, fr = lane & 15, fq = lane >> 4;
    const int nt = FP8 ? K / 128 : K / BK;
    const int RP = FP8 ? K : 2 * K;
    unsigned voffA[2], voffB[2]; int srow[2], scol[2];
#pragma unroll
    for (int i = 0; i < 2; ++i) { int R, C; stage_rc(tid * 16 + i * 8192, R, C); const int Rb = (R & ~31) + perm32(R & 31);
        voffA[i] = (unsigned)(R * RP + C * 2); voffB[i] = (unsigned)(Rb * RP + C * 2); srow[i] = R; scol[i] = C * 2; }
    const size_t kstep = (size_t)(BK * 2);
    const size_t hstep = (size_t)HALF * RP;
    const unsigned ldsw = (unsigned)wid * 1024u;
    unsigned cO0[2], cO1[2], nO0[2], nO1[2];
#define PG8_GOFF(D0, D1, ui_) do { if constexpr (GATHER) { const LAS int* rw_ = S.rows(ui_); _Pragma("unroll") for (int i_ = 0; i_ < 2; ++i_) { \
        D0[i_] = (unsigned)rw_[srow[i_]] * (unsigned)RP + (unsigned)scol[i_]; D1[i_] = (unsigned)rw_[128 + srow[i_]] * (unsigned)RP + (unsigned)scol[i_]; } } \
      else { _Pragma("unroll") for (int i_ = 0; i_ < 2; ++i_) { D0[i_] = voffA[i_]; D1[i_] = voffA[i_] + (unsigned)hstep; } } } while (0)
    const int aoff = lds_byte(wr * 64 + fr, FP8 ? fq * 16 : fq * 8), boff = lds_byte(wc * 32 + fr, FP8 ? fq * 16 : fq * 8);
    constexpr int KOFF = FP8 ? 16 : 1024;
#define PG8_SA(b, h) (((b) * 2 + (h)) * HTB)
#define PG8_SB(b, h) ((4 + (b) * 2 + (h)) * HTB)
#define PG8_STAGE(bufoff, gbase, voff) do { _Pragma("unroll") for (int _i = 0; _i < 2; ++_i) \
        __builtin_amdgcn_global_load_lds((const unsigned*)((const char*)(gbase) + (voff)[_i]), (LAS unsigned*)(lds + (bufoff) + ldsw + _i * 8192), 16, 0, 0); } while (0)
#define PG8_LD32(p) __builtin_bit_cast(i32x8, __builtin_shufflevector(*(const LAS u32x4*)(p), *(const LAS u32x4*)((p) + 16), 0, 1, 2, 3, 4, 5, 6, 7))
#define PG8_LDA8(dst, b, h) do { _Pragma("unroll") for (int m = 0; m < 4; ++m) dst[m] = PG8_LD32(lds + PG8_SA(b, h) + aoff + m * 2048); } while (0)
#define PG8_LDB8(dst, b, h) do { _Pragma("unroll") for (int n = 0; n < 2; ++n) dst[n] = PG8_LD32(lds + PG8_SB(b, h) + boff + n * 2048); } while (0)
#define PG8_LDA(dst, b, h) do { _Pragma("unroll") for (int m = 0; m < 4; ++m) _Pragma("unroll") for (int k = 0; k < 2; ++k) dst[m][k] = *(const LAS bf16x8*)(lds + PG8_SA(b, h) + aoff + m * 2048 + k * KOFF); } while (0)
#define PG8_LDB(dst, b, h) do { _Pragma("unroll") for (int n = 0; n < 2; ++n) _Pragma("unroll") for (int k = 0; k < 2; ++k) dst[n][k] = *(const LAS bf16x8*)(lds + PG8_SB(b, h) + boff + n * 2048 + k * KOFF); } while (0)
#define PG8_MMA(ai, bj, At, Bt) do { __builtin_amdgcn_s_setprio(1); _Pragma("unroll") for (int m = 0; m < 4; ++m) _Pragma("unroll") for (int n = 0; n < 2; ++n) _Pragma("unroll") for (int k = 0; k < 2; ++k) \
        acc[ai][bj][m][n] = __builtin_amdgcn_mfma_f32_16x16x32_bf16(Bt[n][k], At[m][k], acc[ai][bj][m][n], 0, 0, 0); __builtin_amdgcn_s_setprio(0); } while (0)
#define PG8_MMA8(ai, bj, At, Bt) do { __builtin_amdgcn_s_setprio(1); _Pragma("unroll") for (int m = 0; m < 4; ++m) _Pragma("unroll") for (int n = 0; n < 2; ++n) \
        asm volatile("v_mfma_scale_f32_16x16x128_f8f6f4 %0, %1, %2, %0, %3, %3 op_sel_hi:[0,0,0]" : "+v"(acc[ai][bj][m][n]) : "v"(Bt[n]), "v"(At[m]), "v"(one_scale)); __builtin_amdgcn_s_setprio(0); } while (0)
#define PG8_WAIT_V(n) asm volatile("s_waitcnt vmcnt(" #n ")" ::: "memory")
#define PG8_WAIT_L(n) asm volatile("s_waitcnt lgkmcnt(" #n ")" ::: "memory")
#define PG8_BAR __builtin_amdgcn_s_barrier()
#define PG8_SCHED __builtin_amdgcn_sched_barrier(0)
    Unit cur, nxt; int ui = 0;
    if (!S.next(0, cur)) return;
    f32x4 acc[2][2][4][2];
#pragma unroll
    for (int a = 0; a < 2; ++a)
#pragma unroll
        for (int b = 0; b < 2; ++b)
#pragma unroll
            for (int m = 0; m < 4; ++m)
#pragma unroll
                for (int n = 0; n < 2; ++n) acc[a][b][m][n] = (f32x4){0.f, 0.f, 0.f, 0.f};
    bf16x8 At[4][2], B0[2][2], B1[2][2];
    i32x8 At8[4], B08[2], B18[2];
    const unsigned one_scale = 0x7f7f7f7fu;
    const char* cA = cur.a; const char* cB = cur.b;
    PG8_GOFF(cO0, cO1, 0);
    if constexpr (SP2) {
    PG8_STAGE(PG8_SB(0, 0), cB, voffB); PG8_STAGE(PG8_SB(0, 1), cB + hstep, voffB); PG8_STAGE(PG8_SA(0, 0), cA, cO0); PG8_STAGE(PG8_SA(0, 1), cA, cO1);
    if (wr == 1) PG8_BAR;
    PG8_WAIT_V(2); PG8_BAR;
    PG8_STAGE(PG8_SB(1, 0), cB + kstep, voffB); PG8_STAGE(PG8_SA(1, 0), cA + kstep, cO0); PG8_STAGE(PG8_SB(1, 1), cB + hstep + kstep, voffB);
    PG8_WAIT_V(6); PG8_BAR;
    } else {
    PG8_STAGE(PG8_SB(0, 0), cB, voffB); PG8_STAGE(PG8_SA(0, 0), cA, cO0); PG8_STAGE(PG8_SB(0, 1), cB + hstep, voffB); PG8_STAGE(PG8_SA(0, 1), cA, cO1);
    if (wr == 1) PG8_BAR;
    PG8_WAIT_V(4); PG8_BAR;
    PG8_STAGE(PG8_SB(1, 0), cB + kstep, voffB); PG8_STAGE(PG8_SA(1, 0), cA + kstep, cO0); PG8_STAGE(PG8_SB(1, 1), cB + hstep + kstep, voffB);
    PG8_WAIT_V(6); PG8_BAR;
    }
    for (;;) {
        const bool has_next = S.next(ui + 1, nxt);
        const char* nA = has_next ? nxt.a : cA; const char* nB = has_next ? nxt.b : cB;
        if (has_next) PG8_GOFF(nO0, nO1, ui + 1); else { _Pragma("unroll") for (int i_ = 0; i_ < 2; ++i_) { nO0[i_] = cO0[i_]; nO1[i_] = cO1[i_]; } }
#pragma unroll 1
        for (int t = 0; t < nt; t += 2) {
            const bool last = (t == nt - 2);
            const char* a1 = cA + (size_t)(t + 1) * kstep;
            const char* a2 = last ? nA : cA + (size_t)(t + 2) * kstep; const char* b2 = last ? nB : cB + (size_t)(t + 2) * kstep;
            const char* a3 = a2 + kstep; const char* b3 = b2 + kstep;
            unsigned o20[2], o21[2];
#pragma unroll
            for (int i_ = 0; i_ < 2; ++i_) { o20[i_] = last ? nO0[i_] : cO0[i_]; o21[i_] = last ? nO1[i_] : cO1[i_]; }
            if constexpr (FP8 && SP2) {
            PG8_LDB8(B08, 0, 0); PG8_LDB8(B18, 0, 1); PG8_SCHED; PG8_LDA8(At8, 0, 0); PG8_STAGE(PG8_SA(1, 1), a1, cO1);
            PG8_WAIT_V(8); PG8_WAIT_L(0); PG8_BAR; PG8_MMA8(0, 0, At8, B08); PG8_MMA8(0, 1, At8, B18); PG8_BAR; PG8_SCHED;
            PG8_LDA8(At8, 0, 1); PG8_STAGE(PG8_SB(0, 0), b2, voffB); PG8_STAGE(PG8_SB(0, 1), b2 + hstep, voffB); PG8_STAGE(PG8_SA(0, 0), a2, o20);
            PG8_WAIT_V(8); PG8_WAIT_L(0); PG8_BAR; PG8_MMA8(1, 0, At8, B08); PG8_MMA8(1, 1, At8, B18); PG8_BAR; PG8_SCHED;
            PG8_LDB8(B08, 1, 0); PG8_LDB8(B18, 1, 1); PG8_SCHED; PG8_LDA8(At8, 1, 0); PG8_STAGE(PG8_SA(0, 1), a2, o21);
            PG8_WAIT_V(8); PG8_WAIT_L(0); PG8_BAR; PG8_MMA8(0, 0, At8, B08); PG8_MMA8(0, 1, At8, B18); PG8_BAR; PG8_SCHED;
            PG8_LDA8(At8, 1, 1); PG8_STAGE(PG8_SB(1, 0), b3, voffB); PG8_STAGE(PG8_SB(1, 1), b3 + hstep, voffB); PG8_STAGE(PG8_SA(1, 0), a3, o20);
            PG8_WAIT_V(8); PG8_WAIT_L(0); PG8_BAR; PG8_MMA8(1, 0, At8, B08); PG8_MMA8(1, 1, At8, B18); PG8_BAR; PG8_SCHED;
            } else if constexpr (FP8) {
            PG8_LDB8(B08, 0, 0); PG8_SCHED; PG8_LDA8(At8, 0, 0); PG8_STAGE(PG8_SA(1, 1), a1, cO1);
            PG8_WAIT_L(8); PG8_BAR; PG8_WAIT_L(0); PG8_MMA8(0, 0, At8, B08); PG8_BAR; PG8_SCHED;
            PG8_LDB8(B18, 0, 1); PG8_STAGE(PG8_SB(0, 0), b2, voffB);
            PG8_BAR; PG8_WAIT_L(0); PG8_MMA8(0, 1, At8, B18); PG8_BAR;
            PG8_LDA8(At8, 0, 1); PG8_STAGE(PG8_SA(0, 0), a2, o20);
            PG8_BAR; PG8_WAIT_L(0); PG8_MMA8(1, 0, At8, B08); PG8_BAR; PG8_SCHED;
            PG8_STAGE(PG8_SB(0, 1), b2 + hstep, voffB);
            PG8_WAIT_V(6); PG8_BAR; PG8_MMA8(1, 1, At8, B18); PG8_BAR;
            PG8_LDB8(B08, 1, 0); PG8_SCHED; PG8_LDA8(At8, 1, 0); PG8_STAGE(PG8_SA(0, 1), a2, o21);
            PG8_WAIT_L(8); PG8_BAR; PG8_WAIT_L(0); PG8_MMA8(0, 0, At8, B08); PG8_BAR; PG8_SCHED;
            PG8_LDB8(B18, 1, 1); PG8_STAGE(PG8_SB(1, 0), b3, voffB);
            PG8_BAR; PG8_WAIT_L(0); PG8_MMA8(0, 1, At8, B18); PG8_BAR;
            PG8_LDA8(At8, 1, 1); PG8_STAGE(PG8_SA(1, 0), a3, o20);
            PG8_BAR; PG8_WAIT_L(0); PG8_MMA8(1, 0, At8, B08); PG8_BAR; PG8_SCHED;
            PG8_STAGE(PG8_SB(1, 1), b3 + hstep, voffB);
            PG8_WAIT_V(6); PG8_BAR; PG8_MMA8(1, 1, At8, B18); PG8_BAR;
            } else {
            PG8_LDB(B0, 0, 0); PG8_LDB(B1, 0, 1); PG8_SCHED; PG8_LDA(At, 0, 0); PG8_STAGE(PG8_SA(1, 1), a1, cO1);
            PG8_WAIT_V(8); PG8_WAIT_L(0); PG8_BAR; PG8_MMA(0, 0, At, B0); PG8_MMA(0, 1, At, B1); PG8_BAR; PG8_SCHED;
            PG8_LDA(At, 0, 1); PG8_STAGE(PG8_SB(0, 0), b2, voffB); PG8_STAGE(PG8_SB(0, 1), b2 + hstep, voffB); PG8_STAGE(PG8_SA(0, 0), a2, o20);
            PG8_WAIT_V(8); PG8_WAIT_L(0); PG8_BAR; PG8_MMA(1, 0, At, B0); PG8_MMA(1, 1, At, B1); PG8_BAR; PG8_SCHED;
            PG8_LDB(B0, 1, 0); PG8_LDB(B1, 1, 1); PG8_SCHED; PG8_LDA(At, 1, 0); PG8_STAGE(PG8_SA(0, 1), a2, o21);
            PG8_WAIT_V(8); PG8_WAIT_L(0); PG8_BAR; PG8_MMA(0, 0, At, B0); PG8_MMA(0, 1, At, B1); PG8_BAR; PG8_SCHED;
            PG8_LDA(At, 1, 1); PG8_STAGE(PG8_SB(1, 0), b3, voffB); PG8_STAGE(PG8_SB(1, 1), b3 + hstep, voffB); PG8_STAGE(PG8_SA(1, 0), a3, o20);
            PG8_WAIT_V(8); PG8_WAIT_L(0); PG8_BAR; PG8_MMA(1, 0, At, B0); PG8_MMA(1, 1, At, B1); PG8_BAR; PG8_SCHED;
            }
        }
        if (wr == 0) PG8_BAR;
        if constexpr (FP8) asm volatile("s_nop 15\n\ts_nop 15" ::: "memory");
        E(acc, cur, wr, wc, fr, fq);
        if (!has_next) break;
#pragma unroll
        for (int a = 0; a < 2; ++a)
#pragma unroll
            for (int b = 0; b < 2; ++b)
#pragma unroll
                for (int m = 0; m < 4; ++m)
#pragma unroll
                    for (int n = 0; n < 2; ++n) acc[a][b][m][n] = (f32x4){0.f, 0.f, 0.f, 0.f};
        cur = nxt; cA = nA; cB = nB; ++ui;
#pragma unroll
        for (int i_ = 0; i_ < 2; ++i_) { cO0[i_] = nO0[i_]; cO1[i_] = nO1[i_]; }
        if (wr == 1) PG8_BAR;
    }
    PG8_WAIT_V(0);
    PG8_BAR;
#undef PG8_SA
#undef PG8_GOFF
#undef PG8_SB
#undef PG8_STAGE
#undef PG8_LDA
#undef PG8_LDB
#undef PG8_MMA
#undef PG8_MMA8
#undef PG8_LDA8
#undef PG8_LDB8
#undef PG8_LD32
#undef PG8_WAIT_V
#undef PG8_WAIT_L
#undef PG8_BAR
#undef PG8_SCHED
}
template <bool FP8, bool GATHER, class Epi, class Sched>
__device__ __forceinline__ void gemm_phase_g(LAS unsigned char* lds, const int K, const Sched& S, const Epi& E, const int wid, const int lane) { gemm_phase_s<FP8, GATHER, !FP8>(lds, K, S, E, wid, lane); }
template <bool FP8, class Epi, class Sched>
__device__ __forceinline__ void gemm_phase(LAS unsigned char* lds, const int K, const Sched& S, const Epi& E, const int wid, const int lane) { gemm_phase_s<FP8, false, !FP8>(lds, K, S, E, wid, lane); }
}

__device__ __forceinline__ int lane_id() { int l; asm volatile("v_mbcnt_lo_u32_b32 %0, -1, 0\n\tv_mbcnt_hi_u32_b32 %0, -1, %0" : "=v"(l)); return l; }
#define FT_DECL const int f_lane = lane_id(), f_tid = F.wave * 64 + f_lane; (void)f_tid; (void)f_lane
typedef const float* cfp_t;
typedef __attribute__((address_space(4))) cfp_t* kin_t;
struct Frame {
    LAS unsigned char* lds;
    volatile LAS unsigned* MISC;
    gu32* ctl;
    int wave, vcu, G;
    kin_t in;
    float* out;
    unsigned char* ws;
};
#define WSP(T, off) ((T*)(F.ws + (off)))

template <class RowMap>
__device__ __forceinline__ void p0_transpose_item(const float* W, int K, int N, bf16_t* WT, const RowMap& rowmap, const float* kscale, LAS float* scr, int item, int lane, bool kperm = false) {
    const int nblk = N / 32, kb = item / nblk, nb = item % nblk, k0 = 64 * kb, n0 = 32 * nb;
#pragma unroll 8
    for (int i = 0; i < 32; ++i) { const int kk = 2 * i + (lane >> 5); int ks = k0 + kk; if (kperm && ks >= K / 2) { const int j = ks - K / 2; ks = K / 2 + (j >> 3) + 64 * (j & 7); }
        float v = W[(size_t)ks * N + n0 + (lane & 31)]; if (kscale) v *= kscale[k0 + kk]; scr[kk * 33 + (lane & 31)] = v; }
    LDS_WAIT(); asm volatile("" ::: "memory");
    const int c = lane & 7;
#pragma unroll
    for (int j = 0; j < 4; ++j) { const int n = (lane >> 3) + 8 * j; const LAS float* s = scr + (8 * c) * 33 + n;
        u32x4 o; o.x = cvt_pk_bf16(s[0 * 33], s[1 * 33]); o.y = cvt_pk_bf16(s[2 * 33], s[3 * 33]); o.z = cvt_pk_bf16(s[4 * 33], s[5 * 33]); o.w = cvt_pk_bf16(s[6 * 33], s[7 * 33]);
        *(GAS u32x4*)(WT + (size_t)rowmap(n0 + n) * K + k0 + 8 * c) = o; }
    LDS_WAIT(); asm volatile("" ::: "memory");
}

__device__ __forceinline__ unsigned pk4_fp8(float a, float b, float c, float d) { int r = __builtin_amdgcn_cvt_pk_fp8_f32(a, b, 0, false); r = __builtin_amdgcn_cvt_pk_fp8_f32(c, d, r, true); return (unsigned)r; }
constexpr float EOSCALE = 16.f;
constexpr float WSCALE = 32.f;
template <class RowMap>
__device__ __forceinline__ void p0_transpose_item_f8(const float* W, int K, int N, unsigned char* WT, const RowMap& rowmap, LAS float* scr, int item, int lane) {
    const int nblk = N / 32, kb = item / nblk, nb = item % nblk, k0 = 128 * kb, n0 = 32 * nb;
#pragma unroll
    for (int hh = 0; hh < 2; ++hh) { float v[32];
#pragma unroll
        for (int i = 0; i < 32; ++i) { const int kk = 2 * (32 * hh + i) + (lane >> 5); v[i] = __builtin_nontemporal_load(W + (size_t)(k0 + kk) * N + n0 + (lane & 31)); }
#pragma unroll
        for (int i = 0; i < 32; ++i) { const int kk = 2 * (32 * hh + i) + (lane >> 5); scr[kk * 33 + (lane & 31)] = v[i] * WSCALE; } }
    LDS_WAIT(); asm volatile("" ::: "memory");
    const int c = lane & 7;
#pragma unroll
    for (int j = 0; j < 4; ++j) { const int n = (lane >> 3) + 8 * j; const LAS float* sp = scr + (16 * c) * 33 + n;
        u32x4 o; o.x = pk4_fp8(sp[0 * 33], sp[1 * 33], sp[2 * 33], sp[3 * 33]); o.y = pk4_fp8(sp[4 * 33], sp[5 * 33], sp[6 * 33], sp[7 * 33]);
        o.z = pk4_fp8(sp[8 * 33], sp[9 * 33], sp[10 * 33], sp[11 * 33]); o.w = pk4_fp8(sp[12 * 33], sp[13 * 33], sp[14 * 33], sp[15 * 33]);
        *(GAS u32x4*)(WT + (size_t)rowmap(n0 + n) * K + k0 + 16 * c) = o; }
    LDS_WAIT(); asm volatile("" ::: "memory");
}
struct MapW2 { __device__ __forceinline__ int operator()(int l) const { const int t = l & ~255, r = l & 255, wc = r >> 6, fq = (r >> 4) & 3, bj = (r >> 3) & 1, low = r & 7; return t + 128 * bj + 32 * wc + 8 * fq + low; } };
struct MapIdent { int off; __device__ __forceinline__ int operator()(int n) const { return off + n; } };
struct MapWin { __device__ __forceinline__ int operator()(int l) const {
    if (l >= 1024) return l;
    const int t = l & ~255, r = l & 255, wc = r >> 6, blk = (r >> 5) & 1, bj = (r >> 4) & 1, low = r & 15;
    return t + 128 * bj + 32 * wc + 16 * blk + low; } };
struct MapW1 { int off; __device__ __forceinline__ int operator()(int jp) const { const int bj = jp >> 10, j = jp & 1023; return off + 256 * (j >> 7) + 128 * bj + (j & 127); } };


__device__ __forceinline__ void p0_filter_item(Frame& F, int item) {
    FT_DECL;
#define in F.in
    LAS float* h1s = (LAS float*)(F.lds);
    LAS float* h2s = (LAS float*)(F.lds + 4096);
    const int t0 = item * 16;
    {
        const int tt = f_tid >> 5, hh = (f_tid & 31) * 2; const float pos = (float)(t0 + tt);
        float feats[17]; feats[0] = pos * (1.f / SEQ);
#pragma unroll
        for (int i = 0; i < 8; ++i) { const float band = 1e-4f + (float)i * ((7.f - 1e-4f) / 7.f); const float ang = (6.283185307179586f / SEQ) * pos * band; feats[1 + i] = __sinf(ang); feats[9 + i] = __cosf(ang); }
#pragma unroll
        for (int u = 0; u < 2; ++u) { const int h = hh + u; float a = in[19][h];
#pragma unroll
            for (int k = 0; k < 17; ++k) a += feats[k] * in[18][k * 64 + h];
            h1s[tt * 64 + h] = __sinf(in[20][h] * a); }
        __syncthreads();
#pragma unroll
        for (int u = 0; u < 2; ++u) { const int h = hh + u; float a = in[22][h];
#pragma unroll 8
            for (int k = 0; k < 64; ++k) a += h1s[tt * 64 + k] * in[21][k * 64 + h];
            h2s[tt * 64 + h] = __sinf(in[23][h] * a); }
        __syncthreads();
    }
    f32x4 acc[16];
#pragma unroll
    for (int t = 0; t < 16; ++t) acc[t] = (f32x4){0.f, 0.f, 0.f, 0.f};
    const int o = 4 * f_tid;
    for (int k0 = 0; k0 < 64; k0 += 4) { f32x4 w[4];
#pragma unroll
        for (int q = 0; q < 4; ++q) w[q] = *(const f32x4*)(in[24] + (size_t)(k0 + q) * 2048 + o);
#pragma unroll
        for (int t = 0; t < 16; ++t) { const f32x4 hv = *(const LAS f32x4*)(h2s + t * 64 + k0); acc[t] += w[0] * hv[0] + w[1] * hv[1] + w[2] * hv[2] + w[3] * hv[3]; } }
    const int c0 = o & 511, od = o >> 9;
    float* dst = WSP(float, WS_FILT) + ((size_t)od * 512 + c0) * SEQ + t0;
#pragma unroll
    for (int e = 0; e < 4; ++e) { const float la = -3.0701134573253944f, lb = -15.350567286626972f; const float delta = fabsf(la + (float)(c0 + e) * ((lb - la) / 511.f));
#pragma unroll
        for (int q = 0; q < 4; ++q) { f32x4 v;
#pragma unroll
            for (int i = 0; i < 4; ++i) { const int t = 4 * q + i; const float tn = (float)(t0 + t) * (1.f / SEQ); v[i] = acc[t][e] * __expf(-tn * delta); }
            *(f32x4*)(dst + (size_t)e * SEQ + 4 * q) = v; } }
    __syncthreads();
#undef in
}

__device__ __forceinline__ float silu_f(float v) { return v / (1.f + __expf(-v)); }

__device__ __forceinline__ void p0_prologue(Frame& F) {
    FT_DECL;
#define in F.in
    const int wg = blockIdx.x;
    if (wg < 96) {
        LAS float* sv = (LAS float*)F.lds;
        for (int i = f_tid; i < 9 * 1024; i += 512) { const int r = i >> 10, k = i & 1023; const float c = (r < 8) ? in[1][r * 1024 + k] : in[3][k]; sv[i] = silu_f(c); }
        __syncthreads();
        const int j = wg * 64 + f_lane; const float* wm = in[4];
        float acc[9];
#pragma unroll
        for (int r = 0; r < 9; ++r) acc[r] = 0.f;
        const int kbeg = F.wave * 128;
        for (int k0 = kbeg; k0 < kbeg + 128; k0 += 16) { float w[16];
#pragma unroll
            for (int q = 0; q < 16; ++q) w[q] = __builtin_nontemporal_load(wm + (size_t)(k0 + q) * (NMOD * DM) + j);
#pragma unroll
            for (int q = 0; q < 16; ++q)
#pragma unroll
                for (int r = 0; r < 9; ++r) acc[r] += sv[r * 1024 + k0 + q] * w[q]; }
        LAS float* red = (LAS float*)(F.lds + 40960);
#pragma unroll
        for (int r = 0; r < 9; ++r) red[(F.wave * 9 + r) * 64 + f_lane] = acc[r];
        __syncthreads();
        for (int i = f_tid; i < 9 * 64; i += 512) { const int r = i >> 6, l = i & 63; float s = in[5][wg * 64 + l];
#pragma unroll
            for (int w = 0; w < 8; ++w) s += red[(w * 9 + r) * 64 + l];
            WSP(float, WS_SMALL + SM_MOD)[r * (NMOD * DM) + wg * 64 + l] = s; }
        __syncthreads();
    } else if (wg == 96) {
        if (F.wave == 0) {
            const float a = wave_sum(in[11][f_lane] * in[12][f_lane]), b = wave_sum(in[13][f_lane] * in[14][f_lane]);
            float gq = fabsf(in[9][f_lane]), gk = fabsf(in[10][f_lane]);
#pragma unroll
            for (int o = 1; o < 64; o <<= 1) { gq = fmaxf(gq, __shfl_xor(gq, o)); gk = fmaxf(gk, __shfl_xor(gk, o)); }
            if (f_lane == 0) { float* sc = WSP(float, WS_SMALL + SM_SCAL); sc[0] = expf(a) - expf(b) + LAM_INIT;
                sc[1] = (8.f * gq * gk * 1.02f + 0.05f) * 1.4426950408889634f; }
        }
        for (int i = f_tid; i < 64 * 16; i += 512) { const int pos = i >> 4, f = i & 15;
            const float inv = powf(10000.f, -(float)f / 16.f); const float ang = (float)pos * inv;
            float* rt = WSP(float, WS_SMALL + SM_ROPE); rt[2 * i] = cosf(ang); rt[2 * i + 1] = sinf(ang); }
    }
    __syncthreads();
    for (int it = wg; it < SEQ / 16; it += F.G) p0_filter_item(F, it);
    __syncthreads();
    {
        LAS float* scr = (LAS float*)(F.lds + F.wave * 16896);
        const int gw = F.vcu * NWAVES + F.wave, NGW = F.G * NWAVES;
        constexpr int I_IN = (DM / 64) * (INC / 32), I_OUT = (DM / 64) * (DM / 32), I_1 = (DM / 128) * (2 * DM / 32), I_2 = (DM / 128) * (DM / 32);
        constexpr int NITEMS = I_IN + I_OUT + NEXP * (I_1 + I_2);
        for (int it = gw; it < NITEMS; it += NGW) {
            int r = it;
            if (r < I_IN) { p0_transpose_item(in[8], DM, INC, WSP(bf16_t, WS_WIN), MapWin{}, nullptr, scr, r, f_lane); continue; } r -= I_IN;
            if (r < I_OUT) { p0_transpose_item(in[27], DM, DM, WSP(bf16_t, WS_WOUT), MapIdent{0}, nullptr, scr, r, f_lane, true); continue; } r -= I_OUT;
            const int e = r / (I_1 + I_2); r -= e * (I_1 + I_2);
            if (r < I_1) p0_transpose_item_f8(in[30] + (size_t)e * DM * 2 * DM, DM, 2 * DM, WSP(unsigned char, WS_W1) + (size_t)e * 2 * DM * DM, MapW1{0}, scr, r, f_lane);
            else p0_transpose_item_f8(in[32] + (size_t)e * DM * DM, DM, DM, WSP(unsigned char, WS_W2) + (size_t)e * DM * DM, MapW2{}, scr, r - I_1, f_lane);
        }
    }
}
#undef in

__device__ __forceinline__ void p1_norm1(Frame& F) {
    FT_DECL;
    const int gw = F.vcu * NWAVES + F.wave, NGW = F.G * NWAVES;
    const float* mod = WSP(float, WS_SMALL + SM_MOD); const float* g1 = F.in[6];
    bf16_t* H = WSP(bf16_t, WS_H);
    constexpr int RPW = MTOT / (256 * NWAVES);
    for (int run = gw; run * RPW < MTOT; run += NGW) {
        const int r0 = run * RPW, r1 = (r0 + RPW < MTOT) ? r0 + RPW : MTOT;
        int curb = -1; f32x4 PA[4], PB[4];
        for (int m0 = r0; m0 < r1; m0 += 4) {
            f32x4 v[4][4];
#pragma unroll
            for (int u = 0; u < 4; ++u) { const int m = m0 + u; if (m < r1) {
                const float* xrow = (m < MROWS) ? F.in[0] + (size_t)m * DM : F.in[2] + (size_t)(m - MROWS) * DM; const GAS f32x4* xr = (const GAS f32x4*)xrow + f_lane;
#pragma unroll
                for (int j = 0; j < 4; ++j) v[u][j] = __builtin_nontemporal_load(xr + 64 * j); } }
#pragma unroll
            for (int u = 0; u < 4; ++u) { const int m = m0 + u; if (m < r1) {
                const int mb = (m < MROWS) ? (m >> 12) : 8;
                if (mb != curb) { curb = mb; const float* sh = mod + (size_t)mb * (NMOD * DM); const float* sc = sh + DM;
#pragma unroll
                    for (int j = 0; j < 4; ++j) { const int c = 4 * f_lane + 256 * j; PA[j] = *(const f32x4*)(g1 + c) * (*(const f32x4*)(sc + c) + 1.f); PB[j] = *(const f32x4*)(sh + c); } }
                float s = 0.f;
#pragma unroll
                for (int j = 0; j < 4; ++j) s += (v[u][j].x * v[u][j].x + v[u][j].y * v[u][j].y) + (v[u][j].z * v[u][j].z + v[u][j].w * v[u][j].w);
                const float rstd = rsqrtf(wave_sum(s) * (1.f / DM) + EPS);
                GAS u32x2* o8 = (GAS u32x2*)(H + (size_t)m * DM) + f_lane;
#pragma unroll
                for (int j = 0; j < 4; ++j) { const f32x4 y = v[u][j] * rstd * PA[j] + PB[j];
                    u32x2 w; w.x = cvt_pk_bf16(y.x, y.y); w.y = cvt_pk_bf16(y.z, y.w); o8[64 * j] = w; } } }
        }
    }
}

struct SchedInProj {
    int G, c; const char* H; const char* W;
    static constexpr int NA = 136 * 4, NV = 2 * 136, NBU = 6 * 128;
    __device__ __forceinline__ bool next(int i, g8::Unit& u) const {
        const long L = (long)i * G + c;
        if (L < NA) { g8::tile_of((int)L, 136, 4, u.pm, u.pn); u.a = H + (size_t)u.pm * 256 * DM * 2; u.b = W + (size_t)u.pn * 256 * DM * 2; u.kind = 0; u.ex = 0; return true; }
        if (L < NA + NV) { g8::tile_of((int)L - NA, 2, 136, u.pm, u.pn); u.a = W + (size_t)(1024 + u.pm * 256) * DM * 2; u.b = H + (size_t)u.pn * 256 * DM * 2; u.kind = 2; u.ex = 0; return true; }
        if (L < NA + NV + NBU) { g8::tile_of((int)L - NA - NV, 6, 128, u.pm, u.pn); u.a = W + (size_t)(QKVC + u.pm * 256) * DM * 2; u.b = H + (size_t)u.pn * 256 * DM * 2; u.kind = 1; u.ex = 0; return true; }
        return false;
    }
};
constexpr float Q8SCALE = 16.f;
struct EpiInProj {
    unsigned char *Q8, *K8, *VT8; bf16_t* UT; const float *gq, *gk, *rope;
    __device__ __forceinline__ void operator()(f32x4 (&acc)[2][2][4][2], const g8::Unit& u, int wr, int wc, int fr, int fq) const {
        asm volatile("" : "+v"(fr), "+v"(fq));
        if (u.kind == 1) {
            const int row0 = u.pm * 256 + wr * 64 + fr, col0 = u.pn * 256 + wc * 32 + 8 * fq;
#pragma unroll
            for (int ai = 0; ai < 2; ++ai)
#pragma unroll
                for (int m = 0; m < 4; ++m) { const int ch = row0 + ai * 128 + m * 16;
#pragma unroll
                    for (int bj = 0; bj < 2; ++bj) { const int tok = col0 + bj * 128; const f32x4 v0 = acc[ai][bj][m][0], v1 = acc[ai][bj][m][1];
                        u32x4 w; w.x = cvt_pk_bf16(v0[0], v0[1]); w.y = cvt_pk_bf16(v0[2], v0[3]); w.z = cvt_pk_bf16(v1[0], v1[1]); w.w = cvt_pk_bf16(v1[2], v1[3]);
                        *(u32x4*)(UT + ((size_t)(tok >> 7) * HYC + ch) * 128 + (tok & 127)) = w; } }
            return;
        }
        if (u.kind == 2) {
#pragma unroll
            for (int bj = 0; bj < 2; ++bj) { const int t8 = u.pn * 256 + bj * 128 + wc * 32 + 8 * fq;
                int b, key; if (t8 < MROWS) { b = t8 >> 12; key = CTXL + (t8 & 4095); } else { const int j = t8 - MROWS; b = j >> 8; key = j & 255; }
                const int tile = key >> 6, k = key & 63, ipos = (k < 32) ? 4 * (k >> 3) : 16 + 4 * ((k - 32) >> 3);
#pragma unroll
                for (int ai = 0; ai < 2; ++ai)
#pragma unroll
                    for (int m = 0; m < 4; ++m) { const int ch = u.pm * 256 + ai * 128 + wr * 64 + m * 16 + fr;
                        unsigned char* dst = VT8 + ((((size_t)(b * NHEAD + (ch >> 7)) * 68 + tile) * 128 + (ch & 127)) * 64) + ipos;
                        const f32x4 v0 = acc[ai][bj][m][0], v1 = acc[ai][bj][m][1];
                        *(unsigned*)dst = pk4_fp8(v0[0], v0[1], v0[2], v0[3]); *(unsigned*)(dst + 32) = pk4_fp8(v1[0], v1[1], v1[2], v1[3]); } }
            return;
        }
        const int blk = fq >> 1, f = fq & 1;
        const int sec = u.pn >> 1;
        const bool ctx = (u.pm >= 128);
        if (sec == 0 && ctx) return;
        const int colbase = (u.pn & 1) * 256 + wc * 64 + 32 * blk + 8 * f;
        float gg[2][2][4];
        { const float* gp = (sec == 0 ? gq : gk) + 32 * blk + 8 * f;
#pragma unroll
            for (int bj = 0; bj < 2; ++bj)
#pragma unroll
                for (int n = 0; n < 2; ++n) { const f32x4 t = *(const f32x4*)(gp + 16 * bj + 4 * n); gg[bj][n][0] = t[0]; gg[bj][n][1] = t[1]; gg[bj][n][2] = t[2]; gg[bj][n][3] = t[3]; } }
#pragma unroll
        for (int ai = 0; ai < 2; ++ai)
#pragma unroll
            for (int m = 0; m < 4; ++m) {
                const int rloc = ai * 128 + wr * 64 + m * 16 + fr; const int r = u.pm * 256 + rloc;
                f32x4 v[2][2];
#pragma unroll
                for (int bj = 0; bj < 2; ++bj)
#pragma unroll
                    for (int n = 0; n < 2; ++n) v[bj][n] = acc[ai][bj][m][n];
                size_t orow;
                if (sec == 0) orow = (size_t)r;
                else if (!ctx) orow = (size_t)(r >> 12) * KVL + CTXL + (r & 4095);
                else { const int j = r - MROWS; orow = (size_t)(j >> 8) * KVL + (j & 255); }
                float ss = 0.f;
#pragma unroll
                for (int bj = 0; bj < 2; ++bj)
#pragma unroll
                    for (int n = 0; n < 2; ++n) ss += (v[bj][n][0] * v[bj][n][0] + v[bj][n][1] * v[bj][n][1]) + (v[bj][n][2] * v[bj][n][2] + v[bj][n][3] * v[bj][n][3]);
                ss += __shfl_xor(ss, 16); ss += __shfl_xor(ss, 32);
                const float rstd = rsqrtf(ss * (1.f / 64.f) + EPS) * (sec == 0 ? QSCALE * Q8SCALE : 1.f);
#pragma unroll
                for (int bj = 0; bj < 2; ++bj)
#pragma unroll
                    for (int n = 0; n < 2; ++n)
#pragma unroll
                        for (int e = 0; e < 4; ++e) v[bj][n][e] *= rstd * gg[bj][n][e];
                if (!ctx) {
                    const int t = r & 4095; const int pos = blk ? (t & 63) : (t >> 6);
                    const float* rp = rope + (size_t)(pos * 16 + 8 * f) * 2;
#pragma unroll
                    for (int n = 0; n < 2; ++n) { const f32x4 c0 = *(const f32x4*)(rp + 8 * n), c1 = *(const f32x4*)(rp + 8 * n + 4);
                        const float cs[4] = {c0[0], c0[2], c1[0], c1[2]}, sn[4] = {c0[1], c0[3], c1[1], c1[3]};
#pragma unroll
                        for (int e = 0; e < 4; ++e) { const float x1 = v[0][n][e], x2 = v[1][n][e]; v[0][n][e] = x1 * cs[e] - x2 * sn[e]; v[1][n][e] = x2 * cs[e] + x1 * sn[e]; } }
                }
                unsigned char* dst = (sec == 0 ? Q8 : K8) + orow * QKW + colbase;
#pragma unroll
                for (int bj = 0; bj < 2; ++bj) { u32x2 w; w.x = pk4_fp8(v[bj][0][0], v[bj][0][1], v[bj][0][2], v[bj][0][3]); w.y = pk4_fp8(v[bj][1][0], v[bj][1][1], v[bj][1][2], v[bj][1][3]);
                    *(u32x2*)(dst + 16 * bj) = w; }
            }
    }
};

struct SchedStatic {
    int G, c, nM, nN; const char* A; const char* B;
    __device__ __forceinline__ bool next(int i, g8::Unit& u) const {
        const long L = (long)i * G + c; if (L >= (long)nM * nN) return false;
        g8::tile_of((int)L, nM, nN, u.pm, u.pn); u.a = A + (size_t)u.pm * 256 * DM * 2; u.b = B + (size_t)u.pn * 256 * DM * 2; u.kind = 0; u.ex = 0; return true;
    }
};
struct EpiOutProj {
    const float* x; bf16_t* out; const float* mod;
    __device__ __forceinline__ void operator()(f32x4 (&acc)[2][2][4][2], const g8::Unit& u, int wr, int wc, int fr, int fq) const {
        asm volatile("" : "+v"(fr), "+v"(fq));
        const int col0 = u.pn * 256 + wc * 32 + 8 * fq;
        const float* g1 = mod + (size_t)((u.pm * 256) >> 12) * (NMOD * DM) + 2 * DM + col0;
        f32x4 gv[2][2];
#pragma unroll
        for (int bj = 0; bj < 2; ++bj)
#pragma unroll
            for (int n = 0; n < 2; ++n) gv[bj][n] = *(const f32x4*)(g1 + bj * 128 + 4 * n);
#pragma unroll
        for (int ai = 0; ai < 2; ++ai)
#pragma unroll
            for (int m = 0; m < 4; ++m) { const int r = u.pm * 256 + ai * 128 + wr * 64 + m * 16 + fr;
                const size_t off = (size_t)r * DM + col0;
#pragma unroll
                for (int bj = 0; bj < 2; ++bj) { f32x4 o[2];
#pragma unroll
                    for (int n = 0; n < 2; ++n) { const f32x4 xv = __builtin_nontemporal_load((const f32x4*)(x + off + bj * 128 + 4 * n)); o[n] = xv + gv[bj][n] * acc[ai][bj][m][n]; }
                    u32x4 w; w.x = cvt_pk_bf16(o[0][0], o[0][1]); w.y = cvt_pk_bf16(o[0][2], o[0][3]); w.z = cvt_pk_bf16(o[1][0], o[1][1]); w.w = cvt_pk_bf16(o[1][2], o[1][3]);
                    *(u32x4*)(out + off + bj * 128) = w; } }
    }
};

namespace att8 {
constexpr int NT = KVL / 64, SHMB = 8192, LDS_V0 = 3 * SHMB;
typedef int i32x8 __attribute__((ext_vector_type(8)));
#define SBAR() __builtin_amdgcn_sched_barrier(0)
__device__ __forceinline__ int crow(int r, int hi) { return (r & 3) + 8 * (r >> 2) + 4 * hi; }
__device__ __forceinline__ i32x8 ld32(const LAS unsigned char* p0, const LAS unsigned char* p1) {
    const u32x4 a = *(const LAS u32x4*)p0, b = *(const LAS u32x4*)p1; return (i32x8){(int)a.x, (int)a.y, (int)a.z, (int)a.w, (int)b.x, (int)b.y, (int)b.z, (int)b.w}; }
__device__ __forceinline__ void mfma_qk(f32x16& p, const i32x8& kf, const i32x8& qf, const f32x16& negc) {
    const unsigned s1 = 0x7f7f7f7fu, sq = 0x7b7b7b7bu;
    asm volatile("s_nop 1\n\tv_mfma_scale_f32_32x32x64_f8f6f4 %0, %1, %2, %3, %4, %5 op_sel_hi:[0,0,0]" : "=&v"(p) : "v"(kf), "v"(qf), "v"(negc), "v"(s1), "v"(sq));
}
__device__ __forceinline__ void mfma_pv(f32x16& o, const i32x8& pa, const i32x8& vf) {
    const unsigned s1 = 0x7f7f7f7fu;
    asm volatile("s_nop 2\n\tv_mfma_scale_f32_32x32x64_f8f6f4 %0, %1, %2, %0, %3, %3 op_sel_hi:[0,0,0]" : "+v"(o) : "v"(pa), "v"(vf), "v"(s1));
}
__device__ __forceinline__ void qkt(f32x16& p0, f32x16& p1, const LAS unsigned char* Kb, const i32x8& qf, const f32x16& negc, int r32, int hi, int sub) {
    const int c0 = sub * 4 + hi * 2;
    const int k0 = r32, k1 = 32 + r32;
    const i32x8 kf0 = ld32(Kb + k0 * 128 + ((c0 ^ ((k0 >> 1) & 7)) << 4), Kb + k0 * 128 + (((c0 + 1) ^ ((k0 >> 1) & 7)) << 4));
    const i32x8 kf1 = ld32(Kb + k1 * 128 + ((c0 ^ ((k1 >> 1) & 7)) << 4), Kb + k1 * 128 + (((c0 + 1) ^ ((k1 >> 1) & 7)) << 4));
    mfma_qk(p0, kf0, qf, negc); mfma_qk(p1, kf1, qf, negc);
}
__device__ __forceinline__ void mfma_wait(f32x16& p0, f32x16& p1) { asm volatile("s_nop 15\n\ts_nop 3" : "+v"(p0), "+v"(p1)); }
__device__ __forceinline__ void expA(f32x16& p) {
#pragma unroll
    for (int r = 0; r < 16; ++r) p[r] = __builtin_amdgcn_exp2f(p[r]);
}
__device__ __forceinline__ void finishSM(f32x16& p0, f32x16& p1, i32x8& pa) {
#pragma unroll
    for (int r = 0; r < 16; ++r) p1[r] = __builtin_amdgcn_exp2f(p1[r]);
#pragma unroll
    for (int j = 0; j < 4; ++j) { pa[j] = (int)pk4_fp8(p0[4 * j], p0[4 * j + 1], p0[4 * j + 2], p0[4 * j + 3]); pa[4 + j] = (int)pk4_fp8(p1[4 * j], p1[4 * j + 1], p1[4 * j + 2], p1[4 * j + 3]); }
}
__device__ __forceinline__ void pv(f32x16* o, f32x16& ol, const i32x8& ones, const LAS unsigned char* Vb, const i32x8& pa, int r32, int hi) {
    mfma_pv(ol, pa, ones);
#pragma unroll
    for (int d0 = 0; d0 < 4; ++d0) { const int d = 32 * d0 + r32, sw = (d >> 2) & 3;
        const i32x8 vf = ld32(Vb + d * 64 + (((2 * hi) ^ sw) << 4), Vb + d * 64 + (((2 * hi + 1) ^ sw) << 4));
        mfma_pv(o[d0], pa, vf); }
}
__device__ __forceinline__ void attn_unit(const unsigned char* __restrict__ Qb, const unsigned char* __restrict__ Kh, const unsigned char* __restrict__ VTh, bf16_t* MIXo,
                                          const float lam, const float* __restrict__ subg, char* lds, const int wid) {
    const int lane = lane_id(), tid = wid * 64 + lane, r32 = lane & 31, hi = lane >> 5;
    const int sub = wid >> 2, wq = wid & 3;
    const LAS unsigned char* L = (const LAS unsigned char*)(uintptr_t)(unsigned)(uintptr_t)lds;
    f32x16 o[4] = {}; f32x16 ol = {};
    i32x8 ones; { int c1 = 0x38383838; asm volatile("" : "+v"(c1)); ones = (i32x8){c1, c1, c1, c1, c1, c1, c1, c1}; }
    i32x8 qf; { const unsigned char* qp = Qb + (size_t)(wq * 32 + r32) * QKW + sub * 64 + 32 * hi; const u32x4 a = *(const u32x4*)qp, b = *(const u32x4*)(qp + 16);
        qf = (i32x8){(int)a.x, (int)a.y, (int)a.z, (int)a.w, (int)b.x, (int)b.y, (int)b.z, (int)b.w}; }
    f32x16 negc;
#pragma unroll
    for (int r = 0; r < 16; ++r) negc[r] = -5.f;
    asm volatile("" : "+v"(negc));
    long ksrc, vsrc;
    { const int r = 8 * wid + (lane >> 3), c = (lane & 7) ^ ((r >> 1) & 7); ksrc = (long)r * QKW + c * 16; }
    { const int d = 16 * wid + (lane >> 2), c = (lane & 3) ^ ((d >> 2) & 3); vsrc = (long)d * 64 + c * 16; }
    const unsigned ldsb = (unsigned)(uintptr_t)lds, kdst = ldsb + (unsigned)wid * 1024u, vdst = ldsb + LDS_V0 + (unsigned)wid * 1024u;
#define DMA_TILE(t, boff) do { \
        __builtin_amdgcn_global_load_lds((const unsigned*)(Kh + (long)(t) * 64 * QKW + ksrc), (LAS unsigned*)(uintptr_t)__builtin_amdgcn_readfirstlane(kdst + (unsigned)(boff)), 16, 0, 0); \
        __builtin_amdgcn_global_load_lds((const unsigned*)(VTh + (long)(t) * 8192 + vsrc), (LAS unsigned*)(uintptr_t)__builtin_amdgcn_readfirstlane(vdst + (unsigned)(boff)), 16, 0, 0); } while (0)
#define WBAR() do { asm volatile("s_waitcnt vmcnt(0) lgkmcnt(0)" ::: "memory"); __builtin_amdgcn_s_barrier(); asm volatile("" ::: "memory"); } while (0)
#define ROT3(x) ((x) == 2 * SHMB ? 0 : (x) + SHMB)
    f32x16 pA0, pA1, pB0, pB1; i32x8 pa;
    DMA_TILE(0, 0); WBAR();
    DMA_TILE(1, SHMB);
    qkt(pA0, pA1, L, qf, negc, r32, hi, sub); mfma_wait(pA0, pA1); expA(pA0);
    WBAR();
    int bprev = 0, bcur = SHMB, bnext = 2 * SHMB;
    for (int j = 1; j + 1 < NT; j += 2) {
        DMA_TILE(j + 1, bnext);
        SBAR(); qkt(pB0, pB1, L + bcur, qf, negc, r32, hi, sub);
        finishSM(pA0, pA1, pa); SBAR();
        pv(o, ol, ones, L + LDS_V0 + bprev, pa, r32, hi); mfma_wait(pB0, pB1); expA(pB0);
        WBAR();
        bprev = bcur; bcur = bnext; bnext = ROT3(bnext);
        if (j + 2 < NT) DMA_TILE(j + 2, bnext);
        SBAR(); qkt(pA0, pA1, L + bcur, qf, negc, r32, hi, sub);
        finishSM(pB0, pB1, pa); SBAR();
        pv(o, ol, ones, L + LDS_V0 + bprev, pa, r32, hi); mfma_wait(pA0, pA1); expA(pA0);
        WBAR();
        bprev = bcur; bcur = bnext; bnext = ROT3(bnext);
    }
    SBAR(); qkt(pB0, pB1, L + bcur, qf, negc, r32, hi, sub);
    finishSM(pA0, pA1, pa); SBAR();
    pv(o, ol, ones, L + LDS_V0 + bprev, pa, r32, hi); mfma_wait(pB0, pB1); expA(pB0);
    finishSM(pB0, pB1, pa); SBAR();
    pv(o, ol, ones, L + LDS_V0 + bcur, pa, r32, hi);
    asm volatile("s_nop 15\n\ts_nop 3" : "+v"(o[0]), "+v"(o[1]), "+v"(o[2]), "+v"(o[3]), "+v"(ol));
#undef ROT3
#undef DMA_TILE
#undef WBAR
    __syncthreads();
    float* X = (float*)lds;
    float rli[16];
#pragma unroll
    for (int r = 0; r < 16; ++r) rli[r] = __builtin_amdgcn_rcpf(ol[r]);
    if (sub == 1) {
#pragma unroll
        for (int r = 0; r < 16; ++r) { const int row = wq * 32 + crow(r, hi); const float sc = lam * rli[r];
#pragma unroll
            for (int d0 = 0; d0 < 4; ++d0) X[row * 128 + d0 * 32 + r32] = o[d0][r] * sc; }
    }
    __syncthreads();
    bf16_t* Y = (bf16_t*)(lds + 65536);
    if (sub == 0) {
        float sg[4];
#pragma unroll
        for (int d0 = 0; d0 < 4; ++d0) sg[d0] = subg[d0 * 32 + r32] * (1.f - LAM_INIT);
#pragma unroll
        for (int r = 0; r < 16; ++r) { const int row = wq * 32 + crow(r, hi);
            float v[4]; float ss = 0.f;
#pragma unroll
            for (int d0 = 0; d0 < 4; ++d0) { v[d0] = o[d0][r] * rli[r] - X[row * 128 + d0 * 32 + r32]; ss += v[d0] * v[d0]; }
            ss += __shfl_xor(ss, 1); ss += __shfl_xor(ss, 2); ss += __shfl_xor(ss, 4); ss += __shfl_xor(ss, 8); ss += __shfl_xor(ss, 16);
            const float rstd = rsqrtf(ss * (1.f / 128.f) + EPS);
#pragma unroll
            for (int d0 = 0; d0 < 4; ++d0) Y[row * 128 + d0 * 32 + r32] = (bf16_t)(cvt_pk_bf16(v[d0] * rstd * sg[d0], 0.f) & 0xffffu); }
    }
    __syncthreads();
    { const int row = tid >> 2, seg = (tid & 3) * 32;
#pragma unroll
        for (int i = 0; i < 4; ++i) { const u32x4 v = *(const u32x4*)(Y + row * 128 + seg + i * 8); *(u32x4*)(MIXo + (size_t)row * DM + seg + i * 8) = v; } }
    __syncthreads();
}
#undef SBAR
}

__device__ __forceinline__ void p3_attention8(Frame& F) {
    FT_DECL;
    const float* sc = WSP(float, WS_SMALL + SM_SCAL);
    const float lam = sc[0];
    const unsigned char* Q8 = WSP(unsigned char, WS_Q); const unsigned char* K8 = WSP(unsigned char, WS_K); const unsigned char* VT8 = WSP(unsigned char, WS_V); bf16_t* MIX = WSP(bf16_t, WS_MIX);
    const int c = blockIdx.x, xcd = c & 7, ci = c >> 3, per = F.G >> 3;
    for (int j = ci; j < 128; j += per) {
        const int pair = xcd * 4 + (j >> 5), qb = j & 31, b = pair >> 2, h = pair & 3;
        att8::attn_unit(Q8 + ((size_t)b * SEQ + qb * 128) * QKW + h * 128, K8 + (size_t)b * KVL * QKW + h * 128, VT8 + (size_t)(b * NHEAD + h) * 68 * 8192,
                        MIX + ((size_t)b * SEQ + qb * 128) * DM + h * 128, lam, F.in[15], (char*)F.lds, F.wave);
    }
}

namespace hy {
constexpr int RB_BYTES = 4352 * 8, IN_OFF = 2 * RB_BYTES, TW1_OFF = IN_OFF + 32768, TW2_OFF = TW1_OFF + 15 * 256 * 8, LDS_END = TW2_OFF + 15 * 16 * 8;
__device__ __forceinline__ f32x2 cmul(f32x2 a, f32x2 b) { return (f32x2){a.x * b.x - a.y * b.y, a.x * b.y + a.y * b.x}; }
__device__ __forceinline__ f32x2 cmulc(f32x2 a, f32x2 b) { return (f32x2){a.x * b.x + a.y * b.y, a.y * b.x - a.x * b.y}; }
__device__ __forceinline__ int P(int i) { return i + (i >> 4); }
template <bool INV> __device__ __forceinline__ void r4(f32x2& a, f32x2& b, f32x2& c, f32x2& d) {
    const f32x2 t0 = a + c, t1 = a - c, t2 = b + d, t3 = b - d;
    const f32x2 st3 = INV ? (f32x2){-t3.y, t3.x} : (f32x2){t3.y, -t3.x};
    a = t0 + t2; c = t0 - t2; b = t1 + st3; d = t1 - st3;
}
template <bool INV> __device__ __forceinline__ f32x2 tw(f32x2 v, float c, float s) {
    return INV ? (f32x2){v.x * c - v.y * s, v.y * c + v.x * s} : (f32x2){v.x * c + v.y * s, v.y * c - v.x * s};
}
template <bool INV> __device__ __forceinline__ void dft16(f32x2 (&v)[16]) {
    constexpr float C1 = 0.9238795325112867f, S1 = 0.3826834323650898f, R2 = 0.7071067811865476f;
    r4<INV>(v[0], v[4], v[8], v[12]); r4<INV>(v[1], v[5], v[9], v[13]); r4<INV>(v[2], v[6], v[10], v[14]); r4<INV>(v[3], v[7], v[11], v[15]);
    v[5] = tw<INV>(v[5], C1, S1);  v[9] = tw<INV>(v[9], R2, R2);    v[13] = tw<INV>(v[13], S1, C1);
    v[6] = tw<INV>(v[6], R2, R2);  v[10] = tw<INV>(v[10], 0.f, 1.f); v[14] = tw<INV>(v[14], -R2, R2);
    v[7] = tw<INV>(v[7], S1, C1);  v[11] = tw<INV>(v[11], -R2, R2);  v[15] = tw<INV>(v[15], -C1, -S1);
    r4<INV>(v[0], v[1], v[2], v[3]); r4<INV>(v[4], v[5], v[6], v[7]); r4<INV>(v[8], v[9], v[10], v[11]); r4<INV>(v[12], v[13], v[14], v[15]);
    f32x2 t;
    t = v[1]; v[1] = v[4]; v[4] = t;   t = v[2]; v[2] = v[8]; v[8] = t;    t = v[3]; v[3] = v[12]; v[12] = t;
    t = v[6]; v[6] = v[9]; v[9] = t;   t = v[7]; v[7] = v[13]; v[13] = t;  t = v[11]; v[11] = v[14]; v[14] = t;
}
struct Ctx { LAS f32x2* R; LAS f32x2* IN; LAS f32x2* TW1; LAS f32x2* TW2; int t, half; f32x2 wt; };
#define HY_OPAQUE(x) asm volatile("" : "+v"(x))
#define HY_W32(m) (f32x2){__builtin_cosf(-0.19634954084936207f * (m)), __builtin_sinf(-0.19634954084936207f * (m))}
template <int MODE> __device__ __forceinline__ void pass1_fwd(const Ctx& X) {
    f32x2 v[16]; int t = X.t; HY_OPAQUE(t);
#pragma unroll
    for (int m = 0; m < 16; ++m) { f32x2 a = X.IN[t + 256 * m]; if (MODE == 1) a = (f32x2){X.half ? a.y : a.x, 0.f}; v[m] = a; }
    if (X.half) {
#pragma unroll
        for (int m = 0; m < 16; ++m) v[m] = cmul(cmul(v[m], HY_W32(m)), X.wt);
    }
    dft16<false>(v);
#pragma unroll
    for (int q = 1; q < 16; ++q) v[q] = cmul(v[q], X.TW1[(q - 1) * 256 + t]);
    const int pb = t + (t >> 4);
#pragma unroll
    for (int q = 0; q < 16; ++q) X.R[pb + 272 * q] = v[q];
}
__device__ __forceinline__ void pass2_fwd(const Ctx& X) {
    int t = X.t; HY_OPAQUE(t);
    const int n2 = t & 15, pb = (t >> 4) * 272 + n2; f32x2 v[16];
#pragma unroll
    for (int m = 0; m < 16; ++m) v[m] = X.R[pb + 17 * m];
    dft16<false>(v);
#pragma unroll
    for (int q = 1; q < 16; ++q) v[q] = cmul(v[q], X.TW2[(q - 1) * 16 + n2]);
#pragma unroll
    for (int q = 0; q < 16; ++q) X.R[pb + 17 * q] = v[q];
}
template <bool FILTER> __device__ __forceinline__ void pass3(const Ctx& X, f32x2 (&H)[16]) {
    f32x2 v[16]; int t = X.t; HY_OPAQUE(t); const int pb = 17 * t;
#pragma unroll
    for (int m = 0; m < 16; ++m) v[m] = X.R[pb + m];
    dft16<false>(v);
    if (FILTER) {
#pragma unroll
        for (int q = 0; q < 16; ++q) H[q] = v[q] * (1.f / 8192.f);
    } else {
#pragma unroll
        for (int q = 0; q < 16; ++q) v[q] = cmul(v[q], H[q]);
        dft16<true>(v);
#pragma unroll
        for (int m = 0; m < 16; ++m) X.R[pb + m] = v[m];
    }
}
__device__ __forceinline__ void pass2_inv(const Ctx& X) {
    int t = X.t; HY_OPAQUE(t);
    const int n2 = t & 15, pb = (t >> 4) * 272 + n2; f32x2 v[16];
    v[0] = X.R[pb];
#pragma unroll
    for (int q = 1; q < 16; ++q) v[q] = cmulc(X.R[pb + 17 * q], X.TW2[(q - 1) * 16 + n2]);
    dft16<true>(v);
#pragma unroll
    for (int m = 0; m < 16; ++m) X.R[pb + 17 * m] = v[m];
}
__device__ __forceinline__ void pass1_inv(const Ctx& X) {
    f32x2 v[16]; int t = X.t; HY_OPAQUE(t); const int pb = t + (t >> 4);
    v[0] = X.R[pb];
#pragma unroll
    for (int q = 1; q < 16; ++q) v[q] = cmulc(X.R[pb + 272 * q], X.TW1[(q - 1) * 256 + t]);
    dft16<true>(v);
    if (X.half) {
#pragma unroll
        for (int m = 0; m < 16; ++m) v[m] = cmulc(cmulc(v[m], HY_W32(m)), X.wt);
    }
#pragma unroll
    for (int m = 0; m < 16; ++m) X.R[pb + 272 * m] = v[m];
}
#define HY_WSYNC() asm volatile("s_waitcnt lgkmcnt(0)" ::: "memory")
__device__ __forceinline__ void conv_fft(const Ctx& X, f32x2 (&H)[16]) {
    __syncthreads(); pass1_fwd<0>(X); __syncthreads(); pass2_fwd(X); HY_WSYNC(); pass3<false>(X, H); HY_WSYNC(); pass2_inv(X); __syncthreads(); pass1_inv(X); __syncthreads();
}
constexpr int STG_OFF = LDS_END;
constexpr int LDS_END2 = STG_OFF + 2 * SEQ * 2;
static_assert(LDS_END2 <= LDSCTL_OFF, "hyena LDS map");
__device__ __forceinline__ float sconv_lds(const LAS bf16_t* stg, int bs, int n, float w0, float w1, float w2, float bias) {
    const LAS bf16_t* p = stg + bs * SEQ;
    const float c = bf2f(p[n]), lv = bf2f(p[n - ((n > 0) ? 1 : 0)]), rv = bf2f(p[n + ((n < SEQ - 1) ? 1 : 0)]);
    const float l = (n > 0) ? lv : 0.f, r = (n < SEQ - 1) ? rv : 0.f;
    return bias + w0 * l + w1 * c + w2 * r;
}
__device__ __forceinline__ void setup_tables(LAS unsigned char* lds, int tid) {
    LAS f32x2* TW1 = (LAS f32x2*)(lds + TW1_OFF); LAS f32x2* TW2 = (LAS f32x2*)(lds + TW2_OFF);
    for (int i = tid; i < 15 * 256; i += 512) { const int q = i / 256 + 1, t = i & 255; float s, c; sincosf(-6.283185307179586f * (float)((t * q) & 4095) * (1.f / 4096.f), &s, &c); TW1[i] = (f32x2){c, s}; }
    for (int i = tid; i < 15 * 16; i += 512) { const int q = i / 16 + 1, n2 = i & 15; float s, c; sincosf(-6.283185307179586f * (float)((n2 * q) & 255) * (1.f / 256.f), &s, &c); TW2[i] = (f32x2){c, s}; }
}
__device__ __forceinline__ void unit(Frame& F, int c) {
    FT_DECL;
    const int tid = f_tid; Ctx X; X.half = F.wave >> 2; X.t = tid & 255;
    X.R = (LAS f32x2*)(F.lds + X.half * RB_BYTES); X.IN = (LAS f32x2*)(F.lds + IN_OFF); X.TW1 = (LAS f32x2*)(F.lds + TW1_OFF); X.TW2 = (LAS f32x2*)(F.lds + TW2_OFF);
    { float s, cc; sincosf(-6.283185307179586f * (float)X.t * (1.f / 8192.f), &s, &cc); X.wt = (f32x2){cc, s}; }
    LAS f32x2* RB0 = (LAS f32x2*)(F.lds); LAS f32x2* RB1 = (LAS f32x2*)(F.lds + RB_BYTES);
    const float* FILT = WSP(float, WS_FILT);
    f32x2 H0[16], H1[16];
#pragma unroll
    for (int ord = 0; ord < 2; ++ord) {
        const float* hf = FILT + ((size_t)(ord * 2 + 0) * 512 + c) * SEQ; const float* hb = FILT + ((size_t)(ord * 2 + 1) * 512 + c) * SEQ;
        __syncthreads();
        int nb = tid; HY_OPAQUE(nb);
#pragma unroll
        for (int j = 0; j < 8; ++j) { const int n = nb + 512 * j; const float a = hf[n], b = hb[(SEQ - n) & (SEQ - 1)]; const float lo = (n == 0) ? a + b : a, hi = (n == 0) ? 0.f : b; X.IN[n] = (f32x2){lo + hi, lo - hi}; }
        __syncthreads(); pass1_fwd<1>(X); __syncthreads(); pass2_fwd(X); HY_WSYNC();
        if (ord == 0) pass3<true>(X, H0); else pass3<true>(X, H1);
    }
    const bf16_t* UT = WSP(bf16_t, WS_UT);
    const bf16_t* rv = UT + (size_t)c * 128; const bf16_t* r1 = UT + (size_t)(512 + c) * 128; const bf16_t* r2 = UT + (size_t)(1024 + c) * 128;
#define HY_LD(rowp, t) (*(const u32x4*)((rowp) + (size_t)((t) >> 7) * (HYC * 128) + ((t) & 127)))
    const float* cw = F.in[16]; const float* cb = F.in[17];
    const float wv0 = cw[c], wv1 = cw[HYC + c], wv2 = cw[2 * HYC + c], bv = cb[c];
    const float wa0 = cw[512 + c], wa1 = cw[HYC + 512 + c], wa2 = cw[2 * HYC + 512 + c], ba = cb[512 + c];
    const float wb0 = cw[1024 + c], wb1 = cw[HYC + 1024 + c], wb2 = cw[2 * HYC + 1024 + c], bb = cb[1024 + c];
    const float sk0 = F.in[25][c], sk1 = F.in[25][512 + c];
    bf16_t* Z = WSP(bf16_t, WS_Z2T) + (size_t)c * 128;
    LAS bf16_t* STG = (LAS bf16_t*)(F.lds + STG_OFF);
    u32x4 g0 = HY_LD(rv, tid * 8), g1 = HY_LD(rv, SEQ + tid * 8);
    for (int pr = 0; pr < 4; ++pr) {
        const int b0 = 2 * pr, b1 = b0 + 1;
        f32x2 z[8]; int pc = tid + (tid >> 4); HY_OPAQUE(pc); int nb = tid; HY_OPAQUE(nb);
        __syncthreads();
        *(LAS u32x4*)(STG + tid * 8) = g0; *(LAS u32x4*)(STG + SEQ + tid * 8) = g1;
        __syncthreads();
#pragma unroll
        for (int j = 0; j < 8; ++j) { const int n = nb + 512 * j; z[j] = (f32x2){sconv_lds(STG, 0, n, wv0, wv1, wv2, bv), sconv_lds(STG, 1, n, wv0, wv1, wv2, bv)}; X.IN[n] = z[j]; }
        g0 = HY_LD(r1, b0 * SEQ + tid * 8); g1 = HY_LD(r1, b1 * SEQ + tid * 8);
        conv_fft(X, H0);
        *(LAS u32x4*)(STG + tid * 8) = g0; *(LAS u32x4*)(STG + SEQ + tid * 8) = g1;
        __syncthreads();
        HY_OPAQUE(nb); HY_OPAQUE(pc);
#pragma unroll
        for (int j = 0; j < 8; ++j) { const int n = nb + 512 * j; const f32x2 y = RB0[pc + 544 * j] + RB1[pc + 544 * j];
            const f32x2 g = (f32x2){sconv_lds(STG, 0, n, wa0, wa1, wa2, ba), sconv_lds(STG, 1, n, wa0, wa1, wa2, ba)};
            z[j] = g * (y + sk0 * z[j]); X.IN[n] = z[j]; }
        g0 = HY_LD(r2, b0 * SEQ + tid * 8); g1 = HY_LD(r2, b1 * SEQ + tid * 8);
        conv_fft(X, H1);
        *(LAS u32x4*)(STG + tid * 8) = g0; *(LAS u32x4*)(STG + SEQ + tid * 8) = g1;
        __syncthreads();
        if (pr < 3) { g0 = HY_LD(rv, (b0 + 2) * SEQ + tid * 8); g1 = HY_LD(rv, (b1 + 2) * SEQ + tid * 8); }
        HY_OPAQUE(nb); HY_OPAQUE(pc);
        f32x2 o[8];
#pragma unroll
        for (int j = 0; j < 8; ++j) { const int n = nb + 512 * j; const f32x2 y = RB0[pc + 544 * j] + RB1[pc + 544 * j];
            const f32x2 g = (f32x2){sconv_lds(STG, 0, n, wb0, wb1, wb2, bb), sconv_lds(STG, 1, n, wb0, wb1, wb2, bb)};
            o[j] = g * (y + sk1 * z[j]); }
        __syncthreads();
#pragma unroll
        for (int j = 0; j < 8; ++j) { const int n = nb + 512 * j; STG[n] = (bf16_t)(cvt_pk_bf16(o[j].x, 0.f) & 0xffffu); STG[SEQ + n] = (bf16_t)(cvt_pk_bf16(o[j].y, 0.f) & 0xffffu); }
        __syncthreads();
        { const int t0 = b0 * SEQ + tid * 8, t1 = b1 * SEQ + tid * 8;
          *(u32x4*)(Z + (size_t)(t0 >> 7) * (HYW * 128) + (t0 & 127)) = *(const LAS u32x4*)(STG + tid * 8); *(u32x4*)(Z + (size_t)(t1 >> 7) * (HYW * 128) + (t1 & 127)) = *(const LAS u32x4*)(STG + SEQ + tid * 8); }
    }
    __syncthreads();
}
}

__device__ __forceinline__ void p3_hyena(Frame& F) {
    FT_DECL;
    __syncthreads();
    hy::setup_tables(F.lds, f_tid);
    __syncthreads();
    for (int c = F.vcu; c < HYW; c += F.G) hy::unit(F, c);
}

__device__ __forceinline__ void p4_hynorm(Frame& F) {
    FT_DECL;
    const bf16_t* Z = WSP(bf16_t, WS_Z2T); bf16_t* MIX = WSP(bf16_t, WS_MIX); const float* g = F.in[26];
    constexpr int TP = 132;
    LAS bf16_t* T = (LAS bf16_t*)F.lds;
    LAS float* red = (LAS float*)(F.lds + 512 * TP * 2);
    LAS float* rs = red + 512;
    float gl[8];
#pragma unroll
    for (int e = 0; e < 8; ++e) gl[e] = g[(f_tid & 63) + 64 * e];
    for (int it = F.vcu; it < MROWS / 128; it += F.G) {
        const int tok0 = it * 128; const bf16_t* zt = Z + (size_t)it * (HYW * 128);
        __syncthreads();
        u32x4 v[16];
#pragma unroll
        for (int j = 0; j < 16; ++j) v[j] = __builtin_nontemporal_load((const u32x4*)(zt + (size_t)(f_tid + 512 * j) * 8));
#pragma unroll
        for (int j = 0; j < 16; ++j) { const int i = f_tid + 512 * j; LAS u32x2* d = (LAS u32x2*)(T + (i >> 4) * TP + (i & 15) * 8); d[0] = (u32x2){v[j].x, v[j].y}; d[1] = (u32x2){v[j].z, v[j].w}; }
        __syncthreads();
        { const int tok = f_tid & 127, grp = f_tid >> 7; float ss = 0.f;
#pragma unroll 8
            for (int k = 0; k < 128; ++k) { const float x = bf2f(T[(grp * 128 + k) * TP + tok]); ss += x * x; }
            red[grp * 128 + tok] = ss; }
        __syncthreads();
        if (f_tid < 128) rs[f_tid] = rsqrtf(((red[f_tid] + red[128 + f_tid]) + (red[256 + f_tid] + red[384 + f_tid])) * (1.f / HYW) + EPS);
        __syncthreads();
#pragma unroll
        for (int j = 0; j < 16; ++j) { const int i = f_tid + 512 * j, tok = i >> 6, l = i & 63; const float r = rs[tok];
            float x[8];
#pragma unroll
            for (int e = 0; e < 8; ++e) x[e] = bf2f(T[(l + 64 * e) * TP + tok]) * r * gl[e];
            u32x4 w; w.x = cvt_pk_bf16(x[0], x[1]); w.y = cvt_pk_bf16(x[2], x[3]); w.z = cvt_pk_bf16(x[4], x[5]); w.w = cvt_pk_bf16(x[6], x[7]);
            *(u32x4*)(MIX + (size_t)(tok0 + tok) * DM + 512 + 8 * l) = w; }
    }
}

constexpr size_t RT_TOPI = 0;
constexpr size_t RT_GATE = 512 * 1024;
constexpr size_t RT_POS = 1024 * 1024;
constexpr size_t RT_WGCNT = 1536 * 1024;
constexpr size_t RT_META = 1600 * 1024;
constexpr size_t RT_LIST = 2048 * 1024;
constexpr size_t RT_GSLOT = 2048 * 1024 + 640 * 1024;
constexpr int MAXSLOT = MROWS * TOPK + NEXP * 256;
constexpr int MAXTILE = MAXSLOT / 256;
constexpr size_t WS_XS = WS_EO;
constexpr int RW_PITCH = 32;
constexpr int P6_LDS_TOPI = 1024 * RW_PITCH * 4;

__device__ __forceinline__ void p6_router_mfma(Frame& F) {
    FT_DECL;
#define in F.in
    LAS float* WP = (LAS float*)F.lds;
    LAS int* TI = (LAS int*)(F.lds + P6_LDS_TOPI);
    LAS int* PS = TI + 512;
    LAS int* SC = PS + 512;
    LAS float* RSTD = (LAS float*)(SC + 512);
    LAS float* BIAS = RSTD + 128;
    LAS float* SSX = BIAS + 32;
    const float* rw = in[28]; const float* mod = WSP(float, WS_SMALL + SM_MOD); const float* g2n = in[7]; const float* rb = in[29];
    const bf16_t* XN = WSP(bf16_t, WS_XN); unsigned char* H2 = WSP(unsigned char, WS_H);
    int* topi_g = WSP(int, WS_ROUTE + RT_TOPI); float* gate_g = WSP(float, WS_ROUTE + RT_GATE); int* pos_g = WSP(int, WS_ROUTE + RT_POS); int* wgcnt = WSP(int, WS_ROUTE + RT_WGCNT);
    for (int blk = blockIdx.x; blk < MROWS / 128; blk += F.G) {
        const float* sh2 = mod + (size_t)(blk >> 5) * (NMOD * DM) + 3 * DM; const float* sc2 = sh2 + DM;
        __syncthreads();
#pragma unroll 1
        for (int hb = 0; hb < 2; ++hb) { f32x4 wv[8]; float gm[8];
#pragma unroll
            for (int q = 0; q < 8; ++q) { const int i = f_tid + 512 * (8 * hb + q), k = i >> 3, c4 = i & 7; wv[q] = *(const f32x4*)(rw + (size_t)k * 32 + c4 * 4); gm[q] = g2n[k] * (1.f + sc2[k]); }
#pragma unroll
            for (int q = 0; q < 8; ++q) { const int i = f_tid + 512 * (8 * hb + q), k = i >> 3, c4 = i & 7; *(LAS f32x4*)(WP + k * 32 + c4 * 4) = wv[q] * gm[q]; } }
        { const int e = f_tid & 31, part = f_tid >> 5; float a = 0.f;
#pragma unroll 1
            for (int k0 = part * 64; k0 < part * 64 + 64; k0 += 8) { float w[8], sh[8];
#pragma unroll
                for (int q = 0; q < 8; ++q) { w[q] = rw[(size_t)(k0 + q) * 32 + e]; sh[q] = sh2[k0 + q]; }
#pragma unroll
                for (int q = 0; q < 8; ++q) a += sh[q] * w[q]; }
            ((LAS float*)SC)[part * 32 + e] = a; }
        __syncthreads();
        if (f_tid < 32) { float a = rb[f_tid];
#pragma unroll
            for (int p = 0; p < 16; ++p) a += ((LAS float*)SC)[p * 32 + f_tid];
            BIAS[f_tid] = a; }
        const int rg = F.wave & 3, kh = F.wave >> 2, j = f_lane & 31, hi = f_lane >> 5;
        f32x16 acc = {};
        float ss = 0.f;
        { const bf16_t* xrow = XN + (size_t)(blk * 128 + rg * 32 + j) * DM + 512 * kh + 8 * hi;
            const LAS float* wp = WP + (512 * kh + 8 * hi) * 32 + j;
#pragma unroll 8
            for (int c = 0; c < 32; ++c) { const u32x4 xb = *(const u32x4*)(xrow + 16 * c);
                float xf[8] = {__uint_as_float(xb.x << 16), __uint_as_float(xb.x & 0xffff0000u), __uint_as_float(xb.y << 16), __uint_as_float(xb.y & 0xffff0000u),
                               __uint_as_float(xb.z << 16), __uint_as_float(xb.z & 0xffff0000u), __uint_as_float(xb.w << 16), __uint_as_float(xb.w & 0xffff0000u)};
#pragma unroll
                for (int q = 0; q < 8; ++q) { ss += xf[q] * xf[q]; acc = __builtin_amdgcn_mfma_f32_32x32x2f32(wp[(16 * c + q) * 32], xf[q], acc, 0, 0, 0); } } }
        { auto rr = __builtin_amdgcn_permlane32_swap(__float_as_uint(ss), __float_as_uint(ss), false, false); ss = __uint_as_float(rr[0]) + __uint_as_float(rr[1]); }
        if (hi == 0) SSX[kh * 128 + rg * 32 + j] = ss;
        __syncthreads();
        if (kh == 1) {
#pragma unroll
            for (int r = 0; r < 16; ++r) WP[(rg * 16 + r) * 64 + f_lane] = acc[r]; }
        if (f_tid < 128) RSTD[f_tid] = rsqrtf((SSX[f_tid] + SSX[128 + f_tid]) * (1.f / DM) + EPS);
        __syncthreads();
        if (kh == 0) {
            const float rstd = RSTD[rg * 32 + j];
            float tv[4] = {-INFINITY, -INFINITY, -INFINITY, -INFINITY}; int ti[4] = {1 << 20, 1 << 20, 1 << 20, 1 << 20};
#define P6_INS(V, E) do { float cv = (V); int ce = (E); _Pragma("unroll") for (int q = 0; q < 4; ++q) { const bool b = cv > tv[q] || (cv == tv[q] && ce < ti[q]); \
                const float nv = b ? tv[q] : cv; const int ne = b ? ti[q] : ce; tv[q] = b ? cv : tv[q]; ti[q] = b ? ce : ti[q]; cv = nv; ce = ne; } } while (0)
#pragma unroll
            for (int r = 0; r < 16; ++r) { const int e = (r & 3) + 8 * (r >> 2) + 4 * hi; const float v = (acc[r] + WP[(rg * 16 + r) * 64 + f_lane]) * rstd + BIAS[e]; P6_INS(v, e); }
            float ov[4]; int oe[4];
#pragma unroll
            for (int q = 0; q < 4; ++q) { ov[q] = __shfl_xor(tv[q], 32); oe[q] = __shfl_xor(ti[q], 32); }
#pragma unroll
            for (int q = 0; q < 4; ++q) P6_INS(ov[q], oe[q]);
#undef P6_INS
            if (hi == 0) { const int rl = rg * 32 + j, r = blk * 128 + rl;
                const float e1 = __expf(tv[1] - tv[0]), e2 = __expf(tv[2] - tv[0]), e3 = __expf(tv[3] - tv[0]); const float inv = 1.f / (1.f + e1 + e2 + e3);
                typedef int i32x4_t __attribute__((ext_vector_type(4))); const i32x4_t t4 = {ti[0], ti[1], ti[2], ti[3]};
                *(i32x4_t*)(topi_g + (size_t)r * 4) = t4; *(f32x4*)(gate_g + (size_t)r * 4) = (f32x4){inv, e1 * inv, e2 * inv, e3 * inv};
                *(LAS i32x4_t*)(TI + rl * 4) = t4; }
        }
        __syncthreads();
        { const int t2 = F.wave * 64 + lane_id(); const int e = t2 & 31, seg = t2 >> 5; int cnt = 0;
#pragma unroll 4
            for (int i = 0; i < 32; ++i) cnt += (TI[seg * 32 + i] == e) ? 1 : 0;
            SC[seg * 32 + e] = cnt;
            __syncthreads();
            int pre = 0;
            for (int s2 = 0; s2 < seg; ++s2) pre += SC[s2 * 32 + e];
            if (seg == 15) wgcnt[blk * 32 + e] = pre + cnt;
            for (int i = 0; i < 32; ++i) if (TI[seg * 32 + i] == e) { PS[seg * 32 + i] = pre; ++pre; }
        }
        __syncthreads();
        { const int t3 = F.wave * 64 + lane_id(); pos_g[(size_t)blk * 512 + t3] = PS[t3]; }
        { const int lane = lane_id();
            f32x4 PA[4], PB[4];
#pragma unroll
            for (int jj = 0; jj < 4; ++jj) { const int c = 4 * lane + 256 * jj; PA[jj] = *(const f32x4*)(g2n + c) * (*(const f32x4*)(sc2 + c) + 1.f); PB[jj] = *(const f32x4*)(sh2 + c); }
            for (int it = 0; it < 4; ++it) { u32x2 xb[4][4];
#pragma unroll
                for (int u = 0; u < 4; ++u) { const GAS u32x2* xr = (const GAS u32x2*)(XN + (size_t)(blk * 128 + F.wave * 16 + 4 * it + u) * DM) + lane;
#pragma unroll
                    for (int jj = 0; jj < 4; ++jj) xb[u][jj] = xr[64 * jj]; }
#pragma unroll
                for (int u = 0; u < 4; ++u) { const int rl = F.wave * 16 + 4 * it + u; const float rstd = RSTD[rl];
                    GAS unsigned* o4 = (GAS unsigned*)(H2 + (size_t)(blk * 128 + rl) * DM) + lane;
#pragma unroll
                    for (int jj = 0; jj < 4; ++jj) {
                        const f32x4 x = (f32x4){__uint_as_float(xb[u][jj].x << 16), __uint_as_float(xb[u][jj].x & 0xffff0000u), __uint_as_float(xb[u][jj].y << 16), __uint_as_float(xb[u][jj].y & 0xffff0000u)};
                        const f32x4 h = x * rstd * PA[jj] + PB[jj];
                        o4[64 * jj] = pk4_fp8(h.x, h.y, h.z, h.w); } } }
        }
    }
#undef in
}

__device__ __forceinline__ void p7_scatter(Frame& F) {
    FT_DECL;
    LAS int* TOT = (LAS int*)F.lds;
    LAS int* BASE = TOT + 32;
    LAS int* PRE = BASE + 32;
    LAS int* PART = PRE + 32;
    const int* wgcnt = WSP(int, WS_ROUTE + RT_WGCNT); const int* topi_g = WSP(int, WS_ROUTE + RT_TOPI); const float* gate_g = WSP(float, WS_ROUTE + RT_GATE); const int* pos_g = WSP(int, WS_ROUTE + RT_POS);
    int* list = WSP(int, WS_ROUTE + RT_LIST); float* gslot = WSP(float, WS_ROUTE + RT_GSLOT); int* meta = WSP(int, WS_ROUTE + RT_META);
    for (int blk = blockIdx.x; blk < MROWS / 128; blk += F.G) {
        __syncthreads();
        { const int e = f_tid & 31, part = f_tid >> 5; int st = 0, sp = 0;
            for (int w = part * 16; w < part * 16 + 16; ++w) { const int c = wgcnt[w * 32 + e]; st += c; if (w < blk) sp += c; }
            PART[part * 32 + e] = st; PART[512 + part * 32 + e] = sp; }
        __syncthreads();
        if (f_tid < 32) { int st = 0, sp = 0;
#pragma unroll
            for (int p = 0; p < 16; ++p) { st += PART[p * 32 + f_tid]; sp += PART[512 + p * 32 + f_tid]; }
            TOT[f_tid] = st; PRE[f_tid] = sp; }
        __syncthreads();
        if (f_tid == 0) { int b = 0; for (int e = 0; e < 32; ++e) { BASE[e] = b; b += (TOT[e] + 255) & ~255; }
            if (blk == 0) { int t = 0; for (int e = 0; e < 32; ++e) { meta[e] = TOT[e]; meta[32 + e] = BASE[e]; const int nt = (TOT[e] + 255) >> 8; for (int q = 0; q < nt; ++q) meta[128 + t + q] = e; t += nt; } meta[64] = t; } }
        __syncthreads();
        { const int a = f_tid, row = blk * 128 + (a >> 2); const int e = topi_g[(size_t)blk * 512 + a]; const int slot = BASE[e] + PRE[e] + pos_g[(size_t)blk * 512 + a];
            list[slot] = row * 4 + (a & 3); gslot[slot] = gate_g[(size_t)blk * 512 + a];
            PART[a] = slot; }
        __syncthreads();
        if (blk < NEXP) { const int e = blk, lo = BASE[e] + TOT[e], hi = BASE[e] + ((TOT[e] + 255) & ~255);
            for (int sl = lo + f_tid; sl < hi; sl += 512) { list[sl] = -1; gslot[sl] = 0.f; } }
    }
}

template <int NPN> struct SchedMoE {
    int G, c, nT; const char* A; const char* W; size_t wstride; const LAS unsigned char* tileE; const LAS int* RW; bool gath;
    __device__ __forceinline__ const LAS int* rows(int i) const { return RW + i * 256; }
    __device__ __forceinline__ bool next(int i, g8::Unit& u) const {
        const int L = i * G + c, xcd = L & 7, j = L >> 3, T = (j / NPN) * 8 + xcd, pn = j % NPN;
        if (T >= nT) return false;
        const int e = tileE[T];
        u.pm = T; u.pn = pn; u.kind = i; u.ex = e; u.a = gath ? A : A + (size_t)T * 256 * DM; u.b = W + (size_t)e * wstride + (size_t)pn * 256 * DM; return true;
    }
};
struct EpiSwiGLU {
    unsigned char* ACT; const float* b1;
    __device__ __forceinline__ void operator()(f32x4 (&acc)[2][2][4][2], const g8::Unit& u, int wr, int wc, int fr, int fq) const {
        asm volatile("" : "+v"(fr), "+v"(fq));
        const int j0 = u.pn * 128 + wc * 32 + 8 * fq; const float* bp = b1 + (size_t)u.ex * 2 * DM + j0;
        f32x4 bg[2], bl[2];
#pragma unroll
        for (int n = 0; n < 2; ++n) { bg[n] = *(const f32x4*)(bp + 4 * n); bl[n] = *(const f32x4*)(bp + DM + 4 * n); }
#pragma unroll
        for (int ai = 0; ai < 2; ++ai)
#pragma unroll
            for (int m = 0; m < 4; ++m) { const size_t slot = (size_t)u.pm * 256 + ai * 128 + wr * 64 + m * 16 + fr; float o[8];
#pragma unroll
                for (int n = 0; n < 2; ++n) { const f32x4 g4 = acc[ai][0][m][n] * (1.f / WSCALE) + bg[n], l4 = acc[ai][1][m][n] * (1.f / WSCALE) + bl[n];
#pragma unroll
                    for (int e = 0; e < 4; ++e) { const float g = fminf(g4[e], 7.f), l = __builtin_amdgcn_fmed3f(l4[e], -7.f, 7.f);
                        const float ex = __builtin_amdgcn_exp2f(g * (-1.702f * 1.4426950408889634f)); const float glu = g * __builtin_amdgcn_rcpf(1.f + ex);
                        o[4 * n + e] = fmaf(l, glu, glu); } }
                u32x2 w; w.x = pk4_fp8(o[0], o[1], o[2], o[3]); w.y = pk4_fp8(o[4], o[5], o[6], o[7]);
                *(u32x2*)(ACT + slot * DM + j0) = w; }
    }
};
struct EpiDown {
    unsigned char* EO; const float* b2; const LAS int* LL; int G, c;
    __device__ __forceinline__ void operator()(f32x4 (&acc)[2][2][4][2], const g8::Unit& u, int wr, int wc, int fr, int fq) const {
        asm volatile("" : "+v"(fr), "+v"(fq));
        const int c0 = u.pn * 256 + wc * 64 + 16 * fq; const float* bp = b2 + (size_t)u.ex * DM + c0;
        f32x4 bb[2][2];
#pragma unroll
        for (int bj = 0; bj < 2; ++bj)
#pragma unroll
            for (int n = 0; n < 2; ++n) bb[bj][n] = *(const f32x4*)(bp + bj * 8 + 4 * n);
        const LAS int* L = LL + u.kind * 512;
        int li[8]; float gt[8];
#pragma unroll
        for (int q = 0; q < 8; ++q) { const int rl = (q >> 2) * 128 + wr * 64 + (q & 3) * 16 + fr; li[q] = L[rl]; gt[q] = __int_as_float(L[256 + rl]) * (1.f / WSCALE); }
#pragma unroll
        for (int ai = 0; ai < 2; ++ai)
#pragma unroll
            for (int m = 0; m < 4; ++m) { const int l = li[ai * 4 + m]; const float g = gt[ai * 4 + m];
                unsigned char* dst = EO + ((size_t)(l & 3) * MROWS + (l >> 2)) * DM + c0;
                u32x4 w;
                { const f32x4 v0 = acc[ai][0][m][0] * g + bb[0][0] * (g * WSCALE), v1 = acc[ai][0][m][1] * g + bb[0][1] * (g * WSCALE);
                  w.x = pk4_fp8(v0[0] * EOSCALE, v0[1] * EOSCALE, v0[2] * EOSCALE, v0[3] * EOSCALE); w.y = pk4_fp8(v1[0] * EOSCALE, v1[1] * EOSCALE, v1[2] * EOSCALE, v1[3] * EOSCALE); }
                { const f32x4 v0 = acc[ai][1][m][0] * g + bb[1][0] * (g * WSCALE), v1 = acc[ai][1][m][1] * g + bb[1][1] * (g * WSCALE);
                  w.z = pk4_fp8(v0[0] * EOSCALE, v0[1] * EOSCALE, v0[2] * EOSCALE, v0[3] * EOSCALE); w.w = pk4_fp8(v1[0] * EOSCALE, v1[1] * EOSCALE, v1[2] * EOSCALE, v1[3] * EOSCALE); }
                if (l >= 0) *(u32x4*)dst = w; }
    }
};
__device__ __forceinline__ const LAS unsigned char* moe_tiles(Frame& F, int& nT) {
    FT_DECL;
    LAS unsigned char* TE = (LAS unsigned char*)(F.lds + RING_BYTES); const int* meta = WSP(int, WS_ROUTE + RT_META);
    __syncthreads();
    nT = meta[64]; if (nT > MAXTILE) nT = MAXTILE;
    for (int i = f_tid; i < MAXTILE; i += 512) TE[i] = (unsigned char)((i < nT) ? meta[128 + i] : 0);
    __syncthreads();
    return (const LAS unsigned char*)TE;
}

__device__ __forceinline__ void p10_combine(Frame& F) {
    FT_DECL;
    const float* mod = WSP(float, WS_SMALL + SM_MOD); const unsigned char* EO = WSP(unsigned char, WS_EO);
    const size_t gt = (size_t)F.vcu * 512 + f_tid, NTH = (size_t)F.G * 512;
    constexpr int U = 4;
    for (size_t i0 = gt; i0 < (size_t)MROWS * 128; i0 += NTH * U) {
        u32x2 ev[U][4]; f32x4 xv[U][2], gv[U][2];
#pragma unroll
        for (int u = 0; u < U; ++u) { const size_t i = i0 + (size_t)u * NTH; const size_t row = i >> 7; const int c0 = (int)(i & 127) * 8;
            const float* g2 = mod + (size_t)(row >> 12) * (NMOD * DM) + 5 * DM + c0; const bf16_t* op = WSP(bf16_t, WS_XN) + row * DM + c0;
#pragma unroll
            for (int k = 0; k < 4; ++k) ev[u][k] = __builtin_nontemporal_load((const u32x2*)(EO + ((size_t)k * MROWS + row) * DM + c0));
            { const u32x4 xb = *(const u32x4*)op; xv[u][0] = (f32x4){__uint_as_float(xb.x << 16), __uint_as_float(xb.x & 0xffff0000u), __uint_as_float(xb.y << 16), __uint_as_float(xb.y & 0xffff0000u)};
              xv[u][1] = (f32x4){__uint_as_float(xb.z << 16), __uint_as_float(xb.z & 0xffff0000u), __uint_as_float(xb.w << 16), __uint_as_float(xb.w & 0xffff0000u)}; }
            gv[u][0] = *(const f32x4*)g2; gv[u][1] = *(const f32x4*)(g2 + 4); }
#pragma unroll
        for (int u = 0; u < U; ++u) { const size_t i = i0 + (size_t)u * NTH; const size_t row = i >> 7; const int c0 = (int)(i & 127) * 8;
            float s[8];
#pragma unroll
            for (int e = 0; e < 8; ++e) s[e] = 0.f;
#pragma unroll
            for (int k = 0; k < 4; ++k) { const u32x2 v = ev[u][k];
                const f32x2 a = __builtin_amdgcn_cvt_pk_f32_fp8((int)v.x, false), b = __builtin_amdgcn_cvt_pk_f32_fp8((int)v.x, true), c = __builtin_amdgcn_cvt_pk_f32_fp8((int)v.y, false), d = __builtin_amdgcn_cvt_pk_f32_fp8((int)v.y, true);
                s[0] += a.x; s[1] += a.y; s[2] += b.x; s[3] += b.y; s[4] += c.x; s[5] += c.y; s[6] += d.x; s[7] += d.y; }
#pragma unroll
            for (int e = 0; e < 8; ++e) s[e] *= (1.f / EOSCALE);
            f32x4 o0 = xv[u][0] + gv[u][0] * (f32x4){s[0], s[1], s[2], s[3]}, o1 = xv[u][1] + gv[u][1] * (f32x4){s[4], s[5], s[6], s[7]};
            float* op = F.out + row * DM + c0;
            __builtin_nontemporal_store(o0, (f32x4*)op); __builtin_nontemporal_store(o1, (f32x4*)(op + 4)); }
    }
}

struct Args { const float* in[34]; float* out; unsigned char* ws; int ph_lo, ph_hi; };
constexpr int N_PHASES = 11;

__global__ void __launch_bounds__(512, 2) mega(Args args) {
    extern __shared__ __attribute__((aligned(16))) unsigned char lds[];
    Frame F;
    F.lds = (LAS unsigned char*)lds;
    F.MISC = (volatile LAS unsigned*)(F.lds + LDSCTL_OFF);
    F.wave = __builtin_amdgcn_readfirstlane(threadIdx.x >> 6);
    FT_DECL;
    F.G = gridDim.x; { const int bx = blockIdx.x; F.vcu = (F.G % 8 == 0) ? (bx % 8) * (F.G / 8) + bx / 8 : bx; }
    F.in = (kin_t)__builtin_amdgcn_kernarg_segment_ptr();
    F.out = args.out; F.ws = args.ws;
    F.ctl = (gu32*)(args.ws + WS_CTL);
    for (int u = f_tid; u < (LDS_BYTES - LDSCTL_OFF) / 4; u += NWAVES * 64) ((LAS unsigned*)(F.lds + LDSCTL_OFF))[u] = 0u;
    __syncthreads();
    const int lo = args.ph_lo, hi = args.ph_hi;
    XcdBarrier bar; bar.bar = (unsigned*)(F.ctl + CW_BAR); bar.x = 0; bar.st = nullptr;
    if (hi - lo > 1) bar = xcd_barrier_post((unsigned*)(F.ctl + CW_BAR), F.MISC + 8, f_tid == 0);
#define IN(k) (lo <= (k) && (k) < hi)
#define SEAM(k) do { if (IN(k) && IN((k) + 1)) xcd_barrier(bar, F.wave == 0 && lane_id() == 0); } while (0)

    if (IN(0)) { p0_prologue(F); } SEAM(0);
    if (IN(1)) { p1_norm1(F); } SEAM(1);
    if (IN(2)) {
        SchedInProj S{F.G, (int)blockIdx.x, (const char*)WSP(bf16_t, WS_H), (const char*)WSP(bf16_t, WS_WIN)};
        EpiInProj E{WSP(unsigned char, WS_Q), WSP(unsigned char, WS_K), WSP(unsigned char, WS_V), WSP(bf16_t, WS_UT), F.in[9], F.in[10], WSP(float, WS_SMALL + SM_ROPE)};
        g8::gemm_phase<false>(F.lds, DM, S, E, F.wave, lane_id());
    } SEAM(2);
    if (IN(3)) { p3_attention8(F); p3_hyena(F); } SEAM(3);
    if (IN(4)) { p4_hynorm(F); } SEAM(4);
    if (IN(5)) {
        SchedStatic S{F.G, (int)blockIdx.x, MROWS / 256, DM / 256, (const char*)WSP(bf16_t, WS_MIX), (const char*)WSP(bf16_t, WS_WOUT)};
        EpiOutProj E{F.in[0], WSP(bf16_t, WS_XN), WSP(float, WS_SMALL + SM_MOD)};
        g8::gemm_phase<false>(F.lds, DM, S, E, F.wave, lane_id());
    } SEAM(5);
    if (IN(6)) { p6_router_mfma(F); } SEAM(6);
    if (IN(7)) { p7_scatter(F); } SEAM(7);
    if (IN(8)) {
        int nT; const LAS unsigned char* TE = moe_tiles(F, nT);
        LAS int* RWL = (LAS int*)(F.lds + RING_BYTES + 1024);
        static_assert(RING_BYTES + 1024 + 17 * 1024 <= LDSCTL_OFF, "LDS map");
        SchedMoE<8> S{F.G, (int)blockIdx.x, nT, (const char*)WSP(char, WS_H), (const char*)WSP(char, WS_W1), (size_t)2 * DM * DM, TE, RWL, true};
        { const int* list = WSP(int, WS_ROUTE + RT_LIST); const int t8 = F.wave * 64 + lane_id();
            g8::Unit u; for (int i = 0; i < 17 && S.next(i, u); i += 2) { const int ii = i + (t8 >> 8); g8::Unit u2; if (S.next(ii, u2)) { const int li = list[(size_t)u2.pm * 256 + (t8 & 255)]; RWL[ii * 256 + (t8 & 255)] = (li >= 0) ? (li >> 2) : 0; } }
            __syncthreads(); }
        EpiSwiGLU E{WSP(unsigned char, WS_ACT), F.in[31]};
        g8::gemm_phase_g<true, true>(F.lds, DM, S, E, F.wave, lane_id());
    } SEAM(8);
    if (IN(9)) {
        int nT; const LAS unsigned char* TE = moe_tiles(F, nT);
        SchedMoE<4> S{F.G, (int)blockIdx.x, nT, (const char*)WSP(char, WS_ACT), (const char*)WSP(char, WS_W2), (size_t)DM * DM, TE, nullptr, false};
        LAS int* LL = (LAS int*)(F.lds + RING_BYTES + 1024);
        static_assert(RING_BYTES + 1024 + 9 * 2048 <= LDSCTL_OFF, "LDS map");
        { const int* list = WSP(int, WS_ROUTE + RT_LIST); const float* gslot = WSP(float, WS_ROUTE + RT_GSLOT);
            const int t9 = F.wave * 64 + lane_id();
            g8::Unit u; for (int i = 0; i < 9 && S.next(i, u); ++i) { const int t = t9 & 255; const size_t slot = (size_t)u.pm * 256 + t;
                LL[i * 512 + (t9 >> 8) * 256 + t] = (t9 < 256) ? list[slot] : __float_as_int(gslot[slot]); }
            __syncthreads(); }
        EpiDown E{WSP(unsigned char, WS_EO), F.in[33], LL, F.G, (int)blockIdx.x};
        g8::gemm_phase<true>(F.lds, DM, S, E, F.wave, lane_id());
    } SEAM(9);
    if (IN(10)) { p10_combine(F); }
#undef IN
#undef SEAM
}

extern "C" void kernel_launch(void* const* d_in, const int* in_sizes, int n_in, void* d_out, int out_size, void* d_ws, size_t ws_size, hipStream_t stream) {
    static int grid = 0;
    if (grid == 0) {
        if (n_in != 34 || out_size != MROWS * DM || ws_size < WS_END) { fprintf(stderr, "kernel_launch: unexpected shapes: n_in %d out %d ws %zu (need %zu)\n", n_in, out_size, ws_size, (size_t)WS_END); grid = -1; return; }
        int dev = 0, cus = 0, per_cu = 0;
        if (hipGetDevice(&dev) != hipSuccess || hipDeviceGetAttribute(&cus, hipDeviceAttributeMultiprocessorCount, dev) != hipSuccess) { grid = -1; return; }
        if (hipFuncSetAttribute((const void*)mega, hipFuncAttributeMaxDynamicSharedMemorySize, LDS_BYTES) != hipSuccess) { fprintf(stderr, "kernel_launch: hipFuncSetAttribute failed\n"); grid = -1; return; }
        if (hipOccupancyMaxActiveBlocksPerMultiprocessor(&per_cu, (const void*)mega, NWAVES * 64, LDS_BYTES) != hipSuccess || per_cu < 1) { fprintf(stderr, "kernel_launch: occupancy query says %d\n", per_cu); per_cu = 1; }
        (void)hipGetLastError();
        grid = cus;
    }
    if (grid < 0) return;
    (void)hipMemsetAsync((char*)d_ws + WS_CTL, 0, CTL_ZERO_BYTES, stream);
    Args a{};
    for (int i = 0; i < 34; ++i) a.in[i] = (const float*)d_in[i];
    a.out = (float*)d_out; a.ws = (unsigned char*)d_ws;
    constexpr int LAST = MK_LAST_PHASE + 1;
    if (MK_N_LAUNCHES == 1) { a.ph_lo = 0; a.ph_hi = LAST; hipLaunchKernelGGL(mega, dim3(grid), dim3(NWAVES * 64), LDS_BYTES, stream, a); }
    else for (int p = 0; p < LAST; ++p) { a.ph_lo = p; a.ph_hi = p + 1; hipLaunchKernelGGL(mega, dim3(grid), dim3(NWAVES * 64), LDS_BYTES, stream, a); }
    const hipError_t le = hipPeekAtLastError();
    if (le != hipSuccess) fprintf(stderr, "kernel_launch: launch failed: %s\n", hipGetErrorName(le));
}
```

```cpp
#include <hip/hip_runtime.h>
#include <hip/hip_bf16.h>
#include <cstdio>
#include <cstdint>

#ifndef MK_N_LAUNCHES
#define MK_N_LAUNCHES 1
#endif
#ifndef MK_LAST_PHASE
#define MK_LAST_PHASE 10
#endif

#define GAS __attribute__((address_space(1)))
#define LAS __attribute__((address_space(3)))
typedef unsigned short bf16_t;
typedef short bf16x8 __attribute__((ext_vector_type(8)));
typedef short s16x4 __attribute__((ext_vector_type(4)));
typedef float f32x2 __attribute__((ext_vector_type(2)));
typedef float f32x4 __attribute__((ext_vector_type(4)));
typedef float f32x16 __attribute__((ext_vector_type(16)));
typedef unsigned u32x2 __attribute__((ext_vector_type(2)));
typedef unsigned u32x4 __attribute__((ext_vector_type(4)));
typedef GAS unsigned gu32;

constexpr int NB = 8, SEQ = 4096, DM = 1024, MROWS = NB * SEQ, CTXL = 256, MCTX = NB * CTXL, MTOT = MROWS + MCTX;
constexpr int KVL = CTXL + SEQ;
constexpr int NHEAD = 4, QKW = 512;
constexpr int HYW = 512, HYC = 1536, INC = 3072, QKVC = 1536;
constexpr int NEXP = 32, TOPK = 4, NMOD = 6;
constexpr float EPS = 1e-6f;
constexpr float LAM_INIT = 0.2f;
constexpr float QSCALE = 0.125f * 1.4426950408889634f;

constexpr size_t MiB = 1u << 20;
constexpr size_t WS_CTL = 0, CTL_ZERO_BYTES = 64 * 1024;
constexpr size_t WS_SMALL = 1 * MiB;
constexpr size_t WS_WIN = 2 * MiB;
constexpr size_t WS_WOUT = 8 * MiB;
constexpr size_t WS_W1 = 10 * MiB;
constexpr size_t WS_W2 = 138 * MiB;
constexpr size_t WS_H = 202 * MiB;
constexpr size_t WS_Q = 270 * MiB;
constexpr size_t WS_K = 302 * MiB;
constexpr size_t WS_V = 336 * MiB;
constexpr size_t WS_UT = 370 * MiB;
constexpr size_t WS_FILT = 466 * MiB;
constexpr size_t WS_Z2T = 498 * MiB;
constexpr size_t WS_MIX = 530 * MiB;
constexpr size_t WS_ROUTE = 594 * MiB;
constexpr size_t WS_ACT = 270 * MiB;
constexpr size_t WS_EO = 598 * MiB;
constexpr size_t WS_XN = 870 * MiB;
constexpr size_t WS_END = 998 * MiB;
constexpr size_t SM_MOD = 0;
constexpr size_t SM_SCAL = 256 * 1024;
constexpr size_t SM_ROPE = 260 * 1024;
constexpr int CW_BAR = 4096;

constexpr int RING_BYTES = 131072;
constexpr int LDSCTL_OFF = 151552;
constexpr int LDS_BYTES = 152576;
constexpr int NWAVES = 8;

#define LDS_WAIT() asm volatile("s_waitcnt lgkmcnt(0)" ::: "memory")
#define VM_WAIT() asm volatile("s_waitcnt vmcnt(0)" ::: "memory")
#define RLX_AGENT __ATOMIC_RELAXED, __HIP_MEMORY_SCOPE_AGENT

__device__ __forceinline__ unsigned cvt_pk_bf16(float lo, float hi) { unsigned r; asm volatile("v_cvt_pk_bf16_f32 %0, %1, %2" : "=v"(r) : "v"(lo), "v"(hi)); return r; }
__device__ __forceinline__ float bf2f(bf16_t v) { return __uint_as_float(((unsigned)v) << 16); }
__device__ __forceinline__ float wave_sum(float v) {
#pragma unroll
    for (int o = 1; o < 64; o <<= 1) v += __shfl_xor(v, o);
    return v;
}

#define XB_TMO      128
#define XB_XCNT(j)  (256  + 64 * (j))
#define XB_XSUB(j)  (1280 + 64 * (j))
#define XB_XGEN(j)  (2304 + 64 * (j))
#define XB_TOP      3328
#define XB_TOPGEN   3392
#define XCD_BAR_WORDS 3456
#define XB_SPIN_CAP (1u << 22)
__device__ __forceinline__ unsigned xb_ld(unsigned* p)              { return __hip_atomic_load(p, __ATOMIC_RELAXED, __HIP_MEMORY_SCOPE_AGENT); }
__device__ __forceinline__ unsigned xb_add(unsigned* p, unsigned v) { return __hip_atomic_fetch_add(p, v, __ATOMIC_RELAXED, __HIP_MEMORY_SCOPE_AGENT); }
__device__ __forceinline__ unsigned xb_xcc_id() { return (unsigned)__builtin_amdgcn_s_getreg((3 << 11) | 20) & 0xFu; }
#define XB_SPIN(cond, bar) do { unsigned _sp = 0; while (cond) { __builtin_amdgcn_s_sleep(1); \
    if ((++_sp & 255u) == 0u) { if (xb_ld(&(bar)[XB_TMO])) break; if (_sp > XB_SPIN_CAP) { atomicAdd(&(bar)[XB_TMO], 1u); break; } } } } while (0)
struct XcdBarrier { unsigned* bar; unsigned x; volatile LAS unsigned* st; };
__device__ __forceinline__ XcdBarrier xcd_barrier_post(unsigned* bar, volatile LAS unsigned* st, bool leader) {
    XcdBarrier b; b.bar = bar; b.x = xb_xcc_id(); b.st = st;
    if (leader) (void)xb_add(&bar[XB_XCNT(b.x)], 1u);
    return b;
}
__device__ __forceinline__ void xcd_barrier_complete(unsigned* bar, unsigned x, unsigned& nloc, unsigned& nx) {
    const unsigned G = gridDim.x * gridDim.y * gridDim.z;
    unsigned sum, cnt, mine, sp = 0u;
    for (;;) {
        sum = 0u; cnt = 0u; mine = 0u;
#pragma unroll
        for (unsigned j = 0; j < 16; ++j) { const unsigned c = xb_ld(&bar[XB_XCNT(j)]); sum += c; cnt += (c > 0u) ? 1u : 0u; mine = (j == x) ? c : mine; }
        if (sum == G) break;
        __builtin_amdgcn_s_sleep(1);
        if ((++sp & 255u) == 0u) { if (xb_ld(&bar[XB_TMO])) break; if (sp > XB_SPIN_CAP) { atomicAdd(&bar[XB_TMO], 1u); break; } }
    }
    nloc = mine > 0u ? mine : 1u; nx = cnt > 0u ? cnt : 1u;
}
__device__ __forceinline__ void xcd_barrier(const XcdBarrier& b, bool leader) {
    asm volatile("s_waitcnt vmcnt(0)" ::: "memory");
    __syncthreads();
    if (leader) {
        unsigned* bar = b.bar;
        __builtin_amdgcn_s_waitcnt(0);
        unsigned nloc = b.st[0], nx = b.st[1];
        if (nloc == 0u) { xcd_barrier_complete(bar, b.x, nloc, nx); b.st[0] = nloc; b.st[1] = nx; }
        const unsigned old = xb_add(&bar[XB_XSUB(b.x)], 1u);
        const unsigned gen = old / nloc;
        if (old + 1u == (gen + 1u) * nloc) {
            __builtin_amdgcn_fence(__ATOMIC_RELEASE, "agent");
            asm volatile("s_waitcnt vmcnt(0)" ::: "memory");
            const unsigned og = xb_add(&bar[XB_TOP], 1u);
            const unsigned tg = og / nx;
            if (og + 1u == (tg + 1u) * nx) xb_add(&bar[XB_TOPGEN], 1u);
            else XB_SPIN(xb_ld(&bar[XB_TOPGEN]) == tg, bar);
            __builtin_amdgcn_fence(__ATOMIC_ACQUIRE, "agent");
            xb_add(&bar[XB_XGEN(b.x)], 1u);
            asm volatile("s_waitcnt vmcnt(0)" ::: "memory");
        } else {
            XB_SPIN(xb_ld(&bar[XB_XGEN(b.x)]) == gen, bar);
            __builtin_amdgcn_fence(__ATOMIC_ACQUIRE, "agent");
            asm volatile("s_waitcnt vmcnt(0)" ::: "memory");
        }
    }
    __syncthreads();
}

namespace g8 {
constexpr int BM = 256, BK = 64, HALF = 128, HTB = HALF * BK * 2, STAGE_BYTES = 8 * HTB, NXCD = 8, WGM = 8;
__host__ __device__ __forceinline__ int lds_byte(int r, int c) { const int st = (r >> 4) * 2 + (c >> 5), rr = r & 15, cc = c & 31, ob = rr * 64 + cc * 2; return st * 1024 + (ob ^ (((ob >> 9) & 1) << 5)); }
__host__ __device__ __forceinline__ void stage_rc(int b, int& R, int& C) { const int st = b / 1024, sb = b % 1024, swz = sb ^ (((sb >> 9) & 1) << 5); R = (st >> 1) * 16 + swz / 64; C = (st & 1) * 32 + (swz % 64) / 2; }
__host__ __device__ __forceinline__ int perm32(int rho) { const int n = rho >> 4, i = rho & 15; return 8 * (i >> 2) + 4 * n + (i & 3); }

struct Unit { const char* a; const char* b; int pm, pn, kind, ex; };

__device__ __forceinline__ void tile_of(int L, int nM, int nN, int& pm, int& pn) {
    const int nwg = nM * nN; int wgid = L;
    { const int q = nwg / NXCD, r = nwg % NXCD, xcd = wgid % NXCD, off = wgid / NXCD; wgid = (xcd < r ? xcd * (q + 1) : r * (q + 1) + (xcd - r) * q) + off; }
    const int nig = WGM * nN, gid = wgid / nig, fm = gid * WGM, gsz = (nM - fm) < WGM ? (nM - fm) : WGM;
    pm = fm + ((wgid % nig) % gsz); pn = (wgid % nig) / gsz;
}

typedef int i32x8 __attribute__((ext_vector_type(8)));
template <bool FP8, bool GATHER, bool SP2, class Epi, class Sched>
__device__ __forceinline__ void gemm_phase_s(LAS unsigned char* lds, const int K, const Sched& S, const Epi& E, const int wid, const int lane) {
    const int tid = wid * 64 + lane, wr = wid >> 2, wc = wid & 3, fr = lane & 15, fq = lane >> 4;
    const int nt = FP8 ? K / 128 : K / BK;
    const int RP = FP8 ? K : 2 * K;
    unsigned voffA[2], voffB[2]; int srow[2], scol[2];
#pragma unroll
    for (int i = 0; i < 2; ++i) { int R, C; stage_rc(tid * 16 + i * 8192, R, C); const int Rb = (R & ~31) + perm32(R & 31);
        voffA[i] = (unsigned)(R * RP + C * 2); voffB[i] = (unsigned)(Rb * RP + C * 2); srow[i] = R; scol[i] = C * 2; }
    const size_t kstep = (size_t)(BK * 2);
    const size_t hstep = (size_t)HALF * RP;
    const unsigned ldsw = (unsigned)wid * 1024u;
    unsigned cO0[2], cO1[2], nO0[2], nO1[2];
#define PG8_GOFF(D0, D1, ui_) do { if constexpr (GATHER) { const LAS int* rw_ = S.rows(ui_); _Pragma("unroll") for (int i_ = 0; i_ < 2; ++i_) { \
        D0[i_] = (unsigned)rw_[srow[i_]] * (unsigned)RP + (unsigned)scol[i_]; D1[i_] = (unsigned)rw_[128 + srow[i_]] * (unsigned)RP + (unsigned)scol[i_]; } } \
      else { _Pragma("unroll") for (int i_ = 0; i_ < 2; ++i_) { D0[i_] = voffA[i_]; D1[i_] = voffA[i_] + (unsigned)hstep; } } } while (0)
    const int aoff = lds_byte(wr * 64 + fr, FP8 ? fq * 16 : fq * 8), boff = lds_byte(wc * 32 + fr, FP8 ? fq * 16 : fq * 8);
    constexpr int KOFF = FP8 ? 16 : 1024;
#define PG8_SA(b, h) (((b) * 2 + (h)) * HTB)
#define PG8_SB(b, h) ((4 + (b) * 2 + (h)) * HTB)
#define PG8_STAGE(bufoff, gbase, voff) do { _Pragma("unroll") for (int _i = 0; _i < 2; ++_i) \
        __builtin_amdgcn_global_load_lds((const unsigned*)((const char*)(gbase) + (voff)[_i]), (LAS unsigned*)(lds + (bufoff) + ldsw + _i * 8192), 16, 0, 0); } while (0)
#define PG8_LD32(p) __builtin_bit_cast(i32x8, __builtin_shufflevector(*(const LAS u32x4*)(p), *(const LAS u32x4*)((p) + 16), 0, 1, 2, 3, 4, 5, 6, 7))
#define PG8_LDA8(dst, b, h) do { _Pragma("unroll") for (int m = 0; m < 4; ++m) dst[m] = PG8_LD32(lds + PG8_SA(b, h) + aoff + m * 2048); } while (0)
#define PG8_LDB8(dst, b, h) do { _Pragma("unroll") for (int n = 0; n < 2; ++n) dst[n] = PG8_LD32(lds + PG8_SB(b, h) + boff + n * 2048); } while (0)
#define PG8_LDA(dst, b, h) do { _Pragma("unroll") for (int m = 0; m < 4; ++m) _Pragma("unroll") for (int k = 0; k < 2; ++k) dst[m][k] = *(const LAS bf16x8*)(lds + PG8_SA(b, h) + aoff + m * 2048 + k * KOFF); } while (0)
#define PG8_LDB(dst, b, h) do { _Pragma("unroll") for (int n = 0; n < 2; ++n) _Pragma("unroll") for (int k = 0; k < 2; ++k) dst[n][k] = *(const LAS bf16x8*)(lds + PG8_SB(b, h) + boff + n * 2048 + k * KOFF); } while (0)
#define PG8_MMA(ai, bj, At, Bt) do { __builtin_amdgcn_s_setprio(1); _Pragma("unroll") for (int m = 0; m < 4; ++m) _Pragma("unroll") for (int n = 0; n < 2; ++n) _Pragma("unroll") for (int k = 0; k < 2; ++k) \
        acc[ai][bj][m][n] = __builtin_amdgcn_mfma_f32_16x16x32_bf16(Bt[n][k], At[m][k], acc[ai][bj][m][n], 0, 0, 0); __builtin_amdgcn_s_setprio(0); } while (0)
#define PG8_MMA8(ai, bj, At, Bt) do { __builtin_amdgcn_s_setprio(1); _Pragma("unroll") for (int m = 0; m < 4; ++m) _Pragma("unroll") for (int n = 0; n < 2; ++n) \
        asm volatile("v_mfma_scale_f32_16x16x128_f8f6f4 %0, %1, %2, %0, %3, %3 op_sel_hi:[0,0,0]" : "+v"(acc[ai][bj][m][n]) : "v"(Bt[n]), "v"(At[m]), "v"(one_scale)); __builtin_amdgcn_s_setprio(0); } while (0)
#define PG8_WAIT_V(n) asm volatile("s_waitcnt vmcnt(" #n ")" ::: "memory")
#define PG8_WAIT_L(n) asm volatile("s_waitcnt lgkmcnt(" #n ")" ::: "memory")
#define PG8_BAR __builtin_amdgcn_s_barrier()
#define PG8_SCHED __builtin_amdgcn_sched_barrier(0)
    Unit cur, nxt; int ui = 0;
    if (!S.next(0, cur)) return;
    f32x4 acc[2][2][4][2];
#pragma unroll
    for (int a = 0; a < 2; ++a)
#pragma unroll
        for (int b = 0; b < 2; ++b)
#pragma unroll
            for (int m = 0; m < 4; ++m)
#pragma unroll
                for (int n = 0; n < 2; ++n) acc[a][b][m][n] = (f32x4){0.f, 0.f, 0.f, 0.f};
    bf16x8 At[4][2], B0[2][2], B1[2][2];
    i32x8 At8[4], B08[2], B18[2];
    const unsigned one_scale = 0x7f7f7f7fu;
    const char* cA = cur.a; const char* cB = cur.b;
    PG8_GOFF(cO0, cO1, 0);
    if constexpr (SP2) {
    PG8_STAGE(PG8_SB(0, 0), cB, voffB); PG8_STAGE(PG8_SB(0, 1), cB + hstep, voffB); PG8_STAGE(PG8_SA(0, 0), cA, cO0); PG8_STAGE(PG8_SA(0, 1), cA, cO1);
    if (wr == 1) PG8_BAR;
    PG8_WAIT_V(2); PG8_BAR;
    PG8_STAGE(PG8_SB(1, 0), cB + kstep, voffB); PG8_STAGE(PG8_SA(1, 0), cA + kstep, cO0); PG8_STAGE(PG8_SB(1, 1), cB + hstep + kstep, voffB);
    PG8_WAIT_V(6); PG8_BAR;
    } else {
    PG8_STAGE(PG8_SB(0, 0), cB, voffB); PG8_STAGE(PG8_SA(0, 0), cA, cO0); PG8_STAGE(PG8_SB(0, 1), cB + hstep, voffB); PG8_STAGE(PG8_SA(0, 1), cA, cO1);
    if (wr == 1) PG8_BAR;
    PG8_WAIT_V(4); PG8_BAR;
    PG8_STAGE(PG8_SB(1, 0), cB + kstep, voffB); PG8_STAGE(PG8_SA(1, 0), cA + kstep, cO0); PG8_STAGE(PG8_SB(1, 1), cB + hstep + kstep, voffB);
    PG8_WAIT_V(6); PG8_BAR;
    }
    for (;;) {
        const bool has_next = S.next(ui + 1, nxt);
        const char* nA = has_next ? nxt.a : cA; const char* nB = has_next ? nxt.b : cB;
        if (has_next) PG8_GOFF(nO0, nO1, ui + 1); else { _Pragma("unroll") for (int i_ = 0; i_ < 2; ++i_) { nO0[i_] = cO0[i_]; nO1[i_] = cO1[i_]; } }
#pragma unroll 1
        for (int t = 0; t < nt; t += 2) {
            const bool last = (t == nt - 2);
            const char* a1 = cA + (size_t)(t + 1) * kstep;
            const char* a2 = last ? nA : cA + (size_t)(t + 2) * kstep; const char* b2 = last ? nB : cB + (size_t)(t + 2) * kstep;
            const char* a3 = a2 + kstep; const char* b3 = b2 + kstep;
            unsigned o20[2], o21[2];
#pragma unroll
            for (int i_ = 0; i_ < 2; ++i_) { o20[i_] = last ? nO0[i_] : cO0[i_]; o21[i_] = last ? nO1[i_] : cO1[i_]; }
            if constexpr (FP8 && SP2) {
            PG8_LDB8(B08, 0, 0); PG8_LDB8(B18, 0, 1); PG8_SCHED; PG8_LDA8(At8, 0, 0); PG8_STAGE(PG8_SA(1, 1), a1, cO1);
            PG8_WAIT_V(8); PG8_WAIT_L(0); PG8_BAR; PG8_MMA8(0, 0, At8, B08); PG8_MMA8(0, 1, At8, B18); PG8_BAR; PG8_SCHED;
            PG8_LDA8(At8, 0, 1); PG8_STAGE(PG8_SB(0, 0), b2, voffB); PG8_STAGE(PG8_SB(0, 1), b2 + hstep, voffB); PG8_STAGE(PG8_SA(0, 0), a2, o20);
            PG8_WAIT_V(8); PG8_WAIT_L(0); PG8_BAR; PG8_MMA8(1, 0, At8, B08); PG8_MMA8(1, 1, At8, B18); PG8_BAR; PG8_SCHED;
            PG8_LDB8(B08, 1, 0); PG8_LDB8(B18, 1, 1); PG8_SCHED; PG8_LDA8(At8, 1, 0); PG8_STAGE(PG8_SA(0, 1), a2, o21);
            PG8_WAIT_V(8); PG8_WAIT_L(0); PG8_BAR; PG8_MMA8(0, 0, At8, B08); PG8_MMA8(0, 1, At8, B18); PG8_BAR; PG8_SCHED;
            PG8_LDA8(At8, 1, 1); PG8_STAGE(PG8_SB(1, 0), b3, voffB); PG8_STAGE(PG8_SB(1, 1), b3 + hstep, voffB); PG8_STAGE(PG8_SA(1, 0), a3, o20);
            PG8_WAIT_V(8); PG8_WAIT_L(0); PG8_BAR; PG8_MMA8(1, 0, At8, B08); PG8_MMA8(1, 1, At8, B18); PG8_BAR; PG8_SCHED;
            } else if constexpr (FP8) {
            PG8_LDB8(B08, 0, 0); PG8_SCHED; PG8_LDA8(At8, 0, 0); PG8_STAGE(PG8_SA(1, 1), a1, cO1);
            PG8_WAIT_L(8); PG8_BAR; PG8_WAIT_L(0); PG8_MMA8(0, 0, At8, B08); PG8_BAR; PG8_SCHED;
            PG8_LDB8(B18, 0, 1); PG8_STAGE(PG8_SB(0, 0), b2, voffB);
            PG8_BAR; PG8_WAIT_L(0); PG8_MMA8(0, 1, At8, B18); PG8_BAR;
            PG8_LDA8(At8, 0, 1); PG8_STAGE(PG8_SA(0, 0), a2, o20);
            PG8_BAR; PG8_WAIT_L(0); PG8_MMA8(1, 0, At8, B08); PG8_BAR; PG8_SCHED;
            PG8_STAGE(PG8_SB(0, 1), b2 + hstep, voffB);
            PG8_WAIT_V(6); PG8_BAR; PG8_MMA8(1, 1, At8, B18); PG8_BAR;
            PG8_LDB8(B08, 1, 0); PG8_SCHED; PG8_LDA8(At8, 1, 0); PG8_STAGE(PG8_SA(0, 1), a2, o21);
            PG8_WAIT_L(8); PG8_BAR; PG8_WAIT_L(0); PG8_MMA8(0, 0, At8, B08); PG8_BAR; PG8_SCHED;
            PG8_LDB8(B18, 1, 1); PG8_STAGE(PG8_SB(1, 0), b3, voffB);
            PG8_BAR; PG8_WAIT_L(0); PG8_MMA8(0, 1, At8, B18); PG8_BAR;
            PG8_LDA8(At8, 1, 1); PG8_STAGE(PG8_SA(1, 0), a3, o20);
            PG8_BAR; PG8_WAIT_L(0); PG8_MMA8(1, 0, At8, B08); PG8_BAR; PG8_SCHED;
            PG8_STAGE(PG8_SB(1, 1), b3 + hstep, voffB);
            PG8_WAIT_V(6); PG8_BAR; PG8_MMA8(1, 1, At8, B18); PG8_BAR;
            } else {
            PG8_LDB(B0, 0, 0); PG8_LDB(B1, 0, 1); PG8_SCHED; PG8_LDA(At, 0, 0); PG8_STAGE(PG8_SA(1, 1), a1, cO1);
            PG8_WAIT_V(8); PG8_WAIT_L(0); PG8_BAR; PG8_MMA(0, 0, At, B0); PG8_MMA(0, 1, At, B1); PG8_BAR; PG8_SCHED;
            PG8_LDA(At, 0, 1); PG8_STAGE(PG8_SB(0, 0), b2, voffB); PG8_STAGE(PG8_SB(0, 1), b2 + hstep, voffB); PG8_STAGE(PG8_SA(0, 0), a2, o20);
            PG8_WAIT_V(8); PG8_WAIT_L(0); PG8_BAR; PG8_MMA(1, 0, At, B0); PG8_MMA(1, 1, At, B1); PG8_BAR; PG8_SCHED;
            PG8_LDB(B0, 1, 0); PG8_LDB(B1, 1, 1); PG8_SCHED; PG8_LDA(At, 1, 0); PG8_STAGE(PG8_SA(0, 1), a2, o21);
            PG8_WAIT_V(8); PG8_WAIT_L(0); PG8_BAR; PG8_MMA(0, 0, At, B0); PG8_MMA(0, 1, At, B1); PG8_BAR; PG8_SCHED;
            PG8_LDA(At, 1, 1); PG8_STAGE(PG8_SB(1, 0), b3, voffB); PG8_STAGE(PG8_SB(1, 1), b3 + hstep, voffB); PG8_STAGE(PG8_SA(1, 0), a3, o20);
            PG8_WAIT_V(8); PG8_WAIT_L(0); PG8_BAR; PG8_MMA(1, 0, At, B0); PG8_MMA(1, 1, At, B1); PG8_BAR; PG8_SCHED;
            }
        }
        if (wr == 0) PG8_BAR;
        if constexpr (FP8) asm volatile("s_nop 15\n\ts_nop 15" ::: "memory");
        E(acc, cur, wr, wc, fr, fq);
        if (!has_next) break;
#pragma unroll
        for (int a = 0; a < 2; ++a)
#pragma unroll
            for (int b = 0; b < 2; ++b)
#pragma unroll
                for (int m = 0; m < 4; ++m)
#pragma unroll
                    for (int n = 0; n < 2; ++n) acc[a][b][m][n] = (f32x4){0.f, 0.f, 0.f, 0.f};
        cur = nxt; cA = nA; cB = nB; ++ui;
#pragma unroll
        for (int i_ = 0; i_ < 2; ++i_) { cO0[i_] = nO0[i_]; cO1[i_] = nO1[i_]; }
        if (wr == 1) PG8_BAR;
    }
    PG8_WAIT_V(0);
    PG8_BAR;
#undef PG8_SA
#undef PG8_GOFF
#undef PG8_SB
#undef PG8_STAGE
#undef PG8_LDA
#undef PG8_LDB
#undef PG8_MMA
#undef PG8_MMA8
#undef PG8_LDA8
#undef PG8_LDB8
#undef PG8_LD32
#undef PG8_WAIT_V
#undef PG8_WAIT_L
#undef PG8_BAR
#undef PG8_SCHED
}
template <bool FP8, bool GATHER, class Epi, class Sched>
__device__ __forceinline__ void gemm_phase_g(LAS unsigned char* lds, const int K, const Sched& S, const Epi& E, const int wid, const int lane) { gemm_phase_s<FP8, GATHER, !FP8>(lds, K, S, E, wid, lane); }
template <bool FP8, class Epi, class Sched>
__device__ __forceinline__ void gemm_phase(LAS unsigned char* lds, const int K, const Sched& S, const Epi& E, const int wid, const int lane) { gemm_phase_s<FP8, false, !FP8>(lds, K, S, E, wid, lane); }
}

__device__ __forceinline__ int lane_id() { int l; asm volatile("v_mbcnt_lo_u32_b32 %0, -1, 0\n\tv_mbcnt_hi_u32_b32 %0, -1, %0" : "=v"(l)); return l; }
#define FT_DECL const int f_lane = lane_id(), f_tid = F.wave * 64 + f_lane; (void)f_tid; (void)f_lane
typedef const float* cfp_t;
typedef __attribute__((address_space(4))) cfp_t* kin_t;
struct Frame {
    LAS unsigned char* lds;
    volatile LAS unsigned* MISC;
    gu32* ctl;
    int wave, vcu, G;
    kin_t in;
    float* out;
    unsigned char* ws;
};
#define WSP(T, off) ((T*)(F.ws + (off)))

template <class RowMap>
__device__ __forceinline__ void p0_transpose_item(const float* W, int K, int N, bf16_t* WT, const RowMap& rowmap, const float* kscale, LAS float* scr, int item, int lane, bool kperm = false) {
    const int nblk = N / 32, kb = item / nblk, nb = item % nblk, k0 = 64 * kb, n0 = 32 * nb;
#pragma unroll 8
    for (int i = 0; i < 32; ++i) { const int kk = 2 * i + (lane >> 5); int ks = k0 + kk; if (kperm && ks >= K / 2) { const int j = ks - K / 2; ks = K / 2 + (j >> 3) + 64 * (j & 7); }
        float v = W[(size_t)ks * N + n0 + (lane & 31)]; if (kscale) v *= kscale[k0 + kk]; scr[kk * 33 + (lane & 31)] = v; }
    LDS_WAIT(); asm volatile("" ::: "memory");
    const int c = lane & 7;
#pragma unroll
    for (int j = 0; j < 4; ++j) { const int n = (lane >> 3) + 8 * j; const LAS float* s = scr + (8 * c) * 33 + n;
        u32x4 o; o.x = cvt_pk_bf16(s[0 * 33], s[1 * 33]); o.y = cvt_pk_bf16(s[2 * 33], s[3 * 33]); o.z = cvt_pk_bf16(s[4 * 33], s[5 * 33]); o.w = cvt_pk_bf16(s[6 * 33], s[7 * 33]);
        *(GAS u32x4*)(WT + (size_t)rowmap(n0 + n) * K + k0 + 8 * c) = o; }
    LDS_WAIT(); asm volatile("" ::: "memory");
}

__device__ __forceinline__ unsigned pk4_fp8(float a, float b, float c, float d) { int r = __builtin_amdgcn_cvt_pk_fp8_f32(a, b, 0, false); r = __builtin_amdgcn_cvt_pk_fp8_f32(c, d, r, true); return (unsigned)r; }
constexpr float EOSCALE = 16.f;
constexpr float WSCALE = 32.f;
template <class RowMap>
__device__ __forceinline__ void p0_transpose_item_f8(const float* W, int K, int N, unsigned char* WT, const RowMap& rowmap, LAS float* scr, int item, int lane) {
    const int nblk = N / 32, kb = item / nblk, nb = item % nblk, k0 = 128 * kb, n0 = 32 * nb;
#pragma unroll
    for (int hh = 0; hh < 2; ++hh) { float v[32];
#pragma unroll
        for (int i = 0; i < 32; ++i) { const int kk = 2 * (32 * hh + i) + (lane >> 5); v[i] = __builtin_nontemporal_load(W + (size_t)(k0 + kk) * N + n0 + (lane & 31)); }
#pragma unroll
        for (int i = 0; i < 32; ++i) { const int kk = 2 * (32 * hh + i) + (lane >> 5); scr[kk * 33 + (lane & 31)] = v[i] * WSCALE; } }
    LDS_WAIT(); asm volatile("" ::: "memory");
    const int c = lane & 7;
#pragma unroll
    for (int j = 0; j < 4; ++j) { const int n = (lane >> 3) + 8 * j; const LAS float* sp = scr + (16 * c) * 33 + n;
        u32x4 o; o.x = pk4_fp8(sp[0 * 33], sp[1 * 33], sp[2 * 33], sp[3 * 33]); o.y = pk4_fp8(sp[4 * 33], sp[5 * 33], sp[6 * 33], sp[7 * 33]);
        o.z = pk4_fp8(sp[8 * 33], sp[9 * 33], sp[10 * 33], sp[11 * 33]); o.w = pk4_fp8(sp[12 * 33], sp[13 * 33], sp[14 * 33], sp[15 * 33]);
        *(GAS u32x4*)(WT + (size_t)rowmap(n0 + n) * K + k0 + 16 * c) = o; }
    LDS_WAIT(); asm volatile("" ::: "memory");
}
struct MapW2 { __device__ __forceinline__ int operator()(int l) const { const int t = l & ~255, r = l & 255, wc = r >> 6, fq = (r >> 4) & 3, bj = (r >> 3) & 1, low = r & 7; return t + 128 * bj + 32 * wc + 8 * fq + low; } };
struct MapIdent { int off; __device__ __forceinline__ int operator()(int n) const { return off + n; } };
struct MapWin { __device__ __forceinline__ int operator()(int l) const {
    if (l >= 1024) return l;
    const int t = l & ~255, r = l & 255, wc = r >> 6, blk = (r >> 5) & 1, bj = (r >> 4) & 1, low = r & 15;
    return t + 128 * bj + 32 * wc + 16 * blk + low; } };
struct MapW1 { int off; __device__ __forceinline__ int operator()(int jp) const { const int bj = jp >> 10, j = jp & 1023; return off + 256 * (j >> 7) + 128 * bj + (j & 127); } };


__device__ __forceinline__ void p0_filter_item(Frame& F, int item) {
    FT_DECL;
#define in F.in
    LAS float* h1s = (LAS float*)(F.lds);
    LAS float* h2s = (LAS float*)(F.lds + 4096);
    const int t0 = item * 16;
    {
        const int tt = f_tid >> 5, hh = (f_tid & 31) * 2; const float pos = (float)(t0 + tt);
        float feats[17]; feats[0] = pos * (1.f / SEQ);
#pragma unroll
        for (int i = 0; i < 8; ++i) { const float band = 1e-4f + (float)i * ((7.f - 1e-4f) / 7.f); const float ang = (6.283185307179586f / SEQ) * pos * band; feats[1 + i] = __sinf(ang); feats[9 + i] = __cosf(ang); }
#pragma unroll
        for (int u = 0; u < 2; ++u) { const int h = hh + u; float a = in[19][h];
#pragma unroll
            for (int k = 0; k < 17; ++k) a += feats[k] * in[18][k * 64 + h];
            h1s[tt * 64 + h] = __sinf(in[20][h] * a); }
        __syncthreads();
#pragma unroll
        for (int u = 0; u < 2; ++u) { const int h = hh + u; float a = in[22][h];
#pragma unroll 8
            for (int k = 0; k < 64; ++k) a += h1s[tt * 64 + k] * in[21][k * 64 + h];
            h2s[tt * 64 + h] = __sinf(in[23][h] * a); }
        __syncthreads();
    }
    f32x4 acc[16];
#pragma unroll
    for (int t = 0; t < 16; ++t) acc[t] = (f32x4){0.f, 0.f, 0.f, 0.f};
    const int o = 4 * f_tid;
    for (int k0 = 0; k0 < 64; k0 += 4) { f32x4 w[4];
#pragma unroll
        for (int q = 0; q < 4; ++q) w[q] = *(const f32x4*)(in[24] + (size_t)(k0 + q) * 2048 + o);
#pragma unroll
        for (int t = 0; t < 16; ++t) { const f32x4 hv = *(const LAS f32x4*)(h2s + t * 64 + k0); acc[t] += w[0] * hv[0] + w[1] * hv[1] + w[2] * hv[2] + w[3] * hv[3]; } }
    const int c0 = o & 511, od = o >> 9;
    float* dst = WSP(float, WS_FILT) + ((size_t)od * 512 + c0) * SEQ + t0;
#pragma unroll
    for (int e = 0; e < 4; ++e) { const float la = -3.0701134573253944f, lb = -15.350567286626972f; const float delta = fabsf(la + (float)(c0 + e) * ((lb - la) / 511.f));
#pragma unroll
        for (int q = 0; q < 4; ++q) { f32x4 v;
#pragma unroll
            for (int i = 0; i < 4; ++i) { const int t = 4 * q + i; const float tn = (float)(t0 + t) * (1.f / SEQ); v[i] = acc[t][e] * __expf(-tn * delta); }
            *(f32x4*)(dst + (size_t)e * SEQ + 4 * q) = v; } }
    __syncthreads();
#undef in
}

__device__ __forceinline__ float silu_f(float v) { return v / (1.f + __expf(-v)); }

__device__ __forceinline__ void p0_prologue(Frame& F) {
    FT_DECL;
#define in F.in
    const int wg = blockIdx.x;
    if (wg < 96) {
        LAS float* sv = (LAS float*)F.lds;
        for (int i = f_tid; i < 9 * 1024; i += 512) { const int r = i >> 10, k = i & 1023; const float c = (r < 8) ? in[1][r * 1024 + k] : in[3][k]; sv[i] = silu_f(c); }
        __syncthreads();
        const int j = wg * 64 + f_lane; const float* wm = in[4];
        float acc[9];
#pragma unroll
        for (int r = 0; r < 9; ++r) acc[r] = 0.f;
        const int kbeg = F.wave * 128;
        for (int k0 = kbeg; k0 < kbeg + 128; k0 += 16) { float w[16];
#pragma unroll
            for (int q = 0; q < 16; ++q) w[q] = __builtin_nontemporal_load(wm + (size_t)(k0 + q) * (NMOD * DM) + j);
#pragma unroll
            for (int q = 0; q < 16; ++q)
#pragma unroll
                for (int r = 0; r < 9; ++r) acc[r] += sv[r * 1024 + k0 + q] * w[q]; }
        LAS float* red = (LAS float*)(F.lds + 40960);
#pragma unroll
        for (int r = 0; r < 9; ++r) red[(F.wave * 9 + r) * 64 + f_lane] = acc[r];
        __syncthreads();
        for (int i = f_tid; i < 9 * 64; i += 512) { const int r = i >> 6, l = i & 63; float s = in[5][wg * 64 + l];
#pragma unroll
            for (int w = 0; w < 8; ++w) s += red[(w * 9 + r) * 64 + l];
            WSP(float, WS_SMALL + SM_MOD)[r * (NMOD * DM) + wg * 64 + l] = s; }
        __syncthreads();
    } else if (wg == 96) {
        if (F.wave == 0) {
            const float a = wave_sum(in[11][f_lane] * in[12][f_lane]), b = wave_sum(in[13][f_lane] * in[14][f_lane]);
            float gq = fabsf(in[9][f_lane]), gk = fabsf(in[10][f_lane]);
#pragma unroll
            for (int o = 1; o < 64; o <<= 1) { gq = fmaxf(gq, __shfl_xor(gq, o)); gk = fmaxf(gk, __shfl_xor(gk, o)); }
            if (f_lane == 0) { float* sc = WSP(float, WS_SMALL + SM_SCAL); sc[0] = expf(a) - expf(b) + LAM_INIT;
                sc[1] = (8.f * gq * gk * 1.02f + 0.05f) * 1.4426950408889634f; }
        }
        for (int i = f_tid; i < 64 * 16; i += 512) { const int pos = i >> 4, f = i & 15;
            const float inv = powf(10000.f, -(float)f / 16.f); const float ang = (float)pos * inv;
            float* rt = WSP(float, WS_SMALL + SM_ROPE); rt[2 * i] = cosf(ang); rt[2 * i + 1] = sinf(ang); }
    }
    __syncthreads();
    for (int it = wg; it < SEQ / 16; it += F.G) p0_filter_item(F, it);
    __syncthreads();
    {
        LAS float* scr = (LAS float*)(F.lds + F.wave * 16896);
        const int gw = F.vcu * NWAVES + F.wave, NGW = F.G * NWAVES;
        constexpr int I_IN = (DM / 64) * (INC / 32), I_OUT = (DM / 64) * (DM / 32), I_1 = (DM / 128) * (2 * DM / 32), I_2 = (DM / 128) * (DM / 32);
        constexpr int NITEMS = I_IN + I_OUT + NEXP * (I_1 + I_2);
        for (int it = gw; it < NITEMS; it += NGW) {
            int r = it;
            if (r < I_IN) { p0_transpose_item(in[8], DM, INC, WSP(bf16_t, WS_WIN), MapWin{}, nullptr, scr, r, f_lane); continue; } r -= I_IN;
            if (r < I_OUT) { p0_transpose_item(in[27], DM, DM, WSP(bf16_t, WS_WOUT), MapIdent{0}, nullptr, scr, r, f_lane, true); continue; } r -= I_OUT;
            const int e = r / (I_1 + I_2); r -= e * (I_1 + I_2);
            if (r < I_1) p0_transpose_item_f8(in[30] + (size_t)e * DM * 2 * DM, DM, 2 * DM, WSP(unsigned char, WS_W1) + (size_t)e * 2 * DM * DM, MapW1{0}, scr, r, f_lane);
            else p0_transpose_item_f8(in[32] + (size_t)e * DM * DM, DM, DM, WSP(unsigned char, WS_W2) + (size_t)e * DM * DM, MapW2{}, scr, r - I_1, f_lane);
        }
    }
}
#undef in

__device__ __forceinline__ void p1_norm1(Frame& F) {
    FT_DECL;
    const int gw = F.vcu * NWAVES + F.wave, NGW = F.G * NWAVES;
    const float* mod = WSP(float, WS_SMALL + SM_MOD); const float* g1 = F.in[6];
    bf16_t* H = WSP(bf16_t, WS_H);
    constexpr int RPW = MTOT / (256 * NWAVES);
    for (int run = gw; run * RPW < MTOT; run += NGW) {
        const int r0 = run * RPW, r1 = (r0 + RPW < MTOT) ? r0 + RPW : MTOT;
        int curb = -1; f32x4 PA[4], PB[4];
        for (int m0 = r0; m0 < r1; m0 += 4) {
            f32x4 v[4][4];
#pragma unroll
            for (int u = 0; u < 4; ++u) { const int m = m0 + u; if (m < r1) {
                const float* xrow = (m < MROWS) ? F.in[0] + (size_t)m * DM : F.in[2] + (size_t)(m - MROWS) * DM; const GAS f32x4* xr = (const GAS f32x4*)xrow + f_lane;
#pragma unroll
                for (int j = 0; j < 4; ++j) v[u][j] = __builtin_nontemporal_load(xr + 64 * j); } }
#pragma unroll
            for (int u = 0; u < 4; ++u) { const int m = m0 + u; if (m < r1) {
                const int mb = (m < MROWS) ? (m >> 12) : 8;
                if (mb != curb) { curb = mb; const float* sh = mod + (size_t)mb * (NMOD * DM); const float* sc = sh + DM;
#pragma unroll
                    for (int j = 0; j < 4; ++j) { const int c = 4 * f_lane + 256 * j; PA[j] = *(const f32x4*)(g1 + c) * (*(const f32x4*)(sc + c) + 1.f); PB[j] = *(const f32x4*)(sh + c); } }
                float s = 0.f;
#pragma unroll
                for (int j = 0; j < 4; ++j) s += (v[u][j].x * v[u][j].x + v[u][j].y * v[u][j].y) + (v[u][j].z * v[u][j].z + v[u][j].w * v[u][j].w);
                const float rstd = rsqrtf(wave_sum(s) * (1.f / DM) + EPS);
                GAS u32x2* o8 = (GAS u32x2*)(H + (size_t)m * DM) + f_lane;
#pragma unroll
                for (int j = 0; j < 4; ++j) { const f32x4 y = v[u][j] * rstd * PA[j] + PB[j];
                    u32x2 w; w.x = cvt_pk_bf16(y.x, y.y); w.y = cvt_pk_bf16(y.z, y.w); o8[64 * j] = w; } } }
        }
    }
}

struct SchedInProj {
    int G, c; const char* H; const char* W;
    static constexpr int NA = 136 * 4, NV = 2 * 136, NBU = 6 * 128;
    __device__ __forceinline__ bool next(int i, g8::Unit& u) const {
        const long L = (long)i * G + c;
        if (L < NA) { g8::tile_of((int)L, 136, 4, u.pm, u.pn); u.a = H + (size_t)u.pm * 256 * DM * 2; u.b = W + (size_t)u.pn * 256 * DM * 2; u.kind = 0; u.ex = 0; return true; }
        if (L < NA + NV) { g8::tile_of((int)L - NA, 2, 136, u.pm, u.pn); u.a = W + (size_t)(1024 + u.pm * 256) * DM * 2; u.b = H + (size_t)u.pn * 256 * DM * 2; u.kind = 2; u.ex = 0; return true; }
        if (L < NA + NV + NBU) { g8::tile_of((int)L - NA - NV, 6, 128, u.pm, u.pn); u.a = W + (size_t)(QKVC + u.pm * 256) * DM * 2; u.b = H + (size_t)u.pn * 256 * DM * 2; u.kind = 1; u.ex = 0; return true; }
        return false;
    }
};
constexpr float Q8SCALE = 16.f;
struct EpiInProj {
    unsigned char *Q8, *K8, *VT8; bf16_t* UT; const float *gq, *gk, *rope;
    __device__ __forceinline__ void operator()(f32x4 (&acc)[2][2][4][2], const g8::Unit& u, int wr, int wc, int fr, int fq) const {
        asm volatile("" : "+v"(fr), "+v"(fq));
        if (u.kind == 1) {
            const int row0 = u.pm * 256 + wr * 64 + fr, col0 = u.pn * 256 + wc * 32 + 8 * fq;
#pragma unroll
            for (int ai = 0; ai < 2; ++ai)
#pragma unroll
                for (int m = 0; m < 4; ++m) { const int ch = row0 + ai * 128 + m * 16;
#pragma unroll
                    for (int bj = 0; bj < 2; ++bj) { const int tok = col0 + bj * 128; const f32x4 v0 = acc[ai][bj][m][0], v1 = acc[ai][bj][m][1];
                        u32x4 w; w.x = cvt_pk_bf16(v0[0], v0[1]); w.y = cvt_pk_bf16(v0[2], v0[3]); w.z = cvt_pk_bf16(v1[0], v1[1]); w.w = cvt_pk_bf16(v1[2], v1[3]);
                        *(u32x4*)(UT + ((size_t)(tok >> 7) * HYC + ch) * 128 + (tok & 127)) = w; } }
            return;
        }
        if (u.kind == 2) {
#pragma unroll
            for (int bj = 0; bj < 2; ++bj) { const int t8 = u.pn * 256 + bj * 128 + wc * 32 + 8 * fq;
                int b, key; if (t8 < MROWS) { b = t8 >> 12; key = CTXL + (t8 & 4095); } else { const int j = t8 - MROWS; b = j >> 8; key = j & 255; }
                const int tile = key >> 6, k = key & 63, ipos = (k < 32) ? 4 * (k >> 3) : 16 + 4 * ((k - 32) >> 3);
#pragma unroll
                for (int ai = 0; ai < 2; ++ai)
#pragma unroll
                    for (int m = 0; m < 4; ++m) { const int ch = u.pm * 256 + ai * 128 + wr * 64 + m * 16 + fr;
                        unsigned char* dst = VT8 + ((((size_t)(b * NHEAD + (ch >> 7)) * 68 + tile) * 128 + (ch & 127)) * 64) + ipos;
                        const f32x4 v0 = acc[ai][bj][m][0], v1 = acc[ai][bj][m][1];
                        *(unsigned*)dst = pk4_fp8(v0[0], v0[1], v0[2], v0[3]); *(unsigned*)(dst + 32) = pk4_fp8(v1[0], v1[1], v1[2], v1[3]); } }
            return;
        }
        const int blk = fq >> 1, f = fq & 1;
        const int sec = u.pn >> 1;
        const bool ctx = (u.pm >= 128);
        if (sec == 0 && ctx) return;
        const int colbase = (u.pn & 1) * 256 + wc * 64 + 32 * blk + 8 * f;
        float gg[2][2][4];
        { const float* gp = (sec == 0 ? gq : gk) + 32 * blk + 8 * f;
#pragma unroll
            for (int bj = 0; bj < 2; ++bj)
#pragma unroll
                for (int n = 0; n < 2; ++n) { const f32x4 t = *(const f32x4*)(gp + 16 * bj + 4 * n); gg[bj][n][0] = t[0]; gg[bj][n][1] = t[1]; gg[bj][n][2] = t[2]; gg[bj][n][3] = t[3]; } }
#pragma unroll
        for (int ai = 0; ai < 2; ++ai)
#pragma unroll
            for (int m = 0; m < 4; ++m) {
                const int rloc = ai * 128 + wr * 64 + m * 16 + fr; const int r = u.pm * 256 + rloc;
                f32x4 v[2][2];
#pragma unroll
                for (int bj = 0; bj < 2; ++bj)
#pragma unroll
                    for (int n = 0; n < 2; ++n) v[bj][n] = acc[ai][bj][m][n];
                size_t orow;
                if (sec == 0) orow = (size_t)r;
                else if (!ctx) orow = (size_t)(r >> 12) * KVL + CTXL + (r & 4095);
                else { const int j = r - MROWS; orow = (size_t)(j >> 8) * KVL + (j & 255); }
                float ss = 0.f;
#pragma unroll
                for (int bj = 0; bj < 2; ++bj)
#pragma unroll
                    for (int n = 0; n < 2; ++n) ss += (v[bj][n][0] * v[bj][n][0] + v[bj][n][1] * v[bj][n][1]) + (v[bj][n][2] * v[bj][n][2] + v[bj][n][3] * v[bj][n][3]);
                ss += __shfl_xor(ss, 16); ss += __shfl_xor(ss, 32);
                const float rstd = rsqrtf(ss * (1.f / 64.f) + EPS) * (sec == 0 ? QSCALE * Q8SCALE : 1.f);
#pragma unroll
                for (int bj = 0; bj < 2; ++bj)
#pragma unroll
                    for (int n = 0; n < 2; ++n)
#pragma unroll
                        for (int e = 0; e < 4; ++e) v[bj][n][e] *= rstd * gg[bj][n][e];
                if (!ctx) {
                    const int t = r & 4095; const int pos = blk ? (t & 63) : (t >> 6);
                    const float* rp = rope + (size_t)(pos * 16 + 8 * f) * 2;
#pragma unroll
                    for (int n = 0; n < 2; ++n) { const f32x4 c0 = *(const f32x4*)(rp + 8 * n), c1 = *(const f32x4*)(rp + 8 * n + 4);
                        const float cs[4] = {c0[0], c0[2], c1[0], c1[2]}, sn[4] = {c0[1], c0[3], c1[1], c1[3]};
#pragma unroll
                        for (int e = 0; e < 4; ++e) { const float x1 = v[0][n][e], x2 = v[1][n][e]; v[0][n][e] = x1 * cs[e] - x2 * sn[e]; v[1][n][e] = x2 * cs[e] + x1 * sn[e]; } }
                }
                unsigned char* dst = (sec == 0 ? Q8 : K8) + orow * QKW + colbase;
#pragma unroll
                for (int bj = 0; bj < 2; ++bj) { u32x2 w; w.x = pk4_fp8(v[bj][0][0], v[bj][0][1], v[bj][0][2], v[bj][0][3]); w.y = pk4_fp8(v[bj][1][0], v[bj][1][1], v[bj][1][2], v[bj][1][3]);
                    *(u32x2*)(dst + 16 * bj) = w; }
            }
    }
};

struct SchedStatic {
    int G, c, nM, nN; const char* A; const char* B;
    __device__ __forceinline__ bool next(int i, g8::Unit& u) const {
        const long L = (long)i * G + c; if (L >= (long)nM * nN) return false;
        g8::tile_of((int)L, nM, nN, u.pm, u.pn); u.a = A + (size_t)u.pm * 256 * DM * 2; u.b = B + (size_t)u.pn * 256 * DM * 2; u.kind = 0; u.ex = 0; return true;
    }
};
struct EpiOutProj {
    const float* x; bf16_t* out; const float* mod;
    __device__ __forceinline__ void operator()(f32x4 (&acc)[2][2][4][2], const g8::Unit& u, int wr, int wc, int fr, int fq) const {
        asm volatile("" : "+v"(fr), "+v"(fq));
        const int col0 = u.pn * 256 + wc * 32 + 8 * fq;
        const float* g1 = mod + (size_t)((u.pm * 256) >> 12) * (NMOD * DM) + 2 * DM + col0;
        f32x4 gv[2][2];
#pragma unroll
        for (int bj = 0; bj < 2; ++bj)
#pragma unroll
            for (int n = 0; n < 2; ++n) gv[bj][n] = *(const f32x4*)(g1 + bj * 128 + 4 * n);
#pragma unroll
        for (int ai = 0; ai < 2; ++ai)
#pragma unroll
            for (int m = 0; m < 4; ++m) { const int r = u.pm * 256 + ai * 128 + wr * 64 + m * 16 + fr;
                const size_t off = (size_t)r * DM + col0;
#pragma unroll
                for (int bj = 0; bj < 2; ++bj) { f32x4 o[2];
#pragma unroll
                    for (int n = 0; n < 2; ++n) { const f32x4 xv = __builtin_nontemporal_load((const f32x4*)(x + off + bj * 128 + 4 * n)); o[n] = xv + gv[bj][n] * acc[ai][bj][m][n]; }
                    u32x4 w; w.x = cvt_pk_bf16(o[0][0], o[0][1]); w.y = cvt_pk_bf16(o[0][2], o[0][3]); w.z = cvt_pk_bf16(o[1][0], o[1][1]); w.w = cvt_pk_bf16(o[1][2], o[1][3]);
                    *(u32x4*)(out + off + bj * 128) = w; } }
    }
};

namespace att8 {
constexpr int NT = KVL / 64, SHMB = 8192, LDS_V0 = 3 * SHMB;
typedef int i32x8 __attribute__((ext_vector_type(8)));
#define SBAR() __builtin_amdgcn_sched_barrier(0)
__device__ __forceinline__ int crow(int r, int hi) { return (r & 3) + 8 * (r >> 2) + 4 * hi; }
__device__ __forceinline__ i32x8 ld32(const LAS unsigned char* p0, const LAS unsigned char* p1) {
    const u32x4 a = *(const LAS u32x4*)p0, b = *(const LAS u32x4*)p1; return (i32x8){(int)a.x, (int)a.y, (int)a.z, (int)a.w, (int)b.x, (int)b.y, (int)b.z, (int)b.w}; }
__device__ __forceinline__ void mfma_qk(f32x16& p, const i32x8& kf, const i32x8& qf, const f32x16& negc) {
    const unsigned s1 = 0x7f7f7f7fu, sq = 0x7b7b7b7bu;
    asm volatile("s_nop 1\n\tv_mfma_scale_f32_32x32x64_f8f6f4 %0, %1, %2, %3, %4, %5 op_sel_hi:[0,0,0]" : "=&v"(p) : "v"(kf), "v"(qf), "v"(negc), "v"(s1), "v"(sq));
}
__device__ __forceinline__ void mfma_pv(f32x16& o, const i32x8& pa, const i32x8& vf) {
    const unsigned s1 = 0x7f7f7f7fu;
    asm volatile("s_nop 2\n\tv_mfma_scale_f32_32x32x64_f8f6f4 %0, %1, %2, %0, %3, %3 op_sel_hi:[0,0,0]" : "+v"(o) : "v"(pa), "v"(vf), "v"(s1));
}
__device__ __forceinline__ void qkt(f32x16& p0, f32x16& p1, const LAS unsigned char* Kb, const i32x8& qf, const f32x16& negc, int r32, int hi, int sub) {
    const int c0 = sub * 4 + hi * 2;
    const int k0 = r32, k1 = 32 + r32;
    const i32x8 kf0 = ld32(Kb + k0 * 128 + ((c0 ^ ((k0 >> 1) & 7)) << 4), Kb + k0 * 128 + (((c0 + 1) ^ ((k0 >> 1) & 7)) << 4));
    const i32x8 kf1 = ld32(Kb + k1 * 128 + ((c0 ^ ((k1 >> 1) & 7)) << 4), Kb + k1 * 128 + (((c0 + 1) ^ ((k1 >> 1) & 7)) << 4));
    mfma_qk(p0, kf0, qf, negc); mfma_qk(p1, kf1, qf, negc);
}
__device__ __forceinline__ void mfma_wait(f32x16& p0, f32x16& p1) { asm volatile("s_nop 15\n\ts_nop 3" : "+v"(p0), "+v"(p1)); }
__device__ __forceinline__ void expA(f32x16& p) {
#pragma unroll
    for (int r = 0; r < 16; ++r) p[r] = __builtin_amdgcn_exp2f(p[r]);
}
__device__ __forceinline__ void finishSM(f32x16& p0, f32x16& p1, i32x8& pa) {
#pragma unroll
    for (int r = 0; r < 16; ++r) p1[r] = __builtin_amdgcn_exp2f(p1[r]);
#pragma unroll
    for (int j = 0; j < 4; ++j) { pa[j] = (int)pk4_fp8(p0[4 * j], p0[4 * j + 1], p0[4 * j + 2], p0[4 * j + 3]); pa[4 + j] = (int)pk4_fp8(p1[4 * j], p1[4 * j + 1], p1[4 * j + 2], p1[4 * j + 3]); }
}
__device__ __forceinline__ void pv(f32x16* o, f32x16& ol, const i32x8& ones, const LAS unsigned char* Vb, const i32x8& pa, int r32, int hi) {
    mfma_pv(ol, pa, ones);
#pragma unroll
    for (int d0 = 0; d0 < 4; ++d0) { const int d = 32 * d0 + r32, sw = (d >> 2) & 3;
        const i32x8 vf = ld32(Vb + d * 64 + (((2 * hi) ^ sw) << 4), Vb + d * 64 + (((2 * hi + 1) ^ sw) << 4));
        mfma_pv(o[d0], pa, vf); }
}
__device__ __forceinline__ void attn_unit(const unsigned char* __restrict__ Qb, const unsigned char* __restrict__ Kh, const unsigned char* __restrict__ VTh, bf16_t* MIXo,
                                          const float lam, const float* __restrict__ subg, char* lds, const int wid) {
    const int lane = lane_id(), tid = wid * 64 + lane, r32 = lane & 31, hi = lane >> 5;
    const int sub = wid >> 2, wq = wid & 3;
    const LAS unsigned char* L = (const LAS unsigned char*)(uintptr_t)(unsigned)(uintptr_t)lds;
    f32x16 o[4] = {}; f32x16 ol = {};
    i32x8 ones; { int c1 = 0x38383838; asm volatile("" : "+v"(c1)); ones = (i32x8){c1, c1, c1, c1, c1, c1, c1, c1}; }
    i32x8 qf; { const unsigned char* qp = Qb + (size_t)(wq * 32 + r32) * QKW + sub * 64 + 32 * hi; const u32x4 a = *(const u32x4*)qp, b = *(const u32x4*)(qp + 16);
        qf = (i32x8){(int)a.x, (int)a.y, (int)a.z, (int)a.w, (int)b.x, (int)b.y, (int)b.z, (int)b.w}; }
    f32x16 negc;
#pragma unroll
    for (int r = 0; r < 16; ++r) negc[r] = -5.f;
    asm volatile("" : "+v"(negc));
    long ksrc, vsrc;
    { const int r = 8 * wid + (lane >> 3), c = (lane & 7) ^ ((r >> 1) & 7); ksrc = (long)r * QKW + c * 16; }
    { const int d = 16 * wid + (lane >> 2), c = (lane & 3) ^ ((d >> 2) & 3); vsrc = (long)d * 64 + c * 16; }
    const unsigned ldsb = (unsigned)(uintptr_t)lds, kdst = ldsb + (unsigned)wid * 1024u, vdst = ldsb + LDS_V0 + (unsigned)wid * 1024u;
#define DMA_TILE(t, boff) do { \
        __builtin_amdgcn_global_load_lds((const unsigned*)(Kh + (long)(t) * 64 * QKW + ksrc), (LAS unsigned*)(uintptr_t)__builtin_amdgcn_readfirstlane(kdst + (unsigned)(boff)), 16, 0, 0); \
        __builtin_amdgcn_global_load_lds((const unsigned*)(VTh + (long)(t) * 8192 + vsrc), (LAS unsigned*)(uintptr_t)__builtin_amdgcn_readfirstlane(vdst + (unsigned)(boff)), 16, 0, 0); } while (0)
#define WBAR() do { asm volatile("s_waitcnt vmcnt(0) lgkmcnt(0)" ::: "memory"); __builtin_amdgcn_s_barrier(); asm volatile("" ::: "memory"); } while (0)
#define ROT3(x) ((x) == 2 * SHMB ? 0 : (x) + SHMB)
    f32x16 pA0, pA1, pB0, pB1; i32x8 pa;
    DMA_TILE(0, 0); WBAR();
    DMA_TILE(1, SHMB);
    qkt(pA0, pA1, L, qf, negc, r32, hi, sub); mfma_wait(pA0, pA1); expA(pA0);
    WBAR();
    int bprev = 0, bcur = SHMB, bnext = 2 * SHMB;
    for (int j = 1; j + 1 < NT; j += 2) {
        DMA_TILE(j + 1, bnext);
        SBAR(); qkt(pB0, pB1, L + bcur, qf, negc, r32, hi, sub);
        finishSM(pA0, pA1, pa); SBAR();
        pv(o, ol, ones, L + LDS_V0 + bprev, pa, r32, hi); mfma_wait(pB0, pB1); expA(pB0);
        WBAR();
        bprev = bcur; bcur = bnext; bnext = ROT3(bnext);
        if (j + 2 < NT) DMA_TILE(j + 2, bnext);
        SBAR(); qkt(pA0, pA1, L + bcur, qf, negc, r32, hi, sub);
        finishSM(pB0, pB1, pa); SBAR();
        pv(o, ol, ones, L + LDS_V0 + bprev, pa, r32, hi); mfma_wait(pA0, pA1); expA(pA0);
        WBAR();
        bprev = bcur; bcur = bnext; bnext = ROT3(bnext);
    }
    SBAR(); qkt(pB0, pB1, L + bcur, qf, negc, r32, hi, sub);
    finishSM(pA0, pA1, pa); SBAR();
    pv(o, ol, ones, L + LDS_V0 + bprev, pa, r32, hi); mfma_wait(pB0, pB1); expA(pB0);
    finishSM(pB0, pB1, pa); SBAR();
    pv(o, ol, ones, L + LDS_V0 + bcur, pa, r32, hi);
    asm volatile("s_nop 15\n\ts_nop 3" : "+v"(o[0]), "+v"(o[1]), "+v"(o[2]), "+v"(o[3]), "+v"(ol));
#undef ROT3
#undef DMA_TILE
#undef WBAR
    __syncthreads();
    float* X = (float*)lds;
    float rli[16];
#pragma unroll
    for (int r = 0; r < 16; ++r) rli[r] = __builtin_amdgcn_rcpf(ol[r]);
    if (sub == 1) {
#pragma unroll
        for (int r = 0; r < 16; ++r) { const int row = wq * 32 + crow(r, hi); const float sc = lam * rli[r];
#pragma unroll
            for (int d0 = 0; d0 < 4; ++d0) X[row * 128 + d0 * 32 + r32] = o[d0][r] * sc; }
    }
    __syncthreads();
    bf16_t* Y = (bf16_t*)(lds + 65536);
    if (sub == 0) {
        float sg[4];
#pragma unroll
        for (int d0 = 0; d0 < 4; ++d0) sg[d0] = subg[d0 * 32 + r32] * (1.f - LAM_INIT);
#pragma unroll
        for (int r = 0; r < 16; ++r) { const int row = wq * 32 + crow(r, hi);
            float v[4]; float ss = 0.f;
#pragma unroll
            for (int d0 = 0; d0 < 4; ++d0) { v[d0] = o[d0][r] * rli[r] - X[row * 128 + d0 * 32 + r32]; ss += v[d0] * v[d0]; }
            ss += __shfl_xor(ss, 1); ss += __shfl_xor(ss, 2); ss += __shfl_xor(ss, 4); ss += __shfl_xor(ss, 8); ss += __shfl_xor(ss, 16);
            const float rstd = rsqrtf(ss * (1.f / 128.f) + EPS);
#pragma unroll
            for (int d0 = 0; d0 < 4; ++d0) Y[row * 128 + d0 * 32 + r32] = (bf16_t)(cvt_pk_bf16(v[d0] * rstd * sg[d0], 0.f) & 0xffffu); }
    }
    __syncthreads();
    { const int row = tid >> 2, seg = (tid & 3) * 32;
#pragma unroll
        for (int i = 0; i < 4; ++i) { const u32x4 v = *(const u32x4*)(Y + row * 128 + seg + i * 8); *(u32x4*)(MIXo + (size_t)row * DM + seg + i * 8) = v; } }
    __syncthreads();
}
#undef SBAR
}

__device__ __forceinline__ void p3_attention8(Frame& F) {
    FT_DECL;
    const float* sc = WSP(float, WS_SMALL + SM_SCAL);
    const float lam = sc[0];
    const unsigned char* Q8 = WSP(unsigned char, WS_Q); const unsigned char* K8 = WSP(unsigned char, WS_K); const unsigned char* VT8 = WSP(unsigned char, WS_V); bf16_t* MIX = WSP(bf16_t, WS_MIX);
    const int c = blockIdx.x, xcd = c & 7, ci = c >> 3, per = F.G >> 3;
    for (int j = ci; j < 128; j += per) {
        const int pair = xcd * 4 + (j >> 5), qb = j & 31, b = pair >> 2, h = pair & 3;
        att8::attn_unit(Q8 + ((size_t)b * SEQ + qb * 128) * QKW + h * 128, K8 + (size_t)b * KVL * QKW + h * 128, VT8 + (size_t)(b * NHEAD + h) * 68 * 8192,
                        MIX + ((size_t)b * SEQ + qb * 128) * DM + h * 128, lam, F.in[15], (char*)F.lds, F.wave);
    }
}

namespace hy {
constexpr int RB_BYTES = 4352 * 8, IN_OFF = 2 * RB_BYTES, TW1_OFF = IN_OFF + 32768, TW2_OFF = TW1_OFF + 15 * 256 * 8, LDS_END = TW2_OFF + 15 * 16 * 8;
__device__ __forceinline__ f32x2 cmul(f32x2 a, f32x2 b) { return (f32x2){a.x * b.x - a.y * b.y, a.x * b.y + a.y * b.x}; }
__device__ __forceinline__ f32x2 cmulc(f32x2 a, f32x2 b) { return (f32x2){a.x * b.x + a.y * b.y, a.y * b.x - a.x * b.y}; }
__device__ __forceinline__ int P(int i) { return i + (i >> 4); }
template <bool INV> __device__ __forceinline__ void r4(f32x2& a, f32x2& b, f32x2& c, f32x2& d) {
    const f32x2 t0 = a + c, t1 = a - c, t2 = b + d, t3 = b - d;
    const f32x2 st3 = INV ? (f32x2){-t3.y, t3.x} : (f32x2){t3.y, -t3.x};
    a = t0 + t2; c = t0 - t2; b = t1 + st3; d = t1 - st3;
}
template <bool INV> __device__ __forceinline__ f32x2 tw(f32x2 v, float c, float s) {
    return INV ? (f32x2){v.x * c - v.y * s, v.y * c + v.x * s} : (f32x2){v.x * c + v.y * s, v.y * c - v.x * s};
}
template <bool INV> __device__ __forceinline__ void dft16(f32x2 (&v)[16]) {
    constexpr float C1 = 0.9238795325112867f, S1 = 0.3826834323650898f, R2 = 0.7071067811865476f;
    r4<INV>(v[0], v[4], v[8], v[12]); r4<INV>(v[1], v[5], v[9], v[13]); r4<INV>(v[2], v[6], v[10], v[14]); r4<INV>(v[3], v[7], v[11], v[15]);
    v[5] = tw<INV>(v[5], C1, S1);  v[9] = tw<INV>(v[9], R2, R2);    v[13] = tw<INV>(v[13], S1, C1);
    v[6] = tw<INV>(v[6], R2, R2);  v[10] = tw<INV>(v[10], 0.f, 1.f); v[14] = tw<INV>(v[14], -R2, R2);
    v[7] = tw<INV>(v[7], S1, C1);  v[11] = tw<INV>(v[11], -R2, R2);  v[15] = tw<INV>(v[15], -C1, -S1);
    r4<INV>(v[0], v[1], v[2], v[3]); r4<INV>(v[4], v[5], v[6], v[7]); r4<INV>(v[8], v[9], v[10], v[11]); r4<INV>(v[12], v[13], v[14], v[15]);
    f32x2 t;
    t = v[1]; v[1] = v[4]; v[4] = t;   t = v[2]; v[2] = v[8]; v[8] = t;    t = v[3]; v[3] = v[12]; v[12] = t;
    t = v[6]; v[6] = v[9]; v[9] = t;   t = v[7]; v[7] = v[13]; v[13] = t;  t = v[11]; v[11] = v[14]; v[14] = t;
}
struct Ctx { LAS f32x2* R; LAS f32x2* IN; LAS f32x2* TW1; LAS f32x2* TW2; int t, half; f32x2 wt; };
#define HY_OPAQUE(x) asm volatile("" : "+v"(x))
#define HY_W32(m) (f32x2){__builtin_cosf(-0.19634954084936207f * (m)), __builtin_sinf(-0.19634954084936207f * (m))}
template <int MODE> __device__ __forceinline__ void pass1_fwd(const Ctx& X) {
    f32x2 v[16]; int t = X.t; HY_OPAQUE(t);
#pragma unroll
    for (int m = 0; m < 16; ++m) { f32x2 a = X.IN[t + 256 * m]; if (MODE == 1) a = (f32x2){X.half ? a.y : a.x, 0.f}; v[m] = a; }
    if (X.half) {
#pragma unroll
        for (int m = 0; m < 16; ++m) v[m] = cmul(cmul(v[m], HY_W32(m)), X.wt);
    }
    dft16<false>(v);
#pragma unroll
    for (int q = 1; q < 16; ++q) v[q] = cmul(v[q], X.TW1[(q - 1) * 256 + t]);
    const int pb = t + (t >> 4);
#pragma unroll
    for (int q = 0; q < 16; ++q) X.R[pb + 272 * q] = v[q];
}
__device__ __forceinline__ void pass2_fwd(const Ctx& X) {
    int t = X.t; HY_OPAQUE(t);
    const int n2 = t & 15, pb = (t >> 4) * 272 + n2; f32x2 v[16];
#pragma unroll
    for (int m = 0; m < 16; ++m) v[m] = X.R[pb + 17 * m];
    dft16<false>(v);
#pragma unroll
    for (int q = 1; q < 16; ++q) v[q] = cmul(v[q], X.TW2[(q - 1) * 16 + n2]);
#pragma unroll
    for (int q = 0; q < 16; ++q) X.R[pb + 17 * q] = v[q];
}
template <bool FILTER> __device__ __forceinline__ void pass3(const Ctx& X, f32x2 (&H)[16]) {
    f32x2 v[16]; int t = X.t; HY_OPAQUE(t); const int pb = 17 * t;
#pragma unroll
    for (int m = 0; m < 16; ++m) v[m] = X.R[pb + m];
    dft16<false>(v);
    if (FILTER) {
#pragma unroll
        for (int q = 0; q < 16; ++q) H[q] = v[q] * (1.f / 8192.f);
    } else {
#pragma unroll
        for (int q = 0; q < 16; ++q) v[q] = cmul(v[q], H[q]);
        dft16<true>(v);
#pragma unroll
        for (int m = 0; m < 16; ++m) X.R[pb + m] = v[m];
    }
}
__device__ __forceinline__ void pass2_inv(const Ctx& X) {
    int t = X.t; HY_OPAQUE(t);
    const int n2 = t & 15, pb = (t >> 4) * 272 + n2; f32x2 v[16];
    v[0] = X.R[pb];
#pragma unroll
    for (int q = 1; q < 16; ++q) v[q] = cmulc(X.R[pb + 17 * q], X.TW2[(q - 1) * 16 + n2]);
    dft16<true>(v);
#pragma unroll
    for (int m = 0; m < 16; ++m) X.R[pb + 17 * m] = v[m];
}
__device__ __forceinline__ void pass1_inv(const Ctx& X) {
    f32x2 v[16]; int t = X.t; HY_OPAQUE(t); const int pb = t + (t >> 4);
    v[0] = X.R[pb];
#pragma unroll
    for (int q = 1; q < 16; ++q) v[q] = cmulc(X.R[pb + 272 * q], X.TW1[(q - 1) * 256 + t]);
    dft16<true>(v);
    if (X.half) {
#pragma unroll
        for (int m = 0; m < 16; ++m) v[m] = cmulc(cmulc(v[m], HY_W32(m)), X.wt);
    }
#pragma unroll
    for (int m = 0; m < 16; ++m) X.R[pb + 272 * m] = v[m];
}
#define HY_WSYNC() asm volatile("s_waitcnt lgkmcnt(0)" ::: "memory")
__device__ __forceinline__ void conv_fft(const Ctx& X, f32x2 (&H)[16]) {
    __syncthreads(); pass1_fwd<0>(X); __syncthreads(); pass2_fwd(X); HY_WSYNC(); pass3<false>(X, H); HY_WSYNC(); pass2_inv(X); __syncthreads(); pass1_inv(X); __syncthreads();
}
constexpr int STG_OFF = LDS_END;
constexpr int LDS_END2 = STG_OFF + 2 * SEQ * 2;
static_assert(LDS_END2 <= LDSCTL_OFF, "hyena LDS map");
__device__ __forceinline__ float sconv_lds(const LAS bf16_t* stg, int bs, int n, float w0, float w1, float w2, float bias) {
    const LAS bf16_t* p = stg + bs * SEQ;
    const float c = bf2f(p[n]), lv = bf2f(p[n - ((n > 0) ? 1 : 0)]), rv = bf2f(p[n + ((n < SEQ - 1) ? 1 : 0)]);
    const float l = (n > 0) ? lv : 0.f, r = (n < SEQ - 1) ? rv : 0.f;
    return bias + w0 * l + w1 * c + w2 * r;
}
__device__ __forceinline__ void setup_tables(LAS unsigned char* lds, int tid) {
    LAS f32x2* TW1 = (LAS f32x2*)(lds + TW1_OFF); LAS f32x2* TW2 = (LAS f32x2*)(lds + TW2_OFF);
    for (int i = tid; i < 15 * 256; i += 512) { const int q = i / 256 + 1, t = i & 255; float s, c; sincosf(-6.283185307179586f * (float)((t * q) & 4095) * (1.f / 4096.f), &s, &c); TW1[i] = (f32x2){c, s}; }
    for (int i = tid; i < 15 * 16; i += 512) { const int q = i / 16 + 1, n2 = i & 15; float s, c; sincosf(-6.283185307179586f * (float)((n2 * q) & 255) * (1.f / 256.f), &s, &c); TW2[i] = (f32x2){c, s}; }
}
__device__ __forceinline__ void unit(Frame& F, int c) {
    FT_DECL;
    const int tid = f_tid; Ctx X; X.half = F.wave >> 2; X.t = tid & 255;
    X.R = (LAS f32x2*)(F.lds + X.half * RB_BYTES); X.IN = (LAS f32x2*)(F.lds + IN_OFF); X.TW1 = (LAS f32x2*)(F.lds + TW1_OFF); X.TW2 = (LAS f32x2*)(F.lds + TW2_OFF);
    { float s, cc; sincosf(-6.283185307179586f * (float)X.t * (1.f / 8192.f), &s, &cc); X.wt = (f32x2){cc, s}; }
    LAS f32x2* RB0 = (LAS f32x2*)(F.lds); LAS f32x2* RB1 = (LAS f32x2*)(F.lds + RB_BYTES);
    const float* FILT = WSP(float, WS_FILT);
    f32x2 H0[16], H1[16];
#pragma unroll
    for (int ord = 0; ord < 2; ++ord) {
        const float* hf = FILT + ((size_t)(ord * 2 + 0) * 512 + c) * SEQ; const float* hb = FILT + ((size_t)(ord * 2 + 1) * 512 + c) * SEQ;
        __syncthreads();
        int nb = tid; HY_OPAQUE(nb);
#pragma unroll
        for (int j = 0; j < 8; ++j) { const int n = nb + 512 * j; const float a = hf[n], b = hb[(SEQ - n) & (SEQ - 1)]; const float lo = (n == 0) ? a + b : a, hi = (n == 0) ? 0.f : b; X.IN[n] = (f32x2){lo + hi, lo - hi}; }
        __syncthreads(); pass1_fwd<1>(X); __syncthreads(); pass2_fwd(X); HY_WSYNC();
        if (ord == 0) pass3<true>(X, H0); else pass3<true>(X, H1);
    }
    const bf16_t* UT = WSP(bf16_t, WS_UT);
    const bf16_t* rv = UT + (size_t)c * 128; const bf16_t* r1 = UT + (size_t)(512 + c) * 128; const bf16_t* r2 = UT + (size_t)(1024 + c) * 128;
#define HY_LD(rowp, t) (*(const u32x4*)((rowp) + (size_t)((t) >> 7) * (HYC * 128) + ((t) & 127)))
    const float* cw = F.in[16]; const float* cb = F.in[17];
    const float wv0 = cw[c], wv1 = cw[HYC + c], wv2 = cw[2 * HYC + c], bv = cb[c];
    const float wa0 = cw[512 + c], wa1 = cw[HYC + 512 + c], wa2 = cw[2 * HYC + 512 + c], ba = cb[512 + c];
    const float wb0 = cw[1024 + c], wb1 = cw[HYC + 1024 + c], wb2 = cw[2 * HYC + 1024 + c], bb = cb[1024 + c];
    const float sk0 = F.in[25][c], sk1 = F.in[25][512 + c];
    bf16_t* Z = WSP(bf16_t, WS_Z2T) + (size_t)c * 128;
    LAS bf16_t* STG = (LAS bf16_t*)(F.lds + STG_OFF);
    u32x4 g0 = HY_LD(rv, tid * 8), g1 = HY_LD(rv, SEQ + tid * 8);
    for (int pr = 0; pr < 4; ++pr) {
        const int b0 = 2 * pr, b1 = b0 + 1;
        f32x2 z[8]; int pc = tid + (tid >> 4); HY_OPAQUE(pc); int nb = tid; HY_OPAQUE(nb);
        __syncthreads();
        *(LAS u32x4*)(STG + tid * 8) = g0; *(LAS u32x4*)(STG + SEQ + tid * 8) = g1;
        __syncthreads();
#pragma unroll
        for (int j = 0; j < 8; ++j) { const int n = nb + 512 * j; z[j] = (f32x2){sconv_lds(STG, 0, n, wv0, wv1, wv2, bv), sconv_lds(STG, 1, n, wv0, wv1, wv2, bv)}; X.IN[n] = z[j]; }
        g0 = HY_LD(r1, b0 * SEQ + tid * 8); g1 = HY_LD(r1, b1 * SEQ + tid * 8);
        conv_fft(X, H0);
        *(LAS u32x4*)(STG + tid * 8) = g0; *(LAS u32x4*)(STG + SEQ + tid * 8) = g1;
        __syncthreads();
        HY_OPAQUE(nb); HY_OPAQUE(pc);
#pragma unroll
        for (int j = 0; j < 8; ++j) { const int n = nb + 512 * j; const f32x2 y = RB0[pc + 544 * j] + RB1[pc + 544 * j];
            const f32x2 g = (f32x2){sconv_lds(STG, 0, n, wa0, wa1, wa2, ba), sconv_lds(STG, 1, n, wa0, wa1, wa2, ba)};
            z[j] = g * (y + sk0 * z[j]); X.IN[n] = z[j]; }
        g0 = HY_LD(r2, b0 * SEQ + tid * 8); g1 = HY_LD(r2, b1 * SEQ + tid * 8);
        conv_fft(X, H1);
        *(LAS u32x4*)(STG + tid * 8) = g0; *(LAS u32x4*)(STG + SEQ + tid * 8) = g1;
        __syncthreads();
        if (pr < 3) { g0 = HY_LD(rv, (b0 + 2) * SEQ + tid * 8); g1 = HY_LD(rv, (b1 + 2) * SEQ + tid * 8); }
        HY_OPAQUE(nb); HY_OPAQUE(pc);
        f32x2 o[8];
#pragma unroll
        for (int j = 0; j < 8; ++j) { const int n = nb + 512 * j; const f32x2 y = RB0[pc + 544 * j] + RB1[pc + 544 * j];
            const f32x2 g = (f32x2){sconv_lds(STG, 0, n, wb0, wb1, wb2, bb), sconv_lds(STG, 1, n, wb0, wb1, wb2, bb)};
            o[j] = g * (y + sk1 * z[j]); }
        __syncthreads();
#pragma unroll
        for (int j = 0; j < 8; ++j) { const int n = nb + 512 * j; STG[n] = (bf16_t)(cvt_pk_bf16(o[j].x, 0.f) & 0xffffu); STG[SEQ + n] = (bf16_t)(cvt_pk_bf16(o[j].y, 0.f) & 0xffffu); }
        __syncthreads();
        { const int t0 = b0 * SEQ + tid * 8, t1 = b1 * SEQ + tid * 8;
          *(u32x4*)(Z + (size_t)(t0 >> 7) * (HYW * 128) + (t0 & 127)) = *(const LAS u32x4*)(STG + tid * 8); *(u32x4*)(Z + (size_t)(t1 >> 7) * (HYW * 128) + (t1 & 127)) = *(const LAS u32x4*)(STG + SEQ + tid * 8); }
    }
    __syncthreads();
}
}

__device__ __forceinline__ void p3_hyena(Frame& F) {
    FT_DECL;
    __syncthreads();
    hy::setup_tables(F.lds, f_tid);
    __syncthreads();
    for (int c = F.vcu; c < HYW; c += F.G) hy::unit(F, c);
}

__device__ __forceinline__ void p4_hynorm(Frame& F) {
    FT_DECL;
    const bf16_t* Z = WSP(bf16_t, WS_Z2T); bf16_t* MIX = WSP(bf16_t, WS_MIX); const float* g = F.in[26];
    constexpr int TP = 132;
    LAS bf16_t* T = (LAS bf16_t*)F.lds;
    LAS float* red = (LAS float*)(F.lds + 512 * TP * 2);
    LAS float* rs = red + 512;
    float gl[8];
#pragma unroll
    for (int e = 0; e < 8; ++e) gl[e] = g[(f_tid & 63) + 64 * e];
    for (int it = F.vcu; it < MROWS / 128; it += F.G) {
        const int tok0 = it * 128; const bf16_t* zt = Z + (size_t)it * (HYW * 128);
        __syncthreads();
        u32x4 v[16];
#pragma unroll
        for (int j = 0; j < 16; ++j) v[j] = __builtin_nontemporal_load((const u32x4*)(zt + (size_t)(f_tid + 512 * j) * 8));
#pragma unroll
        for (int j = 0; j < 16; ++j) { const int i = f_tid + 512 * j; LAS u32x2* d = (LAS u32x2*)(T + (i >> 4) * TP + (i & 15) * 8); d[0] = (u32x2){v[j].x, v[j].y}; d[1] = (u32x2){v[j].z, v[j].w}; }
        __syncthreads();
        { const int tok = f_tid & 127, grp = f_tid >> 7; float ss = 0.f;
#pragma unroll 8
            for (int k = 0; k < 128; ++k) { const float x = bf2f(T[(grp * 128 + k) * TP + tok]); ss += x * x; }
            red[grp * 128 + tok] = ss; }
        __syncthreads();
        if (f_tid < 128) rs[f_tid] = rsqrtf(((red[f_tid] + red[128 + f_tid]) + (red[256 + f_tid] + red[384 + f_tid])) * (1.f / HYW) + EPS);
        __syncthreads();
#pragma unroll
        for (int j = 0; j < 16; ++j) { const int i = f_tid + 512 * j, tok = i >> 6, l = i & 63; const float r = rs[tok];
            float x[8];
#pragma unroll
            for (int e = 0; e < 8; ++e) x[e] = bf2f(T[(l + 64 * e) * TP + tok]) * r * gl[e];
            u32x4 w; w.x = cvt_pk_bf16(x[0], x[1]); w.y = cvt_pk_bf16(x[2], x[3]); w.z = cvt_pk_bf16(x[4], x[5]); w.w = cvt_pk_bf16(x[6], x[7]);
            *(u32x4*)(MIX + (size_t)(tok0 + tok) * DM + 512 + 8 * l) = w; }
    }
}

constexpr size_t RT_TOPI = 0;
constexpr size_t RT_GATE = 512 * 1024;
constexpr size_t RT_POS = 1024 * 1024;
constexpr size_t RT_WGCNT = 1536 * 1024;
constexpr size_t RT_META = 1600 * 1024;
constexpr size_t RT_LIST = 2048 * 1024;
constexpr size_t RT_GSLOT = 2048 * 1024 + 640 * 1024;
constexpr int MAXSLOT = MROWS * TOPK + NEXP * 256;
constexpr int MAXTILE = MAXSLOT / 256;
constexpr size_t WS_XS = WS_EO;
constexpr int RW_PITCH = 32;
constexpr int P6_LDS_TOPI = 1024 * RW_PITCH * 4;

__device__ __forceinline__ void p6_router_mfma(Frame& F) {
    FT_DECL;
#define in F.in
    LAS float* WP = (LAS float*)F.lds;
    LAS int* TI = (LAS int*)(F.lds + P6_LDS_TOPI);
    LAS int* PS = TI + 512;
    LAS int* SC = PS + 512;
    LAS float* RSTD = (LAS float*)(SC + 512);
    LAS float* BIAS = RSTD + 128;
    LAS float* SSX = BIAS + 32;
    const float* rw = in[28]; const float* mod = WSP(float, WS_SMALL + SM_MOD); const float* g2n = in[7]; const float* rb = in[29];
    const bf16_t* XN = WSP(bf16_t, WS_XN); unsigned char* H2 = WSP(unsigned char, WS_H);
    int* topi_g = WSP(int, WS_ROUTE + RT_TOPI); float* gate_g = WSP(float, WS_ROUTE + RT_GATE); int* pos_g = WSP(int, WS_ROUTE + RT_POS); int* wgcnt = WSP(int, WS_ROUTE + RT_WGCNT);
    for (int blk = blockIdx.x; blk < MROWS / 128; blk += F.G) {
        const float* sh2 = mod + (size_t)(blk >> 5) * (NMOD * DM) + 3 * DM; const float* sc2 = sh2 + DM;
        __syncthreads();
#pragma unroll 1
        for (int hb = 0; hb < 2; ++hb) { f32x4 wv[8]; float gm[8];
#pragma unroll
            for (int q = 0; q < 8; ++q) { const int i = f_tid + 512 * (8 * hb + q), k = i >> 3, c4 = i & 7; wv[q] = *(const f32x4*)(rw + (size_t)k * 32 + c4 * 4); gm[q] = g2n[k] * (1.f + sc2[k]); }
#pragma unroll
            for (int q = 0; q < 8; ++q) { const int i = f_tid + 512 * (8 * hb + q), k = i >> 3, c4 = i & 7; *(LAS f32x4*)(WP + k * 32 + c4 * 4) = wv[q] * gm[q]; } }
        { const int e = f_tid & 31, part = f_tid >> 5; float a = 0.f;
#pragma unroll 1
            for (int k0 = part * 64; k0 < part * 64 + 64; k0 += 8) { float w[8], sh[8];
#pragma unroll
                for (int q = 0; q < 8; ++q) { w[q] = rw[(size_t)(k0 + q) * 32 + e]; sh[q] = sh2[k0 + q]; }
#pragma unroll
                for (int q = 0; q < 8; ++q) a += sh[q] * w[q]; }
            ((LAS float*)SC)[part * 32 + e] = a; }
        __syncthreads();
        if (f_tid < 32) { float a = rb[f_tid];
#pragma unroll
            for (int p = 0; p < 16; ++p) a += ((LAS float*)SC)[p * 32 + f_tid];
            BIAS[f_tid] = a; }
        const int rg = F.wave & 3, kh = F.wave >> 2, j = f_lane & 31, hi = f_lane >> 5;
        f32x16 acc = {};
        float ss = 0.f;
        { const bf16_t* xrow = XN + (size_t)(blk * 128 + rg * 32 + j) * DM + 512 * kh + 8 * hi;
            const LAS float* wp = WP + (512 * kh + 8 * hi) * 32 + j;
#pragma unroll 8
            for (int c = 0; c < 32; ++c) { const u32x4 xb = *(const u32x4*)(xrow + 16 * c);
                float xf[8] = {__uint_as_float(xb.x << 16), __uint_as_float(xb.x & 0xffff0000u), __uint_as_float(xb.y << 16), __uint_as_float(xb.y & 0xffff0000u),
                               __uint_as_float(xb.z << 16), __uint_as_float(xb.z & 0xffff0000u), __uint_as_float(xb.w << 16), __uint_as_float(xb.w & 0xffff0000u)};
#pragma unroll
                for (int q = 0; q < 8; ++q) { ss += xf[q] * xf[q]; acc = __builtin_amdgcn_mfma_f32_32x32x2f32(wp[(16 * c + q) * 32], xf[q], acc, 0, 0, 0); } } }
        { auto rr = __builtin_amdgcn_permlane32_swap(__float_as_uint(ss), __float_as_uint(ss), false, false); ss = __uint_as_float(rr[0]) + __uint_as_float(rr[1]); }
        if (hi == 0) SSX[kh * 128 + rg * 32 + j] = ss;
        __syncthreads();
        if (kh == 1) {
#pragma unroll
            for (int r = 0; r < 16; ++r) WP[(rg * 16 + r) * 64 + f_lane] = acc[r]; }
        if (f_tid < 128) RSTD[f_tid] = rsqrtf((SSX[f_tid] + SSX[128 + f_tid]) * (1.f / DM) + EPS);
        __syncthreads();
        if (kh == 0) {
            const float rstd = RSTD[rg * 32 + j];
            float tv[4] = {-INFINITY, -INFINITY, -INFINITY, -INFINITY}; int ti[4] = {1 << 20, 1 << 20, 1 << 20, 1 << 20};
#define P6_INS(V, E) do { float cv = (V); int ce = (E); _Pragma("unroll") for (int q = 0; q < 4; ++q) { const bool b = cv > tv[q] || (cv == tv[q] && ce < ti[q]); \
                const float nv = b ? tv[q] : cv; const int ne = b ? ti[q] : ce; tv[q] = b ? cv : tv[q]; ti[q] = b ? ce : ti[q]; cv = nv; ce = ne; } } while (0)
#pragma unroll
            for (int r = 0; r < 16; ++r) { const int e = (r & 3) + 8 * (r >> 2) + 4 * hi; const float v = (acc[r] + WP[(rg * 16 + r) * 64 + f_lane]) * rstd + BIAS[e]; P6_INS(v, e); }
            float ov[4]; int oe[4];
#pragma unroll
            for (int q = 0; q < 4; ++q) { ov[q] = __shfl_xor(tv[q], 32); oe[q] = __shfl_xor(ti[q], 32); }
#pragma unroll
            for (int q = 0; q < 4; ++q) P6_INS(ov[q], oe[q]);
#undef P6_INS
            if (hi == 0) { const int rl = rg * 32 + j, r = blk * 128 + rl;
                const float e1 = __expf(tv[1] - tv[0]), e2 = __expf(tv[2] - tv[0]), e3 = __expf(tv[3] - tv[0]); const float inv = 1.f / (1.f + e1 + e2 + e3);
                typedef int i32x4_t __attribute__((ext_vector_type(4))); const i32x4_t t4 = {ti[0], ti[1], ti[2], ti[3]};
                *(i32x4_t*)(topi_g + (size_t)r * 4) = t4; *(f32x4*)(gate_g + (size_t)r * 4) = (f32x4){inv, e1 * inv, e2 * inv, e3 * inv};
                *(LAS i32x4_t*)(TI + rl * 4) = t4; }
        }
        __syncthreads();
        { const int t2 = F.wave * 64 + lane_id(); const int e = t2 & 31, seg = t2 >> 5; int cnt = 0;
#pragma unroll 4
            for (int i = 0; i < 32; ++i) cnt += (TI[seg * 32 + i] == e) ? 1 : 0;
            SC[seg * 32 + e] = cnt;
            __syncthreads();
            int pre = 0;
            for (int s2 = 0; s2 < seg; ++s2) pre += SC[s2 * 32 + e];
            if (seg == 15) wgcnt[blk * 32 + e] = pre + cnt;
            for (int i = 0; i < 32; ++i) if (TI[seg * 32 + i] == e) { PS[seg * 32 + i] = pre; ++pre; }
        }
        __syncthreads();
        { const int t3 = F.wave * 64 + lane_id(); pos_g[(size_t)blk * 512 + t3] = PS[t3]; }
        { const int lane = lane_id();
            f32x4 PA[4], PB[4];
#pragma unroll
            for (int jj = 0; jj < 4; ++jj) { const int c = 4 * lane + 256 * jj; PA[jj] = *(const f32x4*)(g2n + c) * (*(const f32x4*)(sc2 + c) + 1.f); PB[jj] = *(const f32x4*)(sh2 + c); }
            for (int it = 0; it < 4; ++it) { u32x2 xb[4][4];
#pragma unroll
                for (int u = 0; u < 4; ++u) { const GAS u32x2* xr = (const GAS u32x2*)(XN + (size_t)(blk * 128 + F.wave * 16 + 4 * it + u) * DM) + lane;
#pragma unroll
                    for (int jj = 0; jj < 4; ++jj) xb[u][jj] = xr[64 * jj]; }
#pragma unroll
                for (int u = 0; u < 4; ++u) { const int rl = F.wave * 16 + 4 * it + u; const float rstd = RSTD[rl];
                    GAS unsigned* o4 = (GAS unsigned*)(H2 + (size_t)(blk * 128 + rl) * DM) + lane;
#pragma unroll
                    for (int jj = 0; jj < 4; ++jj) {
                        const f32x4 x = (f32x4){__uint_as_float(xb[u][jj].x << 16), __uint_as_float(xb[u][jj].x & 0xffff0000u), __uint_as_float(xb[u][jj].y << 16), __uint_as_float(xb[u][jj].y & 0xffff0000u)};
                        const f32x4 h = x * rstd * PA[jj] + PB[jj];
                        o4[64 * jj] = pk4_fp8(h.x, h.y, h.z, h.w); } } }
        }
    }
#undef in
}

__device__ __forceinline__ void p7_scatter(Frame& F) {
    FT_DECL;
    LAS int* TOT = (LAS int*)F.lds;
    LAS int* BASE = TOT + 32;
    LAS int* PRE = BASE + 32;
    LAS int* PART = PRE + 32;
    const int* wgcnt = WSP(int, WS_ROUTE + RT_WGCNT); const int* topi_g = WSP(int, WS_ROUTE + RT_TOPI); const float* gate_g = WSP(float, WS_ROUTE + RT_GATE); const int* pos_g = WSP(int, WS_ROUTE + RT_POS);
    int* list = WSP(int, WS_ROUTE + RT_LIST); float* gslot = WSP(float, WS_ROUTE + RT_GSLOT); int* meta = WSP(int, WS_ROUTE + RT_META);
    for (int blk = blockIdx.x; blk < MROWS / 128; blk += F.G) {
        __syncthreads();
        { const int e = f_tid & 31, part = f_tid >> 5; int st = 0, sp = 0;
            for (int w = part * 16; w < part * 16 + 16; ++w) { const int c = wgcnt[w * 32 + e]; st += c; if (w < blk) sp += c; }
            PART[part * 32 + e] = st; PART[512 + part * 32 + e] = sp; }
        __syncthreads();
        if (f_tid < 32) { int st = 0, sp = 0;
#pragma unroll
            for (int p = 0; p < 16; ++p) { st += PART[p * 32 + f_tid]; sp += PART[512 + p * 32 + f_tid]; }
            TOT[f_tid] = st; PRE[f_tid] = sp; }
        __syncthreads();
        if (f_tid == 0) { int b = 0; for (int e = 0; e < 32; ++e) { BASE[e] = b; b += (TOT[e] + 255) & ~255; }
            if (blk == 0) { int t = 0; for (int e = 0; e < 32; ++e) { meta[e] = TOT[e]; meta[32 + e] = BASE[e]; const int nt = (TOT[e] + 255) >> 8; for (int q = 0; q < nt; ++q) meta[128 + t + q] = e; t += nt; } meta[64] = t; } }
        __syncthreads();
        { const int a = f_tid, row = blk * 128 + (a >> 2); const int e = topi_g[(size_t)blk * 512 + a]; const int slot = BASE[e] + PRE[e] + pos_g[(size_t)blk * 512 + a];
            list[slot] = row * 4 + (a & 3); gslot[slot] = gate_g[(size_t)blk * 512 + a];
            PART[a] = slot; }
        __syncthreads();
        if (blk < NEXP) { const int e = blk, lo = BASE[e] + TOT[e], hi = BASE[e] + ((TOT[e] + 255) & ~255);
            for (int sl = lo + f_tid; sl < hi; sl += 512) { list[sl] = -1; gslot[sl] = 0.f; } }
    }
}

template <int NPN> struct SchedMoE {
    int G, c, nT; const char* A; const char* W; size_t wstride; const LAS unsigned char* tileE; const LAS int* RW; bool gath;
    __device__ __forceinline__ const LAS int* rows(int i) const { return RW + i * 256; }
    __device__ __forceinline__ bool next(int i, g8::Unit& u) const {
        const int L = i * G + c, xcd = L & 7, j = L >> 3, nTx = (nT + 7) >> 3, tl = j / NPN, T = xcd * nTx + tl, pn = j % NPN;
        if (tl >= nTx || T >= nT) return false;
        const int e = tileE[T];
        u.pm = T; u.pn = pn; u.kind = i; u.ex = e; u.a = gath ? A : A + (size_t)T * 256 * DM; u.b = W + (size_t)e * wstride + (size_t)pn * 256 * DM; return true;
    }
};
struct EpiSwiGLU {
    unsigned char* ACT; const float* b1;
    __device__ __forceinline__ void operator()(f32x4 (&acc)[2][2][4][2], const g8::Unit& u, int wr, int wc, int fr, int fq) const {
        asm volatile("" : "+v"(fr), "+v"(fq));
        const int j0 = u.pn * 128 + wc * 32 + 8 * fq; const float* bp = b1 + (size_t)u.ex * 2 * DM + j0;
        f32x4 bg[2], bl[2];
#pragma unroll
        for (int n = 0; n < 2; ++n) { bg[n] = *(const f32x4*)(bp + 4 * n); bl[n] = *(const f32x4*)(bp + DM + 4 * n); }
#pragma unroll
        for (int ai = 0; ai < 2; ++ai)
#pragma unroll
            for (int m = 0; m < 4; ++m) { const size_t slot = (size_t)u.pm * 256 + ai * 128 + wr * 64 + m * 16 + fr; float o[8];
#pragma unroll
                for (int n = 0; n < 2; ++n) { const f32x4 g4 = acc[ai][0][m][n] * (1.f / WSCALE) + bg[n], l4 = acc[ai][1][m][n] * (1.f / WSCALE) + bl[n];
#pragma unroll
                    for (int e = 0; e < 4; ++e) { const float g = fminf(g4[e], 7.f), l = __builtin_amdgcn_fmed3f(l4[e], -7.f, 7.f);
                        const float ex = __builtin_amdgcn_exp2f(g * (-1.702f * 1.4426950408889634f)); const float glu = g * __builtin_amdgcn_rcpf(1.f + ex);
                        o[4 * n + e] = fmaf(l, glu, glu); } }
                u32x2 w; w.x = pk4_fp8(o[0], o[1], o[2], o[3]); w.y = pk4_fp8(o[4], o[5], o[6], o[7]);
                *(u32x2*)(ACT + slot * DM + j0) = w; }
    }
};
struct EpiDown {
    unsigned char* EO; const float* b2; const LAS int* LL; int G, c;
    __device__ __forceinline__ void operator()(f32x4 (&acc)[2][2][4][2], const g8::Unit& u, int wr, int wc, int fr, int fq) const {
        asm volatile("" : "+v"(fr), "+v"(fq));
        const int c0 = u.pn * 256 + wc * 64 + 16 * fq; const float* bp = b2 + (size_t)u.ex * DM + c0;
        f32x4 bb[2][2];
#pragma unroll
        for (int bj = 0; bj < 2; ++bj)
#pragma unroll
            for (int n = 0; n < 2; ++n) bb[bj][n] = *(const f32x4*)(bp + bj * 8 + 4 * n);
        const LAS int* L = LL + u.kind * 512;
        int li[8]; float gt[8];
#pragma unroll
        for (int q = 0; q < 8; ++q) { const int rl = (q >> 2) * 128 + wr * 64 + (q & 3) * 16 + fr; li[q] = L[rl]; gt[q] = __int_as_float(L[256 + rl]) * (1.f / WSCALE); }
#pragma unroll
        for (int ai = 0; ai < 2; ++ai)
#pragma unroll
            for (int m = 0; m < 4; ++m) { const int l = li[ai * 4 + m]; const float g = gt[ai * 4 + m];
                unsigned char* dst = EO + ((size_t)(l & 3) * MROWS + (l >> 2)) * DM + c0;
                u32x4 w;
                { const f32x4 v0 = acc[ai][0][m][0] * g + bb[0][0] * (g * WSCALE), v1 = acc[ai][0][m][1] * g + bb[0][1] * (g * WSCALE);
                  w.x = pk4_fp8(v0[0] * EOSCALE, v0[1] * EOSCALE, v0[2] * EOSCALE, v0[3] * EOSCALE); w.y = pk4_fp8(v1[0] * EOSCALE, v1[1] * EOSCALE, v1[2] * EOSCALE, v1[3] * EOSCALE); }
                { const f32x4 v0 = acc[ai][1][m][0] * g + bb[1][0] * (g * WSCALE), v1 = acc[ai][1][m][1] * g + bb[1][1] * (g * WSCALE);
                  w.z = pk4_fp8(v0[0] * EOSCALE, v0[1] * EOSCALE, v0[2] * EOSCALE, v0[3] * EOSCALE); w.w = pk4_fp8(v1[0] * EOSCALE, v1[1] * EOSCALE, v1[2] * EOSCALE, v1[3] * EOSCALE); }
                if (l >= 0) *(u32x4*)dst = w; }
    }
};
__device__ __forceinline__ const LAS unsigned char* moe_tiles(Frame& F, int& nT) {
    FT_DECL;
    LAS unsigned char* TE = (LAS unsigned char*)(F.lds + RING_BYTES); const int* meta = WSP(int, WS_ROUTE + RT_META);
    __syncthreads();
    nT = meta[64]; if (nT > MAXTILE) nT = MAXTILE;
    for (int i = f_tid; i < MAXTILE; i += 512) TE[i] = (unsigned char)((i < nT) ? meta[128 + i] : 0);
    __syncthreads();
    return (const LAS unsigned char*)TE;
}

__device__ __forceinline__ void p10_combine(Frame& F) {
    FT_DECL;
    const float* mod = WSP(float, WS_SMALL + SM_MOD); const unsigned char* EO = WSP(unsigned char, WS_EO);
    const size_t gt = (size_t)F.vcu * 512 + f_tid, NTH = (size_t)F.G * 512;
    constexpr int U = 4;
    for (size_t i0 = gt; i0 < (size_t)MROWS * 128; i0 += NTH * U) {
        u32x2 ev[U][4]; f32x4 xv[U][2], gv[U][2];
#pragma unroll
        for (int u = 0; u < U; ++u) { const size_t i = i0 + (size_t)u * NTH; const size_t row = i >> 7; const int c0 = (int)(i & 127) * 8;
            const float* g2 = mod + (size_t)(row >> 12) * (NMOD * DM) + 5 * DM + c0; const bf16_t* op = WSP(bf16_t, WS_XN) + row * DM + c0;
#pragma unroll
            for (int k = 0; k < 4; ++k) ev[u][k] = __builtin_nontemporal_load((const u32x2*)(EO + ((size_t)k * MROWS + row) * DM + c0));
            { const u32x4 xb = *(const u32x4*)op; xv[u][0] = (f32x4){__uint_as_float(xb.x << 16), __uint_as_float(xb.x & 0xffff0000u), __uint_as_float(xb.y << 16), __uint_as_float(xb.y & 0xffff0000u)};
              xv[u][1] = (f32x4){__uint_as_float(xb.z << 16), __uint_as_float(xb.z & 0xffff0000u), __uint_as_float(xb.w << 16), __uint_as_float(xb.w & 0xffff0000u)}; }
            gv[u][0] = *(const f32x4*)g2; gv[u][1] = *(const f32x4*)(g2 + 4); }
#pragma unroll
        for (int u = 0; u < U; ++u) { const size_t i = i0 + (size_t)u * NTH; const size_t row = i >> 7; const int c0 = (int)(i & 127) * 8;
            float s[8];
#pragma unroll
            for (int e = 0; e < 8; ++e) s[e] = 0.f;
#pragma unroll
            for (int k = 0; k < 4; ++k) { const u32x2 v = ev[u][k];
                const f32x2 a = __builtin_amdgcn_cvt_pk_f32_fp8((int)v.x, false), b = __builtin_amdgcn_cvt_pk_f32_fp8((int)v.x, true), c = __builtin_amdgcn_cvt_pk_f32_fp8((int)v.y, false), d = __builtin_amdgcn_cvt_pk_f32_fp8((int)v.y, true);
                s[0] += a.x; s[1] += a.y; s[2] += b.x; s[3] += b.y; s[4] += c.x; s[5] += c.y; s[6] += d.x; s[7] += d.y; }
#pragma unroll
            for (int e = 0; e < 8; ++e) s[e] *= (1.f / EOSCALE);
            f32x4 o0 = xv[u][0] + gv[u][0] * (f32x4){s[0], s[1], s[2], s[3]}, o1 = xv[u][1] + gv[u][1] * (f32x4){s[4], s[5], s[6], s[7]};
            float* op = F.out + row * DM + c0;
            __builtin_nontemporal_store(o0, (f32x4*)op); __builtin_nontemporal_store(o1, (f32x4*)(op + 4)); }
    }
}

struct Args { const float* in[34]; float* out; unsigned char* ws; int ph_lo, ph_hi; };
constexpr int N_PHASES = 11;

__global__ void __launch_bounds__(512, 2) mega(Args args) {
    extern __shared__ __attribute__((aligned(16))) unsigned char lds[];
    Frame F;
    F.lds = (LAS unsigned char*)lds;
    F.MISC = (volatile LAS unsigned*)(F.lds + LDSCTL_OFF);
    F.wave = __builtin_amdgcn_readfirstlane(threadIdx.x >> 6);
    FT_DECL;
    F.G = gridDim.x; { const int bx = blockIdx.x; F.vcu = (F.G % 8 == 0) ? (bx % 8) * (F.G / 8) + bx / 8 : bx; }
    F.in = (kin_t)__builtin_amdgcn_kernarg_segment_ptr();
    F.out = args.out; F.ws = args.ws;
    F.ctl = (gu32*)(args.ws + WS_CTL);
    for (int u = f_tid; u < (LDS_BYTES - LDSCTL_OFF) / 4; u += NWAVES * 64) ((LAS unsigned*)(F.lds + LDSCTL_OFF))[u] = 0u;
    __syncthreads();
    const int lo = args.ph_lo, hi = args.ph_hi;
    XcdBarrier bar; bar.bar = (unsigned*)(F.ctl + CW_BAR); bar.x = 0; bar.st = nullptr;
    if (hi - lo > 1) bar = xcd_barrier_post((unsigned*)(F.ctl + CW_BAR), F.MISC + 8, f_tid == 0);
#define IN(k) (lo <= (k) && (k) < hi)
#define SEAM(k) do { if (IN(k) && IN((k) + 1)) xcd_barrier(bar, F.wave == 0 && lane_id() == 0); } while (0)

    if (IN(0)) { p0_prologue(F); } SEAM(0);
    if (IN(1)) { p1_norm1(F); } SEAM(1);
    if (IN(2)) {
        SchedInProj S{F.G, (int)blockIdx.x, (const char*)WSP(bf16_t, WS_H), (const char*)WSP(bf16_t, WS_WIN)};
        EpiInProj E{WSP(unsigned char, WS_Q), WSP(unsigned char, WS_K), WSP(unsigned char, WS_V), WSP(bf16_t, WS_UT), F.in[9], F.in[10], WSP(float, WS_SMALL + SM_ROPE)};
        g8::gemm_phase<false>(F.lds, DM, S, E, F.wave, lane_id());
    } SEAM(2);
    if (IN(3)) { p3_attention8(F); p3_hyena(F); } SEAM(3);
    if (IN(4)) { p4_hynorm(F); } SEAM(4);
    if (IN(5)) {
        SchedStatic S{F.G, (int)blockIdx.x, MROWS / 256, DM / 256, (const char*)WSP(bf16_t, WS_MIX), (const char*)WSP(bf16_t, WS_WOUT)};
        EpiOutProj E{F.in[0], WSP(bf16_t, WS_XN), WSP(float, WS_SMALL + SM_MOD)};
        g8::gemm_phase<false>(F.lds, DM, S, E, F.wave, lane_id());
    } SEAM(5);
    if (IN(6)) { p6_router_mfma(F); } SEAM(6);
    if (IN(7)) { p7_scatter(F); } SEAM(7);
    if (IN(8)) {
        int nT; const LAS unsigned char* TE = moe_tiles(F, nT);
        LAS int* RWL = (LAS int*)(F.lds + RING_BYTES + 1024);
        static_assert(RING_BYTES + 1024 + 17 * 1024 <= LDSCTL_OFF, "LDS map");
        SchedMoE<8> S{F.G, (int)blockIdx.x, nT, (const char*)WSP(char, WS_H), (const char*)WSP(char, WS_W1), (size_t)2 * DM * DM, TE, RWL, true};
        { const int* list = WSP(int, WS_ROUTE + RT_LIST); const int t8 = F.wave * 64 + lane_id();
            g8::Unit u; for (int i = 0; i < 17 && S.next(i, u); i += 2) { const int ii = i + (t8 >> 8); g8::Unit u2; if (S.next(ii, u2)) { const int li = list[(size_t)u2.pm * 256 + (t8 & 255)]; RWL[ii * 256 + (t8 & 255)] = (li >= 0) ? (li >> 2) : 0; } }
            __syncthreads(); }
        EpiSwiGLU E{WSP(unsigned char, WS_ACT), F.in[31]};
        g8::gemm_phase_g<true, true>(F.lds, DM, S, E, F.wave, lane_id());
    } SEAM(8);
    if (IN(9)) {
        int nT; const LAS unsigned char* TE = moe_tiles(F, nT);
        SchedMoE<4> S{F.G, (int)blockIdx.x, nT, (const char*)WSP(char, WS_ACT), (const char*)WSP(char, WS_W2), (size_t)DM * DM, TE, nullptr, false};
        LAS int* LL = (LAS int*)(F.lds + RING_BYTES + 1024);
        static_assert(RING_BYTES + 1024 + 9 * 2048 <= LDSCTL_OFF, "LDS map");
        { const int* list = WSP(int, WS_ROUTE + RT_LIST); const float* gslot = WSP(float, WS_ROUTE + RT_GSLOT);
            const int t9 = F.wave * 64 + lane_id();
            g8::Unit u; for (int i = 0; i < 9 && S.next(i, u); ++i) { const int t = t9 & 255; const size_t slot = (size_t)u.pm * 256 + t;
                LL[i * 512 + (t9 >> 8) * 256 + t] = (t9 < 256) ? list[slot] : __float_as_int(gslot[slot]); }
            __syncthreads(); }
        EpiDown E{WSP(unsigned char, WS_EO), F.in[33], LL, F.G, (int)blockIdx.x};
        g8::gemm_phase<true>(F.lds, DM, S, E, F.wave, lane_id());
    } SEAM(9);
    if (IN(10)) { p10_combine(F); }
#undef IN
#undef SEAM
}

extern "C" void kernel_launch(void* const* d_in, const int* in_sizes, int n_in, void* d_out, int out_size, void* d_ws, size_t ws_size, hipStream_t stream) {
    static int grid = 0;
    if (grid == 0) {
        if (n_in != 34 || out_size != MROWS * DM || ws_size < WS_END) { fprintf(stderr, "kernel_launch: unexpected shapes: n_in %d out %d ws %zu (need %zu)\n", n_in, out_size, ws_size, (size_t)WS_END); grid = -1; return; }
        int dev = 0, cus = 0, per_cu = 0;
        if (hipGetDevice(&dev) != hipSuccess || hipDeviceGetAttribute(&cus, hipDeviceAttributeMultiprocessorCount, dev) != hipSuccess) { grid = -1; return; }
        if (hipFuncSetAttribute((const void*)mega, hipFuncAttributeMaxDynamicSharedMemorySize, LDS_BYTES) != hipSuccess) { fprintf(stderr, "kernel_launch: hipFuncSetAttribute failed\n"); grid = -1; return; }
        if (hipOccupancyMaxActiveBlocksPerMultiprocessor(&per_cu, (const void*)mega, NWAVES * 64, LDS_BYTES) != hipSuccess || per_cu < 1) { fprintf(stderr, "kernel_launch: occupancy query says %d\n", per_cu); per_cu = 1; }
        (void)hipGetLastError();
        grid = cus;
    }
    if (grid < 0) return;
    (void)hipMemsetAsync((char*)d_ws + WS_CTL, 0, CTL_ZERO_BYTES, stream);
    Args a{};
    for (int i = 0; i < 34; ++i) a.in[i] = (const float*)d_in[i];
    a.out = (float*)d_out; a.ws = (unsigned char*)d_ws;
    constexpr int LAST = MK_LAST_PHASE + 1;
    if (MK_N_LAUNCHES == 1) { a.ph_lo = 0; a.ph_hi = LAST; hipLaunchKernelGGL(mega, dim3(grid), dim3(NWAVES * 64), LDS_BYTES, stream, a); }
    else for (int p = 0; p < LAST; ++p) { a.ph_lo = p; a.ph_hi = p + 1; hipLaunchKernelGGL(mega, dim3(grid), dim3(NWAVES * 64), LDS_BYTES, stream, a); }
    const hipError_t le = hipPeekAtLastError();
    if (le != hipSuccess) fprintf(stderr, "kernel_launch: launch failed: %s\n", hipGetErrorName(le));
}
```

```cpp
#include <hip/hip_runtime.h>
#include <hip/hip_bf16.h>
#include <cstdio>
#include <cstdint>

#ifndef MK_N_LAUNCHES
#define MK_N_LAUNCHES 1
#endif
#ifndef MK_LAST_PHASE
#define MK_LAST_PHASE 10
#endif

#define GAS __attribute__((address_space(1)))
#define LAS __attribute__((address_space(3)))
typedef unsigned short bf16_t;
typedef short bf16x8 __attribute__((ext_vector_type(8)));
typedef short s16x4 __attribute__((ext_vector_type(4)));
typedef float f32x2 __attribute__((ext_vector_type(2)));
typedef float f32x4 __attribute__((ext_vector_type(4)));
typedef float f32x16 __attribute__((ext_vector_type(16)));
typedef unsigned u32x2 __attribute__((ext_vector_type(2)));
typedef unsigned u32x4 __attribute__((ext_vector_type(4)));
typedef GAS unsigned gu32;

constexpr int NB = 8, SEQ = 4096, DM = 1024, MROWS = NB * SEQ, CTXL = 256, MCTX = NB * CTXL, MTOT = MROWS + MCTX;
constexpr int KVL = CTXL + SEQ;
constexpr int NHEAD = 4, QKW = 512;
constexpr int HYW = 512, HYC = 1536, INC = 3072, QKVC = 1536;
constexpr int NEXP = 32, TOPK = 4, NMOD = 6;
constexpr float EPS = 1e-6f;
constexpr float LAM_INIT = 0.2f;
constexpr float QSCALE = 0.125f * 1.4426950408889634f;

constexpr size_t MiB = 1u << 20;
constexpr size_t WS_CTL = 0, CTL_ZERO_BYTES = 64 * 1024;
constexpr size_t WS_SMALL = 1 * MiB;
constexpr size_t WS_WIN = 2 * MiB;
constexpr size_t WS_WOUT = 8 * MiB;
constexpr size_t WS_W1 = 10 * MiB;
constexpr size_t WS_W2 = 138 * MiB;
constexpr size_t WS_H = 202 * MiB;
constexpr size_t WS_Q = 270 * MiB;
constexpr size_t WS_K = 302 * MiB;
constexpr size_t WS_V = 336 * MiB;
constexpr size_t WS_UT = 370 * MiB;
constexpr size_t WS_FILT = 466 * MiB;
constexpr size_t WS_Z2T = 498 * MiB;
constexpr size_t WS_MIX = 530 * MiB;
constexpr size_t WS_ROUTE = 594 * MiB;
constexpr size_t WS_ACT = 270 * MiB;
constexpr size_t WS_EO = 598 * MiB;
constexpr size_t WS_XN = 870 * MiB;
constexpr size_t WS_END = 998 * MiB;
constexpr size_t SM_MOD = 0;
constexpr size_t SM_SCAL = 256 * 1024;
constexpr size_t SM_ROPE = 260 * 1024;
constexpr int CW_BAR = 4096;

constexpr int RING_BYTES = 131072;
constexpr int LDSCTL_OFF = 151552;
constexpr int LDS_BYTES = 152576;
constexpr int NWAVES = 8;

#define LDS_WAIT() asm volatile("s_waitcnt lgkmcnt(0)" ::: "memory")
#define VM_WAIT() asm volatile("s_waitcnt vmcnt(0)" ::: "memory")
#define RLX_AGENT __ATOMIC_RELAXED, __HIP_MEMORY_SCOPE_AGENT

__device__ __forceinline__ unsigned cvt_pk_bf16(float lo, float hi) { unsigned r; asm volatile("v_cvt_pk_bf16_f32 %0, %1, %2" : "=v"(r) : "v"(lo), "v"(hi)); return r; }
__device__ __forceinline__ float bf2f(bf16_t v) { return __uint_as_float(((unsigned)v) << 16); }
__device__ __forceinline__ float wave_sum(float v) {
#pragma unroll
    for (int o = 1; o < 64; o <<= 1) v += __shfl_xor(v, o);
    return v;
}

#define XB_TMO      128
#define XB_XCNT(j)  (256  + 64 * (j))
#define XB_XSUB(j)  (1280 + 64 * (j))
#define XB_XGEN(j)  (2304 + 64 * (j))
#define XB_TOP      3328
#define XB_TOPGEN   3392
#define XCD_BAR_WORDS 3456
#define XB_SPIN_CAP (1u << 22)
__device__ __forceinline__ unsigned xb_ld(unsigned* p)              { return __hip_atomic_load(p, __ATOMIC_RELAXED, __HIP_MEMORY_SCOPE_AGENT); }
__device__ __forceinline__ unsigned xb_add(unsigned* p, unsigned v) { return __hip_atomic_fetch_add(p, v, __ATOMIC_RELAXED, __HIP_MEMORY_SCOPE_AGENT); }
__device__ __forceinline__ unsigned xb_xcc_id() { return (unsigned)__builtin_amdgcn_s_getreg((3 << 11) | 20) & 0xFu; }
#define XB_SPIN(cond, bar) do { unsigned _sp = 0; while (cond) { __builtin_amdgcn_s_sleep(1); \
    if ((++_sp & 255u) == 0u) { if (xb_ld(&(bar)[XB_TMO])) break; if (_sp > XB_SPIN_CAP) { atomicAdd(&(bar)[XB_TMO], 1u); break; } } } } while (0)
struct XcdBarrier { unsigned* bar; unsigned x; volatile LAS unsigned* st; };
__device__ __forceinline__ XcdBarrier xcd_barrier_post(unsigned* bar, volatile LAS unsigned* st, bool leader) {
    XcdBarrier b; b.bar = bar; b.x = xb_xcc_id(); b.st = st;
    if (leader) (void)xb_add(&bar[XB_XCNT(b.x)], 1u);
    return b;
}
__device__ __forceinline__ void xcd_barrier_complete(unsigned* bar, unsigned x, unsigned& nloc, unsigned& nx) {
    const unsigned G = gridDim.x * gridDim.y * gridDim.z;
    unsigned sum, cnt, mine, sp = 0u;
    for (;;) {
        sum = 0u; cnt = 0u; mine = 0u;
#pragma unroll
        for (unsigned j = 0; j < 16; ++j) { const unsigned c = xb_ld(&bar[XB_XCNT(j)]); sum += c; cnt += (c > 0u) ? 1u : 0u; mine = (j == x) ? c : mine; }
        if (sum == G) break;
        __builtin_amdgcn_s_sleep(1);
        if ((++sp & 255u) == 0u) { if (xb_ld(&bar[XB_TMO])) break; if (sp > XB_SPIN_CAP) { atomicAdd(&bar[XB_TMO], 1u); break; } }
    }
    nloc = mine > 0u ? mine : 1u; nx = cnt > 0u ? cnt : 1u;
}
__device__ __forceinline__ void xcd_barrier(const XcdBarrier& b, bool leader) {
    asm volatile("s_waitcnt vmcnt(0)" ::: "memory");
    __syncthreads();
    if (leader) {
        unsigned* bar = b.bar;
        __builtin_amdgcn_s_waitcnt(0);
        unsigned nloc = b.st[0], nx = b.st[1];
        if (nloc == 0u) { xcd_barrier_complete(bar, b.x, nloc, nx); b.st[0] = nloc; b.st[1] = nx; }
        const unsigned old = xb_add(&bar[XB_XSUB(b.x)], 1u);
        const unsigned gen = old / nloc;
        if (old + 1u == (gen + 1u) * nloc) {
            __builtin_amdgcn_fence(__ATOMIC_RELEASE, "agent");
            asm volatile("s_waitcnt vmcnt(0)" ::: "memory");
            const unsigned og = xb_add(&bar[XB_TOP], 1u);
            const unsigned tg = og / nx;
            if (og + 1u == (tg + 1u) * nx) xb_add(&bar[XB_TOPGEN], 1u);
            else XB_SPIN(xb_ld(&bar[XB_TOPGEN]) == tg, bar);
            __builtin_amdgcn_fence(__ATOMIC_ACQUIRE, "agent");
            xb_add(&bar[XB_XGEN(b.x)], 1u);
            asm volatile("s_waitcnt vmcnt(0)" ::: "memory");
        } else {
            XB_SPIN(xb_ld(&bar[XB_XGEN(b.x)]) == gen, bar);
            __builtin_amdgcn_fence(__ATOMIC_ACQUIRE, "agent");
            asm volatile("s_waitcnt vmcnt(0)" ::: "memory");
        }
    }
    __syncthreads();
}

namespace g8 {
constexpr int BM = 256, BK = 64, HALF = 128, HTB = HALF * BK * 2, STAGE_BYTES = 8 * HTB, NXCD = 8, WGM = 8;
__host__ __device__ __forceinline__ int lds_byte(int r, int c) { const int st = (r >> 4) * 2 + (c >> 5), rr = r & 15, cc = c & 31, ob = rr * 64 + cc * 2; return st * 1024 + (ob ^ (((ob >> 9) & 1) << 5)); }
__host__ __device__ __forceinline__ void stage_rc(int b, int& R, int& C) { const int st = b / 1024, sb = b % 1024, swz = sb ^ (((sb >> 9) & 1) << 5); R = (st >> 1) * 16 + swz / 64; C = (st & 1) * 32 + (swz % 64) / 2; }
__host__ __device__ __forceinline__ int perm32(int rho) { const int n = rho >> 4, i = rho & 15; return 8 * (i >> 2) + 4 * n + (i & 3); }

struct Unit { const char* a; const char* b; int pm, pn, kind, ex; };

__device__ __forceinline__ void tile_of(int L, int nM, int nN, int& pm, int& pn) {
    const int nwg = nM * nN; int wgid = L;
    { const int q = nwg / NXCD, r = nwg % NXCD, xcd = wgid % NXCD, off = wgid / NXCD; wgid = (xcd < r ? xcd * (q + 1) : r * (q + 1) + (xcd - r) * q) + off; }
    const int nig = WGM * nN, gid = wgid / nig, fm = gid * WGM, gsz = (nM - fm) < WGM ? (nM - fm) : WGM;
    pm = fm + ((wgid % nig) % gsz); pn = (wgid % nig) / gsz;
}

typedef int i32x8 __attribute__((ext_vector_type(8)));
template <bool FP8, bool GATHER, bool SP2, class Epi, class Sched>
__device__ __forceinline__ void gemm_phase_s(LAS unsigned char* lds, const int K, const Sched& S, const Epi& E, const int wid, const int lane) {
    const int tid = wid * 64 + lane, wr = wid >> 2, wc = wid & 3, fr = lane & 15, fq = lane >> 4;
    const int nt = FP8 ? K / 128 : K / BK;
    const int RP = FP8 ? K : 2 * K;
    unsigned voffA[2], voffB[2]; int srow[2], scol[2];
#pragma unroll
    for (int i = 0; i < 2; ++i) { int R, C; stage_rc(tid * 16 + i * 8192, R, C); const int Rb = (R & ~31) + perm32(R & 31);
        voffA[i] = (unsigned)(R * RP + C * 2); voffB[i] = (unsigned)(Rb * RP + C * 2); srow[i] = R; scol[i] = C * 2; }
    const size_t kstep = (size_t)(BK * 2);
    const size_t hstep = (size_t)HALF * RP;
    const unsigned ldsw = (unsigned)wid * 1024u;
    unsigned cO0[2], cO1[2], nO0[2], nO1[2];
#define PG8_GOFF(D0, D1, ui_) do { if constexpr (GATHER) { const LAS int* rw_ = S.rows(ui_); _Pragma("unroll") for (int i_ = 0; i_ < 2; ++i_) { \
        D0[i_] = (unsigned)rw_[srow[i_]] * (unsigned)RP + (unsigned)scol[i_]; D1[i_] = (unsigned)rw_[128 + srow[i_]] * (unsigned)RP + (unsigned)scol[i_]; } } \
      else { _Pragma("unroll") for (int i_ = 0; i_ < 2; ++i_) { D0[i_] = voffA[i_]; D1[i_] = voffA[i_] + (unsigned)hstep; } } } while (0)
    const int aoff = lds_byte(wr * 64 + fr, FP8 ? fq * 16 : fq * 8), boff = lds_byte(wc * 32 + fr, FP8 ? fq * 16 : fq * 8);
    constexpr int KOFF = FP8 ? 16 : 1024;
#define PG8_SA(b, h) (((b) * 2 + (h)) * HTB)
#define PG8_SB(b, h) ((4 + (b) * 2 + (h)) * HTB)
#define PG8_STAGE(bufoff, gbase, voff) do { _Pragma("unroll") for (int _i = 0; _i < 2; ++_i) \
        __builtin_amdgcn_global_load_lds((const unsigned*)((const char*)(gbase) + (voff)[_i]), (LAS unsigned*)(lds + (bufoff) + ldsw + _i * 8192), 16, 0, 0); } while (0)
#define PG8_LD32(p) __builtin_bit_cast(i32x8, __builtin_shufflevector(*(const LAS u32x4*)(p), *(const LAS u32x4*)((p) + 16), 0, 1, 2, 3, 4, 5, 6, 7))
#define PG8_LDA8(dst, b, h) do { _Pragma("unroll") for (int m = 0; m < 4; ++m) dst[m] = PG8_LD32(lds + PG8_SA(b, h) + aoff + m * 2048); } while (0)
#define PG8_LDB8(dst, b, h) do { _Pragma("unroll") for (int n = 0; n < 2; ++n) dst[n] = PG8_LD32(lds + PG8_SB(b, h) + boff + n * 2048); } while (0)
#define PG8_LDA(dst, b, h) do { _Pragma("unroll") for (int m = 0; m < 4; ++m) _Pragma("unroll") for (int k = 0; k < 2; ++k) dst[m][k] = *(const LAS bf16x8*)(lds + PG8_SA(b, h) + aoff + m * 2048 + k * KOFF); } while (0)
#define PG8_LDB(dst, b, h) do { _Pragma("unroll") for (int n = 0; n < 2; ++n) _Pragma("unroll") for (int k = 0; k < 2; ++k) dst[n][k] = *(const LAS bf16x8*)(lds + PG8_SB(b, h) + boff + n * 2048 + k * KOFF); } while (0)
#define PG8_MMA(ai, bj, At, Bt) do { __builtin_amdgcn_s_setprio(1); _Pragma("unroll") for (int m = 0; m < 4; ++m) _Pragma("unroll") for (int n = 0; n < 2; ++n) _Pragma("unroll") for (int k = 0; k < 2; ++k) \
        acc[ai][bj][m][n] = __builtin_amdgcn_mfma_f32_16x16x32_bf16(Bt[n][k], At[m][k], acc[ai][bj][m][n], 0, 0, 0); __builtin_amdgcn_s_setprio(0); } while (0)
#define PG8_MMA8(ai, bj, At, Bt) do { __builtin_amdgcn_s_setprio(1); _Pragma("unroll") for (int m = 0; m < 4; ++m) _Pragma("unroll") for (int n = 0; n < 2; ++n) \
        asm volatile("v_mfma_scale_f32_16x16x128_f8f6f4 %0, %1, %2, %0, %3, %3 op_sel_hi:[0,0,0]" : "+v"(acc[ai][bj][m][n]) : "v"(Bt[n]), "v"(At[m]), "v"(one_scale)); __builtin_amdgcn_s_setprio(0); } while (0)
#define PG8_WAIT_V(n) asm volatile("s_waitcnt vmcnt(" #n ")" ::: "memory")
#define PG8_WAIT_L(n) asm volatile("s_waitcnt lgkmcnt(" #n ")" ::: "memory")
#define PG8_BAR __builtin_amdgcn_s_barrier()
#define PG8_SCHED __builtin_amdgcn_sched_barrier(0)
    Unit cur, nxt; int ui = 0;
    if (!S.next(0, cur)) return;
    f32x4 acc[2][2][4][2];
#pragma unroll
    for (int a = 0; a < 2; ++a)
#pragma unroll
        for (int b = 0; b < 2; ++b)
#pragma unroll
            for (int m = 0; m < 4; ++m)
#pragma unroll
                for (int n = 0; n < 2; ++n) acc[a][b][m][n] = (f32x4){0.f, 0.f, 0.f, 0.f};
    bf16x8 At[4][2], B0[2][2], B1[2][2];
    i32x8 At8[4], B08[2], B18[2];
    const unsigned one_scale = 0x7f7f7f7fu;
    const char* cA = cur.a; const char* cB = cur.b;
    PG8_GOFF(cO0, cO1, 0);
    if constexpr (SP2) {
    PG8_STAGE(PG8_SB(0, 0), cB, voffB); PG8_STAGE(PG8_SB(0, 1), cB + hstep, voffB); PG8_STAGE(PG8_SA(0, 0), cA, cO0); PG8_STAGE(PG8_SA(0, 1), cA, cO1);
    if (wr == 1) PG8_BAR;
    PG8_WAIT_V(2); PG8_BAR;
    PG8_STAGE(PG8_SB(1, 0), cB + kstep, voffB); PG8_STAGE(PG8_SA(1, 0), cA + kstep, cO0); PG8_STAGE(PG8_SB(1, 1), cB + hstep + kstep, voffB);
    PG8_WAIT_V(6); PG8_BAR;
    } else {
    PG8_STAGE(PG8_SB(0, 0), cB, voffB); PG8_STAGE(PG8_SA(0, 0), cA, cO0); PG8_STAGE(PG8_SB(0, 1), cB + hstep, voffB); PG8_STAGE(PG8_SA(0, 1), cA, cO1);
    if (wr == 1) PG8_BAR;
    PG8_WAIT_V(4); PG8_BAR;
    PG8_STAGE(PG8_SB(1, 0), cB + kstep, voffB); PG8_STAGE(PG8_SA(1, 0), cA + kstep, cO0); PG8_STAGE(PG8_SB(1, 1), cB + hstep + kstep, voffB);
    PG8_WAIT_V(6); PG8_BAR;
    }
    for (;;) {
        const bool has_next = S.next(ui + 1, nxt);
        const char* nA = has_next ? nxt.a : cA; const char* nB = has_next ? nxt.b : cB;
        if (has_next) PG8_GOFF(nO0, nO1, ui + 1); else { _Pragma("unroll") for (int i_ = 0; i_ < 2; ++i_) { nO0[i_] = cO0[i_]; nO1[i_] = cO1[i_]; } }
#pragma unroll 1
        for (int t = 0; t < nt; t += 2) {
            const bool last = (t == nt - 2);
            const char* a1 = cA + (size_t)(t + 1) * kstep;
            const char* a2 = last ? nA : cA + (size_t)(t + 2) * kstep; const char* b2 = last ? nB : cB + (size_t)(t + 2) * kstep;
            const char* a3 = a2 + kstep; const char* b3 = b2 + kstep;
            unsigned o20[2], o21[2];
#pragma unroll
            for (int i_ = 0; i_ < 2; ++i_) { o20[i_] = last ? nO0[i_] : cO0[i_]; o21[i_] = last ? nO1[i_] : cO1[i_]; }
            if constexpr (FP8 && SP2) {
            PG8_LDB8(B08, 0, 0); PG8_LDB8(B18, 0, 1); PG8_SCHED; PG8_LDA8(At8, 0, 0); PG8_STAGE(PG8_SA(1, 1), a1, cO1);
            PG8_WAIT_V(8); PG8_WAIT_L(0); PG8_BAR; PG8_MMA8(0, 0, At8, B08); PG8_MMA8(0, 1, At8, B18); PG8_BAR; PG8_SCHED;
            PG8_LDA8(At8, 0, 1); PG8_STAGE(PG8_SB(0, 0), b2, voffB); PG8_STAGE(PG8_SB(0, 1), b2 + hstep, voffB); PG8_STAGE(PG8_SA(0, 0), a2, o20);
            PG8_WAIT_V(8); PG8_WAIT_L(0); PG8_BAR; PG8_MMA8(1, 0, At8, B08); PG8_MMA8(1, 1, At8, B18); PG8_BAR; PG8_SCHED;
            PG8_LDB8(B08, 1, 0); PG8_LDB8(B18, 1, 1); PG8_SCHED; PG8_LDA8(At8, 1, 0); PG8_STAGE(PG8_SA(0, 1), a2, o21);
            PG8_WAIT_V(8); PG8_WAIT_L(0); PG8_BAR; PG8_MMA8(0, 0, At8, B08); PG8_MMA8(0, 1, At8, B18); PG8_BAR; PG8_SCHED;
            PG8_LDA8(At8, 1, 1); PG8_STAGE(PG8_SB(1, 0), b3, voffB); PG8_STAGE(PG8_SB(1, 1), b3 + hstep, voffB); PG8_STAGE(PG8_SA(1, 0), a3, o20);
            PG8_WAIT_V(8); PG8_WAIT_L(0); PG8_BAR; PG8_MMA8(1, 0, At8, B08); PG8_MMA8(1, 1, At8, B18); PG8_BAR; PG8_SCHED;
            } else if constexpr (FP8) {
            PG8_LDB8(B08, 0, 0); PG8_SCHED; PG8_LDA8(At8, 0, 0); PG8_STAGE(PG8_SA(1, 1), a1, cO1);
            PG8_WAIT_L(8); PG8_BAR; PG8_WAIT_L(0); PG8_MMA8(0, 0, At8, B08); PG8_BAR; PG8_SCHED;
            PG8_LDB8(B18, 0, 1); PG8_STAGE(PG8_SB(0, 0), b2, voffB);
            PG8_BAR; PG8_WAIT_L(0); PG8_MMA8(0, 1, At8, B18); PG8_BAR;
            PG8_LDA8(At8, 0, 1); PG8_STAGE(PG8_SA(0, 0), a2, o20);
            PG8_BAR; PG8_WAIT_L(0); PG8_MMA8(1, 0, At8, B08); PG8_BAR; PG8_SCHED;
            PG8_STAGE(PG8_SB(0, 1), b2 + hstep, voffB);
            PG8_WAIT_V(6); PG8_BAR; PG8_MMA8(1, 1, At8, B18); PG8_BAR;
            PG8_LDB8(B08, 1, 0); PG8_SCHED; PG8_LDA8(At8, 1, 0); PG8_STAGE(PG8_SA(0, 1), a2, o21);
            PG8_WAIT_L(8); PG8_BAR; PG8_WAIT_L(0); PG8_MMA8(0, 0, At8, B08); PG8_BAR; PG8_SCHED;
            PG8_LDB8(B18, 1, 1); PG8_STAGE(PG8_SB(1, 0), b3, voffB);
            PG8_BAR; PG8_WAIT_L(0); PG8_MMA8(0, 1, At8, B18); PG8_BAR;
            PG8_LDA8(At8, 1, 1); PG8_STAGE(PG8_SA(1, 0), a3, o20);
            PG8_BAR; PG8_WAIT_L(0); PG8_MMA8(1, 0, At8, B08); PG8_BAR; PG8_SCHED;
            PG8_STAGE(PG8_SB(1, 1), b3 + hstep, voffB);
            PG8_WAIT_V(6); PG8_BAR; PG8_MMA8(1, 1, At8, B18); PG8_BAR;
            } else {
            PG8_LDB(B0, 0, 0); PG8_LDB(B1, 0, 1); PG8_SCHED; PG8_LDA(At, 0, 0); PG8_STAGE(PG8_SA(1, 1), a1, cO1);
            PG8_WAIT_V(8); PG8_WAIT_L(0); PG8_BAR; PG8_MMA(0, 0, At, B0); PG8_MMA(0, 1, At, B1); PG8_BAR; PG8_SCHED;
            PG8_LDA(At, 0, 1); PG8_STAGE(PG8_SB(0, 0), b2, voffB); PG8_STAGE(PG8_SB(0, 1), b2 + hstep, voffB); PG8_STAGE(PG8_SA(0, 0), a2, o20);
            PG8_WAIT_V(8); PG8_WAIT_L(0); PG8_BAR; PG8_MMA(1, 0, At, B0); PG8_MMA(1, 1, At, B1); PG8_BAR; PG8_SCHED;
            PG8_LDB(B0, 1, 0); PG8_LDB(B1, 1, 1); PG8_SCHED; PG8_LDA(At, 1, 0); PG8_STAGE(PG8_SA(0, 1), a2, o21);
            PG8_WAIT_V(8); PG8_WAIT_L(0); PG8_BAR; PG8_MMA(0, 0, At, B0); PG8_MMA(0, 1, At, B1); PG8_BAR; PG8_SCHED;
            PG8_LDA(At, 1, 1); PG8_STAGE(PG8_SB(1, 0), b3, voffB); PG8_STAGE(PG8_SB(1, 1), b3 + hstep, voffB); PG8_STAGE(PG8_SA(1, 0), a3, o20);
            PG8_WAIT_V(8); PG8_WAIT_L(0); PG8_BAR; PG8_MMA(1, 0, At, B0); PG8_MMA(1, 1, At, B1); PG8_BAR; PG8_SCHED;
            }
        }
        if (wr == 0) PG8_BAR;
        if constexpr (FP8) asm volatile("s_nop 15\n\ts_nop 15" ::: "memory");
        E(acc, cur, wr, wc, fr, fq);
        if (!has_next) break;
#pragma unroll
        for (int a = 0; a < 2; ++a)
#pragma unroll
            for (int b = 0; b < 2; ++b)
#pragma unroll
                for (int m = 0; m < 4; ++m)
#pragma unroll
                    for (int n = 0; n < 2; ++n) acc[a][b][m][n] = (f32x4){0.f, 0.f, 0.f, 0.f};
        cur = nxt; cA = nA; cB = nB; ++ui;
#pragma unroll
        for (int i_ = 0; i_ < 2; ++i_) { cO0[i_] = nO0[i_]; cO1[i_] = nO1[i_]; }
        if (wr == 1) PG8_BAR;
    }
    PG8_WAIT_V(0);
    PG8_BAR;
#undef PG8_SA
#undef PG8_GOFF
#undef PG8_SB
#undef PG8_STAGE
#undef PG8_LDA
#undef PG8_LDB
#undef PG8_MMA
#undef PG8_MMA8
#undef PG8_LDA8
#undef PG8_LDB8
#undef PG8_LD32
#undef PG8_WAIT_V
#undef PG8_WAIT_L
#undef PG8_BAR
#undef PG8_SCHED
}
template <bool FP8, bool GATHER, class Epi, class Sched>
__device__ __forceinline__ void gemm_phase_g(LAS unsigned char* lds, const int K, const Sched& S, const Epi& E, const int wid, const int lane) { gemm_phase_s<FP8, GATHER, !FP8>(lds, K, S, E, wid, lane); }
template <bool FP8, class Epi, class Sched>
__device__ __forceinline__ void gemm_phase(LAS unsigned char* lds, const int K, const Sched& S, const Epi& E, const int wid, const int lane) { gemm_phase_s<FP8, false, !FP8>(lds, K, S, E, wid, lane); }
}

__device__ __forceinline__ int lane_id() { int l; asm volatile("v_mbcnt_lo_u32_b32 %0, -1, 0\n\tv_mbcnt_hi_u32_b32 %0, -1, %0" : "=v"(l)); return l; }
#define FT_DECL const int f_lane = lane_id(), f_tid = F.wave * 64 + f_lane; (void)f_tid; (void)f_lane
typedef const float* cfp_t;
typedef __attribute__((address_space(4))) cfp_t* kin_t;
struct Frame {
    LAS unsigned char* lds;
    volatile LAS unsigned* MISC;
    gu32* ctl;
    int wave, vcu, G;
    kin_t in;
    float* out;
    unsigned char* ws;
};
#define WSP(T, off) ((T*)(F.ws + (off)))

template <class RowMap>
__device__ __forceinline__ void p0_transpose_item(const float* W, int K, int N, bf16_t* WT, const RowMap& rowmap, const float* kscale, LAS float* scr, int item, int lane, bool kperm = false) {
    const int nblk = N / 32, kb = item / nblk, nb = item % nblk, k0 = 64 * kb, n0 = 32 * nb;
#pragma unroll 8
    for (int i = 0; i < 32; ++i) { const int kk = 2 * i + (lane >> 5); int ks = k0 + kk; if (kperm && ks >= K / 2) { const int j = ks - K / 2; ks = K / 2 + (j >> 3) + 64 * (j & 7); }
        float v = W[(size_t)ks * N + n0 + (lane & 31)]; if (kscale) v *= kscale[k0 + kk]; scr[kk * 33 + (lane & 31)] = v; }
    LDS_WAIT(); asm volatile("" ::: "memory");
    const int c = lane & 7;
#pragma unroll
    for (int j = 0; j < 4; ++j) { const int n = (lane >> 3) + 8 * j; const LAS float* s = scr + (8 * c) * 33 + n;
        u32x4 o; o.x = cvt_pk_bf16(s[0 * 33], s[1 * 33]); o.y = cvt_pk_bf16(s[2 * 33], s[3 * 33]); o.z = cvt_pk_bf16(s[4 * 33], s[5 * 33]); o.w = cvt_pk_bf16(s[6 * 33], s[7 * 33]);
        *(GAS u32x4*)(WT + (size_t)rowmap(n0 + n) * K + k0 + 8 * c) = o; }
    LDS_WAIT(); asm volatile("" ::: "memory");
}

__device__ __forceinline__ unsigned pk4_fp8(float a, float b, float c, float d) { int r = __builtin_amdgcn_cvt_pk_fp8_f32(a, b, 0, false); r = __builtin_amdgcn_cvt_pk_fp8_f32(c, d, r, true); return (unsigned)r; }
constexpr float EOSCALE = 16.f;
constexpr float WSCALE = 32.f;
template <class RowMap>
__device__ __forceinline__ void p0_transpose_item_f8(const float* W, int K, int N, unsigned char* WT, const RowMap& rowmap, LAS float* scr, int item, int lane) {
    const int nblk = N / 32, kb = item / nblk, nb = item % nblk, k0 = 128 * kb, n0 = 32 * nb;
#pragma unroll
    for (int hh = 0; hh < 2; ++hh) { float v[32];
#pragma unroll
        for (int i = 0; i < 32; ++i) { const int kk = 2 * (32 * hh + i) + (lane >> 5); v[i] = __builtin_nontemporal_load(W + (size_t)(k0 + kk) * N + n0 + (lane & 31)); }
#pragma unroll
        for (int i = 0; i < 32; ++i) { const int kk = 2 * (32 * hh + i) + (lane >> 5); scr[kk * 33 + (lane & 31)] = v[i] * WSCALE; } }
    LDS_WAIT(); asm volatile("" ::: "memory");
    const int c = lane & 7;
#pragma unroll
    for (int j = 0; j < 4; ++j) { const int n = (lane >> 3) + 8 * j; const LAS float* sp = scr + (16 * c) * 33 + n;
        u32x4 o; o.x = pk4_fp8(sp[0 * 33], sp[1 * 33], sp[2 * 33], sp[3 * 33]); o.y = pk4_fp8(sp[4 * 33], sp[5 * 33], sp[6 * 33], sp[7 * 33]);
        o.z = pk4_fp8(sp[8 * 33], sp[9 * 33], sp[10 * 33], sp[11 * 33]); o.w = pk4_fp8(sp[12 * 33], sp[13 * 33], sp[14 * 33], sp[15 * 33]);
        *(GAS u32x4*)(WT + (size_t)rowmap(n0 + n) * K + k0 + 16 * c) = o; }
    LDS_WAIT(); asm volatile("" ::: "memory");
}
struct MapW2 { __device__ __forceinline__ int operator()(int l) const { const int t = l & ~255, r = l & 255, wc = r >> 6, fq = (r >> 4) & 3, bj = (r >> 3) & 1, low = r & 7; return t + 128 * bj + 32 * wc + 8 * fq + low; } };
struct MapIdent { int off; __device__ __forceinline__ int operator()(int n) const { return off + n; } };
struct MapWin { __device__ __forceinline__ int operator()(int l) const {
    if (l >= 1024) return l;
    const int t = l & ~255, r = l & 255, wc = r >> 6, blk = (r >> 5) & 1, bj = (r >> 4) & 1, low = r & 15;
    return t + 128 * bj + 32 * wc + 16 * blk + low; } };
struct MapW1 { int off; __device__ __forceinline__ int operator()(int jp) const { const int bj = jp >> 10, j = jp & 1023; return off + 256 * (j >> 7) + 128 * bj + (j & 127); } };


__device__ __forceinline__ void p0_filter_item(Frame& F, int item) {
    FT_DECL;
#define in F.in
    LAS float* h1s = (LAS float*)(F.lds);
    LAS float* h2s = (LAS float*)(F.lds + 4096);
    const int t0 = item * 16;
    {
        const int tt = f_tid >> 5, hh = (f_tid & 31) * 2; const float pos = (float)(t0 + tt);
        float feats[17]; feats[0] = pos * (1.f / SEQ);
#pragma unroll
        for (int i = 0; i < 8; ++i) { const float band = 1e-4f + (float)i * ((7.f - 1e-4f) / 7.f); const float ang = (6.283185307179586f / SEQ) * pos * band; feats[1 + i] = __sinf(ang); feats[9 + i] = __cosf(ang); }
#pragma unroll
        for (int u = 0; u < 2; ++u) { const int h = hh + u; float a = in[19][h];
#pragma unroll
            for (int k = 0; k < 17; ++k) a += feats[k] * in[18][k * 64 + h];
            h1s[tt * 64 + h] = __sinf(in[20][h] * a); }
        __syncthreads();
#pragma unroll
        for (int u = 0; u < 2; ++u) { const int h = hh + u; float a = in[22][h];
#pragma unroll 8
            for (int k = 0; k < 64; ++k) a += h1s[tt * 64 + k] * in[21][k * 64 + h];
            h2s[tt * 64 + h] = __sinf(in[23][h] * a); }
        __syncthreads();
    }
    f32x4 acc[16];
#pragma unroll
    for (int t = 0; t < 16; ++t) acc[t] = (f32x4){0.f, 0.f, 0.f, 0.f};
    const int o = 4 * f_tid;
    for (int k0 = 0; k0 < 64; k0 += 4) { f32x4 w[4];
#pragma unroll
        for (int q = 0; q < 4; ++q) w[q] = *(const f32x4*)(in[24] + (size_t)(k0 + q) * 2048 + o);
#pragma unroll
        for (int t = 0; t < 16; ++t) { const f32x4 hv = *(const LAS f32x4*)(h2s + t * 64 + k0); acc[t] += w[0] * hv[0] + w[1] * hv[1] + w[2] * hv[2] + w[3] * hv[3]; } }
    const int c0 = o & 511, od = o >> 9;
    float* dst = WSP(float, WS_FILT) + ((size_t)od * 512 + c0) * SEQ + t0;
#pragma unroll
    for (int e = 0; e < 4; ++e) { const float la = -3.0701134573253944f, lb = -15.350567286626972f; const float delta = fabsf(la + (float)(c0 + e) * ((lb - la) / 511.f));
#pragma unroll
        for (int q = 0; q < 4; ++q) { f32x4 v;
#pragma unroll
            for (int i = 0; i < 4; ++i) { const int t = 4 * q + i; const float tn = (float)(t0 + t) * (1.f / SEQ); v[i] = acc[t][e] * __expf(-tn * delta); }
            *(f32x4*)(dst + (size_t)e * SEQ + 4 * q) = v; } }
    __syncthreads();
#undef in
}

__device__ __forceinline__ float silu_f(float v) { return v / (1.f + __expf(-v)); }

__device__ __forceinline__ void p0_prologue(Frame& F) {
    FT_DECL;
#define in F.in
    const int wg = blockIdx.x;
    if (wg < 96) {
        LAS float* sv = (LAS float*)F.lds;
        for (int i = f_tid; i < 9 * 1024; i += 512) { const int r = i >> 10, k = i & 1023; const float c = (r < 8) ? in[1][r * 1024 + k] : in[3][k]; sv[i] = silu_f(c); }
        __syncthreads();
        const int j = wg * 64 + f_lane; const float* wm = in[4];
        float acc[9];
#pragma unroll
        for (int r = 0; r < 9; ++r) acc[r] = 0.f;
        const int kbeg = F.wave * 128;
        for (int k0 = kbeg; k0 < kbeg + 128; k0 += 16) { float w[16];
#pragma unroll
            for (int q = 0; q < 16; ++q) w[q] = __builtin_nontemporal_load(wm + (size_t)(k0 + q) * (NMOD * DM) + j);
#pragma unroll
            for (int q = 0; q < 16; ++q)
#pragma unroll
                for (int r = 0; r < 9; ++r) acc[r] += sv[r * 1024 + k0 + q] * w[q]; }
        LAS float* red = (LAS float*)(F.lds + 40960);
#pragma unroll
        for (int r = 0; r < 9; ++r) red[(F.wave * 9 + r) * 64 + f_lane] = acc[r];
        __syncthreads();
        for (int i = f_tid; i < 9 * 64; i += 512) { const int r = i >> 6, l = i & 63; float s = in[5][wg * 64 + l];
#pragma unroll
            for (int w = 0; w < 8; ++w) s += red[(w * 9 + r) * 64 + l];
            WSP(float, WS_SMALL + SM_MOD)[r * (NMOD * DM) + wg * 64 + l] = s; }
        __syncthreads();
    } else if (wg == 96) {
        if (F.wave == 0) {
            const float a = wave_sum(in[11][f_lane] * in[12][f_lane]), b = wave_sum(in[13][f_lane] * in[14][f_lane]);
            float gq = fabsf(in[9][f_lane]), gk = fabsf(in[10][f_lane]);
#pragma unroll
            for (int o = 1; o < 64; o <<= 1) { gq = fmaxf(gq, __shfl_xor(gq, o)); gk = fmaxf(gk, __shfl_xor(gk, o)); }
            if (f_lane == 0) { float* sc = WSP(float, WS_SMALL + SM_SCAL); sc[0] = expf(a) - expf(b) + LAM_INIT;
                sc[1] = (8.f * gq * gk * 1.02f + 0.05f) * 1.4426950408889634f; }
        }
        for (int i = f_tid; i < 64 * 16; i += 512) { const int pos = i >> 4, f = i & 15;
            const float inv = powf(10000.f, -(float)f / 16.f); const float ang = (float)pos * inv;
            float* rt = WSP(float, WS_SMALL + SM_ROPE); rt[2 * i] = cosf(ang); rt[2 * i + 1] = sinf(ang); }
    }
    __syncthreads();
    for (int it = wg; it < SEQ / 16; it += F.G) p0_filter_item(F, it);
    __syncthreads();
    {
        LAS float* scr = (LAS float*)(F.lds + F.wave * 16896);
        const int gw = F.vcu * NWAVES + F.wave, NGW = F.G * NWAVES;
        constexpr int I_IN = (DM / 64) * (INC / 32), I_OUT = (DM / 64) * (DM / 32), I_1 = (DM / 128) * (2 * DM / 32), I_2 = (DM / 128) * (DM / 32);
        constexpr int NITEMS = I_IN + I_OUT + NEXP * (I_1 + I_2);
        for (int it = gw; it < NITEMS; it += NGW) {
            int r = it;
            if (r < I_IN) { p0_transpose_item(in[8], DM, INC, WSP(bf16_t, WS_WIN), MapWin{}, nullptr, scr, r, f_lane); continue; } r -= I_IN;
            if (r < I_OUT) { p0_transpose_item(in[27], DM, DM, WSP(bf16_t, WS_WOUT), MapIdent{0}, nullptr, scr, r, f_lane, true); continue; } r -= I_OUT;
            const int e = r / (I_1 + I_2); r -= e * (I_1 + I_2);
            if (r < I_1) p0_transpose_item_f8(in[30] + (size_t)e * DM * 2 * DM, DM, 2 * DM, WSP(unsigned char, WS_W1) + (size_t)e * 2 * DM * DM, MapW1{0}, scr, r, f_lane);
            else p0_transpose_item_f8(in[32] + (size_t)e * DM * DM, DM, DM, WSP(unsigned char, WS_W2) + (size_t)e * DM * DM, MapW2{}, scr, r - I_1, f_lane);
        }
    }
}
#undef in

__device__ __forceinline__ void p1_norm1(Frame& F) {
    FT_DECL;
    const int gw = F.vcu * NWAVES + F.wave, NGW = F.G * NWAVES;
    const float* mod = WSP(float, WS_SMALL + SM_MOD); const float* g1 = F.in[6];
    bf16_t* H = WSP(bf16_t, WS_H);
    constexpr int RPW = MTOT / (256 * NWAVES);
    for (int run = gw; run * RPW < MTOT; run += NGW) {
        const int r0 = run * RPW, r1 = (r0 + RPW < MTOT) ? r0 + RPW : MTOT;
        int curb = -1; f32x4 PA[4], PB[4];
        for (int m0 = r0; m0 < r1; m0 += 4) {
            f32x4 v[4][4];
#pragma unroll
            for (int u = 0; u < 4; ++u) { const int m = m0 + u; if (m < r1) {
                const float* xrow = (m < MROWS) ? F.in[0] + (size_t)m * DM : F.in[2] + (size_t)(m - MROWS) * DM; const GAS f32x4* xr = (const GAS f32x4*)xrow + f_lane;
#pragma unroll
                for (int j = 0; j < 4; ++j) v[u][j] = __builtin_nontemporal_load(xr + 64 * j); } }
#pragma unroll
            for (int u = 0; u < 4; ++u) { const int m = m0 + u; if (m < r1) {
                const int mb = (m < MROWS) ? (m >> 12) : 8;
                if (mb != curb) { curb = mb; const float* sh = mod + (size_t)mb * (NMOD * DM); const float* sc = sh + DM;
#pragma unroll
                    for (int j = 0; j < 4; ++j) { const int c = 4 * f_lane + 256 * j; PA[j] = *(const f32x4*)(g1 + c) * (*(const f32x4*)(sc + c) + 1.f); PB[j] = *(const f32x4*)(sh + c); } }
                float s = 0.f;
#pragma unroll
                for (int j = 0; j < 4; ++j) s += (v[u][j].x * v[u][j].x + v[u][j].y * v[u][j].y) + (v[u][j].z * v[u][j].z + v[u][j].w * v[u][j].w);
                const float rstd = rsqrtf(wave_sum(s) * (1.f / DM) + EPS);
                GAS u32x2* o8 = (GAS u32x2*)(H + (size_t)m * DM) + f_lane;
#pragma unroll
                for (int j = 0; j < 4; ++j) { const f32x4 y = v[u][j] * rstd * PA[j] + PB[j];
                    u32x2 w; w.x = cvt_pk_bf16(y.x, y.y); w.y = cvt_pk_bf16(y.z, y.w); o8[64 * j] = w; } } }
        }
    }
}

struct SchedInProj {
    int G, c; const char* H; const char* W;
    static constexpr int NA = 136 * 4, NV = 2 * 136, NBU = 6 * 128;
    __device__ __forceinline__ bool next(int i, g8::Unit& u) const {
        const long L = (long)i * G + c;
        if (L < NA) { g8::tile_of((int)L, 136, 4, u.pm, u.pn); u.a = H + (size_t)u.pm * 256 * DM * 2; u.b = W + (size_t)u.pn * 256 * DM * 2; u.kind = 0; u.ex = 0; return true; }
        if (L < NA + NV) { g8::tile_of((int)L - NA, 2, 136, u.pm, u.pn); u.a = W + (size_t)(1024 + u.pm * 256) * DM * 2; u.b = H + (size_t)u.pn * 256 * DM * 2; u.kind = 2; u.ex = 0; return true; }
        if (L < NA + NV + NBU) { g8::tile_of((int)L - NA - NV, 6, 128, u.pm, u.pn); u.a = W + (size_t)(QKVC + u.pm * 256) * DM * 2; u.b = H + (size_t)u.pn * 256 * DM * 2; u.kind = 1; u.ex = 0; return true; }
        return false;
    }
};
constexpr float Q8SCALE = 16.f;
struct EpiInProj {
    unsigned char *Q8, *K8, *VT8; bf16_t* UT; const float *gq, *gk, *rope;
    __device__ __forceinline__ void operator()(f32x4 (&acc)[2][2][4][2], const g8::Unit& u, int wr, int wc, int fr, int fq) const {
        asm volatile("" : "+v"(fr), "+v"(fq));
        if (u.kind == 1) {
            const int row0 = u.pm * 256 + wr * 64 + fr, col0 = u.pn * 256 + wc * 32 + 8 * fq;
#pragma unroll
            for (int ai = 0; ai < 2; ++ai)
#pragma unroll
                for (int m = 0; m < 4; ++m) { const int ch = row0 + ai * 128 + m * 16;
#pragma unroll
                    for (int bj = 0; bj < 2; ++bj) { const int tok = col0 + bj * 128; const f32x4 v0 = acc[ai][bj][m][0], v1 = acc[ai][bj][m][1];
                        u32x4 w; w.x = cvt_pk_bf16(v0[0], v0[1]); w.y = cvt_pk_bf16(v0[2], v0[3]); w.z = cvt_pk_bf16(v1[0], v1[1]); w.w = cvt_pk_bf16(v1[2], v1[3]);
                        *(u32x4*)(UT + ((size_t)(tok >> 7) * HYC + ch) * 128 + (tok & 127)) = w; } }
            return;
        }
        if (u.kind == 2) {
#pragma unroll
            for (int bj = 0; bj < 2; ++bj) { const int t8 = u.pn * 256 + bj * 128 + wc * 32 + 8 * fq;
                int b, key; if (t8 < MROWS) { b = t8 >> 12; key = CTXL + (t8 & 4095); } else { const int j = t8 - MROWS; b = j >> 8; key = j & 255; }
                const int tile = key >> 6, k = key & 63, ipos = (k < 32) ? 4 * (k >> 3) : 16 + 4 * ((k - 32) >> 3);
#pragma unroll
                for (int ai = 0; ai < 2; ++ai)
#pragma unroll
                    for (int m = 0; m < 4; ++m) { const int ch = u.pm * 256 + ai * 128 + wr * 64 + m * 16 + fr;
                        unsigned char* dst = VT8 + ((((size_t)(b * NHEAD + (ch >> 7)) * 68 + tile) * 128 + (ch & 127)) * 64) + ipos;
                        const f32x4 v0 = acc[ai][bj][m][0], v1 = acc[ai][bj][m][1];
                        *(unsigned*)dst = pk4_fp8(v0[0], v0[1], v0[2], v0[3]); *(unsigned*)(dst + 32) = pk4_fp8(v1[0], v1[1], v1[2], v1[3]); } }
            return;
        }
        const int blk = fq >> 1, f = fq & 1;
        const int sec = u.pn >> 1;
        const bool ctx = (u.pm >= 128);
        if (sec == 0 && ctx) return;
        const int colbase = (u.pn & 1) * 256 + wc * 64 + 32 * blk + 8 * f;
        float gg[2][2][4];
        { const float* gp = (sec == 0 ? gq : gk) + 32 * blk + 8 * f;
#pragma unroll
            for (int bj = 0; bj < 2; ++bj)
#pragma unroll
                for (int n = 0; n < 2; ++n) { const f32x4 t = *(const f32x4*)(gp + 16 * bj + 4 * n); gg[bj][n][0] = t[0]; gg[bj][n][1] = t[1]; gg[bj][n][2] = t[2]; gg[bj][n][3] = t[3]; } }
#pragma unroll
        for (int ai = 0; ai < 2; ++ai)
#pragma unroll
            for (int m = 0; m < 4; ++m) {
                const int rloc = ai * 128 + wr * 64 + m * 16 + fr; const int r = u.pm * 256 + rloc;
                f32x4 v[2][2];
#pragma unroll
                for (int bj = 0; bj < 2; ++bj)
#pragma unroll
                    for (int n = 0; n < 2; ++n) v[bj][n] = acc[ai][bj][m][n];
                size_t orow;
                if (sec == 0) orow = (size_t)r;
                else if (!ctx) orow = (size_t)(r >> 12) * KVL + CTXL + (r & 4095);
                else { const int j = r - MROWS; orow = (size_t)(j >> 8) * KVL + (j & 255); }
                float ss = 0.f;
#pragma unroll
                for (int bj = 0; bj < 2; ++bj)
#pragma unroll
                    for (int n = 0; n < 2; ++n) ss += (v[bj][n][0] * v[bj][n][0] + v[bj][n][1] * v[bj][n][1]) + (v[bj][n][2] * v[bj][n][2] + v[bj][n][3] * v[bj][n][3]);
                ss += __shfl_xor(ss, 16); ss += __shfl_xor(ss, 32);
                const float rstd = rsqrtf(ss * (1.f / 64.f) + EPS) * (sec == 0 ? QSCALE * Q8SCALE : 1.f);
#pragma unroll
                for (int bj = 0; bj < 2; ++bj)
#pragma unroll
                    for (int n = 0; n < 2; ++n)
#pragma unroll
                        for (int e = 0; e < 4; ++e) v[bj][n][e] *= rstd * gg[bj][n][e];
                if (!ctx) {
                    const int t = r & 4095; const int pos = blk ? (t & 63) : (t >> 6);
                    const float* rp = rope + (size_t)(pos * 16 + 8 * f) * 2;
#pragma unroll
                    for (int n = 0; n < 2; ++n) { const f32x4 c0 = *(const f32x4*)(rp + 8 * n), c1 = *(const f32x4*)(rp + 8 * n + 4);
                        const float cs[4] = {c0[0], c0[2], c1[0], c1[2]}, sn[4] = {c0[1], c0[3], c1[1], c1[3]};
#pragma unroll
                        for (int e = 0; e < 4; ++e) { const float x1 = v[0][n][e], x2 = v[1][n][e]; v[0][n][e] = x1 * cs[e] - x2 * sn[e]; v[1][n][e] = x2 * cs[e] + x1 * sn[e]; } }
                }
                unsigned char* dst = (sec == 0 ? Q8 : K8) + orow * QKW + colbase;
#pragma unroll
                for (int bj = 0; bj < 2; ++bj) { u32x2 w; w.x = pk4_fp8(v[bj][0][0], v[bj][0][1], v[bj][0][2], v[bj][0][3]); w.y = pk4_fp8(v[bj][1][0], v[bj][1][1], v[bj][1][2], v[bj][1][3]);
                    *(u32x2*)(dst + 16 * bj) = w; }
            }
    }
};

struct SchedStatic {
    int G, c, nM, nN; const char* A; const char* B;
    __device__ __forceinline__ bool next(int i, g8::Unit& u) const {
        const long L = (long)i * G + c; if (L >= (long)nM * nN) return false;
        g8::tile_of((int)L, nM, nN, u.pm, u.pn); u.a = A + (size_t)u.pm * 256 * DM * 2; u.b = B + (size_t)u.pn * 256 * DM * 2; u.kind = 0; u.ex = 0; return true;
    }
};
struct EpiOutProj {
    const float* x; bf16_t* out; const float* mod;
    __device__ __forceinline__ void operator()(f32x4 (&acc)[2][2][4][2], const g8::Unit& u, int wr, int wc, int fr, int fq) const {
        asm volatile("" : "+v"(fr), "+v"(fq));
        const int col0 = u.pn * 256 + wc * 32 + 8 * fq;
        const float* g1 = mod + (size_t)((u.pm * 256) >> 12) * (NMOD * DM) + 2 * DM + col0;
        f32x4 gv[2][2];
#pragma unroll
        for (int bj = 0; bj < 2; ++bj)
#pragma unroll
            for (int n = 0; n < 2; ++n) gv[bj][n] = *(const f32x4*)(g1 + bj * 128 + 4 * n);
#pragma unroll
        for (int ai = 0; ai < 2; ++ai)
#pragma unroll
            for (int m = 0; m < 4; ++m) { const int r = u.pm * 256 + ai * 128 + wr * 64 + m * 16 + fr;
                const size_t off = (size_t)r * DM + col0;
#pragma unroll
                for (int bj = 0; bj < 2; ++bj) { f32x4 o[2];
#pragma unroll
                    for (int n = 0; n < 2; ++n) { const f32x4 xv = __builtin_nontemporal_load((const f32x4*)(x + off + bj * 128 + 4 * n)); o[n] = xv + gv[bj][n] * acc[ai][bj][m][n]; }
                    u32x4 w; w.x = cvt_pk_bf16(o[0][0], o[0][1]); w.y = cvt_pk_bf16(o[0][2], o[0][3]); w.z = cvt_pk_bf16(o[1][0], o[1][1]); w.w = cvt_pk_bf16(o[1][2], o[1][3]);
                    *(u32x4*)(out + off + bj * 128) = w; } }
    }
};

namespace att8 {
constexpr int NT = KVL / 64, SHMB = 8192, LDS_V0 = 4 * SHMB;
typedef int i32x8 __attribute__((ext_vector_type(8)));
#define SBAR() __builtin_amdgcn_sched_barrier(0)
__device__ __forceinline__ int crow(int r, int hi) { return (r & 3) + 8 * (r >> 2) + 4 * hi; }
__device__ __forceinline__ i32x8 ld32(const LAS unsigned char* p0, const LAS unsigned char* p1) {
    const u32x4 a = *(const LAS u32x4*)p0, b = *(const LAS u32x4*)p1; return (i32x8){(int)a.x, (int)a.y, (int)a.z, (int)a.w, (int)b.x, (int)b.y, (int)b.z, (int)b.w}; }
__device__ __forceinline__ void mfma_qk(f32x16& p, const i32x8& kf, const i32x8& qf, const f32x16& negc) {
    const unsigned s1 = 0x7f7f7f7fu, sq = 0x7b7b7b7bu;
    asm volatile("v_mfma_scale_f32_32x32x64_f8f6f4 %0, %1, %2, %3, %4, %5 op_sel_hi:[0,0,0]" : "=&v"(p) : "v"(kf), "v"(qf), "v"(negc), "v"(s1), "v"(sq));
}
__device__ __forceinline__ void mfma_pv(f32x16& o, const i32x8& pa, const i32x8& vf) {
    const unsigned s1 = 0x7f7f7f7fu;
    asm volatile("v_mfma_scale_f32_32x32x64_f8f6f4 %0, %1, %2, %0, %3, %3 op_sel_hi:[0,0,0]" : "+v"(o) : "v"(pa), "v"(vf), "v"(s1));
}
__device__ __forceinline__ void mfma_wait(f32x16& p0, f32x16& p1) { asm volatile("s_nop 15\n\ts_nop 3" : "+v"(p0), "+v"(p1)); }
__device__ __forceinline__ int grp(const f32x16& s, const int g) {
    return (int)pk4_fp8(__builtin_amdgcn_exp2f(s[4 * g]), __builtin_amdgcn_exp2f(s[4 * g + 1]), __builtin_amdgcn_exp2f(s[4 * g + 2]), __builtin_amdgcn_exp2f(s[4 * g + 3]));
}
__device__ __forceinline__ void attn_unit(const unsigned char* __restrict__ Qb, const unsigned char* __restrict__ Kh, const unsigned char* __restrict__ VTh, bf16_t* MIXo,
                                          const float lam, const float* __restrict__ subg, char* lds, const int wid) {
    const int lane = lane_id(), tid = wid * 64 + lane, r32 = lane & 31, hi = lane >> 5;
    const int sub = wid >> 2, wq = wid & 3;
    const LAS unsigned char* L = (const LAS unsigned char*)(uintptr_t)(unsigned)(uintptr_t)lds;
    f32x16 o[4] = {}; f32x16 ol = {};
    i32x8 ones; { int c1 = 0x38383838; asm volatile("" : "+v"(c1)); ones = (i32x8){c1, c1, c1, c1, c1, c1, c1, c1}; }
    i32x8 qf; { const unsigned char* qp = Qb + (size_t)(wq * 32 + r32) * QKW + sub * 64 + 32 * hi; const u32x4 a = *(const u32x4*)qp, b = *(const u32x4*)(qp + 16);
        qf = (i32x8){(int)a.x, (int)a.y, (int)a.z, (int)a.w, (int)b.x, (int)b.y, (int)b.z, (int)b.w}; }
    f32x16 negc; { float m5 = -5.f; asm volatile("" : "+v"(m5));
#pragma unroll
        for (int r = 0; r < 16; ++r) negc[r] = m5; }
    long ksrc, vsrc;
    { const int r = 8 * wid + (lane >> 3), c = (lane & 7) ^ ((r >> 1) & 7); ksrc = (long)r * QKW + c * 16; }
    { const int d = 16 * wid + (lane >> 2), c = (lane & 3) ^ ((d >> 2) & 3); vsrc = (long)d * 64 + c * 16; }
    const unsigned ldsb = (unsigned)(uintptr_t)lds, kdst = ldsb + (unsigned)wid * 1024u, vdst = ldsb + LDS_V0 + (unsigned)wid * 1024u;
    const LAS unsigned char *pk0, *pk1, *pv0, *pv1;
    { const int c0 = sub * 4 + hi * 2, sk = (r32 >> 1) & 7, sv = (r32 >> 2) & 3;
      pk0 = L + r32 * 128 + ((c0 ^ sk) << 4); pk1 = L + r32 * 128 + (((c0 + 1) ^ sk) << 4);
      pv0 = L + LDS_V0 + r32 * 64 + (((2 * hi) ^ sv) << 4); pv1 = L + LDS_V0 + r32 * 64 + (((2 * hi + 1) ^ sv) << 4); }
#define KF(b, w) ld32(pk0 + (b) * SHMB + (w) * 4096, pk1 + (b) * SHMB + (w) * 4096)
#define VF(b, d0) ld32(pv0 + (b) * SHMB + (d0) * 2048, pv1 + (b) * SHMB + (d0) * 2048)
#define DMA_TILE(t, b) do { \
        __builtin_amdgcn_global_load_lds((const unsigned*)(Kh + (long)(t) * 64 * QKW + ksrc), (LAS unsigned*)(uintptr_t)__builtin_amdgcn_readfirstlane(kdst + (unsigned)((b) * SHMB)), 16, 0, 0); \
        __builtin_amdgcn_global_load_lds((const unsigned*)(VTh + (long)(t) * 8192 + vsrc), (LAS unsigned*)(uintptr_t)__builtin_amdgcn_readfirstlane(vdst + (unsigned)((b) * SHMB)), 16, 0, 0); } while (0)
#define WBAR() do { asm volatile("s_waitcnt vmcnt(0)" ::: "memory"); __builtin_amdgcn_s_barrier(); asm volatile("" ::: "memory"); } while (0)
#define ITER(J, U, SX0, SX1, SY0, SY1, PC, PN, DO_DMA, DO_QK, DO_BAR) do { \
        mfma_pv(ol, PC, ones); SBAR(); \
        if (DO_DMA) DMA_TILE((J) + 2, ((U) + 3) & 3); \
        if (DO_QK) { kf0 = KF(((U) + 2) & 3, 0); kf1 = KF(((U) + 2) & 3, 1); } \
        vf2 = VF(U, 2); vf3 = VF(U, 3); SBAR(); \
        mfma_pv(o[0], PC, vf0); SBAR(); PN[0] = grp(SX0, 0); SBAR(); \
        mfma_pv(o[1], PC, vf1); SBAR(); PN[1] = grp(SX0, 1); SBAR(); \
        mfma_pv(o[2], PC, vf2); SBAR(); PN[2] = grp(SX0, 2); SBAR(); \
        mfma_pv(o[3], PC, vf3); SBAR(); PN[3] = grp(SX0, 3); SBAR(); \
        if (DO_QK) mfma_qk(SY0, kf0, qf, negc); SBAR(); PN[4] = grp(SX1, 0); SBAR(); \
        if (DO_QK) mfma_qk(SY1, kf1, qf, negc); SBAR(); PN[5] = grp(SX1, 1); PN[6] = grp(SX1, 2); PN[7] = grp(SX1, 3); \
        vf0 = VF(((U) + 1) & 3, 0); vf1 = VF(((U) + 1) & 3, 1); SBAR(); \
        if (DO_BAR) WBAR(); } while (0)
    f32x16 A0, A1, B0, B1; i32x8 paA, paB, kf0, kf1, vf0, vf1, vf2, vf3;
    DMA_TILE(0, 0); DMA_TILE(1, 1); DMA_TILE(2, 2); WBAR();
    kf0 = KF(0, 0); kf1 = KF(0, 1); mfma_qk(A0, kf0, qf, negc); mfma_qk(A1, kf1, qf, negc);
    kf0 = KF(1, 0); kf1 = KF(1, 1); SBAR(); mfma_qk(B0, kf0, qf, negc); mfma_qk(B1, kf1, qf, negc);
    mfma_wait(A0, A1);
#pragma unroll
    for (int g = 0; g < 4; ++g) { paA[g] = grp(A0, g); paA[4 + g] = grp(A1, g); }
    mfma_wait(B0, B1);
    vf0 = VF(0, 0); vf1 = VF(0, 1); SBAR();
#pragma unroll 1
    for (int j = 1; j < NT - 4; j += 4) {
        ITER(j, 0, B0, B1, A0, A1, paA, paB, true, true, true);
        ITER(j + 1, 1, A0, A1, B0, B1, paB, paA, true, true, true);
        ITER(j + 2, 2, B0, B1, A0, A1, paA, paB, true, true, true);
        ITER(j + 3, 3, A0, A1, B0, B1, paB, paA, true, true, true);
    }
    static_assert(NT == 68, "the peeled tail below is written for 68 KV tiles");
    ITER(65, 0, B0, B1, A0, A1, paA, paB, true, true, true);
    ITER(66, 1, A0, A1, B0, B1, paB, paA, false, true, false);
    ITER(67, 2, B0, B1, A0, A1, paA, paB, false, false, false);
    mfma_pv(ol, paB, ones); vf2 = VF(3, 2); vf3 = VF(3, 3); SBAR();
    mfma_pv(o[0], paB, vf0); mfma_pv(o[1], paB, vf1); mfma_pv(o[2], paB, vf2); mfma_pv(o[3], paB, vf3);
    asm volatile("s_nop 15\n\ts_nop 3" : "+v"(o[0]), "+v"(o[1]), "+v"(o[2]), "+v"(o[3]), "+v"(ol));
#undef ITER
#undef KF
#undef VF
#undef DMA_TILE
#undef WBAR
    __syncthreads();
    float* X = (float*)lds;
    float rli[16];
#pragma unroll
    for (int r = 0; r < 16; ++r) rli[r] = __builtin_amdgcn_rcpf(ol[r]);
    if (sub == 1) {
#pragma unroll
        for (int r = 0; r < 16; ++r) { const int row = wq * 32 + crow(r, hi); const float sc = lam * rli[r];
#pragma unroll
            for (int d0 = 0; d0 < 4; ++d0) X[row * 128 + d0 * 32 + r32] = o[d0][r] * sc; }
    }
    __syncthreads();
    bf16_t* Y = (bf16_t*)(lds + 65536);
    if (sub == 0) {
        float sg[4];
#pragma unroll
        for (int d0 = 0; d0 < 4; ++d0) sg[d0] = subg[d0 * 32 + r32] * (1.f - LAM_INIT);
#pragma unroll
        for (int r = 0; r < 16; ++r) { const int row = wq * 32 + crow(r, hi);
            float v[4]; float ss = 0.f;
#pragma unroll
            for (int d0 = 0; d0 < 4; ++d0) { v[d0] = o[d0][r] * rli[r] - X[row * 128 + d0 * 32 + r32]; ss += v[d0] * v[d0]; }
            ss += __shfl_xor(ss, 1); ss += __shfl_xor(ss, 2); ss += __shfl_xor(ss, 4); ss += __shfl_xor(ss, 8); ss += __shfl_xor(ss, 16);
            const float rstd = rsqrtf(ss * (1.f / 128.f) + EPS);
#pragma unroll
            for (int d0 = 0; d0 < 4; ++d0) Y[row * 128 + d0 * 32 + r32] = (bf16_t)(cvt_pk_bf16(v[d0] * rstd * sg[d0], 0.f) & 0xffffu); }
    }
    __syncthreads();
    { const int row = tid >> 2, seg = (tid & 3) * 32;
#pragma unroll
        for (int i = 0; i < 4; ++i) { const u32x4 v = *(const u32x4*)(Y + row * 128 + seg + i * 8); *(u32x4*)(MIXo + (size_t)row * DM + seg + i * 8) = v; } }
    __syncthreads();
}
#undef SBAR
}

__device__ __forceinline__ void p3_attention8(Frame& F) {
    FT_DECL;
    const float* sc = WSP(float, WS_SMALL + SM_SCAL);
    const float lam = sc[0];
    const unsigned char* Q8 = WSP(unsigned char, WS_Q); const unsigned char* K8 = WSP(unsigned char, WS_K); const unsigned char* VT8 = WSP(unsigned char, WS_V); bf16_t* MIX = WSP(bf16_t, WS_MIX);
    const int c = blockIdx.x, xcd = c & 7, ci = c >> 3, per = F.G >> 3;
    for (int j = ci; j < 128; j += per) {
        const int pair = xcd * 4 + (j >> 5), qb = j & 31, b = pair >> 2, h = pair & 3;
        att8::attn_unit(Q8 + ((size_t)b * SEQ + qb * 128) * QKW + h * 128, K8 + (size_t)b * KVL * QKW + h * 128, VT8 + (size_t)(b * NHEAD + h) * 68 * 8192,
                        MIX + ((size_t)b * SEQ + qb * 128) * DM + h * 128, lam, F.in[15], (char*)F.lds, F.wave);
    }
}

namespace hy {
constexpr int RB_BYTES = 4352 * 8, IN_OFF = 2 * RB_BYTES, TW1_OFF = IN_OFF + 32768, TW2_OFF = TW1_OFF + 15 * 256 * 8, LDS_END = TW2_OFF + 15 * 16 * 8;
__device__ __forceinline__ f32x2 cmul(f32x2 a, f32x2 b) { return (f32x2){a.x * b.x - a.y * b.y, a.x * b.y + a.y * b.x}; }
__device__ __forceinline__ f32x2 cmulc(f32x2 a, f32x2 b) { return (f32x2){a.x * b.x + a.y * b.y, a.y * b.x - a.x * b.y}; }
__device__ __forceinline__ int P(int i) { return i + (i >> 4); }
template <bool INV> __device__ __forceinline__ void r4(f32x2& a, f32x2& b, f32x2& c, f32x2& d) {
    const f32x2 t0 = a + c, t1 = a - c, t2 = b + d, t3 = b - d;
    const f32x2 st3 = INV ? (f32x2){-t3.y, t3.x} : (f32x2){t3.y, -t3.x};
    a = t0 + t2; c = t0 - t2; b = t1 + st3; d = t1 - st3;
}
template <bool INV> __device__ __forceinline__ f32x2 tw(f32x2 v, float c, float s) {
    return INV ? (f32x2){v.x * c - v.y * s, v.y * c + v.x * s} : (f32x2){v.x * c + v.y * s, v.y * c - v.x * s};
}
template <bool INV> __device__ __forceinline__ void dft16(f32x2 (&v)[16]) {
    constexpr float C1 = 0.9238795325112867f, S1 = 0.3826834323650898f, R2 = 0.7071067811865476f;
    r4<INV>(v[0], v[4], v[8], v[12]); r4<INV>(v[1], v[5], v[9], v[13]); r4<INV>(v[2], v[6], v[10], v[14]); r4<INV>(v[3], v[7], v[11], v[15]);
    v[5] = tw<INV>(v[5], C1, S1);  v[9] = tw<INV>(v[9], R2, R2);    v[13] = tw<INV>(v[13], S1, C1);
    v[6] = tw<INV>(v[6], R2, R2);  v[10] = tw<INV>(v[10], 0.f, 1.f); v[14] = tw<INV>(v[14], -R2, R2);
    v[7] = tw<INV>(v[7], S1, C1);  v[11] = tw<INV>(v[11], -R2, R2);  v[15] = tw<INV>(v[15], -C1, -S1);
    r4<INV>(v[0], v[1], v[2], v[3]); r4<INV>(v[4], v[5], v[6], v[7]); r4<INV>(v[8], v[9], v[10], v[11]); r4<INV>(v[12], v[13], v[14], v[15]);
    f32x2 t;
    t = v[1]; v[1] = v[4]; v[4] = t;   t = v[2]; v[2] = v[8]; v[8] = t;    t = v[3]; v[3] = v[12]; v[12] = t;
    t = v[6]; v[6] = v[9]; v[9] = t;   t = v[7]; v[7] = v[13]; v[13] = t;  t = v[11]; v[11] = v[14]; v[14] = t;
}
struct Ctx { LAS f32x2* R; LAS f32x2* IN; LAS f32x2* TW1; LAS f32x2* TW2; int t, half; f32x2 wt; };
#define HY_OPAQUE(x) asm volatile("" : "+v"(x))
#define HY_W32(m) (f32x2){__builtin_cosf(-0.19634954084936207f * (m)), __builtin_sinf(-0.19634954084936207f * (m))}
template <int MODE> __device__ __forceinline__ void pass1_fwd(const Ctx& X) {
    f32x2 v[16]; int t = X.t; HY_OPAQUE(t);
#pragma unroll
    for (int m = 0; m < 16; ++m) { f32x2 a = X.IN[t + 256 * m]; if (MODE == 1) a = (f32x2){X.half ? a.y : a.x, 0.f}; v[m] = a; }
    if (X.half) {
#pragma unroll
        for (int m = 0; m < 16; ++m) v[m] = cmul(cmul(v[m], HY_W32(m)), X.wt);
    }
    dft16<false>(v);
#pragma unroll
    for (int q = 1; q < 16; ++q) v[q] = cmul(v[q], X.TW1[(q - 1) * 256 + t]);
    const int pb = t + (t >> 4);
#pragma unroll
    for (int q = 0; q < 16; ++q) X.R[pb + 272 * q] = v[q];
}
__device__ __forceinline__ void pass2_fwd(const Ctx& X) {
    int t = X.t; HY_OPAQUE(t);
    const int n2 = t & 15, pb = (t >> 4) * 272 + n2; f32x2 v[16];
#pragma unroll
    for (int m = 0; m < 16; ++m) v[m] = X.R[pb + 17 * m];
    dft16<false>(v);
#pragma unroll
    for (int q = 1; q < 16; ++q) v[q] = cmul(v[q], X.TW2[(q - 1) * 16 + n2]);
#pragma unroll
    for (int q = 0; q < 16; ++q) X.R[pb + 17 * q] = v[q];
}
template <bool FILTER> __device__ __forceinline__ void pass3(const Ctx& X, f32x2 (&H)[16]) {
    f32x2 v[16]; int t = X.t; HY_OPAQUE(t); const int pb = 17 * t;
#pragma unroll
    for (int m = 0; m < 16; ++m) v[m] = X.R[pb + m];
    dft16<false>(v);
    if (FILTER) {
#pragma unroll
        for (int q = 0; q < 16; ++q) H[q] = v[q] * (1.f / 8192.f);
    } else {
#pragma unroll
        for (int q = 0; q < 16; ++q) v[q] = cmul(v[q], H[q]);
        dft16<true>(v);
#pragma unroll
        for (int m = 0; m < 16; ++m) X.R[pb + m] = v[m];
    }
}
__device__ __forceinline__ void pass2_inv(const Ctx& X) {
    int t = X.t; HY_OPAQUE(t);
    const int n2 = t & 15, pb = (t >> 4) * 272 + n2; f32x2 v[16];
    v[0] = X.R[pb];
#pragma unroll
    for (int q = 1; q < 16; ++q) v[q] = cmulc(X.R[pb + 17 * q], X.TW2[(q - 1) * 16 + n2]);
    dft16<true>(v);
#pragma unroll
    for (int m = 0; m < 16; ++m) X.R[pb + 17 * m] = v[m];
}
__device__ __forceinline__ void pass1_inv(const Ctx& X) {
    f32x2 v[16]; int t = X.t; HY_OPAQUE(t); const int pb = t + (t >> 4);
    v[0] = X.R[pb];
#pragma unroll
    for (int q = 1; q < 16; ++q) v[q] = cmulc(X.R[pb + 272 * q], X.TW1[(q - 1) * 256 + t]);
    dft16<true>(v);
    if (X.half) {
#pragma unroll
        for (int m = 0; m < 16; ++m) v[m] = cmulc(cmulc(v[m], HY_W32(m)), X.wt);
    }
#pragma unroll
    for (int m = 0; m < 16; ++m) X.R[pb + 272 * m] = v[m];
}
#define HY_WSYNC() asm volatile("s_waitcnt lgkmcnt(0)" ::: "memory")
__device__ __forceinline__ void conv_fft(const Ctx& X, f32x2 (&H)[16]) {
    __syncthreads(); pass1_fwd<0>(X); __syncthreads(); pass2_fwd(X); HY_WSYNC(); pass3<false>(X, H); HY_WSYNC(); pass2_inv(X); __syncthreads(); pass1_inv(X); __syncthreads();
}
constexpr int STG_OFF = LDS_END;
constexpr int LDS_END2 = STG_OFF + 2 * SEQ * 2;
static_assert(LDS_END2 <= LDSCTL_OFF, "hyena LDS map");
__device__ __forceinline__ float sconv_lds(const LAS bf16_t* stg, int bs, int n, float w0, float w1, float w2, float bias) {
    const LAS bf16_t* p = stg + bs * SEQ;
    const float c = bf2f(p[n]), lv = bf2f(p[n - ((n > 0) ? 1 : 0)]), rv = bf2f(p[n + ((n < SEQ - 1) ? 1 : 0)]);
    const float l = (n > 0) ? lv : 0.f, r = (n < SEQ - 1) ? rv : 0.f;
    return bias + w0 * l + w1 * c + w2 * r;
}
__device__ __forceinline__ void setup_tables(LAS unsigned char* lds, int tid) {
    LAS f32x2* TW1 = (LAS f32x2*)(lds + TW1_OFF); LAS f32x2* TW2 = (LAS f32x2*)(lds + TW2_OFF);
    for (int i = tid; i < 15 * 256; i += 512) { const int q = i / 256 + 1, t = i & 255; float s, c; sincosf(-6.283185307179586f * (float)((t * q) & 4095) * (1.f / 4096.f), &s, &c); TW1[i] = (f32x2){c, s}; }
    for (int i = tid; i < 15 * 16; i += 512) { const int q = i / 16 + 1, n2 = i & 15; float s, c; sincosf(-6.283185307179586f * (float)((n2 * q) & 255) * (1.f / 256.f), &s, &c); TW2[i] = (f32x2){c, s}; }
}
__device__ __forceinline__ void unit(Frame& F, int c) {
    FT_DECL;
    const int tid = f_tid; Ctx X; X.half = F.wave >> 2; X.t = tid & 255;
    X.R = (LAS f32x2*)(F.lds + X.half * RB_BYTES); X.IN = (LAS f32x2*)(F.lds + IN_OFF); X.TW1 = (LAS f32x2*)(F.lds + TW1_OFF); X.TW2 = (LAS f32x2*)(F.lds + TW2_OFF);
    { float s, cc; sincosf(-6.283185307179586f * (float)X.t * (1.f / 8192.f), &s, &cc); X.wt = (f32x2){cc, s}; }
    LAS f32x2* RB0 = (LAS f32x2*)(F.lds); LAS f32x2* RB1 = (LAS f32x2*)(F.lds + RB_BYTES);
    const float* FILT = WSP(float, WS_FILT);
    f32x2 H0[16], H1[16];
#pragma unroll
    for (int ord = 0; ord < 2; ++ord) {
        const float* hf = FILT + ((size_t)(ord * 2 + 0) * 512 + c) * SEQ; const float* hb = FILT + ((size_t)(ord * 2 + 1) * 512 + c) * SEQ;
        __syncthreads();
        int nb = tid; HY_OPAQUE(nb);
#pragma unroll
        for (int j = 0; j < 8; ++j) { const int n = nb + 512 * j; const float a = hf[n], b = hb[(SEQ - n) & (SEQ - 1)]; const float lo = (n == 0) ? a + b : a, hi = (n == 0) ? 0.f : b; X.IN[n] = (f32x2){lo + hi, lo - hi}; }
        __syncthreads(); pass1_fwd<1>(X); __syncthreads(); pass2_fwd(X); HY_WSYNC();
        if (ord == 0) pass3<true>(X, H0); else pass3<true>(X, H1);
    }
    const bf16_t* UT = WSP(bf16_t, WS_UT);
    const bf16_t* rv = UT + (size_t)c * 128; const bf16_t* r1 = UT + (size_t)(512 + c) * 128; const bf16_t* r2 = UT + (size_t)(1024 + c) * 128;
#define HY_LD(rowp, t) (*(const u32x4*)((rowp) + (size_t)((t) >> 7) * (HYC * 128) + ((t) & 127)))
    const float* cw = F.in[16]; const float* cb = F.in[17];
    const float wv0 = cw[c], wv1 = cw[HYC + c], wv2 = cw[2 * HYC + c], bv = cb[c];
    const float wa0 = cw[512 + c], wa1 = cw[HYC + 512 + c], wa2 = cw[2 * HYC + 512 + c], ba = cb[512 + c];
    const float wb0 = cw[1024 + c], wb1 = cw[HYC + 1024 + c], wb2 = cw[2 * HYC + 1024 + c], bb = cb[1024 + c];
    const float sk0 = F.in[25][c], sk1 = F.in[25][512 + c];
    bf16_t* Z = WSP(bf16_t, WS_Z2T) + (size_t)c * 128;
    LAS bf16_t* STG = (LAS bf16_t*)(F.lds + STG_OFF);
    u32x4 g0 = HY_LD(rv, tid * 8), g1 = HY_LD(rv, SEQ + tid * 8);
    for (int pr = 0; pr < 4; ++pr) {
        const int b0 = 2 * pr, b1 = b0 + 1;
        f32x2 z[8]; int pc = tid + (tid >> 4); HY_OPAQUE(pc); int nb = tid; HY_OPAQUE(nb);
        __syncthreads();
        *(LAS u32x4*)(STG + tid * 8) = g0; *(LAS u32x4*)(STG + SEQ + tid * 8) = g1;
        __syncthreads();
#pragma unroll
        for (int j = 0; j < 8; ++j) { const int n = nb + 512 * j; z[j] = (f32x2){sconv_lds(STG, 0, n, wv0, wv1, wv2, bv), sconv_lds(STG, 1, n, wv0, wv1, wv2, bv)}; X.IN[n] = z[j]; }
        g0 = HY_LD(r1, b0 * SEQ + tid * 8); g1 = HY_LD(r1, b1 * SEQ + tid * 8);
        conv_fft(X, H0);
        *(LAS u32x4*)(STG + tid * 8) = g0; *(LAS u32x4*)(STG + SEQ + tid * 8) = g1;
        __syncthreads();
        HY_OPAQUE(nb); HY_OPAQUE(pc);
#pragma unroll
        for (int j = 0; j < 8; ++j) { const int n = nb + 512 * j; const f32x2 y = RB0[pc + 544 * j] + RB1[pc + 544 * j];
            const f32x2 g = (f32x2){sconv_lds(STG, 0, n, wa0, wa1, wa2, ba), sconv_lds(STG, 1, n, wa0, wa1, wa2, ba)};
            z[j] = g * (y + sk0 * z[j]); X.IN[n] = z[j]; }
        g0 = HY_LD(r2, b0 * SEQ + tid * 8); g1 = HY_LD(r2, b1 * SEQ + tid * 8);
        conv_fft(X, H1);
        *(LAS u32x4*)(STG + tid * 8) = g0; *(LAS u32x4*)(STG + SEQ + tid * 8) = g1;
        __syncthreads();
        if (pr < 3) { g0 = HY_LD(rv, (b0 + 2) * SEQ + tid * 8); g1 = HY_LD(rv, (b1 + 2) * SEQ + tid * 8); }
        HY_OPAQUE(nb); HY_OPAQUE(pc);
        f32x2 o[8];
#pragma unroll
        for (int j = 0; j < 8; ++j) { const int n = nb + 512 * j; const f32x2 y = RB0[pc + 544 * j] + RB1[pc + 544 * j];
            const f32x2 g = (f32x2){sconv_lds(STG, 0, n, wb0, wb1, wb2, bb), sconv_lds(STG, 1, n, wb0, wb1, wb2, bb)};
            o[j] = g * (y + sk1 * z[j]); }
        __syncthreads();
#pragma unroll
        for (int j = 0; j < 8; ++j) { const int n = nb + 512 * j; STG[n] = (bf16_t)(cvt_pk_bf16(o[j].x, 0.f) & 0xffffu); STG[SEQ + n] = (bf16_t)(cvt_pk_bf16(o[j].y, 0.f) & 0xffffu); }
        __syncthreads();
        { const int t0 = b0 * SEQ + tid * 8, t1 = b1 * SEQ + tid * 8;
          *(u32x4*)(Z + (size_t)(t0 >> 7) * (HYW * 128) + (t0 & 127)) = *(const LAS u32x4*)(STG + tid * 8); *(u32x4*)(Z + (size_t)(t1 >> 7) * (HYW * 128) + (t1 & 127)) = *(const LAS u32x4*)(STG + SEQ + tid * 8); }
    }
    __syncthreads();
}
}

__device__ __forceinline__ void p3_hyena(Frame& F) {
    FT_DECL;
    __syncthreads();
    hy::setup_tables(F.lds, f_tid);
    __syncthreads();
    for (int c = F.vcu; c < HYW; c += F.G) hy::unit(F, c);
}

__device__ __forceinline__ void p4_hynorm(Frame& F) {
    FT_DECL;
    const bf16_t* Z = WSP(bf16_t, WS_Z2T); bf16_t* MIX = WSP(bf16_t, WS_MIX); const float* g = F.in[26];
    constexpr int TP = 132;
    LAS bf16_t* T = (LAS bf16_t*)F.lds;
    LAS float* red = (LAS float*)(F.lds + 512 * TP * 2);
    LAS float* rs = red + 512;
    float gl[8];
#pragma unroll
    for (int e = 0; e < 8; ++e) gl[e] = g[(f_tid & 63) + 64 * e];
    for (int it = F.vcu; it < MROWS / 128; it += F.G) {
        const int tok0 = it * 128; const bf16_t* zt = Z + (size_t)it * (HYW * 128);
        __syncthreads();
        u32x4 v[16];
#pragma unroll
        for (int j = 0; j < 16; ++j) v[j] = __builtin_nontemporal_load((const u32x4*)(zt + (size_t)(f_tid + 512 * j) * 8));
#pragma unroll
        for (int j = 0; j < 16; ++j) { const int i = f_tid + 512 * j; LAS u32x2* d = (LAS u32x2*)(T + (i >> 4) * TP + (i & 15) * 8); d[0] = (u32x2){v[j].x, v[j].y}; d[1] = (u32x2){v[j].z, v[j].w}; }
        __syncthreads();
        { const int tok = f_tid & 127, grp = f_tid >> 7; float ss = 0.f;
#pragma unroll 8
            for (int k = 0; k < 128; ++k) { const float x = bf2f(T[(grp * 128 + k) * TP + tok]); ss += x * x; }
            red[grp * 128 + tok] = ss; }
        __syncthreads();
        if (f_tid < 128) rs[f_tid] = rsqrtf(((red[f_tid] + red[128 + f_tid]) + (red[256 + f_tid] + red[384 + f_tid])) * (1.f / HYW) + EPS);
        __syncthreads();
#pragma unroll
        for (int j = 0; j < 16; ++j) { const int i = f_tid + 512 * j, tok = i >> 6, l = i & 63; const float r = rs[tok];
            float x[8];
#pragma unroll
            for (int e = 0; e < 8; ++e) x[e] = bf2f(T[(l + 64 * e) * TP + tok]) * r * gl[e];
            u32x4 w; w.x = cvt_pk_bf16(x[0], x[1]); w.y = cvt_pk_bf16(x[2], x[3]); w.z = cvt_pk_bf16(x[4], x[5]); w.w = cvt_pk_bf16(x[6], x[7]);
            *(u32x4*)(MIX + (size_t)(tok0 + tok) * DM + 512 + 8 * l) = w; }
    }
}

constexpr size_t RT_TOPI = 0;
constexpr size_t RT_GATE = 512 * 1024;
constexpr size_t RT_POS = 1024 * 1024;
constexpr size_t RT_WGCNT = 1536 * 1024;
constexpr size_t RT_META = 1600 * 1024;
constexpr size_t RT_LIST = 2048 * 1024;
constexpr size_t RT_GSLOT = 2048 * 1024 + 640 * 1024;
constexpr int MAXSLOT = MROWS * TOPK + NEXP * 256;
constexpr int MAXTILE = MAXSLOT / 256;
constexpr size_t WS_XS = WS_EO;
constexpr int RW_PITCH = 32;
constexpr int P6_LDS_TOPI = 1024 * RW_PITCH * 4;

__device__ __forceinline__ void p6_router_mfma(Frame& F) {
    FT_DECL;
#define in F.in
    LAS float* WP = (LAS float*)F.lds;
    LAS int* TI = (LAS int*)(F.lds + P6_LDS_TOPI);
    LAS int* PS = TI + 512;
    LAS int* SC = PS + 512;
    LAS float* RSTD = (LAS float*)(SC + 512);
    LAS float* BIAS = RSTD + 128;
    LAS float* SSX = BIAS + 32;
    const float* rw = in[28]; const float* mod = WSP(float, WS_SMALL + SM_MOD); const float* g2n = in[7]; const float* rb = in[29];
    const bf16_t* XN = WSP(bf16_t, WS_XN); unsigned char* H2 = WSP(unsigned char, WS_H);
    int* topi_g = WSP(int, WS_ROUTE + RT_TOPI); float* gate_g = WSP(float, WS_ROUTE + RT_GATE); int* pos_g = WSP(int, WS_ROUTE + RT_POS); int* wgcnt = WSP(int, WS_ROUTE + RT_WGCNT);
    for (int blk = blockIdx.x; blk < MROWS / 128; blk += F.G) {
        const float* sh2 = mod + (size_t)(blk >> 5) * (NMOD * DM) + 3 * DM; const float* sc2 = sh2 + DM;
        __syncthreads();
#pragma unroll 1
        for (int hb = 0; hb < 2; ++hb) { f32x4 wv[8]; float gm[8];
#pragma unroll
            for (int q = 0; q < 8; ++q) { const int i = f_tid + 512 * (8 * hb + q), k = i >> 3, c4 = i & 7; wv[q] = *(const f32x4*)(rw + (size_t)k * 32 + c4 * 4); gm[q] = g2n[k] * (1.f + sc2[k]); }
#pragma unroll
            for (int q = 0; q < 8; ++q) { const int i = f_tid + 512 * (8 * hb + q), k = i >> 3, c4 = i & 7; *(LAS f32x4*)(WP + k * 32 + c4 * 4) = wv[q] * gm[q]; } }
        { const int e = f_tid & 31, part = f_tid >> 5; float a = 0.f;
#pragma unroll 1
            for (int k0 = part * 64; k0 < part * 64 + 64; k0 += 8) { float w[8], sh[8];
#pragma unroll
                for (int q = 0; q < 8; ++q) { w[q] = rw[(size_t)(k0 + q) * 32 + e]; sh[q] = sh2[k0 + q]; }
#pragma unroll
                for (int q = 0; q < 8; ++q) a += sh[q] * w[q]; }
            ((LAS float*)SC)[part * 32 + e] = a; }
        __syncthreads();
        if (f_tid < 32) { float a = rb[f_tid];
#pragma unroll
            for (int p = 0; p < 16; ++p) a += ((LAS float*)SC)[p * 32 + f_tid];
            BIAS[f_tid] = a; }
        const int rg = F.wave & 3, kh = F.wave >> 2, j = f_lane & 31, hi = f_lane >> 5;
        f32x16 acc = {};
        float ss = 0.f;
        { const bf16_t* xrow = XN + (size_t)(blk * 128 + rg * 32 + j) * DM + 512 * kh + 8 * hi;
            const LAS float* wp = WP + (512 * kh + 8 * hi) * 32 + j;
#pragma unroll 8
            for (int c = 0; c < 32; ++c) { const u32x4 xb = *(const u32x4*)(xrow + 16 * c);
                float xf[8] = {__uint_as_float(xb.x << 16), __uint_as_float(xb.x & 0xffff0000u), __uint_as_float(xb.y << 16), __uint_as_float(xb.y & 0xffff0000u),
                               __uint_as_float(xb.z << 16), __uint_as_float(xb.z & 0xffff0000u), __uint_as_float(xb.w << 16), __uint_as_float(xb.w & 0xffff0000u)};
#pragma unroll
                for (int q = 0; q < 8; ++q) { ss += xf[q] * xf[q]; acc = __builtin_amdgcn_mfma_f32_32x32x2f32(wp[(16 * c + q) * 32], xf[q], acc, 0, 0, 0); } } }
        { auto rr = __builtin_amdgcn_permlane32_swap(__float_as_uint(ss), __float_as_uint(ss), false, false); ss = __uint_as_float(rr[0]) + __uint_as_float(rr[1]); }
        if (hi == 0) SSX[kh * 128 + rg * 32 + j] = ss;
        __syncthreads();
        if (kh == 1) {
#pragma unroll
            for (int r = 0; r < 16; ++r) WP[(rg * 16 + r) * 64 + f_lane] = acc[r]; }
        if (f_tid < 128) RSTD[f_tid] = rsqrtf((SSX[f_tid] + SSX[128 + f_tid]) * (1.f / DM) + EPS);
        __syncthreads();
        if (kh == 0) {
            const float rstd = RSTD[rg * 32 + j];
            float tv[4] = {-INFINITY, -INFINITY, -INFINITY, -INFINITY}; int ti[4] = {1 << 20, 1 << 20, 1 << 20, 1 << 20};
#define P6_INS(V, E) do { float cv = (V); int ce = (E); _Pragma("unroll") for (int q = 0; q < 4; ++q) { const bool b = cv > tv[q] || (cv == tv[q] && ce < ti[q]); \
                const float nv = b ? tv[q] : cv; const int ne = b ? ti[q] : ce; tv[q] = b ? cv : tv[q]; ti[q] = b ? ce : ti[q]; cv = nv; ce = ne; } } while (0)
#pragma unroll
            for (int r = 0; r < 16; ++r) { const int e = (r & 3) + 8 * (r >> 2) + 4 * hi; const float v = (acc[r] + WP[(rg * 16 + r) * 64 + f_lane]) * rstd + BIAS[e]; P6_INS(v, e); }
            float ov[4]; int oe[4];
#pragma unroll
            for (int q = 0; q < 4; ++q) { ov[q] = __shfl_xor(tv[q], 32); oe[q] = __shfl_xor(ti[q], 32); }
#pragma unroll
            for (int q = 0; q < 4; ++q) P6_INS(ov[q], oe[q]);
#undef P6_INS
            if (hi == 0) { const int rl = rg * 32 + j, r = blk * 128 + rl;
                const float e1 = __expf(tv[1] - tv[0]), e2 = __expf(tv[2] - tv[0]), e3 = __expf(tv[3] - tv[0]); const float inv = 1.f / (1.f + e1 + e2 + e3);
                typedef int i32x4_t __attribute__((ext_vector_type(4))); const i32x4_t t4 = {ti[0], ti[1], ti[2], ti[3]};
                *(i32x4_t*)(topi_g + (size_t)r * 4) = t4; *(f32x4*)(gate_g + (size_t)r * 4) = (f32x4){inv, e1 * inv, e2 * inv, e3 * inv};
                *(LAS i32x4_t*)(TI + rl * 4) = t4; }
        }
        __syncthreads();
        { const int t2 = F.wave * 64 + lane_id(); const int e = t2 & 31, seg = t2 >> 5; int cnt = 0;
#pragma unroll 4
            for (int i = 0; i < 32; ++i) cnt += (TI[seg * 32 + i] == e) ? 1 : 0;
            SC[seg * 32 + e] = cnt;
            __syncthreads();
            int pre = 0;
            for (int s2 = 0; s2 < seg; ++s2) pre += SC[s2 * 32 + e];
            if (seg == 15) wgcnt[blk * 32 + e] = pre + cnt;
            for (int i = 0; i < 32; ++i) if (TI[seg * 32 + i] == e) { PS[seg * 32 + i] = pre; ++pre; }
        }
        __syncthreads();
        { const int t3 = F.wave * 64 + lane_id(); pos_g[(size_t)blk * 512 + t3] = PS[t3]; }
        { const int lane = lane_id();
            f32x4 PA[4], PB[4];
#pragma unroll
            for (int jj = 0; jj < 4; ++jj) { const int c = 4 * lane + 256 * jj; PA[jj] = *(const f32x4*)(g2n + c) * (*(const f32x4*)(sc2 + c) + 1.f); PB[jj] = *(const f32x4*)(sh2 + c); }
            for (int it = 0; it < 4; ++it) { u32x2 xb[4][4];
#pragma unroll
                for (int u = 0; u < 4; ++u) { const GAS u32x2* xr = (const GAS u32x2*)(XN + (size_t)(blk * 128 + F.wave * 16 + 4 * it + u) * DM) + lane;
#pragma unroll
                    for (int jj = 0; jj < 4; ++jj) xb[u][jj] = xr[64 * jj]; }
#pragma unroll
                for (int u = 0; u < 4; ++u) { const int rl = F.wave * 16 + 4 * it + u; const float rstd = RSTD[rl];
                    GAS unsigned* o4 = (GAS unsigned*)(H2 + (size_t)(blk * 128 + rl) * DM) + lane;
#pragma unroll
                    for (int jj = 0; jj < 4; ++jj) {
                        const f32x4 x = (f32x4){__uint_as_float(xb[u][jj].x << 16), __uint_as_float(xb[u][jj].x & 0xffff0000u), __uint_as_float(xb[u][jj].y << 16), __uint_as_float(xb[u][jj].y & 0xffff0000u)};
                        const f32x4 h = x * rstd * PA[jj] + PB[jj];
                        o4[64 * jj] = pk4_fp8(h.x, h.y, h.z, h.w); } } }
        }
    }
#undef in
}

__device__ __forceinline__ void p7_scatter(Frame& F) {
    FT_DECL;
    LAS int* TOT = (LAS int*)F.lds;
    LAS int* BASE = TOT + 32;
    LAS int* PRE = BASE + 32;
    LAS int* PART = PRE + 32;
    const int* wgcnt = WSP(int, WS_ROUTE + RT_WGCNT); const int* topi_g = WSP(int, WS_ROUTE + RT_TOPI); const float* gate_g = WSP(float, WS_ROUTE + RT_GATE); const int* pos_g = WSP(int, WS_ROUTE + RT_POS);
    int* list = WSP(int, WS_ROUTE + RT_LIST); float* gslot = WSP(float, WS_ROUTE + RT_GSLOT); int* meta = WSP(int, WS_ROUTE + RT_META);
    for (int blk = blockIdx.x; blk < MROWS / 128; blk += F.G) {
        __syncthreads();
        { const int e = f_tid & 31, part = f_tid >> 5; int st = 0, sp = 0;
            for (int w = part * 16; w < part * 16 + 16; ++w) { const int c = wgcnt[w * 32 + e]; st += c; if (w < blk) sp += c; }
            PART[part * 32 + e] = st; PART[512 + part * 32 + e] = sp; }
        __syncthreads();
        if (f_tid < 32) { int st = 0, sp = 0;
#pragma unroll
            for (int p = 0; p < 16; ++p) { st += PART[p * 32 + f_tid]; sp += PART[512 + p * 32 + f_tid]; }
            TOT[f_tid] = st; PRE[f_tid] = sp; }
        __syncthreads();
        if (f_tid == 0) { int b = 0; for (int e = 0; e < 32; ++e) { BASE[e] = b; b += (TOT[e] + 255) & ~255; }
            if (blk == 0) { int t = 0; for (int e = 0; e < 32; ++e) { meta[e] = TOT[e]; meta[32 + e] = BASE[e]; const int nt = (TOT[e] + 255) >> 8; for (int q = 0; q < nt; ++q) meta[128 + t + q] = e; t += nt; } meta[64] = t; } }
        __syncthreads();
        { const int a = f_tid, row = blk * 128 + (a >> 2); const int e = topi_g[(size_t)blk * 512 + a]; const int slot = BASE[e] + PRE[e] + pos_g[(size_t)blk * 512 + a];
            list[slot] = row * 4 + (a & 3); gslot[slot] = gate_g[(size_t)blk * 512 + a];
            PART[a] = slot; }
        __syncthreads();
        if (blk < NEXP) { const int e = blk, lo = BASE[e] + TOT[e], hi = BASE[e] + ((TOT[e] + 255) & ~255);
            for (int sl = lo + f_tid; sl < hi; sl += 512) { list[sl] = -1; gslot[sl] = 0.f; } }
    }
}

template <int NPN> struct SchedMoE {
    int G, c, nT; const char* A; const char* W; size_t wstride; const LAS unsigned char* tileE; const LAS int* RW; bool gath;
    __device__ __forceinline__ const LAS int* rows(int i) const { return RW + i * 256; }
    __device__ __forceinline__ bool next(int i, g8::Unit& u) const {
        const int L = i * G + c, xcd = L & 7, j = L >> 3, nTx = (nT + 7) >> 3, tl = j / NPN, T = xcd * nTx + tl, pn = j % NPN;
        if (tl >= nTx || T >= nT) return false;
        const int e = tileE[T];
        u.pm = T; u.pn = pn; u.kind = i; u.ex = e; u.a = gath ? A : A + (size_t)T * 256 * DM; u.b = W + (size_t)e * wstride + (size_t)pn * 256 * DM; return true;
    }
};
struct EpiSwiGLU {
    unsigned char* ACT; const float* b1;
    __device__ __forceinline__ void operator()(f32x4 (&acc)[2][2][4][2], const g8::Unit& u, int wr, int wc, int fr, int fq) const {
        asm volatile("" : "+v"(fr), "+v"(fq));
        const int j0 = u.pn * 128 + wc * 32 + 8 * fq; const float* bp = b1 + (size_t)u.ex * 2 * DM + j0;
        f32x4 bg[2], bl[2];
#pragma unroll
        for (int n = 0; n < 2; ++n) { bg[n] = *(const f32x4*)(bp + 4 * n); bl[n] = *(const f32x4*)(bp + DM + 4 * n); }
#pragma unroll
        for (int ai = 0; ai < 2; ++ai)
#pragma unroll
            for (int m = 0; m < 4; ++m) { const size_t slot = (size_t)u.pm * 256 + ai * 128 + wr * 64 + m * 16 + fr; float o[8];
#pragma unroll
                for (int n = 0; n < 2; ++n) { const f32x4 g4 = acc[ai][0][m][n] * (1.f / WSCALE) + bg[n], l4 = acc[ai][1][m][n] * (1.f / WSCALE) + bl[n];
#pragma unroll
                    for (int e = 0; e < 4; ++e) { const float g = fminf(g4[e], 7.f), l = __builtin_amdgcn_fmed3f(l4[e], -7.f, 7.f);
                        const float ex = __builtin_amdgcn_exp2f(g * (-1.702f * 1.4426950408889634f)); const float glu = g * __builtin_amdgcn_rcpf(1.f + ex);
                        o[4 * n + e] = fmaf(l, glu, glu); } }
                u32x2 w; w.x = pk4_fp8(o[0], o[1], o[2], o[3]); w.y = pk4_fp8(o[4], o[5], o[6], o[7]);
                *(u32x2*)(ACT + slot * DM + j0) = w; }
    }
};
struct EpiDown {
    unsigned char* EO; const float* b2; const LAS int* LL; int G, c;
    __device__ __forceinline__ void operator()(f32x4 (&acc)[2][2][4][2], const g8::Unit& u, int wr, int wc, int fr, int fq) const {
        asm volatile("" : "+v"(fr), "+v"(fq));
        const int c0 = u.pn * 256 + wc * 64 + 16 * fq; const float* bp = b2 + (size_t)u.ex * DM + c0;
        f32x4 bb[2][2];
#pragma unroll
        for (int bj = 0; bj < 2; ++bj)
#pragma unroll
            for (int n = 0; n < 2; ++n) bb[bj][n] = *(const f32x4*)(bp + bj * 8 + 4 * n);
        const LAS int* L = LL + u.kind * 512;
        int li[8]; float gt[8];
#pragma unroll
        for (int q = 0; q < 8; ++q) { const int rl = (q >> 2) * 128 + wr * 64 + (q & 3) * 16 + fr; li[q] = L[rl]; gt[q] = __int_as_float(L[256 + rl]) * (1.f / WSCALE); }
#pragma unroll
        for (int ai = 0; ai < 2; ++ai)
#pragma unroll
            for (int m = 0; m < 4; ++m) { const int l = li[ai * 4 + m]; const float g = gt[ai * 4 + m];
                unsigned char* dst = EO + ((size_t)(l & 3) * MROWS + (l >> 2)) * DM + c0;
                u32x4 w;
                { const f32x4 v0 = acc[ai][0][m][0] * g + bb[0][0] * (g * WSCALE), v1 = acc[ai][0][m][1] * g + bb[0][1] * (g * WSCALE);
                  w.x = pk4_fp8(v0[0] * EOSCALE, v0[1] * EOSCALE, v0[2] * EOSCALE, v0[3] * EOSCALE); w.y = pk4_fp8(v1[0] * EOSCALE, v1[1] * EOSCALE, v1[2] * EOSCALE, v1[3] * EOSCALE); }
                { const f32x4 v0 = acc[ai][1][m][0] * g + bb[1][0] * (g * WSCALE), v1 = acc[ai][1][m][1] * g + bb[1][1] * (g * WSCALE);
                  w.z = pk4_fp8(v0[0] * EOSCALE, v0[1] * EOSCALE, v0[2] * EOSCALE, v0[3] * EOSCALE); w.w = pk4_fp8(v1[0] * EOSCALE, v1[1] * EOSCALE, v1[2] * EOSCALE, v1[3] * EOSCALE); }
                if (l >= 0) *(u32x4*)dst = w; }
    }
};
__device__ __forceinline__ const LAS unsigned char* moe_tiles(Frame& F, int& nT) {
    FT_DECL;
    LAS unsigned char* TE = (LAS unsigned char*)(F.lds + RING_BYTES); const int* meta = WSP(int, WS_ROUTE + RT_META);
    __syncthreads();
    nT = meta[64]; if (nT > MAXTILE) nT = MAXTILE;
    for (int i = f_tid; i < MAXTILE; i += 512) TE[i] = (unsigned char)((i < nT) ? meta[128 + i] : 0);
    __syncthreads();
    return (const LAS unsigned char*)TE;
}

__device__ __forceinline__ void p10_combine(Frame& F) {
    FT_DECL;
    const float* mod = WSP(float, WS_SMALL + SM_MOD); const unsigned char* EO = WSP(unsigned char, WS_EO);
    const size_t gt = (size_t)F.vcu * 512 + f_tid, NTH = (size_t)F.G * 512;
    constexpr int U = 4;
    for (size_t i0 = gt; i0 < (size_t)MROWS * 128; i0 += NTH * U) {
        u32x2 ev[U][4]; f32x4 xv[U][2], gv[U][2];
#pragma unroll
        for (int u = 0; u < U; ++u) { const size_t i = i0 + (size_t)u * NTH; const size_t row = i >> 7; const int c0 = (int)(i & 127) * 8;
            const float* g2 = mod + (size_t)(row >> 12) * (NMOD * DM) + 5 * DM + c0; const bf16_t* op = WSP(bf16_t, WS_XN) + row * DM + c0;
#pragma unroll
            for (int k = 0; k < 4; ++k) ev[u][k] = __builtin_nontemporal_load((const u32x2*)(EO + ((size_t)k * MROWS + row) * DM + c0));
            { const u32x4 xb = *(const u32x4*)op; xv[u][0] = (f32x4){__uint_as_float(xb.x << 16), __uint_as_float(xb.x & 0xffff0000u), __uint_as_float(xb.y << 16), __uint_as_float(xb.y & 0xffff0000u)};
              xv[u][1] = (f32x4){__uint_as_float(xb.z << 16), __uint_as_float(xb.z & 0xffff0000u), __uint_as_float(xb.w << 16), __uint_as_float(xb.w & 0xffff0000u)}; }
            gv[u][0] = *(const f32x4*)g2; gv[u][1] = *(const f32x4*)(g2 + 4); }
#pragma unroll
        for (int u = 0; u < U; ++u) { const size_t i = i0 + (size_t)u * NTH; const size_t row = i >> 7; const int c0 = (int)(i & 127) * 8;
            float s[8];
#pragma unroll
            for (int e = 0; e < 8; ++e) s[e] = 0.f;
#pragma unroll
            for (int k = 0; k < 4; ++k) { const u32x2 v = ev[u][k];
                const f32x2 a = __builtin_amdgcn_cvt_pk_f32_fp8((int)v.x, false), b = __builtin_amdgcn_cvt_pk_f32_fp8((int)v.x, true), c = __builtin_amdgcn_cvt_pk_f32_fp8((int)v.y, false), d = __builtin_amdgcn_cvt_pk_f32_fp8((int)v.y, true);
                s[0] += a.x; s[1] += a.y; s[2] += b.x; s[3] += b.y; s[4] += c.x; s[5] += c.y; s[6] += d.x; s[7] += d.y; }
#pragma unroll
            for (int e = 0; e < 8; ++e) s[e] *= (1.f / EOSCALE);
            f32x4 o0 = xv[u][0] + gv[u][0] * (f32x4){s[0], s[1], s[2], s[3]}, o1 = xv[u][1] + gv[u][1] * (f32x4){s[4], s[5], s[6], s[7]};
            float* op = F.out + row * DM + c0;
            __builtin_nontemporal_store(o0, (f32x4*)op); __builtin_nontemporal_store(o1, (f32x4*)(op + 4)); }
    }
}

struct Args { const float* in[34]; float* out; unsigned char* ws; int ph_lo, ph_hi; };
constexpr int N_PHASES = 11;

__global__ void __launch_bounds__(512, 2) mega(Args args) {
    extern __shared__ __attribute__((aligned(16))) unsigned char lds[];
    Frame F;
    F.lds = (LAS unsigned char*)lds;
    F.MISC = (volatile LAS unsigned*)(F.lds + LDSCTL_OFF);
    F.wave = __builtin_amdgcn_readfirstlane(threadIdx.x >> 6);
    FT_DECL;
    F.G = gridDim.x; { const int bx = blockIdx.x; F.vcu = (F.G % 8 == 0) ? (bx % 8) * (F.G / 8) + bx / 8 : bx; }
    F.in = (kin_t)__builtin_amdgcn_kernarg_segment_ptr();
    F.out = args.out; F.ws = args.ws;
    F.ctl = (gu32*)(args.ws + WS_CTL);
    for (int u = f_tid; u < (LDS_BYTES - LDSCTL_OFF) / 4; u += NWAVES * 64) ((LAS unsigned*)(F.lds + LDSCTL_OFF))[u] = 0u;
    __syncthreads();
    const int lo = args.ph_lo, hi = args.ph_hi;
    XcdBarrier bar; bar.bar = (unsigned*)(F.ctl + CW_BAR); bar.x = 0; bar.st = nullptr;
    if (hi - lo > 1) bar = xcd_barrier_post((unsigned*)(F.ctl + CW_BAR), F.MISC + 8, f_tid == 0);
#define IN(k) (lo <= (k) && (k) < hi)
#define SEAM(k) do { if (IN(k) && IN((k) + 1)) xcd_barrier(bar, F.wave == 0 && lane_id() == 0); } while (0)

    if (IN(0)) { p0_prologue(F); } SEAM(0);
    if (IN(1)) { p1_norm1(F); } SEAM(1);
    if (IN(2)) {
        SchedInProj S{F.G, (int)blockIdx.x, (const char*)WSP(bf16_t, WS_H), (const char*)WSP(bf16_t, WS_WIN)};
        EpiInProj E{WSP(unsigned char, WS_Q), WSP(unsigned char, WS_K), WSP(unsigned char, WS_V), WSP(bf16_t, WS_UT), F.in[9], F.in[10], WSP(float, WS_SMALL + SM_ROPE)};
        g8::gemm_phase<false>(F.lds, DM, S, E, F.wave, lane_id());
    } SEAM(2);
    if (IN(3)) { p3_attention8(F); p3_hyena(F); } SEAM(3);
    if (IN(4)) { p4_hynorm(F); } SEAM(4);
    if (IN(5)) {
        SchedStatic S{F.G, (int)blockIdx.x, MROWS / 256, DM / 256, (const char*)WSP(bf16_t, WS_MIX), (const char*)WSP(bf16_t, WS_WOUT)};
        EpiOutProj E{F.in[0], WSP(bf16_t, WS_XN), WSP(float, WS_SMALL + SM_MOD)};
        g8::gemm_phase<false>(F.lds, DM, S, E, F.wave, lane_id());
    } SEAM(5);
    if (IN(6)) { p6_router_mfma(F); } SEAM(6);
    if (IN(7)) { p7_scatter(F); } SEAM(7);
    if (IN(8)) {
        int nT; const LAS unsigned char* TE = moe_tiles(F, nT);
        LAS int* RWL = (LAS int*)(F.lds + RING_BYTES + 1024);
        static_assert(RING_BYTES + 1024 + 17 * 1024 <= LDSCTL_OFF, "LDS map");
        SchedMoE<8> S{F.G, (int)blockIdx.x, nT, (const char*)WSP(char, WS_H), (const char*)WSP(char, WS_W1), (size_t)2 * DM * DM, TE, RWL, true};
        { const int* list = WSP(int, WS_ROUTE + RT_LIST); const int t8 = F.wave * 64 + lane_id();
            g8::Unit u; for (int i = 0; i < 17 && S.next(i, u); i += 2) { const int ii = i + (t8 >> 8); g8::Unit u2; if (S.next(ii, u2)) { const int li = list[(size_t)u2.pm * 256 + (t8 & 255)]; RWL[ii * 256 + (t8 & 255)] = (li >= 0) ? (li >> 2) : 0; } }
            __syncthreads(); }
        EpiSwiGLU E{WSP(unsigned char, WS_ACT), F.in[31]};
        g8::gemm_phase_g<true, true>(F.lds, DM, S, E, F.wave, lane_id());
    } SEAM(8);
    if (IN(9)) {
        int nT; const LAS unsigned char* TE = moe_tiles(F, nT);
        SchedMoE<4> S{F.G, (int)blockIdx.x, nT, (const char*)WSP(char, WS_ACT), (const char*)WSP(char, WS_W2), (size_t)DM * DM, TE, nullptr, false};
        LAS int* LL = (LAS int*)(F.lds + RING_BYTES + 1024);
        static_assert(RING_BYTES + 1024 + 9 * 2048 <= LDSCTL_OFF, "LDS map");
        { const int* list = WSP(int, WS_ROUTE + RT_LIST); const float* gslot = WSP(float, WS_ROUTE + RT_GSLOT);
            const int t9 = F.wave * 64 + lane_id();
            g8::Unit u; for (int i = 0; i < 9 && S.next(i, u); ++i) { const int t = t9 & 255; const size_t slot = (size_t)u.pm * 256 + t;
                LL[i * 512 + (t9 >> 8) * 256 + t] = (t9 < 256) ? list[slot] : __float_as_int(gslot[slot]); }
            __syncthreads(); }
        EpiDown E{WSP(unsigned char, WS_EO), F.in[33], LL, F.G, (int)blockIdx.x};
        g8::gemm_phase<true>(F.lds, DM, S, E, F.wave, lane_id());
    } SEAM(9);
    if (IN(10)) { p10_combine(F); }
#undef IN
#undef SEAM
}

extern "C" void kernel_launch(void* const* d_in, const int* in_sizes, int n_in, void* d_out, int out_size, void* d_ws, size_t ws_size, hipStream_t stream) {
    static int grid = 0;
    if (grid == 0) {
        if (n_in != 34 || out_size != MROWS * DM || ws_size < WS_END) { fprintf(stderr, "kernel_launch: unexpected shapes: n_in %d out %d ws %zu (need %zu)\n", n_in, out_size, ws_size, (size_t)WS_END); grid = -1; return; }
        int dev = 0, cus = 0, per_cu = 0;
        if (hipGetDevice(&dev) != hipSuccess || hipDeviceGetAttribute(&cus, hipDeviceAttributeMultiprocessorCount, dev) != hipSuccess) { grid = -1; return; }
        if (hipFuncSetAttribute((const void*)mega, hipFuncAttributeMaxDynamicSharedMemorySize, LDS_BYTES) != hipSuccess) { fprintf(stderr, "kernel_launch: hipFuncSetAttribute failed\n"); grid = -1; return; }
        if (hipOccupancyMaxActiveBlocksPerMultiprocessor(&per_cu, (const void*)mega, NWAVES * 64, LDS_BYTES) != hipSuccess || per_cu < 1) { fprintf(stderr, "kernel_launch: occupancy query says %d\n", per_cu); per_cu = 1; }
        (void)hipGetLastError();
        grid = cus;
    }
    if (grid < 0) return;
    (void)hipMemsetAsync((char*)d_ws + WS_CTL, 0, CTL_ZERO_BYTES, stream);
    Args a{};
    for (int i = 0; i < 34; ++i) a.in[i] = (const float*)d_in[i];
    a.out = (float*)d_out; a.ws = (unsigned char*)d_ws;
    constexpr int LAST = MK_LAST_PHASE + 1;
    if (MK_N_LAUNCHES == 1) { a.ph_lo = 0; a.ph_hi = LAST; hipLaunchKernelGGL(mega, dim3(grid), dim3(NWAVES * 64), LDS_BYTES, stream, a); }
    else for (int p = 0; p < LAST; ++p) { a.ph_lo = p; a.ph_hi = p + 1; hipLaunchKernelGGL(mega, dim3(grid), dim3(NWAVES * 64), LDS_BYTES, stream, a); }
    const hipError_t le = hipPeekAtLastError();
    if (le != hipSuccess) fprintf(stderr, "kernel_launch: launch failed: %s\n", hipGetErrorName(le));
}
```

```cpp
#include <hip/hip_runtime.h>
#include <hip/hip_bf16.h>
#include <cstdio>
#include <cstdint>

#ifndef MK_N_LAUNCHES
#define MK_N_LAUNCHES 1
#endif
#ifndef MK_LAST_PHASE
#define MK_LAST_PHASE 10
#endif

#define GAS __attribute__((address_space(1)))
#define LAS __attribute__((address_space(3)))
typedef unsigned short bf16_t;
typedef short bf16x8 __attribute__((ext_vector_type(8)));
typedef short s16x4 __attribute__((ext_vector_type(4)));
typedef float f32x2 __attribute__((ext_vector_type(2)));
typedef float f32x4 __attribute__((ext_vector_type(4)));
typedef float f32x16 __attribute__((ext_vector_type(16)));
typedef unsigned u32x2 __attribute__((ext_vector_type(2)));
typedef unsigned u32x4 __attribute__((ext_vector_type(4)));
typedef GAS unsigned gu32;

constexpr int NB = 8, SEQ = 4096, DM = 1024, MROWS = NB * SEQ, CTXL = 256, MCTX = NB * CTXL, MTOT = MROWS + MCTX;
constexpr int KVL = CTXL + SEQ;
constexpr int NHEAD = 4, QKW = 512;
constexpr int HYW = 512, HYC = 1536, INC = 3072, QKVC = 1536;
constexpr int NEXP = 32, TOPK = 4, NMOD = 6;
constexpr float EPS = 1e-6f;
constexpr float LAM_INIT = 0.2f;
constexpr float QSCALE = 0.125f * 1.4426950408889634f;

constexpr size_t MiB = 1u << 20;
constexpr size_t WS_CTL = 0, CTL_ZERO_BYTES = 64 * 1024;
constexpr size_t WS_SMALL = 1 * MiB;
constexpr size_t WS_WIN = 2 * MiB;
constexpr size_t WS_WOUT = 8 * MiB;
constexpr size_t WS_W1 = 10 * MiB;
constexpr size_t WS_W2 = 138 * MiB;
constexpr size_t WS_H = 202 * MiB;
constexpr size_t WS_Q = 270 * MiB;
constexpr size_t WS_K = 302 * MiB;
constexpr size_t WS_V = 336 * MiB;
constexpr size_t WS_UT = 370 * MiB;
constexpr size_t WS_FILT = 466 * MiB;
constexpr size_t WS_Z2T = 498 * MiB;
constexpr size_t WS_MIX = 530 * MiB;
constexpr size_t WS_ROUTE = 594 * MiB;
constexpr size_t WS_ACT = 270 * MiB;
constexpr size_t WS_EO = 598 * MiB;
constexpr size_t WS_XN = 870 * MiB;
constexpr size_t WS_END = 998 * MiB;
constexpr size_t SM_MOD = 0;
constexpr size_t SM_SCAL = 256 * 1024;
constexpr size_t SM_ROPE = 260 * 1024;
constexpr int CW_BAR = 4096;

constexpr int RING_BYTES = 131072;
constexpr int LDSCTL_OFF = 151552;
constexpr int LDS_BYTES = 152576;
constexpr int NWAVES = 8;

#define LDS_WAIT() asm volatile("s_waitcnt lgkmcnt(0)" ::: "memory")
#define VM_WAIT() asm volatile("s_waitcnt vmcnt(0)" ::: "memory")
#define RLX_AGENT __ATOMIC_RELAXED, __HIP_MEMORY_SCOPE_AGENT

__device__ __forceinline__ unsigned cvt_pk_bf16(float lo, float hi) { unsigned r; asm volatile("v_cvt_pk_bf16_f32 %0, %1, %2" : "=v"(r) : "v"(lo), "v"(hi)); return r; }
__device__ __forceinline__ float bf2f(bf16_t v) { return __uint_as_float(((unsigned)v) << 16); }
__device__ __forceinline__ float wave_sum(float v) {
#pragma unroll
    for (int o = 1; o < 64; o <<= 1) v += __shfl_xor(v, o);
    return v;
}

#define XB_TMO      128
#define XB_XCNT(j)  (256  + 64 * (j))
#define XB_XSUB(j)  (1280 + 64 * (j))
#define XB_XGEN(j)  (2304 + 64 * (j))
#define XB_TOP      3328
#define XB_TOPGEN   3392
#define XCD_BAR_WORDS 3456
#define XB_SPIN_CAP (1u << 22)
__device__ __forceinline__ unsigned xb_ld(unsigned* p)              { return __hip_atomic_load(p, __ATOMIC_RELAXED, __HIP_MEMORY_SCOPE_AGENT); }
__device__ __forceinline__ unsigned xb_add(unsigned* p, unsigned v) { return __hip_atomic_fetch_add(p, v, __ATOMIC_RELAXED, __HIP_MEMORY_SCOPE_AGENT); }
__device__ __forceinline__ unsigned xb_xcc_id() { return (unsigned)__builtin_amdgcn_s_getreg((3 << 11) | 20) & 0xFu; }
#define XB_SPIN(cond, bar) do { unsigned _sp = 0; while (cond) { __builtin_amdgcn_s_sleep(1); \
    if ((++_sp & 255u) == 0u) { if (xb_ld(&(bar)[XB_TMO])) break; if (_sp > XB_SPIN_CAP) { atomicAdd(&(bar)[XB_TMO], 1u); break; } } } } while (0)
struct XcdBarrier { unsigned* bar; unsigned x; volatile LAS unsigned* st; };
__device__ __forceinline__ XcdBarrier xcd_barrier_post(unsigned* bar, volatile LAS unsigned* st, bool leader) {
    XcdBarrier b; b.bar = bar; b.x = xb_xcc_id(); b.st = st;
    if (leader) (void)xb_add(&bar[XB_XCNT(b.x)], 1u);
    return b;
}
__device__ __forceinline__ void xcd_barrier_complete(unsigned* bar, unsigned x, unsigned& nloc, unsigned& nx) {
    const unsigned G = gridDim.x * gridDim.y * gridDim.z;
    unsigned sum, cnt, mine, sp = 0u;
    for (;;) {
        sum = 0u; cnt = 0u; mine = 0u;
#pragma unroll
        for (unsigned j = 0; j < 16; ++j) { const unsigned c = xb_ld(&bar[XB_XCNT(j)]); sum += c; cnt += (c > 0u) ? 1u : 0u; mine = (j == x) ? c : mine; }
        if (sum == G) break;
        __builtin_amdgcn_s_sleep(1);
        if ((++sp & 255u) == 0u) { if (xb_ld(&bar[XB_TMO])) break; if (sp > XB_SPIN_CAP) { atomicAdd(&bar[XB_TMO], 1u); break; } }
    }
    nloc = mine > 0u ? mine : 1u; nx = cnt > 0u ? cnt : 1u;
}
__device__ __forceinline__ void xcd_barrier(const XcdBarrier& b, bool leader) {
    asm volatile("s_waitcnt vmcnt(0)" ::: "memory");
    __syncthreads();
    if (leader) {
        unsigned* bar = b.bar;
        __builtin_amdgcn_s_waitcnt(0);
        unsigned nloc = b.st[0], nx = b.st[1];
        if (nloc == 0u) { xcd_barrier_complete(bar, b.x, nloc, nx); b.st[0] = nloc; b.st[1] = nx; }
        const unsigned old = xb_add(&bar[XB_XSUB(b.x)], 1u);
        const unsigned gen = old / nloc;
        if (old + 1u == (gen + 1u) * nloc) {
            __builtin_amdgcn_fence(__ATOMIC_RELEASE, "agent");
            asm volatile("s_waitcnt vmcnt(0)" ::: "memory");
            const unsigned og = xb_add(&bar[XB_TOP], 1u);
            const unsigned tg = og / nx;
            if (og + 1u == (tg + 1u) * nx) xb_add(&bar[XB_TOPGEN], 1u);
            else XB_SPIN(xb_ld(&bar[XB_TOPGEN]) == tg, bar);
            __builtin_amdgcn_fence(__ATOMIC_ACQUIRE, "agent");
            xb_add(&bar[XB_XGEN(b.x)], 1u);
            asm volatile("s_waitcnt vmcnt(0)" ::: "memory");
        } else {
            XB_SPIN(xb_ld(&bar[XB_XGEN(b.x)]) == gen, bar);
            __builtin_amdgcn_fence(__ATOMIC_ACQUIRE, "agent");
            asm volatile("s_waitcnt vmcnt(0)" ::: "memory");
        }
    }
    __syncthreads();
}

namespace g8 {
constexpr int BM = 256, BK = 64, HALF = 128, HTB = HALF * BK * 2, STAGE_BYTES = 8 * HTB, NXCD = 8, WGM = 8;
__host__ __device__ __forceinline__ int lds_byte(int r, int c) { const int st = (r >> 4) * 2 + (c >> 5), rr = r & 15, cc = c & 31, ob = rr * 64 + cc * 2; return st * 1024 + (ob ^ (((ob >> 9) & 1) << 5)); }
__host__ __device__ __forceinline__ void stage_rc(int b, int& R, int& C) { const int st = b / 1024, sb = b % 1024, swz = sb ^ (((sb >> 9) & 1) << 5); R = (st >> 1) * 16 + swz / 64; C = (st & 1) * 32 + (swz % 64) / 2; }
__host__ __device__ __forceinline__ int perm32(int rho) { const int n = rho >> 4, i = rho & 15; return 8 * (i >> 2) + 4 * n + (i & 3); }

struct Unit { const char* a; const char* b; int pm, pn, kind, ex; };

__device__ __forceinline__ void tile_of(int L, int nM, int nN, int& pm, int& pn) {
    const int nwg = nM * nN; int wgid = L;
    { const int q = nwg / NXCD, r = nwg % NXCD, xcd = wgid % NXCD, off = wgid / NXCD; wgid = (xcd < r ? xcd * (q + 1) : r * (q + 1) + (xcd - r) * q) + off; }
    const int nig = WGM * nN, gid = wgid / nig, fm = gid * WGM, gsz = (nM - fm) < WGM ? (nM - fm) : WGM;
    pm = fm + ((wgid % nig) % gsz); pn = (wgid % nig) / gsz;
}

typedef int i32x8 __attribute__((ext_vector_type(8)));
template <bool FP8, bool GATHER, bool SP2, class Epi, class Sched>
__device__ __forceinline__ void gemm_phase_s(LAS unsigned char* lds, const int K, const Sched& S, const Epi& E, const int wid, const int lane) {
    const int tid = wid * 64 + lane, wr = wid >> 2, wc = wid & 3, fr = lane & 15, fq = lane >> 4;
    const int nt = FP8 ? K / 128 : K / BK;
    const int RP = FP8 ? K : 2 * K;
    unsigned voffA[2], voffB[2]; int srow[2], scol[2];
#pragma unroll
    for (int i = 0; i < 2; ++i) { int R, C; stage_rc(tid * 16 + i * 8192, R, C); const int Rb = (R & ~31) + perm32(R & 31);
        voffA[i] = (unsigned)(R * RP + C * 2); voffB[i] = (unsigned)(Rb * RP + C * 2); srow[i] = R; scol[i] = C * 2; }
    const size_t kstep = (size_t)(BK * 2);
    const size_t hstep = (size_t)HALF * RP;
    const unsigned ldsw = (unsigned)wid * 1024u;
    unsigned cO0[2], cO1[2], nO0[2], nO1[2];
#define PG8_GOFF(D0, D1, ui_) do { if constexpr (GATHER) { const LAS int* rw_ = S.rows(ui_); _Pragma("unroll") for (int i_ = 0; i_ < 2; ++i_) { \
        D0[i_] = (unsigned)rw_[srow[i_]] * (unsigned)RP + (unsigned)scol[i_]; D1[i_] = (unsigned)rw_[128 + srow[i_]] * (unsigned)RP + (unsigned)scol[i_]; } } \
      else { _Pragma("unroll") for (int i_ = 0; i_ < 2; ++i_) { D0[i_] = voffA[i_]; D1[i_] = voffA[i_] + (unsigned)hstep; } } } while (0)
    const int aoff = lds_byte(wr * 64 + fr, FP8 ? fq * 16 : fq * 8), boff = lds_byte(wc * 32 + fr, FP8 ? fq * 16 : fq * 8);
    constexpr int KOFF = FP8 ? 16 : 1024;
#define PG8_SA(b, h) (((b) * 2 + (h)) * HTB)
#define PG8_SB(b, h) ((4 + (b) * 2 + (h)) * HTB)
#define PG8_STAGE(bufoff, gbase, voff) do { _Pragma("unroll") for (int _i = 0; _i < 2; ++_i) \
        __builtin_amdgcn_global_load_lds((const unsigned*)((const char*)(gbase) + (voff)[_i]), (LAS unsigned*)(lds + (bufoff) + ldsw + _i * 8192), 16, 0, 0); } while (0)
#define PG8_LD32(p) __builtin_bit_cast(i32x8, __builtin_shufflevector(*(const LAS u32x4*)(p), *(const LAS u32x4*)((p) + 16), 0, 1, 2, 3, 4, 5, 6, 7))
#define PG8_LDA8(dst, b, h) do { _Pragma("unroll") for (int m = 0; m < 4; ++m) dst[m] = PG8_LD32(lds + PG8_SA(b, h) + aoff + m * 2048); } while (0)
#define PG8_LDB8(dst, b, h) do { _Pragma("unroll") for (int n = 0; n < 2; ++n) dst[n] = PG8_LD32(lds + PG8_SB(b, h) + boff + n * 2048); } while (0)
#define PG8_LDA(dst, b, h) do { _Pragma("unroll") for (int m = 0; m < 4; ++m) _Pragma("unroll") for (int k = 0; k < 2; ++k) dst[m][k] = *(const LAS bf16x8*)(lds + PG8_SA(b, h) + aoff + m * 2048 + k * KOFF); } while (0)
#define PG8_LDB(dst, b, h) do { _Pragma("unroll") for (int n = 0; n < 2; ++n) _Pragma("unroll") for (int k = 0; k < 2; ++k) dst[n][k] = *(const LAS bf16x8*)(lds + PG8_SB(b, h) + boff + n * 2048 + k * KOFF); } while (0)
#define PG8_MMA(ai, bj, At, Bt) do { __builtin_amdgcn_s_setprio(1); _Pragma("unroll") for (int m = 0; m < 4; ++m) _Pragma("unroll") for (int n = 0; n < 2; ++n) _Pragma("unroll") for (int k = 0; k < 2; ++k) \
        acc[ai][bj][m][n] = __builtin_amdgcn_mfma_f32_16x16x32_bf16(Bt[n][k], At[m][k], acc[ai][bj][m][n], 0, 0, 0); __builtin_amdgcn_s_setprio(0); } while (0)
#define PG8_MMA8(ai, bj, At, Bt) do { __builtin_amdgcn_s_setprio(1); _Pragma("unroll") for (int m = 0; m < 4; ++m) _Pragma("unroll") for (int n = 0; n < 2; ++n) \
        asm volatile("v_mfma_scale_f32_16x16x128_f8f6f4 %0, %1, %2, %0, %3, %3 op_sel_hi:[0,0,0]" : "+v"(acc[ai][bj][m][n]) : "v"(Bt[n]), "v"(At[m]), "v"(one_scale)); __builtin_amdgcn_s_setprio(0); } while (0)
#define PG8_WAIT_V(n) asm volatile("s_waitcnt vmcnt(" #n ")" ::: "memory")
#define PG8_WAIT_L(n) asm volatile("s_waitcnt lgkmcnt(" #n ")" ::: "memory")
#define PG8_BAR __builtin_amdgcn_s_barrier()
#define PG8_SCHED __builtin_amdgcn_sched_barrier(0)
    Unit cur, nxt; int ui = 0;
    if (!S.next(0, cur)) return;
    f32x4 acc[2][2][4][2];
#pragma unroll
    for (int a = 0; a < 2; ++a)
#pragma unroll
        for (int b = 0; b < 2; ++b)
#pragma unroll
            for (int m = 0; m < 4; ++m)
#pragma unroll
                for (int n = 0; n < 2; ++n) acc[a][b][m][n] = (f32x4){0.f, 0.f, 0.f, 0.f};
    bf16x8 At[4][2], B0[2][2], B1[2][2];
    i32x8 At8[4], B08[2], B18[2];
    const unsigned one_scale = 0x7f7f7f7fu;
    const char* cA = cur.a; const char* cB = cur.b;
    PG8_GOFF(cO0, cO1, 0);
    if constexpr (SP2) {
    PG8_STAGE(PG8_SB(0, 0), cB, voffB); PG8_STAGE(PG8_SB(0, 1), cB + hstep, voffB); PG8_STAGE(PG8_SA(0, 0), cA, cO0); PG8_STAGE(PG8_SA(0, 1), cA, cO1);
    if (wr == 1) PG8_BAR;
    PG8_WAIT_V(2); PG8_BAR;
    PG8_STAGE(PG8_SB(1, 0), cB + kstep, voffB); PG8_STAGE(PG8_SA(1, 0), cA + kstep, cO0); PG8_STAGE(PG8_SB(1, 1), cB + hstep + kstep, voffB);
    PG8_WAIT_V(6); PG8_BAR;
    } else {
    PG8_STAGE(PG8_SB(0, 0), cB, voffB); PG8_STAGE(PG8_SA(0, 0), cA, cO0); PG8_STAGE(PG8_SB(0, 1), cB + hstep, voffB); PG8_STAGE(PG8_SA(0, 1), cA, cO1);
    if (wr == 1) PG8_BAR;
    PG8_WAIT_V(4); PG8_BAR;
    PG8_STAGE(PG8_SB(1, 0), cB + kstep, voffB); PG8_STAGE(PG8_SA(1, 0), cA + kstep, cO0); PG8_STAGE(PG8_SB(1, 1), cB + hstep + kstep, voffB);
    PG8_WAIT_V(6); PG8_BAR;
    }
    for (;;) {
        const bool has_next = S.next(ui + 1, nxt);
        const char* nA = has_next ? nxt.a : cA; const char* nB = has_next ? nxt.b : cB;
        if (has_next) PG8_GOFF(nO0, nO1, ui + 1); else { _Pragma("unroll") for (int i_ = 0; i_ < 2; ++i_) { nO0[i_] = cO0[i_]; nO1[i_] = cO1[i_]; } }
#pragma unroll 1
        for (int t = 0; t < nt; t += 2) {
            const bool last = (t == nt - 2);
            const char* a1 = cA + (size_t)(t + 1) * kstep;
            const char* a2 = last ? nA : cA + (size_t)(t + 2) * kstep; const char* b2 = last ? nB : cB + (size_t)(t + 2) * kstep;
            const char* a3 = a2 + kstep; const char* b3 = b2 + kstep;
            unsigned o20[2], o21[2];
#pragma unroll
            for (int i_ = 0; i_ < 2; ++i_) { o20[i_] = last ? nO0[i_] : cO0[i_]; o21[i_] = last ? nO1[i_] : cO1[i_]; }
            if constexpr (FP8 && SP2) {
            PG8_LDB8(B08, 0, 0); PG8_LDB8(B18, 0, 1); PG8_SCHED; PG8_LDA8(At8, 0, 0); PG8_STAGE(PG8_SA(1, 1), a1, cO1);
            PG8_WAIT_V(8); PG8_WAIT_L(0); PG8_BAR; PG8_MMA8(0, 0, At8, B08); PG8_MMA8(0, 1, At8, B18); PG8_BAR; PG8_SCHED;
            PG8_LDA8(At8, 0, 1); PG8_STAGE(PG8_SB(0, 0), b2, voffB); PG8_STAGE(PG8_SB(0, 1), b2 + hstep, voffB); PG8_STAGE(PG8_SA(0, 0), a2, o20);
            PG8_WAIT_V(8); PG8_WAIT_L(0); PG8_BAR; PG8_MMA8(1, 0, At8, B08); PG8_MMA8(1, 1, At8, B18); PG8_BAR; PG8_SCHED;
            PG8_LDB8(B08, 1, 0); PG8_LDB8(B18, 1, 1); PG8_SCHED; PG8_LDA8(At8, 1, 0); PG8_STAGE(PG8_SA(0, 1), a2, o21);
            PG8_WAIT_V(8); PG8_WAIT_L(0); PG8_BAR; PG8_MMA8(0, 0, At8, B08); PG8_MMA8(0, 1, At8, B18); PG8_BAR; PG8_SCHED;
            PG8_LDA8(At8, 1, 1); PG8_STAGE(PG8_SB(1, 0), b3, voffB); PG8_STAGE(PG8_SB(1, 1), b3 + hstep, voffB); PG8_STAGE(PG8_SA(1, 0), a3, o20);
            PG8_WAIT_V(8); PG8_WAIT_L(0); PG8_BAR; PG8_MMA8(1, 0, At8, B08); PG8_MMA8(1, 1, At8, B18); PG8_BAR; PG8_SCHED;
            } else if constexpr (FP8) {
            PG8_LDB8(B08, 0, 0); PG8_SCHED; PG8_LDA8(At8, 0, 0); PG8_STAGE(PG8_SA(1, 1), a1, cO1);
            PG8_WAIT_L(8); PG8_BAR; PG8_WAIT_L(0); PG8_MMA8(0, 0, At8, B08); PG8_BAR; PG8_SCHED;
            PG8_LDB8(B18, 0, 1); PG8_STAGE(PG8_SB(0, 0), b2, voffB);
            PG8_BAR; PG8_WAIT_L(0); PG8_MMA8(0, 1, At8, B18); PG8_BAR;
            PG8_LDA8(At8, 0, 1); PG8_STAGE(PG8_SA(0, 0), a2, o20);
            PG8_BAR; PG8_WAIT_L(0); PG8_MMA8(1, 0, At8, B08); PG8_BAR; PG8_SCHED;
            PG8_STAGE(PG8_SB(0, 1), b2 + hstep, voffB);
            PG8_WAIT_V(6); PG8_BAR; PG8_MMA8(1, 1, At8, B18); PG8_BAR;
            PG8_LDB8(B08, 1, 0); PG8_SCHED; PG8_LDA8(At8, 1, 0); PG8_STAGE(PG8_SA(0, 1), a2, o21);
            PG8_WAIT_L(8); PG8_BAR; PG8_WAIT_L(0); PG8_MMA8(0, 0, At8, B08); PG8_BAR; PG8_SCHED;
            PG8_LDB8(B18, 1, 1); PG8_STAGE(PG8_SB(1, 0), b3, voffB);
            PG8_BAR; PG8_WAIT_L(0); PG8_MMA8(0, 1, At8, B18); PG8_BAR;
            PG8_LDA8(At8, 1, 1); PG8_STAGE(PG8_SA(1, 0), a3, o20);
            PG8_BAR; PG8_WAIT_L(0); PG8_MMA8(1, 0, At8, B08); PG8_BAR; PG8_SCHED;
            PG8_STAGE(PG8_SB(1, 1), b3 + hstep, voffB);
            PG8_WAIT_V(6); PG8_BAR; PG8_MMA8(1, 1, At8, B18); PG8_BAR;
            } else {
            PG8_LDB(B0, 0, 0); PG8_LDB(B1, 0, 1); PG8_SCHED; PG8_LDA(At, 0, 0); PG8_STAGE(PG8_SA(1, 1), a1, cO1);
            PG8_WAIT_V(8); PG8_WAIT_L(0); PG8_BAR; PG8_MMA(0, 0, At, B0); PG8_MMA(0, 1, At, B1); PG8_BAR; PG8_SCHED;
            PG8_LDA(At, 0, 1); PG8_STAGE(PG8_SB(0, 0), b2, voffB); PG8_STAGE(PG8_SB(0, 1), b2 + hstep, voffB); PG8_STAGE(PG8_SA(0, 0), a2, o20);
            PG8_WAIT_V(8); PG8_WAIT_L(0); PG8_BAR; PG8_MMA(1, 0, At, B0); PG8_MMA(1, 1, At, B1); PG8_BAR; PG8_SCHED;
            PG8_LDB(B0, 1, 0); PG8_LDB(B1, 1, 1); PG8_SCHED; PG8_LDA(At, 1, 0); PG8_STAGE(PG8_SA(0, 1), a2, o21);
            PG8_WAIT_V(8); PG8_WAIT_L(0); PG8_BAR; PG8_MMA(0, 0, At, B0); PG8_MMA(0, 1, At, B1); PG8_BAR; PG8_SCHED;
            PG8_LDA(At, 1, 1); PG8_STAGE(PG8_SB(1, 0), b3, voffB); PG8_STAGE(PG8_SB(1, 1), b3 + hstep, voffB); PG8_STAGE(PG8_SA(1, 0), a3, o20);
            PG8_WAIT_V(8); PG8_WAIT_L(0); PG8_BAR; PG8_MMA(1, 0, At, B0); PG8_MMA(1, 1, At, B1); PG8_BAR; PG8_SCHED;
            }
        }
        if (wr == 0) PG8_BAR;
        if constexpr (FP8) asm volatile("s_nop 15\n\ts_nop 15" ::: "memory");
        E(acc, cur, wr, wc, fr, fq);
        if (!has_next) break;
#pragma unroll
        for (int a = 0; a < 2; ++a)
#pragma unroll
            for (int b = 0; b < 2; ++b)
#pragma unroll
                for (int m = 0; m < 4; ++m)
#pragma unroll
                    for (int n = 0; n < 2; ++n) acc[a][b][m][n] = (f32x4){0.f, 0.f, 0.f, 0.f};
        cur = nxt; cA = nA; cB = nB; ++ui;
#pragma unroll
        for (int i_ = 0; i_ < 2; ++i_) { cO0[i_] = nO0[i_]; cO1[i_] = nO1[i_]; }
        if (wr == 1) PG8_BAR;
    }
    PG8_WAIT_V(0);
    PG8_BAR;
#undef PG8_SA
#undef PG8_GOFF
#undef PG8_SB
#undef PG8_STAGE
#undef PG8_LDA
#undef PG8_LDB
#undef PG8_MMA
#undef PG8_MMA8
#undef PG8_LDA8
#undef PG8_LDB8
#undef PG8_LD32
#undef PG8_WAIT_V
#undef PG8_WAIT_L
#undef PG8_BAR
#undef PG8_SCHED
}
template <bool FP8, bool GATHER, class Epi, class Sched>
__device__ __forceinline__ void gemm_phase_g(LAS unsigned char* lds, const int K, const Sched& S, const Epi& E, const int wid, const int lane) { gemm_phase_s<FP8, GATHER, !FP8>(lds, K, S, E, wid, lane); }
template <bool FP8, class Epi, class Sched>
__device__ __forceinline__ void gemm_phase(LAS unsigned char* lds, const int K, const Sched& S, const Epi& E, const int wid, const int lane) { gemm_phase_s<FP8, false, !FP8>(lds, K, S, E, wid, lane); }
}

__device__ __forceinline__ int lane_id() { int l; asm volatile("v_mbcnt_lo_u32_b32 %0, -1, 0\n\tv_mbcnt_hi_u32_b32 %0, -1, %0" : "=v"(l)); return l; }
#define FT_DECL const int f_lane = lane_id(), f_tid = F.wave * 64 + f_lane; (void)f_tid; (void)f_lane
typedef const float* cfp_t;
typedef __attribute__((address_space(4))) cfp_t* kin_t;
struct Frame {
    LAS unsigned char* lds;
    volatile LAS unsigned* MISC;
    gu32* ctl;
    int wave, vcu, G;
    kin_t in;
    float* out;
    unsigned char* ws;
};
#define WSP(T, off) ((T*)(F.ws + (off)))

template <class RowMap>
__device__ __forceinline__ void p0_transpose_item(const float* W, int K, int N, bf16_t* WT, const RowMap& rowmap, const float* kscale, LAS float* scr, int item, int lane, bool kperm = false) {
    const int nblk = N / 32, kb = item / nblk, nb = item % nblk, k0 = 64 * kb, n0 = 32 * nb;
#pragma unroll 8
    for (int i = 0; i < 32; ++i) { const int kk = 2 * i + (lane >> 5); int ks = k0 + kk; if (kperm && ks >= K / 2) { const int j = ks - K / 2; ks = K / 2 + (j >> 3) + 64 * (j & 7); }
        float v = W[(size_t)ks * N + n0 + (lane & 31)]; if (kscale) v *= kscale[k0 + kk]; scr[kk * 33 + (lane & 31)] = v; }
    LDS_WAIT(); asm volatile("" ::: "memory");
    const int c = lane & 7;
#pragma unroll
    for (int j = 0; j < 4; ++j) { const int n = (lane >> 3) + 8 * j; const LAS float* s = scr + (8 * c) * 33 + n;
        u32x4 o; o.x = cvt_pk_bf16(s[0 * 33], s[1 * 33]); o.y = cvt_pk_bf16(s[2 * 33], s[3 * 33]); o.z = cvt_pk_bf16(s[4 * 33], s[5 * 33]); o.w = cvt_pk_bf16(s[6 * 33], s[7 * 33]);
        *(GAS u32x4*)(WT + (size_t)rowmap(n0 + n) * K + k0 + 8 * c) = o; }
    LDS_WAIT(); asm volatile("" ::: "memory");
}

__device__ __forceinline__ unsigned pk4_fp8(float a, float b, float c, float d) { int r = __builtin_amdgcn_cvt_pk_fp8_f32(a, b, 0, false); r = __builtin_amdgcn_cvt_pk_fp8_f32(c, d, r, true); return (unsigned)r; }
constexpr float EOSCALE = 16.f;
constexpr float WSCALE = 32.f;
template <class RowMap>
__device__ __forceinline__ void p0_transpose_item_f8(const float* W, int K, int N, unsigned char* WT, const RowMap& rowmap, LAS float* scr, int item, int lane) {
    const int nblk = N / 32, kb = item / nblk, nb = item % nblk, k0 = 128 * kb, n0 = 32 * nb;
#pragma unroll
    for (int hh = 0; hh < 2; ++hh) { float v[32];
#pragma unroll
        for (int i = 0; i < 32; ++i) { const int kk = 2 * (32 * hh + i) + (lane >> 5); v[i] = __builtin_nontemporal_load(W + (size_t)(k0 + kk) * N + n0 + (lane & 31)); }
#pragma unroll
        for (int i = 0; i < 32; ++i) { const int kk = 2 * (32 * hh + i) + (lane >> 5); scr[kk * 33 + (lane & 31)] = v[i] * WSCALE; } }
    LDS_WAIT(); asm volatile("" ::: "memory");
    const int c = lane & 7;
#pragma unroll
    for (int j = 0; j < 4; ++j) { const int n = (lane >> 3) + 8 * j; const LAS float* sp = scr + (16 * c) * 33 + n;
        u32x4 o; o.x = pk4_fp8(sp[0 * 33], sp[1 * 33], sp[2 * 33], sp[3 * 33]); o.y = pk4_fp8(sp[4 * 33], sp[5 * 33], sp[6 * 33], sp[7 * 33]);
        o.z = pk4_fp8(sp[8 * 33], sp[9 * 33], sp[10 * 33], sp[11 * 33]); o.w = pk4_fp8(sp[12 * 33], sp[13 * 33], sp[14 * 33], sp[15 * 33]);
        *(GAS u32x4*)(WT + (size_t)rowmap(n0 + n) * K + k0 + 16 * c) = o; }
    LDS_WAIT(); asm volatile("" ::: "memory");
}
struct MapW2 { __device__ __forceinline__ int operator()(int l) const { const int t = l & ~255, r = l & 255, wc = r >> 6, fq = (r >> 4) & 3, bj = (r >> 3) & 1, low = r & 7; return t + 128 * bj + 32 * wc + 8 * fq + low; } };
struct MapIdent { int off; __device__ __forceinline__ int operator()(int n) const { return off + n; } };
struct MapWin { __device__ __forceinline__ int operator()(int l) const {
    if (l >= 1024) return l;
    const int t = l & ~255, r = l & 255, wc = r >> 6, blk = (r >> 5) & 1, bj = (r >> 4) & 1, low = r & 15;
    return t + 128 * bj + 32 * wc + 16 * blk + low; } };
struct MapW1 { int off; __device__ __forceinline__ int operator()(int jp) const { const int bj = jp >> 10, j = jp & 1023; return off + 256 * (j >> 7) + 128 * bj + (j & 127); } };


__device__ __forceinline__ void p0_filter_item(Frame& F, int item) {
    FT_DECL;
#define in F.in
    LAS float* h1s = (LAS float*)(F.lds);
    LAS float* h2s = (LAS float*)(F.lds + 4096);
    const int t0 = item * 16;
    {
        const int tt = f_tid >> 5, hh = (f_tid & 31) * 2; const float pos = (float)(t0 + tt);
        float feats[17]; feats[0] = pos * (1.f / SEQ);
#pragma unroll
        for (int i = 0; i < 8; ++i) { const float band = 1e-4f + (float)i * ((7.f - 1e-4f) / 7.f); const float ang = (6.283185307179586f / SEQ) * pos * band; feats[1 + i] = __sinf(ang); feats[9 + i] = __cosf(ang); }
#pragma unroll
        for (int u = 0; u < 2; ++u) { const int h = hh + u; float a = in[19][h];
#pragma unroll
            for (int k = 0; k < 17; ++k) a += feats[k] * in[18][k * 64 + h];
            h1s[tt * 64 + h] = __sinf(in[20][h] * a); }
        __syncthreads();
#pragma unroll
        for (int u = 0; u < 2; ++u) { const int h = hh + u; float a = in[22][h];
#pragma unroll 8
            for (int k = 0; k < 64; ++k) a += h1s[tt * 64 + k] * in[21][k * 64 + h];
            h2s[tt * 64 + h] = __sinf(in[23][h] * a); }
        __syncthreads();
    }
    f32x4 acc[16];
#pragma unroll
    for (int t = 0; t < 16; ++t) acc[t] = (f32x4){0.f, 0.f, 0.f, 0.f};
    const int o = 4 * f_tid;
    for (int k0 = 0; k0 < 64; k0 += 4) { f32x4 w[4];
#pragma unroll
        for (int q = 0; q < 4; ++q) w[q] = *(const f32x4*)(in[24] + (size_t)(k0 + q) * 2048 + o);
#pragma unroll
        for (int t = 0; t < 16; ++t) { const f32x4 hv = *(const LAS f32x4*)(h2s + t * 64 + k0); acc[t] += w[0] * hv[0] + w[1] * hv[1] + w[2] * hv[2] + w[3] * hv[3]; } }
    const int c0 = o & 511, od = o >> 9;
    float* dst = WSP(float, WS_FILT) + ((size_t)od * 512 + c0) * SEQ + t0;
#pragma unroll
    for (int e = 0; e < 4; ++e) { const float la = -3.0701134573253944f, lb = -15.350567286626972f; const float delta = fabsf(la + (float)(c0 + e) * ((lb - la) / 511.f));
#pragma unroll
        for (int q = 0; q < 4; ++q) { f32x4 v;
#pragma unroll
            for (int i = 0; i < 4; ++i) { const int t = 4 * q + i; const float tn = (float)(t0 + t) * (1.f / SEQ); v[i] = acc[t][e] * __expf(-tn * delta); }
            *(f32x4*)(dst + (size_t)e * SEQ + 4 * q) = v; } }
    __syncthreads();
#undef in
}

__device__ __forceinline__ float silu_f(float v) { return v / (1.f + __expf(-v)); }

__device__ __forceinline__ void p0_prologue(Frame& F) {
    FT_DECL;
#define in F.in
    const int wg = blockIdx.x;
    if (wg < 96) {
        LAS float* sv = (LAS float*)F.lds;
        for (int i = f_tid; i < 9 * 1024; i += 512) { const int r = i >> 10, k = i & 1023; const float c = (r < 8) ? in[1][r * 1024 + k] : in[3][k]; sv[i] = silu_f(c); }
        __syncthreads();
        const int j = wg * 64 + f_lane; const float* wm = in[4];
        float acc[9];
#pragma unroll
        for (int r = 0; r < 9; ++r) acc[r] = 0.f;
        const int kbeg = F.wave * 128;
        for (int k0 = kbeg; k0 < kbeg + 128; k0 += 16) { float w[16];
#pragma unroll
            for (int q = 0; q < 16; ++q) w[q] = __builtin_nontemporal_load(wm + (size_t)(k0 + q) * (NMOD * DM) + j);
#pragma unroll
            for (int q = 0; q < 16; ++q)
#pragma unroll
                for (int r = 0; r < 9; ++r) acc[r] += sv[r * 1024 + k0 + q] * w[q]; }
        LAS float* red = (LAS float*)(F.lds + 40960);
#pragma unroll
        for (int r = 0; r < 9; ++r) red[(F.wave * 9 + r) * 64 + f_lane] = acc[r];
        __syncthreads();
        for (int i = f_tid; i < 9 * 64; i += 512) { const int r = i >> 6, l = i & 63; float s = in[5][wg * 64 + l];
#pragma unroll
            for (int w = 0; w < 8; ++w) s += red[(w * 9 + r) * 64 + l];
            WSP(float, WS_SMALL + SM_MOD)[r * (NMOD * DM) + wg * 64 + l] = s; }
        __syncthreads();
    } else if (wg == 96) {
        if (F.wave == 0) {
            const float a = wave_sum(in[11][f_lane] * in[12][f_lane]), b = wave_sum(in[13][f_lane] * in[14][f_lane]);
            float gq = fabsf(in[9][f_lane]), gk = fabsf(in[10][f_lane]);
#pragma unroll
            for (int o = 1; o < 64; o <<= 1) { gq = fmaxf(gq, __shfl_xor(gq, o)); gk = fmaxf(gk, __shfl_xor(gk, o)); }
            if (f_lane == 0) { float* sc = WSP(float, WS_SMALL + SM_SCAL); sc[0] = expf(a) - expf(b) + LAM_INIT;
                sc[1] = (8.f * gq * gk * 1.02f + 0.05f) * 1.4426950408889634f; }
        }
        for (int i = f_tid; i < 64 * 16; i += 512) { const int pos = i >> 4, f = i & 15;
            const float inv = powf(10000.f, -(float)f / 16.f); const float ang = (float)pos * inv;
            float* rt = WSP(float, WS_SMALL + SM_ROPE); rt[2 * i] = cosf(ang); rt[2 * i + 1] = sinf(ang); }
    }
    __syncthreads();
    for (int it = wg; it < SEQ / 16; it += F.G) p0_filter_item(F, it);
    __syncthreads();
    {
        LAS float* scr = (LAS float*)(F.lds + F.wave * 16896);
        const int gw = F.vcu * NWAVES + F.wave, NGW = F.G * NWAVES;
        constexpr int I_IN = (DM / 64) * (INC / 32), I_OUT = (DM / 64) * (DM / 32), I_1 = (DM / 128) * (2 * DM / 32), I_2 = (DM / 128) * (DM / 32);
        constexpr int NITEMS = I_IN + I_OUT + NEXP * (I_1 + I_2);
        for (int it = gw; it < NITEMS; it += NGW) {
            int r = it;
            if (r < I_IN) { p0_transpose_item(in[8], DM, INC, WSP(bf16_t, WS_WIN), MapWin{}, nullptr, scr, r, f_lane); continue; } r -= I_IN;
            if (r < I_OUT) { p0_transpose_item(in[27], DM, DM, WSP(bf16_t, WS_WOUT), MapIdent{0}, nullptr, scr, r, f_lane, true); continue; } r -= I_OUT;
            const int e = r / (I_1 + I_2); r -= e * (I_1 + I_2);
            if (r < I_1) p0_transpose_item_f8(in[30] + (size_t)e * DM * 2 * DM, DM, 2 * DM, WSP(unsigned char, WS_W1) + (size_t)e * 2 * DM * DM, MapW1{0}, scr, r, f_lane);
            else p0_transpose_item_f8(in[32] + (size_t)e * DM * DM, DM, DM, WSP(unsigned char, WS_W2) + (size_t)e * DM * DM, MapW2{}, scr, r - I_1, f_lane);
        }
    }
}
#undef in

__device__ __forceinline__ void p1_norm1(Frame& F) {
    FT_DECL;
    const int gw = F.vcu * NWAVES + F.wave, NGW = F.G * NWAVES;
    const float* mod = WSP(float, WS_SMALL + SM_MOD); const float* g1 = F.in[6];
    bf16_t* H = WSP(bf16_t, WS_H);
    constexpr int RPW = MTOT / (256 * NWAVES);
    for (int run = gw; run * RPW < MTOT; run += NGW) {
        const int r0 = run * RPW, r1 = (r0 + RPW < MTOT) ? r0 + RPW : MTOT;
        int curb = -1; f32x4 PA[4], PB[4];
        for (int m0 = r0; m0 < r1; m0 += 4) {
            f32x4 v[4][4];
#pragma unroll
            for (int u = 0; u < 4; ++u) { const int m = m0 + u; if (m < r1) {
                const float* xrow = (m < MROWS) ? F.in[0] + (size_t)m * DM : F.in[2] + (size_t)(m - MROWS) * DM; const GAS f32x4* xr = (const GAS f32x4*)xrow + f_lane;
#pragma unroll
                for (int j = 0; j < 4; ++j) v[u][j] = __builtin_nontemporal_load(xr + 64 * j); } }
#pragma unroll
            for (int u = 0; u < 4; ++u) { const int m = m0 + u; if (m < r1) {
                const int mb = (m < MROWS) ? (m >> 12) : 8;
                if (mb != curb) { curb = mb; const float* sh = mod + (size_t)mb * (NMOD * DM); const float* sc = sh + DM;
#pragma unroll
                    for (int j = 0; j < 4; ++j) { const int c = 4 * f_lane + 256 * j; PA[j] = *(const f32x4*)(g1 + c) * (*(const f32x4*)(sc + c) + 1.f); PB[j] = *(const f32x4*)(sh + c); } }
                float s = 0.f;
#pragma unroll
                for (int j = 0; j < 4; ++j) s += (v[u][j].x * v[u][j].x + v[u][j].y * v[u][j].y) + (v[u][j].z * v[u][j].z + v[u][j].w * v[u][j].w);
                const float rstd = rsqrtf(wave_sum(s) * (1.f / DM) + EPS);
                GAS u32x2* o8 = (GAS u32x2*)(H + (size_t)m * DM) + f_lane;
#pragma unroll
                for (int j = 0; j < 4; ++j) { const f32x4 y = v[u][j] * rstd * PA[j] + PB[j];
                    u32x2 w; w.x = cvt_pk_bf16(y.x, y.y); w.y = cvt_pk_bf16(y.z, y.w); o8[64 * j] = w; } } }
        }
    }
}

struct SchedInProj {
    int G, c; const char* H; const char* W;
    static constexpr int NA = 136 * 4, NV = 2 * 136, NBU = 6 * 128;
    __device__ __forceinline__ bool next(int i, g8::Unit& u) const {
        const long L = (long)i * G + c;
        if (L < NA) { g8::tile_of((int)L, 136, 4, u.pm, u.pn); u.a = H + (size_t)u.pm * 256 * DM * 2; u.b = W + (size_t)u.pn * 256 * DM * 2; u.kind = 0; u.ex = 0; return true; }
        if (L < NA + NV) { g8::tile_of((int)L - NA, 2, 136, u.pm, u.pn); u.a = W + (size_t)(1024 + u.pm * 256) * DM * 2; u.b = H + (size_t)u.pn * 256 * DM * 2; u.kind = 2; u.ex = 0; return true; }
        if (L < NA + NV + NBU) { g8::tile_of((int)L - NA - NV, 6, 128, u.pm, u.pn); u.a = W + (size_t)(QKVC + u.pm * 256) * DM * 2; u.b = H + (size_t)u.pn * 256 * DM * 2; u.kind = 1; u.ex = 0; return true; }
        return false;
    }
};
constexpr float Q8SCALE = 16.f;
struct EpiInProj {
    unsigned char *Q8, *K8, *VT8; bf16_t* UT; const float *gq, *gk, *rope;
    __device__ __forceinline__ void operator()(f32x4 (&acc)[2][2][4][2], const g8::Unit& u, int wr, int wc, int fr, int fq) const {
        asm volatile("" : "+v"(fr), "+v"(fq));
        if (u.kind == 1) {
            const int row0 = u.pm * 256 + wr * 64 + fr, col0 = u.pn * 256 + wc * 32 + 8 * fq;
#pragma unroll
            for (int ai = 0; ai < 2; ++ai)
#pragma unroll
                for (int m = 0; m < 4; ++m) { const int ch = row0 + ai * 128 + m * 16;
#pragma unroll
                    for (int bj = 0; bj < 2; ++bj) { const int tok = col0 + bj * 128; const f32x4 v0 = acc[ai][bj][m][0], v1 = acc[ai][bj][m][1];
                        u32x4 w; w.x = cvt_pk_bf16(v0[0], v0[1]); w.y = cvt_pk_bf16(v0[2], v0[3]); w.z = cvt_pk_bf16(v1[0], v1[1]); w.w = cvt_pk_bf16(v1[2], v1[3]);
                        *(u32x4*)(UT + ((size_t)(tok >> 7) * HYC + ch) * 128 + (tok & 127)) = w; } }
            return;
        }
        if (u.kind == 2) {
#pragma unroll
            for (int bj = 0; bj < 2; ++bj) { const int t8 = u.pn * 256 + bj * 128 + wc * 32 + 8 * fq;
                int b, key; if (t8 < MROWS) { b = t8 >> 12; key = CTXL + (t8 & 4095); } else { const int j = t8 - MROWS; b = j >> 8; key = j & 255; }
                const int tile = key >> 6, k = key & 63, ipos = (k < 32) ? 4 * (k >> 3) : 16 + 4 * ((k - 32) >> 3);
#pragma unroll
                for (int ai = 0; ai < 2; ++ai)
#pragma unroll
                    for (int m = 0; m < 4; ++m) { const int ch = u.pm * 256 + ai * 128 + wr * 64 + m * 16 + fr;
                        unsigned char* dst = VT8 + ((((size_t)(b * NHEAD + (ch >> 7)) * 68 + tile) * 128 + (ch & 127)) * 64) + ipos;
                        const f32x4 v0 = acc[ai][bj][m][0], v1 = acc[ai][bj][m][1];
                        *(unsigned*)dst = pk4_fp8(v0[0], v0[1], v0[2], v0[3]); *(unsigned*)(dst + 32) = pk4_fp8(v1[0], v1[1], v1[2], v1[3]); } }
            return;
        }
        const int blk = fq >> 1, f = fq & 1;
        const int sec = u.pn >> 1;
        const bool ctx = (u.pm >= 128);
        if (sec == 0 && ctx) return;
        const int colbase = (u.pn & 1) * 256 + wc * 64 + 32 * blk + 8 * f;
        float gg[2][2][4];
        { const float* gp = (sec == 0 ? gq : gk) + 32 * blk + 8 * f;
#pragma unroll
            for (int bj = 0; bj < 2; ++bj)
#pragma unroll
                for (int n = 0; n < 2; ++n) { const f32x4 t = *(const f32x4*)(gp + 16 * bj + 4 * n); gg[bj][n][0] = t[0]; gg[bj][n][1] = t[1]; gg[bj][n][2] = t[2]; gg[bj][n][3] = t[3]; } }
#pragma unroll
        for (int ai = 0; ai < 2; ++ai)
#pragma unroll
            for (int m = 0; m < 4; ++m) {
                const int rloc = ai * 128 + wr * 64 + m * 16 + fr; const int r = u.pm * 256 + rloc;
                f32x4 v[2][2];
#pragma unroll
                for (int bj = 0; bj < 2; ++bj)
#pragma unroll
                    for (int n = 0; n < 2; ++n) v[bj][n] = acc[ai][bj][m][n];
                size_t orow;
                if (sec == 0) orow = (size_t)r;
                else if (!ctx) orow = (size_t)(r >> 12) * KVL + CTXL + (r & 4095);
                else { const int j = r - MROWS; orow = (size_t)(j >> 8) * KVL + (j & 255); }
                float ss = 0.f;
#pragma unroll
                for (int bj = 0; bj < 2; ++bj)
#pragma unroll
                    for (int n = 0; n < 2; ++n) ss += (v[bj][n][0] * v[bj][n][0] + v[bj][n][1] * v[bj][n][1]) + (v[bj][n][2] * v[bj][n][2] + v[bj][n][3] * v[bj][n][3]);
                ss += __shfl_xor(ss, 16); ss += __shfl_xor(ss, 32);
                const float rstd = rsqrtf(ss * (1.f / 64.f) + EPS) * (sec == 0 ? QSCALE * Q8SCALE : 1.f);
#pragma unroll
                for (int bj = 0; bj < 2; ++bj)
#pragma unroll
                    for (int n = 0; n < 2; ++n)
#pragma unroll
                        for (int e = 0; e < 4; ++e) v[bj][n][e] *= rstd * gg[bj][n][e];
                if (!ctx) {
                    const int t = r & 4095; const int pos = blk ? (t & 63) : (t >> 6);
                    const float* rp = rope + (size_t)(pos * 16 + 8 * f) * 2;
#pragma unroll
                    for (int n = 0; n < 2; ++n) { const f32x4 c0 = *(const f32x4*)(rp + 8 * n), c1 = *(const f32x4*)(rp + 8 * n + 4);
                        const float cs[4] = {c0[0], c0[2], c1[0], c1[2]}, sn[4] = {c0[1], c0[3], c1[1], c1[3]};
#pragma unroll
                        for (int e = 0; e < 4; ++e) { const float x1 = v[0][n][e], x2 = v[1][n][e]; v[0][n][e] = x1 * cs[e] - x2 * sn[e]; v[1][n][e] = x2 * cs[e] + x1 * sn[e]; } }
                }
                unsigned char* dst = (sec == 0 ? Q8 : K8) + orow * QKW + colbase;
#pragma unroll
                for (int bj = 0; bj < 2; ++bj) { u32x2 w; w.x = pk4_fp8(v[bj][0][0], v[bj][0][1], v[bj][0][2], v[bj][0][3]); w.y = pk4_fp8(v[bj][1][0], v[bj][1][1], v[bj][1][2], v[bj][1][3]);
                    *(u32x2*)(dst + 16 * bj) = w; }
            }
    }
};

struct SchedStatic {
    int G, c, nM, nN; const char* A; const char* B;
    __device__ __forceinline__ bool next(int i, g8::Unit& u) const {
        const long L = (long)i * G + c; if (L >= (long)nM * nN) return false;
        g8::tile_of((int)L, nM, nN, u.pm, u.pn); u.a = A + (size_t)u.pm * 256 * DM * 2; u.b = B + (size_t)u.pn * 256 * DM * 2; u.kind = 0; u.ex = 0; return true;
    }
};
struct EpiOutProj {
    const float* x; bf16_t* out; const float* mod;
    __device__ __forceinline__ void operator()(f32x4 (&acc)[2][2][4][2], const g8::Unit& u, int wr, int wc, int fr, int fq) const {
        asm volatile("" : "+v"(fr), "+v"(fq));
        const int col0 = u.pn * 256 + wc * 32 + 8 * fq;
        const float* g1 = mod + (size_t)((u.pm * 256) >> 12) * (NMOD * DM) + 2 * DM + col0;
        f32x4 gv[2][2];
#pragma unroll
        for (int bj = 0; bj < 2; ++bj)
#pragma unroll
            for (int n = 0; n < 2; ++n) gv[bj][n] = *(const f32x4*)(g1 + bj * 128 + 4 * n);
#pragma unroll
        for (int ai = 0; ai < 2; ++ai)
#pragma unroll
            for (int m = 0; m < 4; ++m) { const int r = u.pm * 256 + ai * 128 + wr * 64 + m * 16 + fr;
                const size_t off = (size_t)r * DM + col0;
#pragma unroll
                for (int bj = 0; bj < 2; ++bj) { f32x4 o[2];
#pragma unroll
                    for (int n = 0; n < 2; ++n) { const f32x4 xv = __builtin_nontemporal_load((const f32x4*)(x + off + bj * 128 + 4 * n)); o[n] = xv + gv[bj][n] * acc[ai][bj][m][n]; }
                    u32x4 w; w.x = cvt_pk_bf16(o[0][0], o[0][1]); w.y = cvt_pk_bf16(o[0][2], o[0][3]); w.z = cvt_pk_bf16(o[1][0], o[1][1]); w.w = cvt_pk_bf16(o[1][2], o[1][3]);
                    *(u32x4*)(out + off + bj * 128) = w; } }
    }
};

namespace att8 {
constexpr int NT = KVL / 64, SHMB = 8192, NBUF = 6, LDS_V0 = NBUF * SHMB;
typedef int i32x8 __attribute__((ext_vector_type(8)));
#define SBAR() __builtin_amdgcn_sched_barrier(0)
__device__ __forceinline__ int crow(int r, int hi) { return (r & 3) + 8 * (r >> 2) + 4 * hi; }
__device__ __forceinline__ i32x8 ld32(const LAS unsigned char* p0, const LAS unsigned char* p1) {
    const u32x4 a = *(const LAS u32x4*)p0, b = *(const LAS u32x4*)p1; return (i32x8){(int)a.x, (int)a.y, (int)a.z, (int)a.w, (int)b.x, (int)b.y, (int)b.z, (int)b.w}; }
__device__ __forceinline__ void mfma_qk(f32x16& p, const i32x8& kf, const i32x8& qf, const f32x16& negc) {
    const unsigned s1 = 0x7f7f7f7fu, sq = 0x7b7b7b7bu;
    asm volatile("v_mfma_scale_f32_32x32x64_f8f6f4 %0, %1, %2, %3, %4, %5 op_sel_hi:[0,0,0]" : "=&v"(p) : "v"(kf), "v"(qf), "v"(negc), "v"(s1), "v"(sq));
}
__device__ __forceinline__ void mfma_pv(f32x16& o, const i32x8& pa, const i32x8& vf) {
    const unsigned s1 = 0x7f7f7f7fu;
    asm volatile("v_mfma_scale_f32_32x32x64_f8f6f4 %0, %1, %2, %0, %3, %3 op_sel_hi:[0,0,0]" : "+v"(o) : "v"(pa), "v"(vf), "v"(s1));
}
__device__ __forceinline__ void mfma_wait(f32x16& p0, f32x16& p1) { asm volatile("s_nop 15\n\ts_nop 3" : "+v"(p0), "+v"(p1)); }
__device__ __forceinline__ int grp(const f32x16& s, const int g, int old) {
    old = __builtin_amdgcn_cvt_pk_fp8_f32(__builtin_amdgcn_exp2f(s[4 * g]), __builtin_amdgcn_exp2f(s[4 * g + 1]), old, false);
    return __builtin_amdgcn_cvt_pk_fp8_f32(__builtin_amdgcn_exp2f(s[4 * g + 2]), __builtin_amdgcn_exp2f(s[4 * g + 3]), old, true);
}
__device__ __forceinline__ void attn_unit(const unsigned char* __restrict__ Qb, const unsigned char* __restrict__ Kh, const unsigned char* __restrict__ VTh, bf16_t* MIXo,
                                          const float lam, const float* __restrict__ subg, char* lds, const int wid) {
    const int lane = lane_id(), tid = wid * 64 + lane, r32 = lane & 31, hi = lane >> 5;
    const int sub = wid >> 2, wq = wid & 3;
    const LAS unsigned char* L = (const LAS unsigned char*)(uintptr_t)(unsigned)(uintptr_t)lds;
    f32x16 o[4] = {}; f32x16 ol = {};
    i32x8 ones; { int c1 = 0x38383838; asm volatile("" : "+v"(c1)); ones = (i32x8){c1, c1, c1, c1, c1, c1, c1, c1}; }
    i32x8 qf; { const unsigned char* qp = Qb + (size_t)(wq * 32 + r32) * QKW + sub * 64 + 32 * hi; const u32x4 a = *(const u32x4*)qp, b = *(const u32x4*)(qp + 16);
        qf = (i32x8){(int)a.x, (int)a.y, (int)a.z, (int)a.w, (int)b.x, (int)b.y, (int)b.z, (int)b.w}; }
    f32x16 negc; { float m5 = -5.f; asm volatile("" : "+v"(m5));
#pragma unroll
        for (int r = 0; r < 16; ++r) negc[r] = m5; }
    long ksrc, vsrc;
    { const int r = 8 * wid + (lane >> 3), c = (lane & 7) ^ ((r >> 1) & 7); ksrc = (long)r * QKW + c * 16; }
    { const int d = 16 * wid + (lane >> 2), c = (lane & 3) ^ ((d >> 2) & 3); vsrc = (long)d * 64 + c * 16; }
    const unsigned ldsb = (unsigned)(uintptr_t)lds, kdst = ldsb + (unsigned)wid * 1024u, vdst = ldsb + LDS_V0 + (unsigned)wid * 1024u;
    const LAS unsigned char *pk0, *pk1, *pv0, *pv1;
    { const int c0 = sub * 4 + hi * 2, sk = (r32 >> 1) & 7, sv = (r32 >> 2) & 3;
      pk0 = L + r32 * 128 + ((c0 ^ sk) << 4); pk1 = L + r32 * 128 + (((c0 + 1) ^ sk) << 4);
      pv0 = L + LDS_V0 + r32 * 64 + (((2 * hi) ^ sv) << 4); pv1 = L + LDS_V0 + r32 * 64 + (((2 * hi + 1) ^ sv) << 4); }
#define KF(b, w) ld32(pk0 + (b) * SHMB + (w) * 4096, pk1 + (b) * SHMB + (w) * 4096)
#define VF(b, d0) ld32(pv0 + (b) * SHMB + (d0) * 2048, pv1 + (b) * SHMB + (d0) * 2048)
#define DMA_TILE(t, b) do { \
        __builtin_amdgcn_global_load_lds((const unsigned*)(Kh + (long)(t) * 64 * QKW + ksrc), (LAS unsigned*)(uintptr_t)__builtin_amdgcn_readfirstlane(kdst + (unsigned)((b) * SHMB)), 16, 0, 0); \
        __builtin_amdgcn_global_load_lds((const unsigned*)(VTh + (long)(t) * 8192 + vsrc), (LAS unsigned*)(uintptr_t)__builtin_amdgcn_readfirstlane(vdst + (unsigned)((b) * SHMB)), 16, 0, 0); } while (0)
#define WBAR() do { asm volatile("s_waitcnt vmcnt(0)" ::: "memory"); __builtin_amdgcn_s_barrier(); asm volatile("" ::: "memory"); } while (0)
#define ITER(J, U, SX0, SX1, SY0, SY1, PC, PN, DO_DMA, DO_QK, DO_BAR) do { \
        mfma_pv(ol, PC, ones); SBAR(); \
        if (DO_DMA) { if ((J) + 3 < NT) DMA_TILE((J) + 3, ((U) + 4) % NBUF); if ((J) + 4 < NT) DMA_TILE((J) + 4, ((U) + 5) % NBUF); } \
        PN[0] = grp(SX0, 0, PN[0]); SBAR(); \
        mfma_pv(o[0], PC, vf0); SBAR(); \
        vf3 = VF(U, 3); if (DO_QK) { kf0 = KF(((U) + 2) % NBUF, 0); kf1 = KF(((U) + 2) % NBUF, 1); } \
        PN[1] = grp(SX0, 1, PN[1]); SBAR(); \
        mfma_pv(o[1], PC, vf1); SBAR(); PN[2] = grp(SX0, 2, PN[2]); SBAR(); \
        mfma_pv(o[2], PC, vf2); SBAR(); PN[3] = grp(SX0, 3, PN[3]); SBAR(); \
        mfma_pv(o[3], PC, vf3); SBAR(); PN[4] = grp(SX1, 0, PN[4]); SBAR(); \
        if (DO_QK) mfma_qk(SY0, kf0, qf, negc); SBAR(); PN[5] = grp(SX1, 1, PN[5]); SBAR(); \
        if (DO_QK) mfma_qk(SY1, kf1, qf, negc); SBAR(); PN[6] = grp(SX1, 2, PN[6]); PN[7] = grp(SX1, 3, PN[7]); \
        vf0 = VF(((U) + 1) % NBUF, 0); vf1 = VF(((U) + 1) % NBUF, 1); vf2 = VF(((U) + 1) % NBUF, 2); SBAR(); \
        if (DO_BAR) WBAR(); } while (0)
    f32x16 A0, A1, B0, B1; i32x8 paA = {}, paB = {}, kf0, kf1, vf0, vf1, vf2, vf3;
    DMA_TILE(0, 0); DMA_TILE(1, 1); DMA_TILE(2, 2); DMA_TILE(3, 3); WBAR();
    kf0 = KF(0, 0); kf1 = KF(0, 1); mfma_qk(A0, kf0, qf, negc); mfma_qk(A1, kf1, qf, negc);
    kf0 = KF(1, 0); kf1 = KF(1, 1); SBAR(); mfma_qk(B0, kf0, qf, negc); mfma_qk(B1, kf1, qf, negc);
    mfma_wait(A0, A1);
#pragma unroll
    for (int g = 0; g < 4; ++g) { paA[g] = grp(A0, g, paA[g]); paA[4 + g] = grp(A1, g, paA[4 + g]); }
    mfma_wait(B0, B1);
    vf0 = VF(0, 0); vf1 = VF(0, 1); vf2 = VF(0, 2); SBAR();
    static_assert(NT == 68, "the loop below (11 trips of 6 iterations, then iteration 67) is written for 68 KV tiles");
#pragma unroll 1
    for (int j = 1; j < NT - 2; j += 6) {
        ITER(j, 0, B0, B1, A0, A1, paA, paB, true, true, false);
        ITER(j + 1, 1, A0, A1, B0, B1, paB, paA, false, true, true);
        ITER(j + 2, 2, B0, B1, A0, A1, paA, paB, true, true, false);
        ITER(j + 3, 3, A0, A1, B0, B1, paB, paA, false, true, true);
        ITER(j + 4, 4, B0, B1, A0, A1, paA, paB, true, true, false);
        ITER(j + 5, 5, A0, A1, B0, B1, paB, paA, false, true, true);
    }
    ITER(67, 0, B0, B1, A0, A1, paA, paB, false, false, false);
    mfma_pv(ol, paB, ones); vf3 = VF(1, 3); SBAR();
    mfma_pv(o[0], paB, vf0); mfma_pv(o[1], paB, vf1); mfma_pv(o[2], paB, vf2); mfma_pv(o[3], paB, vf3);
    asm volatile("s_nop 15\n\ts_nop 3" : "+v"(o[0]), "+v"(o[1]), "+v"(o[2]), "+v"(o[3]), "+v"(ol));
#undef ITER
#undef KF
#undef VF
#undef DMA_TILE
#undef WBAR
    __syncthreads();
    float* X = (float*)lds;
    float rli[16];
#pragma unroll
    for (int r = 0; r < 16; ++r) rli[r] = __builtin_amdgcn_rcpf(ol[r]);
    if (sub == 1) {
#pragma unroll
        for (int r = 0; r < 16; ++r) { const int row = wq * 32 + crow(r, hi); const float sc = lam * rli[r];
#pragma unroll
            for (int d0 = 0; d0 < 4; ++d0) X[row * 128 + d0 * 32 + r32] = o[d0][r] * sc; }
    }
    __syncthreads();
    bf16_t* Y = (bf16_t*)(lds + 65536);
    if (sub == 0) {
        float sg[4];
#pragma unroll
        for (int d0 = 0; d0 < 4; ++d0) sg[d0] = subg[d0 * 32 + r32] * (1.f - LAM_INIT);
#pragma unroll
        for (int r = 0; r < 16; ++r) { const int row = wq * 32 + crow(r, hi);
            float v[4]; float ss = 0.f;
#pragma unroll
            for (int d0 = 0; d0 < 4; ++d0) { v[d0] = o[d0][r] * rli[r] - X[row * 128 + d0 * 32 + r32]; ss += v[d0] * v[d0]; }
            ss += __shfl_xor(ss, 1); ss += __shfl_xor(ss, 2); ss += __shfl_xor(ss, 4); ss += __shfl_xor(ss, 8); ss += __shfl_xor(ss, 16);
            const float rstd = rsqrtf(ss * (1.f / 128.f) + EPS);
#pragma unroll
            for (int d0 = 0; d0 < 4; ++d0) Y[row * 128 + d0 * 32 + r32] = (bf16_t)(cvt_pk_bf16(v[d0] * rstd * sg[d0], 0.f) & 0xffffu); }
    }
    __syncthreads();
    { const int row = tid >> 2, seg = (tid & 3) * 32;
#pragma unroll
        for (int i = 0; i < 4; ++i) { const u32x4 v = *(const u32x4*)(Y + row * 128 + seg + i * 8); *(u32x4*)(MIXo + (size_t)row * DM + seg + i * 8) = v; } }
    __syncthreads();
}
#undef SBAR
}

__device__ __forceinline__ void p3_attention8(Frame& F) {
    FT_DECL;
    const float* sc = WSP(float, WS_SMALL + SM_SCAL);
    const float lam = sc[0];
    const unsigned char* Q8 = WSP(unsigned char, WS_Q); const unsigned char* K8 = WSP(unsigned char, WS_K); const unsigned char* VT8 = WSP(unsigned char, WS_V); bf16_t* MIX = WSP(bf16_t, WS_MIX);
    const int c = blockIdx.x, xcd = c & 7, ci = c >> 3, per = F.G >> 3;
    for (int j = ci; j < 128; j += per) {
        const int pair = xcd * 4 + (j >> 5), qb = j & 31, b = pair >> 2, h = pair & 3;
        att8::attn_unit(Q8 + ((size_t)b * SEQ + qb * 128) * QKW + h * 128, K8 + (size_t)b * KVL * QKW + h * 128, VT8 + (size_t)(b * NHEAD + h) * 68 * 8192,
                        MIX + ((size_t)b * SEQ + qb * 128) * DM + h * 128, lam, F.in[15], (char*)F.lds, F.wave);
    }
}

namespace hy {
constexpr int RB_BYTES = 4352 * 8, IN_OFF = 2 * RB_BYTES, TW1_OFF = IN_OFF + 32768, TW2_OFF = TW1_OFF + 15 * 256 * 8, LDS_END = TW2_OFF + 15 * 16 * 8;
__device__ __forceinline__ f32x2 cmul(f32x2 a, f32x2 b) { return (f32x2){a.x * b.x - a.y * b.y, a.x * b.y + a.y * b.x}; }
__device__ __forceinline__ f32x2 cmulc(f32x2 a, f32x2 b) { return (f32x2){a.x * b.x + a.y * b.y, a.y * b.x - a.x * b.y}; }
__device__ __forceinline__ int P(int i) { return i + (i >> 4); }
template <bool INV> __device__ __forceinline__ void r4(f32x2& a, f32x2& b, f32x2& c, f32x2& d) {
    const f32x2 t0 = a + c, t1 = a - c, t2 = b + d, t3 = b - d;
    const f32x2 st3 = INV ? (f32x2){-t3.y, t3.x} : (f32x2){t3.y, -t3.x};
    a = t0 + t2; c = t0 - t2; b = t1 + st3; d = t1 - st3;
}
template <bool INV> __device__ __forceinline__ f32x2 tw(f32x2 v, float c, float s) {
    return INV ? (f32x2){v.x * c - v.y * s, v.y * c + v.x * s} : (f32x2){v.x * c + v.y * s, v.y * c - v.x * s};
}
template <bool INV> __device__ __forceinline__ void dft16(f32x2 (&v)[16]) {
    constexpr float C1 = 0.9238795325112867f, S1 = 0.3826834323650898f, R2 = 0.7071067811865476f;
    r4<INV>(v[0], v[4], v[8], v[12]); r4<INV>(v[1], v[5], v[9], v[13]); r4<INV>(v[2], v[6], v[10], v[14]); r4<INV>(v[3], v[7], v[11], v[15]);
    v[5] = tw<INV>(v[5], C1, S1);  v[9] = tw<INV>(v[9], R2, R2);    v[13] = tw<INV>(v[13], S1, C1);
    v[6] = tw<INV>(v[6], R2, R2);  v[10] = tw<INV>(v[10], 0.f, 1.f); v[14] = tw<INV>(v[14], -R2, R2);
    v[7] = tw<INV>(v[7], S1, C1);  v[11] = tw<INV>(v[11], -R2, R2);  v[15] = tw<INV>(v[15], -C1, -S1);
    r4<INV>(v[0], v[1], v[2], v[3]); r4<INV>(v[4], v[5], v[6], v[7]); r4<INV>(v[8], v[9], v[10], v[11]); r4<INV>(v[12], v[13], v[14], v[15]);
    f32x2 t;
    t = v[1]; v[1] = v[4]; v[4] = t;   t = v[2]; v[2] = v[8]; v[8] = t;    t = v[3]; v[3] = v[12]; v[12] = t;
    t = v[6]; v[6] = v[9]; v[9] = t;   t = v[7]; v[7] = v[13]; v[13] = t;  t = v[11]; v[11] = v[14]; v[14] = t;
}
struct Ctx { LAS f32x2* R; LAS f32x2* IN; LAS f32x2* TW1; LAS f32x2* TW2; int t, half; f32x2 wt; };
#define HY_OPAQUE(x) asm volatile("" : "+v"(x))
#define HY_W32(m) (f32x2){__builtin_cosf(-0.19634954084936207f * (m)), __builtin_sinf(-0.19634954084936207f * (m))}
template <int MODE> __device__ __forceinline__ void pass1_fwd(const Ctx& X) {
    f32x2 v[16]; int t = X.t; HY_OPAQUE(t);
#pragma unroll
    for (int m = 0; m < 16; ++m) { f32x2 a = X.IN[t + 256 * m]; if (MODE == 1) a = (f32x2){X.half ? a.y : a.x, 0.f}; v[m] = a; }
    if (X.half) {
#pragma unroll
        for (int m = 0; m < 16; ++m) v[m] = cmul(cmul(v[m], HY_W32(m)), X.wt);
    }
    dft16<false>(v);
#pragma unroll
    for (int q = 1; q < 16; ++q) v[q] = cmul(v[q], X.TW1[(q - 1) * 256 + t]);
    const int pb = t + (t >> 4);
#pragma unroll
    for (int q = 0; q < 16; ++q) X.R[pb + 272 * q] = v[q];
}
__device__ __forceinline__ void pass2_fwd(const Ctx& X) {
    int t = X.t; HY_OPAQUE(t);
    const int n2 = t & 15, pb = (t >> 4) * 272 + n2; f32x2 v[16];
#pragma unroll
    for (int m = 0; m < 16; ++m) v[m] = X.R[pb + 17 * m];
    dft16<false>(v);
#pragma unroll
    for (int q = 1; q < 16; ++q) v[q] = cmul(v[q], X.TW2[(q - 1) * 16 + n2]);
#pragma unroll
    for (int q = 0; q < 16; ++q) X.R[pb + 17 * q] = v[q];
}
template <bool FILTER> __device__ __forceinline__ void pass3(const Ctx& X, f32x2 (&H)[16]) {
    f32x2 v[16]; int t = X.t; HY_OPAQUE(t); const int pb = 17 * t;
#pragma unroll
    for (int m = 0; m < 16; ++m) v[m] = X.R[pb + m];
    dft16<false>(v);
    if (FILTER) {
#pragma unroll
        for (int q = 0; q < 16; ++q) H[q] = v[q] * (1.f / 8192.f);
    } else {
#pragma unroll
        for (int q = 0; q < 16; ++q) v[q] = cmul(v[q], H[q]);
        dft16<true>(v);
#pragma unroll
        for (int m = 0; m < 16; ++m) X.R[pb + m] = v[m];
    }
}
__device__ __forceinline__ void pass2_inv(const Ctx& X) {
    int t = X.t; HY_OPAQUE(t);
    const int n2 = t & 15, pb = (t >> 4) * 272 + n2; f32x2 v[16];
    v[0] = X.R[pb];
#pragma unroll
    for (int q = 1; q < 16; ++q) v[q] = cmulc(X.R[pb + 17 * q], X.TW2[(q - 1) * 16 + n2]);
    dft16<true>(v);
#pragma unroll
    for (int m = 0; m < 16; ++m) X.R[pb + 17 * m] = v[m];
}
__device__ __forceinline__ void pass1_inv(const Ctx& X) {
    f32x2 v[16]; int t = X.t; HY_OPAQUE(t); const int pb = t + (t >> 4);
    v[0] = X.R[pb];
#pragma unroll
    for (int q = 1; q < 16; ++q) v[q] = cmulc(X.R[pb + 272 * q], X.TW1[(q - 1) * 256 + t]);
    dft16<true>(v);
    if (X.half) {
#pragma unroll
        for (int m = 0; m < 16; ++m) v[m] = cmulc(cmulc(v[m], HY_W32(m)), X.wt);
    }
#pragma unroll
    for (int m = 0; m < 16; ++m) X.R[pb + 272 * m] = v[m];
}
#define HY_WSYNC() asm volatile("s_waitcnt lgkmcnt(0)" ::: "memory")
__device__ __forceinline__ void conv_fft(const Ctx& X, f32x2 (&H)[16]) {
    __syncthreads(); pass1_fwd<0>(X); __syncthreads(); pass2_fwd(X); HY_WSYNC(); pass3<false>(X, H); HY_WSYNC(); pass2_inv(X); __syncthreads(); pass1_inv(X); __syncthreads();
}
constexpr int STG_OFF = LDS_END;
constexpr int LDS_END2 = STG_OFF + 2 * SEQ * 2;
static_assert(LDS_END2 <= LDSCTL_OFF, "hyena LDS map");
__device__ __forceinline__ float sconv_lds(const LAS bf16_t* stg, int bs, int n, float w0, float w1, float w2, float bias) {
    const LAS bf16_t* p = stg + bs * SEQ;
    const float c = bf2f(p[n]), lv = bf2f(p[n - ((n > 0) ? 1 : 0)]), rv = bf2f(p[n + ((n < SEQ - 1) ? 1 : 0)]);
    const float l = (n > 0) ? lv : 0.f, r = (n < SEQ - 1) ? rv : 0.f;
    return bias + w0 * l + w1 * c + w2 * r;
}
__device__ __forceinline__ void setup_tables(LAS unsigned char* lds, int tid) {
    LAS f32x2* TW1 = (LAS f32x2*)(lds + TW1_OFF); LAS f32x2* TW2 = (LAS f32x2*)(lds + TW2_OFF);
    for (int i = tid; i < 15 * 256; i += 512) { const int q = i / 256 + 1, t = i & 255; float s, c; sincosf(-6.283185307179586f * (float)((t * q) & 4095) * (1.f / 4096.f), &s, &c); TW1[i] = (f32x2){c, s}; }
    for (int i = tid; i < 15 * 16; i += 512) { const int q = i / 16 + 1, n2 = i & 15; float s, c; sincosf(-6.283185307179586f * (float)((n2 * q) & 255) * (1.f / 256.f), &s, &c); TW2[i] = (f32x2){c, s}; }
}
__device__ __forceinline__ void unit(Frame& F, int c) {
    FT_DECL;
    const int tid = f_tid; Ctx X; X.half = F.wave >> 2; X.t = tid & 255;
    X.R = (LAS f32x2*)(F.lds + X.half * RB_BYTES); X.IN = (LAS f32x2*)(F.lds + IN_OFF); X.TW1 = (LAS f32x2*)(F.lds + TW1_OFF); X.TW2 = (LAS f32x2*)(F.lds + TW2_OFF);
    { float s, cc; sincosf(-6.283185307179586f * (float)X.t * (1.f / 8192.f), &s, &cc); X.wt = (f32x2){cc, s}; }
    LAS f32x2* RB0 = (LAS f32x2*)(F.lds); LAS f32x2* RB1 = (LAS f32x2*)(F.lds + RB_BYTES);
    const float* FILT = WSP(float, WS_FILT);
    f32x2 H0[16], H1[16];
#pragma unroll
    for (int ord = 0; ord < 2; ++ord) {
        const float* hf = FILT + ((size_t)(ord * 2 + 0) * 512 + c) * SEQ; const float* hb = FILT + ((size_t)(ord * 2 + 1) * 512 + c) * SEQ;
        __syncthreads();
        int nb = tid; HY_OPAQUE(nb);
#pragma unroll
        for (int j = 0; j < 8; ++j) { const int n = nb + 512 * j; const float a = hf[n], b = hb[(SEQ - n) & (SEQ - 1)]; const float lo = (n == 0) ? a + b : a, hi = (n == 0) ? 0.f : b; X.IN[n] = (f32x2){lo + hi, lo - hi}; }
        __syncthreads(); pass1_fwd<1>(X); __syncthreads(); pass2_fwd(X); HY_WSYNC();
        if (ord == 0) pass3<true>(X, H0); else pass3<true>(X, H1);
    }
    const bf16_t* UT = WSP(bf16_t, WS_UT);
    const bf16_t* rv = UT + (size_t)c * 128; const bf16_t* r1 = UT + (size_t)(512 + c) * 128; const bf16_t* r2 = UT + (size_t)(1024 + c) * 128;
#define HY_LD(rowp, t) (*(const u32x4*)((rowp) + (size_t)((t) >> 7) * (HYC * 128) + ((t) & 127)))
    const float* cw = F.in[16]; const float* cb = F.in[17];
    const float wv0 = cw[c], wv1 = cw[HYC + c], wv2 = cw[2 * HYC + c], bv = cb[c];
    const float wa0 = cw[512 + c], wa1 = cw[HYC + 512 + c], wa2 = cw[2 * HYC + 512 + c], ba = cb[512 + c];
    const float wb0 = cw[1024 + c], wb1 = cw[HYC + 1024 + c], wb2 = cw[2 * HYC + 1024 + c], bb = cb[1024 + c];
    const float sk0 = F.in[25][c], sk1 = F.in[25][512 + c];
    bf16_t* Z = WSP(bf16_t, WS_Z2T) + (size_t)c * 128;
    LAS bf16_t* STG = (LAS bf16_t*)(F.lds + STG_OFF);
    u32x4 g0 = HY_LD(rv, tid * 8), g1 = HY_LD(rv, SEQ + tid * 8);
    for (int pr = 0; pr < 4; ++pr) {
        const int b0 = 2 * pr, b1 = b0 + 1;
        f32x2 z[8]; int pc = tid + (tid >> 4); HY_OPAQUE(pc); int nb = tid; HY_OPAQUE(nb);
        __syncthreads();
        *(LAS u32x4*)(STG + tid * 8) = g0; *(LAS u32x4*)(STG + SEQ + tid * 8) = g1;
        __syncthreads();
#pragma unroll
        for (int j = 0; j < 8; ++j) { const int n = nb + 512 * j; z[j] = (f32x2){sconv_lds(STG, 0, n, wv0, wv1, wv2, bv), sconv_lds(STG, 1, n, wv0, wv1, wv2, bv)}; X.IN[n] = z[j]; }
        g0 = HY_LD(r1, b0 * SEQ + tid * 8); g1 = HY_LD(r1, b1 * SEQ + tid * 8);
        conv_fft(X, H0);
        *(LAS u32x4*)(STG + tid * 8) = g0; *(LAS u32x4*)(STG + SEQ + tid * 8) = g1;
        __syncthreads();
        HY_OPAQUE(nb); HY_OPAQUE(pc);
#pragma unroll
        for (int j = 0; j < 8; ++j) { const int n = nb + 512 * j; const f32x2 y = RB0[pc + 544 * j] + RB1[pc + 544 * j];
            const f32x2 g = (f32x2){sconv_lds(STG, 0, n, wa0, wa1, wa2, ba), sconv_lds(STG, 1, n, wa0, wa1, wa2, ba)};
            z[j] = g * (y + sk0 * z[j]); X.IN[n] = z[j]; }
        g0 = HY_LD(r2, b0 * SEQ + tid * 8); g1 = HY_LD(r2, b1 * SEQ + tid * 8);
        conv_fft(X, H1);
        *(LAS u32x4*)(STG + tid * 8) = g0; *(LAS u32x4*)(STG + SEQ + tid * 8) = g1;
        __syncthreads();
        if (pr < 3) { g0 = HY_LD(rv, (b0 + 2) * SEQ + tid * 8); g1 = HY_LD(rv, (b1 + 2) * SEQ + tid * 8); }
        HY_OPAQUE(nb); HY_OPAQUE(pc);
        f32x2 o[8];
#pragma unroll
        for (int j = 0; j < 8; ++j) { const int n = nb + 512 * j; const f32x2 y = RB0[pc + 544 * j] + RB1[pc + 544 * j];
            const f32x2 g = (f32x2){sconv_lds(STG, 0, n, wb0, wb1, wb2, bb), sconv_lds(STG, 1, n, wb0, wb1, wb2, bb)};
            o[j] = g * (y + sk1 * z[j]); }
        __syncthreads();
#pragma unroll
        for (int j = 0; j < 8; ++j) { const int n = nb + 512 * j; STG[n] = (bf16_t)(cvt_pk_bf16(o[j].x, 0.f) & 0xffffu); STG[SEQ + n] = (bf16_t)(cvt_pk_bf16(o[j].y, 0.f) & 0xffffu); }
        __syncthreads();
        { const int t0 = b0 * SEQ + tid * 8, t1 = b1 * SEQ + tid * 8;
          *(u32x4*)(Z + (size_t)(t0 >> 7) * (HYW * 128) + (t0 & 127)) = *(const LAS u32x4*)(STG + tid * 8); *(u32x4*)(Z + (size_t)(t1 >> 7) * (HYW * 128) + (t1 & 127)) = *(const LAS u32x4*)(STG + SEQ + tid * 8); }
    }
    __syncthreads();
}
}

__device__ __forceinline__ void p3_hyena(Frame& F) {
    FT_DECL;
    __syncthreads();
    hy::setup_tables(F.lds, f_tid);
    __syncthreads();
    for (int c = F.vcu; c < HYW; c += F.G) hy::unit(F, c);
}

__device__ __forceinline__ void p4_hynorm(Frame& F) {
    FT_DECL;
    const bf16_t* Z = WSP(bf16_t, WS_Z2T); bf16_t* MIX = WSP(bf16_t, WS_MIX); const float* g = F.in[26];
    constexpr int TP = 132;
    LAS bf16_t* T = (LAS bf16_t*)F.lds;
    LAS float* red = (LAS float*)(F.lds + 512 * TP * 2);
    LAS float* rs = red + 512;
    float gl[8];
#pragma unroll
    for (int e = 0; e < 8; ++e) gl[e] = g[(f_tid & 63) + 64 * e];
    for (int it = F.vcu; it < MROWS / 128; it += F.G) {
        const int tok0 = it * 128; const bf16_t* zt = Z + (size_t)it * (HYW * 128);
        __syncthreads();
        u32x4 v[16];
#pragma unroll
        for (int j = 0; j < 16; ++j) v[j] = __builtin_nontemporal_load((const u32x4*)(zt + (size_t)(f_tid + 512 * j) * 8));
#pragma unroll
        for (int j = 0; j < 16; ++j) { const int i = f_tid + 512 * j; LAS u32x2* d = (LAS u32x2*)(T + (i >> 4) * TP + (i & 15) * 8); d[0] = (u32x2){v[j].x, v[j].y}; d[1] = (u32x2){v[j].z, v[j].w}; }
        __syncthreads();
        { const int tok = f_tid & 127, grp = f_tid >> 7; float ss = 0.f;
#pragma unroll 8
            for (int k = 0; k < 128; ++k) { const float x = bf2f(T[(grp * 128 + k) * TP + tok]); ss += x * x; }
            red[grp * 128 + tok] = ss; }
        __syncthreads();
        if (f_tid < 128) rs[f_tid] = rsqrtf(((red[f_tid] + red[128 + f_tid]) + (red[256 + f_tid] + red[384 + f_tid])) * (1.f / HYW) + EPS);
        __syncthreads();
#pragma unroll
        for (int j = 0; j < 16; ++j) { const int i = f_tid + 512 * j, tok = i >> 6, l = i & 63; const float r = rs[tok];
            float x[8];
#pragma unroll
            for (int e = 0; e < 8; ++e) x[e] = bf2f(T[(l + 64 * e) * TP + tok]) * r * gl[e];
            u32x4 w; w.x = cvt_pk_bf16(x[0], x[1]); w.y = cvt_pk_bf16(x[2], x[3]); w.z = cvt_pk_bf16(x[4], x[5]); w.w = cvt_pk_bf16(x[6], x[7]);
            *(u32x4*)(MIX + (size_t)(tok0 + tok) * DM + 512 + 8 * l) = w; }
    }
}

constexpr size_t RT_TOPI = 0;
constexpr size_t RT_GATE = 512 * 1024;
constexpr size_t RT_POS = 1024 * 1024;
constexpr size_t RT_WGCNT = 1536 * 1024;
constexpr size_t RT_META = 1600 * 1024;
constexpr size_t RT_LIST = 2048 * 1024;
constexpr size_t RT_GSLOT = 2048 * 1024 + 640 * 1024;
constexpr int MAXSLOT = MROWS * TOPK + NEXP * 256;
constexpr int MAXTILE = MAXSLOT / 256;
constexpr size_t WS_XS = WS_EO;
constexpr int RW_PITCH = 32;
constexpr int P6_LDS_TOPI = 1024 * RW_PITCH * 4;

__device__ __forceinline__ void p6_router_mfma(Frame& F) {
    FT_DECL;
#define in F.in
    LAS float* WP = (LAS float*)F.lds;
    LAS int* TI = (LAS int*)(F.lds + P6_LDS_TOPI);
    LAS int* PS = TI + 512;
    LAS int* SC = PS + 512;
    LAS float* RSTD = (LAS float*)(SC + 512);
    LAS float* BIAS = RSTD + 128;
    LAS float* SSX = BIAS + 32;
    const float* rw = in[28]; const float* mod = WSP(float, WS_SMALL + SM_MOD); const float* g2n = in[7]; const float* rb = in[29];
    const bf16_t* XN = WSP(bf16_t, WS_XN); unsigned char* H2 = WSP(unsigned char, WS_H);
    int* topi_g = WSP(int, WS_ROUTE + RT_TOPI); float* gate_g = WSP(float, WS_ROUTE + RT_GATE); int* pos_g = WSP(int, WS_ROUTE + RT_POS); int* wgcnt = WSP(int, WS_ROUTE + RT_WGCNT);
    for (int blk = blockIdx.x; blk < MROWS / 128; blk += F.G) {
        const float* sh2 = mod + (size_t)(blk >> 5) * (NMOD * DM) + 3 * DM; const float* sc2 = sh2 + DM;
        __syncthreads();
#pragma unroll 1
        for (int hb = 0; hb < 2; ++hb) { f32x4 wv[8]; float gm[8];
#pragma unroll
            for (int q = 0; q < 8; ++q) { const int i = f_tid + 512 * (8 * hb + q), k = i >> 3, c4 = i & 7; wv[q] = *(const f32x4*)(rw + (size_t)k * 32 + c4 * 4); gm[q] = g2n[k] * (1.f + sc2[k]); }
#pragma unroll
            for (int q = 0; q < 8; ++q) { const int i = f_tid + 512 * (8 * hb + q), k = i >> 3, c4 = i & 7; *(LAS f32x4*)(WP + k * 32 + c4 * 4) = wv[q] * gm[q]; } }
        { const int e = f_tid & 31, part = f_tid >> 5; float a = 0.f;
#pragma unroll 1
            for (int k0 = part * 64; k0 < part * 64 + 64; k0 += 8) { float w[8], sh[8];
#pragma unroll
                for (int q = 0; q < 8; ++q) { w[q] = rw[(size_t)(k0 + q) * 32 + e]; sh[q] = sh2[k0 + q]; }
#pragma unroll
                for (int q = 0; q < 8; ++q) a += sh[q] * w[q]; }
            ((LAS float*)SC)[part * 32 + e] = a; }
        __syncthreads();
        if (f_tid < 32) { float a = rb[f_tid];
#pragma unroll
            for (int p = 0; p < 16; ++p) a += ((LAS float*)SC)[p * 32 + f_tid];
            BIAS[f_tid] = a; }
        const int rg = F.wave & 3, kh = F.wave >> 2, j = f_lane & 31, hi = f_lane >> 5;
        f32x16 acc = {};
        float ss = 0.f;
        { const bf16_t* xrow = XN + (size_t)(blk * 128 + rg * 32 + j) * DM + 512 * kh + 8 * hi;
            const LAS float* wp = WP + (512 * kh + 8 * hi) * 32 + j;
#pragma unroll 8
            for (int c = 0; c < 32; ++c) { const u32x4 xb = *(const u32x4*)(xrow + 16 * c);
                float xf[8] = {__uint_as_float(xb.x << 16), __uint_as_float(xb.x & 0xffff0000u), __uint_as_float(xb.y << 16), __uint_as_float(xb.y & 0xffff0000u),
                               __uint_as_float(xb.z << 16), __uint_as_float(xb.z & 0xffff0000u), __uint_as_float(xb.w << 16), __uint_as_float(xb.w & 0xffff0000u)};
#pragma unroll
                for (int q = 0; q < 8; ++q) { ss += xf[q] * xf[q]; acc = __builtin_amdgcn_mfma_f32_32x32x2f32(wp[(16 * c + q) * 32], xf[q], acc, 0, 0, 0); } } }
        { auto rr = __builtin_amdgcn_permlane32_swap(__float_as_uint(ss), __float_as_uint(ss), false, false); ss = __uint_as_float(rr[0]) + __uint_as_float(rr[1]); }
        if (hi == 0) SSX[kh * 128 + rg * 32 + j] = ss;
        __syncthreads();
        if (kh == 1) {
#pragma unroll
            for (int r = 0; r < 16; ++r) WP[(rg * 16 + r) * 64 + f_lane] = acc[r]; }
        if (f_tid < 128) RSTD[f_tid] = rsqrtf((SSX[f_tid] + SSX[128 + f_tid]) * (1.f / DM) + EPS);
        __syncthreads();
        if (kh == 0) {
            const float rstd = RSTD[rg * 32 + j];
            float tv[4] = {-INFINITY, -INFINITY, -INFINITY, -INFINITY}; int ti[4] = {1 << 20, 1 << 20, 1 << 20, 1 << 20};
#define P6_INS(V, E) do { float cv = (V); int ce = (E); _Pragma("unroll") for (int q = 0; q < 4; ++q) { const bool b = cv > tv[q] || (cv == tv[q] && ce < ti[q]); \
                const float nv = b ? tv[q] : cv; const int ne = b ? ti[q] : ce; tv[q] = b ? cv : tv[q]; ti[q] = b ? ce : ti[q]; cv = nv; ce = ne; } } while (0)
#pragma unroll
            for (int r = 0; r < 16; ++r) { const int e = (r & 3) + 8 * (r >> 2) + 4 * hi; const float v = (acc[r] + WP[(rg * 16 + r) * 64 + f_lane]) * rstd + BIAS[e]; P6_INS(v, e); }
            float ov[4]; int oe[4];
#pragma unroll
            for (int q = 0; q < 4; ++q) { ov[q] = __shfl_xor(tv[q], 32); oe[q] = __shfl_xor(ti[q], 32); }
#pragma unroll
            for (int q = 0; q < 4; ++q) P6_INS(ov[q], oe[q]);
#undef P6_INS
            if (hi == 0) { const int rl = rg * 32 + j, r = blk * 128 + rl;
                const float e1 = __expf(tv[1] - tv[0]), e2 = __expf(tv[2] - tv[0]), e3 = __expf(tv[3] - tv[0]); const float inv = 1.f / (1.f + e1 + e2 + e3);
                typedef int i32x4_t __attribute__((ext_vector_type(4))); const i32x4_t t4 = {ti[0], ti[1], ti[2], ti[3]};
                *(i32x4_t*)(topi_g + (size_t)r * 4) = t4; *(f32x4*)(gate_g + (size_t)r * 4) = (f32x4){inv, e1 * inv, e2 * inv, e3 * inv};
                *(LAS i32x4_t*)(TI + rl * 4) = t4; }
        }
        __syncthreads();
        { const int t2 = F.wave * 64 + lane_id(); const int e = t2 & 31, seg = t2 >> 5; int cnt = 0;
#pragma unroll 4
            for (int i = 0; i < 32; ++i) cnt += (TI[seg * 32 + i] == e) ? 1 : 0;
            SC[seg * 32 + e] = cnt;
            __syncthreads();
            int pre = 0;
            for (int s2 = 0; s2 < seg; ++s2) pre += SC[s2 * 32 + e];
            if (seg == 15) wgcnt[blk * 32 + e] = pre + cnt;
            for (int i = 0; i < 32; ++i) if (TI[seg * 32 + i] == e) { PS[seg * 32 + i] = pre; ++pre; }
        }
        __syncthreads();
        { const int t3 = F.wave * 64 + lane_id(); pos_g[(size_t)blk * 512 + t3] = PS[t3]; }
        { const int lane = lane_id();
            f32x4 PA[4], PB[4];
#pragma unroll
            for (int jj = 0; jj < 4; ++jj) { const int c = 4 * lane + 256 * jj; PA[jj] = *(const f32x4*)(g2n + c) * (*(const f32x4*)(sc2 + c) + 1.f); PB[jj] = *(const f32x4*)(sh2 + c); }
            for (int it = 0; it < 4; ++it) { u32x2 xb[4][4];
#pragma unroll
                for (int u = 0; u < 4; ++u) { const GAS u32x2* xr = (const GAS u32x2*)(XN + (size_t)(blk * 128 + F.wave * 16 + 4 * it + u) * DM) + lane;
#pragma unroll
                    for (int jj = 0; jj < 4; ++jj) xb[u][jj] = xr[64 * jj]; }
#pragma unroll
                for (int u = 0; u < 4; ++u) { const int rl = F.wave * 16 + 4 * it + u; const float rstd = RSTD[rl];
                    GAS unsigned* o4 = (GAS unsigned*)(H2 + (size_t)(blk * 128 + rl) * DM) + lane;
#pragma unroll
                    for (int jj = 0; jj < 4; ++jj) {
                        const f32x4 x = (f32x4){__uint_as_float(xb[u][jj].x << 16), __uint_as_float(xb[u][jj].x & 0xffff0000u), __uint_as_float(xb[u][jj].y << 16), __uint_as_float(xb[u][jj].y & 0xffff0000u)};
                        const f32x4 h = x * rstd * PA[jj] + PB[jj];
                        o4[64 * jj] = pk4_fp8(h.x, h.y, h.z, h.w); } } }
        }
    }
#undef in
}

__device__ __forceinline__ void p7_scatter(Frame& F) {
    FT_DECL;
    LAS int* TOT = (LAS int*)F.lds;
    LAS int* BASE = TOT + 32;
    LAS int* PRE = BASE + 32;
    LAS int* PART = PRE + 32;
    const int* wgcnt = WSP(int, WS_ROUTE + RT_WGCNT); const int* topi_g = WSP(int, WS_ROUTE + RT_TOPI); const float* gate_g = WSP(float, WS_ROUTE + RT_GATE); const int* pos_g = WSP(int, WS_ROUTE + RT_POS);
    int* list = WSP(int, WS_ROUTE + RT_LIST); float* gslot = WSP(float, WS_ROUTE + RT_GSLOT); int* meta = WSP(int, WS_ROUTE + RT_META);
    for (int blk = blockIdx.x; blk < MROWS / 128; blk += F.G) {
        __syncthreads();
        { const int e = f_tid & 31, part = f_tid >> 5; int st = 0, sp = 0;
            for (int w = part * 16; w < part * 16 + 16; ++w) { const int c = wgcnt[w * 32 + e]; st += c; if (w < blk) sp += c; }
            PART[part * 32 + e] = st; PART[512 + part * 32 + e] = sp; }
        __syncthreads();
        if (f_tid < 32) { int st = 0, sp = 0;
#pragma unroll
            for (int p = 0; p < 16; ++p) { st += PART[p * 32 + f_tid]; sp += PART[512 + p * 32 + f_tid]; }
            TOT[f_tid] = st; PRE[f_tid] = sp; }
        __syncthreads();
        if (f_tid == 0) { int b = 0; for (int e = 0; e < 32; ++e) { BASE[e] = b; b += (TOT[e] + 255) & ~255; }
            if (blk == 0) { int t = 0; for (int e = 0; e < 32; ++e) { meta[e] = TOT[e]; meta[32 + e] = BASE[e]; const int nt = (TOT[e] + 255) >> 8; for (int q = 0; q < nt; ++q) meta[128 + t + q] = e; t += nt; } meta[64] = t; } }
        __syncthreads();
        { const int a = f_tid, row = blk * 128 + (a >> 2); const int e = topi_g[(size_t)blk * 512 + a]; const int slot = BASE[e] + PRE[e] + pos_g[(size_t)blk * 512 + a];
            list[slot] = row * 4 + (a & 3); gslot[slot] = gate_g[(size_t)blk * 512 + a];
            PART[a] = slot; }
        __syncthreads();
        if (blk < NEXP) { const int e = blk, lo = BASE[e] + TOT[e], hi = BASE[e] + ((TOT[e] + 255) & ~255);
            for (int sl = lo + f_tid; sl < hi; sl += 512) { list[sl] = -1; gslot[sl] = 0.f; } }
    }
}

template <int NPN> struct SchedMoE {
    int G, c, nT; const char* A; const char* W; size_t wstride; const LAS unsigned char* tileE; const LAS int* RW; bool gath;
    __device__ __forceinline__ const LAS int* rows(int i) const { return RW + i * 256; }
    __device__ __forceinline__ bool next(int i, g8::Unit& u) const {
        const int L = i * G + c, xcd = L & 7, j = L >> 3, nTx = (nT + 7) >> 3, tl = j / NPN, T = xcd * nTx + tl, pn = j % NPN;
        if (tl >= nTx || T >= nT) return false;
        const int e = tileE[T];
        u.pm = T; u.pn = pn; u.kind = i; u.ex = e; u.a = gath ? A : A + (size_t)T * 256 * DM; u.b = W + (size_t)e * wstride + (size_t)pn * 256 * DM; return true;
    }
};
struct EpiSwiGLU {
    unsigned char* ACT; const float* b1;
    __device__ __forceinline__ void operator()(f32x4 (&acc)[2][2][4][2], const g8::Unit& u, int wr, int wc, int fr, int fq) const {
        asm volatile("" : "+v"(fr), "+v"(fq));
        const int j0 = u.pn * 128 + wc * 32 + 8 * fq; const float* bp = b1 + (size_t)u.ex * 2 * DM + j0;
        f32x4 bg[2], bl[2];
#pragma unroll
        for (int n = 0; n < 2; ++n) { bg[n] = *(const f32x4*)(bp + 4 * n); bl[n] = *(const f32x4*)(bp + DM + 4 * n); }
#pragma unroll
        for (int ai = 0; ai < 2; ++ai)
#pragma unroll
            for (int m = 0; m < 4; ++m) { const size_t slot = (size_t)u.pm * 256 + ai * 128 + wr * 64 + m * 16 + fr; float o[8];
#pragma unroll
                for (int n = 0; n < 2; ++n) { const f32x4 g4 = acc[ai][0][m][n] * (1.f / WSCALE) + bg[n], l4 = acc[ai][1][m][n] * (1.f / WSCALE) + bl[n];
#pragma unroll
                    for (int e = 0; e < 4; ++e) { const float g = fminf(g4[e], 7.f), l = __builtin_amdgcn_fmed3f(l4[e], -7.f, 7.f);
                        const float ex = __builtin_amdgcn_exp2f(g * (-1.702f * 1.4426950408889634f)); const float glu = g * __builtin_amdgcn_rcpf(1.f + ex);
                        o[4 * n + e] = fmaf(l, glu, glu); } }
                u32x2 w; w.x = pk4_fp8(o[0], o[1], o[2], o[3]); w.y = pk4_fp8(o[4], o[5], o[6], o[7]);
                *(u32x2*)(ACT + slot * DM + j0) = w; }
    }
};
struct EpiDown {
    unsigned char* EO; const float* b2; const LAS int* LL; int G, c;
    __device__ __forceinline__ void operator()(f32x4 (&acc)[2][2][4][2], const g8::Unit& u, int wr, int wc, int fr, int fq) const {
        asm volatile("" : "+v"(fr), "+v"(fq));
        const int c0 = u.pn * 256 + wc * 64 + 16 * fq; const float* bp = b2 + (size_t)u.ex * DM + c0;
        f32x4 bb[2][2];
#pragma unroll
        for (int bj = 0; bj < 2; ++bj)
#pragma unroll
            for (int n = 0; n < 2; ++n) bb[bj][n] = *(const f32x4*)(bp + bj * 8 + 4 * n);
        const LAS int* L = LL + u.kind * 512;
        int li[8]; float gt[8];
#pragma unroll
        for (int q = 0; q < 8; ++q) { const int rl = (q >> 2) * 128 + wr * 64 + (q & 3) * 16 + fr; li[q] = L[rl]; gt[q] = __int_as_float(L[256 + rl]) * (1.f / WSCALE); }
#pragma unroll
        for (int ai = 0; ai < 2; ++ai)
#pragma unroll
            for (int m = 0; m < 4; ++m) { const int l = li[ai * 4 + m]; const float g = gt[ai * 4 + m];
                unsigned char* dst = EO + ((size_t)(l & 3) * MROWS + (l >> 2)) * DM + c0;
                u32x4 w;
                { const f32x4 v0 = acc[ai][0][m][0] * g + bb[0][0] * (g * WSCALE), v1 = acc[ai][0][m][1] * g + bb[0][1] * (g * WSCALE);
                  w.x = pk4_fp8(v0[0] * EOSCALE, v0[1] * EOSCALE, v0[2] * EOSCALE, v0[3] * EOSCALE); w.y = pk4_fp8(v1[0] * EOSCALE, v1[1] * EOSCALE, v1[2] * EOSCALE, v1[3] * EOSCALE); }
                { const f32x4 v0 = acc[ai][1][m][0] * g + bb[1][0] * (g * WSCALE), v1 = acc[ai][1][m][1] * g + bb[1][1] * (g * WSCALE);
                  w.z = pk4_fp8(v0[0] * EOSCALE, v0[1] * EOSCALE, v0[2] * EOSCALE, v0[3] * EOSCALE); w.w = pk4_fp8(v1[0] * EOSCALE, v1[1] * EOSCALE, v1[2] * EOSCALE, v1[3] * EOSCALE); }
                if (l >= 0) *(u32x4*)dst = w; }
    }
};
__device__ __forceinline__ const LAS unsigned char* moe_tiles(Frame& F, int& nT) {
    FT_DECL;
    LAS unsigned char* TE = (LAS unsigned char*)(F.lds + RING_BYTES); const int* meta = WSP(int, WS_ROUTE + RT_META);
    __syncthreads();
    nT = meta[64]; if (nT > MAXTILE) nT = MAXTILE;
    for (int i = f_tid; i < MAXTILE; i += 512) TE[i] = (unsigned char)((i < nT) ? meta[128 + i] : 0);
    __syncthreads();
    return (const LAS unsigned char*)TE;
}

__device__ __forceinline__ void p10_combine(Frame& F) {
    FT_DECL;
    const float* mod = WSP(float, WS_SMALL + SM_MOD); const unsigned char* EO = WSP(unsigned char, WS_EO);
    const size_t gt = (size_t)F.vcu * 512 + f_tid, NTH = (size_t)F.G * 512;
    constexpr int U = 4;
    for (size_t i0 = gt; i0 < (size_t)MROWS * 128; i0 += NTH * U) {
        u32x2 ev[U][4]; f32x4 xv[U][2], gv[U][2];
#pragma unroll
        for (int u = 0; u < U; ++u) { const size_t i = i0 + (size_t)u * NTH; const size_t row = i >> 7; const int c0 = (int)(i & 127) * 8;
            const float* g2 = mod + (size_t)(row >> 12) * (NMOD * DM) + 5 * DM + c0; const bf16_t* op = WSP(bf16_t, WS_XN) + row * DM + c0;
#pragma unroll
            for (int k = 0; k < 4; ++k) ev[u][k] = __builtin_nontemporal_load((const u32x2*)(EO + ((size_t)k * MROWS + row) * DM + c0));
            { const u32x4 xb = *(const u32x4*)op; xv[u][0] = (f32x4){__uint_as_float(xb.x << 16), __uint_as_float(xb.x & 0xffff0000u), __uint_as_float(xb.y << 16), __uint_as_float(xb.y & 0xffff0000u)};
              xv[u][1] = (f32x4){__uint_as_float(xb.z << 16), __uint_as_float(xb.z & 0xffff0000u), __uint_as_float(xb.w << 16), __uint_as_float(xb.w & 0xffff0000u)}; }
            gv[u][0] = *(const f32x4*)g2; gv[u][1] = *(const f32x4*)(g2 + 4); }
#pragma unroll
        for (int u = 0; u < U; ++u) { const size_t i = i0 + (size_t)u * NTH; const size_t row = i >> 7; const int c0 = (int)(i & 127) * 8;
            float s[8];
#pragma unroll
            for (int e = 0; e < 8; ++e) s[e] = 0.f;
#pragma unroll
            for (int k = 0; k < 4; ++k) { const u32x2 v = ev[u][k];
                const f32x2 a = __builtin_amdgcn_cvt_pk_f32_fp8((int)v.x, false), b = __builtin_amdgcn_cvt_pk_f32_fp8((int)v.x, true), c = __builtin_amdgcn_cvt_pk_f32_fp8((int)v.y, false), d = __builtin_amdgcn_cvt_pk_f32_fp8((int)v.y, true);
                s[0] += a.x; s[1] += a.y; s[2] += b.x; s[3] += b.y; s[4] += c.x; s[5] += c.y; s[6] += d.x; s[7] += d.y; }
#pragma unroll
            for (int e = 0; e < 8; ++e) s[e] *= (1.f / EOSCALE);
            f32x4 o0 = xv[u][0] + gv[u][0] * (f32x4){s[0], s[1], s[2], s[3]}, o1 = xv[u][1] + gv[u][1] * (f32x4){s[4], s[5], s[6], s[7]};
            float* op = F.out + row * DM + c0;
            __builtin_nontemporal_store(o0, (f32x4*)op); __builtin_nontemporal_store(o1, (f32x4*)(op + 4)); }
    }
}

struct Args { const float* in[34]; float* out; unsigned char* ws; int ph_lo, ph_hi; };
constexpr int N_PHASES = 11;

__global__ void __launch_bounds__(512, 2) mega(Args args) {
    extern __shared__ __attribute__((aligned(16))) unsigned char lds[];
    Frame F;
    F.lds = (LAS unsigned char*)lds;
    F.MISC = (volatile LAS unsigned*)(F.lds + LDSCTL_OFF);
    F.wave = __builtin_amdgcn_readfirstlane(threadIdx.x >> 6);
    FT_DECL;
    F.G = gridDim.x; { const int bx = blockIdx.x; F.vcu = (F.G % 8 == 0) ? (bx % 8) * (F.G / 8) + bx / 8 : bx; }
    F.in = (kin_t)__builtin_amdgcn_kernarg_segment_ptr();
    F.out = args.out; F.ws = args.ws;
    F.ctl = (gu32*)(args.ws + WS_CTL);
    for (int u = f_tid; u < (LDS_BYTES - LDSCTL_OFF) / 4; u += NWAVES * 64) ((LAS unsigned*)(F.lds + LDSCTL_OFF))[u] = 0u;
    __syncthreads();
    const int lo = args.ph_lo, hi = args.ph_hi;
    XcdBarrier bar; bar.bar = (unsigned*)(F.ctl + CW_BAR); bar.x = 0; bar.st = nullptr;
    if (hi - lo > 1) bar = xcd_barrier_post((unsigned*)(F.ctl + CW_BAR), F.MISC + 8, f_tid == 0);
#define IN(k) (lo <= (k) && (k) < hi)
#define SEAM(k) do { if (IN(k) && IN((k) + 1)) xcd_barrier(bar, F.wave == 0 && lane_id() == 0); } while (0)

    if (IN(0)) { p0_prologue(F); } SEAM(0);
    if (IN(1)) { p1_norm1(F); } SEAM(1);
    if (IN(2)) {
        SchedInProj S{F.G, (int)blockIdx.x, (const char*)WSP(bf16_t, WS_H), (const char*)WSP(bf16_t, WS_WIN)};
        EpiInProj E{WSP(unsigned char, WS_Q), WSP(unsigned char, WS_K), WSP(unsigned char, WS_V), WSP(bf16_t, WS_UT), F.in[9], F.in[10], WSP(float, WS_SMALL + SM_ROPE)};
        g8::gemm_phase<false>(F.lds, DM, S, E, F.wave, lane_id());
    } SEAM(2);
    if (IN(3)) { p3_attention8(F); p3_hyena(F); } SEAM(3);
    if (IN(4)) { p4_hynorm(F); } SEAM(4);
    if (IN(5)) {
        SchedStatic S{F.G, (int)blockIdx.x, MROWS / 256, DM / 256, (const char*)WSP(bf16_t, WS_MIX), (const char*)WSP(bf16_t, WS_WOUT)};
        EpiOutProj E{F.in[0], WSP(bf16_t, WS_XN), WSP(float, WS_SMALL + SM_MOD)};
        g8::gemm_phase<false>(F.lds, DM, S, E, F.wave, lane_id());
    } SEAM(5);
    if (IN(6)) { p6_router_mfma(F); } SEAM(6);
    if (IN(7)) { p7_scatter(F); } SEAM(7);
    if (IN(8)) {
        int nT; const LAS unsigned char* TE = moe_tiles(F, nT);
        LAS int* RWL = (LAS int*)(F.lds + RING_BYTES + 1024);
        static_assert(RING_BYTES + 1024 + 17 * 1024 <= LDSCTL_OFF, "LDS map");
        SchedMoE<8> S{F.G, (int)blockIdx.x, nT, (const char*)WSP(char, WS_H), (const char*)WSP(char, WS_W1), (size_t)2 * DM * DM, TE, RWL, true};
        { const int* list = WSP(int, WS_ROUTE + RT_LIST); const int t8 = F.wave * 64 + lane_id();
            g8::Unit u; for (int i = 0; i < 17 && S.next(i, u); i += 2) { const int ii = i + (t8 >> 8); g8::Unit u2; if (S.next(ii, u2)) { const int li = list[(size_t)u2.pm * 256 + (t8 & 255)]; RWL[ii * 256 + (t8 & 255)] = (li >= 0) ? (li >> 2) : 0; } }
            __syncthreads(); }
        EpiSwiGLU E{WSP(unsigned char, WS_ACT), F.in[31]};
        g8::gemm_phase_g<true, true>(F.lds, DM, S, E, F.wave, lane_id());
    } SEAM(8);
    if (IN(9)) {
        int nT; const LAS unsigned char* TE = moe_tiles(F, nT);
        SchedMoE<4> S{F.G, (int)blockIdx.x, nT, (const char*)WSP(char, WS_ACT), (const char*)WSP(char, WS_W2), (size_t)DM * DM, TE, nullptr, false};
        LAS int* LL = (LAS int*)(F.lds + RING_BYTES + 1024);
        static_assert(RING_BYTES + 1024 + 9 * 2048 <= LDSCTL_OFF, "LDS map");
        { const int* list = WSP(int, WS_ROUTE + RT_LIST); const float* gslot = WSP(float, WS_ROUTE + RT_GSLOT);
            const int t9 = F.wave * 64 + lane_id();
            g8::Unit u; for (int i = 0; i < 9 && S.next(i, u); ++i) { const int t = t9 & 255; const size_t slot = (size_t)u.pm * 256 + t;
                LL[i * 512 + (t9 >> 8) * 256 + t] = (t9 < 256) ? list[slot] : __float_as_int(gslot[slot]); }
            __syncthreads(); }
        EpiDown E{WSP(unsigned char, WS_EO), F.in[33], LL, F.G, (int)blockIdx.x};
        g8::gemm_phase<true>(F.lds, DM, S, E, F.wave, lane_id());
    } SEAM(9);
    if (IN(10)) { p10_combine(F); }
#undef IN
#undef SEAM
}

extern "C" void kernel_launch(void* const* d_in, const int* in_sizes, int n_in, void* d_out, int out_size, void* d_ws, size_t ws_size, hipStream_t stream) {
    static int grid = 0;
    if (grid == 0) {
        if (n_in != 34 || out_size != MROWS * DM || ws_size < WS_END) { fprintf(stderr, "kernel_launch: unexpected shapes: n_in %d out %d ws %zu (need %zu)\n", n_in, out_size, ws_size, (size_t)WS_END); grid = -1; return; }
        int dev = 0, cus = 0, per_cu = 0;
        if (hipGetDevice(&dev) != hipSuccess || hipDeviceGetAttribute(&cus, hipDeviceAttributeMultiprocessorCount, dev) != hipSuccess) { grid = -1; return; }
        if (hipFuncSetAttribute((const void*)mega, hipFuncAttributeMaxDynamicSharedMemorySize, LDS_BYTES) != hipSuccess) { fprintf(stderr, "kernel_launch: hipFuncSetAttribute failed\n"); grid = -1; return; }
        if (hipOccupancyMaxActiveBlocksPerMultiprocessor(&per_cu, (const void*)mega, NWAVES * 64, LDS_BYTES) != hipSuccess || per_cu < 1) { fprintf(stderr, "kernel_launch: occupancy query says %d\n", per_cu); per_cu = 1; }
        (void)hipGetLastError();
        grid = cus;
    }
    if (grid < 0) return;
    (void)hipMemsetAsync((char*)d_ws + WS_CTL, 0, CTL_ZERO_BYTES, stream);
    Args a{};
    for (int i = 0; i < 34; ++i) a.in[i] = (const float*)d_in[i];
    a.out = (float*)d_out; a.ws = (unsigned char*)d_ws;
    constexpr int LAST = MK_LAST_PHASE + 1;
    if (MK_N_LAUNCHES == 1) { a.ph_lo = 0; a.ph_hi = LAST; hipLaunchKernelGGL(mega, dim3(grid), dim3(NWAVES * 64), LDS_BYTES, stream, a); }
    else for (int p = 0; p < LAST; ++p) { a.ph_lo = p; a.ph_hi = p + 1; hipLaunchKernelGGL(mega, dim3(grid), dim3(NWAVES * 64), LDS_BYTES, stream, a); }
    const hipError_t le = hipPeekAtLastError();
    if (le != hipSuccess) fprintf(stderr, "kernel_launch: launch failed: %s\n", hipGetErrorName(le));
}
```

```cpp
#include <hip/hip_runtime.h>
#include <hip/hip_bf16.h>
#include <cstdio>
#include <cstdint>

#ifndef MK_N_LAUNCHES
#define MK_N_LAUNCHES 1
#endif
#ifndef MK_LAST_PHASE
#define MK_LAST_PHASE 10
#endif

#define GAS __attribute__((address_space(1)))
#define LAS __attribute__((address_space(3)))
typedef unsigned short bf16_t;
typedef short bf16x8 __attribute__((ext_vector_type(8)));
typedef short s16x4 __attribute__((ext_vector_type(4)));
typedef float f32x2 __attribute__((ext_vector_type(2)));
typedef float f32x4 __attribute__((ext_vector_type(4)));
typedef float f32x16 __attribute__((ext_vector_type(16)));
typedef unsigned u32x2 __attribute__((ext_vector_type(2)));
typedef unsigned u32x4 __attribute__((ext_vector_type(4)));
typedef GAS unsigned gu32;

constexpr int NB = 8, SEQ = 4096, DM = 1024, MROWS = NB * SEQ, CTXL = 256, MCTX = NB * CTXL, MTOT = MROWS + MCTX;
constexpr int KVL = CTXL + SEQ;
constexpr int NHEAD = 4, QKW = 512;
constexpr int HYW = 512, HYC = 1536, INC = 3072, QKVC = 1536;
constexpr int NEXP = 32, TOPK = 4, NMOD = 6;
constexpr float EPS = 1e-6f;
constexpr float LAM_INIT = 0.2f;
constexpr float QSCALE = 0.125f * 1.4426950408889634f;

constexpr size_t MiB = 1u << 20;
constexpr size_t WS_CTL = 0, CTL_ZERO_BYTES = 64 * 1024;
constexpr size_t WS_SMALL = 1 * MiB;
constexpr size_t WS_WIN = 2 * MiB;
constexpr size_t WS_WOUT = 8 * MiB;
constexpr size_t WS_W1 = 10 * MiB;
constexpr size_t WS_W2 = 138 * MiB;
constexpr size_t WS_H = 202 * MiB;
constexpr size_t WS_Q = 270 * MiB;
constexpr size_t WS_K = 302 * MiB;
constexpr size_t WS_V = 336 * MiB;
constexpr size_t WS_UT = 370 * MiB;
constexpr size_t WS_FILT = 466 * MiB;
constexpr size_t WS_Z2T = 498 * MiB;
constexpr size_t WS_MIX = 530 * MiB;
constexpr size_t WS_ROUTE = 594 * MiB;
constexpr size_t WS_ACT = 270 * MiB;
constexpr size_t WS_EO = 598 * MiB;
constexpr size_t WS_XN = 870 * MiB;
constexpr size_t WS_END = 998 * MiB;
constexpr size_t SM_MOD = 0;
constexpr size_t SM_SCAL = 256 * 1024;
constexpr size_t SM_ROPE = 260 * 1024;
constexpr int CW_BAR = 4096;

constexpr int RING_BYTES = 131072;
constexpr int LDSCTL_OFF = 151552;
constexpr int LDS_BYTES = 152576;
constexpr int NWAVES = 8;

#define LDS_WAIT() asm volatile("s_waitcnt lgkmcnt(0)" ::: "memory")
#define VM_WAIT() asm volatile("s_waitcnt vmcnt(0)" ::: "memory")
#define RLX_AGENT __ATOMIC_RELAXED, __HIP_MEMORY_SCOPE_AGENT

__device__ __forceinline__ unsigned cvt_pk_bf16(float lo, float hi) { unsigned r; asm volatile("v_cvt_pk_bf16_f32 %0, %1, %2" : "=v"(r) : "v"(lo), "v"(hi)); return r; }
__device__ __forceinline__ float bf2f(bf16_t v) { return __uint_as_float(((unsigned)v) << 16); }
__device__ __forceinline__ float wave_sum(float v) {
#pragma unroll
    for (int o = 1; o < 64; o <<= 1) v += __shfl_xor(v, o);
    return v;
}

#define XB_TMO      128
#define XB_XCNT(j)  (256  + 64 * (j))
#define XB_XSUB(j)  (1280 + 64 * (j))
#define XB_XGEN(j)  (2304 + 64 * (j))
#define XB_TOP      3328
#define XB_TOPGEN   3392
#define XCD_BAR_WORDS 3456
#define XB_SPIN_CAP (1u << 22)
__device__ __forceinline__ unsigned xb_ld(unsigned* p)              { return __hip_atomic_load(p, __ATOMIC_RELAXED, __HIP_MEMORY_SCOPE_AGENT); }
__device__ __forceinline__ unsigned xb_add(unsigned* p, unsigned v) { return __hip_atomic_fetch_add(p, v, __ATOMIC_RELAXED, __HIP_MEMORY_SCOPE_AGENT); }
__device__ __forceinline__ unsigned xb_xcc_id() { return (unsigned)__builtin_amdgcn_s_getreg((3 << 11) | 20) & 0xFu; }
#define XB_SPIN(cond, bar) do { unsigned _sp = 0; while (cond) { __builtin_amdgcn_s_sleep(1); \
    if ((++_sp & 255u) == 0u) { if (xb_ld(&(bar)[XB_TMO])) break; if (_sp > XB_SPIN_CAP) { atomicAdd(&(bar)[XB_TMO], 1u); break; } } } } while (0)
struct XcdBarrier { unsigned* bar; unsigned x; volatile LAS unsigned* st; };
__device__ __forceinline__ XcdBarrier xcd_barrier_post(unsigned* bar, volatile LAS unsigned* st, bool leader) {
    XcdBarrier b; b.bar = bar; b.x = xb_xcc_id(); b.st = st;
    if (leader) (void)xb_add(&bar[XB_XCNT(b.x)], 1u);
    return b;
}
__device__ __forceinline__ void xcd_barrier_complete(unsigned* bar, unsigned x, unsigned& nloc, unsigned& nx) {
    const unsigned G = gridDim.x * gridDim.y * gridDim.z;
    unsigned sum, cnt, mine, sp = 0u;
    for (;;) {
        sum = 0u; cnt = 0u; mine = 0u;
#pragma unroll
        for (unsigned j = 0; j < 16; ++j) { const unsigned c = xb_ld(&bar[XB_XCNT(j)]); sum += c; cnt += (c > 0u) ? 1u : 0u; mine = (j == x) ? c : mine; }
        if (sum == G) break;
        __builtin_amdgcn_s_sleep(1);
        if ((++sp & 255u) == 0u) { if (xb_ld(&bar[XB_TMO])) break; if (sp > XB_SPIN_CAP) { atomicAdd(&bar[XB_TMO], 1u); break; } }
    }
    nloc = mine > 0u ? mine : 1u; nx = cnt > 0u ? cnt : 1u;
}
__device__ __forceinline__ void xcd_barrier(const XcdBarrier& b, bool leader) {
    asm volatile("s_waitcnt vmcnt(0)" ::: "memory");
    __syncthreads();
    if (leader) {
        unsigned* bar = b.bar;
        __builtin_amdgcn_s_waitcnt(0);
        unsigned nloc = b.st[0], nx = b.st[1];
        if (nloc == 0u) { xcd_barrier_complete(bar, b.x, nloc, nx); b.st[0] = nloc; b.st[1] = nx; }
        const unsigned old = xb_add(&bar[XB_XSUB(b.x)], 1u);
        const unsigned gen = old / nloc;
        if (old + 1u == (gen + 1u) * nloc) {
            __builtin_amdgcn_fence(__ATOMIC_RELEASE, "agent");
            asm volatile("s_waitcnt vmcnt(0)" ::: "memory");
            const unsigned og = xb_add(&bar[XB_TOP], 1u);
            const unsigned tg = og / nx;
            if (og + 1u == (tg + 1u) * nx) xb_add(&bar[XB_TOPGEN], 1u);
            else XB_SPIN(xb_ld(&bar[XB_TOPGEN]) == tg, bar);
            __builtin_amdgcn_fence(__ATOMIC_ACQUIRE, "agent");
            xb_add(&bar[XB_XGEN(b.x)], 1u);
            asm volatile("s_waitcnt vmcnt(0)" ::: "memory");
        } else {
            XB_SPIN(xb_ld(&bar[XB_XGEN(b.x)]) == gen, bar);
            __builtin_amdgcn_fence(__ATOMIC_ACQUIRE, "agent");
            asm volatile("s_waitcnt vmcnt(0)" ::: "memory");
        }
    }
    __syncthreads();
}

namespace g8 {
constexpr int BM = 256, BK = 64, HALF = 128, HTB = HALF * BK * 2, STAGE_BYTES = 8 * HTB, NXCD = 8, WGM = 8;
__host__ __device__ __forceinline__ int lds_byte(int r, int c) { const int st = (r >> 4) * 2 + (c >> 5), rr = r & 15, cc = c & 31, ob = rr * 64 + cc * 2; return st * 1024 + (ob ^ (((ob >> 9) & 1) << 5)); }
__host__ __device__ __forceinline__ void stage_rc(int b, int& R, int& C) { const int st = b / 1024, sb = b % 1024, swz = sb ^ (((sb >> 9) & 1) << 5); R = (st >> 1) * 16 + swz / 64; C = (st & 1) * 32 + (swz % 64) / 2; }
__host__ __device__ __forceinline__ int perm32(int rho) { const int n = rho >> 4, i = rho & 15; return 8 * (i >> 2) + 4 * n + (i & 3); }

struct Unit { const char* a; const char* b; int pm, pn, kind, ex; };

__device__ __forceinline__ void tile_of(int L, int nM, int nN, int& pm, int& pn) {
    const int nwg = nM * nN; int wgid = L;
    { const int q = nwg / NXCD, r = nwg % NXCD, xcd = wgid % NXCD, off = wgid / NXCD; wgid = (xcd < r ? xcd * (q + 1) : r * (q + 1) + (xcd - r) * q) + off; }
    const int nig = WGM * nN, gid = wgid / nig, fm = gid * WGM, gsz = (nM - fm) < WGM ? (nM - fm) : WGM;
    pm = fm + ((wgid % nig) % gsz); pn = (wgid % nig) / gsz;
}

typedef int i32x8 __attribute__((ext_vector_type(8)));
template <bool FP8, bool GATHER, bool SP2, class Epi, class Sched>
__device__ __forceinline__ void gemm_phase_s(LAS unsigned char* lds, const int K, const Sched& S, const Epi& E, const int wid, const int lane) {
    const int tid = wid * 64 + lane, wr = wid >> 2, wc = wid & 3, fr = lane & 15, fq = lane >> 4;
    const int nt = FP8 ? K / 128 : K / BK;
    const int RP = FP8 ? K : 2 * K;
    unsigned voffA[2], voffB[2]; int srow[2], scol[2];
#pragma unroll
    for (int i = 0; i < 2; ++i) { int R, C; stage_rc(tid * 16 + i * 8192, R, C); const int Rb = (R & ~31) + perm32(R & 31);
        voffA[i] = (unsigned)(R * RP + C * 2); voffB[i] = (unsigned)(Rb * RP + C * 2); srow[i] = R; scol[i] = C * 2; }
    const size_t kstep = (size_t)(BK * 2);
    const size_t hstep = (size_t)HALF * RP;
    const unsigned ldsw = (unsigned)wid * 1024u;
    unsigned cO0[2], cO1[2], nO0[2], nO1[2];
#define PG8_GOFF(D0, D1, ui_) do { if constexpr (GATHER) { const LAS int* rw_ = S.rows(ui_); _Pragma("unroll") for (int i_ = 0; i_ < 2; ++i_) { \
        D0[i_] = (unsigned)rw_[srow[i_]] * (unsigned)RP + (unsigned)scol[i_]; D1[i_] = (unsigned)rw_[128 + srow[i_]] * (unsigned)RP + (unsigned)scol[i_]; } } \
      else { _Pragma("unroll") for (int i_ = 0; i_ < 2; ++i_) { D0[i_] = voffA[i_]; D1[i_] = voffA[i_] + (unsigned)hstep; } } } while (0)
    const int aoff = lds_byte(wr * 64 + fr, FP8 ? fq * 16 : fq * 8), boff = lds_byte(wc * 32 + fr, FP8 ? fq * 16 : fq * 8);
    constexpr int KOFF = FP8 ? 16 : 1024;
#define PG8_SA(b, h) (((b) * 2 + (h)) * HTB)
#define PG8_SB(b, h) ((4 + (b) * 2 + (h)) * HTB)
#define PG8_STAGE(bufoff, gbase, voff) do { _Pragma("unroll") for (int _i = 0; _i < 2; ++_i) \
        __builtin_amdgcn_global_load_lds((const unsigned*)((const char*)(gbase) + (voff)[_i]), (LAS unsigned*)(lds + (bufoff) + ldsw + _i * 8192), 16, 0, 0); } while (0)
#define PG8_LD32(p) __builtin_bit_cast(i32x8, __builtin_shufflevector(*(const LAS u32x4*)(p), *(const LAS u32x4*)((p) + 16), 0, 1, 2, 3, 4, 5, 6, 7))
#define PG8_LDA8(dst, b, h) do { _Pragma("unroll") for (int m = 0; m < 4; ++m) dst[m] = PG8_LD32(lds + PG8_SA(b, h) + aoff + m * 2048); } while (0)
#define PG8_LDB8(dst, b, h) do { _Pragma("unroll") for (int n = 0; n < 2; ++n) dst[n] = PG8_LD32(lds + PG8_SB(b, h) + boff + n * 2048); } while (0)
#define PG8_LDA(dst, b, h) do { _Pragma("unroll") for (int m = 0; m < 4; ++m) _Pragma("unroll") for (int k = 0; k < 2; ++k) dst[m][k] = *(const LAS bf16x8*)(lds + PG8_SA(b, h) + aoff + m * 2048 + k * KOFF); } while (0)
#define PG8_LDB(dst, b, h) do { _Pragma("unroll") for (int n = 0; n < 2; ++n) _Pragma("unroll") for (int k = 0; k < 2; ++k) dst[n][k] = *(const LAS bf16x8*)(lds + PG8_SB(b, h) + boff + n * 2048 + k * KOFF); } while (0)
#define PG8_MMA(ai, bj, At, Bt) do { __builtin_amdgcn_s_setprio(1); _Pragma("unroll") for (int m = 0; m < 4; ++m) _Pragma("unroll") for (int n = 0; n < 2; ++n) _Pragma("unroll") for (int k = 0; k < 2; ++k) \
        acc[ai][bj][m][n] = __builtin_amdgcn_mfma_f32_16x16x32_bf16(Bt[n][k], At[m][k], acc[ai][bj][m][n], 0, 0, 0); __builtin_amdgcn_s_setprio(0); } while (0)
#define PG8_MMA8(ai, bj, At, Bt) do { __builtin_amdgcn_s_setprio(1); _Pragma("unroll") for (int m = 0; m < 4; ++m) _Pragma("unroll") for (int n = 0; n < 2; ++n) \
        asm volatile("v_mfma_scale_f32_16x16x128_f8f6f4 %0, %1, %2, %0, %3, %3 op_sel_hi:[0,0,0]" : "+v"(acc[ai][bj][m][n]) : "v"(Bt[n]), "v"(At[m]), "v"(one_scale)); __builtin_amdgcn_s_setprio(0); } while (0)
#define PG8_WAIT_V(n) asm volatile("s_waitcnt vmcnt(" #n ")" ::: "memory")
#define PG8_WAIT_L(n) asm volatile("s_waitcnt lgkmcnt(" #n ")" ::: "memory")
#define PG8_BAR __builtin_amdgcn_s_barrier()
#define PG8_SCHED __builtin_amdgcn_sched_barrier(0)
    Unit cur, nxt; int ui = 0;
    if (!S.next(0, cur)) return;
    f32x4 acc[2][2][4][2];
#pragma unroll
    for (int a = 0; a < 2; ++a)
#pragma unroll
        for (int b = 0; b < 2; ++b)
#pragma unroll
            for (int m = 0; m < 4; ++m)
#pragma unroll
                for (int n = 0; n < 2; ++n) acc[a][b][m][n] = (f32x4){0.f, 0.f, 0.f, 0.f};
    bf16x8 At[4][2], B0[2][2], B1[2][2];
    i32x8 At8[4], B08[2], B18[2];
    const unsigned one_scale = 0x7f7f7f7fu;
    const char* cA = cur.a; const char* cB = cur.b;
    PG8_GOFF(cO0, cO1, 0);
    if constexpr (SP2) {
    PG8_STAGE(PG8_SB(0, 0), cB, voffB); PG8_STAGE(PG8_SB(0, 1), cB + hstep, voffB); PG8_STAGE(PG8_SA(0, 0), cA, cO0); PG8_STAGE(PG8_SA(0, 1), cA, cO1);
    if (wr == 1) PG8_BAR;
    PG8_WAIT_V(2); PG8_BAR;
    PG8_STAGE(PG8_SB(1, 0), cB + kstep, voffB); PG8_STAGE(PG8_SA(1, 0), cA + kstep, cO0); PG8_STAGE(PG8_SB(1, 1), cB + hstep + kstep, voffB);
    PG8_WAIT_V(6); PG8_BAR;
    } else {
    PG8_STAGE(PG8_SB(0, 0), cB, voffB); PG8_STAGE(PG8_SA(0, 0), cA, cO0); PG8_STAGE(PG8_SB(0, 1), cB + hstep, voffB); PG8_STAGE(PG8_SA(0, 1), cA, cO1);
    if (wr == 1) PG8_BAR;
    PG8_WAIT_V(4); PG8_BAR;
    PG8_STAGE(PG8_SB(1, 0), cB + kstep, voffB); PG8_STAGE(PG8_SA(1, 0), cA + kstep, cO0); PG8_STAGE(PG8_SB(1, 1), cB + hstep + kstep, voffB);
    PG8_WAIT_V(6); PG8_BAR;
    }
    for (;;) {
        const bool has_next = S.next(ui + 1, nxt);
        const char* nA = has_next ? nxt.a : cA; const char* nB = has_next ? nxt.b : cB;
        if (has_next) PG8_GOFF(nO0, nO1, ui + 1); else { _Pragma("unroll") for (int i_ = 0; i_ < 2; ++i_) { nO0[i_] = cO0[i_]; nO1[i_] = cO1[i_]; } }
#pragma unroll 1
        for (int t = 0; t < nt; t += 2) {
            const bool last = (t == nt - 2);
            const char* a1 = cA + (size_t)(t + 1) * kstep;
            const char* a2 = last ? nA : cA + (size_t)(t + 2) * kstep; const char* b2 = last ? nB : cB + (size_t)(t + 2) * kstep;
            const char* a3 = a2 + kstep; const char* b3 = b2 + kstep;
            unsigned o20[2], o21[2];
#pragma unroll
            for (int i_ = 0; i_ < 2; ++i_) { o20[i_] = last ? nO0[i_] : cO0[i_]; o21[i_] = last ? nO1[i_] : cO1[i_]; }
            if constexpr (FP8 && SP2) {
            PG8_LDB8(B08, 0, 0); PG8_LDB8(B18, 0, 1); PG8_SCHED; PG8_LDA8(At8, 0, 0); PG8_STAGE(PG8_SA(1, 1), a1, cO1);
            PG8_WAIT_V(8); PG8_WAIT_L(0); PG8_BAR; PG8_MMA8(0, 0, At8, B08); PG8_MMA8(0, 1, At8, B18); PG8_BAR; PG8_SCHED;
            PG8_LDA8(At8, 0, 1); PG8_STAGE(PG8_SB(0, 0), b2, voffB); PG8_STAGE(PG8_SB(0, 1), b2 + hstep, voffB); PG8_STAGE(PG8_SA(0, 0), a2, o20);
            PG8_WAIT_V(8); PG8_WAIT_L(0); PG8_BAR; PG8_MMA8(1, 0, At8, B08); PG8_MMA8(1, 1, At8, B18); PG8_BAR; PG8_SCHED;
            PG8_LDB8(B08, 1, 0); PG8_LDB8(B18, 1, 1); PG8_SCHED; PG8_LDA8(At8, 1, 0); PG8_STAGE(PG8_SA(0, 1), a2, o21);
            PG8_WAIT_V(8); PG8_WAIT_L(0); PG8_BAR; PG8_MMA8(0, 0, At8, B08); PG8_MMA8(0, 1, At8, B18); PG8_BAR; PG8_SCHED;
            PG8_LDA8(At8, 1, 1); PG8_STAGE(PG8_SB(1, 0), b3, voffB); PG8_STAGE(PG8_SB(1, 1), b3 + hstep, voffB); PG8_STAGE(PG8_SA(1, 0), a3, o20);
            PG8_WAIT_V(8); PG8_WAIT_L(0); PG8_BAR; PG8_MMA8(1, 0, At8, B08); PG8_MMA8(1, 1, At8, B18); PG8_BAR; PG8_SCHED;
            } else if constexpr (FP8) {
            PG8_LDB8(B08, 0, 0); PG8_SCHED; PG8_LDA8(At8, 0, 0); PG8_STAGE(PG8_SA(1, 1), a1, cO1);
            PG8_WAIT_L(8); PG8_BAR; PG8_WAIT_L(0); PG8_MMA8(0, 0, At8, B08); PG8_BAR; PG8_SCHED;
            PG8_LDB8(B18, 0, 1); PG8_STAGE(PG8_SB(0, 0), b2, voffB);
            PG8_BAR; PG8_WAIT_L(0); PG8_MMA8(0, 1, At8, B18); PG8_BAR;
            PG8_LDA8(At8, 0, 1); PG8_STAGE(PG8_SA(0, 0), a2, o20);
            PG8_BAR; PG8_WAIT_L(0); PG8_MMA8(1, 0, At8, B08); PG8_BAR; PG8_SCHED;
            PG8_STAGE(PG8_SB(0, 1), b2 + hstep, voffB);
            PG8_WAIT_V(6); PG8_BAR; PG8_MMA8(1, 1, At8, B18); PG8_BAR;
            PG8_LDB8(B08, 1, 0); PG8_SCHED; PG8_LDA8(At8, 1, 0); PG8_STAGE(PG8_SA(0, 1), a2, o21);
            PG8_WAIT_L(8); PG8_BAR; PG8_WAIT_L(0); PG8_MMA8(0, 0, At8, B08); PG8_BAR; PG8_SCHED;
            PG8_LDB8(B18, 1, 1); PG8_STAGE(PG8_SB(1, 0), b3, voffB);
            PG8_BAR; PG8_WAIT_L(0); PG8_MMA8(0, 1, At8, B18); PG8_BAR;
            PG8_LDA8(At8, 1, 1); PG8_STAGE(PG8_SA(1, 0), a3, o20);
            PG8_BAR; PG8_WAIT_L(0); PG8_MMA8(1, 0, At8, B08); PG8_BAR; PG8_SCHED;
            PG8_STAGE(PG8_SB(1, 1), b3 + hstep, voffB);
            PG8_WAIT_V(6); PG8_BAR; PG8_MMA8(1, 1, At8, B18); PG8_BAR;
            } else {
            PG8_LDB(B0, 0, 0); PG8_LDB(B1, 0, 1); PG8_SCHED; PG8_LDA(At, 0, 0); PG8_STAGE(PG8_SA(1, 1), a1, cO1);
            PG8_WAIT_V(8); PG8_WAIT_L(0); PG8_BAR; PG8_MMA(0, 0, At, B0); PG8_MMA(0, 1, At, B1); PG8_BAR; PG8_SCHED;
            PG8_LDA(At, 0, 1); PG8_STAGE(PG8_SB(0, 0), b2, voffB); PG8_STAGE(PG8_SB(0, 1), b2 + hstep, voffB); PG8_STAGE(PG8_SA(0, 0), a2, o20);
            PG8_WAIT_V(8); PG8_WAIT_L(0); PG8_BAR; PG8_MMA(1, 0, At, B0); PG8_MMA(1, 1, At, B1); PG8_BAR; PG8_SCHED;
            PG8_LDB(B0, 1, 0); PG8_LDB(B1, 1, 1); PG8_SCHED; PG8_LDA(At, 1, 0); PG8_STAGE(PG8_SA(0, 1), a2, o21);
            PG8_WAIT_V(8); PG8_WAIT_L(0); PG8_BAR; PG8_MMA(0, 0, At, B0); PG8_MMA(0, 1, At, B1); PG8_BAR; PG8_SCHED;
            PG8_LDA(At, 1, 1); PG8_STAGE(PG8_SB(1, 0), b3, voffB); PG8_STAGE(PG8_SB(1, 1), b3 + hstep, voffB); PG8_STAGE(PG8_SA(1, 0), a3, o20);
            PG8_WAIT_V(8); PG8_WAIT_L(0); PG8_BAR; PG8_MMA(1, 0, At, B0); PG8_MMA(1, 1, At, B1); PG8_BAR; PG8_SCHED;
            }
        }
        if (wr == 0) PG8_BAR;
        if constexpr (FP8) asm volatile("s_nop 15\n\ts_nop 15" ::: "memory");
        E(acc, cur, wr, wc, fr, fq);
        if (!has_next) break;
#pragma unroll
        for (int a = 0; a < 2; ++a)
#pragma unroll
            for (int b = 0; b < 2; ++b)
#pragma unroll
                for (int m = 0; m < 4; ++m)
#pragma unroll
                    for (int n = 0; n < 2; ++n) acc[a][b][m][n] = (f32x4){0.f, 0.f, 0.f, 0.f};
        cur = nxt; cA = nA; cB = nB; ++ui;
#pragma unroll
        for (int i_ = 0; i_ < 2; ++i_) { cO0[i_] = nO0[i_]; cO1[i_] = nO1[i_]; }
        if (wr == 1) PG8_BAR;
    }
    PG8_WAIT_V(0);
    PG8_BAR;
#undef PG8_SA
#undef PG8_GOFF
#undef PG8_SB
#undef PG8_STAGE
#undef PG8_LDA
#undef PG8_LDB
#undef PG8_MMA
#undef PG8_MMA8
#undef PG8_LDA8
#undef PG8_LDB8
#undef PG8_LD32
#undef PG8_WAIT_V
#undef PG8_WAIT_L
#undef PG8_BAR
#undef PG8_SCHED
}
template <bool FP8, bool GATHER, class Epi, class Sched>
__device__ __forceinline__ void gemm_phase_g(LAS unsigned char* lds, const int K, const Sched& S, const Epi& E, const int wid, const int lane) { gemm_phase_s<FP8, GATHER, !FP8>(lds, K, S, E, wid, lane); }
template <bool FP8, class Epi, class Sched>
__device__ __forceinline__ void gemm_phase(LAS unsigned char* lds, const int K, const Sched& S, const Epi& E, const int wid, const int lane) { gemm_phase_s<FP8, false, !FP8>(lds, K, S, E, wid, lane); }
}

__device__ __forceinline__ int lane_id() { int l; asm volatile("v_mbcnt_lo_u32_b32 %0, -1, 0\n\tv_mbcnt_hi_u32_b32 %0, -1, %0" : "=v"(l)); return l; }
#define FT_DECL const int f_lane = lane_id(), f_tid = F.wave * 64 + f_lane; (void)f_tid; (void)f_lane
typedef const float* cfp_t;
typedef __attribute__((address_space(4))) cfp_t* kin_t;
struct Frame {
    LAS unsigned char* lds;
    volatile LAS unsigned* MISC;
    gu32* ctl;
    int wave, vcu, G;
    kin_t in;
    float* out;
    unsigned char* ws;
};
#define WSP(T, off) ((T*)(F.ws + (off)))

template <class RowMap>
__device__ __forceinline__ void p0_transpose_item(const float* W, int K, int N, bf16_t* WT, const RowMap& rowmap, const float* kscale, LAS float* scr, int item, int lane, bool kperm = false) {
    const int nblk = N / 32, kb = item / nblk, nb = item % nblk, k0 = 64 * kb, n0 = 32 * nb;
#pragma unroll 8
    for (int i = 0; i < 32; ++i) { const int kk = 2 * i + (lane >> 5); int ks = k0 + kk; if (kperm && ks >= K / 2) { const int j = ks - K / 2; ks = K / 2 + (j >> 3) + 64 * (j & 7); }
        float v = W[(size_t)ks * N + n0 + (lane & 31)]; if (kscale) v *= kscale[k0 + kk]; scr[kk * 33 + (lane & 31)] = v; }
    LDS_WAIT(); asm volatile("" ::: "memory");
    const int c = lane & 7;
#pragma unroll
    for (int j = 0; j < 4; ++j) { const int n = (lane >> 3) + 8 * j; const LAS float* s = scr + (8 * c) * 33 + n;
        u32x4 o; o.x = cvt_pk_bf16(s[0 * 33], s[1 * 33]); o.y = cvt_pk_bf16(s[2 * 33], s[3 * 33]); o.z = cvt_pk_bf16(s[4 * 33], s[5 * 33]); o.w = cvt_pk_bf16(s[6 * 33], s[7 * 33]);
        *(GAS u32x4*)(WT + (size_t)rowmap(n0 + n) * K + k0 + 8 * c) = o; }
    LDS_WAIT(); asm volatile("" ::: "memory");
}

__device__ __forceinline__ unsigned pk4_fp8(float a, float b, float c, float d) { int r = __builtin_amdgcn_cvt_pk_fp8_f32(a, b, 0, false); r = __builtin_amdgcn_cvt_pk_fp8_f32(c, d, r, true); return (unsigned)r; }
constexpr float EOSCALE = 16.f;
constexpr float WSCALE = 32.f;
template <class RowMap>
__device__ __forceinline__ void p0_transpose_item_f8(const float* W, int K, int N, unsigned char* WT, const RowMap& rowmap, LAS float* scr, int item, int lane) {
    const int nblk = N / 32, kb = item / nblk, nb = item % nblk, k0 = 128 * kb, n0 = 32 * nb;
#pragma unroll
    for (int hh = 0; hh < 2; ++hh) { float v[32];
#pragma unroll
        for (int i = 0; i < 32; ++i) { const int kk = 2 * (32 * hh + i) + (lane >> 5); v[i] = __builtin_nontemporal_load(W + (size_t)(k0 + kk) * N + n0 + (lane & 31)); }
#pragma unroll
        for (int i = 0; i < 32; ++i) { const int kk = 2 * (32 * hh + i) + (lane >> 5); scr[kk * 33 + (lane & 31)] = v[i] * WSCALE; } }
    LDS_WAIT(); asm volatile("" ::: "memory");
    const int c = lane & 7;
#pragma unroll
    for (int j = 0; j < 4; ++j) { const int n = (lane >> 3) + 8 * j; const LAS float* sp = scr + (16 * c) * 33 + n;
        u32x4 o; o.x = pk4_fp8(sp[0 * 33], sp[1 * 33], sp[2 * 33], sp[3 * 33]); o.y = pk4_fp8(sp[4 * 33], sp[5 * 33], sp[6 * 33], sp[7 * 33]);
        o.z = pk4_fp8(sp[8 * 33], sp[9 * 33], sp[10 * 33], sp[11 * 33]); o.w = pk4_fp8(sp[12 * 33], sp[13 * 33], sp[14 * 33], sp[15 * 33]);
        *(GAS u32x4*)(WT + (size_t)rowmap(n0 + n) * K + k0 + 16 * c) = o; }
    LDS_WAIT(); asm volatile("" ::: "memory");
}
struct MapW2 { __device__ __forceinline__ int operator()(int l) const { const int t = l & ~255, r = l & 255, wc = r >> 6, fq = (r >> 4) & 3, bj = (r >> 3) & 1, low = r & 7; return t + 128 * bj + 32 * wc + 8 * fq + low; } };
struct MapIdent { int off; __device__ __forceinline__ int operator()(int n) const { return off + n; } };
struct MapWin { __device__ __forceinline__ int operator()(int l) const {
    if (l >= 1024) return l;
    const int t = l & ~255, r = l & 255, wc = r >> 6, blk = (r >> 5) & 1, bj = (r >> 4) & 1, low = r & 15;
    return t + 128 * bj + 32 * wc + 16 * blk + low; } };
struct MapW1 { int off; __device__ __forceinline__ int operator()(int jp) const { const int bj = jp >> 10, j = jp & 1023; return off + 256 * (j >> 7) + 128 * bj + (j & 127); } };


__device__ __forceinline__ void p0_filter_item(Frame& F, int item) {
    FT_DECL;
#define in F.in
    LAS float* h1s = (LAS float*)(F.lds);
    LAS float* h2s = (LAS float*)(F.lds + 4096);
    const int t0 = item * 16;
    {
        const int tt = f_tid >> 5, hh = (f_tid & 31) * 2; const float pos = (float)(t0 + tt);
        float feats[17]; feats[0] = pos * (1.f / SEQ);
#pragma unroll
        for (int i = 0; i < 8; ++i) { const float band = 1e-4f + (float)i * ((7.f - 1e-4f) / 7.f); const float ang = (6.283185307179586f / SEQ) * pos * band; feats[1 + i] = __sinf(ang); feats[9 + i] = __cosf(ang); }
#pragma unroll
        for (int u = 0; u < 2; ++u) { const int h = hh + u; float a = in[19][h];
#pragma unroll
            for (int k = 0; k < 17; ++k) a += feats[k] * in[18][k * 64 + h];
            h1s[tt * 64 + h] = __sinf(in[20][h] * a); }
        __syncthreads();
#pragma unroll
        for (int u = 0; u < 2; ++u) { const int h = hh + u; float a = in[22][h];
#pragma unroll 8
            for (int k = 0; k < 64; ++k) a += h1s[tt * 64 + k] * in[21][k * 64 + h];
            h2s[tt * 64 + h] = __sinf(in[23][h] * a); }
        __syncthreads();
    }
    f32x4 acc[16];
#pragma unroll
    for (int t = 0; t < 16; ++t) acc[t] = (f32x4){0.f, 0.f, 0.f, 0.f};
    const int o = 4 * f_tid;
    for (int k0 = 0; k0 < 64; k0 += 4) { f32x4 w[4];
#pragma unroll
        for (int q = 0; q < 4; ++q) w[q] = *(const f32x4*)(in[24] + (size_t)(k0 + q) * 2048 + o);
#pragma unroll
        for (int t = 0; t < 16; ++t) { const f32x4 hv = *(const LAS f32x4*)(h2s + t * 64 + k0); acc[t] += w[0] * hv[0] + w[1] * hv[1] + w[2] * hv[2] + w[3] * hv[3]; } }
    const int c0 = o & 511, od = o >> 9;
    float* dst = WSP(float, WS_FILT) + ((size_t)od * 512 + c0) * SEQ + t0;
#pragma unroll
    for (int e = 0; e < 4; ++e) { const float la = -3.0701134573253944f, lb = -15.350567286626972f; const float delta = fabsf(la + (float)(c0 + e) * ((lb - la) / 511.f));
#pragma unroll
        for (int q = 0; q < 4; ++q) { f32x4 v;
#pragma unroll
            for (int i = 0; i < 4; ++i) { const int t = 4 * q + i; const float tn = (float)(t0 + t) * (1.f / SEQ); v[i] = acc[t][e] * __expf(-tn * delta); }
            *(f32x4*)(dst + (size_t)e * SEQ + 4 * q) = v; } }
    __syncthreads();
#undef in
}

__device__ __forceinline__ float silu_f(float v) { return v / (1.f + __expf(-v)); }

__device__ __forceinline__ void p0_prologue(Frame& F) {
    FT_DECL;
#define in F.in
    const int wg = blockIdx.x;
    if (wg < 96) {
        LAS float* sv = (LAS float*)F.lds;
        for (int i = f_tid; i < 9 * 1024; i += 512) { const int r = i >> 10, k = i & 1023; const float c = (r < 8) ? in[1][r * 1024 + k] : in[3][k]; sv[i] = silu_f(c); }
        __syncthreads();
        const int j = wg * 64 + f_lane; const float* wm = in[4];
        float acc[9];
#pragma unroll
        for (int r = 0; r < 9; ++r) acc[r] = 0.f;
        const int kbeg = F.wave * 128;
        for (int k0 = kbeg; k0 < kbeg + 128; k0 += 16) { float w[16];
#pragma unroll
            for (int q = 0; q < 16; ++q) w[q] = __builtin_nontemporal_load(wm + (size_t)(k0 + q) * (NMOD * DM) + j);
#pragma unroll
            for (int q = 0; q < 16; ++q)
#pragma unroll
                for (int r = 0; r < 9; ++r) acc[r] += sv[r * 1024 + k0 + q] * w[q]; }
        LAS float* red = (LAS float*)(F.lds + 40960);
#pragma unroll
        for (int r = 0; r < 9; ++r) red[(F.wave * 9 + r) * 64 + f_lane] = acc[r];
        __syncthreads();
        for (int i = f_tid; i < 9 * 64; i += 512) { const int r = i >> 6, l = i & 63; float s = in[5][wg * 64 + l];
#pragma unroll
            for (int w = 0; w < 8; ++w) s += red[(w * 9 + r) * 64 + l];
            WSP(float, WS_SMALL + SM_MOD)[r * (NMOD * DM) + wg * 64 + l] = s; }
        __syncthreads();
    } else if (wg == 96) {
        if (F.wave == 0) {
            const float a = wave_sum(in[11][f_lane] * in[12][f_lane]), b = wave_sum(in[13][f_lane] * in[14][f_lane]);
            float gq = fabsf(in[9][f_lane]), gk = fabsf(in[10][f_lane]);
#pragma unroll
            for (int o = 1; o < 64; o <<= 1) { gq = fmaxf(gq, __shfl_xor(gq, o)); gk = fmaxf(gk, __shfl_xor(gk, o)); }
            if (f_lane == 0) { float* sc = WSP(float, WS_SMALL + SM_SCAL); sc[0] = expf(a) - expf(b) + LAM_INIT;
                sc[1] = (8.f * gq * gk * 1.02f + 0.05f) * 1.4426950408889634f; }
        }
        for (int i = f_tid; i < 64 * 16; i += 512) { const int pos = i >> 4, f = i & 15;
            const float inv = powf(10000.f, -(float)f / 16.f); const float ang = (float)pos * inv;
            float* rt = WSP(float, WS_SMALL + SM_ROPE); rt[2 * i] = cosf(ang); rt[2 * i + 1] = sinf(ang); }
    }
    __syncthreads();
    for (int it = wg; it < SEQ / 16; it += F.G) p0_filter_item(F, it);
    __syncthreads();
    {
        LAS float* scr = (LAS float*)(F.lds + F.wave * 16896);
        const int gw = F.vcu * NWAVES + F.wave, NGW = F.G * NWAVES;
        constexpr int I_IN = (DM / 64) * (INC / 32), I_OUT = (DM / 64) * (DM / 32), I_1 = (DM / 128) * (2 * DM / 32), I_2 = (DM / 128) * (DM / 32);
        constexpr int NITEMS = I_IN + I_OUT + NEXP * (I_1 + I_2);
        for (int it = gw; it < NITEMS; it += NGW) {
            int r = it;
            if (r < I_IN) { p0_transpose_item(in[8], DM, INC, WSP(bf16_t, WS_WIN), MapWin{}, nullptr, scr, r, f_lane); continue; } r -= I_IN;
            if (r < I_OUT) { p0_transpose_item(in[27], DM, DM, WSP(bf16_t, WS_WOUT), MapIdent{0}, nullptr, scr, r, f_lane, true); continue; } r -= I_OUT;
            const int e = r / (I_1 + I_2); r -= e * (I_1 + I_2);
            if (r < I_1) p0_transpose_item_f8(in[30] + (size_t)e * DM * 2 * DM, DM, 2 * DM, WSP(unsigned char, WS_W1) + (size_t)e * 2 * DM * DM, MapW1{0}, scr, r, f_lane);
            else p0_transpose_item_f8(in[32] + (size_t)e * DM * DM, DM, DM, WSP(unsigned char, WS_W2) + (size_t)e * DM * DM, MapW2{}, scr, r - I_1, f_lane);
        }
    }
}
#undef in

__device__ __forceinline__ void p1_norm1(Frame& F) {
    FT_DECL;
    const int gw = F.vcu * NWAVES + F.wave, NGW = F.G * NWAVES;
    const float* mod = WSP(float, WS_SMALL + SM_MOD); const float* g1 = F.in[6];
    bf16_t* H = WSP(bf16_t, WS_H);
    constexpr int RPW = MTOT / (256 * NWAVES);
    for (int run = gw; run * RPW < MTOT; run += NGW) {
        const int r0 = run * RPW, r1 = (r0 + RPW < MTOT) ? r0 + RPW : MTOT;
        int curb = -1; f32x4 PA[4], PB[4];
        for (int m0 = r0; m0 < r1; m0 += 4) {
            f32x4 v[4][4];
#pragma unroll
            for (int u = 0; u < 4; ++u) { const int m = m0 + u; if (m < r1) {
                const float* xrow = (m < MROWS) ? F.in[0] + (size_t)m * DM : F.in[2] + (size_t)(m - MROWS) * DM; const GAS f32x4* xr = (const GAS f32x4*)xrow + f_lane;
#pragma unroll
                for (int j = 0; j < 4; ++j) v[u][j] = __builtin_nontemporal_load(xr + 64 * j); } }
#pragma unroll
            for (int u = 0; u < 4; ++u) { const int m = m0 + u; if (m < r1) {
                const int mb = (m < MROWS) ? (m >> 12) : 8;
                if (mb != curb) { curb = mb; const float* sh = mod + (size_t)mb * (NMOD * DM); const float* sc = sh + DM;
#pragma unroll
                    for (int j = 0; j < 4; ++j) { const int c = 4 * f_lane + 256 * j; PA[j] = *(const f32x4*)(g1 + c) * (*(const f32x4*)(sc + c) + 1.f); PB[j] = *(const f32x4*)(sh + c); } }
                float s = 0.f;
#pragma unroll
                for (int j = 0; j < 4; ++j) s += (v[u][j].x * v[u][j].x + v[u][j].y * v[u][j].y) + (v[u][j].z * v[u][j].z + v[u][j].w * v[u][j].w);
                const float rstd = rsqrtf(wave_sum(s) * (1.f / DM) + EPS);
                GAS u32x2* o8 = (GAS u32x2*)(H + (size_t)m * DM) + f_lane;
#pragma unroll
                for (int j = 0; j < 4; ++j) { const f32x4 y = v[u][j] * rstd * PA[j] + PB[j];
                    u32x2 w; w.x = cvt_pk_bf16(y.x, y.y); w.y = cvt_pk_bf16(y.z, y.w); o8[64 * j] = w; } } }
        }
    }
}

struct SchedInProj {
    int G, c; const char* H; const char* W;
    static constexpr int NA = 136 * 4, NV = 2 * 136, NBU = 6 * 128;
    __device__ __forceinline__ bool next(int i, g8::Unit& u) const {
        const long L = (long)i * G + c;
        if (L < NA) { g8::tile_of((int)L, 136, 4, u.pm, u.pn); u.a = H + (size_t)u.pm * 256 * DM * 2; u.b = W + (size_t)u.pn * 256 * DM * 2; u.kind = 0; u.ex = 0; return true; }
        if (L < NA + NV) { g8::tile_of((int)L - NA, 2, 136, u.pm, u.pn); u.a = W + (size_t)(1024 + u.pm * 256) * DM * 2; u.b = H + (size_t)u.pn * 256 * DM * 2; u.kind = 2; u.ex = 0; return true; }
        if (L < NA + NV + NBU) { g8::tile_of((int)L - NA - NV, 6, 128, u.pm, u.pn); u.a = W + (size_t)(QKVC + u.pm * 256) * DM * 2; u.b = H + (size_t)u.pn * 256 * DM * 2; u.kind = 1; u.ex = 0; return true; }
        return false;
    }
};
constexpr float Q8SCALE = 16.f;
struct EpiInProj {
    unsigned char *Q8, *K8, *VT8; bf16_t* UT; const float *gq, *gk, *rope;
    __device__ __forceinline__ void operator()(f32x4 (&acc)[2][2][4][2], const g8::Unit& u, int wr, int wc, int fr, int fq) const {
        asm volatile("" : "+v"(fr), "+v"(fq));
        if (u.kind == 1) {
            const int row0 = u.pm * 256 + wr * 64 + fr, col0 = u.pn * 256 + wc * 32 + 8 * fq;
#pragma unroll
            for (int ai = 0; ai < 2; ++ai)
#pragma unroll
                for (int m = 0; m < 4; ++m) { const int ch = row0 + ai * 128 + m * 16;
#pragma unroll
                    for (int bj = 0; bj < 2; ++bj) { const int tok = col0 + bj * 128; const f32x4 v0 = acc[ai][bj][m][0], v1 = acc[ai][bj][m][1];
                        u32x4 w; w.x = cvt_pk_bf16(v0[0], v0[1]); w.y = cvt_pk_bf16(v0[2], v0[3]); w.z = cvt_pk_bf16(v1[0], v1[1]); w.w = cvt_pk_bf16(v1[2], v1[3]);
                        *(u32x4*)(UT + ((size_t)(tok >> 7) * HYC + ch) * 128 + (tok & 127)) = w; } }
            return;
        }
        if (u.kind == 2) {
#pragma unroll
            for (int bj = 0; bj < 2; ++bj) { const int t8 = u.pn * 256 + bj * 128 + wc * 32 + 8 * fq;
                int b, key; if (t8 < MROWS) { b = t8 >> 12; key = CTXL + (t8 & 4095); } else { const int j = t8 - MROWS; b = j >> 8; key = j & 255; }
                const int tile = key >> 6, k = key & 63, ipos = (k < 32) ? 4 * (k >> 3) : 16 + 4 * ((k - 32) >> 3);
#pragma unroll
                for (int ai = 0; ai < 2; ++ai)
#pragma unroll
                    for (int m = 0; m < 4; ++m) { const int ch = u.pm * 256 + ai * 128 + wr * 64 + m * 16 + fr;
                        unsigned char* dst = VT8 + ((((size_t)(b * NHEAD + (ch >> 7)) * 68 + tile) * 128 + (ch & 127)) * 64) + ipos;
                        const f32x4 v0 = acc[ai][bj][m][0], v1 = acc[ai][bj][m][1];
                        *(unsigned*)dst = pk4_fp8(v0[0], v0[1], v0[2], v0[3]); *(unsigned*)(dst + 32) = pk4_fp8(v1[0], v1[1], v1[2], v1[3]); } }
            return;
        }
        const int blk = fq >> 1, f = fq & 1;
        const int sec = u.pn >> 1;
        const bool ctx = (u.pm >= 128);
        if (sec == 0 && ctx) return;
        const int colbase = (u.pn & 1) * 256 + wc * 64 + 32 * blk + 8 * f;
        float gg[2][2][4];
        { const float* gp = (sec == 0 ? gq : gk) + 32 * blk + 8 * f;
#pragma unroll
            for (int bj = 0; bj < 2; ++bj)
#pragma unroll
                for (int n = 0; n < 2; ++n) { const f32x4 t = *(const f32x4*)(gp + 16 * bj + 4 * n); gg[bj][n][0] = t[0]; gg[bj][n][1] = t[1]; gg[bj][n][2] = t[2]; gg[bj][n][3] = t[3]; } }
#pragma unroll
        for (int ai = 0; ai < 2; ++ai)
#pragma unroll
            for (int m = 0; m < 4; ++m) {
                const int rloc = ai * 128 + wr * 64 + m * 16 + fr; const int r = u.pm * 256 + rloc;
                f32x4 v[2][2];
#pragma unroll
                for (int bj = 0; bj < 2; ++bj)
#pragma unroll
                    for (int n = 0; n < 2; ++n) v[bj][n] = acc[ai][bj][m][n];
                size_t orow;
                if (sec == 0) orow = (size_t)r;
                else if (!ctx) orow = (size_t)(r >> 12) * KVL + CTXL + (r & 4095);
                else { const int j = r - MROWS; orow = (size_t)(j >> 8) * KVL + (j & 255); }
                float ss = 0.f;
#pragma unroll
                for (int bj = 0; bj < 2; ++bj)
#pragma unroll
                    for (int n = 0; n < 2; ++n) ss += (v[bj][n][0] * v[bj][n][0] + v[bj][n][1] * v[bj][n][1]) + (v[bj][n][2] * v[bj][n][2] + v[bj][n][3] * v[bj][n][3]);
                ss += __shfl_xor(ss, 16); ss += __shfl_xor(ss, 32);
                const float rstd = rsqrtf(ss * (1.f / 64.f) + EPS) * (sec == 0 ? QSCALE * Q8SCALE : 1.f);
#pragma unroll
                for (int bj = 0; bj < 2; ++bj)
#pragma unroll
                    for (int n = 0; n < 2; ++n)
#pragma unroll
                        for (int e = 0; e < 4; ++e) v[bj][n][e] *= rstd * gg[bj][n][e];
                if (!ctx) {
                    const int t = r & 4095; const int pos = blk ? (t & 63) : (t >> 6);
                    const float* rp = rope + (size_t)(pos * 16 + 8 * f) * 2;
#pragma unroll
                    for (int n = 0; n < 2; ++n) { const f32x4 c0 = *(const f32x4*)(rp + 8 * n), c1 = *(const f32x4*)(rp + 8 * n + 4);
                        const float cs[4] = {c0[0], c0[2], c1[0], c1[2]}, sn[4] = {c0[1], c0[3], c1[1], c1[3]};
#pragma unroll
                        for (int e = 0; e < 4; ++e) { const float x1 = v[0][n][e], x2 = v[1][n][e]; v[0][n][e] = x1 * cs[e] - x2 * sn[e]; v[1][n][e] = x2 * cs[e] + x1 * sn[e]; } }
                }
                unsigned char* dst = (sec == 0 ? Q8 : K8) + orow * QKW + colbase;
#pragma unroll
                for (int bj = 0; bj < 2; ++bj) { u32x2 w; w.x = pk4_fp8(v[bj][0][0], v[bj][0][1], v[bj][0][2], v[bj][0][3]); w.y = pk4_fp8(v[bj][1][0], v[bj][1][1], v[bj][1][2], v[bj][1][3]);
                    *(u32x2*)(dst + 16 * bj) = w; }
            }
    }
};

struct SchedStatic {
    int G, c, nM, nN; const char* A; const char* B;
    __device__ __forceinline__ bool next(int i, g8::Unit& u) const {
        const long L = (long)i * G + c; if (L >= (long)nM * nN) return false;
        g8::tile_of((int)L, nM, nN, u.pm, u.pn); u.a = A + (size_t)u.pm * 256 * DM * 2; u.b = B + (size_t)u.pn * 256 * DM * 2; u.kind = 0; u.ex = 0; return true;
    }
};
struct EpiOutProj {
    const float* x; bf16_t* out; const float* mod;
    __device__ __forceinline__ void operator()(f32x4 (&acc)[2][2][4][2], const g8::Unit& u, int wr, int wc, int fr, int fq) const {
        asm volatile("" : "+v"(fr), "+v"(fq));
        const int col0 = u.pn * 256 + wc * 32 + 8 * fq;
        const float* g1 = mod + (size_t)((u.pm * 256) >> 12) * (NMOD * DM) + 2 * DM + col0;
        f32x4 gv[2][2];
#pragma unroll
        for (int bj = 0; bj < 2; ++bj)
#pragma unroll
            for (int n = 0; n < 2; ++n) gv[bj][n] = *(const f32x4*)(g1 + bj * 128 + 4 * n);
#pragma unroll
        for (int ai = 0; ai < 2; ++ai)
#pragma unroll
            for (int m = 0; m < 4; ++m) { const int r = u.pm * 256 + ai * 128 + wr * 64 + m * 16 + fr;
                const size_t off = (size_t)r * DM + col0;
#pragma unroll
                for (int bj = 0; bj < 2; ++bj) { f32x4 o[2];
#pragma unroll
                    for (int n = 0; n < 2; ++n) { const f32x4 xv = __builtin_nontemporal_load((const f32x4*)(x + off + bj * 128 + 4 * n)); o[n] = xv + gv[bj][n] * acc[ai][bj][m][n]; }
                    u32x4 w; w.x = cvt_pk_bf16(o[0][0], o[0][1]); w.y = cvt_pk_bf16(o[0][2], o[0][3]); w.z = cvt_pk_bf16(o[1][0], o[1][1]); w.w = cvt_pk_bf16(o[1][2], o[1][3]);
                    *(u32x4*)(out + off + bj * 128) = w; } }
    }
};

namespace att8 {
constexpr int NT = KVL / 64, SHMB = 8192, NBUF = 6, LDS_V0 = NBUF * SHMB;
typedef int i32x8 __attribute__((ext_vector_type(8)));
#define SBAR() __builtin_amdgcn_sched_barrier(0)
__device__ __forceinline__ int crow(int r, int hi) { return (r & 3) + 8 * (r >> 2) + 4 * hi; }
__device__ __forceinline__ i32x8 ld32(const LAS unsigned char* p0, const LAS unsigned char* p1) {
    const u32x4 a = *(const LAS u32x4*)p0, b = *(const LAS u32x4*)p1; return (i32x8){(int)a.x, (int)a.y, (int)a.z, (int)a.w, (int)b.x, (int)b.y, (int)b.z, (int)b.w}; }
__device__ __forceinline__ void mfma_qk(f32x16& p, const i32x8& kf, const i32x8& qf, const f32x16& negc) {
    const unsigned s1 = 0x7f7f7f7fu, sq = 0x7b7b7b7bu;
    asm volatile("v_mfma_scale_f32_32x32x64_f8f6f4 %0, %1, %2, %3, %4, %5 op_sel_hi:[0,0,0]" : "=&v"(p) : "v"(kf), "v"(qf), "v"(negc), "v"(s1), "v"(sq));
}
__device__ __forceinline__ void mfma_pv(f32x16& o, const i32x8& pa, const i32x8& vf) {
    const unsigned s1 = 0x7f7f7f7fu;
    asm volatile("v_mfma_scale_f32_32x32x64_f8f6f4 %0, %1, %2, %0, %3, %3 op_sel_hi:[0,0,0]" : "+v"(o) : "v"(pa), "v"(vf), "v"(s1));
}
__device__ __forceinline__ void mfma_wait(f32x16& p0, f32x16& p1) { asm volatile("s_nop 15\n\ts_nop 3" : "+v"(p0), "+v"(p1)); }
__device__ __forceinline__ int grp(const f32x16& s, const int g, int old) {
    old = __builtin_amdgcn_cvt_pk_fp8_f32(__builtin_amdgcn_exp2f(s[4 * g]), __builtin_amdgcn_exp2f(s[4 * g + 1]), old, false);
    return __builtin_amdgcn_cvt_pk_fp8_f32(__builtin_amdgcn_exp2f(s[4 * g + 2]), __builtin_amdgcn_exp2f(s[4 * g + 3]), old, true);
}
__device__ __forceinline__ void attn_unit(const unsigned char* __restrict__ Qb, const unsigned char* __restrict__ Kh, const unsigned char* __restrict__ VTh, bf16_t* MIXo,
                                          const float lam, const float* __restrict__ subg, char* lds, const int wid) {
    const int lane = lane_id(), tid = wid * 64 + lane, r32 = lane & 31, hi = lane >> 5;
    const int sub = wid >> 2, wq = wid & 3;
    const LAS unsigned char* L = (const LAS unsigned char*)(uintptr_t)(unsigned)(uintptr_t)lds;
    f32x16 o[4] = {}; f32x16 ol = {};
    i32x8 ones; { int c1 = 0x38383838; asm volatile("" : "+v"(c1)); ones = (i32x8){c1, c1, c1, c1, c1, c1, c1, c1}; }
    i32x8 qf; { const unsigned char* qp = Qb + (size_t)(wq * 32 + r32) * QKW + sub * 64 + 32 * hi; const u32x4 a = *(const u32x4*)qp, b = *(const u32x4*)(qp + 16);
        qf = (i32x8){(int)a.x, (int)a.y, (int)a.z, (int)a.w, (int)b.x, (int)b.y, (int)b.z, (int)b.w}; }
    f32x16 negc; { float m5 = -5.f; asm volatile("" : "+v"(m5));
#pragma unroll
        for (int r = 0; r < 16; ++r) negc[r] = m5; }
    long ksrc, vsrc;
    { const int r = 8 * wid + (lane >> 3), c = (lane & 7) ^ ((r >> 1) & 7); ksrc = (long)r * QKW + c * 16; }
    { const int d = 16 * wid + (lane >> 2), c = (lane & 3) ^ ((d >> 2) & 3); vsrc = (long)d * 64 + c * 16; }
    const unsigned ldsb = (unsigned)(uintptr_t)lds, kdst = ldsb + (unsigned)wid * 1024u, vdst = ldsb + LDS_V0 + (unsigned)wid * 1024u;
    const LAS unsigned char *pk0, *pk1, *pv0, *pv1;
    { const int c0 = sub * 4 + hi * 2, sk = (r32 >> 1) & 7, sv = (r32 >> 2) & 3;
      pk0 = L + r32 * 128 + ((c0 ^ sk) << 4); pk1 = L + r32 * 128 + (((c0 + 1) ^ sk) << 4);
      pv0 = L + LDS_V0 + r32 * 64 + (((2 * hi) ^ sv) << 4); pv1 = L + LDS_V0 + r32 * 64 + (((2 * hi + 1) ^ sv) << 4); }
#define KF(b, w) ld32(pk0 + (b) * SHMB + (w) * 4096, pk1 + (b) * SHMB + (w) * 4096)
#define VF(b, d0) ld32(pv0 + (b) * SHMB + (d0) * 2048, pv1 + (b) * SHMB + (d0) * 2048)
#define DMA_TILE(t, b) do { \
        __builtin_amdgcn_global_load_lds((const unsigned*)(Kh + (long)(t) * 64 * QKW + ksrc), (LAS unsigned*)(uintptr_t)__builtin_amdgcn_readfirstlane(kdst + (unsigned)((b) * SHMB)), 16, 0, 0); \
        __builtin_amdgcn_global_load_lds((const unsigned*)(VTh + (long)(t) * 8192 + vsrc), (LAS unsigned*)(uintptr_t)__builtin_amdgcn_readfirstlane(vdst + (unsigned)((b) * SHMB)), 16, 0, 0); } while (0)
#define WBAR() do { asm volatile("s_waitcnt vmcnt(0)" ::: "memory"); __builtin_amdgcn_s_barrier(); asm volatile("" ::: "memory"); } while (0)
#define ITER(J, U, SX0, SX1, SY0, SY1, PC, PN, DO_DMA, DO_QK, DO_BAR) do { \
        mfma_pv(ol, PC, ones); SBAR(); \
        if (DO_DMA) { if ((J) + 3 < NT) DMA_TILE((J) + 3, ((U) + 4) % NBUF); if ((J) + 4 < NT) DMA_TILE((J) + 4, ((U) + 5) % NBUF); } \
        PN[0] = grp(SX0, 0, PN[0]); SBAR(); \
        mfma_pv(o[0], PC, vf0); SBAR(); \
        vf3 = VF(U, 3); if (DO_QK) { kf0 = KF(((U) + 2) % NBUF, 0); kf1 = KF(((U) + 2) % NBUF, 1); } \
        PN[1] = grp(SX0, 1, PN[1]); SBAR(); \
        mfma_pv(o[1], PC, vf1); SBAR(); PN[2] = grp(SX0, 2, PN[2]); SBAR(); \
        mfma_pv(o[2], PC, vf2); SBAR(); PN[3] = grp(SX0, 3, PN[3]); SBAR(); \
        mfma_pv(o[3], PC, vf3); SBAR(); PN[4] = grp(SX1, 0, PN[4]); SBAR(); \
        if (DO_QK) mfma_qk(SY0, kf0, qf, negc); SBAR(); PN[5] = grp(SX1, 1, PN[5]); SBAR(); \
        if (DO_QK) mfma_qk(SY1, kf1, qf, negc); SBAR(); PN[6] = grp(SX1, 2, PN[6]); PN[7] = grp(SX1, 3, PN[7]); \
        vf0 = VF(((U) + 1) % NBUF, 0); vf1 = VF(((U) + 1) % NBUF, 1); vf2 = VF(((U) + 1) % NBUF, 2); SBAR(); \
        if (DO_BAR) WBAR(); } while (0)
    f32x16 A0, A1, B0, B1; i32x8 paA = {}, paB = {}, kf0, kf1, vf0, vf1, vf2, vf3;
    DMA_TILE(0, 0); DMA_TILE(1, 1); DMA_TILE(2, 2); DMA_TILE(3, 3); WBAR();
    kf0 = KF(0, 0); kf1 = KF(0, 1); mfma_qk(A0, kf0, qf, negc); mfma_qk(A1, kf1, qf, negc);
    kf0 = KF(1, 0); kf1 = KF(1, 1); SBAR(); mfma_qk(B0, kf0, qf, negc); mfma_qk(B1, kf1, qf, negc);
    mfma_wait(A0, A1);
#pragma unroll
    for (int g = 0; g < 4; ++g) { paA[g] = grp(A0, g, paA[g]); paA[4 + g] = grp(A1, g, paA[4 + g]); }
    mfma_wait(B0, B1);
    vf0 = VF(0, 0); vf1 = VF(0, 1); vf2 = VF(0, 2); SBAR();
    static_assert(NT == 68, "the loop below (11 trips of 6 iterations, then iteration 67) is written for 68 KV tiles");
#pragma unroll 1
    for (int j = 1; j < NT - 2; j += 6) {
        ITER(j, 0, B0, B1, A0, A1, paA, paB, true, true, false);
        ITER(j + 1, 1, A0, A1, B0, B1, paB, paA, false, true, true);
        ITER(j + 2, 2, B0, B1, A0, A1, paA, paB, true, true, false);
        ITER(j + 3, 3, A0, A1, B0, B1, paB, paA, false, true, true);
        ITER(j + 4, 4, B0, B1, A0, A1, paA, paB, true, true, false);
        ITER(j + 5, 5, A0, A1, B0, B1, paB, paA, false, true, true);
    }
    ITER(67, 0, B0, B1, A0, A1, paA, paB, false, false, false);
    mfma_pv(ol, paB, ones); vf3 = VF(1, 3); SBAR();
    mfma_pv(o[0], paB, vf0); mfma_pv(o[1], paB, vf1); mfma_pv(o[2], paB, vf2); mfma_pv(o[3], paB, vf3);
    asm volatile("s_nop 15\n\ts_nop 3" : "+v"(o[0]), "+v"(o[1]), "+v"(o[2]), "+v"(o[3]), "+v"(ol));
#undef ITER
#undef KF
#undef VF
#undef DMA_TILE
#undef WBAR
    __syncthreads();
    float* X = (float*)lds;
    float rli[16];
#pragma unroll
    for (int r = 0; r < 16; ++r) rli[r] = __builtin_amdgcn_rcpf(ol[r]);
    if (sub == 1) {
#pragma unroll
        for (int r = 0; r < 16; ++r) { const int row = wq * 32 + crow(r, hi); const float sc = lam * rli[r];
#pragma unroll
            for (int d0 = 0; d0 < 4; ++d0) X[row * 128 + d0 * 32 + r32] = o[d0][r] * sc; }
    }
    __syncthreads();
    bf16_t* Y = (bf16_t*)(lds + 65536);
    if (sub == 0) {
        float sg[4];
#pragma unroll
        for (int d0 = 0; d0 < 4; ++d0) sg[d0] = subg[d0 * 32 + r32] * (1.f - LAM_INIT);
#pragma unroll
        for (int r = 0; r < 16; ++r) { const int row = wq * 32 + crow(r, hi);
            float v[4]; float ss = 0.f;
#pragma unroll
            for (int d0 = 0; d0 < 4; ++d0) { v[d0] = o[d0][r] * rli[r] - X[row * 128 + d0 * 32 + r32]; ss += v[d0] * v[d0]; }
            ss += __shfl_xor(ss, 1); ss += __shfl_xor(ss, 2); ss += __shfl_xor(ss, 4); ss += __shfl_xor(ss, 8); ss += __shfl_xor(ss, 16);
            const float rstd = rsqrtf(ss * (1.f / 128.f) + EPS);
#pragma unroll
            for (int d0 = 0; d0 < 4; ++d0) Y[row * 128 + d0 * 32 + r32] = (bf16_t)(cvt_pk_bf16(v[d0] * rstd * sg[d0], 0.f) & 0xffffu); }
    }
    __syncthreads();
    { const int row = tid >> 2, seg = (tid & 3) * 32;
#pragma unroll
        for (int i = 0; i < 4; ++i) { const u32x4 v = *(const u32x4*)(Y + row * 128 + seg + i * 8); *(u32x4*)(MIXo + (size_t)row * DM + seg + i * 8) = v; } }
    __syncthreads();
}
#undef SBAR
}

__device__ __forceinline__ void p3_attention8(Frame& F) {
    FT_DECL;
    const float* sc = WSP(float, WS_SMALL + SM_SCAL);
    const float lam = sc[0];
    const unsigned char* Q8 = WSP(unsigned char, WS_Q); const unsigned char* K8 = WSP(unsigned char, WS_K); const unsigned char* VT8 = WSP(unsigned char, WS_V); bf16_t* MIX = WSP(bf16_t, WS_MIX);
    const int c = blockIdx.x, xcd = c & 7, ci = c >> 3, per = F.G >> 3;
    for (int j = ci; j < 128; j += per) {
        const int pair = xcd * 4 + (j >> 5), qb = j & 31, b = pair >> 2, h = pair & 3;
        att8::attn_unit(Q8 + ((size_t)b * SEQ + qb * 128) * QKW + h * 128, K8 + (size_t)b * KVL * QKW + h * 128, VT8 + (size_t)(b * NHEAD + h) * 68 * 8192,
                        MIX + ((size_t)b * SEQ + qb * 128) * DM + h * 128, lam, F.in[15], (char*)F.lds, F.wave);
    }
}

namespace hy {
constexpr int RB_BYTES = 4352 * 8, IN_OFF = 2 * RB_BYTES, TW1_OFF = IN_OFF + 32768, TW2_OFF = TW1_OFF + 15 * 256 * 8, LDS_END = TW2_OFF + 15 * 16 * 8;
__device__ __forceinline__ f32x2 cmul(f32x2 a, f32x2 b) { return (f32x2){a.x * b.x - a.y * b.y, a.x * b.y + a.y * b.x}; }
__device__ __forceinline__ f32x2 cmulc(f32x2 a, f32x2 b) { return (f32x2){a.x * b.x + a.y * b.y, a.y * b.x - a.x * b.y}; }
__device__ __forceinline__ int P(int i) { return i + (i >> 4); }
template <bool INV> __device__ __forceinline__ void r4(f32x2& a, f32x2& b, f32x2& c, f32x2& d) {
    const f32x2 t0 = a + c, t1 = a - c, t2 = b + d, t3 = b - d;
    const f32x2 st3 = INV ? (f32x2){-t3.y, t3.x} : (f32x2){t3.y, -t3.x};
    a = t0 + t2; c = t0 - t2; b = t1 + st3; d = t1 - st3;
}
template <bool INV> __device__ __forceinline__ f32x2 tw(f32x2 v, float c, float s) {
    return INV ? (f32x2){v.x * c - v.y * s, v.y * c + v.x * s} : (f32x2){v.x * c + v.y * s, v.y * c - v.x * s};
}
template <bool INV> __device__ __forceinline__ void dft16(f32x2 (&v)[16]) {
    constexpr float C1 = 0.9238795325112867f, S1 = 0.3826834323650898f, R2 = 0.7071067811865476f;
    r4<INV>(v[0], v[4], v[8], v[12]); r4<INV>(v[1], v[5], v[9], v[13]); r4<INV>(v[2], v[6], v[10], v[14]); r4<INV>(v[3], v[7], v[11], v[15]);
    v[5] = tw<INV>(v[5], C1, S1);  v[9] = tw<INV>(v[9], R2, R2);    v[13] = tw<INV>(v[13], S1, C1);
    v[6] = tw<INV>(v[6], R2, R2);  v[10] = tw<INV>(v[10], 0.f, 1.f); v[14] = tw<INV>(v[14], -R2, R2);
    v[7] = tw<INV>(v[7], S1, C1);  v[11] = tw<INV>(v[11], -R2, R2);  v[15] = tw<INV>(v[15], -C1, -S1);
    r4<INV>(v[0], v[1], v[2], v[3]); r4<INV>(v[4], v[5], v[6], v[7]); r4<INV>(v[8], v[9], v[10], v[11]); r4<INV>(v[12], v[13], v[14], v[15]);
    f32x2 t;
    t = v[1]; v[1] = v[4]; v[4] = t;   t = v[2]; v[2] = v[8]; v[8] = t;    t = v[3]; v[3] = v[12]; v[12] = t;
    t = v[6]; v[6] = v[9]; v[9] = t;   t = v[7]; v[7] = v[13]; v[13] = t;  t = v[11]; v[11] = v[14]; v[14] = t;
}
struct Ctx { LAS f32x2* R; LAS f32x2* IN; LAS f32x2* TW1; LAS f32x2* TW2; int t, half; f32x2 wt; };
#define HY_OPAQUE(x) asm volatile("" : "+v"(x))
#define HY_W32(m) (f32x2){__builtin_cosf(-0.19634954084936207f * (m)), __builtin_sinf(-0.19634954084936207f * (m))}
template <int MODE> __device__ __forceinline__ void pass1_fwd(const Ctx& X) {
    f32x2 v[16]; int t = X.t; HY_OPAQUE(t);
#pragma unroll
    for (int m = 0; m < 16; ++m) { f32x2 a = X.IN[t + 256 * m]; if (MODE == 1) a = (f32x2){X.half ? a.y : a.x, 0.f}; v[m] = a; }
    if (X.half) {
#pragma unroll
        for (int m = 0; m < 16; ++m) v[m] = cmul(cmul(v[m], HY_W32(m)), X.wt);
    }
    dft16<false>(v);
#pragma unroll
    for (int q = 1; q < 16; ++q) v[q] = cmul(v[q], X.TW1[(q - 1) * 256 + t]);
    const int pb = t + (t >> 4);
#pragma unroll
    for (int q = 0; q < 16; ++q) X.R[pb + 272 * q] = v[q];
}
__device__ __forceinline__ void pass2_fwd(const Ctx& X) {
    int t = X.t; HY_OPAQUE(t);
    const int n2 = t & 15, pb = (t >> 4) * 272 + n2; f32x2 v[16];
#pragma unroll
    for (int m = 0; m < 16; ++m) v[m] = X.R[pb + 17 * m];
    dft16<false>(v);
#pragma unroll
    for (int q = 1; q < 16; ++q) v[q] = cmul(v[q], X.TW2[(q - 1) * 16 + n2]);
#pragma unroll
    for (int q = 0; q < 16; ++q) X.R[pb + 17 * q] = v[q];
}
template <bool FILTER> __device__ __forceinline__ void pass3(const Ctx& X, f32x2 (&H)[16]) {
    f32x2 v[16]; int t = X.t; HY_OPAQUE(t); const int pb = 17 * t;
#pragma unroll
    for (int m = 0; m < 16; ++m) v[m] = X.R[pb + m];
    dft16<false>(v);
    if (FILTER) {
#pragma unroll
        for (int q = 0; q < 16; ++q) H[q] = v[q] * (1.f / 8192.f);
    } else {
#pragma unroll
        for (int q = 0; q < 16; ++q) v[q] = cmul(v[q], H[q]);
        dft16<true>(v);
#pragma unroll
        for (int m = 0; m < 16; ++m) X.R[pb + m] = v[m];
    }
}
__device__ __forceinline__ void pass2_inv(const Ctx& X) {
    int t = X.t; HY_OPAQUE(t);
    const int n2 = t & 15, pb = (t >> 4) * 272 + n2; f32x2 v[16];
    v[0] = X.R[pb];
#pragma unroll
    for (int q = 1; q < 16; ++q) v[q] = cmulc(X.R[pb + 17 * q], X.TW2[(q - 1) * 16 + n2]);
    dft16<true>(v);
#pragma unroll
    for (int m = 0; m < 16; ++m) X.R[pb + 17 * m] = v[m];
}
__device__ __forceinline__ void pass1_inv(const Ctx& X) {
    f32x2 v[16]; int t = X.t; HY_OPAQUE(t); const int pb = t + (t >> 4);
    v[0] = X.R[pb];
#pragma unroll
    for (int q = 1; q < 16; ++q) v[q] = cmulc(X.R[pb + 272 * q], X.TW1[(q - 1) * 256 + t]);
    dft16<true>(v);
    if (X.half) {
#pragma unroll
        for (int m = 0; m < 16; ++m) v[m] = cmulc(cmulc(v[m], HY_W32(m)), X.wt);
    }
#pragma unroll
    for (int m = 0; m < 16; ++m) X.R[pb + 272 * m] = v[m];
}
#define HY_WSYNC() asm volatile("s_waitcnt lgkmcnt(0)" ::: "memory")
__device__ __forceinline__ void conv_fft(const Ctx& X, f32x2 (&H)[16]) {
    __syncthreads(); pass1_fwd<0>(X); __syncthreads(); pass2_fwd(X); HY_WSYNC(); pass3<false>(X, H); HY_WSYNC(); pass2_inv(X); __syncthreads(); pass1_inv(X); __syncthreads();
}
constexpr int STG_OFF = LDS_END;
constexpr int LDS_END2 = STG_OFF + 2 * SEQ * 2;
static_assert(LDS_END2 <= LDSCTL_OFF, "hyena LDS map");
__device__ __forceinline__ float sconv_lds(const LAS bf16_t* stg, int bs, int n, float w0, float w1, float w2, float bias) {
    const LAS bf16_t* p = stg + bs * SEQ;
    const float c = bf2f(p[n]), lv = bf2f(p[n - ((n > 0) ? 1 : 0)]), rv = bf2f(p[n + ((n < SEQ - 1) ? 1 : 0)]);
    const float l = (n > 0) ? lv : 0.f, r = (n < SEQ - 1) ? rv : 0.f;
    return bias + w0 * l + w1 * c + w2 * r;
}
__device__ __forceinline__ void setup_tables(LAS unsigned char* lds, int tid) {
    LAS f32x2* TW1 = (LAS f32x2*)(lds + TW1_OFF); LAS f32x2* TW2 = (LAS f32x2*)(lds + TW2_OFF);
    for (int i = tid; i < 15 * 256; i += 512) { const int q = i / 256 + 1, t = i & 255; float s, c; sincosf(-6.283185307179586f * (float)((t * q) & 4095) * (1.f / 4096.f), &s, &c); TW1[i] = (f32x2){c, s}; }
    for (int i = tid; i < 15 * 16; i += 512) { const int q = i / 16 + 1, n2 = i & 15; float s, c; sincosf(-6.283185307179586f * (float)((n2 * q) & 255) * (1.f / 256.f), &s, &c); TW2[i] = (f32x2){c, s}; }
}
__device__ __forceinline__ void unit(Frame& F, int c) {
    FT_DECL;
    const int tid = f_tid; Ctx X; X.half = F.wave >> 2; X.t = tid & 255;
    X.R = (LAS f32x2*)(F.lds + X.half * RB_BYTES); X.IN = (LAS f32x2*)(F.lds + IN_OFF); X.TW1 = (LAS f32x2*)(F.lds + TW1_OFF); X.TW2 = (LAS f32x2*)(F.lds + TW2_OFF);
    { float s, cc; sincosf(-6.283185307179586f * (float)X.t * (1.f / 8192.f), &s, &cc); X.wt = (f32x2){cc, s}; }
    LAS f32x2* RB0 = (LAS f32x2*)(F.lds); LAS f32x2* RB1 = (LAS f32x2*)(F.lds + RB_BYTES);
    const float* FILT = WSP(float, WS_FILT);
    f32x2 H0[16], H1[16];
#pragma unroll
    for (int ord = 0; ord < 2; ++ord) {
        const float* hf = FILT + ((size_t)(ord * 2 + 0) * 512 + c) * SEQ; const float* hb = FILT + ((size_t)(ord * 2 + 1) * 512 + c) * SEQ;
        __syncthreads();
        int nb = tid; HY_OPAQUE(nb);
#pragma unroll
        for (int j = 0; j < 8; ++j) { const int n = nb + 512 * j; const float a = hf[n], b = hb[(SEQ - n) & (SEQ - 1)]; const float lo = (n == 0) ? a + b : a, hi = (n == 0) ? 0.f : b; X.IN[n] = (f32x2){lo + hi, lo - hi}; }
        __syncthreads(); pass1_fwd<1>(X); __syncthreads(); pass2_fwd(X); HY_WSYNC();
        if (ord == 0) pass3<true>(X, H0); else pass3<true>(X, H1);
    }
    const bf16_t* UT = WSP(bf16_t, WS_UT);
    const bf16_t* rv = UT + (size_t)c * 128; const bf16_t* r1 = UT + (size_t)(512 + c) * 128; const bf16_t* r2 = UT + (size_t)(1024 + c) * 128;
#define HY_LD(rowp, t) (*(const u32x4*)((rowp) + (size_t)((t) >> 7) * (HYC * 128) + ((t) & 127)))
    const float* cw = F.in[16]; const float* cb = F.in[17];
    const float wv0 = cw[c], wv1 = cw[HYC + c], wv2 = cw[2 * HYC + c], bv = cb[c];
    const float wa0 = cw[512 + c], wa1 = cw[HYC + 512 + c], wa2 = cw[2 * HYC + 512 + c], ba = cb[512 + c];
    const float wb0 = cw[1024 + c], wb1 = cw[HYC + 1024 + c], wb2 = cw[2 * HYC + 1024 + c], bb = cb[1024 + c];
    const float sk0 = F.in[25][c], sk1 = F.in[25][512 + c];
    bf16_t* Z = WSP(bf16_t, WS_Z2T) + (size_t)c * 128;
    LAS bf16_t* STG = (LAS bf16_t*)(F.lds + STG_OFF);
    u32x4 g0 = HY_LD(rv, tid * 8), g1 = HY_LD(rv, SEQ + tid * 8);
    for (int pr = 0; pr < 4; ++pr) {
        const int b0 = 2 * pr, b1 = b0 + 1;
        f32x2 z[8]; int pc = tid + (tid >> 4); HY_OPAQUE(pc); int nb = tid; HY_OPAQUE(nb);
        __syncthreads();
        *(LAS u32x4*)(STG + tid * 8) = g0; *(LAS u32x4*)(STG + SEQ + tid * 8) = g1;
        __syncthreads();
#pragma unroll
        for (int j = 0; j < 8; ++j) { const int n = nb + 512 * j; z[j] = (f32x2){sconv_lds(STG, 0, n, wv0, wv1, wv2, bv), sconv_lds(STG, 1, n, wv0, wv1, wv2, bv)}; X.IN[n] = z[j]; }
        g0 = HY_LD(r1, b0 * SEQ + tid * 8); g1 = HY_LD(r1, b1 * SEQ + tid * 8);
        conv_fft(X, H0);
        *(LAS u32x4*)(STG + tid * 8) = g0; *(LAS u32x4*)(STG + SEQ + tid * 8) = g1;
        __syncthreads();
        HY_OPAQUE(nb); HY_OPAQUE(pc);
#pragma unroll
        for (int j = 0; j < 8; ++j) { const int n = nb + 512 * j; const f32x2 y = RB0[pc + 544 * j] + RB1[pc + 544 * j];
            const f32x2 g = (f32x2){sconv_lds(STG, 0, n, wa0, wa1, wa2, ba), sconv_lds(STG, 1, n, wa0, wa1, wa2, ba)};
            z[j] = g * (y + sk0 * z[j]); X.IN[n] = z[j]; }
        g0 = HY_LD(r2, b0 * SEQ + tid * 8); g1 = HY_LD(r2, b1 * SEQ + tid * 8);
        conv_fft(X, H1);
        *(LAS u32x4*)(STG + tid * 8) = g0; *(LAS u32x4*)(STG + SEQ + tid * 8) = g1;
        __syncthreads();
        if (pr < 3) { g0 = HY_LD(rv, (b0 + 2) * SEQ + tid * 8); g1 = HY_LD(rv, (b1 + 2) * SEQ + tid * 8); }
        HY_OPAQUE(nb); HY_OPAQUE(pc);
        f32x2 o[8];
#pragma unroll
        for (int j = 0; j < 8; ++j) { const int n = nb + 512 * j; const f32x2 y = RB0[pc + 544 * j] + RB1[pc + 544 * j];
            const f32x2 g = (f32x2){sconv_lds(STG, 0, n, wb0, wb1, wb2, bb), sconv_lds(STG, 1, n, wb0, wb1, wb2, bb)};
            o[j] = g * (y + sk1 * z[j]); }
        __syncthreads();
#pragma unroll
        for (int j = 0; j < 8; ++j) { const int n = nb + 512 * j; STG[n] = (bf16_t)(cvt_pk_bf16(o[j].x, 0.f) & 0xffffu); STG[SEQ + n] = (bf16_t)(cvt_pk_bf16(o[j].y, 0.f) & 0xffffu); }
        __syncthreads();
        { const int t0 = b0 * SEQ + tid * 8, t1 = b1 * SEQ + tid * 8;
          *(u32x4*)(Z + (size_t)(t0 >> 7) * (HYW * 128) + (t0 & 127)) = *(const LAS u32x4*)(STG + tid * 8); *(u32x4*)(Z + (size_t)(t1 >> 7) * (HYW * 128) + (t1 & 127)) = *(const LAS u32x4*)(STG + SEQ + tid * 8); }
    }
    __syncthreads();
}
}

__device__ __forceinline__ void p3_hyena(Frame& F) {
    FT_DECL;
    __syncthreads();
    hy::setup_tables(F.lds, f_tid);
    __syncthreads();
    for (int c = F.vcu; c < HYW; c += F.G) hy::unit(F, c);
}

__device__ __forceinline__ void p4_hynorm(Frame& F) {
    FT_DECL;
    const bf16_t* Z = WSP(bf16_t, WS_Z2T); bf16_t* MIX = WSP(bf16_t, WS_MIX); const float* g = F.in[26];
    constexpr int TP = 132;
    LAS bf16_t* T = (LAS bf16_t*)F.lds;
    LAS float* red = (LAS float*)(F.lds + 512 * TP * 2);
    LAS float* rs = red + 512;
    float gl[8];
#pragma unroll
    for (int e = 0; e < 8; ++e) gl[e] = g[(f_tid & 63) + 64 * e];
    for (int it = F.vcu; it < MROWS / 128; it += F.G) {
        const int tok0 = it * 128; const bf16_t* zt = Z + (size_t)it * (HYW * 128);
        __syncthreads();
        u32x4 v[16];
#pragma unroll
        for (int j = 0; j < 16; ++j) v[j] = __builtin_nontemporal_load((const u32x4*)(zt + (size_t)(f_tid + 512 * j) * 8));
#pragma unroll
        for (int j = 0; j < 16; ++j) { const int i = f_tid + 512 * j; LAS u32x2* d = (LAS u32x2*)(T + (i >> 4) * TP + (i & 15) * 8); d[0] = (u32x2){v[j].x, v[j].y}; d[1] = (u32x2){v[j].z, v[j].w}; }
        __syncthreads();
        { const int tok = f_tid & 127, grp = f_tid >> 7; float ss = 0.f;
#pragma unroll 8
            for (int k = 0; k < 128; ++k) { const float x = bf2f(T[(grp * 128 + k) * TP + tok]); ss += x * x; }
            red[grp * 128 + tok] = ss; }
        __syncthreads();
        if (f_tid < 128) rs[f_tid] = rsqrtf(((red[f_tid] + red[128 + f_tid]) + (red[256 + f_tid] + red[384 + f_tid])) * (1.f / HYW) + EPS);
        __syncthreads();
#pragma unroll
        for (int j = 0; j < 16; ++j) { const int i = f_tid + 512 * j, tok = i >> 6, l = i & 63; const float r = rs[tok];
            float x[8];
#pragma unroll
            for (int e = 0; e < 8; ++e) x[e] = bf2f(T[(l + 64 * e) * TP + tok]) * r * gl[e];
            u32x4 w; w.x = cvt_pk_bf16(x[0], x[1]); w.y = cvt_pk_bf16(x[2], x[3]); w.z = cvt_pk_bf16(x[4], x[5]); w.w = cvt_pk_bf16(x[6], x[7]);
            *(u32x4*)(MIX + (size_t)(tok0 + tok) * DM + 512 + 8 * l) = w; }
    }
}

constexpr size_t WS_LIST2 = WS_FILT;
constexpr size_t WS_GSLOT2 = WS_FILT + 4 * MiB;
constexpr int CW_ECNT = 256;
constexpr int MAXSLOT = MROWS * TOPK + NEXP * 256;
constexpr int MAXTILE = MAXSLOT / 256;
constexpr size_t WS_XS = WS_EO;
constexpr int RW_PITCH = 32;
constexpr int P6_LDS_TOPI = 1024 * RW_PITCH * 4;

__device__ __forceinline__ void p6_router_mfma(Frame& F) {
    FT_DECL;
#define in F.in
    LAS float* WP = (LAS float*)F.lds;
    LAS int* TI = (LAS int*)(F.lds + P6_LDS_TOPI);
    LAS int* PS = TI + 512;
    LAS int* SC = PS + 512;
    LAS float* RSTD = (LAS float*)(SC + 512);
    LAS float* BIAS = RSTD + 128;
    LAS float* SSX = BIAS + 32;
    const float* rw = in[28]; const float* mod = WSP(float, WS_SMALL + SM_MOD); const float* g2n = in[7]; const float* rb = in[29];
    const bf16_t* XN = WSP(bf16_t, WS_XN); unsigned char* H2 = WSP(unsigned char, WS_H);
    int* list2 = WSP(int, WS_LIST2); float* gslot2 = WSP(float, WS_GSLOT2); int* ecnt = (int*)(F.ctl + CW_ECNT);
    LAS float* GT = SSX + 256;
    LAS int* EB = (LAS int*)(GT + 512);
    for (int blk = blockIdx.x; blk < MROWS / 128; blk += F.G) {
        const float* sh2 = mod + (size_t)(blk >> 5) * (NMOD * DM) + 3 * DM; const float* sc2 = sh2 + DM;
        __syncthreads();
#pragma unroll 1
        for (int hb = 0; hb < 2; ++hb) { f32x4 wv[8]; float gm[8];
#pragma unroll
            for (int q = 0; q < 8; ++q) { const int i = f_tid + 512 * (8 * hb + q), k = i >> 3, c4 = i & 7; wv[q] = *(const f32x4*)(rw + (size_t)k * 32 + c4 * 4); gm[q] = g2n[k] * (1.f + sc2[k]); }
#pragma unroll
            for (int q = 0; q < 8; ++q) { const int i = f_tid + 512 * (8 * hb + q), k = i >> 3, c4 = i & 7; *(LAS f32x4*)(WP + k * 32 + c4 * 4) = wv[q] * gm[q]; } }
        { const int e = f_tid & 31, part = f_tid >> 5; float a = 0.f;
#pragma unroll 1
            for (int k0 = part * 64; k0 < part * 64 + 64; k0 += 8) { float w[8], sh[8];
#pragma unroll
                for (int q = 0; q < 8; ++q) { w[q] = rw[(size_t)(k0 + q) * 32 + e]; sh[q] = sh2[k0 + q]; }
#pragma unroll
                for (int q = 0; q < 8; ++q) a += sh[q] * w[q]; }
            ((LAS float*)SC)[part * 32 + e] = a; }
        __syncthreads();
        if (f_tid < 32) { float a = rb[f_tid];
#pragma unroll
            for (int p = 0; p < 16; ++p) a += ((LAS float*)SC)[p * 32 + f_tid];
            BIAS[f_tid] = a; }
        const int rg = F.wave & 3, kh = F.wave >> 2, j = f_lane & 31, hi = f_lane >> 5;
        f32x16 acc = {};
        float ss = 0.f;
        { const bf16_t* xrow = XN + (size_t)(blk * 128 + rg * 32 + j) * DM + 512 * kh + 8 * hi;
            const LAS float* wp = WP + (512 * kh + 8 * hi) * 32 + j;
#pragma unroll 8
            for (int c = 0; c < 32; ++c) { const u32x4 xb = *(const u32x4*)(xrow + 16 * c);
                float xf[8] = {__uint_as_float(xb.x << 16), __uint_as_float(xb.x & 0xffff0000u), __uint_as_float(xb.y << 16), __uint_as_float(xb.y & 0xffff0000u),
                               __uint_as_float(xb.z << 16), __uint_as_float(xb.z & 0xffff0000u), __uint_as_float(xb.w << 16), __uint_as_float(xb.w & 0xffff0000u)};
#pragma unroll
                for (int q = 0; q < 8; ++q) { ss += xf[q] * xf[q]; acc = __builtin_amdgcn_mfma_f32_32x32x2f32(wp[(16 * c + q) * 32], xf[q], acc, 0, 0, 0); } } }
        { auto rr = __builtin_amdgcn_permlane32_swap(__float_as_uint(ss), __float_as_uint(ss), false, false); ss = __uint_as_float(rr[0]) + __uint_as_float(rr[1]); }
        if (hi == 0) SSX[kh * 128 + rg * 32 + j] = ss;
        __syncthreads();
        if (kh == 1) {
#pragma unroll
            for (int r = 0; r < 16; ++r) WP[(rg * 16 + r) * 64 + f_lane] = acc[r]; }
        if (f_tid < 128) RSTD[f_tid] = rsqrtf((SSX[f_tid] + SSX[128 + f_tid]) * (1.f / DM) + EPS);
        __syncthreads();
        if (kh == 0) {
            const float rstd = RSTD[rg * 32 + j];
            float tv[4] = {-INFINITY, -INFINITY, -INFINITY, -INFINITY}; int ti[4] = {1 << 20, 1 << 20, 1 << 20, 1 << 20};
#define P6_INS(V, E) do { float cv = (V); int ce = (E); _Pragma("unroll") for (int q = 0; q < 4; ++q) { const bool b = cv > tv[q] || (cv == tv[q] && ce < ti[q]); \
                const float nv = b ? tv[q] : cv; const int ne = b ? ti[q] : ce; tv[q] = b ? cv : tv[q]; ti[q] = b ? ce : ti[q]; cv = nv; ce = ne; } } while (0)
#pragma unroll
            for (int r = 0; r < 16; ++r) { const int e = (r & 3) + 8 * (r >> 2) + 4 * hi; const float v = (acc[r] + WP[(rg * 16 + r) * 64 + f_lane]) * rstd + BIAS[e]; P6_INS(v, e); }
            float ov[4]; int oe[4];
#pragma unroll
            for (int q = 0; q < 4; ++q) { ov[q] = __shfl_xor(tv[q], 32); oe[q] = __shfl_xor(ti[q], 32); }
#pragma unroll
            for (int q = 0; q < 4; ++q) P6_INS(ov[q], oe[q]);
#undef P6_INS
            if (hi == 0) { const int rl = rg * 32 + j;
                const float e1 = __expf(tv[1] - tv[0]), e2 = __expf(tv[2] - tv[0]), e3 = __expf(tv[3] - tv[0]); const float inv = 1.f / (1.f + e1 + e2 + e3);
                typedef int i32x4_t __attribute__((ext_vector_type(4))); const i32x4_t t4 = {ti[0], ti[1], ti[2], ti[3]};
                *(LAS f32x4*)(GT + rl * 4) = (f32x4){inv, e1 * inv, e2 * inv, e3 * inv};
                *(LAS i32x4_t*)(TI + rl * 4) = t4; }
        }
        __syncthreads();
        { const int t2 = F.wave * 64 + lane_id(); const int e = t2 & 31, seg = t2 >> 5; int cnt = 0;
#pragma unroll 4
            for (int i = 0; i < 32; ++i) cnt += (TI[seg * 32 + i] == e) ? 1 : 0;
            SC[seg * 32 + e] = cnt;
            __syncthreads();
            int pre = 0;
            for (int s2 = 0; s2 < seg; ++s2) pre += SC[s2 * 32 + e];
            if (seg == 15) EB[e] = __hip_atomic_fetch_add(ecnt + e, pre + cnt, __ATOMIC_RELAXED, __HIP_MEMORY_SCOPE_AGENT);
            for (int i = 0; i < 32; ++i) if (TI[seg * 32 + i] == e) { PS[seg * 32 + i] = pre; ++pre; }
        }
        __syncthreads();
        { const int t3 = F.wave * 64 + lane_id(); const int e = TI[t3]; const size_t sl = (size_t)e * MROWS + EB[e] + PS[t3];
            list2[sl] = (blk * 128 + (t3 >> 2)) * 4 + (t3 & 3); gslot2[sl] = GT[t3]; }
        { const int lane = lane_id();
            f32x4 PA[4], PB[4];
#pragma unroll
            for (int jj = 0; jj < 4; ++jj) { const int c = 4 * lane + 256 * jj; PA[jj] = *(const f32x4*)(g2n + c) * (*(const f32x4*)(sc2 + c) + 1.f); PB[jj] = *(const f32x4*)(sh2 + c); }
            for (int it = 0; it < 4; ++it) { u32x2 xb[4][4];
#pragma unroll
                for (int u = 0; u < 4; ++u) { const GAS u32x2* xr = (const GAS u32x2*)(XN + (size_t)(blk * 128 + F.wave * 16 + 4 * it + u) * DM) + lane;
#pragma unroll
                    for (int jj = 0; jj < 4; ++jj) xb[u][jj] = xr[64 * jj]; }
#pragma unroll
                for (int u = 0; u < 4; ++u) { const int rl = F.wave * 16 + 4 * it + u; const float rstd = RSTD[rl];
                    GAS unsigned* o4 = (GAS unsigned*)(H2 + (size_t)(blk * 128 + rl) * DM) + lane;
#pragma unroll
                    for (int jj = 0; jj < 4; ++jj) {
                        const f32x4 x = (f32x4){__uint_as_float(xb[u][jj].x << 16), __uint_as_float(xb[u][jj].x & 0xffff0000u), __uint_as_float(xb[u][jj].y << 16), __uint_as_float(xb[u][jj].y & 0xffff0000u)};
                        const f32x4 h = x * rstd * PA[jj] + PB[jj];
                        o4[64 * jj] = pk4_fp8(h.x, h.y, h.z, h.w); } } }
        }
    }
#undef in
}

template <int NPN> struct SchedMoE {
    int G, c, nT; const char* A; const char* W; size_t wstride; const LAS unsigned char* tileE; const LAS int* RW; bool gath;
    __device__ __forceinline__ long lidx(int T, int e, int i) const { const LAS int* TB = (const LAS int*)(tileE + 544); const int r = (T - TB[e]) * 256 + i; return (r < TB[32 + e]) ? (long)e * MROWS + r : -1L; }
    __device__ __forceinline__ const LAS int* rows(int i) const { return RW + i * 256; }
    __device__ __forceinline__ bool next(int i, g8::Unit& u) const {
        const int L = i * G + c, xcd = L & 7, j = L >> 3, nTx = (nT + 7) >> 3, tl = j / NPN, T = xcd * nTx + tl, pn = j % NPN;
        if (tl >= nTx || T >= nT) return false;
        const int e = tileE[T];
        u.pm = T; u.pn = pn; u.kind = i; u.ex = e; u.a = gath ? A : A + (size_t)T * 256 * DM; u.b = W + (size_t)e * wstride + (size_t)pn * 256 * DM; return true;
    }
};
struct EpiSwiGLU {
    unsigned char* ACT; const float* b1;
    __device__ __forceinline__ void operator()(f32x4 (&acc)[2][2][4][2], const g8::Unit& u, int wr, int wc, int fr, int fq) const {
        asm volatile("" : "+v"(fr), "+v"(fq));
        const int j0 = u.pn * 128 + wc * 32 + 8 * fq; const float* bp = b1 + (size_t)u.ex * 2 * DM + j0;
        f32x4 bg[2], bl[2];
#pragma unroll
        for (int n = 0; n < 2; ++n) { bg[n] = *(const f32x4*)(bp + 4 * n); bl[n] = *(const f32x4*)(bp + DM + 4 * n); }
#pragma unroll
        for (int ai = 0; ai < 2; ++ai)
#pragma unroll
            for (int m = 0; m < 4; ++m) { const size_t slot = (size_t)u.pm * 256 + ai * 128 + wr * 64 + m * 16 + fr; float o[8];
#pragma unroll
                for (int n = 0; n < 2; ++n) { const f32x4 g4 = acc[ai][0][m][n] * (1.f / WSCALE) + bg[n], l4 = acc[ai][1][m][n] * (1.f / WSCALE) + bl[n];
#pragma unroll
                    for (int e = 0; e < 4; ++e) { const float g = fminf(g4[e], 7.f), l = __builtin_amdgcn_fmed3f(l4[e], -7.f, 7.f);
                        const float ex = __builtin_amdgcn_exp2f(g * (-1.702f * 1.4426950408889634f)); const float glu = g * __builtin_amdgcn_rcpf(1.f + ex);
                        o[4 * n + e] = fmaf(l, glu, glu); } }
                u32x2 w; w.x = pk4_fp8(o[0], o[1], o[2], o[3]); w.y = pk4_fp8(o[4], o[5], o[6], o[7]);
                *(u32x2*)(ACT + slot * DM + j0) = w; }
    }
};
struct EpiDown {
    unsigned char* EO; const float* b2; const LAS int* LL; int G, c;
    __device__ __forceinline__ void operator()(f32x4 (&acc)[2][2][4][2], const g8::Unit& u, int wr, int wc, int fr, int fq) const {
        asm volatile("" : "+v"(fr), "+v"(fq));
        const int c0 = u.pn * 256 + wc * 64 + 16 * fq; const float* bp = b2 + (size_t)u.ex * DM + c0;
        f32x4 bb[2][2];
#pragma unroll
        for (int bj = 0; bj < 2; ++bj)
#pragma unroll
            for (int n = 0; n < 2; ++n) bb[bj][n] = *(const f32x4*)(bp + bj * 8 + 4 * n);
        const LAS int* L = LL + u.kind * 512;
        int li[8]; float gt[8];
#pragma unroll
        for (int q = 0; q < 8; ++q) { const int rl = (q >> 2) * 128 + wr * 64 + (q & 3) * 16 + fr; li[q] = L[rl]; gt[q] = __int_as_float(L[256 + rl]) * (1.f / WSCALE); }
#pragma unroll
        for (int ai = 0; ai < 2; ++ai)
#pragma unroll
            for (int m = 0; m < 4; ++m) { const int l = li[ai * 4 + m]; const float g = gt[ai * 4 + m];
                unsigned char* dst = EO + ((size_t)(l & 3) * MROWS + (l >> 2)) * DM + c0;
                u32x4 w;
                { const f32x4 v0 = acc[ai][0][m][0] * g + bb[0][0] * (g * WSCALE), v1 = acc[ai][0][m][1] * g + bb[0][1] * (g * WSCALE);
                  w.x = pk4_fp8(v0[0] * EOSCALE, v0[1] * EOSCALE, v0[2] * EOSCALE, v0[3] * EOSCALE); w.y = pk4_fp8(v1[0] * EOSCALE, v1[1] * EOSCALE, v1[2] * EOSCALE, v1[3] * EOSCALE); }
                { const f32x4 v0 = acc[ai][1][m][0] * g + bb[1][0] * (g * WSCALE), v1 = acc[ai][1][m][1] * g + bb[1][1] * (g * WSCALE);
                  w.z = pk4_fp8(v0[0] * EOSCALE, v0[1] * EOSCALE, v0[2] * EOSCALE, v0[3] * EOSCALE); w.w = pk4_fp8(v1[0] * EOSCALE, v1[1] * EOSCALE, v1[2] * EOSCALE, v1[3] * EOSCALE); }
                if (l >= 0) *(u32x4*)dst = w; }
    }
};
__device__ __forceinline__ const LAS unsigned char* moe_tiles(Frame& F, int& nT) {
    FT_DECL;
    LAS unsigned char* TE = (LAS unsigned char*)(F.lds + RING_BYTES); LAS int* TB = (LAS int*)(TE + 544); LAS int* TOT = TB + 32; LAS int* NTL = TOT + 32;
    const int* ecnt = (const int*)(F.ctl + CW_ECNT);
    __syncthreads();
    if (f_tid < 32) { const int t = ecnt[f_tid]; TOT[f_tid] = t; NTL[f_tid] = (t + 255) >> 8; }
    __syncthreads();
    if (f_tid < 33) { int b = 0; for (int e = 0; e < f_tid; ++e) b += NTL[e]; if (f_tid < 32) TB[f_tid] = b; else NTL[32] = b; }
    __syncthreads();
    nT = NTL[32]; if (nT > MAXTILE) nT = MAXTILE;
    for (int i = f_tid; i < MAXTILE; i += 512) { int e = 0;
#pragma unroll 8
        for (int q = 0; q < 32; ++q) e += (TB[q] + NTL[q] <= i) ? 1 : 0;
        TE[i] = (unsigned char)((i < nT) ? e : 0); }
    __syncthreads();
    return (const LAS unsigned char*)TE;
}

__device__ __forceinline__ void p10_combine(Frame& F) {
    FT_DECL;
    const float* mod = WSP(float, WS_SMALL + SM_MOD); const unsigned char* EO = WSP(unsigned char, WS_EO);
    const size_t gt = (size_t)F.vcu * 512 + f_tid, NTH = (size_t)F.G * 512;
    constexpr int U = 4;
    for (size_t i0 = gt; i0 < (size_t)MROWS * 128; i0 += NTH * U) {
        u32x2 ev[U][4]; f32x4 xv[U][2], gv[U][2];
#pragma unroll
        for (int u = 0; u < U; ++u) { const size_t i = i0 + (size_t)u * NTH; const size_t row = i >> 7; const int c0 = (int)(i & 127) * 8;
            const float* g2 = mod + (size_t)(row >> 12) * (NMOD * DM) + 5 * DM + c0; const bf16_t* op = WSP(bf16_t, WS_XN) + row * DM + c0;
#pragma unroll
            for (int k = 0; k < 4; ++k) ev[u][k] = __builtin_nontemporal_load((const u32x2*)(EO + ((size_t)k * MROWS + row) * DM + c0));
            { const u32x4 xb = *(const u32x4*)op; xv[u][0] = (f32x4){__uint_as_float(xb.x << 16), __uint_as_float(xb.x & 0xffff0000u), __uint_as_float(xb.y << 16), __uint_as_float(xb.y & 0xffff0000u)};
              xv[u][1] = (f32x4){__uint_as_float(xb.z << 16), __uint_as_float(xb.z & 0xffff0000u), __uint_as_float(xb.w << 16), __uint_as_float(xb.w & 0xffff0000u)}; }
            gv[u][0] = *(const f32x4*)g2; gv[u][1] = *(const f32x4*)(g2 + 4); }
#pragma unroll
        for (int u = 0; u < U; ++u) { const size_t i = i0 + (size_t)u * NTH; const size_t row = i >> 7; const int c0 = (int)(i & 127) * 8;
            float s[8];
#pragma unroll
            for (int e = 0; e < 8; ++e) s[e] = 0.f;
#pragma unroll
            for (int k = 0; k < 4; ++k) { const u32x2 v = ev[u][k];
                const f32x2 a = __builtin_amdgcn_cvt_pk_f32_fp8((int)v.x, false), b = __builtin_amdgcn_cvt_pk_f32_fp8((int)v.x, true), c = __builtin_amdgcn_cvt_pk_f32_fp8((int)v.y, false), d = __builtin_amdgcn_cvt_pk_f32_fp8((int)v.y, true);
                s[0] += a.x; s[1] += a.y; s[2] += b.x; s[3] += b.y; s[4] += c.x; s[5] += c.y; s[6] += d.x; s[7] += d.y; }
#pragma unroll
            for (int e = 0; e < 8; ++e) s[e] *= (1.f / EOSCALE);
            f32x4 o0 = xv[u][0] + gv[u][0] * (f32x4){s[0], s[1], s[2], s[3]}, o1 = xv[u][1] + gv[u][1] * (f32x4){s[4], s[5], s[6], s[7]};
            float* op = F.out + row * DM + c0;
            __builtin_nontemporal_store(o0, (f32x4*)op); __builtin_nontemporal_store(o1, (f32x4*)(op + 4)); }
    }
}

struct Args { const float* in[34]; float* out; unsigned char* ws; int ph_lo, ph_hi; };
constexpr int N_PHASES = 11;

__global__ void __launch_bounds__(512, 2) mega(Args args) {
    extern __shared__ __attribute__((aligned(16))) unsigned char lds[];
    Frame F;
    F.lds = (LAS unsigned char*)lds;
    F.MISC = (volatile LAS unsigned*)(F.lds + LDSCTL_OFF);
    F.wave = __builtin_amdgcn_readfirstlane(threadIdx.x >> 6);
    FT_DECL;
    F.G = gridDim.x; { const int bx = blockIdx.x; F.vcu = (F.G % 8 == 0) ? (bx % 8) * (F.G / 8) + bx / 8 : bx; }
    F.in = (kin_t)__builtin_amdgcn_kernarg_segment_ptr();
    F.out = args.out; F.ws = args.ws;
    F.ctl = (gu32*)(args.ws + WS_CTL);
    for (int u = f_tid; u < (LDS_BYTES - LDSCTL_OFF) / 4; u += NWAVES * 64) ((LAS unsigned*)(F.lds + LDSCTL_OFF))[u] = 0u;
    __syncthreads();
    const int lo = args.ph_lo, hi = args.ph_hi;
    XcdBarrier bar; bar.bar = (unsigned*)(F.ctl + CW_BAR); bar.x = 0; bar.st = nullptr;
    if (hi - lo > 1) bar = xcd_barrier_post((unsigned*)(F.ctl + CW_BAR), F.MISC + 8, f_tid == 0);
#define IN(k) (lo <= (k) && (k) < hi)
#define SEAM(k) do { if (IN(k) && IN((k) + 1)) xcd_barrier(bar, F.wave == 0 && lane_id() == 0); } while (0)

    if (IN(0)) { p0_prologue(F); } SEAM(0);
    if (IN(1)) { p1_norm1(F); } SEAM(1);
    if (IN(2)) {
        SchedInProj S{F.G, (int)blockIdx.x, (const char*)WSP(bf16_t, WS_H), (const char*)WSP(bf16_t, WS_WIN)};
        EpiInProj E{WSP(unsigned char, WS_Q), WSP(unsigned char, WS_K), WSP(unsigned char, WS_V), WSP(bf16_t, WS_UT), F.in[9], F.in[10], WSP(float, WS_SMALL + SM_ROPE)};
        g8::gemm_phase<false>(F.lds, DM, S, E, F.wave, lane_id());
    } SEAM(2);
    if (IN(3)) { p3_attention8(F); p3_hyena(F); } SEAM(3);
    if (IN(4)) { p4_hynorm(F); } SEAM(4);
    if (IN(5)) {
        SchedStatic S{F.G, (int)blockIdx.x, MROWS / 256, DM / 256, (const char*)WSP(bf16_t, WS_MIX), (const char*)WSP(bf16_t, WS_WOUT)};
        EpiOutProj E{F.in[0], WSP(bf16_t, WS_XN), WSP(float, WS_SMALL + SM_MOD)};
        g8::gemm_phase<false>(F.lds, DM, S, E, F.wave, lane_id());
    } SEAM(5);
    if (IN(6)) { p6_router_mfma(F); } SEAM(6);
    if (IN(8)) {
        int nT; const LAS unsigned char* TE = moe_tiles(F, nT);
        LAS int* RWL = (LAS int*)(F.lds + RING_BYTES + 1024);
        static_assert(RING_BYTES + 1024 + 17 * 1024 <= LDSCTL_OFF, "LDS map");
        SchedMoE<8> S{F.G, (int)blockIdx.x, nT, (const char*)WSP(char, WS_H), (const char*)WSP(char, WS_W1), (size_t)2 * DM * DM, TE, RWL, true};
        { const int* list = WSP(int, WS_LIST2); const int t8 = F.wave * 64 + lane_id();
            g8::Unit u; for (int i = 0; i < 17 && S.next(i, u); i += 2) { const int ii = i + (t8 >> 8); g8::Unit u2; if (S.next(ii, u2)) { const long ix = S.lidx(u2.pm, u2.ex, t8 & 255); RWL[ii * 256 + (t8 & 255)] = (ix >= 0) ? (list[ix] >> 2) : 0; } }
            __syncthreads(); }
        EpiSwiGLU E{WSP(unsigned char, WS_ACT), F.in[31]};
        g8::gemm_phase_g<true, true>(F.lds, DM, S, E, F.wave, lane_id());
    } SEAM(8);
    if (IN(9)) {
        int nT; const LAS unsigned char* TE = moe_tiles(F, nT);
        SchedMoE<4> S{F.G, (int)blockIdx.x, nT, (const char*)WSP(char, WS_ACT), (const char*)WSP(char, WS_W2), (size_t)DM * DM, TE, nullptr, false};
        LAS int* LL = (LAS int*)(F.lds + RING_BYTES + 1024);
        static_assert(RING_BYTES + 1024 + 9 * 2048 <= LDSCTL_OFF, "LDS map");
        { const int* list = WSP(int, WS_LIST2); const float* gslot = WSP(float, WS_GSLOT2);
            const int t9 = F.wave * 64 + lane_id();
            g8::Unit u; for (int i = 0; i < 9 && S.next(i, u); ++i) { const int t = t9 & 255; const long ix = S.lidx(u.pm, u.ex, t);
                LL[i * 512 + (t9 >> 8) * 256 + t] = (ix < 0) ? ((t9 < 256) ? -1 : 0) : ((t9 < 256) ? list[ix] : __float_as_int(gslot[ix])); }
            __syncthreads(); }
        EpiDown E{WSP(unsigned char, WS_EO), F.in[33], LL, F.G, (int)blockIdx.x};
        g8::gemm_phase<true>(F.lds, DM, S, E, F.wave, lane_id());
    } SEAM(9);
    if (IN(10)) { p10_combine(F); }
#undef IN
#undef SEAM
}

extern "C" void kernel_launch(void* const* d_in, const int* in_sizes, int n_in, void* d_out, int out_size, void* d_ws, size_t ws_size, hipStream_t stream) {
    static int grid = 0;
    if (grid == 0) {
        if (n_in != 34 || out_size != MROWS * DM || ws_size < WS_END) { fprintf(stderr, "kernel_launch: unexpected shapes: n_in %d out %d ws %zu (need %zu)\n", n_in, out_size, ws_size, (size_t)WS_END); grid = -1; return; }
        int dev = 0, cus = 0, per_cu = 0;
        if (hipGetDevice(&dev) != hipSuccess || hipDeviceGetAttribute(&cus, hipDeviceAttributeMultiprocessorCount, dev) != hipSuccess) { grid = -1; return; }
        if (hipFuncSetAttribute((const void*)mega, hipFuncAttributeMaxDynamicSharedMemorySize, LDS_BYTES) != hipSuccess) { fprintf(stderr, "kernel_launch: hipFuncSetAttribute failed\n"); grid = -1; return; }
        if (hipOccupancyMaxActiveBlocksPerMultiprocessor(&per_cu, (const void*)mega, NWAVES * 64, LDS_BYTES) != hipSuccess || per_cu < 1) { fprintf(stderr, "kernel_launch: occupancy query says %d\n", per_cu); per_cu = 1; }
        (void)hipGetLastError();
        grid = cus;
    }
    if (grid < 0) return;
    (void)hipMemsetAsync((char*)d_ws + WS_CTL, 0, CTL_ZERO_BYTES, stream);
    Args a{};
    for (int i = 0; i < 34; ++i) a.in[i] = (const float*)d_in[i];
    a.out = (float*)d_out; a.ws = (unsigned char*)d_ws;
    constexpr int LAST = MK_LAST_PHASE + 1;
    if (MK_N_LAUNCHES == 1) { a.ph_lo = 0; a.ph_hi = LAST; hipLaunchKernelGGL(mega, dim3(grid), dim3(NWAVES * 64), LDS_BYTES, stream, a); }
    else for (int p = 0; p < LAST; ++p) { a.ph_lo = p; a.ph_hi = p + 1; hipLaunchKernelGGL(mega, dim3(grid), dim3(NWAVES * 64), LDS_BYTES, stream, a); }
    const hipError_t le = hipPeekAtLastError();
    if (le != hipSuccess) fprintf(stderr, "kernel_launch: launch failed: %s\n", hipGetErrorName(le));
}
```

```cpp
#include <hip/hip_runtime.h>
#include <hip/hip_bf16.h>
#include <cstdio>
#include <cstdint>

#ifndef MK_N_LAUNCHES
#define MK_N_LAUNCHES 1
#endif
#ifndef MK_LAST_PHASE
#define MK_LAST_PHASE 10
#endif

#define GAS __attribute__((address_space(1)))
#define LAS __attribute__((address_space(3)))
typedef unsigned short bf16_t;
typedef short bf16x8 __attribute__((ext_vector_type(8)));
typedef short s16x4 __attribute__((ext_vector_type(4)));
typedef float f32x2 __attribute__((ext_vector_type(2)));
typedef float f32x4 __attribute__((ext_vector_type(4)));
typedef float f32x16 __attribute__((ext_vector_type(16)));
typedef unsigned u32x2 __attribute__((ext_vector_type(2)));
typedef unsigned u32x4 __attribute__((ext_vector_type(4)));
typedef GAS unsigned gu32;

constexpr int NB = 8, SEQ = 4096, DM = 1024, MROWS = NB * SEQ, CTXL = 256, MCTX = NB * CTXL, MTOT = MROWS + MCTX;
constexpr int KVL = CTXL + SEQ;
constexpr int NHEAD = 4, QKW = 512;
constexpr int HYW = 512, HYC = 1536, INC = 3072, QKVC = 1536;
constexpr int NEXP = 32, TOPK = 4, NMOD = 6;
constexpr float EPS = 1e-6f;
constexpr float LAM_INIT = 0.2f;
constexpr float QSCALE = 0.125f * 1.4426950408889634f;

constexpr size_t MiB = 1u << 20;
constexpr size_t WS_CTL = 0, CTL_ZERO_BYTES = 64 * 1024;
constexpr size_t WS_SMALL = 1 * MiB;
constexpr size_t WS_WIN = 2 * MiB;
constexpr size_t WS_WOUT = 8 * MiB;
constexpr size_t WS_W1 = 10 * MiB;
constexpr size_t WS_W2 = 138 * MiB;
constexpr size_t WS_H = 202 * MiB;
constexpr size_t WS_Q = 270 * MiB;
constexpr size_t WS_K = 302 * MiB;
constexpr size_t WS_V = 336 * MiB;
constexpr size_t WS_UT = 370 * MiB;
constexpr size_t WS_FILT = 466 * MiB;
constexpr size_t WS_Z2T = 498 * MiB;
constexpr size_t WS_MIX = 530 * MiB;
constexpr size_t WS_ROUTE = 594 * MiB;
constexpr size_t WS_ACT = 270 * MiB;
constexpr size_t WS_EO = 598 * MiB;
constexpr size_t WS_XN = 870 * MiB;
constexpr size_t WS_END = 998 * MiB;
constexpr size_t SM_MOD = 0;
constexpr size_t SM_SCAL = 256 * 1024;
constexpr size_t SM_ROPE = 260 * 1024;
constexpr size_t SM_RBIAS = 272 * 1024;
constexpr int CW_BAR = 4096;

constexpr int RING_BYTES = 131072;
constexpr int LDSCTL_OFF = 151552;
constexpr int LDS_BYTES = 152576;
constexpr int NWAVES = 8;

#define LDS_WAIT() asm volatile("s_waitcnt lgkmcnt(0)" ::: "memory")
#define VM_WAIT() asm volatile("s_waitcnt vmcnt(0)" ::: "memory")
#define RLX_AGENT __ATOMIC_RELAXED, __HIP_MEMORY_SCOPE_AGENT

__device__ __forceinline__ unsigned cvt_pk_bf16(float lo, float hi) { unsigned r; asm volatile("v_cvt_pk_bf16_f32 %0, %1, %2" : "=v"(r) : "v"(lo), "v"(hi)); return r; }
__device__ __forceinline__ float bf2f(bf16_t v) { return __uint_as_float(((unsigned)v) << 16); }
__device__ __forceinline__ float wave_sum(float v) {
#pragma unroll
    for (int o = 1; o < 64; o <<= 1) v += __shfl_xor(v, o);
    return v;
}

#define XB_TMO      128
#define XB_XCNT(j)  (256  + 64 * (j))
#define XB_XSUB(j)  (1280 + 64 * (j))
#define XB_XGEN(j)  (2304 + 64 * (j))
#define XB_TOP      3328
#define XB_TOPGEN   3392
#define XCD_BAR_WORDS 3456
#define XB_SPIN_CAP (1u << 22)
__device__ __forceinline__ unsigned xb_ld(unsigned* p)              { return __hip_atomic_load(p, __ATOMIC_RELAXED, __HIP_MEMORY_SCOPE_AGENT); }
__device__ __forceinline__ unsigned xb_add(unsigned* p, unsigned v) { return __hip_atomic_fetch_add(p, v, __ATOMIC_RELAXED, __HIP_MEMORY_SCOPE_AGENT); }
__device__ __forceinline__ unsigned xb_xcc_id() { return (unsigned)__builtin_amdgcn_s_getreg((3 << 11) | 20) & 0xFu; }
#define XB_SPIN(cond, bar) do { unsigned _sp = 0; while (cond) { __builtin_amdgcn_s_sleep(1); \
    if ((++_sp & 255u) == 0u) { if (xb_ld(&(bar)[XB_TMO])) break; if (_sp > XB_SPIN_CAP) { atomicAdd(&(bar)[XB_TMO], 1u); break; } } } } while (0)
struct XcdBarrier { unsigned* bar; unsigned x; volatile LAS unsigned* st; };
__device__ __forceinline__ XcdBarrier xcd_barrier_post(unsigned* bar, volatile LAS unsigned* st, bool leader) {
    XcdBarrier b; b.bar = bar; b.x = xb_xcc_id(); b.st = st;
    if (leader) (void)xb_add(&bar[XB_XCNT(b.x)], 1u);
    return b;
}
__device__ __forceinline__ void xcd_barrier_complete(unsigned* bar, unsigned x, unsigned& nloc, unsigned& nx) {
    const unsigned G = gridDim.x * gridDim.y * gridDim.z;
    unsigned sum, cnt, mine, sp = 0u;
    for (;;) {
        sum = 0u; cnt = 0u; mine = 0u;
#pragma unroll
        for (unsigned j = 0; j < 16; ++j) { const unsigned c = xb_ld(&bar[XB_XCNT(j)]); sum += c; cnt += (c > 0u) ? 1u : 0u; mine = (j == x) ? c : mine; }
        if (sum == G) break;
        __builtin_amdgcn_s_sleep(1);
        if ((++sp & 255u) == 0u) { if (xb_ld(&bar[XB_TMO])) break; if (sp > XB_SPIN_CAP) { atomicAdd(&bar[XB_TMO], 1u); break; } }
    }
    nloc = mine > 0u ? mine : 1u; nx = cnt > 0u ? cnt : 1u;
}
__device__ __forceinline__ void xcd_barrier(const XcdBarrier& b, bool leader) {
    asm volatile("s_waitcnt vmcnt(0)" ::: "memory");
    __syncthreads();
    if (leader) {
        unsigned* bar = b.bar;
        __builtin_amdgcn_s_waitcnt(0);
        unsigned nloc = b.st[0], nx = b.st[1];
        if (nloc == 0u) { xcd_barrier_complete(bar, b.x, nloc, nx); b.st[0] = nloc; b.st[1] = nx; }
        const unsigned old = xb_add(&bar[XB_XSUB(b.x)], 1u);
        const unsigned gen = old / nloc;
        if (old + 1u == (gen + 1u) * nloc) {
            __builtin_amdgcn_fence(__ATOMIC_RELEASE, "agent");
            asm volatile("s_waitcnt vmcnt(0)" ::: "memory");
            const unsigned og = xb_add(&bar[XB_TOP], 1u);
            const unsigned tg = og / nx;
            if (og + 1u == (tg + 1u) * nx) xb_add(&bar[XB_TOPGEN], 1u);
            else XB_SPIN(xb_ld(&bar[XB_TOPGEN]) == tg, bar);
            __builtin_amdgcn_fence(__ATOMIC_ACQUIRE, "agent");
            xb_add(&bar[XB_XGEN(b.x)], 1u);
            asm volatile("s_waitcnt vmcnt(0)" ::: "memory");
        } else {
            XB_SPIN(xb_ld(&bar[XB_XGEN(b.x)]) == gen, bar);
            __builtin_amdgcn_fence(__ATOMIC_ACQUIRE, "agent");
            asm volatile("s_waitcnt vmcnt(0)" ::: "memory");
        }
    }
    __syncthreads();
}

namespace g8 {
constexpr int BM = 256, BK = 64, HALF = 128, HTB = HALF * BK * 2, STAGE_BYTES = 8 * HTB, NXCD = 8, WGM = 8;
__host__ __device__ __forceinline__ int lds_byte(int r, int c) { const int st = (r >> 4) * 2 + (c >> 5), rr = r & 15, cc = c & 31, ob = rr * 64 + cc * 2; return st * 1024 + (ob ^ (((ob >> 9) & 1) << 5)); }
__host__ __device__ __forceinline__ void stage_rc(int b, int& R, int& C) { const int st = b / 1024, sb = b % 1024, swz = sb ^ (((sb >> 9) & 1) << 5); R = (st >> 1) * 16 + swz / 64; C = (st & 1) * 32 + (swz % 64) / 2; }
__host__ __device__ __forceinline__ int perm32(int rho) { const int n = rho >> 4, i = rho & 15; return 8 * (i >> 2) + 4 * n + (i & 3); }

struct Unit { const char* a; const char* b; int pm, pn, kind, ex; };

__device__ __forceinline__ void tile_of(int L, int nM, int nN, int& pm, int& pn) {
    const int nwg = nM * nN; int wgid = L;
    { const int q = nwg / NXCD, r = nwg % NXCD, xcd = wgid % NXCD, off = wgid / NXCD; wgid = (xcd < r ? xcd * (q + 1) : r * (q + 1) + (xcd - r) * q) + off; }
    const int nig = WGM * nN, gid = wgid / nig, fm = gid * WGM, gsz = (nM - fm) < WGM ? (nM - fm) : WGM;
    pm = fm + ((wgid % nig) % gsz); pn = (wgid % nig) / gsz;
}

typedef int i32x8 __attribute__((ext_vector_type(8)));
template <bool FP8, bool GATHER, bool SP2, class Epi, class Sched>
__device__ __forceinline__ void gemm_phase_s(LAS unsigned char* lds, const int K, const Sched& S, const Epi& E, const int wid, const int lane) {
    const int tid = wid * 64 + lane, wr = wid >> 2, wc = wid & 3, fr = lane & 15, fq = lane >> 4;
    const int nt = FP8 ? K / 128 : K / BK;
    const int RP = FP8 ? K : 2 * K;
    unsigned voffA[2], voffB[2]; int srow[2], scol[2];
#pragma unroll
    for (int i = 0; i < 2; ++i) { int R, C; stage_rc(tid * 16 + i * 8192, R, C); const int Rb = (R & ~31) + perm32(R & 31);
        voffA[i] = (unsigned)(R * RP + C * 2); voffB[i] = (unsigned)(Rb * RP + C * 2); srow[i] = R; scol[i] = C * 2; }
    const size_t kstep = (size_t)(BK * 2);
    const size_t hstep = (size_t)HALF * RP;
    const unsigned ldsw = (unsigned)wid * 1024u;
    unsigned cO0[2], cO1[2], nO0[2], nO1[2];
#define PG8_GOFF(D0, D1, ui_) do { if constexpr (GATHER) { const LAS int* rw_ = S.rows(ui_); _Pragma("unroll") for (int i_ = 0; i_ < 2; ++i_) { \
        D0[i_] = (unsigned)rw_[srow[i_]] * (unsigned)RP + (unsigned)scol[i_]; D1[i_] = (unsigned)rw_[128 + srow[i_]] * (unsigned)RP + (unsigned)scol[i_]; } } \
      else { _Pragma("unroll") for (int i_ = 0; i_ < 2; ++i_) { D0[i_] = voffA[i_]; D1[i_] = voffA[i_] + (unsigned)hstep; } } } while (0)
    const int aoff = lds_byte(wr * 64 + fr, FP8 ? fq * 16 : fq * 8), boff = lds_byte(wc * 32 + fr, FP8 ? fq * 16 : fq * 8);
    constexpr int KOFF = FP8 ? 16 : 1024;
#define PG8_SA(b, h) (((b) * 2 + (h)) * HTB)
#define PG8_SB(b, h) ((4 + (b) * 2 + (h)) * HTB)
#define PG8_STAGE(bufoff, gbase, voff) do { _Pragma("unroll") for (int _i = 0; _i < 2; ++_i) \
        __builtin_amdgcn_global_load_lds((const unsigned*)((const char*)(gbase) + (voff)[_i]), (LAS unsigned*)(lds + (bufoff) + ldsw + _i * 8192), 16, 0, 0); } while (0)
#define PG8_LD32(p) __builtin_bit_cast(i32x8, __builtin_shufflevector(*(const LAS u32x4*)(p), *(const LAS u32x4*)((p) + 16), 0, 1, 2, 3, 4, 5, 6, 7))
#define PG8_LDA8(dst, b, h) do { _Pragma("unroll") for (int m = 0; m < 4; ++m) dst[m] = PG8_LD32(lds + PG8_SA(b, h) + aoff + m * 2048); } while (0)
#define PG8_LDB8(dst, b, h) do { _Pragma("unroll") for (int n = 0; n < 2; ++n) dst[n] = PG8_LD32(lds + PG8_SB(b, h) + boff + n * 2048); } while (0)
#define PG8_LDA(dst, b, h) do { _Pragma("unroll") for (int m = 0; m < 4; ++m) _Pragma("unroll") for (int k = 0; k < 2; ++k) dst[m][k] = *(const LAS bf16x8*)(lds + PG8_SA(b, h) + aoff + m * 2048 + k * KOFF); } while (0)
#define PG8_LDB(dst, b, h) do { _Pragma("unroll") for (int n = 0; n < 2; ++n) _Pragma("unroll") for (int k = 0; k < 2; ++k) dst[n][k] = *(const LAS bf16x8*)(lds + PG8_SB(b, h) + boff + n * 2048 + k * KOFF); } while (0)
#define PG8_MMA(ai, bj, At, Bt) do { __builtin_amdgcn_s_setprio(1); _Pragma("unroll") for (int m = 0; m < 4; ++m) _Pragma("unroll") for (int n = 0; n < 2; ++n) _Pragma("unroll") for (int k = 0; k < 2; ++k) \
        acc[ai][bj][m][n] = __builtin_amdgcn_mfma_f32_16x16x32_bf16(Bt[n][k], At[m][k], acc[ai][bj][m][n], 0, 0, 0); __builtin_amdgcn_s_setprio(0); } while (0)
#define PG8_MMA8(ai, bj, At, Bt) do { __builtin_amdgcn_s_setprio(1); _Pragma("unroll") for (int m = 0; m < 4; ++m) _Pragma("unroll") for (int n = 0; n < 2; ++n) \
        asm volatile("v_mfma_scale_f32_16x16x128_f8f6f4 %0, %1, %2, %0, %3, %3 op_sel_hi:[0,0,0]" : "+v"(acc[ai][bj][m][n]) : "v"(Bt[n]), "v"(At[m]), "v"(one_scale)); __builtin_amdgcn_s_setprio(0); } while (0)
#define PG8_WAIT_V(n) asm volatile("s_waitcnt vmcnt(" #n ")" ::: "memory")
#define PG8_WAIT_L(n) asm volatile("s_waitcnt lgkmcnt(" #n ")" ::: "memory")
#define PG8_BAR __builtin_amdgcn_s_barrier()
#define PG8_SCHED __builtin_amdgcn_sched_barrier(0)
    Unit cur, nxt; int ui = 0;
    if (!S.next(0, cur)) return;
    f32x4 acc[2][2][4][2];
#pragma unroll
    for (int a = 0; a < 2; ++a)
#pragma unroll
        for (int b = 0; b < 2; ++b)
#pragma unroll
            for (int m = 0; m < 4; ++m)
#pragma unroll
                for (int n = 0; n < 2; ++n) acc[a][b][m][n] = (f32x4){0.f, 0.f, 0.f, 0.f};
    bf16x8 At[4][2], B0[2][2], B1[2][2];
    i32x8 At8[4], B08[2], B18[2];
    const unsigned one_scale = 0x7f7f7f7fu;
    const char* cA = cur.a; const char* cB = cur.b;
    PG8_GOFF(cO0, cO1, 0);
    if constexpr (SP2) {
    PG8_STAGE(PG8_SB(0, 0), cB, voffB); PG8_STAGE(PG8_SB(0, 1), cB + hstep, voffB); PG8_STAGE(PG8_SA(0, 0), cA, cO0); PG8_STAGE(PG8_SA(0, 1), cA, cO1);
    if (wr == 1) PG8_BAR;
    PG8_WAIT_V(2); PG8_BAR;
    PG8_STAGE(PG8_SB(1, 0), cB + kstep, voffB); PG8_STAGE(PG8_SA(1, 0), cA + kstep, cO0); PG8_STAGE(PG8_SB(1, 1), cB + hstep + kstep, voffB);
    PG8_WAIT_V(6); PG8_BAR;
    } else {
    PG8_STAGE(PG8_SB(0, 0), cB, voffB); PG8_STAGE(PG8_SA(0, 0), cA, cO0); PG8_STAGE(PG8_SB(0, 1), cB + hstep, voffB); PG8_STAGE(PG8_SA(0, 1), cA, cO1);
    if (wr == 1) PG8_BAR;
    PG8_WAIT_V(4); PG8_BAR;
    PG8_STAGE(PG8_SB(1, 0), cB + kstep, voffB); PG8_STAGE(PG8_SA(1, 0), cA + kstep, cO0); PG8_STAGE(PG8_SB(1, 1), cB + hstep + kstep, voffB);
    PG8_WAIT_V(6); PG8_BAR;
    }
    for (;;) {
        const bool has_next = S.next(ui + 1, nxt);
        const char* nA = has_next ? nxt.a : cA; const char* nB = has_next ? nxt.b : cB;
        if (has_next) PG8_GOFF(nO0, nO1, ui + 1); else { _Pragma("unroll") for (int i_ = 0; i_ < 2; ++i_) { nO0[i_] = cO0[i_]; nO1[i_] = cO1[i_]; } }
#pragma unroll 1
        for (int t = 0; t < nt; t += 2) {
            const bool last = (t == nt - 2);
            const char* a1 = cA + (size_t)(t + 1) * kstep;
            const char* a2 = last ? nA : cA + (size_t)(t + 2) * kstep; const char* b2 = last ? nB : cB + (size_t)(t + 2) * kstep;
            const char* a3 = a2 + kstep; const char* b3 = b2 + kstep;
            unsigned o20[2], o21[2];
#pragma unroll
            for (int i_ = 0; i_ < 2; ++i_) { o20[i_] = last ? nO0[i_] : cO0[i_]; o21[i_] = last ? nO1[i_] : cO1[i_]; }
            if constexpr (FP8 && SP2) {
            PG8_LDB8(B08, 0, 0); PG8_LDB8(B18, 0, 1); PG8_SCHED; PG8_LDA8(At8, 0, 0); PG8_STAGE(PG8_SA(1, 1), a1, cO1);
            PG8_WAIT_V(8); PG8_WAIT_L(0); PG8_BAR; PG8_MMA8(0, 0, At8, B08); PG8_MMA8(0, 1, At8, B18); PG8_BAR; PG8_SCHED;
            PG8_LDA8(At8, 0, 1); PG8_STAGE(PG8_SB(0, 0), b2, voffB); PG8_STAGE(PG8_SB(0, 1), b2 + hstep, voffB); PG8_STAGE(PG8_SA(0, 0), a2, o20);
            PG8_WAIT_V(8); PG8_WAIT_L(0); PG8_BAR; PG8_MMA8(1, 0, At8, B08); PG8_MMA8(1, 1, At8, B18); PG8_BAR; PG8_SCHED;
            PG8_LDB8(B08, 1, 0); PG8_LDB8(B18, 1, 1); PG8_SCHED; PG8_LDA8(At8, 1, 0); PG8_STAGE(PG8_SA(0, 1), a2, o21);
            PG8_WAIT_V(8); PG8_WAIT_L(0); PG8_BAR; PG8_MMA8(0, 0, At8, B08); PG8_MMA8(0, 1, At8, B18); PG8_BAR; PG8_SCHED;
            PG8_LDA8(At8, 1, 1); PG8_STAGE(PG8_SB(1, 0), b3, voffB); PG8_STAGE(PG8_SB(1, 1), b3 + hstep, voffB); PG8_STAGE(PG8_SA(1, 0), a3, o20);
            PG8_WAIT_V(8); PG8_WAIT_L(0); PG8_BAR; PG8_MMA8(1, 0, At8, B08); PG8_MMA8(1, 1, At8, B18); PG8_BAR; PG8_SCHED;
            } else if constexpr (FP8) {
            PG8_LDB8(B08, 0, 0); PG8_SCHED; PG8_LDA8(At8, 0, 0); PG8_STAGE(PG8_SA(1, 1), a1, cO1);
            PG8_WAIT_L(8); PG8_BAR; PG8_WAIT_L(0); PG8_MMA8(0, 0, At8, B08); PG8_BAR; PG8_SCHED;
            PG8_LDB8(B18, 0, 1); PG8_STAGE(PG8_SB(0, 0), b2, voffB);
            PG8_BAR; PG8_WAIT_L(0); PG8_MMA8(0, 1, At8, B18); PG8_BAR;
            PG8_LDA8(At8, 0, 1); PG8_STAGE(PG8_SA(0, 0), a2, o20);
            PG8_BAR; PG8_WAIT_L(0); PG8_MMA8(1, 0, At8, B08); PG8_BAR; PG8_SCHED;
            PG8_STAGE(PG8_SB(0, 1), b2 + hstep, voffB);
            PG8_WAIT_V(6); PG8_BAR; PG8_MMA8(1, 1, At8, B18); PG8_BAR;
            PG8_LDB8(B08, 1, 0); PG8_SCHED; PG8_LDA8(At8, 1, 0); PG8_STAGE(PG8_SA(0, 1), a2, o21);
            PG8_WAIT_L(8); PG8_BAR; PG8_WAIT_L(0); PG8_MMA8(0, 0, At8, B08); PG8_BAR; PG8_SCHED;
            PG8_LDB8(B18, 1, 1); PG8_STAGE(PG8_SB(1, 0), b3, voffB);
            PG8_BAR; PG8_WAIT_L(0); PG8_MMA8(0, 1, At8, B18); PG8_BAR;
            PG8_LDA8(At8, 1, 1); PG8_STAGE(PG8_SA(1, 0), a3, o20);
            PG8_BAR; PG8_WAIT_L(0); PG8_MMA8(1, 0, At8, B08); PG8_BAR; PG8_SCHED;
            PG8_STAGE(PG8_SB(1, 1), b3 + hstep, voffB);
            PG8_WAIT_V(6); PG8_BAR; PG8_MMA8(1, 1, At8, B18); PG8_BAR;
            } else {
            PG8_LDB(B0, 0, 0); PG8_LDB(B1, 0, 1); PG8_SCHED; PG8_LDA(At, 0, 0); PG8_STAGE(PG8_SA(1, 1), a1, cO1);
            PG8_WAIT_V(8); PG8_WAIT_L(0); PG8_BAR; PG8_MMA(0, 0, At, B0); PG8_MMA(0, 1, At, B1); PG8_BAR; PG8_SCHED;
            PG8_LDA(At, 0, 1); PG8_STAGE(PG8_SB(0, 0), b2, voffB); PG8_STAGE(PG8_SB(0, 1), b2 + hstep, voffB); PG8_STAGE(PG8_SA(0, 0), a2, o20);
            PG8_WAIT_V(8); PG8_WAIT_L(0); PG8_BAR; PG8_MMA(1, 0, At, B0); PG8_MMA(1, 1, At, B1); PG8_BAR; PG8_SCHED;
            PG8_LDB(B0, 1, 0); PG8_LDB(B1, 1, 1); PG8_SCHED; PG8_LDA(At, 1, 0); PG8_STAGE(PG8_SA(0, 1), a2, o21);
            PG8_WAIT_V(8); PG8_WAIT_L(0); PG8_BAR; PG8_MMA(0, 0, At, B0); PG8_MMA(0, 1, At, B1); PG8_BAR; PG8_SCHED;
            PG8_LDA(At, 1, 1); PG8_STAGE(PG8_SB(1, 0), b3, voffB); PG8_STAGE(PG8_SB(1, 1), b3 + hstep, voffB); PG8_STAGE(PG8_SA(1, 0), a3, o20);
            PG8_WAIT_V(8); PG8_WAIT_L(0); PG8_BAR; PG8_MMA(1, 0, At, B0); PG8_MMA(1, 1, At, B1); PG8_BAR; PG8_SCHED;
            }
        }
        if (wr == 0) PG8_BAR;
        if constexpr (FP8) asm volatile("s_nop 15\n\ts_nop 15" ::: "memory");
        E(acc, cur, wr, wc, fr, fq);
        if (!has_next) break;
#pragma unroll
        for (int a = 0; a < 2; ++a)
#pragma unroll
            for (int b = 0; b < 2; ++b)
#pragma unroll
                for (int m = 0; m < 4; ++m)
#pragma unroll
                    for (int n = 0; n < 2; ++n) acc[a][b][m][n] = (f32x4){0.f, 0.f, 0.f, 0.f};
        cur = nxt; cA = nA; cB = nB; ++ui;
#pragma unroll
        for (int i_ = 0; i_ < 2; ++i_) { cO0[i_] = nO0[i_]; cO1[i_] = nO1[i_]; }
        if (wr == 1) PG8_BAR;
    }
    PG8_WAIT_V(0);
    PG8_BAR;
#undef PG8_SA
#undef PG8_GOFF
#undef PG8_SB
#undef PG8_STAGE
#undef PG8_LDA
#undef PG8_LDB
#undef PG8_MMA
#undef PG8_MMA8
#undef PG8_LDA8
#undef PG8_LDB8
#undef PG8_LD32
#undef PG8_WAIT_V
#undef PG8_WAIT_L
#undef PG8_BAR
#undef PG8_SCHED
}
template <bool FP8, bool GATHER, class Epi, class Sched>
__device__ __forceinline__ void gemm_phase_g(LAS unsigned char* lds, const int K, const Sched& S, const Epi& E, const int wid, const int lane) { gemm_phase_s<FP8, GATHER, !FP8>(lds, K, S, E, wid, lane); }
template <bool FP8, class Epi, class Sched>
__device__ __forceinline__ void gemm_phase(LAS unsigned char* lds, const int K, const Sched& S, const Epi& E, const int wid, const int lane) { gemm_phase_s<FP8, false, !FP8>(lds, K, S, E, wid, lane); }
}

__device__ __forceinline__ int lane_id() { int l; asm volatile("v_mbcnt_lo_u32_b32 %0, -1, 0\n\tv_mbcnt_hi_u32_b32 %0, -1, %0" : "=v"(l)); return l; }
#define FT_DECL const int f_lane = lane_id(), f_tid = F.wave * 64 + f_lane; (void)f_tid; (void)f_lane
typedef const float* cfp_t;
typedef __attribute__((address_space(4))) cfp_t* kin_t;
struct Frame {
    LAS unsigned char* lds;
    volatile LAS unsigned* MISC;
    gu32* ctl;
    int wave, vcu, G;
    kin_t in;
    float* out;
    unsigned char* ws;
};
#define WSP(T, off) ((T*)(F.ws + (off)))

template <class RowMap>
__device__ __forceinline__ void p0_transpose_item(const float* W, int K, int N, bf16_t* WT, const RowMap& rowmap, const float* kscale, LAS float* scr, int item, int lane, bool kperm = false) {
    const int nblk = N / 32, kb = item / nblk, nb = item % nblk, k0 = 64 * kb, n0 = 32 * nb;
#pragma unroll 8
    for (int i = 0; i < 32; ++i) { const int kk = 2 * i + (lane >> 5); int ks = k0 + kk; if (kperm && ks >= K / 2) { const int j = ks - K / 2; ks = K / 2 + (j >> 3) + 64 * (j & 7); }
        float v = W[(size_t)ks * N + n0 + (lane & 31)]; if (kscale) v *= kscale[k0 + kk]; scr[kk * 33 + (lane & 31)] = v; }
    LDS_WAIT(); asm volatile("" ::: "memory");
    const int c = lane & 7;
#pragma unroll
    for (int j = 0; j < 4; ++j) { const int n = (lane >> 3) + 8 * j; const LAS float* s = scr + (8 * c) * 33 + n;
        u32x4 o; o.x = cvt_pk_bf16(s[0 * 33], s[1 * 33]); o.y = cvt_pk_bf16(s[2 * 33], s[3 * 33]); o.z = cvt_pk_bf16(s[4 * 33], s[5 * 33]); o.w = cvt_pk_bf16(s[6 * 33], s[7 * 33]);
        *(GAS u32x4*)(WT + (size_t)rowmap(n0 + n) * K + k0 + 8 * c) = o; }
    LDS_WAIT(); asm volatile("" ::: "memory");
}

__device__ __forceinline__ unsigned pk4_fp8(float a, float b, float c, float d) { int r = __builtin_amdgcn_cvt_pk_fp8_f32(a, b, 0, false); r = __builtin_amdgcn_cvt_pk_fp8_f32(c, d, r, true); return (unsigned)r; }
constexpr float EOSCALE = 16.f;
constexpr float WSCALE = 32.f;
template <class RowMap>
__device__ __forceinline__ void p0_transpose_item_f8(const float* W, int K, int N, unsigned char* WT, const RowMap& rowmap, LAS float* scr, int item, int lane) {
    const int nblk = N / 32, kb = item / nblk, nb = item % nblk, k0 = 128 * kb, n0 = 32 * nb;
#pragma unroll
    for (int hh = 0; hh < 2; ++hh) { float v[32];
#pragma unroll
        for (int i = 0; i < 32; ++i) { const int kk = 2 * (32 * hh + i) + (lane >> 5); v[i] = __builtin_nontemporal_load(W + (size_t)(k0 + kk) * N + n0 + (lane & 31)); }
#pragma unroll
        for (int i = 0; i < 32; ++i) { const int kk = 2 * (32 * hh + i) + (lane >> 5); scr[kk * 33 + (lane & 31)] = v[i] * WSCALE; } }
    LDS_WAIT(); asm volatile("" ::: "memory");
    const int c = lane & 7;
#pragma unroll
    for (int j = 0; j < 4; ++j) { const int n = (lane >> 3) + 8 * j; const LAS float* sp = scr + (16 * c) * 33 + n;
        u32x4 o; o.x = pk4_fp8(sp[0 * 33], sp[1 * 33], sp[2 * 33], sp[3 * 33]); o.y = pk4_fp8(sp[4 * 33], sp[5 * 33], sp[6 * 33], sp[7 * 33]);
        o.z = pk4_fp8(sp[8 * 33], sp[9 * 33], sp[10 * 33], sp[11 * 33]); o.w = pk4_fp8(sp[12 * 33], sp[13 * 33], sp[14 * 33], sp[15 * 33]);
        *(GAS u32x4*)(WT + (size_t)rowmap(n0 + n) * K + k0 + 16 * c) = o; }
    LDS_WAIT(); asm volatile("" ::: "memory");
}
struct MapW2 { __device__ __forceinline__ int operator()(int l) const { const int t = l & ~255, r = l & 255, wc = r >> 6, fq = (r >> 4) & 3, bj = (r >> 3) & 1, low = r & 7; return t + 128 * bj + 32 * wc + 8 * fq + low; } };
struct MapIdent { int off; __device__ __forceinline__ int operator()(int n) const { return off + n; } };
struct MapWin { __device__ __forceinline__ int operator()(int l) const {
    if (l >= 1024) return l;
    const int t = l & ~255, r = l & 255, wc = r >> 6, blk = (r >> 5) & 1, bj = (r >> 4) & 1, low = r & 15;
    return t + 128 * bj + 32 * wc + 16 * blk + low; } };
struct MapW1 { int off; __device__ __forceinline__ int operator()(int jp) const { const int bj = jp >> 10, j = jp & 1023; return off + 256 * (j >> 7) + 128 * bj + (j & 127); } };


__device__ __forceinline__ void p0_filter_item(Frame& F, int item) {
    FT_DECL;
#define in F.in
    LAS float* h1s = (LAS float*)(F.lds);
    LAS float* h2s = (LAS float*)(F.lds + 4096);
    const int t0 = item * 16;
    {
        const int tt = f_tid >> 5, hh = (f_tid & 31) * 2; const float pos = (float)(t0 + tt);
        float feats[17]; feats[0] = pos * (1.f / SEQ);
#pragma unroll
        for (int i = 0; i < 8; ++i) { const float band = 1e-4f + (float)i * ((7.f - 1e-4f) / 7.f); const float ang = (6.283185307179586f / SEQ) * pos * band; feats[1 + i] = __sinf(ang); feats[9 + i] = __cosf(ang); }
#pragma unroll
        for (int u = 0; u < 2; ++u) { const int h = hh + u; float a = in[19][h];
#pragma unroll
            for (int k = 0; k < 17; ++k) a += feats[k] * in[18][k * 64 + h];
            h1s[tt * 64 + h] = __sinf(in[20][h] * a); }
        __syncthreads();
#pragma unroll
        for (int u = 0; u < 2; ++u) { const int h = hh + u; float a = in[22][h];
#pragma unroll 8
            for (int k = 0; k < 64; ++k) a += h1s[tt * 64 + k] * in[21][k * 64 + h];
            h2s[tt * 64 + h] = __sinf(in[23][h] * a); }
        __syncthreads();
    }
    f32x4 acc[16];
#pragma unroll
    for (int t = 0; t < 16; ++t) acc[t] = (f32x4){0.f, 0.f, 0.f, 0.f};
    const int o = 4 * f_tid;
    for (int k0 = 0; k0 < 64; k0 += 4) { f32x4 w[4];
#pragma unroll
        for (int q = 0; q < 4; ++q) w[q] = *(const f32x4*)(in[24] + (size_t)(k0 + q) * 2048 + o);
#pragma unroll
        for (int t = 0; t < 16; ++t) { const f32x4 hv = *(const LAS f32x4*)(h2s + t * 64 + k0); acc[t] += w[0] * hv[0] + w[1] * hv[1] + w[2] * hv[2] + w[3] * hv[3]; } }
    const int c0 = o & 511, od = o >> 9;
    float* dst = WSP(float, WS_FILT) + ((size_t)od * 512 + c0) * SEQ + t0;
#pragma unroll
    for (int e = 0; e < 4; ++e) { const float la = -3.0701134573253944f, lb = -15.350567286626972f; const float delta = fabsf(la + (float)(c0 + e) * ((lb - la) / 511.f));
#pragma unroll
        for (int q = 0; q < 4; ++q) { f32x4 v;
#pragma unroll
            for (int i = 0; i < 4; ++i) { const int t = 4 * q + i; const float tn = (float)(t0 + t) * (1.f / SEQ); v[i] = acc[t][e] * __expf(-tn * delta); }
            *(f32x4*)(dst + (size_t)e * SEQ + 4 * q) = v; } }
    __syncthreads();
#undef in
}

__device__ __forceinline__ float silu_f(float v) { return v / (1.f + __expf(-v)); }

__device__ __forceinline__ void p0_prologue(Frame& F) {
    FT_DECL;
#define in F.in
    const int wg = blockIdx.x;
    if (wg < 96) {
        LAS float* sv = (LAS float*)F.lds;
        for (int i = f_tid; i < 9 * 1024; i += 512) { const int r = i >> 10, k = i & 1023; const float c = (r < 8) ? in[1][r * 1024 + k] : in[3][k]; sv[i] = silu_f(c); }
        __syncthreads();
        const int j = wg * 64 + f_lane; const float* wm = in[4];
        float acc[9];
#pragma unroll
        for (int r = 0; r < 9; ++r) acc[r] = 0.f;
        const int kbeg = F.wave * 128;
        for (int k0 = kbeg; k0 < kbeg + 128; k0 += 16) { float w[16];
#pragma unroll
            for (int q = 0; q < 16; ++q) w[q] = __builtin_nontemporal_load(wm + (size_t)(k0 + q) * (NMOD * DM) + j);
#pragma unroll
            for (int q = 0; q < 16; ++q)
#pragma unroll
                for (int r = 0; r < 9; ++r) acc[r] += sv[r * 1024 + k0 + q] * w[q]; }
        LAS float* red = (LAS float*)(F.lds + 40960);
#pragma unroll
        for (int r = 0; r < 9; ++r) red[(F.wave * 9 + r) * 64 + f_lane] = acc[r];
        __syncthreads();
        for (int i = f_tid; i < 9 * 64; i += 512) { const int r = i >> 6, l = i & 63; float s = in[5][wg * 64 + l];
#pragma unroll
            for (int w = 0; w < 8; ++w) s += red[(w * 9 + r) * 64 + l];
            WSP(float, WS_SMALL + SM_MOD)[r * (NMOD * DM) + wg * 64 + l] = s; }
        __syncthreads();
    } else if (wg == 96) {
        if (F.wave == 0) {
            const float a = wave_sum(in[11][f_lane] * in[12][f_lane]), b = wave_sum(in[13][f_lane] * in[14][f_lane]);
            float gq = fabsf(in[9][f_lane]), gk = fabsf(in[10][f_lane]);
#pragma unroll
            for (int o = 1; o < 64; o <<= 1) { gq = fmaxf(gq, __shfl_xor(gq, o)); gk = fmaxf(gk, __shfl_xor(gk, o)); }
            if (f_lane == 0) { float* sc = WSP(float, WS_SMALL + SM_SCAL); sc[0] = expf(a) - expf(b) + LAM_INIT;
                sc[1] = (8.f * gq * gk * 1.02f + 0.05f) * 1.4426950408889634f; }
        }
        for (int i = f_tid; i < 64 * 16; i += 512) { const int pos = i >> 4, f = i & 15;
            const float inv = powf(10000.f, -(float)f / 16.f); const float ang = (float)pos * inv;
            float* rt = WSP(float, WS_SMALL + SM_ROPE); rt[2 * i] = cosf(ang); rt[2 * i + 1] = sinf(ang); }
    }
    __syncthreads();
    for (int it = wg; it < SEQ / 16; it += F.G) p0_filter_item(F, it);
    __syncthreads();
    {
        LAS float* scr = (LAS float*)(F.lds + F.wave * 16896);
        const int gw = F.vcu * NWAVES + F.wave, NGW = F.G * NWAVES;
        constexpr int I_IN = (DM / 64) * (INC / 32), I_OUT = (DM / 64) * (DM / 32), I_1 = (DM / 128) * (2 * DM / 32), I_2 = (DM / 128) * (DM / 32);
        constexpr int NITEMS = I_IN + I_OUT + NEXP * (I_1 + I_2);
        for (int it = gw; it < NITEMS; it += NGW) {
            int r = it;
            if (r < I_IN) { p0_transpose_item(in[8], DM, INC, WSP(bf16_t, WS_WIN), MapWin{}, nullptr, scr, r, f_lane); continue; } r -= I_IN;
            if (r < I_OUT) { p0_transpose_item(in[27], DM, DM, WSP(bf16_t, WS_WOUT), MapIdent{0}, nullptr, scr, r, f_lane, true); continue; } r -= I_OUT;
            const int e = r / (I_1 + I_2); r -= e * (I_1 + I_2);
            if (r < I_1) p0_transpose_item_f8(in[30] + (size_t)e * DM * 2 * DM, DM, 2 * DM, WSP(unsigned char, WS_W1) + (size_t)e * 2 * DM * DM, MapW1{0}, scr, r, f_lane);
            else p0_transpose_item_f8(in[32] + (size_t)e * DM * DM, DM, DM, WSP(unsigned char, WS_W2) + (size_t)e * DM * DM, MapW2{}, scr, r - I_1, f_lane);
        }
    }
}
#undef in

__device__ __forceinline__ void p1_norm1(Frame& F) {
    FT_DECL;
    const int gw = F.vcu * NWAVES + F.wave, NGW = F.G * NWAVES;
    const float* mod = WSP(float, WS_SMALL + SM_MOD); const float* g1 = F.in[6];
    bf16_t* H = WSP(bf16_t, WS_H);
    for (int pe = blockIdx.x; pe < NB * NEXP; pe += F.G) { const int b = pe >> 5, e = pe & 31; const float* sh2 = mod + (size_t)b * (NMOD * DM) + 3 * DM; const float* rw = F.in[28];
        const int t = F.wave * 64 + lane_id();
        float a = sh2[t] * rw[(size_t)t * 32 + e] + sh2[t + 512] * rw[(size_t)(t + 512) * 32 + e];
        a = wave_sum(a);
        LAS float* red = (LAS float*)F.lds;
        __syncthreads(); if (lane_id() == 0) red[F.wave] = a; __syncthreads();
        if (t == 0) { float sacc = F.in[29][e];
#pragma unroll
            for (int w = 0; w < NWAVES; ++w) sacc += red[w];
            WSP(float, WS_SMALL + SM_RBIAS)[pe] = sacc; }
        __syncthreads(); }
    constexpr int RPW = MTOT / (256 * NWAVES);
    for (int run = gw; run * RPW < MTOT; run += NGW) {
        const int r0 = run * RPW, r1 = (r0 + RPW < MTOT) ? r0 + RPW : MTOT;
        int curb = -1; f32x4 PA[4], PB[4];
        for (int m0 = r0; m0 < r1; m0 += 4) {
            f32x4 v[4][4];
#pragma unroll
            for (int u = 0; u < 4; ++u) { const int m = m0 + u; if (m < r1) {
                const float* xrow = (m < MROWS) ? F.in[0] + (size_t)m * DM : F.in[2] + (size_t)(m - MROWS) * DM; const GAS f32x4* xr = (const GAS f32x4*)xrow + f_lane;
#pragma unroll
                for (int j = 0; j < 4; ++j) v[u][j] = __builtin_nontemporal_load(xr + 64 * j); } }
#pragma unroll
            for (int u = 0; u < 4; ++u) { const int m = m0 + u; if (m < r1) {
                const int mb = (m < MROWS) ? (m >> 12) : 8;
                if (mb != curb) { curb = mb; const float* sh = mod + (size_t)mb * (NMOD * DM); const float* sc = sh + DM;
#pragma unroll
                    for (int j = 0; j < 4; ++j) { const int c = 4 * f_lane + 256 * j; PA[j] = *(const f32x4*)(g1 + c) * (*(const f32x4*)(sc + c) + 1.f); PB[j] = *(const f32x4*)(sh + c); } }
                float s = 0.f;
#pragma unroll
                for (int j = 0; j < 4; ++j) s += (v[u][j].x * v[u][j].x + v[u][j].y * v[u][j].y) + (v[u][j].z * v[u][j].z + v[u][j].w * v[u][j].w);
                const float rstd = rsqrtf(wave_sum(s) * (1.f / DM) + EPS);
                GAS u32x2* o8 = (GAS u32x2*)(H + (size_t)m * DM) + f_lane;
#pragma unroll
                for (int j = 0; j < 4; ++j) { const f32x4 y = v[u][j] * rstd * PA[j] + PB[j];
                    u32x2 w; w.x = cvt_pk_bf16(y.x, y.y); w.y = cvt_pk_bf16(y.z, y.w); o8[64 * j] = w; } } }
        }
    }
}

struct SchedInProj {
    int G, c; const char* H; const char* W;
    static constexpr int NA = 136 * 4, NV = 2 * 136, NBU = 6 * 128;
    __device__ __forceinline__ bool next(int i, g8::Unit& u) const {
        const long L = (long)i * G + c;
        if (L < NA) { g8::tile_of((int)L, 136, 4, u.pm, u.pn); u.a = H + (size_t)u.pm * 256 * DM * 2; u.b = W + (size_t)u.pn * 256 * DM * 2; u.kind = 0; u.ex = 0; return true; }
        if (L < NA + NV) { g8::tile_of((int)L - NA, 2, 136, u.pm, u.pn); u.a = W + (size_t)(1024 + u.pm * 256) * DM * 2; u.b = H + (size_t)u.pn * 256 * DM * 2; u.kind = 2; u.ex = 0; return true; }
        if (L < NA + NV + NBU) { g8::tile_of((int)L - NA - NV, 6, 128, u.pm, u.pn); u.a = W + (size_t)(QKVC + u.pm * 256) * DM * 2; u.b = H + (size_t)u.pn * 256 * DM * 2; u.kind = 1; u.ex = 0; return true; }
        return false;
    }
};
constexpr float Q8SCALE = 16.f;
struct EpiInProj {
    unsigned char *Q8, *K8, *VT8; bf16_t* UT; const float *gq, *gk, *rope;
    __device__ __forceinline__ void operator()(f32x4 (&acc)[2][2][4][2], const g8::Unit& u, int wr, int wc, int fr, int fq) const {
        asm volatile("" : "+v"(fr), "+v"(fq));
        if (u.kind == 1) {
            const int row0 = u.pm * 256 + wr * 64 + fr, col0 = u.pn * 256 + wc * 32 + 8 * fq;
#pragma unroll
            for (int ai = 0; ai < 2; ++ai)
#pragma unroll
                for (int m = 0; m < 4; ++m) { const int ch = row0 + ai * 128 + m * 16;
#pragma unroll
                    for (int bj = 0; bj < 2; ++bj) { const int tok = col0 + bj * 128; const f32x4 v0 = acc[ai][bj][m][0], v1 = acc[ai][bj][m][1];
                        u32x4 w; w.x = cvt_pk_bf16(v0[0], v0[1]); w.y = cvt_pk_bf16(v0[2], v0[3]); w.z = cvt_pk_bf16(v1[0], v1[1]); w.w = cvt_pk_bf16(v1[2], v1[3]);
                        *(u32x4*)(UT + ((size_t)(tok >> 7) * HYC + ch) * 128 + (tok & 127)) = w; } }
            return;
        }
        if (u.kind == 2) {
#pragma unroll
            for (int bj = 0; bj < 2; ++bj) { const int t8 = u.pn * 256 + bj * 128 + wc * 32 + 8 * fq;
                int b, key; if (t8 < MROWS) { b = t8 >> 12; key = CTXL + (t8 & 4095); } else { const int j = t8 - MROWS; b = j >> 8; key = j & 255; }
                const int tile = key >> 6, k = key & 63, ipos = (k < 32) ? 4 * (k >> 3) : 16 + 4 * ((k - 32) >> 3);
#pragma unroll
                for (int ai = 0; ai < 2; ++ai)
#pragma unroll
                    for (int m = 0; m < 4; ++m) { const int ch = u.pm * 256 + ai * 128 + wr * 64 + m * 16 + fr;
                        unsigned char* dst = VT8 + ((((size_t)(b * NHEAD + (ch >> 7)) * 68 + tile) * 128 + (ch & 127)) * 64) + ipos;
                        const f32x4 v0 = acc[ai][bj][m][0], v1 = acc[ai][bj][m][1];
                        *(unsigned*)dst = pk4_fp8(v0[0], v0[1], v0[2], v0[3]); *(unsigned*)(dst + 32) = pk4_fp8(v1[0], v1[1], v1[2], v1[3]); } }
            return;
        }
        const int blk = fq >> 1, f = fq & 1;
        const int sec = u.pn >> 1;
        const bool ctx = (u.pm >= 128);
        if (sec == 0 && ctx) return;
        const int colbase = (u.pn & 1) * 256 + wc * 64 + 32 * blk + 8 * f;
        float gg[2][2][4];
        { const float* gp = (sec == 0 ? gq : gk) + 32 * blk + 8 * f;
#pragma unroll
            for (int bj = 0; bj < 2; ++bj)
#pragma unroll
                for (int n = 0; n < 2; ++n) { const f32x4 t = *(const f32x4*)(gp + 16 * bj + 4 * n); gg[bj][n][0] = t[0]; gg[bj][n][1] = t[1]; gg[bj][n][2] = t[2]; gg[bj][n][3] = t[3]; } }
#pragma unroll
        for (int ai = 0; ai < 2; ++ai)
#pragma unroll
            for (int m = 0; m < 4; ++m) {
                const int rloc = ai * 128 + wr * 64 + m * 16 + fr; const int r = u.pm * 256 + rloc;
                f32x4 v[2][2];
#pragma unroll
                for (int bj = 0; bj < 2; ++bj)
#pragma unroll
                    for (int n = 0; n < 2; ++n) v[bj][n] = acc[ai][bj][m][n];
                size_t orow;
                if (sec == 0) orow = (size_t)r;
                else if (!ctx) orow = (size_t)(r >> 12) * KVL + CTXL + (r & 4095);
                else { const int j = r - MROWS; orow = (size_t)(j >> 8) * KVL + (j & 255); }
                float ss = 0.f;
#pragma unroll
                for (int bj = 0; bj < 2; ++bj)
#pragma unroll
                    for (int n = 0; n < 2; ++n) ss += (v[bj][n][0] * v[bj][n][0] + v[bj][n][1] * v[bj][n][1]) + (v[bj][n][2] * v[bj][n][2] + v[bj][n][3] * v[bj][n][3]);
                ss += __shfl_xor(ss, 16); ss += __shfl_xor(ss, 32);
                const float rstd = rsqrtf(ss * (1.f / 64.f) + EPS) * (sec == 0 ? QSCALE * Q8SCALE : 1.f);
#pragma unroll
                for (int bj = 0; bj < 2; ++bj)
#pragma unroll
                    for (int n = 0; n < 2; ++n)
#pragma unroll
                        for (int e = 0; e < 4; ++e) v[bj][n][e] *= rstd * gg[bj][n][e];
                if (!ctx) {
                    const int t = r & 4095; const int pos = blk ? (t & 63) : (t >> 6);
                    const float* rp = rope + (size_t)(pos * 16 + 8 * f) * 2;
#pragma unroll
                    for (int n = 0; n < 2; ++n) { const f32x4 c0 = *(const f32x4*)(rp + 8 * n), c1 = *(const f32x4*)(rp + 8 * n + 4);
                        const float cs[4] = {c0[0], c0[2], c1[0], c1[2]}, sn[4] = {c0[1], c0[3], c1[1], c1[3]};
#pragma unroll
                        for (int e = 0; e < 4; ++e) { const float x1 = v[0][n][e], x2 = v[1][n][e]; v[0][n][e] = x1 * cs[e] - x2 * sn[e]; v[1][n][e] = x2 * cs[e] + x1 * sn[e]; } }
                }
                unsigned char* dst = (sec == 0 ? Q8 : K8) + orow * QKW + colbase;
#pragma unroll
                for (int bj = 0; bj < 2; ++bj) { u32x2 w; w.x = pk4_fp8(v[bj][0][0], v[bj][0][1], v[bj][0][2], v[bj][0][3]); w.y = pk4_fp8(v[bj][1][0], v[bj][1][1], v[bj][1][2], v[bj][1][3]);
                    *(u32x2*)(dst + 16 * bj) = w; }
            }
    }
};

struct SchedStatic {
    int G, c, nM, nN; const char* A; const char* B;
    __device__ __forceinline__ bool next(int i, g8::Unit& u) const {
        const long L = (long)i * G + c; if (L >= (long)nM * nN) return false;
        g8::tile_of((int)L, nM, nN, u.pm, u.pn); u.a = A + (size_t)u.pm * 256 * DM * 2; u.b = B + (size_t)u.pn * 256 * DM * 2; u.kind = 0; u.ex = 0; return true;
    }
};
struct EpiOutProj {
    const float* x; bf16_t* out; const float* mod;
    __device__ __forceinline__ void operator()(f32x4 (&acc)[2][2][4][2], const g8::Unit& u, int wr, int wc, int fr, int fq) const {
        asm volatile("" : "+v"(fr), "+v"(fq));
        const int col0 = u.pn * 256 + wc * 32 + 8 * fq;
        const float* g1 = mod + (size_t)((u.pm * 256) >> 12) * (NMOD * DM) + 2 * DM + col0;
        f32x4 gv[2][2];
#pragma unroll
        for (int bj = 0; bj < 2; ++bj)
#pragma unroll
            for (int n = 0; n < 2; ++n) gv[bj][n] = *(const f32x4*)(g1 + bj * 128 + 4 * n);
#pragma unroll
        for (int ai = 0; ai < 2; ++ai)
#pragma unroll
            for (int m = 0; m < 4; ++m) { const int r = u.pm * 256 + ai * 128 + wr * 64 + m * 16 + fr;
                const size_t off = (size_t)r * DM + col0;
#pragma unroll
                for (int bj = 0; bj < 2; ++bj) { f32x4 o[2];
#pragma unroll
                    for (int n = 0; n < 2; ++n) { const f32x4 xv = __builtin_nontemporal_load((const f32x4*)(x + off + bj * 128 + 4 * n)); o[n] = xv + gv[bj][n] * acc[ai][bj][m][n]; }
                    u32x4 w; w.x = cvt_pk_bf16(o[0][0], o[0][1]); w.y = cvt_pk_bf16(o[0][2], o[0][3]); w.z = cvt_pk_bf16(o[1][0], o[1][1]); w.w = cvt_pk_bf16(o[1][2], o[1][3]);
                    *(u32x4*)(out + off + bj * 128) = w; } }
    }
};

namespace att8 {
constexpr int NT = KVL / 64, SHMB = 8192, NBUF = 6, LDS_V0 = NBUF * SHMB;
typedef int i32x8 __attribute__((ext_vector_type(8)));
#define SBAR() __builtin_amdgcn_sched_barrier(0)
__device__ __forceinline__ int crow(int r, int hi) { return (r & 3) + 8 * (r >> 2) + 4 * hi; }
__device__ __forceinline__ i32x8 ld32(const LAS unsigned char* p0, const LAS unsigned char* p1) {
    const u32x4 a = *(const LAS u32x4*)p0, b = *(const LAS u32x4*)p1; return (i32x8){(int)a.x, (int)a.y, (int)a.z, (int)a.w, (int)b.x, (int)b.y, (int)b.z, (int)b.w}; }
__device__ __forceinline__ void mfma_qk(f32x16& p, const i32x8& kf, const i32x8& qf, const f32x16& negc) {
    const unsigned s1 = 0x7f7f7f7fu, sq = 0x7b7b7b7bu;
    asm volatile("v_mfma_scale_f32_32x32x64_f8f6f4 %0, %1, %2, %3, %4, %5 op_sel_hi:[0,0,0]" : "=&v"(p) : "v"(kf), "v"(qf), "v"(negc), "v"(s1), "v"(sq));
}
__device__ __forceinline__ void mfma_pv(f32x16& o, const i32x8& pa, const i32x8& vf) {
    const unsigned s1 = 0x7f7f7f7fu;
    asm volatile("v_mfma_scale_f32_32x32x64_f8f6f4 %0, %1, %2, %0, %3, %3 op_sel_hi:[0,0,0]" : "+v"(o) : "v"(pa), "v"(vf), "v"(s1));
}
__device__ __forceinline__ void mfma_wait(f32x16& p0, f32x16& p1) { asm volatile("s_nop 15\n\ts_nop 3" : "+v"(p0), "+v"(p1)); }
__device__ __forceinline__ int grp(const f32x16& s, const int g, int old) {
    old = __builtin_amdgcn_cvt_pk_fp8_f32(__builtin_amdgcn_exp2f(s[4 * g]), __builtin_amdgcn_exp2f(s[4 * g + 1]), old, false);
    return __builtin_amdgcn_cvt_pk_fp8_f32(__builtin_amdgcn_exp2f(s[4 * g + 2]), __builtin_amdgcn_exp2f(s[4 * g + 3]), old, true);
}
__device__ __forceinline__ void attn_unit(const unsigned char* __restrict__ Qb, const unsigned char* __restrict__ Kh, const unsigned char* __restrict__ VTh, bf16_t* MIXo,
                                          const float lam, const float* __restrict__ subg, char* lds, const int wid) {
    const int lane = lane_id(), tid = wid * 64 + lane, r32 = lane & 31, hi = lane >> 5;
    const int sub = wid >> 2, wq = wid & 3;
    const LAS unsigned char* L = (const LAS unsigned char*)(uintptr_t)(unsigned)(uintptr_t)lds;
    f32x16 o[4] = {}; f32x16 ol = {};
    i32x8 ones; { int c1 = 0x38383838; asm volatile("" : "+v"(c1)); ones = (i32x8){c1, c1, c1, c1, c1, c1, c1, c1}; }
    i32x8 qf; { const unsigned char* qp = Qb + (size_t)(wq * 32 + r32) * QKW + sub * 64 + 32 * hi; const u32x4 a = *(const u32x4*)qp, b = *(const u32x4*)(qp + 16);
        qf = (i32x8){(int)a.x, (int)a.y, (int)a.z, (int)a.w, (int)b.x, (int)b.y, (int)b.z, (int)b.w}; }
    f32x16 negc; { float m5 = -5.f; asm volatile("" : "+v"(m5));
#pragma unroll
        for (int r = 0; r < 16; ++r) negc[r] = m5; }
    long ksrc, vsrc;
    { const int r = 8 * wid + (lane >> 3), c = (lane & 7) ^ ((r >> 1) & 7); ksrc = (long)r * QKW + c * 16; }
    { const int d = 16 * wid + (lane >> 2), c = (lane & 3) ^ ((d >> 2) & 3); vsrc = (long)d * 64 + c * 16; }
    const unsigned ldsb = (unsigned)(uintptr_t)lds, kdst = ldsb + (unsigned)wid * 1024u, vdst = ldsb + LDS_V0 + (unsigned)wid * 1024u;
    const LAS unsigned char *pk0, *pk1, *pv0, *pv1;
    { const int c0 = sub * 4 + hi * 2, sk = (r32 >> 1) & 7, sv = (r32 >> 2) & 3;
      pk0 = L + r32 * 128 + ((c0 ^ sk) << 4); pk1 = L + r32 * 128 + (((c0 + 1) ^ sk) << 4);
      pv0 = L + LDS_V0 + r32 * 64 + (((2 * hi) ^ sv) << 4); pv1 = L + LDS_V0 + r32 * 64 + (((2 * hi + 1) ^ sv) << 4); }
#define KF(b, w) ld32(pk0 + (b) * SHMB + (w) * 4096, pk1 + (b) * SHMB + (w) * 4096)
#define VF(b, d0) ld32(pv0 + (b) * SHMB + (d0) * 2048, pv1 + (b) * SHMB + (d0) * 2048)
#define DMA_TILE(t, b) do { \
        __builtin_amdgcn_global_load_lds((const unsigned*)(Kh + (long)(t) * 64 * QKW + ksrc), (LAS unsigned*)(uintptr_t)__builtin_amdgcn_readfirstlane(kdst + (unsigned)((b) * SHMB)), 16, 0, 0); \
        __builtin_amdgcn_global_load_lds((const unsigned*)(VTh + (long)(t) * 8192 + vsrc), (LAS unsigned*)(uintptr_t)__builtin_amdgcn_readfirstlane(vdst + (unsigned)((b) * SHMB)), 16, 0, 0); } while (0)
#define WBAR() do { asm volatile("s_waitcnt vmcnt(0)" ::: "memory"); __builtin_amdgcn_s_barrier(); asm volatile("" ::: "memory"); } while (0)
#define ITER(J, U, SX0, SX1, SY0, SY1, PC, PN, DO_DMA, DO_QK, DO_BAR) do { \
        mfma_pv(ol, PC, ones); SBAR(); \
        if (DO_DMA) { if ((J) + 3 < NT) DMA_TILE((J) + 3, ((U) + 4) % NBUF); if ((J) + 4 < NT) DMA_TILE((J) + 4, ((U) + 5) % NBUF); } \
        PN[0] = grp(SX0, 0, PN[0]); SBAR(); \
        mfma_pv(o[0], PC, vf0); SBAR(); \
        vf3 = VF(U, 3); if (DO_QK) { kf0 = KF(((U) + 2) % NBUF, 0); kf1 = KF(((U) + 2) % NBUF, 1); } \
        PN[1] = grp(SX0, 1, PN[1]); SBAR(); \
        mfma_pv(o[1], PC, vf1); SBAR(); PN[2] = grp(SX0, 2, PN[2]); SBAR(); \
        mfma_pv(o[2], PC, vf2); SBAR(); PN[3] = grp(SX0, 3, PN[3]); SBAR(); \
        mfma_pv(o[3], PC, vf3); SBAR(); PN[4] = grp(SX1, 0, PN[4]); SBAR(); \
        if (DO_QK) mfma_qk(SY0, kf0, qf, negc); SBAR(); PN[5] = grp(SX1, 1, PN[5]); SBAR(); \
        if (DO_QK) mfma_qk(SY1, kf1, qf, negc); SBAR(); PN[6] = grp(SX1, 2, PN[6]); PN[7] = grp(SX1, 3, PN[7]); \
        vf0 = VF(((U) + 1) % NBUF, 0); vf1 = VF(((U) + 1) % NBUF, 1); vf2 = VF(((U) + 1) % NBUF, 2); SBAR(); \
        if (DO_BAR) WBAR(); } while (0)
    f32x16 A0, A1, B0, B1; i32x8 paA = {}, paB = {}, kf0, kf1, vf0, vf1, vf2, vf3;
    DMA_TILE(0, 0); DMA_TILE(1, 1); DMA_TILE(2, 2); DMA_TILE(3, 3); WBAR();
    kf0 = KF(0, 0); kf1 = KF(0, 1); mfma_qk(A0, kf0, qf, negc); mfma_qk(A1, kf1, qf, negc);
    kf0 = KF(1, 0); kf1 = KF(1, 1); SBAR(); mfma_qk(B0, kf0, qf, negc); mfma_qk(B1, kf1, qf, negc);
    mfma_wait(A0, A1);
#pragma unroll
    for (int g = 0; g < 4; ++g) { paA[g] = grp(A0, g, paA[g]); paA[4 + g] = grp(A1, g, paA[4 + g]); }
    mfma_wait(B0, B1);
    vf0 = VF(0, 0); vf1 = VF(0, 1); vf2 = VF(0, 2); SBAR();
    static_assert(NT == 68, "the loop below (11 trips of 6 iterations, then iteration 67) is written for 68 KV tiles");
#pragma unroll 1
    for (int j = 1; j < NT - 2; j += 6) {
        ITER(j, 0, B0, B1, A0, A1, paA, paB, true, true, false);
        ITER(j + 1, 1, A0, A1, B0, B1, paB, paA, false, true, true);
        ITER(j + 2, 2, B0, B1, A0, A1, paA, paB, true, true, false);
        ITER(j + 3, 3, A0, A1, B0, B1, paB, paA, false, true, true);
        ITER(j + 4, 4, B0, B1, A0, A1, paA, paB, true, true, false);
        ITER(j + 5, 5, A0, A1, B0, B1, paB, paA, false, true, true);
    }
    ITER(67, 0, B0, B1, A0, A1, paA, paB, false, false, false);
    mfma_pv(ol, paB, ones); vf3 = VF(1, 3); SBAR();
    mfma_pv(o[0], paB, vf0); mfma_pv(o[1], paB, vf1); mfma_pv(o[2], paB, vf2); mfma_pv(o[3], paB, vf3);
    asm volatile("s_nop 15\n\ts_nop 3" : "+v"(o[0]), "+v"(o[1]), "+v"(o[2]), "+v"(o[3]), "+v"(ol));
#undef ITER
#undef KF
#undef VF
#undef DMA_TILE
#undef WBAR
    __syncthreads();
    float* X = (float*)lds;
    float rli[16];
#pragma unroll
    for (int r = 0; r < 16; ++r) rli[r] = __builtin_amdgcn_rcpf(ol[r]);
    if (sub == 1) {
#pragma unroll
        for (int r = 0; r < 16; ++r) { const int row = wq * 32 + crow(r, hi); const float sc = lam * rli[r];
#pragma unroll
            for (int d0 = 0; d0 < 4; ++d0) X[row * 128 + d0 * 32 + r32] = o[d0][r] * sc; }
    }
    __syncthreads();
    bf16_t* Y = (bf16_t*)(lds + 65536);
    if (sub == 0) {
        float sg[4];
#pragma unroll
        for (int d0 = 0; d0 < 4; ++d0) sg[d0] = subg[d0 * 32 + r32] * (1.f - LAM_INIT);
#pragma unroll
        for (int r = 0; r < 16; ++r) { const int row = wq * 32 + crow(r, hi);
            float v[4]; float ss = 0.f;
#pragma unroll
            for (int d0 = 0; d0 < 4; ++d0) { v[d0] = o[d0][r] * rli[r] - X[row * 128 + d0 * 32 + r32]; ss += v[d0] * v[d0]; }
            ss += __shfl_xor(ss, 1); ss += __shfl_xor(ss, 2); ss += __shfl_xor(ss, 4); ss += __shfl_xor(ss, 8); ss += __shfl_xor(ss, 16);
            const float rstd = rsqrtf(ss * (1.f / 128.f) + EPS);
#pragma unroll
            for (int d0 = 0; d0 < 4; ++d0) Y[row * 128 + d0 * 32 + r32] = (bf16_t)(cvt_pk_bf16(v[d0] * rstd * sg[d0], 0.f) & 0xffffu); }
    }
    __syncthreads();
    { const int row = tid >> 2, seg = (tid & 3) * 32;
#pragma unroll
        for (int i = 0; i < 4; ++i) { const u32x4 v = *(const u32x4*)(Y + row * 128 + seg + i * 8); *(u32x4*)(MIXo + (size_t)row * DM + seg + i * 8) = v; } }
    __syncthreads();
}
#undef SBAR
}

__device__ __forceinline__ void p3_attention8(Frame& F) {
    FT_DECL;
    const float* sc = WSP(float, WS_SMALL + SM_SCAL);
    const float lam = sc[0];
    const unsigned char* Q8 = WSP(unsigned char, WS_Q); const unsigned char* K8 = WSP(unsigned char, WS_K); const unsigned char* VT8 = WSP(unsigned char, WS_V); bf16_t* MIX = WSP(bf16_t, WS_MIX);
    const int c = blockIdx.x, xcd = c & 7, ci = c >> 3, per = F.G >> 3;
    for (int j = ci; j < 128; j += per) {
        const int pair = xcd * 4 + (j >> 5), qb = j & 31, b = pair >> 2, h = pair & 3;
        att8::attn_unit(Q8 + ((size_t)b * SEQ + qb * 128) * QKW + h * 128, K8 + (size_t)b * KVL * QKW + h * 128, VT8 + (size_t)(b * NHEAD + h) * 68 * 8192,
                        MIX + ((size_t)b * SEQ + qb * 128) * DM + h * 128, lam, F.in[15], (char*)F.lds, F.wave);
    }
}

namespace hy {
constexpr int RB_BYTES = 4352 * 8, IN_OFF = 2 * RB_BYTES, TW1_OFF = IN_OFF + 32768, TW2_OFF = TW1_OFF + 15 * 256 * 8, LDS_END = TW2_OFF + 15 * 16 * 8;
__device__ __forceinline__ f32x2 cmul(f32x2 a, f32x2 b) { return (f32x2){a.x * b.x - a.y * b.y, a.x * b.y + a.y * b.x}; }
__device__ __forceinline__ f32x2 cmulc(f32x2 a, f32x2 b) { return (f32x2){a.x * b.x + a.y * b.y, a.y * b.x - a.x * b.y}; }
__device__ __forceinline__ int P(int i) { return i + (i >> 4); }
template <bool INV> __device__ __forceinline__ void r4(f32x2& a, f32x2& b, f32x2& c, f32x2& d) {
    const f32x2 t0 = a + c, t1 = a - c, t2 = b + d, t3 = b - d;
    const f32x2 st3 = INV ? (f32x2){-t3.y, t3.x} : (f32x2){t3.y, -t3.x};
    a = t0 + t2; c = t0 - t2; b = t1 + st3; d = t1 - st3;
}
template <bool INV> __device__ __forceinline__ f32x2 tw(f32x2 v, float c, float s) {
    return INV ? (f32x2){v.x * c - v.y * s, v.y * c + v.x * s} : (f32x2){v.x * c + v.y * s, v.y * c - v.x * s};
}
template <bool INV> __device__ __forceinline__ void dft16(f32x2 (&v)[16]) {
    constexpr float C1 = 0.9238795325112867f, S1 = 0.3826834323650898f, R2 = 0.7071067811865476f;
    r4<INV>(v[0], v[4], v[8], v[12]); r4<INV>(v[1], v[5], v[9], v[13]); r4<INV>(v[2], v[6], v[10], v[14]); r4<INV>(v[3], v[7], v[11], v[15]);
    v[5] = tw<INV>(v[5], C1, S1);  v[9] = tw<INV>(v[9], R2, R2);    v[13] = tw<INV>(v[13], S1, C1);
    v[6] = tw<INV>(v[6], R2, R2);  v[10] = tw<INV>(v[10], 0.f, 1.f); v[14] = tw<INV>(v[14], -R2, R2);
    v[7] = tw<INV>(v[7], S1, C1);  v[11] = tw<INV>(v[11], -R2, R2);  v[15] = tw<INV>(v[15], -C1, -S1);
    r4<INV>(v[0], v[1], v[2], v[3]); r4<INV>(v[4], v[5], v[6], v[7]); r4<INV>(v[8], v[9], v[10], v[11]); r4<INV>(v[12], v[13], v[14], v[15]);
    f32x2 t;
    t = v[1]; v[1] = v[4]; v[4] = t;   t = v[2]; v[2] = v[8]; v[8] = t;    t = v[3]; v[3] = v[12]; v[12] = t;
    t = v[6]; v[6] = v[9]; v[9] = t;   t = v[7]; v[7] = v[13]; v[13] = t;  t = v[11]; v[11] = v[14]; v[14] = t;
}
struct Ctx { LAS f32x2* R; LAS f32x2* IN; LAS f32x2* TW1; LAS f32x2* TW2; int t, half; f32x2 wt; };
#define HY_OPAQUE(x) asm volatile("" : "+v"(x))
#define HY_W32(m) (f32x2){__builtin_cosf(-0.19634954084936207f * (m)), __builtin_sinf(-0.19634954084936207f * (m))}
template <int MODE> __device__ __forceinline__ void pass1_fwd(const Ctx& X) {
    f32x2 v[16]; int t = X.t; HY_OPAQUE(t);
#pragma unroll
    for (int m = 0; m < 16; ++m) { f32x2 a = X.IN[t + 256 * m]; if (MODE == 1) a = (f32x2){X.half ? a.y : a.x, 0.f}; v[m] = a; }
    if (X.half) {
#pragma unroll
        for (int m = 0; m < 16; ++m) v[m] = cmul(cmul(v[m], HY_W32(m)), X.wt);
    }
    dft16<false>(v);
#pragma unroll
    for (int q = 1; q < 16; ++q) v[q] = cmul(v[q], X.TW1[(q - 1) * 256 + t]);
    const int pb = t + (t >> 4);
#pragma unroll
    for (int q = 0; q < 16; ++q) X.R[pb + 272 * q] = v[q];
}
__device__ __forceinline__ void pass2_fwd(const Ctx& X) {
    int t = X.t; HY_OPAQUE(t);
    const int n2 = t & 15, pb = (t >> 4) * 272 + n2; f32x2 v[16];
#pragma unroll
    for (int m = 0; m < 16; ++m) v[m] = X.R[pb + 17 * m];
    dft16<false>(v);
#pragma unroll
    for (int q = 1; q < 16; ++q) v[q] = cmul(v[q], X.TW2[(q - 1) * 16 + n2]);
#pragma unroll
    for (int q = 0; q < 16; ++q) X.R[pb + 17 * q] = v[q];
}
template <bool FILTER> __device__ __forceinline__ void pass3(const Ctx& X, f32x2 (&H)[16]) {
    f32x2 v[16]; int t = X.t; HY_OPAQUE(t); const int pb = 17 * t;
#pragma unroll
    for (int m = 0; m < 16; ++m) v[m] = X.R[pb + m];
    dft16<false>(v);
    if (FILTER) {
#pragma unroll
        for (int q = 0; q < 16; ++q) H[q] = v[q] * (1.f / 8192.f);
    } else {
#pragma unroll
        for (int q = 0; q < 16; ++q) v[q] = cmul(v[q], H[q]);
        dft16<true>(v);
#pragma unroll
        for (int m = 0; m < 16; ++m) X.R[pb + m] = v[m];
    }
}
__device__ __forceinline__ void pass2_inv(const Ctx& X) {
    int t = X.t; HY_OPAQUE(t);
    const int n2 = t & 15, pb = (t >> 4) * 272 + n2; f32x2 v[16];
    v[0] = X.R[pb];
#pragma unroll
    for (int q = 1; q < 16; ++q) v[q] = cmulc(X.R[pb + 17 * q], X.TW2[(q - 1) * 16 + n2]);
    dft16<true>(v);
#pragma unroll
    for (int m = 0; m < 16; ++m) X.R[pb + 17 * m] = v[m];
}
__device__ __forceinline__ void pass1_inv(const Ctx& X) {
    f32x2 v[16]; int t = X.t; HY_OPAQUE(t); const int pb = t + (t >> 4);
    v[0] = X.R[pb];
#pragma unroll
    for (int q = 1; q < 16; ++q) v[q] = cmulc(X.R[pb + 272 * q], X.TW1[(q - 1) * 256 + t]);
    dft16<true>(v);
    if (X.half) {
#pragma unroll
        for (int m = 0; m < 16; ++m) v[m] = cmulc(cmulc(v[m], HY_W32(m)), X.wt);
    }
#pragma unroll
    for (int m = 0; m < 16; ++m) X.R[pb + 272 * m] = v[m];
}
#define HY_WSYNC() asm volatile("s_waitcnt lgkmcnt(0)" ::: "memory")
__device__ __forceinline__ void conv_fft(const Ctx& X, f32x2 (&H)[16]) {
    __syncthreads(); pass1_fwd<0>(X); __syncthreads(); pass2_fwd(X); HY_WSYNC(); pass3<false>(X, H); HY_WSYNC(); pass2_inv(X); __syncthreads(); pass1_inv(X); __syncthreads();
}
constexpr int STG_OFF = LDS_END;
constexpr int LDS_END2 = STG_OFF + 2 * SEQ * 2;
static_assert(LDS_END2 <= LDSCTL_OFF, "hyena LDS map");
__device__ __forceinline__ float sconv_lds(const LAS bf16_t* stg, int bs, int n, float w0, float w1, float w2, float bias) {
    const LAS bf16_t* p = stg + bs * SEQ;
    const float c = bf2f(p[n]), lv = bf2f(p[n - ((n > 0) ? 1 : 0)]), rv = bf2f(p[n + ((n < SEQ - 1) ? 1 : 0)]);
    const float l = (n > 0) ? lv : 0.f, r = (n < SEQ - 1) ? rv : 0.f;
    return bias + w0 * l + w1 * c + w2 * r;
}
__device__ __forceinline__ void setup_tables(LAS unsigned char* lds, int tid) {
    LAS f32x2* TW1 = (LAS f32x2*)(lds + TW1_OFF); LAS f32x2* TW2 = (LAS f32x2*)(lds + TW2_OFF);
    for (int i = tid; i < 15 * 256; i += 512) { const int q = i / 256 + 1, t = i & 255; float s, c; sincosf(-6.283185307179586f * (float)((t * q) & 4095) * (1.f / 4096.f), &s, &c); TW1[i] = (f32x2){c, s}; }
    for (int i = tid; i < 15 * 16; i += 512) { const int q = i / 16 + 1, n2 = i & 15; float s, c; sincosf(-6.283185307179586f * (float)((n2 * q) & 255) * (1.f / 256.f), &s, &c); TW2[i] = (f32x2){c, s}; }
}
__device__ __forceinline__ void unit(Frame& F, int c) {
    FT_DECL;
    const int tid = f_tid; Ctx X; X.half = F.wave >> 2; X.t = tid & 255;
    X.R = (LAS f32x2*)(F.lds + X.half * RB_BYTES); X.IN = (LAS f32x2*)(F.lds + IN_OFF); X.TW1 = (LAS f32x2*)(F.lds + TW1_OFF); X.TW2 = (LAS f32x2*)(F.lds + TW2_OFF);
    { float s, cc; sincosf(-6.283185307179586f * (float)X.t * (1.f / 8192.f), &s, &cc); X.wt = (f32x2){cc, s}; }
    LAS f32x2* RB0 = (LAS f32x2*)(F.lds); LAS f32x2* RB1 = (LAS f32x2*)(F.lds + RB_BYTES);
    const float* FILT = WSP(float, WS_FILT);
    f32x2 H0[16], H1[16];
#pragma unroll
    for (int ord = 0; ord < 2; ++ord) {
        const float* hf = FILT + ((size_t)(ord * 2 + 0) * 512 + c) * SEQ; const float* hb = FILT + ((size_t)(ord * 2 + 1) * 512 + c) * SEQ;
        __syncthreads();
        int nb = tid; HY_OPAQUE(nb);
#pragma unroll
        for (int j = 0; j < 8; ++j) { const int n = nb + 512 * j; const float a = hf[n], b = hb[(SEQ - n) & (SEQ - 1)]; const float lo = (n == 0) ? a + b : a, hi = (n == 0) ? 0.f : b; X.IN[n] = (f32x2){lo + hi, lo - hi}; }
        __syncthreads(); pass1_fwd<1>(X); __syncthreads(); pass2_fwd(X); HY_WSYNC();
        if (ord == 0) pass3<true>(X, H0); else pass3<true>(X, H1);
    }
    const bf16_t* UT = WSP(bf16_t, WS_UT);
    const bf16_t* rv = UT + (size_t)c * 128; const bf16_t* r1 = UT + (size_t)(512 + c) * 128; const bf16_t* r2 = UT + (size_t)(1024 + c) * 128;
#define HY_LD(rowp, t) (*(const u32x4*)((rowp) + (size_t)((t) >> 7) * (HYC * 128) + ((t) & 127)))
    const float* cw = F.in[16]; const float* cb = F.in[17];
    const float wv0 = cw[c], wv1 = cw[HYC + c], wv2 = cw[2 * HYC + c], bv = cb[c];
    const float wa0 = cw[512 + c], wa1 = cw[HYC + 512 + c], wa2 = cw[2 * HYC + 512 + c], ba = cb[512 + c];
    const float wb0 = cw[1024 + c], wb1 = cw[HYC + 1024 + c], wb2 = cw[2 * HYC + 1024 + c], bb = cb[1024 + c];
    const float sk0 = F.in[25][c], sk1 = F.in[25][512 + c];
    bf16_t* Z = WSP(bf16_t, WS_Z2T) + (size_t)c * 128;
    LAS bf16_t* STG = (LAS bf16_t*)(F.lds + STG_OFF);
    u32x4 g0 = HY_LD(rv, tid * 8), g1 = HY_LD(rv, SEQ + tid * 8);
    for (int pr = 0; pr < 4; ++pr) {
        const int b0 = 2 * pr, b1 = b0 + 1;
        f32x2 z[8]; int pc = tid + (tid >> 4); HY_OPAQUE(pc); int nb = tid; HY_OPAQUE(nb);
        __syncthreads();
        *(LAS u32x4*)(STG + tid * 8) = g0; *(LAS u32x4*)(STG + SEQ + tid * 8) = g1;
        __syncthreads();
#pragma unroll
        for (int j = 0; j < 8; ++j) { const int n = nb + 512 * j; z[j] = (f32x2){sconv_lds(STG, 0, n, wv0, wv1, wv2, bv), sconv_lds(STG, 1, n, wv0, wv1, wv2, bv)}; X.IN[n] = z[j]; }
        g0 = HY_LD(r1, b0 * SEQ + tid * 8); g1 = HY_LD(r1, b1 * SEQ + tid * 8);
        conv_fft(X, H0);
        *(LAS u32x4*)(STG + tid * 8) = g0; *(LAS u32x4*)(STG + SEQ + tid * 8) = g1;
        __syncthreads();
        HY_OPAQUE(nb); HY_OPAQUE(pc);
#pragma unroll
        for (int j = 0; j < 8; ++j) { const int n = nb + 512 * j; const f32x2 y = RB0[pc + 544 * j] + RB1[pc + 544 * j];
            const f32x2 g = (f32x2){sconv_lds(STG, 0, n, wa0, wa1, wa2, ba), sconv_lds(STG, 1, n, wa0, wa1, wa2, ba)};
            z[j] = g * (y + sk0 * z[j]); X.IN[n] = z[j]; }
        g0 = HY_LD(r2, b0 * SEQ + tid * 8); g1 = HY_LD(r2, b1 * SEQ + tid * 8);
        conv_fft(X, H1);
        *(LAS u32x4*)(STG + tid * 8) = g0; *(LAS u32x4*)(STG + SEQ + tid * 8) = g1;
        __syncthreads();
        if (pr < 3) { g0 = HY_LD(rv, (b0 + 2) * SEQ + tid * 8); g1 = HY_LD(rv, (b1 + 2) * SEQ + tid * 8); }
        HY_OPAQUE(nb); HY_OPAQUE(pc);
        f32x2 o[8];
#pragma unroll
        for (int j = 0; j < 8; ++j) { const int n = nb + 512 * j; const f32x2 y = RB0[pc + 544 * j] + RB1[pc + 544 * j];
            const f32x2 g = (f32x2){sconv_lds(STG, 0, n, wb0, wb1, wb2, bb), sconv_lds(STG, 1, n, wb0, wb1, wb2, bb)};
            o[j] = g * (y + sk1 * z[j]); }
        __syncthreads();
#pragma unroll
        for (int j = 0; j < 8; ++j) { const int n = nb + 512 * j; STG[n] = (bf16_t)(cvt_pk_bf16(o[j].x, 0.f) & 0xffffu); STG[SEQ + n] = (bf16_t)(cvt_pk_bf16(o[j].y, 0.f) & 0xffffu); }
        __syncthreads();
        { const int t0 = b0 * SEQ + tid * 8, t1 = b1 * SEQ + tid * 8;
          *(u32x4*)(Z + (size_t)(t0 >> 7) * (HYW * 128) + (t0 & 127)) = *(const LAS u32x4*)(STG + tid * 8); *(u32x4*)(Z + (size_t)(t1 >> 7) * (HYW * 128) + (t1 & 127)) = *(const LAS u32x4*)(STG + SEQ + tid * 8); }
    }
    __syncthreads();
}
}

__device__ __forceinline__ void p3_hyena(Frame& F) {
    FT_DECL;
    __syncthreads();
    hy::setup_tables(F.lds, f_tid);
    __syncthreads();
    for (int c = F.vcu; c < HYW; c += F.G) hy::unit(F, c);
}

__device__ __forceinline__ void p4_hynorm(Frame& F) {
    FT_DECL;
    const bf16_t* Z = WSP(bf16_t, WS_Z2T); bf16_t* MIX = WSP(bf16_t, WS_MIX); const float* g = F.in[26];
    constexpr int TP = 132;
    LAS bf16_t* T = (LAS bf16_t*)F.lds;
    LAS float* red = (LAS float*)(F.lds + 512 * TP * 2);
    LAS float* rs = red + 512;
    float gl[8];
#pragma unroll
    for (int e = 0; e < 8; ++e) gl[e] = g[(f_tid & 63) + 64 * e];
    for (int it = F.vcu; it < MROWS / 128; it += F.G) {
        const int tok0 = it * 128; const bf16_t* zt = Z + (size_t)it * (HYW * 128);
        __syncthreads();
        u32x4 v[16];
#pragma unroll
        for (int j = 0; j < 16; ++j) v[j] = __builtin_nontemporal_load((const u32x4*)(zt + (size_t)(f_tid + 512 * j) * 8));
#pragma unroll
        for (int j = 0; j < 16; ++j) { const int i = f_tid + 512 * j; LAS u32x2* d = (LAS u32x2*)(T + (i >> 4) * TP + (i & 15) * 8); d[0] = (u32x2){v[j].x, v[j].y}; d[1] = (u32x2){v[j].z, v[j].w}; }
        __syncthreads();
        { const int tok = f_tid & 127, grp = f_tid >> 7; float ss = 0.f;
#pragma unroll 8
            for (int k = 0; k < 128; ++k) { const float x = bf2f(T[(grp * 128 + k) * TP + tok]); ss += x * x; }
            red[grp * 128 + tok] = ss; }
        __syncthreads();
        if (f_tid < 128) rs[f_tid] = rsqrtf(((red[f_tid] + red[128 + f_tid]) + (red[256 + f_tid] + red[384 + f_tid])) * (1.f / HYW) + EPS);
        __syncthreads();
#pragma unroll
        for (int j = 0; j < 16; ++j) { const int i = f_tid + 512 * j, tok = i >> 6, l = i & 63; const float r = rs[tok];
            float x[8];
#pragma unroll
            for (int e = 0; e < 8; ++e) x[e] = bf2f(T[(l + 64 * e) * TP + tok]) * r * gl[e];
            u32x4 w; w.x = cvt_pk_bf16(x[0], x[1]); w.y = cvt_pk_bf16(x[2], x[3]); w.z = cvt_pk_bf16(x[4], x[5]); w.w = cvt_pk_bf16(x[6], x[7]);
            *(u32x4*)(MIX + (size_t)(tok0 + tok) * DM + 512 + 8 * l) = w; }
    }
}

constexpr size_t WS_LIST2 = WS_FILT;
constexpr size_t WS_GSLOT2 = WS_FILT + 4 * MiB;
constexpr int CW_ECNT = 256;
constexpr int MAXSLOT = MROWS * TOPK + NEXP * 256;
constexpr int MAXTILE = MAXSLOT / 256;
constexpr size_t WS_XS = WS_EO;
constexpr int RW_PITCH = 32;
constexpr int P6_LDS_TOPI = 1024 * RW_PITCH * 4;

__device__ __forceinline__ void p6_router_mfma(Frame& F) {
    FT_DECL;
#define in F.in
    LAS float* WP = (LAS float*)F.lds;
    LAS int* TI = (LAS int*)(F.lds + P6_LDS_TOPI);
    LAS int* PS = TI + 512;
    LAS int* SC = PS + 512;
    LAS float* RSTD = (LAS float*)(SC + 512);
    LAS float* BIAS = RSTD + 128;
    LAS float* SSX = BIAS + 32;
    const float* rw = in[28]; const float* mod = WSP(float, WS_SMALL + SM_MOD); const float* g2n = in[7]; const float* rb = in[29];
    const bf16_t* XN = WSP(bf16_t, WS_XN); unsigned char* H2 = WSP(unsigned char, WS_H);
    int* list2 = WSP(int, WS_LIST2); float* gslot2 = WSP(float, WS_GSLOT2); int* ecnt = (int*)(F.ctl + CW_ECNT);
    LAS float* GT = SSX + 256;
    LAS int* EB = (LAS int*)(GT + 512);
    LAS float* GM = (LAS float*)(EB + 32);
    for (int blk = blockIdx.x; blk < MROWS / 128; blk += F.G) {
        const float* sh2 = mod + (size_t)(blk >> 5) * (NMOD * DM) + 3 * DM; const float* sc2 = sh2 + DM;
        __syncthreads();
        { const char* rwb = (const char*)rw; const unsigned wbase = (unsigned)(uintptr_t)F.lds;
#pragma unroll
            for (int i = 0; i < 16; ++i) { const int chunk = i * NWAVES + F.wave;
                __builtin_amdgcn_global_load_lds((const unsigned*)(rwb + (size_t)chunk * 1024 + lane_id() * 16), (LAS unsigned*)(uintptr_t)__builtin_amdgcn_readfirstlane(wbase + (unsigned)chunk * 1024u), 16, 0, 0); } }
        for (int i = f_tid; i < DM; i += 512) GM[i] = g2n[i] * (1.f + sc2[i]);
        if (f_tid < 32) BIAS[f_tid] = WSP(float, WS_SMALL + SM_RBIAS)[(blk >> 5) * 32 + f_tid];
        asm volatile("s_waitcnt vmcnt(0)" ::: "memory");
        __syncthreads();
        const int rg = F.wave & 3, kh = F.wave >> 2, j = f_lane & 31, hi = f_lane >> 5;
        f32x16 acc = {};
        float ss = 0.f;
        { const bf16_t* xrow = XN + (size_t)(blk * 128 + rg * 32 + j) * DM + 512 * kh + 8 * hi;
            const LAS float* wp = WP + (512 * kh + 8 * hi) * 32 + j;
            const LAS float* gmp = GM + 512 * kh + 8 * hi;
#pragma unroll 8
            for (int c = 0; c < 32; ++c) { const u32x4 xb = *(const u32x4*)(xrow + 16 * c);
                float xf[8] = {__uint_as_float(xb.x << 16), __uint_as_float(xb.x & 0xffff0000u), __uint_as_float(xb.y << 16), __uint_as_float(xb.y & 0xffff0000u),
                               __uint_as_float(xb.z << 16), __uint_as_float(xb.z & 0xffff0000u), __uint_as_float(xb.w << 16), __uint_as_float(xb.w & 0xffff0000u)};
                const f32x4 g0 = *(const LAS f32x4*)(gmp + 16 * c), g1v = *(const LAS f32x4*)(gmp + 16 * c + 4); const float gq[8] = {g0.x, g0.y, g0.z, g0.w, g1v.x, g1v.y, g1v.z, g1v.w};
#pragma unroll
                for (int q = 0; q < 8; ++q) { ss += xf[q] * xf[q]; acc = __builtin_amdgcn_mfma_f32_32x32x2f32(wp[(16 * c + q) * 32], xf[q] * gq[q], acc, 0, 0, 0); } } }
        { auto rr = __builtin_amdgcn_permlane32_swap(__float_as_uint(ss), __float_as_uint(ss), false, false); ss = __uint_as_float(rr[0]) + __uint_as_float(rr[1]); }
        if (hi == 0) SSX[kh * 128 + rg * 32 + j] = ss;
        __syncthreads();
        if (kh == 1) {
#pragma unroll
            for (int r = 0; r < 16; ++r) WP[(rg * 16 + r) * 64 + f_lane] = acc[r]; }
        if (f_tid < 128) RSTD[f_tid] = rsqrtf((SSX[f_tid] + SSX[128 + f_tid]) * (1.f / DM) + EPS);
        __syncthreads();
        if (kh == 0) {
            const float rstd = RSTD[rg * 32 + j];
            float tv[4] = {-INFINITY, -INFINITY, -INFINITY, -INFINITY}; int ti[4] = {1 << 20, 1 << 20, 1 << 20, 1 << 20};
#define P6_INS(V, E) do { float cv = (V); int ce = (E); _Pragma("unroll") for (int q = 0; q < 4; ++q) { const bool b = cv > tv[q] || (cv == tv[q] && ce < ti[q]); \
                const float nv = b ? tv[q] : cv; const int ne = b ? ti[q] : ce; tv[q] = b ? cv : tv[q]; ti[q] = b ? ce : ti[q]; cv = nv; ce = ne; } } while (0)
#pragma unroll
            for (int r = 0; r < 16; ++r) { const int e = (r & 3) + 8 * (r >> 2) + 4 * hi; const float v = (acc[r] + WP[(rg * 16 + r) * 64 + f_lane]) * rstd + BIAS[e]; P6_INS(v, e); }
            float ov[4]; int oe[4];
#pragma unroll
            for (int q = 0; q < 4; ++q) { ov[q] = __shfl_xor(tv[q], 32); oe[q] = __shfl_xor(ti[q], 32); }
#pragma unroll
            for (int q = 0; q < 4; ++q) P6_INS(ov[q], oe[q]);
#undef P6_INS
            if (hi == 0) { const int rl = rg * 32 + j;
                const float e1 = __expf(tv[1] - tv[0]), e2 = __expf(tv[2] - tv[0]), e3 = __expf(tv[3] - tv[0]); const float inv = 1.f / (1.f + e1 + e2 + e3);
                typedef int i32x4_t __attribute__((ext_vector_type(4))); const i32x4_t t4 = {ti[0], ti[1], ti[2], ti[3]};
                *(LAS f32x4*)(GT + rl * 4) = (f32x4){inv, e1 * inv, e2 * inv, e3 * inv};
                *(LAS i32x4_t*)(TI + rl * 4) = t4; }
        }
        __syncthreads();
        { const int t2 = F.wave * 64 + lane_id(); const int e = t2 & 31, seg = t2 >> 5; int cnt = 0;
#pragma unroll 4
            for (int i = 0; i < 32; ++i) cnt += (TI[seg * 32 + i] == e) ? 1 : 0;
            SC[seg * 32 + e] = cnt;
            __syncthreads();
            int pre = 0;
            for (int s2 = 0; s2 < seg; ++s2) pre += SC[s2 * 32 + e];
            if (seg == 15) EB[e] = __hip_atomic_fetch_add(ecnt + e, pre + cnt, __ATOMIC_RELAXED, __HIP_MEMORY_SCOPE_AGENT);
            for (int i = 0; i < 32; ++i) if (TI[seg * 32 + i] == e) { PS[seg * 32 + i] = pre; ++pre; }
        }
        __syncthreads();
        { const int t3 = F.wave * 64 + lane_id(); const int e = TI[t3]; const size_t sl = (size_t)e * MROWS + EB[e] + PS[t3];
            list2[sl] = (blk * 128 + (t3 >> 2)) * 4 + (t3 & 3); gslot2[sl] = GT[t3]; }
        { const int lane = lane_id();
            f32x4 PA[4], PB[4];
#pragma unroll
            for (int jj = 0; jj < 4; ++jj) { const int c = 4 * lane + 256 * jj; PA[jj] = *(const f32x4*)(g2n + c) * (*(const f32x4*)(sc2 + c) + 1.f); PB[jj] = *(const f32x4*)(sh2 + c); }
            for (int it = 0; it < 4; ++it) { u32x2 xb[4][4];
#pragma unroll
                for (int u = 0; u < 4; ++u) { const GAS u32x2* xr = (const GAS u32x2*)(XN + (size_t)(blk * 128 + F.wave * 16 + 4 * it + u) * DM) + lane;
#pragma unroll
                    for (int jj = 0; jj < 4; ++jj) xb[u][jj] = xr[64 * jj]; }
#pragma unroll
                for (int u = 0; u < 4; ++u) { const int rl = F.wave * 16 + 4 * it + u; const float rstd = RSTD[rl];
                    GAS unsigned* o4 = (GAS unsigned*)(H2 + (size_t)(blk * 128 + rl) * DM) + lane;
#pragma unroll
                    for (int jj = 0; jj < 4; ++jj) {
                        const f32x4 x = (f32x4){__uint_as_float(xb[u][jj].x << 16), __uint_as_float(xb[u][jj].x & 0xffff0000u), __uint_as_float(xb[u][jj].y << 16), __uint_as_float(xb[u][jj].y & 0xffff0000u)};
                        const f32x4 h = x * rstd * PA[jj] + PB[jj];
                        o4[64 * jj] = pk4_fp8(h.x, h.y, h.z, h.w); } } }
        }
    }
#undef in
}

template <int NPN> struct SchedMoE {
    int G, c, nT; const char* A; const char* W; size_t wstride; const LAS unsigned char* tileE; const LAS int* RW; bool gath;
    __device__ __forceinline__ long lidx(int T, int e, int i) const { const LAS int* TB = (const LAS int*)(tileE + 544); const int r = (T - TB[e]) * 256 + i; return (r < TB[32 + e]) ? (long)e * MROWS + r : -1L; }
    __device__ __forceinline__ const LAS int* rows(int i) const { return RW + i * 256; }
    __device__ __forceinline__ bool next(int i, g8::Unit& u) const {
        const int L = i * G + c, xcd = L & 7, j = L >> 3, nTx = (nT + 7) >> 3, tl = j / NPN, T = xcd * nTx + tl, pn = j % NPN;
        if (tl >= nTx || T >= nT) return false;
        const int e = tileE[T];
        u.pm = T; u.pn = pn; u.kind = i; u.ex = e; u.a = gath ? A : A + (size_t)T * 256 * DM; u.b = W + (size_t)e * wstride + (size_t)pn * 256 * DM; return true;
    }
};
struct EpiSwiGLU {
    unsigned char* ACT; const float* b1;
    __device__ __forceinline__ void operator()(f32x4 (&acc)[2][2][4][2], const g8::Unit& u, int wr, int wc, int fr, int fq) const {
        asm volatile("" : "+v"(fr), "+v"(fq));
        const int j0 = u.pn * 128 + wc * 32 + 8 * fq; const float* bp = b1 + (size_t)u.ex * 2 * DM + j0;
        f32x4 bg[2], bl[2];
#pragma unroll
        for (int n = 0; n < 2; ++n) { bg[n] = *(const f32x4*)(bp + 4 * n); bl[n] = *(const f32x4*)(bp + DM + 4 * n); }
#pragma unroll
        for (int ai = 0; ai < 2; ++ai)
#pragma unroll
            for (int m = 0; m < 4; ++m) { const size_t slot = (size_t)u.pm * 256 + ai * 128 + wr * 64 + m * 16 + fr; float o[8];
#pragma unroll
                for (int n = 0; n < 2; ++n) { const f32x4 g4 = acc[ai][0][m][n] * (1.f / WSCALE) + bg[n], l4 = acc[ai][1][m][n] * (1.f / WSCALE) + bl[n];
#pragma unroll
                    for (int e = 0; e < 4; ++e) { const float g = fminf(g4[e], 7.f), l = __builtin_amdgcn_fmed3f(l4[e], -7.f, 7.f);
                        const float ex = __builtin_amdgcn_exp2f(g * (-1.702f * 1.4426950408889634f)); const float glu = g * __builtin_amdgcn_rcpf(1.f + ex);
                        o[4 * n + e] = fmaf(l, glu, glu); } }
                u32x2 w; w.x = pk4_fp8(o[0], o[1], o[2], o[3]); w.y = pk4_fp8(o[4], o[5], o[6], o[7]);
                *(u32x2*)(ACT + slot * DM + j0) = w; }
    }
};
struct EpiDown {
    unsigned char* EO; const float* b2; const LAS int* LL; int G, c;
    __device__ __forceinline__ void operator()(f32x4 (&acc)[2][2][4][2], const g8::Unit& u, int wr, int wc, int fr, int fq) const {
        asm volatile("" : "+v"(fr), "+v"(fq));
        const int c0 = u.pn * 256 + wc * 64 + 16 * fq; const float* bp = b2 + (size_t)u.ex * DM + c0;
        f32x4 bb[2][2];
#pragma unroll
        for (int bj = 0; bj < 2; ++bj)
#pragma unroll
            for (int n = 0; n < 2; ++n) bb[bj][n] = *(const f32x4*)(bp + bj * 8 + 4 * n);
        const LAS int* L = LL + u.kind * 512;
        int li[8]; float gt[8];
#pragma unroll
        for (int q = 0; q < 8; ++q) { const int rl = (q >> 2) * 128 + wr * 64 + (q & 3) * 16 + fr; li[q] = L[rl]; gt[q] = __int_as_float(L[256 + rl]) * (1.f / WSCALE); }
#pragma unroll
        for (int ai = 0; ai < 2; ++ai)
#pragma unroll
            for (int m = 0; m < 4; ++m) { const int l = li[ai * 4 + m]; const float g = gt[ai * 4 + m];
                unsigned char* dst = EO + ((size_t)(l & 3) * MROWS + (l >> 2)) * DM + c0;
                u32x4 w;
                { const f32x4 v0 = acc[ai][0][m][0] * g + bb[0][0] * (g * WSCALE), v1 = acc[ai][0][m][1] * g + bb[0][1] * (g * WSCALE);
                  w.x = pk4_fp8(v0[0] * EOSCALE, v0[1] * EOSCALE, v0[2] * EOSCALE, v0[3] * EOSCALE); w.y = pk4_fp8(v1[0] * EOSCALE, v1[1] * EOSCALE, v1[2] * EOSCALE, v1[3] * EOSCALE); }
                { const f32x4 v0 = acc[ai][1][m][0] * g + bb[1][0] * (g * WSCALE), v1 = acc[ai][1][m][1] * g + bb[1][1] * (g * WSCALE);
                  w.z = pk4_fp8(v0[0] * EOSCALE, v0[1] * EOSCALE, v0[2] * EOSCALE, v0[3] * EOSCALE); w.w = pk4_fp8(v1[0] * EOSCALE, v1[1] * EOSCALE, v1[2] * EOSCALE, v1[3] * EOSCALE); }
                if (l >= 0) *(u32x4*)dst = w; }
    }
};
__device__ __forceinline__ const LAS unsigned char* moe_tiles(Frame& F, int& nT) {
    FT_DECL;
    LAS unsigned char* TE = (LAS unsigned char*)(F.lds + RING_BYTES); LAS int* TB = (LAS int*)(TE + 544); LAS int* TOT = TB + 32; LAS int* NTL = TOT + 32;
    const int* ecnt = (const int*)(F.ctl + CW_ECNT);
    __syncthreads();
    if (f_tid < 32) { const int t = ecnt[f_tid]; TOT[f_tid] = t; NTL[f_tid] = (t + 255) >> 8; }
    __syncthreads();
    if (f_tid < 33) { int b = 0; for (int e = 0; e < f_tid; ++e) b += NTL[e]; if (f_tid < 32) TB[f_tid] = b; else NTL[32] = b; }
    __syncthreads();
    nT = NTL[32]; if (nT > MAXTILE) nT = MAXTILE;
    for (int i = f_tid; i < MAXTILE; i += 512) { int e = 0;
#pragma unroll 8
        for (int q = 0; q < 32; ++q) e += (TB[q] + NTL[q] <= i) ? 1 : 0;
        TE[i] = (unsigned char)((i < nT) ? e : 0); }
    __syncthreads();
    return (const LAS unsigned char*)TE;
}

__device__ __forceinline__ void p10_combine(Frame& F) {
    FT_DECL;
    const float* mod = WSP(float, WS_SMALL + SM_MOD); const unsigned char* EO = WSP(unsigned char, WS_EO);
    const size_t gt = (size_t)F.vcu * 512 + f_tid, NTH = (size_t)F.G * 512;
    constexpr int U = 4;
    for (size_t i0 = gt; i0 < (size_t)MROWS * 128; i0 += NTH * U) {
        u32x2 ev[U][4]; f32x4 xv[U][2], gv[U][2];
#pragma unroll
        for (int u = 0; u < U; ++u) { const size_t i = i0 + (size_t)u * NTH; const size_t row = i >> 7; const int c0 = (int)(i & 127) * 8;
            const float* g2 = mod + (size_t)(row >> 12) * (NMOD * DM) + 5 * DM + c0; const bf16_t* op = WSP(bf16_t, WS_XN) + row * DM + c0;
#pragma unroll
            for (int k = 0; k < 4; ++k) ev[u][k] = __builtin_nontemporal_load((const u32x2*)(EO + ((size_t)k * MROWS + row) * DM + c0));
            { const u32x4 xb = *(const u32x4*)op; xv[u][0] = (f32x4){__uint_as_float(xb.x << 16), __uint_as_float(xb.x & 0xffff0000u), __uint_as_float(xb.y << 16), __uint_as_float(xb.y & 0xffff0000u)};
              xv[u][1] = (f32x4){__uint_as_float(xb.z << 16), __uint_as_float(xb.z & 0xffff0000u), __uint_as_float(xb.w << 16), __uint_as_float(xb.w & 0xffff0000u)}; }
            gv[u][0] = *(const f32x4*)g2; gv[u][1] = *(const f32x4*)(g2 + 4); }
#pragma unroll
        for (int u = 0; u < U; ++u) { const size_t i = i0 + (size_t)u * NTH; const size_t row = i >> 7; const int c0 = (int)(i & 127) * 8;
            float s[8];
#pragma unroll
            for (int e = 0; e < 8; ++e) s[e] = 0.f;
#pragma unroll
            for (int k = 0; k < 4; ++k) { const u32x2 v = ev[u][k];
                const f32x2 a = __builtin_amdgcn_cvt_pk_f32_fp8((int)v.x, false), b = __builtin_amdgcn_cvt_pk_f32_fp8((int)v.x, true), c = __builtin_amdgcn_cvt_pk_f32_fp8((int)v.y, false), d = __builtin_amdgcn_cvt_pk_f32_fp8((int)v.y, true);
                s[0] += a.x; s[1] += a.y; s[2] += b.x; s[3] += b.y; s[4] += c.x; s[5] += c.y; s[6] += d.x; s[7] += d.y; }
#pragma unroll
            for (int e = 0; e < 8; ++e) s[e] *= (1.f / EOSCALE);
            f32x4 o0 = xv[u][0] + gv[u][0] * (f32x4){s[0], s[1], s[2], s[3]}, o1 = xv[u][1] + gv[u][1] * (f32x4){s[4], s[5], s[6], s[7]};
            float* op = F.out + row * DM + c0;
            __builtin_nontemporal_store(o0, (f32x4*)op); __builtin_nontemporal_store(o1, (f32x4*)(op + 4)); }
    }
}

struct Args { const float* in[34]; float* out; unsigned char* ws; int ph_lo, ph_hi; };
constexpr int N_PHASES = 11;

__global__ void __launch_bounds__(512, 2) mega(Args args) {
    extern __shared__ __attribute__((aligned(16))) unsigned char lds[];
    Frame F;
    F.lds = (LAS unsigned char*)lds;
    F.MISC = (volatile LAS unsigned*)(F.lds + LDSCTL_OFF);
    F.wave = __builtin_amdgcn_readfirstlane(threadIdx.x >> 6);
    FT_DECL;
    F.G = gridDim.x; { const int bx = blockIdx.x; F.vcu = (F.G % 8 == 0) ? (bx % 8) * (F.G / 8) + bx / 8 : bx; }
    F.in = (kin_t)__builtin_amdgcn_kernarg_segment_ptr();
    F.out = args.out; F.ws = args.ws;
    F.ctl = (gu32*)(args.ws + WS_CTL);
    for (int u = f_tid; u < (LDS_BYTES - LDSCTL_OFF) / 4; u += NWAVES * 64) ((LAS unsigned*)(F.lds + LDSCTL_OFF))[u] = 0u;
    __syncthreads();
    const int lo = args.ph_lo, hi = args.ph_hi;
    XcdBarrier bar; bar.bar = (unsigned*)(F.ctl + CW_BAR); bar.x = 0; bar.st = nullptr;
    if (hi - lo > 1) bar = xcd_barrier_post((unsigned*)(F.ctl + CW_BAR), F.MISC + 8, f_tid == 0);
#define IN(k) (lo <= (k) && (k) < hi)
#define SEAM(k) do { if (IN(k) && IN((k) + 1)) xcd_barrier(bar, F.wave == 0 && lane_id() == 0); } while (0)

    if (IN(0)) { p0_prologue(F); } SEAM(0);
    if (IN(1)) { p1_norm1(F); } SEAM(1);
    if (IN(2)) {
        SchedInProj S{F.G, (int)blockIdx.x, (const char*)WSP(bf16_t, WS_H), (const char*)WSP(bf16_t, WS_WIN)};
        EpiInProj E{WSP(unsigned char, WS_Q), WSP(unsigned char, WS_K), WSP(unsigned char, WS_V), WSP(bf16_t, WS_UT), F.in[9], F.in[10], WSP(float, WS_SMALL + SM_ROPE)};
        g8::gemm_phase<false>(F.lds, DM, S, E, F.wave, lane_id());
    } SEAM(2);
    if (IN(3)) { p3_attention8(F); p3_hyena(F); } SEAM(3);
    if (IN(4)) { p4_hynorm(F); } SEAM(4);
    if (IN(5)) {
        SchedStatic S{F.G, (int)blockIdx.x, MROWS / 256, DM / 256, (const char*)WSP(bf16_t, WS_MIX), (const char*)WSP(bf16_t, WS_WOUT)};
        EpiOutProj E{F.in[0], WSP(bf16_t, WS_XN), WSP(float, WS_SMALL + SM_MOD)};
        g8::gemm_phase<false>(F.lds, DM, S, E, F.wave, lane_id());
    } SEAM(5);
    if (IN(6)) { p6_router_mfma(F); } SEAM(6);
    if (IN(8)) {
        int nT; const LAS unsigned char* TE = moe_tiles(F, nT);
        LAS int* RWL = (LAS int*)(F.lds + RING_BYTES + 1024);
        static_assert(RING_BYTES + 1024 + 17 * 1024 <= LDSCTL_OFF, "LDS map");
        SchedMoE<8> S{F.G, (int)blockIdx.x, nT, (const char*)WSP(char, WS_H), (const char*)WSP(char, WS_W1), (size_t)2 * DM * DM, TE, RWL, true};
        { const int* list = WSP(int, WS_LIST2); const int t8 = F.wave * 64 + lane_id();
            g8::Unit u; for (int i = 0; i < 17 && S.next(i, u); i += 2) { const int ii = i + (t8 >> 8); g8::Unit u2; if (S.next(ii, u2)) { const long ix = S.lidx(u2.pm, u2.ex, t8 & 255); RWL[ii * 256 + (t8 & 255)] = (ix >= 0) ? (list[ix] >> 2) : 0; } }
            __syncthreads(); }
        EpiSwiGLU E{WSP(unsigned char, WS_ACT), F.in[31]};
        g8::gemm_phase_g<true, true>(F.lds, DM, S, E, F.wave, lane_id());
    } SEAM(8);
    if (IN(9)) {
        int nT; const LAS unsigned char* TE = moe_tiles(F, nT);
        SchedMoE<4> S{F.G, (int)blockIdx.x, nT, (const char*)WSP(char, WS_ACT), (const char*)WSP(char, WS_W2), (size_t)DM * DM, TE, nullptr, false};
        LAS int* LL = (LAS int*)(F.lds + RING_BYTES + 1024);
        static_assert(RING_BYTES + 1024 + 9 * 2048 <= LDSCTL_OFF, "LDS map");
        { const int* list = WSP(int, WS_LIST2); const float* gslot = WSP(float, WS_GSLOT2);
            const int t9 = F.wave * 64 + lane_id();
            g8::Unit u; for (int i = 0; i < 9 && S.next(i, u); ++i) { const int t = t9 & 255; const long ix = S.lidx(u.pm, u.ex, t);
                LL[i * 512 + (t9 >> 8) * 256 + t] = (ix < 0) ? ((t9 < 256) ? -1 : 0) : ((t9 < 256) ? list[ix] : __float_as_int(gslot[ix])); }
            __syncthreads(); }
        EpiDown E{WSP(unsigned char, WS_EO), F.in[33], LL, F.G, (int)blockIdx.x};
        g8::gemm_phase<true>(F.lds, DM, S, E, F.wave, lane_id());
    } SEAM(9);
    if (IN(10)) { p10_combine(F); }
#undef IN
#undef SEAM
}

extern "C" void kernel_launch(void* const* d_in, const int* in_sizes, int n_in, void* d_out, int out_size, void* d_ws, size_t ws_size, hipStream_t stream) {
    static int grid = 0;
    if (grid == 0) {
        if (n_in != 34 || out_size != MROWS * DM || ws_size < WS_END) { fprintf(stderr, "kernel_launch: unexpected shapes: n_in %d out %d ws %zu (need %zu)\n", n_in, out_size, ws_size, (size_t)WS_END); grid = -1; return; }
        int dev = 0, cus = 0, per_cu = 0;
        if (hipGetDevice(&dev) != hipSuccess || hipDeviceGetAttribute(&cus, hipDeviceAttributeMultiprocessorCount, dev) != hipSuccess) { grid = -1; return; }
        if (hipFuncSetAttribute((const void*)mega, hipFuncAttributeMaxDynamicSharedMemorySize, LDS_BYTES) != hipSuccess) { fprintf(stderr, "kernel_launch: hipFuncSetAttribute failed\n"); grid = -1; return; }
        if (hipOccupancyMaxActiveBlocksPerMultiprocessor(&per_cu, (const void*)mega, NWAVES * 64, LDS_BYTES) != hipSuccess || per_cu < 1) { fprintf(stderr, "kernel_launch: occupancy query says %d\n", per_cu); per_cu = 1; }
        (void)hipGetLastError();
        grid = cus;
    }
    if (grid < 0) return;
    (void)hipMemsetAsync((char*)d_ws + WS_CTL, 0, CTL_ZERO_BYTES, stream);
    Args a{};
    for (int i = 0; i < 34; ++i) a.in[i] = (const float*)d_in[i];
    a.out = (float*)d_out; a.ws = (unsigned char*)d_ws;
    constexpr int LAST = MK_LAST_PHASE + 1;
    if (MK_N_LAUNCHES == 1) { a.ph_lo = 0; a.ph_hi = LAST; hipLaunchKernelGGL(mega, dim3(grid), dim3(NWAVES * 64), LDS_BYTES, stream, a); }
    else for (int p = 0; p < LAST; ++p) { a.ph_lo = p; a.ph_hi = p + 1; hipLaunchKernelGGL(mega, dim3(grid), dim3(NWAVES * 64), LDS_BYTES, stream, a); }
    const hipError_t le = hipPeekAtLastError();
    if (le != hipSuccess) fprintf(stderr, "kernel_launch: launch failed: %s\n", hipGetErrorName(le));
}
```

```cpp
#include <hip/hip_runtime.h>
#include <hip/hip_bf16.h>
#include <cstdio>
#include <cstdint>

#ifndef MK_N_LAUNCHES
#define MK_N_LAUNCHES 1
#endif
#ifndef MK_LAST_PHASE
#define MK_LAST_PHASE 10
#endif

#define GAS __attribute__((address_space(1)))
#define LAS __attribute__((address_space(3)))
typedef unsigned short bf16_t;
typedef short bf16x8 __attribute__((ext_vector_type(8)));
typedef short s16x4 __attribute__((ext_vector_type(4)));
typedef float f32x2 __attribute__((ext_vector_type(2)));
typedef float f32x4 __attribute__((ext_vector_type(4)));
typedef float f32x16 __attribute__((ext_vector_type(16)));
typedef unsigned u32x2 __attribute__((ext_vector_type(2)));
typedef unsigned u32x4 __attribute__((ext_vector_type(4)));
typedef GAS unsigned gu32;

constexpr int NB = 8, SEQ = 4096, DM = 1024, MROWS = NB * SEQ, CTXL = 256, MCTX = NB * CTXL, MTOT = MROWS + MCTX;
constexpr int KVL = CTXL + SEQ;
constexpr int NHEAD = 4, QKW = 512;
constexpr int HYW = 512, HYC = 1536, INC = 3072, QKVC = 1536;
constexpr int NEXP = 32, TOPK = 4, NMOD = 6;
constexpr float EPS = 1e-6f;
constexpr float LAM_INIT = 0.2f;
constexpr float QSCALE = 0.125f * 1.4426950408889634f;

constexpr size_t MiB = 1u << 20;
constexpr size_t WS_CTL = 0, CTL_ZERO_BYTES = 64 * 1024;
constexpr size_t WS_SMALL = 1 * MiB;
constexpr size_t WS_WIN = 2 * MiB;
constexpr size_t WS_WOUT = 8 * MiB;
constexpr size_t WS_W1 = 10 * MiB;
constexpr size_t WS_W2 = 138 * MiB;
constexpr size_t WS_H = 202 * MiB;
constexpr size_t WS_Q = 270 * MiB;
constexpr size_t WS_K = 302 * MiB;
constexpr size_t WS_V = 336 * MiB;
constexpr size_t WS_UT = 370 * MiB;
constexpr size_t WS_FILT = 466 * MiB;
constexpr size_t WS_Z2T = 498 * MiB;
constexpr size_t WS_MIX = 530 * MiB;
constexpr size_t WS_ROUTE = 594 * MiB;
constexpr size_t WS_ACT = 270 * MiB;
constexpr size_t WS_EO = 598 * MiB;
constexpr size_t WS_XN = 870 * MiB;
constexpr size_t WS_END = 998 * MiB;
constexpr size_t SM_MOD = 0;
constexpr size_t SM_SCAL = 256 * 1024;
constexpr size_t SM_ROPE = 260 * 1024;
constexpr size_t SM_RBIAS = 272 * 1024;
constexpr int CW_BAR = 4096;

constexpr int RING_BYTES = 131072;
constexpr int LDSCTL_OFF = 151552;
constexpr int LDS_BYTES = 152576;
constexpr int NWAVES = 8;

#define LDS_WAIT() asm volatile("s_waitcnt lgkmcnt(0)" ::: "memory")
#define VM_WAIT() asm volatile("s_waitcnt vmcnt(0)" ::: "memory")
#define RLX_AGENT __ATOMIC_RELAXED, __HIP_MEMORY_SCOPE_AGENT

__device__ __forceinline__ unsigned cvt_pk_bf16(float lo, float hi) { unsigned r; asm volatile("v_cvt_pk_bf16_f32 %0, %1, %2" : "=v"(r) : "v"(lo), "v"(hi)); return r; }
__device__ __forceinline__ float bf2f(bf16_t v) { return __uint_as_float(((unsigned)v) << 16); }
__device__ __forceinline__ float wave_sum(float v) {
#pragma unroll
    for (int o = 1; o < 64; o <<= 1) v += __shfl_xor(v, o);
    return v;
}

#define XB_TMO      128
#define XB_XCNT(j)  (256  + 64 * (j))
#define XB_XSUB(j)  (1280 + 64 * (j))
#define XB_XGEN(j)  (2304 + 64 * (j))
#define XB_TOP      3328
#define XB_TOPGEN   3392
#define XCD_BAR_WORDS 3456
#define XB_SPIN_CAP (1u << 22)
__device__ __forceinline__ unsigned xb_ld(unsigned* p)              { return __hip_atomic_load(p, __ATOMIC_RELAXED, __HIP_MEMORY_SCOPE_AGENT); }
__device__ __forceinline__ unsigned xb_add(unsigned* p, unsigned v) { return __hip_atomic_fetch_add(p, v, __ATOMIC_RELAXED, __HIP_MEMORY_SCOPE_AGENT); }
__device__ __forceinline__ unsigned xb_xcc_id() { return (unsigned)__builtin_amdgcn_s_getreg((3 << 11) | 20) & 0xFu; }
#define XB_SPIN(cond, bar) do { unsigned _sp = 0; while (cond) { __builtin_amdgcn_s_sleep(1); \
    if ((++_sp & 255u) == 0u) { if (xb_ld(&(bar)[XB_TMO])) break; if (_sp > XB_SPIN_CAP) { atomicAdd(&(bar)[XB_TMO], 1u); break; } } } } while (0)
struct XcdBarrier { unsigned* bar; unsigned x; volatile LAS unsigned* st; };
__device__ __forceinline__ XcdBarrier xcd_barrier_post(unsigned* bar, volatile LAS unsigned* st, bool leader) {
    XcdBarrier b; b.bar = bar; b.x = xb_xcc_id(); b.st = st;
    if (leader) (void)xb_add(&bar[XB_XCNT(b.x)], 1u);
    return b;
}
__device__ __forceinline__ void xcd_barrier_complete(unsigned* bar, unsigned x, unsigned& nloc, unsigned& nx) {
    const unsigned G = gridDim.x * gridDim.y * gridDim.z;
    unsigned sum, cnt, mine, sp = 0u;
    for (;;) {
        sum = 0u; cnt = 0u; mine = 0u;
#pragma unroll
        for (unsigned j = 0; j < 16; ++j) { const unsigned c = xb_ld(&bar[XB_XCNT(j)]); sum += c; cnt += (c > 0u) ? 1u : 0u; mine = (j == x) ? c : mine; }
        if (sum == G) break;
        __builtin_amdgcn_s_sleep(1);
        if ((++sp & 255u) == 0u) { if (xb_ld(&bar[XB_TMO])) break; if (sp > XB_SPIN_CAP) { atomicAdd(&bar[XB_TMO], 1u); break; } }
    }
    nloc = mine > 0u ? mine : 1u; nx = cnt > 0u ? cnt : 1u;
}
__device__ __forceinline__ void xcd_barrier(const XcdBarrier& b, bool leader) {
    asm volatile("s_waitcnt vmcnt(0)" ::: "memory");
    __syncthreads();
    if (leader) {
        unsigned* bar = b.bar;
        __builtin_amdgcn_s_waitcnt(0);
        unsigned nloc = b.st[0], nx = b.st[1];
        if (nloc == 0u) { xcd_barrier_complete(bar, b.x, nloc, nx); b.st[0] = nloc; b.st[1] = nx; }
        const unsigned old = xb_add(&bar[XB_XSUB(b.x)], 1u);
        const unsigned gen = old / nloc;
        if (old + 1u == (gen + 1u) * nloc) {
            __builtin_amdgcn_fence(__ATOMIC_RELEASE, "agent");
            asm volatile("s_waitcnt vmcnt(0)" ::: "memory");
            const unsigned og = xb_add(&bar[XB_TOP], 1u);
            const unsigned tg = og / nx;
            if (og + 1u == (tg + 1u) * nx) xb_add(&bar[XB_TOPGEN], 1u);
            else XB_SPIN(xb_ld(&bar[XB_TOPGEN]) == tg, bar);
            __builtin_amdgcn_fence(__ATOMIC_ACQUIRE, "agent");
            xb_add(&bar[XB_XGEN(b.x)], 1u);
            asm volatile("s_waitcnt vmcnt(0)" ::: "memory");
        } else {
            XB_SPIN(xb_ld(&bar[XB_XGEN(b.x)]) == gen, bar);
            __builtin_amdgcn_fence(__ATOMIC_ACQUIRE, "agent");
            asm volatile("s_waitcnt vmcnt(0)" ::: "memory");
        }
    }
    __syncthreads();
}

namespace g8 {
constexpr int BM = 256, BK = 64, HALF = 128, HTB = HALF * BK * 2, STAGE_BYTES = 8 * HTB, NXCD = 8, WGM = 8;
__host__ __device__ __forceinline__ int lds_byte(int r, int c) { const int st = (r >> 4) * 2 + (c >> 5), rr = r & 15, cc = c & 31, ob = rr * 64 + cc * 2; return st * 1024 + (ob ^ (((ob >> 9) & 1) << 5)); }
__host__ __device__ __forceinline__ void stage_rc(int b, int& R, int& C) { const int st = b / 1024, sb = b % 1024, swz = sb ^ (((sb >> 9) & 1) << 5); R = (st >> 1) * 16 + swz / 64; C = (st & 1) * 32 + (swz % 64) / 2; }
__host__ __device__ __forceinline__ int perm32(int rho) { const int n = rho >> 4, i = rho & 15; return 8 * (i >> 2) + 4 * n + (i & 3); }

struct Unit { const char* a; const char* b; int pm, pn, kind, ex; };

__device__ __forceinline__ void tile_of(int L, int nM, int nN, int& pm, int& pn) {
    const int nwg = nM * nN; int wgid = L;
    { const int q = nwg / NXCD, r = nwg % NXCD, xcd = wgid % NXCD, off = wgid / NXCD; wgid = (xcd < r ? xcd * (q + 1) : r * (q + 1) + (xcd - r) * q) + off; }
    const int nig = WGM * nN, gid = wgid / nig, fm = gid * WGM, gsz = (nM - fm) < WGM ? (nM - fm) : WGM;
    pm = fm + ((wgid % nig) % gsz); pn = (wgid % nig) / gsz;
}

typedef int i32x8 __attribute__((ext_vector_type(8)));
template <bool FP8, bool GATHER, bool SP2, class Epi, class Sched>
__device__ __forceinline__ void gemm_phase_s(LAS unsigned char* lds, const int K, const Sched& S, const Epi& E, const int wid, const int lane) {
    const int tid = wid * 64 + lane, wr = wid >> 2, wc = wid & 3, fr = lane & 15, fq = lane >> 4;
    const int nt = FP8 ? K / 128 : K / BK;
    const int RP = FP8 ? K : 2 * K;
    unsigned voffA[2], voffB[2]; int srow[2], scol[2];
#pragma unroll
    for (int i = 0; i < 2; ++i) { int R, C; stage_rc(tid * 16 + i * 8192, R, C); const int Rb = (R & ~31) + perm32(R & 31);
        voffA[i] = (unsigned)(R * RP + C * 2); voffB[i] = (unsigned)(Rb * RP + C * 2); srow[i] = R; scol[i] = C * 2; }
    const size_t kstep = (size_t)(BK * 2);
    const size_t hstep = (size_t)HALF * RP;
    const unsigned ldsw = (unsigned)wid * 1024u;
    unsigned cO0[2], cO1[2], nO0[2], nO1[2];
#define PG8_GOFF(D0, D1, ui_) do { if constexpr (GATHER) { const LAS int* rw_ = S.rows(ui_); _Pragma("unroll") for (int i_ = 0; i_ < 2; ++i_) { \
        D0[i_] = (unsigned)rw_[srow[i_]] * (unsigned)RP + (unsigned)scol[i_]; D1[i_] = (unsigned)rw_[128 + srow[i_]] * (unsigned)RP + (unsigned)scol[i_]; } } \
      else { _Pragma("unroll") for (int i_ = 0; i_ < 2; ++i_) { D0[i_] = voffA[i_]; D1[i_] = voffA[i_] + (unsigned)hstep; } } } while (0)
    const int aoff = lds_byte(wr * 64 + fr, FP8 ? fq * 16 : fq * 8), boff = lds_byte(wc * 32 + fr, FP8 ? fq * 16 : fq * 8);
    constexpr int KOFF = FP8 ? 16 : 1024;
#define PG8_SA(b, h) (((b) * 2 + (h)) * HTB)
#define PG8_SB(b, h) ((4 + (b) * 2 + (h)) * HTB)
#define PG8_STAGE(bufoff, gbase, voff) do { _Pragma("unroll") for (int _i = 0; _i < 2; ++_i) \
        __builtin_amdgcn_global_load_lds((const unsigned*)((const char*)(gbase) + (voff)[_i]), (LAS unsigned*)(lds + (bufoff) + ldsw + _i * 8192), 16, 0, 0); } while (0)
#define PG8_LD32(p) __builtin_bit_cast(i32x8, __builtin_shufflevector(*(const LAS u32x4*)(p), *(const LAS u32x4*)((p) + 16), 0, 1, 2, 3, 4, 5, 6, 7))
#define PG8_LDA8(dst, b, h) do { _Pragma("unroll") for (int m = 0; m < 4; ++m) dst[m] = PG8_LD32(lds + PG8_SA(b, h) + aoff + m * 2048); } while (0)
#define PG8_LDB8(dst, b, h) do { _Pragma("unroll") for (int n = 0; n < 2; ++n) dst[n] = PG8_LD32(lds + PG8_SB(b, h) + boff + n * 2048); } while (0)
#define PG8_LDA(dst, b, h) do { _Pragma("unroll") for (int m = 0; m < 4; ++m) _Pragma("unroll") for (int k = 0; k < 2; ++k) dst[m][k] = *(const LAS bf16x8*)(lds + PG8_SA(b, h) + aoff + m * 2048 + k * KOFF); } while (0)
#define PG8_LDB(dst, b, h) do { _Pragma("unroll") for (int n = 0; n < 2; ++n) _Pragma("unroll") for (int k = 0; k < 2; ++k) dst[n][k] = *(const LAS bf16x8*)(lds + PG8_SB(b, h) + boff + n * 2048 + k * KOFF); } while (0)
#define PG8_MMA(ai, bj, At, Bt) do { __builtin_amdgcn_s_setprio(1); _Pragma("unroll") for (int m = 0; m < 4; ++m) _Pragma("unroll") for (int n = 0; n < 2; ++n) _Pragma("unroll") for (int k = 0; k < 2; ++k) \
        acc[ai][bj][m][n] = __builtin_amdgcn_mfma_f32_16x16x32_bf16(Bt[n][k], At[m][k], acc[ai][bj][m][n], 0, 0, 0); __builtin_amdgcn_s_setprio(0); } while (0)
#define PG8_MMA8(ai, bj, At, Bt) do { __builtin_amdgcn_s_setprio(1); _Pragma("unroll") for (int m = 0; m < 4; ++m) _Pragma("unroll") for (int n = 0; n < 2; ++n) \
        asm volatile("v_mfma_scale_f32_16x16x128_f8f6f4 %0, %1, %2, %0, %3, %3 op_sel_hi:[0,0,0]" : "+v"(acc[ai][bj][m][n]) : "v"(Bt[n]), "v"(At[m]), "v"(one_scale)); __builtin_amdgcn_s_setprio(0); } while (0)
#define PG8_WAIT_V(n) asm volatile("s_waitcnt vmcnt(" #n ")" ::: "memory")
#define PG8_WAIT_L(n) asm volatile("s_waitcnt lgkmcnt(" #n ")" ::: "memory")
#define PG8_BAR __builtin_amdgcn_s_barrier()
#define PG8_SCHED __builtin_amdgcn_sched_barrier(0)
    Unit cur, nxt; int ui = 0;
    if (!S.next(0, cur)) return;
    f32x4 acc[2][2][4][2];
#pragma unroll
    for (int a = 0; a < 2; ++a)
#pragma unroll
        for (int b = 0; b < 2; ++b)
#pragma unroll
            for (int m = 0; m < 4; ++m)
#pragma unroll
                for (int n = 0; n < 2; ++n) acc[a][b][m][n] = (f32x4){0.f, 0.f, 0.f, 0.f};
    bf16x8 At[4][2], B0[2][2], B1[2][2];
    i32x8 At8[4], B08[2], B18[2];
    const unsigned one_scale = 0x7f7f7f7fu;
    const char* cA = cur.a; const char* cB = cur.b;
    PG8_GOFF(cO0, cO1, 0);
    if constexpr (SP2) {
    PG8_STAGE(PG8_SB(0, 0), cB, voffB); PG8_STAGE(PG8_SB(0, 1), cB + hstep, voffB); PG8_STAGE(PG8_SA(0, 0), cA, cO0); PG8_STAGE(PG8_SA(0, 1), cA, cO1);
    if (wr == 1) PG8_BAR;
    PG8_WAIT_V(2); PG8_BAR;
    PG8_STAGE(PG8_SB(1, 0), cB + kstep, voffB); PG8_STAGE(PG8_SA(1, 0), cA + kstep, cO0); PG8_STAGE(PG8_SB(1, 1), cB + hstep + kstep, voffB);
    PG8_WAIT_V(6); PG8_BAR;
    } else {
    PG8_STAGE(PG8_SB(0, 0), cB, voffB); PG8_STAGE(PG8_SA(0, 0), cA, cO0); PG8_STAGE(PG8_SB(0, 1), cB + hstep, voffB); PG8_STAGE(PG8_SA(0, 1), cA, cO1);
    if (wr == 1) PG8_BAR;
    PG8_WAIT_V(4); PG8_BAR;
    PG8_STAGE(PG8_SB(1, 0), cB + kstep, voffB); PG8_STAGE(PG8_SA(1, 0), cA + kstep, cO0); PG8_STAGE(PG8_SB(1, 1), cB + hstep + kstep, voffB);
    PG8_WAIT_V(6); PG8_BAR;
    }
    for (;;) {
        const bool has_next = S.next(ui + 1, nxt);
        const char* nA = has_next ? nxt.a : cA; const char* nB = has_next ? nxt.b : cB;
        if (has_next) PG8_GOFF(nO0, nO1, ui + 1); else { _Pragma("unroll") for (int i_ = 0; i_ < 2; ++i_) { nO0[i_] = cO0[i_]; nO1[i_] = cO1[i_]; } }
#pragma unroll 1
        for (int t = 0; t < nt; t += 2) {
            const bool last = (t == nt - 2);
            const char* a1 = cA + (size_t)(t + 1) * kstep;
            const char* a2 = last ? nA : cA + (size_t)(t + 2) * kstep; const char* b2 = last ? nB : cB + (size_t)(t + 2) * kstep;
            const char* a3 = a2 + kstep; const char* b3 = b2 + kstep;
            unsigned o20[2], o21[2];
#pragma unroll
            for (int i_ = 0; i_ < 2; ++i_) { o20[i_] = last ? nO0[i_] : cO0[i_]; o21[i_] = last ? nO1[i_] : cO1[i_]; }
            if constexpr (FP8 && SP2) {
            PG8_LDB8(B08, 0, 0); PG8_LDB8(B18, 0, 1); PG8_SCHED; PG8_LDA8(At8, 0, 0); PG8_STAGE(PG8_SA(1, 1), a1, cO1);
            PG8_WAIT_V(8); PG8_WAIT_L(0); PG8_BAR; PG8_MMA8(0, 0, At8, B08); PG8_MMA8(0, 1, At8, B18); PG8_BAR; PG8_SCHED;
            PG8_LDA8(At8, 0, 1); PG8_STAGE(PG8_SB(0, 0), b2, voffB); PG8_STAGE(PG8_SB(0, 1), b2 + hstep, voffB); PG8_STAGE(PG8_SA(0, 0), a2, o20);
            PG8_WAIT_V(8); PG8_WAIT_L(0); PG8_BAR; PG8_MMA8(1, 0, At8, B08); PG8_MMA8(1, 1, At8, B18); PG8_BAR; PG8_SCHED;
            PG8_LDB8(B08, 1, 0); PG8_LDB8(B18, 1, 1); PG8_SCHED; PG8_LDA8(At8, 1, 0); PG8_STAGE(PG8_SA(0, 1), a2, o21);
            PG8_WAIT_V(8); PG8_WAIT_L(0); PG8_BAR; PG8_MMA8(0, 0, At8, B08); PG8_MMA8(0, 1, At8, B18); PG8_BAR; PG8_SCHED;
            PG8_LDA8(At8, 1, 1); PG8_STAGE(PG8_SB(1, 0), b3, voffB); PG8_STAGE(PG8_SB(1, 1), b3 + hstep, voffB); PG8_STAGE(PG8_SA(1, 0), a3, o20);
            PG8_WAIT_V(8); PG8_WAIT_L(0); PG8_BAR; PG8_MMA8(1, 0, At8, B08); PG8_MMA8(1, 1, At8, B18); PG8_BAR; PG8_SCHED;
            } else if constexpr (FP8) {
            PG8_LDB8(B08, 0, 0); PG8_SCHED; PG8_LDA8(At8, 0, 0); PG8_STAGE(PG8_SA(1, 1), a1, cO1);
            PG8_WAIT_L(8); PG8_BAR; PG8_WAIT_L(0); PG8_MMA8(0, 0, At8, B08); PG8_BAR; PG8_SCHED;
            PG8_LDB8(B18, 0, 1); PG8_STAGE(PG8_SB(0, 0), b2, voffB);
            PG8_BAR; PG8_WAIT_L(0); PG8_MMA8(0, 1, At8, B18); PG8_BAR;
            PG8_LDA8(At8, 0, 1); PG8_STAGE(PG8_SA(0, 0), a2, o20);
            PG8_BAR; PG8_WAIT_L(0); PG8_MMA8(1, 0, At8, B08); PG8_BAR; PG8_SCHED;
            PG8_STAGE(PG8_SB(0, 1), b2 + hstep, voffB);
            PG8_WAIT_V(6); PG8_BAR; PG8_MMA8(1, 1, At8, B18); PG8_BAR;
            PG8_LDB8(B08, 1, 0); PG8_SCHED; PG8_LDA8(At8, 1, 0); PG8_STAGE(PG8_SA(0, 1), a2, o21);
            PG8_WAIT_L(8); PG8_BAR; PG8_WAIT_L(0); PG8_MMA8(0, 0, At8, B08); PG8_BAR; PG8_SCHED;
            PG8_LDB8(B18, 1, 1); PG8_STAGE(PG8_SB(1, 0), b3, voffB);
            PG8_BAR; PG8_WAIT_L(0); PG8_MMA8(0, 1, At8, B18); PG8_BAR;
            PG8_LDA8(At8, 1, 1); PG8_STAGE(PG8_SA(1, 0), a3, o20);
            PG8_BAR; PG8_WAIT_L(0); PG8_MMA8(1, 0, At8, B08); PG8_BAR; PG8_SCHED;
            PG8_STAGE(PG8_SB(1, 1), b3 + hstep, voffB);
            PG8_WAIT_V(6); PG8_BAR; PG8_MMA8(1, 1, At8, B18); PG8_BAR;
            } else {
            PG8_LDB(B0, 0, 0); PG8_LDB(B1, 0, 1); PG8_SCHED; PG8_LDA(At, 0, 0); PG8_STAGE(PG8_SA(1, 1), a1, cO1);
            PG8_WAIT_V(8); PG8_WAIT_L(0); PG8_BAR; PG8_MMA(0, 0, At, B0); PG8_MMA(0, 1, At, B1); PG8_BAR; PG8_SCHED;
            PG8_LDA(At, 0, 1); PG8_STAGE(PG8_SB(0, 0), b2, voffB); PG8_STAGE(PG8_SB(0, 1), b2 + hstep, voffB); PG8_STAGE(PG8_SA(0, 0), a2, o20);
            PG8_WAIT_V(8); PG8_WAIT_L(0); PG8_BAR; PG8_MMA(1, 0, At, B0); PG8_MMA(1, 1, At, B1); PG8_BAR; PG8_SCHED;
            PG8_LDB(B0, 1, 0); PG8_LDB(B1, 1, 1); PG8_SCHED; PG8_LDA(At, 1, 0); PG8_STAGE(PG8_SA(0, 1), a2, o21);
            PG8_WAIT_V(8); PG8_WAIT_L(0); PG8_BAR; PG8_MMA(0, 0, At, B0); PG8_MMA(0, 1, At, B1); PG8_BAR; PG8_SCHED;
            PG8_LDA(At, 1, 1); PG8_STAGE(PG8_SB(1, 0), b3, voffB); PG8_STAGE(PG8_SB(1, 1), b3 + hstep, voffB); PG8_STAGE(PG8_SA(1, 0), a3, o20);
            PG8_WAIT_V(8); PG8_WAIT_L(0); PG8_BAR; PG8_MMA(1, 0, At, B0); PG8_MMA(1, 1, At, B1); PG8_BAR; PG8_SCHED;
            }
        }
        if (wr == 0) PG8_BAR;
        if constexpr (FP8) asm volatile("s_nop 15\n\ts_nop 15" ::: "memory");
        E(acc, cur, wr, wc, fr, fq);
        if (!has_next) break;
#pragma unroll
        for (int a = 0; a < 2; ++a)
#pragma unroll
            for (int b = 0; b < 2; ++b)
#pragma unroll
                for (int m = 0; m < 4; ++m)
#pragma unroll
                    for (int n = 0; n < 2; ++n) acc[a][b][m][n] = (f32x4){0.f, 0.f, 0.f, 0.f};
        cur = nxt; cA = nA; cB = nB; ++ui;
#pragma unroll
        for (int i_ = 0; i_ < 2; ++i_) { cO0[i_] = nO0[i_]; cO1[i_] = nO1[i_]; }
        if (wr == 1) PG8_BAR;
    }
    PG8_WAIT_V(0);
    PG8_BAR;
#undef PG8_SA
#undef PG8_GOFF
#undef PG8_SB
#undef PG8_STAGE
#undef PG8_LDA
#undef PG8_LDB
#undef PG8_MMA
#undef PG8_MMA8
#undef PG8_LDA8
#undef PG8_LDB8
#undef PG8_LD32
#undef PG8_WAIT_V
#undef PG8_WAIT_L
#undef PG8_BAR
#undef PG8_SCHED
}
template <bool FP8, bool GATHER, class Epi, class Sched>
__device__ __forceinline__ void gemm_phase_g(LAS unsigned char* lds, const int K, const Sched& S, const Epi& E, const int wid, const int lane) { gemm_phase_s<FP8, GATHER, !FP8>(lds, K, S, E, wid, lane); }
template <bool FP8, class Epi, class Sched>
__device__ __forceinline__ void gemm_phase(LAS unsigned char* lds, const int K, const Sched& S, const Epi& E, const int wid, const int lane) { gemm_phase_s<FP8, false, !FP8>(lds, K, S, E, wid, lane); }
}

__device__ __forceinline__ int lane_id() { int l; asm volatile("v_mbcnt_lo_u32_b32 %0, -1, 0\n\tv_mbcnt_hi_u32_b32 %0, -1, %0" : "=v"(l)); return l; }
#define FT_DECL const int f_lane = lane_id(), f_tid = F.wave * 64 + f_lane; (void)f_tid; (void)f_lane
typedef const float* cfp_t;
typedef __attribute__((address_space(4))) cfp_t* kin_t;
struct Frame {
    LAS unsigned char* lds;
    volatile LAS unsigned* MISC;
    gu32* ctl;
    int wave, vcu, G;
    kin_t in;
    float* out;
    unsigned char* ws;
};
#define WSP(T, off) ((T*)(F.ws + (off)))

template <class RowMap>
__device__ __forceinline__ void p0_transpose_item(const float* W, int K, int N, bf16_t* WT, const RowMap& rowmap, const float* kscale, LAS float* scr, int item, int lane, bool kperm = false) {
    const int nblk = N / 32, kb = item / nblk, nb = item % nblk, k0 = 64 * kb, n0 = 32 * nb;
#pragma unroll 8
    for (int i = 0; i < 32; ++i) { const int kk = 2 * i + (lane >> 5); int ks = k0 + kk; if (kperm && ks >= K / 2) { const int j = ks - K / 2; ks = K / 2 + (j >> 3) + 64 * (j & 7); }
        float v = W[(size_t)ks * N + n0 + (lane & 31)]; if (kscale) v *= kscale[k0 + kk]; scr[kk * 33 + (lane & 31)] = v; }
    LDS_WAIT(); asm volatile("" ::: "memory");
    const int c = lane & 7;
#pragma unroll
    for (int j = 0; j < 4; ++j) { const int n = (lane >> 3) + 8 * j; const LAS float* s = scr + (8 * c) * 33 + n;
        u32x4 o; o.x = cvt_pk_bf16(s[0 * 33], s[1 * 33]); o.y = cvt_pk_bf16(s[2 * 33], s[3 * 33]); o.z = cvt_pk_bf16(s[4 * 33], s[5 * 33]); o.w = cvt_pk_bf16(s[6 * 33], s[7 * 33]);
        *(GAS u32x4*)(WT + (size_t)rowmap(n0 + n) * K + k0 + 8 * c) = o; }
    LDS_WAIT(); asm volatile("" ::: "memory");
}

__device__ __forceinline__ unsigned pk4_fp8(float a, float b, float c, float d) { int r = __builtin_amdgcn_cvt_pk_fp8_f32(a, b, 0, false); r = __builtin_amdgcn_cvt_pk_fp8_f32(c, d, r, true); return (unsigned)r; }
constexpr float EOSCALE = 16.f;
constexpr float WSCALE = 32.f;
template <class RowMap>
__device__ __forceinline__ void p0_transpose_item_f8(const float* W, int K, int N, unsigned char* WT, const RowMap& rowmap, LAS float* scr, int item, int lane) {
    const int nblk = N / 32, kb = item / nblk, nb = item % nblk, k0 = 128 * kb, n0 = 32 * nb;
#pragma unroll
    for (int hh = 0; hh < 2; ++hh) { float v[32];
#pragma unroll
        for (int i = 0; i < 32; ++i) { const int kk = 2 * (32 * hh + i) + (lane >> 5); v[i] = __builtin_nontemporal_load(W + (size_t)(k0 + kk) * N + n0 + (lane & 31)); }
#pragma unroll
        for (int i = 0; i < 32; ++i) { const int kk = 2 * (32 * hh + i) + (lane >> 5); scr[kk * 33 + (lane & 31)] = v[i] * WSCALE; } }
    LDS_WAIT(); asm volatile("" ::: "memory");
    const int c = lane & 7;
#pragma unroll
    for (int j = 0; j < 4; ++j) { const int n = (lane >> 3) + 8 * j; const LAS float* sp = scr + (16 * c) * 33 + n;
        u32x4 o; o.x = pk4_fp8(sp[0 * 33], sp[1 * 33], sp[2 * 33], sp[3 * 33]); o.y = pk4_fp8(sp[4 * 33], sp[5 * 33], sp[6 * 33], sp[7 * 33]);
        o.z = pk4_fp8(sp[8 * 33], sp[9 * 33], sp[10 * 33], sp[11 * 33]); o.w = pk4_fp8(sp[12 * 33], sp[13 * 33], sp[14 * 33], sp[15 * 33]);
        *(GAS u32x4*)(WT + (size_t)rowmap(n0 + n) * K + k0 + 16 * c) = o; }
    LDS_WAIT(); asm volatile("" ::: "memory");
}
struct MapW2 { __device__ __forceinline__ int operator()(int l) const { const int t = l & ~255, r = l & 255, wc = r >> 6, fq = (r >> 4) & 3, bj = (r >> 3) & 1, low = r & 7; return t + 128 * bj + 32 * wc + 8 * fq + low; } };
struct MapIdent { int off; __device__ __forceinline__ int operator()(int n) const { return off + n; } };
struct MapWin { __device__ __forceinline__ int operator()(int l) const {
    if (l >= 1024) return l;
    const int t = l & ~255, r = l & 255, wc = r >> 6, blk = (r >> 5) & 1, bj = (r >> 4) & 1, low = r & 15;
    return t + 128 * bj + 32 * wc + 16 * blk + low; } };
struct MapW1 { int off; __device__ __forceinline__ int operator()(int jp) const { const int bj = jp >> 10, j = jp & 1023; return off + 256 * (j >> 7) + 128 * bj + (j & 127); } };


__device__ __forceinline__ void p0_filter_item(Frame& F, int item) {
    FT_DECL;
#define in F.in
    LAS float* h1s = (LAS float*)(F.lds);
    LAS float* h2s = (LAS float*)(F.lds + 4096);
    const int t0 = item * 16;
    {
        const int tt = f_tid >> 5, hh = (f_tid & 31) * 2; const float pos = (float)(t0 + tt);
        float feats[17]; feats[0] = pos * (1.f / SEQ);
#pragma unroll
        for (int i = 0; i < 8; ++i) { const float band = 1e-4f + (float)i * ((7.f - 1e-4f) / 7.f); const float ang = (6.283185307179586f / SEQ) * pos * band; feats[1 + i] = __sinf(ang); feats[9 + i] = __cosf(ang); }
#pragma unroll
        for (int u = 0; u < 2; ++u) { const int h = hh + u; float a = in[19][h];
#pragma unroll
            for (int k = 0; k < 17; ++k) a += feats[k] * in[18][k * 64 + h];
            h1s[tt * 64 + h] = __sinf(in[20][h] * a); }
        __syncthreads();
#pragma unroll
        for (int u = 0; u < 2; ++u) { const int h = hh + u; float a = in[22][h];
#pragma unroll 8
            for (int k = 0; k < 64; ++k) a += h1s[tt * 64 + k] * in[21][k * 64 + h];
            h2s[tt * 64 + h] = __sinf(in[23][h] * a); }
        __syncthreads();
    }
    f32x4 acc[16];
#pragma unroll
    for (int t = 0; t < 16; ++t) acc[t] = (f32x4){0.f, 0.f, 0.f, 0.f};
    const int o = 4 * f_tid;
    for (int k0 = 0; k0 < 64; k0 += 4) { f32x4 w[4];
#pragma unroll
        for (int q = 0; q < 4; ++q) w[q] = *(const f32x4*)(in[24] + (size_t)(k0 + q) * 2048 + o);
#pragma unroll
        for (int t = 0; t < 16; ++t) { const f32x4 hv = *(const LAS f32x4*)(h2s + t * 64 + k0); acc[t] += w[0] * hv[0] + w[1] * hv[1] + w[2] * hv[2] + w[3] * hv[3]; } }
    const int c0 = o & 511, od = o >> 9;
    float* dst = WSP(float, WS_FILT) + ((size_t)od * 512 + c0) * SEQ + t0;
#pragma unroll
    for (int e = 0; e < 4; ++e) { const float la = -3.0701134573253944f, lb = -15.350567286626972f; const float delta = fabsf(la + (float)(c0 + e) * ((lb - la) / 511.f));
#pragma unroll
        for (int q = 0; q < 4; ++q) { f32x4 v;
#pragma unroll
            for (int i = 0; i < 4; ++i) { const int t = 4 * q + i; const float tn = (float)(t0 + t) * (1.f / SEQ); v[i] = acc[t][e] * __expf(-tn * delta); }
            *(f32x4*)(dst + (size_t)e * SEQ + 4 * q) = v; } }
    __syncthreads();
#undef in
}

__device__ __forceinline__ float silu_f(float v) { return v / (1.f + __expf(-v)); }

__device__ __forceinline__ void p0_prologue(Frame& F) {
    FT_DECL;
#define in F.in
    const int wg = blockIdx.x;
    if (wg < 96) {
        LAS float* sv = (LAS float*)F.lds;
        for (int i = f_tid; i < 9 * 1024; i += 512) { const int r = i >> 10, k = i & 1023; const float c = (r < 8) ? in[1][r * 1024 + k] : in[3][k]; sv[i] = silu_f(c); }
        __syncthreads();
        const int j = wg * 64 + f_lane; const float* wm = in[4];
        float acc[9];
#pragma unroll
        for (int r = 0; r < 9; ++r) acc[r] = 0.f;
        const int kbeg = F.wave * 128;
        for (int k0 = kbeg; k0 < kbeg + 128; k0 += 16) { float w[16];
#pragma unroll
            for (int q = 0; q < 16; ++q) w[q] = __builtin_nontemporal_load(wm + (size_t)(k0 + q) * (NMOD * DM) + j);
#pragma unroll
            for (int q = 0; q < 16; ++q)
#pragma unroll
                for (int r = 0; r < 9; ++r) acc[r] += sv[r * 1024 + k0 + q] * w[q]; }
        LAS float* red = (LAS float*)(F.lds + 40960);
#pragma unroll
        for (int r = 0; r < 9; ++r) red[(F.wave * 9 + r) * 64 + f_lane] = acc[r];
        __syncthreads();
        for (int i = f_tid; i < 9 * 64; i += 512) { const int r = i >> 6, l = i & 63; float s = in[5][wg * 64 + l];
#pragma unroll
            for (int w = 0; w < 8; ++w) s += red[(w * 9 + r) * 64 + l];
            WSP(float, WS_SMALL + SM_MOD)[r * (NMOD * DM) + wg * 64 + l] = s; }
        __syncthreads();
    } else if (wg == 96) {
        if (F.wave == 0) {
            const float a = wave_sum(in[11][f_lane] * in[12][f_lane]), b = wave_sum(in[13][f_lane] * in[14][f_lane]);
            float gq = fabsf(in[9][f_lane]), gk = fabsf(in[10][f_lane]);
#pragma unroll
            for (int o = 1; o < 64; o <<= 1) { gq = fmaxf(gq, __shfl_xor(gq, o)); gk = fmaxf(gk, __shfl_xor(gk, o)); }
            if (f_lane == 0) { float* sc = WSP(float, WS_SMALL + SM_SCAL); sc[0] = expf(a) - expf(b) + LAM_INIT;
                sc[1] = (8.f * gq * gk * 1.02f + 0.05f) * 1.4426950408889634f; }
        }
        for (int i = f_tid; i < 64 * 16; i += 512) { const int pos = i >> 4, f = i & 15;
            const float inv = powf(10000.f, -(float)f / 16.f); const float ang = (float)pos * inv;
            float* rt = WSP(float, WS_SMALL + SM_ROPE); rt[2 * i] = cosf(ang); rt[2 * i + 1] = sinf(ang); }
    }
    __syncthreads();
    for (int it = wg; it < SEQ / 16; it += F.G) p0_filter_item(F, it);
    __syncthreads();
    {
        LAS float* scr = (LAS float*)(F.lds + F.wave * 16896);
        const int gw = F.vcu * NWAVES + F.wave, NGW = F.G * NWAVES;
        constexpr int I_IN = (DM / 64) * (INC / 32), I_OUT = (DM / 64) * (DM / 32), I_1 = (DM / 128) * (2 * DM / 32), I_2 = (DM / 128) * (DM / 32);
        constexpr int NITEMS = I_IN + I_OUT + NEXP * (I_1 + I_2);
        for (int it = gw; it < NITEMS; it += NGW) {
            int r = it;
            if (r < I_IN) { p0_transpose_item(in[8], DM, INC, WSP(bf16_t, WS_WIN), MapWin{}, nullptr, scr, r, f_lane); continue; } r -= I_IN;
            if (r < I_OUT) { p0_transpose_item(in[27], DM, DM, WSP(bf16_t, WS_WOUT), MapIdent{0}, nullptr, scr, r, f_lane, true); continue; } r -= I_OUT;
            const int e = r / (I_1 + I_2); r -= e * (I_1 + I_2);
            if (r < I_1) p0_transpose_item_f8(in[30] + (size_t)e * DM * 2 * DM, DM, 2 * DM, WSP(unsigned char, WS_W1) + (size_t)e * 2 * DM * DM, MapW1{0}, scr, r, f_lane);
            else p0_transpose_item_f8(in[32] + (size_t)e * DM * DM, DM, DM, WSP(unsigned char, WS_W2) + (size_t)e * DM * DM, MapW2{}, scr, r - I_1, f_lane);
        }
    }
}
#undef in

__device__ __forceinline__ void p1_norm1(Frame& F) {
    FT_DECL;
    const int gw = F.vcu * NWAVES + F.wave, NGW = F.G * NWAVES;
    const float* mod = WSP(float, WS_SMALL + SM_MOD); const float* g1 = F.in[6];
    bf16_t* H = WSP(bf16_t, WS_H);
    for (int pe = blockIdx.x; pe < NB * NEXP; pe += F.G) { const int b = pe >> 5, e = pe & 31; const float* sh2 = mod + (size_t)b * (NMOD * DM) + 3 * DM; const float* rw = F.in[28];
        const int t = F.wave * 64 + lane_id();
        float a = sh2[t] * rw[(size_t)t * 32 + e] + sh2[t + 512] * rw[(size_t)(t + 512) * 32 + e];
        a = wave_sum(a);
        LAS float* red = (LAS float*)F.lds;
        __syncthreads(); if (lane_id() == 0) red[F.wave] = a; __syncthreads();
        if (t == 0) { float sacc = F.in[29][e];
#pragma unroll
            for (int w = 0; w < NWAVES; ++w) sacc += red[w];
            WSP(float, WS_SMALL + SM_RBIAS)[pe] = sacc; }
        __syncthreads(); }
    constexpr int RPW = MTOT / (256 * NWAVES);
    for (int run = gw; run * RPW < MTOT; run += NGW) {
        const int r0 = run * RPW, r1 = (r0 + RPW < MTOT) ? r0 + RPW : MTOT;
        int curb = -1; f32x4 PA[4], PB[4];
        for (int m0 = r0; m0 < r1; m0 += 4) {
            f32x4 v[4][4];
#pragma unroll
            for (int u = 0; u < 4; ++u) { const int m = m0 + u; if (m < r1) {
                const float* xrow = (m < MROWS) ? F.in[0] + (size_t)m * DM : F.in[2] + (size_t)(m - MROWS) * DM; const GAS f32x4* xr = (const GAS f32x4*)xrow + f_lane;
#pragma unroll
                for (int j = 0; j < 4; ++j) v[u][j] = __builtin_nontemporal_load(xr + 64 * j); } }
#pragma unroll
            for (int u = 0; u < 4; ++u) { const int m = m0 + u; if (m < r1) {
                const int mb = (m < MROWS) ? (m >> 12) : 8;
                if (mb != curb) { curb = mb; const float* sh = mod + (size_t)mb * (NMOD * DM); const float* sc = sh + DM;
#pragma unroll
                    for (int j = 0; j < 4; ++j) { const int c = 4 * f_lane + 256 * j; PA[j] = *(const f32x4*)(g1 + c) * (*(const f32x4*)(sc + c) + 1.f); PB[j] = *(const f32x4*)(sh + c); } }
                float s = 0.f;
#pragma unroll
                for (int j = 0; j < 4; ++j) s += (v[u][j].x * v[u][j].x + v[u][j].y * v[u][j].y) + (v[u][j].z * v[u][j].z + v[u][j].w * v[u][j].w);
                const float rstd = rsqrtf(wave_sum(s) * (1.f / DM) + EPS);
                GAS u32x2* o8 = (GAS u32x2*)(H + (size_t)m * DM) + f_lane;
#pragma unroll
                for (int j = 0; j < 4; ++j) { const f32x4 y = v[u][j] * rstd * PA[j] + PB[j];
                    u32x2 w; w.x = cvt_pk_bf16(y.x, y.y); w.y = cvt_pk_bf16(y.z, y.w); o8[64 * j] = w; } } }
        }
    }
}

struct SchedInProj {
    int G, c; const char* H; const char* W;
    static constexpr int NA = 136 * 4, NV = 2 * 136, NBU = 6 * 128;
    __device__ __forceinline__ bool next(int i, g8::Unit& u) const {
        const long L = (long)i * G + c;
        if (L < NA) { g8::tile_of((int)L, 136, 4, u.pm, u.pn); u.a = H + (size_t)u.pm * 256 * DM * 2; u.b = W + (size_t)u.pn * 256 * DM * 2; u.kind = 0; u.ex = 0; return true; }
        if (L < NA + NV) { g8::tile_of((int)L - NA, 2, 136, u.pm, u.pn); u.a = W + (size_t)(1024 + u.pm * 256) * DM * 2; u.b = H + (size_t)u.pn * 256 * DM * 2; u.kind = 2; u.ex = 0; return true; }
        if (L < NA + NV + NBU) { g8::tile_of((int)L - NA - NV, 6, 128, u.pm, u.pn); u.a = W + (size_t)(QKVC + u.pm * 256) * DM * 2; u.b = H + (size_t)u.pn * 256 * DM * 2; u.kind = 1; u.ex = 0; return true; }
        return false;
    }
};
constexpr float Q8SCALE = 16.f;
struct EpiInProj {
    unsigned char *Q8, *K8, *VT8; bf16_t* UT; const float *gq, *gk, *rope;
    __device__ __forceinline__ void operator()(f32x4 (&acc)[2][2][4][2], const g8::Unit& u, int wr, int wc, int fr, int fq) const {
        asm volatile("" : "+v"(fr), "+v"(fq));
        if (u.kind == 1) {
            const int row0 = u.pm * 256 + wr * 64 + fr, col0 = u.pn * 256 + wc * 32 + 8 * fq;
#pragma unroll
            for (int ai = 0; ai < 2; ++ai)
#pragma unroll
                for (int m = 0; m < 4; ++m) { const int ch = row0 + ai * 128 + m * 16;
#pragma unroll
                    for (int bj = 0; bj < 2; ++bj) { const int tok = col0 + bj * 128; const f32x4 v0 = acc[ai][bj][m][0], v1 = acc[ai][bj][m][1];
                        u32x4 w; w.x = cvt_pk_bf16(v0[0], v0[1]); w.y = cvt_pk_bf16(v0[2], v0[3]); w.z = cvt_pk_bf16(v1[0], v1[1]); w.w = cvt_pk_bf16(v1[2], v1[3]);
                        *(u32x4*)(UT + ((size_t)(tok >> 7) * HYC + ch) * 128 + (tok & 127)) = w; } }
            return;
        }
        if (u.kind == 2) {
#pragma unroll
            for (int bj = 0; bj < 2; ++bj) { const int t8 = u.pn * 256 + bj * 128 + wc * 32 + 8 * fq;
                int b, key; if (t8 < MROWS) { b = t8 >> 12; key = CTXL + (t8 & 4095); } else { const int j = t8 - MROWS; b = j >> 8; key = j & 255; }
                const int tile = key >> 6, k = key & 63, ipos = (k < 32) ? 4 * (k >> 3) : 16 + 4 * ((k - 32) >> 3);
#pragma unroll
                for (int ai = 0; ai < 2; ++ai)
#pragma unroll
                    for (int m = 0; m < 4; ++m) { const int ch = u.pm * 256 + ai * 128 + wr * 64 + m * 16 + fr;
                        unsigned char* dst = VT8 + ((((size_t)(b * NHEAD + (ch >> 7)) * 68 + tile) * 128 + (ch & 127)) * 64) + ipos;
                        const f32x4 v0 = acc[ai][bj][m][0], v1 = acc[ai][bj][m][1];
                        *(unsigned*)dst = pk4_fp8(v0[0], v0[1], v0[2], v0[3]); *(unsigned*)(dst + 32) = pk4_fp8(v1[0], v1[1], v1[2], v1[3]); } }
            return;
        }
        const int blk = fq >> 1, f = fq & 1;
        const int sec = u.pn >> 1;
        const bool ctx = (u.pm >= 128);
        if (sec == 0 && ctx) return;
        const int colbase = (u.pn & 1) * 256 + wc * 64 + 32 * blk + 8 * f;
        float gg[2][2][4];
        { const float* gp = (sec == 0 ? gq : gk) + 32 * blk + 8 * f;
#pragma unroll
            for (int bj = 0; bj < 2; ++bj)
#pragma unroll
                for (int n = 0; n < 2; ++n) { const f32x4 t = *(const f32x4*)(gp + 16 * bj + 4 * n); gg[bj][n][0] = t[0]; gg[bj][n][1] = t[1]; gg[bj][n][2] = t[2]; gg[bj][n][3] = t[3]; } }
#pragma unroll
        for (int ai = 0; ai < 2; ++ai)
#pragma unroll
            for (int m = 0; m < 4; ++m) {
                const int rloc = ai * 128 + wr * 64 + m * 16 + fr; const int r = u.pm * 256 + rloc;
                f32x4 v[2][2];
#pragma unroll
                for (int bj = 0; bj < 2; ++bj)
#pragma unroll
                    for (int n = 0; n < 2; ++n) v[bj][n] = acc[ai][bj][m][n];
                size_t orow;
                if (sec == 0) orow = (size_t)r;
                else if (!ctx) orow = (size_t)(r >> 12) * KVL + CTXL + (r & 4095);
                else { const int j = r - MROWS; orow = (size_t)(j >> 8) * KVL + (j & 255); }
                float ss = 0.f;
#pragma unroll
                for (int bj = 0; bj < 2; ++bj)
#pragma unroll
                    for (int n = 0; n < 2; ++n) ss += (v[bj][n][0] * v[bj][n][0] + v[bj][n][1] * v[bj][n][1]) + (v[bj][n][2] * v[bj][n][2] + v[bj][n][3] * v[bj][n][3]);
                ss += __shfl_xor(ss, 16); ss += __shfl_xor(ss, 32);
                const float rstd = rsqrtf(ss * (1.f / 64.f) + EPS) * (sec == 0 ? QSCALE * Q8SCALE : 1.f);
#pragma unroll
                for (int bj = 0; bj < 2; ++bj)
#pragma unroll
                    for (int n = 0; n < 2; ++n)
#pragma unroll
                        for (int e = 0; e < 4; ++e) v[bj][n][e] *= rstd * gg[bj][n][e];
                if (!ctx) {
                    const int t = r & 4095; const int pos = blk ? (t & 63) : (t >> 6);
                    const float* rp = rope + (size_t)(pos * 16 + 8 * f) * 2;
#pragma unroll
                    for (int n = 0; n < 2; ++n) { const f32x4 c0 = *(const f32x4*)(rp + 8 * n), c1 = *(const f32x4*)(rp + 8 * n + 4);
                        const float cs[4] = {c0[0], c0[2], c1[0], c1[2]}, sn[4] = {c0[1], c0[3], c1[1], c1[3]};
#pragma unroll
                        for (int e = 0; e < 4; ++e) { const float x1 = v[0][n][e], x2 = v[1][n][e]; v[0][n][e] = x1 * cs[e] - x2 * sn[e]; v[1][n][e] = x2 * cs[e] + x1 * sn[e]; } }
                }
                unsigned char* dst = (sec == 0 ? Q8 : K8) + orow * QKW + colbase;
#pragma unroll
                for (int bj = 0; bj < 2; ++bj) { u32x2 w; w.x = pk4_fp8(v[bj][0][0], v[bj][0][1], v[bj][0][2], v[bj][0][3]); w.y = pk4_fp8(v[bj][1][0], v[bj][1][1], v[bj][1][2], v[bj][1][3]);
                    *(u32x2*)(dst + 16 * bj) = w; }
            }
    }
};

struct SchedStatic {
    int G, c, nM, nN; const char* A; const char* B;
    __device__ __forceinline__ bool next(int i, g8::Unit& u) const {
        const long L = (long)i * G + c; if (L >= (long)nM * nN) return false;
        g8::tile_of((int)L, nM, nN, u.pm, u.pn); u.a = A + (size_t)u.pm * 256 * DM * 2; u.b = B + (size_t)u.pn * 256 * DM * 2; u.kind = 0; u.ex = 0; return true;
    }
};
struct EpiOutProj {
    const float* x; bf16_t* out; const float* mod;
    __device__ __forceinline__ void operator()(f32x4 (&acc)[2][2][4][2], const g8::Unit& u, int wr, int wc, int fr, int fq) const {
        asm volatile("" : "+v"(fr), "+v"(fq));
        const int col0 = u.pn * 256 + wc * 32 + 8 * fq;
        const float* g1 = mod + (size_t)((u.pm * 256) >> 12) * (NMOD * DM) + 2 * DM + col0;
        f32x4 gv[2][2];
#pragma unroll
        for (int bj = 0; bj < 2; ++bj)
#pragma unroll
            for (int n = 0; n < 2; ++n) gv[bj][n] = *(const f32x4*)(g1 + bj * 128 + 4 * n);
#pragma unroll
        for (int ai = 0; ai < 2; ++ai)
#pragma unroll
            for (int m = 0; m < 4; ++m) { const int r = u.pm * 256 + ai * 128 + wr * 64 + m * 16 + fr;
                const size_t off = (size_t)r * DM + col0;
#pragma unroll
                for (int bj = 0; bj < 2; ++bj) { f32x4 o[2];
#pragma unroll
                    for (int n = 0; n < 2; ++n) { const f32x4 xv = __builtin_nontemporal_load((const f32x4*)(x + off + bj * 128 + 4 * n)); o[n] = xv + gv[bj][n] * acc[ai][bj][m][n]; }
                    u32x4 w; w.x = cvt_pk_bf16(o[0][0], o[0][1]); w.y = cvt_pk_bf16(o[0][2], o[0][3]); w.z = cvt_pk_bf16(o[1][0], o[1][1]); w.w = cvt_pk_bf16(o[1][2], o[1][3]);
                    *(u32x4*)(out + off + bj * 128) = w; } }
    }
};

namespace att8 {
constexpr int NT = KVL / 64, SHMB = 8192, NBUF = 6, LDS_V0 = NBUF * SHMB;
typedef int i32x8 __attribute__((ext_vector_type(8)));
#define SBAR() __builtin_amdgcn_sched_barrier(0)
__device__ __forceinline__ int crow(int r, int hi) { return (r & 3) + 8 * (r >> 2) + 4 * hi; }
__device__ __forceinline__ i32x8 ld32(const LAS unsigned char* p0, const LAS unsigned char* p1) {
    const u32x4 a = *(const LAS u32x4*)p0, b = *(const LAS u32x4*)p1; return (i32x8){(int)a.x, (int)a.y, (int)a.z, (int)a.w, (int)b.x, (int)b.y, (int)b.z, (int)b.w}; }
__device__ __forceinline__ void mfma_qk(f32x16& p, const i32x8& kf, const i32x8& qf, const f32x16& negc) {
    const unsigned s1 = 0x7f7f7f7fu, sq = 0x7b7b7b7bu;
    asm volatile("v_mfma_scale_f32_32x32x64_f8f6f4 %0, %1, %2, %3, %4, %5 op_sel_hi:[0,0,0]" : "=&v"(p) : "v"(kf), "v"(qf), "v"(negc), "v"(s1), "v"(sq));
}
__device__ __forceinline__ void mfma_pv(f32x16& o, const i32x8& pa, const i32x8& vf) {
    const unsigned s1 = 0x7f7f7f7fu;
    asm volatile("v_mfma_scale_f32_32x32x64_f8f6f4 %0, %1, %2, %0, %3, %3 op_sel_hi:[0,0,0]" : "+v"(o) : "v"(pa), "v"(vf), "v"(s1));
}
__device__ __forceinline__ void mfma_wait(f32x16& p0, f32x16& p1) { asm volatile("s_nop 15\n\ts_nop 3" : "+v"(p0), "+v"(p1)); }
__device__ __forceinline__ int grp(const f32x16& s, const int g, int old) {
    old = __builtin_amdgcn_cvt_pk_fp8_f32(__builtin_amdgcn_exp2f(s[4 * g]), __builtin_amdgcn_exp2f(s[4 * g + 1]), old, false);
    return __builtin_amdgcn_cvt_pk_fp8_f32(__builtin_amdgcn_exp2f(s[4 * g + 2]), __builtin_amdgcn_exp2f(s[4 * g + 3]), old, true);
}
__device__ __forceinline__ void attn_unit(const unsigned char* __restrict__ Qb, const unsigned char* __restrict__ Kh, const unsigned char* __restrict__ VTh, bf16_t* MIXo,
                                          const float lam, const float* __restrict__ subg, char* lds, const int wid) {
    const int lane = lane_id(), tid = wid * 64 + lane, r32 = lane & 31, hi = lane >> 5;
    const int sub = wid >> 2, wq = wid & 3;
    const LAS unsigned char* L = (const LAS unsigned char*)(uintptr_t)(unsigned)(uintptr_t)lds;
    f32x16 o[4] = {}; f32x16 ol = {};
    i32x8 ones; { int c1 = 0x38383838; asm volatile("" : "+v"(c1)); ones = (i32x8){c1, c1, c1, c1, c1, c1, c1, c1}; }
    i32x8 qf; { const unsigned char* qp = Qb + (size_t)(wq * 32 + r32) * QKW + sub * 64 + 32 * hi; const u32x4 a = *(const u32x4*)qp, b = *(const u32x4*)(qp + 16);
        qf = (i32x8){(int)a.x, (int)a.y, (int)a.z, (int)a.w, (int)b.x, (int)b.y, (int)b.z, (int)b.w}; }
    f32x16 negc; { float m5 = -5.f; asm volatile("" : "+v"(m5));
#pragma unroll
        for (int r = 0; r < 16; ++r) negc[r] = m5; }
    long ksrc, vsrc;
    { const int r = 8 * wid + (lane >> 3), c = (lane & 7) ^ ((r >> 1) & 7); ksrc = (long)r * QKW + c * 16; }
    { const int d = 16 * wid + (lane >> 2), c = (lane & 3) ^ ((d >> 2) & 3); vsrc = (long)d * 64 + c * 16; }
    const unsigned ldsb = (unsigned)(uintptr_t)lds, kdst = ldsb + (unsigned)wid * 1024u, vdst = ldsb + LDS_V0 + (unsigned)wid * 1024u;
    const LAS unsigned char *pk0, *pk1, *pv0, *pv1;
    { const int c0 = sub * 4 + hi * 2, sk = (r32 >> 1) & 7, sv = (r32 >> 2) & 3;
      pk0 = L + r32 * 128 + ((c0 ^ sk) << 4); pk1 = L + r32 * 128 + (((c0 + 1) ^ sk) << 4);
      pv0 = L + LDS_V0 + r32 * 64 + (((2 * hi) ^ sv) << 4); pv1 = L + LDS_V0 + r32 * 64 + (((2 * hi + 1) ^ sv) << 4); }
#define KF(b, w) ld32(pk0 + (b) * SHMB + (w) * 4096, pk1 + (b) * SHMB + (w) * 4096)
#define VF(b, d0) ld32(pv0 + (b) * SHMB + (d0) * 2048, pv1 + (b) * SHMB + (d0) * 2048)
#define DMA_TILE(t, b) do { \
        __builtin_amdgcn_global_load_lds((const unsigned*)(Kh + (long)(t) * 64 * QKW + ksrc), (LAS unsigned*)(uintptr_t)__builtin_amdgcn_readfirstlane(kdst + (unsigned)((b) * SHMB)), 16, 0, 0); \
        __builtin_amdgcn_global_load_lds((const unsigned*)(VTh + (long)(t) * 8192 + vsrc), (LAS unsigned*)(uintptr_t)__builtin_amdgcn_readfirstlane(vdst + (unsigned)((b) * SHMB)), 16, 0, 0); } while (0)
#define WBAR() do { asm volatile("s_waitcnt vmcnt(0)" ::: "memory"); __builtin_amdgcn_s_barrier(); asm volatile("" ::: "memory"); } while (0)
#define ITER(J, U, SX0, SX1, SY0, SY1, PC, PN, DO_DMA, DO_QK, DO_BAR) do { \
        mfma_pv(ol, PC, ones); SBAR(); \
        if (DO_DMA) { if ((J) + 3 < NT) DMA_TILE((J) + 3, ((U) + 4) % NBUF); if ((J) + 4 < NT) DMA_TILE((J) + 4, ((U) + 5) % NBUF); } \
        PN[0] = grp(SX0, 0, PN[0]); SBAR(); \
        mfma_pv(o[0], PC, vf0); SBAR(); \
        vf3 = VF(U, 3); if (DO_QK) { kf0 = KF(((U) + 2) % NBUF, 0); kf1 = KF(((U) + 2) % NBUF, 1); } \
        PN[1] = grp(SX0, 1, PN[1]); SBAR(); \
        mfma_pv(o[1], PC, vf1); SBAR(); PN[2] = grp(SX0, 2, PN[2]); SBAR(); \
        mfma_pv(o[2], PC, vf2); SBAR(); PN[3] = grp(SX0, 3, PN[3]); SBAR(); \
        mfma_pv(o[3], PC, vf3); SBAR(); PN[4] = grp(SX1, 0, PN[4]); SBAR(); \
        if (DO_QK) mfma_qk(SY0, kf0, qf, negc); SBAR(); PN[5] = grp(SX1, 1, PN[5]); SBAR(); \
        if (DO_QK) mfma_qk(SY1, kf1, qf, negc); SBAR(); PN[6] = grp(SX1, 2, PN[6]); PN[7] = grp(SX1, 3, PN[7]); \
        vf0 = VF(((U) + 1) % NBUF, 0); vf1 = VF(((U) + 1) % NBUF, 1); vf2 = VF(((U) + 1) % NBUF, 2); SBAR(); \
        if (DO_BAR) WBAR(); } while (0)
    f32x16 A0, A1, B0, B1; i32x8 paA = {}, paB = {}, kf0, kf1, vf0, vf1, vf2, vf3;
    DMA_TILE(0, 0); DMA_TILE(1, 1); DMA_TILE(2, 2); DMA_TILE(3, 3); WBAR();
    kf0 = KF(0, 0); kf1 = KF(0, 1); mfma_qk(A0, kf0, qf, negc); mfma_qk(A1, kf1, qf, negc);
    kf0 = KF(1, 0); kf1 = KF(1, 1); SBAR(); mfma_qk(B0, kf0, qf, negc); mfma_qk(B1, kf1, qf, negc);
    mfma_wait(A0, A1);
#pragma unroll
    for (int g = 0; g < 4; ++g) { paA[g] = grp(A0, g, paA[g]); paA[4 + g] = grp(A1, g, paA[4 + g]); }
    mfma_wait(B0, B1);
    vf0 = VF(0, 0); vf1 = VF(0, 1); vf2 = VF(0, 2); SBAR();
    static_assert(NT == 68, "the loop below (11 trips of 6 iterations, then iteration 67) is written for 68 KV tiles");
#pragma unroll 1
    for (int j = 1; j < NT - 2; j += 6) {
        ITER(j, 0, B0, B1, A0, A1, paA, paB, true, true, false);
        ITER(j + 1, 1, A0, A1, B0, B1, paB, paA, false, true, true);
        ITER(j + 2, 2, B0, B1, A0, A1, paA, paB, true, true, false);
        ITER(j + 3, 3, A0, A1, B0, B1, paB, paA, false, true, true);
        ITER(j + 4, 4, B0, B1, A0, A1, paA, paB, true, true, false);
        ITER(j + 5, 5, A0, A1, B0, B1, paB, paA, false, true, true);
    }
    ITER(67, 0, B0, B1, A0, A1, paA, paB, false, false, false);
    mfma_pv(ol, paB, ones); vf3 = VF(1, 3); SBAR();
    mfma_pv(o[0], paB, vf0); mfma_pv(o[1], paB, vf1); mfma_pv(o[2], paB, vf2); mfma_pv(o[3], paB, vf3);
    asm volatile("s_nop 15\n\ts_nop 3" : "+v"(o[0]), "+v"(o[1]), "+v"(o[2]), "+v"(o[3]), "+v"(ol));
#undef ITER
#undef KF
#undef VF
#undef DMA_TILE
#undef WBAR
    __syncthreads();
    float* X = (float*)lds;
    float rli[16];
#pragma unroll
    for (int r = 0; r < 16; ++r) rli[r] = __builtin_amdgcn_rcpf(ol[r]);
    if (sub == 1) {
#pragma unroll
        for (int r = 0; r < 16; ++r) { const int row = wq * 32 + crow(r, hi); const float sc = lam * rli[r];
#pragma unroll
            for (int d0 = 0; d0 < 4; ++d0) X[row * 128 + d0 * 32 + r32] = o[d0][r] * sc; }
    }
    __syncthreads();
    bf16_t* Y = (bf16_t*)(lds + 65536);
    if (sub == 0) {
        float sg[4];
#pragma unroll
        for (int d0 = 0; d0 < 4; ++d0) sg[d0] = subg[d0 * 32 + r32] * (1.f - LAM_INIT);
#pragma unroll
        for (int r = 0; r < 16; ++r) { const int row = wq * 32 + crow(r, hi);
            float v[4]; float ss = 0.f;
#pragma unroll
            for (int d0 = 0; d0 < 4; ++d0) { v[d0] = o[d0][r] * rli[r] - X[row * 128 + d0 * 32 + r32]; ss += v[d0] * v[d0]; }
            ss += __shfl_xor(ss, 1); ss += __shfl_xor(ss, 2); ss += __shfl_xor(ss, 4); ss += __shfl_xor(ss, 8); ss += __shfl_xor(ss, 16);
            const float rstd = rsqrtf(ss * (1.f / 128.f) + EPS);
#pragma unroll
            for (int d0 = 0; d0 < 4; ++d0) Y[row * 128 + d0 * 32 + r32] = (bf16_t)(cvt_pk_bf16(v[d0] * rstd * sg[d0], 0.f) & 0xffffu); }
    }
    __syncthreads();
    { const int row = tid >> 2, seg = (tid & 3) * 32;
#pragma unroll
        for (int i = 0; i < 4; ++i) { const u32x4 v = *(const u32x4*)(Y + row * 128 + seg + i * 8); *(u32x4*)(MIXo + (size_t)row * DM + seg + i * 8) = v; } }
    __syncthreads();
}
#undef SBAR
}

__device__ __forceinline__ void p3_attention8(Frame& F) {
    FT_DECL;
    const float* sc = WSP(float, WS_SMALL + SM_SCAL);
    const float lam = sc[0];
    const unsigned char* Q8 = WSP(unsigned char, WS_Q); const unsigned char* K8 = WSP(unsigned char, WS_K); const unsigned char* VT8 = WSP(unsigned char, WS_V); bf16_t* MIX = WSP(bf16_t, WS_MIX);
    const int c = blockIdx.x, xcd = c & 7, ci = c >> 3, per = F.G >> 3;
    for (int j = ci; j < 128; j += per) {
        const int pair = xcd * 4 + (j >> 5), qb = j & 31, b = pair >> 2, h = pair & 3;
        att8::attn_unit(Q8 + ((size_t)b * SEQ + qb * 128) * QKW + h * 128, K8 + (size_t)b * KVL * QKW + h * 128, VT8 + (size_t)(b * NHEAD + h) * 68 * 8192,
                        MIX + ((size_t)b * SEQ + qb * 128) * DM + h * 128, lam, F.in[15], (char*)F.lds, F.wave);
    }
}

namespace hy {
constexpr int RB_BYTES = 4352 * 8, IN_OFF = 2 * RB_BYTES, TW1_OFF = IN_OFF + 32768, TW2_OFF = TW1_OFF + 15 * 256 * 8, LDS_END = TW2_OFF + 15 * 16 * 8;
__device__ __forceinline__ f32x2 cmul(f32x2 a, f32x2 b) { return (f32x2){a.x * b.x - a.y * b.y, a.x * b.y + a.y * b.x}; }
__device__ __forceinline__ f32x2 cmulc(f32x2 a, f32x2 b) { return (f32x2){a.x * b.x + a.y * b.y, a.y * b.x - a.x * b.y}; }
__device__ __forceinline__ int P(int i) { return i + (i >> 4); }
template <bool INV> __device__ __forceinline__ void r4(f32x2& a, f32x2& b, f32x2& c, f32x2& d) {
    const f32x2 t0 = a + c, t1 = a - c, t2 = b + d, t3 = b - d;
    const f32x2 st3 = INV ? (f32x2){-t3.y, t3.x} : (f32x2){t3.y, -t3.x};
    a = t0 + t2; c = t0 - t2; b = t1 + st3; d = t1 - st3;
}
template <bool INV> __device__ __forceinline__ f32x2 tw(f32x2 v, float c, float s) {
    return INV ? (f32x2){v.x * c - v.y * s, v.y * c + v.x * s} : (f32x2){v.x * c + v.y * s, v.y * c - v.x * s};
}
template <bool INV> __device__ __forceinline__ void dft16(f32x2 (&v)[16]) {
    constexpr float C1 = 0.9238795325112867f, S1 = 0.3826834323650898f, R2 = 0.7071067811865476f;
    r4<INV>(v[0], v[4], v[8], v[12]); r4<INV>(v[1], v[5], v[9], v[13]); r4<INV>(v[2], v[6], v[10], v[14]); r4<INV>(v[3], v[7], v[11], v[15]);
    v[5] = tw<INV>(v[5], C1, S1);  v[9] = tw<INV>(v[9], R2, R2);    v[13] = tw<INV>(v[13], S1, C1);
    v[6] = tw<INV>(v[6], R2, R2);  v[10] = tw<INV>(v[10], 0.f, 1.f); v[14] = tw<INV>(v[14], -R2, R2);
    v[7] = tw<INV>(v[7], S1, C1);  v[11] = tw<INV>(v[11], -R2, R2);  v[15] = tw<INV>(v[15], -C1, -S1);
    r4<INV>(v[0], v[1], v[2], v[3]); r4<INV>(v[4], v[5], v[6], v[7]); r4<INV>(v[8], v[9], v[10], v[11]); r4<INV>(v[12], v[13], v[14], v[15]);
    f32x2 t;
    t = v[1]; v[1] = v[4]; v[4] = t;   t = v[2]; v[2] = v[8]; v[8] = t;    t = v[3]; v[3] = v[12]; v[12] = t;
    t = v[6]; v[6] = v[9]; v[9] = t;   t = v[7]; v[7] = v[13]; v[13] = t;  t = v[11]; v[11] = v[14]; v[14] = t;
}
struct Ctx { LAS f32x2* R; LAS f32x2* IN; LAS f32x2* TW1; LAS f32x2* TW2; int t, half; f32x2 wt; };
#define HY_OPAQUE(x) asm volatile("" : "+v"(x))
#define HY_W32(m) (f32x2){__builtin_cosf(-0.19634954084936207f * (m)), __builtin_sinf(-0.19634954084936207f * (m))}
template <int MODE> __device__ __forceinline__ void pass1_fwd(const Ctx& X) {
    f32x2 v[16]; int t = X.t; HY_OPAQUE(t);
#pragma unroll
    for (int m = 0; m < 16; ++m) { f32x2 a = X.IN[t + 256 * m]; if (MODE == 1) a = (f32x2){X.half ? a.y : a.x, 0.f}; v[m] = a; }
    if (X.half) {
#pragma unroll
        for (int m = 0; m < 16; ++m) v[m] = cmul(cmul(v[m], HY_W32(m)), X.wt);
    }
    dft16<false>(v);
#pragma unroll
    for (int q = 1; q < 16; ++q) v[q] = cmul(v[q], X.TW1[(q - 1) * 256 + t]);
    const int pb = t + (t >> 4);
#pragma unroll
    for (int q = 0; q < 16; ++q) X.R[pb + 272 * q] = v[q];
}
__device__ __forceinline__ void pass2_fwd(const Ctx& X) {
    int t = X.t; HY_OPAQUE(t);
    const int n2 = t & 15, pb = (t >> 4) * 272 + n2; f32x2 v[16];
#pragma unroll
    for (int m = 0; m < 16; ++m) v[m] = X.R[pb + 17 * m];
    dft16<false>(v);
#pragma unroll
    for (int q = 1; q < 16; ++q) v[q] = cmul(v[q], X.TW2[(q - 1) * 16 + n2]);
#pragma unroll
    for (int q = 0; q < 16; ++q) X.R[pb + 17 * q] = v[q];
}
template <bool FILTER> __device__ __forceinline__ void pass3(const Ctx& X, f32x2 (&H)[16]) {
    f32x2 v[16]; int t = X.t; HY_OPAQUE(t); const int pb = 17 * t;
#pragma unroll
    for (int m = 0; m < 16; ++m) v[m] = X.R[pb + m];
    dft16<false>(v);
    if (FILTER) {
#pragma unroll
        for (int q = 0; q < 16; ++q) H[q] = v[q] * (1.f / 8192.f);
    } else {
#pragma unroll
        for (int q = 0; q < 16; ++q) v[q] = cmul(v[q], H[q]);
        dft16<true>(v);
#pragma unroll
        for (int m = 0; m < 16; ++m) X.R[pb + m] = v[m];
    }
}
__device__ __forceinline__ void pass2_inv(const Ctx& X) {
    int t = X.t; HY_OPAQUE(t);
    const int n2 = t & 15, pb = (t >> 4) * 272 + n2; f32x2 v[16];
    v[0] = X.R[pb];
#pragma unroll
    for (int q = 1; q < 16; ++q) v[q] = cmulc(X.R[pb + 17 * q], X.TW2[(q - 1) * 16 + n2]);
    dft16<true>(v);
#pragma unroll
    for (int m = 0; m < 16; ++m) X.R[pb + 17 * m] = v[m];
}
__device__ __forceinline__ void pass1_inv(const Ctx& X) {
    f32x2 v[16]; int t = X.t; HY_OPAQUE(t); const int pb = t + (t >> 4);
    v[0] = X.R[pb];
#pragma unroll
    for (int q = 1; q < 16; ++q) v[q] = cmulc(X.R[pb + 272 * q], X.TW1[(q - 1) * 256 + t]);
    dft16<true>(v);
    if (X.half) {
#pragma unroll
        for (int m = 0; m < 16; ++m) v[m] = cmulc(cmulc(v[m], HY_W32(m)), X.wt);
    }
#pragma unroll
    for (int m = 0; m < 16; ++m) X.R[pb + 272 * m] = v[m];
}
#define HY_WSYNC() asm volatile("s_waitcnt lgkmcnt(0)" ::: "memory")
__device__ __forceinline__ void conv_fft(const Ctx& X, f32x2 (&H)[16]) {
    __syncthreads(); pass1_fwd<0>(X); __syncthreads(); pass2_fwd(X); HY_WSYNC(); pass3<false>(X, H); HY_WSYNC(); pass2_inv(X); __syncthreads(); pass1_inv(X); __syncthreads();
}
constexpr int STG_OFF = LDS_END;
constexpr int LDS_END2 = STG_OFF + 2 * SEQ * 2;
static_assert(LDS_END2 <= LDSCTL_OFF, "hyena LDS map");
__device__ __forceinline__ float sconv_lds(const LAS bf16_t* stg, int bs, int n, float w0, float w1, float w2, float bias) {
    const LAS bf16_t* p = stg + bs * SEQ;
    const float c = bf2f(p[n]), lv = bf2f(p[n - ((n > 0) ? 1 : 0)]), rv = bf2f(p[n + ((n < SEQ - 1) ? 1 : 0)]);
    const float l = (n > 0) ? lv : 0.f, r = (n < SEQ - 1) ? rv : 0.f;
    return bias + w0 * l + w1 * c + w2 * r;
}
__device__ __forceinline__ void setup_tables(LAS unsigned char* lds, int tid) {
    LAS f32x2* TW1 = (LAS f32x2*)(lds + TW1_OFF); LAS f32x2* TW2 = (LAS f32x2*)(lds + TW2_OFF);
    for (int i = tid; i < 15 * 256; i += 512) { const int q = i / 256 + 1, t = i & 255; float s, c; sincosf(-6.283185307179586f * (float)((t * q) & 4095) * (1.f / 4096.f), &s, &c); TW1[i] = (f32x2){c, s}; }
    for (int i = tid; i < 15 * 16; i += 512) { const int q = i / 16 + 1, n2 = i & 15; float s, c; sincosf(-6.283185307179586f * (float)((n2 * q) & 255) * (1.f / 256.f), &s, &c); TW2[i] = (f32x2){c, s}; }
}
__device__ __forceinline__ void unit(Frame& F, int c) {
    FT_DECL;
    const int tid = f_tid; Ctx X; X.half = F.wave >> 2; X.t = tid & 255;
    X.R = (LAS f32x2*)(F.lds + X.half * RB_BYTES); X.IN = (LAS f32x2*)(F.lds + IN_OFF); X.TW1 = (LAS f32x2*)(F.lds + TW1_OFF); X.TW2 = (LAS f32x2*)(F.lds + TW2_OFF);
    { float s, cc; sincosf(-6.283185307179586f * (float)X.t * (1.f / 8192.f), &s, &cc); X.wt = (f32x2){cc, s}; }
    LAS f32x2* RB0 = (LAS f32x2*)(F.lds); LAS f32x2* RB1 = (LAS f32x2*)(F.lds + RB_BYTES);
    const float* FILT = WSP(float, WS_FILT);
    f32x2 H0[16], H1[16];
#pragma unroll
    for (int ord = 0; ord < 2; ++ord) {
        const float* hf = FILT + ((size_t)(ord * 2 + 0) * 512 + c) * SEQ; const float* hb = FILT + ((size_t)(ord * 2 + 1) * 512 + c) * SEQ;
        __syncthreads();
        int nb = tid; HY_OPAQUE(nb);
#pragma unroll
        for (int j = 0; j < 8; ++j) { const int n = nb + 512 * j; const float a = hf[n], b = hb[(SEQ - n) & (SEQ - 1)]; const float lo = (n == 0) ? a + b : a, hi = (n == 0) ? 0.f : b; X.IN[n] = (f32x2){lo + hi, lo - hi}; }
        __syncthreads(); pass1_fwd<1>(X); __syncthreads(); pass2_fwd(X); HY_WSYNC();
        if (ord == 0) pass3<true>(X, H0); else pass3<true>(X, H1);
    }
    const bf16_t* UT = WSP(bf16_t, WS_UT);
    const bf16_t* rv = UT + (size_t)c * 128; const bf16_t* r1 = UT + (size_t)(512 + c) * 128; const bf16_t* r2 = UT + (size_t)(1024 + c) * 128;
#define HY_LD(rowp, t) (*(const u32x4*)((rowp) + (size_t)((t) >> 7) * (HYC * 128) + ((t) & 127)))
    const float* cw = F.in[16]; const float* cb = F.in[17];
    const float wv0 = cw[c], wv1 = cw[HYC + c], wv2 = cw[2 * HYC + c], bv = cb[c];
    const float wa0 = cw[512 + c], wa1 = cw[HYC + 512 + c], wa2 = cw[2 * HYC + 512 + c], ba = cb[512 + c];
    const float wb0 = cw[1024 + c], wb1 = cw[HYC + 1024 + c], wb2 = cw[2 * HYC + 1024 + c], bb = cb[1024 + c];
    const float sk0 = F.in[25][c], sk1 = F.in[25][512 + c];
    bf16_t* Z = WSP(bf16_t, WS_Z2T) + (size_t)c * 128;
    LAS bf16_t* STG = (LAS bf16_t*)(F.lds + STG_OFF);
    u32x4 g0 = HY_LD(rv, tid * 8), g1 = HY_LD(rv, SEQ + tid * 8);
    for (int pr = 0; pr < 4; ++pr) {
        const int b0 = 2 * pr, b1 = b0 + 1;
        f32x2 z[8]; int pc = tid + (tid >> 4); HY_OPAQUE(pc); int nb = tid; HY_OPAQUE(nb);
        __syncthreads();
        *(LAS u32x4*)(STG + tid * 8) = g0; *(LAS u32x4*)(STG + SEQ + tid * 8) = g1;
        __syncthreads();
#pragma unroll
        for (int j = 0; j < 8; ++j) { const int n = nb + 512 * j; z[j] = (f32x2){sconv_lds(STG, 0, n, wv0, wv1, wv2, bv), sconv_lds(STG, 1, n, wv0, wv1, wv2, bv)}; X.IN[n] = z[j]; }
        g0 = HY_LD(r1, b0 * SEQ + tid * 8); g1 = HY_LD(r1, b1 * SEQ + tid * 8);
        conv_fft(X, H0);
        *(LAS u32x4*)(STG + tid * 8) = g0; *(LAS u32x4*)(STG + SEQ + tid * 8) = g1;
        __syncthreads();
        HY_OPAQUE(nb); HY_OPAQUE(pc);
#pragma unroll
        for (int j = 0; j < 8; ++j) { const int n = nb + 512 * j; const f32x2 y = RB0[pc + 544 * j] + RB1[pc + 544 * j];
            const f32x2 g = (f32x2){sconv_lds(STG, 0, n, wa0, wa1, wa2, ba), sconv_lds(STG, 1, n, wa0, wa1, wa2, ba)};
            z[j] = g * (y + sk0 * z[j]); X.IN[n] = z[j]; }
        g0 = HY_LD(r2, b0 * SEQ + tid * 8); g1 = HY_LD(r2, b1 * SEQ + tid * 8);
        conv_fft(X, H1);
        *(LAS u32x4*)(STG + tid * 8) = g0; *(LAS u32x4*)(STG + SEQ + tid * 8) = g1;
        __syncthreads();
        if (pr < 3) { g0 = HY_LD(rv, (b0 + 2) * SEQ + tid * 8); g1 = HY_LD(rv, (b1 + 2) * SEQ + tid * 8); }
        HY_OPAQUE(nb); HY_OPAQUE(pc);
        f32x2 o[8];
#pragma unroll
        for (int j = 0; j < 8; ++j) { const int n = nb + 512 * j; const f32x2 y = RB0[pc + 544 * j] + RB1[pc + 544 * j];
            const f32x2 g = (f32x2){sconv_lds(STG, 0, n, wb0, wb1, wb2, bb), sconv_lds(STG, 1, n, wb0, wb1, wb2, bb)};
            o[j] = g * (y + sk1 * z[j]); }
        __syncthreads();
#pragma unroll
        for (int j = 0; j < 8; ++j) { const int n = nb + 512 * j; STG[n] = (bf16_t)(cvt_pk_bf16(o[j].x, 0.f) & 0xffffu); STG[SEQ + n] = (bf16_t)(cvt_pk_bf16(o[j].y, 0.f) & 0xffffu); }
        __syncthreads();
        { const int t0 = b0 * SEQ + tid * 8, t1 = b1 * SEQ + tid * 8;
          *(u32x4*)(Z + (size_t)(t0 >> 7) * (HYW * 128) + (t0 & 127)) = *(const LAS u32x4*)(STG + tid * 8); *(u32x4*)(Z + (size_t)(t1 >> 7) * (HYW * 128) + (t1 & 127)) = *(const LAS u32x4*)(STG + SEQ + tid * 8); }
    }
    __syncthreads();
}
}

__device__ __forceinline__ void p3_hyena(Frame& F) {
    FT_DECL;
    __syncthreads();
    hy::setup_tables(F.lds, f_tid);
    __syncthreads();
    for (int c = F.vcu; c < HYW; c += F.G) hy::unit(F, c);
}

__device__ __forceinline__ void p4_hynorm(Frame& F) {
    FT_DECL;
    const bf16_t* Z = WSP(bf16_t, WS_Z2T); bf16_t* MIX = WSP(bf16_t, WS_MIX); const float* g = F.in[26];
    constexpr int TP = 132;
    LAS bf16_t* T = (LAS bf16_t*)F.lds;
    LAS float* red = (LAS float*)(F.lds + 512 * TP * 2);
    LAS float* rs = red + 512;
    float gl[8];
#pragma unroll
    for (int e = 0; e < 8; ++e) gl[e] = g[(f_tid & 63) + 64 * e];
    for (int it = F.vcu; it < MROWS / 128; it += F.G) {
        const int tok0 = it * 128; const bf16_t* zt = Z + (size_t)it * (HYW * 128);
        __syncthreads();
        u32x4 v[16];
#pragma unroll
        for (int j = 0; j < 16; ++j) v[j] = __builtin_nontemporal_load((const u32x4*)(zt + (size_t)(f_tid + 512 * j) * 8));
#pragma unroll
        for (int j = 0; j < 16; ++j) { const int i = f_tid + 512 * j; LAS u32x2* d = (LAS u32x2*)(T + (i >> 4) * TP + (i & 15) * 8); d[0] = (u32x2){v[j].x, v[j].y}; d[1] = (u32x2){v[j].z, v[j].w}; }
        __syncthreads();
        { const int tok = f_tid & 127, grp = f_tid >> 7; float ss = 0.f;
#pragma unroll 8
            for (int k = 0; k < 128; ++k) { const float x = bf2f(T[(grp * 128 + k) * TP + tok]); ss += x * x; }
            red[grp * 128 + tok] = ss; }
        __syncthreads();
        if (f_tid < 128) rs[f_tid] = rsqrtf(((red[f_tid] + red[128 + f_tid]) + (red[256 + f_tid] + red[384 + f_tid])) * (1.f / HYW) + EPS);
        __syncthreads();
#pragma unroll
        for (int j = 0; j < 16; ++j) { const int i = f_tid + 512 * j, tok = i >> 6, l = i & 63; const float r = rs[tok];
            float x[8];
#pragma unroll
            for (int e = 0; e < 8; ++e) x[e] = bf2f(T[(l + 64 * e) * TP + tok]) * r * gl[e];
            u32x4 w; w.x = cvt_pk_bf16(x[0], x[1]); w.y = cvt_pk_bf16(x[2], x[3]); w.z = cvt_pk_bf16(x[4], x[5]); w.w = cvt_pk_bf16(x[6], x[7]);
            *(u32x4*)(MIX + (size_t)(tok0 + tok) * DM + 512 + 8 * l) = w; }
    }
}

constexpr size_t WS_LIST2 = WS_FILT;
constexpr size_t WS_GSLOT2 = WS_FILT + 4 * MiB;
constexpr int CW_ECNT = 256;
constexpr int MAXSLOT = MROWS * TOPK + NEXP * 256;
constexpr int MAXTILE = MAXSLOT / 256;
constexpr size_t WS_XS = WS_EO;
constexpr int P6_WT_PITCH = 2 * DM + 16;
constexpr int P6_LDS_TOPI = 2 * NEXP * P6_WT_PITCH;

__device__ __forceinline__ void p6_router_mfma(Frame& F) {
    FT_DECL;
#define in F.in
    LAS float* WP = (LAS float*)F.lds;
    LAS int* TI = (LAS int*)(F.lds + P6_LDS_TOPI);
    LAS int* PS = TI + 512;
    LAS int* SC = PS + 512;
    LAS float* RSTD = (LAS float*)(SC + 512);
    LAS float* BIAS = RSTD + 128;
    LAS float* SSX = BIAS + 32;
    const float* rw = in[28]; const float* mod = WSP(float, WS_SMALL + SM_MOD); const float* g2n = in[7]; const float* rb = in[29];
    const bf16_t* XN = WSP(bf16_t, WS_XN); unsigned char* H2 = WSP(unsigned char, WS_H);
    int* list2 = WSP(int, WS_LIST2); float* gslot2 = WSP(float, WS_GSLOT2); int* ecnt = (int*)(F.ctl + CW_ECNT);
    LAS float* GT = SSX + 256;
    LAS int* EB = (LAS int*)(GT + 512);
    LAS float* GM = (LAS float*)(EB + 32);
    static_assert(P6_LDS_TOPI + (512 * 3 + 128 + 32 + 256 + 512 + 32 + 1024) * 4 <= LDSCTL_OFF, "router LDS map");
    for (int blk = blockIdx.x; blk < MROWS / 128; blk += F.G) {
        const float* sh2 = mod + (size_t)(blk >> 5) * (NMOD * DM) + 3 * DM; const float* sc2 = sh2 + DM;
        __syncthreads();
        for (int i = f_tid; i < DM; i += 512) GM[i] = g2n[i] * (1.f + sc2[i]);
        if (f_tid < 32) BIAS[f_tid] = WSP(float, WS_SMALL + SM_RBIAS)[(blk >> 5) * 32 + f_tid];
        __syncthreads();
        { const int e = f_lane & 31, h8 = (f_lane >> 5) * 8; LAS unsigned char* WT = (LAS unsigned char*)F.lds;
#pragma unroll 2
            for (int it = 0; it < 8; ++it) { const int k0 = (it * NWAVES + F.wave) * 16 + h8; float w[8];
#pragma unroll
                for (int q = 0; q < 8; ++q) w[q] = rw[(size_t)(k0 + q) * 32 + e];
                const f32x4 ga = *(const LAS f32x4*)(GM + k0), gb = *(const LAS f32x4*)(GM + k0 + 4); const float g[8] = {ga.x, ga.y, ga.z, ga.w, gb.x, gb.y, gb.z, gb.w};
                unsigned ph[4], pl[4];
#pragma unroll
                for (int q = 0; q < 4; ++q) { const float v0 = w[2 * q] * g[2 * q], v1 = w[2 * q + 1] * g[2 * q + 1]; ph[q] = cvt_pk_bf16(v0, v1);
                    pl[q] = cvt_pk_bf16(v0 - __uint_as_float(ph[q] << 16), v1 - __uint_as_float(ph[q] & 0xffff0000u)); }
                *(LAS u32x4*)(WT + e * P6_WT_PITCH + k0 * 2) = (u32x4){ph[0], ph[1], ph[2], ph[3]};
                *(LAS u32x4*)(WT + NEXP * P6_WT_PITCH + e * P6_WT_PITCH + k0 * 2) = (u32x4){pl[0], pl[1], pl[2], pl[3]}; } }
        __syncthreads();
        const int rg = F.wave & 3, kh = F.wave >> 2, j = f_lane & 31, hi = f_lane >> 5;
        f32x16 acc = {};
        float ss = 0.f;
        { const bf16_t* xrow = XN + (size_t)(blk * 128 + rg * 32 + j) * DM + 512 * kh + 8 * hi;
            const LAS unsigned char* wth = (const LAS unsigned char*)F.lds + j * P6_WT_PITCH + (512 * kh + 8 * hi) * 2;
#pragma unroll 8
            for (int c = 0; c < 32; ++c) { const u32x4 xb = *(const u32x4*)(xrow + 16 * c);
                const float xf[8] = {__uint_as_float(xb.x << 16), __uint_as_float(xb.x & 0xffff0000u), __uint_as_float(xb.y << 16), __uint_as_float(xb.y & 0xffff0000u),
                                     __uint_as_float(xb.z << 16), __uint_as_float(xb.z & 0xffff0000u), __uint_as_float(xb.w << 16), __uint_as_float(xb.w & 0xffff0000u)};
#pragma unroll
                for (int q = 0; q < 8; ++q) ss += xf[q] * xf[q];
                const bf16x8 xv = __builtin_bit_cast(bf16x8, xb);
                const bf16x8 ah = *(const LAS bf16x8*)(wth + 32 * c), al = *(const LAS bf16x8*)(wth + NEXP * P6_WT_PITCH + 32 * c);
                acc = __builtin_amdgcn_mfma_f32_32x32x16_bf16(ah, xv, acc, 0, 0, 0);
                acc = __builtin_amdgcn_mfma_f32_32x32x16_bf16(al, xv, acc, 0, 0, 0); } }
        { auto rr = __builtin_amdgcn_permlane32_swap(__float_as_uint(ss), __float_as_uint(ss), false, false); ss = __uint_as_float(rr[0]) + __uint_as_float(rr[1]); }
        if (hi == 0) SSX[kh * 128 + rg * 32 + j] = ss;
        __syncthreads();
        if (kh == 1) {
#pragma unroll
            for (int r = 0; r < 16; ++r) WP[(rg * 16 + r) * 64 + f_lane] = acc[r]; }
        if (f_tid < 128) RSTD[f_tid] = rsqrtf((SSX[f_tid] + SSX[128 + f_tid]) * (1.f / DM) + EPS);
        __syncthreads();
        if (kh == 0) {
            const float rstd = RSTD[rg * 32 + j];
            float tv[4] = {-INFINITY, -INFINITY, -INFINITY, -INFINITY}; int ti[4] = {1 << 20, 1 << 20, 1 << 20, 1 << 20};
#define P6_INS(V, E) do { float cv = (V); int ce = (E); _Pragma("unroll") for (int q = 0; q < 4; ++q) { const bool b = cv > tv[q] || (cv == tv[q] && ce < ti[q]); \
                const float nv = b ? tv[q] : cv; const int ne = b ? ti[q] : ce; tv[q] = b ? cv : tv[q]; ti[q] = b ? ce : ti[q]; cv = nv; ce = ne; } } while (0)
#pragma unroll
            for (int r = 0; r < 16; ++r) { const int e = (r & 3) + 8 * (r >> 2) + 4 * hi; const float v = (acc[r] + WP[(rg * 16 + r) * 64 + f_lane]) * rstd + BIAS[e]; P6_INS(v, e); }
            float ov[4]; int oe[4];
#pragma unroll
            for (int q = 0; q < 4; ++q) { ov[q] = __shfl_xor(tv[q], 32); oe[q] = __shfl_xor(ti[q], 32); }
#pragma unroll
            for (int q = 0; q < 4; ++q) P6_INS(ov[q], oe[q]);
#undef P6_INS
            if (hi == 0) { const int rl = rg * 32 + j;
                const float e1 = __expf(tv[1] - tv[0]), e2 = __expf(tv[2] - tv[0]), e3 = __expf(tv[3] - tv[0]); const float inv = 1.f / (1.f + e1 + e2 + e3);
                typedef int i32x4_t __attribute__((ext_vector_type(4))); const i32x4_t t4 = {ti[0], ti[1], ti[2], ti[3]};
                *(LAS f32x4*)(GT + rl * 4) = (f32x4){inv, e1 * inv, e2 * inv, e3 * inv};
                *(LAS i32x4_t*)(TI + rl * 4) = t4; }
        }
        __syncthreads();
        { const int t2 = F.wave * 64 + lane_id(); const int e = t2 & 31, seg = t2 >> 5; int cnt = 0;
#pragma unroll 4
            for (int i = 0; i < 32; ++i) cnt += (TI[seg * 32 + i] == e) ? 1 : 0;
            SC[seg * 32 + e] = cnt;
            __syncthreads();
            int pre = 0;
            for (int s2 = 0; s2 < seg; ++s2) pre += SC[s2 * 32 + e];
            if (seg == 15) EB[e] = __hip_atomic_fetch_add(ecnt + e, pre + cnt, __ATOMIC_RELAXED, __HIP_MEMORY_SCOPE_AGENT);
            for (int i = 0; i < 32; ++i) if (TI[seg * 32 + i] == e) { PS[seg * 32 + i] = pre; ++pre; }
        }
        __syncthreads();
        { const int t3 = F.wave * 64 + lane_id(); const int e = TI[t3]; const size_t sl = (size_t)e * MROWS + EB[e] + PS[t3];
            list2[sl] = (blk * 128 + (t3 >> 2)) * 4 + (t3 & 3); gslot2[sl] = GT[t3]; }
        { const int lane = lane_id();
            f32x4 PA[4], PB[4];
#pragma unroll
            for (int jj = 0; jj < 4; ++jj) { const int c = 4 * lane + 256 * jj; PA[jj] = *(const f32x4*)(g2n + c) * (*(const f32x4*)(sc2 + c) + 1.f); PB[jj] = *(const f32x4*)(sh2 + c); }
            for (int it = 0; it < 4; ++it) { u32x2 xb[4][4];
#pragma unroll
                for (int u = 0; u < 4; ++u) { const GAS u32x2* xr = (const GAS u32x2*)(XN + (size_t)(blk * 128 + F.wave * 16 + 4 * it + u) * DM) + lane;
#pragma unroll
                    for (int jj = 0; jj < 4; ++jj) xb[u][jj] = xr[64 * jj]; }
#pragma unroll
                for (int u = 0; u < 4; ++u) { const int rl = F.wave * 16 + 4 * it + u; const float rstd = RSTD[rl];
                    GAS unsigned* o4 = (GAS unsigned*)(H2 + (size_t)(blk * 128 + rl) * DM) + lane;
#pragma unroll
                    for (int jj = 0; jj < 4; ++jj) {
                        const f32x4 x = (f32x4){__uint_as_float(xb[u][jj].x << 16), __uint_as_float(xb[u][jj].x & 0xffff0000u), __uint_as_float(xb[u][jj].y << 16), __uint_as_float(xb[u][jj].y & 0xffff0000u)};
                        const f32x4 h = x * rstd * PA[jj] + PB[jj];
                        o4[64 * jj] = pk4_fp8(h.x, h.y, h.z, h.w); } } }
        }
    }
#undef in
}

template <int NPN> struct SchedMoE {
    int G, c, nT; const char* A; const char* W; size_t wstride; const LAS unsigned char* tileE; const LAS int* RW; bool gath;
    __device__ __forceinline__ long lidx(int T, int e, int i) const { const LAS int* TB = (const LAS int*)(tileE + 544); const int r = (T - TB[e]) * 256 + i; return (r < TB[32 + e]) ? (long)e * MROWS + r : -1L; }
    __device__ __forceinline__ const LAS int* rows(int i) const { return RW + i * 256; }
    __device__ __forceinline__ bool next(int i, g8::Unit& u) const {
        const int L = i * G + c, xcd = L & 7, j = L >> 3, nTx = (nT + 7) >> 3, tl = j / NPN, T = xcd * nTx + tl, pn = j % NPN;
        if (tl >= nTx || T >= nT) return false;
        const int e = tileE[T];
        u.pm = T; u.pn = pn; u.kind = i; u.ex = e; u.a = gath ? A : A + (size_t)T * 256 * DM; u.b = W + (size_t)e * wstride + (size_t)pn * 256 * DM; return true;
    }
};
struct EpiSwiGLU {
    unsigned char* ACT; const float* b1;
    __device__ __forceinline__ void operator()(f32x4 (&acc)[2][2][4][2], const g8::Unit& u, int wr, int wc, int fr, int fq) const {
        asm volatile("" : "+v"(fr), "+v"(fq));
        const int j0 = u.pn * 128 + wc * 32 + 8 * fq; const float* bp = b1 + (size_t)u.ex * 2 * DM + j0;
        f32x4 bg[2], bl[2];
#pragma unroll
        for (int n = 0; n < 2; ++n) { bg[n] = *(const f32x4*)(bp + 4 * n); bl[n] = *(const f32x4*)(bp + DM + 4 * n); }
#pragma unroll
        for (int ai = 0; ai < 2; ++ai)
#pragma unroll
            for (int m = 0; m < 4; ++m) { const size_t slot = (size_t)u.pm * 256 + ai * 128 + wr * 64 + m * 16 + fr; float o[8];
#pragma unroll
                for (int n = 0; n < 2; ++n) { const f32x4 g4 = acc[ai][0][m][n] * (1.f / WSCALE) + bg[n], l4 = acc[ai][1][m][n] * (1.f / WSCALE) + bl[n];
#pragma unroll
                    for (int e = 0; e < 4; ++e) { const float g = fminf(g4[e], 7.f), l = __builtin_amdgcn_fmed3f(l4[e], -7.f, 7.f);
                        const float ex = __builtin_amdgcn_exp2f(g * (-1.702f * 1.4426950408889634f)); const float glu = g * __builtin_amdgcn_rcpf(1.f + ex);
                        o[4 * n + e] = fmaf(l, glu, glu); } }
                u32x2 w; w.x = pk4_fp8(o[0], o[1], o[2], o[3]); w.y = pk4_fp8(o[4], o[5], o[6], o[7]);
                *(u32x2*)(ACT + slot * DM + j0) = w; }
    }
};
struct EpiDown {
    unsigned char* EO; const float* b2; const LAS int* LL; int G, c;
    __device__ __forceinline__ void operator()(f32x4 (&acc)[2][2][4][2], const g8::Unit& u, int wr, int wc, int fr, int fq) const {
        asm volatile("" : "+v"(fr), "+v"(fq));
        const int c0 = u.pn * 256 + wc * 64 + 16 * fq; const float* bp = b2 + (size_t)u.ex * DM + c0;
        f32x4 bb[2][2];
#pragma unroll
        for (int bj = 0; bj < 2; ++bj)
#pragma unroll
            for (int n = 0; n < 2; ++n) bb[bj][n] = *(const f32x4*)(bp + bj * 8 + 4 * n);
        const LAS int* L = LL + u.kind * 512;
        int li[8]; float gt[8];
#pragma unroll
        for (int q = 0; q < 8; ++q) { const int rl = (q >> 2) * 128 + wr * 64 + (q & 3) * 16 + fr; li[q] = L[rl]; gt[q] = __int_as_float(L[256 + rl]) * (1.f / WSCALE); }
#pragma unroll
        for (int ai = 0; ai < 2; ++ai)
#pragma unroll
            for (int m = 0; m < 4; ++m) { const int l = li[ai * 4 + m]; const float g = gt[ai * 4 + m];
                unsigned char* dst = EO + ((size_t)(l & 3) * MROWS + (l >> 2)) * DM + c0;
                u32x4 w;
                { const f32x4 v0 = acc[ai][0][m][0] * g + bb[0][0] * (g * WSCALE), v1 = acc[ai][0][m][1] * g + bb[0][1] * (g * WSCALE);
                  w.x = pk4_fp8(v0[0] * EOSCALE, v0[1] * EOSCALE, v0[2] * EOSCALE, v0[3] * EOSCALE); w.y = pk4_fp8(v1[0] * EOSCALE, v1[1] * EOSCALE, v1[2] * EOSCALE, v1[3] * EOSCALE); }
                { const f32x4 v0 = acc[ai][1][m][0] * g + bb[1][0] * (g * WSCALE), v1 = acc[ai][1][m][1] * g + bb[1][1] * (g * WSCALE);
                  w.z = pk4_fp8(v0[0] * EOSCALE, v0[1] * EOSCALE, v0[2] * EOSCALE, v0[3] * EOSCALE); w.w = pk4_fp8(v1[0] * EOSCALE, v1[1] * EOSCALE, v1[2] * EOSCALE, v1[3] * EOSCALE); }
                if (l >= 0) *(u32x4*)dst = w; }
    }
};
__device__ __forceinline__ const LAS unsigned char* moe_tiles(Frame& F, int& nT) {
    FT_DECL;
    LAS unsigned char* TE = (LAS unsigned char*)(F.lds + RING_BYTES); LAS int* TB = (LAS int*)(TE + 544); LAS int* TOT = TB + 32; LAS int* NTL = TOT + 32;
    const int* ecnt = (const int*)(F.ctl + CW_ECNT);
    __syncthreads();
    if (f_tid < 32) { const int t = ecnt[f_tid]; TOT[f_tid] = t; NTL[f_tid] = (t + 255) >> 8; }
    __syncthreads();
    if (f_tid < 33) { int b = 0; for (int e = 0; e < f_tid; ++e) b += NTL[e]; if (f_tid < 32) TB[f_tid] = b; else NTL[32] = b; }
    __syncthreads();
    nT = NTL[32]; if (nT > MAXTILE) nT = MAXTILE;
    for (int i = f_tid; i < MAXTILE; i += 512) { int e = 0;
#pragma unroll 8
        for (int q = 0; q < 32; ++q) e += (TB[q] + NTL[q] <= i) ? 1 : 0;
        TE[i] = (unsigned char)((i < nT) ? e : 0); }
    __syncthreads();
    return (const LAS unsigned char*)TE;
}

__device__ __forceinline__ void p10_combine(Frame& F) {
    FT_DECL;
    const float* mod = WSP(float, WS_SMALL + SM_MOD); const unsigned char* EO = WSP(unsigned char, WS_EO);
    const size_t gt = (size_t)F.vcu * 512 + f_tid, NTH = (size_t)F.G * 512;
    constexpr int U = 4;
    for (size_t i0 = gt; i0 < (size_t)MROWS * 128; i0 += NTH * U) {
        u32x2 ev[U][4]; f32x4 xv[U][2], gv[U][2];
#pragma unroll
        for (int u = 0; u < U; ++u) { const size_t i = i0 + (size_t)u * NTH; const size_t row = i >> 7; const int c0 = (int)(i & 127) * 8;
            const float* g2 = mod + (size_t)(row >> 12) * (NMOD * DM) + 5 * DM + c0; const bf16_t* op = WSP(bf16_t, WS_XN) + row * DM + c0;
#pragma unroll
            for (int k = 0; k < 4; ++k) ev[u][k] = __builtin_nontemporal_load((const u32x2*)(EO + ((size_t)k * MROWS + row) * DM + c0));
            { const u32x4 xb = *(const u32x4*)op; xv[u][0] = (f32x4){__uint_as_float(xb.x << 16), __uint_as_float(xb.x & 0xffff0000u), __uint_as_float(xb.y << 16), __uint_as_float(xb.y & 0xffff0000u)};
              xv[u][1] = (f32x4){__uint_as_float(xb.z << 16), __uint_as_float(xb.z & 0xffff0000u), __uint_as_float(xb.w << 16), __uint_as_float(xb.w & 0xffff0000u)}; }
            gv[u][0] = *(const f32x4*)g2; gv[u][1] = *(const f32x4*)(g2 + 4); }
#pragma unroll
        for (int u = 0; u < U; ++u) { const size_t i = i0 + (size_t)u * NTH; const size_t row = i >> 7; const int c0 = (int)(i & 127) * 8;
            float s[8];
#pragma unroll
            for (int e = 0; e < 8; ++e) s[e] = 0.f;
#pragma unroll
            for (int k = 0; k < 4; ++k) { const u32x2 v = ev[u][k];
                const f32x2 a = __builtin_amdgcn_cvt_pk_f32_fp8((int)v.x, false), b = __builtin_amdgcn_cvt_pk_f32_fp8((int)v.x, true), c = __builtin_amdgcn_cvt_pk_f32_fp8((int)v.y, false), d = __builtin_amdgcn_cvt_pk_f32_fp8((int)v.y, true);
                s[0] += a.x; s[1] += a.y; s[2] += b.x; s[3] += b.y; s[4] += c.x; s[5] += c.y; s[6] += d.x; s[7] += d.y; }
#pragma unroll
            for (int e = 0; e < 8; ++e) s[e] *= (1.f / EOSCALE);
            f32x4 o0 = xv[u][0] + gv[u][0] * (f32x4){s[0], s[1], s[2], s[3]}, o1 = xv[u][1] + gv[u][1] * (f32x4){s[4], s[5], s[6], s[7]};
            float* op = F.out + row * DM + c0;
            __builtin_nontemporal_store(o0, (f32x4*)op); __builtin_nontemporal_store(o1, (f32x4*)(op + 4)); }
    }
}

struct Args { const float* in[34]; float* out; unsigned char* ws; int ph_lo, ph_hi; };
constexpr int N_PHASES = 11;

__global__ void __launch_bounds__(512, 2) mega(Args args) {
    extern __shared__ __attribute__((aligned(16))) unsigned char lds[];
    Frame F;
    F.lds = (LAS unsigned char*)lds;
    F.MISC = (volatile LAS unsigned*)(F.lds + LDSCTL_OFF);
    F.wave = __builtin_amdgcn_readfirstlane(threadIdx.x >> 6);
    FT_DECL;
    F.G = gridDim.x; { const int bx = blockIdx.x; F.vcu = (F.G % 8 == 0) ? (bx % 8) * (F.G / 8) + bx / 8 : bx; }
    F.in = (kin_t)__builtin_amdgcn_kernarg_segment_ptr();
    F.out = args.out; F.ws = args.ws;
    F.ctl = (gu32*)(args.ws + WS_CTL);
    for (int u = f_tid; u < (LDS_BYTES - LDSCTL_OFF) / 4; u += NWAVES * 64) ((LAS unsigned*)(F.lds + LDSCTL_OFF))[u] = 0u;
    __syncthreads();
    const int lo = args.ph_lo, hi = args.ph_hi;
    XcdBarrier bar; bar.bar = (unsigned*)(F.ctl + CW_BAR); bar.x = 0; bar.st = nullptr;
    if (hi - lo > 1) bar = xcd_barrier_post((unsigned*)(F.ctl + CW_BAR), F.MISC + 8, f_tid == 0);
#define IN(k) (lo <= (k) && (k) < hi)
#define SEAM(k) do { if (IN(k) && IN((k) + 1)) xcd_barrier(bar, F.wave == 0 && lane_id() == 0); } while (0)

    if (IN(0)) { p0_prologue(F); } SEAM(0);
    if (IN(1)) { p1_norm1(F); } SEAM(1);
    if (IN(2)) {
        SchedInProj S{F.G, (int)blockIdx.x, (const char*)WSP(bf16_t, WS_H), (const char*)WSP(bf16_t, WS_WIN)};
        EpiInProj E{WSP(unsigned char, WS_Q), WSP(unsigned char, WS_K), WSP(unsigned char, WS_V), WSP(bf16_t, WS_UT), F.in[9], F.in[10], WSP(float, WS_SMALL + SM_ROPE)};
        g8::gemm_phase<false>(F.lds, DM, S, E, F.wave, lane_id());
    } SEAM(2);
    if (IN(3)) { p3_attention8(F); p3_hyena(F); } SEAM(3);
    if (IN(4)) { p4_hynorm(F); } SEAM(4);
    if (IN(5)) {
        SchedStatic S{F.G, (int)blockIdx.x, MROWS / 256, DM / 256, (const char*)WSP(bf16_t, WS_MIX), (const char*)WSP(bf16_t, WS_WOUT)};
        EpiOutProj E{F.in[0], WSP(bf16_t, WS_XN), WSP(float, WS_SMALL + SM_MOD)};
        g8::gemm_phase<false>(F.lds, DM, S, E, F.wave, lane_id());
    } SEAM(5);
    if (IN(6)) { p6_router_mfma(F); } SEAM(6);
    if (IN(8)) {
        int nT; const LAS unsigned char* TE = moe_tiles(F, nT);
        LAS int* RWL = (LAS int*)(F.lds + RING_BYTES + 1024);
        static_assert(RING_BYTES + 1024 + 17 * 1024 <= LDSCTL_OFF, "LDS map");
        SchedMoE<8> S{F.G, (int)blockIdx.x, nT, (const char*)WSP(char, WS_H), (const char*)WSP(char, WS_W1), (size_t)2 * DM * DM, TE, RWL, true};
        { const int* list = WSP(int, WS_LIST2); const int t8 = F.wave * 64 + lane_id();
            g8::Unit u; for (int i = 0; i < 17 && S.next(i, u); i += 2) { const int ii = i + (t8 >> 8); g8::Unit u2; if (S.next(ii, u2)) { const long ix = S.lidx(u2.pm, u2.ex, t8 & 255); RWL[ii * 256 + (t8 & 255)] = (ix >= 0) ? (list[ix] >> 2) : 0; } }
            __syncthreads(); }
        EpiSwiGLU E{WSP(unsigned char, WS_ACT), F.in[31]};
        g8::gemm_phase_g<true, true>(F.lds, DM, S, E, F.wave, lane_id());
    } SEAM(8);
    if (IN(9)) {
        int nT; const LAS unsigned char* TE = moe_tiles(F, nT);
        SchedMoE<4> S{F.G, (int)blockIdx.x, nT, (const char*)WSP(char, WS_ACT), (const char*)WSP(char, WS_W2), (size_t)DM * DM, TE, nullptr, false};
        LAS int* LL = (LAS int*)(F.lds + RING_BYTES + 1024);
        static_assert(RING_BYTES + 1024 + 9 * 2048 <= LDSCTL_OFF, "LDS map");
        { const int* list = WSP(int, WS_LIST2); const float* gslot = WSP(float, WS_GSLOT2);
            const int t9 = F.wave * 64 + lane_id();
            g8::Unit u; for (int i = 0; i < 9 && S.next(i, u); ++i) { const int t = t9 & 255; const long ix = S.lidx(u.pm, u.ex, t);
                LL[i * 512 + (t9 >> 8) * 256 + t] = (ix < 0) ? ((t9 < 256) ? -1 : 0) : ((t9 < 256) ? list[ix] : __float_as_int(gslot[ix])); }
            __syncthreads(); }
        EpiDown E{WSP(unsigned char, WS_EO), F.in[33], LL, F.G, (int)blockIdx.x};
        g8::gemm_phase<true>(F.lds, DM, S, E, F.wave, lane_id());
    } SEAM(9);
    if (IN(10)) { p10_combine(F); }
#undef IN
#undef SEAM
}

extern "C" void kernel_launch(void* const* d_in, const int* in_sizes, int n_in, void* d_out, int out_size, void* d_ws, size_t ws_size, hipStream_t stream) {
    static int grid = 0;
    if (grid == 0) {
        if (n_in != 34 || out_size != MROWS * DM || ws_size < WS_END) { fprintf(stderr, "kernel_launch: unexpected shapes: n_in %d out %d ws %zu (need %zu)\n", n_in, out_size, ws_size, (size_t)WS_END); grid = -1; return; }
        int dev = 0, cus = 0, per_cu = 0;
        if (hipGetDevice(&dev) != hipSuccess || hipDeviceGetAttribute(&cus, hipDeviceAttributeMultiprocessorCount, dev) != hipSuccess) { grid = -1; return; }
        if (hipFuncSetAttribute((const void*)mega, hipFuncAttributeMaxDynamicSharedMemorySize, LDS_BYTES) != hipSuccess) { fprintf(stderr, "kernel_launch: hipFuncSetAttribute failed\n"); grid = -1; return; }
        if (hipOccupancyMaxActiveBlocksPerMultiprocessor(&per_cu, (const void*)mega, NWAVES * 64, LDS_BYTES) != hipSuccess || per_cu < 1) { fprintf(stderr, "kernel_launch: occupancy query says %d\n", per_cu); per_cu = 1; }
        (void)hipGetLastError();
        grid = cus;
    }
    if (grid < 0) return;
    (void)hipMemsetAsync((char*)d_ws + WS_CTL, 0, CTL_ZERO_BYTES, stream);
    Args a{};
    for (int i = 0; i < 34; ++i) a.in[i] = (const float*)d_in[i];
    a.out = (float*)d_out; a.ws = (unsigned char*)d_ws;
    constexpr int LAST = MK_LAST_PHASE + 1;
    if (MK_N_LAUNCHES == 1) { a.ph_lo = 0; a.ph_hi = LAST; hipLaunchKernelGGL(mega, dim3(grid), dim3(NWAVES * 64), LDS_BYTES, stream, a); }
    else for (int p = 0; p < LAST; ++p) { a.ph_lo = p; a.ph_hi = p + 1; hipLaunchKernelGGL(mega, dim3(grid), dim3(NWAVES * 64), LDS_BYTES, stream, a); }
    const hipError_t le = hipPeekAtLastError();
    if (le != hipSuccess) fprintf(stderr, "kernel_launch: launch failed: %s\n", hipGetErrorName(le));
}
```

```cpp
#include <hip/hip_runtime.h>
#include <hip/hip_bf16.h>
#include <cstdio>
#include <cstdint>

#ifndef MK_N_LAUNCHES
#define MK_N_LAUNCHES 1
#endif
#ifndef MK_LAST_PHASE
#define MK_LAST_PHASE 10
#endif

#define GAS __attribute__((address_space(1)))
#define LAS __attribute__((address_space(3)))
typedef unsigned short bf16_t;
typedef short bf16x8 __attribute__((ext_vector_type(8)));
typedef short s16x4 __attribute__((ext_vector_type(4)));
typedef float f32x2 __attribute__((ext_vector_type(2)));
typedef float f32x4 __attribute__((ext_vector_type(4)));
typedef float f32x16 __attribute__((ext_vector_type(16)));
typedef unsigned u32x2 __attribute__((ext_vector_type(2)));
typedef unsigned u32x4 __attribute__((ext_vector_type(4)));
typedef GAS unsigned gu32;

constexpr int NB = 8, SEQ = 4096, DM = 1024, MROWS = NB * SEQ, CTXL = 256, MCTX = NB * CTXL, MTOT = MROWS + MCTX;
constexpr int KVL = CTXL + SEQ;
constexpr int NHEAD = 4, QKW = 512;
constexpr int HYW = 512, HYC = 1536, INC = 3072, QKVC = 1536;
constexpr int NEXP = 32, TOPK = 4, NMOD = 6;
constexpr float EPS = 1e-6f;
constexpr float LAM_INIT = 0.2f;
constexpr float QSCALE = 0.125f * 1.4426950408889634f;

constexpr size_t MiB = 1u << 20;
constexpr size_t WS_CTL = 0, CTL_ZERO_BYTES = 64 * 1024;
constexpr size_t WS_SMALL = 1 * MiB;
constexpr size_t WS_WIN = 2 * MiB;
constexpr size_t WS_WOUT = 8 * MiB;
constexpr size_t WS_W1 = 10 * MiB;
constexpr size_t WS_W2 = 138 * MiB;
constexpr size_t WS_H = 202 * MiB;
constexpr size_t WS_Q = 270 * MiB;
constexpr size_t WS_K = 302 * MiB;
constexpr size_t WS_V = 336 * MiB;
constexpr size_t WS_UT = 370 * MiB;
constexpr size_t WS_FILT = 466 * MiB;
constexpr size_t WS_Z2T = 498 * MiB;
constexpr size_t WS_MIX = 530 * MiB;
constexpr size_t WS_ROUTE = 594 * MiB;
constexpr size_t WS_ACT = 270 * MiB;
constexpr size_t WS_EO = 598 * MiB;
constexpr size_t WS_XN = 870 * MiB;
constexpr size_t WS_END = 998 * MiB;
constexpr size_t SM_MOD = 0;
constexpr size_t SM_SCAL = 256 * 1024;
constexpr size_t SM_ROPE = 260 * 1024;
constexpr size_t SM_RBIAS = 272 * 1024;
constexpr int CW_BAR = 4096;
constexpr int CW_GEMV = 320;

constexpr int RING_BYTES = 131072;
constexpr int LDSCTL_OFF = 151552;
constexpr int LDS_BYTES = 152576;
constexpr int NWAVES = 8;

#define LDS_WAIT() asm volatile("s_waitcnt lgkmcnt(0)" ::: "memory")
#define VM_WAIT() asm volatile("s_waitcnt vmcnt(0)" ::: "memory")
#define RLX_AGENT __ATOMIC_RELAXED, __HIP_MEMORY_SCOPE_AGENT

__device__ __forceinline__ unsigned cvt_pk_bf16(float lo, float hi) { unsigned r; asm volatile("v_cvt_pk_bf16_f32 %0, %1, %2" : "=v"(r) : "v"(lo), "v"(hi)); return r; }
__device__ __forceinline__ float bf2f(bf16_t v) { return __uint_as_float(((unsigned)v) << 16); }
__device__ __forceinline__ float wave_sum(float v) {
#pragma unroll
    for (int o = 1; o < 64; o <<= 1) v += __shfl_xor(v, o);
    return v;
}

#define XB_TMO      128
#define XB_XCNT(j)  (256  + 64 * (j))
#define XB_XSUB(j)  (1280 + 64 * (j))
#define XB_XGEN(j)  (2304 + 64 * (j))
#define XB_TOP      3328
#define XB_TOPGEN   3392
#define XCD_BAR_WORDS 3456
#define XB_SPIN_CAP (1u << 22)
__device__ __forceinline__ unsigned xb_ld(unsigned* p)              { return __hip_atomic_load(p, __ATOMIC_RELAXED, __HIP_MEMORY_SCOPE_AGENT); }
__device__ __forceinline__ unsigned xb_add(unsigned* p, unsigned v) { return __hip_atomic_fetch_add(p, v, __ATOMIC_RELAXED, __HIP_MEMORY_SCOPE_AGENT); }
__device__ __forceinline__ unsigned xb_xcc_id() { return (unsigned)__builtin_amdgcn_s_getreg((3 << 11) | 20) & 0xFu; }
#define XB_SPIN(cond, bar) do { unsigned _sp = 0; while (cond) { __builtin_amdgcn_s_sleep(1); \
    if ((++_sp & 255u) == 0u) { if (xb_ld(&(bar)[XB_TMO])) break; if (_sp > XB_SPIN_CAP) { atomicAdd(&(bar)[XB_TMO], 1u); break; } } } } while (0)
struct XcdBarrier { unsigned* bar; unsigned x; volatile LAS unsigned* st; };
__device__ __forceinline__ XcdBarrier xcd_barrier_post(unsigned* bar, volatile LAS unsigned* st, bool leader) {
    XcdBarrier b; b.bar = bar; b.x = xb_xcc_id(); b.st = st;
    if (leader) (void)xb_add(&bar[XB_XCNT(b.x)], 1u);
    return b;
}
__device__ __forceinline__ void xcd_barrier_complete(unsigned* bar, unsigned x, unsigned& nloc, unsigned& nx) {
    const unsigned G = gridDim.x * gridDim.y * gridDim.z;
    unsigned sum, cnt, mine, sp = 0u;
    for (;;) {
        sum = 0u; cnt = 0u; mine = 0u;
#pragma unroll
        for (unsigned j = 0; j < 16; ++j) { const unsigned c = xb_ld(&bar[XB_XCNT(j)]); sum += c; cnt += (c > 0u) ? 1u : 0u; mine = (j == x) ? c : mine; }
        if (sum == G) break;
        __builtin_amdgcn_s_sleep(1);
        if ((++sp & 255u) == 0u) { if (xb_ld(&bar[XB_TMO])) break; if (sp > XB_SPIN_CAP) { atomicAdd(&bar[XB_TMO], 1u); break; } }
    }
    nloc = mine > 0u ? mine : 1u; nx = cnt > 0u ? cnt : 1u;
}
__device__ __forceinline__ void xcd_barrier(const XcdBarrier& b, bool leader) {
    asm volatile("s_waitcnt vmcnt(0)" ::: "memory");
    __syncthreads();
    if (leader) {
        unsigned* bar = b.bar;
        __builtin_amdgcn_s_waitcnt(0);
        unsigned nloc = b.st[0], nx = b.st[1];
        if (nloc == 0u) { xcd_barrier_complete(bar, b.x, nloc, nx); b.st[0] = nloc; b.st[1] = nx; }
        const unsigned old = xb_add(&bar[XB_XSUB(b.x)], 1u);
        const unsigned gen = old / nloc;
        if (old + 1u == (gen + 1u) * nloc) {
            __builtin_amdgcn_fence(__ATOMIC_RELEASE, "agent");
            asm volatile("s_waitcnt vmcnt(0)" ::: "memory");
            const unsigned og = xb_add(&bar[XB_TOP], 1u);
            const unsigned tg = og / nx;
            if (og + 1u == (tg + 1u) * nx) xb_add(&bar[XB_TOPGEN], 1u);
            else XB_SPIN(xb_ld(&bar[XB_TOPGEN]) == tg, bar);
            __builtin_amdgcn_fence(__ATOMIC_ACQUIRE, "agent");
            xb_add(&bar[XB_XGEN(b.x)], 1u);
            asm volatile("s_waitcnt vmcnt(0)" ::: "memory");
        } else {
            XB_SPIN(xb_ld(&bar[XB_XGEN(b.x)]) == gen, bar);
            __builtin_amdgcn_fence(__ATOMIC_ACQUIRE, "agent");
            asm volatile("s_waitcnt vmcnt(0)" ::: "memory");
        }
    }
    __syncthreads();
}

namespace g8 {
constexpr int BM = 256, BK = 64, HALF = 128, HTB = HALF * BK * 2, STAGE_BYTES = 8 * HTB, NXCD = 8, WGM = 8;
__host__ __device__ __forceinline__ int lds_byte(int r, int c) { const int st = (r >> 4) * 2 + (c >> 5), rr = r & 15, cc = c & 31, ob = rr * 64 + cc * 2; return st * 1024 + (ob ^ (((ob >> 9) & 1) << 5)); }
__host__ __device__ __forceinline__ void stage_rc(int b, int& R, int& C) { const int st = b / 1024, sb = b % 1024, swz = sb ^ (((sb >> 9) & 1) << 5); R = (st >> 1) * 16 + swz / 64; C = (st & 1) * 32 + (swz % 64) / 2; }
__host__ __device__ __forceinline__ int perm32(int rho) { const int n = rho >> 4, i = rho & 15; return 8 * (i >> 2) + 4 * n + (i & 3); }

struct Unit { const char* a; const char* b; int pm, pn, kind, ex; };

__device__ __forceinline__ void tile_of(int L, int nM, int nN, int& pm, int& pn) {
    const int nwg = nM * nN; int wgid = L;
    { const int q = nwg / NXCD, r = nwg % NXCD, xcd = wgid % NXCD, off = wgid / NXCD; wgid = (xcd < r ? xcd * (q + 1) : r * (q + 1) + (xcd - r) * q) + off; }
    const int nig = WGM * nN, gid = wgid / nig, fm = gid * WGM, gsz = (nM - fm) < WGM ? (nM - fm) : WGM;
    pm = fm + ((wgid % nig) % gsz); pn = (wgid % nig) / gsz;
}

typedef int i32x8 __attribute__((ext_vector_type(8)));
template <bool FP8, bool GATHER, bool SP2, class Epi, class Sched>
__device__ __forceinline__ void gemm_phase_s(LAS unsigned char* lds, const int K, const Sched& S, const Epi& E, const int wid, const int lane) {
    const int tid = wid * 64 + lane, wr = wid >> 2, wc = wid & 3, fr = lane & 15, fq = lane >> 4;
    const int nt = FP8 ? K / 128 : K / BK;
    const int RP = FP8 ? K : 2 * K;
    unsigned voffA[2], voffB[2]; int srow[2], scol[2];
#pragma unroll
    for (int i = 0; i < 2; ++i) { int R, C; stage_rc(tid * 16 + i * 8192, R, C); const int Rb = (R & ~31) + perm32(R & 31);
        voffA[i] = (unsigned)(R * RP + C * 2); voffB[i] = (unsigned)(Rb * RP + C * 2); srow[i] = R; scol[i] = C * 2; }
    const size_t kstep = (size_t)(BK * 2);
    const size_t hstep = (size_t)HALF * RP;
    const unsigned ldsw = (unsigned)wid * 1024u;
    unsigned cO0[2], cO1[2], nO0[2], nO1[2];
#define PG8_GOFF(D0, D1, ui_) do { if constexpr (GATHER) { const LAS int* rw_ = S.rows(ui_); _Pragma("unroll") for (int i_ = 0; i_ < 2; ++i_) { \
        D0[i_] = (unsigned)rw_[srow[i_]] * (unsigned)RP + (unsigned)scol[i_]; D1[i_] = (unsigned)rw_[128 + srow[i_]] * (unsigned)RP + (unsigned)scol[i_]; } } \
      else { _Pragma("unroll") for (int i_ = 0; i_ < 2; ++i_) { D0[i_] = voffA[i_]; D1[i_] = voffA[i_] + (unsigned)hstep; } } } while (0)
    const int aoff = lds_byte(wr * 64 + fr, FP8 ? fq * 16 : fq * 8), boff = lds_byte(wc * 32 + fr, FP8 ? fq * 16 : fq * 8);
    constexpr int KOFF = FP8 ? 16 : 1024;
#define PG8_SA(b, h) (((b) * 2 + (h)) * HTB)
#define PG8_SB(b, h) ((4 + (b) * 2 + (h)) * HTB)
#define PG8_STAGE(bufoff, gbase, voff) do { _Pragma("unroll") for (int _i = 0; _i < 2; ++_i) \
        __builtin_amdgcn_global_load_lds((const unsigned*)((const char*)(gbase) + (voff)[_i]), (LAS unsigned*)(lds + (bufoff) + ldsw + _i * 8192), 16, 0, 0); } while (0)
#define PG8_LD32(p) __builtin_bit_cast(i32x8, __builtin_shufflevector(*(const LAS u32x4*)(p), *(const LAS u32x4*)((p) + 16), 0, 1, 2, 3, 4, 5, 6, 7))
#define PG8_LDA8(dst, b, h) do { _Pragma("unroll") for (int m = 0; m < 4; ++m) dst[m] = PG8_LD32(lds + PG8_SA(b, h) + aoff + m * 2048); } while (0)
#define PG8_LDB8(dst, b, h) do { _Pragma("unroll") for (int n = 0; n < 2; ++n) dst[n] = PG8_LD32(lds + PG8_SB(b, h) + boff + n * 2048); } while (0)
#define PG8_LDA(dst, b, h) do { _Pragma("unroll") for (int m = 0; m < 4; ++m) _Pragma("unroll") for (int k = 0; k < 2; ++k) dst[m][k] = *(const LAS bf16x8*)(lds + PG8_SA(b, h) + aoff + m * 2048 + k * KOFF); } while (0)
#define PG8_LDB(dst, b, h) do { _Pragma("unroll") for (int n = 0; n < 2; ++n) _Pragma("unroll") for (int k = 0; k < 2; ++k) dst[n][k] = *(const LAS bf16x8*)(lds + PG8_SB(b, h) + boff + n * 2048 + k * KOFF); } while (0)
#define PG8_MMA(ai, bj, At, Bt) do { __builtin_amdgcn_s_setprio(1); _Pragma("unroll") for (int m = 0; m < 4; ++m) _Pragma("unroll") for (int n = 0; n < 2; ++n) _Pragma("unroll") for (int k = 0; k < 2; ++k) \
        acc[ai][bj][m][n] = __builtin_amdgcn_mfma_f32_16x16x32_bf16(Bt[n][k], At[m][k], acc[ai][bj][m][n], 0, 0, 0); __builtin_amdgcn_s_setprio(0); } while (0)
#define PG8_MMA8(ai, bj, At, Bt) do { __builtin_amdgcn_s_setprio(1); _Pragma("unroll") for (int m = 0; m < 4; ++m) _Pragma("unroll") for (int n = 0; n < 2; ++n) \
        asm volatile("v_mfma_scale_f32_16x16x128_f8f6f4 %0, %1, %2, %0, %3, %3 op_sel_hi:[0,0,0]" : "+v"(acc[ai][bj][m][n]) : "v"(Bt[n]), "v"(At[m]), "v"(one_scale)); __builtin_amdgcn_s_setprio(0); } while (0)
#define PG8_WAIT_V(n) asm volatile("s_waitcnt vmcnt(" #n ")" ::: "memory")
#define PG8_WAIT_L(n) asm volatile("s_waitcnt lgkmcnt(" #n ")" ::: "memory")
#define PG8_BAR __builtin_amdgcn_s_barrier()
#define PG8_SCHED __builtin_amdgcn_sched_barrier(0)
    Unit cur, nxt; int ui = 0;
    if (!S.next(0, cur)) return;
    f32x4 acc[2][2][4][2];
#pragma unroll
    for (int a = 0; a < 2; ++a)
#pragma unroll
        for (int b = 0; b < 2; ++b)
#pragma unroll
            for (int m = 0; m < 4; ++m)
#pragma unroll
                for (int n = 0; n < 2; ++n) acc[a][b][m][n] = (f32x4){0.f, 0.f, 0.f, 0.f};
    bf16x8 At[4][2], B0[2][2], B1[2][2];
    i32x8 At8[4], B08[2], B18[2];
    const unsigned one_scale = 0x7f7f7f7fu;
    const char* cA = cur.a; const char* cB = cur.b;
    PG8_GOFF(cO0, cO1, 0);
    if constexpr (SP2) {
    PG8_STAGE(PG8_SB(0, 0), cB, voffB); PG8_STAGE(PG8_SB(0, 1), cB + hstep, voffB); PG8_STAGE(PG8_SA(0, 0), cA, cO0); PG8_STAGE(PG8_SA(0, 1), cA, cO1);
    if (wr == 1) PG8_BAR;
    PG8_WAIT_V(2); PG8_BAR;
    PG8_STAGE(PG8_SB(1, 0), cB + kstep, voffB); PG8_STAGE(PG8_SA(1, 0), cA + kstep, cO0); PG8_STAGE(PG8_SB(1, 1), cB + hstep + kstep, voffB);
    PG8_WAIT_V(6); PG8_BAR;
    } else {
    PG8_STAGE(PG8_SB(0, 0), cB, voffB); PG8_STAGE(PG8_SA(0, 0), cA, cO0); PG8_STAGE(PG8_SB(0, 1), cB + hstep, voffB); PG8_STAGE(PG8_SA(0, 1), cA, cO1);
    if (wr == 1) PG8_BAR;
    PG8_WAIT_V(4); PG8_BAR;
    PG8_STAGE(PG8_SB(1, 0), cB + kstep, voffB); PG8_STAGE(PG8_SA(1, 0), cA + kstep, cO0); PG8_STAGE(PG8_SB(1, 1), cB + hstep + kstep, voffB);
    PG8_WAIT_V(6); PG8_BAR;
    }
    for (;;) {
        const bool has_next = S.next(ui + 1, nxt);
        const char* nA = has_next ? nxt.a : cA; const char* nB = has_next ? nxt.b : cB;
        if (has_next) PG8_GOFF(nO0, nO1, ui + 1); else { _Pragma("unroll") for (int i_ = 0; i_ < 2; ++i_) { nO0[i_] = cO0[i_]; nO1[i_] = cO1[i_]; } }
#pragma unroll 1
        for (int t = 0; t < nt; t += 2) {
            const bool last = (t == nt - 2);
            const char* a1 = cA + (size_t)(t + 1) * kstep;
            const char* a2 = last ? nA : cA + (size_t)(t + 2) * kstep; const char* b2 = last ? nB : cB + (size_t)(t + 2) * kstep;
            const char* a3 = a2 + kstep; const char* b3 = b2 + kstep;
            unsigned o20[2], o21[2];
#pragma unroll
            for (int i_ = 0; i_ < 2; ++i_) { o20[i_] = last ? nO0[i_] : cO0[i_]; o21[i_] = last ? nO1[i_] : cO1[i_]; }
            if constexpr (FP8 && SP2) {
            PG8_LDB8(B08, 0, 0); PG8_LDB8(B18, 0, 1); PG8_SCHED; PG8_LDA8(At8, 0, 0); PG8_STAGE(PG8_SA(1, 1), a1, cO1);
            PG8_WAIT_V(8); PG8_WAIT_L(0); PG8_BAR; PG8_MMA8(0, 0, At8, B08); PG8_MMA8(0, 1, At8, B18); PG8_BAR; PG8_SCHED;
            PG8_LDA8(At8, 0, 1); PG8_STAGE(PG8_SB(0, 0), b2, voffB); PG8_STAGE(PG8_SB(0, 1), b2 + hstep, voffB); PG8_STAGE(PG8_SA(0, 0), a2, o20);
            PG8_WAIT_V(8); PG8_WAIT_L(0); PG8_BAR; PG8_MMA8(1, 0, At8, B08); PG8_MMA8(1, 1, At8, B18); PG8_BAR; PG8_SCHED;
            PG8_LDB8(B08, 1, 0); PG8_LDB8(B18, 1, 1); PG8_SCHED; PG8_LDA8(At8, 1, 0); PG8_STAGE(PG8_SA(0, 1), a2, o21);
            PG8_WAIT_V(8); PG8_WAIT_L(0); PG8_BAR; PG8_MMA8(0, 0, At8, B08); PG8_MMA8(0, 1, At8, B18); PG8_BAR; PG8_SCHED;
            PG8_LDA8(At8, 1, 1); PG8_STAGE(PG8_SB(1, 0), b3, voffB); PG8_STAGE(PG8_SB(1, 1), b3 + hstep, voffB); PG8_STAGE(PG8_SA(1, 0), a3, o20);
            PG8_WAIT_V(8); PG8_WAIT_L(0); PG8_BAR; PG8_MMA8(1, 0, At8, B08); PG8_MMA8(1, 1, At8, B18); PG8_BAR; PG8_SCHED;
            } else if constexpr (FP8) {
            PG8_LDB8(B08, 0, 0); PG8_SCHED; PG8_LDA8(At8, 0, 0); PG8_STAGE(PG8_SA(1, 1), a1, cO1);
            PG8_WAIT_L(8); PG8_BAR; PG8_WAIT_L(0); PG8_MMA8(0, 0, At8, B08); PG8_BAR; PG8_SCHED;
            PG8_LDB8(B18, 0, 1); PG8_STAGE(PG8_SB(0, 0), b2, voffB);
            PG8_BAR; PG8_WAIT_L(0); PG8_MMA8(0, 1, At8, B18); PG8_BAR;
            PG8_LDA8(At8, 0, 1); PG8_STAGE(PG8_SA(0, 0), a2, o20);
            PG8_BAR; PG8_WAIT_L(0); PG8_MMA8(1, 0, At8, B08); PG8_BAR; PG8_SCHED;
            PG8_STAGE(PG8_SB(0, 1), b2 + hstep, voffB);
            PG8_WAIT_V(6); PG8_BAR; PG8_MMA8(1, 1, At8, B18); PG8_BAR;
            PG8_LDB8(B08, 1, 0); PG8_SCHED; PG8_LDA8(At8, 1, 0); PG8_STAGE(PG8_SA(0, 1), a2, o21);
            PG8_WAIT_L(8); PG8_BAR; PG8_WAIT_L(0); PG8_MMA8(0, 0, At8, B08); PG8_BAR; PG8_SCHED;
            PG8_LDB8(B18, 1, 1); PG8_STAGE(PG8_SB(1, 0), b3, voffB);
            PG8_BAR; PG8_WAIT_L(0); PG8_MMA8(0, 1, At8, B18); PG8_BAR;
            PG8_LDA8(At8, 1, 1); PG8_STAGE(PG8_SA(1, 0), a3, o20);
            PG8_BAR; PG8_WAIT_L(0); PG8_MMA8(1, 0, At8, B08); PG8_BAR; PG8_SCHED;
            PG8_STAGE(PG8_SB(1, 1), b3 + hstep, voffB);
            PG8_WAIT_V(6); PG8_BAR; PG8_MMA8(1, 1, At8, B18); PG8_BAR;
            } else {
            PG8_LDB(B0, 0, 0); PG8_LDB(B1, 0, 1); PG8_SCHED; PG8_LDA(At, 0, 0); PG8_STAGE(PG8_SA(1, 1), a1, cO1);
            PG8_WAIT_V(8); PG8_WAIT_L(0); PG8_BAR; PG8_MMA(0, 0, At, B0); PG8_MMA(0, 1, At, B1); PG8_BAR; PG8_SCHED;
            PG8_LDA(At, 0, 1); PG8_STAGE(PG8_SB(0, 0), b2, voffB); PG8_STAGE(PG8_SB(0, 1), b2 + hstep, voffB); PG8_STAGE(PG8_SA(0, 0), a2, o20);
            PG8_WAIT_V(8); PG8_WAIT_L(0); PG8_BAR; PG8_MMA(1, 0, At, B0); PG8_MMA(1, 1, At, B1); PG8_BAR; PG8_SCHED;
            PG8_LDB(B0, 1, 0); PG8_LDB(B1, 1, 1); PG8_SCHED; PG8_LDA(At, 1, 0); PG8_STAGE(PG8_SA(0, 1), a2, o21);
            PG8_WAIT_V(8); PG8_WAIT_L(0); PG8_BAR; PG8_MMA(0, 0, At, B0); PG8_MMA(0, 1, At, B1); PG8_BAR; PG8_SCHED;
            PG8_LDA(At, 1, 1); PG8_STAGE(PG8_SB(1, 0), b3, voffB); PG8_STAGE(PG8_SB(1, 1), b3 + hstep, voffB); PG8_STAGE(PG8_SA(1, 0), a3, o20);
            PG8_WAIT_V(8); PG8_WAIT_L(0); PG8_BAR; PG8_MMA(1, 0, At, B0); PG8_MMA(1, 1, At, B1); PG8_BAR; PG8_SCHED;
            }
        }
        if (wr == 0) PG8_BAR;
        if constexpr (FP8) asm volatile("s_nop 15\n\ts_nop 15" ::: "memory");
        E(acc, cur, wr, wc, fr, fq);
        if (!has_next) break;
#pragma unroll
        for (int a = 0; a < 2; ++a)
#pragma unroll
            for (int b = 0; b < 2; ++b)
#pragma unroll
                for (int m = 0; m < 4; ++m)
#pragma unroll
                    for (int n = 0; n < 2; ++n) acc[a][b][m][n] = (f32x4){0.f, 0.f, 0.f, 0.f};
        cur = nxt; cA = nA; cB = nB; ++ui;
#pragma unroll
        for (int i_ = 0; i_ < 2; ++i_) { cO0[i_] = nO0[i_]; cO1[i_] = nO1[i_]; }
        if (wr == 1) PG8_BAR;
    }
    PG8_WAIT_V(0);
    PG8_BAR;
#undef PG8_SA
#undef PG8_GOFF
#undef PG8_SB
#undef PG8_STAGE
#undef PG8_LDA
#undef PG8_LDB
#undef PG8_MMA
#undef PG8_MMA8
#undef PG8_LDA8
#undef PG8_LDB8
#undef PG8_LD32
#undef PG8_WAIT_V
#undef PG8_WAIT_L
#undef PG8_BAR
#undef PG8_SCHED
}
template <bool FP8, bool GATHER, class Epi, class Sched>
__device__ __forceinline__ void gemm_phase_g(LAS unsigned char* lds, const int K, const Sched& S, const Epi& E, const int wid, const int lane) { gemm_phase_s<FP8, GATHER, !FP8>(lds, K, S, E, wid, lane); }
template <bool FP8, class Epi, class Sched>
__device__ __forceinline__ void gemm_phase(LAS unsigned char* lds, const int K, const Sched& S, const Epi& E, const int wid, const int lane) { gemm_phase_s<FP8, false, !FP8>(lds, K, S, E, wid, lane); }
}

__device__ __forceinline__ int lane_id() { int l; asm volatile("v_mbcnt_lo_u32_b32 %0, -1, 0\n\tv_mbcnt_hi_u32_b32 %0, -1, %0" : "=v"(l)); return l; }
#define FT_DECL const int f_lane = lane_id(), f_tid = F.wave * 64 + f_lane; (void)f_tid; (void)f_lane
typedef const float* cfp_t;
typedef __attribute__((address_space(4))) cfp_t* kin_t;
struct Frame {
    LAS unsigned char* lds;
    volatile LAS unsigned* MISC;
    gu32* ctl;
    int wave, vcu, G;
    kin_t in;
    float* out;
    unsigned char* ws;
};
#define WSP(T, off) ((T*)(F.ws + (off)))

template <class RowMap>
__device__ __forceinline__ void p0_transpose_item(const float* W, int K, int N, bf16_t* WT, const RowMap& rowmap, const float* kscale, LAS float* scr, int item, int lane, bool kperm = false) {
    const int nblk = N / 32, kb = item / nblk, nb = item % nblk, k0 = 64 * kb, n0 = 32 * nb;
#pragma unroll 8
    for (int i = 0; i < 32; ++i) { const int kk = 2 * i + (lane >> 5); int ks = k0 + kk; if (kperm && ks >= K / 2) { const int j = ks - K / 2; ks = K / 2 + (j >> 3) + 64 * (j & 7); }
        float v = W[(size_t)ks * N + n0 + (lane & 31)]; if (kscale) v *= kscale[k0 + kk]; scr[kk * 33 + (lane & 31)] = v; }
    LDS_WAIT(); asm volatile("" ::: "memory");
    const int c = lane & 7;
#pragma unroll
    for (int j = 0; j < 4; ++j) { const int n = (lane >> 3) + 8 * j; const LAS float* s = scr + (8 * c) * 33 + n;
        u32x4 o; o.x = cvt_pk_bf16(s[0 * 33], s[1 * 33]); o.y = cvt_pk_bf16(s[2 * 33], s[3 * 33]); o.z = cvt_pk_bf16(s[4 * 33], s[5 * 33]); o.w = cvt_pk_bf16(s[6 * 33], s[7 * 33]);
        *(GAS u32x4*)(WT + (size_t)rowmap(n0 + n) * K + k0 + 8 * c) = o; }
    LDS_WAIT(); asm volatile("" ::: "memory");
}

__device__ __forceinline__ unsigned pk4_fp8(float a, float b, float c, float d) { int r = __builtin_amdgcn_cvt_pk_fp8_f32(a, b, 0, false); r = __builtin_amdgcn_cvt_pk_fp8_f32(c, d, r, true); return (unsigned)r; }
constexpr float EOSCALE = 16.f;
constexpr float WSCALE = 32.f;
template <class RowMap>
__device__ __forceinline__ void p0_transpose_item_f8(const float* W, int K, int N, unsigned char* WT, const RowMap& rowmap, LAS float* scr, int item, int lane) {
    const int nblk = N / 32, kb = item / nblk, nb = item % nblk, k0 = 128 * kb, n0 = 32 * nb;
#pragma unroll
    for (int hh = 0; hh < 2; ++hh) { float v[32];
#pragma unroll
        for (int i = 0; i < 32; ++i) { const int kk = 2 * (32 * hh + i) + (lane >> 5); v[i] = __builtin_nontemporal_load(W + (size_t)(k0 + kk) * N + n0 + (lane & 31)); }
#pragma unroll
        for (int i = 0; i < 32; ++i) { const int kk = 2 * (32 * hh + i) + (lane >> 5); scr[kk * 33 + (lane & 31)] = v[i] * WSCALE; } }
    LDS_WAIT(); asm volatile("" ::: "memory");
    const int c = lane & 7;
#pragma unroll
    for (int j = 0; j < 4; ++j) { const int n = (lane >> 3) + 8 * j; const LAS float* sp = scr + (16 * c) * 33 + n;
        u32x4 o; o.x = pk4_fp8(sp[0 * 33], sp[1 * 33], sp[2 * 33], sp[3 * 33]); o.y = pk4_fp8(sp[4 * 33], sp[5 * 33], sp[6 * 33], sp[7 * 33]);
        o.z = pk4_fp8(sp[8 * 33], sp[9 * 33], sp[10 * 33], sp[11 * 33]); o.w = pk4_fp8(sp[12 * 33], sp[13 * 33], sp[14 * 33], sp[15 * 33]);
        *(GAS u32x4*)(WT + (size_t)rowmap(n0 + n) * K + k0 + 16 * c) = o; }
    LDS_WAIT(); asm volatile("" ::: "memory");
}
struct MapW2 { __device__ __forceinline__ int operator()(int l) const { const int t = l & ~255, r = l & 255, wc = r >> 6, fq = (r >> 4) & 3, bj = (r >> 3) & 1, low = r & 7; return t + 128 * bj + 32 * wc + 8 * fq + low; } };
struct MapIdent { int off; __device__ __forceinline__ int operator()(int n) const { return off + n; } };
struct MapWin { __device__ __forceinline__ int operator()(int l) const {
    if (l >= 1024) return l;
    const int t = l & ~255, r = l & 255, wc = r >> 6, blk = (r >> 5) & 1, bj = (r >> 4) & 1, low = r & 15;
    return t + 128 * bj + 32 * wc + 16 * blk + low; } };
struct MapW1 { int off; __device__ __forceinline__ int operator()(int jp) const { const int bj = jp >> 10, j = jp & 1023; return off + 256 * (j >> 7) + 128 * bj + (j & 127); } };


__device__ __forceinline__ void p0_filter_item(Frame& F, int item) {
    FT_DECL;
#define in F.in
    LAS float* h1s = (LAS float*)(F.lds);
    LAS float* h2s = (LAS float*)(F.lds + 4096);
    const int t0 = item * 16;
    {
        const int tt = f_tid >> 5, hh = (f_tid & 31) * 2; const float pos = (float)(t0 + tt);
        float feats[17]; feats[0] = pos * (1.f / SEQ);
#pragma unroll
        for (int i = 0; i < 8; ++i) { const float band = 1e-4f + (float)i * ((7.f - 1e-4f) / 7.f); const float ang = (6.283185307179586f / SEQ) * pos * band; feats[1 + i] = __sinf(ang); feats[9 + i] = __cosf(ang); }
#pragma unroll
        for (int u = 0; u < 2; ++u) { const int h = hh + u; float a = in[19][h];
#pragma unroll
            for (int k = 0; k < 17; ++k) a += feats[k] * in[18][k * 64 + h];
            h1s[tt * 64 + h] = __sinf(in[20][h] * a); }
        __syncthreads();
#pragma unroll
        for (int u = 0; u < 2; ++u) { const int h = hh + u; float a = in[22][h];
#pragma unroll 8
            for (int k = 0; k < 64; ++k) a += h1s[tt * 64 + k] * in[21][k * 64 + h];
            h2s[tt * 64 + h] = __sinf(in[23][h] * a); }
        __syncthreads();
    }
    f32x4 acc[16];
#pragma unroll
    for (int t = 0; t < 16; ++t) acc[t] = (f32x4){0.f, 0.f, 0.f, 0.f};
    const int o = 4 * f_tid;
    for (int k0 = 0; k0 < 64; k0 += 4) { f32x4 w[4];
#pragma unroll
        for (int q = 0; q < 4; ++q) w[q] = *(const f32x4*)(in[24] + (size_t)(k0 + q) * 2048 + o);
#pragma unroll
        for (int t = 0; t < 16; ++t) { const f32x4 hv = *(const LAS f32x4*)(h2s + t * 64 + k0); acc[t] += w[0] * hv[0] + w[1] * hv[1] + w[2] * hv[2] + w[3] * hv[3]; } }
    const int c0 = o & 511, od = o >> 9;
    float* dst = WSP(float, WS_FILT) + ((size_t)od * 512 + c0) * SEQ + t0;
#pragma unroll
    for (int e = 0; e < 4; ++e) { const float la = -3.0701134573253944f, lb = -15.350567286626972f; const float delta = fabsf(la + (float)(c0 + e) * ((lb - la) / 511.f));
#pragma unroll
        for (int q = 0; q < 4; ++q) { f32x4 v;
#pragma unroll
            for (int i = 0; i < 4; ++i) { const int t = 4 * q + i; const float tn = (float)(t0 + t) * (1.f / SEQ); v[i] = acc[t][e] * __expf(-tn * delta); }
            *(f32x4*)(dst + (size_t)e * SEQ + 4 * q) = v; } }
    __syncthreads();
#undef in
}

__device__ __forceinline__ float silu_f(float v) { return v / (1.f + __expf(-v)); }

__device__ __forceinline__ void p0_prologue(Frame& F) {
    FT_DECL;
#define in F.in
    const int wg = blockIdx.x;
    if (wg < 96) {
        LAS float* sv = (LAS float*)F.lds;
        for (int i = f_tid; i < 9 * 1024; i += 512) { const int r = i >> 10, k = i & 1023; const float c = (r < 8) ? in[1][r * 1024 + k] : in[3][k]; sv[i] = silu_f(c); }
        __syncthreads();
        const int j = wg * 64 + f_lane; const float* wm = in[4];
        float acc[9];
#pragma unroll
        for (int r = 0; r < 9; ++r) acc[r] = 0.f;
        const int kbeg = F.wave * 128;
        for (int k0 = kbeg; k0 < kbeg + 128; k0 += 16) { float w[16];
#pragma unroll
            for (int q = 0; q < 16; ++q) w[q] = __builtin_nontemporal_load(wm + (size_t)(k0 + q) * (NMOD * DM) + j);
#pragma unroll
            for (int q = 0; q < 16; ++q)
#pragma unroll
                for (int r = 0; r < 9; ++r) acc[r] += sv[r * 1024 + k0 + q] * w[q]; }
        LAS float* red = (LAS float*)(F.lds + 40960);
#pragma unroll
        for (int r = 0; r < 9; ++r) red[(F.wave * 9 + r) * 64 + f_lane] = acc[r];
        __syncthreads();
        for (int i = f_tid; i < 9 * 64; i += 512) { const int r = i >> 6, l = i & 63; float s = in[5][wg * 64 + l];
#pragma unroll
            for (int w = 0; w < 8; ++w) s += red[(w * 9 + r) * 64 + l];
            WSP(float, WS_SMALL + SM_MOD)[r * (NMOD * DM) + wg * 64 + l] = s; }
        asm volatile("s_waitcnt vmcnt(0)" ::: "memory");
        __syncthreads();
        if (f_tid == 0) { __builtin_amdgcn_fence(__ATOMIC_RELEASE, "agent"); asm volatile("s_waitcnt vmcnt(0)" ::: "memory"); (void)xb_add((unsigned*)(F.ctl + CW_GEMV), 1u); }
    } else if (wg == 96) {
        if (F.wave == 0) {
            const float a = wave_sum(in[11][f_lane] * in[12][f_lane]), b = wave_sum(in[13][f_lane] * in[14][f_lane]);
            float gq = fabsf(in[9][f_lane]), gk = fabsf(in[10][f_lane]);
#pragma unroll
            for (int o = 1; o < 64; o <<= 1) { gq = fmaxf(gq, __shfl_xor(gq, o)); gk = fmaxf(gk, __shfl_xor(gk, o)); }
            if (f_lane == 0) { float* sc = WSP(float, WS_SMALL + SM_SCAL); sc[0] = expf(a) - expf(b) + LAM_INIT;
                sc[1] = (8.f * gq * gk * 1.02f + 0.05f) * 1.4426950408889634f; }
        }
        for (int i = f_tid; i < 64 * 16; i += 512) { const int pos = i >> 4, f = i & 15;
            const float inv = powf(10000.f, -(float)f / 16.f); const float ang = (float)pos * inv;
            float* rt = WSP(float, WS_SMALL + SM_ROPE); rt[2 * i] = cosf(ang); rt[2 * i + 1] = sinf(ang); }
    }
    __syncthreads();
    for (int it = wg; it < SEQ / 16; it += F.G) p0_filter_item(F, it);
    __syncthreads();
    {
        LAS float* scr = (LAS float*)(F.lds + F.wave * 16896);
        const int gw = F.vcu * NWAVES + F.wave, NGW = F.G * NWAVES;
        constexpr int I_IN = (DM / 64) * (INC / 32), I_OUT = (DM / 64) * (DM / 32), I_1 = (DM / 128) * (2 * DM / 32), I_2 = (DM / 128) * (DM / 32);
        constexpr int NITEMS = I_IN + I_OUT + NEXP * (I_1 + I_2);
        for (int it = gw; it < NITEMS; it += NGW) {
            int r = it;
            if (r < I_IN) { p0_transpose_item(in[8], DM, INC, WSP(bf16_t, WS_WIN), MapWin{}, nullptr, scr, r, f_lane); continue; } r -= I_IN;
            if (r < I_OUT) { p0_transpose_item(in[27], DM, DM, WSP(bf16_t, WS_WOUT), MapIdent{0}, nullptr, scr, r, f_lane, true); continue; } r -= I_OUT;
            const int e = r / (I_1 + I_2); r -= e * (I_1 + I_2);
            if (r < I_1) p0_transpose_item_f8(in[30] + (size_t)e * DM * 2 * DM, DM, 2 * DM, WSP(unsigned char, WS_W1) + (size_t)e * 2 * DM * DM, MapW1{0}, scr, r, f_lane);
            else p0_transpose_item_f8(in[32] + (size_t)e * DM * DM, DM, DM, WSP(unsigned char, WS_W2) + (size_t)e * DM * DM, MapW2{}, scr, r - I_1, f_lane);
        }
    }
}
#undef in

__device__ __forceinline__ void p1_norm1(Frame& F) {
    FT_DECL;
    const int gw = F.vcu * NWAVES + F.wave, NGW = F.G * NWAVES;
    const float* mod = WSP(float, WS_SMALL + SM_MOD); const float* g1 = F.in[6];
    bf16_t* H = WSP(bf16_t, WS_H);
    if (f_tid == 0) { unsigned* bar = (unsigned*)(F.ctl + CW_BAR); XB_SPIN(xb_ld((unsigned*)(F.ctl + CW_GEMV)) < 96u, bar); __builtin_amdgcn_fence(__ATOMIC_ACQUIRE, "agent"); asm volatile("s_waitcnt vmcnt(0)" ::: "memory"); }
    __syncthreads();
    for (int pe = blockIdx.x; pe < NB * NEXP; pe += F.G) { const int b = pe >> 5, e = pe & 31; const float* sh2 = mod + (size_t)b * (NMOD * DM) + 3 * DM; const float* rw = F.in[28];
        const int t = F.wave * 64 + lane_id();
        float a = sh2[t] * rw[(size_t)t * 32 + e] + sh2[t + 512] * rw[(size_t)(t + 512) * 32 + e];
        a = wave_sum(a);
        LAS float* red = (LAS float*)F.lds;
        __syncthreads(); if (lane_id() == 0) red[F.wave] = a; __syncthreads();
        if (t == 0) { float sacc = F.in[29][e];
#pragma unroll
            for (int w = 0; w < NWAVES; ++w) sacc += red[w];
            WSP(float, WS_SMALL + SM_RBIAS)[pe] = sacc; }
        __syncthreads(); }
    constexpr int RPW = MTOT / (256 * NWAVES);
    for (int run = gw; run * RPW < MTOT; run += NGW) {
        const int r0 = run * RPW, r1 = (r0 + RPW < MTOT) ? r0 + RPW : MTOT;
        int curb = -1; f32x4 PA[4], PB[4];
        for (int m0 = r0; m0 < r1; m0 += 4) {
            f32x4 v[4][4];
#pragma unroll
            for (int u = 0; u < 4; ++u) { const int m = m0 + u; if (m < r1) {
                const float* xrow = (m < MROWS) ? F.in[0] + (size_t)m * DM : F.in[2] + (size_t)(m - MROWS) * DM; const GAS f32x4* xr = (const GAS f32x4*)xrow + f_lane;
#pragma unroll
                for (int j = 0; j < 4; ++j) v[u][j] = __builtin_nontemporal_load(xr + 64 * j); } }
#pragma unroll
            for (int u = 0; u < 4; ++u) { const int m = m0 + u; if (m < r1) {
                const int mb = (m < MROWS) ? (m >> 12) : 8;
                if (mb != curb) { curb = mb; const float* sh = mod + (size_t)mb * (NMOD * DM); const float* sc = sh + DM;
#pragma unroll
                    for (int j = 0; j < 4; ++j) { const int c = 4 * f_lane + 256 * j; PA[j] = *(const f32x4*)(g1 + c) * (*(const f32x4*)(sc + c) + 1.f); PB[j] = *(const f32x4*)(sh + c); } }
                float s = 0.f;
#pragma unroll
                for (int j = 0; j < 4; ++j) s += (v[u][j].x * v[u][j].x + v[u][j].y * v[u][j].y) + (v[u][j].z * v[u][j].z + v[u][j].w * v[u][j].w);
                const float rstd = rsqrtf(wave_sum(s) * (1.f / DM) + EPS);
                GAS u32x2* o8 = (GAS u32x2*)(H + (size_t)m * DM) + f_lane;
#pragma unroll
                for (int j = 0; j < 4; ++j) { const f32x4 y = v[u][j] * rstd * PA[j] + PB[j];
                    u32x2 w; w.x = cvt_pk_bf16(y.x, y.y); w.y = cvt_pk_bf16(y.z, y.w); o8[64 * j] = w; } } }
        }
    }
}

struct SchedInProj {
    int G, c; const char* H; const char* W;
    static constexpr int NA = 136 * 4, NV = 2 * 136, NBU = 6 * 128;
    __device__ __forceinline__ bool next(int i, g8::Unit& u) const {
        const long L = (long)i * G + c;
        if (L < NA) { g8::tile_of((int)L, 136, 4, u.pm, u.pn); u.a = H + (size_t)u.pm * 256 * DM * 2; u.b = W + (size_t)u.pn * 256 * DM * 2; u.kind = 0; u.ex = 0; return true; }
        if (L < NA + NV) { g8::tile_of((int)L - NA, 2, 136, u.pm, u.pn); u.a = W + (size_t)(1024 + u.pm * 256) * DM * 2; u.b = H + (size_t)u.pn * 256 * DM * 2; u.kind = 2; u.ex = 0; return true; }
        if (L < NA + NV + NBU) { g8::tile_of((int)L - NA - NV, 6, 128, u.pm, u.pn); u.a = W + (size_t)(QKVC + u.pm * 256) * DM * 2; u.b = H + (size_t)u.pn * 256 * DM * 2; u.kind = 1; u.ex = 0; return true; }
        return false;
    }
};
constexpr float Q8SCALE = 16.f;
struct EpiInProj {
    unsigned char *Q8, *K8, *VT8; bf16_t* UT; const float *gq, *gk, *rope;
    __device__ __forceinline__ void operator()(f32x4 (&acc)[2][2][4][2], const g8::Unit& u, int wr, int wc, int fr, int fq) const {
        asm volatile("" : "+v"(fr), "+v"(fq));
        if (u.kind == 1) {
            const int row0 = u.pm * 256 + wr * 64 + fr, col0 = u.pn * 256 + wc * 32 + 8 * fq;
#pragma unroll
            for (int ai = 0; ai < 2; ++ai)
#pragma unroll
                for (int m = 0; m < 4; ++m) { const int ch = row0 + ai * 128 + m * 16;
#pragma unroll
                    for (int bj = 0; bj < 2; ++bj) { const int tok = col0 + bj * 128; const f32x4 v0 = acc[ai][bj][m][0], v1 = acc[ai][bj][m][1];
                        u32x4 w; w.x = cvt_pk_bf16(v0[0], v0[1]); w.y = cvt_pk_bf16(v0[2], v0[3]); w.z = cvt_pk_bf16(v1[0], v1[1]); w.w = cvt_pk_bf16(v1[2], v1[3]);
                        *(u32x4*)(UT + ((size_t)(tok >> 7) * HYC + ch) * 128 + (tok & 127)) = w; } }
            return;
        }
        if (u.kind == 2) {
#pragma unroll
            for (int bj = 0; bj < 2; ++bj) { const int t8 = u.pn * 256 + bj * 128 + wc * 32 + 8 * fq;
                int b, key; if (t8 < MROWS) { b = t8 >> 12; key = CTXL + (t8 & 4095); } else { const int j = t8 - MROWS; b = j >> 8; key = j & 255; }
                const int tile = key >> 6, k = key & 63, ipos = (k < 32) ? 4 * (k >> 3) : 16 + 4 * ((k - 32) >> 3);
#pragma unroll
                for (int ai = 0; ai < 2; ++ai)
#pragma unroll
                    for (int m = 0; m < 4; ++m) { const int ch = u.pm * 256 + ai * 128 + wr * 64 + m * 16 + fr;
                        unsigned char* dst = VT8 + ((((size_t)(b * NHEAD + (ch >> 7)) * 68 + tile) * 128 + (ch & 127)) * 64) + ipos;
                        const f32x4 v0 = acc[ai][bj][m][0], v1 = acc[ai][bj][m][1];
                        *(unsigned*)dst = pk4_fp8(v0[0], v0[1], v0[2], v0[3]); *(unsigned*)(dst + 32) = pk4_fp8(v1[0], v1[1], v1[2], v1[3]); } }
            return;
        }
        const int blk = fq >> 1, f = fq & 1;
        const int sec = u.pn >> 1;
        const bool ctx = (u.pm >= 128);
        if (sec == 0 && ctx) return;
        const int colbase = (u.pn & 1) * 256 + wc * 64 + 32 * blk + 8 * f;
        float gg[2][2][4];
        { const float* gp = (sec == 0 ? gq : gk) + 32 * blk + 8 * f;
#pragma unroll
            for (int bj = 0; bj < 2; ++bj)
#pragma unroll
                for (int n = 0; n < 2; ++n) { const f32x4 t = *(const f32x4*)(gp + 16 * bj + 4 * n); gg[bj][n][0] = t[0]; gg[bj][n][1] = t[1]; gg[bj][n][2] = t[2]; gg[bj][n][3] = t[3]; } }
#pragma unroll
        for (int ai = 0; ai < 2; ++ai)
#pragma unroll
            for (int m = 0; m < 4; ++m) {
                const int rloc = ai * 128 + wr * 64 + m * 16 + fr; const int r = u.pm * 256 + rloc;
                f32x4 v[2][2];
#pragma unroll
                for (int bj = 0; bj < 2; ++bj)
#pragma unroll
                    for (int n = 0; n < 2; ++n) v[bj][n] = acc[ai][bj][m][n];
                size_t orow;
                if (sec == 0) orow = (size_t)r;
                else if (!ctx) orow = (size_t)(r >> 12) * KVL + CTXL + (r & 4095);
                else { const int j = r - MROWS; orow = (size_t)(j >> 8) * KVL + (j & 255); }
                float ss = 0.f;
#pragma unroll
                for (int bj = 0; bj < 2; ++bj)
#pragma unroll
                    for (int n = 0; n < 2; ++n) ss += (v[bj][n][0] * v[bj][n][0] + v[bj][n][1] * v[bj][n][1]) + (v[bj][n][2] * v[bj][n][2] + v[bj][n][3] * v[bj][n][3]);
                ss += __shfl_xor(ss, 16); ss += __shfl_xor(ss, 32);
                const float rstd = rsqrtf(ss * (1.f / 64.f) + EPS) * (sec == 0 ? QSCALE * Q8SCALE : 1.f);
#pragma unroll
                for (int bj = 0; bj < 2; ++bj)
#pragma unroll
                    for (int n = 0; n < 2; ++n)
#pragma unroll
                        for (int e = 0; e < 4; ++e) v[bj][n][e] *= rstd * gg[bj][n][e];
                if (!ctx) {
                    const int t = r & 4095; const int pos = blk ? (t & 63) : (t >> 6);
                    const float* rp = rope + (size_t)(pos * 16 + 8 * f) * 2;
#pragma unroll
                    for (int n = 0; n < 2; ++n) { const f32x4 c0 = *(const f32x4*)(rp + 8 * n), c1 = *(const f32x4*)(rp + 8 * n + 4);
                        const float cs[4] = {c0[0], c0[2], c1[0], c1[2]}, sn[4] = {c0[1], c0[3], c1[1], c1[3]};
#pragma unroll
                        for (int e = 0; e < 4; ++e) { const float x1 = v[0][n][e], x2 = v[1][n][e]; v[0][n][e] = x1 * cs[e] - x2 * sn[e]; v[1][n][e] = x2 * cs[e] + x1 * sn[e]; } }
                }
                unsigned char* dst = (sec == 0 ? Q8 : K8) + orow * QKW + colbase;
#pragma unroll
                for (int bj = 0; bj < 2; ++bj) { u32x2 w; w.x = pk4_fp8(v[bj][0][0], v[bj][0][1], v[bj][0][2], v[bj][0][3]); w.y = pk4_fp8(v[bj][1][0], v[bj][1][1], v[bj][1][2], v[bj][1][3]);
                    *(u32x2*)(dst + 16 * bj) = w; }
            }
    }
};

struct SchedStatic {
    int G, c, nM, nN; const char* A; const char* B;
    __device__ __forceinline__ bool next(int i, g8::Unit& u) const {
        const long L = (long)i * G + c; if (L >= (long)nM * nN) return false;
        g8::tile_of((int)L, nM, nN, u.pm, u.pn); u.a = A + (size_t)u.pm * 256 * DM * 2; u.b = B + (size_t)u.pn * 256 * DM * 2; u.kind = 0; u.ex = 0; return true;
    }
};
struct EpiOutProj {
    const float* x; bf16_t* out; const float* mod;
    __device__ __forceinline__ void operator()(f32x4 (&acc)[2][2][4][2], const g8::Unit& u, int wr, int wc, int fr, int fq) const {
        asm volatile("" : "+v"(fr), "+v"(fq));
        const int col0 = u.pn * 256 + wc * 32 + 8 * fq;
        const float* g1 = mod + (size_t)((u.pm * 256) >> 12) * (NMOD * DM) + 2 * DM + col0;
        f32x4 gv[2][2];
#pragma unroll
        for (int bj = 0; bj < 2; ++bj)
#pragma unroll
            for (int n = 0; n < 2; ++n) gv[bj][n] = *(const f32x4*)(g1 + bj * 128 + 4 * n);
#pragma unroll
        for (int ai = 0; ai < 2; ++ai)
#pragma unroll
            for (int m = 0; m < 4; ++m) { const int r = u.pm * 256 + ai * 128 + wr * 64 + m * 16 + fr;
                const size_t off = (size_t)r * DM + col0;
#pragma unroll
                for (int bj = 0; bj < 2; ++bj) { f32x4 o[2];
#pragma unroll
                    for (int n = 0; n < 2; ++n) { const f32x4 xv = __builtin_nontemporal_load((const f32x4*)(x + off + bj * 128 + 4 * n)); o[n] = xv + gv[bj][n] * acc[ai][bj][m][n]; }
                    u32x4 w; w.x = cvt_pk_bf16(o[0][0], o[0][1]); w.y = cvt_pk_bf16(o[0][2], o[0][3]); w.z = cvt_pk_bf16(o[1][0], o[1][1]); w.w = cvt_pk_bf16(o[1][2], o[1][3]);
                    *(u32x4*)(out + off + bj * 128) = w; } }
    }
};

namespace att8 {
constexpr int NT = KVL / 64, SHMB = 8192, NBUF = 6, LDS_V0 = NBUF * SHMB;
typedef int i32x8 __attribute__((ext_vector_type(8)));
#define SBAR() __builtin_amdgcn_sched_barrier(0)
__device__ __forceinline__ int crow(int r, int hi) { return (r & 3) + 8 * (r >> 2) + 4 * hi; }
__device__ __forceinline__ i32x8 ld32(const LAS unsigned char* p0, const LAS unsigned char* p1) {
    const u32x4 a = *(const LAS u32x4*)p0, b = *(const LAS u32x4*)p1; return (i32x8){(int)a.x, (int)a.y, (int)a.z, (int)a.w, (int)b.x, (int)b.y, (int)b.z, (int)b.w}; }
__device__ __forceinline__ void mfma_qk(f32x16& p, const i32x8& kf, const i32x8& qf, const f32x16& negc) {
    const unsigned s1 = 0x7f7f7f7fu, sq = 0x7b7b7b7bu;
    asm volatile("v_mfma_scale_f32_32x32x64_f8f6f4 %0, %1, %2, %3, %4, %5 op_sel_hi:[0,0,0]" : "=&v"(p) : "v"(kf), "v"(qf), "v"(negc), "v"(s1), "v"(sq));
}
__device__ __forceinline__ void mfma_pv(f32x16& o, const i32x8& pa, const i32x8& vf) {
    const unsigned s1 = 0x7f7f7f7fu;
    asm volatile("v_mfma_scale_f32_32x32x64_f8f6f4 %0, %1, %2, %0, %3, %3 op_sel_hi:[0,0,0]" : "+v"(o) : "v"(pa), "v"(vf), "v"(s1));
}
__device__ __forceinline__ void mfma_wait(f32x16& p0, f32x16& p1) { asm volatile("s_nop 15\n\ts_nop 3" : "+v"(p0), "+v"(p1)); }
__device__ __forceinline__ int grp(const f32x16& s, const int g, int old) {
    old = __builtin_amdgcn_cvt_pk_fp8_f32(__builtin_amdgcn_exp2f(s[4 * g]), __builtin_amdgcn_exp2f(s[4 * g + 1]), old, false);
    return __builtin_amdgcn_cvt_pk_fp8_f32(__builtin_amdgcn_exp2f(s[4 * g + 2]), __builtin_amdgcn_exp2f(s[4 * g + 3]), old, true);
}
__device__ __forceinline__ void attn_unit(const unsigned char* __restrict__ Qb, const unsigned char* __restrict__ Kh, const unsigned char* __restrict__ VTh, bf16_t* MIXo,
                                          const float lam, const float* __restrict__ subg, char* lds, const int wid) {
    const int lane = lane_id(), tid = wid * 64 + lane, r32 = lane & 31, hi = lane >> 5;
    const int sub = wid >> 2, wq = wid & 3;
    const LAS unsigned char* L = (const LAS unsigned char*)(uintptr_t)(unsigned)(uintptr_t)lds;
    f32x16 o[4] = {}; f32x16 ol = {};
    i32x8 ones; { int c1 = 0x38383838; asm volatile("" : "+v"(c1)); ones = (i32x8){c1, c1, c1, c1, c1, c1, c1, c1}; }
    i32x8 qf; { const unsigned char* qp = Qb + (size_t)(wq * 32 + r32) * QKW + sub * 64 + 32 * hi; const u32x4 a = *(const u32x4*)qp, b = *(const u32x4*)(qp + 16);
        qf = (i32x8){(int)a.x, (int)a.y, (int)a.z, (int)a.w, (int)b.x, (int)b.y, (int)b.z, (int)b.w}; }
    f32x16 negc; { float m5 = -5.f; asm volatile("" : "+v"(m5));
#pragma unroll
        for (int r = 0; r < 16; ++r) negc[r] = m5; }
    long ksrc, vsrc;
    { const int r = 8 * wid + (lane >> 3), c = (lane & 7) ^ ((r >> 1) & 7); ksrc = (long)r * QKW + c * 16; }
    { const int d = 16 * wid + (lane >> 2), c = (lane & 3) ^ ((d >> 2) & 3); vsrc = (long)d * 64 + c * 16; }
    const unsigned ldsb = (unsigned)(uintptr_t)lds, kdst = ldsb + (unsigned)wid * 1024u, vdst = ldsb + LDS_V0 + (unsigned)wid * 1024u;
    const LAS unsigned char *pk0, *pk1, *pv0, *pv1;
    { const int c0 = sub * 4 + hi * 2, sk = (r32 >> 1) & 7, sv = (r32 >> 2) & 3;
      pk0 = L + r32 * 128 + ((c0 ^ sk) << 4); pk1 = L + r32 * 128 + (((c0 + 1) ^ sk) << 4);
      pv0 = L + LDS_V0 + r32 * 64 + (((2 * hi) ^ sv) << 4); pv1 = L + LDS_V0 + r32 * 64 + (((2 * hi + 1) ^ sv) << 4); }
#define KF(b, w) ld32(pk0 + (b) * SHMB + (w) * 4096, pk1 + (b) * SHMB + (w) * 4096)
#define VF(b, d0) ld32(pv0 + (b) * SHMB + (d0) * 2048, pv1 + (b) * SHMB + (d0) * 2048)
#define DMA_TILE(t, b) do { \
        __builtin_amdgcn_global_load_lds((const unsigned*)(Kh + (long)(t) * 64 * QKW + ksrc), (LAS unsigned*)(uintptr_t)__builtin_amdgcn_readfirstlane(kdst + (unsigned)((b) * SHMB)), 16, 0, 0); \
        __builtin_amdgcn_global_load_lds((const unsigned*)(VTh + (long)(t) * 8192 + vsrc), (LAS unsigned*)(uintptr_t)__builtin_amdgcn_readfirstlane(vdst + (unsigned)((b) * SHMB)), 16, 0, 0); } while (0)
#define WBAR() do { asm volatile("s_waitcnt vmcnt(0)" ::: "memory"); __builtin_amdgcn_s_barrier(); asm volatile("" ::: "memory"); } while (0)
#define ITER(J, U, SX0, SX1, SY0, SY1, PC, PN, DO_DMA, DO_QK, DO_BAR) do { \
        mfma_pv(ol, PC, ones); SBAR(); \
        if (DO_DMA) { if ((J) + 3 < NT) DMA_TILE((J) + 3, ((U) + 4) % NBUF); if ((J) + 4 < NT) DMA_TILE((J) + 4, ((U) + 5) % NBUF); } \
        PN[0] = grp(SX0, 0, PN[0]); SBAR(); \
        mfma_pv(o[0], PC, vf0); SBAR(); \
        vf3 = VF(U, 3); if (DO_QK) { kf0 = KF(((U) + 2) % NBUF, 0); kf1 = KF(((U) + 2) % NBUF, 1); } \
        PN[1] = grp(SX0, 1, PN[1]); SBAR(); \
        mfma_pv(o[1], PC, vf1); SBAR(); PN[2] = grp(SX0, 2, PN[2]); SBAR(); \
        mfma_pv(o[2], PC, vf2); SBAR(); PN[3] = grp(SX0, 3, PN[3]); SBAR(); \
        mfma_pv(o[3], PC, vf3); SBAR(); PN[4] = grp(SX1, 0, PN[4]); SBAR(); \
        if (DO_QK) mfma_qk(SY0, kf0, qf, negc); SBAR(); PN[5] = grp(SX1, 1, PN[5]); SBAR(); \
        if (DO_QK) mfma_qk(SY1, kf1, qf, negc); SBAR(); PN[6] = grp(SX1, 2, PN[6]); PN[7] = grp(SX1, 3, PN[7]); \
        vf0 = VF(((U) + 1) % NBUF, 0); vf1 = VF(((U) + 1) % NBUF, 1); vf2 = VF(((U) + 1) % NBUF, 2); SBAR(); \
        if (DO_BAR) WBAR(); } while (0)
    f32x16 A0, A1, B0, B1; i32x8 paA = {}, paB = {}, kf0, kf1, vf0, vf1, vf2, vf3;
    DMA_TILE(0, 0); DMA_TILE(1, 1); DMA_TILE(2, 2); DMA_TILE(3, 3); WBAR();
    kf0 = KF(0, 0); kf1 = KF(0, 1); mfma_qk(A0, kf0, qf, negc); mfma_qk(A1, kf1, qf, negc);
    kf0 = KF(1, 0); kf1 = KF(1, 1); SBAR(); mfma_qk(B0, kf0, qf, negc); mfma_qk(B1, kf1, qf, negc);
    mfma_wait(A0, A1);
#pragma unroll
    for (int g = 0; g < 4; ++g) { paA[g] = grp(A0, g, paA[g]); paA[4 + g] = grp(A1, g, paA[4 + g]); }
    mfma_wait(B0, B1);
    vf0 = VF(0, 0); vf1 = VF(0, 1); vf2 = VF(0, 2); SBAR();
    static_assert(NT == 68, "the loop below (11 trips of 6 iterations, then iteration 67) is written for 68 KV tiles");
#pragma unroll 1
    for (int j = 1; j < NT - 2; j += 6) {
        ITER(j, 0, B0, B1, A0, A1, paA, paB, true, true, false);
        ITER(j + 1, 1, A0, A1, B0, B1, paB, paA, false, true, true);
        ITER(j + 2, 2, B0, B1, A0, A1, paA, paB, true, true, false);
        ITER(j + 3, 3, A0, A1, B0, B1, paB, paA, false, true, true);
        ITER(j + 4, 4, B0, B1, A0, A1, paA, paB, true, true, false);
        ITER(j + 5, 5, A0, A1, B0, B1, paB, paA, false, true, true);
    }
    ITER(67, 0, B0, B1, A0, A1, paA, paB, false, false, false);
    mfma_pv(ol, paB, ones); vf3 = VF(1, 3); SBAR();
    mfma_pv(o[0], paB, vf0); mfma_pv(o[1], paB, vf1); mfma_pv(o[2], paB, vf2); mfma_pv(o[3], paB, vf3);
    asm volatile("s_nop 15\n\ts_nop 3" : "+v"(o[0]), "+v"(o[1]), "+v"(o[2]), "+v"(o[3]), "+v"(ol));
#undef ITER
#undef KF
#undef VF
#undef DMA_TILE
#undef WBAR
    __syncthreads();
    float* X = (float*)lds;
    float rli[16];
#pragma unroll
    for (int r = 0; r < 16; ++r) rli[r] = __builtin_amdgcn_rcpf(ol[r]);
    if (sub == 1) {
#pragma unroll
        for (int r = 0; r < 16; ++r) { const int row = wq * 32 + crow(r, hi); const float sc = lam * rli[r];
#pragma unroll
            for (int d0 = 0; d0 < 4; ++d0) X[row * 128 + d0 * 32 + r32] = o[d0][r] * sc; }
    }
    __syncthreads();
    bf16_t* Y = (bf16_t*)(lds + 65536);
    if (sub == 0) {
        float sg[4];
#pragma unroll
        for (int d0 = 0; d0 < 4; ++d0) sg[d0] = subg[d0 * 32 + r32] * (1.f - LAM_INIT);
#pragma unroll
        for (int r = 0; r < 16; ++r) { const int row = wq * 32 + crow(r, hi);
            float v[4]; float ss = 0.f;
#pragma unroll
            for (int d0 = 0; d0 < 4; ++d0) { v[d0] = o[d0][r] * rli[r] - X[row * 128 + d0 * 32 + r32]; ss += v[d0] * v[d0]; }
            ss += __shfl_xor(ss, 1); ss += __shfl_xor(ss, 2); ss += __shfl_xor(ss, 4); ss += __shfl_xor(ss, 8); ss += __shfl_xor(ss, 16);
            const float rstd = rsqrtf(ss * (1.f / 128.f) + EPS);
#pragma unroll
            for (int d0 = 0; d0 < 4; ++d0) Y[row * 128 + d0 * 32 + r32] = (bf16_t)(cvt_pk_bf16(v[d0] * rstd * sg[d0], 0.f) & 0xffffu); }
    }
    __syncthreads();
    { const int row = tid >> 2, seg = (tid & 3) * 32;
#pragma unroll
        for (int i = 0; i < 4; ++i) { const u32x4 v = *(const u32x4*)(Y + row * 128 + seg + i * 8); *(u32x4*)(MIXo + (size_t)row * DM + seg + i * 8) = v; } }
    __syncthreads();
}
#undef SBAR
}

__device__ __forceinline__ void p3_attention8(Frame& F) {
    FT_DECL;
    const float* sc = WSP(float, WS_SMALL + SM_SCAL);
    const float lam = sc[0];
    const unsigned char* Q8 = WSP(unsigned char, WS_Q); const unsigned char* K8 = WSP(unsigned char, WS_K); const unsigned char* VT8 = WSP(unsigned char, WS_V); bf16_t* MIX = WSP(bf16_t, WS_MIX);
    const int c = blockIdx.x, xcd = c & 7, ci = c >> 3, per = F.G >> 3;
    for (int j = ci; j < 128; j += per) {
        const int pair = xcd * 4 + (j >> 5), qb = j & 31, b = pair >> 2, h = pair & 3;
        att8::attn_unit(Q8 + ((size_t)b * SEQ + qb * 128) * QKW + h * 128, K8 + (size_t)b * KVL * QKW + h * 128, VT8 + (size_t)(b * NHEAD + h) * 68 * 8192,
                        MIX + ((size_t)b * SEQ + qb * 128) * DM + h * 128, lam, F.in[15], (char*)F.lds, F.wave);
    }
}

namespace hy {
constexpr int RB_BYTES = 4352 * 8, IN_OFF = 2 * RB_BYTES, TW1_OFF = IN_OFF + 32768, TW2_OFF = TW1_OFF + 15 * 256 * 8, LDS_END = TW2_OFF + 15 * 16 * 8;
__device__ __forceinline__ f32x2 cmul(f32x2 a, f32x2 b) { return (f32x2){a.x * b.x - a.y * b.y, a.x * b.y + a.y * b.x}; }
__device__ __forceinline__ f32x2 cmulc(f32x2 a, f32x2 b) { return (f32x2){a.x * b.x + a.y * b.y, a.y * b.x - a.x * b.y}; }
__device__ __forceinline__ int P(int i) { return i + (i >> 4); }
template <bool INV> __device__ __forceinline__ void r4(f32x2& a, f32x2& b, f32x2& c, f32x2& d) {
    const f32x2 t0 = a + c, t1 = a - c, t2 = b + d, t3 = b - d;
    const f32x2 st3 = INV ? (f32x2){-t3.y, t3.x} : (f32x2){t3.y, -t3.x};
    a = t0 + t2; c = t0 - t2; b = t1 + st3; d = t1 - st3;
}
template <bool INV> __device__ __forceinline__ f32x2 tw(f32x2 v, float c, float s) {
    return INV ? (f32x2){v.x * c - v.y * s, v.y * c + v.x * s} : (f32x2){v.x * c + v.y * s, v.y * c - v.x * s};
}
template <bool INV> __device__ __forceinline__ void dft16(f32x2 (&v)[16]) {
    constexpr float C1 = 0.9238795325112867f, S1 = 0.3826834323650898f, R2 = 0.7071067811865476f;
    r4<INV>(v[0], v[4], v[8], v[12]); r4<INV>(v[1], v[5], v[9], v[13]); r4<INV>(v[2], v[6], v[10], v[14]); r4<INV>(v[3], v[7], v[11], v[15]);
    v[5] = tw<INV>(v[5], C1, S1);  v[9] = tw<INV>(v[9], R2, R2);    v[13] = tw<INV>(v[13], S1, C1);
    v[6] = tw<INV>(v[6], R2, R2);  v[10] = tw<INV>(v[10], 0.f, 1.f); v[14] = tw<INV>(v[14], -R2, R2);
    v[7] = tw<INV>(v[7], S1, C1);  v[11] = tw<INV>(v[11], -R2, R2);  v[15] = tw<INV>(v[15], -C1, -S1);
    r4<INV>(v[0], v[1], v[2], v[3]); r4<INV>(v[4], v[5], v[6], v[7]); r4<INV>(v[8], v[9], v[10], v[11]); r4<INV>(v[12], v[13], v[14], v[15]);
    f32x2 t;
    t = v[1]; v[1] = v[4]; v[4] = t;   t = v[2]; v[2] = v[8]; v[8] = t;    t = v[3]; v[3] = v[12]; v[12] = t;
    t = v[6]; v[6] = v[9]; v[9] = t;   t = v[7]; v[7] = v[13]; v[13] = t;  t = v[11]; v[11] = v[14]; v[14] = t;
}
struct Ctx { LAS f32x2* R; LAS f32x2* IN; LAS f32x2* TW1; LAS f32x2* TW2; int t, half; f32x2 wt; };
#define HY_OPAQUE(x) asm volatile("" : "+v"(x))
#define HY_W32(m) (f32x2){__builtin_cosf(-0.19634954084936207f * (m)), __builtin_sinf(-0.19634954084936207f * (m))}
template <int MODE> __device__ __forceinline__ void pass1_fwd(const Ctx& X) {
    f32x2 v[16]; int t = X.t; HY_OPAQUE(t);
#pragma unroll
    for (int m = 0; m < 16; ++m) { f32x2 a = X.IN[t + 256 * m]; if (MODE == 1) a = (f32x2){X.half ? a.y : a.x, 0.f}; v[m] = a; }
    if (X.half) {
#pragma unroll
        for (int m = 0; m < 16; ++m) v[m] = cmul(cmul(v[m], HY_W32(m)), X.wt);
    }
    dft16<false>(v);
#pragma unroll
    for (int q = 1; q < 16; ++q) v[q] = cmul(v[q], X.TW1[(q - 1) * 256 + t]);
    const int pb = t + (t >> 4);
#pragma unroll
    for (int q = 0; q < 16; ++q) X.R[pb + 272 * q] = v[q];
}
__device__ __forceinline__ void pass2_fwd(const Ctx& X) {
    int t = X.t; HY_OPAQUE(t);
    const int n2 = t & 15, pb = (t >> 4) * 272 + n2; f32x2 v[16];
#pragma unroll
    for (int m = 0; m < 16; ++m) v[m] = X.R[pb + 17 * m];
    dft16<false>(v);
#pragma unroll
    for (int q = 1; q < 16; ++q) v[q] = cmul(v[q], X.TW2[(q - 1) * 16 + n2]);
#pragma unroll
    for (int q = 0; q < 16; ++q) X.R[pb + 17 * q] = v[q];
}
template <bool FILTER> __device__ __forceinline__ void pass3(const Ctx& X, f32x2 (&H)[16]) {
    f32x2 v[16]; int t = X.t; HY_OPAQUE(t); const int pb = 17 * t;
#pragma unroll
    for (int m = 0; m < 16; ++m) v[m] = X.R[pb + m];
    dft16<false>(v);
    if (FILTER) {
#pragma unroll
        for (int q = 0; q < 16; ++q) H[q] = v[q] * (1.f / 8192.f);
    } else {
#pragma unroll
        for (int q = 0; q < 16; ++q) v[q] = cmul(v[q], H[q]);
        dft16<true>(v);
#pragma unroll
        for (int m = 0; m < 16; ++m) X.R[pb + m] = v[m];
    }
}
__device__ __forceinline__ void pass2_inv(const Ctx& X) {
    int t = X.t; HY_OPAQUE(t);
    const int n2 = t & 15, pb = (t >> 4) * 272 + n2; f32x2 v[16];
    v[0] = X.R[pb];
#pragma unroll
    for (int q = 1; q < 16; ++q) v[q] = cmulc(X.R[pb + 17 * q], X.TW2[(q - 1) * 16 + n2]);
    dft16<true>(v);
#pragma unroll
    for (int m = 0; m < 16; ++m) X.R[pb + 17 * m] = v[m];
}
__device__ __forceinline__ void pass1_inv(const Ctx& X) {
    f32x2 v[16]; int t = X.t; HY_OPAQUE(t); const int pb = t + (t >> 4);
    v[0] = X.R[pb];
#pragma unroll
    for (int q = 1; q < 16; ++q) v[q] = cmulc(X.R[pb + 272 * q], X.TW1[(q - 1) * 256 + t]);
    dft16<true>(v);
    if (X.half) {
#pragma unroll
        for (int m = 0; m < 16; ++m) v[m] = cmulc(cmulc(v[m], HY_W32(m)), X.wt);
    }
#pragma unroll
    for (int m = 0; m < 16; ++m) X.R[pb + 272 * m] = v[m];
}
#define HY_WSYNC() asm volatile("s_waitcnt lgkmcnt(0)" ::: "memory")
__device__ __forceinline__ void conv_fft(const Ctx& X, f32x2 (&H)[16]) {
    __syncthreads(); pass1_fwd<0>(X); __syncthreads(); pass2_fwd(X); HY_WSYNC(); pass3<false>(X, H); HY_WSYNC(); pass2_inv(X); __syncthreads(); pass1_inv(X); __syncthreads();
}
constexpr int STG_OFF = LDS_END;
constexpr int LDS_END2 = STG_OFF + 2 * SEQ * 2;
static_assert(LDS_END2 <= LDSCTL_OFF, "hyena LDS map");
__device__ __forceinline__ float sconv_lds(const LAS bf16_t* stg, int bs, int n, float w0, float w1, float w2, float bias) {
    const LAS bf16_t* p = stg + bs * SEQ;
    const float c = bf2f(p[n]), lv = bf2f(p[n - ((n > 0) ? 1 : 0)]), rv = bf2f(p[n + ((n < SEQ - 1) ? 1 : 0)]);
    const float l = (n > 0) ? lv : 0.f, r = (n < SEQ - 1) ? rv : 0.f;
    return bias + w0 * l + w1 * c + w2 * r;
}
__device__ __forceinline__ void setup_tables(LAS unsigned char* lds, int tid) {
    LAS f32x2* TW1 = (LAS f32x2*)(lds + TW1_OFF); LAS f32x2* TW2 = (LAS f32x2*)(lds + TW2_OFF);
    for (int i = tid; i < 15 * 256; i += 512) { const int q = i / 256 + 1, t = i & 255; float s, c; sincosf(-6.283185307179586f * (float)((t * q) & 4095) * (1.f / 4096.f), &s, &c); TW1[i] = (f32x2){c, s}; }
    for (int i = tid; i < 15 * 16; i += 512) { const int q = i / 16 + 1, n2 = i & 15; float s, c; sincosf(-6.283185307179586f * (float)((n2 * q) & 255) * (1.f / 256.f), &s, &c); TW2[i] = (f32x2){c, s}; }
}
__device__ __forceinline__ void unit(Frame& F, int c) {
    FT_DECL;
    const int tid = f_tid; Ctx X; X.half = F.wave >> 2; X.t = tid & 255;
    X.R = (LAS f32x2*)(F.lds + X.half * RB_BYTES); X.IN = (LAS f32x2*)(F.lds + IN_OFF); X.TW1 = (LAS f32x2*)(F.lds + TW1_OFF); X.TW2 = (LAS f32x2*)(F.lds + TW2_OFF);
    { float s, cc; sincosf(-6.283185307179586f * (float)X.t * (1.f / 8192.f), &s, &cc); X.wt = (f32x2){cc, s}; }
    LAS f32x2* RB0 = (LAS f32x2*)(F.lds); LAS f32x2* RB1 = (LAS f32x2*)(F.lds + RB_BYTES);
    const float* FILT = WSP(float, WS_FILT);
    f32x2 H0[16], H1[16];
#pragma unroll
    for (int ord = 0; ord < 2; ++ord) {
        const float* hf = FILT + ((size_t)(ord * 2 + 0) * 512 + c) * SEQ; const float* hb = FILT + ((size_t)(ord * 2 + 1) * 512 + c) * SEQ;
        __syncthreads();
        int nb = tid; HY_OPAQUE(nb);
#pragma unroll
        for (int j = 0; j < 8; ++j) { const int n = nb + 512 * j; const float a = hf[n], b = hb[(SEQ - n) & (SEQ - 1)]; const float lo = (n == 0) ? a + b : a, hi = (n == 0) ? 0.f : b; X.IN[n] = (f32x2){lo + hi, lo - hi}; }
        __syncthreads(); pass1_fwd<1>(X); __syncthreads(); pass2_fwd(X); HY_WSYNC();
        if (ord == 0) pass3<true>(X, H0); else pass3<true>(X, H1);
    }
    const bf16_t* UT = WSP(bf16_t, WS_UT);
    const bf16_t* rv = UT + (size_t)c * 128; const bf16_t* r1 = UT + (size_t)(512 + c) * 128; const bf16_t* r2 = UT + (size_t)(1024 + c) * 128;
#define HY_LD(rowp, t) (*(const u32x4*)((rowp) + (size_t)((t) >> 7) * (HYC * 128) + ((t) & 127)))
    const float* cw = F.in[16]; const float* cb = F.in[17];
    const float wv0 = cw[c], wv1 = cw[HYC + c], wv2 = cw[2 * HYC + c], bv = cb[c];
    const float wa0 = cw[512 + c], wa1 = cw[HYC + 512 + c], wa2 = cw[2 * HYC + 512 + c], ba = cb[512 + c];
    const float wb0 = cw[1024 + c], wb1 = cw[HYC + 1024 + c], wb2 = cw[2 * HYC + 1024 + c], bb = cb[1024 + c];
    const float sk0 = F.in[25][c], sk1 = F.in[25][512 + c];
    bf16_t* Z = WSP(bf16_t, WS_Z2T) + (size_t)c * 128;
    LAS bf16_t* STG = (LAS bf16_t*)(F.lds + STG_OFF);
    u32x4 g0 = HY_LD(rv, tid * 8), g1 = HY_LD(rv, SEQ + tid * 8);
    for (int pr = 0; pr < 4; ++pr) {
        const int b0 = 2 * pr, b1 = b0 + 1;
        f32x2 z[8]; int pc = tid + (tid >> 4); HY_OPAQUE(pc); int nb = tid; HY_OPAQUE(nb);
        __syncthreads();
        *(LAS u32x4*)(STG + tid * 8) = g0; *(LAS u32x4*)(STG + SEQ + tid * 8) = g1;
        __syncthreads();
#pragma unroll
        for (int j = 0; j < 8; ++j) { const int n = nb + 512 * j; z[j] = (f32x2){sconv_lds(STG, 0, n, wv0, wv1, wv2, bv), sconv_lds(STG, 1, n, wv0, wv1, wv2, bv)}; X.IN[n] = z[j]; }
        g0 = HY_LD(r1, b0 * SEQ + tid * 8); g1 = HY_LD(r1, b1 * SEQ + tid * 8);
        conv_fft(X, H0);
        *(LAS u32x4*)(STG + tid * 8) = g0; *(LAS u32x4*)(STG + SEQ + tid * 8) = g1;
        __syncthreads();
        HY_OPAQUE(nb); HY_OPAQUE(pc);
#pragma unroll
        for (int j = 0; j < 8; ++j) { const int n = nb + 512 * j; const f32x2 y = RB0[pc + 544 * j] + RB1[pc + 544 * j];
            const f32x2 g = (f32x2){sconv_lds(STG, 0, n, wa0, wa1, wa2, ba), sconv_lds(STG, 1, n, wa0, wa1, wa2, ba)};
            z[j] = g * (y + sk0 * z[j]); X.IN[n] = z[j]; }
        g0 = HY_LD(r2, b0 * SEQ + tid * 8); g1 = HY_LD(r2, b1 * SEQ + tid * 8);
        conv_fft(X, H1);
        *(LAS u32x4*)(STG + tid * 8) = g0; *(LAS u32x4*)(STG + SEQ + tid * 8) = g1;
        __syncthreads();
        if (pr < 3) { g0 = HY_LD(rv, (b0 + 2) * SEQ + tid * 8); g1 = HY_LD(rv, (b1 + 2) * SEQ + tid * 8); }
        HY_OPAQUE(nb); HY_OPAQUE(pc);
        f32x2 o[8];
#pragma unroll
        for (int j = 0; j < 8; ++j) { const int n = nb + 512 * j; const f32x2 y = RB0[pc + 544 * j] + RB1[pc + 544 * j];
            const f32x2 g = (f32x2){sconv_lds(STG, 0, n, wb0, wb1, wb2, bb), sconv_lds(STG, 1, n, wb0, wb1, wb2, bb)};
            o[j] = g * (y + sk1 * z[j]); }
        __syncthreads();
#pragma unroll
        for (int j = 0; j < 8; ++j) { const int n = nb + 512 * j; STG[n] = (bf16_t)(cvt_pk_bf16(o[j].x, 0.f) & 0xffffu); STG[SEQ + n] = (bf16_t)(cvt_pk_bf16(o[j].y, 0.f) & 0xffffu); }
        __syncthreads();
        { const int t0 = b0 * SEQ + tid * 8, t1 = b1 * SEQ + tid * 8;
          *(u32x4*)(Z + (size_t)(t0 >> 7) * (HYW * 128) + (t0 & 127)) = *(const LAS u32x4*)(STG + tid * 8); *(u32x4*)(Z + (size_t)(t1 >> 7) * (HYW * 128) + (t1 & 127)) = *(const LAS u32x4*)(STG + SEQ + tid * 8); }
    }
    __syncthreads();
}
}

__device__ __forceinline__ void p3_hyena(Frame& F) {
    FT_DECL;
    __syncthreads();
    hy::setup_tables(F.lds, f_tid);
    __syncthreads();
    for (int c = F.vcu; c < HYW; c += F.G) hy::unit(F, c);
}

__device__ __forceinline__ void p4_hynorm(Frame& F) {
    FT_DECL;
    const bf16_t* Z = WSP(bf16_t, WS_Z2T); bf16_t* MIX = WSP(bf16_t, WS_MIX); const float* g = F.in[26];
    constexpr int TP = 132;
    LAS bf16_t* T = (LAS bf16_t*)F.lds;
    LAS float* red = (LAS float*)(F.lds + 512 * TP * 2);
    LAS float* rs = red + 512;
    float gl[8];
#pragma unroll
    for (int e = 0; e < 8; ++e) gl[e] = g[(f_tid & 63) + 64 * e];
    for (int it = F.vcu; it < MROWS / 128; it += F.G) {
        const int tok0 = it * 128; const bf16_t* zt = Z + (size_t)it * (HYW * 128);
        __syncthreads();
        u32x4 v[16];
#pragma unroll
        for (int j = 0; j < 16; ++j) v[j] = __builtin_nontemporal_load((const u32x4*)(zt + (size_t)(f_tid + 512 * j) * 8));
#pragma unroll
        for (int j = 0; j < 16; ++j) { const int i = f_tid + 512 * j; LAS u32x2* d = (LAS u32x2*)(T + (i >> 4) * TP + (i & 15) * 8); d[0] = (u32x2){v[j].x, v[j].y}; d[1] = (u32x2){v[j].z, v[j].w}; }
        __syncthreads();
        { const int tok = f_tid & 127, grp = f_tid >> 7; float ss = 0.f;
#pragma unroll 8
            for (int k = 0; k < 128; ++k) { const float x = bf2f(T[(grp * 128 + k) * TP + tok]); ss += x * x; }
            red[grp * 128 + tok] = ss; }
        __syncthreads();
        if (f_tid < 128) rs[f_tid] = rsqrtf(((red[f_tid] + red[128 + f_tid]) + (red[256 + f_tid] + red[384 + f_tid])) * (1.f / HYW) + EPS);
        __syncthreads();
#pragma unroll
        for (int j = 0; j < 16; ++j) { const int i = f_tid + 512 * j, tok = i >> 6, l = i & 63; const float r = rs[tok];
            float x[8];
#pragma unroll
            for (int e = 0; e < 8; ++e) x[e] = bf2f(T[(l + 64 * e) * TP + tok]) * r * gl[e];
            u32x4 w; w.x = cvt_pk_bf16(x[0], x[1]); w.y = cvt_pk_bf16(x[2], x[3]); w.z = cvt_pk_bf16(x[4], x[5]); w.w = cvt_pk_bf16(x[6], x[7]);
            *(u32x4*)(MIX + (size_t)(tok0 + tok) * DM + 512 + 8 * l) = w; }
    }
}

constexpr size_t WS_LIST2 = WS_FILT;
constexpr size_t WS_GSLOT2 = WS_FILT + 4 * MiB;
constexpr int CW_ECNT = 256;
constexpr int MAXSLOT = MROWS * TOPK + NEXP * 256;
constexpr int MAXTILE = MAXSLOT / 256;
constexpr size_t WS_XS = WS_EO;
constexpr int P6_WT_PITCH = 2 * DM + 16;
constexpr int P6_LDS_TOPI = 2 * NEXP * P6_WT_PITCH;

__device__ __forceinline__ void p6_router_mfma(Frame& F) {
    FT_DECL;
#define in F.in
    LAS float* WP = (LAS float*)F.lds;
    LAS int* TI = (LAS int*)(F.lds + P6_LDS_TOPI);
    LAS int* PS = TI + 512;
    LAS int* SC = PS + 512;
    LAS float* RSTD = (LAS float*)(SC + 512);
    LAS float* BIAS = RSTD + 128;
    LAS float* SSX = BIAS + 32;
    const float* rw = in[28]; const float* mod = WSP(float, WS_SMALL + SM_MOD); const float* g2n = in[7]; const float* rb = in[29];
    const bf16_t* XN = WSP(bf16_t, WS_XN); unsigned char* H2 = WSP(unsigned char, WS_H);
    int* list2 = WSP(int, WS_LIST2); float* gslot2 = WSP(float, WS_GSLOT2); int* ecnt = (int*)(F.ctl + CW_ECNT);
    LAS float* GT = SSX + 256;
    LAS int* EB = (LAS int*)(GT + 512);
    LAS float* GM = (LAS float*)(EB + 32);
    static_assert(P6_LDS_TOPI + (512 * 3 + 128 + 32 + 256 + 512 + 32 + 1024) * 4 <= LDSCTL_OFF, "router LDS map");
    for (int blk = blockIdx.x; blk < MROWS / 128; blk += F.G) {
        const float* sh2 = mod + (size_t)(blk >> 5) * (NMOD * DM) + 3 * DM; const float* sc2 = sh2 + DM;
        __syncthreads();
        for (int i = f_tid; i < DM; i += 512) GM[i] = g2n[i] * (1.f + sc2[i]);
        if (f_tid < 32) BIAS[f_tid] = WSP(float, WS_SMALL + SM_RBIAS)[(blk >> 5) * 32 + f_tid];
        __syncthreads();
        { const int e = f_lane & 31, h8 = (f_lane >> 5) * 8; LAS unsigned char* WT = (LAS unsigned char*)F.lds;
#pragma unroll 2
            for (int it = 0; it < 8; ++it) { const int k0 = (it * NWAVES + F.wave) * 16 + h8; float w[8];
#pragma unroll
                for (int q = 0; q < 8; ++q) w[q] = rw[(size_t)(k0 + q) * 32 + e];
                const f32x4 ga = *(const LAS f32x4*)(GM + k0), gb = *(const LAS f32x4*)(GM + k0 + 4); const float g[8] = {ga.x, ga.y, ga.z, ga.w, gb.x, gb.y, gb.z, gb.w};
                unsigned ph[4], pl[4];
#pragma unroll
                for (int q = 0; q < 4; ++q) { const float v0 = w[2 * q] * g[2 * q], v1 = w[2 * q + 1] * g[2 * q + 1]; ph[q] = cvt_pk_bf16(v0, v1);
                    pl[q] = cvt_pk_bf16(v0 - __uint_as_float(ph[q] << 16), v1 - __uint_as_float(ph[q] & 0xffff0000u)); }
                *(LAS u32x4*)(WT + e * P6_WT_PITCH + k0 * 2) = (u32x4){ph[0], ph[1], ph[2], ph[3]};
                *(LAS u32x4*)(WT + NEXP * P6_WT_PITCH + e * P6_WT_PITCH + k0 * 2) = (u32x4){pl[0], pl[1], pl[2], pl[3]}; } }
        __syncthreads();
        const int rg = F.wave & 3, kh = F.wave >> 2, j = f_lane & 31, hi = f_lane >> 5;
        f32x16 acc = {};
        float ss = 0.f;
        { const bf16_t* xrow = XN + (size_t)(blk * 128 + rg * 32 + j) * DM + 512 * kh + 8 * hi;
            const LAS unsigned char* wth = (const LAS unsigned char*)F.lds + j * P6_WT_PITCH + (512 * kh + 8 * hi) * 2;
#pragma unroll 8
            for (int c = 0; c < 32; ++c) { const u32x4 xb = *(const u32x4*)(xrow + 16 * c);
                const float xf[8] = {__uint_as_float(xb.x << 16), __uint_as_float(xb.x & 0xffff0000u), __uint_as_float(xb.y << 16), __uint_as_float(xb.y & 0xffff0000u),
                                     __uint_as_float(xb.z << 16), __uint_as_float(xb.z & 0xffff0000u), __uint_as_float(xb.w << 16), __uint_as_float(xb.w & 0xffff0000u)};
#pragma unroll
                for (int q = 0; q < 8; ++q) ss += xf[q] * xf[q];
                const bf16x8 xv = __builtin_bit_cast(bf16x8, xb);
                const bf16x8 ah = *(const LAS bf16x8*)(wth + 32 * c), al = *(const LAS bf16x8*)(wth + NEXP * P6_WT_PITCH + 32 * c);
                acc = __builtin_amdgcn_mfma_f32_32x32x16_bf16(ah, xv, acc, 0, 0, 0);
                acc = __builtin_amdgcn_mfma_f32_32x32x16_bf16(al, xv, acc, 0, 0, 0); } }
        { auto rr = __builtin_amdgcn_permlane32_swap(__float_as_uint(ss), __float_as_uint(ss), false, false); ss = __uint_as_float(rr[0]) + __uint_as_float(rr[1]); }
        if (hi == 0) SSX[kh * 128 + rg * 32 + j] = ss;
        __syncthreads();
        if (kh == 1) {
#pragma unroll
            for (int r = 0; r < 16; ++r) WP[(rg * 16 + r) * 64 + f_lane] = acc[r]; }
        if (f_tid < 128) RSTD[f_tid] = rsqrtf((SSX[f_tid] + SSX[128 + f_tid]) * (1.f / DM) + EPS);
        __syncthreads();
        if (kh == 0) {
            const float rstd = RSTD[rg * 32 + j];
            float tv[4] = {-INFINITY, -INFINITY, -INFINITY, -INFINITY}; int ti[4] = {1 << 20, 1 << 20, 1 << 20, 1 << 20};
#define P6_INS(V, E) do { float cv = (V); int ce = (E); _Pragma("unroll") for (int q = 0; q < 4; ++q) { const bool b = cv > tv[q] || (cv == tv[q] && ce < ti[q]); \
                const float nv = b ? tv[q] : cv; const int ne = b ? ti[q] : ce; tv[q] = b ? cv : tv[q]; ti[q] = b ? ce : ti[q]; cv = nv; ce = ne; } } while (0)
#pragma unroll
            for (int r = 0; r < 16; ++r) { const int e = (r & 3) + 8 * (r >> 2) + 4 * hi; const float v = (acc[r] + WP[(rg * 16 + r) * 64 + f_lane]) * rstd + BIAS[e]; P6_INS(v, e); }
            float ov[4]; int oe[4];
#pragma unroll
            for (int q = 0; q < 4; ++q) { ov[q] = __shfl_xor(tv[q], 32); oe[q] = __shfl_xor(ti[q], 32); }
#pragma unroll
            for (int q = 0; q < 4; ++q) P6_INS(ov[q], oe[q]);
#undef P6_INS
            if (hi == 0) { const int rl = rg * 32 + j;
                const float e1 = __expf(tv[1] - tv[0]), e2 = __expf(tv[2] - tv[0]), e3 = __expf(tv[3] - tv[0]); const float inv = 1.f / (1.f + e1 + e2 + e3);
                typedef int i32x4_t __attribute__((ext_vector_type(4))); const i32x4_t t4 = {ti[0], ti[1], ti[2], ti[3]};
                *(LAS f32x4*)(GT + rl * 4) = (f32x4){inv, e1 * inv, e2 * inv, e3 * inv};
                *(LAS i32x4_t*)(TI + rl * 4) = t4; }
        }
        __syncthreads();
        { const int t2 = F.wave * 64 + lane_id(); const int e = t2 & 31, seg = t2 >> 5; int cnt = 0;
#pragma unroll 4
            for (int i = 0; i < 32; ++i) cnt += (TI[seg * 32 + i] == e) ? 1 : 0;
            SC[seg * 32 + e] = cnt;
            __syncthreads();
            int pre = 0;
            for (int s2 = 0; s2 < seg; ++s2) pre += SC[s2 * 32 + e];
            if (seg == 15) EB[e] = __hip_atomic_fetch_add(ecnt + e, pre + cnt, __ATOMIC_RELAXED, __HIP_MEMORY_SCOPE_AGENT);
            for (int i = 0; i < 32; ++i) if (TI[seg * 32 + i] == e) { PS[seg * 32 + i] = pre; ++pre; }
        }
        __syncthreads();
        { const int t3 = F.wave * 64 + lane_id(); const int e = TI[t3]; const size_t sl = (size_t)e * MROWS + EB[e] + PS[t3];
            list2[sl] = (blk * 128 + (t3 >> 2)) * 4 + (t3 & 3); gslot2[sl] = GT[t3]; }
        { const int lane = lane_id();
            f32x4 PA[4], PB[4];
#pragma unroll
            for (int jj = 0; jj < 4; ++jj) { const int c = 4 * lane + 256 * jj; PA[jj] = *(const f32x4*)(g2n + c) * (*(const f32x4*)(sc2 + c) + 1.f); PB[jj] = *(const f32x4*)(sh2 + c); }
            for (int it = 0; it < 4; ++it) { u32x2 xb[4][4];
#pragma unroll
                for (int u = 0; u < 4; ++u) { const GAS u32x2* xr = (const GAS u32x2*)(XN + (size_t)(blk * 128 + F.wave * 16 + 4 * it + u) * DM) + lane;
#pragma unroll
                    for (int jj = 0; jj < 4; ++jj) xb[u][jj] = xr[64 * jj]; }
#pragma unroll
                for (int u = 0; u < 4; ++u) { const int rl = F.wave * 16 + 4 * it + u; const float rstd = RSTD[rl];
                    GAS unsigned* o4 = (GAS unsigned*)(H2 + (size_t)(blk * 128 + rl) * DM) + lane;
#pragma unroll
                    for (int jj = 0; jj < 4; ++jj) {
                        const f32x4 x = (f32x4){__uint_as_float(xb[u][jj].x << 16), __uint_as_float(xb[u][jj].x & 0xffff0000u), __uint_as_float(xb[u][jj].y << 16), __uint_as_float(xb[u][jj].y & 0xffff0000u)};
                        const f32x4 h = x * rstd * PA[jj] + PB[jj];
                        o4[64 * jj] = pk4_fp8(h.x, h.y, h.z, h.w); } } }
        }
    }
#undef in
}

template <int NPN> struct SchedMoE {
    int G, c, nT; const char* A; const char* W; size_t wstride; const LAS unsigned char* tileE; const LAS int* RW; bool gath;
    __device__ __forceinline__ long lidx(int T, int e, int i) const { const LAS int* TB = (const LAS int*)(tileE + 544); const int r = (T - TB[e]) * 256 + i; return (r < TB[32 + e]) ? (long)e * MROWS + r : -1L; }
    __device__ __forceinline__ const LAS int* rows(int i) const { return RW + i * 256; }
    __device__ __forceinline__ bool next(int i, g8::Unit& u) const {
        const int L = i * G + c, xcd = L & 7, j = L >> 3, nTx = (nT + 7) >> 3, tl = j / NPN, T = xcd * nTx + tl, pn = j % NPN;
        if (tl >= nTx || T >= nT) return false;
        const int e = tileE[T];
        u.pm = T; u.pn = pn; u.kind = i; u.ex = e; u.a = gath ? A : A + (size_t)T * 256 * DM; u.b = W + (size_t)e * wstride + (size_t)pn * 256 * DM; return true;
    }
};
struct EpiSwiGLU {
    unsigned char* ACT; const float* b1;
    __device__ __forceinline__ void operator()(f32x4 (&acc)[2][2][4][2], const g8::Unit& u, int wr, int wc, int fr, int fq) const {
        asm volatile("" : "+v"(fr), "+v"(fq));
        const int j0 = u.pn * 128 + wc * 32 + 8 * fq; const float* bp = b1 + (size_t)u.ex * 2 * DM + j0;
        f32x4 bg[2], bl[2];
#pragma unroll
        for (int n = 0; n < 2; ++n) { bg[n] = *(const f32x4*)(bp + 4 * n); bl[n] = *(const f32x4*)(bp + DM + 4 * n); }
#pragma unroll
        for (int ai = 0; ai < 2; ++ai)
#pragma unroll
            for (int m = 0; m < 4; ++m) { const size_t slot = (size_t)u.pm * 256 + ai * 128 + wr * 64 + m * 16 + fr; float o[8];
#pragma unroll
                for (int n = 0; n < 2; ++n) { const f32x4 g4 = acc[ai][0][m][n] * (1.f / WSCALE) + bg[n], l4 = acc[ai][1][m][n] * (1.f / WSCALE) + bl[n];
#pragma unroll
                    for (int e = 0; e < 4; ++e) { const float g = fminf(g4[e], 7.f), l = __builtin_amdgcn_fmed3f(l4[e], -7.f, 7.f);
                        const float ex = __builtin_amdgcn_exp2f(g * (-1.702f * 1.4426950408889634f)); const float glu = g * __builtin_amdgcn_rcpf(1.f + ex);
                        o[4 * n + e] = fmaf(l, glu, glu); } }
                u32x2 w; w.x = pk4_fp8(o[0], o[1], o[2], o[3]); w.y = pk4_fp8(o[4], o[5], o[6], o[7]);
                *(u32x2*)(ACT + slot * DM + j0) = w; }
    }
};
struct EpiDown {
    unsigned char* EO; const float* b2; const LAS int* LL; int G, c;
    __device__ __forceinline__ void operator()(f32x4 (&acc)[2][2][4][2], const g8::Unit& u, int wr, int wc, int fr, int fq) const {
        asm volatile("" : "+v"(fr), "+v"(fq));
        const int c0 = u.pn * 256 + wc * 64 + 16 * fq; const float* bp = b2 + (size_t)u.ex * DM + c0;
        f32x4 bb[2][2];
#pragma unroll
        for (int bj = 0; bj < 2; ++bj)
#pragma unroll
            for (int n = 0; n < 2; ++n) bb[bj][n] = *(const f32x4*)(bp + bj * 8 + 4 * n);
        const LAS int* L = LL + u.kind * 512;
        int li[8]; float gt[8];
#pragma unroll
        for (int q = 0; q < 8; ++q) { const int rl = (q >> 2) * 128 + wr * 64 + (q & 3) * 16 + fr; li[q] = L[rl]; gt[q] = __int_as_float(L[256 + rl]) * (1.f / WSCALE); }
#pragma unroll
        for (int ai = 0; ai < 2; ++ai)
#pragma unroll
            for (int m = 0; m < 4; ++m) { const int l = li[ai * 4 + m]; const float g = gt[ai * 4 + m];
                unsigned char* dst = EO + ((size_t)(l & 3) * MROWS + (l >> 2)) * DM + c0;
                u32x4 w;
                { const f32x4 v0 = acc[ai][0][m][0] * g + bb[0][0] * (g * WSCALE), v1 = acc[ai][0][m][1] * g + bb[0][1] * (g * WSCALE);
                  w.x = pk4_fp8(v0[0] * EOSCALE, v0[1] * EOSCALE, v0[2] * EOSCALE, v0[3] * EOSCALE); w.y = pk4_fp8(v1[0] * EOSCALE, v1[1] * EOSCALE, v1[2] * EOSCALE, v1[3] * EOSCALE); }
                { const f32x4 v0 = acc[ai][1][m][0] * g + bb[1][0] * (g * WSCALE), v1 = acc[ai][1][m][1] * g + bb[1][1] * (g * WSCALE);
                  w.z = pk4_fp8(v0[0] * EOSCALE, v0[1] * EOSCALE, v0[2] * EOSCALE, v0[3] * EOSCALE); w.w = pk4_fp8(v1[0] * EOSCALE, v1[1] * EOSCALE, v1[2] * EOSCALE, v1[3] * EOSCALE); }
                if (l >= 0) *(u32x4*)dst = w; }
    }
};
__device__ __forceinline__ const LAS unsigned char* moe_tiles(Frame& F, int& nT) {
    FT_DECL;
    LAS unsigned char* TE = (LAS unsigned char*)(F.lds + RING_BYTES); LAS int* TB = (LAS int*)(TE + 544); LAS int* TOT = TB + 32; LAS int* NTL = TOT + 32;
    const int* ecnt = (const int*)(F.ctl + CW_ECNT);
    __syncthreads();
    if (f_tid < 32) { const int t = ecnt[f_tid]; TOT[f_tid] = t; NTL[f_tid] = (t + 255) >> 8; }
    __syncthreads();
    if (f_tid < 33) { int b = 0; for (int e = 0; e < f_tid; ++e) b += NTL[e]; if (f_tid < 32) TB[f_tid] = b; else NTL[32] = b; }
    __syncthreads();
    nT = NTL[32]; if (nT > MAXTILE) nT = MAXTILE;
    for (int i = f_tid; i < MAXTILE; i += 512) { int e = 0;
#pragma unroll 8
        for (int q = 0; q < 32; ++q) e += (TB[q] + NTL[q] <= i) ? 1 : 0;
        TE[i] = (unsigned char)((i < nT) ? e : 0); }
    __syncthreads();
    return (const LAS unsigned char*)TE;
}

__device__ __forceinline__ void p10_combine(Frame& F) {
    FT_DECL;
    const float* mod = WSP(float, WS_SMALL + SM_MOD); const unsigned char* EO = WSP(unsigned char, WS_EO);
    const size_t gt = (size_t)F.vcu * 512 + f_tid, NTH = (size_t)F.G * 512;
    constexpr int U = 4;
    for (size_t i0 = gt; i0 < (size_t)MROWS * 128; i0 += NTH * U) {
        u32x2 ev[U][4]; f32x4 xv[U][2], gv[U][2];
#pragma unroll
        for (int u = 0; u < U; ++u) { const size_t i = i0 + (size_t)u * NTH; const size_t row = i >> 7; const int c0 = (int)(i & 127) * 8;
            const float* g2 = mod + (size_t)(row >> 12) * (NMOD * DM) + 5 * DM + c0; const bf16_t* op = WSP(bf16_t, WS_XN) + row * DM + c0;
#pragma unroll
            for (int k = 0; k < 4; ++k) ev[u][k] = __builtin_nontemporal_load((const u32x2*)(EO + ((size_t)k * MROWS + row) * DM + c0));
            { const u32x4 xb = *(const u32x4*)op; xv[u][0] = (f32x4){__uint_as_float(xb.x << 16), __uint_as_float(xb.x & 0xffff0000u), __uint_as_float(xb.y << 16), __uint_as_float(xb.y & 0xffff0000u)};
              xv[u][1] = (f32x4){__uint_as_float(xb.z << 16), __uint_as_float(xb.z & 0xffff0000u), __uint_as_float(xb.w << 16), __uint_as_float(xb.w & 0xffff0000u)}; }
            gv[u][0] = *(const f32x4*)g2; gv[u][1] = *(const f32x4*)(g2 + 4); }
#pragma unroll
        for (int u = 0; u < U; ++u) { const size_t i = i0 + (size_t)u * NTH; const size_t row = i >> 7; const int c0 = (int)(i & 127) * 8;
            float s[8];
#pragma unroll
            for (int e = 0; e < 8; ++e) s[e] = 0.f;
#pragma unroll
            for (int k = 0; k < 4; ++k) { const u32x2 v = ev[u][k];
                const f32x2 a = __builtin_amdgcn_cvt_pk_f32_fp8((int)v.x, false), b = __builtin_amdgcn_cvt_pk_f32_fp8((int)v.x, true), c = __builtin_amdgcn_cvt_pk_f32_fp8((int)v.y, false), d = __builtin_amdgcn_cvt_pk_f32_fp8((int)v.y, true);
                s[0] += a.x; s[1] += a.y; s[2] += b.x; s[3] += b.y; s[4] += c.x; s[5] += c.y; s[6] += d.x; s[7] += d.y; }
#pragma unroll
            for (int e = 0; e < 8; ++e) s[e] *= (1.f / EOSCALE);
            f32x4 o0 = xv[u][0] + gv[u][0] * (f32x4){s[0], s[1], s[2], s[3]}, o1 = xv[u][1] + gv[u][1] * (f32x4){s[4], s[5], s[6], s[7]};
            float* op = F.out + row * DM + c0;
            __builtin_nontemporal_store(o0, (f32x4*)op); __builtin_nontemporal_store(o1, (f32x4*)(op + 4)); }
    }
}

struct Args { const float* in[34]; float* out; unsigned char* ws; int ph_lo, ph_hi; };
constexpr int N_PHASES = 11;

__global__ void __launch_bounds__(512, 2) mega(Args args) {
    extern __shared__ __attribute__((aligned(16))) unsigned char lds[];
    Frame F;
    F.lds = (LAS unsigned char*)lds;
    F.MISC = (volatile LAS unsigned*)(F.lds + LDSCTL_OFF);
    F.wave = __builtin_amdgcn_readfirstlane(threadIdx.x >> 6);
    FT_DECL;
    F.G = gridDim.x; { const int bx = blockIdx.x; F.vcu = (F.G % 8 == 0) ? (bx % 8) * (F.G / 8) + bx / 8 : bx; }
    F.in = (kin_t)__builtin_amdgcn_kernarg_segment_ptr();
    F.out = args.out; F.ws = args.ws;
    F.ctl = (gu32*)(args.ws + WS_CTL);
    for (int u = f_tid; u < (LDS_BYTES - LDSCTL_OFF) / 4; u += NWAVES * 64) ((LAS unsigned*)(F.lds + LDSCTL_OFF))[u] = 0u;
    __syncthreads();
    const int lo = args.ph_lo, hi = args.ph_hi;
    XcdBarrier bar; bar.bar = (unsigned*)(F.ctl + CW_BAR); bar.x = 0; bar.st = nullptr;
    if (hi - lo > 1) bar = xcd_barrier_post((unsigned*)(F.ctl + CW_BAR), F.MISC + 8, f_tid == 0);
#define IN(k) (lo <= (k) && (k) < hi)
#define SEAM(k) do { if (IN(k) && IN((k) + 1)) xcd_barrier(bar, F.wave == 0 && lane_id() == 0); } while (0)

    if (IN(0)) { p0_prologue(F); }
    if (IN(1)) { p1_norm1(F); } SEAM(1);
    if (IN(2)) {
        SchedInProj S{F.G, (int)blockIdx.x, (const char*)WSP(bf16_t, WS_H), (const char*)WSP(bf16_t, WS_WIN)};
        EpiInProj E{WSP(unsigned char, WS_Q), WSP(unsigned char, WS_K), WSP(unsigned char, WS_V), WSP(bf16_t, WS_UT), F.in[9], F.in[10], WSP(float, WS_SMALL + SM_ROPE)};
        g8::gemm_phase<false>(F.lds, DM, S, E, F.wave, lane_id());
    } SEAM(2);
    if (IN(3)) { p3_attention8(F); p3_hyena(F); } SEAM(3);
    if (IN(4)) { p4_hynorm(F); } SEAM(4);
    if (IN(5)) {
        SchedStatic S{F.G, (int)blockIdx.x, MROWS / 256, DM / 256, (const char*)WSP(bf16_t, WS_MIX), (const char*)WSP(bf16_t, WS_WOUT)};
        EpiOutProj E{F.in[0], WSP(bf16_t, WS_XN), WSP(float, WS_SMALL + SM_MOD)};
        g8::gemm_phase<false>(F.lds, DM, S, E, F.wave, lane_id());
    } SEAM(5);
    if (IN(6)) { p6_router_mfma(F); } SEAM(6);
    if (IN(8)) {
        int nT; const LAS unsigned char* TE = moe_tiles(F, nT);
        LAS int* RWL = (LAS int*)(F.lds + RING_BYTES + 1024);
        static_assert(RING_BYTES + 1024 + 17 * 1024 <= LDSCTL_OFF, "LDS map");
        SchedMoE<8> S{F.G, (int)blockIdx.x, nT, (const char*)WSP(char, WS_H), (const char*)WSP(char, WS_W1), (size_t)2 * DM * DM, TE, RWL, true};
        { const int* list = WSP(int, WS_LIST2); const int t8 = F.wave * 64 + lane_id();
            g8::Unit u; for (int i = 0; i < 17 && S.next(i, u); i += 2) { const int ii = i + (t8 >> 8); g8::Unit u2; if (S.next(ii, u2)) { const long ix = S.lidx(u2.pm, u2.ex, t8 & 255); RWL[ii * 256 + (t8 & 255)] = (ix >= 0) ? (list[ix] >> 2) : 0; } }
            __syncthreads(); }
        EpiSwiGLU E{WSP(unsigned char, WS_ACT), F.in[31]};
        g8::gemm_phase_g<true, true>(F.lds, DM, S, E, F.wave, lane_id());
    } SEAM(8);
    if (IN(9)) {
        int nT; const LAS unsigned char* TE = moe_tiles(F, nT);
        SchedMoE<4> S{F.G, (int)blockIdx.x, nT, (const char*)WSP(char, WS_ACT), (const char*)WSP(char, WS_W2), (size_t)DM * DM, TE, nullptr, false};
        LAS int* LL = (LAS int*)(F.lds + RING_BYTES + 1024);
        static_assert(RING_BYTES + 1024 + 9 * 2048 <= LDSCTL_OFF, "LDS map");
        { const int* list = WSP(int, WS_LIST2); const float* gslot = WSP(float, WS_GSLOT2);
            const int t9 = F.wave * 64 + lane_id();
            g8::Unit u; for (int i = 0; i < 9 && S.next(i, u); ++i) { const int t = t9 & 255; const long ix = S.lidx(u.pm, u.ex, t);
                LL[i * 512 + (t9 >> 8) * 256 + t] = (ix < 0) ? ((t9 < 256) ? -1 : 0) : ((t9 < 256) ? list[ix] : __float_as_int(gslot[ix])); }
            __syncthreads(); }
        EpiDown E{WSP(unsigned char, WS_EO), F.in[33], LL, F.G, (int)blockIdx.x};
        g8::gemm_phase<true>(F.lds, DM, S, E, F.wave, lane_id());
    } SEAM(9);
    if (IN(10)) { p10_combine(F); }
#undef IN
#undef SEAM
}

extern "C" void kernel_launch(void* const* d_in, const int* in_sizes, int n_in, void* d_out, int out_size, void* d_ws, size_t ws_size, hipStream_t stream) {
    static int grid = 0;
    if (grid == 0) {
        if (n_in != 34 || out_size != MROWS * DM || ws_size < WS_END) { fprintf(stderr, "kernel_launch: unexpected shapes: n_in %d out %d ws %zu (need %zu)\n", n_in, out_size, ws_size, (size_t)WS_END); grid = -1; return; }
        int dev = 0, cus = 0, per_cu = 0;
        if (hipGetDevice(&dev) != hipSuccess || hipDeviceGetAttribute(&cus, hipDeviceAttributeMultiprocessorCount, dev) != hipSuccess) { grid = -1; return; }
        if (hipFuncSetAttribute((const void*)mega, hipFuncAttributeMaxDynamicSharedMemorySize, LDS_BYTES) != hipSuccess) { fprintf(stderr, "kernel_launch: hipFuncSetAttribute failed\n"); grid = -1; return; }
        if (hipOccupancyMaxActiveBlocksPerMultiprocessor(&per_cu, (const void*)mega, NWAVES * 64, LDS_BYTES) != hipSuccess || per_cu < 1) { fprintf(stderr, "kernel_launch: occupancy query says %d\n", per_cu); per_cu = 1; }
        (void)hipGetLastError();
        grid = cus;
    }
    if (grid < 0) return;
    (void)hipMemsetAsync((char*)d_ws + WS_CTL, 0, CTL_ZERO_BYTES, stream);
    Args a{};
    for (int i = 0; i < 34; ++i) a.in[i] = (const float*)d_in[i];
    a.out = (float*)d_out; a.ws = (unsigned char*)d_ws;
    constexpr int LAST = MK_LAST_PHASE + 1;
    if (MK_N_LAUNCHES == 1) { a.ph_lo = 0; a.ph_hi = LAST; hipLaunchKernelGGL(mega, dim3(grid), dim3(NWAVES * 64), LDS_BYTES, stream, a); }
    else for (int p = 0; p < LAST; ++p) { a.ph_lo = p; a.ph_hi = p + 1; hipLaunchKernelGGL(mega, dim3(grid), dim3(NWAVES * 64), LDS_BYTES, stream, a); }
    const hipError_t le = hipPeekAtLastError();
    if (le != hipSuccess) fprintf(stderr, "kernel_launch: launch failed: %s\n", hipGetErrorName(le));
}
```

```cpp
#include <hip/hip_runtime.h>
#include <hip/hip_bf16.h>
#include <cstdio>
#include <cstdint>

#ifndef MK_N_LAUNCHES
#define MK_N_LAUNCHES 1
#endif
#ifndef MK_LAST_PHASE
#define MK_LAST_PHASE 10
#endif

#define GAS __attribute__((address_space(1)))
#define LAS __attribute__((address_space(3)))
typedef unsigned short bf16_t;
typedef short bf16x8 __attribute__((ext_vector_type(8)));
typedef short s16x4 __attribute__((ext_vector_type(4)));
typedef float f32x2 __attribute__((ext_vector_type(2)));
typedef float f32x4 __attribute__((ext_vector_type(4)));
typedef float f32x16 __attribute__((ext_vector_type(16)));
typedef unsigned u32x2 __attribute__((ext_vector_type(2)));
typedef unsigned u32x4 __attribute__((ext_vector_type(4)));
typedef GAS unsigned gu32;

constexpr int NB = 8, SEQ = 4096, DM = 1024, MROWS = NB * SEQ, CTXL = 256, MCTX = NB * CTXL, MTOT = MROWS + MCTX;
constexpr int KVL = CTXL + SEQ;
constexpr int NHEAD = 4, QKW = 512;
constexpr int HYW = 512, HYC = 1536, INC = 3072, QKVC = 1536;
constexpr int NEXP = 32, TOPK = 4, NMOD = 6;
constexpr float EPS = 1e-6f;
constexpr float LAM_INIT = 0.2f;
constexpr float QSCALE = 0.125f * 1.4426950408889634f;

constexpr size_t MiB = 1u << 20;
constexpr size_t WS_CTL = 0, CTL_ZERO_BYTES = 64 * 1024;
constexpr size_t WS_SMALL = 1 * MiB;
constexpr size_t WS_WIN = 2 * MiB;
constexpr size_t WS_WOUT = 8 * MiB;
constexpr size_t WS_W1 = 10 * MiB;
constexpr size_t WS_W2 = 138 * MiB;
constexpr size_t WS_H = 202 * MiB;
constexpr size_t WS_Q = 270 * MiB;
constexpr size_t WS_K = 302 * MiB;
constexpr size_t WS_V = 336 * MiB;
constexpr size_t WS_UT = 370 * MiB;
constexpr size_t WS_FILT = 466 * MiB;
constexpr size_t WS_Z2T = 498 * MiB;
constexpr size_t WS_MIX = 530 * MiB;
constexpr size_t WS_ROUTE = 594 * MiB;
constexpr size_t WS_ACT = 270 * MiB;
constexpr size_t WS_EO = 598 * MiB;
constexpr size_t WS_XN = 870 * MiB;
constexpr size_t WS_END = 998 * MiB;
constexpr size_t SM_MOD = 0;
constexpr size_t SM_SCAL = 256 * 1024;
constexpr size_t SM_ROPE = 260 * 1024;
constexpr size_t SM_RBIAS = 272 * 1024;
constexpr int CW_BAR = 4096;
constexpr int CW_GEMV = 320;

constexpr int RING_BYTES = 131072;
constexpr int LDSCTL_OFF = 151552;
constexpr int LDS_BYTES = 152576;
constexpr int NWAVES = 8;

#define LDS_WAIT() asm volatile("s_waitcnt lgkmcnt(0)" ::: "memory")
#define VM_WAIT() asm volatile("s_waitcnt vmcnt(0)" ::: "memory")
#define RLX_AGENT __ATOMIC_RELAXED, __HIP_MEMORY_SCOPE_AGENT

__device__ __forceinline__ unsigned cvt_pk_bf16(float lo, float hi) { unsigned r; asm volatile("v_cvt_pk_bf16_f32 %0, %1, %2" : "=v"(r) : "v"(lo), "v"(hi)); return r; }
__device__ __forceinline__ float bf2f(bf16_t v) { return __uint_as_float(((unsigned)v) << 16); }
__device__ __forceinline__ float wave_sum(float v) {
#pragma unroll
    for (int o = 1; o < 64; o <<= 1) v += __shfl_xor(v, o);
    return v;
}

#define XB_TMO      128
#define XB_XCNT(j)  (256  + 64 * (j))
#define XB_XSUB(j)  (1280 + 64 * (j))
#define XB_XGEN(j)  (2304 + 64 * (j))
#define XB_TOP      3328
#define XB_TOPGEN   3392
#define XCD_BAR_WORDS 3456
#define XB_SPIN_CAP (1u << 22)
__device__ __forceinline__ unsigned xb_ld(unsigned* p)              { return __hip_atomic_load(p, __ATOMIC_RELAXED, __HIP_MEMORY_SCOPE_AGENT); }
__device__ __forceinline__ unsigned xb_add(unsigned* p, unsigned v) { return __hip_atomic_fetch_add(p, v, __ATOMIC_RELAXED, __HIP_MEMORY_SCOPE_AGENT); }
__device__ __forceinline__ unsigned xb_xcc_id() { return (unsigned)__builtin_amdgcn_s_getreg((3 << 11) | 20) & 0xFu; }
#define XB_SPIN(cond, bar) do { unsigned _sp = 0; while (cond) { __builtin_amdgcn_s_sleep(1); \
    if ((++_sp & 255u) == 0u) { if (xb_ld(&(bar)[XB_TMO])) break; if (_sp > XB_SPIN_CAP) { atomicAdd(&(bar)[XB_TMO], 1u); break; } } } } while (0)
struct XcdBarrier { unsigned* bar; unsigned x; volatile LAS unsigned* st; };
__device__ __forceinline__ XcdBarrier xcd_barrier_post(unsigned* bar, volatile LAS unsigned* st, bool leader) {
    XcdBarrier b; b.bar = bar; b.x = xb_xcc_id(); b.st = st;
    if (leader) (void)xb_add(&bar[XB_XCNT(b.x)], 1u);
    return b;
}
__device__ __forceinline__ void xcd_barrier_complete(unsigned* bar, unsigned x, unsigned& nloc, unsigned& nx) {
    const unsigned G = gridDim.x * gridDim.y * gridDim.z;
    unsigned sum, cnt, mine, sp = 0u;
    for (;;) {
        sum = 0u; cnt = 0u; mine = 0u;
#pragma unroll
        for (unsigned j = 0; j < 16; ++j) { const unsigned c = xb_ld(&bar[XB_XCNT(j)]); sum += c; cnt += (c > 0u) ? 1u : 0u; mine = (j == x) ? c : mine; }
        if (sum == G) break;
        __builtin_amdgcn_s_sleep(1);
        if ((++sp & 255u) == 0u) { if (xb_ld(&bar[XB_TMO])) break; if (sp > XB_SPIN_CAP) { atomicAdd(&bar[XB_TMO], 1u); break; } }
    }
    nloc = mine > 0u ? mine : 1u; nx = cnt > 0u ? cnt : 1u;
}
__device__ __forceinline__ void xcd_barrier(const XcdBarrier& b, bool leader) {
    asm volatile("s_waitcnt vmcnt(0)" ::: "memory");
    __syncthreads();
    if (leader) {
        unsigned* bar = b.bar;
        __builtin_amdgcn_s_waitcnt(0);
        unsigned nloc = b.st[0], nx = b.st[1];
        if (nloc == 0u) { xcd_barrier_complete(bar, b.x, nloc, nx); b.st[0] = nloc; b.st[1] = nx; }
        const unsigned old = xb_add(&bar[XB_XSUB(b.x)], 1u);
        const unsigned gen = old / nloc;
        if (old + 1u == (gen + 1u) * nloc) {
            __builtin_amdgcn_fence(__ATOMIC_RELEASE, "agent");
            asm volatile("s_waitcnt vmcnt(0)" ::: "memory");
            const unsigned og = xb_add(&bar[XB_TOP], 1u);
            const unsigned tg = og / nx;
            if (og + 1u == (tg + 1u) * nx) xb_add(&bar[XB_TOPGEN], 1u);
            else XB_SPIN(xb_ld(&bar[XB_TOPGEN]) == tg, bar);
            __builtin_amdgcn_fence(__ATOMIC_ACQUIRE, "agent");
            xb_add(&bar[XB_XGEN(b.x)], 1u);
            asm volatile("s_waitcnt vmcnt(0)" ::: "memory");
        } else {
            XB_SPIN(xb_ld(&bar[XB_XGEN(b.x)]) == gen, bar);
            __builtin_amdgcn_fence(__ATOMIC_ACQUIRE, "agent");
            asm volatile("s_waitcnt vmcnt(0)" ::: "memory");
        }
    }
    __syncthreads();
}

namespace g8 {
constexpr int BM = 256, BK = 64, HALF = 128, HTB = HALF * BK * 2, STAGE_BYTES = 8 * HTB, NXCD = 8, WGM = 8;
__host__ __device__ __forceinline__ int lds_byte(int r, int c) { const int st = (r >> 4) * 2 + (c >> 5), rr = r & 15, cc = c & 31, ob = rr * 64 + cc * 2; return st * 1024 + (ob ^ (((ob >> 9) & 1) << 5)); }
__host__ __device__ __forceinline__ void stage_rc(int b, int& R, int& C) { const int st = b / 1024, sb = b % 1024, swz = sb ^ (((sb >> 9) & 1) << 5); R = (st >> 1) * 16 + swz / 64; C = (st & 1) * 32 + (swz % 64) / 2; }
__host__ __device__ __forceinline__ int perm32(int rho) { const int n = rho >> 4, i = rho & 15; return 8 * (i >> 2) + 4 * n + (i & 3); }

struct Unit { const char* a; const char* b; int pm, pn, kind, ex; };

__device__ __forceinline__ void tile_of(int L, int nM, int nN, int& pm, int& pn) {
    const int nwg = nM * nN; int wgid = L;
    { const int q = nwg / NXCD, r = nwg % NXCD, xcd = wgid % NXCD, off = wgid / NXCD; wgid = (xcd < r ? xcd * (q + 1) : r * (q + 1) + (xcd - r) * q) + off; }
    const int nig = WGM * nN, gid = wgid / nig, fm = gid * WGM, gsz = (nM - fm) < WGM ? (nM - fm) : WGM;
    pm = fm + ((wgid % nig) % gsz); pn = (wgid % nig) / gsz;
}

typedef int i32x8 __attribute__((ext_vector_type(8)));
template <bool FP8, bool GATHER, bool SP2, class Epi, class Sched>
__device__ __forceinline__ void gemm_phase_s(LAS unsigned char* lds, const int K, const Sched& S, const Epi& E, const int wid, const int lane) {
    const int tid = wid * 64 + lane, wr = wid >> 2, wc = wid & 3, fr = lane & 15, fq = lane >> 4;
    const int nt = FP8 ? K / 128 : K / BK;
    const int RP = FP8 ? K : 2 * K;
    unsigned voffA[2], voffB[2]; int srow[2], scol[2];
#pragma unroll
    for (int i = 0; i < 2; ++i) { int R, C; stage_rc(tid * 16 + i * 8192, R, C); const int Rb = (R & ~31) + perm32(R & 31);
        voffA[i] = (unsigned)(R * RP + C * 2); voffB[i] = (unsigned)(Rb * RP + C * 2); srow[i] = R; scol[i] = C * 2; }
    const size_t kstep = (size_t)(BK * 2);
    const size_t hstep = (size_t)HALF * RP;
    const unsigned ldsw = (unsigned)wid * 1024u;
    unsigned cO0[2], cO1[2], nO0[2], nO1[2];
#define PG8_GOFF(D0, D1, ui_) do { if constexpr (GATHER) { const LAS int* rw_ = S.rows(ui_); _Pragma("unroll") for (int i_ = 0; i_ < 2; ++i_) { \
        D0[i_] = (unsigned)rw_[srow[i_]] * (unsigned)RP + (unsigned)scol[i_]; D1[i_] = (unsigned)rw_[128 + srow[i_]] * (unsigned)RP + (unsigned)scol[i_]; } } \
      else { _Pragma("unroll") for (int i_ = 0; i_ < 2; ++i_) { D0[i_] = voffA[i_]; D1[i_] = voffA[i_] + (unsigned)hstep; } } } while (0)
    const int aoff = lds_byte(wr * 64 + fr, FP8 ? fq * 16 : fq * 8), boff = lds_byte(wc * 32 + fr, FP8 ? fq * 16 : fq * 8);
    constexpr int KOFF = FP8 ? 16 : 1024;
#define PG8_SA(b, h) (((b) * 2 + (h)) * HTB)
#define PG8_SB(b, h) ((4 + (b) * 2 + (h)) * HTB)
#define PG8_STAGE(bufoff, gbase, voff) do { _Pragma("unroll") for (int _i = 0; _i < 2; ++_i) \
        __builtin_amdgcn_global_load_lds((const unsigned*)((const char*)(gbase) + (voff)[_i]), (LAS unsigned*)(lds + (bufoff) + ldsw + _i * 8192), 16, 0, 0); } while (0)
#define PG8_LD32(p) __builtin_bit_cast(i32x8, __builtin_shufflevector(*(const LAS u32x4*)(p), *(const LAS u32x4*)((p) + 16), 0, 1, 2, 3, 4, 5, 6, 7))
#define PG8_LDA8(dst, b, h) do { _Pragma("unroll") for (int m = 0; m < 4; ++m) dst[m] = PG8_LD32(lds + PG8_SA(b, h) + aoff + m * 2048); } while (0)
#define PG8_LDB8(dst, b, h) do { _Pragma("unroll") for (int n = 0; n < 2; ++n) dst[n] = PG8_LD32(lds + PG8_SB(b, h) + boff + n * 2048); } while (0)
#define PG8_LDA(dst, b, h) do { _Pragma("unroll") for (int m = 0; m < 4; ++m) _Pragma("unroll") for (int k = 0; k < 2; ++k) dst[m][k] = *(const LAS bf16x8*)(lds + PG8_SA(b, h) + aoff + m * 2048 + k * KOFF); } while (0)
#define PG8_LDB(dst, b, h) do { _Pragma("unroll") for (int n = 0; n < 2; ++n) _Pragma("unroll") for (int k = 0; k < 2; ++k) dst[n][k] = *(const LAS bf16x8*)(lds + PG8_SB(b, h) + boff + n * 2048 + k * KOFF); } while (0)
#define PG8_MMA(ai, bj, At, Bt) do { __builtin_amdgcn_s_setprio(1); _Pragma("unroll") for (int m = 0; m < 4; ++m) _Pragma("unroll") for (int n = 0; n < 2; ++n) _Pragma("unroll") for (int k = 0; k < 2; ++k) \
        acc[ai][bj][m][n] = __builtin_amdgcn_mfma_f32_16x16x32_bf16(Bt[n][k], At[m][k], acc[ai][bj][m][n], 0, 0, 0); __builtin_amdgcn_s_setprio(0); } while (0)
#define PG8_MMA8(ai, bj, At, Bt) do { __builtin_amdgcn_s_setprio(1); _Pragma("unroll") for (int m = 0; m < 4; ++m) _Pragma("unroll") for (int n = 0; n < 2; ++n) \
        asm volatile("v_mfma_scale_f32_16x16x128_f8f6f4 %0, %1, %2, %0, %3, %3 op_sel_hi:[0,0,0]" : "+v"(acc[ai][bj][m][n]) : "v"(Bt[n]), "v"(At[m]), "v"(one_scale)); __builtin_amdgcn_s_setprio(0); } while (0)
#define PG8_WAIT_V(n) asm volatile("s_waitcnt vmcnt(" #n ")" ::: "memory")
#define PG8_WAIT_L(n) asm volatile("s_waitcnt lgkmcnt(" #n ")" ::: "memory")
#define PG8_BAR __builtin_amdgcn_s_barrier()
#define PG8_SCHED __builtin_amdgcn_sched_barrier(0)
    Unit cur, nxt; int ui = 0;
    if (!S.next(0, cur)) return;
    f32x4 acc[2][2][4][2];
#pragma unroll
    for (int a = 0; a < 2; ++a)
#pragma unroll
        for (int b = 0; b < 2; ++b)
#pragma unroll
            for (int m = 0; m < 4; ++m)
#pragma unroll
                for (int n = 0; n < 2; ++n) acc[a][b][m][n] = (f32x4){0.f, 0.f, 0.f, 0.f};
    bf16x8 At[4][2], B0[2][2], B1[2][2];
    i32x8 At8[4], B08[2], B18[2];
    const unsigned one_scale = 0x7f7f7f7fu;
    const char* cA = cur.a; const char* cB = cur.b;
    PG8_GOFF(cO0, cO1, 0);
    if constexpr (SP2) {
    PG8_STAGE(PG8_SB(0, 0), cB, voffB); PG8_STAGE(PG8_SB(0, 1), cB + hstep, voffB); PG8_STAGE(PG8_SA(0, 0), cA, cO0); PG8_STAGE(PG8_SA(0, 1), cA, cO1);
    if (wr == 1) PG8_BAR;
    PG8_WAIT_V(2); PG8_BAR;
    PG8_STAGE(PG8_SB(1, 0), cB + kstep, voffB); PG8_STAGE(PG8_SA(1, 0), cA + kstep, cO0); PG8_STAGE(PG8_SB(1, 1), cB + hstep + kstep, voffB);
    PG8_WAIT_V(6); PG8_BAR;
    } else {
    PG8_STAGE(PG8_SB(0, 0), cB, voffB); PG8_STAGE(PG8_SA(0, 0), cA, cO0); PG8_STAGE(PG8_SB(0, 1), cB + hstep, voffB); PG8_STAGE(PG8_SA(0, 1), cA, cO1);
    if (wr == 1) PG8_BAR;
    PG8_WAIT_V(4); PG8_BAR;
    PG8_STAGE(PG8_SB(1, 0), cB + kstep, voffB); PG8_STAGE(PG8_SA(1, 0), cA + kstep, cO0); PG8_STAGE(PG8_SB(1, 1), cB + hstep + kstep, voffB);
    PG8_WAIT_V(6); PG8_BAR;
    }
    for (;;) {
        const bool has_next = S.next(ui + 1, nxt);
        const char* nA = has_next ? nxt.a : cA; const char* nB = has_next ? nxt.b : cB;
        if (has_next) PG8_GOFF(nO0, nO1, ui + 1); else { _Pragma("unroll") for (int i_ = 0; i_ < 2; ++i_) { nO0[i_] = cO0[i_]; nO1[i_] = cO1[i_]; } }
#pragma unroll 1
        for (int t = 0; t < nt; t += 2) {
            const bool last = (t == nt - 2);
            const char* a1 = cA + (size_t)(t + 1) * kstep;
            const char* a2 = last ? nA : cA + (size_t)(t + 2) * kstep; const char* b2 = last ? nB : cB + (size_t)(t + 2) * kstep;
            const char* a3 = a2 + kstep; const char* b3 = b2 + kstep;
            unsigned o20[2], o21[2];
#pragma unroll
            for (int i_ = 0; i_ < 2; ++i_) { o20[i_] = last ? nO0[i_] : cO0[i_]; o21[i_] = last ? nO1[i_] : cO1[i_]; }
            if constexpr (FP8 && SP2) {
            PG8_LDB8(B08, 0, 0); PG8_LDB8(B18, 0, 1); PG8_SCHED; PG8_LDA8(At8, 0, 0); PG8_STAGE(PG8_SA(1, 1), a1, cO1);
            PG8_WAIT_V(8); PG8_WAIT_L(0); PG8_BAR; PG8_MMA8(0, 0, At8, B08); PG8_MMA8(0, 1, At8, B18); PG8_BAR; PG8_SCHED;
            PG8_LDA8(At8, 0, 1); PG8_STAGE(PG8_SB(0, 0), b2, voffB); PG8_STAGE(PG8_SB(0, 1), b2 + hstep, voffB); PG8_STAGE(PG8_SA(0, 0), a2, o20);
            PG8_WAIT_V(8); PG8_WAIT_L(0); PG8_BAR; PG8_MMA8(1, 0, At8, B08); PG8_MMA8(1, 1, At8, B18); PG8_BAR; PG8_SCHED;
            PG8_LDB8(B08, 1, 0); PG8_LDB8(B18, 1, 1); PG8_SCHED; PG8_LDA8(At8, 1, 0); PG8_STAGE(PG8_SA(0, 1), a2, o21);
            PG8_WAIT_V(8); PG8_WAIT_L(0); PG8_BAR; PG8_MMA8(0, 0, At8, B08); PG8_MMA8(0, 1, At8, B18); PG8_BAR; PG8_SCHED;
            PG8_LDA8(At8, 1, 1); PG8_STAGE(PG8_SB(1, 0), b3, voffB); PG8_STAGE(PG8_SB(1, 1), b3 + hstep, voffB); PG8_STAGE(PG8_SA(1, 0), a3, o20);
            PG8_WAIT_V(8); PG8_WAIT_L(0); PG8_BAR; PG8_MMA8(1, 0, At8, B08); PG8_MMA8(1, 1, At8, B18); PG8_BAR; PG8_SCHED;
            } else if constexpr (FP8) {
            PG8_LDB8(B08, 0, 0); PG8_SCHED; PG8_LDA8(At8, 0, 0); PG8_STAGE(PG8_SA(1, 1), a1, cO1);
            PG8_WAIT_L(8); PG8_BAR; PG8_WAIT_L(0); PG8_MMA8(0, 0, At8, B08); PG8_BAR; PG8_SCHED;
            PG8_LDB8(B18, 0, 1); PG8_STAGE(PG8_SB(0, 0), b2, voffB);
            PG8_BAR; PG8_WAIT_L(0); PG8_MMA8(0, 1, At8, B18); PG8_BAR;
            PG8_LDA8(At8, 0, 1); PG8_STAGE(PG8_SA(0, 0), a2, o20);
            PG8_BAR; PG8_WAIT_L(0); PG8_MMA8(1, 0, At8, B08); PG8_BAR; PG8_SCHED;
            PG8_STAGE(PG8_SB(0, 1), b2 + hstep, voffB);
            PG8_WAIT_V(6); PG8_BAR; PG8_MMA8(1, 1, At8, B18); PG8_BAR;
            PG8_LDB8(B08, 1, 0); PG8_SCHED; PG8_LDA8(At8, 1, 0); PG8_STAGE(PG8_SA(0, 1), a2, o21);
            PG8_WAIT_L(8); PG8_BAR; PG8_WAIT_L(0); PG8_MMA8(0, 0, At8, B08); PG8_BAR; PG8_SCHED;
            PG8_LDB8(B18, 1, 1); PG8_STAGE(PG8_SB(1, 0), b3, voffB);
            PG8_BAR; PG8_WAIT_L(0); PG8_MMA8(0, 1, At8, B18); PG8_BAR;
            PG8_LDA8(At8, 1, 1); PG8_STAGE(PG8_SA(1, 0), a3, o20);
            PG8_BAR; PG8_WAIT_L(0); PG8_MMA8(1, 0, At8, B08); PG8_BAR; PG8_SCHED;
            PG8_STAGE(PG8_SB(1, 1), b3 + hstep, voffB);
            PG8_WAIT_V(6); PG8_BAR; PG8_MMA8(1, 1, At8, B18); PG8_BAR;
            } else {
            PG8_LDB(B0, 0, 0); PG8_LDB(B1, 0, 1); PG8_SCHED; PG8_LDA(At, 0, 0); PG8_STAGE(PG8_SA(1, 1), a1, cO1);
            PG8_WAIT_V(8); PG8_WAIT_L(0); PG8_BAR; PG8_MMA(0, 0, At, B0); PG8_MMA(0, 1, At, B1); PG8_BAR; PG8_SCHED;
            PG8_LDA(At, 0, 1); PG8_STAGE(PG8_SB(0, 0), b2, voffB); PG8_STAGE(PG8_SB(0, 1), b2 + hstep, voffB); PG8_STAGE(PG8_SA(0, 0), a2, o20);
            PG8_WAIT_V(8); PG8_WAIT_L(0); PG8_BAR; PG8_MMA(1, 0, At, B0); PG8_MMA(1, 1, At, B1); PG8_BAR; PG8_SCHED;
            PG8_LDB(B0, 1, 0); PG8_LDB(B1, 1, 1); PG8_SCHED; PG8_LDA(At, 1, 0); PG8_STAGE(PG8_SA(0, 1), a2, o21);
            PG8_WAIT_V(8); PG8_WAIT_L(0); PG8_BAR; PG8_MMA(0, 0, At, B0); PG8_MMA(0, 1, At, B1); PG8_BAR; PG8_SCHED;
            PG8_LDA(At, 1, 1); PG8_STAGE(PG8_SB(1, 0), b3, voffB); PG8_STAGE(PG8_SB(1, 1), b3 + hstep, voffB); PG8_STAGE(PG8_SA(1, 0), a3, o20);
            PG8_WAIT_V(8); PG8_WAIT_L(0); PG8_BAR; PG8_MMA(1, 0, At, B0); PG8_MMA(1, 1, At, B1); PG8_BAR; PG8_SCHED;
            }
        }
        if (wr == 0) PG8_BAR;
        if constexpr (FP8) asm volatile("s_nop 15\n\ts_nop 15" ::: "memory");
        E(acc, cur, wr, wc, fr, fq);
        if (!has_next) break;
#pragma unroll
        for (int a = 0; a < 2; ++a)
#pragma unroll
            for (int b = 0; b < 2; ++b)
#pragma unroll
                for (int m = 0; m < 4; ++m)
#pragma unroll
                    for (int n = 0; n < 2; ++n) acc[a][b][m][n] = (f32x4){0.f, 0.f, 0.f, 0.f};
        cur = nxt; cA = nA; cB = nB; ++ui;
#pragma unroll
        for (int i_ = 0; i_ < 2; ++i_) { cO0[i_] = nO0[i_]; cO1[i_] = nO1[i_]; }
        if (wr == 1) PG8_BAR;
    }
    PG8_WAIT_V(0);
    PG8_BAR;
#undef PG8_SA
#undef PG8_GOFF
#undef PG8_SB
#undef PG8_STAGE
#undef PG8_LDA
#undef PG8_LDB
#undef PG8_MMA
#undef PG8_MMA8
#undef PG8_LDA8
#undef PG8_LDB8
#undef PG8_LD32
#undef PG8_WAIT_V
#undef PG8_WAIT_L
#undef PG8_BAR
#undef PG8_SCHED
}
template <bool FP8, bool GATHER, class Epi, class Sched>
__device__ __forceinline__ void gemm_phase_g(LAS unsigned char* lds, const int K, const Sched& S, const Epi& E, const int wid, const int lane) { gemm_phase_s<FP8, GATHER, !FP8>(lds, K, S, E, wid, lane); }
template <bool FP8, class Epi, class Sched>
__device__ __forceinline__ void gemm_phase(LAS unsigned char* lds, const int K, const Sched& S, const Epi& E, const int wid, const int lane) { gemm_phase_s<FP8, false, !FP8>(lds, K, S, E, wid, lane); }
}

__device__ __forceinline__ int lane_id() { int l; asm volatile("v_mbcnt_lo_u32_b32 %0, -1, 0\n\tv_mbcnt_hi_u32_b32 %0, -1, %0" : "=v"(l)); return l; }
#define FT_DECL const int f_lane = lane_id(), f_tid = F.wave * 64 + f_lane; (void)f_tid; (void)f_lane
typedef const float* cfp_t;
typedef __attribute__((address_space(4))) cfp_t* kin_t;
struct Frame {
    LAS unsigned char* lds;
    volatile LAS unsigned* MISC;
    gu32* ctl;
    int wave, vcu, G;
    kin_t in;
    float* out;
    unsigned char* ws;
};
#define WSP(T, off) ((T*)(F.ws + (off)))

template <class RowMap>
__device__ __forceinline__ void p0_transpose_item(const float* W, int K, int N, bf16_t* WT, const RowMap& rowmap, const float* kscale, LAS float* scr, int item, int lane, bool kperm = false) {
    const int nblk = N / 32, kb = item / nblk, nb = item % nblk, k0 = 64 * kb, n0 = 32 * nb;
#pragma unroll 8
    for (int i = 0; i < 32; ++i) { const int kk = 2 * i + (lane >> 5); int ks = k0 + kk; if (kperm && ks >= K / 2) { const int j = ks - K / 2; ks = K / 2 + (j >> 3) + 64 * (j & 7); }
        float v = W[(size_t)ks * N + n0 + (lane & 31)]; if (kscale) v *= kscale[k0 + kk]; scr[kk * 33 + (lane & 31)] = v; }
    LDS_WAIT(); asm volatile("" ::: "memory");
    const int c = lane & 7;
#pragma unroll
    for (int j = 0; j < 4; ++j) { const int n = (lane >> 3) + 8 * j; const LAS float* s = scr + (8 * c) * 33 + n;
        u32x4 o; o.x = cvt_pk_bf16(s[0 * 33], s[1 * 33]); o.y = cvt_pk_bf16(s[2 * 33], s[3 * 33]); o.z = cvt_pk_bf16(s[4 * 33], s[5 * 33]); o.w = cvt_pk_bf16(s[6 * 33], s[7 * 33]);
        *(GAS u32x4*)(WT + (size_t)rowmap(n0 + n) * K + k0 + 8 * c) = o; }
    LDS_WAIT(); asm volatile("" ::: "memory");
}

__device__ __forceinline__ unsigned pk4_fp8(float a, float b, float c, float d) { int r = __builtin_amdgcn_cvt_pk_fp8_f32(a, b, 0, false); r = __builtin_amdgcn_cvt_pk_fp8_f32(c, d, r, true); return (unsigned)r; }
constexpr float EOSCALE = 16.f;
constexpr float WSCALE = 32.f;
template <class RowMap>
__device__ __forceinline__ void p0_transpose_item_f8(const float* W, int K, int N, unsigned char* WT, const RowMap& rowmap, LAS float* scr, int item, int lane) {
    const int nblk = N / 32, kb = item / nblk, nb = item % nblk, k0 = 128 * kb, n0 = 32 * nb;
#pragma unroll
    for (int hh = 0; hh < 2; ++hh) { float v[32];
#pragma unroll
        for (int i = 0; i < 32; ++i) { const int kk = 2 * (32 * hh + i) + (lane >> 5); v[i] = __builtin_nontemporal_load(W + (size_t)(k0 + kk) * N + n0 + (lane & 31)); }
#pragma unroll
        for (int i = 0; i < 32; ++i) { const int kk = 2 * (32 * hh + i) + (lane >> 5); scr[kk * 33 + (lane & 31)] = v[i] * WSCALE; } }
    LDS_WAIT(); asm volatile("" ::: "memory");
    const int c = lane & 7;
#pragma unroll
    for (int j = 0; j < 4; ++j) { const int n = (lane >> 3) + 8 * j; const LAS float* sp = scr + (16 * c) * 33 + n;
        u32x4 o; o.x = pk4_fp8(sp[0 * 33], sp[1 * 33], sp[2 * 33], sp[3 * 33]); o.y = pk4_fp8(sp[4 * 33], sp[5 * 33], sp[6 * 33], sp[7 * 33]);
        o.z = pk4_fp8(sp[8 * 33], sp[9 * 33], sp[10 * 33], sp[11 * 33]); o.w = pk4_fp8(sp[12 * 33], sp[13 * 33], sp[14 * 33], sp[15 * 33]);
        *(GAS u32x4*)(WT + (size_t)rowmap(n0 + n) * K + k0 + 16 * c) = o; }
    LDS_WAIT(); asm volatile("" ::: "memory");
}
struct MapW2 { __device__ __forceinline__ int operator()(int l) const { const int t = l & ~255, r = l & 255, wc = r >> 6, fq = (r >> 4) & 3, bj = (r >> 3) & 1, low = r & 7; return t + 128 * bj + 32 * wc + 8 * fq + low; } };
struct MapIdent { int off; __device__ __forceinline__ int operator()(int n) const { return off + n; } };
struct MapWin { __device__ __forceinline__ int operator()(int l) const {
    if (l >= 1024) return l;
    const int t = l & ~255, r = l & 255, wc = r >> 6, blk = (r >> 5) & 1, bj = (r >> 4) & 1, low = r & 15;
    return t + 128 * bj + 32 * wc + 16 * blk + low; } };
struct MapW1 { int off; __device__ __forceinline__ int operator()(int jp) const { const int bj = jp >> 10, j = jp & 1023; return off + 256 * (j >> 7) + 128 * bj + (j & 127); } };


__device__ __forceinline__ void p0_filter_item(Frame& F, int item) {
    FT_DECL;
#define in F.in
    LAS float* h1s = (LAS float*)(F.lds);
    LAS float* h2s = (LAS float*)(F.lds + 4096);
    const int t0 = item * 16;
    {
        const int tt = f_tid >> 5, hh = (f_tid & 31) * 2; const float pos = (float)(t0 + tt);
        float feats[17]; feats[0] = pos * (1.f / SEQ);
#pragma unroll
        for (int i = 0; i < 8; ++i) { const float band = 1e-4f + (float)i * ((7.f - 1e-4f) / 7.f); const float ang = (6.283185307179586f / SEQ) * pos * band; feats[1 + i] = __sinf(ang); feats[9 + i] = __cosf(ang); }
#pragma unroll
        for (int u = 0; u < 2; ++u) { const int h = hh + u; float a = in[19][h];
#pragma unroll
            for (int k = 0; k < 17; ++k) a += feats[k] * in[18][k * 64 + h];
            h1s[tt * 64 + h] = __sinf(in[20][h] * a); }
        __syncthreads();
#pragma unroll
        for (int u = 0; u < 2; ++u) { const int h = hh + u; float a = in[22][h];
#pragma unroll 8
            for (int k = 0; k < 64; ++k) a += h1s[tt * 64 + k] * in[21][k * 64 + h];
            h2s[tt * 64 + h] = __sinf(in[23][h] * a); }
        __syncthreads();
    }
    f32x4 acc[16];
#pragma unroll
    for (int t = 0; t < 16; ++t) acc[t] = (f32x4){0.f, 0.f, 0.f, 0.f};
    const int o = 4 * f_tid;
    for (int k0 = 0; k0 < 64; k0 += 4) { f32x4 w[4];
#pragma unroll
        for (int q = 0; q < 4; ++q) w[q] = *(const f32x4*)(in[24] + (size_t)(k0 + q) * 2048 + o);
#pragma unroll
        for (int t = 0; t < 16; ++t) { const f32x4 hv = *(const LAS f32x4*)(h2s + t * 64 + k0); acc[t] += w[0] * hv[0] + w[1] * hv[1] + w[2] * hv[2] + w[3] * hv[3]; } }
    const int c0 = o & 511, od = o >> 9;
    float* dst = WSP(float, WS_FILT) + ((size_t)od * 512 + c0) * SEQ + t0;
#pragma unroll
    for (int e = 0; e < 4; ++e) { const float la = -3.0701134573253944f, lb = -15.350567286626972f; const float delta = fabsf(la + (float)(c0 + e) * ((lb - la) / 511.f));
#pragma unroll
        for (int q = 0; q < 4; ++q) { f32x4 v;
#pragma unroll
            for (int i = 0; i < 4; ++i) { const int t = 4 * q + i; const float tn = (float)(t0 + t) * (1.f / SEQ); v[i] = acc[t][e] * __expf(-tn * delta); }
            *(f32x4*)(dst + (size_t)e * SEQ + 4 * q) = v; } }
    __syncthreads();
#undef in
}

__device__ __forceinline__ float silu_f(float v) { return v / (1.f + __expf(-v)); }

__device__ __forceinline__ void p0_prologue(Frame& F) {
    FT_DECL;
#define in F.in
    const int wg = blockIdx.x;
    if (wg < 96) {
        LAS float* sv = (LAS float*)F.lds;
        for (int i = f_tid; i < 9 * 1024; i += 512) { const int r = i >> 10, k = i & 1023; const float c = (r < 8) ? in[1][r * 1024 + k] : in[3][k]; sv[i] = silu_f(c); }
        __syncthreads();
        const int j = wg * 64 + f_lane; const float* wm = in[4];
        float acc[9];
#pragma unroll
        for (int r = 0; r < 9; ++r) acc[r] = 0.f;
        const int kbeg = F.wave * 128;
        for (int k0 = kbeg; k0 < kbeg + 128; k0 += 16) { float w[16];
#pragma unroll
            for (int q = 0; q < 16; ++q) w[q] = __builtin_nontemporal_load(wm + (size_t)(k0 + q) * (NMOD * DM) + j);
#pragma unroll
            for (int q = 0; q < 16; ++q)
#pragma unroll
                for (int r = 0; r < 9; ++r) acc[r] += sv[r * 1024 + k0 + q] * w[q]; }
        LAS float* red = (LAS float*)(F.lds + 40960);
#pragma unroll
        for (int r = 0; r < 9; ++r) red[(F.wave * 9 + r) * 64 + f_lane] = acc[r];
        __syncthreads();
        for (int i = f_tid; i < 9 * 64; i += 512) { const int r = i >> 6, l = i & 63; float s = in[5][wg * 64 + l];
#pragma unroll
            for (int w = 0; w < 8; ++w) s += red[(w * 9 + r) * 64 + l];
            WSP(float, WS_SMALL + SM_MOD)[r * (NMOD * DM) + wg * 64 + l] = s; }
        asm volatile("s_waitcnt vmcnt(0)" ::: "memory");
        __syncthreads();
        if (f_tid == 0) { __builtin_amdgcn_fence(__ATOMIC_RELEASE, "agent"); asm volatile("s_waitcnt vmcnt(0)" ::: "memory"); (void)xb_add((unsigned*)(F.ctl + CW_GEMV), 1u); }
    } else if (wg == 96) {
        if (F.wave == 0) {
            const float a = wave_sum(in[11][f_lane] * in[12][f_lane]), b = wave_sum(in[13][f_lane] * in[14][f_lane]);
            float gq = fabsf(in[9][f_lane]), gk = fabsf(in[10][f_lane]);
#pragma unroll
            for (int o = 1; o < 64; o <<= 1) { gq = fmaxf(gq, __shfl_xor(gq, o)); gk = fmaxf(gk, __shfl_xor(gk, o)); }
            if (f_lane == 0) { float* sc = WSP(float, WS_SMALL + SM_SCAL); sc[0] = expf(a) - expf(b) + LAM_INIT;
                sc[1] = (8.f * gq * gk * 1.02f + 0.05f) * 1.4426950408889634f; }
        }
        for (int i = f_tid; i < 64 * 16; i += 512) { const int pos = i >> 4, f = i & 15;
            const float inv = powf(10000.f, -(float)f / 16.f); const float ang = (float)pos * inv;
            float* rt = WSP(float, WS_SMALL + SM_ROPE); rt[2 * i] = cosf(ang); rt[2 * i + 1] = sinf(ang); }
    }
    __syncthreads();
    for (int it = wg; it < SEQ / 16; it += F.G) p0_filter_item(F, it);
    __syncthreads();
    {
        LAS float* scr = (LAS float*)(F.lds + F.wave * 16896);
        const int gw = F.vcu * NWAVES + F.wave, NGW = F.G * NWAVES;
        constexpr int I_IN = (DM / 64) * (INC / 32), I_OUT = (DM / 64) * (DM / 32), I_1 = (DM / 128) * (2 * DM / 32), I_2 = (DM / 128) * (DM / 32);
        constexpr int NITEMS = I_IN + I_OUT + NEXP * (I_1 + I_2);
        for (int it = gw; it < NITEMS; it += NGW) {
            int r = it;
            if (r < I_IN) { p0_transpose_item(in[8], DM, INC, WSP(bf16_t, WS_WIN), MapWin{}, nullptr, scr, r, f_lane); continue; } r -= I_IN;
            if (r < I_OUT) { p0_transpose_item(in[27], DM, DM, WSP(bf16_t, WS_WOUT), MapIdent{0}, nullptr, scr, r, f_lane, true); continue; } r -= I_OUT;
            const int e = r / (I_1 + I_2); r -= e * (I_1 + I_2);
            if (r < I_1) p0_transpose_item_f8(in[30] + (size_t)e * DM * 2 * DM, DM, 2 * DM, WSP(unsigned char, WS_W1) + (size_t)e * 2 * DM * DM, MapW1{0}, scr, r, f_lane);
            else p0_transpose_item_f8(in[32] + (size_t)e * DM * DM, DM, DM, WSP(unsigned char, WS_W2) + (size_t)e * DM * DM, MapW2{}, scr, r - I_1, f_lane);
        }
    }
}
#undef in

__device__ __forceinline__ void p1_norm1(Frame& F) {
    FT_DECL;
    const int gw = F.vcu * NWAVES + F.wave, NGW = F.G * NWAVES;
    const float* mod = WSP(float, WS_SMALL + SM_MOD); const float* g1 = F.in[6];
    bf16_t* H = WSP(bf16_t, WS_H);
    if (f_tid == 0) { unsigned* bar = (unsigned*)(F.ctl + CW_BAR); XB_SPIN(xb_ld((unsigned*)(F.ctl + CW_GEMV)) < 96u, bar); __builtin_amdgcn_fence(__ATOMIC_ACQUIRE, "agent"); asm volatile("s_waitcnt vmcnt(0)" ::: "memory"); }
    __syncthreads();
    for (int pe = blockIdx.x; pe < NB * NEXP; pe += F.G) { const int b = pe >> 5, e = pe & 31; const float* sh2 = mod + (size_t)b * (NMOD * DM) + 3 * DM; const float* rw = F.in[28];
        const int t = F.wave * 64 + lane_id();
        float a = sh2[t] * rw[(size_t)t * 32 + e] + sh2[t + 512] * rw[(size_t)(t + 512) * 32 + e];
        a = wave_sum(a);
        LAS float* red = (LAS float*)F.lds;
        __syncthreads(); if (lane_id() == 0) red[F.wave] = a; __syncthreads();
        if (t == 0) { float sacc = F.in[29][e];
#pragma unroll
            for (int w = 0; w < NWAVES; ++w) sacc += red[w];
            WSP(float, WS_SMALL + SM_RBIAS)[pe] = sacc; }
        __syncthreads(); }
    constexpr int RPW = MTOT / (256 * NWAVES);
    for (int run = gw; run * RPW < MTOT; run += NGW) {
        const int r0 = run * RPW, r1 = (r0 + RPW < MTOT) ? r0 + RPW : MTOT;
        int curb = -1; f32x4 PA[4], PB[4];
        for (int m0 = r0; m0 < r1; m0 += 4) {
            f32x4 v[4][4];
#pragma unroll
            for (int u = 0; u < 4; ++u) { const int m = m0 + u; if (m < r1) {
                const float* xrow = (m < MROWS) ? F.in[0] + (size_t)m * DM : F.in[2] + (size_t)(m - MROWS) * DM; const GAS f32x4* xr = (const GAS f32x4*)xrow + f_lane;
#pragma unroll
                for (int j = 0; j < 4; ++j) v[u][j] = __builtin_nontemporal_load(xr + 64 * j); } }
#pragma unroll
            for (int u = 0; u < 4; ++u) { const int m = m0 + u; if (m < r1) {
                const int mb = (m < MROWS) ? (m >> 12) : 8;
                if (mb != curb) { curb = mb; const float* sh = mod + (size_t)mb * (NMOD * DM); const float* sc = sh + DM;
#pragma unroll
                    for (int j = 0; j < 4; ++j) { const int c = 4 * f_lane + 256 * j; PA[j] = *(const f32x4*)(g1 + c) * (*(const f32x4*)(sc + c) + 1.f); PB[j] = *(const f32x4*)(sh + c); } }
                float s = 0.f;
#pragma unroll
                for (int j = 0; j < 4; ++j) s += (v[u][j].x * v[u][j].x + v[u][j].y * v[u][j].y) + (v[u][j].z * v[u][j].z + v[u][j].w * v[u][j].w);
                const float rstd = rsqrtf(wave_sum(s) * (1.f / DM) + EPS);
                GAS u32x2* o8 = (GAS u32x2*)(H + (size_t)m * DM) + f_lane;
#pragma unroll
                for (int j = 0; j < 4; ++j) { const f32x4 y = v[u][j] * rstd * PA[j] + PB[j];
                    u32x2 w; w.x = cvt_pk_bf16(y.x, y.y); w.y = cvt_pk_bf16(y.z, y.w); o8[64 * j] = w; } } }
        }
    }
}

struct SchedInProj {
    int G, c; const char* H; const char* W;
    static constexpr int NA = 136 * 4, NV = 2 * 136, NBU = 6 * 128;
    __device__ __forceinline__ bool next(int i, g8::Unit& u) const {
        const long L = (long)i * G + c;
        if (L < NA) { g8::tile_of((int)L, 136, 4, u.pm, u.pn); u.a = H + (size_t)u.pm * 256 * DM * 2; u.b = W + (size_t)u.pn * 256 * DM * 2; u.kind = 0; u.ex = 0; return true; }
        if (L < NA + NV) { g8::tile_of((int)L - NA, 2, 136, u.pm, u.pn); u.a = W + (size_t)(1024 + u.pm * 256) * DM * 2; u.b = H + (size_t)u.pn * 256 * DM * 2; u.kind = 2; u.ex = 0; return true; }
        if (L < NA + NV + NBU) { g8::tile_of((int)L - NA - NV, 6, 128, u.pm, u.pn); u.a = W + (size_t)(QKVC + u.pm * 256) * DM * 2; u.b = H + (size_t)u.pn * 256 * DM * 2; u.kind = 1; u.ex = 0; return true; }
        return false;
    }
};
constexpr float Q8SCALE = 16.f;
struct EpiInProj {
    unsigned char *Q8, *K8, *VT8; bf16_t* UT; const float *gq, *gk, *rope;
    __device__ __forceinline__ void operator()(f32x4 (&acc)[2][2][4][2], const g8::Unit& u, int wr, int wc, int fr, int fq) const {
        asm volatile("" : "+v"(fr), "+v"(fq));
        if (u.kind == 1) {
            const int row0 = u.pm * 256 + wr * 64 + fr, col0 = u.pn * 256 + wc * 32 + 8 * fq;
#pragma unroll
            for (int ai = 0; ai < 2; ++ai)
#pragma unroll
                for (int m = 0; m < 4; ++m) { const int ch = row0 + ai * 128 + m * 16;
#pragma unroll
                    for (int bj = 0; bj < 2; ++bj) { const int tok = col0 + bj * 128; const f32x4 v0 = acc[ai][bj][m][0], v1 = acc[ai][bj][m][1];
                        u32x4 w; w.x = cvt_pk_bf16(v0[0], v0[1]); w.y = cvt_pk_bf16(v0[2], v0[3]); w.z = cvt_pk_bf16(v1[0], v1[1]); w.w = cvt_pk_bf16(v1[2], v1[3]);
                        *(u32x4*)(UT + ((size_t)(tok >> 7) * HYC + ch) * 128 + (tok & 127)) = w; } }
            return;
        }
        if (u.kind == 2) {
#pragma unroll
            for (int bj = 0; bj < 2; ++bj) { const int t8 = u.pn * 256 + bj * 128 + wc * 32 + 8 * fq;
                int b, key; if (t8 < MROWS) { b = t8 >> 12; key = CTXL + (t8 & 4095); } else { const int j = t8 - MROWS; b = j >> 8; key = j & 255; }
                const int tile = key >> 6, k = key & 63, ipos = (k < 32) ? 4 * (k >> 3) : 16 + 4 * ((k - 32) >> 3);
#pragma unroll
                for (int ai = 0; ai < 2; ++ai)
#pragma unroll
                    for (int m = 0; m < 4; ++m) { const int ch = u.pm * 256 + ai * 128 + wr * 64 + m * 16 + fr;
                        unsigned char* dst = VT8 + ((((size_t)(b * NHEAD + (ch >> 7)) * 68 + tile) * 128 + (ch & 127)) * 64) + ipos;
                        const f32x4 v0 = acc[ai][bj][m][0], v1 = acc[ai][bj][m][1];
                        *(unsigned*)dst = pk4_fp8(v0[0], v0[1], v0[2], v0[3]); *(unsigned*)(dst + 32) = pk4_fp8(v1[0], v1[1], v1[2], v1[3]); } }
            return;
        }
        const int blk = fq >> 1, f = fq & 1;
        const int sec = u.pn >> 1;
        const bool ctx = (u.pm >= 128);
        if (sec == 0 && ctx) return;
        const int colbase = (u.pn & 1) * 256 + wc * 64 + 32 * blk + 8 * f;
        float gg[2][2][4];
        { const float* gp = (sec == 0 ? gq : gk) + 32 * blk + 8 * f;
#pragma unroll
            for (int bj = 0; bj < 2; ++bj)
#pragma unroll
                for (int n = 0; n < 2; ++n) { const f32x4 t = *(const f32x4*)(gp + 16 * bj + 4 * n); gg[bj][n][0] = t[0]; gg[bj][n][1] = t[1]; gg[bj][n][2] = t[2]; gg[bj][n][3] = t[3]; } }
#pragma unroll
        for (int ai = 0; ai < 2; ++ai)
#pragma unroll
            for (int m = 0; m < 4; ++m) {
                const int rloc = ai * 128 + wr * 64 + m * 16 + fr; const int r = u.pm * 256 + rloc;
                f32x4 v[2][2];
#pragma unroll
                for (int bj = 0; bj < 2; ++bj)
#pragma unroll
                    for (int n = 0; n < 2; ++n) v[bj][n] = acc[ai][bj][m][n];
                size_t orow;
                if (sec == 0) orow = (size_t)r;
                else if (!ctx) orow = (size_t)(r >> 12) * KVL + CTXL + (r & 4095);
                else { const int j = r - MROWS; orow = (size_t)(j >> 8) * KVL + (j & 255); }
                float ss = 0.f;
#pragma unroll
                for (int bj = 0; bj < 2; ++bj)
#pragma unroll
                    for (int n = 0; n < 2; ++n) ss += (v[bj][n][0] * v[bj][n][0] + v[bj][n][1] * v[bj][n][1]) + (v[bj][n][2] * v[bj][n][2] + v[bj][n][3] * v[bj][n][3]);
                ss += __shfl_xor(ss, 16); ss += __shfl_xor(ss, 32);
                const float rstd = rsqrtf(ss * (1.f / 64.f) + EPS) * (sec == 0 ? QSCALE * Q8SCALE : 1.f);
#pragma unroll
                for (int bj = 0; bj < 2; ++bj)
#pragma unroll
                    for (int n = 0; n < 2; ++n)
#pragma unroll
                        for (int e = 0; e < 4; ++e) v[bj][n][e] *= rstd * gg[bj][n][e];
                if (!ctx) {
                    const int t = r & 4095; const int pos = blk ? (t & 63) : (t >> 6);
                    const float* rp = rope + (size_t)(pos * 16 + 8 * f) * 2;
#pragma unroll
                    for (int n = 0; n < 2; ++n) { const f32x4 c0 = *(const f32x4*)(rp + 8 * n), c1 = *(const f32x4*)(rp + 8 * n + 4);
                        const float cs[4] = {c0[0], c0[2], c1[0], c1[2]}, sn[4] = {c0[1], c0[3], c1[1], c1[3]};
#pragma unroll
                        for (int e = 0; e < 4; ++e) { const float x1 = v[0][n][e], x2 = v[1][n][e]; v[0][n][e] = x1 * cs[e] - x2 * sn[e]; v[1][n][e] = x2 * cs[e] + x1 * sn[e]; } }
                }
                unsigned char* dst = (sec == 0 ? Q8 : K8) + orow * QKW + colbase;
#pragma unroll
                for (int bj = 0; bj < 2; ++bj) { u32x2 w; w.x = pk4_fp8(v[bj][0][0], v[bj][0][1], v[bj][0][2], v[bj][0][3]); w.y = pk4_fp8(v[bj][1][0], v[bj][1][1], v[bj][1][2], v[bj][1][3]);
                    *(u32x2*)(dst + 16 * bj) = w; }
            }
    }
};

struct SchedStatic {
    int G, c, nM, nN; const char* A; const char* B;
    __device__ __forceinline__ bool next(int i, g8::Unit& u) const {
        const long L = (long)i * G + c; if (L >= (long)nM * nN) return false;
        g8::tile_of((int)L, nM, nN, u.pm, u.pn); u.a = A + (size_t)u.pm * 256 * DM * 2; u.b = B + (size_t)u.pn * 256 * DM * 2; u.kind = 0; u.ex = 0; return true;
    }
};
struct EpiOutProj {
    const float* x; bf16_t* out; const float* mod;
    __device__ __forceinline__ void operator()(f32x4 (&acc)[2][2][4][2], const g8::Unit& u, int wr, int wc, int fr, int fq) const {
        asm volatile("" : "+v"(fr), "+v"(fq));
        const int col0 = u.pn * 256 + wc * 32 + 8 * fq;
        const float* g1 = mod + (size_t)((u.pm * 256) >> 12) * (NMOD * DM) + 2 * DM + col0;
        f32x4 gv[2][2];
#pragma unroll
        for (int bj = 0; bj < 2; ++bj)
#pragma unroll
            for (int n = 0; n < 2; ++n) gv[bj][n] = *(const f32x4*)(g1 + bj * 128 + 4 * n);
#pragma unroll
        for (int ai = 0; ai < 2; ++ai)
#pragma unroll
            for (int m = 0; m < 4; ++m) { const int r = u.pm * 256 + ai * 128 + wr * 64 + m * 16 + fr;
                const size_t off = (size_t)r * DM + col0;
#pragma unroll
                for (int bj = 0; bj < 2; ++bj) { f32x4 o[2];
#pragma unroll
                    for (int n = 0; n < 2; ++n) { const f32x4 xv = __builtin_nontemporal_load((const f32x4*)(x + off + bj * 128 + 4 * n)); o[n] = xv + gv[bj][n] * acc[ai][bj][m][n]; }
                    u32x4 w; w.x = cvt_pk_bf16(o[0][0], o[0][1]); w.y = cvt_pk_bf16(o[0][2], o[0][3]); w.z = cvt_pk_bf16(o[1][0], o[1][1]); w.w = cvt_pk_bf16(o[1][2], o[1][3]);
                    *(u32x4*)(out + off + bj * 128) = w; } }
    }
};

namespace att8 {
constexpr int NT = KVL / 64, SHMB = 8192, NBUF = 6, LDS_V0 = NBUF * SHMB;
typedef int i32x8 __attribute__((ext_vector_type(8)));
#define SBAR() __builtin_amdgcn_sched_barrier(0)
__device__ __forceinline__ int crow(int r, int hi) { return (r & 3) + 8 * (r >> 2) + 4 * hi; }
__device__ __forceinline__ i32x8 ld32(const LAS unsigned char* p0, const LAS unsigned char* p1) {
    const u32x4 a = *(const LAS u32x4*)p0, b = *(const LAS u32x4*)p1; return (i32x8){(int)a.x, (int)a.y, (int)a.z, (int)a.w, (int)b.x, (int)b.y, (int)b.z, (int)b.w}; }
__device__ __forceinline__ void mfma_qk(f32x16& p, const i32x8& kf, const i32x8& qf, const f32x16& negc) {
    const unsigned s1 = 0x7f7f7f7fu, sq = 0x7b7b7b7bu;
    asm volatile("v_mfma_scale_f32_32x32x64_f8f6f4 %0, %1, %2, %3, %4, %5 op_sel_hi:[0,0,0]" : "=&v"(p) : "v"(kf), "v"(qf), "v"(negc), "v"(s1), "v"(sq));
}
__device__ __forceinline__ void mfma_pv(f32x16& o, const i32x8& pa, const i32x8& vf) {
    const unsigned s1 = 0x7f7f7f7fu;
    asm volatile("v_mfma_scale_f32_32x32x64_f8f6f4 %0, %1, %2, %0, %3, %3 op_sel_hi:[0,0,0]" : "+v"(o) : "v"(pa), "v"(vf), "v"(s1));
}
__device__ __forceinline__ void mfma_wait(f32x16& p0, f32x16& p1) { asm volatile("s_nop 15\n\ts_nop 3" : "+v"(p0), "+v"(p1)); }
__device__ __forceinline__ int grp(const f32x16& s, const int g, int old) {
    old = __builtin_amdgcn_cvt_pk_fp8_f32(__builtin_amdgcn_exp2f(s[4 * g]), __builtin_amdgcn_exp2f(s[4 * g + 1]), old, false);
    return __builtin_amdgcn_cvt_pk_fp8_f32(__builtin_amdgcn_exp2f(s[4 * g + 2]), __builtin_amdgcn_exp2f(s[4 * g + 3]), old, true);
}
__device__ __forceinline__ void attn_unit(const unsigned char* __restrict__ Qb, const unsigned char* __restrict__ Kh, const unsigned char* __restrict__ VTh, bf16_t* MIXo,
                                          const float lam, const float* __restrict__ subg, char* lds, const int wid,
                                          const bool pre, i32x8& qf, const unsigned char* Qn, const unsigned char* Kn, const unsigned char* VTn) {
    const int lane = lane_id(), tid = wid * 64 + lane, r32 = lane & 31, hi = lane >> 5;
    const int sub = wid >> 2, wq = wid & 3;
    const LAS unsigned char* L = (const LAS unsigned char*)(uintptr_t)(unsigned)(uintptr_t)lds;
    f32x16 o[4] = {}; f32x16 ol = {};
    i32x8 ones; { int c1 = 0x38383838; asm volatile("" : "+v"(c1)); ones = (i32x8){c1, c1, c1, c1, c1, c1, c1, c1}; }
    const size_t qoff = (size_t)(wq * 32 + r32) * QKW + sub * 64 + 32 * hi;
    if (!pre) { const unsigned char* qp = Qb + qoff; const u32x4 a = *(const u32x4*)qp, b = *(const u32x4*)(qp + 16);
        qf = (i32x8){(int)a.x, (int)a.y, (int)a.z, (int)a.w, (int)b.x, (int)b.y, (int)b.z, (int)b.w}; }
    f32x16 negc; { float m5 = -5.f; asm volatile("" : "+v"(m5));
#pragma unroll
        for (int r = 0; r < 16; ++r) negc[r] = m5; }
    long ksrc, vsrc;
    { const int r = 8 * wid + (lane >> 3), c = (lane & 7) ^ ((r >> 1) & 7); ksrc = (long)r * QKW + c * 16; }
    { const int d = 16 * wid + (lane >> 2), c = (lane & 3) ^ ((d >> 2) & 3); vsrc = (long)d * 64 + c * 16; }
    const unsigned ldsb = (unsigned)(uintptr_t)lds, kdst = ldsb + (unsigned)wid * 1024u, vdst = ldsb + LDS_V0 + (unsigned)wid * 1024u;
    const LAS unsigned char *pk0, *pk1, *pv0, *pv1;
    { const int c0 = sub * 4 + hi * 2, sk = (r32 >> 1) & 7, sv = (r32 >> 2) & 3;
      pk0 = L + r32 * 128 + ((c0 ^ sk) << 4); pk1 = L + r32 * 128 + (((c0 + 1) ^ sk) << 4);
      pv0 = L + LDS_V0 + r32 * 64 + (((2 * hi) ^ sv) << 4); pv1 = L + LDS_V0 + r32 * 64 + (((2 * hi + 1) ^ sv) << 4); }
#define KF(b, w) ld32(pk0 + (b) * SHMB + (w) * 4096, pk1 + (b) * SHMB + (w) * 4096)
#define VF(b, d0) ld32(pv0 + (b) * SHMB + (d0) * 2048, pv1 + (b) * SHMB + (d0) * 2048)
#define DMA_TILE(t, b) DMA_TILE_P(Kh, VTh, t, b)
#define DMA_TILE_P(KP, VP, t, b) do { \
        __builtin_amdgcn_global_load_lds((const unsigned*)((KP) + (long)(t) * 64 * QKW + ksrc), (LAS unsigned*)(uintptr_t)__builtin_amdgcn_readfirstlane(kdst + (unsigned)((b) * SHMB)), 16, 0, 0); \
        __builtin_amdgcn_global_load_lds((const unsigned*)((VP) + (long)(t) * 8192 + vsrc), (LAS unsigned*)(uintptr_t)__builtin_amdgcn_readfirstlane(vdst + (unsigned)((b) * SHMB)), 16, 0, 0); } while (0)
#define WBAR() do { asm volatile("s_waitcnt vmcnt(0)" ::: "memory"); __builtin_amdgcn_s_barrier(); asm volatile("" ::: "memory"); } while (0)
#define ITER(J, U, SX0, SX1, SY0, SY1, PC, PN, DO_DMA, DO_QK, DO_BAR) do { \
        mfma_pv(ol, PC, ones); SBAR(); \
        if (DO_DMA) { if ((J) + 3 < NT) DMA_TILE((J) + 3, ((U) + 4) % NBUF); if ((J) + 4 < NT) DMA_TILE((J) + 4, ((U) + 5) % NBUF); } \
        PN[0] = grp(SX0, 0, PN[0]); SBAR(); \
        mfma_pv(o[0], PC, vf0); SBAR(); \
        vf3 = VF(U, 3); if (DO_QK) { kf0 = KF(((U) + 2) % NBUF, 0); kf1 = KF(((U) + 2) % NBUF, 1); } \
        PN[1] = grp(SX0, 1, PN[1]); SBAR(); \
        mfma_pv(o[1], PC, vf1); SBAR(); PN[2] = grp(SX0, 2, PN[2]); SBAR(); \
        mfma_pv(o[2], PC, vf2); SBAR(); PN[3] = grp(SX0, 3, PN[3]); SBAR(); \
        mfma_pv(o[3], PC, vf3); SBAR(); PN[4] = grp(SX1, 0, PN[4]); SBAR(); \
        if (DO_QK) mfma_qk(SY0, kf0, qf, negc); SBAR(); PN[5] = grp(SX1, 1, PN[5]); SBAR(); \
        if (DO_QK) mfma_qk(SY1, kf1, qf, negc); SBAR(); PN[6] = grp(SX1, 2, PN[6]); PN[7] = grp(SX1, 3, PN[7]); \
        vf0 = VF(((U) + 1) % NBUF, 0); vf1 = VF(((U) + 1) % NBUF, 1); vf2 = VF(((U) + 1) % NBUF, 2); SBAR(); \
        if (DO_BAR) WBAR(); } while (0)
    f32x16 A0, A1, B0, B1; i32x8 paA = {}, paB = {}, kf0, kf1, vf0, vf1, vf2, vf3;
    if (!pre) { DMA_TILE(0, 0); DMA_TILE(1, 1); DMA_TILE(2, 2); DMA_TILE(3, 3); }
    WBAR();
    kf0 = KF(0, 0); kf1 = KF(0, 1); mfma_qk(A0, kf0, qf, negc); mfma_qk(A1, kf1, qf, negc);
    kf0 = KF(1, 0); kf1 = KF(1, 1); SBAR(); mfma_qk(B0, kf0, qf, negc); mfma_qk(B1, kf1, qf, negc);
    mfma_wait(A0, A1);
#pragma unroll
    for (int g = 0; g < 4; ++g) { paA[g] = grp(A0, g, paA[g]); paA[4 + g] = grp(A1, g, paA[4 + g]); }
    mfma_wait(B0, B1);
    vf0 = VF(0, 0); vf1 = VF(0, 1); vf2 = VF(0, 2); SBAR();
    static_assert(NT == 68, "the loop below (11 trips of 6 iterations, then iteration 67) is written for 68 KV tiles");
#pragma unroll 1
    for (int j = 1; j < NT - 2; j += 6) {
        ITER(j, 0, B0, B1, A0, A1, paA, paB, true, true, false);
        ITER(j + 1, 1, A0, A1, B0, B1, paB, paA, false, true, true);
        ITER(j + 2, 2, B0, B1, A0, A1, paA, paB, true, true, false);
        ITER(j + 3, 3, A0, A1, B0, B1, paB, paA, false, true, true);
        ITER(j + 4, 4, B0, B1, A0, A1, paA, paB, true, true, false);
        ITER(j + 5, 5, A0, A1, B0, B1, paB, paA, false, true, true);
    }
    ITER(67, 0, B0, B1, A0, A1, paA, paB, false, false, false);
    mfma_pv(ol, paB, ones); vf3 = VF(1, 3); SBAR();
    mfma_pv(o[0], paB, vf0); mfma_pv(o[1], paB, vf1); mfma_pv(o[2], paB, vf2); mfma_pv(o[3], paB, vf3);
    asm volatile("s_nop 15\n\ts_nop 3" : "+v"(o[0]), "+v"(o[1]), "+v"(o[2]), "+v"(o[3]), "+v"(ol));
#undef ITER
#undef KF
#undef VF
    float sg[4];
#pragma unroll
    for (int d0 = 0; d0 < 4; ++d0) sg[d0] = subg[d0 * 32 + r32] * (1.f - LAM_INIT);
    __syncthreads();
    if (Qn != nullptr) { const unsigned char* qp = Qn + qoff; const u32x4 a = *(const u32x4*)qp, b = *(const u32x4*)(qp + 16);
        qf = (i32x8){(int)a.x, (int)a.y, (int)a.z, (int)a.w, (int)b.x, (int)b.y, (int)b.z, (int)b.w};
        DMA_TILE_P(Kn, VTn, 0, 0); DMA_TILE_P(Kn, VTn, 1, 1); DMA_TILE_P(Kn, VTn, 2, 2); DMA_TILE_P(Kn, VTn, 3, 3); }
#define XOFF(q) ((q) == 0 ? 4 * SHMB : (q) == 1 ? LDS_V0 + 4 * SHMB : LDS_V0 + NBUF * SHMB + ((q) - 2) * 16384)
    float* X = (float*)(lds + XOFF(wq));
    float rli[16];
#pragma unroll
    for (int r = 0; r < 16; ++r) rli[r] = __builtin_amdgcn_rcpf(ol[r]);
    if (sub == 1) {
#pragma unroll
        for (int r = 0; r < 16; ++r) { const int row = crow(r, hi); const float sc = lam * rli[r];
#pragma unroll
            for (int d0 = 0; d0 < 4; ++d0) X[row * 128 + d0 * 32 + r32] = o[d0][r] * sc; }
    }
    __syncthreads();
    if (sub == 0) {
        bf16_t* Y = (bf16_t*)X;
#pragma unroll
        for (int r = 0; r < 16; ++r) { const int row = crow(r, hi);
            float v[4]; float ss = 0.f;
#pragma unroll
            for (int d0 = 0; d0 < 4; ++d0) { v[d0] = o[d0][r] * rli[r] - X[row * 128 + d0 * 32 + r32]; ss += v[d0] * v[d0]; }
            ss += __shfl_xor(ss, 1); ss += __shfl_xor(ss, 2); ss += __shfl_xor(ss, 4); ss += __shfl_xor(ss, 8); ss += __shfl_xor(ss, 16);
            const float rstd = rsqrtf(ss * (1.f / 128.f) + EPS);
            asm volatile("" ::: "memory");
#pragma unroll
            for (int d0 = 0; d0 < 4; ++d0) Y[row * 256 + d0 * 32 + r32] = (bf16_t)(cvt_pk_bf16(v[d0] * rstd * sg[d0], 0.f) & 0xffffu); }
    }
    __syncthreads();
    { const int row = tid >> 2, seg = (tid & 3) * 32, qr = row >> 5; const bf16_t* Yr = (const bf16_t*)(lds + XOFF(qr)) + (row & 31) * 256 + seg;
#pragma unroll
        for (int i = 0; i < 4; ++i) { const u32x4 v = *(const u32x4*)(Yr + i * 8); *(u32x4*)(MIXo + (size_t)row * DM + seg + i * 8) = v; } }
    __syncthreads();
#undef XOFF
#undef DMA_TILE
#undef DMA_TILE_P
#undef WBAR
}
#undef SBAR
}

__device__ __forceinline__ void p3_attention8(Frame& F) {
    FT_DECL;
    const float* sc = WSP(float, WS_SMALL + SM_SCAL);
    const float lam = sc[0];
    const unsigned char* Q8 = WSP(unsigned char, WS_Q); const unsigned char* K8 = WSP(unsigned char, WS_K); const unsigned char* VT8 = WSP(unsigned char, WS_V); bf16_t* MIX = WSP(bf16_t, WS_MIX);
    const int c = blockIdx.x, xcd = c & 7, ci = c >> 3, per = F.G >> 3;
    att8::i32x8 qf = {}; bool pre = false;
    for (int j = ci; j < 128; j += per) {
        const int pair = xcd * 4 + (j >> 5), qb = j & 31, b = pair >> 2, h = pair & 3;
        const int jn = j + per; const bool hn = jn < 128; const int pairn = xcd * 4 + (jn >> 5), qbn = jn & 31, bn = pairn >> 2, hn4 = pairn & 3;
        att8::attn_unit(Q8 + ((size_t)b * SEQ + qb * 128) * QKW + h * 128, K8 + (size_t)b * KVL * QKW + h * 128, VT8 + (size_t)(b * NHEAD + h) * 68 * 8192,
                        MIX + ((size_t)b * SEQ + qb * 128) * DM + h * 128, lam, F.in[15], (char*)F.lds, F.wave, pre, qf,
                        hn ? Q8 + ((size_t)bn * SEQ + qbn * 128) * QKW + hn4 * 128 : nullptr, hn ? K8 + (size_t)bn * KVL * QKW + hn4 * 128 : nullptr,
                        hn ? VT8 + (size_t)(bn * NHEAD + hn4) * 68 * 8192 : nullptr);
        pre = hn;
    }
}

namespace hy {
constexpr int RB_BYTES = 4352 * 8, IN_OFF = 2 * RB_BYTES, TW1_OFF = IN_OFF + 32768, TW2_OFF = TW1_OFF + 15 * 256 * 8, LDS_END = TW2_OFF + 15 * 16 * 8;
__device__ __forceinline__ f32x2 cmul(f32x2 a, f32x2 b) { return (f32x2){a.x * b.x - a.y * b.y, a.x * b.y + a.y * b.x}; }
__device__ __forceinline__ f32x2 cmulc(f32x2 a, f32x2 b) { return (f32x2){a.x * b.x + a.y * b.y, a.y * b.x - a.x * b.y}; }
__device__ __forceinline__ int P(int i) { return i + (i >> 4); }
template <bool INV> __device__ __forceinline__ void r4(f32x2& a, f32x2& b, f32x2& c, f32x2& d) {
    const f32x2 t0 = a + c, t1 = a - c, t2 = b + d, t3 = b - d;
    const f32x2 st3 = INV ? (f32x2){-t3.y, t3.x} : (f32x2){t3.y, -t3.x};
    a = t0 + t2; c = t0 - t2; b = t1 + st3; d = t1 - st3;
}
template <bool INV> __device__ __forceinline__ f32x2 tw(f32x2 v, float c, float s) {
    return INV ? (f32x2){v.x * c - v.y * s, v.y * c + v.x * s} : (f32x2){v.x * c + v.y * s, v.y * c - v.x * s};
}
template <bool INV> __device__ __forceinline__ void dft16(f32x2 (&v)[16]) {
    constexpr float C1 = 0.9238795325112867f, S1 = 0.3826834323650898f, R2 = 0.7071067811865476f;
    r4<INV>(v[0], v[4], v[8], v[12]); r4<INV>(v[1], v[5], v[9], v[13]); r4<INV>(v[2], v[6], v[10], v[14]); r4<INV>(v[3], v[7], v[11], v[15]);
    v[5] = tw<INV>(v[5], C1, S1);  v[9] = tw<INV>(v[9], R2, R2);    v[13] = tw<INV>(v[13], S1, C1);
    v[6] = tw<INV>(v[6], R2, R2);  v[10] = tw<INV>(v[10], 0.f, 1.f); v[14] = tw<INV>(v[14], -R2, R2);
    v[7] = tw<INV>(v[7], S1, C1);  v[11] = tw<INV>(v[11], -R2, R2);  v[15] = tw<INV>(v[15], -C1, -S1);
    r4<INV>(v[0], v[1], v[2], v[3]); r4<INV>(v[4], v[5], v[6], v[7]); r4<INV>(v[8], v[9], v[10], v[11]); r4<INV>(v[12], v[13], v[14], v[15]);
    f32x2 t;
    t = v[1]; v[1] = v[4]; v[4] = t;   t = v[2]; v[2] = v[8]; v[8] = t;    t = v[3]; v[3] = v[12]; v[12] = t;
    t = v[6]; v[6] = v[9]; v[9] = t;   t = v[7]; v[7] = v[13]; v[13] = t;  t = v[11]; v[11] = v[14]; v[14] = t;
}
struct Ctx { LAS f32x2* R; LAS f32x2* IN; LAS f32x2* TW1; LAS f32x2* TW2; int t, half; f32x2 wt; };
#define HY_OPAQUE(x) asm volatile("" : "+v"(x))
#define HY_W32(m) (f32x2){__builtin_cosf(-0.19634954084936207f * (m)), __builtin_sinf(-0.19634954084936207f * (m))}
template <int MODE> __device__ __forceinline__ void pass1_fwd(const Ctx& X) {
    f32x2 v[16]; int t = X.t; HY_OPAQUE(t);
#pragma unroll
    for (int m = 0; m < 16; ++m) { f32x2 a = X.IN[t + 256 * m]; if (MODE == 1) a = (f32x2){X.half ? a.y : a.x, 0.f}; v[m] = a; }
    if (X.half) {
#pragma unroll
        for (int m = 0; m < 16; ++m) v[m] = cmul(cmul(v[m], HY_W32(m)), X.wt);
    }
    dft16<false>(v);
#pragma unroll
    for (int q = 1; q < 16; ++q) v[q] = cmul(v[q], X.TW1[(q - 1) * 256 + t]);
    const int pb = t + (t >> 4);
#pragma unroll
    for (int q = 0; q < 16; ++q) X.R[pb + 272 * q] = v[q];
}
__device__ __forceinline__ void pass2_fwd(const Ctx& X) {
    int t = X.t; HY_OPAQUE(t);
    const int n2 = t & 15, pb = (t >> 4) * 272 + n2; f32x2 v[16];
#pragma unroll
    for (int m = 0; m < 16; ++m) v[m] = X.R[pb + 17 * m];
    dft16<false>(v);
#pragma unroll
    for (int q = 1; q < 16; ++q) v[q] = cmul(v[q], X.TW2[(q - 1) * 16 + n2]);
#pragma unroll
    for (int q = 0; q < 16; ++q) X.R[pb + 17 * q] = v[q];
}
template <bool FILTER> __device__ __forceinline__ void pass3(const Ctx& X, f32x2 (&H)[16]) {
    f32x2 v[16]; int t = X.t; HY_OPAQUE(t); const int pb = 17 * t;
#pragma unroll
    for (int m = 0; m < 16; ++m) v[m] = X.R[pb + m];
    dft16<false>(v);
    if (FILTER) {
#pragma unroll
        for (int q = 0; q < 16; ++q) H[q] = v[q] * (1.f / 8192.f);
    } else {
#pragma unroll
        for (int q = 0; q < 16; ++q) v[q] = cmul(v[q], H[q]);
        dft16<true>(v);
#pragma unroll
        for (int m = 0; m < 16; ++m) X.R[pb + m] = v[m];
    }
}
__device__ __forceinline__ void pass2_inv(const Ctx& X) {
    int t = X.t; HY_OPAQUE(t);
    const int n2 = t & 15, pb = (t >> 4) * 272 + n2; f32x2 v[16];
    v[0] = X.R[pb];
#pragma unroll
    for (int q = 1; q < 16; ++q) v[q] = cmulc(X.R[pb + 17 * q], X.TW2[(q - 1) * 16 + n2]);
    dft16<true>(v);
#pragma unroll
    for (int m = 0; m < 16; ++m) X.R[pb + 17 * m] = v[m];
}
__device__ __forceinline__ void pass1_inv(const Ctx& X) {
    f32x2 v[16]; int t = X.t; HY_OPAQUE(t); const int pb = t + (t >> 4);
    v[0] = X.R[pb];
#pragma unroll
    for (int q = 1; q < 16; ++q) v[q] = cmulc(X.R[pb + 272 * q], X.TW1[(q - 1) * 256 + t]);
    dft16<true>(v);
    if (X.half) {
#pragma unroll
        for (int m = 0; m < 16; ++m) v[m] = cmulc(cmulc(v[m], HY_W32(m)), X.wt);
    }
#pragma unroll
    for (int m = 0; m < 16; ++m) X.R[pb + 272 * m] = v[m];
}
#define HY_WSYNC() asm volatile("s_waitcnt lgkmcnt(0)" ::: "memory")
__device__ __forceinline__ void conv_fft(const Ctx& X, f32x2 (&H)[16]) {
    __syncthreads(); pass1_fwd<0>(X); __syncthreads(); pass2_fwd(X); HY_WSYNC(); pass3<false>(X, H); HY_WSYNC(); pass2_inv(X); __syncthreads(); pass1_inv(X); __syncthreads();
}
constexpr int STG_OFF = LDS_END;
constexpr int LDS_END2 = STG_OFF + 2 * SEQ * 2;
static_assert(LDS_END2 <= LDSCTL_OFF, "hyena LDS map");
__device__ __forceinline__ float sconv_lds(const LAS bf16_t* stg, int bs, int n, float w0, float w1, float w2, float bias) {
    const LAS bf16_t* p = stg + bs * SEQ;
    const float c = bf2f(p[n]), lv = bf2f(p[n - ((n > 0) ? 1 : 0)]), rv = bf2f(p[n + ((n < SEQ - 1) ? 1 : 0)]);
    const float l = (n > 0) ? lv : 0.f, r = (n < SEQ - 1) ? rv : 0.f;
    return bias + w0 * l + w1 * c + w2 * r;
}
__device__ __forceinline__ void setup_tables(LAS unsigned char* lds, int tid) {
    LAS f32x2* TW1 = (LAS f32x2*)(lds + TW1_OFF); LAS f32x2* TW2 = (LAS f32x2*)(lds + TW2_OFF);
    for (int i = tid; i < 15 * 256; i += 512) { const int q = i / 256 + 1, t = i & 255; float s, c; sincosf(-6.283185307179586f * (float)((t * q) & 4095) * (1.f / 4096.f), &s, &c); TW1[i] = (f32x2){c, s}; }
    for (int i = tid; i < 15 * 16; i += 512) { const int q = i / 16 + 1, n2 = i & 15; float s, c; sincosf(-6.283185307179586f * (float)((n2 * q) & 255) * (1.f / 256.f), &s, &c); TW2[i] = (f32x2){c, s}; }
}
__device__ __forceinline__ void unit(Frame& F, int c) {
    FT_DECL;
    const int tid = f_tid; Ctx X; X.half = F.wave >> 2; X.t = tid & 255;
    X.R = (LAS f32x2*)(F.lds + X.half * RB_BYTES); X.IN = (LAS f32x2*)(F.lds + IN_OFF); X.TW1 = (LAS f32x2*)(F.lds + TW1_OFF); X.TW2 = (LAS f32x2*)(F.lds + TW2_OFF);
    { float s, cc; sincosf(-6.283185307179586f * (float)X.t * (1.f / 8192.f), &s, &cc); X.wt = (f32x2){cc, s}; }
    LAS f32x2* RB0 = (LAS f32x2*)(F.lds); LAS f32x2* RB1 = (LAS f32x2*)(F.lds + RB_BYTES);
    const float* FILT = WSP(float, WS_FILT);
    f32x2 H0[16], H1[16];
#pragma unroll
    for (int ord = 0; ord < 2; ++ord) {
        const float* hf = FILT + ((size_t)(ord * 2 + 0) * 512 + c) * SEQ; const float* hb = FILT + ((size_t)(ord * 2 + 1) * 512 + c) * SEQ;
        __syncthreads();
        int nb = tid; HY_OPAQUE(nb);
#pragma unroll
        for (int j = 0; j < 8; ++j) { const int n = nb + 512 * j; const float a = hf[n], b = hb[(SEQ - n) & (SEQ - 1)]; const float lo = (n == 0) ? a + b : a, hi = (n == 0) ? 0.f : b; X.IN[n] = (f32x2){lo + hi, lo - hi}; }
        __syncthreads(); pass1_fwd<1>(X); __syncthreads(); pass2_fwd(X); HY_WSYNC();
        if (ord == 0) pass3<true>(X, H0); else pass3<true>(X, H1);
    }
    const bf16_t* UT = WSP(bf16_t, WS_UT);
    const bf16_t* rv = UT + (size_t)c * 128; const bf16_t* r1 = UT + (size_t)(512 + c) * 128; const bf16_t* r2 = UT + (size_t)(1024 + c) * 128;
#define HY_LD(rowp, t) (*(const u32x4*)((rowp) + (size_t)((t) >> 7) * (HYC * 128) + ((t) & 127)))
    const float* cw = F.in[16]; const float* cb = F.in[17];
    const float wv0 = cw[c], wv1 = cw[HYC + c], wv2 = cw[2 * HYC + c], bv = cb[c];
    const float wa0 = cw[512 + c], wa1 = cw[HYC + 512 + c], wa2 = cw[2 * HYC + 512 + c], ba = cb[512 + c];
    const float wb0 = cw[1024 + c], wb1 = cw[HYC + 1024 + c], wb2 = cw[2 * HYC + 1024 + c], bb = cb[1024 + c];
    const float sk0 = F.in[25][c], sk1 = F.in[25][512 + c];
    bf16_t* Z = WSP(bf16_t, WS_Z2T) + (size_t)c * 128;
    LAS bf16_t* STG = (LAS bf16_t*)(F.lds + STG_OFF);
    u32x4 g0 = HY_LD(rv, tid * 8), g1 = HY_LD(rv, SEQ + tid * 8);
    for (int pr = 0; pr < 4; ++pr) {
        const int b0 = 2 * pr, b1 = b0 + 1;
        f32x2 z[8]; int pc = tid + (tid >> 4); HY_OPAQUE(pc); int nb = tid; HY_OPAQUE(nb);
        __syncthreads();
        *(LAS u32x4*)(STG + tid * 8) = g0; *(LAS u32x4*)(STG + SEQ + tid * 8) = g1;
        __syncthreads();
#pragma unroll
        for (int j = 0; j < 8; ++j) { const int n = nb + 512 * j; z[j] = (f32x2){sconv_lds(STG, 0, n, wv0, wv1, wv2, bv), sconv_lds(STG, 1, n, wv0, wv1, wv2, bv)}; X.IN[n] = z[j]; }
        g0 = HY_LD(r1, b0 * SEQ + tid * 8); g1 = HY_LD(r1, b1 * SEQ + tid * 8);
        conv_fft(X, H0);
        *(LAS u32x4*)(STG + tid * 8) = g0; *(LAS u32x4*)(STG + SEQ + tid * 8) = g1;
        __syncthreads();
        HY_OPAQUE(nb); HY_OPAQUE(pc);
#pragma unroll
        for (int j = 0; j < 8; ++j) { const int n = nb + 512 * j; const f32x2 y = RB0[pc + 544 * j] + RB1[pc + 544 * j];
            const f32x2 g = (f32x2){sconv_lds(STG, 0, n, wa0, wa1, wa2, ba), sconv_lds(STG, 1, n, wa0, wa1, wa2, ba)};
            z[j] = g * (y + sk0 * z[j]); X.IN[n] = z[j]; }
        g0 = HY_LD(r2, b0 * SEQ + tid * 8); g1 = HY_LD(r2, b1 * SEQ + tid * 8);
        conv_fft(X, H1);
        *(LAS u32x4*)(STG + tid * 8) = g0; *(LAS u32x4*)(STG + SEQ + tid * 8) = g1;
        __syncthreads();
        if (pr < 3) { g0 = HY_LD(rv, (b0 + 2) * SEQ + tid * 8); g1 = HY_LD(rv, (b1 + 2) * SEQ + tid * 8); }
        HY_OPAQUE(nb); HY_OPAQUE(pc);
        f32x2 o[8];
#pragma unroll
        for (int j = 0; j < 8; ++j) { const int n = nb + 512 * j; const f32x2 y = RB0[pc + 544 * j] + RB1[pc + 544 * j];
            const f32x2 g = (f32x2){sconv_lds(STG, 0, n, wb0, wb1, wb2, bb), sconv_lds(STG, 1, n, wb0, wb1, wb2, bb)};
            o[j] = g * (y + sk1 * z[j]); }
        __syncthreads();
#pragma unroll
        for (int j = 0; j < 8; ++j) { const int n = nb + 512 * j; STG[n] = (bf16_t)(cvt_pk_bf16(o[j].x, 0.f) & 0xffffu); STG[SEQ + n] = (bf16_t)(cvt_pk_bf16(o[j].y, 0.f) & 0xffffu); }
        __syncthreads();
        { const int t0 = b0 * SEQ + tid * 8, t1 = b1 * SEQ + tid * 8;
          *(u32x4*)(Z + (size_t)(t0 >> 7) * (HYW * 128) + (t0 & 127)) = *(const LAS u32x4*)(STG + tid * 8); *(u32x4*)(Z + (size_t)(t1 >> 7) * (HYW * 128) + (t1 & 127)) = *(const LAS u32x4*)(STG + SEQ + tid * 8); }
    }
    __syncthreads();
}
}

__device__ __forceinline__ void p3_hyena(Frame& F) {
    FT_DECL;
    __syncthreads();
    hy::setup_tables(F.lds, f_tid);
    __syncthreads();
    for (int c = F.vcu; c < HYW; c += F.G) hy::unit(F, c);
}

__device__ __forceinline__ void p4_hynorm(Frame& F) {
    FT_DECL;
    const bf16_t* Z = WSP(bf16_t, WS_Z2T); bf16_t* MIX = WSP(bf16_t, WS_MIX); const float* g = F.in[26];
    constexpr int TP = 132;
    LAS bf16_t* T = (LAS bf16_t*)F.lds;
    LAS float* red = (LAS float*)(F.lds + 512 * TP * 2);
    LAS float* rs = red + 512;
    float gl[8];
#pragma unroll
    for (int e = 0; e < 8; ++e) gl[e] = g[(f_tid & 63) + 64 * e];
    for (int it = F.vcu; it < MROWS / 128; it += F.G) {
        const int tok0 = it * 128; const bf16_t* zt = Z + (size_t)it * (HYW * 128);
        __syncthreads();
        u32x4 v[16];
#pragma unroll
        for (int j = 0; j < 16; ++j) v[j] = __builtin_nontemporal_load((const u32x4*)(zt + (size_t)(f_tid + 512 * j) * 8));
#pragma unroll
        for (int j = 0; j < 16; ++j) { const int i = f_tid + 512 * j; LAS u32x2* d = (LAS u32x2*)(T + (i >> 4) * TP + (i & 15) * 8); d[0] = (u32x2){v[j].x, v[j].y}; d[1] = (u32x2){v[j].z, v[j].w}; }
        __syncthreads();
        { const int tok = f_tid & 127, grp = f_tid >> 7; float ss = 0.f;
#pragma unroll 8
            for (int k = 0; k < 128; ++k) { const float x = bf2f(T[(grp * 128 + k) * TP + tok]); ss += x * x; }
            red[grp * 128 + tok] = ss; }
        __syncthreads();
        if (f_tid < 128) rs[f_tid] = rsqrtf(((red[f_tid] + red[128 + f_tid]) + (red[256 + f_tid] + red[384 + f_tid])) * (1.f / HYW) + EPS);
        __syncthreads();
#pragma unroll
        for (int j = 0; j < 16; ++j) { const int i = f_tid + 512 * j, tok = i >> 6, l = i & 63; const float r = rs[tok];
            float x[8];
#pragma unroll
            for (int e = 0; e < 8; ++e) x[e] = bf2f(T[(l + 64 * e) * TP + tok]) * r * gl[e];
            u32x4 w; w.x = cvt_pk_bf16(x[0], x[1]); w.y = cvt_pk_bf16(x[2], x[3]); w.z = cvt_pk_bf16(x[4], x[5]); w.w = cvt_pk_bf16(x[6], x[7]);
            *(u32x4*)(MIX + (size_t)(tok0 + tok) * DM + 512 + 8 * l) = w; }
    }
}

constexpr size_t WS_LIST2 = WS_FILT;
constexpr size_t WS_GSLOT2 = WS_FILT + 4 * MiB;
constexpr int CW_ECNT = 256;
constexpr int MAXSLOT = MROWS * TOPK + NEXP * 256;
constexpr int MAXTILE = MAXSLOT / 256;
constexpr size_t WS_XS = WS_EO;
constexpr int P6_WT_PITCH = 2 * DM + 16;
constexpr int P6_LDS_TOPI = 2 * NEXP * P6_WT_PITCH;

__device__ __forceinline__ void p6_router_mfma(Frame& F) {
    FT_DECL;
#define in F.in
    LAS float* WP = (LAS float*)F.lds;
    LAS int* TI = (LAS int*)(F.lds + P6_LDS_TOPI);
    LAS int* PS = TI + 512;
    LAS int* SC = PS + 512;
    LAS float* RSTD = (LAS float*)(SC + 512);
    LAS float* BIAS = RSTD + 128;
    LAS float* SSX = BIAS + 32;
    const float* rw = in[28]; const float* mod = WSP(float, WS_SMALL + SM_MOD); const float* g2n = in[7]; const float* rb = in[29];
    const bf16_t* XN = WSP(bf16_t, WS_XN); unsigned char* H2 = WSP(unsigned char, WS_H);
    int* list2 = WSP(int, WS_LIST2); float* gslot2 = WSP(float, WS_GSLOT2); int* ecnt = (int*)(F.ctl + CW_ECNT);
    LAS float* GT = SSX + 256;
    LAS int* EB = (LAS int*)(GT + 512);
    LAS float* GM = (LAS float*)(EB + 32);
    static_assert(P6_LDS_TOPI + (512 * 3 + 128 + 32 + 256 + 512 + 32 + 1024) * 4 <= LDSCTL_OFF, "router LDS map");
    for (int blk = blockIdx.x; blk < MROWS / 128; blk += F.G) {
        const float* sh2 = mod + (size_t)(blk >> 5) * (NMOD * DM) + 3 * DM; const float* sc2 = sh2 + DM;
        __syncthreads();
        for (int i = f_tid; i < DM; i += 512) GM[i] = g2n[i] * (1.f + sc2[i]);
        if (f_tid < 32) BIAS[f_tid] = WSP(float, WS_SMALL + SM_RBIAS)[(blk >> 5) * 32 + f_tid];
        __syncthreads();
        { const int e = f_lane & 31, h8 = (f_lane >> 5) * 8; LAS unsigned char* WT = (LAS unsigned char*)F.lds;
#pragma unroll 2
            for (int it = 0; it < 8; ++it) { const int k0 = (it * NWAVES + F.wave) * 16 + h8; float w[8];
#pragma unroll
                for (int q = 0; q < 8; ++q) w[q] = rw[(size_t)(k0 + q) * 32 + e];
                const f32x4 ga = *(const LAS f32x4*)(GM + k0), gb = *(const LAS f32x4*)(GM + k0 + 4); const float g[8] = {ga.x, ga.y, ga.z, ga.w, gb.x, gb.y, gb.z, gb.w};
                unsigned ph[4], pl[4];
#pragma unroll
                for (int q = 0; q < 4; ++q) { const float v0 = w[2 * q] * g[2 * q], v1 = w[2 * q + 1] * g[2 * q + 1]; ph[q] = cvt_pk_bf16(v0, v1);
                    pl[q] = cvt_pk_bf16(v0 - __uint_as_float(ph[q] << 16), v1 - __uint_as_float(ph[q] & 0xffff0000u)); }
                *(LAS u32x4*)(WT + e * P6_WT_PITCH + k0 * 2) = (u32x4){ph[0], ph[1], ph[2], ph[3]};
                *(LAS u32x4*)(WT + NEXP * P6_WT_PITCH + e * P6_WT_PITCH + k0 * 2) = (u32x4){pl[0], pl[1], pl[2], pl[3]}; } }
        __syncthreads();
        const int rg = F.wave & 3, kh = F.wave >> 2, j = f_lane & 31, hi = f_lane >> 5;
        f32x16 acc = {};
        float ss = 0.f;
        { const bf16_t* xrow = XN + (size_t)(blk * 128 + rg * 32 + j) * DM + 512 * kh + 8 * hi;
            const LAS unsigned char* wth = (const LAS unsigned char*)F.lds + j * P6_WT_PITCH + (512 * kh + 8 * hi) * 2;
#pragma unroll 8
            for (int c = 0; c < 32; ++c) { const u32x4 xb = *(const u32x4*)(xrow + 16 * c);
                const float xf[8] = {__uint_as_float(xb.x << 16), __uint_as_float(xb.x & 0xffff0000u), __uint_as_float(xb.y << 16), __uint_as_float(xb.y & 0xffff0000u),
                                     __uint_as_float(xb.z << 16), __uint_as_float(xb.z & 0xffff0000u), __uint_as_float(xb.w << 16), __uint_as_float(xb.w & 0xffff0000u)};
#pragma unroll
                for (int q = 0; q < 8; ++q) ss += xf[q] * xf[q];
                const bf16x8 xv = __builtin_bit_cast(bf16x8, xb);
                const bf16x8 ah = *(const LAS bf16x8*)(wth + 32 * c), al = *(const LAS bf16x8*)(wth + NEXP * P6_WT_PITCH + 32 * c);
                acc = __builtin_amdgcn_mfma_f32_32x32x16_bf16(ah, xv, acc, 0, 0, 0);
                acc = __builtin_amdgcn_mfma_f32_32x32x16_bf16(al, xv, acc, 0, 0, 0); } }
        { auto rr = __builtin_amdgcn_permlane32_swap(__float_as_uint(ss), __float_as_uint(ss), false, false); ss = __uint_as_float(rr[0]) + __uint_as_float(rr[1]); }
        if (hi == 0) SSX[kh * 128 + rg * 32 + j] = ss;
        __syncthreads();
        if (kh == 1) {
#pragma unroll
            for (int r = 0; r < 16; ++r) WP[(rg * 16 + r) * 64 + f_lane] = acc[r]; }
        if (f_tid < 128) RSTD[f_tid] = rsqrtf((SSX[f_tid] + SSX[128 + f_tid]) * (1.f / DM) + EPS);
        __syncthreads();
        if (kh == 0) {
            const float rstd = RSTD[rg * 32 + j];
            float tv[4] = {-INFINITY, -INFINITY, -INFINITY, -INFINITY}; int ti[4] = {1 << 20, 1 << 20, 1 << 20, 1 << 20};
#define P6_INS(V, E) do { float cv = (V); int ce = (E); _Pragma("unroll") for (int q = 0; q < 4; ++q) { const bool b = cv > tv[q] || (cv == tv[q] && ce < ti[q]); \
                const float nv = b ? tv[q] : cv; const int ne = b ? ti[q] : ce; tv[q] = b ? cv : tv[q]; ti[q] = b ? ce : ti[q]; cv = nv; ce = ne; } } while (0)
#pragma unroll
            for (int r = 0; r < 16; ++r) { const int e = (r & 3) + 8 * (r >> 2) + 4 * hi; const float v = (acc[r] + WP[(rg * 16 + r) * 64 + f_lane]) * rstd + BIAS[e]; P6_INS(v, e); }
            float ov[4]; int oe[4];
#pragma unroll
            for (int q = 0; q < 4; ++q) { ov[q] = __shfl_xor(tv[q], 32); oe[q] = __shfl_xor(ti[q], 32); }
#pragma unroll
            for (int q = 0; q < 4; ++q) P6_INS(ov[q], oe[q]);
#undef P6_INS
            if (hi == 0) { const int rl = rg * 32 + j;
                const float e1 = __expf(tv[1] - tv[0]), e2 = __expf(tv[2] - tv[0]), e3 = __expf(tv[3] - tv[0]); const float inv = 1.f / (1.f + e1 + e2 + e3);
                typedef int i32x4_t __attribute__((ext_vector_type(4))); const i32x4_t t4 = {ti[0], ti[1], ti[2], ti[3]};
                *(LAS f32x4*)(GT + rl * 4) = (f32x4){inv, e1 * inv, e2 * inv, e3 * inv};
                *(LAS i32x4_t*)(TI + rl * 4) = t4; }
        }
        __syncthreads();
        { const int t2 = F.wave * 64 + lane_id(); const int e = t2 & 31, seg = t2 >> 5; int cnt = 0;
#pragma unroll 4
            for (int i = 0; i < 32; ++i) cnt += (TI[seg * 32 + i] == e) ? 1 : 0;
            SC[seg * 32 + e] = cnt;
            __syncthreads();
            int pre = 0;
            for (int s2 = 0; s2 < seg; ++s2) pre += SC[s2 * 32 + e];
            if (seg == 15) EB[e] = __hip_atomic_fetch_add(ecnt + e, pre + cnt, __ATOMIC_RELAXED, __HIP_MEMORY_SCOPE_AGENT);
            for (int i = 0; i < 32; ++i) if (TI[seg * 32 + i] == e) { PS[seg * 32 + i] = pre; ++pre; }
        }
        __syncthreads();
        { const int t3 = F.wave * 64 + lane_id(); const int e = TI[t3]; const size_t sl = (size_t)e * MROWS + EB[e] + PS[t3];
            list2[sl] = (blk * 128 + (t3 >> 2)) * 4 + (t3 & 3); gslot2[sl] = GT[t3]; }
        { const int lane = lane_id();
            f32x4 PA[4], PB[4];
#pragma unroll
            for (int jj = 0; jj < 4; ++jj) { const int c = 4 * lane + 256 * jj; PA[jj] = *(const f32x4*)(g2n + c) * (*(const f32x4*)(sc2 + c) + 1.f); PB[jj] = *(const f32x4*)(sh2 + c); }
            for (int it = 0; it < 4; ++it) { u32x2 xb[4][4];
#pragma unroll
                for (int u = 0; u < 4; ++u) { const GAS u32x2* xr = (const GAS u32x2*)(XN + (size_t)(blk * 128 + F.wave * 16 + 4 * it + u) * DM) + lane;
#pragma unroll
                    for (int jj = 0; jj < 4; ++jj) xb[u][jj] = xr[64 * jj]; }
#pragma unroll
                for (int u = 0; u < 4; ++u) { const int rl = F.wave * 16 + 4 * it + u; const float rstd = RSTD[rl];
                    GAS unsigned* o4 = (GAS unsigned*)(H2 + (size_t)(blk * 128 + rl) * DM) + lane;
#pragma unroll
                    for (int jj = 0; jj < 4; ++jj) {
                        const f32x4 x = (f32x4){__uint_as_float(xb[u][jj].x << 16), __uint_as_float(xb[u][jj].x & 0xffff0000u), __uint_as_float(xb[u][jj].y << 16), __uint_as_float(xb[u][jj].y & 0xffff0000u)};
                        const f32x4 h = x * rstd * PA[jj] + PB[jj];
                        o4[64 * jj] = pk4_fp8(h.x, h.y, h.z, h.w); } } }
        }
    }
#undef in
}

template <int NPN> struct SchedMoE {
    int G, c, nT; const char* A; const char* W; size_t wstride; const LAS unsigned char* tileE; const LAS int* RW; bool gath;
    __device__ __forceinline__ long lidx(int T, int e, int i) const { const LAS int* TB = (const LAS int*)(tileE + 544); const int r = (T - TB[e]) * 256 + i; return (r < TB[32 + e]) ? (long)e * MROWS + r : -1L; }
    __device__ __forceinline__ const LAS int* rows(int i) const { return RW + i * 256; }
    __device__ __forceinline__ bool next(int i, g8::Unit& u) const {
        const int L = i * G + c, xcd = L & 7, j = L >> 3, nTx = (nT + 7) >> 3, tl = j / NPN, T = xcd * nTx + tl, pn = j % NPN;
        if (tl >= nTx || T >= nT) return false;
        const int e = tileE[T];
        u.pm = T; u.pn = pn; u.kind = i; u.ex = e; u.a = gath ? A : A + (size_t)T * 256 * DM; u.b = W + (size_t)e * wstride + (size_t)pn * 256 * DM; return true;
    }
};
struct EpiSwiGLU {
    unsigned char* ACT; const float* b1;
    __device__ __forceinline__ void operator()(f32x4 (&acc)[2][2][4][2], const g8::Unit& u, int wr, int wc, int fr, int fq) const {
        asm volatile("" : "+v"(fr), "+v"(fq));
        const int j0 = u.pn * 128 + wc * 32 + 8 * fq; const float* bp = b1 + (size_t)u.ex * 2 * DM + j0;
        f32x4 bg[2], bl[2];
#pragma unroll
        for (int n = 0; n < 2; ++n) { bg[n] = *(const f32x4*)(bp + 4 * n); bl[n] = *(const f32x4*)(bp + DM + 4 * n); }
#pragma unroll
        for (int ai = 0; ai < 2; ++ai)
#pragma unroll
            for (int m = 0; m < 4; ++m) { const size_t slot = (size_t)u.pm * 256 + ai * 128 + wr * 64 + m * 16 + fr; float o[8];
#pragma unroll
                for (int n = 0; n < 2; ++n) { const f32x4 g4 = acc[ai][0][m][n] * (1.f / WSCALE) + bg[n], l4 = acc[ai][1][m][n] * (1.f / WSCALE) + bl[n];
#pragma unroll
                    for (int e = 0; e < 4; ++e) { const float g = fminf(g4[e], 7.f), l = __builtin_amdgcn_fmed3f(l4[e], -7.f, 7.f);
                        const float ex = __builtin_amdgcn_exp2f(g * (-1.702f * 1.4426950408889634f)); const float glu = g * __builtin_amdgcn_rcpf(1.f + ex);
                        o[4 * n + e] = fmaf(l, glu, glu); } }
                u32x2 w; w.x = pk4_fp8(o[0], o[1], o[2], o[3]); w.y = pk4_fp8(o[4], o[5], o[6], o[7]);
                *(u32x2*)(ACT + slot * DM + j0) = w; }
    }
};
struct EpiDown {
    unsigned char* EO; const float* b2; const LAS int* LL; int G, c;
    __device__ __forceinline__ void operator()(f32x4 (&acc)[2][2][4][2], const g8::Unit& u, int wr, int wc, int fr, int fq) const {
        asm volatile("" : "+v"(fr), "+v"(fq));
        const int c0 = u.pn * 256 + wc * 64 + 16 * fq; const float* bp = b2 + (size_t)u.ex * DM + c0;
        f32x4 bb[2][2];
#pragma unroll
        for (int bj = 0; bj < 2; ++bj)
#pragma unroll
            for (int n = 0; n < 2; ++n) bb[bj][n] = *(const f32x4*)(bp + bj * 8 + 4 * n);
        const LAS int* L = LL + u.kind * 512;
        int li[8]; float gt[8];
#pragma unroll
        for (int q = 0; q < 8; ++q) { const int rl = (q >> 2) * 128 + wr * 64 + (q & 3) * 16 + fr; li[q] = L[rl]; gt[q] = __int_as_float(L[256 + rl]) * (1.f / WSCALE); }
#pragma unroll
        for (int ai = 0; ai < 2; ++ai)
#pragma unroll
            for (int m = 0; m < 4; ++m) { const int l = li[ai * 4 + m]; const float g = gt[ai * 4 + m];
                unsigned char* dst = EO + ((size_t)(l & 3) * MROWS + (l >> 2)) * DM + c0;
                u32x4 w;
                { const f32x4 v0 = acc[ai][0][m][0] * g + bb[0][0] * (g * WSCALE), v1 = acc[ai][0][m][1] * g + bb[0][1] * (g * WSCALE);
                  w.x = pk4_fp8(v0[0] * EOSCALE, v0[1] * EOSCALE, v0[2] * EOSCALE, v0[3] * EOSCALE); w.y = pk4_fp8(v1[0] * EOSCALE, v1[1] * EOSCALE, v1[2] * EOSCALE, v1[3] * EOSCALE); }
                { const f32x4 v0 = acc[ai][1][m][0] * g + bb[1][0] * (g * WSCALE), v1 = acc[ai][1][m][1] * g + bb[1][1] * (g * WSCALE);
                  w.z = pk4_fp8(v0[0] * EOSCALE, v0[1] * EOSCALE, v0[2] * EOSCALE, v0[3] * EOSCALE); w.w = pk4_fp8(v1[0] * EOSCALE, v1[1] * EOSCALE, v1[2] * EOSCALE, v1[3] * EOSCALE); }
                if (l >= 0) *(u32x4*)dst = w; }
    }
};
__device__ __forceinline__ const LAS unsigned char* moe_tiles(Frame& F, int& nT) {
    FT_DECL;
    LAS unsigned char* TE = (LAS unsigned char*)(F.lds + RING_BYTES); LAS int* TB = (LAS int*)(TE + 544); LAS int* TOT = TB + 32; LAS int* NTL = TOT + 32;
    const int* ecnt = (const int*)(F.ctl + CW_ECNT);
    __syncthreads();
    if (f_tid < 32) { const int t = ecnt[f_tid]; TOT[f_tid] = t; NTL[f_tid] = (t + 255) >> 8; }
    __syncthreads();
    if (f_tid < 33) { int b = 0; for (int e = 0; e < f_tid; ++e) b += NTL[e]; if (f_tid < 32) TB[f_tid] = b; else NTL[32] = b; }
    __syncthreads();
    nT = NTL[32]; if (nT > MAXTILE) nT = MAXTILE;
    for (int i = f_tid; i < MAXTILE; i += 512) { int e = 0;
#pragma unroll 8
        for (int q = 0; q < 32; ++q) e += (TB[q] + NTL[q] <= i) ? 1 : 0;
        TE[i] = (unsigned char)((i < nT) ? e : 0); }
    __syncthreads();
    return (const LAS unsigned char*)TE;
}

__device__ __forceinline__ void p10_combine(Frame& F) {
    FT_DECL;
    const float* mod = WSP(float, WS_SMALL + SM_MOD); const unsigned char* EO = WSP(unsigned char, WS_EO);
    const size_t gt = (size_t)F.vcu * 512 + f_tid, NTH = (size_t)F.G * 512;
    constexpr int U = 4;
    for (size_t i0 = gt; i0 < (size_t)MROWS * 128; i0 += NTH * U) {
        u32x2 ev[U][4]; f32x4 xv[U][2], gv[U][2];
#pragma unroll
        for (int u = 0; u < U; ++u) { const size_t i = i0 + (size_t)u * NTH; const size_t row = i >> 7; const int c0 = (int)(i & 127) * 8;
            const float* g2 = mod + (size_t)(row >> 12) * (NMOD * DM) + 5 * DM + c0; const bf16_t* op = WSP(bf16_t, WS_XN) + row * DM + c0;
#pragma unroll
            for (int k = 0; k < 4; ++k) ev[u][k] = __builtin_nontemporal_load((const u32x2*)(EO + ((size_t)k * MROWS + row) * DM + c0));
            { const u32x4 xb = *(const u32x4*)op; xv[u][0] = (f32x4){__uint_as_float(xb.x << 16), __uint_as_float(xb.x & 0xffff0000u), __uint_as_float(xb.y << 16), __uint_as_float(xb.y & 0xffff0000u)};
              xv[u][1] = (f32x4){__uint_as_float(xb.z << 16), __uint_as_float(xb.z & 0xffff0000u), __uint_as_float(xb.w << 16), __uint_as_float(xb.w & 0xffff0000u)}; }
            gv[u][0] = *(const f32x4*)g2; gv[u][1] = *(const f32x4*)(g2 + 4); }
#pragma unroll
        for (int u = 0; u < U; ++u) { const size_t i = i0 + (size_t)u * NTH; const size_t row = i >> 7; const int c0 = (int)(i & 127) * 8;
            float s[8];
#pragma unroll
            for (int e = 0; e < 8; ++e) s[e] = 0.f;
#pragma unroll
            for (int k = 0; k < 4; ++k) { const u32x2 v = ev[u][k];
                const f32x2 a = __builtin_amdgcn_cvt_pk_f32_fp8((int)v.x, false), b = __builtin_amdgcn_cvt_pk_f32_fp8((int)v.x, true), c = __builtin_amdgcn_cvt_pk_f32_fp8((int)v.y, false), d = __builtin_amdgcn_cvt_pk_f32_fp8((int)v.y, true);
                s[0] += a.x; s[1] += a.y; s[2] += b.x; s[3] += b.y; s[4] += c.x; s[5] += c.y; s[6] += d.x; s[7] += d.y; }
#pragma unroll
            for (int e = 0; e < 8; ++e) s[e] *= (1.f / EOSCALE);
            f32x4 o0 = xv[u][0] + gv[u][0] * (f32x4){s[0], s[1], s[2], s[3]}, o1 = xv[u][1] + gv[u][1] * (f32x4){s[4], s[5], s[6], s[7]};
            float* op = F.out + row * DM + c0;
            __builtin_nontemporal_store(o0, (f32x4*)op); __builtin_nontemporal_store(o1, (f32x4*)(op + 4)); }
    }
}

struct Args { const float* in[34]; float* out; unsigned char* ws; int ph_lo, ph_hi; };
constexpr int N_PHASES = 11;

__global__ void __launch_bounds__(512, 2) mega(Args args) {
    extern __shared__ __attribute__((aligned(16))) unsigned char lds[];
    Frame F;
    F.lds = (LAS unsigned char*)lds;
    F.MISC = (volatile LAS unsigned*)(F.lds + LDSCTL_OFF);
    F.wave = __builtin_amdgcn_readfirstlane(threadIdx.x >> 6);
    FT_DECL;
    F.G = gridDim.x; { const int bx = blockIdx.x; F.vcu = (F.G % 8 == 0) ? (bx % 8) * (F.G / 8) + bx / 8 : bx; }
    F.in = (kin_t)__builtin_amdgcn_kernarg_segment_ptr();
    F.out = args.out; F.ws = args.ws;
    F.ctl = (gu32*)(args.ws + WS_CTL);
    for (int u = f_tid; u < (LDS_BYTES - LDSCTL_OFF) / 4; u += NWAVES * 64) ((LAS unsigned*)(F.lds + LDSCTL_OFF))[u] = 0u;
    __syncthreads();
    const int lo = args.ph_lo, hi = args.ph_hi;
    XcdBarrier bar; bar.bar = (unsigned*)(F.ctl + CW_BAR); bar.x = 0; bar.st = nullptr;
    if (hi - lo > 1) bar = xcd_barrier_post((unsigned*)(F.ctl + CW_BAR), F.MISC + 8, f_tid == 0);
#define IN(k) (lo <= (k) && (k) < hi)
#define SEAM(k) do { if (IN(k) && IN((k) + 1)) xcd_barrier(bar, F.wave == 0 && lane_id() == 0); } while (0)

    if (IN(0)) { p0_prologue(F); }
    if (IN(1)) { p1_norm1(F); } SEAM(1);
    if (IN(2)) {
        SchedInProj S{F.G, (int)blockIdx.x, (const char*)WSP(bf16_t, WS_H), (const char*)WSP(bf16_t, WS_WIN)};
        EpiInProj E{WSP(unsigned char, WS_Q), WSP(unsigned char, WS_K), WSP(unsigned char, WS_V), WSP(bf16_t, WS_UT), F.in[9], F.in[10], WSP(float, WS_SMALL + SM_ROPE)};
        g8::gemm_phase<false>(F.lds, DM, S, E, F.wave, lane_id());
    } SEAM(2);
    if (IN(3)) { p3_attention8(F); p3_hyena(F); } SEAM(3);
    if (IN(4)) { p4_hynorm(F); } SEAM(4);
    if (IN(5)) {
        SchedStatic S{F.G, (int)blockIdx.x, MROWS / 256, DM / 256, (const char*)WSP(bf16_t, WS_MIX), (const char*)WSP(bf16_t, WS_WOUT)};
        EpiOutProj E{F.in[0], WSP(bf16_t, WS_XN), WSP(float, WS_SMALL + SM_MOD)};
        g8::gemm_phase<false>(F.lds, DM, S, E, F.wave, lane_id());
    } SEAM(5);
    if (IN(6)) { p6_router_mfma(F); } SEAM(6);
    if (IN(8)) {
        int nT; const LAS unsigned char* TE = moe_tiles(F, nT);
        LAS int* RWL = (LAS int*)(F.lds + RING_BYTES + 1024);
        static_assert(RING_BYTES + 1024 + 17 * 1024 <= LDSCTL_OFF, "LDS map");
        SchedMoE<8> S{F.G, (int)blockIdx.x, nT, (const char*)WSP(char, WS_H), (const char*)WSP(char, WS_W1), (size_t)2 * DM * DM, TE, RWL, true};
        { const int* list = WSP(int, WS_LIST2); const int t8 = F.wave * 64 + lane_id();
            g8::Unit u; for (int i = 0; i < 17 && S.next(i, u); i += 2) { const int ii = i + (t8 >> 8); g8::Unit u2; if (S.next(ii, u2)) { const long ix = S.lidx(u2.pm, u2.ex, t8 & 255); RWL[ii * 256 + (t8 & 255)] = (ix >= 0) ? (list[ix] >> 2) : 0; } }
            __syncthreads(); }
        EpiSwiGLU E{WSP(unsigned char, WS_ACT), F.in[31]};
        g8::gemm_phase_g<true, true>(F.lds, DM, S, E, F.wave, lane_id());
    } SEAM(8);
    if (IN(9)) {
        int nT; const LAS unsigned char* TE = moe_tiles(F, nT);
        SchedMoE<4> S{F.G, (int)blockIdx.x, nT, (const char*)WSP(char, WS_ACT), (const char*)WSP(char, WS_W2), (size_t)DM * DM, TE, nullptr, false};
        LAS int* LL = (LAS int*)(F.lds + RING_BYTES + 1024);
        static_assert(RING_BYTES + 1024 + 9 * 2048 <= LDSCTL_OFF, "LDS map");
        { const int* list = WSP(int, WS_LIST2); const float* gslot = WSP(float, WS_GSLOT2);
            const int t9 = F.wave * 64 + lane_id();
            g8::Unit u; for (int i = 0; i < 9 && S.next(i, u); ++i) { const int t = t9 & 255; const long ix = S.lidx(u.pm, u.ex, t);
                LL[i * 512 + (t9 >> 8) * 256 + t] = (ix < 0) ? ((t9 < 256) ? -1 : 0) : ((t9 < 256) ? list[ix] : __float_as_int(gslot[ix])); }
            __syncthreads(); }
        EpiDown E{WSP(unsigned char, WS_EO), F.in[33], LL, F.G, (int)blockIdx.x};
        g8::gemm_phase<true>(F.lds, DM, S, E, F.wave, lane_id());
    } SEAM(9);
    if (IN(10)) { p10_combine(F); }
#undef IN
#undef SEAM
}

extern "C" void kernel_launch(void* const* d_in, const int* in_sizes, int n_in, void* d_out, int out_size, void* d_ws, size_t ws_size, hipStream_t stream) {
    static int grid = 0;
    if (grid == 0) {
        if (n_in != 34 || out_size != MROWS * DM || ws_size < WS_END) { fprintf(stderr, "kernel_launch: unexpected shapes: n_in %d out %d ws %zu (need %zu)\n", n_in, out_size, ws_size, (size_t)WS_END); grid = -1; return; }
        int dev = 0, cus = 0, per_cu = 0;
        if (hipGetDevice(&dev) != hipSuccess || hipDeviceGetAttribute(&cus, hipDeviceAttributeMultiprocessorCount, dev) != hipSuccess) { grid = -1; return; }
        if (hipFuncSetAttribute((const void*)mega, hipFuncAttributeMaxDynamicSharedMemorySize, LDS_BYTES) != hipSuccess) { fprintf(stderr, "kernel_launch: hipFuncSetAttribute failed\n"); grid = -1; return; }
        if (hipOccupancyMaxActiveBlocksPerMultiprocessor(&per_cu, (const void*)mega, NWAVES * 64, LDS_BYTES) != hipSuccess || per_cu < 1) { fprintf(stderr, "kernel_launch: occupancy query says %d\n", per_cu); per_cu = 1; }
        (void)hipGetLastError();
        grid = cus;
    }
    if (grid < 0) return;
    (void)hipMemsetAsync((char*)d_ws + WS_CTL, 0, CTL_ZERO_BYTES, stream);
    Args a{};
    for (int i = 0; i < 34; ++i) a.in[i] = (const float*)d_in[i];
    a.out = (float*)d_out; a.ws = (unsigned char*)d_ws;
    constexpr int LAST = MK_LAST_PHASE + 1;
    if (MK_N_LAUNCHES == 1) { a.ph_lo = 0; a.ph_hi = LAST; hipLaunchKernelGGL(mega, dim3(grid), dim3(NWAVES * 64), LDS_BYTES, stream, a); }
    else for (int p = 0; p < LAST; ++p) { a.ph_lo = p; a.ph_hi = p + 1; hipLaunchKernelGGL(mega, dim3(grid), dim3(NWAVES * 64), LDS_BYTES, stream, a); }
    const hipError_t le = hipPeekAtLastError();
    if (le != hipSuccess) fprintf(stderr, "kernel_launch: launch failed: %s\n", hipGetErrorName(le));
}
```

```cpp
#include <hip/hip_runtime.h>
#include <hip/hip_bf16.h>
#include <cstdio>
#include <cstdint>

#ifndef MK_N_LAUNCHES
#define MK_N_LAUNCHES 1
#endif
#ifndef MK_LAST_PHASE
#define MK_LAST_PHASE 10
#endif

#define GAS __attribute__((address_space(1)))
#define LAS __attribute__((address_space(3)))
typedef unsigned short bf16_t;
typedef short bf16x8 __attribute__((ext_vector_type(8)));
typedef short s16x4 __attribute__((ext_vector_type(4)));
typedef float f32x2 __attribute__((ext_vector_type(2)));
typedef float f32x4 __attribute__((ext_vector_type(4)));
typedef float f32x16 __attribute__((ext_vector_type(16)));
typedef unsigned u32x2 __attribute__((ext_vector_type(2)));
typedef unsigned u32x4 __attribute__((ext_vector_type(4)));
typedef GAS unsigned gu32;

constexpr int NB = 8, SEQ = 4096, DM = 1024, MROWS = NB * SEQ, CTXL = 256, MCTX = NB * CTXL, MTOT = MROWS + MCTX;
constexpr int KVL = CTXL + SEQ;
constexpr int NHEAD = 4, QKW = 512;
constexpr int HYW = 512, HYC = 1536, INC = 3072, QKVC = 1536;
constexpr int NEXP = 32, TOPK = 4, NMOD = 6;
constexpr float EPS = 1e-6f;
constexpr float LAM_INIT = 0.2f;
constexpr float QSCALE = 0.125f * 1.4426950408889634f;

constexpr size_t MiB = 1u << 20;
constexpr size_t WS_CTL = 0, CTL_ZERO_BYTES = 64 * 1024;
constexpr size_t WS_SMALL = 1 * MiB;
constexpr size_t WS_WIN = 2 * MiB;
constexpr size_t WS_WOUT = 8 * MiB;
constexpr size_t WS_W1 = 10 * MiB;
constexpr size_t WS_W2 = 138 * MiB;
constexpr size_t WS_H = 202 * MiB;
constexpr size_t WS_Q = 270 * MiB;
constexpr size_t WS_K = 302 * MiB;
constexpr size_t WS_V = 336 * MiB;
constexpr size_t WS_UT = 370 * MiB;
constexpr size_t WS_FILT = 466 * MiB;
constexpr size_t WS_Z2T = 498 * MiB;
constexpr size_t WS_MIX = 530 * MiB;
constexpr size_t WS_ROUTE = 594 * MiB;
constexpr size_t WS_ACT = 270 * MiB;
constexpr size_t WS_EO = 598 * MiB;
constexpr size_t WS_XN = 870 * MiB;
constexpr size_t WS_END = 998 * MiB;
constexpr size_t SM_MOD = 0;
constexpr size_t SM_SCAL = 256 * 1024;
constexpr size_t SM_ROPE = 260 * 1024;
constexpr size_t SM_RBIAS = 272 * 1024;
constexpr int CW_BAR = 4096;
constexpr int CW_GEMV = 320;

constexpr int RING_BYTES = 131072;
constexpr int LDSCTL_OFF = 151552;
constexpr int LDS_BYTES = 152576;
constexpr int NWAVES = 8;

#define LDS_WAIT() asm volatile("s_waitcnt lgkmcnt(0)" ::: "memory")
#define VM_WAIT() asm volatile("s_waitcnt vmcnt(0)" ::: "memory")
#define RLX_AGENT __ATOMIC_RELAXED, __HIP_MEMORY_SCOPE_AGENT

__device__ __forceinline__ unsigned cvt_pk_bf16(float lo, float hi) { unsigned r; asm volatile("v_cvt_pk_bf16_f32 %0, %1, %2" : "=v"(r) : "v"(lo), "v"(hi)); return r; }
__device__ __forceinline__ float bf2f(bf16_t v) { return __uint_as_float(((unsigned)v) << 16); }
__device__ __forceinline__ float wave_sum(float v) {
#pragma unroll
    for (int o = 1; o < 64; o <<= 1) v += __shfl_xor(v, o);
    return v;
}

#define XB_TMO      128
#define XB_XCNT(j)  (256  + 64 * (j))
#define XB_XSUB(j)  (1280 + 64 * (j))
#define XB_XGEN(j)  (2304 + 64 * (j))
#define XB_TOP      3328
#define XB_TOPGEN   3392
#define XCD_BAR_WORDS 3456
#define XB_SPIN_CAP (1u << 22)
__device__ __forceinline__ unsigned xb_ld(unsigned* p)              { return __hip_atomic_load(p, __ATOMIC_RELAXED, __HIP_MEMORY_SCOPE_AGENT); }
__device__ __forceinline__ unsigned xb_add(unsigned* p, unsigned v) { return __hip_atomic_fetch_add(p, v, __ATOMIC_RELAXED, __HIP_MEMORY_SCOPE_AGENT); }
__device__ __forceinline__ unsigned xb_xcc_id() { return (unsigned)__builtin_amdgcn_s_getreg((3 << 11) | 20) & 0xFu; }
#define XB_SPIN(cond, bar) do { unsigned _sp = 0; while (cond) { __builtin_amdgcn_s_sleep(1); \
    if ((++_sp & 255u) == 0u) { if (xb_ld(&(bar)[XB_TMO])) break; if (_sp > XB_SPIN_CAP) { atomicAdd(&(bar)[XB_TMO], 1u); break; } } } } while (0)
struct XcdBarrier { unsigned* bar; unsigned x; volatile LAS unsigned* st; };
__device__ __forceinline__ XcdBarrier xcd_barrier_post(unsigned* bar, volatile LAS unsigned* st, bool leader) {
    XcdBarrier b; b.bar = bar; b.x = xb_xcc_id(); b.st = st;
    if (leader) (void)xb_add(&bar[XB_XCNT(b.x)], 1u);
    return b;
}
__device__ __forceinline__ void xcd_barrier_complete(unsigned* bar, unsigned x, unsigned& nloc, unsigned& nx) {
    const unsigned G = gridDim.x * gridDim.y * gridDim.z;
    unsigned sum, cnt, mine, sp = 0u;
    for (;;) {
        sum = 0u; cnt = 0u; mine = 0u;
#pragma unroll
        for (unsigned j = 0; j < 16; ++j) { const unsigned c = xb_ld(&bar[XB_XCNT(j)]); sum += c; cnt += (c > 0u) ? 1u : 0u; mine = (j == x) ? c : mine; }
        if (sum == G) break;
        __builtin_amdgcn_s_sleep(1);
        if ((++sp & 255u) == 0u) { if (xb_ld(&bar[XB_TMO])) break; if (sp > XB_SPIN_CAP) { atomicAdd(&bar[XB_TMO], 1u); break; } }
    }
    nloc = mine > 0u ? mine : 1u; nx = cnt > 0u ? cnt : 1u;
}
__device__ __forceinline__ void xcd_barrier(const XcdBarrier& b, bool leader) {
    asm volatile("s_waitcnt vmcnt(0)" ::: "memory");
    __syncthreads();
    if (leader) {
        unsigned* bar = b.bar;
        __builtin_amdgcn_s_waitcnt(0);
        unsigned nloc = b.st[0], nx = b.st[1];
        if (nloc == 0u) { xcd_barrier_complete(bar, b.x, nloc, nx); b.st[0] = nloc; b.st[1] = nx; }
        const unsigned old = xb_add(&bar[XB_XSUB(b.x)], 1u);
        const unsigned gen = old / nloc;
        if (old + 1u == (gen + 1u) * nloc) {
            __builtin_amdgcn_fence(__ATOMIC_RELEASE, "agent");
            asm volatile("s_waitcnt vmcnt(0)" ::: "memory");
            const unsigned og = xb_add(&bar[XB_TOP], 1u);
            const unsigned tg = og / nx;
            if (og + 1u == (tg + 1u) * nx) xb_add(&bar[XB_TOPGEN], 1u);
            else XB_SPIN(xb_ld(&bar[XB_TOPGEN]) == tg, bar);
            __builtin_amdgcn_fence(__ATOMIC_ACQUIRE, "agent");
            xb_add(&bar[XB_XGEN(b.x)], 1u);
            asm volatile("s_waitcnt vmcnt(0)" ::: "memory");
        } else {
            XB_SPIN(xb_ld(&bar[XB_XGEN(b.x)]) == gen, bar);
            __builtin_amdgcn_fence(__ATOMIC_ACQUIRE, "agent");
            asm volatile("s_waitcnt vmcnt(0)" ::: "memory");
        }
    }
    __syncthreads();
}

namespace g8 {
constexpr int BM = 256, BK = 64, HALF = 128, HTB = HALF * BK * 2, STAGE_BYTES = 8 * HTB, NXCD = 8, WGM = 8;
__host__ __device__ __forceinline__ int lds_byte(int r, int c) { const int st = (r >> 4) * 2 + (c >> 5), rr = r & 15, cc = c & 31, ob = rr * 64 + cc * 2; return st * 1024 + (ob ^ (((ob >> 9) & 1) << 5)); }
__host__ __device__ __forceinline__ void stage_rc(int b, int& R, int& C) { const int st = b / 1024, sb = b % 1024, swz = sb ^ (((sb >> 9) & 1) << 5); R = (st >> 1) * 16 + swz / 64; C = (st & 1) * 32 + (swz % 64) / 2; }
__host__ __device__ __forceinline__ int perm32(int rho) { const int n = rho >> 4, i = rho & 15; return 8 * (i >> 2) + 4 * n + (i & 3); }

struct Unit { const char* a; const char* b; int pm, pn, kind, ex; };

__device__ __forceinline__ void tile_of(int L, int nM, int nN, int& pm, int& pn) {
    const int nwg = nM * nN; int wgid = L;
    { const int q = nwg / NXCD, r = nwg % NXCD, xcd = wgid % NXCD, off = wgid / NXCD; wgid = (xcd < r ? xcd * (q + 1) : r * (q + 1) + (xcd - r) * q) + off; }
    const int nig = WGM * nN, gid = wgid / nig, fm = gid * WGM, gsz = (nM - fm) < WGM ? (nM - fm) : WGM;
    pm = fm + ((wgid % nig) % gsz); pn = (wgid % nig) / gsz;
}

typedef int i32x8 __attribute__((ext_vector_type(8)));
template <bool FP8, bool GATHER, bool SP2, class Epi, class Sched>
__device__ __forceinline__ void gemm_phase_s(LAS unsigned char* lds, const int K, const Sched& S, const Epi& E, const int wid, const int lane) {
    const int tid = wid * 64 + lane, wr = wid >> 2, wc = wid & 3, fr = lane & 15, fq = lane >> 4;
    const int nt = FP8 ? K / 128 : K / BK;
    const int RP = FP8 ? K : 2 * K;
    unsigned voffA[2], voffB[2]; int srow[2], scol[2];
#pragma unroll
    for (int i = 0; i < 2; ++i) { int R, C; stage_rc(tid * 16 + i * 8192, R, C); const int Rb = (R & ~31) + perm32(R & 31);
        voffA[i] = (unsigned)(R * RP + C * 2); voffB[i] = (unsigned)(Rb * RP + C * 2); srow[i] = R; scol[i] = C * 2; }
    const size_t kstep = (size_t)(BK * 2);
    const size_t hstep = (size_t)HALF * RP;
    const unsigned ldsw = (unsigned)wid * 1024u;
    unsigned cO0[2], cO1[2], nO0[2], nO1[2];
#define PG8_GOFF(D0, D1, ui_) do { if constexpr (GATHER) { const LAS int* rw_ = S.rows(ui_); _Pragma("unroll") for (int i_ = 0; i_ < 2; ++i_) { \
        D0[i_] = (unsigned)rw_[srow[i_]] * (unsigned)RP + (unsigned)scol[i_]; D1[i_] = (unsigned)rw_[128 + srow[i_]] * (unsigned)RP + (unsigned)scol[i_]; } } \
      else { _Pragma("unroll") for (int i_ = 0; i_ < 2; ++i_) { D0[i_] = voffA[i_]; D1[i_] = voffA[i_] + (unsigned)hstep; } } } while (0)
    const int aoff = lds_byte(wr * 64 + fr, FP8 ? fq * 16 : fq * 8), boff = lds_byte(wc * 32 + fr, FP8 ? fq * 16 : fq * 8);
    constexpr int KOFF = FP8 ? 16 : 1024;
#define PG8_SA(b, h) (((b) * 2 + (h)) * HTB)
#define PG8_SB(b, h) ((4 + (b) * 2 + (h)) * HTB)
#define PG8_STAGE(bufoff, gbase, voff) do { _Pragma("unroll") for (int _i = 0; _i < 2; ++_i) \
        __builtin_amdgcn_global_load_lds((const unsigned*)((const char*)(gbase) + (voff)[_i]), (LAS unsigned*)(lds + (bufoff) + ldsw + _i * 8192), 16, 0, 0); } while (0)
#define PG8_LD32(p) __builtin_bit_cast(i32x8, __builtin_shufflevector(*(const LAS u32x4*)(p), *(const LAS u32x4*)((p) + 16), 0, 1, 2, 3, 4, 5, 6, 7))
#define PG8_LDA8(dst, b, h) do { _Pragma("unroll") for (int m = 0; m < 4; ++m) dst[m] = PG8_LD32(lds + PG8_SA(b, h) + aoff + m * 2048); } while (0)
#define PG8_LDB8(dst, b, h) do { _Pragma("unroll") for (int n = 0; n < 2; ++n) dst[n] = PG8_LD32(lds + PG8_SB(b, h) + boff + n * 2048); } while (0)
#define PG8_LDA(dst, b, h) do { _Pragma("unroll") for (int m = 0; m < 4; ++m) _Pragma("unroll") for (int k = 0; k < 2; ++k) dst[m][k] = *(const LAS bf16x8*)(lds + PG8_SA(b, h) + aoff + m * 2048 + k * KOFF); } while (0)
#define PG8_LDB(dst, b, h) do { _Pragma("unroll") for (int n = 0; n < 2; ++n) _Pragma("unroll") for (int k = 0; k < 2; ++k) dst[n][k] = *(const LAS bf16x8*)(lds + PG8_SB(b, h) + boff + n * 2048 + k * KOFF); } while (0)
#define PG8_MMA(ai, bj, At, Bt) do { __builtin_amdgcn_s_setprio(1); _Pragma("unroll") for (int m = 0; m < 4; ++m) _Pragma("unroll") for (int n = 0; n < 2; ++n) _Pragma("unroll") for (int k = 0; k < 2; ++k) \
        acc[ai][bj][m][n] = __builtin_amdgcn_mfma_f32_16x16x32_bf16(Bt[n][k], At[m][k], acc[ai][bj][m][n], 0, 0, 0); __builtin_amdgcn_s_setprio(0); } while (0)
#define PG8_MMA8(ai, bj, At, Bt) do { __builtin_amdgcn_s_setprio(1); _Pragma("unroll") for (int m = 0; m < 4; ++m) _Pragma("unroll") for (int n = 0; n < 2; ++n) \
        asm volatile("v_mfma_scale_f32_16x16x128_f8f6f4 %0, %1, %2, %0, %3, %3 op_sel_hi:[0,0,0]" : "+v"(acc[ai][bj][m][n]) : "v"(Bt[n]), "v"(At[m]), "v"(one_scale)); __builtin_amdgcn_s_setprio(0); } while (0)
#define PG8_WAIT_V(n) asm volatile("s_waitcnt vmcnt(" #n ")" ::: "memory")
#define PG8_WAIT_L(n) asm volatile("s_waitcnt lgkmcnt(" #n ")" ::: "memory")
#define PG8_BAR __builtin_amdgcn_s_barrier()
#define PG8_SCHED __builtin_amdgcn_sched_barrier(0)
    Unit cur, nxt; int ui = 0;
    if (!S.next(0, cur)) return;
    f32x4 acc[2][2][4][2];
#pragma unroll
    for (int a = 0; a < 2; ++a)
#pragma unroll
        for (int b = 0; b < 2; ++b)
#pragma unroll
            for (int m = 0; m < 4; ++m)
#pragma unroll
                for (int n = 0; n < 2; ++n) acc[a][b][m][n] = (f32x4){0.f, 0.f, 0.f, 0.f};
    bf16x8 At[4][2], B0[2][2], B1[2][2];
    i32x8 At8[4], B08[2], B18[2];
    const unsigned one_scale = 0x7f7f7f7fu;
    const char* cA = cur.a; const char* cB = cur.b;
    PG8_GOFF(cO0, cO1, 0);
    if constexpr (SP2) {
    PG8_STAGE(PG8_SB(0, 0), cB, voffB); PG8_STAGE(PG8_SB(0, 1), cB + hstep, voffB); PG8_STAGE(PG8_SA(0, 0), cA, cO0); PG8_STAGE(PG8_SA(0, 1), cA, cO1);
    if (wr == 1) PG8_BAR;
    PG8_WAIT_V(2); PG8_BAR;
    PG8_STAGE(PG8_SB(1, 0), cB + kstep, voffB); PG8_STAGE(PG8_SA(1, 0), cA + kstep, cO0); PG8_STAGE(PG8_SB(1, 1), cB + hstep + kstep, voffB);
    PG8_WAIT_V(6); PG8_BAR;
    } else {
    PG8_STAGE(PG8_SB(0, 0), cB, voffB); PG8_STAGE(PG8_SA(0, 0), cA, cO0); PG8_STAGE(PG8_SB(0, 1), cB + hstep, voffB); PG8_STAGE(PG8_SA(0, 1), cA, cO1);
    if (wr == 1) PG8_BAR;
    PG8_WAIT_V(4); PG8_BAR;
    PG8_STAGE(PG8_SB(1, 0), cB + kstep, voffB); PG8_STAGE(PG8_SA(1, 0), cA + kstep, cO0); PG8_STAGE(PG8_SB(1, 1), cB + hstep + kstep, voffB);
    PG8_WAIT_V(6); PG8_BAR;
    }
    for (;;) {
        const bool has_next = S.next(ui + 1, nxt);
        const char* nA = has_next ? nxt.a : cA; const char* nB = has_next ? nxt.b : cB;
        if (has_next) PG8_GOFF(nO0, nO1, ui + 1); else { _Pragma("unroll") for (int i_ = 0; i_ < 2; ++i_) { nO0[i_] = cO0[i_]; nO1[i_] = cO1[i_]; } }
#pragma unroll 1
        for (int t = 0; t < nt; t += 2) {
            const bool last = (t == nt - 2);
            const char* a1 = cA + (size_t)(t + 1) * kstep;
            const char* a2 = last ? nA : cA + (size_t)(t + 2) * kstep; const char* b2 = last ? nB : cB + (size_t)(t + 2) * kstep;
            const char* a3 = a2 + kstep; const char* b3 = b2 + kstep;
            unsigned o20[2], o21[2];
#pragma unroll
            for (int i_ = 0; i_ < 2; ++i_) { o20[i_] = last ? nO0[i_] : cO0[i_]; o21[i_] = last ? nO1[i_] : cO1[i_]; }
            if constexpr (FP8 && SP2) {
            PG8_LDB8(B08, 0, 0); PG8_LDB8(B18, 0, 1); PG8_SCHED; PG8_LDA8(At8, 0, 0); PG8_STAGE(PG8_SA(1, 1), a1, cO1);
            PG8_WAIT_V(8); PG8_WAIT_L(0); PG8_BAR; PG8_MMA8(0, 0, At8, B08); PG8_MMA8(0, 1, At8, B18); PG8_BAR; PG8_SCHED;
            PG8_LDA8(At8, 0, 1); PG8_STAGE(PG8_SB(0, 0), b2, voffB); PG8_STAGE(PG8_SB(0, 1), b2 + hstep, voffB); PG8_STAGE(PG8_SA(0, 0), a2, o20);
            PG8_WAIT_V(8); PG8_WAIT_L(0); PG8_BAR; PG8_MMA8(1, 0, At8, B08); PG8_MMA8(1, 1, At8, B18); PG8_BAR; PG8_SCHED;
            PG8_LDB8(B08, 1, 0); PG8_LDB8(B18, 1, 1); PG8_SCHED; PG8_LDA8(At8, 1, 0); PG8_STAGE(PG8_SA(0, 1), a2, o21);
            PG8_WAIT_V(8); PG8_WAIT_L(0); PG8_BAR; PG8_MMA8(0, 0, At8, B08); PG8_MMA8(0, 1, At8, B18); PG8_BAR; PG8_SCHED;
            PG8_LDA8(At8, 1, 1); PG8_STAGE(PG8_SB(1, 0), b3, voffB); PG8_STAGE(PG8_SB(1, 1), b3 + hstep, voffB); PG8_STAGE(PG8_SA(1, 0), a3, o20);
            PG8_WAIT_V(8); PG8_WAIT_L(0); PG8_BAR; PG8_MMA8(1, 0, At8, B08); PG8_MMA8(1, 1, At8, B18); PG8_BAR; PG8_SCHED;
            } else if constexpr (FP8) {
            PG8_LDB8(B08, 0, 0); PG8_SCHED; PG8_LDA8(At8, 0, 0); PG8_STAGE(PG8_SA(1, 1), a1, cO1);
            PG8_WAIT_L(8); PG8_BAR; PG8_WAIT_L(0); PG8_MMA8(0, 0, At8, B08); PG8_BAR; PG8_SCHED;
            PG8_LDB8(B18, 0, 1); PG8_STAGE(PG8_SB(0, 0), b2, voffB);
            PG8_BAR; PG8_WAIT_L(0); PG8_MMA8(0, 1, At8, B18); PG8_BAR;
            PG8_LDA8(At8, 0, 1); PG8_STAGE(PG8_SA(0, 0), a2, o20);
            PG8_BAR; PG8_WAIT_L(0); PG8_MMA8(1, 0, At8, B08); PG8_BAR; PG8_SCHED;
            PG8_STAGE(PG8_SB(0, 1), b2 + hstep, voffB);
            PG8_WAIT_V(6); PG8_BAR; PG8_MMA8(1, 1, At8, B18); PG8_BAR;
            PG8_LDB8(B08, 1, 0); PG8_SCHED; PG8_LDA8(At8, 1, 0); PG8_STAGE(PG8_SA(0, 1), a2, o21);
            PG8_WAIT_L(8); PG8_BAR; PG8_WAIT_L(0); PG8_MMA8(0, 0, At8, B08); PG8_BAR; PG8_SCHED;
            PG8_LDB8(B18, 1, 1); PG8_STAGE(PG8_SB(1, 0), b3, voffB);
            PG8_BAR; PG8_WAIT_L(0); PG8_MMA8(0, 1, At8, B18); PG8_BAR;
            PG8_LDA8(At8, 1, 1); PG8_STAGE(PG8_SA(1, 0), a3, o20);
            PG8_BAR; PG8_WAIT_L(0); PG8_MMA8(1, 0, At8, B08); PG8_BAR; PG8_SCHED;
            PG8_STAGE(PG8_SB(1, 1), b3 + hstep, voffB);
            PG8_WAIT_V(6); PG8_BAR; PG8_MMA8(1, 1, At8, B18); PG8_BAR;
            } else {
            PG8_LDB(B0, 0, 0); PG8_LDB(B1, 0, 1); PG8_SCHED; PG8_LDA(At, 0, 0); PG8_STAGE(PG8_SA(1, 1), a1, cO1);
            PG8_WAIT_V(8); PG8_WAIT_L(0); PG8_BAR; PG8_MMA(0, 0, At, B0); PG8_MMA(0, 1, At, B1); PG8_BAR; PG8_SCHED;
            PG8_LDA(At, 0, 1); PG8_STAGE(PG8_SB(0, 0), b2, voffB); PG8_STAGE(PG8_SB(0, 1), b2 + hstep, voffB); PG8_STAGE(PG8_SA(0, 0), a2, o20);
            PG8_WAIT_V(8); PG8_WAIT_L(0); PG8_BAR; PG8_MMA(1, 0, At, B0); PG8_MMA(1, 1, At, B1); PG8_BAR; PG8_SCHED;
            PG8_LDB(B0, 1, 0); PG8_LDB(B1, 1, 1); PG8_SCHED; PG8_LDA(At, 1, 0); PG8_STAGE(PG8_SA(0, 1), a2, o21);
            PG8_WAIT_V(8); PG8_WAIT_L(0); PG8_BAR; PG8_MMA(0, 0, At, B0); PG8_MMA(0, 1, At, B1); PG8_BAR; PG8_SCHED;
            PG8_LDA(At, 1, 1); PG8_STAGE(PG8_SB(1, 0), b3, voffB); PG8_STAGE(PG8_SB(1, 1), b3 + hstep, voffB); PG8_STAGE(PG8_SA(1, 0), a3, o20);
            PG8_WAIT_V(8); PG8_WAIT_L(0); PG8_BAR; PG8_MMA(1, 0, At, B0); PG8_MMA(1, 1, At, B1); PG8_BAR; PG8_SCHED;
            }
        }
        if (wr == 0) PG8_BAR;
        if constexpr (FP8) asm volatile("s_nop 15\n\ts_nop 15" ::: "memory");
        E(acc, cur, wr, wc, fr, fq);
        if (!has_next) break;
#pragma unroll
        for (int a = 0; a < 2; ++a)
#pragma unroll
            for (int b = 0; b < 2; ++b)
#pragma unroll
                for (int m = 0; m < 4; ++m)
#pragma unroll
                    for (int n = 0; n < 2; ++n) acc[a][b][m][n] = (f32x4){0.f, 0.f, 0.f, 0.f};
        cur = nxt; cA = nA; cB = nB; ++ui;
#pragma unroll
        for (int i_ = 0; i_ < 2; ++i_) { cO0[i_] = nO0[i_]; cO1[i_] = nO1[i_]; }
        if (wr == 1) PG8_BAR;
    }
    PG8_WAIT_V(0);
    PG8_BAR;
#undef PG8_SA
#undef PG8_GOFF
#undef PG8_SB
#undef PG8_STAGE
#undef PG8_LDA
#undef PG8_LDB
#undef PG8_MMA
#undef PG8_MMA8
#undef PG8_LDA8
#undef PG8_LDB8
#undef PG8_LD32
#undef PG8_WAIT_V
#undef PG8_WAIT_L
#undef PG8_BAR
#undef PG8_SCHED
}
template <bool FP8, bool GATHER, class Epi, class Sched>
__device__ __forceinline__ void gemm_phase_g(LAS unsigned char* lds, const int K, const Sched& S, const Epi& E, const int wid, const int lane) { gemm_phase_s<FP8, GATHER, !FP8>(lds, K, S, E, wid, lane); }
template <bool FP8, class Epi, class Sched>
__device__ __forceinline__ void gemm_phase(LAS unsigned char* lds, const int K, const Sched& S, const Epi& E, const int wid, const int lane) { gemm_phase_s<FP8, false, !FP8>(lds, K, S, E, wid, lane); }
}

__device__ __forceinline__ int lane_id() { int l; asm volatile("v_mbcnt_lo_u32_b32 %0, -1, 0\n\tv_mbcnt_hi_u32_b32 %0, -1, %0" : "=v"(l)); return l; }
#define FT_DECL const int f_lane = lane_id(), f_tid = F.wave * 64 + f_lane; (void)f_tid; (void)f_lane
typedef const float* cfp_t;
typedef __attribute__((address_space(4))) cfp_t* kin_t;
struct Frame {
    LAS unsigned char* lds;
    volatile LAS unsigned* MISC;
    gu32* ctl;
    int wave, vcu, G;
    kin_t in;
    float* out;
    unsigned char* ws;
};
#define WSP(T, off) ((T*)(F.ws + (off)))

template <class RowMap>
__device__ __forceinline__ void p0_transpose_item(const float* W, int K, int N, bf16_t* WT, const RowMap& rowmap, const float* kscale, LAS float* scr, int item, int lane, bool kperm = false) {
    const int nblk = N / 32, kb = item / nblk, nb = item % nblk, k0 = 64 * kb, n0 = 32 * nb;
#pragma unroll 8
    for (int i = 0; i < 32; ++i) { const int kk = 2 * i + (lane >> 5); int ks = k0 + kk; if (kperm && ks >= K / 2) { const int j = ks - K / 2; ks = K / 2 + (j >> 3) + 64 * (j & 7); }
        float v = W[(size_t)ks * N + n0 + (lane & 31)]; if (kscale) v *= kscale[k0 + kk]; scr[kk * 33 + (lane & 31)] = v; }
    LDS_WAIT(); asm volatile("" ::: "memory");
    const int c = lane & 7;
#pragma unroll
    for (int j = 0; j < 4; ++j) { const int n = (lane >> 3) + 8 * j; const LAS float* s = scr + (8 * c) * 33 + n;
        u32x4 o; o.x = cvt_pk_bf16(s[0 * 33], s[1 * 33]); o.y = cvt_pk_bf16(s[2 * 33], s[3 * 33]); o.z = cvt_pk_bf16(s[4 * 33], s[5 * 33]); o.w = cvt_pk_bf16(s[6 * 33], s[7 * 33]);
        *(GAS u32x4*)(WT + (size_t)rowmap(n0 + n) * K + k0 + 8 * c) = o; }
    LDS_WAIT(); asm volatile("" ::: "memory");
}

__device__ __forceinline__ unsigned pk4_fp8(float a, float b, float c, float d) { int r = __builtin_amdgcn_cvt_pk_fp8_f32(a, b, 0, false); r = __builtin_amdgcn_cvt_pk_fp8_f32(c, d, r, true); return (unsigned)r; }
constexpr float EOSCALE = 16.f;
constexpr float WSCALE = 32.f;
template <class RowMap>
__device__ __forceinline__ void p0_transpose_item_f8(const float* W, int K, int N, unsigned char* WT, const RowMap& rowmap, LAS float* scr, int item, int lane) {
    const int nblk = N / 32, kb = item / nblk, nb = item % nblk, k0 = 128 * kb, n0 = 32 * nb;
#pragma unroll
    for (int hh = 0; hh < 2; ++hh) { float v[32];
#pragma unroll
        for (int i = 0; i < 32; ++i) { const int kk = 2 * (32 * hh + i) + (lane >> 5); v[i] = __builtin_nontemporal_load(W + (size_t)(k0 + kk) * N + n0 + (lane & 31)); }
#pragma unroll
        for (int i = 0; i < 32; ++i) { const int kk = 2 * (32 * hh + i) + (lane >> 5); scr[kk * 33 + (lane & 31)] = v[i] * WSCALE; } }
    LDS_WAIT(); asm volatile("" ::: "memory");
    const int c = lane & 7;
#pragma unroll
    for (int j = 0; j < 4; ++j) { const int n = (lane >> 3) + 8 * j; const LAS float* sp = scr + (16 * c) * 33 + n;
        u32x4 o; o.x = pk4_fp8(sp[0 * 33], sp[1 * 33], sp[2 * 33], sp[3 * 33]); o.y = pk4_fp8(sp[4 * 33], sp[5 * 33], sp[6 * 33], sp[7 * 33]);
        o.z = pk4_fp8(sp[8 * 33], sp[9 * 33], sp[10 * 33], sp[11 * 33]); o.w = pk4_fp8(sp[12 * 33], sp[13 * 33], sp[14 * 33], sp[15 * 33]);
        *(GAS u32x4*)(WT + (size_t)rowmap(n0 + n) * K + k0 + 16 * c) = o; }
    LDS_WAIT(); asm volatile("" ::: "memory");
}
struct MapW2 { __device__ __forceinline__ int operator()(int l) const { const int t = l & ~255, r = l & 255, wc = r >> 6, fq = (r >> 4) & 3, bj = (r >> 3) & 1, low = r & 7; return t + 128 * bj + 32 * wc + 8 * fq + low; } };
struct MapIdent { int off; __device__ __forceinline__ int operator()(int n) const { return off + n; } };
struct MapWin { __device__ __forceinline__ int operator()(int l) const {
    if (l >= 1024) return l;
    const int t = l & ~255, r = l & 255, wc = r >> 6, blk = (r >> 5) & 1, bj = (r >> 4) & 1, low = r & 15;
    return t + 128 * bj + 32 * wc + 16 * blk + low; } };
struct MapW1 { int off; __device__ __forceinline__ int operator()(int jp) const { const int bj = jp >> 10, j = jp & 1023; return off + 256 * (j >> 7) + 128 * bj + (j & 127); } };


__device__ __forceinline__ void p0_filter_item(Frame& F, int item) {
    FT_DECL;
#define in F.in
    LAS float* h1s = (LAS float*)(F.lds);
    LAS float* h2s = (LAS float*)(F.lds + 4096);
    const int t0 = item * 16;
    {
        const int tt = f_tid >> 5, hh = (f_tid & 31) * 2; const float pos = (float)(t0 + tt);
        float feats[17]; feats[0] = pos * (1.f / SEQ);
#pragma unroll
        for (int i = 0; i < 8; ++i) { const float band = 1e-4f + (float)i * ((7.f - 1e-4f) / 7.f); const float ang = (6.283185307179586f / SEQ) * pos * band; feats[1 + i] = __sinf(ang); feats[9 + i] = __cosf(ang); }
#pragma unroll
        for (int u = 0; u < 2; ++u) { const int h = hh + u; float a = in[19][h];
#pragma unroll
            for (int k = 0; k < 17; ++k) a += feats[k] * in[18][k * 64 + h];
            h1s[tt * 64 + h] = __sinf(in[20][h] * a); }
        __syncthreads();
#pragma unroll
        for (int u = 0; u < 2; ++u) { const int h = hh + u; float a = in[22][h];
#pragma unroll 8
            for (int k = 0; k < 64; ++k) a += h1s[tt * 64 + k] * in[21][k * 64 + h];
            h2s[tt * 64 + h] = __sinf(in[23][h] * a); }
        __syncthreads();
    }
    f32x4 acc[16];
#pragma unroll
    for (int t = 0; t < 16; ++t) acc[t] = (f32x4){0.f, 0.f, 0.f, 0.f};
    const int o = 4 * f_tid;
    for (int k0 = 0; k0 < 64; k0 += 4) { f32x4 w[4];
#pragma unroll
        for (int q = 0; q < 4; ++q) w[q] = *(const f32x4*)(in[24] + (size_t)(k0 + q) * 2048 + o);
#pragma unroll
        for (int t = 0; t < 16; ++t) { const f32x4 hv = *(const LAS f32x4*)(h2s + t * 64 + k0); acc[t] += w[0] * hv[0] + w[1] * hv[1] + w[2] * hv[2] + w[3] * hv[3]; } }
    const int c0 = o & 511, od = o >> 9;
    float* dst = WSP(float, WS_FILT) + ((size_t)od * 512 + c0) * SEQ + t0;
#pragma unroll
    for (int e = 0; e < 4; ++e) { const float la = -3.0701134573253944f, lb = -15.350567286626972f; const float delta = fabsf(la + (float)(c0 + e) * ((lb - la) / 511.f));
#pragma unroll
        for (int q = 0; q < 4; ++q) { f32x4 v;
#pragma unroll
            for (int i = 0; i < 4; ++i) { const int t = 4 * q + i; const float tn = (float)(t0 + t) * (1.f / SEQ); v[i] = acc[t][e] * __expf(-tn * delta); }
            *(f32x4*)(dst + (size_t)e * SEQ + 4 * q) = v; } }
    __syncthreads();
#undef in
}

__device__ __forceinline__ float silu_f(float v) { return v / (1.f + __expf(-v)); }

__device__ __forceinline__ void p0_prologue(Frame& F) {
    FT_DECL;
#define in F.in
    const int wg = blockIdx.x;
    if (wg < 96) {
        LAS float* sv = (LAS float*)F.lds;
        for (int i = f_tid; i < 9 * 1024; i += 512) { const int r = i >> 10, k = i & 1023; const float c = (r < 8) ? in[1][r * 1024 + k] : in[3][k]; sv[i] = silu_f(c); }
        __syncthreads();
        const int j = wg * 64 + f_lane; const float* wm = in[4];
        float acc[9];
#pragma unroll
        for (int r = 0; r < 9; ++r) acc[r] = 0.f;
        const int kbeg = F.wave * 128;
        for (int k0 = kbeg; k0 < kbeg + 128; k0 += 16) { float w[16];
#pragma unroll
            for (int q = 0; q < 16; ++q) w[q] = __builtin_nontemporal_load(wm + (size_t)(k0 + q) * (NMOD * DM) + j);
#pragma unroll
            for (int q = 0; q < 16; ++q)
#pragma unroll
                for (int r = 0; r < 9; ++r) acc[r] += sv[r * 1024 + k0 + q] * w[q]; }
        LAS float* red = (LAS float*)(F.lds + 40960);
#pragma unroll
        for (int r = 0; r < 9; ++r) red[(F.wave * 9 + r) * 64 + f_lane] = acc[r];
        __syncthreads();
        for (int i = f_tid; i < 9 * 64; i += 512) { const int r = i >> 6, l = i & 63; float s = in[5][wg * 64 + l];
#pragma unroll
            for (int w = 0; w < 8; ++w) s += red[(w * 9 + r) * 64 + l];
            WSP(float, WS_SMALL + SM_MOD)[r * (NMOD * DM) + wg * 64 + l] = s; }
        asm volatile("s_waitcnt vmcnt(0)" ::: "memory");
        __syncthreads();
        if (f_tid == 0) { __builtin_amdgcn_fence(__ATOMIC_RELEASE, "agent"); asm volatile("s_waitcnt vmcnt(0)" ::: "memory"); (void)xb_add((unsigned*)(F.ctl + CW_GEMV), 1u); }
    } else if (wg == 96) {
        if (F.wave == 0) {
            const float a = wave_sum(in[11][f_lane] * in[12][f_lane]), b = wave_sum(in[13][f_lane] * in[14][f_lane]);
            float gq = fabsf(in[9][f_lane]), gk = fabsf(in[10][f_lane]);
#pragma unroll
            for (int o = 1; o < 64; o <<= 1) { gq = fmaxf(gq, __shfl_xor(gq, o)); gk = fmaxf(gk, __shfl_xor(gk, o)); }
            if (f_lane == 0) { float* sc = WSP(float, WS_SMALL + SM_SCAL); sc[0] = expf(a) - expf(b) + LAM_INIT;
                sc[1] = (8.f * gq * gk * 1.02f + 0.05f) * 1.4426950408889634f; }
        }
        for (int i = f_tid; i < 64 * 16; i += 512) { const int pos = i >> 4, f = i & 15;
            const float inv = powf(10000.f, -(float)f / 16.f); const float ang = (float)pos * inv;
            float* rt = WSP(float, WS_SMALL + SM_ROPE); rt[2 * i] = cosf(ang); rt[2 * i + 1] = sinf(ang); }
    }
    __syncthreads();
    for (int it = wg; it < SEQ / 16; it += F.G) p0_filter_item(F, it);
    __syncthreads();
    {
        LAS float* scr = (LAS float*)(F.lds + F.wave * 16896);
        const int gw = F.vcu * NWAVES + F.wave, NGW = F.G * NWAVES;
        constexpr int I_IN = (DM / 64) * (INC / 32), I_OUT = (DM / 64) * (DM / 32), I_1 = (DM / 128) * (2 * DM / 32), I_2 = (DM / 128) * (DM / 32);
        constexpr int NITEMS = I_IN + I_OUT + NEXP * (I_1 + I_2);
        for (int it = gw; it < NITEMS; it += NGW) {
            int r = it;
            if (r < I_IN) { p0_transpose_item(in[8], DM, INC, WSP(bf16_t, WS_WIN), MapWin{}, nullptr, scr, r, f_lane); continue; } r -= I_IN;
            if (r < I_OUT) { p0_transpose_item(in[27], DM, DM, WSP(bf16_t, WS_WOUT), MapIdent{0}, nullptr, scr, r, f_lane, true); continue; } r -= I_OUT;
            const int e = r / (I_1 + I_2); r -= e * (I_1 + I_2);
            if (r < I_1) p0_transpose_item_f8(in[30] + (size_t)e * DM * 2 * DM, DM, 2 * DM, WSP(unsigned char, WS_W1) + (size_t)e * 2 * DM * DM, MapW1{0}, scr, r, f_lane);
            else p0_transpose_item_f8(in[32] + (size_t)e * DM * DM, DM, DM, WSP(unsigned char, WS_W2) + (size_t)e * DM * DM, MapW2{}, scr, r - I_1, f_lane);
        }
    }
}
#undef in

__device__ __forceinline__ void p1_norm1(Frame& F) {
    FT_DECL;
    const int gw = F.vcu * NWAVES + F.wave, NGW = F.G * NWAVES;
    const float* mod = WSP(float, WS_SMALL + SM_MOD); const float* g1 = F.in[6];
    bf16_t* H = WSP(bf16_t, WS_H);
    if (f_tid == 0) { unsigned* bar = (unsigned*)(F.ctl + CW_BAR); XB_SPIN(xb_ld((unsigned*)(F.ctl + CW_GEMV)) < 96u, bar); __builtin_amdgcn_fence(__ATOMIC_ACQUIRE, "agent"); asm volatile("s_waitcnt vmcnt(0)" ::: "memory"); }
    __syncthreads();
    for (int pe = blockIdx.x; pe < NB * NEXP; pe += F.G) { const int b = pe >> 5, e = pe & 31; const float* sh2 = mod + (size_t)b * (NMOD * DM) + 3 * DM; const float* rw = F.in[28];
        const int t = F.wave * 64 + lane_id();
        float a = sh2[t] * rw[(size_t)t * 32 + e] + sh2[t + 512] * rw[(size_t)(t + 512) * 32 + e];
        a = wave_sum(a);
        LAS float* red = (LAS float*)F.lds;
        __syncthreads(); if (lane_id() == 0) red[F.wave] = a; __syncthreads();
        if (t == 0) { float sacc = F.in[29][e];
#pragma unroll
            for (int w = 0; w < NWAVES; ++w) sacc += red[w];
            WSP(float, WS_SMALL + SM_RBIAS)[pe] = sacc; }
        __syncthreads(); }
    constexpr int RPW = MTOT / (256 * NWAVES);
    for (int run = gw; run * RPW < MTOT; run += NGW) {
        const int r0 = run * RPW, r1 = (r0 + RPW < MTOT) ? r0 + RPW : MTOT;
        int curb = -1; f32x4 PA[4], PB[4];
        for (int m0 = r0; m0 < r1; m0 += 4) {
            f32x4 v[4][4];
#pragma unroll
            for (int u = 0; u < 4; ++u) { const int m = m0 + u; if (m < r1) {
                const float* xrow = (m < MROWS) ? F.in[0] + (size_t)m * DM : F.in[2] + (size_t)(m - MROWS) * DM; const GAS f32x4* xr = (const GAS f32x4*)xrow + f_lane;
#pragma unroll
                for (int j = 0; j < 4; ++j) v[u][j] = __builtin_nontemporal_load(xr + 64 * j); } }
#pragma unroll
            for (int u = 0; u < 4; ++u) { const int m = m0 + u; if (m < r1) {
                const int mb = (m < MROWS) ? (m >> 12) : 8;
                if (mb != curb) { curb = mb; const float* sh = mod + (size_t)mb * (NMOD * DM); const float* sc = sh + DM;
#pragma unroll
                    for (int j = 0; j < 4; ++j) { const int c = 4 * f_lane + 256 * j; PA[j] = *(const f32x4*)(g1 + c) * (*(const f32x4*)(sc + c) + 1.f); PB[j] = *(const f32x4*)(sh + c); } }
                float s = 0.f;
#pragma unroll
                for (int j = 0; j < 4; ++j) s += (v[u][j].x * v[u][j].x + v[u][j].y * v[u][j].y) + (v[u][j].z * v[u][j].z + v[u][j].w * v[u][j].w);
                const float rstd = rsqrtf(wave_sum(s) * (1.f / DM) + EPS);
                GAS u32x2* o8 = (GAS u32x2*)(H + (size_t)m * DM) + f_lane;
#pragma unroll
                for (int j = 0; j < 4; ++j) { const f32x4 y = v[u][j] * rstd * PA[j] + PB[j];
                    u32x2 w; w.x = cvt_pk_bf16(y.x, y.y); w.y = cvt_pk_bf16(y.z, y.w); o8[64 * j] = w; } } }
        }
    }
}

struct SchedInProj {
    int G, c; const char* H; const char* W;
    static constexpr int NA = 136 * 4, NV = 2 * 136, NBU = 6 * 128;
    __device__ __forceinline__ bool next(int i, g8::Unit& u) const {
        const long L = (long)i * G + c;
        if (L < NA) { g8::tile_of((int)L, 136, 4, u.pm, u.pn); u.a = H + (size_t)u.pm * 256 * DM * 2; u.b = W + (size_t)u.pn * 256 * DM * 2; u.kind = 0; u.ex = 0; return true; }
        if (L < NA + NV) { g8::tile_of((int)L - NA, 2, 136, u.pm, u.pn); u.a = W + (size_t)(1024 + u.pm * 256) * DM * 2; u.b = H + (size_t)u.pn * 256 * DM * 2; u.kind = 2; u.ex = 0; return true; }
        if (L < NA + NV + NBU) { g8::tile_of((int)L - NA - NV, 6, 128, u.pm, u.pn); u.a = W + (size_t)(QKVC + u.pm * 256) * DM * 2; u.b = H + (size_t)u.pn * 256 * DM * 2; u.kind = 1; u.ex = 0; return true; }
        return false;
    }
};
constexpr float Q8SCALE = 16.f;
struct EpiInProj {
    unsigned char *Q8, *K8, *VT8; bf16_t* UT; const float *gq, *gk, *rope;
    __device__ __forceinline__ void operator()(f32x4 (&acc)[2][2][4][2], const g8::Unit& u, int wr, int wc, int fr, int fq) const {
        asm volatile("" : "+v"(fr), "+v"(fq));
        if (u.kind == 1) {
            const int row0 = u.pm * 256 + wr * 64 + fr, col0 = u.pn * 256 + wc * 32 + 8 * fq;
#pragma unroll
            for (int ai = 0; ai < 2; ++ai)
#pragma unroll
                for (int m = 0; m < 4; ++m) { const int ch = row0 + ai * 128 + m * 16;
#pragma unroll
                    for (int bj = 0; bj < 2; ++bj) { const int tok = col0 + bj * 128; const f32x4 v0 = acc[ai][bj][m][0], v1 = acc[ai][bj][m][1];
                        u32x4 w; w.x = cvt_pk_bf16(v0[0], v0[1]); w.y = cvt_pk_bf16(v0[2], v0[3]); w.z = cvt_pk_bf16(v1[0], v1[1]); w.w = cvt_pk_bf16(v1[2], v1[3]);
                        *(u32x4*)(UT + ((size_t)(tok >> 7) * HYC + ch) * 128 + (tok & 127)) = w; } }
            return;
        }
        if (u.kind == 2) {
#pragma unroll
            for (int bj = 0; bj < 2; ++bj) { const int t8 = u.pn * 256 + bj * 128 + wc * 32 + 8 * fq;
                int b, key; if (t8 < MROWS) { b = t8 >> 12; key = CTXL + (t8 & 4095); } else { const int j = t8 - MROWS; b = j >> 8; key = j & 255; }
                const int tile = key >> 6, k = key & 63, ipos = (k < 32) ? 4 * (k >> 3) : 16 + 4 * ((k - 32) >> 3);
#pragma unroll
                for (int ai = 0; ai < 2; ++ai)
#pragma unroll
                    for (int m = 0; m < 4; ++m) { const int ch = u.pm * 256 + ai * 128 + wr * 64 + m * 16 + fr;
                        unsigned char* dst = VT8 + ((((size_t)(b * NHEAD + (ch >> 7)) * 68 + tile) * 128 + (ch & 127)) * 64) + ipos;
                        const f32x4 v0 = acc[ai][bj][m][0], v1 = acc[ai][bj][m][1];
                        *(unsigned*)dst = pk4_fp8(v0[0], v0[1], v0[2], v0[3]); *(unsigned*)(dst + 32) = pk4_fp8(v1[0], v1[1], v1[2], v1[3]); } }
            return;
        }
        const int blk = fq >> 1, f = fq & 1;
        const int sec = u.pn >> 1;
        const bool ctx = (u.pm >= 128);
        if (sec == 0 && ctx) return;
        const int colbase = (u.pn & 1) * 256 + wc * 64 + 32 * blk + 8 * f;
        float gg[2][2][4];
        { const float* gp = (sec == 0 ? gq : gk) + 32 * blk + 8 * f;
#pragma unroll
            for (int bj = 0; bj < 2; ++bj)
#pragma unroll
                for (int n = 0; n < 2; ++n) { const f32x4 t = *(const f32x4*)(gp + 16 * bj + 4 * n); gg[bj][n][0] = t[0]; gg[bj][n][1] = t[1]; gg[bj][n][2] = t[2]; gg[bj][n][3] = t[3]; } }
#pragma unroll
        for (int ai = 0; ai < 2; ++ai)
#pragma unroll
            for (int m = 0; m < 4; ++m) {
                const int rloc = ai * 128 + wr * 64 + m * 16 + fr; const int r = u.pm * 256 + rloc;
                f32x4 v[2][2];
#pragma unroll
                for (int bj = 0; bj < 2; ++bj)
#pragma unroll
                    for (int n = 0; n < 2; ++n) v[bj][n] = acc[ai][bj][m][n];
                size_t orow;
                if (sec == 0) orow = (size_t)r;
                else if (!ctx) orow = (size_t)(r >> 12) * KVL + CTXL + (r & 4095);
                else { const int j = r - MROWS; orow = (size_t)(j >> 8) * KVL + (j & 255); }
                float ss = 0.f;
#pragma unroll
                for (int bj = 0; bj < 2; ++bj)
#pragma unroll
                    for (int n = 0; n < 2; ++n) ss += (v[bj][n][0] * v[bj][n][0] + v[bj][n][1] * v[bj][n][1]) + (v[bj][n][2] * v[bj][n][2] + v[bj][n][3] * v[bj][n][3]);
                ss += __shfl_xor(ss, 16); ss += __shfl_xor(ss, 32);
                const float rstd = rsqrtf(ss * (1.f / 64.f) + EPS) * (sec == 0 ? QSCALE * Q8SCALE : 1.f);
#pragma unroll
                for (int bj = 0; bj < 2; ++bj)
#pragma unroll
                    for (int n = 0; n < 2; ++n)
#pragma unroll
                        for (int e = 0; e < 4; ++e) v[bj][n][e] *= rstd * gg[bj][n][e];
                if (!ctx) {
                    const int t = r & 4095; const int pos = blk ? (t & 63) : (t >> 6);
                    const float* rp = rope + (size_t)(pos * 16 + 8 * f) * 2;
#pragma unroll
                    for (int n = 0; n < 2; ++n) { const f32x4 c0 = *(const f32x4*)(rp + 8 * n), c1 = *(const f32x4*)(rp + 8 * n + 4);
                        const float cs[4] = {c0[0], c0[2], c1[0], c1[2]}, sn[4] = {c0[1], c0[3], c1[1], c1[3]};
#pragma unroll
                        for (int e = 0; e < 4; ++e) { const float x1 = v[0][n][e], x2 = v[1][n][e]; v[0][n][e] = x1 * cs[e] - x2 * sn[e]; v[1][n][e] = x2 * cs[e] + x1 * sn[e]; } }
                }
                unsigned char* dst = (sec == 0 ? Q8 : K8) + orow * QKW + colbase;
#pragma unroll
                for (int bj = 0; bj < 2; ++bj) { u32x2 w; w.x = pk4_fp8(v[bj][0][0], v[bj][0][1], v[bj][0][2], v[bj][0][3]); w.y = pk4_fp8(v[bj][1][0], v[bj][1][1], v[bj][1][2], v[bj][1][3]);
                    *(u32x2*)(dst + 16 * bj) = w; }
            }
    }
};

struct SchedStatic {
    int G, c, nM, nN; const char* A; const char* B;
    __device__ __forceinline__ bool next(int i, g8::Unit& u) const {
        const long L = (long)i * G + c; if (L >= (long)nM * nN) return false;
        g8::tile_of((int)L, nM, nN, u.pm, u.pn); u.a = A + (size_t)u.pm * 256 * DM * 2; u.b = B + (size_t)u.pn * 256 * DM * 2; u.kind = 0; u.ex = 0; return true;
    }
};
struct EpiOutProj {
    const float* x; bf16_t* out; const float* mod;
    __device__ __forceinline__ void operator()(f32x4 (&acc)[2][2][4][2], const g8::Unit& u, int wr, int wc, int fr, int fq) const {
        asm volatile("" : "+v"(fr), "+v"(fq));
        const int col0 = u.pn * 256 + wc * 32 + 8 * fq;
        const float* g1 = mod + (size_t)((u.pm * 256) >> 12) * (NMOD * DM) + 2 * DM + col0;
        f32x4 gv[2][2];
#pragma unroll
        for (int bj = 0; bj < 2; ++bj)
#pragma unroll
            for (int n = 0; n < 2; ++n) gv[bj][n] = *(const f32x4*)(g1 + bj * 128 + 4 * n);
#pragma unroll
        for (int ai = 0; ai < 2; ++ai)
#pragma unroll
            for (int m = 0; m < 4; ++m) { const int r = u.pm * 256 + ai * 128 + wr * 64 + m * 16 + fr;
                const size_t off = (size_t)r * DM + col0;
#pragma unroll
                for (int bj = 0; bj < 2; ++bj) { f32x4 o[2];
#pragma unroll
                    for (int n = 0; n < 2; ++n) { const f32x4 xv = __builtin_nontemporal_load((const f32x4*)(x + off + bj * 128 + 4 * n)); o[n] = xv + gv[bj][n] * acc[ai][bj][m][n]; }
                    u32x4 w; w.x = cvt_pk_bf16(o[0][0], o[0][1]); w.y = cvt_pk_bf16(o[0][2], o[0][3]); w.z = cvt_pk_bf16(o[1][0], o[1][1]); w.w = cvt_pk_bf16(o[1][2], o[1][3]);
                    *(u32x4*)(out + off + bj * 128) = w; } }
    }
};

namespace att8 {
constexpr int NT = KVL / 64, SHMB = 8192, NBUF = 6, LDS_V0 = NBUF * SHMB;
typedef int i32x8 __attribute__((ext_vector_type(8)));
#define SBAR() __builtin_amdgcn_sched_barrier(0)
__device__ __forceinline__ int crow(int r, int hi) { return (r & 3) + 8 * (r >> 2) + 4 * hi; }
__device__ __forceinline__ i32x8 ld32(const LAS unsigned char* p0, const LAS unsigned char* p1) {
    const u32x4 a = *(const LAS u32x4*)p0, b = *(const LAS u32x4*)p1; return (i32x8){(int)a.x, (int)a.y, (int)a.z, (int)a.w, (int)b.x, (int)b.y, (int)b.z, (int)b.w}; }
__device__ __forceinline__ void mfma_qk(f32x16& p, const i32x8& kf, const i32x8& qf, const f32x16& negc) {
    const unsigned s1 = 0x7f7f7f7fu, sq = 0x7b7b7b7bu;
    asm volatile("v_mfma_scale_f32_32x32x64_f8f6f4 %0, %1, %2, %3, %4, %5 op_sel_hi:[0,0,0]" : "=&v"(p) : "v"(kf), "v"(qf), "v"(negc), "v"(s1), "v"(sq));
}
__device__ __forceinline__ void mfma_pv(f32x16& o, const i32x8& pa, const i32x8& vf) {
    const unsigned s1 = 0x7f7f7f7fu;
    asm volatile("v_mfma_scale_f32_32x32x64_f8f6f4 %0, %1, %2, %0, %3, %3 op_sel_hi:[0,0,0]" : "+v"(o) : "v"(pa), "v"(vf), "v"(s1));
}
__device__ __forceinline__ void mfma_wait(f32x16& p0, f32x16& p1) { asm volatile("s_nop 15\n\ts_nop 3" : "+v"(p0), "+v"(p1)); }
__device__ __forceinline__ int grp(const f32x16& s, const int g, int old) {
    old = __builtin_amdgcn_cvt_pk_fp8_f32(__builtin_amdgcn_exp2f(s[4 * g]), __builtin_amdgcn_exp2f(s[4 * g + 1]), old, false);
    return __builtin_amdgcn_cvt_pk_fp8_f32(__builtin_amdgcn_exp2f(s[4 * g + 2]), __builtin_amdgcn_exp2f(s[4 * g + 3]), old, true);
}
__device__ __forceinline__ void attn_unit(const unsigned char* __restrict__ Qb, const unsigned char* __restrict__ Kh, const unsigned char* __restrict__ VTh, bf16_t* MIXo,
                                          const float lam, const float* __restrict__ subg, char* lds, const int wid,
                                          const bool pre, i32x8& qf, const unsigned char* Qn, const unsigned char* Kn, const unsigned char* VTn) {
    const int lane = lane_id(), tid = wid * 64 + lane, r32 = lane & 31, hi = lane >> 5;
    const int sub = wid >> 2, wq = wid & 3;
    const LAS unsigned char* L = (const LAS unsigned char*)(uintptr_t)(unsigned)(uintptr_t)lds;
    f32x16 o[4] = {}; f32x16 ol = {};
    i32x8 ones; { int c1 = 0x38383838; asm volatile("" : "+v"(c1)); ones = (i32x8){c1, c1, c1, c1, c1, c1, c1, c1}; }
    const size_t qoff = (size_t)(wq * 32 + r32) * QKW + sub * 64 + 32 * hi;
    if (!pre) { const unsigned char* qp = Qb + qoff; const u32x4 a = *(const u32x4*)qp, b = *(const u32x4*)(qp + 16);
        qf = (i32x8){(int)a.x, (int)a.y, (int)a.z, (int)a.w, (int)b.x, (int)b.y, (int)b.z, (int)b.w}; }
    f32x16 negc; { float m5 = -5.f; asm volatile("" : "+v"(m5));
#pragma unroll
        for (int r = 0; r < 16; ++r) negc[r] = m5; }
    long ksrc, vsrc;
    { const int r = 8 * wid + (lane >> 3), c = (lane & 7) ^ ((r >> 1) & 7); ksrc = (long)r * QKW + c * 16; }
    { const int d = 16 * wid + (lane >> 2), c = (lane & 3) ^ ((d >> 2) & 3); vsrc = (long)d * 64 + c * 16; }
    const unsigned ldsb = (unsigned)(uintptr_t)lds, kdst = ldsb + (unsigned)wid * 1024u, vdst = ldsb + LDS_V0 + (unsigned)wid * 1024u;
    const LAS unsigned char *pk0, *pk1, *pv0, *pv1;
    { const int c0 = sub * 4 + hi * 2, sk = (r32 >> 1) & 7, sv = (r32 >> 2) & 3;
      pk0 = L + r32 * 128 + ((c0 ^ sk) << 4); pk1 = L + r32 * 128 + (((c0 + 1) ^ sk) << 4);
      pv0 = L + LDS_V0 + r32 * 64 + (((2 * hi) ^ sv) << 4); pv1 = L + LDS_V0 + r32 * 64 + (((2 * hi + 1) ^ sv) << 4); }
#define KF(b, w) ld32(pk0 + (b) * SHMB + (w) * 4096, pk1 + (b) * SHMB + (w) * 4096)
#define VF(b, d0) ld32(pv0 + (b) * SHMB + (d0) * 2048, pv1 + (b) * SHMB + (d0) * 2048)
#define DMA_TILE(t, b) DMA_TILE_P(Kh, VTh, t, b)
#define DMA_TILE_P(KP, VP, t, b) do { \
        __builtin_amdgcn_global_load_lds((const unsigned*)((KP) + (long)(t) * 64 * QKW + ksrc), (LAS unsigned*)(uintptr_t)__builtin_amdgcn_readfirstlane(kdst + (unsigned)((b) * SHMB)), 16, 0, 0); \
        __builtin_amdgcn_global_load_lds((const unsigned*)((VP) + (long)(t) * 8192 + vsrc), (LAS unsigned*)(uintptr_t)__builtin_amdgcn_readfirstlane(vdst + (unsigned)((b) * SHMB)), 16, 0, 0); } while (0)
#define WBAR() do { asm volatile("s_waitcnt vmcnt(0)" ::: "memory"); __builtin_amdgcn_s_barrier(); asm volatile("" ::: "memory"); } while (0)
#define ITER(J, U, SX0, SX1, SY0, SY1, PC, PN, DO_DMA, DO_QK, DO_BAR) do { \
        mfma_pv(ol, PC, ones); SBAR(); \
        if (DO_DMA) { if ((J) + 3 < NT) DMA_TILE((J) + 3, ((U) + 4) % NBUF); if ((J) + 4 < NT) DMA_TILE((J) + 4, ((U) + 5) % NBUF); } \
        PN[0] = grp(SX0, 0, PN[0]); SBAR(); \
        mfma_pv(o[0], PC, vf0); SBAR(); \
        vf3 = VF(U, 3); if (DO_QK) { kf0 = KF(((U) + 2) % NBUF, 0); kf1 = KF(((U) + 2) % NBUF, 1); } \
        PN[1] = grp(SX0, 1, PN[1]); SBAR(); \
        mfma_pv(o[1], PC, vf1); SBAR(); PN[2] = grp(SX0, 2, PN[2]); SBAR(); \
        mfma_pv(o[2], PC, vf2); SBAR(); PN[3] = grp(SX0, 3, PN[3]); SBAR(); \
        mfma_pv(o[3], PC, vf3); SBAR(); PN[4] = grp(SX1, 0, PN[4]); SBAR(); \
        if (DO_QK) mfma_qk(SY0, kf0, qf, negc); SBAR(); PN[5] = grp(SX1, 1, PN[5]); SBAR(); \
        if (DO_QK) mfma_qk(SY1, kf1, qf, negc); SBAR(); PN[6] = grp(SX1, 2, PN[6]); PN[7] = grp(SX1, 3, PN[7]); \
        vf0 = VF(((U) + 1) % NBUF, 0); vf1 = VF(((U) + 1) % NBUF, 1); vf2 = VF(((U) + 1) % NBUF, 2); SBAR(); \
        if (DO_BAR) WBAR(); } while (0)
    f32x16 A0, A1, B0, B1; i32x8 paA = {}, paB = {}, kf0, kf1, vf0, vf1, vf2, vf3;
    if (!pre) { DMA_TILE(0, 0); DMA_TILE(1, 1); DMA_TILE(2, 2); DMA_TILE(3, 3); }
    WBAR();
    kf0 = KF(0, 0); kf1 = KF(0, 1); mfma_qk(A0, kf0, qf, negc); mfma_qk(A1, kf1, qf, negc);
    kf0 = KF(1, 0); kf1 = KF(1, 1); SBAR(); mfma_qk(B0, kf0, qf, negc); mfma_qk(B1, kf1, qf, negc);
    mfma_wait(A0, A1);
#pragma unroll
    for (int g = 0; g < 4; ++g) { paA[g] = grp(A0, g, paA[g]); paA[4 + g] = grp(A1, g, paA[4 + g]); }
    mfma_wait(B0, B1);
    vf0 = VF(0, 0); vf1 = VF(0, 1); vf2 = VF(0, 2); SBAR();
    static_assert(NT == 68, "the loop below (11 trips of 6 iterations, then iteration 67) is written for 68 KV tiles");
#pragma unroll 1
    for (int j = 1; j < NT - 2; j += 6) {
        ITER(j, 0, B0, B1, A0, A1, paA, paB, true, true, false);
        ITER(j + 1, 1, A0, A1, B0, B1, paB, paA, false, true, true);
        ITER(j + 2, 2, B0, B1, A0, A1, paA, paB, true, true, false);
        ITER(j + 3, 3, A0, A1, B0, B1, paB, paA, false, true, true);
        ITER(j + 4, 4, B0, B1, A0, A1, paA, paB, true, true, false);
        ITER(j + 5, 5, A0, A1, B0, B1, paB, paA, false, true, true);
    }
    ITER(67, 0, B0, B1, A0, A1, paA, paB, false, false, false);
    mfma_pv(ol, paB, ones); vf3 = VF(1, 3); SBAR();
    mfma_pv(o[0], paB, vf0); mfma_pv(o[1], paB, vf1); mfma_pv(o[2], paB, vf2); mfma_pv(o[3], paB, vf3);
    asm volatile("s_nop 15\n\ts_nop 3" : "+v"(o[0]), "+v"(o[1]), "+v"(o[2]), "+v"(o[3]), "+v"(ol));
#undef ITER
#undef KF
#undef VF
    float sg[4];
#pragma unroll
    for (int d0 = 0; d0 < 4; ++d0) sg[d0] = subg[d0 * 32 + r32] * (1.f - LAM_INIT);
    __syncthreads();
    if (Qn != nullptr) { const unsigned char* qp = Qn + qoff; const u32x4 a = *(const u32x4*)qp, b = *(const u32x4*)(qp + 16);
        qf = (i32x8){(int)a.x, (int)a.y, (int)a.z, (int)a.w, (int)b.x, (int)b.y, (int)b.z, (int)b.w};
        DMA_TILE_P(Kn, VTn, 0, 0); DMA_TILE_P(Kn, VTn, 1, 1); DMA_TILE_P(Kn, VTn, 2, 2); DMA_TILE_P(Kn, VTn, 3, 3); }
#define XOFF(q) ((q) == 0 ? 4 * SHMB : (q) == 1 ? LDS_V0 + 4 * SHMB : LDS_V0 + NBUF * SHMB + ((q) - 2) * 16384)
    float* X = (float*)(lds + XOFF(wq));
    float rli[16];
#pragma unroll
    for (int r = 0; r < 16; ++r) rli[r] = __builtin_amdgcn_rcpf(ol[r]);
    if (sub == 1) {
#pragma unroll
        for (int r = 0; r < 16; ++r) { const int row = crow(r, hi); const float sc = lam * rli[r];
#pragma unroll
            for (int d0 = 0; d0 < 4; ++d0) X[row * 128 + d0 * 32 + r32] = o[d0][r] * sc; }
    }
    __syncthreads();
    if (sub == 0) {
        bf16_t* Y = (bf16_t*)X;
#pragma unroll
        for (int r = 0; r < 16; ++r) { const int row = crow(r, hi);
            float v[4]; float ss = 0.f;
#pragma unroll
            for (int d0 = 0; d0 < 4; ++d0) { v[d0] = o[d0][r] * rli[r] - X[row * 128 + d0 * 32 + r32]; ss += v[d0] * v[d0]; }
            ss += __shfl_xor(ss, 1); ss += __shfl_xor(ss, 2); ss += __shfl_xor(ss, 4); ss += __shfl_xor(ss, 8); ss += __shfl_xor(ss, 16);
            const float rstd = rsqrtf(ss * (1.f / 128.f) + EPS);
            asm volatile("" ::: "memory");
#pragma unroll
            for (int d0 = 0; d0 < 4; ++d0) Y[row * 256 + d0 * 32 + r32] = (bf16_t)(cvt_pk_bf16(v[d0] * rstd * sg[d0], 0.f) & 0xffffu); }
    }
    __syncthreads();
    { const int row = tid >> 2, seg = (tid & 3) * 32, qr = row >> 5; const bf16_t* Yr = (const bf16_t*)(lds + XOFF(qr)) + (row & 31) * 256 + seg;
#pragma unroll
        for (int i = 0; i < 4; ++i) { const u32x4 v = *(const u32x4*)(Yr + i * 8); *(u32x4*)(MIXo + (size_t)row * DM + seg + i * 8) = v; } }
    __syncthreads();
#undef XOFF
#undef DMA_TILE
#undef DMA_TILE_P
#undef WBAR
}
#undef SBAR
}

__device__ __forceinline__ void p3_attention8(Frame& F) {
    FT_DECL;
    const float* sc = WSP(float, WS_SMALL + SM_SCAL);
    const float lam = sc[0];
    const unsigned char* Q8 = WSP(unsigned char, WS_Q); const unsigned char* K8 = WSP(unsigned char, WS_K); const unsigned char* VT8 = WSP(unsigned char, WS_V); bf16_t* MIX = WSP(bf16_t, WS_MIX);
    const int c = blockIdx.x, xcd = c & 7, ci = c >> 3, per = F.G >> 3;
    att8::i32x8 qf = {}; bool pre = false;
    for (int j = ci; j < 128; j += per) {
        const int pair = xcd * 4 + (j >> 5), qb = j & 31, b = pair >> 2, h = pair & 3;
        const int jn = j + per; const bool hn = jn < 128; const int pairn = xcd * 4 + (jn >> 5), qbn = jn & 31, bn = pairn >> 2, hn4 = pairn & 3;
        att8::attn_unit(Q8 + ((size_t)b * SEQ + qb * 128) * QKW + h * 128, K8 + (size_t)b * KVL * QKW + h * 128, VT8 + (size_t)(b * NHEAD + h) * 68 * 8192,
                        MIX + ((size_t)b * SEQ + qb * 128) * DM + h * 128, lam, F.in[15], (char*)F.lds, F.wave, pre, qf,
                        hn ? Q8 + ((size_t)bn * SEQ + qbn * 128) * QKW + hn4 * 128 : nullptr, hn ? K8 + (size_t)bn * KVL * QKW + hn4 * 128 : nullptr,
                        hn ? VT8 + (size_t)(bn * NHEAD + hn4) * 68 * 8192 : nullptr);
        pre = hn;
    }
}

namespace hy {
constexpr int RB_BYTES = 4352 * 8, IN_OFF = 2 * RB_BYTES, TW1_OFF = IN_OFF + 32768, TW2_OFF = TW1_OFF + 15 * 256 * 8, LDS_END = TW2_OFF + 15 * 16 * 8;
__device__ __forceinline__ f32x2 cmul(f32x2 a, f32x2 b) { return (f32x2){a.x * b.x - a.y * b.y, a.x * b.y + a.y * b.x}; }
__device__ __forceinline__ f32x2 cmulc(f32x2 a, f32x2 b) { return (f32x2){a.x * b.x + a.y * b.y, a.y * b.x - a.x * b.y}; }
__device__ __forceinline__ int P(int i) { return i + (i >> 4); }
template <bool INV> __device__ __forceinline__ void r4(f32x2& a, f32x2& b, f32x2& c, f32x2& d) {
    const f32x2 t0 = a + c, t1 = a - c, t2 = b + d, t3 = b - d;
    const f32x2 st3 = INV ? (f32x2){-t3.y, t3.x} : (f32x2){t3.y, -t3.x};
    a = t0 + t2; c = t0 - t2; b = t1 + st3; d = t1 - st3;
}
template <bool INV> __device__ __forceinline__ f32x2 tw(f32x2 v, float c, float s) {
    return INV ? (f32x2){v.x * c - v.y * s, v.y * c + v.x * s} : (f32x2){v.x * c + v.y * s, v.y * c - v.x * s};
}
template <bool INV> __device__ __forceinline__ void dft16(f32x2 (&v)[16]) {
    constexpr float C1 = 0.9238795325112867f, S1 = 0.3826834323650898f, R2 = 0.7071067811865476f;
    r4<INV>(v[0], v[4], v[8], v[12]); r4<INV>(v[1], v[5], v[9], v[13]); r4<INV>(v[2], v[6], v[10], v[14]); r4<INV>(v[3], v[7], v[11], v[15]);
    v[5] = tw<INV>(v[5], C1, S1);  v[9] = tw<INV>(v[9], R2, R2);    v[13] = tw<INV>(v[13], S1, C1);
    v[6] = tw<INV>(v[6], R2, R2);  v[10] = tw<INV>(v[10], 0.f, 1.f); v[14] = tw<INV>(v[14], -R2, R2);
    v[7] = tw<INV>(v[7], S1, C1);  v[11] = tw<INV>(v[11], -R2, R2);  v[15] = tw<INV>(v[15], -C1, -S1);
    r4<INV>(v[0], v[1], v[2], v[3]); r4<INV>(v[4], v[5], v[6], v[7]); r4<INV>(v[8], v[9], v[10], v[11]); r4<INV>(v[12], v[13], v[14], v[15]);
    f32x2 t;
    t = v[1]; v[1] = v[4]; v[4] = t;   t = v[2]; v[2] = v[8]; v[8] = t;    t = v[3]; v[3] = v[12]; v[12] = t;
    t = v[6]; v[6] = v[9]; v[9] = t;   t = v[7]; v[7] = v[13]; v[13] = t;  t = v[11]; v[11] = v[14]; v[14] = t;
}
struct Ctx { LAS f32x2* R; LAS f32x2* IN; LAS f32x2* TW1; LAS f32x2* TW2; int t, half; f32x2 wt; };
#define HY_OPAQUE(x) asm volatile("" : "+v"(x))
#define HY_W32(m) (f32x2){__builtin_cosf(-0.19634954084936207f * (m)), __builtin_sinf(-0.19634954084936207f * (m))}
template <int MODE> __device__ __forceinline__ void pass1_fwd(const Ctx& X) {
    f32x2 v[16]; int t = X.t; HY_OPAQUE(t);
#pragma unroll
    for (int m = 0; m < 16; ++m) { f32x2 a = X.IN[t + 256 * m]; if (MODE == 1) a = (f32x2){X.half ? a.y : a.x, 0.f}; v[m] = a; }
    if (X.half) {
#pragma unroll
        for (int m = 0; m < 16; ++m) v[m] = cmul(cmul(v[m], HY_W32(m)), X.wt);
    }
    dft16<false>(v);
#pragma unroll
    for (int q = 1; q < 16; ++q) v[q] = cmul(v[q], X.TW1[(q - 1) * 256 + t]);
    const int pb = t + (t >> 4);
#pragma unroll
    for (int q = 0; q < 16; ++q) X.R[pb + 272 * q] = v[q];
}
__device__ __forceinline__ void pass2_fwd(const Ctx& X) {
    int t = X.t; HY_OPAQUE(t);
    const int n2 = t & 15, pb = (t >> 4) * 272 + n2; f32x2 v[16];
#pragma unroll
    for (int m = 0; m < 16; ++m) v[m] = X.R[pb + 17 * m];
    dft16<false>(v);
#pragma unroll
    for (int q = 1; q < 16; ++q) v[q] = cmul(v[q], X.TW2[(q - 1) * 16 + n2]);
#pragma unroll
    for (int q = 0; q < 16; ++q) X.R[pb + 17 * q] = v[q];
}
template <bool FILTER> __device__ __forceinline__ void pass3(const Ctx& X, f32x2 (&H)[16]) {
    f32x2 v[16]; int t = X.t; HY_OPAQUE(t); const int pb = 17 * t;
#pragma unroll
    for (int m = 0; m < 16; ++m) v[m] = X.R[pb + m];
    dft16<false>(v);
    if (FILTER) {
#pragma unroll
        for (int q = 0; q < 16; ++q) H[q] = v[q] * (1.f / 8192.f);
    } else {
#pragma unroll
        for (int q = 0; q < 16; ++q) v[q] = cmul(v[q], H[q]);
        dft16<true>(v);
#pragma unroll
        for (int m = 0; m < 16; ++m) X.R[pb + m] = v[m];
    }
}
__device__ __forceinline__ void pass2_inv(const Ctx& X) {
    int t = X.t; HY_OPAQUE(t);
    const int n2 = t & 15, pb = (t >> 4) * 272 + n2; f32x2 v[16];
    v[0] = X.R[pb];
#pragma unroll
    for (int q = 1; q < 16; ++q) v[q] = cmulc(X.R[pb + 17 * q], X.TW2[(q - 1) * 16 + n2]);
    dft16<true>(v);
#pragma unroll
    for (int m = 0; m < 16; ++m) X.R[pb + 17 * m] = v[m];
}
__device__ __forceinline__ void pass1_inv(const Ctx& X) {
    f32x2 v[16]; int t = X.t; HY_OPAQUE(t); const int pb = t + (t >> 4);
    v[0] = X.R[pb];
#pragma unroll
    for (int q = 1; q < 16; ++q) v[q] = cmulc(X.R[pb + 272 * q], X.TW1[(q - 1) * 256 + t]);
    dft16<true>(v);
    if (X.half) {
#pragma unroll
        for (int m = 0; m < 16; ++m) v[m] = cmulc(cmulc(v[m], HY_W32(m)), X.wt);
    }
#pragma unroll
    for (int m = 0; m < 16; ++m) X.R[pb + 272 * m] = v[m];
}
#define HY_WSYNC() asm volatile("s_waitcnt lgkmcnt(0)" ::: "memory")
__device__ __forceinline__ void conv_fft(const Ctx& X, f32x2 (&H)[16]) {
    __syncthreads(); pass1_fwd<0>(X); __syncthreads(); pass2_fwd(X); HY_WSYNC(); pass3<false>(X, H); HY_WSYNC(); pass2_inv(X); __syncthreads(); pass1_inv(X); __syncthreads();
}
constexpr int STG_OFF = LDS_END;
constexpr int LDS_END2 = STG_OFF + 2 * SEQ * 2;
static_assert(LDS_END2 <= LDSCTL_OFF, "hyena LDS map");
__device__ __forceinline__ float sconv_lds(const LAS bf16_t* stg, int bs, int n, float w0, float w1, float w2, float bias) {
    const LAS bf16_t* p = stg + bs * SEQ;
    const float c = bf2f(p[n]), lv = bf2f(p[n - ((n > 0) ? 1 : 0)]), rv = bf2f(p[n + ((n < SEQ - 1) ? 1 : 0)]);
    const float l = (n > 0) ? lv : 0.f, r = (n < SEQ - 1) ? rv : 0.f;
    return bias + w0 * l + w1 * c + w2 * r;
}
__device__ __forceinline__ void setup_tables(LAS unsigned char* lds, int tid) {
    LAS f32x2* TW1 = (LAS f32x2*)(lds + TW1_OFF); LAS f32x2* TW2 = (LAS f32x2*)(lds + TW2_OFF);
    for (int i = tid; i < 15 * 256; i += 512) { const int q = i / 256 + 1, t = i & 255; float s, c; sincosf(-6.283185307179586f * (float)((t * q) & 4095) * (1.f / 4096.f), &s, &c); TW1[i] = (f32x2){c, s}; }
    for (int i = tid; i < 15 * 16; i += 512) { const int q = i / 16 + 1, n2 = i & 15; float s, c; sincosf(-6.283185307179586f * (float)((n2 * q) & 255) * (1.f / 256.f), &s, &c); TW2[i] = (f32x2){c, s}; }
}
__device__ __forceinline__ void unit(Frame& F, int c) {
    FT_DECL;
    const int tid = f_tid; Ctx X; X.half = F.wave >> 2; X.t = tid & 255;
    X.R = (LAS f32x2*)(F.lds + X.half * RB_BYTES); X.IN = (LAS f32x2*)(F.lds + IN_OFF); X.TW1 = (LAS f32x2*)(F.lds + TW1_OFF); X.TW2 = (LAS f32x2*)(F.lds + TW2_OFF);
    { float s, cc; sincosf(-6.283185307179586f * (float)X.t * (1.f / 8192.f), &s, &cc); X.wt = (f32x2){cc, s}; }
    LAS f32x2* RB0 = (LAS f32x2*)(F.lds); LAS f32x2* RB1 = (LAS f32x2*)(F.lds + RB_BYTES);
    const float* FILT = WSP(float, WS_FILT);
    f32x2 H0[16], H1[16];
#pragma unroll
    for (int ord = 0; ord < 2; ++ord) {
        const float* hf = FILT + ((size_t)(ord * 2 + 0) * 512 + c) * SEQ; const float* hb = FILT + ((size_t)(ord * 2 + 1) * 512 + c) * SEQ;
        __syncthreads();
        int nb = tid; HY_OPAQUE(nb);
#pragma unroll
        for (int j = 0; j < 8; ++j) { const int n = nb + 512 * j; const float a = hf[n], b = hb[(SEQ - n) & (SEQ - 1)]; const float lo = (n == 0) ? a + b : a, hi = (n == 0) ? 0.f : b; X.IN[n] = (f32x2){lo + hi, lo - hi}; }
        __syncthreads(); pass1_fwd<1>(X); __syncthreads(); pass2_fwd(X); HY_WSYNC();
        if (ord == 0) pass3<true>(X, H0); else pass3<true>(X, H1);
    }
    const bf16_t* UT = WSP(bf16_t, WS_UT);
    const bf16_t* rv = UT + (size_t)c * 128; const bf16_t* r1 = UT + (size_t)(512 + c) * 128; const bf16_t* r2 = UT + (size_t)(1024 + c) * 128;
#define HY_LD(rowp, t) (*(const u32x4*)((rowp) + (size_t)((t) >> 7) * (HYC * 128) + ((t) & 127)))
    const float* cw = F.in[16]; const float* cb = F.in[17];
    const float wv0 = cw[c], wv1 = cw[HYC + c], wv2 = cw[2 * HYC + c], bv = cb[c];
    const float wa0 = cw[512 + c], wa1 = cw[HYC + 512 + c], wa2 = cw[2 * HYC + 512 + c], ba = cb[512 + c];
    const float wb0 = cw[1024 + c], wb1 = cw[HYC + 1024 + c], wb2 = cw[2 * HYC + 1024 + c], bb = cb[1024 + c];
    const float sk0 = F.in[25][c], sk1 = F.in[25][512 + c];
    bf16_t* Z = WSP(bf16_t, WS_Z2T) + (size_t)c * 128;
    LAS bf16_t* STG = (LAS bf16_t*)(F.lds + STG_OFF);
    u32x4 g0 = HY_LD(rv, tid * 8), g1 = HY_LD(rv, SEQ + tid * 8);
    for (int pr = 0; pr < 4; ++pr) {
        const int b0 = 2 * pr, b1 = b0 + 1;
        f32x2 z[8]; int pc = tid + (tid >> 4); HY_OPAQUE(pc); int nb = tid; HY_OPAQUE(nb);
        __syncthreads();
        *(LAS u32x4*)(STG + tid * 8) = g0; *(LAS u32x4*)(STG + SEQ + tid * 8) = g1;
        __syncthreads();
#pragma unroll
        for (int j = 0; j < 8; ++j) { const int n = nb + 512 * j; z[j] = (f32x2){sconv_lds(STG, 0, n, wv0, wv1, wv2, bv), sconv_lds(STG, 1, n, wv0, wv1, wv2, bv)}; X.IN[n] = z[j]; }
        g0 = HY_LD(r1, b0 * SEQ + tid * 8); g1 = HY_LD(r1, b1 * SEQ + tid * 8);
        conv_fft(X, H0);
        *(LAS u32x4*)(STG + tid * 8) = g0; *(LAS u32x4*)(STG + SEQ + tid * 8) = g1;
        __syncthreads();
        HY_OPAQUE(nb); HY_OPAQUE(pc);
#pragma unroll
        for (int j = 0; j < 8; ++j) { const int n = nb + 512 * j; const f32x2 y = RB0[pc + 544 * j] + RB1[pc + 544 * j];
            const f32x2 g = (f32x2){sconv_lds(STG, 0, n, wa0, wa1, wa2, ba), sconv_lds(STG, 1, n, wa0, wa1, wa2, ba)};
            z[j] = g * (y + sk0 * z[j]); X.IN[n] = z[j]; }
        g0 = HY_LD(r2, b0 * SEQ + tid * 8); g1 = HY_LD(r2, b1 * SEQ + tid * 8);
        conv_fft(X, H1);
        *(LAS u32x4*)(STG + tid * 8) = g0; *(LAS u32x4*)(STG + SEQ + tid * 8) = g1;
        __syncthreads();
        if (pr < 3) { g0 = HY_LD(rv, (b0 + 2) * SEQ + tid * 8); g1 = HY_LD(rv, (b1 + 2) * SEQ + tid * 8); }
        HY_OPAQUE(nb); HY_OPAQUE(pc);
        f32x2 o[8];
#pragma unroll
        for (int j = 0; j < 8; ++j) { const int n = nb + 512 * j; const f32x2 y = RB0[pc + 544 * j] + RB1[pc + 544 * j];
            const f32x2 g = (f32x2){sconv_lds(STG, 0, n, wb0, wb1, wb2, bb), sconv_lds(STG, 1, n, wb0, wb1, wb2, bb)};
            o[j] = g * (y + sk1 * z[j]); }
        __syncthreads();
#pragma unroll
        for (int j = 0; j < 8; ++j) { const int n = nb + 512 * j; STG[n] = (bf16_t)(cvt_pk_bf16(o[j].x, 0.f) & 0xffffu); STG[SEQ + n] = (bf16_t)(cvt_pk_bf16(o[j].y, 0.f) & 0xffffu); }
        __syncthreads();
        { const int t0 = b0 * SEQ + tid * 8, t1 = b1 * SEQ + tid * 8;
          *(u32x4*)(Z + (size_t)(t0 >> 7) * (HYW * 128) + (t0 & 127)) = *(const LAS u32x4*)(STG + tid * 8); *(u32x4*)(Z + (size_t)(t1 >> 7) * (HYW * 128) + (t1 & 127)) = *(const LAS u32x4*)(STG + SEQ + tid * 8); }
    }
    __syncthreads();
}
}

__device__ __forceinline__ void p3_hyena(Frame& F) {
    FT_DECL;
    __syncthreads();
    hy::setup_tables(F.lds, f_tid);
    __syncthreads();
    for (int c = F.vcu; c < HYW; c += F.G) hy::unit(F, c);
}

__device__ __forceinline__ void p4_hynorm(Frame& F) {
    FT_DECL;
    const bf16_t* Z = WSP(bf16_t, WS_Z2T); bf16_t* MIX = WSP(bf16_t, WS_MIX); const float* g = F.in[26];
    constexpr int TP = 132;
    LAS bf16_t* T = (LAS bf16_t*)F.lds;
    LAS float* red = (LAS float*)(F.lds + 512 * TP * 2);
    LAS float* rs = red + 512;
    float gl[8];
#pragma unroll
    for (int e = 0; e < 8; ++e) gl[e] = g[(f_tid & 63) + 64 * e];
    for (int it = F.vcu; it < MROWS / 128; it += F.G) {
        const int tok0 = it * 128; const bf16_t* zt = Z + (size_t)it * (HYW * 128);
        __syncthreads();
        u32x4 v[16];
#pragma unroll
        for (int j = 0; j < 16; ++j) v[j] = __builtin_nontemporal_load((const u32x4*)(zt + (size_t)(f_tid + 512 * j) * 8));
#pragma unroll
        for (int j = 0; j < 16; ++j) { const int i = f_tid + 512 * j; LAS u32x2* d = (LAS u32x2*)(T + (i >> 4) * TP + (i & 15) * 8); d[0] = (u32x2){v[j].x, v[j].y}; d[1] = (u32x2){v[j].z, v[j].w}; }
        __syncthreads();
        { const int tok = f_tid & 127, grp = f_tid >> 7; float ss = 0.f;
#pragma unroll 8
            for (int k = 0; k < 128; ++k) { const float x = bf2f(T[(grp * 128 + k) * TP + tok]); ss += x * x; }
            red[grp * 128 + tok] = ss; }
        __syncthreads();
        if (f_tid < 128) rs[f_tid] = rsqrtf(((red[f_tid] + red[128 + f_tid]) + (red[256 + f_tid] + red[384 + f_tid])) * (1.f / HYW) + EPS);
        __syncthreads();
#pragma unroll
        for (int j = 0; j < 16; ++j) { const int i = f_tid + 512 * j, tok = i >> 6, l = i & 63; const float r = rs[tok];
            float x[8];
#pragma unroll
            for (int e = 0; e < 8; ++e) x[e] = bf2f(T[(l + 64 * e) * TP + tok]) * r * gl[e];
            u32x4 w; w.x = cvt_pk_bf16(x[0], x[1]); w.y = cvt_pk_bf16(x[2], x[3]); w.z = cvt_pk_bf16(x[4], x[5]); w.w = cvt_pk_bf16(x[6], x[7]);
            *(u32x4*)(MIX + (size_t)(tok0 + tok) * DM + 512 + 8 * l) = w; }
    }
}

constexpr size_t WS_LIST2 = WS_FILT;
constexpr size_t WS_GSLOT2 = WS_FILT + 4 * MiB;
constexpr int CW_ECNT = 256;
constexpr int MAXSLOT = MROWS * TOPK + NEXP * 256;
constexpr int MAXTILE = MAXSLOT / 256;
constexpr size_t WS_XS = WS_EO;
constexpr int P6_WT_PITCH = 2 * DM + 16;
constexpr int P6_LDS_TOPI = 2 * NEXP * P6_WT_PITCH;

__device__ __forceinline__ void p6_router_mfma(Frame& F) {
    FT_DECL;
#define in F.in
    LAS float* WP = (LAS float*)F.lds;
    LAS int* TI = (LAS int*)(F.lds + P6_LDS_TOPI);
    LAS int* PS = TI + 512;
    LAS int* SC = PS + 512;
    LAS float* RSTD = (LAS float*)(SC + 512);
    LAS float* BIAS = RSTD + 128;
    LAS float* SSX = BIAS + 32;
    const float* rw = in[28]; const float* mod = WSP(float, WS_SMALL + SM_MOD); const float* g2n = in[7]; const float* rb = in[29];
    const bf16_t* XN = WSP(bf16_t, WS_XN); unsigned char* H2 = WSP(unsigned char, WS_H);
    int* list2 = WSP(int, WS_LIST2); float* gslot2 = WSP(float, WS_GSLOT2); int* ecnt = (int*)(F.ctl + CW_ECNT);
    LAS float* GT = SSX + 256;
    LAS int* EB = (LAS int*)(GT + 512);
    LAS float* GM = (LAS float*)(EB + 32);
    static_assert(P6_LDS_TOPI + (512 * 3 + 128 + 32 + 256 + 512 + 32 + 1024) * 4 <= LDSCTL_OFF, "router LDS map");
    for (int blk = blockIdx.x; blk < MROWS / 128; blk += F.G) {
        const float* sh2 = mod + (size_t)(blk >> 5) * (NMOD * DM) + 3 * DM; const float* sc2 = sh2 + DM;
        __syncthreads();
        for (int i = f_tid; i < DM; i += 512) GM[i] = g2n[i] * (1.f + sc2[i]);
        if (f_tid < 32) BIAS[f_tid] = WSP(float, WS_SMALL + SM_RBIAS)[(blk >> 5) * 32 + f_tid];
        __syncthreads();
        { const int e = f_lane & 31, h8 = (f_lane >> 5) * 8; LAS unsigned char* WT = (LAS unsigned char*)F.lds;
#pragma unroll 1
            for (int it0 = 0; it0 < 8; it0 += 4) { float w[4][8];
#pragma unroll
                for (int u = 0; u < 4; ++u) { const int k0 = ((it0 + u) * NWAVES + F.wave) * 16 + h8;
#pragma unroll
                    for (int q = 0; q < 8; ++q) w[u][q] = rw[(size_t)(k0 + q) * 32 + e]; }
#pragma unroll
                for (int u = 0; u < 4; ++u) { const int k0 = ((it0 + u) * NWAVES + F.wave) * 16 + h8;
                    const f32x4 ga = *(const LAS f32x4*)(GM + k0), gb = *(const LAS f32x4*)(GM + k0 + 4); const float g[8] = {ga.x, ga.y, ga.z, ga.w, gb.x, gb.y, gb.z, gb.w};
                    unsigned ph[4], pl[4];
#pragma unroll
                    for (int q = 0; q < 4; ++q) { const float v0 = w[u][2 * q] * g[2 * q], v1 = w[u][2 * q + 1] * g[2 * q + 1]; ph[q] = cvt_pk_bf16(v0, v1);
                        pl[q] = cvt_pk_bf16(v0 - __uint_as_float(ph[q] << 16), v1 - __uint_as_float(ph[q] & 0xffff0000u)); }
                    *(LAS u32x4*)(WT + e * P6_WT_PITCH + k0 * 2) = (u32x4){ph[0], ph[1], ph[2], ph[3]};
                    *(LAS u32x4*)(WT + NEXP * P6_WT_PITCH + e * P6_WT_PITCH + k0 * 2) = (u32x4){pl[0], pl[1], pl[2], pl[3]}; } } }
        __syncthreads();
        const int rg = F.wave & 3, kh = F.wave >> 2, j = f_lane & 31, hi = f_lane >> 5;
        f32x16 acc = {};
        float ss = 0.f;
        { const bf16_t* xrow = XN + (size_t)(blk * 128 + rg * 32 + j) * DM + 512 * kh + 8 * hi;
            const LAS unsigned char* wth = (const LAS unsigned char*)F.lds + j * P6_WT_PITCH + (512 * kh + 8 * hi) * 2;
#pragma unroll 16
            for (int c = 0; c < 32; ++c) { const u32x4 xb = *(const u32x4*)(xrow + 16 * c);
                const float xf[8] = {__uint_as_float(xb.x << 16), __uint_as_float(xb.x & 0xffff0000u), __uint_as_float(xb.y << 16), __uint_as_float(xb.y & 0xffff0000u),
                                     __uint_as_float(xb.z << 16), __uint_as_float(xb.z & 0xffff0000u), __uint_as_float(xb.w << 16), __uint_as_float(xb.w & 0xffff0000u)};
#pragma unroll
                for (int q = 0; q < 8; ++q) ss += xf[q] * xf[q];
                const bf16x8 xv = __builtin_bit_cast(bf16x8, xb);
                const bf16x8 ah = *(const LAS bf16x8*)(wth + 32 * c), al = *(const LAS bf16x8*)(wth + NEXP * P6_WT_PITCH + 32 * c);
                acc = __builtin_amdgcn_mfma_f32_32x32x16_bf16(ah, xv, acc, 0, 0, 0);
                acc = __builtin_amdgcn_mfma_f32_32x32x16_bf16(al, xv, acc, 0, 0, 0); } }
        { auto rr = __builtin_amdgcn_permlane32_swap(__float_as_uint(ss), __float_as_uint(ss), false, false); ss = __uint_as_float(rr[0]) + __uint_as_float(rr[1]); }
        if (hi == 0) SSX[kh * 128 + rg * 32 + j] = ss;
        __syncthreads();
        if (kh == 1) {
#pragma unroll
            for (int r = 0; r < 16; ++r) WP[(rg * 16 + r) * 64 + f_lane] = acc[r]; }
        if (f_tid < 128) RSTD[f_tid] = rsqrtf((SSX[f_tid] + SSX[128 + f_tid]) * (1.f / DM) + EPS);
        __syncthreads();
        if (kh == 0) {
            const float rstd = RSTD[rg * 32 + j];
            float tv[4] = {-INFINITY, -INFINITY, -INFINITY, -INFINITY}; int ti[4] = {1 << 20, 1 << 20, 1 << 20, 1 << 20};
#define P6_INS(V, E) do { float cv = (V); int ce = (E); _Pragma("unroll") for (int q = 0; q < 4; ++q) { const bool b = cv > tv[q] || (cv == tv[q] && ce < ti[q]); \
                const float nv = b ? tv[q] : cv; const int ne = b ? ti[q] : ce; tv[q] = b ? cv : tv[q]; ti[q] = b ? ce : ti[q]; cv = nv; ce = ne; } } while (0)
#pragma unroll
            for (int r = 0; r < 16; ++r) { const int e = (r & 3) + 8 * (r >> 2) + 4 * hi; const float v = (acc[r] + WP[(rg * 16 + r) * 64 + f_lane]) * rstd + BIAS[e]; P6_INS(v, e); }
            float ov[4]; int oe[4];
#pragma unroll
            for (int q = 0; q < 4; ++q) { ov[q] = __shfl_xor(tv[q], 32); oe[q] = __shfl_xor(ti[q], 32); }
#pragma unroll
            for (int q = 0; q < 4; ++q) P6_INS(ov[q], oe[q]);
#undef P6_INS
            if (hi == 0) { const int rl = rg * 32 + j;
                const float e1 = __expf(tv[1] - tv[0]), e2 = __expf(tv[2] - tv[0]), e3 = __expf(tv[3] - tv[0]); const float inv = 1.f / (1.f + e1 + e2 + e3);
                typedef int i32x4_t __attribute__((ext_vector_type(4))); const i32x4_t t4 = {ti[0], ti[1], ti[2], ti[3]};
                *(LAS f32x4*)(GT + rl * 4) = (f32x4){inv, e1 * inv, e2 * inv, e3 * inv};
                *(LAS i32x4_t*)(TI + rl * 4) = t4; }
        }
        __syncthreads();
        { const int t2 = F.wave * 64 + lane_id(); const int e = t2 & 31, seg = t2 >> 5; int cnt = 0;
#pragma unroll 4
            for (int i = 0; i < 32; ++i) cnt += (TI[seg * 32 + i] == e) ? 1 : 0;
            SC[seg * 32 + e] = cnt;
            __syncthreads();
            int pre = 0;
            for (int s2 = 0; s2 < seg; ++s2) pre += SC[s2 * 32 + e];
            if (seg == 15) EB[e] = __hip_atomic_fetch_add(ecnt + e, pre + cnt, __ATOMIC_RELAXED, __HIP_MEMORY_SCOPE_AGENT);
            for (int i = 0; i < 32; ++i) if (TI[seg * 32 + i] == e) { PS[seg * 32 + i] = pre; ++pre; }
        }
        __syncthreads();
        { const int t3 = F.wave * 64 + lane_id(); const int e = TI[t3]; const size_t sl = (size_t)e * MROWS + EB[e] + PS[t3];
            list2[sl] = (blk * 128 + (t3 >> 2)) * 4 + (t3 & 3); gslot2[sl] = GT[t3]; }
        { const int lane = lane_id();
            f32x4 PA[4], PB[4];
#pragma unroll
            for (int jj = 0; jj < 4; ++jj) { const int c = 4 * lane + 256 * jj; PA[jj] = *(const f32x4*)(g2n + c) * (*(const f32x4*)(sc2 + c) + 1.f); PB[jj] = *(const f32x4*)(sh2 + c); }
            for (int it = 0; it < 2; ++it) { u32x2 xb[8][4];
#pragma unroll
                for (int u = 0; u < 8; ++u) { const GAS u32x2* xr = (const GAS u32x2*)(XN + (size_t)(blk * 128 + F.wave * 16 + 8 * it + u) * DM) + lane;
#pragma unroll
                    for (int jj = 0; jj < 4; ++jj) xb[u][jj] = xr[64 * jj]; }
#pragma unroll
                for (int u = 0; u < 8; ++u) { const int rl = F.wave * 16 + 8 * it + u; const float rstd = RSTD[rl];
                    GAS unsigned* o4 = (GAS unsigned*)(H2 + (size_t)(blk * 128 + rl) * DM) + lane;
#pragma unroll
                    for (int jj = 0; jj < 4; ++jj) {
                        const f32x4 x = (f32x4){__uint_as_float(xb[u][jj].x << 16), __uint_as_float(xb[u][jj].x & 0xffff0000u), __uint_as_float(xb[u][jj].y << 16), __uint_as_float(xb[u][jj].y & 0xffff0000u)};
                        const f32x4 h = x * rstd * PA[jj] + PB[jj];
                        o4[64 * jj] = pk4_fp8(h.x, h.y, h.z, h.w); } } }
        }
    }
#undef in
}

template <int NPN> struct SchedMoE {
    int G, c, nT; const char* A; const char* W; size_t wstride; const LAS unsigned char* tileE; const LAS int* RW; bool gath;
    __device__ __forceinline__ long lidx(int T, int e, int i) const { const LAS int* TB = (const LAS int*)(tileE + 544); const int r = (T - TB[e]) * 256 + i; return (r < TB[32 + e]) ? (long)e * MROWS + r : -1L; }
    __device__ __forceinline__ const LAS int* rows(int i) const { return RW + i * 256; }
    __device__ __forceinline__ bool next(int i, g8::Unit& u) const {
        const int L = i * G + c, xcd = L & 7, j = L >> 3, nTx = (nT + 7) >> 3, tl = j / NPN, T = xcd * nTx + tl, pn = j % NPN;
        if (tl >= nTx || T >= nT) return false;
        const int e = tileE[T];
        u.pm = T; u.pn = pn; u.kind = i; u.ex = e; u.a = gath ? A : A + (size_t)T * 256 * DM; u.b = W + (size_t)e * wstride + (size_t)pn * 256 * DM; return true;
    }
};
struct EpiSwiGLU {
    unsigned char* ACT; const float* b1;
    __device__ __forceinline__ void operator()(f32x4 (&acc)[2][2][4][2], const g8::Unit& u, int wr, int wc, int fr, int fq) const {
        asm volatile("" : "+v"(fr), "+v"(fq));
        const int j0 = u.pn * 128 + wc * 32 + 8 * fq; const float* bp = b1 + (size_t)u.ex * 2 * DM + j0;
        f32x4 bg[2], bl[2];
#pragma unroll
        for (int n = 0; n < 2; ++n) { bg[n] = *(const f32x4*)(bp + 4 * n); bl[n] = *(const f32x4*)(bp + DM + 4 * n); }
#pragma unroll
        for (int ai = 0; ai < 2; ++ai)
#pragma unroll
            for (int m = 0; m < 4; ++m) { const size_t slot = (size_t)u.pm * 256 + ai * 128 + wr * 64 + m * 16 + fr; float o[8];
#pragma unroll
                for (int n = 0; n < 2; ++n) { const f32x4 g4 = acc[ai][0][m][n] * (1.f / WSCALE) + bg[n], l4 = acc[ai][1][m][n] * (1.f / WSCALE) + bl[n];
#pragma unroll
                    for (int e = 0; e < 4; ++e) { const float g = fminf(g4[e], 7.f), l = __builtin_amdgcn_fmed3f(l4[e], -7.f, 7.f);
                        const float ex = __builtin_amdgcn_exp2f(g * (-1.702f * 1.4426950408889634f)); const float glu = g * __builtin_amdgcn_rcpf(1.f + ex);
                        o[4 * n + e] = fmaf(l, glu, glu); } }
                u32x2 w; w.x = pk4_fp8(o[0], o[1], o[2], o[3]); w.y = pk4_fp8(o[4], o[5], o[6], o[7]);
                *(u32x2*)(ACT + slot * DM + j0) = w; }
    }
};
struct EpiDown {
    unsigned char* EO; const float* b2; const LAS int* LL; int G, c;
    __device__ __forceinline__ void operator()(f32x4 (&acc)[2][2][4][2], const g8::Unit& u, int wr, int wc, int fr, int fq) const {
        asm volatile("" : "+v"(fr), "+v"(fq));
        const int c0 = u.pn * 256 + wc * 64 + 16 * fq; const float* bp = b2 + (size_t)u.ex * DM + c0;
        f32x4 bb[2][2];
#pragma unroll
        for (int bj = 0; bj < 2; ++bj)
#pragma unroll
            for (int n = 0; n < 2; ++n) bb[bj][n] = *(const f32x4*)(bp + bj * 8 + 4 * n);
        const LAS int* L = LL + u.kind * 512;
        int li[8]; float gt[8];
#pragma unroll
        for (int q = 0; q < 8; ++q) { const int rl = (q >> 2) * 128 + wr * 64 + (q & 3) * 16 + fr; li[q] = L[rl]; gt[q] = __int_as_float(L[256 + rl]) * (1.f / WSCALE); }
#pragma unroll
        for (int ai = 0; ai < 2; ++ai)
#pragma unroll
            for (int m = 0; m < 4; ++m) { const int l = li[ai * 4 + m]; const float g = gt[ai * 4 + m];
                unsigned char* dst = EO + ((size_t)(l & 3) * MROWS + (l >> 2)) * DM + c0;
                u32x4 w;
                { const f32x4 v0 = acc[ai][0][m][0] * g + bb[0][0] * (g * WSCALE), v1 = acc[ai][0][m][1] * g + bb[0][1] * (g * WSCALE);
                  w.x = pk4_fp8(v0[0] * EOSCALE, v0[1] * EOSCALE, v0[2] * EOSCALE, v0[3] * EOSCALE); w.y = pk4_fp8(v1[0] * EOSCALE, v1[1] * EOSCALE, v1[2] * EOSCALE, v1[3] * EOSCALE); }
                { const f32x4 v0 = acc[ai][1][m][0] * g + bb[1][0] * (g * WSCALE), v1 = acc[ai][1][m][1] * g + bb[1][1] * (g * WSCALE);
                  w.z = pk4_fp8(v0[0] * EOSCALE, v0[1] * EOSCALE, v0[2] * EOSCALE, v0[3] * EOSCALE); w.w = pk4_fp8(v1[0] * EOSCALE, v1[1] * EOSCALE, v1[2] * EOSCALE, v1[3] * EOSCALE); }
                if (l >= 0) *(u32x4*)dst = w; }
    }
};
__device__ __forceinline__ const LAS unsigned char* moe_tiles(Frame& F, int& nT) {
    FT_DECL;
    LAS unsigned char* TE = (LAS unsigned char*)(F.lds + RING_BYTES); LAS int* TB = (LAS int*)(TE + 544); LAS int* TOT = TB + 32; LAS int* NTL = TOT + 32;
    const int* ecnt = (const int*)(F.ctl + CW_ECNT);
    __syncthreads();
    if (f_tid < 32) { const int t = ecnt[f_tid]; TOT[f_tid] = t; NTL[f_tid] = (t + 255) >> 8; }
    __syncthreads();
    if (f_tid < 33) { int b = 0; for (int e = 0; e < f_tid; ++e) b += NTL[e]; if (f_tid < 32) TB[f_tid] = b; else NTL[32] = b; }
    __syncthreads();
    nT = NTL[32]; if (nT > MAXTILE) nT = MAXTILE;
    for (int i = f_tid; i < MAXTILE; i += 512) { int e = 0;
#pragma unroll 8
        for (int q = 0; q < 32; ++q) e += (TB[q] + NTL[q] <= i) ? 1 : 0;
        TE[i] = (unsigned char)((i < nT) ? e : 0); }
    __syncthreads();
    return (const LAS unsigned char*)TE;
}

__device__ __forceinline__ void p10_combine(Frame& F) {
    FT_DECL;
    const float* mod = WSP(float, WS_SMALL + SM_MOD); const unsigned char* EO = WSP(unsigned char, WS_EO);
    const size_t gt = (size_t)F.vcu * 512 + f_tid, NTH = (size_t)F.G * 512;
    constexpr int U = 4;
    for (size_t i0 = gt; i0 < (size_t)MROWS * 128; i0 += NTH * U) {
        u32x2 ev[U][4]; f32x4 xv[U][2], gv[U][2];
#pragma unroll
        for (int u = 0; u < U; ++u) { const size_t i = i0 + (size_t)u * NTH; const size_t row = i >> 7; const int c0 = (int)(i & 127) * 8;
            const float* g2 = mod + (size_t)(row >> 12) * (NMOD * DM) + 5 * DM + c0; const bf16_t* op = WSP(bf16_t, WS_XN) + row * DM + c0;
#pragma unroll
            for (int k = 0; k < 4; ++k) ev[u][k] = __builtin_nontemporal_load((const u32x2*)(EO + ((size_t)k * MROWS + row) * DM + c0));
            { const u32x4 xb = *(const u32x4*)op; xv[u][0] = (f32x4){__uint_as_float(xb.x << 16), __uint_as_float(xb.x & 0xffff0000u), __uint_as_float(xb.y << 16), __uint_as_float(xb.y & 0xffff0000u)};
              xv[u][1] = (f32x4){__uint_as_float(xb.z << 16), __uint_as_float(xb.z & 0xffff0000u), __uint_as_float(xb.w << 16), __uint_as_float(xb.w & 0xffff0000u)}; }
            gv[u][0] = *(const f32x4*)g2; gv[u][1] = *(const f32x4*)(g2 + 4); }
#pragma unroll
        for (int u = 0; u < U; ++u) { const size_t i = i0 + (size_t)u * NTH; const size_t row = i >> 7; const int c0 = (int)(i & 127) * 8;
            float s[8];
#pragma unroll
            for (int e = 0; e < 8; ++e) s[e] = 0.f;
#pragma unroll
            for (int k = 0; k < 4; ++k) { const u32x2 v = ev[u][k];
                const f32x2 a = __builtin_amdgcn_cvt_pk_f32_fp8((int)v.x, false), b = __builtin_amdgcn_cvt_pk_f32_fp8((int)v.x, true), c = __builtin_amdgcn_cvt_pk_f32_fp8((int)v.y, false), d = __builtin_amdgcn_cvt_pk_f32_fp8((int)v.y, true);
                s[0] += a.x; s[1] += a.y; s[2] += b.x; s[3] += b.y; s[4] += c.x; s[5] += c.y; s[6] += d.x; s[7] += d.y; }
#pragma unroll
            for (int e = 0; e < 8; ++e) s[e] *= (1.f / EOSCALE);
            f32x4 o0 = xv[u][0] + gv[u][0] * (f32x4){s[0], s[1], s[2], s[3]}, o1 = xv[u][1] + gv[u][1] * (f32x4){s[4], s[5], s[6], s[7]};
            float* op = F.out + row * DM + c0;
            __builtin_nontemporal_store(o0, (f32x4*)op); __builtin_nontemporal_store(o1, (f32x4*)(op + 4)); }
    }
}

struct Args { const float* in[34]; float* out; unsigned char* ws; int ph_lo, ph_hi; };
constexpr int N_PHASES = 11;

__global__ void __launch_bounds__(512, 2) mega(Args args) {
    extern __shared__ __attribute__((aligned(16))) unsigned char lds[];
    Frame F;
    F.lds = (LAS unsigned char*)lds;
    F.MISC = (volatile LAS unsigned*)(F.lds + LDSCTL_OFF);
    F.wave = __builtin_amdgcn_readfirstlane(threadIdx.x >> 6);
    FT_DECL;
    F.G = gridDim.x; { const int bx = blockIdx.x; F.vcu = (F.G % 8 == 0) ? (bx % 8) * (F.G / 8) + bx / 8 : bx; }
    F.in = (kin_t)__builtin_amdgcn_kernarg_segment_ptr();
    F.out = args.out; F.ws = args.ws;
    F.ctl = (gu32*)(args.ws + WS_CTL);
    for (int u = f_tid; u < (LDS_BYTES - LDSCTL_OFF) / 4; u += NWAVES * 64) ((LAS unsigned*)(F.lds + LDSCTL_OFF))[u] = 0u;
    __syncthreads();
    const int lo = args.ph_lo, hi = args.ph_hi;
    XcdBarrier bar; bar.bar = (unsigned*)(F.ctl + CW_BAR); bar.x = 0; bar.st = nullptr;
    if (hi - lo > 1) bar = xcd_barrier_post((unsigned*)(F.ctl + CW_BAR), F.MISC + 8, f_tid == 0);
#define IN(k) (lo <= (k) && (k) < hi)
#define SEAM(k) do { if (IN(k) && IN((k) + 1)) xcd_barrier(bar, F.wave == 0 && lane_id() == 0); } while (0)

    if (IN(0)) { p0_prologue(F); }
    if (IN(1)) { p1_norm1(F); } SEAM(1);
    if (IN(2)) {
        SchedInProj S{F.G, (int)blockIdx.x, (const char*)WSP(bf16_t, WS_H), (const char*)WSP(bf16_t, WS_WIN)};
        EpiInProj E{WSP(unsigned char, WS_Q), WSP(unsigned char, WS_K), WSP(unsigned char, WS_V), WSP(bf16_t, WS_UT), F.in[9], F.in[10], WSP(float, WS_SMALL + SM_ROPE)};
        g8::gemm_phase<false>(F.lds, DM, S, E, F.wave, lane_id());
    } SEAM(2);
    if (IN(3)) { p3_attention8(F); p3_hyena(F); } SEAM(3);
    if (IN(4)) { p4_hynorm(F); } SEAM(4);
    if (IN(5)) {
        SchedStatic S{F.G, (int)blockIdx.x, MROWS / 256, DM / 256, (const char*)WSP(bf16_t, WS_MIX), (const char*)WSP(bf16_t, WS_WOUT)};
        EpiOutProj E{F.in[0], WSP(bf16_t, WS_XN), WSP(float, WS_SMALL + SM_MOD)};
        g8::gemm_phase<false>(F.lds, DM, S, E, F.wave, lane_id());
    } SEAM(5);
    if (IN(6)) { p6_router_mfma(F); } SEAM(6);
    if (IN(8)) {
        int nT; const LAS unsigned char* TE = moe_tiles(F, nT);
        LAS int* RWL = (LAS int*)(F.lds + RING_BYTES + 1024);
        static_assert(RING_BYTES + 1024 + 17 * 1024 <= LDSCTL_OFF, "LDS map");
        SchedMoE<8> S{F.G, (int)blockIdx.x, nT, (const char*)WSP(char, WS_H), (const char*)WSP(char, WS_W1), (size_t)2 * DM * DM, TE, RWL, true};
        { const int* list = WSP(int, WS_LIST2); const int t8 = F.wave * 64 + lane_id();
            g8::Unit u; for (int i = 0; i < 17 && S.next(i, u); i += 2) { const int ii = i + (t8 >> 8); g8::Unit u2; if (S.next(ii, u2)) { const long ix = S.lidx(u2.pm, u2.ex, t8 & 255); RWL[ii * 256 + (t8 & 255)] = (ix >= 0) ? (list[ix] >> 2) : 0; } }
            __syncthreads(); }
        EpiSwiGLU E{WSP(unsigned char, WS_ACT), F.in[31]};
        g8::gemm_phase_g<true, true>(F.lds, DM, S, E, F.wave, lane_id());
    } SEAM(8);
    if (IN(9)) {
        int nT; const LAS unsigned char* TE = moe_tiles(F, nT);
        SchedMoE<4> S{F.G, (int)blockIdx.x, nT, (const char*)WSP(char, WS_ACT), (const char*)WSP(char, WS_W2), (size_t)DM * DM, TE, nullptr, false};
        LAS int* LL = (LAS int*)(F.lds + RING_BYTES + 1024);
        static_assert(RING_BYTES + 1024 + 9 * 2048 <= LDSCTL_OFF, "LDS map");
        { const int* list = WSP(int, WS_LIST2); const float* gslot = WSP(float, WS_GSLOT2);
            const int t9 = F.wave * 64 + lane_id();
            g8::Unit u; for (int i = 0; i < 9 && S.next(i, u); ++i) { const int t = t9 & 255; const long ix = S.lidx(u.pm, u.ex, t);
                LL[i * 512 + (t9 >> 8) * 256 + t] = (ix < 0) ? ((t9 < 256) ? -1 : 0) : ((t9 < 256) ? list[ix] : __float_as_int(gslot[ix])); }
            __syncthreads(); }
        EpiDown E{WSP(unsigned char, WS_EO), F.in[33], LL, F.G, (int)blockIdx.x};
        g8::gemm_phase<true>(F.lds, DM, S, E, F.wave, lane_id());
    } SEAM(9);
    if (IN(10)) { p10_combine(F); }
#undef IN
#undef SEAM
}

extern "C" void kernel_launch(void* const* d_in, const int* in_sizes, int n_in, void* d_out, int out_size, void* d_ws, size_t ws_size, hipStream_t stream) {
    static int grid = 0;
    if (grid == 0) {
        if (n_in != 34 || out_size != MROWS * DM || ws_size < WS_END) { fprintf(stderr, "kernel_launch: unexpected shapes: n_in %d out %d ws %zu (need %zu)\n", n_in, out_size, ws_size, (size_t)WS_END); grid = -1; return; }
        int dev = 0, cus = 0, per_cu = 0;
        if (hipGetDevice(&dev) != hipSuccess || hipDeviceGetAttribute(&cus, hipDeviceAttributeMultiprocessorCount, dev) != hipSuccess) { grid = -1; return; }
        if (hipFuncSetAttribute((const void*)mega, hipFuncAttributeMaxDynamicSharedMemorySize, LDS_BYTES) != hipSuccess) { fprintf(stderr, "kernel_launch: hipFuncSetAttribute failed\n"); grid = -1; return; }
        if (hipOccupancyMaxActiveBlocksPerMultiprocessor(&per_cu, (const void*)mega, NWAVES * 64, LDS_BYTES) != hipSuccess || per_cu < 1) { fprintf(stderr, "kernel_launch: occupancy query says %d\n", per_cu); per_cu = 1; }
        (void)hipGetLastError();
        grid = cus;
    }
    if (grid < 0) return;
    (void)hipMemsetAsync((char*)d_ws + WS_CTL, 0, CTL_ZERO_BYTES, stream);
    Args a{};
    for (int i = 0; i < 34; ++i) a.in[i] = (const float*)d_in[i];
    a.out = (float*)d_out; a.ws = (unsigned char*)d_ws;
    constexpr int LAST = MK_LAST_PHASE + 1;
    if (MK_N_LAUNCHES == 1) { a.ph_lo = 0; a.ph_hi = LAST; hipLaunchKernelGGL(mega, dim3(grid), dim3(NWAVES * 64), LDS_BYTES, stream, a); }
    else for (int p = 0; p < LAST; ++p) { a.ph_lo = p; a.ph_hi = p + 1; hipLaunchKernelGGL(mega, dim3(grid), dim3(NWAVES * 64), LDS_BYTES, stream, a); }
    const hipError_t le = hipPeekAtLastError();
    if (le != hipSuccess) fprintf(stderr, "kernel_launch: launch failed: %s\n", hipGetErrorName(le));
}
```

```cpp
#include <hip/hip_runtime.h>
#include <hip/hip_bf16.h>
#include <cstdio>
#include <cstdint>

#ifndef MK_N_LAUNCHES
#define MK_N_LAUNCHES 1
#endif
#ifndef MK_LAST_PHASE
#define MK_LAST_PHASE 10
#endif

#define GAS __attribute__((address_space(1)))
#define LAS __attribute__((address_space(3)))
typedef unsigned short bf16_t;
typedef short bf16x8 __attribute__((ext_vector_type(8)));
typedef short s16x4 __attribute__((ext_vector_type(4)));
typedef float f32x2 __attribute__((ext_vector_type(2)));
typedef float f32x4 __attribute__((ext_vector_type(4)));
typedef float f32x16 __attribute__((ext_vector_type(16)));
typedef unsigned u32x2 __attribute__((ext_vector_type(2)));
typedef unsigned u32x4 __attribute__((ext_vector_type(4)));
typedef GAS unsigned gu32;

constexpr int NB = 8, SEQ = 4096, DM = 1024, MROWS = NB * SEQ, CTXL = 256, MCTX = NB * CTXL, MTOT = MROWS + MCTX;
constexpr int KVL = CTXL + SEQ;
constexpr int NHEAD = 4, QKW = 512;
constexpr int HYW = 512, HYC = 1536, INC = 3072, QKVC = 1536;
constexpr int NEXP = 32, TOPK = 4, NMOD = 6;
constexpr float EPS = 1e-6f;
constexpr float LAM_INIT = 0.2f;
constexpr float QSCALE = 0.125f * 1.4426950408889634f;

constexpr size_t MiB = 1u << 20;
constexpr size_t WS_CTL = 0, CTL_ZERO_BYTES = 64 * 1024;
constexpr size_t WS_SMALL = 1 * MiB;
constexpr size_t WS_WIN = 2 * MiB;
constexpr size_t WS_WOUT = 8 * MiB;
constexpr size_t WS_W1 = 10 * MiB;
constexpr size_t WS_W2 = 138 * MiB;
constexpr size_t WS_H = 202 * MiB;
constexpr size_t WS_Q = 270 * MiB;
constexpr size_t WS_K = 302 * MiB;
constexpr size_t WS_V = 336 * MiB;
constexpr size_t WS_UT = 370 * MiB;
constexpr size_t WS_FILT = 466 * MiB;
constexpr size_t WS_Z2T = 498 * MiB;
constexpr size_t WS_MIX = 530 * MiB;
constexpr size_t WS_ROUTE = 594 * MiB;
constexpr size_t WS_ACT = 270 * MiB;
constexpr size_t WS_EO = 598 * MiB;
constexpr size_t WS_XN = 870 * MiB;
constexpr size_t WS_H8 = 936 * MiB;
constexpr size_t WS_WIN8 = 972 * MiB;
constexpr size_t WS_END = 998 * MiB;
constexpr size_t SM_MOD = 0;
constexpr size_t SM_SCAL = 256 * 1024;
constexpr size_t SM_ROPE = 260 * 1024;
constexpr size_t SM_RBIAS = 272 * 1024;
constexpr int CW_BAR = 4096;
constexpr int CW_MT = 1024;
constexpr int CW_XCC = 2048;
constexpr int CW_GEMV = 320;

constexpr int RING_BYTES = 131072;
constexpr int LDSCTL_OFF = 151552;
constexpr int LDS_BYTES = 152576;
constexpr int NWAVES = 8;

#define LDS_WAIT() asm volatile("s_waitcnt lgkmcnt(0)" ::: "memory")
#define VM_WAIT() asm volatile("s_waitcnt vmcnt(0)" ::: "memory")
#define RLX_AGENT __ATOMIC_RELAXED, __HIP_MEMORY_SCOPE_AGENT

__device__ __forceinline__ unsigned cvt_pk_bf16(float lo, float hi) { unsigned r; asm volatile("v_cvt_pk_bf16_f32 %0, %1, %2" : "=v"(r) : "v"(lo), "v"(hi)); return r; }
__device__ __forceinline__ float bf2f(bf16_t v) { return __uint_as_float(((unsigned)v) << 16); }
__device__ __forceinline__ float row_sum16(float v) {
#define WS_DPP(ctrl) __builtin_bit_cast(float, __builtin_amdgcn_update_dpp(0, __builtin_bit_cast(int, v), ctrl, 0xf, 0xf, true))
    v += WS_DPP(0xB1); v += WS_DPP(0x4E); v += WS_DPP(0x141); v += WS_DPP(0x140);
#undef WS_DPP
    return v;
}
__device__ __forceinline__ float wave_sum(float v) {
    v = row_sum16(v); v += __shfl_xor(v, 16); v += __shfl_xor(v, 32);
    return v;
}

#define XB_TMO      128
#define XB_XCNT(j)  (256  + 64 * (j))
#define XB_XSUB(j)  (1280 + 64 * (j))
#define XB_XGEN(j)  (2304 + 64 * (j))
#define XB_TOP      3328
#define XB_TOPGEN   3392
#define XCD_BAR_WORDS 3456
#define XB_SPIN_CAP (1u << 22)
__device__ __forceinline__ unsigned xb_ld(unsigned* p)              { return __hip_atomic_load(p, __ATOMIC_RELAXED, __HIP_MEMORY_SCOPE_AGENT); }
__device__ __forceinline__ unsigned xb_add(unsigned* p, unsigned v) { return __hip_atomic_fetch_add(p, v, __ATOMIC_RELAXED, __HIP_MEMORY_SCOPE_AGENT); }
__device__ __forceinline__ unsigned xb_xcc_id() { return (unsigned)__builtin_amdgcn_s_getreg((3 << 11) | 20) & 0xFu; }
#define XB_SPIN(cond, bar) do { unsigned _sp = 0; while (cond) { __builtin_amdgcn_s_sleep(1); \
    if ((++_sp & 255u) == 0u) { if (xb_ld(&(bar)[XB_TMO])) break; if (_sp > XB_SPIN_CAP) { atomicAdd(&(bar)[XB_TMO], 1u); break; } } } } while (0)
struct XcdBarrier { unsigned* bar; unsigned x; volatile LAS unsigned* st; };
__device__ __forceinline__ XcdBarrier xcd_barrier_post(unsigned* bar, volatile LAS unsigned* st, bool leader) {
    XcdBarrier b; b.bar = bar; b.x = xb_xcc_id(); b.st = st;
    if (leader) (void)xb_add(&bar[XB_XCNT(b.x)], 1u);
    return b;
}
__device__ __forceinline__ void xcd_barrier_complete(unsigned* bar, unsigned x, unsigned& nloc, unsigned& nx) {
    const unsigned G = gridDim.x * gridDim.y * gridDim.z;
    unsigned sum, cnt, mine, sp = 0u;
    for (;;) {
        sum = 0u; cnt = 0u; mine = 0u;
#pragma unroll
        for (unsigned j = 0; j < 16; ++j) { const unsigned c = xb_ld(&bar[XB_XCNT(j)]); sum += c; cnt += (c > 0u) ? 1u : 0u; mine = (j == x) ? c : mine; }
        if (sum == G) break;
        __builtin_amdgcn_s_sleep(1);
        if ((++sp & 255u) == 0u) { if (xb_ld(&bar[XB_TMO])) break; if (sp > XB_SPIN_CAP) { atomicAdd(&bar[XB_TMO], 1u); break; } }
    }
    nloc = mine > 0u ? mine : 1u; nx = cnt > 0u ? cnt : 1u;
}
__device__ __forceinline__ void xcd_barrier(const XcdBarrier& b, bool leader) {
    asm volatile("s_waitcnt vmcnt(0)" ::: "memory");
    __syncthreads();
    if (leader) {
        unsigned* bar = b.bar;
        __builtin_amdgcn_s_waitcnt(0);
        unsigned nloc = b.st[0], nx = b.st[1];
        if (nloc == 0u) { xcd_barrier_complete(bar, b.x, nloc, nx); b.st[0] = nloc; b.st[1] = nx; }
        const unsigned old = xb_add(&bar[XB_XSUB(b.x)], 1u);
        const unsigned gen = old / nloc;
        if (old + 1u == (gen + 1u) * nloc) {
            __builtin_amdgcn_fence(__ATOMIC_RELEASE, "agent");
            asm volatile("s_waitcnt vmcnt(0)" ::: "memory");
            const unsigned og = xb_add(&bar[XB_TOP], 1u);
            const unsigned tg = og / nx;
            if (og + 1u != (tg + 1u) * nx) XB_SPIN(xb_ld(&bar[XB_TOP]) < (tg + 1u) * nx, bar);
            __builtin_amdgcn_fence(__ATOMIC_ACQUIRE, "agent");
            asm volatile("s_waitcnt vmcnt(0)" ::: "memory");
        } else {
            XB_SPIN(xb_ld(&bar[XB_TOP]) < (gen + 1u) * nx, bar);
            __builtin_amdgcn_fence(__ATOMIC_ACQUIRE, "agent");
            asm volatile("s_waitcnt vmcnt(0)" ::: "memory");
        }
    }
    __syncthreads();
}

struct XbTicket { unsigned mode, gen; };
__device__ __forceinline__ XbTicket xcd_barrier_arrive(const XcdBarrier& b, bool leader) {
    asm volatile("s_waitcnt vmcnt(0)" ::: "memory");
    __syncthreads();
    XbTicket t; t.mode = 3u; t.gen = 0u;
    if (leader) {
        unsigned* bar = b.bar;
        __builtin_amdgcn_s_waitcnt(0);
        unsigned nloc = b.st[0], nx = b.st[1];
        if (nloc == 0u) { xcd_barrier_complete(bar, b.x, nloc, nx); b.st[0] = nloc; b.st[1] = nx; }
        const unsigned old = xb_add(&bar[XB_XSUB(b.x)], 1u);
        const unsigned gen = old / nloc;
        if (old + 1u == (gen + 1u) * nloc) {
            __builtin_amdgcn_fence(__ATOMIC_RELEASE, "agent");
            asm volatile("s_waitcnt vmcnt(0)" ::: "memory");
            const unsigned og = xb_add(&bar[XB_TOP], 1u);
            const unsigned tg = og / nx;
            if (og + 1u == (tg + 1u) * nx) t.mode = 2u;
            else { t.mode = 1u; t.gen = (tg + 1u) * nx; }
        } else { t.mode = 0u; t.gen = (gen + 1u) * nx; }
    }
    return t;
}
__device__ __forceinline__ void xcd_barrier_wait(const XcdBarrier& b, const XbTicket t, bool leader) {
    if (leader) {
        unsigned* bar = b.bar;
        if (t.mode <= 1u) { XB_SPIN(xb_ld(&bar[XB_TOP]) < t.gen, bar); }
        __builtin_amdgcn_fence(__ATOMIC_ACQUIRE, "agent");
        asm volatile("s_waitcnt vmcnt(0)" ::: "memory");
    }
    __syncthreads();
}

namespace g8 {
constexpr int BM = 256, BK = 64, HALF = 128, HTB = HALF * BK * 2, STAGE_BYTES = 8 * HTB, NXCD = 8, WGM = 8;
__host__ __device__ __forceinline__ int lds_byte(int r, int c) { const int st = (r >> 4) * 2 + (c >> 5), rr = r & 15, cc = c & 31, ob = rr * 64 + cc * 2; return st * 1024 + (ob ^ (((ob >> 9) & 1) << 5)); }
__host__ __device__ __forceinline__ void stage_rc(int b, int& R, int& C) { const int st = b / 1024, sb = b % 1024, swz = sb ^ (((sb >> 9) & 1) << 5); R = (st >> 1) * 16 + swz / 64; C = (st & 1) * 32 + (swz % 64) / 2; }
__host__ __device__ __forceinline__ int perm32(int rho) { const int n = rho >> 4, i = rho & 15; return 8 * (i >> 2) + 4 * n + (i & 3); }

struct Unit { const char* a; const char* b; int pm, pn, kind, ex; };

__device__ __forceinline__ void tile_of(int L, int nM, int nN, int& pm, int& pn) {
    const int nwg = nM * nN; int wgid = L;
    { const int q = nwg / NXCD, r = nwg % NXCD, xcd = wgid % NXCD, off = wgid / NXCD; wgid = (xcd < r ? xcd * (q + 1) : r * (q + 1) + (xcd - r) * q) + off; }
    const int nig = WGM * nN, gid = wgid / nig, fm = gid * WGM, gsz = (nM - fm) < WGM ? (nM - fm) : WGM;
    pm = fm + ((wgid % nig) % gsz); pn = (wgid % nig) / gsz;
}

typedef int i32x8 __attribute__((ext_vector_type(8)));
template <bool FP8, bool GATHER, bool SP2, class Epi, class Sched>
__device__ __forceinline__ void gemm_phase_s(LAS unsigned char* lds, const int K, const Sched& S, const Epi& E, const int wid_, const int lane) {
    int wid = wid_; asm volatile("" : "+s"(wid));
    const int tid = wid * 64 + lane, wr = wid >> 2, wc = wid & 3, fr = lane & 15, fq = lane >> 4;
    const int nt = FP8 ? K / 128 : K / BK;
    const int RP = FP8 ? K : 2 * K;
    unsigned voffA[2], voffB[2]; int srow[2], scol[2];
#pragma unroll
    for (int i = 0; i < 2; ++i) { int R, C; stage_rc(tid * 16 + i * 8192, R, C); const int Rb = (R & ~31) + perm32(R & 31);
        voffA[i] = (unsigned)(R * RP + C * 2); voffB[i] = (unsigned)(Rb * RP + C * 2); srow[i] = R; scol[i] = C * 2; }
    const size_t kstep = (size_t)(BK * 2);
    const size_t hstep = (size_t)HALF * RP;
    const unsigned ldsw = (unsigned)wid * 1024u;
    unsigned cO0[2], cO1[2], nO0[2], nO1[2];
#define PG8_GOFF(D0, D1, ui_) do { if constexpr (GATHER) { const LAS int* rw_ = S.rows(ui_); _Pragma("unroll") for (int i_ = 0; i_ < 2; ++i_) { \
        D0[i_] = (unsigned)rw_[srow[i_]] * (unsigned)RP + (unsigned)scol[i_]; D1[i_] = (unsigned)rw_[128 + srow[i_]] * (unsigned)RP + (unsigned)scol[i_]; } } \
      else { _Pragma("unroll") for (int i_ = 0; i_ < 2; ++i_) { D0[i_] = voffA[i_]; D1[i_] = voffA[i_] + (unsigned)hstep; } } } while (0)
    const int aoff = lds_byte(wr * 64 + fr, FP8 ? fq * 16 : fq * 8), boff = lds_byte(wc * 32 + fr, FP8 ? fq * 16 : fq * 8);
    constexpr int KOFF = FP8 ? 16 : 1024;
#define PG8_SA(b, h) (((b) * 2 + (h)) * HTB)
#define PG8_SB(b, h) ((4 + (b) * 2 + (h)) * HTB)
#define PG8_STAGE(bufoff, gbase, voff) do { _Pragma("unroll") for (int _i = 0; _i < 2; ++_i) \
        __builtin_amdgcn_global_load_lds((const unsigned*)((const char*)(gbase) + (voff)[_i]), (LAS unsigned*)(lds + (bufoff) + ldsw + _i * 8192), 16, 0, 0); } while (0)
#define PG8_LD32(p) __builtin_bit_cast(i32x8, __builtin_shufflevector(*(const LAS u32x4*)(p), *(const LAS u32x4*)((p) + 16), 0, 1, 2, 3, 4, 5, 6, 7))
#define PG8_LDA8(dst, b, h) do { _Pragma("unroll") for (int m = 0; m < 4; ++m) dst[m] = PG8_LD32(lds + PG8_SA(b, h) + aoff + m * 2048); } while (0)
#define PG8_LDB8(dst, b, h) do { _Pragma("unroll") for (int n = 0; n < 2; ++n) dst[n] = PG8_LD32(lds + PG8_SB(b, h) + boff + n * 2048); } while (0)
#define PG8_LDA(dst, b, h) do { _Pragma("unroll") for (int m = 0; m < 4; ++m) _Pragma("unroll") for (int k = 0; k < 2; ++k) dst[m][k] = *(const LAS bf16x8*)(lds + PG8_SA(b, h) + aoff + m * 2048 + k * KOFF); } while (0)
#define PG8_LDB(dst, b, h) do { _Pragma("unroll") for (int n = 0; n < 2; ++n) _Pragma("unroll") for (int k = 0; k < 2; ++k) dst[n][k] = *(const LAS bf16x8*)(lds + PG8_SB(b, h) + boff + n * 2048 + k * KOFF); } while (0)
#define PG8_MMA(ai, bj, At, Bt) do { __builtin_amdgcn_s_setprio(1); _Pragma("unroll") for (int m = 0; m < 4; ++m) _Pragma("unroll") for (int n = 0; n < 2; ++n) _Pragma("unroll") for (int k = 0; k < 2; ++k) \
        acc[ai][bj][m][n] = __builtin_amdgcn_mfma_f32_16x16x32_bf16(Bt[n][k], At[m][k], acc[ai][bj][m][n], 0, 0, 0); __builtin_amdgcn_s_setprio(0); } while (0)
#define PG8_MMA8(ai, bj, At, Bt) do { __builtin_amdgcn_s_setprio(1); _Pragma("unroll") for (int m = 0; m < 4; ++m) _Pragma("unroll") for (int n = 0; n < 2; ++n) \
        asm volatile("v_mfma_scale_f32_16x16x128_f8f6f4 %0, %1, %2, %0, %3, %3 op_sel_hi:[0,0,0]" : "+v"(acc[ai][bj][m][n]) : "v"(Bt[n]), "v"(At[m]), "v"(one_scale)); __builtin_amdgcn_s_setprio(0); } while (0)
#define PG8_WAIT_V(n) asm volatile("s_waitcnt vmcnt(" #n ")" ::: "memory")
#define PG8_WAIT_L(n) asm volatile("s_waitcnt lgkmcnt(" #n ")" ::: "memory")
#define PG8_BAR __builtin_amdgcn_s_barrier()
#define PG8_SCHED __builtin_amdgcn_sched_barrier(0)
    Unit cur, nxt; int ui = 0;
    if (!S.next(0, cur)) return;
    f32x4 acc[2][2][4][2];
#pragma unroll
    for (int a = 0; a < 2; ++a)
#pragma unroll
        for (int b = 0; b < 2; ++b)
#pragma unroll
            for (int m = 0; m < 4; ++m)
#pragma unroll
                for (int n = 0; n < 2; ++n) acc[a][b][m][n] = (f32x4){0.f, 0.f, 0.f, 0.f};
    bf16x8 At[4][2], B0[2][2], B1[2][2];
    i32x8 At8[4], B08[2], B18[2];
    const unsigned one_scale = 0x7f7f7f7fu;
    const char* cA = cur.a; const char* cB = cur.b;
    PG8_GOFF(cO0, cO1, 0);
    if constexpr (SP2) {
    PG8_STAGE(PG8_SB(0, 0), cB, voffB); PG8_STAGE(PG8_SB(0, 1), cB + hstep, voffB); PG8_STAGE(PG8_SA(0, 0), cA, cO0); PG8_STAGE(PG8_SA(0, 1), cA, cO1);
    if (wr == 1) PG8_BAR;
    PG8_WAIT_V(2); PG8_BAR;
    PG8_STAGE(PG8_SB(1, 0), cB + kstep, voffB); PG8_STAGE(PG8_SA(1, 0), cA + kstep, cO0); PG8_STAGE(PG8_SB(1, 1), cB + hstep + kstep, voffB);
    PG8_WAIT_V(6); PG8_BAR;
    } else {
    PG8_STAGE(PG8_SB(0, 0), cB, voffB); PG8_STAGE(PG8_SA(0, 0), cA, cO0); PG8_STAGE(PG8_SB(0, 1), cB + hstep, voffB); PG8_STAGE(PG8_SA(0, 1), cA, cO1);
    if (wr == 1) PG8_BAR;
    PG8_WAIT_V(4); PG8_BAR;
    PG8_STAGE(PG8_SB(1, 0), cB + kstep, voffB); PG8_STAGE(PG8_SA(1, 0), cA + kstep, cO0); PG8_STAGE(PG8_SB(1, 1), cB + hstep + kstep, voffB);
    PG8_WAIT_V(6); PG8_BAR;
    }
    for (;;) {
        const bool has_next = S.next(ui + 1, nxt);
        const typename Epi::Pre pre = E.preload(cur, wr, wc, fr, fq);
        const char* nA = has_next ? nxt.a : cA; const char* nB = has_next ? nxt.b : cB;
        if (has_next) PG8_GOFF(nO0, nO1, ui + 1); else { _Pragma("unroll") for (int i_ = 0; i_ < 2; ++i_) { nO0[i_] = cO0[i_]; nO1[i_] = cO1[i_]; } }
#pragma unroll 1
        for (int t = 0; t < nt; t += 2) {
            const bool last = (t == nt - 2);
            const char* a1 = cA + (size_t)(t + 1) * kstep;
            const char* a2 = last ? nA : cA + (size_t)(t + 2) * kstep; const char* b2 = last ? nB : cB + (size_t)(t + 2) * kstep;
            const char* a3 = a2 + kstep; const char* b3 = b2 + kstep;
            unsigned o20[2], o21[2];
#pragma unroll
            for (int i_ = 0; i_ < 2; ++i_) { o20[i_] = last ? nO0[i_] : cO0[i_]; o21[i_] = last ? nO1[i_] : cO1[i_]; }
            if constexpr (FP8 && SP2) {
            PG8_LDB8(B08, 0, 0); PG8_LDB8(B18, 0, 1); PG8_SCHED; PG8_LDA8(At8, 0, 0); PG8_STAGE(PG8_SA(1, 1), a1, cO1);
            PG8_WAIT_V(8); PG8_WAIT_L(0); PG8_BAR; PG8_MMA8(0, 0, At8, B08); PG8_MMA8(0, 1, At8, B18); PG8_BAR; PG8_SCHED;
            PG8_LDA8(At8, 0, 1); PG8_STAGE(PG8_SB(0, 0), b2, voffB); PG8_STAGE(PG8_SB(0, 1), b2 + hstep, voffB); PG8_STAGE(PG8_SA(0, 0), a2, o20);
            PG8_WAIT_V(8); PG8_WAIT_L(0); PG8_BAR; PG8_MMA8(1, 0, At8, B08); PG8_MMA8(1, 1, At8, B18); PG8_BAR; PG8_SCHED;
            PG8_LDB8(B08, 1, 0); PG8_LDB8(B18, 1, 1); PG8_SCHED; PG8_LDA8(At8, 1, 0); PG8_STAGE(PG8_SA(0, 1), a2, o21);
            PG8_WAIT_V(8); PG8_WAIT_L(0); PG8_BAR; PG8_MMA8(0, 0, At8, B08); PG8_MMA8(0, 1, At8, B18); PG8_BAR; PG8_SCHED;
            PG8_LDA8(At8, 1, 1); PG8_STAGE(PG8_SB(1, 0), b3, voffB); PG8_STAGE(PG8_SB(1, 1), b3 + hstep, voffB); PG8_STAGE(PG8_SA(1, 0), a3, o20);
            PG8_WAIT_V(8); PG8_WAIT_L(0); PG8_BAR; PG8_MMA8(1, 0, At8, B08); PG8_MMA8(1, 1, At8, B18); PG8_BAR; PG8_SCHED;
            } else if constexpr (FP8) {
            PG8_LDB8(B08, 0, 0); PG8_SCHED; PG8_LDA8(At8, 0, 0); PG8_STAGE(PG8_SA(1, 1), a1, cO1);
            PG8_WAIT_L(8); PG8_BAR; PG8_WAIT_L(0); PG8_MMA8(0, 0, At8, B08); PG8_BAR; PG8_SCHED;
            PG8_LDB8(B18, 0, 1); PG8_STAGE(PG8_SB(0, 0), b2, voffB);
            PG8_BAR; PG8_WAIT_L(0); PG8_MMA8(0, 1, At8, B18); PG8_BAR;
            PG8_LDA8(At8, 0, 1); PG8_STAGE(PG8_SA(0, 0), a2, o20);
            PG8_BAR; PG8_WAIT_L(0); PG8_MMA8(1, 0, At8, B08); PG8_BAR; PG8_SCHED;
            PG8_STAGE(PG8_SB(0, 1), b2 + hstep, voffB);
            PG8_WAIT_V(6); PG8_BAR; PG8_MMA8(1, 1, At8, B18); PG8_BAR;
            PG8_LDB8(B08, 1, 0); PG8_SCHED; PG8_LDA8(At8, 1, 0); PG8_STAGE(PG8_SA(0, 1), a2, o21);
            PG8_WAIT_L(8); PG8_BAR; PG8_WAIT_L(0); PG8_MMA8(0, 0, At8, B08); PG8_BAR; PG8_SCHED;
            PG8_LDB8(B18, 1, 1); PG8_STAGE(PG8_SB(1, 0), b3, voffB);
            PG8_BAR; PG8_WAIT_L(0); PG8_MMA8(0, 1, At8, B18); PG8_BAR;
            PG8_LDA8(At8, 1, 1); PG8_STAGE(PG8_SA(1, 0), a3, o20);
            PG8_BAR; PG8_WAIT_L(0); PG8_MMA8(1, 0, At8, B08); PG8_BAR; PG8_SCHED;
            PG8_STAGE(PG8_SB(1, 1), b3 + hstep, voffB);
            PG8_WAIT_V(6); PG8_BAR; PG8_MMA8(1, 1, At8, B18); PG8_BAR;
            } else {
            PG8_LDB(B0, 0, 0); PG8_LDB(B1, 0, 1); PG8_SCHED; PG8_LDA(At, 0, 0); PG8_STAGE(PG8_SA(1, 1), a1, cO1);
            PG8_WAIT_V(8); PG8_WAIT_L(0); PG8_BAR; PG8_MMA(0, 0, At, B0); PG8_MMA(0, 1, At, B1); PG8_BAR; PG8_SCHED;
            PG8_LDA(At, 0, 1); PG8_STAGE(PG8_SB(0, 0), b2, voffB); PG8_STAGE(PG8_SB(0, 1), b2 + hstep, voffB); PG8_STAGE(PG8_SA(0, 0), a2, o20);
            PG8_WAIT_V(8); PG8_WAIT_L(0); PG8_BAR; PG8_MMA(1, 0, At, B0); PG8_MMA(1, 1, At, B1); PG8_BAR; PG8_SCHED;
            PG8_LDB(B0, 1, 0); PG8_LDB(B1, 1, 1); PG8_SCHED; PG8_LDA(At, 1, 0); PG8_STAGE(PG8_SA(0, 1), a2, o21);
            PG8_WAIT_V(8); PG8_WAIT_L(0); PG8_BAR; PG8_MMA(0, 0, At, B0); PG8_MMA(0, 1, At, B1); PG8_BAR; PG8_SCHED;
            PG8_LDA(At, 1, 1); PG8_STAGE(PG8_SB(1, 0), b3, voffB); PG8_STAGE(PG8_SB(1, 1), b3 + hstep, voffB); PG8_STAGE(PG8_SA(1, 0), a3, o20);
            PG8_WAIT_V(8); PG8_WAIT_L(0); PG8_BAR; PG8_MMA(1, 0, At, B0); PG8_MMA(1, 1, At, B1); PG8_BAR; PG8_SCHED;
            }
        }
        if (wr == 0) PG8_BAR;
        if constexpr (FP8) asm volatile("s_nop 15\n\ts_nop 15" ::: "memory");
        E(acc, cur, wr, wc, fr, fq, pre);
        if (!has_next) break;
#pragma unroll
        for (int a = 0; a < 2; ++a)
#pragma unroll
            for (int b = 0; b < 2; ++b)
#pragma unroll
                for (int m = 0; m < 4; ++m)
#pragma unroll
                    for (int n = 0; n < 2; ++n) acc[a][b][m][n] = (f32x4){0.f, 0.f, 0.f, 0.f};
        cur = nxt; cA = nA; cB = nB; ++ui;
#pragma unroll
        for (int i_ = 0; i_ < 2; ++i_) { cO0[i_] = nO0[i_]; cO1[i_] = nO1[i_]; }
        if (wr == 1) PG8_BAR;
    }
    PG8_WAIT_V(0);
    PG8_BAR;
#undef PG8_SA
#undef PG8_GOFF
#undef PG8_SB
#undef PG8_STAGE
#undef PG8_LDA
#undef PG8_LDB
#undef PG8_MMA
#undef PG8_MMA8
#undef PG8_LDA8
#undef PG8_LDB8
#undef PG8_LD32
#undef PG8_WAIT_V
#undef PG8_WAIT_L
#undef PG8_BAR
#undef PG8_SCHED
}
template <bool FP8, bool GATHER, class Epi, class Sched>
__device__ __forceinline__ void gemm_phase_g(LAS unsigned char* lds, const int K, const Sched& S, const Epi& E, const int wid, const int lane) { gemm_phase_s<FP8, GATHER, !FP8>(lds, K, S, E, wid, lane); }
template <bool FP8, class Epi, class Sched>
__device__ __forceinline__ void gemm_phase(LAS unsigned char* lds, const int K, const Sched& S, const Epi& E, const int wid, const int lane) { gemm_phase_s<FP8, false, !FP8>(lds, K, S, E, wid, lane); }
}

__device__ __forceinline__ int lane_id() { int l; asm volatile("v_mbcnt_lo_u32_b32 %0, -1, 0\n\tv_mbcnt_hi_u32_b32 %0, -1, %0" : "=v"(l)); return l; }
#define FT_DECL const int f_lane = lane_id(), f_tid = F.wave * 64 + f_lane; (void)f_tid; (void)f_lane
typedef const float* cfp_t;
typedef __attribute__((address_space(4))) cfp_t* kin_t;
struct Frame {
    LAS unsigned char* lds;
    volatile LAS unsigned* MISC;
    gu32* ctl;
    int wave, vcu, G;
    kin_t in;
    float* out;
    unsigned char* ws;
};
#define WSP(T, off) ((T*)(F.ws + (off)))

template <class RowMap>
__device__ __forceinline__ void p0_transpose_item(const float* W, int K, int N, bf16_t* WT, const RowMap& rowmap, const float* kscale, LAS float* scr, int item, int lane, bool kperm = false) {
    const int nblk = N / 32, kb = item / nblk, nb = item % nblk, k0 = 64 * kb, n0 = 32 * nb;
#pragma unroll 8
    for (int i = 0; i < 32; ++i) { const int kk = 2 * i + (lane >> 5); int ks = k0 + kk; if (kperm && ks >= K / 2) { const int j = ks - K / 2; ks = K / 2 + (j >> 3) + 64 * (j & 7); }
        float v = W[(size_t)ks * N + n0 + (lane & 31)]; if (kscale) v *= kscale[k0 + kk]; scr[kk * 33 + (lane & 31)] = v; }
    LDS_WAIT(); asm volatile("" ::: "memory");
    const int c = lane & 7;
#pragma unroll
    for (int j = 0; j < 4; ++j) { const int n = (lane >> 3) + 8 * j; const LAS float* s = scr + (8 * c) * 33 + n;
        u32x4 o; o.x = cvt_pk_bf16(s[0 * 33], s[1 * 33]); o.y = cvt_pk_bf16(s[2 * 33], s[3 * 33]); o.z = cvt_pk_bf16(s[4 * 33], s[5 * 33]); o.w = cvt_pk_bf16(s[6 * 33], s[7 * 33]);
        *(GAS u32x4*)(WT + (size_t)rowmap(n0 + n) * K + k0 + 8 * c) = o; }
    LDS_WAIT(); asm volatile("" ::: "memory");
}

__device__ __forceinline__ unsigned pk4_fp8(float a, float b, float c, float d) { int r = __builtin_amdgcn_cvt_pk_fp8_f32(a, b, 0, false); r = __builtin_amdgcn_cvt_pk_fp8_f32(c, d, r, true); return (unsigned)r; }
constexpr float EOSCALE = 16.f;
constexpr float WSCALE = 32.f;
template <class RowMap>
__device__ __forceinline__ void p0_transpose_item_f8(const float* W, int K, int N, unsigned char* WT, const RowMap& rowmap, LAS float* scr, int item, int lane, int ncols = 0) {
    const int nblk = (ncols ? ncols : N) / 32, kb = item / nblk, nb = item % nblk, k0 = 128 * kb, n0 = 32 * nb;
#pragma unroll
    for (int hh = 0; hh < 2; ++hh) { float v[32];
#pragma unroll
        for (int i = 0; i < 32; ++i) { const int kk = 2 * (32 * hh + i) + (lane >> 5); v[i] = __builtin_nontemporal_load(W + (size_t)(k0 + kk) * N + n0 + (lane & 31)); }
#pragma unroll
        for (int i = 0; i < 32; ++i) { const int kk = 2 * (32 * hh + i) + (lane >> 5); scr[kk * 33 + (lane & 31)] = v[i] * WSCALE; } }
    LDS_WAIT(); asm volatile("" ::: "memory");
    const int c = lane & 7;
#pragma unroll
    for (int j = 0; j < 4; ++j) { const int n = (lane >> 3) + 8 * j; const LAS float* sp = scr + (16 * c) * 33 + n;
        u32x4 o; o.x = pk4_fp8(sp[0 * 33], sp[1 * 33], sp[2 * 33], sp[3 * 33]); o.y = pk4_fp8(sp[4 * 33], sp[5 * 33], sp[6 * 33], sp[7 * 33]);
        o.z = pk4_fp8(sp[8 * 33], sp[9 * 33], sp[10 * 33], sp[11 * 33]); o.w = pk4_fp8(sp[12 * 33], sp[13 * 33], sp[14 * 33], sp[15 * 33]);
        *(GAS u32x4*)(WT + (size_t)rowmap(n0 + n) * K + k0 + 16 * c) = o; }
    LDS_WAIT(); asm volatile("" ::: "memory");
}
__device__ __forceinline__ void f8_item_load4(const float* W, int N, int item, int lane, f32x4 (&v)[16]) {
    const int nblk = N / 32, kb = item / nblk, nb = item % nblk, k0 = 128 * kb, n0 = 32 * nb;
    const float* p = W + (size_t)(k0 + (lane >> 3)) * N + n0 + 4 * (lane & 7);
#pragma unroll
    for (int i = 0; i < 16; ++i) v[i] = __builtin_nontemporal_load((const f32x4*)(p + (size_t)(8 * i) * N));
}
template <class RowMap>
__device__ __forceinline__ void f8_item_finish4(const f32x4 (&v)[16], int K, int N, unsigned char* WT, const RowMap& rowmap, LAS float* scr, int item, int lane) {
    const int nblk = N / 32, kb = item / nblk, nb = item % nblk, k0 = 128 * kb, n0 = 32 * nb;
    LAS float* w = scr + (lane >> 3) * 33 + 4 * (lane & 7);
#pragma unroll
    for (int i = 0; i < 16; ++i) { w[(8 * i) * 33 + 0] = v[i].x * WSCALE; w[(8 * i) * 33 + 1] = v[i].y * WSCALE; w[(8 * i) * 33 + 2] = v[i].z * WSCALE; w[(8 * i) * 33 + 3] = v[i].w * WSCALE; }
    LDS_WAIT(); asm volatile("" ::: "memory");
    const int c = lane & 7;
#pragma unroll
    for (int j = 0; j < 4; ++j) { const int n = (lane >> 3) + 8 * j; const LAS float* sp = scr + (16 * c) * 33 + n;
        u32x4 o; o.x = pk4_fp8(sp[0 * 33], sp[1 * 33], sp[2 * 33], sp[3 * 33]); o.y = pk4_fp8(sp[4 * 33], sp[5 * 33], sp[6 * 33], sp[7 * 33]);
        o.z = pk4_fp8(sp[8 * 33], sp[9 * 33], sp[10 * 33], sp[11 * 33]); o.w = pk4_fp8(sp[12 * 33], sp[13 * 33], sp[14 * 33], sp[15 * 33]);
        *(GAS u32x4*)(WT + (size_t)rowmap(n0 + n) * K + k0 + 16 * c) = o; }
    LDS_WAIT(); asm volatile("" ::: "memory");
}
struct MapW2 { __device__ __forceinline__ int operator()(int l) const { const int t = l & ~255, r = l & 255, wc = r >> 6, fq = (r >> 4) & 3, bj = (r >> 3) & 1, low = r & 7; return t + 128 * bj + 32 * wc + 8 * fq + low; } };
struct MapIdent { int off; __device__ __forceinline__ int operator()(int n) const { return off + n; } };
struct MapWin { __device__ __forceinline__ int operator()(int l) const {
    if (l >= 1024) return l;
    const int t = l & ~255, r = l & 255, wc = r >> 6, blk = (r >> 5) & 1, bj = (r >> 4) & 1, low = r & 15;
    return t + 128 * bj + 32 * wc + 16 * blk + low; } };
struct MapW1 { int off; __device__ __forceinline__ int operator()(int jp) const { const int bj = jp >> 10, j = jp & 1023; return off + 256 * (j >> 7) + 128 * bj + (j & 127); } };


__device__ __forceinline__ void p0_filter_item(Frame& F, int item) {
    FT_DECL;
#define in F.in
    LAS float* h1s = (LAS float*)(F.lds);
    LAS float* h2s = (LAS float*)(F.lds + 4096);
    const int t0 = item * 16;
    {
        const int tt = f_tid >> 5, hh = (f_tid & 31) * 2; const float pos = (float)(t0 + tt);
        float feats[17]; feats[0] = pos * (1.f / SEQ);
#pragma unroll
        for (int i = 0; i < 8; ++i) { const float band = 1e-4f + (float)i * ((7.f - 1e-4f) / 7.f); const float ang = (6.283185307179586f / SEQ) * pos * band; feats[1 + i] = __sinf(ang); feats[9 + i] = __cosf(ang); }
#pragma unroll
        for (int u = 0; u < 2; ++u) { const int h = hh + u; float a = in[19][h];
#pragma unroll
            for (int k = 0; k < 17; ++k) a += feats[k] * in[18][k * 64 + h];
            h1s[tt * 64 + h] = __sinf(in[20][h] * a); }
        __syncthreads();
#pragma unroll
        for (int u = 0; u < 2; ++u) { const int h = hh + u; float a = in[22][h];
#pragma unroll 8
            for (int k = 0; k < 64; ++k) a += h1s[tt * 64 + k] * in[21][k * 64 + h];
            h2s[tt * 64 + h] = __sinf(in[23][h] * a); }
        __syncthreads();
    }
    f32x4 acc[16];
#pragma unroll
    for (int t = 0; t < 16; ++t) acc[t] = (f32x4){0.f, 0.f, 0.f, 0.f};
    const int o = 4 * f_tid;
    for (int k0 = 0; k0 < 64; k0 += 4) { f32x4 w[4];
#pragma unroll
        for (int q = 0; q < 4; ++q) w[q] = *(const f32x4*)(in[24] + (size_t)(k0 + q) * 2048 + o);
#pragma unroll
        for (int t = 0; t < 16; ++t) { const f32x4 hv = *(const LAS f32x4*)(h2s + t * 64 + k0); acc[t] += w[0] * hv[0] + w[1] * hv[1] + w[2] * hv[2] + w[3] * hv[3]; } }
    const int c0 = o & 511, od = o >> 9;
    float* dst = WSP(float, WS_FILT) + ((size_t)od * 512 + c0) * SEQ + t0;
#pragma unroll
    for (int e = 0; e < 4; ++e) { const float la = -3.0701134573253944f, lb = -15.350567286626972f; const float delta = fabsf(la + (float)(c0 + e) * ((lb - la) / 511.f));
#pragma unroll
        for (int q = 0; q < 4; ++q) { f32x4 v;
#pragma unroll
            for (int i = 0; i < 4; ++i) { const int t = 4 * q + i; const float tn = (float)(t0 + t) * (1.f / SEQ); v[i] = acc[t][e] * __expf(-tn * delta); }
            *(f32x4*)(dst + (size_t)e * SEQ + 4 * q) = v; } }
    __syncthreads();
#undef in
}

__device__ __forceinline__ float silu_f(float v) { return v / (1.f + __expf(-v)); }

__device__ __forceinline__ void p0_prologue(Frame& F) {
    FT_DECL;
#define in F.in
    const int wg = blockIdx.x;
    if (wg < 96) {
        LAS float* sv = (LAS float*)F.lds;
        for (int i = f_tid; i < 9 * 1024; i += 512) { const int r = i >> 10, k = i & 1023; const float c = (r < 8) ? in[1][r * 1024 + k] : in[3][k]; sv[i] = silu_f(c); }
        __syncthreads();
        const int j = wg * 64 + f_lane; const float* wm = in[4];
        float acc[9];
#pragma unroll
        for (int r = 0; r < 9; ++r) acc[r] = 0.f;
        const int kbeg = F.wave * 128;
        for (int k0 = kbeg; k0 < kbeg + 128; k0 += 16) { float w[16];
#pragma unroll
            for (int q = 0; q < 16; ++q) w[q] = __builtin_nontemporal_load(wm + (size_t)(k0 + q) * (NMOD * DM) + j);
#pragma unroll
            for (int q = 0; q < 16; ++q)
#pragma unroll
                for (int r = 0; r < 9; ++r) acc[r] += sv[r * 1024 + k0 + q] * w[q]; }
        LAS float* red = (LAS float*)(F.lds + 40960);
#pragma unroll
        for (int r = 0; r < 9; ++r) red[(F.wave * 9 + r) * 64 + f_lane] = acc[r];
        __syncthreads();
        for (int i = f_tid; i < 9 * 64; i += 512) { const int r = i >> 6, l = i & 63; float s = in[5][wg * 64 + l];
#pragma unroll
            for (int w = 0; w < 8; ++w) s += red[(w * 9 + r) * 64 + l];
            WSP(float, WS_SMALL + SM_MOD)[r * (NMOD * DM) + wg * 64 + l] = s; }
        asm volatile("s_waitcnt vmcnt(0)" ::: "memory");
        __syncthreads();
        if (f_tid == 0) { __builtin_amdgcn_fence(__ATOMIC_RELEASE, "agent"); asm volatile("s_waitcnt vmcnt(0)" ::: "memory"); (void)xb_add((unsigned*)(F.ctl + CW_GEMV), 1u); }
    } else if (wg == 96) {
        if (F.wave == 0) {
            const float a = wave_sum(in[11][f_lane] * in[12][f_lane]), b = wave_sum(in[13][f_lane] * in[14][f_lane]);
            float gq = fabsf(in[9][f_lane]), gk = fabsf(in[10][f_lane]);
#pragma unroll
            for (int o = 1; o < 64; o <<= 1) { gq = fmaxf(gq, __shfl_xor(gq, o)); gk = fmaxf(gk, __shfl_xor(gk, o)); }
            if (f_lane == 0) { float* sc = WSP(float, WS_SMALL + SM_SCAL); sc[0] = expf(a) - expf(b) + LAM_INIT;
                sc[1] = (8.f * gq * gk * 1.02f + 0.05f) * 1.4426950408889634f; }
        }
        for (int i = f_tid; i < 64 * 16; i += 512) { const int pos = i >> 4, f = i & 15;
            const float inv = powf(10000.f, -(float)f / 16.f); const float ang = (float)pos * inv;
            float* rt = WSP(float, WS_SMALL + SM_ROPE); rt[2 * i] = cosf(ang); rt[2 * i + 1] = sinf(ang); }
    }
    __syncthreads();
    for (int it = wg; it < SEQ / 16; it += F.G) p0_filter_item(F, it);
    __syncthreads();
    {
        LAS float* scr = (LAS float*)(F.lds + F.wave * 16896);
        const int gw = F.vcu * NWAVES + F.wave, NGW = F.G * NWAVES;
        constexpr int I_IN = (DM / 64) * (INC / 32), I_OUT = (DM / 64) * (DM / 32), I_IN8 = (DM / 128) * (QKVC / 32);
        constexpr int NITEMS = I_IN + I_OUT + I_IN8;
        for (int it = gw; it < NITEMS; it += NGW) {
            int r = it;
            if (r < I_IN) { p0_transpose_item(in[8], DM, INC, WSP(bf16_t, WS_WIN), MapWin{}, nullptr, scr, r, f_lane); continue; } r -= I_IN;
            if (r < I_OUT) { p0_transpose_item(in[27], DM, DM, WSP(bf16_t, WS_WOUT), MapIdent{0}, nullptr, scr, r, f_lane, true); continue; } r -= I_OUT;
            p0_transpose_item_f8(in[8], DM, INC, WSP(unsigned char, WS_WIN8), MapWin{}, scr, r, f_lane, QKVC);
        }
    }
}
#undef in

constexpr int CV_NIT = NEXP * ((DM / 128) * (2 * DM / 32) + (DM / 128) * (DM / 32));
constexpr int CV_SPLIT = 7680;
__device__ __forceinline__ void p2_convert_chunk(Frame& F, int q, int ncw, int lo, int NIT) {
    FT_DECL;
    constexpr int I_1 = (DM / 128) * (2 * DM / 32), I_2 = (DM / 128) * (DM / 32);
    LAS float* scr = (LAS float*)(F.lds + F.wave * 16896);
    asm volatile("s_waitcnt vmcnt(0)" ::: "memory");
    __syncthreads();
    const int st = ncw * NWAVES;
#define CV_SRC(it) const int e_ = (it) / (I_1 + I_2), r_ = (it) - e_ * (I_1 + I_2); const bool one_ = r_ < I_1; \
        const float* W_ = one_ ? F.in[30] + (size_t)e_ * DM * 2 * DM : F.in[32] + (size_t)e_ * DM * DM; const int N_ = one_ ? 2 * DM : DM
#define CV_LOAD(v, it) do { CV_SRC(it); f8_item_load4(W_, N_, one_ ? r_ : r_ - I_1, f_lane, v); } while (0)
#define CV_FIN(v, it) do { CV_SRC(it); (void)W_; (void)N_; \
        if (one_) f8_item_finish4(v, DM, 2 * DM, WSP(unsigned char, WS_W1) + (size_t)e_ * 2 * DM * DM, MapW1{0}, scr, r_, f_lane); \
        else f8_item_finish4(v, DM, DM, WSP(unsigned char, WS_W2) + (size_t)e_ * DM * DM, MapW2{}, scr, r_ - I_1, f_lane); } while (0)
    f32x4 va[16], vb[16];
    int it = lo + q * NWAVES + F.wave;
    if (it < NIT) CV_LOAD(va, it);
#pragma unroll 1
    for (; it < NIT; it += 2 * st) {
        if (it + st < NIT) CV_LOAD(vb, it + st);
        CV_FIN(va, it);
        if (it + 2 * st < NIT) CV_LOAD(va, it + 2 * st);
        if (it + st < NIT) CV_FIN(vb, it + st);
    }
#undef CV_SRC
#undef CV_LOAD
#undef CV_FIN
    __syncthreads();
}

__device__ __forceinline__ void p1_rbias(Frame& F) {
    FT_DECL;
    const float* mod = WSP(float, WS_SMALL + SM_MOD);
    for (int pe = blockIdx.x; pe < NB * NEXP; pe += F.G) { const int b = pe >> 5, e = pe & 31; const float* sh2 = mod + (size_t)b * (NMOD * DM) + 3 * DM; const float* rw = F.in[28];
        const int t = F.wave * 64 + lane_id();
        float a = sh2[t] * rw[(size_t)t * 32 + e] + sh2[t + 512] * rw[(size_t)(t + 512) * 32 + e];
        a = wave_sum(a);
        LAS float* red = (LAS float*)F.lds;
        __syncthreads(); if (lane_id() == 0) red[F.wave] = a; __syncthreads();
        if (t == 0) { float sacc = F.in[29][e];
#pragma unroll
            for (int w = 0; w < NWAVES; ++w) sacc += red[w];
            WSP(float, WS_SMALL + SM_RBIAS)[pe] = sacc; }
        __syncthreads(); }
}
__device__ __forceinline__ void p1_norm1(Frame& F) {
    FT_DECL;
    const int gw = F.vcu * NWAVES + F.wave, NGW = F.G * NWAVES;
    const float* mod = WSP(float, WS_SMALL + SM_MOD); const float* g1 = F.in[6];
    bf16_t* H = WSP(bf16_t, WS_H);
    if (f_tid == 0) { unsigned* bar = (unsigned*)(F.ctl + CW_BAR); XB_SPIN(xb_ld((unsigned*)(F.ctl + CW_GEMV)) < 96u, bar); __builtin_amdgcn_fence(__ATOMIC_ACQUIRE, "agent"); asm volatile("s_waitcnt vmcnt(0)" ::: "memory"); }
    __syncthreads();
    constexpr int RPW = MTOT / (256 * NWAVES);
    for (int run = gw; run * RPW < MTOT; run += NGW) {
        const int r0 = run * RPW, r1 = (r0 + RPW < MTOT) ? r0 + RPW : MTOT;
        int curb = -1; f32x4 PA[4], PB[4];
        for (int m0 = r0; m0 < r1; m0 += 4) {
            f32x4 v[4][4];
#pragma unroll
            for (int u = 0; u < 4; ++u) { const int m = m0 + u; if (m < r1) {
                const float* xrow = (m < MROWS) ? F.in[0] + (size_t)m * DM : F.in[2] + (size_t)(m - MROWS) * DM; const GAS f32x4* xr = (const GAS f32x4*)xrow + f_lane;
#pragma unroll
                for (int j = 0; j < 4; ++j) v[u][j] = __builtin_nontemporal_load(xr + 64 * j); } }
#pragma unroll
            for (int u = 0; u < 4; ++u) { const int m = m0 + u; if (m < r1) {
                const int mb = (m < MROWS) ? (m >> 12) : 8;
                if (mb != curb) { curb = mb; const float* sh = mod + (size_t)mb * (NMOD * DM); const float* sc = sh + DM;
#pragma unroll
                    for (int j = 0; j < 4; ++j) { const int c = 4 * f_lane + 256 * j; PA[j] = *(const f32x4*)(g1 + c) * (*(const f32x4*)(sc + c) + 1.f); PB[j] = *(const f32x4*)(sh + c); } }
                float s = 0.f;
#pragma unroll
                for (int j = 0; j < 4; ++j) s += (v[u][j].x * v[u][j].x + v[u][j].y * v[u][j].y) + (v[u][j].z * v[u][j].z + v[u][j].w * v[u][j].w);
                const float rstd = rsqrtf(wave_sum(s) * (1.f / DM) + EPS);
                GAS u32x2* o8 = (GAS u32x2*)(H + (size_t)m * DM) + f_lane;
#pragma unroll
                for (int j = 0; j < 4; ++j) { const f32x4 y = v[u][j] * rstd * PA[j] + PB[j];
                    u32x2 w; w.x = cvt_pk_bf16(y.x, y.y); w.y = cvt_pk_bf16(y.z, y.w); o8[64 * j] = w;
                    ((GAS unsigned*)(WSP(unsigned char, WS_H8) + (size_t)m * DM))[f_lane + 64 * j] = pk4_fp8(y.x, y.y, y.z, y.w); } } }
        }
    }
}

struct SchedInProj8 {
    int G, c; const char* H; const char* W; int i0, i1;
    static constexpr int NA = 136 * 4, NV = 2 * 136;
    __device__ __forceinline__ bool next(int i, g8::Unit& u) const {
        if (i + i0 >= i1) return false;
        const long L = (long)(i + i0) * G + c;
        if (L < NA) { g8::tile_of((int)L, 136, 4, u.pm, u.pn); u.a = H + (size_t)u.pm * 256 * DM; u.b = W + (size_t)u.pn * 256 * DM; u.kind = 0; u.ex = 0; return true; }
        if (L < NA + NV) { g8::tile_of((int)L - NA, 2, 136, u.pm, u.pn); u.a = W + (size_t)(1024 + u.pm * 256) * DM; u.b = H + (size_t)u.pn * 256 * DM; u.kind = 2; u.ex = 0; return true; }
        return false;
    }
};
struct SchedInProj {
    int G, c; const char* H; const char* W; int i0, i1; int skip;
    static constexpr int NA = 136 * 4, NV = 2 * 136, NBU = 6 * 128;
    __device__ __forceinline__ bool next(int i, g8::Unit& u) const {
        if (i + i0 >= i1) return false;
        const long L = (long)(i + i0) * G + c + skip;
        if (L < NA) { g8::tile_of((int)L, 136, 4, u.pm, u.pn); u.a = H + (size_t)u.pm * 256 * DM * 2; u.b = W + (size_t)u.pn * 256 * DM * 2; u.kind = 0; u.ex = 0; return true; }
        if (L < NA + NV) { g8::tile_of((int)L - NA, 2, 136, u.pm, u.pn); u.a = W + (size_t)(1024 + u.pm * 256) * DM * 2; u.b = H + (size_t)u.pn * 256 * DM * 2; u.kind = 2; u.ex = 0; return true; }
        if (L < NA + NV + NBU) { g8::tile_of((int)L - NA - NV, 6, 128, u.pm, u.pn); u.a = W + (size_t)(QKVC + u.pm * 256) * DM * 2; u.b = H + (size_t)u.pn * 256 * DM * 2; u.kind = 1; u.ex = 0; return true; }
        return false;
    }
};
constexpr float Q8SCALE = 16.f;
struct EpiInProj {
    unsigned char *Q8, *K8, *VT8; bf16_t* UT; const float *gq, *gk; const LAS float* rope;
    struct Pre { f32x4 g[2][2]; };
    __device__ __forceinline__ Pre preload(const g8::Unit& u, int wr, int wc, int fr, int fq) const {
        Pre p; const int blk = fq >> 1, f = fq & 1; const float* gp = ((u.pn >> 1) == 0 ? gq : gk) + 32 * blk + 8 * f;
#pragma unroll
        for (int bj = 0; bj < 2; ++bj)
#pragma unroll
            for (int n = 0; n < 2; ++n) p.g[bj][n] = (u.kind == 0) ? *(const f32x4*)(gp + 16 * bj + 4 * n) : (f32x4){0.f, 0.f, 0.f, 0.f};
        return p;
    }
    __device__ __forceinline__ void operator()(f32x4 (&acc)[2][2][4][2], const g8::Unit& u, int wr, int wc, int fr, int fq, const Pre& P) const {
        asm volatile("" : "+v"(fr), "+v"(fq));
        if (u.kind == 1) {
            const int row0 = u.pm * 256 + wr * 64 + fr, col0 = u.pn * 256 + wc * 32 + 8 * fq;
#pragma unroll
            for (int ai = 0; ai < 2; ++ai)
#pragma unroll
                for (int m = 0; m < 4; ++m) { const int ch = row0 + ai * 128 + m * 16;
#pragma unroll
                    for (int bj = 0; bj < 2; ++bj) { const int tok = col0 + bj * 128; const f32x4 v0 = acc[ai][bj][m][0], v1 = acc[ai][bj][m][1];
                        u32x4 w; w.x = cvt_pk_bf16(v0[0], v0[1]); w.y = cvt_pk_bf16(v0[2], v0[3]); w.z = cvt_pk_bf16(v1[0], v1[1]); w.w = cvt_pk_bf16(v1[2], v1[3]);
                        *(u32x4*)(UT + ((size_t)(tok >> 7) * HYC + ch) * 128 + (tok & 127)) = w; } }
            return;
        }
        if (u.kind == 2) {
#pragma unroll
            for (int bj = 0; bj < 2; ++bj) { const int t8 = u.pn * 256 + bj * 128 + wc * 32 + 8 * fq;
                int b, key; if (t8 < MROWS) { b = t8 >> 12; key = CTXL + (t8 & 4095); } else { const int j = t8 - MROWS; b = j >> 8; key = j & 255; }
                const int tile = key >> 6, k = key & 63, ipos = (k < 32) ? 4 * (k >> 3) : 16 + 4 * ((k - 32) >> 3);
#pragma unroll
                for (int ai = 0; ai < 2; ++ai)
#pragma unroll
                    for (int m = 0; m < 4; ++m) { const int ch = u.pm * 256 + ai * 128 + wr * 64 + m * 16 + fr;
                        unsigned char* dst = VT8 + ((((size_t)(b * NHEAD + (ch >> 7)) * 68 + tile) * 128 + (ch & 127)) * 64) + ipos;
                        const f32x4 v0 = acc[ai][bj][m][0] * (1.f / WSCALE), v1 = acc[ai][bj][m][1] * (1.f / WSCALE);
                        *(unsigned*)dst = pk4_fp8(v0[0], v0[1], v0[2], v0[3]); *(unsigned*)(dst + 32) = pk4_fp8(v1[0], v1[1], v1[2], v1[3]); } }
            return;
        }
        const int blk = fq >> 1, f = fq & 1;
        const int sec = u.pn >> 1;
        const bool ctx = (u.pm >= 128);
        if (sec == 0 && ctx) return;
        const int colbase = (u.pn & 1) * 256 + wc * 64 + 32 * blk + 8 * f;
#pragma unroll
        for (int ai = 0; ai < 2; ++ai)
#pragma unroll
            for (int m = 0; m < 4; ++m) {
                const int rloc = ai * 128 + wr * 64 + m * 16 + fr; const int r = u.pm * 256 + rloc;
                f32x4 v[2][2];
#pragma unroll
                for (int bj = 0; bj < 2; ++bj)
#pragma unroll
                    for (int n = 0; n < 2; ++n) v[bj][n] = acc[ai][bj][m][n];
                size_t orow;
                if (sec == 0) orow = (size_t)r;
                else if (!ctx) orow = (size_t)(r >> 12) * KVL + CTXL + (r & 4095);
                else { const int j = r - MROWS; orow = (size_t)(j >> 8) * KVL + (j & 255); }
                float ss = 0.f;
#pragma unroll
                for (int bj = 0; bj < 2; ++bj)
#pragma unroll
                    for (int n = 0; n < 2; ++n) { const f32x4 sq = v[bj][n] * v[bj][n]; ss += (sq[0] + sq[1]) + (sq[2] + sq[3]); }
                ss += __shfl_xor(ss, 16); ss += __shfl_xor(ss, 32);
                const float rstd = rsqrtf(ss * (1.f / (64.f * WSCALE * WSCALE)) + EPS) * ((sec == 0 ? QSCALE * Q8SCALE : 1.f) / WSCALE);
#pragma unroll
                for (int bj = 0; bj < 2; ++bj)
#pragma unroll
                    for (int n = 0; n < 2; ++n) v[bj][n] *= P.g[bj][n] * rstd;
                if (!ctx) {
                    const int t = r & 4095; const int pos = blk ? (t & 63) : (t >> 6);
                    const LAS float* rp = rope + (pos * 16 + 8 * f) * 2;
#pragma unroll
                    for (int n = 0; n < 2; ++n) { const f32x4 cv = *(const LAS f32x4*)(rp + 8 * n), sv = *(const LAS f32x4*)(rp + 8 * n + 4);
                        const f32x4 x1 = v[0][n], x2 = v[1][n]; v[0][n] = x1 * cv - x2 * sv; v[1][n] = x2 * cv + x1 * sv; }
                }
                unsigned char* dst = (sec == 0 ? Q8 : K8) + orow * QKW + colbase;
#pragma unroll
                for (int bj = 0; bj < 2; ++bj) { u32x2 w; w.x = pk4_fp8(v[bj][0][0], v[bj][0][1], v[bj][0][2], v[bj][0][3]); w.y = pk4_fp8(v[bj][1][0], v[bj][1][1], v[bj][1][2], v[bj][1][3]);
                    *(u32x2*)(dst + 16 * bj) = w; }
            }
    }
};

struct SchedStatic {
    int G, c, nM, nN; const char* A; const char* B;
    __device__ __forceinline__ bool next(int i, g8::Unit& u) const {
        const long L = (long)i * G + c; if (L >= (long)nM * nN) return false;
        g8::tile_of((int)L, nM, nN, u.pm, u.pn); u.a = A + (size_t)u.pm * 256 * DM * 2; u.b = B + (size_t)u.pn * 256 * DM * 2; u.kind = 0; u.ex = 0; return true;
    }
};
struct EpiOutProj {
    const float* x; bf16_t* out; const float* mod;
    struct Pre { f32x4 gv[2][2]; };
    __device__ __forceinline__ Pre preload(const g8::Unit& u, int wr, int wc, int fr, int fq) const {
        const int col0 = u.pn * 256 + wc * 32 + 8 * fq; const float* g1 = mod + (size_t)((u.pm * 256) >> 12) * (NMOD * DM) + 2 * DM + col0; Pre p;
#pragma unroll
        for (int bj = 0; bj < 2; ++bj)
#pragma unroll
            for (int n = 0; n < 2; ++n) p.gv[bj][n] = *(const f32x4*)(g1 + bj * 128 + 4 * n);
        return p;
    }
    __device__ __forceinline__ void operator()(f32x4 (&acc)[2][2][4][2], const g8::Unit& u, int wr, int wc, int fr, int fq, const Pre& P) const {
        asm volatile("" : "+v"(fr), "+v"(fq));
        const int col0 = u.pn * 256 + wc * 32 + 8 * fq;
        const f32x4 gv[2][2] = {{P.gv[0][0], P.gv[0][1]}, {P.gv[1][0], P.gv[1][1]}};
#pragma unroll
        for (int ai = 0; ai < 2; ++ai)
#pragma unroll
            for (int m = 0; m < 4; ++m) { const int r = u.pm * 256 + ai * 128 + wr * 64 + m * 16 + fr;
                const size_t off = (size_t)r * DM + col0;
#pragma unroll
                for (int bj = 0; bj < 2; ++bj) { f32x4 o[2];
#pragma unroll
                    for (int n = 0; n < 2; ++n) { const f32x4 xv = __builtin_nontemporal_load((const f32x4*)(x + off + bj * 128 + 4 * n)); o[n] = xv + gv[bj][n] * acc[ai][bj][m][n]; }
                    u32x4 w; w.x = cvt_pk_bf16(o[0][0], o[0][1]); w.y = cvt_pk_bf16(o[0][2], o[0][3]); w.z = cvt_pk_bf16(o[1][0], o[1][1]); w.w = cvt_pk_bf16(o[1][2], o[1][3]);
                    *(u32x4*)(out + off + bj * 128) = w; } }
    }
};

namespace att8 {
constexpr int NT = KVL / 64, SHMB = 8192, NBUF = 6, LDS_V0 = NBUF * SHMB;
typedef int i32x8 __attribute__((ext_vector_type(8)));
#define SBAR() __builtin_amdgcn_sched_barrier(0)
__device__ __forceinline__ int crow(int r, int hi) { return (r & 3) + 8 * (r >> 2) + 4 * hi; }
__device__ __forceinline__ i32x8 ld32(const LAS unsigned char* p0, const LAS unsigned char* p1) {
    const u32x4 a = *(const LAS u32x4*)p0, b = *(const LAS u32x4*)p1; return (i32x8){(int)a.x, (int)a.y, (int)a.z, (int)a.w, (int)b.x, (int)b.y, (int)b.z, (int)b.w}; }
__device__ __forceinline__ void mfma_qk(f32x16& p, const i32x8& kf, const i32x8& qf, const f32x16& negc) {
    const unsigned s1 = 0x7f7f7f7fu, sq = 0x7b7b7b7bu;
    asm volatile("v_mfma_scale_f32_32x32x64_f8f6f4 %0, %1, %2, %3, %4, %5 op_sel_hi:[0,0,0]" : "=&v"(p) : "v"(kf), "v"(qf), "v"(negc), "v"(s1), "v"(sq));
}
__device__ __forceinline__ void mfma_pv(f32x16& o, const i32x8& pa, const i32x8& vf) {
    const unsigned s1 = 0x7f7f7f7fu;
    asm volatile("v_mfma_scale_f32_32x32x64_f8f6f4 %0, %1, %2, %0, %3, %3 op_sel_hi:[0,0,0]" : "+v"(o) : "v"(pa), "v"(vf), "v"(s1));
}
__device__ __forceinline__ void mfma_wait(f32x16& p0, f32x16& p1) { asm volatile("s_nop 15\n\ts_nop 3" : "+v"(p0), "+v"(p1)); }
__device__ __forceinline__ int grp(const f32x16& s, const int g, int old) {
    old = __builtin_amdgcn_cvt_pk_fp8_f32(__builtin_amdgcn_exp2f(s[4 * g]), __builtin_amdgcn_exp2f(s[4 * g + 1]), old, false);
    return __builtin_amdgcn_cvt_pk_fp8_f32(__builtin_amdgcn_exp2f(s[4 * g + 2]), __builtin_amdgcn_exp2f(s[4 * g + 3]), old, true);
}
__device__ __forceinline__ void attn_unit(const unsigned char* __restrict__ Qb, const unsigned char* __restrict__ Kh, const unsigned char* __restrict__ VTh, bf16_t* MIXo,
                                          const float lam, const float* __restrict__ subg, char* lds, const int wid,
                                          const bool pre, i32x8& qf, const unsigned char* Qn, const unsigned char* Kn, const unsigned char* VTn) {
    const int lane = lane_id(), tid = wid * 64 + lane, r32 = lane & 31, hi = lane >> 5;
    const int sub = wid >> 2, wq = wid & 3;
    const LAS unsigned char* L = (const LAS unsigned char*)(uintptr_t)(unsigned)(uintptr_t)lds;
    f32x16 o[4] = {}; f32x16 ol = {};
    i32x8 ones; { int c1 = 0x38383838; asm volatile("" : "+v"(c1)); ones = (i32x8){c1, c1, c1, c1, c1, c1, c1, c1}; }
    const size_t qoff = (size_t)(wq * 32 + r32) * QKW + sub * 64 + 32 * hi;
    if (!pre) { const unsigned char* qp = Qb + qoff; const u32x4 a = *(const u32x4*)qp, b = *(const u32x4*)(qp + 16);
        qf = (i32x8){(int)a.x, (int)a.y, (int)a.z, (int)a.w, (int)b.x, (int)b.y, (int)b.z, (int)b.w}; }
    f32x16 negc; { float m5 = -5.f; asm volatile("" : "+v"(m5));
#pragma unroll
        for (int r = 0; r < 16; ++r) negc[r] = m5; }
    long ksrc, vsrc;
    { const int r = 8 * wid + (lane >> 3), c = (lane & 7) ^ ((r >> 1) & 7); ksrc = (long)r * QKW + c * 16; }
    { const int d = 16 * wid + (lane >> 2), c = (lane & 3) ^ ((d >> 2) & 3); vsrc = (long)d * 64 + c * 16; }
    const unsigned ldsb = (unsigned)(uintptr_t)lds, kdst = ldsb + (unsigned)wid * 1024u, vdst = ldsb + LDS_V0 + (unsigned)wid * 1024u;
    const LAS unsigned char *pk0, *pk1, *pv0, *pv1;
    { const int c0 = sub * 4 + hi * 2, sk = (r32 >> 1) & 7, sv = (r32 >> 2) & 3;
      pk0 = L + r32 * 128 + ((c0 ^ sk) << 4); pk1 = L + r32 * 128 + (((c0 + 1) ^ sk) << 4);
      pv0 = L + LDS_V0 + r32 * 64 + (((2 * hi) ^ sv) << 4); pv1 = L + LDS_V0 + r32 * 64 + (((2 * hi + 1) ^ sv) << 4); }
#define KF(b, w) ld32(pk0 + (b) * SHMB + (w) * 4096, pk1 + (b) * SHMB + (w) * 4096)
#define VF(b, d0) ld32(pv0 + (b) * SHMB + (d0) * 2048, pv1 + (b) * SHMB + (d0) * 2048)
#define DMA_TILE(t, b) DMA_TILE_P(Kh, VTh, t, b)
#define DMA_TILE_P(KP, VP, t, b) do { \
        __builtin_amdgcn_global_load_lds((const unsigned*)((KP) + (long)(t) * 64 * QKW + ksrc), (LAS unsigned*)(uintptr_t)__builtin_amdgcn_readfirstlane(kdst + (unsigned)((b) * SHMB)), 16, 0, 0); \
        __builtin_amdgcn_global_load_lds((const unsigned*)((VP) + (long)(t) * 8192 + vsrc), (LAS unsigned*)(uintptr_t)__builtin_amdgcn_readfirstlane(vdst + (unsigned)((b) * SHMB)), 16, 0, 0); } while (0)
#define WBAR() do { asm volatile("s_waitcnt vmcnt(0)" ::: "memory"); __builtin_amdgcn_s_barrier(); asm volatile("" ::: "memory"); } while (0)
#define ITER(J, U, SX0, SX1, SY0, SY1, PC, PN, DO_DMA, DO_QK, DO_BAR) do { \
        mfma_pv(ol, PC, ones); SBAR(); \
        if (DO_DMA) { if ((J) + 3 < NT) DMA_TILE((J) + 3, ((U) + 4) % NBUF); if ((J) + 4 < NT) DMA_TILE((J) + 4, ((U) + 5) % NBUF); } \
        PN[0] = grp(SX0, 0, PN[0]); SBAR(); \
        mfma_pv(o[0], PC, vf0); SBAR(); \
        vf3 = VF(U, 3); if (DO_QK) { kf0 = KF(((U) + 2) % NBUF, 0); kf1 = KF(((U) + 2) % NBUF, 1); } \
        PN[1] = grp(SX0, 1, PN[1]); SBAR(); \
        mfma_pv(o[1], PC, vf1); SBAR(); PN[2] = grp(SX0, 2, PN[2]); SBAR(); \
        mfma_pv(o[2], PC, vf2); SBAR(); PN[3] = grp(SX0, 3, PN[3]); SBAR(); \
        mfma_pv(o[3], PC, vf3); SBAR(); PN[4] = grp(SX1, 0, PN[4]); SBAR(); \
        if (DO_QK) mfma_qk(SY0, kf0, qf, negc); SBAR(); PN[5] = grp(SX1, 1, PN[5]); SBAR(); \
        if (DO_QK) mfma_qk(SY1, kf1, qf, negc); SBAR(); PN[6] = grp(SX1, 2, PN[6]); PN[7] = grp(SX1, 3, PN[7]); \
        vf0 = VF(((U) + 1) % NBUF, 0); vf1 = VF(((U) + 1) % NBUF, 1); vf2 = VF(((U) + 1) % NBUF, 2); SBAR(); \
        if (DO_BAR) WBAR(); } while (0)
    f32x16 A0, A1, B0, B1; i32x8 paA = {}, paB = {}, kf0, kf1, vf0, vf1, vf2, vf3;
    if (!pre) { DMA_TILE(0, 0); DMA_TILE(1, 1); DMA_TILE(2, 2); DMA_TILE(3, 3); }
    WBAR();
    kf0 = KF(0, 0); kf1 = KF(0, 1); mfma_qk(A0, kf0, qf, negc); mfma_qk(A1, kf1, qf, negc);
    kf0 = KF(1, 0); kf1 = KF(1, 1); SBAR(); mfma_qk(B0, kf0, qf, negc); mfma_qk(B1, kf1, qf, negc);
    mfma_wait(A0, A1);
#pragma unroll
    for (int g = 0; g < 4; ++g) { paA[g] = grp(A0, g, paA[g]); paA[4 + g] = grp(A1, g, paA[4 + g]); }
    mfma_wait(B0, B1);
    vf0 = VF(0, 0); vf1 = VF(0, 1); vf2 = VF(0, 2); SBAR();
    static_assert(NT == 68, "the loop below (11 trips of 6 iterations, then iteration 67) is written for 68 KV tiles");
#pragma unroll 1
    for (int j = 1; j < NT - 2; j += 6) {
        ITER(j, 0, B0, B1, A0, A1, paA, paB, true, true, false);
        ITER(j + 1, 1, A0, A1, B0, B1, paB, paA, false, true, true);
        ITER(j + 2, 2, B0, B1, A0, A1, paA, paB, true, true, false);
        ITER(j + 3, 3, A0, A1, B0, B1, paB, paA, false, true, true);
        ITER(j + 4, 4, B0, B1, A0, A1, paA, paB, true, true, false);
        ITER(j + 5, 5, A0, A1, B0, B1, paB, paA, false, true, true);
    }
    ITER(67, 0, B0, B1, A0, A1, paA, paB, false, false, false);
    mfma_pv(ol, paB, ones); vf3 = VF(1, 3); SBAR();
    mfma_pv(o[0], paB, vf0); mfma_pv(o[1], paB, vf1); mfma_pv(o[2], paB, vf2); mfma_pv(o[3], paB, vf3);
    asm volatile("s_nop 15\n\ts_nop 3" : "+v"(o[0]), "+v"(o[1]), "+v"(o[2]), "+v"(o[3]), "+v"(ol));
#undef ITER
#undef KF
#undef VF
    float sg[4];
#pragma unroll
    for (int d0 = 0; d0 < 4; ++d0) sg[d0] = subg[d0 * 32 + r32] * (1.f - LAM_INIT);
    __syncthreads();
    if (Qn != nullptr) { const unsigned char* qp = Qn + qoff; const u32x4 a = *(const u32x4*)qp, b = *(const u32x4*)(qp + 16);
        qf = (i32x8){(int)a.x, (int)a.y, (int)a.z, (int)a.w, (int)b.x, (int)b.y, (int)b.z, (int)b.w};
        DMA_TILE_P(Kn, VTn, 0, 0); DMA_TILE_P(Kn, VTn, 1, 1); DMA_TILE_P(Kn, VTn, 2, 2); DMA_TILE_P(Kn, VTn, 3, 3); }
#define XOFF(q) ((q) == 0 ? 4 * SHMB : (q) == 1 ? LDS_V0 + 4 * SHMB : LDS_V0 + NBUF * SHMB + ((q) - 2) * 16384)
    float* X = (float*)(lds + XOFF(wq));
    float rli[16];
#pragma unroll
    for (int r = 0; r < 16; ++r) rli[r] = __builtin_amdgcn_rcpf(ol[r]);
    if (sub == 1) {
#pragma unroll
        for (int r = 0; r < 16; ++r) { const int row = crow(r, hi); const float sc = lam * rli[r];
#pragma unroll
            for (int d0 = 0; d0 < 4; ++d0) X[row * 128 + d0 * 32 + r32] = o[d0][r] * sc; }
    }
    __syncthreads();
    if (sub == 0) {
        bf16_t* Y = (bf16_t*)X;
#pragma unroll
        for (int r = 0; r < 16; ++r) { const int row = crow(r, hi);
            float v[4]; float ss = 0.f;
#pragma unroll
            for (int d0 = 0; d0 < 4; ++d0) { v[d0] = o[d0][r] * rli[r] - X[row * 128 + d0 * 32 + r32]; ss += v[d0] * v[d0]; }
            ss = row_sum16(ss); ss += __shfl_xor(ss, 16);
            const float rstd = rsqrtf(ss * (1.f / 128.f) + EPS);
            asm volatile("" ::: "memory");
#pragma unroll
            for (int d0 = 0; d0 < 4; ++d0) Y[row * 256 + d0 * 32 + r32] = (bf16_t)(cvt_pk_bf16(v[d0] * rstd * sg[d0], 0.f) & 0xffffu); }
    }
    __syncthreads();
    { const int row = tid >> 2, seg = (tid & 3) * 32, qr = row >> 5; const bf16_t* Yr = (const bf16_t*)(lds + XOFF(qr)) + (row & 31) * 256 + seg;
#pragma unroll
        for (int i = 0; i < 4; ++i) { const u32x4 v = *(const u32x4*)(Yr + i * 8); *(u32x4*)(MIXo + (size_t)row * DM + seg + i * 8) = v; } }
    __syncthreads();
#undef XOFF
#undef DMA_TILE
#undef DMA_TILE_P
#undef WBAR
}
#undef SBAR
}

__device__ __forceinline__ void p3_attention8(Frame& F, int slot) {
    FT_DECL;
    const float* sc = WSP(float, WS_SMALL + SM_SCAL);
    const float lam = sc[0];
    const unsigned char* Q8 = WSP(unsigned char, WS_Q); const unsigned char* K8 = WSP(unsigned char, WS_K); const unsigned char* VT8 = WSP(unsigned char, WS_V); bf16_t* MIX = WSP(bf16_t, WS_MIX);
    const int c = blockIdx.x, xcd = c & 7, ci = c >> 3, per = F.G >> 3;
    att8::i32x8 qf = {}; bool pre = false; int ua = 0;
    for (int j = ci; j < 128; j += per, ++ua) {
        if (ua == slot) { p2_convert_chunk(F, (int)blockIdx.x, F.G, CV_SPLIT, CV_NIT); pre = false; qf = att8::i32x8{}; }
        const int pair = xcd * 4 + (j >> 5), qb = j & 31, b = pair >> 2, h = pair & 3;
        const int jn = j + per; const bool hn = (jn < 128) && (ua + 1 != slot); const int pairn = xcd * 4 + (jn >> 5), qbn = jn & 31, bn = pairn >> 2, hn4 = pairn & 3;
        att8::attn_unit(Q8 + ((size_t)b * SEQ + qb * 128) * QKW + h * 128, K8 + (size_t)b * KVL * QKW + h * 128, VT8 + (size_t)(b * NHEAD + h) * 68 * 8192,
                        MIX + ((size_t)b * SEQ + qb * 128) * DM + h * 128, lam, F.in[15], (char*)F.lds, F.wave, pre, qf,
                        hn ? Q8 + ((size_t)bn * SEQ + qbn * 128) * QKW + hn4 * 128 : nullptr, hn ? K8 + (size_t)bn * KVL * QKW + hn4 * 128 : nullptr,
                        hn ? VT8 + (size_t)(bn * NHEAD + hn4) * 68 * 8192 : nullptr);
        pre = hn;
    }
    if (slot >= ua) p2_convert_chunk(F, (int)blockIdx.x, F.G, CV_SPLIT, CV_NIT);
}

namespace hy {
constexpr int RB_BYTES = 4352 * 8, IN_OFF = 2 * RB_BYTES, TW1_OFF = IN_OFF + 32768, TW2_OFF = TW1_OFF + 15 * 256 * 8, LDS_END = TW2_OFF + 15 * 16 * 8;
__device__ __forceinline__ f32x2 cmul(f32x2 a, f32x2 b) {
    const f32x2 ax = __builtin_shufflevector(a, a, 0, 0), ay = __builtin_shufflevector(a, a, 1, 1), byx = __builtin_shufflevector(b, b, 1, 0);
    return __builtin_elementwise_fma(ay * byx, (f32x2){-1.f, 1.f}, ax * b); }
__device__ __forceinline__ f32x2 cmulc(f32x2 a, f32x2 b) {
    const f32x2 bx = __builtin_shufflevector(b, b, 0, 0), by = __builtin_shufflevector(b, b, 1, 1), ayx = __builtin_shufflevector(a, a, 1, 0);
    return __builtin_elementwise_fma(ayx * by, (f32x2){1.f, -1.f}, a * bx); }
__device__ __forceinline__ int P(int i) { return i + (i >> 4); }
#define HY_CMUL3(dst, A, B) do { f32x2 t_[3], u_[3]; \
        _Pragma("unroll") for (int i_ = 0; i_ < 3; ++i_) { const f32x2 a_ = (A), b_ = (B); t_[i_] = __builtin_shufflevector(a_, a_, 0, 0) * b_; u_[i_] = __builtin_shufflevector(a_, a_, 1, 1) * __builtin_shufflevector(b_, b_, 1, 0); } \
        __builtin_amdgcn_sched_barrier(0); \
        _Pragma("unroll") for (int i_ = 0; i_ < 3; ++i_) dst = __builtin_elementwise_fma(u_[i_], (f32x2){-1.f, 1.f}, t_[i_]); } while (0)
#define HY_CMULC3(dst, A, B) do { f32x2 t_[3], u_[3]; \
        _Pragma("unroll") for (int i_ = 0; i_ < 3; ++i_) { const f32x2 a_ = (A), b_ = (B); t_[i_] = a_ * __builtin_shufflevector(b_, b_, 0, 0); u_[i_] = __builtin_shufflevector(a_, a_, 1, 0) * __builtin_shufflevector(b_, b_, 1, 1); } \
        __builtin_amdgcn_sched_barrier(0); \
        _Pragma("unroll") for (int i_ = 0; i_ < 3; ++i_) dst = __builtin_elementwise_fma(u_[i_], (f32x2){1.f, -1.f}, t_[i_]); } while (0)
template <bool INV> __device__ __forceinline__ void r4(f32x2& a, f32x2& b, f32x2& c, f32x2& d) {
    const f32x2 t0 = a + c, t1 = a - c, t2 = b + d, t3 = b - d;
    const f32x2 sw = __builtin_shufflevector(t3, t3, 1, 0);
    const f32x2 sg = INV ? (f32x2){-1.f, 1.f} : (f32x2){1.f, -1.f};
    a = t0 + t2; c = t0 - t2; b = __builtin_elementwise_fma(sw, sg, t1); d = __builtin_elementwise_fma(sw, -sg, t1);
}
template <bool INV> __device__ __forceinline__ f32x2 tw(f32x2 v, float c, float s) {
    const f32x2 sw = __builtin_shufflevector(v, v, 1, 0);
    return __builtin_elementwise_fma(sw, INV ? (f32x2){-s, s} : (f32x2){s, -s}, v * (f32x2){c, c});
}
template <bool INV> __device__ __forceinline__ void dft16(f32x2 (&v)[16]) {
    constexpr float C1 = 0.9238795325112867f, S1 = 0.3826834323650898f, R2 = 0.7071067811865476f;
    r4<INV>(v[0], v[4], v[8], v[12]); r4<INV>(v[1], v[5], v[9], v[13]); r4<INV>(v[2], v[6], v[10], v[14]); r4<INV>(v[3], v[7], v[11], v[15]);
    {
        constexpr int IX[9] = {5, 9, 13, 6, 10, 14, 7, 11, 15};
        constexpr float CC[9] = {C1, R2, S1, R2, 0.f, -R2, S1, -R2, -C1}, SS[9] = {S1, R2, C1, R2, 1.f, R2, C1, R2, -S1};
        f32x2 m_[9];
#pragma unroll
        for (int i = 0; i < 9; ++i) m_[i] = v[IX[i]] * (f32x2){CC[i], CC[i]};
        __builtin_amdgcn_sched_barrier(0);
#pragma unroll
        for (int i = 0; i < 9; ++i) { const f32x2 sw = __builtin_shufflevector(v[IX[i]], v[IX[i]], 1, 0);
            v[IX[i]] = __builtin_elementwise_fma(sw, INV ? (f32x2){-SS[i], SS[i]} : (f32x2){SS[i], -SS[i]}, m_[i]); }
    }
    r4<INV>(v[0], v[1], v[2], v[3]); r4<INV>(v[4], v[5], v[6], v[7]); r4<INV>(v[8], v[9], v[10], v[11]); r4<INV>(v[12], v[13], v[14], v[15]);
    f32x2 t;
    t = v[1]; v[1] = v[4]; v[4] = t;   t = v[2]; v[2] = v[8]; v[8] = t;    t = v[3]; v[3] = v[12]; v[12] = t;
    t = v[6]; v[6] = v[9]; v[9] = t;   t = v[7]; v[7] = v[13]; v[13] = t;  t = v[11]; v[11] = v[14]; v[14] = t;
}
struct Ctx { LAS f32x2* R; LAS f32x2* IN; LAS f32x2* TW1; LAS f32x2* TW2; int t, half; f32x2 wt; };
#define HY_OPAQUE(x) asm volatile("" : "+v"(x))
#define HY_W32(m) (f32x2){__builtin_cosf(-0.19634954084936207f * (m)), __builtin_sinf(-0.19634954084936207f * (m))}
template <int MODE> __device__ __forceinline__ void pass1_fwd(const Ctx& X) {
    f32x2 v[16]; int t = X.t; HY_OPAQUE(t);
#pragma unroll
    for (int m = 0; m < 16; ++m) { f32x2 a = X.IN[t + 256 * m]; if (MODE == 1) a = (f32x2){X.half ? a.y : a.x, 0.f}; v[m] = a; }
    if (X.half) {
#pragma unroll
        for (int m = 0; m < 16; ++m) v[m] = cmul(cmul(v[m], HY_W32(m)), X.wt);
    }
    dft16<false>(v);
#pragma unroll
    for (int q0 = 1; q0 < 16; q0 += 3) HY_CMUL3(v[q0 + i_], v[q0 + i_], X.TW1[(q0 + i_ - 1) * 256 + t]);
    const int pb = t + (t >> 4);
#pragma unroll
    for (int q = 0; q < 16; ++q) X.R[pb + 272 * q] = v[q];
}
__device__ __forceinline__ void pass2_fwd(const Ctx& X) {
    int t = X.t; HY_OPAQUE(t);
    const int n2 = t & 15, pb = (t >> 4) * 272 + n2; f32x2 v[16];
#pragma unroll
    for (int m = 0; m < 16; ++m) v[m] = X.R[pb + 17 * m];
    dft16<false>(v);
#pragma unroll
    for (int q0 = 1; q0 < 16; q0 += 3) HY_CMUL3(v[q0 + i_], v[q0 + i_], X.TW2[(q0 + i_ - 1) * 16 + n2]);
#pragma unroll
    for (int q = 0; q < 16; ++q) X.R[pb + 17 * q] = v[q];
}
template <bool FILTER> __device__ __forceinline__ void pass3(const Ctx& X, f32x2 (&H)[16]) {
    f32x2 v[16]; int t = X.t; HY_OPAQUE(t); const int pb = 17 * t;
#pragma unroll
    for (int m = 0; m < 16; ++m) v[m] = X.R[pb + m];
    dft16<false>(v);
    if (FILTER) {
#pragma unroll
        for (int q = 0; q < 16; ++q) H[q] = v[q] * (1.f / 8192.f);
    } else {
#pragma unroll
        for (int q = 0; q < 16; ++q) v[q] = cmul(v[q], H[q]);
        dft16<true>(v);
#pragma unroll
        for (int m = 0; m < 16; ++m) X.R[pb + m] = v[m];
    }
}
__device__ __forceinline__ void pass2_inv(const Ctx& X) {
    int t = X.t; HY_OPAQUE(t);
    const int n2 = t & 15, pb = (t >> 4) * 272 + n2; f32x2 v[16];
    v[0] = X.R[pb];
#pragma unroll
    for (int q0 = 1; q0 < 16; q0 += 3) HY_CMULC3(v[q0 + i_], X.R[pb + 17 * (q0 + i_)], X.TW2[(q0 + i_ - 1) * 16 + n2]);
    dft16<true>(v);
#pragma unroll
    for (int m = 0; m < 16; ++m) X.R[pb + 17 * m] = v[m];
}
__device__ __forceinline__ void pass1_inv(const Ctx& X) {
    f32x2 v[16]; int t = X.t; HY_OPAQUE(t); const int pb = t + (t >> 4);
    v[0] = X.R[pb];
#pragma unroll
    for (int q0 = 1; q0 < 16; q0 += 3) HY_CMULC3(v[q0 + i_], X.R[pb + 272 * (q0 + i_)], X.TW1[(q0 + i_ - 1) * 256 + t]);
    dft16<true>(v);
    if (X.half) {
#pragma unroll
        for (int m = 0; m < 16; ++m) v[m] = cmulc(cmulc(v[m], HY_W32(m)), X.wt);
    }
#pragma unroll
    for (int m = 0; m < 16; ++m) X.R[pb + 272 * m] = v[m];
}
#define HY_WSYNC() asm volatile("s_waitcnt lgkmcnt(0)" ::: "memory")
__device__ __forceinline__ void conv_fft(const Ctx& X, f32x2 (&H)[16]) {
    __syncthreads(); pass1_fwd<0>(X); __syncthreads(); pass2_fwd(X); HY_WSYNC(); pass3<false>(X, H); HY_WSYNC(); pass2_inv(X); __syncthreads(); pass1_inv(X); __syncthreads();
}
constexpr int STG_OFF = LDS_END;
constexpr int SPITCH = SEQ + 8;
constexpr int LDS_END2 = STG_OFF + (8 + 2 * SPITCH) * 2;
static_assert(LDS_END2 <= LDSCTL_OFF, "hyena LDS map");
__device__ __forceinline__ float sconv_lds(const LAS bf16_t* stg, int bs, int n, float w0, float w1, float w2, float bias) {
    const volatile LAS bf16_t* p = stg + bs * SPITCH;
    const bf16_t l = p[n - 1], c = p[n], r = p[n + 1];
    return bias + w0 * bf2f(l) + w1 * bf2f(c) + w2 * bf2f(r);
}
__device__ __forceinline__ void setup_tables(LAS unsigned char* lds, int tid) {
    LAS f32x2* TW1 = (LAS f32x2*)(lds + TW1_OFF); LAS f32x2* TW2 = (LAS f32x2*)(lds + TW2_OFF);
    for (int i = tid; i < 15 * 256; i += 512) { const int q = i / 256 + 1, t = i & 255; float s, c; sincosf(-6.283185307179586f * (float)((t * q) & 4095) * (1.f / 4096.f), &s, &c); TW1[i] = (f32x2){c, s}; }
    for (int i = tid; i < 15 * 16; i += 512) { const int q = i / 16 + 1, n2 = i & 15; float s, c; sincosf(-6.283185307179586f * (float)((n2 * q) & 255) * (1.f / 256.f), &s, &c); TW2[i] = (f32x2){c, s}; }
}
__device__ __forceinline__ void unit(Frame& F, int c) {
    FT_DECL;
    const int tid = f_tid; Ctx X; X.half = F.wave >> 2; X.t = tid & 255;
    X.R = (LAS f32x2*)(F.lds + X.half * RB_BYTES); X.IN = (LAS f32x2*)(F.lds + IN_OFF); X.TW1 = (LAS f32x2*)(F.lds + TW1_OFF); X.TW2 = (LAS f32x2*)(F.lds + TW2_OFF);
    { float s, cc; sincosf(-6.283185307179586f * (float)X.t * (1.f / 8192.f), &s, &cc); X.wt = (f32x2){cc, s}; }
    LAS f32x2* RB0 = (LAS f32x2*)(F.lds); LAS f32x2* RB1 = (LAS f32x2*)(F.lds + RB_BYTES);
    const float* FILT = WSP(float, WS_FILT);
    f32x2 H0[16], H1[16];
#pragma unroll
    for (int ord = 0; ord < 2; ++ord) {
        const float* hf = FILT + ((size_t)(ord * 2 + 0) * 512 + c) * SEQ; const float* hb = FILT + ((size_t)(ord * 2 + 1) * 512 + c) * SEQ;
        __syncthreads();
        int nb = tid; HY_OPAQUE(nb);
#pragma unroll
        for (int j = 0; j < 8; ++j) { const int n = nb + 512 * j; const float a = hf[n], b = hb[(SEQ - n) & (SEQ - 1)]; const float lo = (n == 0) ? a + b : a, hi = (n == 0) ? 0.f : b; X.IN[n] = (f32x2){lo + hi, lo - hi}; }
        __syncthreads(); pass1_fwd<1>(X); __syncthreads(); pass2_fwd(X); HY_WSYNC();
        if (ord == 0) pass3<true>(X, H0); else pass3<true>(X, H1);
    }
    const bf16_t* UT = WSP(bf16_t, WS_UT);
    const bf16_t* rv = UT + (size_t)c * 128; const bf16_t* r1 = UT + (size_t)(512 + c) * 128; const bf16_t* r2 = UT + (size_t)(1024 + c) * 128;
#define HY_LD(rowp, t) (*(const u32x4*)((rowp) + (size_t)((t) >> 7) * (HYC * 128) + ((t) & 127)))
    const float* cw = F.in[16]; const float* cb = F.in[17];
    const float wv0 = cw[c], wv1 = cw[HYC + c], wv2 = cw[2 * HYC + c], bv = cb[c];
    const float wa0 = cw[512 + c], wa1 = cw[HYC + 512 + c], wa2 = cw[2 * HYC + 512 + c], ba = cb[512 + c];
    const float wb0 = cw[1024 + c], wb1 = cw[HYC + 1024 + c], wb2 = cw[2 * HYC + 1024 + c], bb = cb[1024 + c];
    const float sk0 = F.in[25][c], sk1 = F.in[25][512 + c];
    bf16_t* Z = WSP(bf16_t, WS_Z2T) + (size_t)c * 128;
    LAS bf16_t* STG = (LAS bf16_t*)(F.lds + STG_OFF) + 8;
    if (tid < 4) STG[(tid >> 1) * SPITCH + ((tid & 1) ? SEQ : -1)] = (bf16_t)0;
    u32x4 g0 = HY_LD(rv, tid * 8), g1 = HY_LD(rv, SEQ + tid * 8);
    for (int pr = 0; pr < 4; ++pr) {
        const int b0 = 2 * pr, b1 = b0 + 1;
        f32x2 z[8]; int pc = tid + (tid >> 4); HY_OPAQUE(pc); int nb = tid; HY_OPAQUE(nb);
        __syncthreads();
        *(LAS u32x4*)(STG + tid * 8) = g0; *(LAS u32x4*)(STG + SPITCH + tid * 8) = g1;
        __syncthreads();
#pragma unroll
        for (int j = 0; j < 8; ++j) { const int n = nb + 512 * j; z[j] = (f32x2){sconv_lds(STG, 0, n, wv0, wv1, wv2, bv), sconv_lds(STG, 1, n, wv0, wv1, wv2, bv)}; X.IN[n] = z[j]; }
        g0 = HY_LD(r1, b0 * SEQ + tid * 8); g1 = HY_LD(r1, b1 * SEQ + tid * 8);
        conv_fft(X, H0);
        *(LAS u32x4*)(STG + tid * 8) = g0; *(LAS u32x4*)(STG + SPITCH + tid * 8) = g1;
        __syncthreads();
        HY_OPAQUE(nb); HY_OPAQUE(pc);
#pragma unroll
        for (int j = 0; j < 8; ++j) { const int n = nb + 512 * j; const f32x2 y = RB0[pc + 544 * j] + RB1[pc + 544 * j];
            const f32x2 g = (f32x2){sconv_lds(STG, 0, n, wa0, wa1, wa2, ba), sconv_lds(STG, 1, n, wa0, wa1, wa2, ba)};
            z[j] = g * (y + sk0 * z[j]); X.IN[n] = z[j]; }
        g0 = HY_LD(r2, b0 * SEQ + tid * 8); g1 = HY_LD(r2, b1 * SEQ + tid * 8);
        conv_fft(X, H1);
        *(LAS u32x4*)(STG + tid * 8) = g0; *(LAS u32x4*)(STG + SPITCH + tid * 8) = g1;
        __syncthreads();
        if (pr < 3) { g0 = HY_LD(rv, (b0 + 2) * SEQ + tid * 8); g1 = HY_LD(rv, (b1 + 2) * SEQ + tid * 8); }
        HY_OPAQUE(nb); HY_OPAQUE(pc);
        f32x2 o[8];
#pragma unroll
        for (int j = 0; j < 8; ++j) { const int n = nb + 512 * j; const f32x2 y = RB0[pc + 544 * j] + RB1[pc + 544 * j];
            const f32x2 g = (f32x2){sconv_lds(STG, 0, n, wb0, wb1, wb2, bb), sconv_lds(STG, 1, n, wb0, wb1, wb2, bb)};
            o[j] = g * (y + sk1 * z[j]); }
        __syncthreads();
#pragma unroll
        for (int j = 0; j < 8; ++j) { const int n = nb + 512 * j; STG[n] = (bf16_t)(cvt_pk_bf16(o[j].x, 0.f) & 0xffffu); STG[SPITCH + n] = (bf16_t)(cvt_pk_bf16(o[j].y, 0.f) & 0xffffu); }
        __syncthreads();
        { const int t0 = b0 * SEQ + tid * 8, t1 = b1 * SEQ + tid * 8;
          *(u32x4*)(Z + (size_t)(t0 >> 7) * (HYW * 128) + (t0 & 127)) = *(const LAS u32x4*)(STG + tid * 8); *(u32x4*)(Z + (size_t)(t1 >> 7) * (HYW * 128) + (t1 & 127)) = *(const LAS u32x4*)(STG + SPITCH + tid * 8); }
    }
    __syncthreads();
}
}

__device__ __forceinline__ void p3_hyena(Frame& F) {
    FT_DECL;
    __syncthreads();
    hy::setup_tables(F.lds, f_tid);
    __syncthreads();
    for (int c = F.vcu; c < HYW; c += F.G) hy::unit(F, c);
}

__device__ __forceinline__ void p4_hynorm(Frame& F) {
    FT_DECL;
    const bf16_t* Z = WSP(bf16_t, WS_Z2T); bf16_t* MIX = WSP(bf16_t, WS_MIX); const float* g = F.in[26];
    constexpr int TP = 132;
    LAS bf16_t* T = (LAS bf16_t*)F.lds;
    LAS float* red = (LAS float*)(F.lds + 512 * TP * 2);
    LAS float* rs = red + 512;
    float gl[8];
#pragma unroll
    for (int e = 0; e < 8; ++e) gl[e] = g[(f_tid & 63) + 64 * e];
    for (int it = F.vcu; it < MROWS / 128; it += F.G) {
        const int tok0 = it * 128; const bf16_t* zt = Z + (size_t)it * (HYW * 128);
        __syncthreads();
        u32x4 v[16];
#pragma unroll
        for (int j = 0; j < 16; ++j) v[j] = __builtin_nontemporal_load((const u32x4*)(zt + (size_t)(f_tid + 512 * j) * 8));
#pragma unroll
        for (int j = 0; j < 16; ++j) { const int i = f_tid + 512 * j; LAS u32x2* d = (LAS u32x2*)(T + (i >> 4) * TP + (i & 15) * 8); d[0] = (u32x2){v[j].x, v[j].y}; d[1] = (u32x2){v[j].z, v[j].w}; }
        __syncthreads();
        { const int tok = f_tid & 127, grp = f_tid >> 7; float ss = 0.f;
#pragma unroll 8
            for (int k = 0; k < 128; ++k) { const float x = bf2f(T[(grp * 128 + k) * TP + tok]); ss += x * x; }
            red[grp * 128 + tok] = ss; }
        __syncthreads();
        if (f_tid < 128) rs[f_tid] = rsqrtf(((red[f_tid] + red[128 + f_tid]) + (red[256 + f_tid] + red[384 + f_tid])) * (1.f / HYW) + EPS);
        __syncthreads();
#pragma unroll
        for (int j = 0; j < 16; ++j) { const int i = f_tid + 512 * j, tok = i >> 6, l = i & 63; const float r = rs[tok];
            float x[8];
#pragma unroll
            for (int e = 0; e < 8; ++e) x[e] = bf2f(T[(l + 64 * e) * TP + tok]) * r * gl[e];
            u32x4 w; w.x = cvt_pk_bf16(x[0], x[1]); w.y = cvt_pk_bf16(x[2], x[3]); w.z = cvt_pk_bf16(x[4], x[5]); w.w = cvt_pk_bf16(x[6], x[7]);
            *(u32x4*)(MIX + (size_t)(tok0 + tok) * DM + 512 + 8 * l) = w; }
    }
}

constexpr size_t WS_LIST2 = WS_FILT;
constexpr size_t WS_GSLOT2 = WS_FILT + 4 * MiB;
constexpr int CW_ECNT = 256;
constexpr int MAXSLOT = MROWS * TOPK + NEXP * 256;
constexpr int MAXTILE = MAXSLOT / 256;
constexpr size_t WS_XS = WS_EO;
constexpr int P6_WT_PITCH = 2 * DM + 16;
constexpr int P6_LDS_TOPI = 2 * NEXP * P6_WT_PITCH;

__device__ __forceinline__ void p6_router_mfma(Frame& F, bool flagged) {
    FT_DECL;
#define in F.in
    LAS float* WP = (LAS float*)F.lds;
    LAS int* TI = (LAS int*)(F.lds + P6_LDS_TOPI);
    LAS int* PS = TI + 512;
    LAS int* SC = PS + 512;
    LAS float* RSTD = (LAS float*)(SC + 512);
    LAS float* BIAS = RSTD + 128;
    LAS float* SSX = BIAS + 32;
    const float* rw = in[28]; const float* mod = WSP(float, WS_SMALL + SM_MOD); const float* g2n = in[7]; const float* rb = in[29];
    const bf16_t* XN = WSP(bf16_t, WS_XN); unsigned char* H2 = WSP(unsigned char, WS_H);
    int* list2 = WSP(int, WS_LIST2); float* gslot2 = WSP(float, WS_GSLOT2); int* ecnt = (int*)(F.ctl + CW_ECNT);
    LAS float* GT = SSX + 256;
    LAS int* EB = (LAS int*)(GT + 512);
    LAS float* GM = (LAS float*)(EB + 32);
    static_assert(P6_LDS_TOPI + (512 * 3 + 128 + 32 + 256 + 512 + 32 + 1024) * 4 <= LDSCTL_OFF, "router LDS map");
    for (int blk = F.vcu; blk < MROWS / 128; blk += F.G) {
        const float* sh2 = mod + (size_t)(blk >> 5) * (NMOD * DM) + 3 * DM; const float* sc2 = sh2 + DM;
        __syncthreads();
        for (int i = f_tid; i < DM; i += 512) GM[i] = g2n[i] * (1.f + sc2[i]);
        if (f_tid < 32) BIAS[f_tid] = WSP(float, WS_SMALL + SM_RBIAS)[(blk >> 5) * 32 + f_tid];
        __syncthreads();
        { const int e = f_lane & 31, h8 = (f_lane >> 5) * 8; LAS unsigned char* WT = (LAS unsigned char*)F.lds;
#pragma unroll 1
            for (int it0 = 0; it0 < 8; it0 += 4) { float w[4][8];
#pragma unroll
                for (int u = 0; u < 4; ++u) { const int k0 = ((it0 + u) * NWAVES + F.wave) * 16 + h8;
#pragma unroll
                    for (int q = 0; q < 8; ++q) w[u][q] = rw[(size_t)(k0 + q) * 32 + e]; }
#pragma unroll
                for (int u = 0; u < 4; ++u) { const int k0 = ((it0 + u) * NWAVES + F.wave) * 16 + h8;
                    const f32x4 ga = *(const LAS f32x4*)(GM + k0), gb = *(const LAS f32x4*)(GM + k0 + 4); const float g[8] = {ga.x, ga.y, ga.z, ga.w, gb.x, gb.y, gb.z, gb.w};
                    unsigned ph[4], pl[4];
#pragma unroll
                    for (int q = 0; q < 4; ++q) { const float v0 = w[u][2 * q] * g[2 * q], v1 = w[u][2 * q + 1] * g[2 * q + 1]; ph[q] = cvt_pk_bf16(v0, v1);
                        pl[q] = cvt_pk_bf16(v0 - __uint_as_float(ph[q] << 16), v1 - __uint_as_float(ph[q] & 0xffff0000u)); }
                    *(LAS u32x4*)(WT + e * P6_WT_PITCH + k0 * 2) = (u32x4){ph[0], ph[1], ph[2], ph[3]};
                    *(LAS u32x4*)(WT + NEXP * P6_WT_PITCH + e * P6_WT_PITCH + k0 * 2) = (u32x4){pl[0], pl[1], pl[2], pl[3]}; } } }
        if (flagged && f_tid == 0) { unsigned* bar = (unsigned*)(F.ctl + CW_BAR); XB_SPIN(xb_ld((unsigned*)(F.ctl + CW_MT + (blk >> 1))) < 4u, bar);
            const unsigned me = xb_xcc_id() + 1u; bool same = (F.G == 256); const int pm = blk >> 1;
#pragma unroll
            for (int pn = 0; pn < 4; ++pn) { const int wgid = (pm >> 3) * 32 + pn * 8 + (pm & 7), L = (wgid & 63) * 8 + (wgid >> 6); same = same && (xb_ld((unsigned*)(F.ctl + CW_XCC + (L & 255))) == me); }
            if (!same) __builtin_amdgcn_fence(__ATOMIC_ACQUIRE, "agent");
            asm volatile("s_waitcnt vmcnt(0)" ::: "memory"); }
        __syncthreads();
        const int rg = F.wave & 3, kh = F.wave >> 2, j = f_lane & 31, hi = f_lane >> 5;
        f32x16 acc = {};
        float ss = 0.f;
        { const bf16_t* xrow = XN + (size_t)(blk * 128 + rg * 32 + j) * DM + 512 * kh + 8 * hi;
            const LAS unsigned char* wth = (const LAS unsigned char*)F.lds + j * P6_WT_PITCH + (512 * kh + 8 * hi) * 2;
#pragma unroll 16
            for (int c = 0; c < 32; ++c) { const u32x4 xb = *(const u32x4*)(xrow + 16 * c);
                const float xf[8] = {__uint_as_float(xb.x << 16), __uint_as_float(xb.x & 0xffff0000u), __uint_as_float(xb.y << 16), __uint_as_float(xb.y & 0xffff0000u),
                                     __uint_as_float(xb.z << 16), __uint_as_float(xb.z & 0xffff0000u), __uint_as_float(xb.w << 16), __uint_as_float(xb.w & 0xffff0000u)};
#pragma unroll
                for (int q = 0; q < 8; ++q) ss += xf[q] * xf[q];
                const bf16x8 xv = __builtin_bit_cast(bf16x8, xb);
                const bf16x8 ah = *(const LAS bf16x8*)(wth + 32 * c), al = *(const LAS bf16x8*)(wth + NEXP * P6_WT_PITCH + 32 * c);
                acc = __builtin_amdgcn_mfma_f32_32x32x16_bf16(ah, xv, acc, 0, 0, 0);
                acc = __builtin_amdgcn_mfma_f32_32x32x16_bf16(al, xv, acc, 0, 0, 0); } }
        { auto rr = __builtin_amdgcn_permlane32_swap(__float_as_uint(ss), __float_as_uint(ss), false, false); ss = __uint_as_float(rr[0]) + __uint_as_float(rr[1]); }
        if (hi == 0) SSX[kh * 128 + rg * 32 + j] = ss;
        __syncthreads();
        if (kh == 1) {
#pragma unroll
            for (int r = 0; r < 16; ++r) WP[(rg * 16 + r) * 64 + f_lane] = acc[r]; }
        if (f_tid < 128) RSTD[f_tid] = rsqrtf((SSX[f_tid] + SSX[128 + f_tid]) * (1.f / DM) + EPS);
        __syncthreads();
        if (kh == 0) {
            const float rstd = RSTD[rg * 32 + j];
            float tv[4] = {-INFINITY, -INFINITY, -INFINITY, -INFINITY}; int ti[4] = {1 << 20, 1 << 20, 1 << 20, 1 << 20};
#define P6_INS(V, E) do { float cv = (V); int ce = (E); _Pragma("unroll") for (int q = 0; q < 4; ++q) { const bool b = cv > tv[q] || (cv == tv[q] && ce < ti[q]); \
                const float nv = b ? tv[q] : cv; const int ne = b ? ti[q] : ce; tv[q] = b ? cv : tv[q]; ti[q] = b ? ce : ti[q]; cv = nv; ce = ne; } } while (0)
#pragma unroll
            for (int r = 0; r < 16; ++r) { const int e = (r & 3) + 8 * (r >> 2) + 4 * hi; const float v = (acc[r] + WP[(rg * 16 + r) * 64 + f_lane]) * rstd + BIAS[e]; P6_INS(v, e); }
            float ov[4]; int oe[4];
#pragma unroll
            for (int q = 0; q < 4; ++q) { ov[q] = __shfl_xor(tv[q], 32); oe[q] = __shfl_xor(ti[q], 32); }
#pragma unroll
            for (int q = 0; q < 4; ++q) P6_INS(ov[q], oe[q]);
#undef P6_INS
            if (hi == 0) { const int rl = rg * 32 + j;
                const float e1 = __expf(tv[1] - tv[0]), e2 = __expf(tv[2] - tv[0]), e3 = __expf(tv[3] - tv[0]); const float inv = 1.f / (1.f + e1 + e2 + e3);
                typedef int i32x4_t __attribute__((ext_vector_type(4))); const i32x4_t t4 = {ti[0], ti[1], ti[2], ti[3]};
                *(LAS f32x4*)(GT + rl * 4) = (f32x4){inv, e1 * inv, e2 * inv, e3 * inv};
                *(LAS i32x4_t*)(TI + rl * 4) = t4; }
        }
        __syncthreads();
        { const int t2 = F.wave * 64 + lane_id(); const int e = t2 & 31, seg = t2 >> 5; int cnt = 0;
#pragma unroll 4
            for (int i = 0; i < 32; ++i) cnt += (TI[seg * 32 + i] == e) ? 1 : 0;
            SC[seg * 32 + e] = cnt;
            __syncthreads();
            int pre = 0;
            for (int s2 = 0; s2 < seg; ++s2) pre += SC[s2 * 32 + e];
            if (seg == 15) EB[e] = __hip_atomic_fetch_add(ecnt + e, pre + cnt, __ATOMIC_RELAXED, __HIP_MEMORY_SCOPE_AGENT);
            for (int i = 0; i < 32; ++i) if (TI[seg * 32 + i] == e) { PS[seg * 32 + i] = pre; ++pre; }
        }
        __syncthreads();
        { const int t3 = F.wave * 64 + lane_id(); const int e = TI[t3]; const size_t sl = (size_t)e * MROWS + EB[e] + PS[t3];
            list2[sl] = (blk * 128 + (t3 >> 2)) * 4 + (t3 & 3); gslot2[sl] = GT[t3]; }
        { const int lane = lane_id();
            f32x4 PA[4], PB[4];
#pragma unroll
            for (int jj = 0; jj < 4; ++jj) { const int c = 4 * lane + 256 * jj; PA[jj] = *(const f32x4*)(g2n + c) * (*(const f32x4*)(sc2 + c) + 1.f); PB[jj] = *(const f32x4*)(sh2 + c); }
            for (int it = 0; it < 2; ++it) { u32x2 xb[8][4];
#pragma unroll
                for (int u = 0; u < 8; ++u) { const GAS u32x2* xr = (const GAS u32x2*)(XN + (size_t)(blk * 128 + F.wave * 16 + 8 * it + u) * DM) + lane;
#pragma unroll
                    for (int jj = 0; jj < 4; ++jj) xb[u][jj] = xr[64 * jj]; }
#pragma unroll
                for (int u = 0; u < 8; ++u) { const int rl = F.wave * 16 + 8 * it + u; const float rstd = RSTD[rl];
                    GAS unsigned* o4 = (GAS unsigned*)(H2 + (size_t)(blk * 128 + rl) * DM) + lane;
#pragma unroll
                    for (int jj = 0; jj < 4; ++jj) {
                        const f32x4 x = (f32x4){__uint_as_float(xb[u][jj].x << 16), __uint_as_float(xb[u][jj].x & 0xffff0000u), __uint_as_float(xb[u][jj].y << 16), __uint_as_float(xb[u][jj].y & 0xffff0000u)};
                        const f32x4 h = x * rstd * PA[jj] + PB[jj];
                        o4[64 * jj] = pk4_fp8(h.x, h.y, h.z, h.w); } } }
        }
    }
#undef in
}

template <int NPN> struct SchedMoE {
    int G, c, nT; const char* A; const char* W; size_t wstride; const LAS unsigned char* tileE; const LAS int* RW; bool gath;
    __device__ __forceinline__ long lidx(int T, int e, int i) const { const LAS int* TB = (const LAS int*)(tileE + 544); const int r = (T - TB[e]) * 256 + i; return (r < TB[32 + e]) ? (long)e * MROWS + r : -1L; }
    __device__ __forceinline__ const LAS int* rows(int i) const { return RW + i * 256; }
    __device__ __forceinline__ bool next(int i, g8::Unit& u) const {
        const int L = i * G + c, xcd = L & 7, j = L >> 3, nTx = (nT + 7) >> 3, tl = j / NPN, T = xcd * nTx + tl, pn = j % NPN;
        if (tl >= nTx || T >= nT) return false;
        const int e = tileE[T];
        u.pm = T; u.pn = pn; u.kind = i; u.ex = e; u.a = gath ? A : A + (size_t)T * 256 * DM; u.b = W + (size_t)e * wstride + (size_t)pn * 256 * DM; return true;
    }
};
struct EpiSwiGLU {
    unsigned char* ACT; const float* b1;
    struct Pre { f32x4 bg[2], bl[2]; };
    __device__ __forceinline__ Pre preload(const g8::Unit& u, int wr, int wc, int fr, int fq) const {
        const int j0 = u.pn * 128 + wc * 32 + 8 * fq; const float* bp = b1 + (size_t)u.ex * 2 * DM + j0; Pre p;
#pragma unroll
        for (int n = 0; n < 2; ++n) { p.bg[n] = *(const f32x4*)(bp + 4 * n); p.bl[n] = *(const f32x4*)(bp + DM + 4 * n); }
        return p;
    }
    __device__ __forceinline__ void operator()(f32x4 (&acc)[2][2][4][2], const g8::Unit& u, int wr, int wc, int fr, int fq, const Pre& P) const {
        asm volatile("" : "+v"(fr), "+v"(fq));
        const int j0 = u.pn * 128 + wc * 32 + 8 * fq;
        const f32x4 bg[2] = {P.bg[0], P.bg[1]}, bl[2] = {P.bl[0], P.bl[1]};
#pragma unroll
        for (int ai = 0; ai < 2; ++ai)
#pragma unroll
            for (int m = 0; m < 4; ++m) { const size_t slot = (size_t)u.pm * 256 + ai * 128 + wr * 64 + m * 16 + fr; float o[8];
#pragma unroll
                for (int n = 0; n < 2; ++n) {
                    const f32x4 ag = acc[ai][0][m][n], al = acc[ai][1][m][n];
#pragma unroll
                    for (int h = 0; h < 2; ++h) {
                        const f32x2 S2 = {1.f / WSCALE, 1.f / WSCALE}, C2 = {-1.702f * 1.4426950408889634f, -1.702f * 1.4426950408889634f}, ONE2 = {1.f, 1.f};
                        f32x2 g2 = (f32x2){ag[2 * h], ag[2 * h + 1]} * S2 + (f32x2){bg[n][2 * h], bg[n][2 * h + 1]};
                        f32x2 l2 = (f32x2){al[2 * h], al[2 * h + 1]} * S2 + (f32x2){bl[n][2 * h], bl[n][2 * h + 1]};
                        g2.x = fminf(g2.x, 7.f); g2.y = fminf(g2.y, 7.f); l2.x = __builtin_amdgcn_fmed3f(l2.x, -7.f, 7.f); l2.y = __builtin_amdgcn_fmed3f(l2.y, -7.f, 7.f);
                        const f32x2 gc = g2 * C2; const f32x2 ex = {__builtin_amdgcn_exp2f(gc.x), __builtin_amdgcn_exp2f(gc.y)};
                        const f32x2 den = ex + ONE2; const f32x2 r = {__builtin_amdgcn_rcpf(den.x), __builtin_amdgcn_rcpf(den.y)};
                        const f32x2 glu = g2 * r; const f32x2 ov = l2 * glu + glu;
                        o[4 * n + 2 * h] = ov.x; o[4 * n + 2 * h + 1] = ov.y; } }
                u32x2 w; w.x = pk4_fp8(o[0], o[1], o[2], o[3]); w.y = pk4_fp8(o[4], o[5], o[6], o[7]);
                *(u32x2*)(ACT + slot * DM + j0) = w; }
    }
};
struct EpiDown {
    unsigned char* EO; const float* b2; const LAS int* LL; int G, c;
    struct Pre { f32x4 bb[2][2]; };
    __device__ __forceinline__ Pre preload(const g8::Unit& u, int wr, int wc, int fr, int fq) const {
        const int c0 = u.pn * 256 + wc * 64 + 16 * fq; const float* bp = b2 + (size_t)u.ex * DM + c0; Pre p;
#pragma unroll
        for (int bj = 0; bj < 2; ++bj)
#pragma unroll
            for (int n = 0; n < 2; ++n) p.bb[bj][n] = *(const f32x4*)(bp + bj * 8 + 4 * n);
        return p;
    }
    __device__ __forceinline__ void operator()(f32x4 (&acc)[2][2][4][2], const g8::Unit& u, int wr, int wc, int fr, int fq, const Pre& P) const {
        asm volatile("" : "+v"(fr), "+v"(fq));
        const int c0 = u.pn * 256 + wc * 64 + 16 * fq;
        const f32x4 bb[2][2] = {{P.bb[0][0], P.bb[0][1]}, {P.bb[1][0], P.bb[1][1]}};
        const LAS int* L = LL + u.kind * 512;
        int li[8]; float gt[8];
#pragma unroll
        for (int q = 0; q < 8; ++q) { const int rl = (q >> 2) * 128 + wr * 64 + (q & 3) * 16 + fr; li[q] = L[rl]; gt[q] = __int_as_float(L[256 + rl]) * (1.f / WSCALE); }
#pragma unroll
        for (int ai = 0; ai < 2; ++ai)
#pragma unroll
            for (int m = 0; m < 4; ++m) { const int l = li[ai * 4 + m]; const float g = gt[ai * 4 + m];
                unsigned char* dst = EO + ((size_t)(l & 3) * MROWS + (l >> 2)) * DM + c0;
                u32x4 w;
                { const f32x4 v0 = acc[ai][0][m][0] * g + bb[0][0] * (g * WSCALE), v1 = acc[ai][0][m][1] * g + bb[0][1] * (g * WSCALE);
                  w.x = pk4_fp8(v0[0] * EOSCALE, v0[1] * EOSCALE, v0[2] * EOSCALE, v0[3] * EOSCALE); w.y = pk4_fp8(v1[0] * EOSCALE, v1[1] * EOSCALE, v1[2] * EOSCALE, v1[3] * EOSCALE); }
                { const f32x4 v0 = acc[ai][1][m][0] * g + bb[1][0] * (g * WSCALE), v1 = acc[ai][1][m][1] * g + bb[1][1] * (g * WSCALE);
                  w.z = pk4_fp8(v0[0] * EOSCALE, v0[1] * EOSCALE, v0[2] * EOSCALE, v0[3] * EOSCALE); w.w = pk4_fp8(v1[0] * EOSCALE, v1[1] * EOSCALE, v1[2] * EOSCALE, v1[3] * EOSCALE); }
                if (l >= 0) *(u32x4*)dst = w; }
    }
};
__device__ __forceinline__ const LAS unsigned char* moe_tiles(Frame& F, int& nT) {
    FT_DECL;
    LAS unsigned char* TE = (LAS unsigned char*)(F.lds + RING_BYTES); LAS int* TB = (LAS int*)(TE + 544); LAS int* TOT = TB + 32; LAS int* NTL = TOT + 32;
    const int* ecnt = (const int*)(F.ctl + CW_ECNT);
    __syncthreads();
    if (f_tid < 32) { const int t = ecnt[f_tid]; TOT[f_tid] = t; NTL[f_tid] = (t + 255) >> 8; }
    __syncthreads();
    if (f_tid < 33) { int b = 0; for (int e = 0; e < f_tid; ++e) b += NTL[e]; if (f_tid < 32) TB[f_tid] = b; else NTL[32] = b; }
    __syncthreads();
    nT = NTL[32]; if (nT > MAXTILE) nT = MAXTILE;
    for (int i = f_tid; i < MAXTILE; i += 512) { int e = 0;
#pragma unroll 8
        for (int q = 0; q < 32; ++q) e += (TB[q] + NTL[q] <= i) ? 1 : 0;
        TE[i] = (unsigned char)((i < nT) ? e : 0); }
    __syncthreads();
    return (const LAS unsigned char*)TE;
}

__device__ __forceinline__ void p10_combine(Frame& F) {
    FT_DECL;
    const float* mod = WSP(float, WS_SMALL + SM_MOD); const unsigned char* EO = WSP(unsigned char, WS_EO);
    const size_t gt = (size_t)F.vcu * 512 + f_tid, NTH = (size_t)F.G * 512;
    constexpr int U = 4;
    for (size_t i0 = gt; i0 < (size_t)MROWS * 128; i0 += NTH * U) {
        u32x2 ev[U][4]; f32x4 xv[U][2], gv[U][2];
#pragma unroll
        for (int u = 0; u < U; ++u) { const size_t i = i0 + (size_t)u * NTH; const size_t row = i >> 7; const int c0 = (int)(i & 127) * 8;
            const float* g2 = mod + (size_t)(row >> 12) * (NMOD * DM) + 5 * DM + c0; const bf16_t* op = WSP(bf16_t, WS_XN) + row * DM + c0;
#pragma unroll
            for (int k = 0; k < 4; ++k) ev[u][k] = __builtin_nontemporal_load((const u32x2*)(EO + ((size_t)k * MROWS + row) * DM + c0));
            { const u32x4 xb = *(const u32x4*)op; xv[u][0] = (f32x4){__uint_as_float(xb.x << 16), __uint_as_float(xb.x & 0xffff0000u), __uint_as_float(xb.y << 16), __uint_as_float(xb.y & 0xffff0000u)};
              xv[u][1] = (f32x4){__uint_as_float(xb.z << 16), __uint_as_float(xb.z & 0xffff0000u), __uint_as_float(xb.w << 16), __uint_as_float(xb.w & 0xffff0000u)}; }
            gv[u][0] = *(const f32x4*)g2; gv[u][1] = *(const f32x4*)(g2 + 4); }
#pragma unroll
        for (int u = 0; u < U; ++u) { const size_t i = i0 + (size_t)u * NTH; const size_t row = i >> 7; const int c0 = (int)(i & 127) * 8;
            float s[8];
#pragma unroll
            for (int e = 0; e < 8; ++e) s[e] = 0.f;
#pragma unroll
            for (int k = 0; k < 4; ++k) { const u32x2 v = ev[u][k];
                const f32x2 a = __builtin_amdgcn_cvt_pk_f32_fp8((int)v.x, false), b = __builtin_amdgcn_cvt_pk_f32_fp8((int)v.x, true), c = __builtin_amdgcn_cvt_pk_f32_fp8((int)v.y, false), d = __builtin_amdgcn_cvt_pk_f32_fp8((int)v.y, true);
                s[0] += a.x; s[1] += a.y; s[2] += b.x; s[3] += b.y; s[4] += c.x; s[5] += c.y; s[6] += d.x; s[7] += d.y; }
#pragma unroll
            for (int e = 0; e < 8; ++e) s[e] *= (1.f / EOSCALE);
            f32x4 o0 = xv[u][0] + gv[u][0] * (f32x4){s[0], s[1], s[2], s[3]}, o1 = xv[u][1] + gv[u][1] * (f32x4){s[4], s[5], s[6], s[7]};
            float* op = F.out + row * DM + c0;
            __builtin_nontemporal_store(o0, (f32x4*)op); __builtin_nontemporal_store(o1, (f32x4*)(op + 4)); }
    }
}

struct Args { const float* in[34]; float* out; unsigned char* ws; int ph_lo, ph_hi; };
constexpr int N_PHASES = 11;

__global__ void __launch_bounds__(512, 2) mega(Args args) {
    extern __shared__ __attribute__((aligned(16))) unsigned char lds[];
    Frame F;
    F.lds = (LAS unsigned char*)lds;
    F.MISC = (volatile LAS unsigned*)(F.lds + LDSCTL_OFF);
    F.wave = __builtin_amdgcn_readfirstlane(threadIdx.x >> 6);
    FT_DECL;
    F.G = gridDim.x; { const int bx = blockIdx.x; F.vcu = (F.G % 8 == 0) ? (bx % 8) * (F.G / 8) + bx / 8 : bx; }
    F.in = (kin_t)__builtin_amdgcn_kernarg_segment_ptr();
    F.out = args.out; F.ws = args.ws;
    F.ctl = (gu32*)(args.ws + WS_CTL);
    for (int u = f_tid; u < (LDS_BYTES - LDSCTL_OFF) / 4; u += NWAVES * 64) ((LAS unsigned*)(F.lds + LDSCTL_OFF))[u] = 0u;
    __syncthreads();
    if (f_tid == 0) __hip_atomic_store((unsigned*)(F.ctl + CW_XCC + blockIdx.x), xb_xcc_id() + 1u, RLX_AGENT);
    const int lo = args.ph_lo, hi = args.ph_hi;
    XcdBarrier bar; bar.bar = (unsigned*)(F.ctl + CW_BAR); bar.x = 0; bar.st = nullptr;
    if (hi - lo > 1) bar = xcd_barrier_post((unsigned*)(F.ctl + CW_BAR), F.MISC + 8, f_tid == 0);
#define IN(k) (lo <= (k) && (k) < hi)
#define SEAM(k) do { if (IN(k) && IN((k) + 1)) xcd_barrier(bar, F.wave == 0 && lane_id() == 0); } while (0)

    if (IN(0)) { p0_prologue(F); }
    if (IN(1)) { p1_norm1(F); }
    { const bool split1 = IN(1) && IN(2); XbTicket tk1; tk1.mode = 3u; tk1.gen = 0u;
        if (split1) tk1 = xcd_barrier_arrive(bar, F.wave == 0 && lane_id() == 0);
        if (IN(1)) p1_rbias(F);
        if (split1) xcd_barrier_wait(bar, tk1, F.wave == 0 && lane_id() == 0); }
    if (IN(2)) {
        LAS float* ropeL = (LAS float*)(F.lds + RING_BYTES + 8192);
        { const float* rt = WSP(float, WS_SMALL + SM_ROPE); const int t2 = F.wave * 64 + lane_id(); __syncthreads();
            for (int i = t2; i < 64 * 16 * 2; i += 512) { const int pf = i >> 1, cs = i & 1, f = pf & 15; ropeL[((pf - f) + (f & ~3)) * 2 + cs * 4 + (f & 3)] = rt[i]; }
            __syncthreads(); }
        EpiInProj E{WSP(unsigned char, WS_Q), WSP(unsigned char, WS_K), WSP(unsigned char, WS_V), WSP(bf16_t, WS_UT), F.in[9], F.in[10], ropeL};
        constexpr int NU8 = SchedInProj8::NA + SchedInProj8::NV;
#define P2_POS(p8v, pbv, qv, ncwv) int p8v, pbv, qv, ncwv; { int cc = (int)blockIdx.x; asm volatile("" : "+s"(cc)); const int base8 = NU8 / F.G, rem8 = NU8 % F.G, nb16 = (SchedInProj::NBU + F.G - 1) / F.G; \
            qv = cc - rem8; ncwv = F.G - rem8; const int pos = (cc >= rem8) ? qv % (base8 + nb16 + 1) : -1; \
            p8v = (pos >= 0 && pos <= base8) ? pos : -1; pbv = (pos > base8) ? pos - base8 : -1; }
#pragma unroll 1
        for (int part = 0; part < 2; ++part) {
            { P2_POS(p8, pb, q, ncw); (void)pb; (void)q; (void)ncw; if (part == 1 && p8 < 0) break;
              SchedInProj8 S{F.G, (int)blockIdx.x, (const char*)WSP(char, WS_H8), (const char*)WSP(char, WS_WIN8), part ? p8 : 0, (part == 0 && p8 >= 0) ? p8 : (1 << 30)};
              g8::gemm_phase<true>(F.lds, DM, S, E, F.wave, lane_id()); }
            { P2_POS(p8, pb, q, ncw); (void)pb; if (part == 0 && p8 >= 0) p2_convert_chunk(F, q, ncw, 0, CV_SPLIT); }
        }
#pragma unroll 1
        for (int part = 0; part < 2; ++part) {
            { P2_POS(p8, pb, q, ncw); (void)p8; (void)q; (void)ncw; if (part == 1 && pb < 0) break;
              SchedInProj S{F.G, (int)blockIdx.x, (const char*)WSP(bf16_t, WS_H), (const char*)WSP(bf16_t, WS_WIN), part ? pb : 0, (part == 0 && pb >= 0) ? pb : (1 << 30), NU8};
              g8::gemm_phase<false>(F.lds, DM, S, E, F.wave, lane_id()); }
            { P2_POS(p8, pb, q, ncw); (void)p8; if (part == 0 && pb >= 0) p2_convert_chunk(F, q, ncw, 0, CV_SPLIT); }
        }
#undef P2_POS
    } SEAM(2);
    if (IN(3)) {
        const int cslot = (int)((blockIdx.x >> 4) + (blockIdx.x & 7)) % 5; const bool hfirst = (blockIdx.x & 8) != 0;
#pragma unroll 1
        for (int blk = 0; blk < 2; ++blk) {
            if ((blk == 0) == hfirst) { if (cslot == 4) p2_convert_chunk(F, (int)blockIdx.x, F.G, CV_SPLIT, CV_NIT); p3_hyena(F); }
            else p3_attention8(F, cslot < 4 ? cslot : -1);
            __syncthreads(); }
    } SEAM(3);
    if (IN(4)) { p4_hynorm(F); } SEAM(4);
    if (IN(5)) {
        SchedStatic S{F.G, (int)blockIdx.x, MROWS / 256, DM / 256, (const char*)WSP(bf16_t, WS_MIX), (const char*)WSP(bf16_t, WS_WOUT)};
        EpiOutProj E{F.in[0], WSP(bf16_t, WS_XN), WSP(float, WS_SMALL + SM_MOD)};
        g8::gemm_phase<false>(F.lds, DM, S, E, F.wave, lane_id());
        asm volatile("s_waitcnt vmcnt(0)" ::: "memory");
        __syncthreads();
        if (f_tid == 0) { g8::Unit u; const unsigned me = xb_xcc_id() + 1u; bool same = (F.G % 8 == 0); const int G8 = F.G / 8;
            for (int i = 0; S.next(i, u); ++i)
#pragma unroll
                for (int h = 0; h < 2; ++h) { const int blk = 2 * u.pm + h; same = same && (xb_ld((unsigned*)(F.ctl + CW_XCC + (blk % G8) * 8 + blk / G8)) == me); }
            if (!same) __builtin_amdgcn_fence(__ATOMIC_RELEASE, "agent");
            asm volatile("s_waitcnt vmcnt(0)" ::: "memory");
            for (int i = 0; S.next(i, u); ++i) (void)xb_add((unsigned*)(F.ctl + CW_MT + u.pm), 1u); }
    }
    if (IN(6)) { p6_router_mfma(F, IN(5)); } SEAM(6);
    if (IN(8)) {
        int nT; const LAS unsigned char* TE = moe_tiles(F, nT);
        LAS int* RWL = (LAS int*)(F.lds + RING_BYTES + 1024);
        static_assert(RING_BYTES + 1024 + 17 * 1024 <= LDSCTL_OFF, "LDS map");
        SchedMoE<8> S{F.G, (int)blockIdx.x, nT, (const char*)WSP(char, WS_H), (const char*)WSP(char, WS_W1), (size_t)2 * DM * DM, TE, RWL, true};
        { const int* list = WSP(int, WS_LIST2); const int t8 = F.wave * 64 + lane_id();
            g8::Unit u; for (int i = 0; i < 17 && S.next(i, u); i += 2) { const int ii = i + (t8 >> 8); g8::Unit u2; if (S.next(ii, u2)) { const long ix = S.lidx(u2.pm, u2.ex, t8 & 255); RWL[ii * 256 + (t8 & 255)] = (ix >= 0) ? (list[ix] >> 2) : 0; } }
            __syncthreads(); }
        EpiSwiGLU E{WSP(unsigned char, WS_ACT), F.in[31]};
        g8::gemm_phase_g<true, true>(F.lds, DM, S, E, F.wave, lane_id());
    }
    const bool split8 = IN(8) && IN(9); XbTicket tk8; tk8.mode = 3u; tk8.gen = 0u;
    if (split8) tk8 = xcd_barrier_arrive(bar, F.wave == 0 && lane_id() == 0);
    if (IN(9)) {
        int nT; const LAS unsigned char* TE;
        if (IN(8)) { TE = (const LAS unsigned char*)(F.lds + RING_BYTES); nT = ((const LAS int*)(TE + 544))[96]; if (nT > MAXTILE) nT = MAXTILE; }
        else TE = moe_tiles(F, nT);
        SchedMoE<4> S{F.G, (int)blockIdx.x, nT, (const char*)WSP(char, WS_ACT), (const char*)WSP(char, WS_W2), (size_t)DM * DM, TE, nullptr, false};
        LAS int* LL = (LAS int*)(F.lds + RING_BYTES + 1024);
        static_assert(RING_BYTES + 1024 + 9 * 2048 <= LDSCTL_OFF, "LDS map");
        { const int* list = WSP(int, WS_LIST2); const float* gslot = WSP(float, WS_GSLOT2);
            const int t9 = F.wave * 64 + lane_id();
            g8::Unit u; for (int i = 0; i < 9 && S.next(i, u); ++i) { const int t = t9 & 255; const long ix = S.lidx(u.pm, u.ex, t);
                LL[i * 512 + (t9 >> 8) * 256 + t] = (ix < 0) ? ((t9 < 256) ? -1 : 0) : ((t9 < 256) ? list[ix] : __float_as_int(gslot[ix])); }
            __syncthreads(); }
        if (split8) xcd_barrier_wait(bar, tk8, F.wave == 0 && lane_id() == 0);
        EpiDown E{WSP(unsigned char, WS_EO), F.in[33], LL, F.G, (int)blockIdx.x};
        g8::gemm_phase<true>(F.lds, DM, S, E, F.wave, lane_id());
    } SEAM(9);
    if (IN(10)) { p10_combine(F); }
#undef IN
#undef SEAM
}

extern "C" void kernel_launch(void* const* d_in, const int* in_sizes, int n_in, void* d_out, int out_size, void* d_ws, size_t ws_size, hipStream_t stream) {
    static int grid = 0;
    if (grid == 0) {
        if (n_in != 34 || out_size != MROWS * DM || ws_size < WS_END) { fprintf(stderr, "kernel_launch: unexpected shapes: n_in %d out %d ws %zu (need %zu)\n", n_in, out_size, ws_size, (size_t)WS_END); grid = -1; return; }
        int dev = 0, cus = 0, per_cu = 0;
        if (hipGetDevice(&dev) != hipSuccess || hipDeviceGetAttribute(&cus, hipDeviceAttributeMultiprocessorCount, dev) != hipSuccess) { grid = -1; return; }
        if (hipFuncSetAttribute((const void*)mega, hipFuncAttributeMaxDynamicSharedMemorySize, LDS_BYTES) != hipSuccess) { fprintf(stderr, "kernel_launch: hipFuncSetAttribute failed\n"); grid = -1; return; }
        if (hipOccupancyMaxActiveBlocksPerMultiprocessor(&per_cu, (const void*)mega, NWAVES * 64, LDS_BYTES) != hipSuccess || per_cu < 1) { fprintf(stderr, "kernel_launch: occupancy query says %d\n", per_cu); per_cu = 1; }
        (void)hipGetLastError();
        grid = cus;
    }
    if (grid < 0) return;
    (void)hipMemsetAsync((char*)d_ws + WS_CTL, 0, CTL_ZERO_BYTES, stream);
    Args a{};
    for (int i = 0; i < 34; ++i) a.in[i] = (const float*)d_in[i];
    a.out = (float*)d_out; a.ws = (unsigned char*)d_ws;
    constexpr int LAST = MK_LAST_PHASE + 1;
    if (MK_N_LAUNCHES == 1) { a.ph_lo = 0; a.ph_hi = LAST; hipLaunchKernelGGL(mega, dim3(grid), dim3(NWAVES * 64), LDS_BYTES, stream, a); }
    else for (int p = 0; p < LAST; ++p) { a.ph_lo = p; a.ph_hi = p + 1; hipLaunchKernelGGL(mega, dim3(grid), dim3(NWAVES * 64), LDS_BYTES, stream, a); }
    const hipError_t le = hipPeekAtLastError();
    if (le != hipSuccess) fprintf(stderr, "kernel_launch: launch failed: %s\n", hipGetErrorName(le));
}
```
